# Optimizing an MI355X kernel written in HIP

```python
import math
import jax
import jax.numpy as jnp
from jax import lax
import numpy as np

D_MODEL = 1024
BATCH = 16
SEQ = 256
DEPTH = 2
DEC_BATCH = 2
DEC_SEQ = 2048
PAST_LEN = 256

GRID_W = 64
HEAD_DIM = 64
NA_HEADS = 6
NA_WIN_ROWS = 8
NA_WIN_COLS = 16
ML_HEADS = 4
ML_CHUNK = 64
GQA_HEADS = 6
GQA_KV_HEADS = 2
Q_BLOCK = 128
ROPE_THETA = 10000.0
N_EXPERTS = 16
EC_CAPACITY = 2
EXPERT_HIDDEN = 2816
NORM_EPS = 1e-6
NA_W = NA_HEADS * HEAD_DIM
ML_W = ML_HEADS * HEAD_DIM
GQA_W = GQA_HEADS * HEAD_DIM
GQA_KV_W = GQA_KV_HEADS * HEAD_DIM
MIX_W = NA_W + ML_W + GQA_W
N_GATES = 4 * ML_HEADS
PROJ_SIZES = (NA_W, NA_W, NA_W, ML_W, ML_W, ML_W, ML_W, N_GATES, GQA_W, GQA_KV_W, GQA_KV_W)
PROJ_W = 3 * NA_W + 4 * ML_W + N_GATES + GQA_W + 2 * GQA_KV_W
DEEPNORM_ALPHA = (2 * DEPTH) ** 0.25
DEEPNORM_BETA = (8 * DEPTH) ** -0.25
ATTN_SCALE = HEAD_DIM ** -0.5
F32 = jnp.float32

kernel_name = 'hybrid_diffusion_na_mlstm_gqa_ec_step'


def layer_norm(x, g, b):
    xf = x.astype(F32)
    mu = jnp.mean(xf, -1, keepdims=True)
    var = jnp.mean(jnp.square(xf - mu), -1, keepdims=True)
    return ((xf - mu) * lax.rsqrt(var + NORM_EPS) * g + b).astype(x.dtype)


def rms_norm(x, g):
    xf = x.astype(F32)
    return (xf * lax.rsqrt(jnp.mean(xf * xf, -1, keepdims=True) + NORM_EPS) * g).astype(x.dtype)


def adaln_modulation(cond, ada_w, ada_b):
    m = jax.nn.silu(cond) @ ada_w + ada_b
    return jnp.split(m, 6, axis=-1)


def modulate(x, shift, scale):
    return x * (1.0 + scale[:, None, :]) + shift[:, None, :]


def heads(a):
    return a.reshape(*a.shape[:-1], a.shape[-1] // HEAD_DIM, HEAD_DIM)


def split_projection(z):
    parts, start = [], 0
    for size in PROJ_SIZES:
        parts.append(z[..., start:start + size])
        start += size
    return parts


def axial_rope(n_tokens):
    t = jnp.arange(n_tokens)
    row = (t // GRID_W).astype(F32)
    col = (t % GRID_W).astype(F32)
    half = HEAD_DIM // 2
    inv = ROPE_THETA ** (-jnp.arange(0, half, 2, dtype=F32) / half)
    ang_r = row[:, None] * inv
    ang_c = col[:, None] * inv
    ang = jnp.concatenate([ang_r, ang_r, ang_c, ang_c], -1)
    return jnp.cos(ang), jnp.sin(ang)


def rotate_half(x):
    x1, x2 = jnp.split(x, 2, -1)
    return jnp.concatenate([-x2, x1], -1)


def apply_axial_rope(x, cos, sin):
    xf = x.astype(F32)
    xr, xc = jnp.split(xf, 2, -1)
    rot = jnp.concatenate([rotate_half(xr), rotate_half(xc)], -1)
    return (xf * cos[:, None, :] + rot * sin[:, None, :]).astype(x.dtype)


def dense_attention(q, k, v):
    B, S, Hq, d = q.shape
    Hk = k.shape[2]
    qg = q.reshape(B, S, Hk, Hq // Hk, d)
    s = jnp.einsum('bqhgd,bkhd->bhgqk', qg, k).astype(F32) * ATTN_SCALE
    p = jax.nn.softmax(s, -1).astype(v.dtype)
    o = jnp.einsum('bhgqk,bkhd->bqhgd', p, v)
    return o.reshape(B, S, Hq * d)


def neighbourhood_attention(q, k, v, rpb, ctx_k, ctx_v):
    B, L, H, d = q.shape
    rows = L // GRID_W
    kr = min(NA_WIN_ROWS, rows)
    kc = NA_WIN_COLS
    r = jnp.arange(rows)
    row_start = jnp.clip(r - kr // 2, 0, rows - kr)
    row_idx = row_start[:, None] + jnp.arange(kr)
    cq = jnp.arange(GRID_W)
    col_start = jnp.clip(cq - kc // 2, 0, GRID_W - kc)
    ck = jnp.arange(GRID_W)
    in_win = (ck[None, :] >= col_start[:, None]) & (ck[None, :] < col_start[:, None] + kc)
    dr = row_idx - r[:, None]
    dc = jnp.clip(ck[None, :] - cq[:, None], -(kc - 1), kc - 1)
    bias = rpb[:, dr[:, None, :, None] + NA_WIN_ROWS - 1, dc[None, :, None, :] + NA_WIN_COLS - 1]
    bias = jnp.transpose(bias, (1, 2, 0, 3, 4)).astype(F32)
    qg = q.reshape(B, rows, GRID_W, H, d)
    kg = k.reshape(B, rows, GRID_W, H, d)[:, row_idx]
    vg = v.reshape(B, rows, GRID_W, H, d)[:, row_idx]
    s_loc = jnp.einsum('brwhd,brjkhd->brwhjk', qg, kg).astype(F32) * ATTN_SCALE + bias[None]
    s_loc = jnp.where(in_win[None, None, :, None, None, :], s_loc, -jnp.inf)
    s_ctx = jnp.einsum('brwhd,bphd->brwhp', qg, ctx_k).astype(F32) * ATTN_SCALE
    n_loc = kr * GRID_W
    s = jnp.concatenate([s_loc.reshape(B, rows, GRID_W, H, n_loc), s_ctx], -1)
    p = jax.nn.softmax(s, -1).astype(v.dtype)
    p_loc = p[..., :n_loc].reshape(B, rows, GRID_W, H, kr, GRID_W)
    p_ctx = p[..., n_loc:]
    o = jnp.einsum('brwhjk,brjkhd->brwhd', p_loc, vg) + jnp.einsum('brwhp,bphd->brwhd', p_ctx, ctx_v)
    return o.reshape(B, L, H * d)


def gqa_latent(q, k, v, ctx_k, ctx_v):
    B, L, Hq, d = q.shape
    Hk = k.shape[2]
    keys = jnp.concatenate([ctx_k, k], 1)
    vals = jnp.concatenate([ctx_v, v], 1)
    qb = q.reshape(B, L // Q_BLOCK, Q_BLOCK, Hk, Hq // Hk, d).transpose(1, 0, 2, 3, 4, 5)

    def block(qi):
        s = jnp.einsum('bqhgd,bkhd->bhgqk', qi, keys).astype(F32) * ATTN_SCALE
        p = jax.nn.softmax(s, -1).astype(vals.dtype)
        return jnp.einsum('bhgqk,bkhd->bqhgd', p, vals)

    o = lax.map(block, qb)
    return o.transpose(1, 0, 2, 3, 4, 5).reshape(B, L, Hq * d)


def mlstm_chunked(q, k, v, log_i, log_f, c0, n0, m0):
    B, H, L, d = q.shape
    T = ML_CHUNK
    nc = L // T

    def to_chunks(a):
        return jnp.moveaxis(a.reshape(B, H, nc, T, *a.shape[3:]), 2, 0)

    xs = tuple(to_chunks(a) for a in (q, k, v, log_i, log_f))
    causal = jnp.tril(jnp.ones((T, T), bool))

    def step(carry, inp):
        c, n, m = carry
        qc, kc, vc, ic, fc = inp
        b = jnp.cumsum(fc, -1)
        dmat = b[..., :, None] - b[..., None, :] + ic[..., None, :]
        dmat = jnp.where(causal, dmat, -jnp.inf)
        m_inter = b + m[..., None]
        m_j = jnp.maximum(m_inter, jnp.max(dmat, -1))
        w = jnp.exp(dmat - m_j[..., None])
        decay = jnp.exp(m_inter - m_j)
        qk = jnp.einsum('bhjd,bhsd->bhjs', qc, kc) * w
        num = decay[..., None] * jnp.einsum('bhjk,bhkv->bhjv', qc, c) + jnp.einsum('bhjs,bhsv->bhjv', qk, vc)
        den = decay * jnp.einsum('bhjk,bhk->bhj', qc, n) + jnp.sum(qk, -1)
        h = num / jnp.maximum(jnp.abs(den), jnp.exp(-m_j))[..., None]
        b_last = b[..., -1]
        g = b_last[..., None] - b + ic
        m_new = jnp.maximum(b_last + m, jnp.max(g, -1))
        ws = jnp.exp(g - m_new[..., None])
        d_last = jnp.exp(b_last + m - m_new)
        c_new = d_last[..., None, None] * c + jnp.einsum('bhs,bhsk,bhsv->bhkv', ws, kc, vc)
        n_new = d_last[..., None] * n + jnp.einsum('bhs,bhsk->bhk', ws, kc)
        return (c_new, n_new, m_new), h

    (c, n, m), h = lax.scan(step, (c0, n0, m0), xs)
    h = jnp.moveaxis(h, 0, 2).reshape(B, H, L, d)
    return h, c, n, m


def mlstm_mix(ml, norm_g, c0, n0, m0):
    q, k, v, o, g = ml
    gi_f, gf_f, gi_b, gf_b = [jnp.swapaxes(a, 1, 2) for a in jnp.split(g.astype(F32), 4, -1)]
    c0, n0, m0 = c0.astype(F32), n0.astype(F32), m0.astype(F32)
    h_f, cf, nf, mf = mlstm_chunked(q, k, v, gi_f, jax.nn.log_sigmoid(gf_f), c0[:, 0], n0[:, 0], m0[:, 0])
    flip = lambda a: jnp.flip(a, 2)
    h_b, cb, nb, mb = mlstm_chunked(flip(q), flip(k), flip(v), flip(gi_b), jax.nn.log_sigmoid(flip(gf_b)),
                                    c0[:, 1], n0[:, 1], m0[:, 1])
    h = h_f + flip(h_b)
    mu = jnp.mean(h, -1, keepdims=True)
    var = jnp.mean(jnp.square(h - mu), -1, keepdims=True)
    h = (h - mu) * lax.rsqrt(var + NORM_EPS)
    B, H, L, d = h.shape
    h = jnp.swapaxes(h, 1, 2).reshape(B, L, H * d) * norm_g
    out = (h * jax.nn.sigmoid(o.astype(F32))).astype(o.dtype)
    return out, (jnp.stack([cf, cb], 1), jnp.stack([nf, nb], 1), jnp.stack([mf, mb], 1))


def mixer_inputs(h, w_in, b_gate, qk_norm_g):
    z = h @ w_in
    na_q, na_k, na_v, ml_q, ml_k, ml_v, ml_o, ml_g, gq_q, gq_k, gq_v = split_projection(z)
    to_bhld = lambda a: jnp.swapaxes(heads(a), 1, 2).astype(F32)
    na = (heads(na_q), heads(na_k), heads(na_v))
    ml = (to_bhld(ml_q), to_bhld(ml_k) * ATTN_SCALE, to_bhld(ml_v), ml_o, ml_g + b_gate)
    gq = (rms_norm(heads(gq_q), qk_norm_g[0]), rms_norm(heads(gq_k), qk_norm_g[1]), heads(gq_v))
    return na, ml, gq


def context_mixers(h, w_in, b_gate, qk_norm_g, ml_norm_g):
    na, ml, gq = mixer_inputs(h, w_in, b_gate, qk_norm_g)
    B = h.shape[0]
    zc = jnp.zeros((B, 2, ML_HEADS, HEAD_DIM, HEAD_DIM), F32)
    zn = jnp.zeros((B, 2, ML_HEADS, HEAD_DIM), F32)
    zm = jnp.zeros((B, 2, ML_HEADS), F32)
    out_a = dense_attention(*na)
    out_b, (sc, sn, sm) = mlstm_mix(ml, ml_norm_g, zc, zn, zm)
    out_c = dense_attention(*gq)
    mixed = jnp.concatenate([out_a, out_b, out_c], -1)
    return mixed, (na[1], na[2], gq[1], gq[2], sc, sn, sm)


def latent_mixers(h, w_in, b_gate, qk_norm_g, ml_norm_g, rpb, ck_a, cv_a, ck_c, cv_c, sc, sn, sm):
    na, ml, gq = mixer_inputs(h, w_in, b_gate, qk_norm_g)
    out_a = neighbourhood_attention(na[0], na[1], na[2], rpb, ck_a, cv_a)
    out_b, _ = mlstm_mix(ml, ml_norm_g, sc, sn, sm)
    cos, sin = axial_rope(h.shape[1])
    out_c = gqa_latent(apply_axial_rope(gq[0], cos, sin), apply_axial_rope(gq[1], cos, sin), gq[2], ck_c, cv_c)
    return jnp.concatenate([out_a, out_b, out_c], -1)


def expert_choice_ffn(x, router_w, w_gate, w_up, w_down):
    n = x.shape[0]
    cap = EC_CAPACITY * n // N_EXPERTS
    aff = jax.nn.softmax((x @ router_w).astype(F32), -1)
    g, idx = lax.top_k(aff.T, cap)
    xe = x[idx]
    hid = jax.nn.silu(jnp.einsum('ecd,edf->ecf', xe, w_gate)) * jnp.einsum('ecd,edf->ecf', xe, w_up)
    ye = jnp.einsum('ecf,efd->ecd', hid, w_down) * g[..., None].astype(x.dtype)
    return jnp.zeros_like(x).at[idx.reshape(-1)].add(ye.reshape(-1, x.shape[-1]))


def finish_layer(x, mixed, mods, w_out, ln_g, ln_b, router_w, w_gate, w_up, w_down):
    _, _, gate1, shift2, scale2, gate2 = mods
    x = layer_norm(DEEPNORM_ALPHA * x + gate1[:, None, :] * (mixed @ w_out), ln_g[0], ln_b[0])
    h = modulate(x, shift2, scale2)
    ffn = jax.vmap(expert_choice_ffn, in_axes=(0, None, None, None, None))(h, router_w, w_gate, w_up, w_down)
    return layer_norm(DEEPNORM_ALPHA * x + gate2[:, None, :] * ffn, ln_g[1], ln_b[1])


def setup_inputs(seed: int = 0) -> dict:
    key = jax.random.key(seed)
    ks = jax.random.split(key, 32)

    def nrm(i, shape, scale=1.0):
        return scale * jax.random.normal(ks[i], shape, F32)

    f_bias = jnp.linspace(3.0, 6.0, ML_HEADS, dtype=F32)
    b_gate = jnp.concatenate([nrm(13, (DEPTH, ML_HEADS), 0.1), f_bias + nrm(14, (DEPTH, ML_HEADS), 0.1),
                              nrm(15, (DEPTH, ML_HEADS), 0.1), f_bias + nrm(16, (DEPTH, ML_HEADS), 0.1)], -1)
    return {
        'x_prompt': nrm(0, (BATCH, SEQ, D_MODEL)),
        'x_sample': nrm(1, (DEC_BATCH, DEC_SEQ, D_MODEL)),
        'c': nrm(2, (DEC_BATCH, D_MODEL)),
        'cache_na_k': nrm(3, (DEC_BATCH, DEPTH, PAST_LEN, NA_HEADS, HEAD_DIM)),
        'cache_na_v': nrm(4, (DEC_BATCH, DEPTH, PAST_LEN, NA_HEADS, HEAD_DIM)),
        'cache_gqa_k': nrm(5, (DEC_BATCH, DEPTH, PAST_LEN, GQA_KV_HEADS, HEAD_DIM)),
        'cache_gqa_v': nrm(6, (DEC_BATCH, DEPTH, PAST_LEN, GQA_KV_HEADS, HEAD_DIM)),
        'state_mlstm_c': nrm(7, (DEC_BATCH, DEPTH, 2, ML_HEADS, HEAD_DIM, HEAD_DIM), 0.1),
        'state_mlstm_n': nrm(8, (DEC_BATCH, DEPTH, 2, ML_HEADS, HEAD_DIM), 0.1),
        'state_mlstm_m': nrm(9, (DEC_BATCH, DEPTH, 2, ML_HEADS)),
        'c_ctx': nrm(10, (D_MODEL,)),
        'ada_w': nrm(11, (DEPTH, D_MODEL, 6 * D_MODEL), 0.5 * D_MODEL ** -0.5),
        'ada_b': nrm(12, (DEPTH, 6 * D_MODEL), 0.02),
        'w_in': nrm(17, (DEPTH, D_MODEL, PROJ_W), D_MODEL ** -0.5),
        'b_gate': b_gate,
        'w_out': nrm(18, (DEPTH, MIX_W, D_MODEL), DEEPNORM_BETA * MIX_W ** -0.5),
        'na_rpb': nrm(19, (DEPTH, NA_HEADS, 2 * NA_WIN_ROWS - 1, 2 * NA_WIN_COLS - 1), 0.1),
        'qk_norm_g': 1.0 + nrm(20, (DEPTH, 2, HEAD_DIM), 0.1),
        'ml_norm_g': 1.0 + nrm(21, (DEPTH, ML_W), 0.1),
        'ln_g': 1.0 + nrm(22, (DEPTH, 2, D_MODEL), 0.1),
        'ln_b': nrm(23, (DEPTH, 2, D_MODEL), 0.02),
        'router_w': nrm(24, (DEPTH, D_MODEL, N_EXPERTS), D_MODEL ** -0.5),
        'w_gate': nrm(25, (DEPTH, N_EXPERTS, D_MODEL, EXPERT_HIDDEN), D_MODEL ** -0.5),
        'w_up': nrm(26, (DEPTH, N_EXPERTS, D_MODEL, EXPERT_HIDDEN), D_MODEL ** -0.5),
        'w_down': nrm(27, (DEPTH, N_EXPERTS, EXPERT_HIDDEN, D_MODEL), DEEPNORM_BETA * EXPERT_HIDDEN ** -0.5),
    }


def reference(x_prompt, x_sample, c, cache_na_k, cache_na_v, cache_gqa_k, cache_gqa_v,
              state_mlstm_c, state_mlstm_n, state_mlstm_m, c_ctx, ada_w, ada_b, w_in, b_gate,
              w_out, na_rpb, qk_norm_g, ml_norm_g, ln_g, ln_b, router_w, w_gate, w_up, w_down):
    xp = x_prompt
    collected = [[] for _ in range(7)]
    for l in range(DEPTH):
        mods = adaln_modulation(c_ctx[None, :], ada_w[l], ada_b[l])
        h = modulate(xp, mods[0], mods[1])
        mixed, ctx_tensors = context_mixers(h, w_in[l], b_gate[l], qk_norm_g[l], ml_norm_g[l])
        for lst, t in zip(collected, ctx_tensors):
            lst.append(t)
        xp = finish_layer(xp, mixed, mods, w_out[l], ln_g[l], ln_b[l], router_w[l], w_gate[l], w_up[l], w_down[l])
    y_prompt = xp
    new_na_k, new_na_v, new_gqa_k, new_gqa_v, new_mlstm_c, new_mlstm_n, new_mlstm_m = [
        jnp.stack(lst, 1).astype(x_prompt.dtype) for lst in collected]

    xs = x_sample
    for l in range(DEPTH):
        mods = adaln_modulation(c, ada_w[l], ada_b[l])
        h = modulate(xs, mods[0], mods[1])
        mixed = latent_mixers(h, w_in[l], b_gate[l], qk_norm_g[l], ml_norm_g[l], na_rpb[l],
                              cache_na_k[:, l], cache_na_v[:, l], cache_gqa_k[:, l], cache_gqa_v[:, l],
                              state_mlstm_c[:, l], state_mlstm_n[:, l], state_mlstm_m[:, l])
        xs = finish_layer(xs, mixed, mods, w_out[l], ln_g[l], ln_b[l], router_w[l], w_gate[l], w_up[l], w_down[l])
    y_sample = xs
    return (y_prompt, y_sample, new_na_k, new_na_v, new_gqa_k, new_gqa_v, new_mlstm_c, new_mlstm_n, new_mlstm_m)
```

```cpp
#ifndef EMU
#include <hip/hip_runtime.h>
#define DEV __device__ __forceinline__
#else
#define DEV static inline __attribute__((always_inline))
#endif
#include <stdint.h>
#include <stddef.h>

#ifndef CFG_D
#define CFG_D 1024
#define CFG_BATCH 16
#define CFG_SEQ 256
#define CFG_DEC_BATCH 2
#define CFG_DEC_SEQ 2048
#define CFG_PAST 256
#define CFG_EH 2816
#endif
constexpr int D = CFG_D, BATCH = CFG_BATCH, SEQ = CFG_SEQ, DEC_BATCH = CFG_DEC_BATCH, DEC_SEQ = CFG_DEC_SEQ, PAST = CFG_PAST, EH = CFG_EH;
constexpr int DEPTH = 2, HD = 64, NAH = 6, MLH = 4, GQH = 6, GQKV = 2, NEXP = 16, GRIDW = 64;
constexpr int NP = BATCH * SEQ, NS = DEC_BATCH * DEC_SEQ, NT = NP + NS, NCOND = 1 + DEC_BATCH;
constexpr int PROJ_W = 2832, MIXW = 1024;
constexpr int CAP_P = SEQ / 8, CAP_S = DEC_SEQ / 8, SLOTS = BATCH * CAP_P + DEC_BATCH * CAP_S;
constexpr int ROWS = DEC_SEQ / GRIDW, KR = ROWS < 8 ? ROWS : 8, KC = 16;
constexpr int NCH_P = SEQ / 64, NCH_S = DEC_SEQ / 64;
constexpr float ALPHA = 1.41421356237309515f;
constexpr float ATT_SCALE = 0.125f;
constexpr float EPS = 1e-6f;
static_assert(SLOTS % 256 == 0 && NP % 256 == 0 && NS % 256 == 0 && SEQ % 256 == 0 && DEC_SEQ % 256 == 0, "tile divisibility");
static_assert(D % 256 == 0 && EH % 128 == 0 && PAST % 64 == 0, "tile divisibility");

typedef unsigned short bf16_t;
typedef short s8v __attribute__((ext_vector_type(8)));
typedef short s4v __attribute__((ext_vector_type(4)));
typedef float f16v __attribute__((ext_vector_type(16)));
typedef float f4v __attribute__((ext_vector_type(4)));
typedef unsigned u4v __attribute__((ext_vector_type(4)));
typedef unsigned u2v __attribute__((ext_vector_type(2)));

enum { I_XP = 0, I_XS, I_C, I_CNAK, I_CNAV, I_CGQK, I_CGQV, I_SC, I_SN, I_SM, I_CCTX, I_ADAW, I_ADAB, I_WIN, I_BGATE, I_WOUT, I_RPB, I_QKG, I_MLG,
       I_LNG, I_LNB, I_RW, I_WG, I_WU, I_WD, N_IN };

constexpr size_t O_YP = 0;
constexpr size_t O_YS = O_YP + (size_t)NP * D;
constexpr size_t O_NAK = O_YS + (size_t)NS * D;
constexpr size_t O_NAV = O_NAK + (size_t)BATCH * DEPTH * SEQ * NAH * HD;
constexpr size_t O_GQK = O_NAV + (size_t)BATCH * DEPTH * SEQ * NAH * HD;
constexpr size_t O_GQV = O_GQK + (size_t)BATCH * DEPTH * SEQ * GQKV * HD;
constexpr size_t O_MC = O_GQV + (size_t)BATCH * DEPTH * SEQ * GQKV * HD;
constexpr size_t O_MN = O_MC + (size_t)BATCH * DEPTH * 2 * MLH * HD * HD;
constexpr size_t O_MM = O_MN + (size_t)BATCH * DEPTH * 2 * MLH * HD;
constexpr size_t O_END = O_MM + (size_t)BATCH * DEPTH * 2 * MLH;

constexpr size_t al256(size_t x) { return (x + 255) & ~(size_t)255; }
constexpr size_t WS_BAR = 0;
constexpr size_t WS_BAR_BYTES = 32768;
constexpr size_t WS_MODS = WS_BAR + WS_BAR_BYTES;
constexpr size_t WS_ROPE = al256(WS_MODS + (size_t)DEPTH * NCOND * 6 * D * 4);
constexpr size_t WS_CNAK = al256(WS_ROPE + 64 * 16 * 2 * 4);
constexpr size_t WS_CNAV = al256(WS_CNAK + (size_t)DEC_BATCH * DEPTH * PAST * NAH * HD * 2);
constexpr size_t WS_CGQK = al256(WS_CNAV + (size_t)DEC_BATCH * DEPTH * PAST * NAH * HD * 2);
constexpr size_t WS_CGQV = al256(WS_CGQK + (size_t)DEC_BATCH * DEPTH * PAST * GQKV * HD * 2);
constexpr size_t WS_XBUF = al256(WS_CGQV + (size_t)DEC_BATCH * DEPTH * PAST * GQKV * HD * 2);
constexpr size_t WS_HMOD = al256(WS_XBUF + (size_t)NT * D * 4);
constexpr size_t WS_GATES = al256(WS_HMOD + (size_t)NT * D * 2);
constexpr size_t WS_NAQ = al256(WS_GATES + (size_t)NT * 16 * 4);
constexpr size_t WS_NAK = al256(WS_NAQ + (size_t)NT * 384 * 2);
constexpr size_t WS_NAV = al256(WS_NAK + (size_t)NT * 384 * 2);
constexpr size_t WS_MLQ = al256(WS_NAV + (size_t)NT * 384 * 2);
constexpr size_t WS_MLK = al256(WS_MLQ + (size_t)NT * 256 * 2);
constexpr size_t WS_MLV = al256(WS_MLK + (size_t)NT * 256 * 2);
constexpr size_t WS_MLO = al256(WS_MLV + (size_t)NT * 256 * 2);
constexpr size_t WS_GQQ = al256(WS_MLO + (size_t)NT * 256 * 2);
constexpr size_t WS_GQK = al256(WS_GQQ + (size_t)NT * 384 * 2);
constexpr size_t WS_GQV = al256(WS_GQK + (size_t)NT * 128 * 2);
constexpr size_t WS_MIXED = al256(WS_GQV + (size_t)NT * 128 * 2);
constexpr size_t WS_U = al256(WS_MIXED + (size_t)NT * MIXW * 2);
constexpr size_t WS_X1 = al256(WS_U + (size_t)NT * D * 4);
constexpr size_t WS_H2 = al256(WS_X1 + (size_t)NT * D * 4);
constexpr size_t WS_AFF = al256(WS_H2 + (size_t)NT * D * 2);
constexpr size_t WS_IDX = al256(WS_AFF + (size_t)NT * 16 * 4);
constexpr size_t WS_GSEL = al256(WS_IDX + (size_t)NEXP * SLOTS * 4);
constexpr size_t WS_TOKSLOT = al256(WS_GSEL + (size_t)NEXP * SLOTS * 4);
constexpr size_t WS_HID = al256(WS_TOKSLOT + (size_t)NT * 16 * 4);
constexpr size_t WS_YE = al256(WS_HID + (size_t)NEXP * SLOTS * EH * 2);
constexpr int MLSUM_STRIDE = 4096 + 64 + 64;
constexpr int N_MLSUM = (BATCH * NCH_P + DEC_BATCH * NCH_S) * MLH * 2;
constexpr size_t WS_MLSUM = al256(WS_YE + (size_t)NEXP * SLOTS * D * 4);
constexpr int PART_STRIDE = 256 * 64 + 512;
constexpr int N_PART = DEC_BATCH * GQH * (DEC_SEQ / 256) * 2;
constexpr size_t WS_PART = al256(WS_MLSUM + (size_t)N_MLSUM * MLSUM_STRIDE * 4);
constexpr size_t WS_TOTAL = al256(WS_PART + (size_t)N_PART * PART_STRIDE * 4);

struct Params {
    const float* in[N_IN];
    float* out;
    char* ws;
    int ph0, ph1;
};

DEV float bf2f(bf16_t s) { unsigned u = ((unsigned)s) << 16; return __builtin_bit_cast(float, u); }
DEV bf16_t f2bf(float f) {
#ifdef EMU
    unsigned u = __builtin_bit_cast(unsigned, f); u += 0x7fffu + ((u >> 16) & 1u); return (bf16_t)(u >> 16);
#else
    return __builtin_bit_cast(bf16_t, (__bf16)f);
#endif
}
DEV unsigned pack2(float a, float b) {
#ifdef EMU
    return (unsigned)f2bf(a) | ((unsigned)f2bf(b) << 16);
#else
    typedef __bf16 b2 __attribute__((ext_vector_type(2))); b2 r; r[0] = (__bf16)a; r[1] = (__bf16)b; return __builtin_bit_cast(unsigned, r);
#endif
}
DEV float fexp(float x) {
#ifdef EMU
    return expf(x);
#else
    return __expf(x);
#endif
}
DEV float sigmoidf_(float x) { return 1.f / (1.f + fexp(-x)); }
DEV float siluf_(float x) { return x / (1.f + fexp(-x)); }
DEV float logsigmoidf_(float x) { return fminf(x, 0.f) - log1pf(expf(-fabsf(x))); }
DEV f16v mfma32(s8v a, s8v b, f16v c) {
#ifdef EMU
    return emu_mfma_32x32x16_bf16(a, b, c);
#else
    typedef __bf16 bf8 __attribute__((ext_vector_type(8)));
    return __builtin_amdgcn_mfma_f32_32x32x16_bf16(__builtin_bit_cast(bf8, a), __builtin_bit_cast(bf8, b), c, 0, 0, 0);
#endif
}
DEV s4v lds_tr16(const void* p) {
#ifdef EMU
    return emu_ds_read_tr16_b64(p);
#else
    typedef s4v __attribute__((address_space(3))) * lp;
    return __builtin_amdgcn_ds_read_tr16_b64_v4i16((lp)(p));
#endif
}
DEV float wave_sum(float v) { for (int m = 32; m >= 1; m >>= 1) v += __shfl_xor(v, m); return v; }
DEV float wave_max(float v) { for (int m = 32; m >= 1; m >>= 1) v = fmaxf(v, __shfl_xor(v, m)); return v; }
DEV f16v f16zero() { f16v z; for (int i = 0; i < 16; ++i) z[i] = 0.f; return z; }

#ifdef EMU
#define CFENCE() do {} while (0)
#else
#define CFENCE() asm volatile("" ::: "memory")
#endif
#ifdef EMU
DEV int get_tid() { return (int)threadIdx.x; }
#else
DEV int get_tid() { int t = threadIdx.x; asm volatile("" : "+v"(t)); return t; }
#endif
DEV int tok_cond(int t) { return t < NP ? 0 : 1 + (t - NP) / DEC_SEQ; }

#ifndef EMU
#define XB_TMO      128
#define XB_XCNT(j)  (256  + 64 * (j))
#define XB_XSUB(j)  (1280 + 64 * (j))
#define XB_XGEN(j)  (2304 + 64 * (j))
#define XB_TOP      3328
#define XB_TOPGEN   3392
#define XCD_BAR_WORDS 3456
#define XB_SPIN_CAP (1u << 20)
#define LAS __attribute__((address_space(3)))
__device__ __forceinline__ unsigned xb_ld(unsigned* p)              { return __hip_atomic_load(p, __ATOMIC_RELAXED, __HIP_MEMORY_SCOPE_AGENT); }
__device__ __forceinline__ unsigned xb_add(unsigned* p, unsigned v) { return __hip_atomic_fetch_add(p, v, __ATOMIC_RELAXED, __HIP_MEMORY_SCOPE_AGENT); }
__device__ __forceinline__ unsigned xb_xcc_id() { return (unsigned)__builtin_amdgcn_s_getreg((3 << 11) | 20) & 0xFu; }
#define XB_SPIN(cond, bar) do { unsigned _sp = 0; while (cond) { __builtin_amdgcn_s_sleep(1); \
    if ((++_sp & 255u) == 0u) { if (xb_ld(&(bar)[XB_TMO])) break; if (_sp > XB_SPIN_CAP) { atomicAdd(&(bar)[XB_TMO], 1u); break; } } } } while (0)
struct XcdBarrier { unsigned* bar; unsigned x; volatile LAS unsigned* st; };
__device__ __forceinline__ XcdBarrier xcd_barrier_post(unsigned* bar, volatile LAS unsigned* st) {
    XcdBarrier b; b.bar = bar; b.x = xb_xcc_id(); b.st = st;
    if (threadIdx.x == 0) (void)xb_add(&bar[XB_XCNT(b.x)], 1u);
    return b;
}
__device__ __forceinline__ void xcd_barrier_complete(unsigned* bar, unsigned x, unsigned& nloc, unsigned& nx) {
    const unsigned G = gridDim.x * gridDim.y * gridDim.z;
    unsigned sum, cnt, mine, sp = 0u;
    for (;;) {
        sum = 0u; cnt = 0u; mine = 0u;
#pragma unroll
        for (unsigned j = 0; j < 16; ++j) { const unsigned c = xb_ld(&bar[XB_XCNT(j)]); sum += c; cnt += (c > 0u) ? 1u : 0u; mine = (j == x) ? c : mine; }
        if (sum == G) break;
        __builtin_amdgcn_s_sleep(1);
        if ((++sp & 255u) == 0u) { if (xb_ld(&bar[XB_TMO])) break; if (sp > XB_SPIN_CAP) { atomicAdd(&bar[XB_TMO], 1u); break; } }
    }
    nloc = mine > 0u ? mine : 1u; nx = cnt > 0u ? cnt : 1u;
}
__device__ __forceinline__ void xcd_barrier(const XcdBarrier& b) {
    asm volatile("s_waitcnt vmcnt(0)" ::: "memory");
    __syncthreads();
    if (threadIdx.x == 0) {
        unsigned* bar = b.bar;
        __builtin_amdgcn_s_waitcnt(0);
        unsigned nloc = b.st[0], nx = b.st[1];
        if (nloc == 0u) { xcd_barrier_complete(bar, b.x, nloc, nx); b.st[0] = nloc; b.st[1] = nx; }
        const unsigned old = xb_add(&bar[XB_XSUB(b.x)], 1u);
        const unsigned gen = old / nloc;
        if (old + 1u == (gen + 1u) * nloc) {
            __builtin_amdgcn_fence(__ATOMIC_RELEASE, "agent");
            asm volatile("s_waitcnt vmcnt(0)" ::: "memory");
            const unsigned og = xb_add(&bar[XB_TOP], 1u);
            const unsigned tg = og / nx;
            if (og + 1u == (tg + 1u) * nx) xb_add(&bar[XB_TOPGEN], 1u);
            else XB_SPIN(xb_ld(&bar[XB_TOPGEN]) == tg, bar);
            __builtin_amdgcn_fence(__ATOMIC_ACQUIRE, "agent");
            xb_add(&bar[XB_XGEN(b.x)], 1u);
            asm volatile("s_waitcnt vmcnt(0)" ::: "memory");
        } else {
            XB_SPIN(xb_ld(&bar[XB_XGEN(b.x)]) == gen, bar);
            __builtin_amdgcn_fence(__ATOMIC_ACQUIRE, "agent");
            asm volatile("s_waitcnt vmcnt(0)" ::: "memory");
        }
    }
    __syncthreads();
}
#endif
constexpr int QUEUE_WORD0 = 4096;

constexpr int LROW = 144;
constexpr int GEMM_AS = 256 * LROW;
constexpr int SMEM_BYTES = 2 * GEMM_AS + 2 * 256 * LROW + 64;
constexpr int SMEM_XB = 2 * GEMM_AS + 2 * 256 * LROW;

template <int NTW, class Epi>
DEV void gemm_tile(char* smem, const bf16_t* abase, unsigned ao0, unsigned ao1, unsigned ao2, unsigned ao3,
                   const float* bcol, size_t ldb, int K, Epi&& epi) {
    constexpr int BN = 64 * NTW, KPT = 8 * NTW, KH = KPT / 2;
    const int tid = get_tid(), lane = tid & 63, wave = tid >> 6, wm = wave & 3, wn = wave >> 2, h = lane >> 5, l31 = lane & 31;
    char* As = smem; char* Bs = smem + 2 * GEMM_AS;
    constexpr int BSZ = BN * LROW;
    const int ar = tid >> 3, ac = tid & 7;
    const int bn = tid % BN, bk = (tid / BN) * KPT;
    u4v areg[4]; float breg[KH];
    f16v acc[NTW][2];
#pragma unroll
    for (int i = 0; i < NTW; ++i) { acc[i][0] = f16zero(); acc[i][1] = f16zero(); }
    auto gloadA = [&](int k0) {
        areg[0] = *(const u4v*)(abase + ao0 + k0); areg[1] = *(const u4v*)(abase + ao1 + k0); areg[2] = *(const u4v*)(abase + ao2 + k0); areg[3] = *(const u4v*)(abase + ao3 + k0);
    };
    auto gloadB = [&](int k0, int half) {
        const float* bp = bcol + (size_t)(k0 + bk + half * KH) * ldb;
#pragma unroll
        for (int j = 0; j < KH; ++j) breg[j] = bp[(size_t)j * ldb];
    };
    auto lstoreA = [&](int buf) {
        char* ab = As + buf * GEMM_AS + ar * LROW + ac * 16;
#pragma unroll
        for (int i = 0; i < 4; ++i) *(u4v*)(ab + i * 64 * LROW) = areg[i];
    };
    auto lstoreB = [&](int buf, int half) {
        char* bb = Bs + buf * BSZ + bn * LROW + (bk + half * KH) * 2;
#pragma unroll
        for (int o = 0; o < KH / 8; ++o) {
            u4v v; v[0] = pack2(breg[8 * o], breg[8 * o + 1]); v[1] = pack2(breg[8 * o + 2], breg[8 * o + 3]);
            v[2] = pack2(breg[8 * o + 4], breg[8 * o + 5]); v[3] = pack2(breg[8 * o + 6], breg[8 * o + 7]);
            *(u4v*)(bb + o * 16) = v;
        }
    };
    auto compute = [&](int buf, int s) {
        const char* ab = As + buf * GEMM_AS + (wm * 64 + l31) * LROW + h * 16;
        const char* bb = Bs + buf * BSZ + (wn * NTW * 32 + l31) * LROW + h * 16;
        s8v xf[2], wf[NTW];
        xf[0] = *(const s8v*)(ab + s * 32); xf[1] = *(const s8v*)(ab + 32 * LROW + s * 32);
#pragma unroll
        for (int ft = 0; ft < NTW; ++ft) wf[ft] = *(const s8v*)(bb + ft * 32 * LROW + s * 32);
#pragma unroll
        for (int ft = 0; ft < NTW; ++ft) { acc[ft][0] = mfma32(wf[ft], xf[0], acc[ft][0]); acc[ft][1] = mfma32(wf[ft], xf[1], acc[ft][1]); }
    };
    const int nk = K / 64;
    gloadA(0); gloadB(0, 0); lstoreA(0); lstoreB(0, 0); gloadB(0, 1); lstoreB(0, 1);
    __syncthreads();
    for (int kt = 0; kt < nk; ++kt) {
        const int buf = kt & 1;
        const bool more = kt + 1 < nk;
        if (more) { gloadA((kt + 1) * 64); gloadB((kt + 1) * 64, 0); }
        compute(buf, 0); compute(buf, 1);
        if (more) { lstoreB(buf ^ 1, 0); gloadB((kt + 1) * 64, 1); }
        compute(buf, 2); compute(buf, 3);
        if (more) { lstoreA(buf ^ 1); lstoreB(buf ^ 1, 1); }
        __syncthreads();
    }
    epi(acc);
}

DEV void phase_ada(const Params& p, char* smem) {
    const int tid = get_tid();
    float* siluS = (float*)smem;
    float* red = (float*)(smem + NCOND * D * 4);
    for (int i = tid; i < NCOND * D; i += 512) {
        const int cnd = i / D, k = i % D;
        const float c = cnd == 0 ? p.in[I_CCTX][k] : p.in[I_C][(cnd - 1) * D + k];
        siluS[i] = c / (1.f + expf(-c));
    }
    __syncthreads();
    constexpr int CPL = 6 * D / 32, NCHUNK = DEPTH * CPL, KG = D / 16;
    float* mods = (float*)(p.ws + WS_MODS);
    const int col = tid & 31, kg = tid >> 5;
    for (int u = blockIdx.x; u < NCHUNK; u += gridDim.x) {
        const int l = u / CPL, c0 = (u % CPL) * 32;
        const float* W = p.in[I_ADAW] + (size_t)l * D * 6 * D + c0 + col;
        float acc[NCOND];
#pragma unroll
        for (int c = 0; c < NCOND; ++c) acc[c] = 0.f;
#pragma unroll 8
        for (int k = kg * KG; k < kg * KG + KG; ++k) {
            const float w = W[(size_t)k * 6 * D];
#pragma unroll
            for (int c = 0; c < NCOND; ++c) acc[c] += siluS[c * D + k] * w;
        }
#pragma unroll
        for (int c = 0; c < NCOND; ++c) red[(kg * NCOND + c) * 32 + col] = acc[c];
        __syncthreads();
        if (tid < 32 * NCOND) {
            const int c = tid >> 5, cc = tid & 31;
            float s = 0.f;
            for (int g = 0; g < 16; ++g) s += red[(g * NCOND + c) * 32 + cc];
            mods[((size_t)l * NCOND + c) * 6 * D + c0 + cc] = s + p.in[I_ADAB][(size_t)l * 6 * D + c0 + cc];
        }
        __syncthreads();
    }
    const int gtid = blockIdx.x * 512 + tid, gsz = gridDim.x * 512;
    float* rope = (float*)(p.ws + WS_ROPE);
    for (int i = gtid; i < 64 * 16; i += gsz) {
        const int pos = i >> 4, fi = i & 15;
        const float inv = powf(10000.f, -(float)(2 * fi) / 32.f);
        const float ang = (float)pos * inv;
        rope[2 * i] = cosf(ang); rope[2 * i + 1] = sinf(ang);
    }
    constexpr int NNA = DEC_BATCH * DEPTH * PAST * NAH * HD, NGQ = DEC_BATCH * DEPTH * PAST * GQKV * HD;
    bf16_t* cnak = (bf16_t*)(p.ws + WS_CNAK); bf16_t* cnav = (bf16_t*)(p.ws + WS_CNAV);
    bf16_t* cgqk = (bf16_t*)(p.ws + WS_CGQK); bf16_t* cgqv = (bf16_t*)(p.ws + WS_CGQV);
    for (int i = gtid; i < NNA; i += gsz) { cnak[i] = f2bf(p.in[I_CNAK][i]); cnav[i] = f2bf(p.in[I_CNAV][i]); }
    for (int i = gtid; i < NGQ; i += gsz) { cgqk[i] = f2bf(p.in[I_CGQK][i]); cgqv[i] = f2bf(p.in[I_CGQV][i]); }
}

constexpr int EPL = D / 64;
constexpr int W16ROW = 20;
template <int MODE>
DEV void phase_rows(const Params& p, char* smem, int l) {
    const int tid = get_tid(), lane = tid & 63, wave = tid >> 6;
    float* W16 = (float*)smem;
    const bool need_w = (MODE == 1) || (l < DEPTH);
    if (need_w) {
        for (int i = tid; i < D * 4; i += 512) {
            const int k = i >> 2, q = i & 3;
            const float* src = (MODE == 1) ? p.in[I_RW] + ((size_t)l * D + k) * 16 + q * 4 : p.in[I_WIN] + ((size_t)l * D + k) * PROJ_W + 2176 + q * 4;
            *(f4v*)(W16 + k * W16ROW + q * 4) = *(const f4v*)src;
        }
    }
    __syncthreads();
    const float* mods = (const float*)(p.ws + WS_MODS);
    for (int t = blockIdx.x * 8 + wave; t < NT; t += gridDim.x * 8) {
        const int cnd = tok_cond(t);
        float v[EPL];
        if (MODE == 0) {
            if (l == 0) {
                const float* xr = t < NP ? p.in[I_XP] + (size_t)t * D : p.in[I_XS] + (size_t)(t - NP) * D;
#pragma unroll
                for (int j = 0; j < EPL; ++j) v[j] = xr[lane + 64 * j];
            } else {
                const float* x1 = (const float*)(p.ws + WS_X1) + (size_t)t * D;
                const float* g2 = mods + ((size_t)(l - 1) * NCOND + cnd) * 6 * D + 5 * D;
                float f[EPL];
#pragma unroll
                for (int j = 0; j < EPL; ++j) f[j] = 0.f;
                const int* ts = (const int*)(p.ws + WS_TOKSLOT) + (size_t)t * 16;
                const int myslot = lane < 16 ? ts[lane] : -1;
                for (int e = 0; e < NEXP; ++e) {
                    const int slot = __shfl(myslot, e);
                    if (slot >= 0) {
                        const float* yr = (const float*)(p.ws + WS_YE) + ((size_t)e * SLOTS + slot) * D;
#pragma unroll
                        for (int j = 0; j < EPL; ++j) f[j] += yr[lane + 64 * j];
                    }
                }
                float s = 0.f;
#pragma unroll
                for (int j = 0; j < EPL; ++j) { v[j] = ALPHA * x1[lane + 64 * j] + g2[lane + 64 * j] * f[j]; s += v[j]; }
                const float mu = wave_sum(s) * (1.f / D);
                float q = 0.f;
#pragma unroll
                for (int j = 0; j < EPL; ++j) { const float dlt = v[j] - mu; q += dlt * dlt; }
                const float rstd = 1.f / sqrtf(wave_sum(q) * (1.f / D) + EPS);
                const float* lg = p.in[I_LNG] + ((size_t)(l - 1) * 2 + 1) * D; const float* lb = p.in[I_LNB] + ((size_t)(l - 1) * 2 + 1) * D;
                float* dst = (l == DEPTH) ? (t < NP ? p.out + O_YP + (size_t)t * D : p.out + O_YS + (size_t)(t - NP) * D) : (float*)(p.ws + WS_XBUF) + (size_t)t * D;
#pragma unroll
                for (int j = 0; j < EPL; ++j) { v[j] = (v[j] - mu) * rstd * lg[lane + 64 * j] + lb[lane + 64 * j]; dst[lane + 64 * j] = v[j]; }
            }
            if (l < DEPTH) {
                const float* sh = mods + ((size_t)l * NCOND + cnd) * 6 * D; const float* sc = sh + D;
                bf16_t* hm = (bf16_t*)(p.ws + WS_HMOD) + (size_t)t * D;
                float a16[16];
#pragma unroll
                for (int e = 0; e < 16; ++e) a16[e] = 0.f;
#pragma unroll
                for (int j = 0; j < EPL; ++j) {
                    const int k = lane + 64 * j;
                    const float hv = v[j] * (1.f + sc[k]) + sh[k];
                    hm[k] = f2bf(hv);
                    const float* wr = W16 + k * W16ROW;
#pragma unroll
                    for (int q = 0; q < 4; ++q) { const f4v w4 = *(const f4v*)(wr + 4 * q); a16[4 * q] += hv * w4[0]; a16[4 * q + 1] += hv * w4[1]; a16[4 * q + 2] += hv * w4[2]; a16[4 * q + 3] += hv * w4[3]; }
                    CFENCE();
                }
                float mine = 0.f;
#pragma unroll
                for (int e = 0; e < 16; ++e) { const float s = wave_sum(a16[e]); if (lane == e) mine = s; }
                if (lane < 16) ((float*)(p.ws + WS_GATES))[(size_t)t * 16 + lane] = mine + p.in[I_BGATE][l * 16 + lane];
            }
        } else {
            const float* u = (const float*)(p.ws + WS_U) + (size_t)t * D;
            float s = 0.f;
#pragma unroll
            for (int j = 0; j < EPL; ++j) { v[j] = u[lane + 64 * j]; s += v[j]; }
            const float mu = wave_sum(s) * (1.f / D);
            float q = 0.f;
#pragma unroll
            for (int j = 0; j < EPL; ++j) { const float dlt = v[j] - mu; q += dlt * dlt; }
            const float rstd = 1.f / sqrtf(wave_sum(q) * (1.f / D) + EPS);
            const float* lg = p.in[I_LNG] + ((size_t)l * 2) * D; const float* lb = p.in[I_LNB] + ((size_t)l * 2) * D;
            const float* sh = mods + ((size_t)l * NCOND + cnd) * 6 * D + 3 * D; const float* sc = sh + D;
            float* x1 = (float*)(p.ws + WS_X1) + (size_t)t * D;
            bf16_t* h2 = (bf16_t*)(p.ws + WS_H2) + (size_t)t * D;
            float a16[16];
#pragma unroll
            for (int e = 0; e < 16; ++e) a16[e] = 0.f;
#pragma unroll
            for (int j = 0; j < EPL; ++j) {
                const int k = lane + 64 * j;
                const float xv = (v[j] - mu) * rstd * lg[k] + lb[k];
                x1[k] = xv;
                const float hv = xv * (1.f + sc[k]) + sh[k];
                h2[k] = f2bf(hv);
                const float* wr = W16 + k * W16ROW;
#pragma unroll
                for (int q4 = 0; q4 < 4; ++q4) { const f4v w4 = *(const f4v*)(wr + 4 * q4); a16[4 * q4] += hv * w4[0]; a16[4 * q4 + 1] += hv * w4[1]; a16[4 * q4 + 2] += hv * w4[2]; a16[4 * q4 + 3] += hv * w4[3]; }
                CFENCE();
            }
            float mine = -1e30f;
#pragma unroll
            for (int e = 0; e < 16; ++e) { const float sm = wave_sum(a16[e]); if (lane == e) mine = sm; }
            float mx = mine;
            for (int m = 8; m >= 1; m >>= 1) mx = fmaxf(mx, __shfl_xor(mx, m));
            const float ex = lane < 16 ? expf(mine - mx) : 0.f;
            float sm = ex;
            for (int m = 8; m >= 1; m >>= 1) sm += __shfl_xor(sm, m);
            if (lane < 16) ((float*)(p.ws + WS_AFF))[(size_t)t * 16 + lane] = ex / sm;
        }
    }
}

DEV void phase_topk(const Params& p, char* smem) {
    const int tid = get_tid();
    float* colS = (float*)smem;
    int* cntS = (int*)(smem + 8192 * 4);
    constexpr int UP = BATCH * NEXP * (SEQ / 256), US = DEC_BATCH * NEXP * (DEC_SEQ / 256);
    const float* aff = (const float*)(p.ws + WS_AFF);
    int* idx = (int*)(p.ws + WS_IDX); float* gsel = (float*)(p.ws + WS_GSEL); int* tokslot = (int*)(p.ws + WS_TOKSLOT);
    for (int u = blockIdx.x; u < UP + US; u += gridDim.x) {
        int tb, n, cap, sbase, e, sl;
        if (u < UP) { const int b = u / (NEXP * (SEQ / 256)); const int r = u % (NEXP * (SEQ / 256)); e = r / (SEQ / 256); sl = r % (SEQ / 256); tb = b * SEQ; n = SEQ; cap = CAP_P; sbase = b * CAP_P; }
        else { const int uu = u - UP; const int b = uu / (NEXP * (DEC_SEQ / 256)); const int r = uu % (NEXP * (DEC_SEQ / 256)); e = r / (DEC_SEQ / 256); sl = r % (DEC_SEQ / 256);
               tb = NP + b * DEC_SEQ; n = DEC_SEQ; cap = CAP_S; sbase = BATCH * CAP_P + b * CAP_S; }
        for (int j = tid; j < n; j += 512) colS[j] = aff[(size_t)(tb + j) * 16 + e];
        __syncthreads();
        const int i = sl * 256 + (tid & 255), half = tid >> 8;
        const float ai = colS[i];
        int cnt = 0;
        const int j0 = half * (n / 2), j1 = j0 + n / 2;
        for (int j = j0; j < j1; ++j) { const float aj = colS[j]; cnt += (aj > ai || (aj == ai && j < i)) ? 1 : 0; }
        cntS[tid] = cnt;
        __syncthreads();
        if (tid < 256) {
            const int rank = cntS[tid] + cntS[tid + 256];
            const int t = tb + i;
            if (rank < cap) { const int slot = sbase + rank; idx[e * SLOTS + slot] = t; gsel[e * SLOTS + slot] = ai; tokslot[(size_t)t * 16 + e] = slot; }
            else tokslot[(size_t)t * 16 + e] = -1;
        }
        __syncthreads();
    }
}

DEV void store_head(bf16_t* dst_bf, float* dst_f32, const f16v& v0, const f16v& v1, int h) {
#pragma unroll
    for (int ft = 0; ft < 2; ++ft) {
        const f16v& v = ft ? v1 : v0;
#pragma unroll
        for (int g = 0; g < 4; ++g) {
            const int d0 = ft * 32 + 8 * g + 4 * h;
            u2v pk; pk[0] = pack2(v[4 * g], v[4 * g + 1]); pk[1] = pack2(v[4 * g + 2], v[4 * g + 3]);
            *(u2v*)(dst_bf + d0) = pk;
            if (dst_f32) { f4v o; o[0] = v[4 * g]; o[1] = v[4 * g + 1]; o[2] = v[4 * g + 2]; o[3] = v[4 * g + 3]; *(f4v*)(dst_f32 + d0) = o; }
        }
    }
}
DEV void phase_inproj(const Params& p, char* smem, int l) {
    constexpr int NJ = 22, NU = (NT / 256) * NJ;
    const int tid = get_tid(), lane = tid & 63, wave = tid >> 6, wm = wave & 3, wn = wave >> 2, h = lane >> 5, l31 = lane & 31;
    const bf16_t* hmod = (const bf16_t*)(p.ws + WS_HMOD);
    const float* rope = (const float*)(p.ws + WS_ROPE);
    for (int u = blockIdx.x; u < NU; u += gridDim.x) {
        const int mb = u / NJ, j = u % NJ;
        const int colbase = j < 17 ? 128 * j : 2192 + 128 * (j - 17);
        const unsigned ao = (unsigned)(mb * 256 + (tid >> 3)) * D + (tid & 7) * 8;
        const float* bcol = p.in[I_WIN] + (size_t)l * D * PROJ_W + colbase + (tid & 127);
        gemm_tile<2>(smem, hmod, ao, ao + 64u * D, ao + 128u * D, ao + 192u * D, bcol, PROJ_W, D, [&](f16v (&acc)[2][2]) {
            const int cb = colbase + wn * 64;
#pragma unroll
            for (int tt = 0; tt < 2; ++tt) {
                const int t = mb * 256 + wm * 64 + tt * 32 + l31;
                const bool isP = t < NP;
                const int bP = t / SEQ, sP = t % SEQ;
                f16v v0 = acc[0][tt], v1 = acc[1][tt];
                if (cb < 1152) {
                    const int seg = cb / 384, head = (cb % 384) / 64;
                    bf16_t* dst = (bf16_t*)(p.ws + (seg == 0 ? WS_NAQ : seg == 1 ? WS_NAK : WS_NAV)) + (size_t)t * 384 + head * 64;
                    float* of = nullptr;
                    if (seg >= 1 && isP) of = p.out + (seg == 1 ? O_NAK : O_NAV) + ((((size_t)bP * DEPTH + l) * SEQ + sP) * NAH + head) * 64;
                    store_head(dst, of, v0, v1, h);
                } else if (cb < 2176) {
                    const int seg = (cb - 1152) / 256, head = ((cb - 1152) % 256) / 64;
                    if (seg == 1) { v0 *= ATT_SCALE; v1 *= ATT_SCALE; }
                    bf16_t* dst = (bf16_t*)(p.ws + (seg == 0 ? WS_MLQ : seg == 1 ? WS_MLK : seg == 2 ? WS_MLV : WS_MLO)) + (size_t)t * 256 + head * 64;
                    store_head(dst, nullptr, v0, v1, h);
                } else {
                    const int c2 = cb - 2192;
                    if (c2 < 512) {
                        const bool isq = c2 < 384;
                        const int head = isq ? c2 / 64 : (c2 - 384) / 64;
                        float ss = 0.f;
#pragma unroll
                        for (int r = 0; r < 16; ++r) ss += v0[r] * v0[r] + v1[r] * v1[r];
                        ss += __shfl_xor(ss, 32);
                        const float rn = 1.f / sqrtf(ss * (1.f / 64.f) + EPS);
                        const float* gq = p.in[I_QKG] + ((size_t)l * 2 + (isq ? 0 : 1)) * 64;
#pragma unroll
                        for (int r = 0; r < 16; ++r) {
                            const int d = (r & 3) + 8 * (r >> 2) + 4 * h;
                            v0[r] *= rn * gq[d]; v1[r] *= rn * gq[32 + d];
                        }
                        if (isP) {
                            if (isq) store_head((bf16_t*)(p.ws + WS_GQQ) + (size_t)t * 384 + head * 64, nullptr, v0, v1, h);
                            else store_head((bf16_t*)(p.ws + WS_GQK) + (size_t)t * 128 + head * 64, p.out + O_GQK + ((((size_t)bP * DEPTH + l) * SEQ + sP) * GQKV + head) * 64, v0, v1, h);
                        } else {
                            const int pos = (t - NP) % DEC_SEQ, prow = pos / GRIDW, pcol = pos % GRIDW;
#pragma unroll
                            for (int r = 0; r < 8; ++r) {
                                const int rr = r;
                                const int fi = (rr & 3) + 8 * ((rr >> 2) & 1) + 4 * h;
                                const float c0 = rope[(prow * 16 + fi) * 2], s0 = rope[(prow * 16 + fi) * 2 + 1];
                                const float c1 = rope[(pcol * 16 + fi) * 2], s1 = rope[(pcol * 16 + fi) * 2 + 1];
                                const float a_lo = v0[rr], a_hi = v0[rr + 8]; v0[rr] = a_lo * c0 - a_hi * s0; v0[rr + 8] = a_hi * c0 + a_lo * s0;
                                const float b_lo = v1[rr], b_hi = v1[rr + 8]; v1[rr] = b_lo * c1 - b_hi * s1; v1[rr + 8] = b_hi * c1 + b_lo * s1;
                            }
                            if (isq) store_head((bf16_t*)(p.ws + WS_GQQ) + (size_t)t * 384 + head * 64, nullptr, v0, v1, h);
                            else store_head((bf16_t*)(p.ws + WS_GQK) + (size_t)t * 128 + head * 64, nullptr, v0, v1, h);
                        }
                    } else {
                        const int head = (c2 - 512) / 64;
                        float* of = isP ? p.out + O_GQV + ((((size_t)bP * DEPTH + l) * SEQ + sP) * GQKV + head) * 64 : nullptr;
                        store_head((bf16_t*)(p.ws + WS_GQV) + (size_t)t * 128 + head * 64, of, v0, v1, h);
                    }
                }
            }
        });
    }
}

DEV void phase_outproj(const Params& p, char* smem, int l) {
    constexpr int NC = D / 128, NU = (NT / 256) * NC;
    const int tid = get_tid(), lane = tid & 63, wave = tid >> 6, wm = wave & 3, wn = wave >> 2, h = lane >> 5, l31 = lane & 31;
    const bf16_t* mixed = (const bf16_t*)(p.ws + WS_MIXED);
    const float* mods = (const float*)(p.ws + WS_MODS);
    float* U = (float*)(p.ws + WS_U);
    for (int u = blockIdx.x; u < NU; u += gridDim.x) {
        const int mb = u / NC, cbk = u % NC;
        const unsigned ao = (unsigned)(mb * 256 + (tid >> 3)) * MIXW + (tid & 7) * 8;
        const float* bcol = p.in[I_WOUT] + (size_t)l * MIXW * D + cbk * 128 + (tid & 127);
        gemm_tile<2>(smem, mixed, ao, ao + 64u * MIXW, ao + 128u * MIXW, ao + 192u * MIXW, bcol, D, MIXW, [&](f16v (&acc)[2][2]) {
#pragma unroll
            for (int tt = 0; tt < 2; ++tt) {
                const int t = mb * 256 + wm * 64 + tt * 32 + l31;
                const float* xr = (l == 0) ? (t < NP ? p.in[I_XP] + (size_t)t * D : p.in[I_XS] + (size_t)(t - NP) * D) : (const float*)(p.ws + WS_XBUF) + (size_t)t * D;
                const float* g1 = mods + ((size_t)l * NCOND + tok_cond(t)) * 6 * D + 2 * D;
#pragma unroll
                for (int ft = 0; ft < 2; ++ft)
#pragma unroll
                    for (int g = 0; g < 4; ++g) {
                        const int f0 = cbk * 128 + wn * 64 + ft * 32 + 8 * g + 4 * h;
                        const f4v xv = *(const f4v*)(xr + f0); const f4v gv = *(const f4v*)(g1 + f0);
                        f4v o;
#pragma unroll
                        for (int q = 0; q < 4; ++q) o[q] = ALPHA * xv[q] + gv[q] * acc[ft][tt][4 * g + q];
                        *(f4v*)(U + (size_t)t * D + f0) = o;
                    }
            }
        });
    }
}

DEV void phase_gateup(const Params& p, char* smem, int l) {
    constexpr int NRB = SLOTS / 256, NCB = EH / 128, NU = NEXP * NCB * NRB;
    const int tid = get_tid(), lane = tid & 63, wave = tid >> 6, wm = wave & 3, wn = wave >> 2, h = lane >> 5, l31 = lane & 31;
    const bf16_t* h2 = (const bf16_t*)(p.ws + WS_H2);
    const int* idx = (const int*)(p.ws + WS_IDX);
    bf16_t* hid = (bf16_t*)(p.ws + WS_HID);
    for (int u = blockIdx.x; u < NU; u += gridDim.x) {
        const int rb = u % NRB, cbk = (u / NRB) % NCB, e = u / (NRB * NCB);
        const int* ip = idx + e * SLOTS + rb * 256 + (tid >> 3);
        const unsigned a0 = (unsigned)ip[0] * D + (tid & 7) * 8, a1 = (unsigned)ip[64] * D + (tid & 7) * 8;
        const unsigned a2 = (unsigned)ip[128] * D + (tid & 7) * 8, a3 = (unsigned)ip[192] * D + (tid & 7) * 8;
        const int n = tid & 255, bwn = n >> 7, bft = (n >> 5) & 3, bc = n & 31;
        const int hcol = cbk * 128 + bwn * 64 + (bft >> 1) * 32 + bc;
        const float* bcol = p.in[(bft & 1) ? I_WU : I_WG] + ((size_t)l * NEXP + e) * D * EH + hcol;
        gemm_tile<4>(smem, h2, a0, a1, a2, a3, bcol, EH, D, [&](f16v (&acc)[4][2]) {
#pragma unroll
            for (int tt = 0; tt < 2; ++tt) {
                const int slot = rb * 256 + wm * 64 + tt * 32 + l31;
                bf16_t* dst = hid + ((size_t)e * SLOTS + slot) * EH + cbk * 128 + wn * 64;
#pragma unroll
                for (int pr = 0; pr < 2; ++pr)
#pragma unroll
                    for (int g = 0; g < 4; ++g) {
                        float o[4];
#pragma unroll
                        for (int q = 0; q < 4; ++q) o[q] = siluf_(acc[2 * pr][tt][4 * g + q]) * acc[2 * pr + 1][tt][4 * g + q];
                        u2v pk; pk[0] = pack2(o[0], o[1]); pk[1] = pack2(o[2], o[3]);
                        *(u2v*)(dst + pr * 32 + 8 * g + 4 * h) = pk;
                    }
            }
        });
    }
}

DEV void phase_down(const Params& p, char* smem, int l) {
    constexpr int NRB = SLOTS / 256, NCB = D / 256, NU = NEXP * NCB * NRB;
    const int tid = get_tid(), lane = tid & 63, wave = tid >> 6, wm = wave & 3, wn = wave >> 2, h = lane >> 5, l31 = lane & 31;
    const bf16_t* hid = (const bf16_t*)(p.ws + WS_HID);
    const float* gsel = (const float*)(p.ws + WS_GSEL);
    float* ye = (float*)(p.ws + WS_YE);
    for (int u = blockIdx.x; u < NU; u += gridDim.x) {
        const int rb = u % NRB, cbk = (u / NRB) % NCB, e = u / (NRB * NCB);
        const unsigned ao = (unsigned)(e * SLOTS + rb * 256 + (tid >> 3)) * EH + (tid & 7) * 8;
        const float* bcol = p.in[I_WD] + ((size_t)l * NEXP + e) * EH * D + cbk * 256 + (tid & 255);
        gemm_tile<4>(smem, hid, ao, ao + 64u * EH, ao + 128u * EH, ao + 192u * EH, bcol, D, EH, [&](f16v (&acc)[4][2]) {
#pragma unroll
            for (int tt = 0; tt < 2; ++tt) {
                const int slot = rb * 256 + wm * 64 + tt * 32 + l31;
                const float gs = gsel[e * SLOTS + slot];
                float* dst = ye + ((size_t)e * SLOTS + slot) * D + cbk * 256 + wn * 128;
#pragma unroll
                for (int ft = 0; ft < 4; ++ft)
#pragma unroll
                    for (int g = 0; g < 4; ++g) {
                        f4v o;
#pragma unroll
                        for (int q = 0; q < 4; ++q) o[q] = acc[ft][tt][4 * g + q] * gs;
                        *(f4v*)(dst + ft * 32 + 8 * g + 4 * h) = o;
                    }
            }
        });
    }
}

struct AttnDesc {
    const bf16_t* q; int qstride;
    int ntiles, n0;
    const bf16_t *k0, *v0; int stride0;
    const bf16_t *k1, *v1; int stride1;
    int na;
    int r0, rlo;
    const float* rpb;
    bf16_t* out; int ostride;
    float* part;
};
constexpr int ATT_TILE = 64 * LROW;
DEV int na_row_start(int r) { int s = r - KR / 2; s = s < 0 ? 0 : s; return s > ROWS - KR ? ROWS - KR : s; }
DEV void attn_unit(char* smem, const AttnDesc& d) {
    const int tid = get_tid(), lane = tid & 63, wave = tid >> 6, h = lane >> 5, l31 = lane & 31;
    char* Ks = smem; char* Vs = smem + 2 * ATT_TILE; float* rpbS = (float*)(smem + 4 * ATT_TILE);
    if (d.na) { for (int i = tid; i < 15 * 31; i += 512) rpbS[i] = d.rpb[i]; }
    const bf16_t* qp = d.q + (size_t)(wave * 32 + l31) * d.qstride + h * 8;
    s8v qf[4];
#pragma unroll
    for (int s = 0; s < 4; ++s) qf[s] = *(const s8v*)(qp + 16 * s);
    float m_run = -1e30f, l_run = 0.f;
    f16v o[2]; o[0] = f16zero(); o[1] = f16zero();
    const int srow = tid >> 3, sch = tid & 7;
    u4v kreg, vreg;
    auto gload = [&](int t) {
        const bf16_t *kp, *vp;
        if (t < d.n0) { const size_t off = (size_t)(t * 64 + srow) * d.stride0 + sch * 8; kp = d.k0 + off; vp = d.v0 + off; }
        else { const size_t off = (size_t)((t - d.n0) * 64 + srow) * d.stride1 + sch * 8; kp = d.k1 + off; vp = d.v1 + off; }
        kreg = *(const u4v*)kp; vreg = *(const u4v*)vp;
    };
    auto lstore = [&](int buf) { *(u4v*)(Ks + buf * ATT_TILE + srow * LROW + sch * 16) = kreg; *(u4v*)(Vs + buf * ATT_TILE + srow * LROW + sch * 16) = vreg; };
    const int qr = d.r0 + (wave >> 1), qw = (wave & 1) * 32 + l31;
    const int rs = na_row_start(qr);
    int cs = qw - KC / 2; cs = cs < 0 ? 0 : (cs > GRIDW - KC ? GRIDW - KC : cs);
    gload(0); lstore(0);
    __syncthreads();
    for (int t = 0; t < d.ntiles; ++t) {
        const int buf = t & 1;
        if (t + 1 < d.ntiles) gload(t + 1);
        const bool local = d.na && t >= d.n0;
        const int kr = d.rlo + (t - d.n0);
        const bool active = !local || (kr >= rs && kr < rs + KR);
        if (active) {
            const char* kb = Ks + buf * ATT_TILE + l31 * LROW + h * 16;
            f16v sa[2];
#pragma unroll
            for (int kt = 0; kt < 2; ++kt) {
                sa[kt] = f16zero();
#pragma unroll
                for (int s = 0; s < 4; ++s) { const s8v kf = *(const s8v*)(kb + kt * 32 * LROW + s * 32); sa[kt] = mfma32(kf, qf[s], sa[kt]); }
            }
            float mx = -1e30f;
#pragma unroll
            for (int kt = 0; kt < 2; ++kt)
#pragma unroll
                for (int r = 0; r < 16; ++r) {
                    float v = sa[kt][r] * ATT_SCALE;
                    if (local) {
                        const int kc = kt * 32 + (r & 3) + 8 * (r >> 2) + 4 * h;
                        const bool inw = kc >= cs && kc < cs + KC;
                        const int bi = (kr - qr + 7) * 31 + (kc - qw + 15);
                        v = inw ? v + rpbS[inw ? bi : 0] : -1e30f;
                    }
                    sa[kt][r] = v; mx = fmaxf(mx, v);
                }
            mx = fmaxf(mx, __shfl_xor(mx, 32));
            const float m_new = fmaxf(m_run, mx);
            const float alpha = fexp(m_run - m_new);
            float ps = 0.f;
#pragma unroll
            for (int kt = 0; kt < 2; ++kt)
#pragma unroll
                for (int r = 0; r < 16; ++r) { const float pv = fexp(sa[kt][r] - m_new); sa[kt][r] = pv; ps += pv; }
            l_run = l_run * alpha + ps; m_run = m_new;
            o[0] *= alpha; o[1] *= alpha;
            const char* vb = Vs + buf * ATT_TILE + (4 * h + ((lane & 15) >> 2)) * LROW + (((lane >> 4) & 1) * 16 + 4 * (lane & 3)) * 2;
#pragma unroll
            for (int ks = 0; ks < 4; ++ks) {
                const int kt = ks >> 1, rb = 8 * (ks & 1);
                u4v pk; pk[0] = pack2(sa[kt][rb], sa[kt][rb + 1]); pk[1] = pack2(sa[kt][rb + 2], sa[kt][rb + 3]);
                pk[2] = pack2(sa[kt][rb + 4], sa[kt][rb + 5]); pk[3] = pack2(sa[kt][rb + 6], sa[kt][rb + 7]);
                const s8v pf = __builtin_bit_cast(s8v, pk);
                const char* vk = vb + (kt * 32 + 16 * (ks & 1)) * LROW;
#pragma unroll
                for (int dt = 0; dt < 2; ++dt) {
                    const s4v lo = lds_tr16(vk + dt * 64), hi = lds_tr16(vk + 8 * LROW + dt * 64);
                    s8v vf; vf[0] = lo[0]; vf[1] = lo[1]; vf[2] = lo[2]; vf[3] = lo[3]; vf[4] = hi[0]; vf[5] = hi[1]; vf[6] = hi[2]; vf[7] = hi[3];
                    o[dt] = mfma32(vf, pf, o[dt]);
                }
            }
        }
        if (t + 1 < d.ntiles) lstore(buf ^ 1);
        __syncthreads();
    }
    const float l_tot = l_run + __shfl_xor(l_run, 32);
    const int qrow = wave * 32 + l31;
    if (d.part) {
        float* po = d.part + (size_t)qrow * 64;
#pragma unroll
        for (int dt = 0; dt < 2; ++dt)
#pragma unroll
            for (int g = 0; g < 4; ++g) { f4v v; v[0] = o[dt][4 * g]; v[1] = o[dt][4 * g + 1]; v[2] = o[dt][4 * g + 2]; v[3] = o[dt][4 * g + 3]; *(f4v*)(po + dt * 32 + 8 * g + 4 * h) = v; }
        if (h == 0) { d.part[256 * 64 + qrow] = m_run; d.part[256 * 64 + 256 + qrow] = l_tot; }
    } else {
        const float inv = 1.f / l_tot;
        bf16_t* po = d.out + (size_t)qrow * d.ostride;
#pragma unroll
        for (int dt = 0; dt < 2; ++dt)
#pragma unroll
            for (int g = 0; g < 4; ++g) {
                u2v pk; pk[0] = pack2(o[dt][4 * g] * inv, o[dt][4 * g + 1] * inv); pk[1] = pack2(o[dt][4 * g + 2] * inv, o[dt][4 * g + 3] * inv);
                *(u2v*)(po + dt * 32 + 8 * g + 4 * h) = pk;
            }
    }
}

DEV int ml_sidx(int grp, int b, int head, int c) { return grp == 0 ? ((b * MLH + head) * NCH_P + c) : BATCH * MLH * NCH_P + ((b * MLH + head) * NCH_S + c); }
DEV float lane_prefix_sum(float v, int lane) { for (int dlt = 1; dlt < 64; dlt <<= 1) { const float o = __shfl(v, lane - dlt); if (lane >= dlt) v += o; } return v; }
DEV float lane_prefix_max(float v, int lane) { for (int dlt = 1; dlt < 64; dlt <<= 1) { const float o = __shfl(v, lane - dlt); if (lane >= dlt) v = fmaxf(v, o); } return v; }

DEV void mlstm_summary_unit(const Params& p, char* smem, int grp, int b, int head, int c) {
    const int tid = get_tid(), lane = tid & 63, wave = tid >> 6, h = lane >> 5, l31 = lane & 31;
    char* KT = smem;
    char* VT = smem + 2 * ATT_TILE;
    float* wsS = (float*)(smem + 3 * ATT_TILE);
    float* scal = wsS + 128;
    const int tb = (grp == 0 ? b * SEQ : NP + b * DEC_SEQ) + c * 64;
    const float* gates = (const float*)(p.ws + WS_GATES);
    if (wave == 0) {
        const float* gr = gates + (size_t)(tb + lane) * 16;
        const float i_f = gr[head], lf_f = logsigmoidf_(gr[4 + head]), i_b = gr[8 + head], lf_b = logsigmoidf_(gr[12 + head]);
        const float pf = lane_prefix_sum(lf_f, lane), pb = lane_prefix_sum(lf_b, lane);
        const float tot_f = __shfl(pf, 63), tot_b = __shfl(pb, 63);
        const float g_f = (tot_f - pf) + i_f, g_b = (pb - lf_b) + i_b;
        const float G_f = wave_max(g_f), G_b = wave_max(g_b);
        wsS[lane] = expf(g_f - G_f); wsS[64 + lane] = expf(g_b - G_b);
        if (lane == 0) { scal[0] = tot_f; scal[1] = tot_b; scal[2] = G_f; scal[3] = G_b; }
    }
    __syncthreads();
    {
        const int tau = tid >> 3, ch = tid & 7;
        const u4v kv = *(const u4v*)((const bf16_t*)(p.ws + WS_MLK) + (size_t)(tb + tau) * 256 + head * 64 + ch * 8);
        const u4v vv = *(const u4v*)((const bf16_t*)(p.ws + WS_MLV) + (size_t)(tb + tau) * 256 + head * 64 + ch * 8);
        const float wf = wsS[tau], wb = wsS[64 + tau];
#pragma unroll
        for (int j = 0; j < 8; ++j) {
            const bf16_t kb = (bf16_t)(kv[j >> 1] >> (16 * (j & 1))), vb = (bf16_t)(vv[j >> 1] >> (16 * (j & 1)));
            const int dim = ch * 8 + j; const float kf = bf2f(kb);
            *(bf16_t*)(KT + dim * LROW + tau * 2) = f2bf(kf * wf);
            *(bf16_t*)(KT + ATT_TILE + dim * LROW + tau * 2) = f2bf(kf * wb);
            *(bf16_t*)(VT + dim * LROW + tau * 2) = vb;
        }
    }
    __syncthreads();
    float* sum = (float*)(p.ws + WS_MLSUM);
    const int sidx = ml_sidx(grp, b, head, c);
    {
        const int dir = wave >> 2, mi = (wave >> 1) & 1, ni = wave & 1;
        f16v acc = f16zero();
#pragma unroll
        for (int s = 0; s < 4; ++s) {
            const s8v af = *(const s8v*)(KT + dir * ATT_TILE + (mi * 32 + l31) * LROW + (16 * s + 8 * h) * 2);
            const s8v bf = *(const s8v*)(VT + (ni * 32 + l31) * LROW + (16 * s + 8 * h) * 2);
            acc = mfma32(af, bf, acc);
        }
        float* U = sum + (size_t)(sidx * 2 + dir) * MLSUM_STRIDE;
#pragma unroll
        for (int r = 0; r < 16; ++r) U[(mi * 32 + (r & 3) + 8 * (r >> 2) + 4 * h) * 64 + ni * 32 + l31] = acc[r];
    }
    if (tid < 128) {
        const int dir = tid >> 6, kd = tid & 63;
        float s = 0.f;
        for (int tau = 0; tau < 64; ++tau) s += bf2f(*(const bf16_t*)(KT + dir * ATT_TILE + kd * LROW + tau * 2));
        float* E = sum + (size_t)(sidx * 2 + dir) * MLSUM_STRIDE;
        E[4096 + kd] = s;
        if (kd == 0) { E[4160] = scal[dir]; E[4161] = scal[2 + dir]; }
    }
    __syncthreads();
}

DEV void mlstm_output_unit(const Params& p, char* smem, int l, int grp, int b, int head, int c) {
    const int tid = get_tid(), lane = tid & 63, wave = tid >> 6, h = lane >> 5, l31 = lane & 31;
    const int nc = grp ? NCH_S : NCH_P;
    char* Qs = smem;
    char* Ks = smem + 2 * ATT_TILE;
    char* VT = smem + 4 * ATT_TILE;
    char* CT = smem + 6 * ATT_TILE;
    char* QK = smem + 8 * ATT_TILE;
    float* hS = (float*)(smem + 10 * ATT_TILE);
    float* vec = hS + 2 * 64 * 68;
    float* aS = vec; float* MjS = vec + 128; float* bS = vec + 256; float* nS = vec + 384; float* denp = vec + 512; float* qnS = vec + 768; float* scal = vec + 896;
    const int tb = (grp == 0 ? b * SEQ : NP + b * DEC_SEQ) + c * 64;
    const float* sum = (const float*)(p.ws + WS_MLSUM);
#pragma unroll
    for (int dir = 0; dir < 2; ++dir) {
        float C[8], nst = 0.f, m;
        if (grp == 0) {
#pragma unroll
            for (int i = 0; i < 8; ++i) C[i] = 0.f;
            m = 0.f;
        } else {
            const size_t sb = (((size_t)b * DEPTH + l) * 2 + dir) * MLH + head;
#pragma unroll
            for (int i = 0; i < 8; ++i) C[i] = p.in[I_SC][sb * 4096 + tid + 512 * i];
            if (tid < 64) nst = p.in[I_SN][sb * 64 + tid];
            m = p.in[I_SM][sb];
        }
        const int nsteps = dir == 0 ? c : nc - 1 - c;
        const bool fin = (grp == 0) && (dir == 0 ? c == nc - 1 : c == 0);
        for (int st = 0; st < nsteps + (fin ? 1 : 0); ++st) {
            const int cc = dir == 0 ? st : nc - 1 - st;
            const float* E = sum + (size_t)(ml_sidx(grp, b, head, cc) * 2 + dir) * MLSUM_STRIDE;
            if (st == nsteps) {
#pragma unroll
                for (int i = 0; i < 8; ++i) { const int e = tid + 512 * i; *(bf16_t*)(CT + dir * ATT_TILE + (e & 63) * LROW + (e >> 6) * 2) = f2bf(C[i]); }
                if (tid < 64) nS[dir * 64 + tid] = nst;
                if (tid == 0) scal[dir] = m;
            }
            const float A = E[4160], G = E[4161];
            const float m_new = fmaxf(A + m, G);
            const float sc = expf(A + m - m_new), su = expf(G - m_new);
#pragma unroll
            for (int i = 0; i < 8; ++i) C[i] = sc * C[i] + su * E[tid + 512 * i];
            if (tid < 64) nst = sc * nst + su * E[4096 + tid];
            m = m_new;
        }
        if (!fin) {
#pragma unroll
            for (int i = 0; i < 8; ++i) { const int e = tid + 512 * i; *(bf16_t*)(CT + dir * ATT_TILE + (e & 63) * LROW + (e >> 6) * 2) = f2bf(C[i]); }
            if (tid < 64) nS[dir * 64 + tid] = nst;
            if (tid == 0) scal[dir] = m;
        } else {
            const size_t ob = (((size_t)b * DEPTH + l) * 2 + dir) * MLH + head;
#pragma unroll
            for (int i = 0; i < 8; ++i) p.out[O_MC + ob * 4096 + tid + 512 * i] = C[i];
            if (tid < 64) p.out[O_MN + ob * 64 + tid] = nst;
            if (tid == 0) p.out[O_MM + ob] = m;
        }
    }
    {
        const int row = tid >> 3, ch = tid & 7;
#pragma unroll
        for (int dir = 0; dir < 2; ++dir) {
            const int tok = tb + (dir ? 63 - row : row);
            const size_t off = (size_t)tok * 256 + head * 64 + ch * 8;
            *(u4v*)(Qs + dir * ATT_TILE + row * LROW + ch * 16) = *(const u4v*)((const bf16_t*)(p.ws + WS_MLQ) + off);
            *(u4v*)(Ks + dir * ATT_TILE + row * LROW + ch * 16) = *(const u4v*)((const bf16_t*)(p.ws + WS_MLK) + off);
            const u4v vv = *(const u4v*)((const bf16_t*)(p.ws + WS_MLV) + off);
#pragma unroll
            for (int j = 0; j < 8; ++j) *(bf16_t*)(VT + dir * ATT_TILE + (ch * 8 + j) * LROW + row * 2) = (bf16_t)(vv[j >> 1] >> (16 * (j & 1)));
        }
    }
    __syncthreads();
    if (wave < 2) {
        const int dir = wave;
        const float* gr = (const float*)(p.ws + WS_GATES) + (size_t)(tb + (dir ? 63 - lane : lane)) * 16;
        const float ig = gr[dir * 8 + head], lf = logsigmoidf_(gr[dir * 8 + 4 + head]);
        const float bj = lane_prefix_sum(lf, lane);
        const float a = ig - bj;
        const float Pj = lane_prefix_max(a, lane);
        aS[dir * 64 + lane] = a; bS[dir * 64 + lane] = bj; MjS[dir * 64 + lane] = fmaxf(scal[dir], Pj);
    } else if (wave < 4) {
        const int dir = wave - 2;
        float s = 0.f;
        for (int k = 0; k < 64; ++k) s += bf2f(*(const bf16_t*)(Qs + dir * ATT_TILE + lane * LROW + k * 2)) * nS[dir * 64 + k];
        qnS[dir * 64 + lane] = s;
    }
    __syncthreads();
    const int dir = wave >> 2, rt = (wave >> 1) & 1, jt = wave & 1;
    const int j = jt * 32 + l31;
    const float Mj = MjS[dir * 64 + j];
    {
        f16v acc = f16zero();
#pragma unroll
        for (int s4 = 0; s4 < 4; ++s4) {
            const s8v af = *(const s8v*)(Ks + dir * ATT_TILE + (rt * 32 + l31) * LROW + (16 * s4 + 8 * h) * 2);
            const s8v bf = *(const s8v*)(Qs + dir * ATT_TILE + j * LROW + (16 * s4 + 8 * h) * 2);
            acc = mfma32(af, bf, acc);
        }
        float dsum = 0.f;
#pragma unroll
        for (int g = 0; g < 4; ++g) {
            float o[4];
#pragma unroll
            for (int q = 0; q < 4; ++q) {
                const int s = rt * 32 + 8 * g + 4 * h + q;
                const float w = s <= j ? expf(aS[dir * 64 + s] - Mj) : 0.f;
                o[q] = acc[4 * g + q] * w; dsum += o[q];
            }
            u2v pk; pk[0] = pack2(o[0], o[1]); pk[1] = pack2(o[2], o[3]);
            *(u2v*)(QK + dir * ATT_TILE + j * LROW + (rt * 32 + 8 * g + 4 * h) * 2) = pk;
        }
        dsum += __shfl_xor(dsum, 32);
        if (h == 0) denp[(dir * 2 + rt) * 64 + j] = dsum;
    }
    __syncthreads();
    {
        const float mst = scal[dir];
        const float decay = expf(mst - Mj);
        f16v acc = f16zero();
#pragma unroll
        for (int s4 = 0; s4 < 4; ++s4) {
            const s8v af = *(const s8v*)(CT + dir * ATT_TILE + (rt * 32 + l31) * LROW + (16 * s4 + 8 * h) * 2);
            const s8v bf = *(const s8v*)(Qs + dir * ATT_TILE + j * LROW + (16 * s4 + 8 * h) * 2);
            acc = mfma32(af, bf, acc);
        }
        acc *= decay;
#pragma unroll
        for (int s4 = 0; s4 < 4; ++s4) {
            const s8v af = *(const s8v*)(VT + dir * ATT_TILE + (rt * 32 + l31) * LROW + (16 * s4 + 8 * h) * 2);
            const s8v bf = *(const s8v*)(QK + dir * ATT_TILE + j * LROW + (16 * s4 + 8 * h) * 2);
            acc = mfma32(af, bf, acc);
        }
        const float den = decay * qnS[dir * 64 + j] + denp[(dir * 2) * 64 + j] + denp[(dir * 2 + 1) * 64 + j];
        const float dn = fmaxf(fabsf(den), expf(-(bS[dir * 64 + j] + Mj)));
        const float inv = 1.f / dn;
#pragma unroll
        for (int g = 0; g < 4; ++g) { f4v o; o[0] = acc[4 * g] * inv; o[1] = acc[4 * g + 1] * inv; o[2] = acc[4 * g + 2] * inv; o[3] = acc[4 * g + 3] * inv;
            *(f4v*)(hS + (dir * 64 + j) * 68 + rt * 32 + 8 * g + 4 * h) = o; }
    }
    __syncthreads();
    {
        const int tau = tid >> 3, v8 = (tid & 7) * 8;
        float hv[8]; float s = 0.f;
#pragma unroll
        for (int q = 0; q < 8; ++q) { hv[q] = hS[tau * 68 + v8 + q] + hS[(64 + 63 - tau) * 68 + v8 + q]; s += hv[q]; }
        s += __shfl_xor(s, 1); s += __shfl_xor(s, 2); s += __shfl_xor(s, 4);
        const float mu = s * (1.f / 64.f);
        float qq = 0.f;
#pragma unroll
        for (int q = 0; q < 8; ++q) { const float dlt = hv[q] - mu; qq += dlt * dlt; }
        qq += __shfl_xor(qq, 1); qq += __shfl_xor(qq, 2); qq += __shfl_xor(qq, 4);
        const float rstd = 1.f / sqrtf(qq * (1.f / 64.f) + EPS);
        const int t = tb + tau;
        const u4v ov = *(const u4v*)((const bf16_t*)(p.ws + WS_MLO) + (size_t)t * 256 + head * 64 + v8);
        const float* ng = p.in[I_MLG] + (size_t)l * 256 + head * 64 + v8;
        float o[8];
#pragma unroll
        for (int q = 0; q < 8; ++q) { const float og = bf2f((bf16_t)(ov[q >> 1] >> (16 * (q & 1)))); o[q] = (hv[q] - mu) * rstd * ng[q] * sigmoidf_(og); }
        u4v pk; pk[0] = pack2(o[0], o[1]); pk[1] = pack2(o[2], o[3]); pk[2] = pack2(o[4], o[5]); pk[3] = pack2(o[6], o[7]);
        *(u4v*)((bf16_t*)(p.ws + WS_MIXED) + (size_t)t * MIXW + 384 + head * 64 + v8) = pk;
    }
    __syncthreads();
}

DEV int queue_next(const Params& p, char* smem, int qi) {
    int* slot = (int*)(smem + SMEM_XB + 32);
    __syncthreads();
    if (threadIdx.x == 0) {
#ifdef EMU
        unsigned* w = (unsigned*)(p.ws + WS_BAR) + QUEUE_WORD0 + 64 * qi; *slot = (int)(*w)++;
#else
        *slot = (int)__hip_atomic_fetch_add((unsigned*)(p.ws + WS_BAR) + QUEUE_WORD0 + 64 * qi, 1u, __ATOMIC_RELAXED, __HIP_MEMORY_SCOPE_AGENT);
#endif
    }
    __syncthreads();
    return *slot;
}
DEV void phase_attn(const Params& p, char* smem, int l) {
    constexpr int QB_S = DEC_SEQ / 256, QB_P = SEQ / 256;
    constexpr int U_SG = DEC_BATCH * GQH * QB_S * 2, U_SN = DEC_BATCH * NAH * QB_S, U_PN = BATCH * NAH * QB_P, U_PG = BATCH * GQH * QB_P;
    constexpr int U_MP = BATCH * MLH * NCH_P, U_MS = DEC_BATCH * MLH * NCH_S;
    constexpr int NU = U_SG + U_SN + U_PN + U_PG + U_MP + U_MS;
    const bf16_t* naq = (const bf16_t*)(p.ws + WS_NAQ); const bf16_t* nak = (const bf16_t*)(p.ws + WS_NAK); const bf16_t* nav = (const bf16_t*)(p.ws + WS_NAV);
    const bf16_t* gqq = (const bf16_t*)(p.ws + WS_GQQ); const bf16_t* gqk = (const bf16_t*)(p.ws + WS_GQK); const bf16_t* gqv = (const bf16_t*)(p.ws + WS_GQV);
    bf16_t* mixed = (bf16_t*)(p.ws + WS_MIXED);
    for (;;) {
        int u = queue_next(p, smem, l);
        if (u >= NU) break;
        AttnDesc d; d.na = 0; d.r0 = 0; d.rlo = 0; d.rpb = nullptr; d.part = nullptr; d.out = nullptr; d.ostride = MIXW; d.n0 = 0; d.k0 = d.v0 = nullptr; d.stride0 = 0;
        if (u < U_SG) {
            const int half = u & 1, qb = (u >> 1) % QB_S, qh = (u / (2 * QB_S)) % GQH, b = u / (2 * QB_S * GQH);
            const int kvh = qh / (GQH / GQKV);
            constexpr int NCT = PAST / 64, TT = NCT + DEC_SEQ / 64, H0 = TT / 2;
            const size_t tq = (size_t)NP + (size_t)b * DEC_SEQ + qb * 256;
            d.q = gqq + tq * 384 + qh * 64; d.qstride = 384;
            const bf16_t* lk = gqk + ((size_t)NP + (size_t)b * DEC_SEQ) * 128 + kvh * 64; const bf16_t* lv = gqv + ((size_t)NP + (size_t)b * DEC_SEQ) * 128 + kvh * 64;
            if (half == 0) {
                d.n0 = NCT; d.ntiles = H0; d.stride0 = 128;
                const size_t co = (((size_t)b * DEPTH + l) * PAST) * 128 + kvh * 64;
                d.k0 = (const bf16_t*)(p.ws + WS_CGQK) + co; d.v0 = (const bf16_t*)(p.ws + WS_CGQV) + co;
                d.k1 = lk; d.v1 = lv; d.stride1 = 128;
            } else {
                d.n0 = 0; d.ntiles = TT - H0; d.stride1 = 128;
                d.k1 = lk + (size_t)(H0 - NCT) * 64 * 128; d.v1 = lv + (size_t)(H0 - NCT) * 64 * 128;
            }
            d.part = (float*)(p.ws + WS_PART) + (size_t)u * PART_STRIDE;
            attn_unit(smem, d);
        } else if (u < U_SG + U_SN) {
            const int uu = u - U_SG; const int qb = uu % QB_S, hd = (uu / QB_S) % NAH, b = uu / (QB_S * NAH);
            const size_t t0 = (size_t)NP + (size_t)b * DEC_SEQ;
            d.q = naq + (t0 + qb * 256) * 384 + hd * 64; d.qstride = 384;
            d.na = 1; d.r0 = qb * 4; d.rlo = na_row_start(d.r0);
            const int rhi = na_row_start(d.r0 + 3) + KR;
            d.n0 = PAST / 64; d.ntiles = d.n0 + (rhi - d.rlo); d.stride0 = 384; d.stride1 = 384;
            const size_t co = (((size_t)b * DEPTH + l) * PAST) * 384 + hd * 64;
            d.k0 = (const bf16_t*)(p.ws + WS_CNAK) + co; d.v0 = (const bf16_t*)(p.ws + WS_CNAV) + co;
            d.k1 = nak + (t0 + (size_t)d.rlo * 64) * 384 + hd * 64; d.v1 = nav + (t0 + (size_t)d.rlo * 64) * 384 + hd * 64;
            d.rpb = p.in[I_RPB] + ((size_t)l * NAH + hd) * 15 * 31;
            d.out = mixed + (t0 + qb * 256) * MIXW + hd * 64;
            attn_unit(smem, d);
        } else if (u < U_SG + U_SN + U_PN) {
            const int uu = u - U_SG - U_SN; const int qb = uu % QB_P, hd = (uu / QB_P) % NAH, b = uu / (QB_P * NAH);
            const size_t t0 = (size_t)b * SEQ;
            d.q = naq + (t0 + qb * 256) * 384 + hd * 64; d.qstride = 384;
            d.n0 = 0; d.ntiles = SEQ / 64; d.stride1 = 384; d.k1 = nak + t0 * 384 + hd * 64; d.v1 = nav + t0 * 384 + hd * 64;
            d.out = mixed + (t0 + qb * 256) * MIXW + hd * 64;
            attn_unit(smem, d);
        } else if (u < U_SG + U_SN + U_PN + U_PG) {
            const int uu = u - U_SG - U_SN - U_PN; const int qb = uu % QB_P, qh = (uu / QB_P) % GQH, b = uu / (QB_P * GQH);
            const int kvh = qh / (GQH / GQKV);
            const size_t t0 = (size_t)b * SEQ;
            d.q = gqq + (t0 + qb * 256) * 384 + qh * 64; d.qstride = 384;
            d.n0 = 0; d.ntiles = SEQ / 64; d.stride1 = 128; d.k1 = gqk + t0 * 128 + kvh * 64; d.v1 = gqv + t0 * 128 + kvh * 64;
            d.out = mixed + (t0 + qb * 256) * MIXW + 640 + qh * 64;
            attn_unit(smem, d);
        } else if (u < U_SG + U_SN + U_PN + U_PG + U_MP) {
            const int uu = u - (U_SG + U_SN + U_PN + U_PG); const int c = uu % NCH_P, hd = (uu / NCH_P) % MLH, b = uu / (NCH_P * MLH);
            mlstm_summary_unit(p, smem, 0, b, hd, c);
        } else {
            const int uu = u - (U_SG + U_SN + U_PN + U_PG + U_MP); const int c = uu % NCH_S, hd = (uu / NCH_S) % MLH, b = uu / (NCH_S * MLH);
            mlstm_summary_unit(p, smem, 1, b, hd, c);
        }
    }
}

DEV void phase_mlout(const Params& p, char* smem, int l) {
    constexpr int QB_S = DEC_SEQ / 256;
    constexpr int U_MS = DEC_BATCH * MLH * NCH_S, U_MP = BATCH * MLH * NCH_P, U_CB = DEC_BATCH * GQH * QB_S;
    const int tid = get_tid();
    for (int u = blockIdx.x; u < U_MS + U_MP + U_CB; u += gridDim.x) {
        if (u < U_MS) { const int c = u % NCH_S, hd = (u / NCH_S) % MLH, b = u / (NCH_S * MLH); mlstm_output_unit(p, smem, l, 1, b, hd, c); }
        else if (u < U_MS + U_MP) { const int uu = u - U_MS; const int c = uu % NCH_P, hd = (uu / NCH_P) % MLH, b = uu / (NCH_P * MLH); mlstm_output_unit(p, smem, l, 0, b, hd, c); }
        else {
            const int uu = u - U_MS - U_MP; const int qb = uu % QB_S, qh = (uu / QB_S) % GQH, b = uu / (QB_S * GQH);
            const float* p0 = (const float*)(p.ws + WS_PART) + (size_t)(2 * uu) * PART_STRIDE; const float* p1 = p0 + PART_STRIDE;
            const int q = tid >> 1, d0 = (tid & 1) * 32;
            const float m0 = p0[256 * 64 + q], m1 = p1[256 * 64 + q], l0 = p0[256 * 64 + 256 + q], l1 = p1[256 * 64 + 256 + q];
            const float m = fmaxf(m0, m1), w0 = expf(m0 - m), w1 = expf(m1 - m);
            const float inv = 1.f / (l0 * w0 + l1 * w1);
            bf16_t* dst = (bf16_t*)(p.ws + WS_MIXED) + ((size_t)NP + (size_t)b * DEC_SEQ + qb * 256 + q) * MIXW + 640 + qh * 64 + d0;
#pragma unroll
            for (int i = 0; i < 8; ++i) {
                const f4v a = *(const f4v*)(p0 + (size_t)q * 64 + d0 + 4 * i), bb = *(const f4v*)(p1 + (size_t)q * 64 + d0 + 4 * i);
                u2v pk; pk[0] = pack2((a[0] * w0 + bb[0] * w1) * inv, (a[1] * w0 + bb[1] * w1) * inv); pk[1] = pack2((a[2] * w0 + bb[2] * w1) * inv, (a[3] * w0 + bb[3] * w1) * inv);
                *(u2v*)(dst + 4 * i) = pk;
            }
        }
    }
}

constexpr int N_PHASES = 2 + 9 * DEPTH;
#ifdef EMU
static char emu_smem[SMEM_BYTES + 64];
#endif
__global__ void __launch_bounds__(512, 2) mega_kernel(Params p_) {
    const int ph0 = p_.ph0, ph1 = p_.ph1;
#ifdef EMU
    char* smem = emu_smem;
#define GRID_SYNC() do {} while (0)
#else
    extern __shared__ __attribute__((aligned(16))) char smem[];
    if (threadIdx.x == 0) *(u4v*)(smem + SMEM_XB) = (u4v){0u, 0u, 0u, 0u};
    __syncthreads();
    XcdBarrier xb = xcd_barrier_post((unsigned*)(p_.ws + WS_BAR), (volatile LAS unsigned*)(smem + SMEM_XB));
    const bool multi = (ph1 - ph0) > 1;
#define GRID_SYNC() do { if (multi) xcd_barrier(xb); } while (0)
#endif
    int ph = 0;
#ifndef KIND_MASK
#define KIND_MASK 0x3ff
#endif
#ifdef EMU
#define LOAD_PARAMS() const Params& p = p_
#else
#define LOAD_PARAMS() const __attribute__((address_space(4))) char* kp4 = (const __attribute__((address_space(4))) char*)__builtin_amdgcn_kernarg_segment_ptr(); \
    asm volatile("" : "+s"(kp4)); Params p; __builtin_memcpy(&p, (const char*)kp4, sizeof(Params))
#endif
#define RUN_PHASE(body) do { if (((KIND_MASK >> (ph == 0 ? 0 : ph == 1 + 9 * DEPTH ? 1 : 1 + (ph - 1) % 9)) & 1) && ph >= ph0 && ph < ph1) { { LOAD_PARAMS(); body; } if (ph + 1 < ph1) GRID_SYNC(); } ++ph; } while (0)
    RUN_PHASE(phase_ada(p, smem));
    for (int l = 0; l < DEPTH; ++l) {
        RUN_PHASE(phase_rows<0>(p, smem, l));
        RUN_PHASE(phase_inproj(p, smem, l));
        RUN_PHASE(phase_attn(p, smem, l));
        RUN_PHASE(phase_mlout(p, smem, l));
        RUN_PHASE(phase_outproj(p, smem, l));
        RUN_PHASE(phase_rows<1>(p, smem, l));
        RUN_PHASE(phase_topk(p, smem));
        RUN_PHASE(phase_gateup(p, smem, l));
        RUN_PHASE(phase_down(p, smem, l));
    }
    RUN_PHASE(phase_rows<0>(p, smem, DEPTH));
}

#ifndef EMU
#ifndef MK_N_LAUNCHES
#define MK_N_LAUNCHES 1
#endif
extern "C" void kernel_launch(void* const* d_in, const int* in_sizes, int n_in, void* d_out, int out_size, void* d_ws, size_t ws_size, hipStream_t stream) {
    (void)in_sizes; (void)n_in; (void)out_size; (void)ws_size;
    static int grid = 0;
    if (!grid) {
        int dev = 0, cus = 0, per_cu = 0;
        (void)hipGetDevice(&dev);
        (void)hipDeviceGetAttribute(&cus, hipDeviceAttributeMultiprocessorCount, dev);
        (void)hipFuncSetAttribute((const void*)mega_kernel, hipFuncAttributeMaxDynamicSharedMemorySize, SMEM_BYTES);
        (void)hipOccupancyMaxActiveBlocksPerMultiprocessor(&per_cu, mega_kernel, 512, SMEM_BYTES);
        grid = cus * (per_cu < 1 ? per_cu : 1);
        if (grid <= 0) grid = cus;
    }
    (void)hipMemsetAsync((char*)d_ws + WS_BAR, 0, WS_BAR_BYTES, stream);
    Params p = {};
    for (int i = 0; i < N_IN; ++i) p.in[i] = (const float*)d_in[i];
    p.out = (float*)d_out; p.ws = (char*)d_ws;
#if MK_N_LAUNCHES == 1
    p.ph0 = 0; p.ph1 = N_PHASES;
    mega_kernel<<<dim3(grid), dim3(512), SMEM_BYTES, stream>>>(p);
#else
    for (int ph = 0; ph < N_PHASES; ++ph) { p.ph0 = ph; p.ph1 = ph + 1; mega_kernel<<<dim3(grid), dim3(512), SMEM_BYTES, stream>>>(p); }
#endif
}
#endif
```

```cpp
#ifndef EMU
#include <hip/hip_runtime.h>
#define DEV __device__ __forceinline__
#else
#define DEV static inline __attribute__((always_inline))
#endif
#include <stdint.h>
#include <stddef.h>

#ifndef CFG_D
#define CFG_D 1024
#define CFG_BATCH 16
#define CFG_SEQ 256
#define CFG_DEC_BATCH 2
#define CFG_DEC_SEQ 2048
#define CFG_PAST 256
#define CFG_EH 2816
#endif
constexpr int D = CFG_D, BATCH = CFG_BATCH, SEQ = CFG_SEQ, DEC_BATCH = CFG_DEC_BATCH, DEC_SEQ = CFG_DEC_SEQ, PAST = CFG_PAST, EH = CFG_EH;
constexpr int DEPTH = 2, HD = 64, NAH = 6, MLH = 4, GQH = 6, GQKV = 2, NEXP = 16, GRIDW = 64;
constexpr int NP = BATCH * SEQ, NS = DEC_BATCH * DEC_SEQ, NT = NP + NS, NCOND = 1 + DEC_BATCH;
constexpr int PROJ_W = 2832, MIXW = 1024;
constexpr int CAP_P = SEQ / 8, CAP_S = DEC_SEQ / 8, SLOTS = BATCH * CAP_P + DEC_BATCH * CAP_S;
constexpr int ROWS = DEC_SEQ / GRIDW, KR = ROWS < 8 ? ROWS : 8, KC = 16;
constexpr int NCH_P = SEQ / 64, NCH_S = DEC_SEQ / 64;
constexpr float ALPHA = 1.41421356237309515f;
constexpr float ATT_SCALE = 0.125f;
constexpr float EPS = 1e-6f;
static_assert(SLOTS % 256 == 0 && NP % 256 == 0 && NS % 256 == 0 && SEQ % 256 == 0 && DEC_SEQ % 256 == 0, "tile divisibility");
static_assert(D % 256 == 0 && EH % 128 == 0 && PAST % 64 == 0, "tile divisibility");

typedef unsigned short bf16_t;
typedef short s8v __attribute__((ext_vector_type(8)));
typedef short s4v __attribute__((ext_vector_type(4)));
typedef float f16v __attribute__((ext_vector_type(16)));
typedef float f4v __attribute__((ext_vector_type(4)));
typedef unsigned u4v __attribute__((ext_vector_type(4)));
typedef unsigned u2v __attribute__((ext_vector_type(2)));

enum { I_XP = 0, I_XS, I_C, I_CNAK, I_CNAV, I_CGQK, I_CGQV, I_SC, I_SN, I_SM, I_CCTX, I_ADAW, I_ADAB, I_WIN, I_BGATE, I_WOUT, I_RPB, I_QKG, I_MLG,
       I_LNG, I_LNB, I_RW, I_WG, I_WU, I_WD, N_IN };

constexpr size_t O_YP = 0;
constexpr size_t O_YS = O_YP + (size_t)NP * D;
constexpr size_t O_NAK = O_YS + (size_t)NS * D;
constexpr size_t O_NAV = O_NAK + (size_t)BATCH * DEPTH * SEQ * NAH * HD;
constexpr size_t O_GQK = O_NAV + (size_t)BATCH * DEPTH * SEQ * NAH * HD;
constexpr size_t O_GQV = O_GQK + (size_t)BATCH * DEPTH * SEQ * GQKV * HD;
constexpr size_t O_MC = O_GQV + (size_t)BATCH * DEPTH * SEQ * GQKV * HD;
constexpr size_t O_MN = O_MC + (size_t)BATCH * DEPTH * 2 * MLH * HD * HD;
constexpr size_t O_MM = O_MN + (size_t)BATCH * DEPTH * 2 * MLH * HD;
constexpr size_t O_END = O_MM + (size_t)BATCH * DEPTH * 2 * MLH;

constexpr size_t al256(size_t x) { return (x + 255) & ~(size_t)255; }
constexpr size_t WS_BAR = 0;
constexpr size_t WS_BAR_BYTES = 32768;
constexpr size_t WS_MODS = WS_BAR + WS_BAR_BYTES;
constexpr size_t WS_ROPE = al256(WS_MODS + (size_t)DEPTH * NCOND * 6 * D * 4);
constexpr size_t WS_CNAK = al256(WS_ROPE + 64 * 16 * 2 * 4);
constexpr size_t WS_CNAV = al256(WS_CNAK + (size_t)DEC_BATCH * DEPTH * PAST * NAH * HD * 2);
constexpr size_t WS_CGQK = al256(WS_CNAV + (size_t)DEC_BATCH * DEPTH * PAST * NAH * HD * 2);
constexpr size_t WS_CGQV = al256(WS_CGQK + (size_t)DEC_BATCH * DEPTH * PAST * GQKV * HD * 2);
constexpr size_t WS_XBUF = al256(WS_CGQV + (size_t)DEC_BATCH * DEPTH * PAST * GQKV * HD * 2);
constexpr size_t WS_HMOD = al256(WS_XBUF + (size_t)NT * D * 4);
constexpr size_t WS_GATES = al256(WS_HMOD + (size_t)NT * D * 2);
constexpr size_t WS_NAQ = al256(WS_GATES + (size_t)NT * 16 * 4);
constexpr size_t WS_NAK = al256(WS_NAQ + (size_t)NT * 384 * 2);
constexpr size_t WS_NAV = al256(WS_NAK + (size_t)NT * 384 * 2);
constexpr size_t WS_MLQ = al256(WS_NAV + (size_t)NT * 384 * 2);
constexpr size_t WS_MLK = al256(WS_MLQ + (size_t)NT * 256 * 2);
constexpr size_t WS_MLV = al256(WS_MLK + (size_t)NT * 256 * 2);
constexpr size_t WS_MLO = al256(WS_MLV + (size_t)NT * 256 * 2);
constexpr size_t WS_GQQ = al256(WS_MLO + (size_t)NT * 256 * 2);
constexpr size_t WS_GQK = al256(WS_GQQ + (size_t)NT * 384 * 2);
constexpr size_t WS_GQV = al256(WS_GQK + (size_t)NT * 128 * 2);
constexpr size_t WS_MIXED = al256(WS_GQV + (size_t)NT * 128 * 2);
constexpr size_t WS_U = al256(WS_MIXED + (size_t)NT * MIXW * 2);
constexpr size_t WS_X1 = al256(WS_U + (size_t)NT * D * 4);
constexpr size_t WS_H2 = al256(WS_X1 + (size_t)NT * D * 4);
constexpr size_t WS_AFF = al256(WS_H2 + (size_t)NT * D * 2);
constexpr size_t WS_IDX = al256(WS_AFF + (size_t)NT * 16 * 4);
constexpr size_t WS_GSEL = al256(WS_IDX + (size_t)NEXP * SLOTS * 4);
constexpr size_t WS_TOKSLOT = al256(WS_GSEL + (size_t)NEXP * SLOTS * 4);
constexpr size_t WS_HID = al256(WS_TOKSLOT + (size_t)NT * 16 * 4);
constexpr size_t WS_YE = al256(WS_HID + (size_t)NEXP * SLOTS * EH * 2);
constexpr int MLSUM_STRIDE = 4096 + 64 + 64;
constexpr int N_MLSUM = (BATCH * NCH_P + DEC_BATCH * NCH_S) * MLH * 2;
constexpr size_t WS_MLSUM = al256(WS_YE + (size_t)NEXP * SLOTS * D * 4);
constexpr int PART_STRIDE = 256 * 64 + 512;
constexpr int N_PART = DEC_BATCH * GQH * (DEC_SEQ / 256) * 2;
constexpr size_t WS_PART = al256(WS_MLSUM + (size_t)N_MLSUM * MLSUM_STRIDE * 4);
constexpr size_t WS_TOTAL = al256(WS_PART + (size_t)N_PART * PART_STRIDE * 4);

struct Params {
    const float* in[N_IN];
    float* out;
    char* ws;
    int ph0, ph1;
};

DEV float bf2f(bf16_t s) { unsigned u = ((unsigned)s) << 16; return __builtin_bit_cast(float, u); }
DEV bf16_t f2bf(float f) {
#ifdef EMU
    unsigned u = __builtin_bit_cast(unsigned, f); u += 0x7fffu + ((u >> 16) & 1u); return (bf16_t)(u >> 16);
#else
    return __builtin_bit_cast(bf16_t, (__bf16)f);
#endif
}
DEV unsigned pack2(float a, float b) {
#ifdef EMU
    return (unsigned)f2bf(a) | ((unsigned)f2bf(b) << 16);
#else
    typedef __bf16 b2 __attribute__((ext_vector_type(2))); b2 r; r[0] = (__bf16)a; r[1] = (__bf16)b; return __builtin_bit_cast(unsigned, r);
#endif
}
DEV float fexp(float x) {
#ifdef EMU
    return expf(x);
#else
    return __expf(x);
#endif
}
DEV float sigmoidf_(float x) { return 1.f / (1.f + fexp(-x)); }
DEV float siluf_(float x) { return x / (1.f + fexp(-x)); }
DEV float logsigmoidf_(float x) { return fminf(x, 0.f) - log1pf(expf(-fabsf(x))); }
DEV f16v mfma32(s8v a, s8v b, f16v c) {
#ifdef EMU
    return emu_mfma_32x32x16_bf16(a, b, c);
#else
    typedef __bf16 bf8 __attribute__((ext_vector_type(8)));
    return __builtin_amdgcn_mfma_f32_32x32x16_bf16(__builtin_bit_cast(bf8, a), __builtin_bit_cast(bf8, b), c, 0, 0, 0);
#endif
}
DEV s4v lds_tr16(const void* p) {
#ifdef EMU
    return emu_ds_read_tr16_b64(p);
#else
    typedef s4v __attribute__((address_space(3))) * lp;
    return __builtin_amdgcn_ds_read_tr16_b64_v4i16((lp)(p));
#endif
}
#ifdef EMU
DEV float wave_sum(float v) { for (int m = 32; m >= 1; m >>= 1) v += __shfl_xor(v, m); return v; }
#else
template <int CTRL, int RM> DEV float dpp_f(float v) { return __builtin_bit_cast(float, __builtin_amdgcn_update_dpp(0, __builtin_bit_cast(int, v), CTRL, RM, 0xF, false)); }
DEV float wave_sum(float v) {
    v += dpp_f<0xB1, 0xF>(v); v += dpp_f<0x4E, 0xF>(v); v += dpp_f<0x141, 0xF>(v); v += dpp_f<0x140, 0xF>(v);
    v += dpp_f<0x142, 0xA>(v); v += dpp_f<0x143, 0xC>(v);
    return __builtin_bit_cast(float, __builtin_amdgcn_readlane(__builtin_bit_cast(int, v), 63));
}
#endif
DEV float wave_max(float v) { for (int m = 32; m >= 1; m >>= 1) v = fmaxf(v, __shfl_xor(v, m)); return v; }
DEV f16v f16zero() { f16v z; for (int i = 0; i < 16; ++i) z[i] = 0.f; return z; }

#ifdef EMU
#define SGPR_PIN(x) do {} while (0)
#define SCHED_FENCE() do {} while (0)
#define CFENCE() do {} while (0)
#else
#define SCHED_FENCE() __builtin_amdgcn_sched_barrier(0)
#define SGPR_PIN(x) asm volatile("" : "+s"(x))
#define CFENCE() asm volatile("" ::: "memory")
#endif
#ifdef EMU
DEV int get_tid() { return (int)threadIdx.x; }
#else
DEV int get_tid() { int t = threadIdx.x; asm volatile("" : "+v"(t)); return t; }
#endif
struct UnitIter { int i, end, step; };
DEV UnitIter unit_iter(int NU) {
    const int G = (int)gridDim.x, b = (int)blockIdx.x;
    UnitIter it;
    if ((G & 7) == 0 && (NU & 7) == 0) { const int W = G >> 3, x = b & 7, j = b >> 3, C = NU >> 3; it.i = x * C + j; it.end = (x + 1) * C; it.step = W; }
    else { it.i = b; it.end = NU; it.step = G; }
    return it;
}
DEV int tok_cond(int t) { return t < NP ? 0 : 1 + (t - NP) / DEC_SEQ; }

#ifndef EMU
#define XB_TMO      128
#define XB_XCNT(j)  (256  + 64 * (j))
#define XB_XSUB(j)  (1280 + 64 * (j))
#define XB_XGEN(j)  (2304 + 64 * (j))
#define XB_TOP      3328
#define XB_TOPGEN   3392
#define XCD_BAR_WORDS 3456
#define XB_SPIN_CAP (1u << 20)
#define LAS __attribute__((address_space(3)))
__device__ __forceinline__ unsigned xb_ld(unsigned* p)              { return __hip_atomic_load(p, __ATOMIC_RELAXED, __HIP_MEMORY_SCOPE_AGENT); }
__device__ __forceinline__ unsigned xb_add(unsigned* p, unsigned v) { return __hip_atomic_fetch_add(p, v, __ATOMIC_RELAXED, __HIP_MEMORY_SCOPE_AGENT); }
__device__ __forceinline__ unsigned xb_xcc_id() { return (unsigned)__builtin_amdgcn_s_getreg((3 << 11) | 20) & 0xFu; }
#define XB_SPIN(cond, bar) do { unsigned _sp = 0; while (cond) { __builtin_amdgcn_s_sleep(1); \
    if ((++_sp & 255u) == 0u) { if (xb_ld(&(bar)[XB_TMO])) break; if (_sp > XB_SPIN_CAP) { atomicAdd(&(bar)[XB_TMO], 1u); break; } } } } while (0)
struct XcdBarrier { unsigned* bar; unsigned x; volatile LAS unsigned* st; };
__device__ __forceinline__ XcdBarrier xcd_barrier_post(unsigned* bar, volatile LAS unsigned* st) {
    XcdBarrier b; b.bar = bar; b.x = xb_xcc_id(); b.st = st;
    if (threadIdx.x == 0) (void)xb_add(&bar[XB_XCNT(b.x)], 1u);
    return b;
}
__device__ __forceinline__ void xcd_barrier_complete(unsigned* bar, unsigned x, unsigned& nloc, unsigned& nx) {
    const unsigned G = gridDim.x * gridDim.y * gridDim.z;
    unsigned sum, cnt, mine, sp = 0u;
    for (;;) {
        sum = 0u; cnt = 0u; mine = 0u;
#pragma unroll
        for (unsigned j = 0; j < 16; ++j) { const unsigned c = xb_ld(&bar[XB_XCNT(j)]); sum += c; cnt += (c > 0u) ? 1u : 0u; mine = (j == x) ? c : mine; }
        if (sum == G) break;
        __builtin_amdgcn_s_sleep(1);
        if ((++sp & 255u) == 0u) { if (xb_ld(&bar[XB_TMO])) break; if (sp > XB_SPIN_CAP) { atomicAdd(&bar[XB_TMO], 1u); break; } }
    }
    nloc = mine > 0u ? mine : 1u; nx = cnt > 0u ? cnt : 1u;
}
__device__ __forceinline__ void xcd_barrier(const XcdBarrier& b) {
    asm volatile("s_waitcnt vmcnt(0)" ::: "memory");
    __syncthreads();
    if (threadIdx.x == 0) {
        unsigned* bar = b.bar;
        __builtin_amdgcn_s_waitcnt(0);
        unsigned nloc = b.st[0], nx = b.st[1];
        if (nloc == 0u) { xcd_barrier_complete(bar, b.x, nloc, nx); b.st[0] = nloc; b.st[1] = nx; }
        const unsigned old = xb_add(&bar[XB_XSUB(b.x)], 1u);
        const unsigned gen = old / nloc;
        if (old + 1u == (gen + 1u) * nloc) {
            __builtin_amdgcn_fence(__ATOMIC_RELEASE, "agent");
            asm volatile("s_waitcnt vmcnt(0)" ::: "memory");
            const unsigned og = xb_add(&bar[XB_TOP], 1u);
            const unsigned tg = og / nx;
            if (og + 1u == (tg + 1u) * nx) xb_add(&bar[XB_TOPGEN], 1u);
            else XB_SPIN(xb_ld(&bar[XB_TOPGEN]) == tg, bar);
            __builtin_amdgcn_fence(__ATOMIC_ACQUIRE, "agent");
            xb_add(&bar[XB_XGEN(b.x)], 1u);
            asm volatile("s_waitcnt vmcnt(0)" ::: "memory");
        } else {
            XB_SPIN(xb_ld(&bar[XB_XGEN(b.x)]) == gen, bar);
            __builtin_amdgcn_fence(__ATOMIC_ACQUIRE, "agent");
            asm volatile("s_waitcnt vmcnt(0)" ::: "memory");
        }
    }
    __syncthreads();
}
#endif
constexpr int QUEUE_WORD0 = 4096;

constexpr int LROW = 144;
constexpr int GEMM_AS = 256 * LROW;
constexpr int GEMM_BS = 64 * (256 * 2 + 64);
constexpr int SMEM_BYTES = 2 * GEMM_AS + 2 * GEMM_BS + 64;
constexpr int SMEM_XB = 2 * GEMM_AS + 2 * GEMM_BS;

#ifdef EMU
struct BufRsrc { const char* base; };
DEV BufRsrc make_rsrc(const void* p) { BufRsrc r; r.base = (const char*)p; return r; }
DEV float buf_load_f32(BufRsrc r, unsigned voff, unsigned soff) { return *(const float*)(r.base + voff + soff); }
DEV u4v buf_load_b128(BufRsrc r, unsigned voff, unsigned soff) { return *(const u4v*)(r.base + voff + soff); }
#else
typedef __amdgpu_buffer_rsrc_t BufRsrc;
DEV BufRsrc make_rsrc(const void* p) { return __builtin_amdgcn_make_buffer_rsrc((void*)p, 0, 0x7fffffff, 0x00020000); }
DEV float buf_load_f32(BufRsrc r, unsigned voff, unsigned soff) { return __builtin_bit_cast(float, __builtin_amdgcn_raw_buffer_load_b32(r, voff, soff, 0)); }
DEV u4v buf_load_b128(BufRsrc r, unsigned voff, unsigned soff) { return __builtin_amdgcn_raw_buffer_load_b128(r, voff, soff, 0); }
#endif
template <int NTW, int VAR, class Epi>
DEV void gemm_tile(char* smem, BufRsrc ars, unsigned ao0, unsigned ao1, unsigned ao2, unsigned ao3,
                   BufRsrc brs, unsigned bvo, unsigned blds, unsigned ldb4, int K, Epi&& epi) {
    constexpr int BN = 64 * NTW, NLD = 2 * NTW, KSTEP = 64 / NLD, RSB = BN * 2 + 64;
    const int tid = get_tid(), lane = tid & 63, wave = tid >> 6, wm = wave & 3, wn = wave >> 2, h = lane >> 5, l31 = lane & 31;
    char* As = smem; char* Bs = smem + 2 * GEMM_AS;
    constexpr int BSZ = 64 * RSB;
    const int ar = tid >> 3, ac = tid & 7;
    u4v areg[4]; f4v b0[NLD], b1[NLD];
    if (VAR & 3) { for (int i = 0; i < 4; ++i) areg[i] = (u4v){1u, 2u, 3u, 4u}; for (int j = 0; j < NLD; ++j) { b0[j] = (f4v){1.f, 1.f, 1.f, 1.f}; b1[j] = (f4v){2.f, 2.f, 2.f, 2.f}; } }
    f16v acc[NTW][2];
#pragma unroll
    for (int i = 0; i < NTW; ++i) { acc[i][0] = f16zero(); acc[i][1] = f16zero(); }
    auto gloadA = [&](int k0, bool real) {
        if (VAR & 2) return;
        const unsigned so = real ? k0 * 2 : 0u;
        areg[0] = buf_load_b128(ars, real ? ao0 : 0u, so); areg[1] = buf_load_b128(ars, real ? ao1 : 0u, so);
        areg[2] = buf_load_b128(ars, real ? ao2 : 0u, so); areg[3] = buf_load_b128(ars, real ? ao3 : 0u, so);
    };
    auto gloadB = [&](int k0, bool real, f4v (&br)[NLD]) {
        if (VAR & 1) return;
        const unsigned vo = real ? bvo : 0u; const int kk = real ? k0 : 0;
        unsigned so = (unsigned)kk * ldb4;
#pragma unroll
        for (int j = 0; j < NLD; ++j) { br[j] = __builtin_bit_cast(f4v, buf_load_b128(brs, vo, so)); so += KSTEP * ldb4; SGPR_PIN(so); }
    };
    auto lstoreA = [&](int buf) {
        if (VAR & 16) return;
        char* ab = As + buf * GEMM_AS + ar * LROW + ac * 16;
#pragma unroll
        for (int i = 0; i < 4; ++i) *(u4v*)(ab + i * 64 * LROW) = areg[i];
    };
    auto lstoreB = [&](int buf, const f4v (&br)[NLD]) {
        if (VAR & 16) return;
        char* bb = Bs + buf * BSZ + blds;
#pragma unroll
        for (int j = 0; j < NLD; ++j) { u2v v; v[0] = pack2(br[j][0], br[j][1]); v[1] = pack2(br[j][2], br[j][3]); *(u2v*)(bb + j * KSTEP * RSB) = v; }
    };
    const unsigned btr = (unsigned)(8 * h + ((lane & 15) >> 2)) * RSB + (unsigned)((((lane >> 4) & 1) * 16 + 4 * (lane & 3)) * 2) + (unsigned)(wn * NTW * 32) * 2;
    auto compute = [&](int buf, int s) {
        if (VAR & 8) return;
        const char* ab = As + buf * GEMM_AS + (wm * 64 + l31) * LROW + h * 16;
        const char* bb = Bs + buf * BSZ + btr + s * 16 * RSB;
        s8v xf[2];
        xf[0] = *(const s8v*)(ab + s * 32); xf[1] = *(const s8v*)(ab + 32 * LROW + s * 32);
#pragma unroll
        for (int ft = 0; ft < NTW; ++ft) {
            const s4v lo = lds_tr16(bb + ft * 64), hi = lds_tr16(bb + ft * 64 + 4 * RSB);
            s8v wf; wf[0] = lo[0]; wf[1] = lo[1]; wf[2] = lo[2]; wf[3] = lo[3]; wf[4] = hi[0]; wf[5] = hi[1]; wf[6] = hi[2]; wf[7] = hi[3];
            if (VAR & 4) { acc[ft][0][0] += __builtin_bit_cast(float, (int)wf[0] | ((int)xf[0][1] << 16)); acc[ft][1][0] += __builtin_bit_cast(float, (int)wf[1] | ((int)xf[1][1] << 16)); }
            else { acc[ft][0] = mfma32(wf, xf[0], acc[ft][0]); acc[ft][1] = mfma32(wf, xf[1], acc[ft][1]); }
        }
        SCHED_FENCE();
    };
    const int nk = K / 64;
    gloadA(0, true); gloadB(0, true, b0); gloadB(64, true, b1);
    lstoreA(0); lstoreB(0, b0);
    __syncthreads();
    for (int kt = 0; kt < nk; kt += 2) {
        const bool t2 = kt + 2 < nk;
        gloadA((kt + 1) * 64, true);
        gloadB((kt + 2) * 64, t2, b0);
        compute(0, 0); compute(0, 1); compute(0, 2); compute(0, 3);
        lstoreA(1); lstoreB(1, b1);
        __syncthreads();
        gloadA((kt + 2) * 64, t2);
        gloadB((kt + 3) * 64, t2, b1);
        compute(1, 0); compute(1, 1); compute(1, 2); compute(1, 3);
        lstoreA(0); lstoreB(0, b0);
        __syncthreads();
    }
    epi(acc);
}

DEV void phase_ada(const Params& p, char* smem) {
    const int tid = get_tid();
    float* siluS = (float*)smem;
    float* red = (float*)(smem + NCOND * D * 4);
    for (int i = tid; i < NCOND * D; i += 512) {
        const int cnd = i / D, k = i % D;
        const float c = cnd == 0 ? p.in[I_CCTX][k] : p.in[I_C][(cnd - 1) * D + k];
        siluS[i] = c / (1.f + expf(-c));
    }
    __syncthreads();
    constexpr int CPL = 6 * D / 32, NCHUNK = DEPTH * CPL, KG = D / 16;
    float* mods = (float*)(p.ws + WS_MODS);
    const int col = tid & 31, kg = tid >> 5;
    for (int u = blockIdx.x; u < NCHUNK; u += gridDim.x) {
        const int l = u / CPL, c0 = (u % CPL) * 32;
        const float* W = p.in[I_ADAW] + (size_t)l * D * 6 * D + c0 + col;
        float acc[NCOND];
#pragma unroll
        for (int c = 0; c < NCOND; ++c) acc[c] = 0.f;
#pragma unroll 8
        for (int k = kg * KG; k < kg * KG + KG; ++k) {
            const float w = W[(size_t)k * 6 * D];
#pragma unroll
            for (int c = 0; c < NCOND; ++c) acc[c] += siluS[c * D + k] * w;
        }
#pragma unroll
        for (int c = 0; c < NCOND; ++c) red[(kg * NCOND + c) * 32 + col] = acc[c];
        __syncthreads();
        if (tid < 32 * NCOND) {
            const int c = tid >> 5, cc = tid & 31;
            float s = 0.f;
            for (int g = 0; g < 16; ++g) s += red[(g * NCOND + c) * 32 + cc];
            mods[((size_t)l * NCOND + c) * 6 * D + c0 + cc] = s + p.in[I_ADAB][(size_t)l * 6 * D + c0 + cc];
        }
        __syncthreads();
    }
    const int gtid = blockIdx.x * 512 + tid, gsz = gridDim.x * 512;
    float* rope = (float*)(p.ws + WS_ROPE);
    for (int i = gtid; i < 64 * 16; i += gsz) {
        const int pos = i >> 4, fi = i & 15;
        const float inv = powf(10000.f, -(float)(2 * fi) / 32.f);
        const float ang = (float)pos * inv;
        rope[2 * i] = cosf(ang); rope[2 * i + 1] = sinf(ang);
    }
    constexpr int NNA = DEC_BATCH * DEPTH * PAST * NAH * HD, NGQ = DEC_BATCH * DEPTH * PAST * GQKV * HD;
    bf16_t* cnak = (bf16_t*)(p.ws + WS_CNAK); bf16_t* cnav = (bf16_t*)(p.ws + WS_CNAV);
    bf16_t* cgqk = (bf16_t*)(p.ws + WS_CGQK); bf16_t* cgqv = (bf16_t*)(p.ws + WS_CGQV);
    for (int i = gtid; i < NNA; i += gsz) { cnak[i] = f2bf(p.in[I_CNAK][i]); cnav[i] = f2bf(p.in[I_CNAV][i]); }
    for (int i = gtid; i < NGQ; i += gsz) { cgqk[i] = f2bf(p.in[I_CGQK][i]); cgqv[i] = f2bf(p.in[I_CGQV][i]); }
}

constexpr int EPL = D / 64;
constexpr int W16ROW = 20;
template <int MODE>
DEV void phase_rows(const Params& p, char* smem, int l) {
    const int tid = get_tid(), lane = tid & 63, wave = tid >> 6;
    float* W16 = (float*)smem;
    const bool need_w = (MODE == 1) || (l < DEPTH);
    if (need_w) {
        for (int i = tid; i < D * 4; i += 512) {
            const int k = i >> 2, q = i & 3;
            const float* src = (MODE == 1) ? p.in[I_RW] + ((size_t)l * D + k) * 16 + q * 4 : p.in[I_WIN] + ((size_t)l * D + k) * PROJ_W + 2176 + q * 4;
            *(f4v*)(W16 + k * W16ROW + q * 4) = *(const f4v*)src;
        }
    }
    __syncthreads();
    const float* mods = (const float*)(p.ws + WS_MODS);
    for (int t = blockIdx.x * 8 + wave; t < NT; t += gridDim.x * 8) {
        const int cnd = tok_cond(t);
        float v[EPL];
        if (MODE == 0) {
            if (l == 0) {
                const float* xr = t < NP ? p.in[I_XP] + (size_t)t * D : p.in[I_XS] + (size_t)(t - NP) * D;
#pragma unroll
                for (int j = 0; j < EPL; ++j) v[j] = xr[lane + 64 * j];
            } else {
                const float* x1 = (const float*)(p.ws + WS_X1) + (size_t)t * D;
                const float* g2 = mods + ((size_t)(l - 1) * NCOND + cnd) * 6 * D + 5 * D;
                float f[EPL];
#pragma unroll
                for (int j = 0; j < EPL; ++j) f[j] = 0.f;
                const int* ts = (const int*)(p.ws + WS_TOKSLOT) + (size_t)t * 16;
                const int myslot = lane < 16 ? ts[lane] : -1;
                unsigned vm = (unsigned)__ballot(myslot >= 0);
                while (vm) {
                    const int e = __builtin_ctz(vm); vm &= vm - 1u;
                    const int slot = __shfl(myslot, e);
                    const float* yr = (const float*)(p.ws + WS_YE) + ((size_t)e * SLOTS + slot) * D;
#pragma unroll
                    for (int j = 0; j < EPL; ++j) f[j] += yr[lane + 64 * j];
                }
                float s = 0.f;
#pragma unroll
                for (int j = 0; j < EPL; ++j) { v[j] = ALPHA * x1[lane + 64 * j] + g2[lane + 64 * j] * f[j]; s += v[j]; }
                const float mu = wave_sum(s) * (1.f / D);
                float q = 0.f;
#pragma unroll
                for (int j = 0; j < EPL; ++j) { const float dlt = v[j] - mu; q += dlt * dlt; }
                const float rstd = 1.f / sqrtf(wave_sum(q) * (1.f / D) + EPS);
                const float* lg = p.in[I_LNG] + ((size_t)(l - 1) * 2 + 1) * D; const float* lb = p.in[I_LNB] + ((size_t)(l - 1) * 2 + 1) * D;
                float* dst = (l == DEPTH) ? (t < NP ? p.out + O_YP + (size_t)t * D : p.out + O_YS + (size_t)(t - NP) * D) : (float*)(p.ws + WS_XBUF) + (size_t)t * D;
#pragma unroll
                for (int j = 0; j < EPL; ++j) { v[j] = (v[j] - mu) * rstd * lg[lane + 64 * j] + lb[lane + 64 * j]; dst[lane + 64 * j] = v[j]; }
            }
            if (l < DEPTH) {
                const float* sh = mods + ((size_t)l * NCOND + cnd) * 6 * D; const float* sc = sh + D;
                bf16_t* hm = (bf16_t*)(p.ws + WS_HMOD) + (size_t)t * D;
                float a16[16];
#pragma unroll
                for (int e = 0; e < 16; ++e) a16[e] = 0.f;
#pragma unroll
                for (int j = 0; j < EPL; ++j) {
                    const int k = lane + 64 * j;
                    const float hv = v[j] * (1.f + sc[k]) + sh[k];
                    hm[k] = f2bf(hv);
                    const float* wr = W16 + k * W16ROW;
#pragma unroll
                    for (int q = 0; q < 4; ++q) { const f4v w4 = *(const f4v*)(wr + 4 * q); a16[4 * q] += hv * w4[0]; a16[4 * q + 1] += hv * w4[1]; a16[4 * q + 2] += hv * w4[2]; a16[4 * q + 3] += hv * w4[3]; }
                    CFENCE();
                }
                float mine = 0.f;
#pragma unroll
                for (int e = 0; e < 16; ++e) { const float s = wave_sum(a16[e]); if (lane == e) mine = s; }
                if (lane < 16) ((float*)(p.ws + WS_GATES))[(size_t)t * 16 + lane] = mine + p.in[I_BGATE][l * 16 + lane];
            }
        } else {
            const float* u = (const float*)(p.ws + WS_U) + (size_t)t * D;
            float s = 0.f;
#pragma unroll
            for (int j = 0; j < EPL; ++j) { v[j] = u[lane + 64 * j]; s += v[j]; }
            const float mu = wave_sum(s) * (1.f / D);
            float q = 0.f;
#pragma unroll
            for (int j = 0; j < EPL; ++j) { const float dlt = v[j] - mu; q += dlt * dlt; }
            const float rstd = 1.f / sqrtf(wave_sum(q) * (1.f / D) + EPS);
            const float* lg = p.in[I_LNG] + ((size_t)l * 2) * D; const float* lb = p.in[I_LNB] + ((size_t)l * 2) * D;
            const float* sh = mods + ((size_t)l * NCOND + cnd) * 6 * D + 3 * D; const float* sc = sh + D;
            float* x1 = (float*)(p.ws + WS_X1) + (size_t)t * D;
            bf16_t* h2 = (bf16_t*)(p.ws + WS_H2) + (size_t)t * D;
            float a16[16];
#pragma unroll
            for (int e = 0; e < 16; ++e) a16[e] = 0.f;
#pragma unroll
            for (int j = 0; j < EPL; ++j) {
                const int k = lane + 64 * j;
                const float xv = (v[j] - mu) * rstd * lg[k] + lb[k];
                x1[k] = xv;
                const float hv = xv * (1.f + sc[k]) + sh[k];
                h2[k] = f2bf(hv);
                const float* wr = W16 + k * W16ROW;
#pragma unroll
                for (int q4 = 0; q4 < 4; ++q4) { const f4v w4 = *(const f4v*)(wr + 4 * q4); a16[4 * q4] += hv * w4[0]; a16[4 * q4 + 1] += hv * w4[1]; a16[4 * q4 + 2] += hv * w4[2]; a16[4 * q4 + 3] += hv * w4[3]; }
                CFENCE();
            }
            float mine = -1e30f;
#pragma unroll
            for (int e = 0; e < 16; ++e) { const float sm = wave_sum(a16[e]); if (lane == e) mine = sm; }
            float mx = mine;
            for (int m = 8; m >= 1; m >>= 1) mx = fmaxf(mx, __shfl_xor(mx, m));
            const float ex = lane < 16 ? expf(mine - mx) : 0.f;
            float sm = ex;
            for (int m = 8; m >= 1; m >>= 1) sm += __shfl_xor(sm, m);
            if (lane < 16) ((float*)(p.ws + WS_AFF))[(size_t)t * 16 + lane] = ex / sm;
        }
    }
}

template <int NPL>
DEV void topk_wave(const Params& p, int tb, int cap, int sbase, int e, int lane) {
    const float* aff = (const float*)(p.ws + WS_AFF);
    int* idx = (int*)(p.ws + WS_IDX); float* gsel = (float*)(p.ws + WS_GSEL); int* tokslot = (int*)(p.ws + WS_TOKSLOT);
    unsigned bits[NPL];
#pragma unroll
    for (int i = 0; i < NPL; ++i) bits[i] = __builtin_bit_cast(unsigned, aff[(size_t)(tb + lane + 64 * i) * 16 + e]);
    unsigned T = 0u;
    for (int b = 30; b >= 0; --b) {
        const unsigned cand = T | (1u << b);
        int cnt = 0;
#pragma unroll
        for (int i = 0; i < NPL; ++i) cnt += __popcll(__ballot(bits[i] >= cand));
        if (cnt >= cap) T = cand;
    }
    int ngt = 0;
#pragma unroll
    for (int i = 0; i < NPL; ++i) ngt += __popcll(__ballot(bits[i] > T));
    int need_eq = cap - ngt, run = 0;
    const unsigned long long lt = (1ull << lane) - 1ull;
#pragma unroll
    for (int i = 0; i < NPL; ++i) {
        const bool eq = bits[i] == T;
        const unsigned long long meq = __ballot(eq);
        const int eqrank = __popcll(meq & lt);
        const bool sel = bits[i] > T || (eq && eqrank < need_eq);
        const unsigned long long ms = __ballot(sel);
        const int t = tb + lane + 64 * i;
        if (sel) { const int slot = sbase + run + __popcll(ms & lt); idx[e * SLOTS + slot] = t; gsel[e * SLOTS + slot] = __builtin_bit_cast(float, bits[i]); tokslot[(size_t)t * 16 + e] = slot; }
        else tokslot[(size_t)t * 16 + e] = -1;
        run += __popcll(ms);
        const int neq = __popcll(meq); need_eq -= neq < need_eq ? neq : need_eq;
    }
}
DEV void phase_topk(const Params& p, char* smem) {
    (void)smem;
    const int tid = get_tid(), lane = tid & 63;
    constexpr int US = DEC_BATCH * NEXP, UP = BATCH * NEXP;
    const int gw = blockIdx.x * 8 + (tid >> 6), nw = gridDim.x * 8;
    for (int u = gw; u < US + UP; u += nw) {
        if (u < US) { const int b = u / NEXP, e = u % NEXP; topk_wave<DEC_SEQ / 64>(p, NP + b * DEC_SEQ, CAP_S, BATCH * CAP_P + b * CAP_S, e, lane); }
        else { const int uu = u - US; const int b = uu / NEXP, e = uu % NEXP; topk_wave<SEQ / 64>(p, b * SEQ, CAP_P, b * CAP_P, e, lane); }
    }
}

DEV void store_head(bf16_t* dst_bf, float* dst_f32, const f16v& v0, const f16v& v1, int h) {
#pragma unroll
    for (int ft = 0; ft < 2; ++ft) {
        const f16v& v = ft ? v1 : v0;
#pragma unroll
        for (int g = 0; g < 4; ++g) {
            const int d0 = ft * 32 + 8 * g + 4 * h;
            u2v pk; pk[0] = pack2(v[4 * g], v[4 * g + 1]); pk[1] = pack2(v[4 * g + 2], v[4 * g + 3]);
            *(u2v*)(dst_bf + d0) = pk;
            if (dst_f32) { f4v o; o[0] = v[4 * g]; o[1] = v[4 * g + 1]; o[2] = v[4 * g + 2]; o[3] = v[4 * g + 3]; *(f4v*)(dst_f32 + d0) = o; }
        }
    }
}
template <int VAR>
DEV void phase_inproj(const Params& p, char* smem, int l) {
    constexpr int NJ = 22, NU = (NT / 256) * NJ;
    const int tid = get_tid(), lane = tid & 63, wave = tid >> 6, wm = wave & 3, wn = wave >> 2, h = lane >> 5, l31 = lane & 31;
    const bf16_t* hmod = (const bf16_t*)(p.ws + WS_HMOD);
    const float* rope = (const float*)(p.ws + WS_ROPE);
    constexpr int NMB = NT / 256, RPX = (NMB % 8 == 0) ? NMB / 8 : NMB;
    const UnitIter it = unit_iter(NU);
    for (int u = it.i; u < it.end; u += it.step) {
        const int mb = (u / (RPX * NJ)) * RPX + u % RPX, j = (u / RPX) % NJ;
        const int colbase = j < 17 ? 128 * j : 2192 + 128 * (j - 17);
        const unsigned ao = ((unsigned)(mb * 256 + (tid >> 3)) * D + (tid & 7) * 8) * 2;
        const unsigned bvo = (unsigned)(colbase + 4 * (tid & 31)) * 4 + (unsigned)(tid >> 5) * (PROJ_W * 4);
        const unsigned blds = (unsigned)(tid >> 5) * 320u + (unsigned)(tid & 31) * 8u;
        gemm_tile<2, VAR>(smem, make_rsrc(hmod), ao, ao + 128u * D, ao + 256u * D, ao + 384u * D, make_rsrc(p.in[I_WIN] + (size_t)l * D * PROJ_W), bvo, blds, PROJ_W * 4, D, [&](f16v (&acc)[2][2]) {
            const int cb = colbase + wn * 64;
#pragma unroll
            for (int tt = 0; tt < 2; ++tt) {
                const int t = mb * 256 + wm * 64 + tt * 32 + l31;
                const bool isP = t < NP;
                const int bP = t / SEQ, sP = t % SEQ;
                f16v v0 = acc[0][tt], v1 = acc[1][tt];
                if (cb < 1152) {
                    const int seg = cb / 384, head = (cb % 384) / 64;
                    bf16_t* dst = (bf16_t*)(p.ws + (seg == 0 ? WS_NAQ : seg == 1 ? WS_NAK : WS_NAV)) + (size_t)t * 384 + head * 64;
                    float* of = nullptr;
                    if (seg >= 1 && isP) of = p.out + (seg == 1 ? O_NAK : O_NAV) + ((((size_t)bP * DEPTH + l) * SEQ + sP) * NAH + head) * 64;
                    store_head(dst, of, v0, v1, h);
                } else if (cb < 2176) {
                    const int seg = (cb - 1152) / 256, head = ((cb - 1152) % 256) / 64;
                    if (seg == 1) { v0 *= ATT_SCALE; v1 *= ATT_SCALE; }
                    bf16_t* dst = (bf16_t*)(p.ws + (seg == 0 ? WS_MLQ : seg == 1 ? WS_MLK : seg == 2 ? WS_MLV : WS_MLO)) + (size_t)t * 256 + head * 64;
                    store_head(dst, nullptr, v0, v1, h);
                } else {
                    const int c2 = cb - 2192;
                    if (c2 < 512) {
                        const bool isq = c2 < 384;
                        const int head = isq ? c2 / 64 : (c2 - 384) / 64;
                        float ss = 0.f;
#pragma unroll
                        for (int r = 0; r < 16; ++r) ss += v0[r] * v0[r] + v1[r] * v1[r];
                        ss += __shfl_xor(ss, 32);
                        const float rn = 1.f / sqrtf(ss * (1.f / 64.f) + EPS);
                        const float* gq = p.in[I_QKG] + ((size_t)l * 2 + (isq ? 0 : 1)) * 64;
#pragma unroll
                        for (int r = 0; r < 16; ++r) {
                            const int d = (r & 3) + 8 * (r >> 2) + 4 * h;
                            v0[r] *= rn * gq[d]; v1[r] *= rn * gq[32 + d];
                        }
                        if (isP) {
                            if (isq) store_head((bf16_t*)(p.ws + WS_GQQ) + (size_t)t * 384 + head * 64, nullptr, v0, v1, h);
                            else store_head((bf16_t*)(p.ws + WS_GQK) + (size_t)t * 128 + head * 64, p.out + O_GQK + ((((size_t)bP * DEPTH + l) * SEQ + sP) * GQKV + head) * 64, v0, v1, h);
                        } else {
                            const int pos = (t - NP) % DEC_SEQ, prow = pos / GRIDW, pcol = pos % GRIDW;
#pragma unroll
                            for (int r = 0; r < 8; ++r) {
                                const int rr = r;
                                const int fi = (rr & 3) + 8 * ((rr >> 2) & 1) + 4 * h;
                                const float c0 = rope[(prow * 16 + fi) * 2], s0 = rope[(prow * 16 + fi) * 2 + 1];
                                const float c1 = rope[(pcol * 16 + fi) * 2], s1 = rope[(pcol * 16 + fi) * 2 + 1];
                                const float a_lo = v0[rr], a_hi = v0[rr + 8]; v0[rr] = a_lo * c0 - a_hi * s0; v0[rr + 8] = a_hi * c0 + a_lo * s0;
                                const float b_lo = v1[rr], b_hi = v1[rr + 8]; v1[rr] = b_lo * c1 - b_hi * s1; v1[rr + 8] = b_hi * c1 + b_lo * s1;
                            }
                            if (isq) store_head((bf16_t*)(p.ws + WS_GQQ) + (size_t)t * 384 + head * 64, nullptr, v0, v1, h);
                            else store_head((bf16_t*)(p.ws + WS_GQK) + (size_t)t * 128 + head * 64, nullptr, v0, v1, h);
                        }
                    } else {
                        const int head = (c2 - 512) / 64;
                        float* of = isP ? p.out + O_GQV + ((((size_t)bP * DEPTH + l) * SEQ + sP) * GQKV + head) * 64 : nullptr;
                        store_head((bf16_t*)(p.ws + WS_GQV) + (size_t)t * 128 + head * 64, of, v0, v1, h);
                    }
                }
            }
        });
    }
}

template <int VAR>
DEV void phase_outproj(const Params& p, char* smem, int l) {
    constexpr int NC = D / 128, NU = (NT / 256) * NC;
    const int tid = get_tid(), lane = tid & 63, wave = tid >> 6, wm = wave & 3, wn = wave >> 2, h = lane >> 5, l31 = lane & 31;
    const bf16_t* mixed = (const bf16_t*)(p.ws + WS_MIXED);
    const float* mods = (const float*)(p.ws + WS_MODS);
    float* U = (float*)(p.ws + WS_U);
    constexpr int NMB = NT / 256, RPX = (NMB % 8 == 0) ? NMB / 8 : NMB;
    const UnitIter it = unit_iter(NU);
    for (int u = it.i; u < it.end; u += it.step) {
        const int mb = (u / (RPX * NC)) * RPX + u % RPX, cbk = (u / RPX) % NC;
        const unsigned ao = ((unsigned)(mb * 256 + (tid >> 3)) * MIXW + (tid & 7) * 8) * 2;
        const unsigned bvo = (unsigned)(cbk * 128 + 4 * (tid & 31)) * 4 + (unsigned)(tid >> 5) * (D * 4);
        const unsigned blds = (unsigned)(tid >> 5) * 320u + (unsigned)(tid & 31) * 8u;
        gemm_tile<2, VAR>(smem, make_rsrc(mixed), ao, ao + 128u * MIXW, ao + 256u * MIXW, ao + 384u * MIXW, make_rsrc(p.in[I_WOUT] + (size_t)l * MIXW * D), bvo, blds, D * 4, MIXW, [&](f16v (&acc)[2][2]) {
#pragma unroll
            for (int tt = 0; tt < 2; ++tt) {
                const int t = mb * 256 + wm * 64 + tt * 32 + l31;
                const float* xr = (l == 0) ? (t < NP ? p.in[I_XP] + (size_t)t * D : p.in[I_XS] + (size_t)(t - NP) * D) : (const float*)(p.ws + WS_XBUF) + (size_t)t * D;
                const float* g1 = mods + ((size_t)l * NCOND + tok_cond(t)) * 6 * D + 2 * D;
#pragma unroll
                for (int ft = 0; ft < 2; ++ft)
#pragma unroll
                    for (int g = 0; g < 4; ++g) {
                        const int f0 = cbk * 128 + wn * 64 + ft * 32 + 8 * g + 4 * h;
                        const f4v xv = *(const f4v*)(xr + f0); const f4v gv = *(const f4v*)(g1 + f0);
                        f4v o;
#pragma unroll
                        for (int q = 0; q < 4; ++q) o[q] = ALPHA * xv[q] + gv[q] * acc[ft][tt][4 * g + q];
                        *(f4v*)(U + (size_t)t * D + f0) = o;
                    }
            }
        });
    }
}

template <int VAR>
DEV void phase_gateup(const Params& p, char* smem, int l) {
    constexpr int NRB = SLOTS / 256, NCB = EH / 128, NU = NEXP * NCB * NRB;
    const int tid = get_tid(), lane = tid & 63, wave = tid >> 6, wm = wave & 3, wn = wave >> 2, h = lane >> 5, l31 = lane & 31;
    const bf16_t* h2 = (const bf16_t*)(p.ws + WS_H2);
    const int* idx = (const int*)(p.ws + WS_IDX);
    bf16_t* hid = (bf16_t*)(p.ws + WS_HID);
    const UnitIter it = unit_iter(NU);
    for (int u = it.i; u < it.end; u += it.step) {
        const int rb = u % NRB, cbk = (u / NRB) % NCB, e = u / (NRB * NCB);
        const int* ip = idx + e * SLOTS + rb * 256 + (tid >> 3);
        const unsigned a0 = ((unsigned)ip[0] * D + (tid & 7) * 8) * 2, a1 = ((unsigned)ip[64] * D + (tid & 7) * 8) * 2;
        const unsigned a2 = ((unsigned)ip[128] * D + (tid & 7) * 8) * 2, a3 = ((unsigned)ip[192] * D + (tid & 7) * 8) * 2;
#ifdef EMU
        const int bw = tid >> 6;
#else
        const int bw = __builtin_amdgcn_readfirstlane(tid >> 6);
#endif
        const int is_up = bw & 1, bkr = 2 * (bw >> 1) + ((tid >> 5) & 1), hc = 4 * (tid & 31);
        const int ncol = (hc >> 6) * 128 + (2 * ((hc >> 5) & 1) + is_up) * 32 + (hc & 31);
        const unsigned bvo = (unsigned)(cbk * 128 + hc) * 4 + (unsigned)bkr * (EH * 4);
        const unsigned blds = (unsigned)bkr * 576u + (unsigned)ncol * 2u;
        const float* wmat = (is_up ? p.in[I_WU] : p.in[I_WG]) + ((size_t)l * NEXP + e) * D * EH;
        gemm_tile<4, VAR>(smem, make_rsrc(h2), a0, a1, a2, a3, make_rsrc(wmat), bvo, blds, EH * 4, D, [&](f16v (&acc)[4][2]) {
#pragma unroll
            for (int tt = 0; tt < 2; ++tt) {
                const int slot = rb * 256 + wm * 64 + tt * 32 + l31;
                bf16_t* dst = hid + ((size_t)e * SLOTS + slot) * EH + cbk * 128 + wn * 64;
#pragma unroll
                for (int pr = 0; pr < 2; ++pr)
#pragma unroll
                    for (int g = 0; g < 4; ++g) {
                        float o[4];
#pragma unroll
                        for (int q = 0; q < 4; ++q) o[q] = siluf_(acc[2 * pr][tt][4 * g + q]) * acc[2 * pr + 1][tt][4 * g + q];
                        u2v pk; pk[0] = pack2(o[0], o[1]); pk[1] = pack2(o[2], o[3]);
                        *(u2v*)(dst + pr * 32 + 8 * g + 4 * h) = pk;
                    }
            }
        });
    }
}

template <int VAR>
DEV void phase_down(const Params& p, char* smem, int l) {
    constexpr int NRB = SLOTS / 256, NCB = D / 256, NU = NEXP * NCB * NRB;
    const int tid = get_tid(), lane = tid & 63, wave = tid >> 6, wm = wave & 3, wn = wave >> 2, h = lane >> 5, l31 = lane & 31;
    const bf16_t* hid = (const bf16_t*)(p.ws + WS_HID);
    const float* gsel = (const float*)(p.ws + WS_GSEL);
    float* ye = (float*)(p.ws + WS_YE);
    const UnitIter it = unit_iter(NU);
    for (int u = it.i; u < it.end; u += it.step) {
        const int rb = u % NRB, cbk = (u / NRB) % NCB, e = u / (NRB * NCB);
        const unsigned ao = ((unsigned)(rb * 256 + (tid >> 3)) * EH + (tid & 7) * 8) * 2;
        const unsigned bvo = (unsigned)(cbk * 256 + 4 * (tid & 63)) * 4 + (unsigned)(tid >> 6) * (D * 4);
        const unsigned blds = (unsigned)(tid >> 6) * 576u + (unsigned)(tid & 63) * 8u;
        gemm_tile<4, VAR>(smem, make_rsrc(hid + (size_t)e * SLOTS * EH), ao, ao + 128u * EH, ao + 256u * EH, ao + 384u * EH, make_rsrc(p.in[I_WD] + ((size_t)l * NEXP + e) * EH * D), bvo, blds, D * 4, EH, [&](f16v (&acc)[4][2]) {
#pragma unroll
            for (int tt = 0; tt < 2; ++tt) {
                const int slot = rb * 256 + wm * 64 + tt * 32 + l31;
                const float gs = gsel[e * SLOTS + slot];
                float* dst = ye + ((size_t)e * SLOTS + slot) * D + cbk * 256 + wn * 128;
#pragma unroll
                for (int ft = 0; ft < 4; ++ft)
#pragma unroll
                    for (int g = 0; g < 4; ++g) {
                        f4v o;
#pragma unroll
                        for (int q = 0; q < 4; ++q) o[q] = acc[ft][tt][4 * g + q] * gs;
                        *(f4v*)(dst + ft * 32 + 8 * g + 4 * h) = o;
                    }
            }
        });
    }
}

struct AttnDesc {
    const bf16_t* q; int qstride;
    int ntiles, n0;
    const bf16_t *k0, *v0; int stride0;
    const bf16_t *k1, *v1; int stride1;
    int na;
    int r0, rlo;
    const float* rpb;
    bf16_t* out; int ostride;
    float* part;
};
constexpr int ATT_TILE = 64 * LROW;
DEV int na_row_start(int r) { int s = r - KR / 2; s = s < 0 ? 0 : s; return s > ROWS - KR ? ROWS - KR : s; }
DEV void attn_unit(char* smem, const AttnDesc& d) {
    const int tid = get_tid(), lane = tid & 63, wave = tid >> 6, h = lane >> 5, l31 = lane & 31;
    char* Ks = smem; char* Vs = smem + 2 * ATT_TILE; float* rpbS = (float*)(smem + 4 * ATT_TILE);
    if (d.na) { for (int i = tid; i < 15 * 31; i += 512) rpbS[i] = d.rpb[i]; }
    const bf16_t* qp = d.q + (size_t)(wave * 32 + l31) * d.qstride + h * 8;
    s8v qf[4];
#pragma unroll
    for (int s = 0; s < 4; ++s) qf[s] = *(const s8v*)(qp + 16 * s);
    float m_run = -1e30f, l_run = 0.f;
    f16v o[2]; o[0] = f16zero(); o[1] = f16zero();
    const int srow = tid >> 3, sch = tid & 7;
    u4v kreg, vreg;
    auto gload = [&](int t) {
        const bf16_t *kp, *vp;
        if (t < d.n0) { const size_t off = (size_t)(t * 64 + srow) * d.stride0 + sch * 8; kp = d.k0 + off; vp = d.v0 + off; }
        else { const size_t off = (size_t)((t - d.n0) * 64 + srow) * d.stride1 + sch * 8; kp = d.k1 + off; vp = d.v1 + off; }
        kreg = *(const u4v*)kp; vreg = *(const u4v*)vp;
    };
    auto lstore = [&](int buf) { *(u4v*)(Ks + buf * ATT_TILE + srow * LROW + sch * 16) = kreg; *(u4v*)(Vs + buf * ATT_TILE + srow * LROW + sch * 16) = vreg; };
    const int qr = d.r0 + (wave >> 1), qw = (wave & 1) * 32 + l31;
    const int rs = na_row_start(qr);
    int cs = qw - KC / 2; cs = cs < 0 ? 0 : (cs > GRIDW - KC ? GRIDW - KC : cs);
    gload(0); lstore(0);
    __syncthreads();
    for (int t = 0; t < d.ntiles; ++t) {
        const int buf = t & 1;
        if (t + 1 < d.ntiles) gload(t + 1);
        const bool local = d.na && t >= d.n0;
        const int kr = d.rlo + (t - d.n0);
        const bool active = !local || (kr >= rs && kr < rs + KR);
        if (active) {
            const char* kb = Ks + buf * ATT_TILE + l31 * LROW + h * 16;
            f16v sa[2];
#pragma unroll
            for (int kt = 0; kt < 2; ++kt) {
                sa[kt] = f16zero();
#pragma unroll
                for (int s = 0; s < 4; ++s) { const s8v kf = *(const s8v*)(kb + kt * 32 * LROW + s * 32); sa[kt] = mfma32(kf, qf[s], sa[kt]); }
            }
            float mx = -1e30f;
#pragma unroll
            for (int kt = 0; kt < 2; ++kt)
#pragma unroll
                for (int r = 0; r < 16; ++r) {
                    float v = sa[kt][r] * ATT_SCALE;
                    if (local) {
                        const int kc = kt * 32 + (r & 3) + 8 * (r >> 2) + 4 * h;
                        const bool inw = kc >= cs && kc < cs + KC;
                        const int bi = (kr - qr + 7) * 31 + (kc - qw + 15);
                        v = inw ? v + rpbS[inw ? bi : 0] : -1e30f;
                    }
                    sa[kt][r] = v; mx = fmaxf(mx, v);
                }
            mx = fmaxf(mx, __shfl_xor(mx, 32));
            const float m_new = fmaxf(m_run, mx);
            const float alpha = fexp(m_run - m_new);
            float ps = 0.f;
#pragma unroll
            for (int kt = 0; kt < 2; ++kt)
#pragma unroll
                for (int r = 0; r < 16; ++r) { const float pv = fexp(sa[kt][r] - m_new); sa[kt][r] = pv; ps += pv; }
            l_run = l_run * alpha + ps; m_run = m_new;
            o[0] *= alpha; o[1] *= alpha;
            const char* vb = Vs + buf * ATT_TILE + (4 * h + ((lane & 15) >> 2)) * LROW + (((lane >> 4) & 1) * 16 + 4 * (lane & 3)) * 2;
#pragma unroll
            for (int ks = 0; ks < 4; ++ks) {
                const int kt = ks >> 1, rb = 8 * (ks & 1);
                u4v pk; pk[0] = pack2(sa[kt][rb], sa[kt][rb + 1]); pk[1] = pack2(sa[kt][rb + 2], sa[kt][rb + 3]);
                pk[2] = pack2(sa[kt][rb + 4], sa[kt][rb + 5]); pk[3] = pack2(sa[kt][rb + 6], sa[kt][rb + 7]);
                const s8v pf = __builtin_bit_cast(s8v, pk);
                const char* vk = vb + (kt * 32 + 16 * (ks & 1)) * LROW;
#pragma unroll
                for (int dt = 0; dt < 2; ++dt) {
                    const s4v lo = lds_tr16(vk + dt * 64), hi = lds_tr16(vk + 8 * LROW + dt * 64);
                    s8v vf; vf[0] = lo[0]; vf[1] = lo[1]; vf[2] = lo[2]; vf[3] = lo[3]; vf[4] = hi[0]; vf[5] = hi[1]; vf[6] = hi[2]; vf[7] = hi[3];
                    o[dt] = mfma32(vf, pf, o[dt]);
                }
            }
        }
        if (t + 1 < d.ntiles) lstore(buf ^ 1);
        __syncthreads();
    }
    const float l_tot = l_run + __shfl_xor(l_run, 32);
    const int qrow = wave * 32 + l31;
    if (d.part) {
        float* po = d.part + (size_t)qrow * 64;
#pragma unroll
        for (int dt = 0; dt < 2; ++dt)
#pragma unroll
            for (int g = 0; g < 4; ++g) { f4v v; v[0] = o[dt][4 * g]; v[1] = o[dt][4 * g + 1]; v[2] = o[dt][4 * g + 2]; v[3] = o[dt][4 * g + 3]; *(f4v*)(po + dt * 32 + 8 * g + 4 * h) = v; }
        if (h == 0) { d.part[256 * 64 + qrow] = m_run; d.part[256 * 64 + 256 + qrow] = l_tot; }
    } else {
        const float inv = 1.f / l_tot;
        bf16_t* po = d.out + (size_t)qrow * d.ostride;
#pragma unroll
        for (int dt = 0; dt < 2; ++dt)
#pragma unroll
            for (int g = 0; g < 4; ++g) {
                u2v pk; pk[0] = pack2(o[dt][4 * g] * inv, o[dt][4 * g + 1] * inv); pk[1] = pack2(o[dt][4 * g + 2] * inv, o[dt][4 * g + 3] * inv);
                *(u2v*)(po + dt * 32 + 8 * g + 4 * h) = pk;
            }
    }
}

DEV int ml_sidx(int grp, int b, int head, int c) { return grp == 0 ? ((b * MLH + head) * NCH_P + c) : BATCH * MLH * NCH_P + ((b * MLH + head) * NCH_S + c); }
DEV float lane_prefix_sum(float v, int lane) { for (int dlt = 1; dlt < 64; dlt <<= 1) { const float o = __shfl(v, lane - dlt); if (lane >= dlt) v += o; } return v; }
DEV float lane_prefix_max(float v, int lane) { for (int dlt = 1; dlt < 64; dlt <<= 1) { const float o = __shfl(v, lane - dlt); if (lane >= dlt) v = fmaxf(v, o); } return v; }

DEV void mlstm_summary_unit(const Params& p, char* smem, int grp, int b, int head, int c) {
    const int tid = get_tid(), lane = tid & 63, wave = tid >> 6, h = lane >> 5, l31 = lane & 31;
    char* KT = smem;
    char* VT = smem + 2 * ATT_TILE;
    float* wsS = (float*)(smem + 3 * ATT_TILE);
    float* scal = wsS + 128;
    const int tb = (grp == 0 ? b * SEQ : NP + b * DEC_SEQ) + c * 64;
    const float* gates = (const float*)(p.ws + WS_GATES);
    if (wave == 0) {
        const float* gr = gates + (size_t)(tb + lane) * 16;
        const float i_f = gr[head], lf_f = logsigmoidf_(gr[4 + head]), i_b = gr[8 + head], lf_b = logsigmoidf_(gr[12 + head]);
        const float pf = lane_prefix_sum(lf_f, lane), pb = lane_prefix_sum(lf_b, lane);
        const float tot_f = __shfl(pf, 63), tot_b = __shfl(pb, 63);
        const float g_f = (tot_f - pf) + i_f, g_b = (pb - lf_b) + i_b;
        const float G_f = wave_max(g_f), G_b = wave_max(g_b);
        wsS[lane] = expf(g_f - G_f); wsS[64 + lane] = expf(g_b - G_b);
        if (lane == 0) { scal[0] = tot_f; scal[1] = tot_b; scal[2] = G_f; scal[3] = G_b; }
    }
    __syncthreads();
    {
        const int tau = tid >> 3, ch = tid & 7;
        const u4v kv = *(const u4v*)((const bf16_t*)(p.ws + WS_MLK) + (size_t)(tb + tau) * 256 + head * 64 + ch * 8);
        const u4v vv = *(const u4v*)((const bf16_t*)(p.ws + WS_MLV) + (size_t)(tb + tau) * 256 + head * 64 + ch * 8);
        const float wf = wsS[tau], wb = wsS[64 + tau];
#pragma unroll
        for (int j = 0; j < 8; ++j) {
            const bf16_t kb = (bf16_t)(kv[j >> 1] >> (16 * (j & 1))), vb = (bf16_t)(vv[j >> 1] >> (16 * (j & 1)));
            const int dim = ch * 8 + j; const float kf = bf2f(kb);
            *(bf16_t*)(KT + dim * LROW + tau * 2) = f2bf(kf * wf);
            *(bf16_t*)(KT + ATT_TILE + dim * LROW + tau * 2) = f2bf(kf * wb);
            *(bf16_t*)(VT + dim * LROW + tau * 2) = vb;
        }
    }
    __syncthreads();
    float* sum = (float*)(p.ws + WS_MLSUM);
    const int sidx = ml_sidx(grp, b, head, c);
    {
        const int dir = wave >> 2, mi = (wave >> 1) & 1, ni = wave & 1;
        f16v acc = f16zero();
#pragma unroll
        for (int s = 0; s < 4; ++s) {
            const s8v af = *(const s8v*)(KT + dir * ATT_TILE + (mi * 32 + l31) * LROW + (16 * s + 8 * h) * 2);
            const s8v bf = *(const s8v*)(VT + (ni * 32 + l31) * LROW + (16 * s + 8 * h) * 2);
            acc = mfma32(af, bf, acc);
        }
        float* U = sum + (size_t)(sidx * 2 + dir) * MLSUM_STRIDE;
#pragma unroll
        for (int r = 0; r < 16; ++r) U[(mi * 32 + (r & 3) + 8 * (r >> 2) + 4 * h) * 64 + ni * 32 + l31] = acc[r];
    }
    if (tid < 128) {
        const int dir = tid >> 6, kd = tid & 63;
        float s = 0.f;
        for (int tau = 0; tau < 64; ++tau) s += bf2f(*(const bf16_t*)(KT + dir * ATT_TILE + kd * LROW + tau * 2));
        float* E = sum + (size_t)(sidx * 2 + dir) * MLSUM_STRIDE;
        E[4096 + kd] = s;
        if (kd == 0) { E[4160] = scal[dir]; E[4161] = scal[2 + dir]; }
    }
    __syncthreads();
}

DEV void mlstm_output_unit(const Params& p, char* smem, int l, int grp, int b, int head, int c) {
    const int tid = get_tid(), lane = tid & 63, wave = tid >> 6, h = lane >> 5, l31 = lane & 31;
    const int nc = grp ? NCH_S : NCH_P;
    char* Qs = smem;
    char* Ks = smem + 2 * ATT_TILE;
    char* VT = smem + 4 * ATT_TILE;
    char* CT = smem + 6 * ATT_TILE;
    char* QK = smem + 8 * ATT_TILE;
    float* hS = (float*)(smem + 10 * ATT_TILE);
    float* vec = hS + 2 * 64 * 68;
    float* aS = vec; float* MjS = vec + 128; float* bS = vec + 256; float* nS = vec + 384; float* denp = vec + 512; float* qnS = vec + 768; float* scal = vec + 896;
    const int tb = (grp == 0 ? b * SEQ : NP + b * DEC_SEQ) + c * 64;
    const float* sum = (const float*)(p.ws + WS_MLSUM);
#pragma unroll
    for (int dir = 0; dir < 2; ++dir) {
        float C[8], nst = 0.f, m;
        if (grp == 0) {
#pragma unroll
            for (int i = 0; i < 8; ++i) C[i] = 0.f;
            m = 0.f;
        } else {
            const size_t sb = (((size_t)b * DEPTH + l) * 2 + dir) * MLH + head;
#pragma unroll
            for (int i = 0; i < 8; ++i) C[i] = p.in[I_SC][sb * 4096 + tid + 512 * i];
            if (tid < 64) nst = p.in[I_SN][sb * 64 + tid];
            m = p.in[I_SM][sb];
        }
        const int nsteps = dir == 0 ? c : nc - 1 - c;
        const bool fin = (grp == 0) && (dir == 0 ? c == nc - 1 : c == 0);
        for (int st = 0; st < nsteps + (fin ? 1 : 0); ++st) {
            const int cc = dir == 0 ? st : nc - 1 - st;
            const float* E = sum + (size_t)(ml_sidx(grp, b, head, cc) * 2 + dir) * MLSUM_STRIDE;
            if (st == nsteps) {
#pragma unroll
                for (int i = 0; i < 8; ++i) { const int e = tid + 512 * i; *(bf16_t*)(CT + dir * ATT_TILE + (e & 63) * LROW + (e >> 6) * 2) = f2bf(C[i]); }
                if (tid < 64) nS[dir * 64 + tid] = nst;
                if (tid == 0) scal[dir] = m;
            }
            const float A = E[4160], G = E[4161];
            const float m_new = fmaxf(A + m, G);
            const float sc = expf(A + m - m_new), su = expf(G - m_new);
#pragma unroll
            for (int i = 0; i < 8; ++i) C[i] = sc * C[i] + su * E[tid + 512 * i];
            if (tid < 64) nst = sc * nst + su * E[4096 + tid];
            m = m_new;
        }
        if (!fin) {
#pragma unroll
            for (int i = 0; i < 8; ++i) { const int e = tid + 512 * i; *(bf16_t*)(CT + dir * ATT_TILE + (e & 63) * LROW + (e >> 6) * 2) = f2bf(C[i]); }
            if (tid < 64) nS[dir * 64 + tid] = nst;
            if (tid == 0) scal[dir] = m;
        } else {
            const size_t ob = (((size_t)b * DEPTH + l) * 2 + dir) * MLH + head;
#pragma unroll
            for (int i = 0; i < 8; ++i) p.out[O_MC + ob * 4096 + tid + 512 * i] = C[i];
            if (tid < 64) p.out[O_MN + ob * 64 + tid] = nst;
            if (tid == 0) p.out[O_MM + ob] = m;
        }
    }
    {
        const int row = tid >> 3, ch = tid & 7;
#pragma unroll
        for (int dir = 0; dir < 2; ++dir) {
            const int tok = tb + (dir ? 63 - row : row);
            const size_t off = (size_t)tok * 256 + head * 64 + ch * 8;
            *(u4v*)(Qs + dir * ATT_TILE + row * LROW + ch * 16) = *(const u4v*)((const bf16_t*)(p.ws + WS_MLQ) + off);
            *(u4v*)(Ks + dir * ATT_TILE + row * LROW + ch * 16) = *(const u4v*)((const bf16_t*)(p.ws + WS_MLK) + off);
            const u4v vv = *(const u4v*)((const bf16_t*)(p.ws + WS_MLV) + off);
#pragma unroll
            for (int j = 0; j < 8; ++j) *(bf16_t*)(VT + dir * ATT_TILE + (ch * 8 + j) * LROW + row * 2) = (bf16_t)(vv[j >> 1] >> (16 * (j & 1)));
        }
    }
    __syncthreads();
    if (wave < 2) {
        const int dir = wave;
        const float* gr = (const float*)(p.ws + WS_GATES) + (size_t)(tb + (dir ? 63 - lane : lane)) * 16;
        const float ig = gr[dir * 8 + head], lf = logsigmoidf_(gr[dir * 8 + 4 + head]);
        const float bj = lane_prefix_sum(lf, lane);
        const float a = ig - bj;
        const float Pj = lane_prefix_max(a, lane);
        aS[dir * 64 + lane] = a; bS[dir * 64 + lane] = bj; MjS[dir * 64 + lane] = fmaxf(scal[dir], Pj);
    } else if (wave < 4) {
        const int dir = wave - 2;
        float s = 0.f;
        for (int k = 0; k < 64; ++k) s += bf2f(*(const bf16_t*)(Qs + dir * ATT_TILE + lane * LROW + k * 2)) * nS[dir * 64 + k];
        qnS[dir * 64 + lane] = s;
    }
    __syncthreads();
    const int dir = wave >> 2, rt = (wave >> 1) & 1, jt = wave & 1;
    const int j = jt * 32 + l31;
    const float Mj = MjS[dir * 64 + j];
    {
        f16v acc = f16zero();
#pragma unroll
        for (int s4 = 0; s4 < 4; ++s4) {
            const s8v af = *(const s8v*)(Ks + dir * ATT_TILE + (rt * 32 + l31) * LROW + (16 * s4 + 8 * h) * 2);
            const s8v bf = *(const s8v*)(Qs + dir * ATT_TILE + j * LROW + (16 * s4 + 8 * h) * 2);
            acc = mfma32(af, bf, acc);
        }
        float dsum = 0.f;
#pragma unroll
        for (int g = 0; g < 4; ++g) {
            float o[4];
#pragma unroll
            for (int q = 0; q < 4; ++q) {
                const int s = rt * 32 + 8 * g + 4 * h + q;
                const float w = s <= j ? expf(aS[dir * 64 + s] - Mj) : 0.f;
                o[q] = acc[4 * g + q] * w; dsum += o[q];
            }
            u2v pk; pk[0] = pack2(o[0], o[1]); pk[1] = pack2(o[2], o[3]);
            *(u2v*)(QK + dir * ATT_TILE + j * LROW + (rt * 32 + 8 * g + 4 * h) * 2) = pk;
        }
        dsum += __shfl_xor(dsum, 32);
        if (h == 0) denp[(dir * 2 + rt) * 64 + j] = dsum;
    }
    __syncthreads();
    {
        const float mst = scal[dir];
        const float decay = expf(mst - Mj);
        f16v acc = f16zero();
#pragma unroll
        for (int s4 = 0; s4 < 4; ++s4) {
            const s8v af = *(const s8v*)(CT + dir * ATT_TILE + (rt * 32 + l31) * LROW + (16 * s4 + 8 * h) * 2);
            const s8v bf = *(const s8v*)(Qs + dir * ATT_TILE + j * LROW + (16 * s4 + 8 * h) * 2);
            acc = mfma32(af, bf, acc);
        }
        acc *= decay;
#pragma unroll
        for (int s4 = 0; s4 < 4; ++s4) {
            const s8v af = *(const s8v*)(VT + dir * ATT_TILE + (rt * 32 + l31) * LROW + (16 * s4 + 8 * h) * 2);
            const s8v bf = *(const s8v*)(QK + dir * ATT_TILE + j * LROW + (16 * s4 + 8 * h) * 2);
            acc = mfma32(af, bf, acc);
        }
        const float den = decay * qnS[dir * 64 + j] + denp[(dir * 2) * 64 + j] + denp[(dir * 2 + 1) * 64 + j];
        const float dn = fmaxf(fabsf(den), expf(-(bS[dir * 64 + j] + Mj)));
        const float inv = 1.f / dn;
#pragma unroll
        for (int g = 0; g < 4; ++g) { f4v o; o[0] = acc[4 * g] * inv; o[1] = acc[4 * g + 1] * inv; o[2] = acc[4 * g + 2] * inv; o[3] = acc[4 * g + 3] * inv;
            *(f4v*)(hS + (dir * 64 + j) * 68 + rt * 32 + 8 * g + 4 * h) = o; }
    }
    __syncthreads();
    {
        const int tau = tid >> 3, v8 = (tid & 7) * 8;
        float hv[8]; float s = 0.f;
#pragma unroll
        for (int q = 0; q < 8; ++q) { hv[q] = hS[tau * 68 + v8 + q] + hS[(64 + 63 - tau) * 68 + v8 + q]; s += hv[q]; }
        s += __shfl_xor(s, 1); s += __shfl_xor(s, 2); s += __shfl_xor(s, 4);
        const float mu = s * (1.f / 64.f);
        float qq = 0.f;
#pragma unroll
        for (int q = 0; q < 8; ++q) { const float dlt = hv[q] - mu; qq += dlt * dlt; }
        qq += __shfl_xor(qq, 1); qq += __shfl_xor(qq, 2); qq += __shfl_xor(qq, 4);
        const float rstd = 1.f / sqrtf(qq * (1.f / 64.f) + EPS);
        const int t = tb + tau;
        const u4v ov = *(const u4v*)((const bf16_t*)(p.ws + WS_MLO) + (size_t)t * 256 + head * 64 + v8);
        const float* ng = p.in[I_MLG] + (size_t)l * 256 + head * 64 + v8;
        float o[8];
#pragma unroll
        for (int q = 0; q < 8; ++q) { const float og = bf2f((bf16_t)(ov[q >> 1] >> (16 * (q & 1)))); o[q] = (hv[q] - mu) * rstd * ng[q] * sigmoidf_(og); }
        u4v pk; pk[0] = pack2(o[0], o[1]); pk[1] = pack2(o[2], o[3]); pk[2] = pack2(o[4], o[5]); pk[3] = pack2(o[6], o[7]);
        *(u4v*)((bf16_t*)(p.ws + WS_MIXED) + (size_t)t * MIXW + 384 + head * 64 + v8) = pk;
    }
    __syncthreads();
}

DEV int queue_next(const Params& p, char* smem, int qi) {
    int* slot = (int*)(smem + SMEM_XB + 32);
    __syncthreads();
    if (threadIdx.x == 0) {
#ifdef EMU
        unsigned* w = (unsigned*)(p.ws + WS_BAR) + QUEUE_WORD0 + 64 * qi; *slot = (int)(*w)++;
#else
        *slot = (int)__hip_atomic_fetch_add((unsigned*)(p.ws + WS_BAR) + QUEUE_WORD0 + 64 * qi, 1u, __ATOMIC_RELAXED, __HIP_MEMORY_SCOPE_AGENT);
#endif
    }
    __syncthreads();
    return *slot;
}
DEV void phase_attn(const Params& p, char* smem, int l, int qi) {
    constexpr int QB_S = DEC_SEQ / 256, QB_P = SEQ / 256;
    constexpr int U_SG = DEC_BATCH * GQH * QB_S * 2, U_SN = DEC_BATCH * NAH * QB_S, U_PN = BATCH * NAH * QB_P, U_PG = BATCH * GQH * QB_P;
    constexpr int U_MP = BATCH * MLH * NCH_P, U_MS = DEC_BATCH * MLH * NCH_S;
    constexpr int NU = U_SG + U_SN + U_PN + U_PG + U_MP + U_MS;
    const bf16_t* naq = (const bf16_t*)(p.ws + WS_NAQ); const bf16_t* nak = (const bf16_t*)(p.ws + WS_NAK); const bf16_t* nav = (const bf16_t*)(p.ws + WS_NAV);
    const bf16_t* gqq = (const bf16_t*)(p.ws + WS_GQQ); const bf16_t* gqk = (const bf16_t*)(p.ws + WS_GQK); const bf16_t* gqv = (const bf16_t*)(p.ws + WS_GQV);
    bf16_t* mixed = (bf16_t*)(p.ws + WS_MIXED);
    for (;;) {
        int u = queue_next(p, smem, qi);
        if (u >= NU) break;
        AttnDesc d; d.na = 0; d.r0 = 0; d.rlo = 0; d.rpb = nullptr; d.part = nullptr; d.out = nullptr; d.ostride = MIXW; d.n0 = 0; d.k0 = d.v0 = nullptr; d.stride0 = 0;
        if (u < U_SG) {
            const int half = u & 1, qb = (u >> 1) % QB_S, qh = (u / (2 * QB_S)) % GQH, b = u / (2 * QB_S * GQH);
            const int kvh = qh / (GQH / GQKV);
            constexpr int NCT = PAST / 64, TT = NCT + DEC_SEQ / 64, H0 = TT / 2;
            const size_t tq = (size_t)NP + (size_t)b * DEC_SEQ + qb * 256;
            d.q = gqq + tq * 384 + qh * 64; d.qstride = 384;
            const bf16_t* lk = gqk + ((size_t)NP + (size_t)b * DEC_SEQ) * 128 + kvh * 64; const bf16_t* lv = gqv + ((size_t)NP + (size_t)b * DEC_SEQ) * 128 + kvh * 64;
            if (half == 0) {
                d.n0 = NCT; d.ntiles = H0; d.stride0 = 128;
                const size_t co = (((size_t)b * DEPTH + l) * PAST) * 128 + kvh * 64;
                d.k0 = (const bf16_t*)(p.ws + WS_CGQK) + co; d.v0 = (const bf16_t*)(p.ws + WS_CGQV) + co;
                d.k1 = lk; d.v1 = lv; d.stride1 = 128;
            } else {
                d.n0 = 0; d.ntiles = TT - H0; d.stride1 = 128;
                d.k1 = lk + (size_t)(H0 - NCT) * 64 * 128; d.v1 = lv + (size_t)(H0 - NCT) * 64 * 128;
            }
            d.part = (float*)(p.ws + WS_PART) + (size_t)u * PART_STRIDE;
            attn_unit(smem, d);
        } else if (u < U_SG + U_SN) {
            const int uu = u - U_SG; const int qb = uu % QB_S, hd = (uu / QB_S) % NAH, b = uu / (QB_S * NAH);
            const size_t t0 = (size_t)NP + (size_t)b * DEC_SEQ;
            d.q = naq + (t0 + qb * 256) * 384 + hd * 64; d.qstride = 384;
            d.na = 1; d.r0 = qb * 4; d.rlo = na_row_start(d.r0);
            const int rhi = na_row_start(d.r0 + 3) + KR;
            d.n0 = PAST / 64; d.ntiles = d.n0 + (rhi - d.rlo); d.stride0 = 384; d.stride1 = 384;
            const size_t co = (((size_t)b * DEPTH + l) * PAST) * 384 + hd * 64;
            d.k0 = (const bf16_t*)(p.ws + WS_CNAK) + co; d.v0 = (const bf16_t*)(p.ws + WS_CNAV) + co;
            d.k1 = nak + (t0 + (size_t)d.rlo * 64) * 384 + hd * 64; d.v1 = nav + (t0 + (size_t)d.rlo * 64) * 384 + hd * 64;
            d.rpb = p.in[I_RPB] + ((size_t)l * NAH + hd) * 15 * 31;
            d.out = mixed + (t0 + qb * 256) * MIXW + hd * 64;
            attn_unit(smem, d);
        } else if (u < U_SG + U_SN + U_PN) {
            const int uu = u - U_SG - U_SN; const int qb = uu % QB_P, hd = (uu / QB_P) % NAH, b = uu / (QB_P * NAH);
            const size_t t0 = (size_t)b * SEQ;
            d.q = naq + (t0 + qb * 256) * 384 + hd * 64; d.qstride = 384;
            d.n0 = 0; d.ntiles = SEQ / 64; d.stride1 = 384; d.k1 = nak + t0 * 384 + hd * 64; d.v1 = nav + t0 * 384 + hd * 64;
            d.out = mixed + (t0 + qb * 256) * MIXW + hd * 64;
            attn_unit(smem, d);
        } else if (u < U_SG + U_SN + U_PN + U_PG) {
            const int uu = u - U_SG - U_SN - U_PN; const int qb = uu % QB_P, qh = (uu / QB_P) % GQH, b = uu / (QB_P * GQH);
            const int kvh = qh / (GQH / GQKV);
            const size_t t0 = (size_t)b * SEQ;
            d.q = gqq + (t0 + qb * 256) * 384 + qh * 64; d.qstride = 384;
            d.n0 = 0; d.ntiles = SEQ / 64; d.stride1 = 128; d.k1 = gqk + t0 * 128 + kvh * 64; d.v1 = gqv + t0 * 128 + kvh * 64;
            d.out = mixed + (t0 + qb * 256) * MIXW + 640 + qh * 64;
            attn_unit(smem, d);
        } else if (u < U_SG + U_SN + U_PN + U_PG + U_MP) {
            const int uu = u - (U_SG + U_SN + U_PN + U_PG); const int c = uu % NCH_P, hd = (uu / NCH_P) % MLH, b = uu / (NCH_P * MLH);
            mlstm_summary_unit(p, smem, 0, b, hd, c);
        } else {
            const int uu = u - (U_SG + U_SN + U_PN + U_PG + U_MP); const int c = uu % NCH_S, hd = (uu / NCH_S) % MLH, b = uu / (NCH_S * MLH);
            mlstm_summary_unit(p, smem, 1, b, hd, c);
        }
    }
}

DEV void phase_mlout(const Params& p, char* smem, int l) {
    constexpr int QB_S = DEC_SEQ / 256;
    constexpr int U_MS = DEC_BATCH * MLH * NCH_S, U_MP = BATCH * MLH * NCH_P, U_CB = DEC_BATCH * GQH * QB_S;
    const int tid = get_tid();
    for (int u = blockIdx.x; u < U_MS + U_MP + U_CB; u += gridDim.x) {
        if (u < U_MS) { const int c = u % NCH_S, hd = (u / NCH_S) % MLH, b = u / (NCH_S * MLH); mlstm_output_unit(p, smem, l, 1, b, hd, c); }
        else if (u < U_MS + U_MP) { const int uu = u - U_MS; const int c = uu % NCH_P, hd = (uu / NCH_P) % MLH, b = uu / (NCH_P * MLH); mlstm_output_unit(p, smem, l, 0, b, hd, c); }
        else {
            const int uu = u - U_MS - U_MP; const int qb = uu % QB_S, qh = (uu / QB_S) % GQH, b = uu / (QB_S * GQH);
            const float* p0 = (const float*)(p.ws + WS_PART) + (size_t)(2 * uu) * PART_STRIDE; const float* p1 = p0 + PART_STRIDE;
            const int q = tid >> 1, d0 = (tid & 1) * 32;
            const float m0 = p0[256 * 64 + q], m1 = p1[256 * 64 + q], l0 = p0[256 * 64 + 256 + q], l1 = p1[256 * 64 + 256 + q];
            const float m = fmaxf(m0, m1), w0 = expf(m0 - m), w1 = expf(m1 - m);
            const float inv = 1.f / (l0 * w0 + l1 * w1);
            bf16_t* dst = (bf16_t*)(p.ws + WS_MIXED) + ((size_t)NP + (size_t)b * DEC_SEQ + qb * 256 + q) * MIXW + 640 + qh * 64 + d0;
#pragma unroll
            for (int i = 0; i < 8; ++i) {
                const f4v a = *(const f4v*)(p0 + (size_t)q * 64 + d0 + 4 * i), bb = *(const f4v*)(p1 + (size_t)q * 64 + d0 + 4 * i);
                u2v pk; pk[0] = pack2((a[0] * w0 + bb[0] * w1) * inv, (a[1] * w0 + bb[1] * w1) * inv); pk[1] = pack2((a[2] * w0 + bb[2] * w1) * inv, (a[3] * w0 + bb[3] * w1) * inv);
                *(u2v*)(dst + 4 * i) = pk;
            }
        }
    }
}

constexpr int N_PHASES = 2 + 9 * DEPTH;
#ifndef EMU
typedef const __attribute__((address_space(4))) Params* KParamsPtr;
DEV void load_params(Params& p) {
    KParamsPtr kp = (KParamsPtr)__builtin_amdgcn_kernarg_segment_ptr();
    asm volatile("" : "+s"(kp));
#pragma unroll
    for (int i = 0; i < N_IN; ++i) p.in[i] = kp->in[i];
    p.out = kp->out; p.ws = kp->ws; p.ph0 = kp->ph0; p.ph1 = kp->ph1;
}
#endif
#ifdef EMU
static char emu_smem[SMEM_BYTES + 64];
#endif
__global__ void __launch_bounds__(512, 2) mega_kernel(Params p_) {
    const int ph0 = p_.ph0, ph1 = p_.ph1;
#ifdef EMU
    char* smem = emu_smem;
#define GRID_SYNC() do {} while (0)
#else
    extern __shared__ __attribute__((aligned(16))) char smem[];
    if (threadIdx.x == 0) *(u4v*)(smem + SMEM_XB) = (u4v){0u, 0u, 0u, 0u};
    __syncthreads();
    XcdBarrier xb = xcd_barrier_post((unsigned*)(p_.ws + WS_BAR), (volatile LAS unsigned*)(smem + SMEM_XB));
    const bool multi = (ph1 - ph0) > 1;
#define GRID_SYNC() do { if (multi) xcd_barrier(xb); } while (0)
#endif
    int ph = 0;
#ifndef KIND_MASK
#define KIND_MASK 0x3ff
#endif
#ifdef EMU
#define LOAD_PARAMS() const Params& p = p_
#else
#define LOAD_PARAMS() Params p; load_params(p)
#endif
#ifndef DOUBLE_MASK
#define DOUBLE_MASK 0
#endif
#define PH_KIND() (ph == 0 ? 0 : ph == 1 + 9 * DEPTH ? 1 : 1 + (ph - 1) % 9)
#define RUN_PHASE(body) do { if (((KIND_MASK >> PH_KIND()) & 1) && ph >= ph0 && ph < ph1) { \
    if (DOUBLE_MASK && ((DOUBLE_MASK >> PH_KIND()) & 1)) { { const int rep_ = 1; LOAD_PARAMS(); body; } GRID_SYNC(); } \
    { const int rep_ = 0; LOAD_PARAMS(); body; } if (ph + 1 < ph1) GRID_SYNC(); } ++ph; } while (0)
    RUN_PHASE(phase_ada(p, smem));
    for (int l = 0; l < DEPTH; ++l) {
        RUN_PHASE(phase_rows<0>(p, smem, l));
        RUN_PHASE(phase_inproj<0>(p, smem, l));
        RUN_PHASE(phase_attn(p, smem, l, l + DEPTH * rep_));
        RUN_PHASE(phase_mlout(p, smem, l));
        RUN_PHASE(phase_outproj<0>(p, smem, l));
        RUN_PHASE(phase_rows<1>(p, smem, l));
        RUN_PHASE(phase_topk(p, smem));
        RUN_PHASE(phase_gateup<0>(p, smem, l));
        RUN_PHASE(phase_down<0>(p, smem, l));
    }
    RUN_PHASE(phase_rows<0>(p, smem, DEPTH));
}

#if !defined(EMU) && defined(PROBE_KIND)
__global__ void __launch_bounds__(512, 2) probe_kernel(Params p) {
    extern __shared__ __attribute__((aligned(16))) char smem[];
    for (int r = 0; r < PROBE_REPS; ++r) {
#if PROBE_KIND == 8
        phase_gateup<PROBE_VAR>(p, smem, 1);
#elif PROBE_KIND == 9
        phase_down<PROBE_VAR>(p, smem, 1);
#elif PROBE_KIND == 2
        phase_inproj<PROBE_VAR>(p, smem, 1);
#elif PROBE_KIND == 5
        phase_outproj<PROBE_VAR>(p, smem, 1);
#elif PROBE_KIND == 0
        phase_ada(p, smem);
#elif PROBE_KIND == 1
        phase_rows<0>(p, smem, 1);
#elif PROBE_KIND == 6
        phase_rows<1>(p, smem, 1);
#elif PROBE_KIND == 7
        phase_topk(p, smem);
#elif PROBE_KIND == 3
        phase_attn(p, smem, 1, 8 + r);
#elif PROBE_KIND == 4
        phase_mlout(p, smem, 1);
#endif
        __syncthreads();
    }
}
#endif
#ifndef EMU
#ifndef MK_N_LAUNCHES
#define MK_N_LAUNCHES 1
#endif
extern "C" void kernel_launch(void* const* d_in, const int* in_sizes, int n_in, void* d_out, int out_size, void* d_ws, size_t ws_size, hipStream_t stream) {
    (void)in_sizes; (void)n_in; (void)out_size; (void)ws_size;
    static int grid = 0;
    if (!grid) {
        int dev = 0, cus = 0, per_cu = 0;
        (void)hipGetDevice(&dev);
        (void)hipDeviceGetAttribute(&cus, hipDeviceAttributeMultiprocessorCount, dev);
        (void)hipFuncSetAttribute((const void*)mega_kernel, hipFuncAttributeMaxDynamicSharedMemorySize, SMEM_BYTES);
        (void)hipOccupancyMaxActiveBlocksPerMultiprocessor(&per_cu, mega_kernel, 512, SMEM_BYTES);
        grid = cus * (per_cu < 1 ? per_cu : 1);
        if (grid <= 0) grid = cus;
    }
    (void)hipMemsetAsync((char*)d_ws + WS_BAR, 0, WS_BAR_BYTES, stream);
    Params p = {};
    for (int i = 0; i < N_IN; ++i) p.in[i] = (const float*)d_in[i];
    p.out = (float*)d_out; p.ws = (char*)d_ws;
#if MK_N_LAUNCHES == 1
    p.ph0 = 0; p.ph1 = N_PHASES;
    mega_kernel<<<dim3(grid), dim3(512), SMEM_BYTES, stream>>>(p);
#ifdef PROBE_KIND
    (void)hipFuncSetAttribute((const void*)probe_kernel, hipFuncAttributeMaxDynamicSharedMemorySize, SMEM_BYTES);
    probe_kernel<<<dim3(grid), dim3(512), SMEM_BYTES, stream>>>(p);
#endif
#else
    for (int ph = 0; ph < N_PHASES; ++ph) { p.ph0 = ph; p.ph1 = ph + 1; mega_kernel<<<dim3(grid), dim3(512), SMEM_BYTES, stream>>>(p); }
#endif
}
#endif
```

```cpp
#ifndef EMU
#include <hip/hip_runtime.h>
#define DEV __device__ __forceinline__
#else
#define DEV static inline __attribute__((always_inline))
#endif
#include <stdint.h>
#include <stddef.h>

#ifndef CFG_D
#define CFG_D 1024
#define CFG_BATCH 16
#define CFG_SEQ 256
#define CFG_DEC_BATCH 2
#define CFG_DEC_SEQ 2048
#define CFG_PAST 256
#define CFG_EH 2816
#endif
constexpr int D = CFG_D, BATCH = CFG_BATCH, SEQ = CFG_SEQ, DEC_BATCH = CFG_DEC_BATCH, DEC_SEQ = CFG_DEC_SEQ, PAST = CFG_PAST, EH = CFG_EH;
constexpr int DEPTH = 2, HD = 64, NAH = 6, MLH = 4, GQH = 6, GQKV = 2, NEXP = 16, GRIDW = 64;
constexpr int NP = BATCH * SEQ, NS = DEC_BATCH * DEC_SEQ, NT = NP + NS, NCOND = 1 + DEC_BATCH;
constexpr int PROJ_W = 2832, MIXW = 1024;
constexpr int CAP_P = SEQ / 8, CAP_S = DEC_SEQ / 8, SLOTS = BATCH * CAP_P + DEC_BATCH * CAP_S;
constexpr int ROWS = DEC_SEQ / GRIDW, KR = ROWS < 8 ? ROWS : 8, KC = 16;
constexpr int NCH_P = SEQ / 64, NCH_S = DEC_SEQ / 64;
constexpr float ALPHA = 1.41421356237309515f;
constexpr float ATT_SCALE = 0.125f;
constexpr float EPS = 1e-6f;
static_assert(SLOTS % 256 == 0 && NP % 256 == 0 && NS % 256 == 0 && SEQ % 256 == 0 && DEC_SEQ % 256 == 0, "tile divisibility");
static_assert(D % 256 == 0 && EH % 128 == 0 && PAST % 64 == 0, "tile divisibility");

typedef unsigned short bf16_t;
typedef short s8v __attribute__((ext_vector_type(8)));
typedef short s4v __attribute__((ext_vector_type(4)));
typedef float f16v __attribute__((ext_vector_type(16)));
typedef float f4v __attribute__((ext_vector_type(4)));
typedef unsigned u4v __attribute__((ext_vector_type(4)));
typedef unsigned u2v __attribute__((ext_vector_type(2)));

enum { I_XP = 0, I_XS, I_C, I_CNAK, I_CNAV, I_CGQK, I_CGQV, I_SC, I_SN, I_SM, I_CCTX, I_ADAW, I_ADAB, I_WIN, I_BGATE, I_WOUT, I_RPB, I_QKG, I_MLG,
       I_LNG, I_LNB, I_RW, I_WG, I_WU, I_WD, N_IN };

constexpr size_t O_YP = 0;
constexpr size_t O_YS = O_YP + (size_t)NP * D;
constexpr size_t O_NAK = O_YS + (size_t)NS * D;
constexpr size_t O_NAV = O_NAK + (size_t)BATCH * DEPTH * SEQ * NAH * HD;
constexpr size_t O_GQK = O_NAV + (size_t)BATCH * DEPTH * SEQ * NAH * HD;
constexpr size_t O_GQV = O_GQK + (size_t)BATCH * DEPTH * SEQ * GQKV * HD;
constexpr size_t O_MC = O_GQV + (size_t)BATCH * DEPTH * SEQ * GQKV * HD;
constexpr size_t O_MN = O_MC + (size_t)BATCH * DEPTH * 2 * MLH * HD * HD;
constexpr size_t O_MM = O_MN + (size_t)BATCH * DEPTH * 2 * MLH * HD;
constexpr size_t O_END = O_MM + (size_t)BATCH * DEPTH * 2 * MLH;

constexpr size_t al256(size_t x) { return (x + 255) & ~(size_t)255; }
constexpr size_t WS_BAR = 0;
constexpr size_t WS_BAR_BYTES = 32768;
constexpr size_t WS_MODS = WS_BAR + WS_BAR_BYTES;
constexpr size_t WS_ROPE = al256(WS_MODS + (size_t)DEPTH * NCOND * 6 * D * 4);
constexpr size_t WS_CNAK = al256(WS_ROPE + 64 * 16 * 2 * 4);
constexpr size_t WS_CNAV = al256(WS_CNAK + (size_t)DEC_BATCH * DEPTH * PAST * NAH * HD * 2);
constexpr size_t WS_CGQK = al256(WS_CNAV + (size_t)DEC_BATCH * DEPTH * PAST * NAH * HD * 2);
constexpr size_t WS_CGQV = al256(WS_CGQK + (size_t)DEC_BATCH * DEPTH * PAST * GQKV * HD * 2);
constexpr size_t WS_XBUF = al256(WS_CGQV + (size_t)DEC_BATCH * DEPTH * PAST * GQKV * HD * 2);
constexpr size_t WS_HMOD = al256(WS_XBUF + (size_t)NT * D * 4);
constexpr size_t WS_GATES = al256(WS_HMOD + (size_t)NT * D * 2);
constexpr size_t WS_NAQ = al256(WS_GATES + (size_t)NT * 16 * 4);
constexpr size_t WS_NAK = al256(WS_NAQ + (size_t)NT * 384 * 2);
constexpr size_t WS_NAV = al256(WS_NAK + (size_t)NT * 384 * 2);
constexpr size_t WS_MLQ = al256(WS_NAV + (size_t)NT * 384 * 2);
constexpr size_t WS_MLK = al256(WS_MLQ + (size_t)NT * 256 * 2);
constexpr size_t WS_MLV = al256(WS_MLK + (size_t)NT * 256 * 2);
constexpr size_t WS_MLO = al256(WS_MLV + (size_t)NT * 256 * 2);
constexpr size_t WS_GQQ = al256(WS_MLO + (size_t)NT * 256 * 2);
constexpr size_t WS_GQK = al256(WS_GQQ + (size_t)NT * 384 * 2);
constexpr size_t WS_GQV = al256(WS_GQK + (size_t)NT * 128 * 2);
constexpr size_t WS_MIXED = al256(WS_GQV + (size_t)NT * 128 * 2);
constexpr size_t WS_U = al256(WS_MIXED + (size_t)NT * MIXW * 2);
constexpr size_t WS_X1 = al256(WS_U + (size_t)NT * D * 4);
constexpr size_t WS_H2 = al256(WS_X1 + (size_t)NT * D * 4);
constexpr size_t WS_AFF = al256(WS_H2 + (size_t)NT * D * 2);
constexpr size_t WS_IDX = al256(WS_AFF + (size_t)NT * 16 * 4);
constexpr size_t WS_GSEL = al256(WS_IDX + (size_t)NEXP * SLOTS * 4);
constexpr size_t WS_TOKSLOT = al256(WS_GSEL + (size_t)NEXP * SLOTS * 4);
constexpr size_t WS_HID = al256(WS_TOKSLOT + (size_t)NT * 16 * 4);
constexpr size_t WS_YE = al256(WS_HID + (size_t)NEXP * SLOTS * EH * 2);
constexpr int MLSUM_STRIDE = 4096 + 64 + 64;
constexpr int N_MLSUM = (BATCH * NCH_P + DEC_BATCH * NCH_S) * MLH * 2;
constexpr size_t WS_MLSUM = al256(WS_YE + (size_t)NEXP * SLOTS * D * 4);
constexpr int PART_STRIDE = 256 * 64 + 512;
constexpr int N_PART = DEC_BATCH * GQH * (DEC_SEQ / 256) * 2;
constexpr size_t WS_PART = al256(WS_MLSUM + (size_t)N_MLSUM * MLSUM_STRIDE * 4);
constexpr size_t WS_TOTAL = al256(WS_PART + (size_t)N_PART * PART_STRIDE * 4);

struct Params {
    const float* in[N_IN];
    float* out;
    char* ws;
    int ph0, ph1;
};

DEV float bf2f(bf16_t s) { unsigned u = ((unsigned)s) << 16; return __builtin_bit_cast(float, u); }
DEV bf16_t f2bf(float f) {
#ifdef EMU
    unsigned u = __builtin_bit_cast(unsigned, f); u += 0x7fffu + ((u >> 16) & 1u); return (bf16_t)(u >> 16);
#else
    return __builtin_bit_cast(bf16_t, (__bf16)f);
#endif
}
DEV unsigned pack2(float a, float b) {
#ifdef EMU
    return (unsigned)f2bf(a) | ((unsigned)f2bf(b) << 16);
#else
    typedef __bf16 b2 __attribute__((ext_vector_type(2))); b2 r; r[0] = (__bf16)a; r[1] = (__bf16)b; return __builtin_bit_cast(unsigned, r);
#endif
}
DEV float fexp(float x) {
#ifdef EMU
    return expf(x);
#else
    return __expf(x);
#endif
}
DEV float sigmoidf_(float x) { return 1.f / (1.f + fexp(-x)); }
DEV float siluf_(float x) { return x / (1.f + fexp(-x)); }
DEV float logsigmoidf_(float x) { return fminf(x, 0.f) - log1pf(expf(-fabsf(x))); }
DEV f16v mfma32(s8v a, s8v b, f16v c) {
#ifdef EMU
    return emu_mfma_32x32x16_bf16(a, b, c);
#else
    typedef __bf16 bf8 __attribute__((ext_vector_type(8)));
    return __builtin_amdgcn_mfma_f32_32x32x16_bf16(__builtin_bit_cast(bf8, a), __builtin_bit_cast(bf8, b), c, 0, 0, 0);
#endif
}
DEV s4v lds_tr16(const void* p) {
#ifdef EMU
    return emu_ds_read_tr16_b64(p);
#else
    typedef s4v __attribute__((address_space(3))) * lp;
    return __builtin_amdgcn_ds_read_tr16_b64_v4i16((lp)(p));
#endif
}
#ifdef EMU
DEV float wave_sum(float v) { for (int m = 32; m >= 1; m >>= 1) v += __shfl_xor(v, m); return v; }
#else
template <int CTRL, int RM> DEV float dpp_f(float v) { return __builtin_bit_cast(float, __builtin_amdgcn_update_dpp(0, __builtin_bit_cast(int, v), CTRL, RM, 0xF, false)); }
DEV float wave_sum(float v) {
    v += dpp_f<0xB1, 0xF>(v); v += dpp_f<0x4E, 0xF>(v); v += dpp_f<0x141, 0xF>(v); v += dpp_f<0x140, 0xF>(v);
    v += dpp_f<0x142, 0xA>(v); v += dpp_f<0x143, 0xC>(v);
    return __builtin_bit_cast(float, __builtin_amdgcn_readlane(__builtin_bit_cast(int, v), 63));
}
#endif
DEV float wave_max(float v) { for (int m = 32; m >= 1; m >>= 1) v = fmaxf(v, __shfl_xor(v, m)); return v; }
DEV f16v f16zero() { f16v z; for (int i = 0; i < 16; ++i) z[i] = 0.f; return z; }

#ifdef EMU
#define SGPR_PIN(x) do {} while (0)
#define SCHED_FENCE() do {} while (0)
#define CFENCE() do {} while (0)
#else
#define SCHED_FENCE() __builtin_amdgcn_sched_barrier(0)
#define SGPR_PIN(x) asm volatile("" : "+s"(x))
#define CFENCE() asm volatile("" ::: "memory")
#endif
#ifdef EMU
DEV int get_tid() { return (int)threadIdx.x; }
#else
DEV int get_tid() { int t = threadIdx.x; asm volatile("" : "+v"(t)); return t; }
#endif
struct UnitIter { int i, end, step; };
DEV UnitIter unit_iter(int NU) {
    const int G = (int)gridDim.x, b = (int)blockIdx.x;
    UnitIter it;
#ifndef XCD_MODE
#define XCD_MODE 0
#endif
    if ((G & 7) == 0 && (NU & 7) == 0) { const int W = G >> 3, x = XCD_MODE ? b / W : b & 7, j = XCD_MODE ? b % W : b >> 3, C = NU >> 3; it.i = x * C + j; it.end = (x + 1) * C; it.step = W; }
    else { it.i = b; it.end = NU; it.step = G; }
    return it;
}
DEV int tok_cond(int t) { return t < NP ? 0 : 1 + (t - NP) / DEC_SEQ; }

#ifndef EMU
#define XB_TMO      128
#define XB_XCNT(j)  (256  + 64 * (j))
#define XB_XSUB(j)  (1280 + 64 * (j))
#define XB_XGEN(j)  (2304 + 64 * (j))
#define XB_TOP      3328
#define XB_TOPGEN   3392
#define XCD_BAR_WORDS 3456
#define XB_SPIN_CAP (1u << 20)
#define LAS __attribute__((address_space(3)))
__device__ __forceinline__ unsigned xb_ld(unsigned* p)              { return __hip_atomic_load(p, __ATOMIC_RELAXED, __HIP_MEMORY_SCOPE_AGENT); }
__device__ __forceinline__ unsigned xb_add(unsigned* p, unsigned v) { return __hip_atomic_fetch_add(p, v, __ATOMIC_RELAXED, __HIP_MEMORY_SCOPE_AGENT); }
__device__ __forceinline__ unsigned xb_xcc_id() { return (unsigned)__builtin_amdgcn_s_getreg((3 << 11) | 20) & 0xFu; }
#define XB_SPIN(cond, bar) do { unsigned _sp = 0; while (cond) { __builtin_amdgcn_s_sleep(1); \
    if ((++_sp & 255u) == 0u) { if (xb_ld(&(bar)[XB_TMO])) break; if (_sp > XB_SPIN_CAP) { atomicAdd(&(bar)[XB_TMO], 1u); break; } } } } while (0)
struct XcdBarrier { unsigned* bar; unsigned x; volatile LAS unsigned* st; };
__device__ __forceinline__ XcdBarrier xcd_barrier_post(unsigned* bar, volatile LAS unsigned* st) {
    XcdBarrier b; b.bar = bar; b.x = xb_xcc_id(); b.st = st;
    if (threadIdx.x == 0) (void)xb_add(&bar[XB_XCNT(b.x)], 1u);
    return b;
}
__device__ __forceinline__ void xcd_barrier_complete(unsigned* bar, unsigned x, unsigned& nloc, unsigned& nx) {
    const unsigned G = gridDim.x * gridDim.y * gridDim.z;
    unsigned sum, cnt, mine, sp = 0u;
    for (;;) {
        sum = 0u; cnt = 0u; mine = 0u;
#pragma unroll
        for (unsigned j = 0; j < 16; ++j) { const unsigned c = xb_ld(&bar[XB_XCNT(j)]); sum += c; cnt += (c > 0u) ? 1u : 0u; mine = (j == x) ? c : mine; }
        if (sum == G) break;
        __builtin_amdgcn_s_sleep(1);
        if ((++sp & 255u) == 0u) { if (xb_ld(&bar[XB_TMO])) break; if (sp > XB_SPIN_CAP) { atomicAdd(&bar[XB_TMO], 1u); break; } }
    }
    nloc = mine > 0u ? mine : 1u; nx = cnt > 0u ? cnt : 1u;
}
__device__ __forceinline__ void xcd_barrier(const XcdBarrier& b) {
    asm volatile("s_waitcnt vmcnt(0)" ::: "memory");
    __syncthreads();
    if (threadIdx.x == 0) {
        unsigned* bar = b.bar;
        __builtin_amdgcn_s_waitcnt(0);
        unsigned nloc = b.st[0], nx = b.st[1];
        if (nloc == 0u) { xcd_barrier_complete(bar, b.x, nloc, nx); b.st[0] = nloc; b.st[1] = nx; }
        const unsigned old = xb_add(&bar[XB_XSUB(b.x)], 1u);
        const unsigned gen = old / nloc;
        if (old + 1u == (gen + 1u) * nloc) {
            __builtin_amdgcn_fence(__ATOMIC_RELEASE, "agent");
            asm volatile("s_waitcnt vmcnt(0)" ::: "memory");
            const unsigned og = xb_add(&bar[XB_TOP], 1u);
            const unsigned tg = og / nx;
            if (og + 1u == (tg + 1u) * nx) xb_add(&bar[XB_TOPGEN], 1u);
            else XB_SPIN(xb_ld(&bar[XB_TOPGEN]) == tg, bar);
            __builtin_amdgcn_fence(__ATOMIC_ACQUIRE, "agent");
            xb_add(&bar[XB_XGEN(b.x)], 1u);
            asm volatile("s_waitcnt vmcnt(0)" ::: "memory");
        } else {
            XB_SPIN(xb_ld(&bar[XB_XGEN(b.x)]) == gen, bar);
            __builtin_amdgcn_fence(__ATOMIC_ACQUIRE, "agent");
            asm volatile("s_waitcnt vmcnt(0)" ::: "memory");
        }
    }
    __syncthreads();
}
#endif
constexpr int QUEUE_WORD0 = 4096;

constexpr int LROW = 144;
constexpr int GEMM_AS = 256 * LROW;
constexpr int GEMM_BS = 64 * (256 * 2 + 64);
constexpr int SMEM_BYTES = 2 * GEMM_AS + 2 * GEMM_BS + 64;
constexpr int SMEM_XB = 2 * GEMM_AS + 2 * GEMM_BS;

#ifdef EMU
struct BufRsrc { const char* base; };
DEV BufRsrc make_rsrc(const void* p) { BufRsrc r; r.base = (const char*)p; return r; }
DEV float buf_load_f32(BufRsrc r, unsigned voff, unsigned soff) { return *(const float*)(r.base + voff + soff); }
DEV u4v buf_load_b128(BufRsrc r, unsigned voff, unsigned soff) { return *(const u4v*)(r.base + voff + soff); }
#else
typedef __amdgpu_buffer_rsrc_t BufRsrc;
DEV BufRsrc make_rsrc(const void* p) { return __builtin_amdgcn_make_buffer_rsrc((void*)p, 0, 0x7fffffff, 0x00020000); }
DEV float buf_load_f32(BufRsrc r, unsigned voff, unsigned soff) { return __builtin_bit_cast(float, __builtin_amdgcn_raw_buffer_load_b32(r, voff, soff, 0)); }
DEV u4v buf_load_b128(BufRsrc r, unsigned voff, unsigned soff) { return __builtin_amdgcn_raw_buffer_load_b128(r, voff, soff, 0); }
#endif
template <int NTW, int VAR, class Epi>
DEV void gemm_tile(char* smem, BufRsrc ars, unsigned ao0, unsigned ao1, unsigned ao2, unsigned ao3,
                   BufRsrc brs, unsigned bvo, unsigned blds, unsigned ldb4, int K, Epi&& epi) {
    constexpr int BN = 64 * NTW, NLD = 2 * NTW, KSTEP = 64 / NLD, RSB = BN * 2 + 64;
    const int tid = get_tid(), lane = tid & 63, wave = tid >> 6, wm = wave & 3, wn = wave >> 2, h = lane >> 5, l31 = lane & 31;
    char* As = smem; char* Bs = smem + 2 * GEMM_AS;
    constexpr int BSZ = 64 * RSB;
    const int ar = tid >> 3, ac = tid & 7;
    u4v areg[4]; f4v b0[NLD], b1[NLD];
    if (VAR & 3) { for (int i = 0; i < 4; ++i) areg[i] = (u4v){1u, 2u, 3u, 4u}; for (int j = 0; j < NLD; ++j) { b0[j] = (f4v){1.f, 1.f, 1.f, 1.f}; b1[j] = (f4v){2.f, 2.f, 2.f, 2.f}; } }
    f16v acc[NTW][2];
#pragma unroll
    for (int i = 0; i < NTW; ++i) { acc[i][0] = f16zero(); acc[i][1] = f16zero(); }
    auto gloadA = [&](int k0, bool real) {
        if (VAR & 2) return;
        const unsigned so = real ? k0 * 2 : 0u;
        areg[0] = buf_load_b128(ars, real ? ao0 : 0u, so); areg[1] = buf_load_b128(ars, real ? ao1 : 0u, so);
        areg[2] = buf_load_b128(ars, real ? ao2 : 0u, so); areg[3] = buf_load_b128(ars, real ? ao3 : 0u, so);
    };
    auto gloadB = [&](int k0, bool real, f4v (&br)[NLD]) {
        if (VAR & 1) return;
        const unsigned vo = real ? bvo : 0u; const int kk = real ? k0 : 0;
        unsigned so = (unsigned)kk * ldb4;
#pragma unroll
        for (int j = 0; j < NLD; ++j) { br[j] = __builtin_bit_cast(f4v, buf_load_b128(brs, vo, so)); so += KSTEP * ldb4; SGPR_PIN(so); }
    };
    auto lstoreA = [&](int buf) {
        if (VAR & 16) return;
        char* ab = As + buf * GEMM_AS + ar * LROW + ac * 16;
#pragma unroll
        for (int i = 0; i < 4; ++i) *(u4v*)(ab + i * 64 * LROW) = areg[i];
    };
    auto lstoreB = [&](int buf, const f4v (&br)[NLD]) {
        if (VAR & 16) return;
        char* bb = Bs + buf * BSZ + blds;
#pragma unroll
        for (int j = 0; j < NLD; ++j) { u2v v; v[0] = pack2(br[j][0], br[j][1]); v[1] = pack2(br[j][2], br[j][3]); *(u2v*)(bb + j * KSTEP * RSB) = v; }
    };
    const unsigned btr = (unsigned)(8 * h + ((lane & 15) >> 2)) * RSB + (unsigned)((((lane >> 4) & 1) * 16 + 4 * (lane & 3)) * 2) + (unsigned)(wn * NTW * 32) * 2;
    auto compute = [&](int buf, int s) {
        if (VAR & 8) return;
        const char* ab = As + buf * GEMM_AS + (wm * 64 + l31) * LROW + h * 16;
        const char* bb = Bs + buf * BSZ + btr + s * 16 * RSB;
        s8v xf[2];
        xf[0] = *(const s8v*)(ab + s * 32); xf[1] = *(const s8v*)(ab + 32 * LROW + s * 32);
#pragma unroll
        for (int ft = 0; ft < NTW; ++ft) {
            const s4v lo = lds_tr16(bb + ft * 64), hi = lds_tr16(bb + ft * 64 + 4 * RSB);
            s8v wf; wf[0] = lo[0]; wf[1] = lo[1]; wf[2] = lo[2]; wf[3] = lo[3]; wf[4] = hi[0]; wf[5] = hi[1]; wf[6] = hi[2]; wf[7] = hi[3];
            if (VAR & 4) { acc[ft][0][0] += __builtin_bit_cast(float, (int)wf[0] | ((int)xf[0][1] << 16)); acc[ft][1][0] += __builtin_bit_cast(float, (int)wf[1] | ((int)xf[1][1] << 16)); }
            else { acc[ft][0] = mfma32(wf, xf[0], acc[ft][0]); acc[ft][1] = mfma32(wf, xf[1], acc[ft][1]); }
        }
        SCHED_FENCE();
    };
    const int nk = K / 64;
    gloadA(0, true); gloadB(0, true, b0); gloadB(64, true, b1);
    lstoreA(0); lstoreB(0, b0);
    __syncthreads();
    for (int kt = 0; kt < nk; kt += 2) {
        const bool t2 = kt + 2 < nk;
        gloadA((kt + 1) * 64, true);
        gloadB((kt + 2) * 64, t2, b0);
        compute(0, 0); compute(0, 1); compute(0, 2); compute(0, 3);
        lstoreA(1); lstoreB(1, b1);
        __syncthreads();
        gloadA((kt + 2) * 64, t2);
        gloadB((kt + 3) * 64, t2, b1);
        compute(1, 0); compute(1, 1); compute(1, 2); compute(1, 3);
        lstoreA(0); lstoreB(0, b0);
        __syncthreads();
    }
    epi(acc);
}

DEV void phase_ada(const Params& p, char* smem) {
    const int tid = get_tid();
    float* siluS = (float*)smem;
    float* red = (float*)(smem + NCOND * D * 4);
    for (int i = tid; i < NCOND * D; i += 512) {
        const int cnd = i / D, k = i % D;
        const float c = cnd == 0 ? p.in[I_CCTX][k] : p.in[I_C][(cnd - 1) * D + k];
        siluS[i] = c / (1.f + expf(-c));
    }
    __syncthreads();
    constexpr int CPL = 6 * D / 32, NCHUNK = DEPTH * CPL, KG = D / 16;
    float* mods = (float*)(p.ws + WS_MODS);
    const int col = tid & 31, kg = tid >> 5;
    for (int u = blockIdx.x; u < NCHUNK; u += gridDim.x) {
        const int l = u / CPL, c0 = (u % CPL) * 32;
        const float* W = p.in[I_ADAW] + (size_t)l * D * 6 * D + c0 + col;
        float acc[NCOND];
#pragma unroll
        for (int c = 0; c < NCOND; ++c) acc[c] = 0.f;
#pragma unroll 8
        for (int k = kg * KG; k < kg * KG + KG; ++k) {
            const float w = W[(size_t)k * 6 * D];
#pragma unroll
            for (int c = 0; c < NCOND; ++c) acc[c] += siluS[c * D + k] * w;
        }
#pragma unroll
        for (int c = 0; c < NCOND; ++c) red[(kg * NCOND + c) * 32 + col] = acc[c];
        __syncthreads();
        if (tid < 32 * NCOND) {
            const int c = tid >> 5, cc = tid & 31;
            float s = 0.f;
            for (int g = 0; g < 16; ++g) s += red[(g * NCOND + c) * 32 + cc];
            mods[((size_t)l * NCOND + c) * 6 * D + c0 + cc] = s + p.in[I_ADAB][(size_t)l * 6 * D + c0 + cc];
        }
        __syncthreads();
    }
    const int gtid = blockIdx.x * 512 + tid, gsz = gridDim.x * 512;
    float* rope = (float*)(p.ws + WS_ROPE);
    for (int i = gtid; i < 64 * 16; i += gsz) {
        const int pos = i >> 4, fi = i & 15;
        const float inv = powf(10000.f, -(float)(2 * fi) / 32.f);
        const float ang = (float)pos * inv;
        rope[2 * i] = cosf(ang); rope[2 * i + 1] = sinf(ang);
    }
    constexpr int NNA = DEC_BATCH * DEPTH * PAST * NAH * HD, NGQ = DEC_BATCH * DEPTH * PAST * GQKV * HD;
    bf16_t* cnak = (bf16_t*)(p.ws + WS_CNAK); bf16_t* cnav = (bf16_t*)(p.ws + WS_CNAV);
    bf16_t* cgqk = (bf16_t*)(p.ws + WS_CGQK); bf16_t* cgqv = (bf16_t*)(p.ws + WS_CGQV);
    for (int i = gtid; i < NNA; i += gsz) { cnak[i] = f2bf(p.in[I_CNAK][i]); cnav[i] = f2bf(p.in[I_CNAV][i]); }
    for (int i = gtid; i < NGQ; i += gsz) { cgqk[i] = f2bf(p.in[I_CGQK][i]); cgqv[i] = f2bf(p.in[I_CGQV][i]); }
}

constexpr int EPL = D / 64;
constexpr int W16ROW = 20;
template <int MODE>
DEV void phase_rows(const Params& p, char* smem, int l) {
    const int tid = get_tid(), lane = tid & 63, wave = tid >> 6;
    float* W16 = (float*)smem;
    const bool need_w = (MODE == 1) || (l < DEPTH);
    if (need_w) {
        for (int i = tid; i < D * 4; i += 512) {
            const int k = i >> 2, q = i & 3;
            const float* src = (MODE == 1) ? p.in[I_RW] + ((size_t)l * D + k) * 16 + q * 4 : p.in[I_WIN] + ((size_t)l * D + k) * PROJ_W + 2176 + q * 4;
            *(f4v*)(W16 + k * W16ROW + q * 4) = *(const f4v*)src;
        }
    }
    __syncthreads();
    const float* mods = (const float*)(p.ws + WS_MODS);
    for (int t = blockIdx.x * 8 + wave; t < NT; t += gridDim.x * 8) {
        const int cnd = tok_cond(t);
        float v[EPL];
        if (MODE == 0 && l == 0) {
            const float* xr = t < NP ? p.in[I_XP] + (size_t)t * D : p.in[I_XS] + (size_t)(t - NP) * D;
#pragma unroll
            for (int j = 0; j < EPL; ++j) v[j] = xr[lane + 64 * j];
        } else if (MODE == 0) {
            const float* x1 = (const float*)(p.ws + WS_X1) + (size_t)t * D;
            const float* g2 = mods + ((size_t)(l - 1) * NCOND + cnd) * 6 * D + 5 * D;
            float f[EPL], xv[EPL], gv[EPL];
#pragma unroll
            for (int j = 0; j < EPL; ++j) { f[j] = 0.f; xv[j] = x1[lane + 64 * j]; gv[j] = g2[lane + 64 * j]; }
            const int* ts = (const int*)(p.ws + WS_TOKSLOT) + (size_t)t * 16;
            const int myslot = lane < 16 ? ts[lane] : -1;
            unsigned vm = (unsigned)__ballot(myslot >= 0);
            while (vm) {
                const int e = __builtin_ctz(vm); vm &= vm - 1u;
                const int slot = __shfl(myslot, e);
                const float* yr = (const float*)(p.ws + WS_YE) + ((size_t)e * SLOTS + slot) * D;
#pragma unroll
                for (int j = 0; j < EPL; ++j) f[j] += yr[lane + 64 * j];
            }
#pragma unroll
            for (int j = 0; j < EPL; ++j) v[j] = ALPHA * xv[j] + gv[j] * f[j];
        } else {
            const float* u = (const float*)(p.ws + WS_U) + (size_t)t * D;
#pragma unroll
            for (int j = 0; j < EPL; ++j) v[j] = u[lane + 64 * j];
        }
        if (!(MODE == 0 && l == 0)) {
            const int li = (MODE == 0) ? (l - 1) * 2 + 1 : l * 2;
            const float* lg = p.in[I_LNG] + (size_t)li * D; const float* lb = p.in[I_LNB] + (size_t)li * D;
            float g[EPL], bb[EPL];
#pragma unroll
            for (int j = 0; j < EPL; ++j) { g[j] = lg[lane + 64 * j]; bb[j] = lb[lane + 64 * j]; }
            float s = 0.f;
#pragma unroll
            for (int j = 0; j < EPL; ++j) s += v[j];
            const float mu = wave_sum(s) * (1.f / D);
            float q = 0.f;
#pragma unroll
            for (int j = 0; j < EPL; ++j) { const float dlt = v[j] - mu; q += dlt * dlt; }
            const float rstd = 1.f / sqrtf(wave_sum(q) * (1.f / D) + EPS);
            float* dst = (MODE == 1) ? (float*)(p.ws + WS_X1) + (size_t)t * D
                       : (l == DEPTH) ? (t < NP ? p.out + O_YP + (size_t)t * D : p.out + O_YS + (size_t)(t - NP) * D) : (float*)(p.ws + WS_XBUF) + (size_t)t * D;
#pragma unroll
            for (int j = 0; j < EPL; ++j) { v[j] = (v[j] - mu) * rstd * g[j] + bb[j]; dst[lane + 64 * j] = v[j]; }
        }
        if (MODE == 1 || l < DEPTH) {
            const float* sh = mods + ((size_t)l * NCOND + cnd) * 6 * D + (MODE == 1 ? 3 * D : 0); const float* sc = sh + D;
            bf16_t* hb = (bf16_t*)(p.ws + (MODE == 1 ? WS_H2 : WS_HMOD)) + (size_t)t * D;
            {
                float s1[EPL], s0[EPL];
#pragma unroll
                for (int j = 0; j < EPL; ++j) { s1[j] = sc[lane + 64 * j]; s0[j] = sh[lane + 64 * j]; }
#pragma unroll
                for (int j = 0; j < EPL; ++j) { v[j] = v[j] * (1.f + s1[j]) + s0[j]; hb[lane + 64 * j] = f2bf(v[j]); }
            }
            CFENCE();
            float a16[16];
#pragma unroll
            for (int e = 0; e < 16; ++e) a16[e] = 0.f;
#pragma unroll
            for (int j = 0; j < EPL; ++j) {
                const float hv = v[j];
                const float* wr = W16 + (lane + 64 * j) * W16ROW;
#pragma unroll
                for (int q = 0; q < 4; ++q) { const f4v w4 = *(const f4v*)(wr + 4 * q); a16[4 * q] += hv * w4[0]; a16[4 * q + 1] += hv * w4[1]; a16[4 * q + 2] += hv * w4[2]; a16[4 * q + 3] += hv * w4[3]; }
                if (j & 1) CFENCE();
            }
            float mine = -1e30f;
#pragma unroll
            for (int e = 0; e < 16; ++e) { const float sm = wave_sum(a16[e]); if (lane == e) mine = sm; }
            if (MODE == 0) {
                if (lane < 16) ((float*)(p.ws + WS_GATES))[(size_t)t * 16 + lane] = mine + p.in[I_BGATE][l * 16 + lane];
            } else {
                float mx = mine;
                for (int m = 8; m >= 1; m >>= 1) mx = fmaxf(mx, __shfl_xor(mx, m));
                const float ex = lane < 16 ? expf(mine - mx) : 0.f;
                float sm = ex;
                for (int m = 8; m >= 1; m >>= 1) sm += __shfl_xor(sm, m);
                if (lane < 16) ((float*)(p.ws + WS_AFF))[(size_t)t * 16 + lane] = ex / sm;
            }
        }
    }
}

template <int NPL>
DEV void topk_wave(const Params& p, int tb, int cap, int sbase, int e, int lane) {
    const float* aff = (const float*)(p.ws + WS_AFF);
    int* idx = (int*)(p.ws + WS_IDX); float* gsel = (float*)(p.ws + WS_GSEL); int* tokslot = (int*)(p.ws + WS_TOKSLOT);
    unsigned bits[NPL];
#pragma unroll
    for (int i = 0; i < NPL; ++i) bits[i] = __builtin_bit_cast(unsigned, aff[(size_t)(tb + lane + 64 * i) * 16 + e]);
    unsigned T = 0u;
    for (int b = 30; b >= 0; --b) {
        const unsigned cand = T | (1u << b);
        int cnt = 0;
#pragma unroll
        for (int i = 0; i < NPL; ++i) cnt += __popcll(__ballot(bits[i] >= cand));
        if (cnt >= cap) T = cand;
    }
    int ngt = 0;
#pragma unroll
    for (int i = 0; i < NPL; ++i) ngt += __popcll(__ballot(bits[i] > T));
    int need_eq = cap - ngt, run = 0;
    const unsigned long long lt = (1ull << lane) - 1ull;
#pragma unroll
    for (int i = 0; i < NPL; ++i) {
        const bool eq = bits[i] == T;
        const unsigned long long meq = __ballot(eq);
        const int eqrank = __popcll(meq & lt);
        const bool sel = bits[i] > T || (eq && eqrank < need_eq);
        const unsigned long long ms = __ballot(sel);
        const int t = tb + lane + 64 * i;
        if (sel) { const int slot = sbase + run + __popcll(ms & lt); idx[e * SLOTS + slot] = t; gsel[e * SLOTS + slot] = __builtin_bit_cast(float, bits[i]); tokslot[(size_t)t * 16 + e] = slot; }
        else tokslot[(size_t)t * 16 + e] = -1;
        run += __popcll(ms);
        const int neq = __popcll(meq); need_eq -= neq < need_eq ? neq : need_eq;
    }
}
DEV void phase_topk(const Params& p, char* smem) {
    (void)smem;
    const int tid = get_tid(), lane = tid & 63;
    constexpr int US = DEC_BATCH * NEXP, UP = BATCH * NEXP;
    const int gw = blockIdx.x * 8 + (tid >> 6), nw = gridDim.x * 8;
    for (int u = gw; u < US + UP; u += nw) {
        if (u < US) { const int b = u / NEXP, e = u % NEXP; topk_wave<DEC_SEQ / 64>(p, NP + b * DEC_SEQ, CAP_S, BATCH * CAP_P + b * CAP_S, e, lane); }
        else { const int uu = u - US; const int b = uu / NEXP, e = uu % NEXP; topk_wave<SEQ / 64>(p, b * SEQ, CAP_P, b * CAP_P, e, lane); }
    }
}

DEV void store_head(bf16_t* dst_bf, float* dst_f32, const f16v& v0, const f16v& v1, int h) {
#pragma unroll
    for (int ft = 0; ft < 2; ++ft) {
        const f16v& v = ft ? v1 : v0;
#pragma unroll
        for (int g = 0; g < 4; ++g) {
            const int d0 = ft * 32 + 8 * g + 4 * h;
            u2v pk; pk[0] = pack2(v[4 * g], v[4 * g + 1]); pk[1] = pack2(v[4 * g + 2], v[4 * g + 3]);
            *(u2v*)(dst_bf + d0) = pk;
            if (dst_f32) { f4v o; o[0] = v[4 * g]; o[1] = v[4 * g + 1]; o[2] = v[4 * g + 2]; o[3] = v[4 * g + 3]; *(f4v*)(dst_f32 + d0) = o; }
        }
    }
}
template <int VAR>
DEV void phase_inproj(const Params& p, char* smem, int l) {
    constexpr int NJ = 22, NU = (NT / 256) * NJ;
    const int tid = get_tid(), lane = tid & 63, wave = tid >> 6, wm = wave & 3, wn = wave >> 2, h = lane >> 5, l31 = lane & 31;
    const bf16_t* hmod = (const bf16_t*)(p.ws + WS_HMOD);
    const float* rope = (const float*)(p.ws + WS_ROPE);
    constexpr int NMB = NT / 256, RPX = (NMB % 8 == 0) ? NMB / 8 : NMB;
    const UnitIter it = unit_iter(NU);
    for (int u = it.i; u < it.end; u += it.step) {
        const int mb = (u / (RPX * NJ)) * RPX + u % RPX, j = (u / RPX) % NJ;
        const int colbase = j < 17 ? 128 * j : 2192 + 128 * (j - 17);
        const unsigned ao = ((unsigned)(mb * 256 + (tid >> 3)) * D + (tid & 7) * 8) * 2;
        const unsigned bvo = (unsigned)(colbase + 4 * (tid & 31)) * 4 + (unsigned)(tid >> 5) * (PROJ_W * 4);
        const unsigned blds = (unsigned)(tid >> 5) * 320u + (unsigned)(tid & 31) * 8u;
        gemm_tile<2, VAR>(smem, make_rsrc(hmod), ao, ao + 128u * D, ao + 256u * D, ao + 384u * D, make_rsrc(p.in[I_WIN] + (size_t)l * D * PROJ_W), bvo, blds, PROJ_W * 4, D, [&](f16v (&acc)[2][2]) {
            const int cb = colbase + wn * 64;
#pragma unroll
            for (int tt = 0; tt < 2; ++tt) {
                const int t = mb * 256 + wm * 64 + tt * 32 + l31;
                const bool isP = t < NP;
                const int bP = t / SEQ, sP = t % SEQ;
                f16v v0 = acc[0][tt], v1 = acc[1][tt];
                if (cb < 1152) {
                    const int seg = cb / 384, head = (cb % 384) / 64;
                    bf16_t* dst = (bf16_t*)(p.ws + (seg == 0 ? WS_NAQ : seg == 1 ? WS_NAK : WS_NAV)) + (size_t)t * 384 + head * 64;
                    float* of = nullptr;
                    if (seg >= 1 && isP) of = p.out + (seg == 1 ? O_NAK : O_NAV) + ((((size_t)bP * DEPTH + l) * SEQ + sP) * NAH + head) * 64;
                    store_head(dst, of, v0, v1, h);
                } else if (cb < 2176) {
                    const int seg = (cb - 1152) / 256, head = ((cb - 1152) % 256) / 64;
                    if (seg == 1) { v0 *= ATT_SCALE; v1 *= ATT_SCALE; }
                    bf16_t* dst = (bf16_t*)(p.ws + (seg == 0 ? WS_MLQ : seg == 1 ? WS_MLK : seg == 2 ? WS_MLV : WS_MLO)) + (size_t)t * 256 + head * 64;
                    store_head(dst, nullptr, v0, v1, h);
                } else {
                    const int c2 = cb - 2192;
                    if (c2 < 512) {
                        const bool isq = c2 < 384;
                        const int head = isq ? c2 / 64 : (c2 - 384) / 64;
                        float ss = 0.f;
#pragma unroll
                        for (int r = 0; r < 16; ++r) ss += v0[r] * v0[r] + v1[r] * v1[r];
                        ss += __shfl_xor(ss, 32);
                        const float rn = 1.f / sqrtf(ss * (1.f / 64.f) + EPS);
                        const float* gq = p.in[I_QKG] + ((size_t)l * 2 + (isq ? 0 : 1)) * 64;
#pragma unroll
                        for (int r = 0; r < 16; ++r) {
                            const int d = (r & 3) + 8 * (r >> 2) + 4 * h;
                            v0[r] *= rn * gq[d]; v1[r] *= rn * gq[32 + d];
                        }
                        if (isP) {
                            if (isq) store_head((bf16_t*)(p.ws + WS_GQQ) + (size_t)t * 384 + head * 64, nullptr, v0, v1, h);
                            else store_head((bf16_t*)(p.ws + WS_GQK) + (size_t)t * 128 + head * 64, p.out + O_GQK + ((((size_t)bP * DEPTH + l) * SEQ + sP) * GQKV + head) * 64, v0, v1, h);
                        } else {
                            const int pos = (t - NP) % DEC_SEQ, prow = pos / GRIDW, pcol = pos % GRIDW;
#pragma unroll
                            for (int r = 0; r < 8; ++r) {
                                const int rr = r;
                                const int fi = (rr & 3) + 8 * ((rr >> 2) & 1) + 4 * h;
                                const float c0 = rope[(prow * 16 + fi) * 2], s0 = rope[(prow * 16 + fi) * 2 + 1];
                                const float c1 = rope[(pcol * 16 + fi) * 2], s1 = rope[(pcol * 16 + fi) * 2 + 1];
                                const float a_lo = v0[rr], a_hi = v0[rr + 8]; v0[rr] = a_lo * c0 - a_hi * s0; v0[rr + 8] = a_hi * c0 + a_lo * s0;
                                const float b_lo = v1[rr], b_hi = v1[rr + 8]; v1[rr] = b_lo * c1 - b_hi * s1; v1[rr + 8] = b_hi * c1 + b_lo * s1;
                            }
                            if (isq) store_head((bf16_t*)(p.ws + WS_GQQ) + (size_t)t * 384 + head * 64, nullptr, v0, v1, h);
                            else store_head((bf16_t*)(p.ws + WS_GQK) + (size_t)t * 128 + head * 64, nullptr, v0, v1, h);
                        }
                    } else {
                        const int head = (c2 - 512) / 64;
                        float* of = isP ? p.out + O_GQV + ((((size_t)bP * DEPTH + l) * SEQ + sP) * GQKV + head) * 64 : nullptr;
                        store_head((bf16_t*)(p.ws + WS_GQV) + (size_t)t * 128 + head * 64, of, v0, v1, h);
                    }
                }
            }
        });
    }
}

template <int VAR>
DEV void phase_outproj(const Params& p, char* smem, int l) {
    constexpr int NC = D / 128, NU = (NT / 256) * NC;
    const int tid = get_tid(), lane = tid & 63, wave = tid >> 6, wm = wave & 3, wn = wave >> 2, h = lane >> 5, l31 = lane & 31;
    const bf16_t* mixed = (const bf16_t*)(p.ws + WS_MIXED);
    const float* mods = (const float*)(p.ws + WS_MODS);
    float* U = (float*)(p.ws + WS_U);
    constexpr int NMB = NT / 256, RPX = (NMB % 8 == 0) ? NMB / 8 : NMB;
    const UnitIter it = unit_iter(NU);
    for (int u = it.i; u < it.end; u += it.step) {
        const int mb = (u / (RPX * NC)) * RPX + u % RPX, cbk = (u / RPX) % NC;
        const unsigned ao = ((unsigned)(mb * 256 + (tid >> 3)) * MIXW + (tid & 7) * 8) * 2;
        const unsigned bvo = (unsigned)(cbk * 128 + 4 * (tid & 31)) * 4 + (unsigned)(tid >> 5) * (D * 4);
        const unsigned blds = (unsigned)(tid >> 5) * 320u + (unsigned)(tid & 31) * 8u;
        gemm_tile<2, VAR>(smem, make_rsrc(mixed), ao, ao + 128u * MIXW, ao + 256u * MIXW, ao + 384u * MIXW, make_rsrc(p.in[I_WOUT] + (size_t)l * MIXW * D), bvo, blds, D * 4, MIXW, [&](f16v (&acc)[2][2]) {
#pragma unroll
            for (int tt = 0; tt < 2; ++tt) {
                const int t = mb * 256 + wm * 64 + tt * 32 + l31;
                const float* xr = (l == 0) ? (t < NP ? p.in[I_XP] + (size_t)t * D : p.in[I_XS] + (size_t)(t - NP) * D) : (const float*)(p.ws + WS_XBUF) + (size_t)t * D;
                const float* g1 = mods + ((size_t)l * NCOND + tok_cond(t)) * 6 * D + 2 * D;
#pragma unroll
                for (int ft = 0; ft < 2; ++ft)
#pragma unroll
                    for (int g = 0; g < 4; ++g) {
                        const int f0 = cbk * 128 + wn * 64 + ft * 32 + 8 * g + 4 * h;
                        const f4v xv = *(const f4v*)(xr + f0); const f4v gv = *(const f4v*)(g1 + f0);
                        f4v o;
#pragma unroll
                        for (int q = 0; q < 4; ++q) o[q] = ALPHA * xv[q] + gv[q] * acc[ft][tt][4 * g + q];
                        *(f4v*)(U + (size_t)t * D + f0) = o;
                    }
            }
        });
    }
}

template <int VAR>
DEV void phase_gateup(const Params& p, char* smem, int l) {
    constexpr int NRB = SLOTS / 256, NCB = EH / 128, NU = NEXP * NCB * NRB;
    const int tid = get_tid(), lane = tid & 63, wave = tid >> 6, wm = wave & 3, wn = wave >> 2, h = lane >> 5, l31 = lane & 31;
    const bf16_t* h2 = (const bf16_t*)(p.ws + WS_H2);
    const int* idx = (const int*)(p.ws + WS_IDX);
    bf16_t* hid = (bf16_t*)(p.ws + WS_HID);
    const UnitIter it = unit_iter(NU);
    for (int u = it.i; u < it.end; u += it.step) {
        const int rb = u % NRB, cbk = (u / NRB) % NCB, e = u / (NRB * NCB);
        const int* ip = idx + e * SLOTS + rb * 256 + (tid >> 3);
        const unsigned a0 = ((unsigned)ip[0] * D + (tid & 7) * 8) * 2, a1 = ((unsigned)ip[64] * D + (tid & 7) * 8) * 2;
        const unsigned a2 = ((unsigned)ip[128] * D + (tid & 7) * 8) * 2, a3 = ((unsigned)ip[192] * D + (tid & 7) * 8) * 2;
#ifdef EMU
        const int bw = tid >> 6;
#else
        const int bw = __builtin_amdgcn_readfirstlane(tid >> 6);
#endif
        const int is_up = bw & 1, bkr = 2 * (bw >> 1) + ((tid >> 5) & 1), hc = 4 * (tid & 31);
        const int ncol = (hc >> 6) * 128 + (2 * ((hc >> 5) & 1) + is_up) * 32 + (hc & 31);
        const unsigned bvo = (unsigned)(cbk * 128 + hc) * 4 + (unsigned)bkr * (EH * 4);
        const unsigned blds = (unsigned)bkr * 576u + (unsigned)ncol * 2u;
        const float* wmat = (is_up ? p.in[I_WU] : p.in[I_WG]) + ((size_t)l * NEXP + e) * D * EH;
        gemm_tile<4, VAR>(smem, make_rsrc(h2), a0, a1, a2, a3, make_rsrc(wmat), bvo, blds, EH * 4, D, [&](f16v (&acc)[4][2]) {
#pragma unroll
            for (int tt = 0; tt < 2; ++tt) {
                const int slot = rb * 256 + wm * 64 + tt * 32 + l31;
                bf16_t* dst = hid + ((size_t)e * SLOTS + slot) * EH + cbk * 128 + wn * 64;
#pragma unroll
                for (int pr = 0; pr < 2; ++pr)
#pragma unroll
                    for (int g = 0; g < 4; ++g) {
                        float o[4];
#pragma unroll
                        for (int q = 0; q < 4; ++q) o[q] = siluf_(acc[2 * pr][tt][4 * g + q]) * acc[2 * pr + 1][tt][4 * g + q];
                        u2v pk; pk[0] = pack2(o[0], o[1]); pk[1] = pack2(o[2], o[3]);
                        *(u2v*)(dst + pr * 32 + 8 * g + 4 * h) = pk;
                    }
            }
        });
    }
}

template <int VAR>
DEV void phase_down(const Params& p, char* smem, int l) {
    constexpr int NRB = SLOTS / 256, NCB = D / 256, NU = NEXP * NCB * NRB;
    const int tid = get_tid(), lane = tid & 63, wave = tid >> 6, wm = wave & 3, wn = wave >> 2, h = lane >> 5, l31 = lane & 31;
    const bf16_t* hid = (const bf16_t*)(p.ws + WS_HID);
    const float* gsel = (const float*)(p.ws + WS_GSEL);
    float* ye = (float*)(p.ws + WS_YE);
    const UnitIter it = unit_iter(NU);
    for (int u = it.i; u < it.end; u += it.step) {
        const int rb = u % NRB, cbk = (u / NRB) % NCB, e = u / (NRB * NCB);
        const unsigned ao = ((unsigned)(rb * 256 + (tid >> 3)) * EH + (tid & 7) * 8) * 2;
        const unsigned bvo = (unsigned)(cbk * 256 + 4 * (tid & 63)) * 4 + (unsigned)(tid >> 6) * (D * 4);
        const unsigned blds = (unsigned)(tid >> 6) * 576u + (unsigned)(tid & 63) * 8u;
        gemm_tile<4, VAR>(smem, make_rsrc(hid + (size_t)e * SLOTS * EH), ao, ao + 128u * EH, ao + 256u * EH, ao + 384u * EH, make_rsrc(p.in[I_WD] + ((size_t)l * NEXP + e) * EH * D), bvo, blds, D * 4, EH, [&](f16v (&acc)[4][2]) {
#pragma unroll
            for (int tt = 0; tt < 2; ++tt) {
                const int slot = rb * 256 + wm * 64 + tt * 32 + l31;
                const float gs = gsel[e * SLOTS + slot];
                float* dst = ye + ((size_t)e * SLOTS + slot) * D + cbk * 256 + wn * 128;
#pragma unroll
                for (int ft = 0; ft < 4; ++ft)
#pragma unroll
                    for (int g = 0; g < 4; ++g) {
                        f4v o;
#pragma unroll
                        for (int q = 0; q < 4; ++q) o[q] = acc[ft][tt][4 * g + q] * gs;
                        *(f4v*)(dst + ft * 32 + 8 * g + 4 * h) = o;
                    }
            }
        });
    }
}

struct AttnDesc {
    const bf16_t* q; int qstride;
    int ntiles, n0;
    const bf16_t *k0, *v0; int stride0;
    const bf16_t *k1, *v1; int stride1;
    int na;
    int r0, rlo;
    const float* rpb;
    bf16_t* out; int ostride;
    float* part;
};
constexpr int ATT_TILE = 64 * LROW;
DEV int na_row_start(int r) { int s = r - KR / 2; s = s < 0 ? 0 : s; return s > ROWS - KR ? ROWS - KR : s; }
DEV void attn_unit(char* smem, const AttnDesc& d) {
    const int tid = get_tid(), lane = tid & 63, wave = tid >> 6, h = lane >> 5, l31 = lane & 31;
    char* Ks = smem; char* Vs = smem + 2 * ATT_TILE; float* rpbS = (float*)(smem + 4 * ATT_TILE);
    if (d.na) { for (int i = tid; i < 15 * 31; i += 512) rpbS[i] = d.rpb[i]; }
    const bf16_t* qp = d.q + (size_t)(wave * 32 + l31) * d.qstride + h * 8;
    s8v qf[4];
#pragma unroll
    for (int s = 0; s < 4; ++s) qf[s] = *(const s8v*)(qp + 16 * s);
    float m_run = -1e30f, l_run = 0.f;
    f16v o[2]; o[0] = f16zero(); o[1] = f16zero();
    const int srow = tid >> 3, sch = tid & 7;
    u4v kreg, vreg;
    auto gload = [&](int t) {
        const bf16_t *kp, *vp;
        if (t < d.n0) { const size_t off = (size_t)(t * 64 + srow) * d.stride0 + sch * 8; kp = d.k0 + off; vp = d.v0 + off; }
        else { const size_t off = (size_t)((t - d.n0) * 64 + srow) * d.stride1 + sch * 8; kp = d.k1 + off; vp = d.v1 + off; }
        kreg = *(const u4v*)kp; vreg = *(const u4v*)vp;
    };
    auto lstore = [&](int buf) { *(u4v*)(Ks + buf * ATT_TILE + srow * LROW + sch * 16) = kreg; *(u4v*)(Vs + buf * ATT_TILE + srow * LROW + sch * 16) = vreg; };
    const int qr = d.r0 + (wave >> 1), qw = (wave & 1) * 32 + l31;
    const int rs = na_row_start(qr);
    int cs = qw - KC / 2; cs = cs < 0 ? 0 : (cs > GRIDW - KC ? GRIDW - KC : cs);
    gload(0); lstore(0);
    __syncthreads();
    for (int t = 0; t < d.ntiles; ++t) {
        const int buf = t & 1;
        if (t + 1 < d.ntiles) gload(t + 1);
        const bool local = d.na && t >= d.n0;
        const int kr = d.rlo + (t - d.n0);
        const bool active = !local || (kr >= rs && kr < rs + KR);
        if (active) {
            const char* kb = Ks + buf * ATT_TILE + l31 * LROW + h * 16;
            f16v sa[2];
#pragma unroll
            for (int kt = 0; kt < 2; ++kt) {
                sa[kt] = f16zero();
#pragma unroll
                for (int s = 0; s < 4; ++s) { const s8v kf = *(const s8v*)(kb + kt * 32 * LROW + s * 32); sa[kt] = mfma32(kf, qf[s], sa[kt]); }
            }
            float mx = -1e30f;
#pragma unroll
            for (int kt = 0; kt < 2; ++kt)
#pragma unroll
                for (int r = 0; r < 16; ++r) {
                    float v = sa[kt][r] * ATT_SCALE;
                    if (local) {
                        const int kc = kt * 32 + (r & 3) + 8 * (r >> 2) + 4 * h;
                        const bool inw = kc >= cs && kc < cs + KC;
                        const int bi = (kr - qr + 7) * 31 + (kc - qw + 15);
                        v = inw ? v + rpbS[inw ? bi : 0] : -1e30f;
                    }
                    sa[kt][r] = v; mx = fmaxf(mx, v);
                }
            mx = fmaxf(mx, __shfl_xor(mx, 32));
            const float m_new = fmaxf(m_run, mx);
            const float alpha = fexp(m_run - m_new);
            float ps = 0.f;
#pragma unroll
            for (int kt = 0; kt < 2; ++kt)
#pragma unroll
                for (int r = 0; r < 16; ++r) { const float pv = fexp(sa[kt][r] - m_new); sa[kt][r] = pv; ps += pv; }
            l_run = l_run * alpha + ps; m_run = m_new;
            o[0] *= alpha; o[1] *= alpha;
            const char* vb = Vs + buf * ATT_TILE + (4 * h + ((lane & 15) >> 2)) * LROW + (((lane >> 4) & 1) * 16 + 4 * (lane & 3)) * 2;
#pragma unroll
            for (int ks = 0; ks < 4; ++ks) {
                const int kt = ks >> 1, rb = 8 * (ks & 1);
                u4v pk; pk[0] = pack2(sa[kt][rb], sa[kt][rb + 1]); pk[1] = pack2(sa[kt][rb + 2], sa[kt][rb + 3]);
                pk[2] = pack2(sa[kt][rb + 4], sa[kt][rb + 5]); pk[3] = pack2(sa[kt][rb + 6], sa[kt][rb + 7]);
                const s8v pf = __builtin_bit_cast(s8v, pk);
                const char* vk = vb + (kt * 32 + 16 * (ks & 1)) * LROW;
#pragma unroll
                for (int dt = 0; dt < 2; ++dt) {
                    const s4v lo = lds_tr16(vk + dt * 64), hi = lds_tr16(vk + 8 * LROW + dt * 64);
                    s8v vf; vf[0] = lo[0]; vf[1] = lo[1]; vf[2] = lo[2]; vf[3] = lo[3]; vf[4] = hi[0]; vf[5] = hi[1]; vf[6] = hi[2]; vf[7] = hi[3];
                    o[dt] = mfma32(vf, pf, o[dt]);
                }
            }
        }
        if (t + 1 < d.ntiles) lstore(buf ^ 1);
        __syncthreads();
    }
    const float l_tot = l_run + __shfl_xor(l_run, 32);
    const int qrow = wave * 32 + l31;
    if (d.part) {
        float* po = d.part + (size_t)qrow * 64;
#pragma unroll
        for (int dt = 0; dt < 2; ++dt)
#pragma unroll
            for (int g = 0; g < 4; ++g) { f4v v; v[0] = o[dt][4 * g]; v[1] = o[dt][4 * g + 1]; v[2] = o[dt][4 * g + 2]; v[3] = o[dt][4 * g + 3]; *(f4v*)(po + dt * 32 + 8 * g + 4 * h) = v; }
        if (h == 0) { d.part[256 * 64 + qrow] = m_run; d.part[256 * 64 + 256 + qrow] = l_tot; }
    } else {
        const float inv = 1.f / l_tot;
        bf16_t* po = d.out + (size_t)qrow * d.ostride;
#pragma unroll
        for (int dt = 0; dt < 2; ++dt)
#pragma unroll
            for (int g = 0; g < 4; ++g) {
                u2v pk; pk[0] = pack2(o[dt][4 * g] * inv, o[dt][4 * g + 1] * inv); pk[1] = pack2(o[dt][4 * g + 2] * inv, o[dt][4 * g + 3] * inv);
                *(u2v*)(po + dt * 32 + 8 * g + 4 * h) = pk;
            }
    }
}

DEV int ml_sidx(int grp, int b, int head, int c) { return grp == 0 ? ((b * MLH + head) * NCH_P + c) : BATCH * MLH * NCH_P + ((b * MLH + head) * NCH_S + c); }
DEV float lane_prefix_sum(float v, int lane) { for (int dlt = 1; dlt < 64; dlt <<= 1) { const float o = __shfl(v, lane - dlt); if (lane >= dlt) v += o; } return v; }
DEV float lane_prefix_max(float v, int lane) { for (int dlt = 1; dlt < 64; dlt <<= 1) { const float o = __shfl(v, lane - dlt); if (lane >= dlt) v = fmaxf(v, o); } return v; }

DEV void mlstm_summary_unit(const Params& p, char* smem, int grp, int b, int head, int c) {
    const int tid = get_tid(), lane = tid & 63, wave = tid >> 6, h = lane >> 5, l31 = lane & 31;
    char* KT = smem;
    char* VT = smem + 2 * ATT_TILE;
    float* wsS = (float*)(smem + 3 * ATT_TILE);
    float* scal = wsS + 128;
    const int tb = (grp == 0 ? b * SEQ : NP + b * DEC_SEQ) + c * 64;
    const float* gates = (const float*)(p.ws + WS_GATES);
    if (wave == 0) {
        const float* gr = gates + (size_t)(tb + lane) * 16;
        const float i_f = gr[head], lf_f = logsigmoidf_(gr[4 + head]), i_b = gr[8 + head], lf_b = logsigmoidf_(gr[12 + head]);
        const float pf = lane_prefix_sum(lf_f, lane), pb = lane_prefix_sum(lf_b, lane);
        const float tot_f = __shfl(pf, 63), tot_b = __shfl(pb, 63);
        const float g_f = (tot_f - pf) + i_f, g_b = (pb - lf_b) + i_b;
        const float G_f = wave_max(g_f), G_b = wave_max(g_b);
        wsS[lane] = expf(g_f - G_f); wsS[64 + lane] = expf(g_b - G_b);
        if (lane == 0) { scal[0] = tot_f; scal[1] = tot_b; scal[2] = G_f; scal[3] = G_b; }
    }
    __syncthreads();
    {
        const int tau = tid >> 3, ch = tid & 7;
        const u4v kv = *(const u4v*)((const bf16_t*)(p.ws + WS_MLK) + (size_t)(tb + tau) * 256 + head * 64 + ch * 8);
        const u4v vv = *(const u4v*)((const bf16_t*)(p.ws + WS_MLV) + (size_t)(tb + tau) * 256 + head * 64 + ch * 8);
        const float wf = wsS[tau], wb = wsS[64 + tau];
#pragma unroll
        for (int j = 0; j < 8; ++j) {
            const bf16_t kb = (bf16_t)(kv[j >> 1] >> (16 * (j & 1))), vb = (bf16_t)(vv[j >> 1] >> (16 * (j & 1)));
            const int dim = ch * 8 + j; const float kf = bf2f(kb);
            *(bf16_t*)(KT + dim * LROW + tau * 2) = f2bf(kf * wf);
            *(bf16_t*)(KT + ATT_TILE + dim * LROW + tau * 2) = f2bf(kf * wb);
            *(bf16_t*)(VT + dim * LROW + tau * 2) = vb;
        }
    }
    __syncthreads();
    float* sum = (float*)(p.ws + WS_MLSUM);
    const int sidx = ml_sidx(grp, b, head, c);
    {
        const int dir = wave >> 2, mi = (wave >> 1) & 1, ni = wave & 1;
        f16v acc = f16zero();
#pragma unroll
        for (int s = 0; s < 4; ++s) {
            const s8v af = *(const s8v*)(KT + dir * ATT_TILE + (mi * 32 + l31) * LROW + (16 * s + 8 * h) * 2);
            const s8v bf = *(const s8v*)(VT + (ni * 32 + l31) * LROW + (16 * s + 8 * h) * 2);
            acc = mfma32(af, bf, acc);
        }
        float* U = sum + (size_t)(sidx * 2 + dir) * MLSUM_STRIDE;
#pragma unroll
        for (int r = 0; r < 16; ++r) U[(mi * 32 + (r & 3) + 8 * (r >> 2) + 4 * h) * 64 + ni * 32 + l31] = acc[r];
    }
    if (tid < 128) {
        const int dir = tid >> 6, kd = tid & 63;
        float s = 0.f;
        for (int tau = 0; tau < 64; ++tau) s += bf2f(*(const bf16_t*)(KT + dir * ATT_TILE + kd * LROW + tau * 2));
        float* E = sum + (size_t)(sidx * 2 + dir) * MLSUM_STRIDE;
        E[4096 + kd] = s;
        if (kd == 0) { E[4160] = scal[dir]; E[4161] = scal[2 + dir]; }
    }
    __syncthreads();
}

DEV void mlstm_output_unit(const Params& p, char* smem, int l, int grp, int b, int head, int c) {
    const int tid = get_tid(), lane = tid & 63, wave = tid >> 6, h = lane >> 5, l31 = lane & 31;
    const int nc = grp ? NCH_S : NCH_P;
    char* Qs = smem;
    char* Ks = smem + 2 * ATT_TILE;
    char* VT = smem + 4 * ATT_TILE;
    char* CT = smem + 6 * ATT_TILE;
    char* QK = smem + 8 * ATT_TILE;
    float* hS = (float*)(smem + 10 * ATT_TILE);
    float* vec = hS + 2 * 64 * 68;
    float* aS = vec; float* MjS = vec + 128; float* bS = vec + 256; float* nS = vec + 384; float* denp = vec + 512; float* qnS = vec + 768; float* scal = vec + 896;
    const int tb = (grp == 0 ? b * SEQ : NP + b * DEC_SEQ) + c * 64;
    const float* sum = (const float*)(p.ws + WS_MLSUM);
#pragma unroll
    for (int dir = 0; dir < 2; ++dir) {
        float C[8], nst = 0.f, m;
        if (grp == 0) {
#pragma unroll
            for (int i = 0; i < 8; ++i) C[i] = 0.f;
            m = 0.f;
        } else {
            const size_t sb = (((size_t)b * DEPTH + l) * 2 + dir) * MLH + head;
#pragma unroll
            for (int i = 0; i < 8; ++i) C[i] = p.in[I_SC][sb * 4096 + tid + 512 * i];
            if (tid < 64) nst = p.in[I_SN][sb * 64 + tid];
            m = p.in[I_SM][sb];
        }
        const int nsteps = dir == 0 ? c : nc - 1 - c;
        const bool fin = (grp == 0) && (dir == 0 ? c == nc - 1 : c == 0);
        for (int st = 0; st < nsteps + (fin ? 1 : 0); ++st) {
            const int cc = dir == 0 ? st : nc - 1 - st;
            const float* E = sum + (size_t)(ml_sidx(grp, b, head, cc) * 2 + dir) * MLSUM_STRIDE;
            if (st == nsteps) {
#pragma unroll
                for (int i = 0; i < 8; ++i) { const int e = tid + 512 * i; *(bf16_t*)(CT + dir * ATT_TILE + (e & 63) * LROW + (e >> 6) * 2) = f2bf(C[i]); }
                if (tid < 64) nS[dir * 64 + tid] = nst;
                if (tid == 0) scal[dir] = m;
            }
            const float A = E[4160], G = E[4161];
            const float m_new = fmaxf(A + m, G);
            const float sc = expf(A + m - m_new), su = expf(G - m_new);
#pragma unroll
            for (int i = 0; i < 8; ++i) C[i] = sc * C[i] + su * E[tid + 512 * i];
            if (tid < 64) nst = sc * nst + su * E[4096 + tid];
            m = m_new;
        }
        if (!fin) {
#pragma unroll
            for (int i = 0; i < 8; ++i) { const int e = tid + 512 * i; *(bf16_t*)(CT + dir * ATT_TILE + (e & 63) * LROW + (e >> 6) * 2) = f2bf(C[i]); }
            if (tid < 64) nS[dir * 64 + tid] = nst;
            if (tid == 0) scal[dir] = m;
        } else {
            const size_t ob = (((size_t)b * DEPTH + l) * 2 + dir) * MLH + head;
#pragma unroll
            for (int i = 0; i < 8; ++i) p.out[O_MC + ob * 4096 + tid + 512 * i] = C[i];
            if (tid < 64) p.out[O_MN + ob * 64 + tid] = nst;
            if (tid == 0) p.out[O_MM + ob] = m;
        }
    }
    {
        const int row = tid >> 3, ch = tid & 7;
#pragma unroll
        for (int dir = 0; dir < 2; ++dir) {
            const int tok = tb + (dir ? 63 - row : row);
            const size_t off = (size_t)tok * 256 + head * 64 + ch * 8;
            *(u4v*)(Qs + dir * ATT_TILE + row * LROW + ch * 16) = *(const u4v*)((const bf16_t*)(p.ws + WS_MLQ) + off);
            *(u4v*)(Ks + dir * ATT_TILE + row * LROW + ch * 16) = *(const u4v*)((const bf16_t*)(p.ws + WS_MLK) + off);
            const u4v vv = *(const u4v*)((const bf16_t*)(p.ws + WS_MLV) + off);
#pragma unroll
            for (int j = 0; j < 8; ++j) *(bf16_t*)(VT + dir * ATT_TILE + (ch * 8 + j) * LROW + row * 2) = (bf16_t)(vv[j >> 1] >> (16 * (j & 1)));
        }
    }
    __syncthreads();
    if (wave < 2) {
        const int dir = wave;
        const float* gr = (const float*)(p.ws + WS_GATES) + (size_t)(tb + (dir ? 63 - lane : lane)) * 16;
        const float ig = gr[dir * 8 + head], lf = logsigmoidf_(gr[dir * 8 + 4 + head]);
        const float bj = lane_prefix_sum(lf, lane);
        const float a = ig - bj;
        const float Pj = lane_prefix_max(a, lane);
        aS[dir * 64 + lane] = a; bS[dir * 64 + lane] = bj; MjS[dir * 64 + lane] = fmaxf(scal[dir], Pj);
    } else if (wave < 4) {
        const int dir = wave - 2;
        float s = 0.f;
        for (int k = 0; k < 64; ++k) s += bf2f(*(const bf16_t*)(Qs + dir * ATT_TILE + lane * LROW + k * 2)) * nS[dir * 64 + k];
        qnS[dir * 64 + lane] = s;
    }
    __syncthreads();
    const int dir = wave >> 2, rt = (wave >> 1) & 1, jt = wave & 1;
    const int j = jt * 32 + l31;
    const float Mj = MjS[dir * 64 + j];
    {
        f16v acc = f16zero();
#pragma unroll
        for (int s4 = 0; s4 < 4; ++s4) {
            const s8v af = *(const s8v*)(Ks + dir * ATT_TILE + (rt * 32 + l31) * LROW + (16 * s4 + 8 * h) * 2);
            const s8v bf = *(const s8v*)(Qs + dir * ATT_TILE + j * LROW + (16 * s4 + 8 * h) * 2);
            acc = mfma32(af, bf, acc);
        }
        float dsum = 0.f;
#pragma unroll
        for (int g = 0; g < 4; ++g) {
            float o[4];
#pragma unroll
            for (int q = 0; q < 4; ++q) {
                const int s = rt * 32 + 8 * g + 4 * h + q;
                const float w = s <= j ? expf(aS[dir * 64 + s] - Mj) : 0.f;
                o[q] = acc[4 * g + q] * w; dsum += o[q];
            }
            u2v pk; pk[0] = pack2(o[0], o[1]); pk[1] = pack2(o[2], o[3]);
            *(u2v*)(QK + dir * ATT_TILE + j * LROW + (rt * 32 + 8 * g + 4 * h) * 2) = pk;
        }
        dsum += __shfl_xor(dsum, 32);
        if (h == 0) denp[(dir * 2 + rt) * 64 + j] = dsum;
    }
    __syncthreads();
    {
        const float mst = scal[dir];
        const float decay = expf(mst - Mj);
        f16v acc = f16zero();
#pragma unroll
        for (int s4 = 0; s4 < 4; ++s4) {
            const s8v af = *(const s8v*)(CT + dir * ATT_TILE + (rt * 32 + l31) * LROW + (16 * s4 + 8 * h) * 2);
            const s8v bf = *(const s8v*)(Qs + dir * ATT_TILE + j * LROW + (16 * s4 + 8 * h) * 2);
            acc = mfma32(af, bf, acc);
        }
        acc *= decay;
#pragma unroll
        for (int s4 = 0; s4 < 4; ++s4) {
            const s8v af = *(const s8v*)(VT + dir * ATT_TILE + (rt * 32 + l31) * LROW + (16 * s4 + 8 * h) * 2);
            const s8v bf = *(const s8v*)(QK + dir * ATT_TILE + j * LROW + (16 * s4 + 8 * h) * 2);
            acc = mfma32(af, bf, acc);
        }
        const float den = decay * qnS[dir * 64 + j] + denp[(dir * 2) * 64 + j] + denp[(dir * 2 + 1) * 64 + j];
        const float dn = fmaxf(fabsf(den), expf(-(bS[dir * 64 + j] + Mj)));
        const float inv = 1.f / dn;
#pragma unroll
        for (int g = 0; g < 4; ++g) { f4v o; o[0] = acc[4 * g] * inv; o[1] = acc[4 * g + 1] * inv; o[2] = acc[4 * g + 2] * inv; o[3] = acc[4 * g + 3] * inv;
            *(f4v*)(hS + (dir * 64 + j) * 68 + rt * 32 + 8 * g + 4 * h) = o; }
    }
    __syncthreads();
    {
        const int tau = tid >> 3, v8 = (tid & 7) * 8;
        float hv[8]; float s = 0.f;
#pragma unroll
        for (int q = 0; q < 8; ++q) { hv[q] = hS[tau * 68 + v8 + q] + hS[(64 + 63 - tau) * 68 + v8 + q]; s += hv[q]; }
        s += __shfl_xor(s, 1); s += __shfl_xor(s, 2); s += __shfl_xor(s, 4);
        const float mu = s * (1.f / 64.f);
        float qq = 0.f;
#pragma unroll
        for (int q = 0; q < 8; ++q) { const float dlt = hv[q] - mu; qq += dlt * dlt; }
        qq += __shfl_xor(qq, 1); qq += __shfl_xor(qq, 2); qq += __shfl_xor(qq, 4);
        const float rstd = 1.f / sqrtf(qq * (1.f / 64.f) + EPS);
        const int t = tb + tau;
        const u4v ov = *(const u4v*)((const bf16_t*)(p.ws + WS_MLO) + (size_t)t * 256 + head * 64 + v8);
        const float* ng = p.in[I_MLG] + (size_t)l * 256 + head * 64 + v8;
        float o[8];
#pragma unroll
        for (int q = 0; q < 8; ++q) { const float og = bf2f((bf16_t)(ov[q >> 1] >> (16 * (q & 1)))); o[q] = (hv[q] - mu) * rstd * ng[q] * sigmoidf_(og); }
        u4v pk; pk[0] = pack2(o[0], o[1]); pk[1] = pack2(o[2], o[3]); pk[2] = pack2(o[4], o[5]); pk[3] = pack2(o[6], o[7]);
        *(u4v*)((bf16_t*)(p.ws + WS_MIXED) + (size_t)t * MIXW + 384 + head * 64 + v8) = pk;
    }
    __syncthreads();
}

DEV int queue_next(const Params& p, char* smem, int qi) {
    int* slot = (int*)(smem + SMEM_XB + 32);
    __syncthreads();
    if (threadIdx.x == 0) {
#ifdef EMU
        unsigned* w = (unsigned*)(p.ws + WS_BAR) + QUEUE_WORD0 + 64 * qi; *slot = (int)(*w)++;
#else
        *slot = (int)__hip_atomic_fetch_add((unsigned*)(p.ws + WS_BAR) + QUEUE_WORD0 + 64 * qi, 1u, __ATOMIC_RELAXED, __HIP_MEMORY_SCOPE_AGENT);
#endif
    }
    __syncthreads();
    return *slot;
}
DEV void phase_attn(const Params& p, char* smem, int l, int qi) {
    constexpr int QB_S = DEC_SEQ / 256, QB_P = SEQ / 256;
    constexpr int U_SG = DEC_BATCH * GQH * QB_S * 2, U_SN = DEC_BATCH * NAH * QB_S, U_PN = BATCH * NAH * QB_P, U_PG = BATCH * GQH * QB_P;
    constexpr int U_MP = BATCH * MLH * NCH_P, U_MS = DEC_BATCH * MLH * NCH_S;
    constexpr int NU = U_SG + U_SN + U_PN + U_PG + U_MP + U_MS;
    const bf16_t* naq = (const bf16_t*)(p.ws + WS_NAQ); const bf16_t* nak = (const bf16_t*)(p.ws + WS_NAK); const bf16_t* nav = (const bf16_t*)(p.ws + WS_NAV);
    const bf16_t* gqq = (const bf16_t*)(p.ws + WS_GQQ); const bf16_t* gqk = (const bf16_t*)(p.ws + WS_GQK); const bf16_t* gqv = (const bf16_t*)(p.ws + WS_GQV);
    bf16_t* mixed = (bf16_t*)(p.ws + WS_MIXED);
    for (;;) {
        int u = queue_next(p, smem, qi);
        if (u >= NU) break;
        AttnDesc d; d.na = 0; d.r0 = 0; d.rlo = 0; d.rpb = nullptr; d.part = nullptr; d.out = nullptr; d.ostride = MIXW; d.n0 = 0; d.k0 = d.v0 = nullptr; d.stride0 = 0;
        if (u < U_SG) {
            const int half = u & 1, qb = (u >> 1) % QB_S, qh = (u / (2 * QB_S)) % GQH, b = u / (2 * QB_S * GQH);
            const int kvh = qh / (GQH / GQKV);
            constexpr int NCT = PAST / 64, TT = NCT + DEC_SEQ / 64, H0 = TT / 2;
            const size_t tq = (size_t)NP + (size_t)b * DEC_SEQ + qb * 256;
            d.q = gqq + tq * 384 + qh * 64; d.qstride = 384;
            const bf16_t* lk = gqk + ((size_t)NP + (size_t)b * DEC_SEQ) * 128 + kvh * 64; const bf16_t* lv = gqv + ((size_t)NP + (size_t)b * DEC_SEQ) * 128 + kvh * 64;
            if (half == 0) {
                d.n0 = NCT; d.ntiles = H0; d.stride0 = 128;
                const size_t co = (((size_t)b * DEPTH + l) * PAST) * 128 + kvh * 64;
                d.k0 = (const bf16_t*)(p.ws + WS_CGQK) + co; d.v0 = (const bf16_t*)(p.ws + WS_CGQV) + co;
                d.k1 = lk; d.v1 = lv; d.stride1 = 128;
            } else {
                d.n0 = 0; d.ntiles = TT - H0; d.stride1 = 128;
                d.k1 = lk + (size_t)(H0 - NCT) * 64 * 128; d.v1 = lv + (size_t)(H0 - NCT) * 64 * 128;
            }
            d.part = (float*)(p.ws + WS_PART) + (size_t)u * PART_STRIDE;
        } else if (u < U_SG + U_SN) {
            const int uu = u - U_SG; const int qb = uu % QB_S, hd = (uu / QB_S) % NAH, b = uu / (QB_S * NAH);
            const size_t t0 = (size_t)NP + (size_t)b * DEC_SEQ;
            d.q = naq + (t0 + qb * 256) * 384 + hd * 64; d.qstride = 384;
            d.na = 1; d.r0 = qb * 4; d.rlo = na_row_start(d.r0);
            const int rhi = na_row_start(d.r0 + 3) + KR;
            d.n0 = PAST / 64; d.ntiles = d.n0 + (rhi - d.rlo); d.stride0 = 384; d.stride1 = 384;
            const size_t co = (((size_t)b * DEPTH + l) * PAST) * 384 + hd * 64;
            d.k0 = (const bf16_t*)(p.ws + WS_CNAK) + co; d.v0 = (const bf16_t*)(p.ws + WS_CNAV) + co;
            d.k1 = nak + (t0 + (size_t)d.rlo * 64) * 384 + hd * 64; d.v1 = nav + (t0 + (size_t)d.rlo * 64) * 384 + hd * 64;
            d.rpb = p.in[I_RPB] + ((size_t)l * NAH + hd) * 15 * 31;
            d.out = mixed + (t0 + qb * 256) * MIXW + hd * 64;
        } else if (u < U_SG + U_SN + U_PN) {
            const int uu = u - U_SG - U_SN; const int qb = uu % QB_P, hd = (uu / QB_P) % NAH, b = uu / (QB_P * NAH);
            const size_t t0 = (size_t)b * SEQ;
            d.q = naq + (t0 + qb * 256) * 384 + hd * 64; d.qstride = 384;
            d.n0 = 0; d.ntiles = SEQ / 64; d.stride1 = 384; d.k1 = nak + t0 * 384 + hd * 64; d.v1 = nav + t0 * 384 + hd * 64;
            d.out = mixed + (t0 + qb * 256) * MIXW + hd * 64;
        } else if (u < U_SG + U_SN + U_PN + U_PG) {
            const int uu = u - U_SG - U_SN - U_PN; const int qb = uu % QB_P, qh = (uu / QB_P) % GQH, b = uu / (QB_P * GQH);
            const int kvh = qh / (GQH / GQKV);
            const size_t t0 = (size_t)b * SEQ;
            d.q = gqq + (t0 + qb * 256) * 384 + qh * 64; d.qstride = 384;
            d.n0 = 0; d.ntiles = SEQ / 64; d.stride1 = 128; d.k1 = gqk + t0 * 128 + kvh * 64; d.v1 = gqv + t0 * 128 + kvh * 64;
            d.out = mixed + (t0 + qb * 256) * MIXW + 640 + qh * 64;
        } else {
            int uu = u - (U_SG + U_SN + U_PN + U_PG); const int grp = uu >= U_MP ? 1 : 0; if (grp) uu -= U_MP;
            const int nch = grp ? NCH_S : NCH_P;
            mlstm_summary_unit(p, smem, grp, uu / (nch * MLH), (uu / nch) % MLH, uu % nch);
        }
        if (u < U_SG + U_SN + U_PN + U_PG) attn_unit(smem, d);
    }
}

DEV void phase_mlout(const Params& p, char* smem, int l) {
    constexpr int QB_S = DEC_SEQ / 256;
    constexpr int U_MS = DEC_BATCH * MLH * NCH_S, U_MP = BATCH * MLH * NCH_P, U_CB = DEC_BATCH * GQH * QB_S;
    const int tid = get_tid();
    for (int u = blockIdx.x; u < U_MS + U_MP + U_CB; u += gridDim.x) {
        if (u < U_MS + U_MP) { const int grp = u < U_MS ? 1 : 0; const int uu = grp ? u : u - U_MS; const int nch = grp ? NCH_S : NCH_P;
            mlstm_output_unit(p, smem, l, grp, uu / (nch * MLH), (uu / nch) % MLH, uu % nch); }
        else {
            const int uu = u - U_MS - U_MP; const int qb = uu % QB_S, qh = (uu / QB_S) % GQH, b = uu / (QB_S * GQH);
            const float* p0 = (const float*)(p.ws + WS_PART) + (size_t)(2 * uu) * PART_STRIDE; const float* p1 = p0 + PART_STRIDE;
            const int q = tid >> 1, d0 = (tid & 1) * 32;
            const float m0 = p0[256 * 64 + q], m1 = p1[256 * 64 + q], l0 = p0[256 * 64 + 256 + q], l1 = p1[256 * 64 + 256 + q];
            const float m = fmaxf(m0, m1), w0 = expf(m0 - m), w1 = expf(m1 - m);
            const float inv = 1.f / (l0 * w0 + l1 * w1);
            bf16_t* dst = (bf16_t*)(p.ws + WS_MIXED) + ((size_t)NP + (size_t)b * DEC_SEQ + qb * 256 + q) * MIXW + 640 + qh * 64 + d0;
#pragma unroll
            for (int i = 0; i < 8; ++i) {
                const f4v a = *(const f4v*)(p0 + (size_t)q * 64 + d0 + 4 * i), bb = *(const f4v*)(p1 + (size_t)q * 64 + d0 + 4 * i);
                u2v pk; pk[0] = pack2((a[0] * w0 + bb[0] * w1) * inv, (a[1] * w0 + bb[1] * w1) * inv); pk[1] = pack2((a[2] * w0 + bb[2] * w1) * inv, (a[3] * w0 + bb[3] * w1) * inv);
                *(u2v*)(dst + 4 * i) = pk;
            }
        }
    }
}

constexpr int N_PHASES = 2 + 9 * DEPTH;
#ifndef EMU
typedef const __attribute__((address_space(4))) Params* KParamsPtr;
DEV void load_params(Params& p) {
    KParamsPtr kp = (KParamsPtr)__builtin_amdgcn_kernarg_segment_ptr();
    asm volatile("" : "+s"(kp));
#pragma unroll
    for (int i = 0; i < N_IN; ++i) p.in[i] = kp->in[i];
    p.out = kp->out; p.ws = kp->ws; p.ph0 = kp->ph0; p.ph1 = kp->ph1;
}
#endif
#ifdef EMU
static char emu_smem[SMEM_BYTES + 64];
#endif
__global__ void __launch_bounds__(512, 2) mega_kernel(Params p_) {
    const int ph0 = p_.ph0, ph1 = p_.ph1;
#ifdef EMU
    char* smem = emu_smem;
#define GRID_SYNC() do {} while (0)
#else
    extern __shared__ __attribute__((aligned(16))) char smem[];
    if (threadIdx.x == 0) *(u4v*)(smem + SMEM_XB) = (u4v){0u, 0u, 0u, 0u};
    __syncthreads();
    (void)xcd_barrier_post((unsigned*)(p_.ws + WS_BAR), (volatile LAS unsigned*)(smem + SMEM_XB));
    const bool multi = (ph1 - ph0) > 1;
#define GRID_SYNC() do { if (multi) { KParamsPtr kpb = (KParamsPtr)__builtin_amdgcn_kernarg_segment_ptr(); asm volatile("" : "+s"(kpb)); \
        XcdBarrier xb; xb.bar = (unsigned*)(kpb->ws + WS_BAR); xb.x = xb_xcc_id(); xb.st = (volatile LAS unsigned*)(smem + SMEM_XB); xcd_barrier(xb); } } while (0)
#endif
    int ph = 0;
#ifndef KIND_MASK
#define KIND_MASK 0x3ff
#endif
#ifdef EMU
#define LOAD_PARAMS() const Params& p = p_
#else
#define LOAD_PARAMS() Params p; load_params(p)
#endif
#ifndef DOUBLE_MASK
#define DOUBLE_MASK 0
#endif
#define PH_KIND() (ph == 0 ? 0 : ph == 1 + 9 * DEPTH ? 1 : 1 + (ph - 1) % 9)
#define RUN_PHASE(body) do { if (((KIND_MASK >> PH_KIND()) & 1) && ph >= ph0 && ph < ph1) { \
    if (DOUBLE_MASK && ((DOUBLE_MASK >> PH_KIND()) & 1)) { { const int rep_ = 1; LOAD_PARAMS(); body; } GRID_SYNC(); } \
    { const int rep_ = 0; LOAD_PARAMS(); body; } if (ph + 1 < ph1) GRID_SYNC(); } ++ph; } while (0)
    RUN_PHASE(phase_ada(p, smem));
    for (int l = 0; l < DEPTH; ++l) {
        RUN_PHASE(phase_rows<0>(p, smem, l));
        RUN_PHASE(phase_inproj<0>(p, smem, l));
        RUN_PHASE(phase_attn(p, smem, l, l + DEPTH * rep_));
        RUN_PHASE(phase_mlout(p, smem, l));
        RUN_PHASE(phase_outproj<0>(p, smem, l));
        RUN_PHASE(phase_rows<1>(p, smem, l));
        RUN_PHASE(phase_topk(p, smem));
        RUN_PHASE(phase_gateup<0>(p, smem, l));
        RUN_PHASE(phase_down<0>(p, smem, l));
    }
    RUN_PHASE(phase_rows<0>(p, smem, DEPTH));
}

#if !defined(EMU) && defined(PROBE_KIND)
__global__ void __launch_bounds__(512, 2) probe_kernel(Params p) {
    extern __shared__ __attribute__((aligned(16))) char smem[];
    for (int r = 0; r < PROBE_REPS; ++r) {
#if PROBE_KIND == 8
        phase_gateup<PROBE_VAR>(p, smem, 1);
#elif PROBE_KIND == 9
        phase_down<PROBE_VAR>(p, smem, 1);
#elif PROBE_KIND == 2
        phase_inproj<PROBE_VAR>(p, smem, 1);
#elif PROBE_KIND == 5
        phase_outproj<PROBE_VAR>(p, smem, 1);
#elif PROBE_KIND == 0
        phase_ada(p, smem);
#elif PROBE_KIND == 1
        phase_rows<0>(p, smem, 1);
#elif PROBE_KIND == 6
        phase_rows<1>(p, smem, 1);
#elif PROBE_KIND == 7
        phase_topk(p, smem);
#elif PROBE_KIND == 3
        phase_attn(p, smem, 1, 8 + r);
#elif PROBE_KIND == 4
        phase_mlout(p, smem, 1);
#endif
        __syncthreads();
    }
}
#endif
#ifndef EMU
#ifndef MK_N_LAUNCHES
#define MK_N_LAUNCHES 1
#endif
extern "C" void kernel_launch(void* const* d_in, const int* in_sizes, int n_in, void* d_out, int out_size, void* d_ws, size_t ws_size, hipStream_t stream) {
    (void)in_sizes; (void)n_in; (void)out_size; (void)ws_size;
    static int grid = 0;
    if (!grid) {
        int dev = 0, cus = 0, per_cu = 0;
        (void)hipGetDevice(&dev);
        (void)hipDeviceGetAttribute(&cus, hipDeviceAttributeMultiprocessorCount, dev);
        (void)hipFuncSetAttribute((const void*)mega_kernel, hipFuncAttributeMaxDynamicSharedMemorySize, SMEM_BYTES);
        (void)hipOccupancyMaxActiveBlocksPerMultiprocessor(&per_cu, mega_kernel, 512, SMEM_BYTES);
        grid = cus * (per_cu < 1 ? per_cu : 1);
        if (grid <= 0) grid = cus;
    }
    (void)hipMemsetAsync((char*)d_ws + WS_BAR, 0, WS_BAR_BYTES, stream);
    Params p = {};
    for (int i = 0; i < N_IN; ++i) p.in[i] = (const float*)d_in[i];
    p.out = (float*)d_out; p.ws = (char*)d_ws;
#if MK_N_LAUNCHES == 1
    p.ph0 = 0; p.ph1 = N_PHASES;
    mega_kernel<<<dim3(grid), dim3(512), SMEM_BYTES, stream>>>(p);
#ifdef PROBE_KIND
    (void)hipFuncSetAttribute((const void*)probe_kernel, hipFuncAttributeMaxDynamicSharedMemorySize, SMEM_BYTES);
    probe_kernel<<<dim3(grid), dim3(512), SMEM_BYTES, stream>>>(p);
#endif
#else
    for (int ph = 0; ph < N_PHASES; ++ph) { p.ph0 = ph; p.ph1 = ph + 1; mega_kernel<<<dim3(grid), dim3(512), SMEM_BYTES, stream>>>(p); }
#endif
}
#endif
```

```cpp
#ifndef EMU
#include <hip/hip_runtime.h>
#define DEV __device__ __forceinline__
#else
#define DEV static inline __attribute__((always_inline))
#endif
#include <stdint.h>
#include <stddef.h>

#ifndef CFG_D
#define CFG_D 1024
#define CFG_BATCH 16
#define CFG_SEQ 256
#define CFG_DEC_BATCH 2
#define CFG_DEC_SEQ 2048
#define CFG_PAST 256
#define CFG_EH 2816
#endif
constexpr int D = CFG_D, BATCH = CFG_BATCH, SEQ = CFG_SEQ, DEC_BATCH = CFG_DEC_BATCH, DEC_SEQ = CFG_DEC_SEQ, PAST = CFG_PAST, EH = CFG_EH;
constexpr int DEPTH = 2, HD = 64, NAH = 6, MLH = 4, GQH = 6, GQKV = 2, NEXP = 16, GRIDW = 64;
constexpr int NP = BATCH * SEQ, NS = DEC_BATCH * DEC_SEQ, NT = NP + NS, NCOND = 1 + DEC_BATCH;
constexpr int PROJ_W = 2832, MIXW = 1024;
constexpr int CAP_P = SEQ / 8, CAP_S = DEC_SEQ / 8, SLOTS = BATCH * CAP_P + DEC_BATCH * CAP_S;
constexpr int ROWS = DEC_SEQ / GRIDW, KR = ROWS < 8 ? ROWS : 8, KC = 16;
constexpr int NCH_P = SEQ / 64, NCH_S = DEC_SEQ / 64;
constexpr float ALPHA = 1.41421356237309515f;
constexpr float ATT_SCALE = 0.125f;
constexpr float EPS = 1e-6f;
static_assert(SLOTS % 256 == 0 && NP % 256 == 0 && NS % 256 == 0 && SEQ % 256 == 0 && DEC_SEQ % 256 == 0, "tile divisibility");
static_assert(D % 256 == 0 && EH % 128 == 0 && PAST % 64 == 0, "tile divisibility");

typedef unsigned short bf16_t;
typedef short s8v __attribute__((ext_vector_type(8)));
typedef short s4v __attribute__((ext_vector_type(4)));
typedef float f16v __attribute__((ext_vector_type(16)));
typedef float f4v __attribute__((ext_vector_type(4)));
typedef unsigned u4v __attribute__((ext_vector_type(4)));
typedef unsigned u2v __attribute__((ext_vector_type(2)));

enum { I_XP = 0, I_XS, I_C, I_CNAK, I_CNAV, I_CGQK, I_CGQV, I_SC, I_SN, I_SM, I_CCTX, I_ADAW, I_ADAB, I_WIN, I_BGATE, I_WOUT, I_RPB, I_QKG, I_MLG,
       I_LNG, I_LNB, I_RW, I_WG, I_WU, I_WD, N_IN };

constexpr size_t O_YP = 0;
constexpr size_t O_YS = O_YP + (size_t)NP * D;
constexpr size_t O_NAK = O_YS + (size_t)NS * D;
constexpr size_t O_NAV = O_NAK + (size_t)BATCH * DEPTH * SEQ * NAH * HD;
constexpr size_t O_GQK = O_NAV + (size_t)BATCH * DEPTH * SEQ * NAH * HD;
constexpr size_t O_GQV = O_GQK + (size_t)BATCH * DEPTH * SEQ * GQKV * HD;
constexpr size_t O_MC = O_GQV + (size_t)BATCH * DEPTH * SEQ * GQKV * HD;
constexpr size_t O_MN = O_MC + (size_t)BATCH * DEPTH * 2 * MLH * HD * HD;
constexpr size_t O_MM = O_MN + (size_t)BATCH * DEPTH * 2 * MLH * HD;
constexpr size_t O_END = O_MM + (size_t)BATCH * DEPTH * 2 * MLH;

constexpr size_t al256(size_t x) { return (x + 255) & ~(size_t)255; }
constexpr size_t WS_BAR = 0;
constexpr size_t WS_BAR_BYTES = 32768;
constexpr size_t WS_MODS = WS_BAR + WS_BAR_BYTES;
constexpr size_t WS_ROPE = al256(WS_MODS + (size_t)DEPTH * NCOND * 6 * D * 4);
constexpr size_t WS_CNAK = al256(WS_ROPE + 64 * 16 * 2 * 4);
constexpr size_t WS_CNAV = al256(WS_CNAK + (size_t)DEC_BATCH * DEPTH * PAST * NAH * HD * 2);
constexpr size_t WS_CGQK = al256(WS_CNAV + (size_t)DEC_BATCH * DEPTH * PAST * NAH * HD * 2);
constexpr size_t WS_CGQV = al256(WS_CGQK + (size_t)DEC_BATCH * DEPTH * PAST * GQKV * HD * 2);
constexpr size_t WS_XBUF = al256(WS_CGQV + (size_t)DEC_BATCH * DEPTH * PAST * GQKV * HD * 2);
constexpr size_t WS_HMOD = al256(WS_XBUF + (size_t)NT * D * 4);
constexpr size_t WS_GATES = al256(WS_HMOD + (size_t)NT * D * 2);
constexpr size_t WS_NAQ = al256(WS_GATES + (size_t)NT * 16 * 4);
constexpr size_t WS_NAK = al256(WS_NAQ + (size_t)NT * 384 * 2);
constexpr size_t WS_NAV = al256(WS_NAK + (size_t)NT * 384 * 2);
constexpr size_t WS_MLQ = al256(WS_NAV + (size_t)NT * 384 * 2);
constexpr size_t WS_MLK = al256(WS_MLQ + (size_t)NT * 256 * 2);
constexpr size_t WS_MLV = al256(WS_MLK + (size_t)NT * 256 * 2);
constexpr size_t WS_MLO = al256(WS_MLV + (size_t)NT * 256 * 2);
constexpr size_t WS_GQQ = al256(WS_MLO + (size_t)NT * 256 * 2);
constexpr size_t WS_GQK = al256(WS_GQQ + (size_t)NT * 384 * 2);
constexpr size_t WS_GQV = al256(WS_GQK + (size_t)NT * 128 * 2);
constexpr size_t WS_MIXED = al256(WS_GQV + (size_t)NT * 128 * 2);
constexpr size_t WS_U = al256(WS_MIXED + (size_t)NT * MIXW * 2);
constexpr size_t WS_X1 = al256(WS_U + (size_t)NT * D * 4);
constexpr size_t WS_H2 = al256(WS_X1 + (size_t)NT * D * 4);
constexpr size_t WS_AFF = al256(WS_H2 + (size_t)NT * D * 2);
constexpr size_t WS_IDX = al256(WS_AFF + (size_t)NT * 16 * 4);
constexpr size_t WS_GSEL = al256(WS_IDX + (size_t)NEXP * SLOTS * 4);
constexpr size_t WS_TOKSLOT = al256(WS_GSEL + (size_t)NEXP * SLOTS * 4);
constexpr size_t WS_HID = al256(WS_TOKSLOT + (size_t)NT * 16 * 4);
constexpr size_t WS_YE = al256(WS_HID + (size_t)NEXP * SLOTS * EH * 2);
constexpr int MLSUM_STRIDE = 4096 + 64 + 64;
constexpr int N_MLSUM = (BATCH * NCH_P + DEC_BATCH * NCH_S) * MLH * 2;
constexpr size_t WS_MLSUM = al256(WS_YE + (size_t)NEXP * SLOTS * D * 4);
constexpr int PART_STRIDE = 256 * 64 + 512;
constexpr int N_PART = DEC_BATCH * GQH * (DEC_SEQ / 256) * 2;
constexpr size_t WS_PART = al256(WS_MLSUM + (size_t)N_MLSUM * MLSUM_STRIDE * 4);
constexpr size_t WS_TOTAL = al256(WS_PART + (size_t)N_PART * PART_STRIDE * 4);

struct Params {
    const float* in[N_IN];
    float* out;
    char* ws;
    int ph0, ph1;
};

DEV float bf2f(bf16_t s) { unsigned u = ((unsigned)s) << 16; return __builtin_bit_cast(float, u); }
DEV bf16_t f2bf(float f) {
#ifdef EMU
    unsigned u = __builtin_bit_cast(unsigned, f); u += 0x7fffu + ((u >> 16) & 1u); return (bf16_t)(u >> 16);
#else
    return __builtin_bit_cast(bf16_t, (__bf16)f);
#endif
}
DEV unsigned pack2(float a, float b) {
#ifdef EMU
    return (unsigned)f2bf(a) | ((unsigned)f2bf(b) << 16);
#else
    typedef __bf16 b2 __attribute__((ext_vector_type(2))); b2 r; r[0] = (__bf16)a; r[1] = (__bf16)b; return __builtin_bit_cast(unsigned, r);
#endif
}
DEV float fexp(float x) {
#ifdef EMU
    return expf(x);
#else
    return __expf(x);
#endif
}
DEV float sigmoidf_(float x) { return 1.f / (1.f + fexp(-x)); }
DEV float siluf_(float x) { return x / (1.f + fexp(-x)); }
DEV float logsigmoidf_(float x) { return fminf(x, 0.f) - log1pf(expf(-fabsf(x))); }
DEV f16v mfma32(s8v a, s8v b, f16v c) {
#ifdef EMU
    return emu_mfma_32x32x16_bf16(a, b, c);
#else
    typedef __bf16 bf8 __attribute__((ext_vector_type(8)));
    return __builtin_amdgcn_mfma_f32_32x32x16_bf16(__builtin_bit_cast(bf8, a), __builtin_bit_cast(bf8, b), c, 0, 0, 0);
#endif
}
DEV s4v lds_tr16(const void* p) {
#ifdef EMU
    return emu_ds_read_tr16_b64(p);
#else
    typedef s4v __attribute__((address_space(3))) * lp;
    return __builtin_amdgcn_ds_read_tr16_b64_v4i16((lp)(p));
#endif
}
#ifdef EMU
DEV float wave_sum(float v) { for (int m = 32; m >= 1; m >>= 1) v += __shfl_xor(v, m); return v; }
#else
template <int CTRL, int RM> DEV float dpp_f(float v) { return __builtin_bit_cast(float, __builtin_amdgcn_update_dpp(0, __builtin_bit_cast(int, v), CTRL, RM, 0xF, false)); }
DEV float wave_sum(float v) {
    v += dpp_f<0xB1, 0xF>(v); v += dpp_f<0x4E, 0xF>(v); v += dpp_f<0x141, 0xF>(v); v += dpp_f<0x140, 0xF>(v);
    v += dpp_f<0x142, 0xA>(v); v += dpp_f<0x143, 0xC>(v);
    return __builtin_bit_cast(float, __builtin_amdgcn_readlane(__builtin_bit_cast(int, v), 63));
}
#endif
DEV float wave_max(float v) { for (int m = 32; m >= 1; m >>= 1) v = fmaxf(v, __shfl_xor(v, m)); return v; }
DEV f16v f16zero() { f16v z; for (int i = 0; i < 16; ++i) z[i] = 0.f; return z; }

#ifdef EMU
#define SGPR_PIN(x) do {} while (0)
#define SCHED_FENCE() do {} while (0)
#define CFENCE() do {} while (0)
#else
#define SCHED_FENCE() __builtin_amdgcn_sched_barrier(0)
#define SGPR_PIN(x) asm volatile("" : "+s"(x))
#define CFENCE() asm volatile("" ::: "memory")
#endif
#ifdef EMU
DEV int get_tid() { return (int)threadIdx.x; }
#else
DEV int get_tid() { int t = threadIdx.x; asm volatile("" : "+v"(t)); return t; }
#endif
struct UnitIter { int i, end, step; };
DEV UnitIter unit_iter(int NU) {
    const int G = (int)gridDim.x, b = (int)blockIdx.x;
    UnitIter it;
#ifndef XCD_MODE
#define XCD_MODE 0
#endif
    if ((G & 7) == 0 && (NU & 7) == 0) { const int W = G >> 3, x = XCD_MODE ? b / W : b & 7, j = XCD_MODE ? b % W : b >> 3, C = NU >> 3; it.i = x * C + j; it.end = (x + 1) * C; it.step = W; }
    else { it.i = b; it.end = NU; it.step = G; }
    return it;
}
DEV int tok_cond(int t) { return t < NP ? 0 : 1 + (t - NP) / DEC_SEQ; }

#ifndef EMU
#define XB_TMO      128
#define XB_XCNT(j)  (256  + 64 * (j))
#define XB_XSUB(j)  (1280 + 64 * (j))
#define XB_XGEN(j)  (2304 + 64 * (j))
#define XB_TOP      3328
#define XB_TOPGEN   3392
#define XCD_BAR_WORDS 3456
#define XB_SPIN_CAP (1u << 20)
#define LAS __attribute__((address_space(3)))
__device__ __forceinline__ unsigned xb_ld(unsigned* p)              { return __hip_atomic_load(p, __ATOMIC_RELAXED, __HIP_MEMORY_SCOPE_AGENT); }
__device__ __forceinline__ unsigned xb_add(unsigned* p, unsigned v) { return __hip_atomic_fetch_add(p, v, __ATOMIC_RELAXED, __HIP_MEMORY_SCOPE_AGENT); }
__device__ __forceinline__ unsigned xb_xcc_id() { return (unsigned)__builtin_amdgcn_s_getreg((3 << 11) | 20) & 0xFu; }
#define XB_SPIN(cond, bar) do { unsigned _sp = 0; while (cond) { __builtin_amdgcn_s_sleep(1); \
    if ((++_sp & 255u) == 0u) { if (xb_ld(&(bar)[XB_TMO])) break; if (_sp > XB_SPIN_CAP) { atomicAdd(&(bar)[XB_TMO], 1u); break; } } } } while (0)
struct XcdBarrier { unsigned* bar; unsigned x; volatile LAS unsigned* st; };
__device__ __forceinline__ XcdBarrier xcd_barrier_post(unsigned* bar, volatile LAS unsigned* st) {
    XcdBarrier b; b.bar = bar; b.x = xb_xcc_id(); b.st = st;
    if (threadIdx.x == 0) (void)xb_add(&bar[XB_XCNT(b.x)], 1u);
    return b;
}
__device__ __forceinline__ void xcd_barrier_complete(unsigned* bar, unsigned x, unsigned& nloc, unsigned& nx) {
    const unsigned G = gridDim.x * gridDim.y * gridDim.z;
    unsigned sum, cnt, mine, sp = 0u;
    for (;;) {
        sum = 0u; cnt = 0u; mine = 0u;
#pragma unroll
        for (unsigned j = 0; j < 16; ++j) { const unsigned c = xb_ld(&bar[XB_XCNT(j)]); sum += c; cnt += (c > 0u) ? 1u : 0u; mine = (j == x) ? c : mine; }
        if (sum == G) break;
        __builtin_amdgcn_s_sleep(1);
        if ((++sp & 255u) == 0u) { if (xb_ld(&bar[XB_TMO])) break; if (sp > XB_SPIN_CAP) { atomicAdd(&bar[XB_TMO], 1u); break; } }
    }
    nloc = mine > 0u ? mine : 1u; nx = cnt > 0u ? cnt : 1u;
}
__device__ __forceinline__ void xcd_barrier(const XcdBarrier& b) {
    asm volatile("s_waitcnt vmcnt(0)" ::: "memory");
    __syncthreads();
    if (threadIdx.x == 0) {
        unsigned* bar = b.bar;
        __builtin_amdgcn_s_waitcnt(0);
        unsigned nloc = b.st[0], nx = b.st[1];
        if (nloc == 0u) { xcd_barrier_complete(bar, b.x, nloc, nx); b.st[0] = nloc; b.st[1] = nx; }
        const unsigned old = xb_add(&bar[XB_XSUB(b.x)], 1u);
        const unsigned gen = old / nloc;
        if (old + 1u == (gen + 1u) * nloc) {
            __builtin_amdgcn_fence(__ATOMIC_RELEASE, "agent");
            asm volatile("s_waitcnt vmcnt(0)" ::: "memory");
            const unsigned og = xb_add(&bar[XB_TOP], 1u);
            const unsigned tg = og / nx;
            if (og + 1u == (tg + 1u) * nx) xb_add(&bar[XB_TOPGEN], 1u);
            else XB_SPIN(xb_ld(&bar[XB_TOPGEN]) == tg, bar);
            __builtin_amdgcn_fence(__ATOMIC_ACQUIRE, "agent");
            xb_add(&bar[XB_XGEN(b.x)], 1u);
            asm volatile("s_waitcnt vmcnt(0)" ::: "memory");
        } else {
            XB_SPIN(xb_ld(&bar[XB_XGEN(b.x)]) == gen, bar);
            __builtin_amdgcn_fence(__ATOMIC_ACQUIRE, "agent");
            asm volatile("s_waitcnt vmcnt(0)" ::: "memory");
        }
    }
    __syncthreads();
}
#endif
constexpr int QUEUE_WORD0 = 4096;

constexpr int LROW = 144;
constexpr int GEMM_AS = 256 * LROW;
constexpr int GEMM_BS = 64 * (256 * 2 + 64);
constexpr int SMEM_BYTES = 2 * GEMM_AS + 2 * GEMM_BS + 64;
constexpr int SMEM_XB = 2 * GEMM_AS + 2 * GEMM_BS;

#ifdef EMU
struct BufRsrc { const char* base; };
DEV BufRsrc make_rsrc(const void* p) { BufRsrc r; r.base = (const char*)p; return r; }
DEV float buf_load_f32(BufRsrc r, unsigned voff, unsigned soff) { return *(const float*)(r.base + voff + soff); }
DEV u4v buf_load_b128(BufRsrc r, unsigned voff, unsigned soff) { return *(const u4v*)(r.base + voff + soff); }
#else
typedef __amdgpu_buffer_rsrc_t BufRsrc;
DEV BufRsrc make_rsrc(const void* p) { return __builtin_amdgcn_make_buffer_rsrc((void*)p, 0, 0x7fffffff, 0x00020000); }
DEV float buf_load_f32(BufRsrc r, unsigned voff, unsigned soff) { return __builtin_bit_cast(float, __builtin_amdgcn_raw_buffer_load_b32(r, voff, soff, 0)); }
DEV u4v buf_load_b128(BufRsrc r, unsigned voff, unsigned soff) { return __builtin_amdgcn_raw_buffer_load_b128(r, voff, soff, 0); }
#endif
template <int NTW, int VAR, class Epi>
DEV void gemm_tile(char* smem, BufRsrc ars, unsigned ao0, unsigned ao1, unsigned ao2, unsigned ao3,
                   BufRsrc brs, unsigned bvo, unsigned blds, unsigned ldb4, int K, Epi&& epi) {
    constexpr int BN = 64 * NTW, NLD = 2 * NTW, KSTEP = 64 / NLD, RSB = BN * 2 + 64;
    const int tid = get_tid(), lane = tid & 63, wave = tid >> 6, wm = wave & 3, wn = wave >> 2, h = lane >> 5, l31 = lane & 31;
    char* As = smem; char* Bs = smem + 2 * GEMM_AS;
    constexpr int BSZ = 64 * RSB;
    const int ar = tid >> 3, ac = tid & 7;
    u4v areg[2]; f4v b0[NLD], b1[NLD];
    if (VAR & 3) { for (int i = 0; i < 2; ++i) areg[i] = (u4v){1u, 2u, 3u, 4u}; for (int j = 0; j < NLD; ++j) { b0[j] = (f4v){1.f, 1.f, 1.f, 1.f}; b1[j] = (f4v){2.f, 2.f, 2.f, 2.f}; } }
    f16v acc[NTW][2];
#pragma unroll
    for (int i = 0; i < NTW; ++i) { acc[i][0] = f16zero(); acc[i][1] = f16zero(); }
    auto gloadA = [&](int k0, bool real, int half) {
        if (VAR & 2) return;
        const unsigned so = real ? k0 * 2 : 0u;
        areg[0] = buf_load_b128(ars, real ? (half ? ao2 : ao0) : 0u, so); areg[1] = buf_load_b128(ars, real ? (half ? ao3 : ao1) : 0u, so);
    };
    auto gloadB = [&](int k0, bool real, f4v (&br)[NLD]) {
        if (VAR & 1) return;
        const unsigned vo = real ? bvo : 0u; const int kk = real ? k0 : 0;
        unsigned so = (unsigned)kk * ldb4;
#pragma unroll
        for (int j = 0; j < NLD; ++j) { br[j] = __builtin_bit_cast(f4v, buf_load_b128(brs, vo, so)); so += KSTEP * ldb4; SGPR_PIN(so); }
    };
    auto lstoreA = [&](int buf, int half) {
        if (VAR & 16) return;
        char* ab = As + buf * GEMM_AS + (ar + half * 128) * LROW + ac * 16;
        *(u4v*)(ab) = areg[0]; *(u4v*)(ab + 64 * LROW) = areg[1];
    };
    auto lstoreB = [&](int buf, const f4v (&br)[NLD]) {
        if (VAR & 16) return;
        char* bb = Bs + buf * BSZ + blds;
#pragma unroll
        for (int j = 0; j < NLD; ++j) { u2v v; v[0] = pack2(br[j][0], br[j][1]); v[1] = pack2(br[j][2], br[j][3]); *(u2v*)(bb + j * KSTEP * RSB) = v; }
    };
    const unsigned btr = (unsigned)(8 * h + ((lane & 15) >> 2)) * RSB + (unsigned)((((lane >> 4) & 1) * 16 + 4 * (lane & 3)) * 2) + (unsigned)(wn * NTW * 32) * 2;
    const unsigned atr = (unsigned)(wm * 64 + l31) * LROW + h * 16;
    auto rdw = [&](int buf, int s, int ft) -> s8v {
        const char* bb = Bs + buf * BSZ + btr + s * 16 * RSB + ft * 64;
        const s4v lo = lds_tr16(bb), hi = lds_tr16(bb + 4 * RSB);
        s8v wf; wf[0] = lo[0]; wf[1] = lo[1]; wf[2] = lo[2]; wf[3] = lo[3]; wf[4] = hi[0]; wf[5] = hi[1]; wf[6] = hi[2]; wf[7] = hi[3];
        return wf;
    };
    auto compute2 = [&](int buf, int s0) {
        if (VAR & 8) return;
        const char* ab = As + buf * GEMM_AS + atr;
        s8v xa[2];
        xa[0] = *(const s8v*)(ab + s0 * 32); xa[1] = *(const s8v*)(ab + 32 * LROW + s0 * 32);
        s8v wcur = rdw(buf, s0, 0);
#pragma unroll
        for (int g = 0; g < 2 * NTW; ++g) {
            const int ft = g % NTW;
            s8v wnext = wcur;
            if (g + 1 < 2 * NTW) wnext = rdw(buf, s0 + (g + 1) / NTW, (g + 1) % NTW);
            if (VAR & 4) { acc[ft][0][0] += __builtin_bit_cast(float, (int)wcur[0] | ((int)xa[0][1] << 16)); acc[ft][1][0] += __builtin_bit_cast(float, (int)wcur[1] | ((int)xa[1][1] << 16)); }
            else { acc[ft][0] = mfma32(wcur, xa[0], acc[ft][0]); acc[ft][1] = mfma32(wcur, xa[1], acc[ft][1]); }
            if (g == NTW - 1) { xa[0] = *(const s8v*)(ab + (s0 + 1) * 32); xa[1] = *(const s8v*)(ab + 32 * LROW + (s0 + 1) * 32); }
            wcur = wnext;
            SCHED_FENCE();
        }
    };
    const int nk = K / 64;
    gloadA(0, true, 0); gloadB(0, true, b0); lstoreA(0, 0); gloadA(0, true, 1); gloadB(64, true, b1); lstoreA(0, 1); lstoreB(0, b0);
    __syncthreads();
    for (int kt = 0; kt < nk; kt += 2) {
        const bool t2 = kt + 2 < nk;
        gloadA((kt + 1) * 64, true, 0);
        compute2(0, 0);
        lstoreA(1, 0);
        gloadA((kt + 1) * 64, true, 1);
        gloadB((kt + 2) * 64, t2, b0);
        compute2(0, 2);
        lstoreA(1, 1); lstoreB(1, b1);
        __syncthreads();
        gloadA((kt + 2) * 64, t2, 0);
        compute2(1, 0);
        lstoreA(0, 0);
        gloadA((kt + 2) * 64, t2, 1);
        gloadB((kt + 3) * 64, t2, b1);
        compute2(1, 2);
        lstoreA(0, 1); lstoreB(0, b0);
        __syncthreads();
    }
    epi(acc);
}

DEV void phase_ada(const Params& p, char* smem) {
    const int tid = get_tid();
    float* siluS = (float*)smem;
    float* red = (float*)(smem + NCOND * D * 4);
    for (int i = tid; i < NCOND * D; i += 512) {
        const int cnd = i / D, k = i % D;
        const float c = cnd == 0 ? p.in[I_CCTX][k] : p.in[I_C][(cnd - 1) * D + k];
        siluS[i] = c / (1.f + expf(-c));
    }
    __syncthreads();
    constexpr int CPL = 6 * D / 32, NCHUNK = DEPTH * CPL, KG = D / 16;
    float* mods = (float*)(p.ws + WS_MODS);
    const int col = tid & 31, kg = tid >> 5;
    for (int u = blockIdx.x; u < NCHUNK; u += gridDim.x) {
        const int l = u / CPL, c0 = (u % CPL) * 32;
        const float* W = p.in[I_ADAW] + (size_t)l * D * 6 * D + c0 + col;
        float acc[NCOND];
#pragma unroll
        for (int c = 0; c < NCOND; ++c) acc[c] = 0.f;
#pragma unroll 8
        for (int k = kg * KG; k < kg * KG + KG; ++k) {
            const float w = W[(size_t)k * 6 * D];
#pragma unroll
            for (int c = 0; c < NCOND; ++c) acc[c] += siluS[c * D + k] * w;
        }
#pragma unroll
        for (int c = 0; c < NCOND; ++c) red[(kg * NCOND + c) * 32 + col] = acc[c];
        __syncthreads();
        if (tid < 32 * NCOND) {
            const int c = tid >> 5, cc = tid & 31;
            float s = 0.f;
            for (int g = 0; g < 16; ++g) s += red[(g * NCOND + c) * 32 + cc];
            mods[((size_t)l * NCOND + c) * 6 * D + c0 + cc] = s + p.in[I_ADAB][(size_t)l * 6 * D + c0 + cc];
        }
        __syncthreads();
    }
    const int gtid = blockIdx.x * 512 + tid, gsz = gridDim.x * 512;
    float* rope = (float*)(p.ws + WS_ROPE);
    for (int i = gtid; i < 64 * 16; i += gsz) {
        const int pos = i >> 4, fi = i & 15;
        const float inv = powf(10000.f, -(float)(2 * fi) / 32.f);
        const float ang = (float)pos * inv;
        rope[2 * i] = cosf(ang); rope[2 * i + 1] = sinf(ang);
    }
    constexpr int NNA = DEC_BATCH * DEPTH * PAST * NAH * HD, NGQ = DEC_BATCH * DEPTH * PAST * GQKV * HD;
    bf16_t* cnak = (bf16_t*)(p.ws + WS_CNAK); bf16_t* cnav = (bf16_t*)(p.ws + WS_CNAV);
    bf16_t* cgqk = (bf16_t*)(p.ws + WS_CGQK); bf16_t* cgqv = (bf16_t*)(p.ws + WS_CGQV);
    for (int i = gtid; i < NNA; i += gsz) { cnak[i] = f2bf(p.in[I_CNAK][i]); cnav[i] = f2bf(p.in[I_CNAV][i]); }
    for (int i = gtid; i < NGQ; i += gsz) { cgqk[i] = f2bf(p.in[I_CGQK][i]); cgqv[i] = f2bf(p.in[I_CGQV][i]); }
}

constexpr int EPL = D / 64;
constexpr int W16ROW = 20;
template <int MODE>
DEV void phase_rows(const Params& p, char* smem, int l) {
    const int tid = get_tid(), lane = tid & 63, wave = tid >> 6;
    float* W16 = (float*)smem;
    const bool need_w = (MODE == 1) || (l < DEPTH);
    if (need_w) {
        for (int i = tid; i < D * 4; i += 512) {
            const int k = i >> 2, q = i & 3;
            const float* src = (MODE == 1) ? p.in[I_RW] + ((size_t)l * D + k) * 16 + q * 4 : p.in[I_WIN] + ((size_t)l * D + k) * PROJ_W + 2176 + q * 4;
            *(f4v*)(W16 + k * W16ROW + q * 4) = *(const f4v*)src;
        }
    }
    __syncthreads();
    const float* mods = (const float*)(p.ws + WS_MODS);
    for (int t = blockIdx.x * 8 + wave; t < NT; t += gridDim.x * 8) {
        const int cnd = tok_cond(t);
        float v[EPL];
        if (MODE == 0 && l == 0) {
            const float* xr = t < NP ? p.in[I_XP] + (size_t)t * D : p.in[I_XS] + (size_t)(t - NP) * D;
#pragma unroll
            for (int j = 0; j < EPL; ++j) v[j] = xr[lane + 64 * j];
        } else if (MODE == 0) {
            const float* x1 = (const float*)(p.ws + WS_X1) + (size_t)t * D;
            const float* g2 = mods + ((size_t)(l - 1) * NCOND + cnd) * 6 * D + 5 * D;
            float f[EPL], xv[EPL], gv[EPL];
#pragma unroll
            for (int j = 0; j < EPL; ++j) { f[j] = 0.f; xv[j] = x1[lane + 64 * j]; gv[j] = g2[lane + 64 * j]; }
            const int* ts = (const int*)(p.ws + WS_TOKSLOT) + (size_t)t * 16;
            const int myslot = lane < 16 ? ts[lane] : -1;
            unsigned vm = (unsigned)__ballot(myslot >= 0);
            while (vm) {
                const int e = __builtin_ctz(vm); vm &= vm - 1u;
                const int slot = __shfl(myslot, e);
                const float* yr = (const float*)(p.ws + WS_YE) + ((size_t)e * SLOTS + slot) * D;
#pragma unroll
                for (int j = 0; j < EPL; ++j) f[j] += yr[lane + 64 * j];
            }
#pragma unroll
            for (int j = 0; j < EPL; ++j) v[j] = ALPHA * xv[j] + gv[j] * f[j];
        } else {
            const float* u = (const float*)(p.ws + WS_U) + (size_t)t * D;
#pragma unroll
            for (int j = 0; j < EPL; ++j) v[j] = u[lane + 64 * j];
        }
        if (!(MODE == 0 && l == 0)) {
            const int li = (MODE == 0) ? (l - 1) * 2 + 1 : l * 2;
            const float* lg = p.in[I_LNG] + (size_t)li * D; const float* lb = p.in[I_LNB] + (size_t)li * D;
            float g[EPL], bb[EPL];
#pragma unroll
            for (int j = 0; j < EPL; ++j) { g[j] = lg[lane + 64 * j]; bb[j] = lb[lane + 64 * j]; }
            float s = 0.f;
#pragma unroll
            for (int j = 0; j < EPL; ++j) s += v[j];
            const float mu = wave_sum(s) * (1.f / D);
            float q = 0.f;
#pragma unroll
            for (int j = 0; j < EPL; ++j) { const float dlt = v[j] - mu; q += dlt * dlt; }
            const float rstd = 1.f / sqrtf(wave_sum(q) * (1.f / D) + EPS);
            float* dst = (MODE == 1) ? (float*)(p.ws + WS_X1) + (size_t)t * D
                       : (l == DEPTH) ? (t < NP ? p.out + O_YP + (size_t)t * D : p.out + O_YS + (size_t)(t - NP) * D) : (float*)(p.ws + WS_XBUF) + (size_t)t * D;
#pragma unroll
            for (int j = 0; j < EPL; ++j) { v[j] = (v[j] - mu) * rstd * g[j] + bb[j]; dst[lane + 64 * j] = v[j]; }
        }
        if (MODE == 1 || l < DEPTH) {
            const float* sh = mods + ((size_t)l * NCOND + cnd) * 6 * D + (MODE == 1 ? 3 * D : 0); const float* sc = sh + D;
            bf16_t* hb = (bf16_t*)(p.ws + (MODE == 1 ? WS_H2 : WS_HMOD)) + (size_t)t * D;
            {
                float s1[EPL], s0[EPL];
#pragma unroll
                for (int j = 0; j < EPL; ++j) { s1[j] = sc[lane + 64 * j]; s0[j] = sh[lane + 64 * j]; }
#pragma unroll
                for (int j = 0; j < EPL; ++j) { v[j] = v[j] * (1.f + s1[j]) + s0[j]; hb[lane + 64 * j] = f2bf(v[j]); }
            }
            CFENCE();
            float a16[16];
#pragma unroll
            for (int e = 0; e < 16; ++e) a16[e] = 0.f;
#pragma unroll
            for (int j = 0; j < EPL; ++j) {
                const float hv = v[j];
                const float* wr = W16 + (lane + 64 * j) * W16ROW;
#pragma unroll
                for (int q = 0; q < 4; ++q) { const f4v w4 = *(const f4v*)(wr + 4 * q); a16[4 * q] += hv * w4[0]; a16[4 * q + 1] += hv * w4[1]; a16[4 * q + 2] += hv * w4[2]; a16[4 * q + 3] += hv * w4[3]; }
                if (j & 1) CFENCE();
            }
            float mine = -1e30f;
#pragma unroll
            for (int e = 0; e < 16; ++e) { const float sm = wave_sum(a16[e]); if (lane == e) mine = sm; }
            if (MODE == 0) {
                if (lane < 16) ((float*)(p.ws + WS_GATES))[(size_t)t * 16 + lane] = mine + p.in[I_BGATE][l * 16 + lane];
            } else {
                float mx = mine;
                for (int m = 8; m >= 1; m >>= 1) mx = fmaxf(mx, __shfl_xor(mx, m));
                const float ex = lane < 16 ? expf(mine - mx) : 0.f;
                float sm = ex;
                for (int m = 8; m >= 1; m >>= 1) sm += __shfl_xor(sm, m);
                if (lane < 16) ((float*)(p.ws + WS_AFF))[(size_t)t * 16 + lane] = ex / sm;
            }
        }
    }
}

template <int NPL>
DEV void topk_wave(const Params& p, int tb, int cap, int sbase, int e, int lane) {
    const float* aff = (const float*)(p.ws + WS_AFF);
    int* idx = (int*)(p.ws + WS_IDX); float* gsel = (float*)(p.ws + WS_GSEL); int* tokslot = (int*)(p.ws + WS_TOKSLOT);
    unsigned bits[NPL];
#pragma unroll
    for (int i = 0; i < NPL; ++i) bits[i] = __builtin_bit_cast(unsigned, aff[(size_t)(tb + lane + 64 * i) * 16 + e]);
    unsigned T = 0u;
    for (int b = 30; b >= 0; --b) {
        const unsigned cand = T | (1u << b);
        int cnt = 0;
#pragma unroll
        for (int i = 0; i < NPL; ++i) cnt += __popcll(__ballot(bits[i] >= cand));
        if (cnt >= cap) T = cand;
    }
    int ngt = 0;
#pragma unroll
    for (int i = 0; i < NPL; ++i) ngt += __popcll(__ballot(bits[i] > T));
    int need_eq = cap - ngt, run = 0;
    const unsigned long long lt = (1ull << lane) - 1ull;
#pragma unroll
    for (int i = 0; i < NPL; ++i) {
        const bool eq = bits[i] == T;
        const unsigned long long meq = __ballot(eq);
        const int eqrank = __popcll(meq & lt);
        const bool sel = bits[i] > T || (eq && eqrank < need_eq);
        const unsigned long long ms = __ballot(sel);
        const int t = tb + lane + 64 * i;
        if (sel) { const int slot = sbase + run + __popcll(ms & lt); idx[e * SLOTS + slot] = t; gsel[e * SLOTS + slot] = __builtin_bit_cast(float, bits[i]); tokslot[(size_t)t * 16 + e] = slot; }
        else tokslot[(size_t)t * 16 + e] = -1;
        run += __popcll(ms);
        const int neq = __popcll(meq); need_eq -= neq < need_eq ? neq : need_eq;
    }
}
DEV void phase_topk(const Params& p, char* smem) {
    (void)smem;
    const int tid = get_tid(), lane = tid & 63;
    constexpr int US = DEC_BATCH * NEXP, UP = BATCH * NEXP;
    const int gw = blockIdx.x * 8 + (tid >> 6), nw = gridDim.x * 8;
    for (int u = gw; u < US + UP; u += nw) {
        if (u < US) { const int b = u / NEXP, e = u % NEXP; topk_wave<DEC_SEQ / 64>(p, NP + b * DEC_SEQ, CAP_S, BATCH * CAP_P + b * CAP_S, e, lane); }
        else { const int uu = u - US; const int b = uu / NEXP, e = uu % NEXP; topk_wave<SEQ / 64>(p, b * SEQ, CAP_P, b * CAP_P, e, lane); }
    }
}

DEV void store_head(bf16_t* dst_bf, float* dst_f32, const f16v& v0, const f16v& v1, int h) {
#pragma unroll
    for (int ft = 0; ft < 2; ++ft) {
        const f16v& v = ft ? v1 : v0;
#pragma unroll
        for (int g = 0; g < 4; ++g) {
            const int d0 = ft * 32 + 8 * g + 4 * h;
            u2v pk; pk[0] = pack2(v[4 * g], v[4 * g + 1]); pk[1] = pack2(v[4 * g + 2], v[4 * g + 3]);
            *(u2v*)(dst_bf + d0) = pk;
            if (dst_f32) { f4v o; o[0] = v[4 * g]; o[1] = v[4 * g + 1]; o[2] = v[4 * g + 2]; o[3] = v[4 * g + 3]; *(f4v*)(dst_f32 + d0) = o; }
        }
    }
}
template <int VAR>
DEV void phase_inproj(const Params& p, char* smem, int l) {
    constexpr int NJ = 22, NU = (NT / 256) * NJ;
    const int tid = get_tid(), lane = tid & 63, wave = tid >> 6, wm = wave & 3, wn = wave >> 2, h = lane >> 5, l31 = lane & 31;
    const bf16_t* hmod = (const bf16_t*)(p.ws + WS_HMOD);
    const float* rope = (const float*)(p.ws + WS_ROPE);
    constexpr int NMB = NT / 256, RPX = (NMB % 8 == 0) ? NMB / 8 : NMB;
    const UnitIter it = unit_iter(NU);
    for (int u = it.i; u < it.end; u += it.step) {
        const int mb = (u / (RPX * NJ)) * RPX + u % RPX, j = (u / RPX) % NJ;
        const int colbase = j < 17 ? 128 * j : 2192 + 128 * (j - 17);
        const unsigned ao = ((unsigned)(mb * 256 + (tid >> 3)) * D + (tid & 7) * 8) * 2;
        const unsigned bvo = (unsigned)(colbase + 4 * (tid & 31)) * 4 + (unsigned)(tid >> 5) * (PROJ_W * 4);
        const unsigned blds = (unsigned)(tid >> 5) * 320u + (unsigned)(tid & 31) * 8u;
        gemm_tile<2, VAR>(smem, make_rsrc(hmod), ao, ao + 128u * D, ao + 256u * D, ao + 384u * D, make_rsrc(p.in[I_WIN] + (size_t)l * D * PROJ_W), bvo, blds, PROJ_W * 4, D, [&](f16v (&acc)[2][2]) {
            const int cb = colbase + wn * 64;
#pragma unroll
            for (int tt = 0; tt < 2; ++tt) {
                const int t = mb * 256 + wm * 64 + tt * 32 + l31;
                const bool isP = t < NP;
                const int bP = t / SEQ, sP = t % SEQ;
                f16v v0 = acc[0][tt], v1 = acc[1][tt];
                if (cb < 1152) {
                    const int seg = cb / 384, head = (cb % 384) / 64;
                    bf16_t* dst = (bf16_t*)(p.ws + (seg == 0 ? WS_NAQ : seg == 1 ? WS_NAK : WS_NAV)) + (size_t)t * 384 + head * 64;
                    float* of = nullptr;
                    if (seg >= 1 && isP) of = p.out + (seg == 1 ? O_NAK : O_NAV) + ((((size_t)bP * DEPTH + l) * SEQ + sP) * NAH + head) * 64;
                    store_head(dst, of, v0, v1, h);
                } else if (cb < 2176) {
                    const int seg = (cb - 1152) / 256, head = ((cb - 1152) % 256) / 64;
                    if (seg == 1) { v0 *= ATT_SCALE; v1 *= ATT_SCALE; }
                    bf16_t* dst = (bf16_t*)(p.ws + (seg == 0 ? WS_MLQ : seg == 1 ? WS_MLK : seg == 2 ? WS_MLV : WS_MLO)) + (size_t)t * 256 + head * 64;
                    store_head(dst, nullptr, v0, v1, h);
                } else {
                    const int c2 = cb - 2192;
                    if (c2 < 512) {
                        const bool isq = c2 < 384;
                        const int head = isq ? c2 / 64 : (c2 - 384) / 64;
                        float ss = 0.f;
#pragma unroll
                        for (int r = 0; r < 16; ++r) ss += v0[r] * v0[r] + v1[r] * v1[r];
                        ss += __shfl_xor(ss, 32);
                        const float rn = 1.f / sqrtf(ss * (1.f / 64.f) + EPS);
                        const float* gq = p.in[I_QKG] + ((size_t)l * 2 + (isq ? 0 : 1)) * 64;
#pragma unroll
                        for (int r = 0; r < 16; ++r) {
                            const int d = (r & 3) + 8 * (r >> 2) + 4 * h;
                            v0[r] *= rn * gq[d]; v1[r] *= rn * gq[32 + d];
                        }
                        if (isP) {
                            if (isq) store_head((bf16_t*)(p.ws + WS_GQQ) + (size_t)t * 384 + head * 64, nullptr, v0, v1, h);
                            else store_head((bf16_t*)(p.ws + WS_GQK) + (size_t)t * 128 + head * 64, p.out + O_GQK + ((((size_t)bP * DEPTH + l) * SEQ + sP) * GQKV + head) * 64, v0, v1, h);
                        } else {
                            const int pos = (t - NP) % DEC_SEQ, prow = pos / GRIDW, pcol = pos % GRIDW;
#pragma unroll
                            for (int r = 0; r < 8; ++r) {
                                const int rr = r;
                                const int fi = (rr & 3) + 8 * ((rr >> 2) & 1) + 4 * h;
                                const float c0 = rope[(prow * 16 + fi) * 2], s0 = rope[(prow * 16 + fi) * 2 + 1];
                                const float c1 = rope[(pcol * 16 + fi) * 2], s1 = rope[(pcol * 16 + fi) * 2 + 1];
                                const float a_lo = v0[rr], a_hi = v0[rr + 8]; v0[rr] = a_lo * c0 - a_hi * s0; v0[rr + 8] = a_hi * c0 + a_lo * s0;
                                const float b_lo = v1[rr], b_hi = v1[rr + 8]; v1[rr] = b_lo * c1 - b_hi * s1; v1[rr + 8] = b_hi * c1 + b_lo * s1;
                            }
                            if (isq) store_head((bf16_t*)(p.ws + WS_GQQ) + (size_t)t * 384 + head * 64, nullptr, v0, v1, h);
                            else store_head((bf16_t*)(p.ws + WS_GQK) + (size_t)t * 128 + head * 64, nullptr, v0, v1, h);
                        }
                    } else {
                        const int head = (c2 - 512) / 64;
                        float* of = isP ? p.out + O_GQV + ((((size_t)bP * DEPTH + l) * SEQ + sP) * GQKV + head) * 64 : nullptr;
                        store_head((bf16_t*)(p.ws + WS_GQV) + (size_t)t * 128 + head * 64, of, v0, v1, h);
                    }
                }
            }
        });
    }
}

template <int VAR>
DEV void phase_outproj(const Params& p, char* smem, int l) {
    constexpr int NC = D / 128, NU = (NT / 256) * NC;
    const int tid = get_tid(), lane = tid & 63, wave = tid >> 6, wm = wave & 3, wn = wave >> 2, h = lane >> 5, l31 = lane & 31;
    const bf16_t* mixed = (const bf16_t*)(p.ws + WS_MIXED);
    const float* mods = (const float*)(p.ws + WS_MODS);
    float* U = (float*)(p.ws + WS_U);
    constexpr int NMB = NT / 256, RPX = (NMB % 8 == 0) ? NMB / 8 : NMB;
    const UnitIter it = unit_iter(NU);
    for (int u = it.i; u < it.end; u += it.step) {
        const int mb = (u / (RPX * NC)) * RPX + u % RPX, cbk = (u / RPX) % NC;
        const unsigned ao = ((unsigned)(mb * 256 + (tid >> 3)) * MIXW + (tid & 7) * 8) * 2;
        const unsigned bvo = (unsigned)(cbk * 128 + 4 * (tid & 31)) * 4 + (unsigned)(tid >> 5) * (D * 4);
        const unsigned blds = (unsigned)(tid >> 5) * 320u + (unsigned)(tid & 31) * 8u;
        gemm_tile<2, VAR>(smem, make_rsrc(mixed), ao, ao + 128u * MIXW, ao + 256u * MIXW, ao + 384u * MIXW, make_rsrc(p.in[I_WOUT] + (size_t)l * MIXW * D), bvo, blds, D * 4, MIXW, [&](f16v (&acc)[2][2]) {
#pragma unroll
            for (int tt = 0; tt < 2; ++tt) {
                const int t = mb * 256 + wm * 64 + tt * 32 + l31;
                const float* xr = (l == 0) ? (t < NP ? p.in[I_XP] + (size_t)t * D : p.in[I_XS] + (size_t)(t - NP) * D) : (const float*)(p.ws + WS_XBUF) + (size_t)t * D;
                const float* g1 = mods + ((size_t)l * NCOND + tok_cond(t)) * 6 * D + 2 * D;
#pragma unroll
                for (int ft = 0; ft < 2; ++ft)
#pragma unroll
                    for (int g = 0; g < 4; ++g) {
                        const int f0 = cbk * 128 + wn * 64 + ft * 32 + 8 * g + 4 * h;
                        const f4v xv = *(const f4v*)(xr + f0); const f4v gv = *(const f4v*)(g1 + f0);
                        f4v o;
#pragma unroll
                        for (int q = 0; q < 4; ++q) o[q] = ALPHA * xv[q] + gv[q] * acc[ft][tt][4 * g + q];
                        *(f4v*)(U + (size_t)t * D + f0) = o;
                    }
            }
        });
    }
}

template <int VAR>
DEV void phase_gateup(const Params& p, char* smem, int l) {
    constexpr int NRB = SLOTS / 256, NCB = EH / 128, NU = NEXP * NCB * NRB;
    const int tid = get_tid(), lane = tid & 63, wave = tid >> 6, wm = wave & 3, wn = wave >> 2, h = lane >> 5, l31 = lane & 31;
    const bf16_t* h2 = (const bf16_t*)(p.ws + WS_H2);
    const int* idx = (const int*)(p.ws + WS_IDX);
    bf16_t* hid = (bf16_t*)(p.ws + WS_HID);
    const UnitIter it = unit_iter(NU);
    for (int u = it.i; u < it.end; u += it.step) {
        const int rb = u % NRB, cbk = (u / NRB) % NCB, e = u / (NRB * NCB);
        const int* ip = idx + e * SLOTS + rb * 256 + (tid >> 3);
        const unsigned a0 = ((unsigned)ip[0] * D + (tid & 7) * 8) * 2, a1 = ((unsigned)ip[64] * D + (tid & 7) * 8) * 2;
        const unsigned a2 = ((unsigned)ip[128] * D + (tid & 7) * 8) * 2, a3 = ((unsigned)ip[192] * D + (tid & 7) * 8) * 2;
#ifdef EMU
        const int bw = tid >> 6;
#else
        const int bw = __builtin_amdgcn_readfirstlane(tid >> 6);
#endif
        const int is_up = bw & 1, bkr = 2 * (bw >> 1) + ((tid >> 5) & 1), hc = 4 * (tid & 31);
        const int ncol = (hc >> 6) * 128 + (2 * ((hc >> 5) & 1) + is_up) * 32 + (hc & 31);
        const unsigned bvo = (unsigned)(cbk * 128 + hc) * 4 + (unsigned)bkr * (EH * 4);
        const unsigned blds = (unsigned)bkr * 576u + (unsigned)ncol * 2u;
        const float* wmat = (is_up ? p.in[I_WU] : p.in[I_WG]) + ((size_t)l * NEXP + e) * D * EH;
        gemm_tile<4, VAR>(smem, make_rsrc(h2), a0, a1, a2, a3, make_rsrc(wmat), bvo, blds, EH * 4, D, [&](f16v (&acc)[4][2]) {
#pragma unroll
            for (int tt = 0; tt < 2; ++tt) {
                const int slot = rb * 256 + wm * 64 + tt * 32 + l31;
                bf16_t* dst = hid + ((size_t)e * SLOTS + slot) * EH + cbk * 128 + wn * 64;
#pragma unroll
                for (int pr = 0; pr < 2; ++pr)
#pragma unroll
                    for (int g = 0; g < 4; ++g) {
                        float o[4];
#pragma unroll
                        for (int q = 0; q < 4; ++q) o[q] = siluf_(acc[2 * pr][tt][4 * g + q]) * acc[2 * pr + 1][tt][4 * g + q];
                        u2v pk; pk[0] = pack2(o[0], o[1]); pk[1] = pack2(o[2], o[3]);
                        *(u2v*)(dst + pr * 32 + 8 * g + 4 * h) = pk;
                    }
            }
        });
    }
}

template <int VAR>
DEV void phase_down(const Params& p, char* smem, int l) {
    constexpr int NRB = SLOTS / 256, NCB = D / 256, NU = NEXP * NCB * NRB;
    const int tid = get_tid(), lane = tid & 63, wave = tid >> 6, wm = wave & 3, wn = wave >> 2, h = lane >> 5, l31 = lane & 31;
    const bf16_t* hid = (const bf16_t*)(p.ws + WS_HID);
    const float* gsel = (const float*)(p.ws + WS_GSEL);
    float* ye = (float*)(p.ws + WS_YE);
    const UnitIter it = unit_iter(NU);
    for (int u = it.i; u < it.end; u += it.step) {
        const int rb = u % NRB, cbk = (u / NRB) % NCB, e = u / (NRB * NCB);
        const unsigned ao = ((unsigned)(rb * 256 + (tid >> 3)) * EH + (tid & 7) * 8) * 2;
        const unsigned bvo = (unsigned)(cbk * 256 + 4 * (tid & 63)) * 4 + (unsigned)(tid >> 6) * (D * 4);
        const unsigned blds = (unsigned)(tid >> 6) * 576u + (unsigned)(tid & 63) * 8u;
        gemm_tile<4, VAR>(smem, make_rsrc(hid + (size_t)e * SLOTS * EH), ao, ao + 128u * EH, ao + 256u * EH, ao + 384u * EH, make_rsrc(p.in[I_WD] + ((size_t)l * NEXP + e) * EH * D), bvo, blds, D * 4, EH, [&](f16v (&acc)[4][2]) {
#pragma unroll
            for (int tt = 0; tt < 2; ++tt) {
                const int slot = rb * 256 + wm * 64 + tt * 32 + l31;
                const float gs = gsel[e * SLOTS + slot];
                float* dst = ye + ((size_t)e * SLOTS + slot) * D + cbk * 256 + wn * 128;
#pragma unroll
                for (int ft = 0; ft < 4; ++ft)
#pragma unroll
                    for (int g = 0; g < 4; ++g) {
                        f4v o;
#pragma unroll
                        for (int q = 0; q < 4; ++q) o[q] = acc[ft][tt][4 * g + q] * gs;
                        *(f4v*)(dst + ft * 32 + 8 * g + 4 * h) = o;
                    }
            }
        });
    }
}

struct AttnDesc {
    const bf16_t* q; int qstride;
    int ntiles, n0;
    const bf16_t *k0, *v0; int stride0;
    const bf16_t *k1, *v1; int stride1;
    int na;
    int r0, rlo;
    const float* rpb;
    bf16_t* out; int ostride;
    float* part;
};
constexpr int ATT_TILE = 64 * LROW;
DEV int na_row_start(int r) { int s = r - KR / 2; s = s < 0 ? 0 : s; return s > ROWS - KR ? ROWS - KR : s; }
DEV void attn_unit(char* smem, const AttnDesc& d) {
    const int tid = get_tid(), lane = tid & 63, wave = tid >> 6, h = lane >> 5, l31 = lane & 31;
    char* Ks = smem; char* Vs = smem + 2 * ATT_TILE; float* rpbS = (float*)(smem + 4 * ATT_TILE);
    if (d.na) { for (int i = tid; i < 15 * 31; i += 512) rpbS[i] = d.rpb[i]; }
    const bf16_t* qp = d.q + (size_t)(wave * 32 + l31) * d.qstride + h * 8;
    s8v qf[4];
#pragma unroll
    for (int s = 0; s < 4; ++s) qf[s] = *(const s8v*)(qp + 16 * s);
    float m_run = -1e30f, l_run = 0.f;
    f16v o[2]; o[0] = f16zero(); o[1] = f16zero();
    const int srow = tid >> 3, sch = tid & 7;
    u4v kreg, vreg;
    auto gload = [&](int t) {
        const bf16_t *kp, *vp;
        if (t < d.n0) { const size_t off = (size_t)(t * 64 + srow) * d.stride0 + sch * 8; kp = d.k0 + off; vp = d.v0 + off; }
        else { const size_t off = (size_t)((t - d.n0) * 64 + srow) * d.stride1 + sch * 8; kp = d.k1 + off; vp = d.v1 + off; }
        kreg = *(const u4v*)kp; vreg = *(const u4v*)vp;
    };
    auto lstore = [&](int buf) { *(u4v*)(Ks + buf * ATT_TILE + srow * LROW + sch * 16) = kreg; *(u4v*)(Vs + buf * ATT_TILE + srow * LROW + sch * 16) = vreg; };
    const int qr = d.r0 + (wave >> 1), qw = (wave & 1) * 32 + l31;
    const int rs = na_row_start(qr);
    int cs = qw - KC / 2; cs = cs < 0 ? 0 : (cs > GRIDW - KC ? GRIDW - KC : cs);
    gload(0); lstore(0);
    __syncthreads();
    for (int t = 0; t < d.ntiles; ++t) {
        const int buf = t & 1;
        if (t + 1 < d.ntiles) gload(t + 1);
        const bool local = d.na && t >= d.n0;
        const int kr = d.rlo + (t - d.n0);
        const bool active = !local || (kr >= rs && kr < rs + KR);
        if (active) {
            const char* kb = Ks + buf * ATT_TILE + l31 * LROW + h * 16;
            f16v sa[2];
#pragma unroll
            for (int kt = 0; kt < 2; ++kt) {
                sa[kt] = f16zero();
#pragma unroll
                for (int s = 0; s < 4; ++s) { const s8v kf = *(const s8v*)(kb + kt * 32 * LROW + s * 32); sa[kt] = mfma32(kf, qf[s], sa[kt]); }
            }
            float mx = -1e30f;
#pragma unroll
            for (int kt = 0; kt < 2; ++kt)
#pragma unroll
                for (int r = 0; r < 16; ++r) {
                    float v = sa[kt][r] * ATT_SCALE;
                    if (local) {
                        const int kc = kt * 32 + (r & 3) + 8 * (r >> 2) + 4 * h;
                        const bool inw = kc >= cs && kc < cs + KC;
                        const int bi = (kr - qr + 7) * 31 + (kc - qw + 15);
                        v = inw ? v + rpbS[inw ? bi : 0] : -1e30f;
                    }
                    sa[kt][r] = v; mx = fmaxf(mx, v);
                }
            mx = fmaxf(mx, __shfl_xor(mx, 32));
            const float m_new = fmaxf(m_run, mx);
            const float alpha = fexp(m_run - m_new);
            float ps = 0.f;
#pragma unroll
            for (int kt = 0; kt < 2; ++kt)
#pragma unroll
                for (int r = 0; r < 16; ++r) { const float pv = fexp(sa[kt][r] - m_new); sa[kt][r] = pv; ps += pv; }
            l_run = l_run * alpha + ps; m_run = m_new;
            o[0] *= alpha; o[1] *= alpha;
            const char* vb = Vs + buf * ATT_TILE + (4 * h + ((lane & 15) >> 2)) * LROW + (((lane >> 4) & 1) * 16 + 4 * (lane & 3)) * 2;
#pragma unroll
            for (int ks = 0; ks < 4; ++ks) {
                const int kt = ks >> 1, rb = 8 * (ks & 1);
                u4v pk; pk[0] = pack2(sa[kt][rb], sa[kt][rb + 1]); pk[1] = pack2(sa[kt][rb + 2], sa[kt][rb + 3]);
                pk[2] = pack2(sa[kt][rb + 4], sa[kt][rb + 5]); pk[3] = pack2(sa[kt][rb + 6], sa[kt][rb + 7]);
                const s8v pf = __builtin_bit_cast(s8v, pk);
                const char* vk = vb + (kt * 32 + 16 * (ks & 1)) * LROW;
#pragma unroll
                for (int dt = 0; dt < 2; ++dt) {
                    const s4v lo = lds_tr16(vk + dt * 64), hi = lds_tr16(vk + 8 * LROW + dt * 64);
                    s8v vf; vf[0] = lo[0]; vf[1] = lo[1]; vf[2] = lo[2]; vf[3] = lo[3]; vf[4] = hi[0]; vf[5] = hi[1]; vf[6] = hi[2]; vf[7] = hi[3];
                    o[dt] = mfma32(vf, pf, o[dt]);
                }
            }
        }
        if (t + 1 < d.ntiles) lstore(buf ^ 1);
        __syncthreads();
    }
    const float l_tot = l_run + __shfl_xor(l_run, 32);
    const int qrow = wave * 32 + l31;
    if (d.part) {
        float* po = d.part + (size_t)qrow * 64;
#pragma unroll
        for (int dt = 0; dt < 2; ++dt)
#pragma unroll
            for (int g = 0; g < 4; ++g) { f4v v; v[0] = o[dt][4 * g]; v[1] = o[dt][4 * g + 1]; v[2] = o[dt][4 * g + 2]; v[3] = o[dt][4 * g + 3]; *(f4v*)(po + dt * 32 + 8 * g + 4 * h) = v; }
        if (h == 0) { d.part[256 * 64 + qrow] = m_run; d.part[256 * 64 + 256 + qrow] = l_tot; }
    } else {
        const float inv = 1.f / l_tot;
        bf16_t* po = d.out + (size_t)qrow * d.ostride;
#pragma unroll
        for (int dt = 0; dt < 2; ++dt)
#pragma unroll
            for (int g = 0; g < 4; ++g) {
                u2v pk; pk[0] = pack2(o[dt][4 * g] * inv, o[dt][4 * g + 1] * inv); pk[1] = pack2(o[dt][4 * g + 2] * inv, o[dt][4 * g + 3] * inv);
                *(u2v*)(po + dt * 32 + 8 * g + 4 * h) = pk;
            }
    }
}

DEV int ml_sidx(int grp, int b, int head, int c) { return grp == 0 ? ((b * MLH + head) * NCH_P + c) : BATCH * MLH * NCH_P + ((b * MLH + head) * NCH_S + c); }
DEV float lane_prefix_sum(float v, int lane) { for (int dlt = 1; dlt < 64; dlt <<= 1) { const float o = __shfl(v, lane - dlt); if (lane >= dlt) v += o; } return v; }
DEV float lane_prefix_max(float v, int lane) { for (int dlt = 1; dlt < 64; dlt <<= 1) { const float o = __shfl(v, lane - dlt); if (lane >= dlt) v = fmaxf(v, o); } return v; }

DEV void mlstm_summary_unit(const Params& p, char* smem, int grp, int b, int head, int c) {
    const int tid = get_tid(), lane = tid & 63, wave = tid >> 6, h = lane >> 5, l31 = lane & 31;
    char* KT = smem;
    char* VT = smem + 2 * ATT_TILE;
    float* wsS = (float*)(smem + 3 * ATT_TILE);
    float* scal = wsS + 128;
    const int tb = (grp == 0 ? b * SEQ : NP + b * DEC_SEQ) + c * 64;
    const float* gates = (const float*)(p.ws + WS_GATES);
    if (wave == 0) {
        const float* gr = gates + (size_t)(tb + lane) * 16;
        const float i_f = gr[head], lf_f = logsigmoidf_(gr[4 + head]), i_b = gr[8 + head], lf_b = logsigmoidf_(gr[12 + head]);
        const float pf = lane_prefix_sum(lf_f, lane), pb = lane_prefix_sum(lf_b, lane);
        const float tot_f = __shfl(pf, 63), tot_b = __shfl(pb, 63);
        const float g_f = (tot_f - pf) + i_f, g_b = (pb - lf_b) + i_b;
        const float G_f = wave_max(g_f), G_b = wave_max(g_b);
        wsS[lane] = expf(g_f - G_f); wsS[64 + lane] = expf(g_b - G_b);
        if (lane == 0) { scal[0] = tot_f; scal[1] = tot_b; scal[2] = G_f; scal[3] = G_b; }
    }
    __syncthreads();
    {
        const int tau = tid >> 3, ch = tid & 7;
        const u4v kv = *(const u4v*)((const bf16_t*)(p.ws + WS_MLK) + (size_t)(tb + tau) * 256 + head * 64 + ch * 8);
        const u4v vv = *(const u4v*)((const bf16_t*)(p.ws + WS_MLV) + (size_t)(tb + tau) * 256 + head * 64 + ch * 8);
        const float wf = wsS[tau], wb = wsS[64 + tau];
#pragma unroll
        for (int j = 0; j < 8; ++j) {
            const bf16_t kb = (bf16_t)(kv[j >> 1] >> (16 * (j & 1))), vb = (bf16_t)(vv[j >> 1] >> (16 * (j & 1)));
            const int dim = ch * 8 + j; const float kf = bf2f(kb);
            *(bf16_t*)(KT + dim * LROW + tau * 2) = f2bf(kf * wf);
            *(bf16_t*)(KT + ATT_TILE + dim * LROW + tau * 2) = f2bf(kf * wb);
            *(bf16_t*)(VT + dim * LROW + tau * 2) = vb;
        }
    }
    __syncthreads();
    float* sum = (float*)(p.ws + WS_MLSUM);
    const int sidx = ml_sidx(grp, b, head, c);
    {
        const int dir = wave >> 2, mi = (wave >> 1) & 1, ni = wave & 1;
        f16v acc = f16zero();
#pragma unroll
        for (int s = 0; s < 4; ++s) {
            const s8v af = *(const s8v*)(KT + dir * ATT_TILE + (mi * 32 + l31) * LROW + (16 * s + 8 * h) * 2);
            const s8v bf = *(const s8v*)(VT + (ni * 32 + l31) * LROW + (16 * s + 8 * h) * 2);
            acc = mfma32(af, bf, acc);
        }
        float* U = sum + (size_t)(sidx * 2 + dir) * MLSUM_STRIDE;
#pragma unroll
        for (int r = 0; r < 16; ++r) U[(mi * 32 + (r & 3) + 8 * (r >> 2) + 4 * h) * 64 + ni * 32 + l31] = acc[r];
    }
    if (tid < 128) {
        const int dir = tid >> 6, kd = tid & 63;
        float s = 0.f;
        for (int tau = 0; tau < 64; ++tau) s += bf2f(*(const bf16_t*)(KT + dir * ATT_TILE + kd * LROW + tau * 2));
        float* E = sum + (size_t)(sidx * 2 + dir) * MLSUM_STRIDE;
        E[4096 + kd] = s;
        if (kd == 0) { E[4160] = scal[dir]; E[4161] = scal[2 + dir]; }
    }
    __syncthreads();
}

DEV void mlstm_output_unit(const Params& p, char* smem, int l, int grp, int b, int head, int c) {
    const int tid = get_tid(), lane = tid & 63, wave = tid >> 6, h = lane >> 5, l31 = lane & 31;
    const int nc = grp ? NCH_S : NCH_P;
    char* Qs = smem;
    char* Ks = smem + 2 * ATT_TILE;
    char* VT = smem + 4 * ATT_TILE;
    char* CT = smem + 6 * ATT_TILE;
    char* QK = smem + 8 * ATT_TILE;
    float* hS = (float*)(smem + 10 * ATT_TILE);
    float* vec = hS + 2 * 64 * 68;
    float* aS = vec; float* MjS = vec + 128; float* bS = vec + 256; float* nS = vec + 384; float* denp = vec + 512; float* qnS = vec + 768; float* scal = vec + 896;
    const int tb = (grp == 0 ? b * SEQ : NP + b * DEC_SEQ) + c * 64;
    const float* sum = (const float*)(p.ws + WS_MLSUM);
#pragma unroll
    for (int dir = 0; dir < 2; ++dir) {
        float C[8], nst = 0.f, m;
        if (grp == 0) {
#pragma unroll
            for (int i = 0; i < 8; ++i) C[i] = 0.f;
            m = 0.f;
        } else {
            const size_t sb = (((size_t)b * DEPTH + l) * 2 + dir) * MLH + head;
#pragma unroll
            for (int i = 0; i < 8; ++i) C[i] = p.in[I_SC][sb * 4096 + tid + 512 * i];
            if (tid < 64) nst = p.in[I_SN][sb * 64 + tid];
            m = p.in[I_SM][sb];
        }
        const int nsteps = dir == 0 ? c : nc - 1 - c;
        const bool fin = (grp == 0) && (dir == 0 ? c == nc - 1 : c == 0);
        for (int st = 0; st < nsteps + (fin ? 1 : 0); ++st) {
            const int cc = dir == 0 ? st : nc - 1 - st;
            const float* E = sum + (size_t)(ml_sidx(grp, b, head, cc) * 2 + dir) * MLSUM_STRIDE;
            if (st == nsteps) {
#pragma unroll
                for (int i = 0; i < 8; ++i) { const int e = tid + 512 * i; *(bf16_t*)(CT + dir * ATT_TILE + (e & 63) * LROW + (e >> 6) * 2) = f2bf(C[i]); }
                if (tid < 64) nS[dir * 64 + tid] = nst;
                if (tid == 0) scal[dir] = m;
            }
            const float A = E[4160], G = E[4161];
            const float m_new = fmaxf(A + m, G);
            const float sc = expf(A + m - m_new), su = expf(G - m_new);
#pragma unroll
            for (int i = 0; i < 8; ++i) C[i] = sc * C[i] + su * E[tid + 512 * i];
            if (tid < 64) nst = sc * nst + su * E[4096 + tid];
            m = m_new;
        }
        if (!fin) {
#pragma unroll
            for (int i = 0; i < 8; ++i) { const int e = tid + 512 * i; *(bf16_t*)(CT + dir * ATT_TILE + (e & 63) * LROW + (e >> 6) * 2) = f2bf(C[i]); }
            if (tid < 64) nS[dir * 64 + tid] = nst;
            if (tid == 0) scal[dir] = m;
        } else {
            const size_t ob = (((size_t)b * DEPTH + l) * 2 + dir) * MLH + head;
#pragma unroll
            for (int i = 0; i < 8; ++i) p.out[O_MC + ob * 4096 + tid + 512 * i] = C[i];
            if (tid < 64) p.out[O_MN + ob * 64 + tid] = nst;
            if (tid == 0) p.out[O_MM + ob] = m;
        }
    }
    {
        const int row = tid >> 3, ch = tid & 7;
#pragma unroll
        for (int dir = 0; dir < 2; ++dir) {
            const int tok = tb + (dir ? 63 - row : row);
            const size_t off = (size_t)tok * 256 + head * 64 + ch * 8;
            *(u4v*)(Qs + dir * ATT_TILE + row * LROW + ch * 16) = *(const u4v*)((const bf16_t*)(p.ws + WS_MLQ) + off);
            *(u4v*)(Ks + dir * ATT_TILE + row * LROW + ch * 16) = *(const u4v*)((const bf16_t*)(p.ws + WS_MLK) + off);
            const u4v vv = *(const u4v*)((const bf16_t*)(p.ws + WS_MLV) + off);
#pragma unroll
            for (int j = 0; j < 8; ++j) *(bf16_t*)(VT + dir * ATT_TILE + (ch * 8 + j) * LROW + row * 2) = (bf16_t)(vv[j >> 1] >> (16 * (j & 1)));
        }
    }
    __syncthreads();
    if (wave < 2) {
        const int dir = wave;
        const float* gr = (const float*)(p.ws + WS_GATES) + (size_t)(tb + (dir ? 63 - lane : lane)) * 16;
        const float ig = gr[dir * 8 + head], lf = logsigmoidf_(gr[dir * 8 + 4 + head]);
        const float bj = lane_prefix_sum(lf, lane);
        const float a = ig - bj;
        const float Pj = lane_prefix_max(a, lane);
        aS[dir * 64 + lane] = a; bS[dir * 64 + lane] = bj; MjS[dir * 64 + lane] = fmaxf(scal[dir], Pj);
    } else if (wave < 4) {
        const int dir = wave - 2;
        float s = 0.f;
        for (int k = 0; k < 64; ++k) s += bf2f(*(const bf16_t*)(Qs + dir * ATT_TILE + lane * LROW + k * 2)) * nS[dir * 64 + k];
        qnS[dir * 64 + lane] = s;
    }
    __syncthreads();
    const int dir = wave >> 2, rt = (wave >> 1) & 1, jt = wave & 1;
    const int j = jt * 32 + l31;
    const float Mj = MjS[dir * 64 + j];
    {
        f16v acc = f16zero();
#pragma unroll
        for (int s4 = 0; s4 < 4; ++s4) {
            const s8v af = *(const s8v*)(Ks + dir * ATT_TILE + (rt * 32 + l31) * LROW + (16 * s4 + 8 * h) * 2);
            const s8v bf = *(const s8v*)(Qs + dir * ATT_TILE + j * LROW + (16 * s4 + 8 * h) * 2);
            acc = mfma32(af, bf, acc);
        }
        float dsum = 0.f;
#pragma unroll
        for (int g = 0; g < 4; ++g) {
            float o[4];
#pragma unroll
            for (int q = 0; q < 4; ++q) {
                const int s = rt * 32 + 8 * g + 4 * h + q;
                const float w = s <= j ? expf(aS[dir * 64 + s] - Mj) : 0.f;
                o[q] = acc[4 * g + q] * w; dsum += o[q];
            }
            u2v pk; pk[0] = pack2(o[0], o[1]); pk[1] = pack2(o[2], o[3]);
            *(u2v*)(QK + dir * ATT_TILE + j * LROW + (rt * 32 + 8 * g + 4 * h) * 2) = pk;
        }
        dsum += __shfl_xor(dsum, 32);
        if (h == 0) denp[(dir * 2 + rt) * 64 + j] = dsum;
    }
    __syncthreads();
    {
        const float mst = scal[dir];
        const float decay = expf(mst - Mj);
        f16v acc = f16zero();
#pragma unroll
        for (int s4 = 0; s4 < 4; ++s4) {
            const s8v af = *(const s8v*)(CT + dir * ATT_TILE + (rt * 32 + l31) * LROW + (16 * s4 + 8 * h) * 2);
            const s8v bf = *(const s8v*)(Qs + dir * ATT_TILE + j * LROW + (16 * s4 + 8 * h) * 2);
            acc = mfma32(af, bf, acc);
        }
        acc *= decay;
#pragma unroll
        for (int s4 = 0; s4 < 4; ++s4) {
            const s8v af = *(const s8v*)(VT + dir * ATT_TILE + (rt * 32 + l31) * LROW + (16 * s4 + 8 * h) * 2);
            const s8v bf = *(const s8v*)(QK + dir * ATT_TILE + j * LROW + (16 * s4 + 8 * h) * 2);
            acc = mfma32(af, bf, acc);
        }
        const float den = decay * qnS[dir * 64 + j] + denp[(dir * 2) * 64 + j] + denp[(dir * 2 + 1) * 64 + j];
        const float dn = fmaxf(fabsf(den), expf(-(bS[dir * 64 + j] + Mj)));
        const float inv = 1.f / dn;
#pragma unroll
        for (int g = 0; g < 4; ++g) { f4v o; o[0] = acc[4 * g] * inv; o[1] = acc[4 * g + 1] * inv; o[2] = acc[4 * g + 2] * inv; o[3] = acc[4 * g + 3] * inv;
            *(f4v*)(hS + (dir * 64 + j) * 68 + rt * 32 + 8 * g + 4 * h) = o; }
    }
    __syncthreads();
    {
        const int tau = tid >> 3, v8 = (tid & 7) * 8;
        float hv[8]; float s = 0.f;
#pragma unroll
        for (int q = 0; q < 8; ++q) { hv[q] = hS[tau * 68 + v8 + q] + hS[(64 + 63 - tau) * 68 + v8 + q]; s += hv[q]; }
        s += __shfl_xor(s, 1); s += __shfl_xor(s, 2); s += __shfl_xor(s, 4);
        const float mu = s * (1.f / 64.f);
        float qq = 0.f;
#pragma unroll
        for (int q = 0; q < 8; ++q) { const float dlt = hv[q] - mu; qq += dlt * dlt; }
        qq += __shfl_xor(qq, 1); qq += __shfl_xor(qq, 2); qq += __shfl_xor(qq, 4);
        const float rstd = 1.f / sqrtf(qq * (1.f / 64.f) + EPS);
        const int t = tb + tau;
        const u4v ov = *(const u4v*)((const bf16_t*)(p.ws + WS_MLO) + (size_t)t * 256 + head * 64 + v8);
        const float* ng = p.in[I_MLG] + (size_t)l * 256 + head * 64 + v8;
        float o[8];
#pragma unroll
        for (int q = 0; q < 8; ++q) { const float og = bf2f((bf16_t)(ov[q >> 1] >> (16 * (q & 1)))); o[q] = (hv[q] - mu) * rstd * ng[q] * sigmoidf_(og); }
        u4v pk; pk[0] = pack2(o[0], o[1]); pk[1] = pack2(o[2], o[3]); pk[2] = pack2(o[4], o[5]); pk[3] = pack2(o[6], o[7]);
        *(u4v*)((bf16_t*)(p.ws + WS_MIXED) + (size_t)t * MIXW + 384 + head * 64 + v8) = pk;
    }
    __syncthreads();
}

DEV int queue_next(const Params& p, char* smem, int qi) {
    int* slot = (int*)(smem + SMEM_XB + 32);
    __syncthreads();
    if (threadIdx.x == 0) {
#ifdef EMU
        unsigned* w = (unsigned*)(p.ws + WS_BAR) + QUEUE_WORD0 + 64 * qi; *slot = (int)(*w)++;
#else
        *slot = (int)__hip_atomic_fetch_add((unsigned*)(p.ws + WS_BAR) + QUEUE_WORD0 + 64 * qi, 1u, __ATOMIC_RELAXED, __HIP_MEMORY_SCOPE_AGENT);
#endif
    }
    __syncthreads();
    return *slot;
}
DEV void phase_attn(const Params& p, char* smem, int l, int qi) {
    constexpr int QB_S = DEC_SEQ / 256, QB_P = SEQ / 256;
    constexpr int U_SG = DEC_BATCH * GQH * QB_S * 2, U_SN = DEC_BATCH * NAH * QB_S, U_PN = BATCH * NAH * QB_P, U_PG = BATCH * GQH * QB_P;
    constexpr int U_MP = BATCH * MLH * NCH_P, U_MS = DEC_BATCH * MLH * NCH_S;
    constexpr int NU = U_SG + U_SN + U_PN + U_PG + U_MP + U_MS;
    const bf16_t* naq = (const bf16_t*)(p.ws + WS_NAQ); const bf16_t* nak = (const bf16_t*)(p.ws + WS_NAK); const bf16_t* nav = (const bf16_t*)(p.ws + WS_NAV);
    const bf16_t* gqq = (const bf16_t*)(p.ws + WS_GQQ); const bf16_t* gqk = (const bf16_t*)(p.ws + WS_GQK); const bf16_t* gqv = (const bf16_t*)(p.ws + WS_GQV);
    bf16_t* mixed = (bf16_t*)(p.ws + WS_MIXED);
    for (;;) {
        int u = queue_next(p, smem, qi);
        if (u >= NU) break;
        AttnDesc d; d.na = 0; d.r0 = 0; d.rlo = 0; d.rpb = nullptr; d.part = nullptr; d.out = nullptr; d.ostride = MIXW; d.n0 = 0; d.k0 = d.v0 = nullptr; d.stride0 = 0;
        if (u < U_SG) {
            const int half = u & 1, qb = (u >> 1) % QB_S, qh = (u / (2 * QB_S)) % GQH, b = u / (2 * QB_S * GQH);
            const int kvh = qh / (GQH / GQKV);
            constexpr int NCT = PAST / 64, TT = NCT + DEC_SEQ / 64, H0 = TT / 2;
            const size_t tq = (size_t)NP + (size_t)b * DEC_SEQ + qb * 256;
            d.q = gqq + tq * 384 + qh * 64; d.qstride = 384;
            const bf16_t* lk = gqk + ((size_t)NP + (size_t)b * DEC_SEQ) * 128 + kvh * 64; const bf16_t* lv = gqv + ((size_t)NP + (size_t)b * DEC_SEQ) * 128 + kvh * 64;
            if (half == 0) {
                d.n0 = NCT; d.ntiles = H0; d.stride0 = 128;
                const size_t co = (((size_t)b * DEPTH + l) * PAST) * 128 + kvh * 64;
                d.k0 = (const bf16_t*)(p.ws + WS_CGQK) + co; d.v0 = (const bf16_t*)(p.ws + WS_CGQV) + co;
                d.k1 = lk; d.v1 = lv; d.stride1 = 128;
            } else {
                d.n0 = 0; d.ntiles = TT - H0; d.stride1 = 128;
                d.k1 = lk + (size_t)(H0 - NCT) * 64 * 128; d.v1 = lv + (size_t)(H0 - NCT) * 64 * 128;
            }
            d.part = (float*)(p.ws + WS_PART) + (size_t)u * PART_STRIDE;
        } else if (u < U_SG + U_SN) {
            const int uu = u - U_SG; const int qb = uu % QB_S, hd = (uu / QB_S) % NAH, b = uu / (QB_S * NAH);
            const size_t t0 = (size_t)NP + (size_t)b * DEC_SEQ;
            d.q = naq + (t0 + qb * 256) * 384 + hd * 64; d.qstride = 384;
            d.na = 1; d.r0 = qb * 4; d.rlo = na_row_start(d.r0);
            const int rhi = na_row_start(d.r0 + 3) + KR;
            d.n0 = PAST / 64; d.ntiles = d.n0 + (rhi - d.rlo); d.stride0 = 384; d.stride1 = 384;
            const size_t co = (((size_t)b * DEPTH + l) * PAST) * 384 + hd * 64;
            d.k0 = (const bf16_t*)(p.ws + WS_CNAK) + co; d.v0 = (const bf16_t*)(p.ws + WS_CNAV) + co;
            d.k1 = nak + (t0 + (size_t)d.rlo * 64) * 384 + hd * 64; d.v1 = nav + (t0 + (size_t)d.rlo * 64) * 384 + hd * 64;
            d.rpb = p.in[I_RPB] + ((size_t)l * NAH + hd) * 15 * 31;
            d.out = mixed + (t0 + qb * 256) * MIXW + hd * 64;
        } else if (u < U_SG + U_SN + U_PN) {
            const int uu = u - U_SG - U_SN; const int qb = uu % QB_P, hd = (uu / QB_P) % NAH, b = uu / (QB_P * NAH);
            const size_t t0 = (size_t)b * SEQ;
            d.q = naq + (t0 + qb * 256) * 384 + hd * 64; d.qstride = 384;
            d.n0 = 0; d.ntiles = SEQ / 64; d.stride1 = 384; d.k1 = nak + t0 * 384 + hd * 64; d.v1 = nav + t0 * 384 + hd * 64;
            d.out = mixed + (t0 + qb * 256) * MIXW + hd * 64;
        } else if (u < U_SG + U_SN + U_PN + U_PG) {
            const int uu = u - U_SG - U_SN - U_PN; const int qb = uu % QB_P, qh = (uu / QB_P) % GQH, b = uu / (QB_P * GQH);
            const int kvh = qh / (GQH / GQKV);
            const size_t t0 = (size_t)b * SEQ;
            d.q = gqq + (t0 + qb * 256) * 384 + qh * 64; d.qstride = 384;
            d.n0 = 0; d.ntiles = SEQ / 64; d.stride1 = 128; d.k1 = gqk + t0 * 128 + kvh * 64; d.v1 = gqv + t0 * 128 + kvh * 64;
            d.out = mixed + (t0 + qb * 256) * MIXW + 640 + qh * 64;
        } else {
            int uu = u - (U_SG + U_SN + U_PN + U_PG); const int grp = uu >= U_MP ? 1 : 0; if (grp) uu -= U_MP;
            const int nch = grp ? NCH_S : NCH_P;
            mlstm_summary_unit(p, smem, grp, uu / (nch * MLH), (uu / nch) % MLH, uu % nch);
        }
        if (u < U_SG + U_SN + U_PN + U_PG) attn_unit(smem, d);
    }
}

DEV void phase_mlout(const Params& p, char* smem, int l) {
    constexpr int QB_S = DEC_SEQ / 256;
    constexpr int U_MS = DEC_BATCH * MLH * NCH_S, U_MP = BATCH * MLH * NCH_P, U_CB = DEC_BATCH * GQH * QB_S;
    const int tid = get_tid();
    for (int u = blockIdx.x; u < U_MS + U_MP + U_CB; u += gridDim.x) {
        if (u < U_MS + U_MP) { const int grp = u < U_MS ? 1 : 0; const int uu = grp ? u : u - U_MS; const int nch = grp ? NCH_S : NCH_P;
            mlstm_output_unit(p, smem, l, grp, uu / (nch * MLH), (uu / nch) % MLH, uu % nch); }
        else {
            const int uu = u - U_MS - U_MP; const int qb = uu % QB_S, qh = (uu / QB_S) % GQH, b = uu / (QB_S * GQH);
            const float* p0 = (const float*)(p.ws + WS_PART) + (size_t)(2 * uu) * PART_STRIDE; const float* p1 = p0 + PART_STRIDE;
            const int q = tid >> 1, d0 = (tid & 1) * 32;
            const float m0 = p0[256 * 64 + q], m1 = p1[256 * 64 + q], l0 = p0[256 * 64 + 256 + q], l1 = p1[256 * 64 + 256 + q];
            const float m = fmaxf(m0, m1), w0 = expf(m0 - m), w1 = expf(m1 - m);
            const float inv = 1.f / (l0 * w0 + l1 * w1);
            bf16_t* dst = (bf16_t*)(p.ws + WS_MIXED) + ((size_t)NP + (size_t)b * DEC_SEQ + qb * 256 + q) * MIXW + 640 + qh * 64 + d0;
#pragma unroll
            for (int i = 0; i < 8; ++i) {
                const f4v a = *(const f4v*)(p0 + (size_t)q * 64 + d0 + 4 * i), bb = *(const f4v*)(p1 + (size_t)q * 64 + d0 + 4 * i);
                u2v pk; pk[0] = pack2((a[0] * w0 + bb[0] * w1) * inv, (a[1] * w0 + bb[1] * w1) * inv); pk[1] = pack2((a[2] * w0 + bb[2] * w1) * inv, (a[3] * w0 + bb[3] * w1) * inv);
                *(u2v*)(dst + 4 * i) = pk;
            }
        }
    }
}

constexpr int N_PHASES = 2 + 9 * DEPTH;
#ifndef EMU
typedef const __attribute__((address_space(4))) Params* KParamsPtr;
DEV void load_params(Params& p) {
    KParamsPtr kp = (KParamsPtr)__builtin_amdgcn_kernarg_segment_ptr();
    asm volatile("" : "+s"(kp));
#pragma unroll
    for (int i = 0; i < N_IN; ++i) p.in[i] = kp->in[i];
    p.out = kp->out; p.ws = kp->ws; p.ph0 = kp->ph0; p.ph1 = kp->ph1;
}
#endif
#ifdef EMU
static char emu_smem[SMEM_BYTES + 64];
#endif
__global__ void __launch_bounds__(512, 2) mega_kernel(Params p_) {
    const int ph0 = p_.ph0, ph1 = p_.ph1;
#ifdef EMU
    char* smem = emu_smem;
#define GRID_SYNC() do {} while (0)
#else
    extern __shared__ __attribute__((aligned(16))) char smem[];
    if (threadIdx.x == 0) *(u4v*)(smem + SMEM_XB) = (u4v){0u, 0u, 0u, 0u};
    __syncthreads();
    (void)xcd_barrier_post((unsigned*)(p_.ws + WS_BAR), (volatile LAS unsigned*)(smem + SMEM_XB));
    const bool multi = (ph1 - ph0) > 1;
#define GRID_SYNC() do { if (multi) { KParamsPtr kpb = (KParamsPtr)__builtin_amdgcn_kernarg_segment_ptr(); asm volatile("" : "+s"(kpb)); \
        XcdBarrier xb; xb.bar = (unsigned*)(kpb->ws + WS_BAR); xb.x = xb_xcc_id(); xb.st = (volatile LAS unsigned*)(smem + SMEM_XB); xcd_barrier(xb); } } while (0)
#endif
    int ph = 0;
#ifndef KIND_MASK
#define KIND_MASK 0x3ff
#endif
#ifdef EMU
#define LOAD_PARAMS() const Params& p = p_
#else
#define LOAD_PARAMS() Params p; load_params(p)
#endif
#ifndef DOUBLE_MASK
#define DOUBLE_MASK 0
#endif
#define PH_KIND() (ph == 0 ? 0 : ph == 1 + 9 * DEPTH ? 1 : 1 + (ph - 1) % 9)
#define RUN_PHASE(body) do { if (((KIND_MASK >> PH_KIND()) & 1) && ph >= ph0 && ph < ph1) { \
    if (DOUBLE_MASK && ((DOUBLE_MASK >> PH_KIND()) & 1)) { { const int rep_ = 1; LOAD_PARAMS(); body; } GRID_SYNC(); } \
    { const int rep_ = 0; LOAD_PARAMS(); body; } if (ph + 1 < ph1) GRID_SYNC(); } ++ph; } while (0)
    RUN_PHASE(phase_ada(p, smem));
    for (int l = 0; l < DEPTH; ++l) {
        RUN_PHASE(phase_rows<0>(p, smem, l));
        RUN_PHASE(phase_inproj<0>(p, smem, l));
        RUN_PHASE(phase_attn(p, smem, l, l + DEPTH * rep_));
        RUN_PHASE(phase_mlout(p, smem, l));
        RUN_PHASE(phase_outproj<0>(p, smem, l));
        RUN_PHASE(phase_rows<1>(p, smem, l));
        RUN_PHASE(phase_topk(p, smem));
        RUN_PHASE(phase_gateup<0>(p, smem, l));
        RUN_PHASE(phase_down<0>(p, smem, l));
    }
    RUN_PHASE(phase_rows<0>(p, smem, DEPTH));
}

#if !defined(EMU) && defined(PROBE_KIND)
__global__ void __launch_bounds__(512, 2) probe_kernel(Params p) {
    extern __shared__ __attribute__((aligned(16))) char smem[];
    for (int r = 0; r < PROBE_REPS; ++r) {
#if PROBE_KIND == 8
        phase_gateup<PROBE_VAR>(p, smem, 1);
#elif PROBE_KIND == 9
        phase_down<PROBE_VAR>(p, smem, 1);
#elif PROBE_KIND == 2
        phase_inproj<PROBE_VAR>(p, smem, 1);
#elif PROBE_KIND == 5
        phase_outproj<PROBE_VAR>(p, smem, 1);
#elif PROBE_KIND == 0
        phase_ada(p, smem);
#elif PROBE_KIND == 1
        phase_rows<0>(p, smem, 1);
#elif PROBE_KIND == 6
        phase_rows<1>(p, smem, 1);
#elif PROBE_KIND == 7
        phase_topk(p, smem);
#elif PROBE_KIND == 3
        phase_attn(p, smem, 1, 8 + r);
#elif PROBE_KIND == 4
        phase_mlout(p, smem, 1);
#endif
        __syncthreads();
    }
}
#endif
#ifndef EMU
#ifndef MK_N_LAUNCHES
#define MK_N_LAUNCHES 1
#endif
extern "C" void kernel_launch(void* const* d_in, const int* in_sizes, int n_in, void* d_out, int out_size, void* d_ws, size_t ws_size, hipStream_t stream) {
    (void)in_sizes; (void)n_in; (void)out_size; (void)ws_size;
    static int grid = 0;
    if (!grid) {
        int dev = 0, cus = 0, per_cu = 0;
        (void)hipGetDevice(&dev);
        (void)hipDeviceGetAttribute(&cus, hipDeviceAttributeMultiprocessorCount, dev);
        (void)hipFuncSetAttribute((const void*)mega_kernel, hipFuncAttributeMaxDynamicSharedMemorySize, SMEM_BYTES);
        (void)hipOccupancyMaxActiveBlocksPerMultiprocessor(&per_cu, mega_kernel, 512, SMEM_BYTES);
        grid = cus * (per_cu < 1 ? per_cu : 1);
        if (grid <= 0) grid = cus;
    }
    (void)hipMemsetAsync((char*)d_ws + WS_BAR, 0, WS_BAR_BYTES, stream);
    Params p = {};
    for (int i = 0; i < N_IN; ++i) p.in[i] = (const float*)d_in[i];
    p.out = (float*)d_out; p.ws = (char*)d_ws;
#if MK_N_LAUNCHES == 1
    p.ph0 = 0; p.ph1 = N_PHASES;
    mega_kernel<<<dim3(grid), dim3(512), SMEM_BYTES, stream>>>(p);
#ifdef PROBE_KIND
    (void)hipFuncSetAttribute((const void*)probe_kernel, hipFuncAttributeMaxDynamicSharedMemorySize, SMEM_BYTES);
    probe_kernel<<<dim3(grid), dim3(512), SMEM_BYTES, stream>>>(p);
#endif
#else
    for (int ph = 0; ph < N_PHASES; ++ph) { p.ph0 = ph; p.ph1 = ph + 1; mega_kernel<<<dim3(grid), dim3(512), SMEM_BYTES, stream>>>(p); }
#endif
}
#endif
```

```cpp
#ifndef EMU
#include <hip/hip_runtime.h>
#define DEV __device__ __forceinline__
#else
#define DEV static inline __attribute__((always_inline))
#endif
#include <stdint.h>
#include <stddef.h>

#ifndef CFG_D
#define CFG_D 1024
#define CFG_BATCH 16
#define CFG_SEQ 256
#define CFG_DEC_BATCH 2
#define CFG_DEC_SEQ 2048
#define CFG_PAST 256
#define CFG_EH 2816
#endif
constexpr int D = CFG_D, BATCH = CFG_BATCH, SEQ = CFG_SEQ, DEC_BATCH = CFG_DEC_BATCH, DEC_SEQ = CFG_DEC_SEQ, PAST = CFG_PAST, EH = CFG_EH;
constexpr int DEPTH = 2, HD = 64, NAH = 6, MLH = 4, GQH = 6, GQKV = 2, NEXP = 16, GRIDW = 64;
constexpr int NP = BATCH * SEQ, NS = DEC_BATCH * DEC_SEQ, NT = NP + NS, NCOND = 1 + DEC_BATCH;
constexpr int PROJ_W = 2832, MIXW = 1024;
constexpr int CAP_P = SEQ / 8, CAP_S = DEC_SEQ / 8, SLOTS = BATCH * CAP_P + DEC_BATCH * CAP_S;
constexpr int ROWS = DEC_SEQ / GRIDW, KR = ROWS < 8 ? ROWS : 8, KC = 16;
constexpr int NCH_P = SEQ / 64, NCH_S = DEC_SEQ / 64;
constexpr float ALPHA = 1.41421356237309515f;
constexpr float ATT_SCALE = 0.125f;
constexpr float EPS = 1e-6f;
static_assert(SLOTS % 256 == 0 && NP % 256 == 0 && NS % 256 == 0 && SEQ % 256 == 0 && DEC_SEQ % 256 == 0, "tile divisibility");
static_assert(D % 256 == 0 && EH % 128 == 0 && PAST % 64 == 0, "tile divisibility");

typedef unsigned short bf16_t;
typedef short s8v __attribute__((ext_vector_type(8)));
typedef short s4v __attribute__((ext_vector_type(4)));
typedef float f16v __attribute__((ext_vector_type(16)));
typedef float f4v __attribute__((ext_vector_type(4)));
typedef unsigned u4v __attribute__((ext_vector_type(4)));
typedef unsigned u2v __attribute__((ext_vector_type(2)));

enum { I_XP = 0, I_XS, I_C, I_CNAK, I_CNAV, I_CGQK, I_CGQV, I_SC, I_SN, I_SM, I_CCTX, I_ADAW, I_ADAB, I_WIN, I_BGATE, I_WOUT, I_RPB, I_QKG, I_MLG,
       I_LNG, I_LNB, I_RW, I_WG, I_WU, I_WD, N_IN };

constexpr size_t O_YP = 0;
constexpr size_t O_YS = O_YP + (size_t)NP * D;
constexpr size_t O_NAK = O_YS + (size_t)NS * D;
constexpr size_t O_NAV = O_NAK + (size_t)BATCH * DEPTH * SEQ * NAH * HD;
constexpr size_t O_GQK = O_NAV + (size_t)BATCH * DEPTH * SEQ * NAH * HD;
constexpr size_t O_GQV = O_GQK + (size_t)BATCH * DEPTH * SEQ * GQKV * HD;
constexpr size_t O_MC = O_GQV + (size_t)BATCH * DEPTH * SEQ * GQKV * HD;
constexpr size_t O_MN = O_MC + (size_t)BATCH * DEPTH * 2 * MLH * HD * HD;
constexpr size_t O_MM = O_MN + (size_t)BATCH * DEPTH * 2 * MLH * HD;
constexpr size_t O_END = O_MM + (size_t)BATCH * DEPTH * 2 * MLH;

constexpr size_t al256(size_t x) { return (x + 255) & ~(size_t)255; }
constexpr size_t WS_BAR = 0;
constexpr size_t WS_BAR_BYTES = 32768;
constexpr size_t WS_MODS = WS_BAR + WS_BAR_BYTES;
constexpr size_t WS_ROPE = al256(WS_MODS + (size_t)DEPTH * NCOND * 6 * D * 4);
constexpr size_t WS_CNAK = al256(WS_ROPE + 64 * 16 * 2 * 4);
constexpr size_t WS_CNAV = al256(WS_CNAK + (size_t)DEC_BATCH * DEPTH * PAST * NAH * HD * 2);
constexpr size_t WS_CGQK = al256(WS_CNAV + (size_t)DEC_BATCH * DEPTH * PAST * NAH * HD * 2);
constexpr size_t WS_CGQV = al256(WS_CGQK + (size_t)DEC_BATCH * DEPTH * PAST * GQKV * HD * 2);
constexpr size_t WS_XBUF = al256(WS_CGQV + (size_t)DEC_BATCH * DEPTH * PAST * GQKV * HD * 2);
constexpr size_t WS_HMOD = al256(WS_XBUF + (size_t)NT * D * 4);
constexpr size_t WS_GATES = al256(WS_HMOD + (size_t)NT * D * 2);
constexpr size_t WS_NAQ = al256(WS_GATES + (size_t)NT * 16 * 4);
constexpr size_t WS_NAK = al256(WS_NAQ + (size_t)NT * 384 * 2);
constexpr size_t WS_NAV = al256(WS_NAK + (size_t)NT * 384 * 2);
constexpr size_t WS_MLQ = al256(WS_NAV + (size_t)NT * 384 * 2);
constexpr size_t WS_MLK = al256(WS_MLQ + (size_t)NT * 256 * 2);
constexpr size_t WS_MLV = al256(WS_MLK + (size_t)NT * 256 * 2);
constexpr size_t WS_MLO = al256(WS_MLV + (size_t)NT * 256 * 2);
constexpr size_t WS_GQQ = al256(WS_MLO + (size_t)NT * 256 * 2);
constexpr size_t WS_GQK = al256(WS_GQQ + (size_t)NT * 384 * 2);
constexpr size_t WS_GQV = al256(WS_GQK + (size_t)NT * 128 * 2);
constexpr size_t WS_MIXED = al256(WS_GQV + (size_t)NT * 128 * 2);
constexpr size_t WS_U = al256(WS_MIXED + (size_t)NT * MIXW * 2);
constexpr size_t WS_X1 = al256(WS_U + (size_t)NT * D * 4);
constexpr size_t WS_H2 = al256(WS_X1 + (size_t)NT * D * 4);
constexpr size_t WS_AFF = al256(WS_H2 + (size_t)NT * D * 2);
constexpr size_t WS_IDX = al256(WS_AFF + (size_t)NT * 16 * 4);
constexpr size_t WS_GSEL = al256(WS_IDX + (size_t)NEXP * SLOTS * 4);
constexpr size_t WS_TOKSLOT = al256(WS_GSEL + (size_t)NEXP * SLOTS * 4);
constexpr size_t WS_HID = al256(WS_TOKSLOT + (size_t)NT * 16 * 4);
constexpr size_t WS_YE = al256(WS_HID + (size_t)NEXP * SLOTS * EH * 2);
constexpr int MLSUM_STRIDE = 4096 + 64 + 64;
constexpr int N_MLSUM = (BATCH * NCH_P + DEC_BATCH * NCH_S) * MLH * 2;
constexpr size_t WS_MLSUM = al256(WS_YE + (size_t)NEXP * SLOTS * D * 2);
constexpr int PART_STRIDE = 256 * 64 + 512;
constexpr int N_PART = DEC_BATCH * GQH * (DEC_SEQ / 256) * 2;
constexpr size_t WS_PART = al256(WS_MLSUM + (size_t)N_MLSUM * MLSUM_STRIDE * 4);
constexpr size_t WS_TOTAL = al256(WS_PART + (size_t)N_PART * PART_STRIDE * 4);

struct Params {
    const float* in[N_IN];
    float* out;
    char* ws;
    int ph0, ph1;
};

DEV float bf2f(bf16_t s) { unsigned u = ((unsigned)s) << 16; return __builtin_bit_cast(float, u); }
DEV bf16_t f2bf(float f) {
#ifdef EMU
    unsigned u = __builtin_bit_cast(unsigned, f); u += 0x7fffu + ((u >> 16) & 1u); return (bf16_t)(u >> 16);
#else
    return __builtin_bit_cast(bf16_t, (__bf16)f);
#endif
}
DEV unsigned pack2(float a, float b) {
#ifdef EMU
    return (unsigned)f2bf(a) | ((unsigned)f2bf(b) << 16);
#else
    typedef __bf16 b2 __attribute__((ext_vector_type(2))); b2 r; r[0] = (__bf16)a; r[1] = (__bf16)b; return __builtin_bit_cast(unsigned, r);
#endif
}
DEV float fexp(float x) {
#ifdef EMU
    return expf(x);
#else
    return __expf(x);
#endif
}
DEV float sigmoidf_(float x) { return 1.f / (1.f + fexp(-x)); }
DEV float siluf_(float x) { return x / (1.f + fexp(-x)); }
DEV float logsigmoidf_(float x) { return fminf(x, 0.f) - log1pf(expf(-fabsf(x))); }
DEV f16v mfma32(s8v a, s8v b, f16v c) {
#ifdef EMU
    return emu_mfma_32x32x16_bf16(a, b, c);
#else
    typedef __bf16 bf8 __attribute__((ext_vector_type(8)));
    return __builtin_amdgcn_mfma_f32_32x32x16_bf16(__builtin_bit_cast(bf8, a), __builtin_bit_cast(bf8, b), c, 0, 0, 0);
#endif
}
DEV s4v lds_tr16(const void* p) {
#ifdef EMU
    return emu_ds_read_tr16_b64(p);
#else
    typedef s4v __attribute__((address_space(3))) * lp;
    return __builtin_amdgcn_ds_read_tr16_b64_v4i16((lp)(p));
#endif
}
#ifdef EMU
DEV float wave_sum(float v) { for (int m = 32; m >= 1; m >>= 1) v += __shfl_xor(v, m); return v; }
#else
template <int CTRL, int RM> DEV float dpp_f(float v) { return __builtin_bit_cast(float, __builtin_amdgcn_update_dpp(0, __builtin_bit_cast(int, v), CTRL, RM, 0xF, false)); }
DEV float wave_sum(float v) {
    v += dpp_f<0xB1, 0xF>(v); v += dpp_f<0x4E, 0xF>(v); v += dpp_f<0x141, 0xF>(v); v += dpp_f<0x140, 0xF>(v);
    v += dpp_f<0x142, 0xA>(v); v += dpp_f<0x143, 0xC>(v);
    return __builtin_bit_cast(float, __builtin_amdgcn_readlane(__builtin_bit_cast(int, v), 63));
}
#endif
DEV float wave_max(float v) { for (int m = 32; m >= 1; m >>= 1) v = fmaxf(v, __shfl_xor(v, m)); return v; }
DEV f16v f16zero() { f16v z; for (int i = 0; i < 16; ++i) z[i] = 0.f; return z; }

#ifdef EMU
#define VGPR_PIN(x) do {} while (0)
#define SGPR_PIN(x) do {} while (0)
#define SCHED_FENCE() do {} while (0)
#define CFENCE() do {} while (0)
#else
#define SCHED_FENCE() __builtin_amdgcn_sched_barrier(0)
#define SGPR_PIN(x) asm volatile("" : "+s"(x))
#define VGPR_PIN(x) asm volatile("" : "+v"(x))
#define CFENCE() asm volatile("" ::: "memory")
#endif
#ifdef EMU
DEV int get_tid() { return (int)threadIdx.x; }
#else
DEV int get_tid() { int t = threadIdx.x; asm volatile("" : "+v"(t)); return t; }
#endif
struct UnitIter { int i, end, step; };
DEV UnitIter unit_iter(int NU) {
    const int G = (int)gridDim.x, b = (int)blockIdx.x;
    UnitIter it;
#ifndef XCD_MODE
#define XCD_MODE 0
#endif
    if ((G & 7) == 0 && (NU & 7) == 0) { const int W = G >> 3, x = XCD_MODE ? b / W : b & 7, j = XCD_MODE ? b % W : b >> 3, C = NU >> 3; it.i = x * C + j; it.end = (x + 1) * C; it.step = W; }
    else { it.i = b; it.end = NU; it.step = G; }
    return it;
}
DEV int tok_cond(int t) { return t < NP ? 0 : 1 + (t - NP) / DEC_SEQ; }

#ifndef EMU
#define XB_TMO      128
#define XB_XCNT(j)  (256  + 64 * (j))
#define XB_XSUB(j)  (1280 + 64 * (j))
#define XB_XGEN(j)  (2304 + 64 * (j))
#define XB_TOP      3328
#define XB_TOPGEN   3392
#define XCD_BAR_WORDS 3456
#define XB_SPIN_CAP (1u << 20)
#define LAS __attribute__((address_space(3)))
__device__ __forceinline__ unsigned xb_ld(unsigned* p)              { return __hip_atomic_load(p, __ATOMIC_RELAXED, __HIP_MEMORY_SCOPE_AGENT); }
__device__ __forceinline__ unsigned xb_add(unsigned* p, unsigned v) { return __hip_atomic_fetch_add(p, v, __ATOMIC_RELAXED, __HIP_MEMORY_SCOPE_AGENT); }
__device__ __forceinline__ unsigned xb_xcc_id() { return (unsigned)__builtin_amdgcn_s_getreg((3 << 11) | 20) & 0xFu; }
#define XB_SPIN(cond, bar) do { unsigned _sp = 0; while (cond) { __builtin_amdgcn_s_sleep(1); \
    if ((++_sp & 255u) == 0u) { if (xb_ld(&(bar)[XB_TMO])) break; if (_sp > XB_SPIN_CAP) { atomicAdd(&(bar)[XB_TMO], 1u); break; } } } } while (0)
struct XcdBarrier { unsigned* bar; unsigned x; volatile LAS unsigned* st; };
__device__ __forceinline__ XcdBarrier xcd_barrier_post(unsigned* bar, volatile LAS unsigned* st) {
    XcdBarrier b; b.bar = bar; b.x = xb_xcc_id(); b.st = st;
    if (threadIdx.x == 0) (void)xb_add(&bar[XB_XCNT(b.x)], 1u);
    return b;
}
__device__ __forceinline__ void xcd_barrier_complete(unsigned* bar, unsigned x, unsigned& nloc, unsigned& nx) {
    const unsigned G = gridDim.x * gridDim.y * gridDim.z;
    unsigned sum, cnt, mine, sp = 0u;
    for (;;) {
        sum = 0u; cnt = 0u; mine = 0u;
#pragma unroll
        for (unsigned j = 0; j < 16; ++j) { const unsigned c = xb_ld(&bar[XB_XCNT(j)]); sum += c; cnt += (c > 0u) ? 1u : 0u; mine = (j == x) ? c : mine; }
        if (sum == G) break;
        __builtin_amdgcn_s_sleep(1);
        if ((++sp & 255u) == 0u) { if (xb_ld(&bar[XB_TMO])) break; if (sp > XB_SPIN_CAP) { atomicAdd(&bar[XB_TMO], 1u); break; } }
    }
    nloc = mine > 0u ? mine : 1u; nx = cnt > 0u ? cnt : 1u;
}
__device__ __forceinline__ void xcd_barrier(const XcdBarrier& b) {
    asm volatile("s_waitcnt vmcnt(0)" ::: "memory");
    __syncthreads();
    if (threadIdx.x == 0) {
        unsigned* bar = b.bar;
        __builtin_amdgcn_s_waitcnt(0);
        unsigned nloc = b.st[0], nx = b.st[1];
        if (nloc == 0u) { xcd_barrier_complete(bar, b.x, nloc, nx); b.st[0] = nloc; b.st[1] = nx; }
        const unsigned old = xb_add(&bar[XB_XSUB(b.x)], 1u);
        const unsigned gen = old / nloc;
        if (old + 1u == (gen + 1u) * nloc) {
            __builtin_amdgcn_fence(__ATOMIC_RELEASE, "agent");
            asm volatile("s_waitcnt vmcnt(0)" ::: "memory");
            const unsigned og = xb_add(&bar[XB_TOP], 1u);
            const unsigned tg = og / nx;
            if (og + 1u == (tg + 1u) * nx) xb_add(&bar[XB_TOPGEN], 1u);
            else XB_SPIN(xb_ld(&bar[XB_TOPGEN]) == tg, bar);
            __builtin_amdgcn_fence(__ATOMIC_ACQUIRE, "agent");
            xb_add(&bar[XB_XGEN(b.x)], 1u);
            asm volatile("s_waitcnt vmcnt(0)" ::: "memory");
        } else {
            XB_SPIN(xb_ld(&bar[XB_XGEN(b.x)]) == gen, bar);
            __builtin_amdgcn_fence(__ATOMIC_ACQUIRE, "agent");
            asm volatile("s_waitcnt vmcnt(0)" ::: "memory");
        }
    }
    __syncthreads();
}
#endif
constexpr int QUEUE_WORD0 = 4096;

constexpr int LROW = 144;
constexpr int GEMM_AS = 256 * LROW;
constexpr int GEMM_BS = 64 * (256 * 2 + 64);
constexpr int SMEM_BYTES = 2 * GEMM_AS + 2 * GEMM_BS + 64;
constexpr int SMEM_XB = 2 * GEMM_AS + 2 * GEMM_BS;

#ifdef EMU
struct BufRsrc { const char* base; };
DEV BufRsrc make_rsrc(const void* p) { BufRsrc r; r.base = (const char*)p; return r; }
DEV float buf_load_f32(BufRsrc r, unsigned voff, unsigned soff) { return *(const float*)(r.base + voff + soff); }
DEV u4v buf_load_b128(BufRsrc r, unsigned voff, unsigned soff) { return *(const u4v*)(r.base + voff + soff); }
#else
typedef __amdgpu_buffer_rsrc_t BufRsrc;
DEV BufRsrc make_rsrc(const void* p) { return __builtin_amdgcn_make_buffer_rsrc((void*)p, 0, 0x7fffffff, 0x00020000); }
DEV float buf_load_f32(BufRsrc r, unsigned voff, unsigned soff) { return __builtin_bit_cast(float, __builtin_amdgcn_raw_buffer_load_b32(r, voff, soff, 0)); }
DEV u4v buf_load_b128(BufRsrc r, unsigned voff, unsigned soff) { return __builtin_amdgcn_raw_buffer_load_b128(r, voff, soff, 0); }
#endif
#ifdef EMU
#define WAVE_SYNC() do { (void)__shfl(0, 0); } while (0)
#else
#define WAVE_SYNC() asm volatile("s_waitcnt lgkmcnt(0)" ::: "memory")
#endif
DEV char* wave_stage_ptr(char* smem, int wave) { return smem + (wave < 4 ? GEMM_AS + wave * 9216 : 2 * GEMM_AS + GEMM_BS + (wave - 4) * 9216); }
DEV void stage64_write_bf16(char* stg, int tt, const f16v& v0, const f16v& v1, int l31, int h) {
    char* row = stg + (tt * 32 + l31) * LROW;
#pragma unroll
    for (int ft = 0; ft < 2; ++ft) {
        const f16v& v = ft ? v1 : v0;
#pragma unroll
        for (int g = 0; g < 4; ++g) { u2v pk; pk[0] = pack2(v[4 * g], v[4 * g + 1]); pk[1] = pack2(v[4 * g + 2], v[4 * g + 3]); *(u2v*)(row + (ft * 32 + 8 * g + 4 * h) * 2) = pk; }
    }
}
DEV void stage64_write4(char* stg, int row, int col, float a, float b, float c, float d) {
    u2v pk; pk[0] = pack2(a, b); pk[1] = pack2(c, d); *(u2v*)(stg + row * LROW + col * 2) = pk;
}
DEV void stage64_flush_bf16(const char* stg, bf16_t* dst0, size_t row_stride, int lane) {
    WAVE_SYNC();
#pragma unroll
    for (int i = 0; i < 8; ++i) { const int r = (lane >> 3) + 8 * i, c = lane & 7; const u4v v = *(const u4v*)(stg + r * LROW + c * 16); *(u4v*)(dst0 + (size_t)r * row_stride + c * 8) = v; }
    WAVE_SYNC();
}
template <int NTW, int VAR, class Epi>
DEV void gemm_tile(char* smem, BufRsrc ars, unsigned ao0, unsigned ao1, unsigned ao2, unsigned ao3,
                   BufRsrc brs, unsigned bvo, unsigned blds, unsigned ldb4, int K, Epi&& epi) {
    constexpr int BN = 64 * NTW, NLD = 2 * NTW, KSTEP = 64 / NLD, RSB = BN * 2 + 64;
    const int tid = get_tid(), lane = tid & 63, wave = tid >> 6, wm = wave & 3, wn = wave >> 2, h = lane >> 5, l31 = lane & 31;
    char* As = smem; char* Bs = smem + 2 * GEMM_AS;
    constexpr int BSZ = GEMM_BS;
    const int ar = tid >> 3, ac = tid & 7;
    u4v areg[2]; f4v b0[NLD], b1[NLD];
    if (VAR & 3) { for (int i = 0; i < 2; ++i) areg[i] = (u4v){1u, 2u, 3u, 4u}; for (int j = 0; j < NLD; ++j) { b0[j] = (f4v){1.f, 1.f, 1.f, 1.f}; b1[j] = (f4v){2.f, 2.f, 2.f, 2.f}; } }
    f16v acc[NTW][2];
#pragma unroll
    for (int i = 0; i < NTW; ++i) { acc[i][0] = f16zero(); acc[i][1] = f16zero(); }
    auto gloadA = [&](int k0, bool real, int half) {
        if (VAR & 2) return;
        const unsigned so = real ? k0 * 2 : 0u;
        areg[0] = buf_load_b128(ars, real ? (half ? ao2 : ao0) : 0u, so); areg[1] = buf_load_b128(ars, real ? (half ? ao3 : ao1) : 0u, so);
    };
    auto gloadB = [&](int k0, bool real, f4v (&br)[NLD]) {
        if (VAR & 1) return;
        const unsigned vo = real ? bvo : 0u; const int kk = real ? k0 : 0;
        unsigned so = (unsigned)kk * ldb4;
#pragma unroll
        for (int j = 0; j < NLD; ++j) { br[j] = __builtin_bit_cast(f4v, buf_load_b128(brs, vo, so)); so += KSTEP * ldb4; SGPR_PIN(so); }
    };
    auto lstoreA = [&](int buf, int half) {
        if (VAR & 16) return;
        char* ab = As + buf * GEMM_AS + (ar + half * 128) * LROW + ac * 16;
        *(u4v*)(ab) = areg[0]; *(u4v*)(ab + 64 * LROW) = areg[1];
    };
    auto lstoreB = [&](int buf, const f4v (&br)[NLD]) {
        if (VAR & 16) return;
        char* bb = Bs + buf * BSZ + blds;
#pragma unroll
        for (int j = 0; j < NLD; ++j) { u2v v; v[0] = pack2(br[j][0], br[j][1]); v[1] = pack2(br[j][2], br[j][3]); *(u2v*)(bb + j * KSTEP * RSB) = v; }
    };
    const unsigned btr = (unsigned)(8 * h + ((lane & 15) >> 2)) * RSB + (unsigned)((((lane >> 4) & 1) * 16 + 4 * (lane & 3)) * 2) + (unsigned)(wn * NTW * 32) * 2;
    const unsigned atr = (unsigned)(wm * 64 + l31) * LROW + h * 16;
    auto rdw = [&](int buf, int s, int ft) -> s8v {
        const char* bb = Bs + buf * BSZ + btr + s * 16 * RSB + ft * 64;
        const s4v lo = lds_tr16(bb), hi = lds_tr16(bb + 4 * RSB);
        s8v wf; wf[0] = lo[0]; wf[1] = lo[1]; wf[2] = lo[2]; wf[3] = lo[3]; wf[4] = hi[0]; wf[5] = hi[1]; wf[6] = hi[2]; wf[7] = hi[3];
        return wf;
    };
    auto compute2 = [&](int buf, int s0) {
        if (VAR & 8) return;
        const char* ab = As + buf * GEMM_AS + atr;
        s8v xa[2];
        xa[0] = *(const s8v*)(ab + s0 * 32); xa[1] = *(const s8v*)(ab + 32 * LROW + s0 * 32);
        s8v wcur = rdw(buf, s0, 0);
#pragma unroll
        for (int g = 0; g < 2 * NTW; ++g) {
            const int ft = g % NTW;
            s8v wnext = wcur;
            if (g + 1 < 2 * NTW) wnext = rdw(buf, s0 + (g + 1) / NTW, (g + 1) % NTW);
            if (VAR & 4) { acc[ft][0][0] += __builtin_bit_cast(float, (int)wcur[0] | ((int)xa[0][1] << 16)); acc[ft][1][0] += __builtin_bit_cast(float, (int)wcur[1] | ((int)xa[1][1] << 16)); }
            else { acc[ft][0] = mfma32(wcur, xa[0], acc[ft][0]); acc[ft][1] = mfma32(wcur, xa[1], acc[ft][1]); }
            if (g == NTW - 1) { xa[0] = *(const s8v*)(ab + (s0 + 1) * 32); xa[1] = *(const s8v*)(ab + 32 * LROW + (s0 + 1) * 32); }
            wcur = wnext;
            SCHED_FENCE();
        }
    };
    const int nk = K / 64;
    if (NTW == 2) {
        u4v a0[4], a1[4];
        if (VAR & 3) { for (int i = 0; i < 4; ++i) { a0[i] = (u4v){1u, 2u, 3u, 4u}; a1[i] = (u4v){1u, 2u, 3u, 4u}; } }
        auto gA = [&](int k0, bool real, u4v (&ar4)[4]) {
            if (VAR & 2) return;
            const unsigned so = real ? k0 * 2 : 0u;
            ar4[0] = buf_load_b128(ars, real ? ao0 : 0u, so); ar4[1] = buf_load_b128(ars, real ? ao1 : 0u, so);
            ar4[2] = buf_load_b128(ars, real ? ao2 : 0u, so); ar4[3] = buf_load_b128(ars, real ? ao3 : 0u, so);
        };
        auto sA = [&](int buf, const u4v (&ar4)[4]) {
            if (VAR & 16) return;
            char* ab = As + buf * GEMM_AS + ar * LROW + ac * 16;
#pragma unroll
            for (int i = 0; i < 4; ++i) *(u4v*)(ab + i * 64 * LROW) = ar4[i];
        };
        gA(0, true, a0); gloadB(0, true, b0); gA(64, true, a1); gloadB(64, true, b1);
        sA(0, a0); lstoreB(0, b0);
        __syncthreads();
        for (int kt = 0; kt < nk; kt += 2) {
            const bool t2 = kt + 2 < nk;
            gA((kt + 2) * 64, t2, a0); gloadB((kt + 2) * 64, t2, b0);
            compute2(0, 0); compute2(0, 2);
            sA(1, a1); lstoreB(1, b1);
            __syncthreads();
            gA((kt + 3) * 64, t2, a1); gloadB((kt + 3) * 64, t2, b1);
            compute2(1, 0); compute2(1, 2);
            sA(0, a0); lstoreB(0, b0);
            __syncthreads();
        }
    } else {
    gloadA(0, true, 0); gloadB(0, true, b0); lstoreA(0, 0); gloadA(0, true, 1); gloadB(64, true, b1); lstoreA(0, 1); lstoreB(0, b0);
    __syncthreads();
    for (int kt = 0; kt < nk; kt += 2) {
        const bool t2 = kt + 2 < nk;
        gloadA((kt + 1) * 64, true, 0);
        compute2(0, 0);
        lstoreA(1, 0);
        gloadA((kt + 1) * 64, true, 1);
        gloadB((kt + 2) * 64, t2, b0);
        compute2(0, 2);
        lstoreA(1, 1); lstoreB(1, b1);
        __syncthreads();
        gloadA((kt + 2) * 64, t2, 0);
        compute2(1, 0);
        lstoreA(0, 0);
        gloadA((kt + 2) * 64, t2, 1);
        gloadB((kt + 3) * 64, t2, b1);
        compute2(1, 2);
        lstoreA(0, 1); lstoreB(0, b0);
        __syncthreads();
    }
    }
    if (VAR & 32) { float t = 0.f; for (int i = 0; i < NTW; ++i) t += acc[i][0][0] + acc[i][1][5]; if (t == 123.456f) *(float*)smem = t; }
    else epi(acc);
}

DEV void phase_ada(const Params& p, char* smem) {
    const int tid = get_tid();
    float* siluS = (float*)smem;
    float* red = (float*)(smem + NCOND * D * 4);
    for (int i = tid; i < NCOND * D; i += 512) {
        const int cnd = i / D, k = i % D;
        const float c = cnd == 0 ? p.in[I_CCTX][k] : p.in[I_C][(cnd - 1) * D + k];
        siluS[i] = c / (1.f + expf(-c));
    }
    __syncthreads();
    constexpr int CPL = 6 * D / 32, NCHUNK = DEPTH * CPL, KG = D / 16;
    float* mods = (float*)(p.ws + WS_MODS);
    const int col = tid & 31, kg = tid >> 5;
    for (int u = blockIdx.x; u < NCHUNK; u += gridDim.x) {
        const int l = u / CPL, c0 = (u % CPL) * 32;
        const float* W = p.in[I_ADAW] + (size_t)l * D * 6 * D + c0 + col;
        float acc[NCOND];
#pragma unroll
        for (int c = 0; c < NCOND; ++c) acc[c] = 0.f;
#pragma unroll 8
        for (int k = kg * KG; k < kg * KG + KG; ++k) {
            const float w = W[(size_t)k * 6 * D];
#pragma unroll
            for (int c = 0; c < NCOND; ++c) acc[c] += siluS[c * D + k] * w;
        }
#pragma unroll
        for (int c = 0; c < NCOND; ++c) red[(kg * NCOND + c) * 32 + col] = acc[c];
        __syncthreads();
        if (tid < 32 * NCOND) {
            const int c = tid >> 5, cc = tid & 31;
            float s = 0.f;
            for (int g = 0; g < 16; ++g) s += red[(g * NCOND + c) * 32 + cc];
            mods[((size_t)l * NCOND + c) * 6 * D + c0 + cc] = s + p.in[I_ADAB][(size_t)l * 6 * D + c0 + cc];
        }
        __syncthreads();
    }
    const int gtid = blockIdx.x * 512 + tid, gsz = gridDim.x * 512;
    float* rope = (float*)(p.ws + WS_ROPE);
    for (int i = gtid; i < 64 * 16; i += gsz) {
        const int pos = i >> 4, fi = i & 15;
        const float inv = powf(10000.f, -(float)(2 * fi) / 32.f);
        const float ang = (float)pos * inv;
        rope[2 * i] = cosf(ang); rope[2 * i + 1] = sinf(ang);
    }
    constexpr int NNA = DEC_BATCH * DEPTH * PAST * NAH * HD, NGQ = DEC_BATCH * DEPTH * PAST * GQKV * HD;
    bf16_t* cnak = (bf16_t*)(p.ws + WS_CNAK); bf16_t* cnav = (bf16_t*)(p.ws + WS_CNAV);
    bf16_t* cgqk = (bf16_t*)(p.ws + WS_CGQK); bf16_t* cgqv = (bf16_t*)(p.ws + WS_CGQV);
    for (int i = gtid; i < NNA; i += gsz) { cnak[i] = f2bf(p.in[I_CNAK][i]); cnav[i] = f2bf(p.in[I_CNAV][i]); }
    for (int i = gtid; i < NGQ; i += gsz) { cgqk[i] = f2bf(p.in[I_CGQK][i]); cgqv[i] = f2bf(p.in[I_CGQV][i]); }
}

constexpr int EPL = D / 64;
constexpr int W16ROW = 20;
template <int MODE>
DEV void phase_rows(const Params& p, char* smem, int l) {
    const int tid = get_tid(), lane = tid & 63, wave = tid >> 6;
    float* W16 = (float*)smem;
    const bool need_w = (MODE == 1) || (l < DEPTH);
    if (need_w) {
        for (int i = tid; i < D * 4; i += 512) {
            const int k = i >> 2, q = i & 3;
            const float* src = (MODE == 1) ? p.in[I_RW] + ((size_t)l * D + k) * 16 + q * 4 : p.in[I_WIN] + ((size_t)l * D + k) * PROJ_W + 2176 + q * 4;
            *(f4v*)(W16 + k * W16ROW + q * 4) = *(const f4v*)src;
        }
    }
    __syncthreads();
    const float* mods = (const float*)(p.ws + WS_MODS);
    for (int t = blockIdx.x * 8 + wave; t < NT; t += gridDim.x * 8) {
        const int cnd = tok_cond(t);
        float v[EPL];
        if (MODE == 0 && l == 0) {
            const float* xr = t < NP ? p.in[I_XP] + (size_t)t * D : p.in[I_XS] + (size_t)(t - NP) * D;
#pragma unroll
            for (int j = 0; j < EPL; ++j) v[j] = xr[lane + 64 * j];
        } else if (MODE == 0) {
            const float* x1 = (const float*)(p.ws + WS_X1) + (size_t)t * D;
            const float* g2 = mods + ((size_t)(l - 1) * NCOND + cnd) * 6 * D + 5 * D;
            float f[EPL], xv[EPL], gv[EPL];
#pragma unroll
            for (int j = 0; j < EPL; ++j) { f[j] = 0.f; xv[j] = x1[lane + 64 * j]; gv[j] = g2[lane + 64 * j]; }
            const int* ts = (const int*)(p.ws + WS_TOKSLOT) + (size_t)t * 16;
            const int myslot = lane < 16 ? ts[lane] : -1;
            unsigned vm = (unsigned)__ballot(myslot >= 0);
            while (vm) {
                const int e = __builtin_ctz(vm); vm &= vm - 1u;
                const int slot = __shfl(myslot, e);
                const bf16_t* yr = (const bf16_t*)(p.ws + WS_YE) + ((size_t)e * SLOTS + slot) * D;
#pragma unroll
                for (int j = 0; j < EPL; ++j) f[j] += bf2f(yr[lane + 64 * j]);
            }
#pragma unroll
            for (int j = 0; j < EPL; ++j) v[j] = ALPHA * xv[j] + gv[j] * f[j];
        } else {
            const float* u = (const float*)(p.ws + WS_U) + (size_t)t * D;
#pragma unroll
            for (int j = 0; j < EPL; ++j) v[j] = u[lane + 64 * j];
        }
        if (!(MODE == 0 && l == 0)) {
            const int li = (MODE == 0) ? (l - 1) * 2 + 1 : l * 2;
            const float* lg = p.in[I_LNG] + (size_t)li * D; const float* lb = p.in[I_LNB] + (size_t)li * D;
            float g[EPL], bb[EPL];
#pragma unroll
            for (int j = 0; j < EPL; ++j) { g[j] = lg[lane + 64 * j]; bb[j] = lb[lane + 64 * j]; }
            float s = 0.f;
#pragma unroll
            for (int j = 0; j < EPL; ++j) s += v[j];
            const float mu = wave_sum(s) * (1.f / D);
            float q = 0.f;
#pragma unroll
            for (int j = 0; j < EPL; ++j) { const float dlt = v[j] - mu; q += dlt * dlt; }
            const float rstd = 1.f / sqrtf(wave_sum(q) * (1.f / D) + EPS);
            float* dst = (MODE == 1) ? (float*)(p.ws + WS_X1) + (size_t)t * D
                       : (l == DEPTH) ? (t < NP ? p.out + O_YP + (size_t)t * D : p.out + O_YS + (size_t)(t - NP) * D) : (float*)(p.ws + WS_XBUF) + (size_t)t * D;
#pragma unroll
            for (int j = 0; j < EPL; ++j) { v[j] = (v[j] - mu) * rstd * g[j] + bb[j]; dst[lane + 64 * j] = v[j]; }
        }
        if (MODE == 1 || l < DEPTH) {
            const float* sh = mods + ((size_t)l * NCOND + cnd) * 6 * D + (MODE == 1 ? 3 * D : 0); const float* sc = sh + D;
            bf16_t* hb = (bf16_t*)(p.ws + (MODE == 1 ? WS_H2 : WS_HMOD)) + (size_t)t * D;
            {
                float s1[EPL], s0[EPL];
#pragma unroll
                for (int j = 0; j < EPL; ++j) { s1[j] = sc[lane + 64 * j]; s0[j] = sh[lane + 64 * j]; }
#pragma unroll
                for (int j = 0; j < EPL; ++j) { v[j] = v[j] * (1.f + s1[j]) + s0[j]; hb[lane + 64 * j] = f2bf(v[j]); }
            }
            CFENCE();
            float a16[16];
#pragma unroll
            for (int e = 0; e < 16; ++e) a16[e] = 0.f;
#pragma unroll
            for (int j = 0; j < EPL; ++j) {
                const float hv = v[j];
                const float* wr = W16 + (lane + 64 * j) * W16ROW;
#pragma unroll
                for (int q = 0; q < 4; ++q) { const f4v w4 = *(const f4v*)(wr + 4 * q); a16[4 * q] += hv * w4[0]; a16[4 * q + 1] += hv * w4[1]; a16[4 * q + 2] += hv * w4[2]; a16[4 * q + 3] += hv * w4[3]; }
                if (j & 1) CFENCE();
            }
            float mine = -1e30f;
#pragma unroll
            for (int e = 0; e < 16; ++e) { const float sm = wave_sum(a16[e]); if (lane == e) mine = sm; }
            if (MODE == 0) {
                if (lane < 16) ((float*)(p.ws + WS_GATES))[(size_t)t * 16 + lane] = mine + p.in[I_BGATE][l * 16 + lane];
            } else {
                float mx = mine;
                for (int m = 8; m >= 1; m >>= 1) mx = fmaxf(mx, __shfl_xor(mx, m));
                const float ex = lane < 16 ? expf(mine - mx) : 0.f;
                float sm = ex;
                for (int m = 8; m >= 1; m >>= 1) sm += __shfl_xor(sm, m);
                if (lane < 16) ((float*)(p.ws + WS_AFF))[(size_t)t * 16 + lane] = ex / sm;
            }
        }
    }
}

template <int NPL>
DEV void topk_wave(const Params& p, int tb, int cap, int sbase, int e, int lane) {
    const float* aff = (const float*)(p.ws + WS_AFF);
    int* idx = (int*)(p.ws + WS_IDX); float* gsel = (float*)(p.ws + WS_GSEL); int* tokslot = (int*)(p.ws + WS_TOKSLOT);
    unsigned bits[NPL];
#pragma unroll
    for (int i = 0; i < NPL; ++i) bits[i] = __builtin_bit_cast(unsigned, aff[(size_t)(tb + lane + 64 * i) * 16 + e]);
    unsigned T = 0u;
    for (int b = 30; b >= 0; --b) {
        const unsigned cand = T | (1u << b);
        int cnt = 0;
#pragma unroll
        for (int i = 0; i < NPL; ++i) cnt += __popcll(__ballot(bits[i] >= cand));
        if (cnt >= cap) T = cand;
    }
    int ngt = 0;
#pragma unroll
    for (int i = 0; i < NPL; ++i) ngt += __popcll(__ballot(bits[i] > T));
    int need_eq = cap - ngt, run = 0;
    const unsigned long long lt = (1ull << lane) - 1ull;
#pragma unroll
    for (int i = 0; i < NPL; ++i) {
        const bool eq = bits[i] == T;
        const unsigned long long meq = __ballot(eq);
        const int eqrank = __popcll(meq & lt);
        const bool sel = bits[i] > T || (eq && eqrank < need_eq);
        const unsigned long long ms = __ballot(sel);
        const int t = tb + lane + 64 * i;
        if (sel) { const int slot = sbase + run + __popcll(ms & lt); idx[e * SLOTS + slot] = t; gsel[e * SLOTS + slot] = __builtin_bit_cast(float, bits[i]); tokslot[(size_t)t * 16 + e] = slot; }
        else tokslot[(size_t)t * 16 + e] = -1;
        run += __popcll(ms);
        const int neq = __popcll(meq); need_eq -= neq < need_eq ? neq : need_eq;
    }
}
DEV void phase_topk(const Params& p, char* smem) {
    (void)smem;
    const int tid = get_tid(), lane = tid & 63;
    constexpr int US = DEC_BATCH * NEXP, UP = BATCH * NEXP;
    const int gw = blockIdx.x * 8 + (tid >> 6), nw = gridDim.x * 8;
    for (int u = gw; u < US + UP; u += nw) {
        if (u < US) { const int b = u / NEXP, e = u % NEXP; topk_wave<DEC_SEQ / 64>(p, NP + b * DEC_SEQ, CAP_S, BATCH * CAP_P + b * CAP_S, e, lane); }
        else { const int uu = u - US; const int b = uu / NEXP, e = uu % NEXP; topk_wave<SEQ / 64>(p, b * SEQ, CAP_P, b * CAP_P, e, lane); }
    }
}

DEV void store_head_f32(float* dst_f32, const f16v& v0, const f16v& v1, int h) {
#pragma unroll
    for (int ft = 0; ft < 2; ++ft) {
        const f16v& v = ft ? v1 : v0;
#pragma unroll
        for (int g = 0; g < 4; ++g) { f4v o; o[0] = v[4 * g]; o[1] = v[4 * g + 1]; o[2] = v[4 * g + 2]; o[3] = v[4 * g + 3]; *(f4v*)(dst_f32 + ft * 32 + 8 * g + 4 * h) = o; }
    }
}
template <int VAR>
DEV void phase_inproj(const Params& p, char* smem, int l) {
    constexpr int NJ = 22, NU = (NT / 256) * NJ;
    const int tid = get_tid(), lane = tid & 63, wave = tid >> 6, wm = wave & 3, wn = wave >> 2, h = lane >> 5, l31 = lane & 31;
    const bf16_t* hmod = (const bf16_t*)(p.ws + WS_HMOD);
    const float* rope = (const float*)(p.ws + WS_ROPE);
    constexpr int NMB = NT / 256, RPX = (NMB % 8 == 0) ? NMB / 8 : NMB;
    const UnitIter it = unit_iter(NU);
    for (int u = it.i; u < it.end; u += it.step) {
        const int mb = (u / (RPX * NJ)) * RPX + u % RPX, j = (u / RPX) % NJ;
        const int colbase = j < 17 ? 128 * j : 2192 + 128 * (j - 17);
        const unsigned ao = ((unsigned)(mb * 256 + (tid >> 3)) * D + (tid & 7) * 8) * 2;
        const unsigned bvo = (unsigned)(colbase + 4 * (tid & 31)) * 4 + (unsigned)(tid >> 5) * (PROJ_W * 4);
        const unsigned blds = (unsigned)(tid >> 5) * 320u + (unsigned)(tid & 31) * 8u;
        gemm_tile<2, VAR>(smem, make_rsrc(hmod), ao, ao + 128u * D, ao + 256u * D, ao + 384u * D, make_rsrc(p.in[I_WIN] + (size_t)l * D * PROJ_W), bvo, blds, PROJ_W * 4, D, [&](f16v (&acc)[2][2]) {
            int lane_e = lane; VGPR_PIN(lane_e); const int lane = lane_e, l31 = lane_e & 31, h = lane_e >> 5; (void)l31; (void)h;
            const int cb = colbase + wn * 64;
            char* stg = wave_stage_ptr(smem, wave);
            const int t0 = mb * 256 + wm * 64;
            const bool isP = t0 < NP;
            bf16_t* dstb; size_t dstride;
            int f32out = 0, fhead = 0, fheads = 0; size_t fbase = 0;
            int mode = 0;
            if (cb < 1152) {
                const int seg = cb / 384, head = (cb % 384) / 64;
                dstb = (bf16_t*)(p.ws + (seg == 0 ? WS_NAQ : seg == 1 ? WS_NAK : WS_NAV)) + (size_t)t0 * 384 + head * 64; dstride = 384;
                if (seg >= 1 && isP) { f32out = 1; fbase = seg == 1 ? O_NAK : O_NAV; fhead = head; fheads = NAH; }
            } else if (cb < 2176) {
                const int seg = (cb - 1152) / 256, head = ((cb - 1152) % 256) / 64;
                dstb = (bf16_t*)(p.ws + (seg == 0 ? WS_MLQ : seg == 1 ? WS_MLK : seg == 2 ? WS_MLV : WS_MLO)) + (size_t)t0 * 256 + head * 64; dstride = 256;
                mode = seg == 1 ? 1 : 0;
            } else {
                const int c2 = cb - 2192;
                if (c2 < 384) { dstb = (bf16_t*)(p.ws + WS_GQQ) + (size_t)t0 * 384 + (c2 / 64) * 64; dstride = 384; mode = 2; }
                else if (c2 < 512) { const int head = (c2 - 384) / 64; dstb = (bf16_t*)(p.ws + WS_GQK) + (size_t)t0 * 128 + head * 64; dstride = 128; mode = 3;
                                     if (isP) { f32out = 1; fbase = O_GQK; fhead = head; fheads = GQKV; } }
                else { const int head = (c2 - 512) / 64; dstb = (bf16_t*)(p.ws + WS_GQV) + (size_t)t0 * 128 + head * 64; dstride = 128;
                       if (isP) { f32out = 1; fbase = O_GQV; fhead = head; fheads = GQKV; } }
            }
#pragma unroll
            for (int tt = 0; tt < 2; ++tt) {
                const int t = t0 + tt * 32 + l31;
                f16v v0 = acc[0][tt], v1 = acc[1][tt];
                if (mode == 1) { v0 *= ATT_SCALE; v1 *= ATT_SCALE; }
                if (mode >= 2) {
                    float ss = 0.f;
#pragma unroll
                    for (int r = 0; r < 16; ++r) ss += v0[r] * v0[r] + v1[r] * v1[r];
                    ss += __shfl_xor(ss, 32);
                    const float rn = 1.f / sqrtf(ss * (1.f / 64.f) + EPS);
                    const float* gq = p.in[I_QKG] + ((size_t)l * 2 + (mode == 2 ? 0 : 1)) * 64;
#pragma unroll
                    for (int r = 0; r < 16; ++r) {
                        const int d = (r & 3) + 8 * (r >> 2) + 4 * h;
                        v0[r] *= rn * gq[d]; v1[r] *= rn * gq[32 + d];
                    }
                }
                if (f32out) { const int bP = t / SEQ, sP = t % SEQ; store_head_f32(p.out + fbase + ((((size_t)bP * DEPTH + l) * SEQ + sP) * fheads + fhead) * 64, v0, v1, h); }
                if (mode >= 2 && !isP) {
                    const int pos = (t - NP) % DEC_SEQ, prow = pos / GRIDW, pcol = pos % GRIDW;
#pragma unroll
                    for (int rr = 0; rr < 8; ++rr) {
                        const int fi = (rr & 3) + 8 * ((rr >> 2) & 1) + 4 * h;
                        const float c0 = rope[(prow * 16 + fi) * 2], s0 = rope[(prow * 16 + fi) * 2 + 1];
                        const float c1 = rope[(pcol * 16 + fi) * 2], s1 = rope[(pcol * 16 + fi) * 2 + 1];
                        const float a_lo = v0[rr], a_hi = v0[rr + 8]; v0[rr] = a_lo * c0 - a_hi * s0; v0[rr + 8] = a_hi * c0 + a_lo * s0;
                        const float b_lo = v1[rr], b_hi = v1[rr + 8]; v1[rr] = b_lo * c1 - b_hi * s1; v1[rr + 8] = b_hi * c1 + b_lo * s1;
                    }
                }
                stage64_write_bf16(stg, tt, v0, v1, l31, h);
            }
            stage64_flush_bf16(stg, dstb, dstride, lane);
        });
    }
}

template <int VAR>
DEV void phase_outproj(const Params& p, char* smem, int l) {
    constexpr int NC = D / 128, NU = (NT / 256) * NC;
    const int tid = get_tid(), lane = tid & 63, wave = tid >> 6, wm = wave & 3, wn = wave >> 2, h = lane >> 5, l31 = lane & 31;
    const bf16_t* mixed = (const bf16_t*)(p.ws + WS_MIXED);
    const float* mods = (const float*)(p.ws + WS_MODS);
    float* U = (float*)(p.ws + WS_U);
    constexpr int NMB = NT / 256, RPX = (NMB % 8 == 0) ? NMB / 8 : NMB;
    const UnitIter it = unit_iter(NU);
    for (int u = it.i; u < it.end; u += it.step) {
        const int mb = (u / (RPX * NC)) * RPX + u % RPX, cbk = (u / RPX) % NC;
        const unsigned ao = ((unsigned)(mb * 256 + (tid >> 3)) * MIXW + (tid & 7) * 8) * 2;
        const unsigned bvo = (unsigned)(cbk * 128 + 4 * (tid & 31)) * 4 + (unsigned)(tid >> 5) * (D * 4);
        const unsigned blds = (unsigned)(tid >> 5) * 320u + (unsigned)(tid & 31) * 8u;
        gemm_tile<2, VAR>(smem, make_rsrc(mixed), ao, ao + 128u * MIXW, ao + 256u * MIXW, ao + 384u * MIXW, make_rsrc(p.in[I_WOUT] + (size_t)l * MIXW * D), bvo, blds, D * 4, MIXW, [&](f16v (&acc)[2][2]) {
            int lane_e = lane; VGPR_PIN(lane_e); const int lane = lane_e, l31 = lane_e & 31, h = lane_e >> 5; (void)l31; (void)h;
            char* stg = wave_stage_ptr(smem, wave);
            const int t0 = mb * 256 + wm * 64;
            const float* g1 = mods + ((size_t)l * NCOND + tok_cond(t0)) * 6 * D + 2 * D;
#pragma unroll
            for (int ft = 0; ft < 2; ++ft) {
#pragma unroll
                for (int tt = 0; tt < 2; ++tt)
#pragma unroll
                    for (int g = 0; g < 4; ++g) { f4v o; o[0] = acc[ft][tt][4 * g]; o[1] = acc[ft][tt][4 * g + 1]; o[2] = acc[ft][tt][4 * g + 2]; o[3] = acc[ft][tt][4 * g + 3];
                        *(f4v*)(stg + (tt * 32 + l31) * LROW + (8 * g + 4 * h) * 4) = o; }
                WAVE_SYNC();
                const int f0 = cbk * 128 + wn * 64 + ft * 32 + (lane & 7) * 4;
                const f4v gv = *(const f4v*)(g1 + f0);
#pragma unroll
                for (int i = 0; i < 8; ++i) {
                    const int r = (lane >> 3) + 8 * i, t = t0 + r;
                    const f4v a = *(const f4v*)(stg + r * LROW + (lane & 7) * 16);
                    const float* xr = (l == 0) ? (t < NP ? p.in[I_XP] + (size_t)t * D : p.in[I_XS] + (size_t)(t - NP) * D) : (const float*)(p.ws + WS_XBUF) + (size_t)t * D;
                    const f4v xv = *(const f4v*)(xr + f0);
                    f4v o;
#pragma unroll
                    for (int q = 0; q < 4; ++q) o[q] = ALPHA * xv[q] + gv[q] * a[q];
                    *(f4v*)(U + (size_t)t * D + f0) = o;
                }
                WAVE_SYNC();
            }
        });
    }
}

template <int VAR>
DEV void phase_gateup(const Params& p, char* smem, int l) {
    constexpr int NRB = SLOTS / 256, NCB = EH / 128, NU = NEXP * NCB * NRB;
    const int tid = get_tid(), lane = tid & 63, wave = tid >> 6, wm = wave & 3, wn = wave >> 2, h = lane >> 5, l31 = lane & 31;
    const bf16_t* h2 = (const bf16_t*)(p.ws + WS_H2);
    const int* idx = (const int*)(p.ws + WS_IDX);
    bf16_t* hid = (bf16_t*)(p.ws + WS_HID);
    const UnitIter it = unit_iter(NU);
    for (int u = it.i; u < it.end; u += it.step) {
        const int rb = u % NRB, cbk = (u / NRB) % NCB, e = u / (NRB * NCB);
        const int* ip = idx + e * SLOTS + rb * 256 + (tid >> 3);
        const unsigned a0 = ((unsigned)ip[0] * D + (tid & 7) * 8) * 2, a1 = ((unsigned)ip[64] * D + (tid & 7) * 8) * 2;
        const unsigned a2 = ((unsigned)ip[128] * D + (tid & 7) * 8) * 2, a3 = ((unsigned)ip[192] * D + (tid & 7) * 8) * 2;
#ifdef EMU
        const int bw = tid >> 6;
#else
        const int bw = __builtin_amdgcn_readfirstlane(tid >> 6);
#endif
        const int is_up = bw & 1, bkr = 2 * (bw >> 1) + ((tid >> 5) & 1), hc = 4 * (tid & 31);
        const int ncol = (hc >> 6) * 128 + (2 * ((hc >> 5) & 1) + is_up) * 32 + (hc & 31);
        const unsigned bvo = (unsigned)(cbk * 128 + hc) * 4 + (unsigned)bkr * (EH * 4);
        const unsigned blds = (unsigned)bkr * 576u + (unsigned)ncol * 2u;
        const float* wmat = (is_up ? p.in[I_WU] : p.in[I_WG]) + ((size_t)l * NEXP + e) * D * EH;
        gemm_tile<4, VAR>(smem, make_rsrc(h2), a0, a1, a2, a3, make_rsrc(wmat), bvo, blds, EH * 4, D, [&](f16v (&acc)[4][2]) {
            int lane_e = lane; VGPR_PIN(lane_e); const int lane = lane_e, l31 = lane_e & 31, h = lane_e >> 5; (void)l31; (void)h;
            char* stg = wave_stage_ptr(smem, wave);
#pragma unroll
            for (int tt = 0; tt < 2; ++tt)
#pragma unroll
                for (int pr = 0; pr < 2; ++pr)
#pragma unroll
                    for (int g = 0; g < 4; ++g) {
                        float o[4];
#pragma unroll
                        for (int q = 0; q < 4; ++q) o[q] = siluf_(acc[2 * pr][tt][4 * g + q]) * acc[2 * pr + 1][tt][4 * g + q];
                        stage64_write4(stg, tt * 32 + l31, pr * 32 + 8 * g + 4 * h, o[0], o[1], o[2], o[3]);
                    }
            stage64_flush_bf16(stg, hid + ((size_t)e * SLOTS + rb * 256 + wm * 64) * EH + cbk * 128 + wn * 64, EH, lane);
        });
    }
}

template <int VAR>
DEV void phase_down(const Params& p, char* smem, int l) {
    constexpr int NRB = SLOTS / 256, NCB = D / 256, NU = NEXP * NCB * NRB;
    const int tid = get_tid(), lane = tid & 63, wave = tid >> 6, wm = wave & 3, wn = wave >> 2, h = lane >> 5, l31 = lane & 31;
    const bf16_t* hid = (const bf16_t*)(p.ws + WS_HID);
    const float* gsel = (const float*)(p.ws + WS_GSEL);
    bf16_t* ye = (bf16_t*)(p.ws + WS_YE);
    const UnitIter it = unit_iter(NU);
    for (int u = it.i; u < it.end; u += it.step) {
        const int rb = u % NRB, cbk = (u / NRB) % NCB, e = u / (NRB * NCB);
        const unsigned ao = ((unsigned)(rb * 256 + (tid >> 3)) * EH + (tid & 7) * 8) * 2;
        const unsigned bvo = (unsigned)(cbk * 256 + 4 * (tid & 63)) * 4 + (unsigned)(tid >> 6) * (D * 4);
        const unsigned blds = (unsigned)(tid >> 6) * 576u + (unsigned)(tid & 63) * 8u;
        gemm_tile<4, VAR>(smem, make_rsrc(hid + (size_t)e * SLOTS * EH), ao, ao + 128u * EH, ao + 256u * EH, ao + 384u * EH, make_rsrc(p.in[I_WD] + ((size_t)l * NEXP + e) * EH * D), bvo, blds, D * 4, EH, [&](f16v (&acc)[4][2]) {
            int lane_e = lane; VGPR_PIN(lane_e); const int lane = lane_e, l31 = lane_e & 31, h = lane_e >> 5; (void)l31; (void)h;
            char* stg = wave_stage_ptr(smem, wave);
            const float gs0 = gsel[e * SLOTS + rb * 256 + wm * 64 + l31], gs1 = gsel[e * SLOTS + rb * 256 + wm * 64 + 32 + l31];
#pragma unroll
            for (int hb = 0; hb < 2; ++hb) {
#pragma unroll
                for (int tt = 0; tt < 2; ++tt) {
                    const float gs = tt ? gs1 : gs0;
#pragma unroll
                    for (int f2 = 0; f2 < 2; ++f2)
#pragma unroll
                        for (int g = 0; g < 4; ++g) { const f16v& a = acc[2 * hb + f2][tt]; stage64_write4(stg, tt * 32 + l31, f2 * 32 + 8 * g + 4 * h, a[4 * g] * gs, a[4 * g + 1] * gs, a[4 * g + 2] * gs, a[4 * g + 3] * gs); }
                }
                stage64_flush_bf16(stg, ye + ((size_t)e * SLOTS + rb * 256 + wm * 64) * D + cbk * 256 + wn * 128 + hb * 64, D, lane);
            }
        });
    }
}

struct AttnDesc {
    const bf16_t* q; int qstride;
    int ntiles, n0;
    const bf16_t *k0, *v0; int stride0;
    const bf16_t *k1, *v1; int stride1;
    int na;
    int r0, rlo;
    const float* rpb;
    bf16_t* out; int ostride;
    float* part;
};
constexpr int ATT_TILE = 64 * LROW;
DEV int na_row_start(int r) { int s = r - KR / 2; s = s < 0 ? 0 : s; return s > ROWS - KR ? ROWS - KR : s; }
DEV void attn_unit(char* smem, const AttnDesc& d) {
    const int tid = get_tid(), lane = tid & 63, wave = tid >> 6, h = lane >> 5, l31 = lane & 31;
    char* Ks = smem; char* Vs = smem + 2 * ATT_TILE; float* rpbS = (float*)(smem + 4 * ATT_TILE);
    if (d.na) { for (int i = tid; i < 15 * 31; i += 512) rpbS[i] = d.rpb[i]; }
    const bf16_t* qp = d.q + (size_t)(wave * 32 + l31) * d.qstride + h * 8;
    s8v qf[4];
#pragma unroll
    for (int s = 0; s < 4; ++s) qf[s] = *(const s8v*)(qp + 16 * s);
    float m_run = -1e30f, l_run = 0.f;
    f16v o[2]; o[0] = f16zero(); o[1] = f16zero();
    const int srow = tid >> 3, sch = tid & 7;
    u4v kreg, vreg;
    auto gload = [&](int t) {
        const bf16_t *kp, *vp;
        if (t < d.n0) { const size_t off = (size_t)(t * 64 + srow) * d.stride0 + sch * 8; kp = d.k0 + off; vp = d.v0 + off; }
        else { const size_t off = (size_t)((t - d.n0) * 64 + srow) * d.stride1 + sch * 8; kp = d.k1 + off; vp = d.v1 + off; }
        kreg = *(const u4v*)kp; vreg = *(const u4v*)vp;
    };
    auto lstore = [&](int buf) { *(u4v*)(Ks + buf * ATT_TILE + srow * LROW + sch * 16) = kreg; *(u4v*)(Vs + buf * ATT_TILE + srow * LROW + sch * 16) = vreg; };
    const int qr = d.r0 + (wave >> 1), qw = (wave & 1) * 32 + l31;
    const int rs = na_row_start(qr);
    int cs = qw - KC / 2; cs = cs < 0 ? 0 : (cs > GRIDW - KC ? GRIDW - KC : cs);
    gload(0); lstore(0);
    __syncthreads();
    for (int t = 0; t < d.ntiles; ++t) {
        const int buf = t & 1;
        if (t + 1 < d.ntiles) gload(t + 1);
        const bool local = d.na && t >= d.n0;
        const int kr = d.rlo + (t - d.n0);
        const bool active = !local || (kr >= rs && kr < rs + KR);
        if (active) {
            const char* kb = Ks + buf * ATT_TILE + l31 * LROW + h * 16;
            f16v sa[2];
#pragma unroll
            for (int kt = 0; kt < 2; ++kt) {
                sa[kt] = f16zero();
#pragma unroll
                for (int s = 0; s < 4; ++s) { const s8v kf = *(const s8v*)(kb + kt * 32 * LROW + s * 32); sa[kt] = mfma32(kf, qf[s], sa[kt]); }
            }
            float mx = -1e30f;
#pragma unroll
            for (int kt = 0; kt < 2; ++kt)
#pragma unroll
                for (int r = 0; r < 16; ++r) {
                    float v = sa[kt][r] * ATT_SCALE;
                    if (local) {
                        const int kc = kt * 32 + (r & 3) + 8 * (r >> 2) + 4 * h;
                        const bool inw = kc >= cs && kc < cs + KC;
                        const int bi = (kr - qr + 7) * 31 + (kc - qw + 15);
                        v = inw ? v + rpbS[inw ? bi : 0] : -1e30f;
                    }
                    sa[kt][r] = v; mx = fmaxf(mx, v);
                }
            mx = fmaxf(mx, __shfl_xor(mx, 32));
            const float m_new = fmaxf(m_run, mx);
            const float alpha = fexp(m_run - m_new);
            float ps = 0.f;
#pragma unroll
            for (int kt = 0; kt < 2; ++kt)
#pragma unroll
                for (int r = 0; r < 16; ++r) { const float pv = fexp(sa[kt][r] - m_new); sa[kt][r] = pv; ps += pv; }
            l_run = l_run * alpha + ps; m_run = m_new;
            o[0] *= alpha; o[1] *= alpha;
            const char* vb = Vs + buf * ATT_TILE + (4 * h + ((lane & 15) >> 2)) * LROW + (((lane >> 4) & 1) * 16 + 4 * (lane & 3)) * 2;
#pragma unroll
            for (int ks = 0; ks < 4; ++ks) {
                const int kt = ks >> 1, rb = 8 * (ks & 1);
                u4v pk; pk[0] = pack2(sa[kt][rb], sa[kt][rb + 1]); pk[1] = pack2(sa[kt][rb + 2], sa[kt][rb + 3]);
                pk[2] = pack2(sa[kt][rb + 4], sa[kt][rb + 5]); pk[3] = pack2(sa[kt][rb + 6], sa[kt][rb + 7]);
                const s8v pf = __builtin_bit_cast(s8v, pk);
                const char* vk = vb + (kt * 32 + 16 * (ks & 1)) * LROW;
#pragma unroll
                for (int dt = 0; dt < 2; ++dt) {
                    const s4v lo = lds_tr16(vk + dt * 64), hi = lds_tr16(vk + 8 * LROW + dt * 64);
                    s8v vf; vf[0] = lo[0]; vf[1] = lo[1]; vf[2] = lo[2]; vf[3] = lo[3]; vf[4] = hi[0]; vf[5] = hi[1]; vf[6] = hi[2]; vf[7] = hi[3];
                    o[dt] = mfma32(vf, pf, o[dt]);
                }
            }
        }
        if (t + 1 < d.ntiles) lstore(buf ^ 1);
        __syncthreads();
    }
    const float l_tot = l_run + __shfl_xor(l_run, 32);
    const int qrow = wave * 32 + l31;
    if (d.part) {
        float* po = d.part + (size_t)qrow * 64;
#pragma unroll
        for (int dt = 0; dt < 2; ++dt)
#pragma unroll
            for (int g = 0; g < 4; ++g) { f4v v; v[0] = o[dt][4 * g]; v[1] = o[dt][4 * g + 1]; v[2] = o[dt][4 * g + 2]; v[3] = o[dt][4 * g + 3]; *(f4v*)(po + dt * 32 + 8 * g + 4 * h) = v; }
        if (h == 0) { d.part[256 * 64 + qrow] = m_run; d.part[256 * 64 + 256 + qrow] = l_tot; }
    } else {
        const float inv = 1.f / l_tot;
        bf16_t* po = d.out + (size_t)qrow * d.ostride;
#pragma unroll
        for (int dt = 0; dt < 2; ++dt)
#pragma unroll
            for (int g = 0; g < 4; ++g) {
                u2v pk; pk[0] = pack2(o[dt][4 * g] * inv, o[dt][4 * g + 1] * inv); pk[1] = pack2(o[dt][4 * g + 2] * inv, o[dt][4 * g + 3] * inv);
                *(u2v*)(po + dt * 32 + 8 * g + 4 * h) = pk;
            }
    }
}

DEV int ml_sidx(int grp, int b, int head, int c) { return grp == 0 ? ((b * MLH + head) * NCH_P + c) : BATCH * MLH * NCH_P + ((b * MLH + head) * NCH_S + c); }
DEV float lane_prefix_sum(float v, int lane) { for (int dlt = 1; dlt < 64; dlt <<= 1) { const float o = __shfl(v, lane - dlt); if (lane >= dlt) v += o; } return v; }
DEV float lane_prefix_max(float v, int lane) { for (int dlt = 1; dlt < 64; dlt <<= 1) { const float o = __shfl(v, lane - dlt); if (lane >= dlt) v = fmaxf(v, o); } return v; }

DEV void mlstm_summary_unit(const Params& p, char* smem, int grp, int b, int head, int c) {
    const int tid = get_tid(), lane = tid & 63, wave = tid >> 6, h = lane >> 5, l31 = lane & 31;
    char* KT = smem;
    char* VT = smem + 2 * ATT_TILE;
    float* wsS = (float*)(smem + 3 * ATT_TILE);
    float* scal = wsS + 128;
    const int tb = (grp == 0 ? b * SEQ : NP + b * DEC_SEQ) + c * 64;
    const float* gates = (const float*)(p.ws + WS_GATES);
    if (wave == 0) {
        const float* gr = gates + (size_t)(tb + lane) * 16;
        const float i_f = gr[head], lf_f = logsigmoidf_(gr[4 + head]), i_b = gr[8 + head], lf_b = logsigmoidf_(gr[12 + head]);
        const float pf = lane_prefix_sum(lf_f, lane), pb = lane_prefix_sum(lf_b, lane);
        const float tot_f = __shfl(pf, 63), tot_b = __shfl(pb, 63);
        const float g_f = (tot_f - pf) + i_f, g_b = (pb - lf_b) + i_b;
        const float G_f = wave_max(g_f), G_b = wave_max(g_b);
        wsS[lane] = expf(g_f - G_f); wsS[64 + lane] = expf(g_b - G_b);
        if (lane == 0) { scal[0] = tot_f; scal[1] = tot_b; scal[2] = G_f; scal[3] = G_b; }
    }
    __syncthreads();
    {
        const int tau = tid >> 3, ch = tid & 7;
        const u4v kv = *(const u4v*)((const bf16_t*)(p.ws + WS_MLK) + (size_t)(tb + tau) * 256 + head * 64 + ch * 8);
        const u4v vv = *(const u4v*)((const bf16_t*)(p.ws + WS_MLV) + (size_t)(tb + tau) * 256 + head * 64 + ch * 8);
        const float wf = wsS[tau], wb = wsS[64 + tau];
#pragma unroll
        for (int j = 0; j < 8; ++j) {
            const bf16_t kb = (bf16_t)(kv[j >> 1] >> (16 * (j & 1))), vb = (bf16_t)(vv[j >> 1] >> (16 * (j & 1)));
            const int dim = ch * 8 + j; const float kf = bf2f(kb);
            *(bf16_t*)(KT + dim * LROW + tau * 2) = f2bf(kf * wf);
            *(bf16_t*)(KT + ATT_TILE + dim * LROW + tau * 2) = f2bf(kf * wb);
            *(bf16_t*)(VT + dim * LROW + tau * 2) = vb;
        }
    }
    __syncthreads();
    float* sum = (float*)(p.ws + WS_MLSUM);
    const int sidx = ml_sidx(grp, b, head, c);
    {
        const int dir = wave >> 2, mi = (wave >> 1) & 1, ni = wave & 1;
        f16v acc = f16zero();
#pragma unroll
        for (int s = 0; s < 4; ++s) {
            const s8v af = *(const s8v*)(KT + dir * ATT_TILE + (mi * 32 + l31) * LROW + (16 * s + 8 * h) * 2);
            const s8v bf = *(const s8v*)(VT + (ni * 32 + l31) * LROW + (16 * s + 8 * h) * 2);
            acc = mfma32(af, bf, acc);
        }
        float* U = sum + (size_t)(sidx * 2 + dir) * MLSUM_STRIDE;
#pragma unroll
        for (int r = 0; r < 16; ++r) U[(mi * 32 + (r & 3) + 8 * (r >> 2) + 4 * h) * 64 + ni * 32 + l31] = acc[r];
    }
    if (tid < 128) {
        const int dir = tid >> 6, kd = tid & 63;
        float s = 0.f;
        for (int tau = 0; tau < 64; ++tau) s += bf2f(*(const bf16_t*)(KT + dir * ATT_TILE + kd * LROW + tau * 2));
        float* E = sum + (size_t)(sidx * 2 + dir) * MLSUM_STRIDE;
        E[4096 + kd] = s;
        if (kd == 0) { E[4160] = scal[dir]; E[4161] = scal[2 + dir]; }
    }
    __syncthreads();
}

DEV void mlstm_output_unit(const Params& p, char* smem, int l, int grp, int b, int head, int c) {
    const int tid = get_tid(), lane = tid & 63, wave = tid >> 6, h = lane >> 5, l31 = lane & 31;
    const int nc = grp ? NCH_S : NCH_P;
    char* Qs = smem;
    char* Ks = smem + 2 * ATT_TILE;
    char* VT = smem + 4 * ATT_TILE;
    char* CT = smem + 6 * ATT_TILE;
    char* QK = smem + 8 * ATT_TILE;
    float* hS = (float*)(smem + 10 * ATT_TILE);
    float* vec = hS + 2 * 64 * 68;
    float* aS = vec; float* MjS = vec + 128; float* bS = vec + 256; float* nS = vec + 384; float* denp = vec + 512; float* qnS = vec + 768; float* scal = vec + 896;
    const int tb = (grp == 0 ? b * SEQ : NP + b * DEC_SEQ) + c * 64;
    const float* sum = (const float*)(p.ws + WS_MLSUM);
#pragma unroll
    for (int dir = 0; dir < 2; ++dir) {
        float C[8], nst = 0.f, m;
        if (grp == 0) {
#pragma unroll
            for (int i = 0; i < 8; ++i) C[i] = 0.f;
            m = 0.f;
        } else {
            const size_t sb = (((size_t)b * DEPTH + l) * 2 + dir) * MLH + head;
#pragma unroll
            for (int i = 0; i < 8; ++i) C[i] = p.in[I_SC][sb * 4096 + tid + 512 * i];
            if (tid < 64) nst = p.in[I_SN][sb * 64 + tid];
            m = p.in[I_SM][sb];
        }
        const int nsteps = dir == 0 ? c : nc - 1 - c;
        const bool fin = (grp == 0) && (dir == 0 ? c == nc - 1 : c == 0);
        for (int st = 0; st < nsteps + (fin ? 1 : 0); ++st) {
            const int cc = dir == 0 ? st : nc - 1 - st;
            const float* E = sum + (size_t)(ml_sidx(grp, b, head, cc) * 2 + dir) * MLSUM_STRIDE;
            if (st == nsteps) {
#pragma unroll
                for (int i = 0; i < 8; ++i) { const int e = tid + 512 * i; *(bf16_t*)(CT + dir * ATT_TILE + (e & 63) * LROW + (e >> 6) * 2) = f2bf(C[i]); }
                if (tid < 64) nS[dir * 64 + tid] = nst;
                if (tid == 0) scal[dir] = m;
            }
            const float A = E[4160], G = E[4161];
            const float m_new = fmaxf(A + m, G);
            const float sc = expf(A + m - m_new), su = expf(G - m_new);
#pragma unroll
            for (int i = 0; i < 8; ++i) C[i] = sc * C[i] + su * E[tid + 512 * i];
            if (tid < 64) nst = sc * nst + su * E[4096 + tid];
            m = m_new;
        }
        if (!fin) {
#pragma unroll
            for (int i = 0; i < 8; ++i) { const int e = tid + 512 * i; *(bf16_t*)(CT + dir * ATT_TILE + (e & 63) * LROW + (e >> 6) * 2) = f2bf(C[i]); }
            if (tid < 64) nS[dir * 64 + tid] = nst;
            if (tid == 0) scal[dir] = m;
        } else {
            const size_t ob = (((size_t)b * DEPTH + l) * 2 + dir) * MLH + head;
#pragma unroll
            for (int i = 0; i < 8; ++i) p.out[O_MC + ob * 4096 + tid + 512 * i] = C[i];
            if (tid < 64) p.out[O_MN + ob * 64 + tid] = nst;
            if (tid == 0) p.out[O_MM + ob] = m;
        }
    }
    {
        const int row = tid >> 3, ch = tid & 7;
#pragma unroll
        for (int dir = 0; dir < 2; ++dir) {
            const int tok = tb + (dir ? 63 - row : row);
            const size_t off = (size_t)tok * 256 + head * 64 + ch * 8;
            *(u4v*)(Qs + dir * ATT_TILE + row * LROW + ch * 16) = *(const u4v*)((const bf16_t*)(p.ws + WS_MLQ) + off);
            *(u4v*)(Ks + dir * ATT_TILE + row * LROW + ch * 16) = *(const u4v*)((const bf16_t*)(p.ws + WS_MLK) + off);
            const u4v vv = *(const u4v*)((const bf16_t*)(p.ws + WS_MLV) + off);
#pragma unroll
            for (int j = 0; j < 8; ++j) *(bf16_t*)(VT + dir * ATT_TILE + (ch * 8 + j) * LROW + row * 2) = (bf16_t)(vv[j >> 1] >> (16 * (j & 1)));
        }
    }
    __syncthreads();
    if (wave < 2) {
        const int dir = wave;
        const float* gr = (const float*)(p.ws + WS_GATES) + (size_t)(tb + (dir ? 63 - lane : lane)) * 16;
        const float ig = gr[dir * 8 + head], lf = logsigmoidf_(gr[dir * 8 + 4 + head]);
        const float bj = lane_prefix_sum(lf, lane);
        const float a = ig - bj;
        const float Pj = lane_prefix_max(a, lane);
        aS[dir * 64 + lane] = a; bS[dir * 64 + lane] = bj; MjS[dir * 64 + lane] = fmaxf(scal[dir], Pj);
    } else if (wave < 4) {
        const int dir = wave - 2;
        float s = 0.f;
        for (int k = 0; k < 64; ++k) s += bf2f(*(const bf16_t*)(Qs + dir * ATT_TILE + lane * LROW + k * 2)) * nS[dir * 64 + k];
        qnS[dir * 64 + lane] = s;
    }
    __syncthreads();
    const int dir = wave >> 2, rt = (wave >> 1) & 1, jt = wave & 1;
    const int j = jt * 32 + l31;
    const float Mj = MjS[dir * 64 + j];
    {
        f16v acc = f16zero();
#pragma unroll
        for (int s4 = 0; s4 < 4; ++s4) {
            const s8v af = *(const s8v*)(Ks + dir * ATT_TILE + (rt * 32 + l31) * LROW + (16 * s4 + 8 * h) * 2);
            const s8v bf = *(const s8v*)(Qs + dir * ATT_TILE + j * LROW + (16 * s4 + 8 * h) * 2);
            acc = mfma32(af, bf, acc);
        }
        float dsum = 0.f;
#pragma unroll
        for (int g = 0; g < 4; ++g) {
            float o[4];
#pragma unroll
            for (int q = 0; q < 4; ++q) {
                const int s = rt * 32 + 8 * g + 4 * h + q;
                const float w = s <= j ? expf(aS[dir * 64 + s] - Mj) : 0.f;
                o[q] = acc[4 * g + q] * w; dsum += o[q];
            }
            u2v pk; pk[0] = pack2(o[0], o[1]); pk[1] = pack2(o[2], o[3]);
            *(u2v*)(QK + dir * ATT_TILE + j * LROW + (rt * 32 + 8 * g + 4 * h) * 2) = pk;
        }
        dsum += __shfl_xor(dsum, 32);
        if (h == 0) denp[(dir * 2 + rt) * 64 + j] = dsum;
    }
    __syncthreads();
    {
        const float mst = scal[dir];
        const float decay = expf(mst - Mj);
        f16v acc = f16zero();
#pragma unroll
        for (int s4 = 0; s4 < 4; ++s4) {
            const s8v af = *(const s8v*)(CT + dir * ATT_TILE + (rt * 32 + l31) * LROW + (16 * s4 + 8 * h) * 2);
            const s8v bf = *(const s8v*)(Qs + dir * ATT_TILE + j * LROW + (16 * s4 + 8 * h) * 2);
            acc = mfma32(af, bf, acc);
        }
        acc *= decay;
#pragma unroll
        for (int s4 = 0; s4 < 4; ++s4) {
            const s8v af = *(const s8v*)(VT + dir * ATT_TILE + (rt * 32 + l31) * LROW + (16 * s4 + 8 * h) * 2);
            const s8v bf = *(const s8v*)(QK + dir * ATT_TILE + j * LROW + (16 * s4 + 8 * h) * 2);
            acc = mfma32(af, bf, acc);
        }
        const float den = decay * qnS[dir * 64 + j] + denp[(dir * 2) * 64 + j] + denp[(dir * 2 + 1) * 64 + j];
        const float dn = fmaxf(fabsf(den), expf(-(bS[dir * 64 + j] + Mj)));
        const float inv = 1.f / dn;
#pragma unroll
        for (int g = 0; g < 4; ++g) { f4v o; o[0] = acc[4 * g] * inv; o[1] = acc[4 * g + 1] * inv; o[2] = acc[4 * g + 2] * inv; o[3] = acc[4 * g + 3] * inv;
            *(f4v*)(hS + (dir * 64 + j) * 68 + rt * 32 + 8 * g + 4 * h) = o; }
    }
    __syncthreads();
    {
        const int tau = tid >> 3, v8 = (tid & 7) * 8;
        float hv[8]; float s = 0.f;
#pragma unroll
        for (int q = 0; q < 8; ++q) { hv[q] = hS[tau * 68 + v8 + q] + hS[(64 + 63 - tau) * 68 + v8 + q]; s += hv[q]; }
        s += __shfl_xor(s, 1); s += __shfl_xor(s, 2); s += __shfl_xor(s, 4);
        const float mu = s * (1.f / 64.f);
        float qq = 0.f;
#pragma unroll
        for (int q = 0; q < 8; ++q) { const float dlt = hv[q] - mu; qq += dlt * dlt; }
        qq += __shfl_xor(qq, 1); qq += __shfl_xor(qq, 2); qq += __shfl_xor(qq, 4);
        const float rstd = 1.f / sqrtf(qq * (1.f / 64.f) + EPS);
        const int t = tb + tau;
        const u4v ov = *(const u4v*)((const bf16_t*)(p.ws + WS_MLO) + (size_t)t * 256 + head * 64 + v8);
        const float* ng = p.in[I_MLG] + (size_t)l * 256 + head * 64 + v8;
        float o[8];
#pragma unroll
        for (int q = 0; q < 8; ++q) { const float og = bf2f((bf16_t)(ov[q >> 1] >> (16 * (q & 1)))); o[q] = (hv[q] - mu) * rstd * ng[q] * sigmoidf_(og); }
        u4v pk; pk[0] = pack2(o[0], o[1]); pk[1] = pack2(o[2], o[3]); pk[2] = pack2(o[4], o[5]); pk[3] = pack2(o[6], o[7]);
        *(u4v*)((bf16_t*)(p.ws + WS_MIXED) + (size_t)t * MIXW + 384 + head * 64 + v8) = pk;
    }
    __syncthreads();
}

DEV int queue_next(const Params& p, char* smem, int qi) {
    int* slot = (int*)(smem + SMEM_XB + 32);
    __syncthreads();
    if (threadIdx.x == 0) {
#ifdef EMU
        unsigned* w = (unsigned*)(p.ws + WS_BAR) + QUEUE_WORD0 + 64 * qi; *slot = (int)(*w)++;
#else
        *slot = (int)__hip_atomic_fetch_add((unsigned*)(p.ws + WS_BAR) + QUEUE_WORD0 + 64 * qi, 1u, __ATOMIC_RELAXED, __HIP_MEMORY_SCOPE_AGENT);
#endif
    }
    __syncthreads();
    return *slot;
}
DEV void phase_attn(const Params& p, char* smem, int l, int qi) {
    constexpr int QB_S = DEC_SEQ / 256, QB_P = SEQ / 256;
    constexpr int U_SG = DEC_BATCH * GQH * QB_S * 2, U_SN = DEC_BATCH * NAH * QB_S, U_PN = BATCH * NAH * QB_P, U_PG = BATCH * GQH * QB_P;
    constexpr int U_MP = BATCH * MLH * NCH_P, U_MS = DEC_BATCH * MLH * NCH_S;
    constexpr int NU = U_SG + U_SN + U_PN + U_PG + U_MP + U_MS;
    const bf16_t* naq = (const bf16_t*)(p.ws + WS_NAQ); const bf16_t* nak = (const bf16_t*)(p.ws + WS_NAK); const bf16_t* nav = (const bf16_t*)(p.ws + WS_NAV);
    const bf16_t* gqq = (const bf16_t*)(p.ws + WS_GQQ); const bf16_t* gqk = (const bf16_t*)(p.ws + WS_GQK); const bf16_t* gqv = (const bf16_t*)(p.ws + WS_GQV);
    bf16_t* mixed = (bf16_t*)(p.ws + WS_MIXED);
    for (;;) {
        int u = queue_next(p, smem, qi);
        if (u >= NU) break;
        AttnDesc d; d.na = 0; d.r0 = 0; d.rlo = 0; d.rpb = nullptr; d.part = nullptr; d.out = nullptr; d.ostride = MIXW; d.n0 = 0; d.k0 = d.v0 = nullptr; d.stride0 = 0;
        if (u < U_SG) {
            const int half = u & 1, qb = (u >> 1) % QB_S, qh = (u / (2 * QB_S)) % GQH, b = u / (2 * QB_S * GQH);
            const int kvh = qh / (GQH / GQKV);
            constexpr int NCT = PAST / 64, TT = NCT + DEC_SEQ / 64, H0 = TT / 2;
            const size_t tq = (size_t)NP + (size_t)b * DEC_SEQ + qb * 256;
            d.q = gqq + tq * 384 + qh * 64; d.qstride = 384;
            const bf16_t* lk = gqk + ((size_t)NP + (size_t)b * DEC_SEQ) * 128 + kvh * 64; const bf16_t* lv = gqv + ((size_t)NP + (size_t)b * DEC_SEQ) * 128 + kvh * 64;
            if (half == 0) {
                d.n0 = NCT; d.ntiles = H0; d.stride0 = 128;
                const size_t co = (((size_t)b * DEPTH + l) * PAST) * 128 + kvh * 64;
                d.k0 = (const bf16_t*)(p.ws + WS_CGQK) + co; d.v0 = (const bf16_t*)(p.ws + WS_CGQV) + co;
                d.k1 = lk; d.v1 = lv; d.stride1 = 128;
            } else {
                d.n0 = 0; d.ntiles = TT - H0; d.stride1 = 128;
                d.k1 = lk + (size_t)(H0 - NCT) * 64 * 128; d.v1 = lv + (size_t)(H0 - NCT) * 64 * 128;
            }
            d.part = (float*)(p.ws + WS_PART) + (size_t)u * PART_STRIDE;
        } else if (u < U_SG + U_SN) {
            const int uu = u - U_SG; const int qb = uu % QB_S, hd = (uu / QB_S) % NAH, b = uu / (QB_S * NAH);
            const size_t t0 = (size_t)NP + (size_t)b * DEC_SEQ;
            d.q = naq + (t0 + qb * 256) * 384 + hd * 64; d.qstride = 384;
            d.na = 1; d.r0 = qb * 4; d.rlo = na_row_start(d.r0);
            const int rhi = na_row_start(d.r0 + 3) + KR;
            d.n0 = PAST / 64; d.ntiles = d.n0 + (rhi - d.rlo); d.stride0 = 384; d.stride1 = 384;
            const size_t co = (((size_t)b * DEPTH + l) * PAST) * 384 + hd * 64;
            d.k0 = (const bf16_t*)(p.ws + WS_CNAK) + co; d.v0 = (const bf16_t*)(p.ws + WS_CNAV) + co;
            d.k1 = nak + (t0 + (size_t)d.rlo * 64) * 384 + hd * 64; d.v1 = nav + (t0 + (size_t)d.rlo * 64) * 384 + hd * 64;
            d.rpb = p.in[I_RPB] + ((size_t)l * NAH + hd) * 15 * 31;
            d.out = mixed + (t0 + qb * 256) * MIXW + hd * 64;
        } else if (u < U_SG + U_SN + U_PN) {
            const int uu = u - U_SG - U_SN; const int qb = uu % QB_P, hd = (uu / QB_P) % NAH, b = uu / (QB_P * NAH);
            const size_t t0 = (size_t)b * SEQ;
            d.q = naq + (t0 + qb * 256) * 384 + hd * 64; d.qstride = 384;
            d.n0 = 0; d.ntiles = SEQ / 64; d.stride1 = 384; d.k1 = nak + t0 * 384 + hd * 64; d.v1 = nav + t0 * 384 + hd * 64;
            d.out = mixed + (t0 + qb * 256) * MIXW + hd * 64;
        } else if (u < U_SG + U_SN + U_PN + U_PG) {
            const int uu = u - U_SG - U_SN - U_PN; const int qb = uu % QB_P, qh = (uu / QB_P) % GQH, b = uu / (QB_P * GQH);
            const int kvh = qh / (GQH / GQKV);
            const size_t t0 = (size_t)b * SEQ;
            d.q = gqq + (t0 + qb * 256) * 384 + qh * 64; d.qstride = 384;
            d.n0 = 0; d.ntiles = SEQ / 64; d.stride1 = 128; d.k1 = gqk + t0 * 128 + kvh * 64; d.v1 = gqv + t0 * 128 + kvh * 64;
            d.out = mixed + (t0 + qb * 256) * MIXW + 640 + qh * 64;
        } else {
            int uu = u - (U_SG + U_SN + U_PN + U_PG); const int grp = uu >= U_MP ? 1 : 0; if (grp) uu -= U_MP;
            const int nch = grp ? NCH_S : NCH_P;
            mlstm_summary_unit(p, smem, grp, uu / (nch * MLH), (uu / nch) % MLH, uu % nch);
        }
        if (u < U_SG + U_SN + U_PN + U_PG) attn_unit(smem, d);
    }
}

DEV void phase_mlout(const Params& p, char* smem, int l) {
    constexpr int QB_S = DEC_SEQ / 256;
    constexpr int U_MS = DEC_BATCH * MLH * NCH_S, U_MP = BATCH * MLH * NCH_P, U_CB = DEC_BATCH * GQH * QB_S;
    const int tid = get_tid();
    for (int u = blockIdx.x; u < U_MS + U_MP + U_CB; u += gridDim.x) {
        if (u < U_MS + U_MP) { const int grp = u < U_MS ? 1 : 0; const int uu = grp ? u : u - U_MS; const int nch = grp ? NCH_S : NCH_P;
            mlstm_output_unit(p, smem, l, grp, uu / (nch * MLH), (uu / nch) % MLH, uu % nch); }
        else {
            const int uu = u - U_MS - U_MP; const int qb = uu % QB_S, qh = (uu / QB_S) % GQH, b = uu / (QB_S * GQH);
            const float* p0 = (const float*)(p.ws + WS_PART) + (size_t)(2 * uu) * PART_STRIDE; const float* p1 = p0 + PART_STRIDE;
            const int q = tid >> 1, d0 = (tid & 1) * 32;
            const float m0 = p0[256 * 64 + q], m1 = p1[256 * 64 + q], l0 = p0[256 * 64 + 256 + q], l1 = p1[256 * 64 + 256 + q];
            const float m = fmaxf(m0, m1), w0 = expf(m0 - m), w1 = expf(m1 - m);
            const float inv = 1.f / (l0 * w0 + l1 * w1);
            bf16_t* dst = (bf16_t*)(p.ws + WS_MIXED) + ((size_t)NP + (size_t)b * DEC_SEQ + qb * 256 + q) * MIXW + 640 + qh * 64 + d0;
#pragma unroll
            for (int i = 0; i < 8; ++i) {
                const f4v a = *(const f4v*)(p0 + (size_t)q * 64 + d0 + 4 * i), bb = *(const f4v*)(p1 + (size_t)q * 64 + d0 + 4 * i);
                u2v pk; pk[0] = pack2((a[0] * w0 + bb[0] * w1) * inv, (a[1] * w0 + bb[1] * w1) * inv); pk[1] = pack2((a[2] * w0 + bb[2] * w1) * inv, (a[3] * w0 + bb[3] * w1) * inv);
                *(u2v*)(dst + 4 * i) = pk;
            }
        }
    }
}

constexpr int N_PHASES = 2 + 9 * DEPTH;
#ifndef EMU
typedef const __attribute__((address_space(4))) Params* KParamsPtr;
DEV void load_params(Params& p) {
    KParamsPtr kp = (KParamsPtr)__builtin_amdgcn_kernarg_segment_ptr();
    asm volatile("" : "+s"(kp));
#pragma unroll
    for (int i = 0; i < N_IN; ++i) p.in[i] = kp->in[i];
    p.out = kp->out; p.ws = kp->ws; p.ph0 = kp->ph0; p.ph1 = kp->ph1;
}
#endif
#ifdef EMU
static char emu_smem[SMEM_BYTES + 64];
#endif
__global__ void __launch_bounds__(512, 2) mega_kernel(Params p_) {
    const int ph0 = p_.ph0, ph1 = p_.ph1;
#ifdef EMU
    char* smem = emu_smem;
#define GRID_SYNC() do {} while (0)
#else
    extern __shared__ __attribute__((aligned(16))) char smem[];
    if (threadIdx.x == 0) *(u4v*)(smem + SMEM_XB) = (u4v){0u, 0u, 0u, 0u};
    __syncthreads();
    (void)xcd_barrier_post((unsigned*)(p_.ws + WS_BAR), (volatile LAS unsigned*)(smem + SMEM_XB));
    const bool multi = (ph1 - ph0) > 1;
#define GRID_SYNC() do { if (multi) { KParamsPtr kpb = (KParamsPtr)__builtin_amdgcn_kernarg_segment_ptr(); asm volatile("" : "+s"(kpb)); \
        XcdBarrier xb; xb.bar = (unsigned*)(kpb->ws + WS_BAR); xb.x = xb_xcc_id(); xb.st = (volatile LAS unsigned*)(smem + SMEM_XB); xcd_barrier(xb); } } while (0)
#endif
    int ph = 0;
#ifndef KIND_MASK
#define KIND_MASK 0x3ff
#endif
#ifdef EMU
#define LOAD_PARAMS() const Params& p = p_
#else
#define LOAD_PARAMS() Params p; load_params(p)
#endif
#ifndef DOUBLE_MASK
#define DOUBLE_MASK 0
#endif
#define PH_KIND() (ph == 0 ? 0 : ph == 1 + 9 * DEPTH ? 1 : 1 + (ph - 1) % 9)
#define RUN_PHASE(body) do { if (((KIND_MASK >> PH_KIND()) & 1) && ph >= ph0 && ph < ph1) { \
    if (DOUBLE_MASK && ((DOUBLE_MASK >> PH_KIND()) & 1)) { { const int rep_ = 1; LOAD_PARAMS(); body; } GRID_SYNC(); } \
    { const int rep_ = 0; LOAD_PARAMS(); body; } if (ph + 1 < ph1) GRID_SYNC(); } ++ph; } while (0)
    RUN_PHASE(phase_ada(p, smem));
    for (int l = 0; l < DEPTH; ++l) {
        RUN_PHASE(phase_rows<0>(p, smem, l));
        RUN_PHASE(phase_inproj<0>(p, smem, l));
        RUN_PHASE(phase_attn(p, smem, l, l + DEPTH * rep_));
        RUN_PHASE(phase_mlout(p, smem, l));
        RUN_PHASE(phase_outproj<0>(p, smem, l));
        RUN_PHASE(phase_rows<1>(p, smem, l));
        RUN_PHASE(phase_topk(p, smem));
        RUN_PHASE(phase_gateup<0>(p, smem, l));
        RUN_PHASE(phase_down<0>(p, smem, l));
    }
    RUN_PHASE(phase_rows<0>(p, smem, DEPTH));
}

#if !defined(EMU) && defined(PROBE_KIND)
__global__ void __launch_bounds__(512, 2) probe_kernel(Params p) {
    extern __shared__ __attribute__((aligned(16))) char smem[];
    for (int r = 0; r < PROBE_REPS; ++r) {
#if PROBE_KIND == 8
        phase_gateup<PROBE_VAR>(p, smem, 1);
#elif PROBE_KIND == 9
        phase_down<PROBE_VAR>(p, smem, 1);
#elif PROBE_KIND == 2
        phase_inproj<PROBE_VAR>(p, smem, 1);
#elif PROBE_KIND == 5
        phase_outproj<PROBE_VAR>(p, smem, 1);
#elif PROBE_KIND == 0
        phase_ada(p, smem);
#elif PROBE_KIND == 1
        phase_rows<0>(p, smem, 1);
#elif PROBE_KIND == 6
        phase_rows<1>(p, smem, 1);
#elif PROBE_KIND == 7
        phase_topk(p, smem);
#elif PROBE_KIND == 3
        phase_attn(p, smem, 1, 8 + r);
#elif PROBE_KIND == 4
        phase_mlout(p, smem, 1);
#endif
        __syncthreads();
    }
}
#endif
#ifndef EMU
#ifndef MK_N_LAUNCHES
#define MK_N_LAUNCHES 1
#endif
extern "C" void kernel_launch(void* const* d_in, const int* in_sizes, int n_in, void* d_out, int out_size, void* d_ws, size_t ws_size, hipStream_t stream) {
    (void)in_sizes; (void)n_in; (void)out_size; (void)ws_size;
    static int grid = 0;
    if (!grid) {
        int dev = 0, cus = 0, per_cu = 0;
        (void)hipGetDevice(&dev);
        (void)hipDeviceGetAttribute(&cus, hipDeviceAttributeMultiprocessorCount, dev);
        (void)hipFuncSetAttribute((const void*)mega_kernel, hipFuncAttributeMaxDynamicSharedMemorySize, SMEM_BYTES);
        (void)hipOccupancyMaxActiveBlocksPerMultiprocessor(&per_cu, mega_kernel, 512, SMEM_BYTES);
        grid = cus * (per_cu < 1 ? per_cu : 1);
        if (grid <= 0) grid = cus;
    }
    (void)hipMemsetAsync((char*)d_ws + WS_BAR, 0, WS_BAR_BYTES, stream);
    Params p = {};
    for (int i = 0; i < N_IN; ++i) p.in[i] = (const float*)d_in[i];
    p.out = (float*)d_out; p.ws = (char*)d_ws;
#if MK_N_LAUNCHES == 1
    p.ph0 = 0; p.ph1 = N_PHASES;
    mega_kernel<<<dim3(grid), dim3(512), SMEM_BYTES, stream>>>(p);
#ifdef PROBE_KIND
    (void)hipFuncSetAttribute((const void*)probe_kernel, hipFuncAttributeMaxDynamicSharedMemorySize, SMEM_BYTES);
    probe_kernel<<<dim3(grid), dim3(512), SMEM_BYTES, stream>>>(p);
#endif
#else
    for (int ph = 0; ph < N_PHASES; ++ph) { p.ph0 = ph; p.ph1 = ph + 1; mega_kernel<<<dim3(grid), dim3(512), SMEM_BYTES, stream>>>(p); }
#endif
}
#endif
```

```cpp
#ifndef EMU
#include <hip/hip_runtime.h>
#define DEV __device__ __forceinline__
#else
#define DEV static inline __attribute__((always_inline))
#endif
#include <stdint.h>
#include <stddef.h>

#ifndef CFG_D
#define CFG_D 1024
#define CFG_BATCH 16
#define CFG_SEQ 256
#define CFG_DEC_BATCH 2
#define CFG_DEC_SEQ 2048
#define CFG_PAST 256
#define CFG_EH 2816
#endif
constexpr int D = CFG_D, BATCH = CFG_BATCH, SEQ = CFG_SEQ, DEC_BATCH = CFG_DEC_BATCH, DEC_SEQ = CFG_DEC_SEQ, PAST = CFG_PAST, EH = CFG_EH;
constexpr int DEPTH = 2, HD = 64, NAH = 6, MLH = 4, GQH = 6, GQKV = 2, NEXP = 16, GRIDW = 64;
constexpr int NP = BATCH * SEQ, NS = DEC_BATCH * DEC_SEQ, NT = NP + NS, NCOND = 1 + DEC_BATCH;
constexpr int PROJ_W = 2832, MIXW = 1024;
constexpr int CAP_P = SEQ / 8, CAP_S = DEC_SEQ / 8, SLOTS = BATCH * CAP_P + DEC_BATCH * CAP_S;
constexpr int ROWS = DEC_SEQ / GRIDW, KR = ROWS < 8 ? ROWS : 8, KC = 16;
constexpr int NCH_P = SEQ / 64, NCH_S = DEC_SEQ / 64;
constexpr float ALPHA = 1.41421356237309515f;
constexpr float ATT_SCALE = 0.125f;
constexpr float EPS = 1e-6f;
static_assert(SLOTS % 256 == 0 && NP % 256 == 0 && NS % 256 == 0 && SEQ % 256 == 0 && DEC_SEQ % 256 == 0, "tile divisibility");
static_assert(D % 256 == 0 && EH % 128 == 0 && PAST % 64 == 0, "tile divisibility");

typedef unsigned short bf16_t;
typedef short s8v __attribute__((ext_vector_type(8)));
typedef short s4v __attribute__((ext_vector_type(4)));
typedef float f16v __attribute__((ext_vector_type(16)));
typedef float f4v __attribute__((ext_vector_type(4)));
typedef unsigned u4v __attribute__((ext_vector_type(4)));
typedef unsigned u2v __attribute__((ext_vector_type(2)));

enum { I_XP = 0, I_XS, I_C, I_CNAK, I_CNAV, I_CGQK, I_CGQV, I_SC, I_SN, I_SM, I_CCTX, I_ADAW, I_ADAB, I_WIN, I_BGATE, I_WOUT, I_RPB, I_QKG, I_MLG,
       I_LNG, I_LNB, I_RW, I_WG, I_WU, I_WD, N_IN };

constexpr size_t O_YP = 0;
constexpr size_t O_YS = O_YP + (size_t)NP * D;
constexpr size_t O_NAK = O_YS + (size_t)NS * D;
constexpr size_t O_NAV = O_NAK + (size_t)BATCH * DEPTH * SEQ * NAH * HD;
constexpr size_t O_GQK = O_NAV + (size_t)BATCH * DEPTH * SEQ * NAH * HD;
constexpr size_t O_GQV = O_GQK + (size_t)BATCH * DEPTH * SEQ * GQKV * HD;
constexpr size_t O_MC = O_GQV + (size_t)BATCH * DEPTH * SEQ * GQKV * HD;
constexpr size_t O_MN = O_MC + (size_t)BATCH * DEPTH * 2 * MLH * HD * HD;
constexpr size_t O_MM = O_MN + (size_t)BATCH * DEPTH * 2 * MLH * HD;
constexpr size_t O_END = O_MM + (size_t)BATCH * DEPTH * 2 * MLH;

constexpr size_t al256(size_t x) { return (x + 255) & ~(size_t)255; }
constexpr size_t WS_BAR = 0;
constexpr size_t WS_BAR_BYTES = 32768;
constexpr size_t WS_MODS = WS_BAR + WS_BAR_BYTES;
constexpr size_t WS_ROPE = al256(WS_MODS + (size_t)DEPTH * NCOND * 6 * D * 4);
constexpr size_t WS_CNAK = al256(WS_ROPE + 64 * 16 * 2 * 4);
constexpr size_t WS_CNAV = al256(WS_CNAK + (size_t)DEC_BATCH * DEPTH * PAST * NAH * HD * 2);
constexpr size_t WS_CGQK = al256(WS_CNAV + (size_t)DEC_BATCH * DEPTH * PAST * NAH * HD * 2);
constexpr size_t WS_CGQV = al256(WS_CGQK + (size_t)DEC_BATCH * DEPTH * PAST * GQKV * HD * 2);
constexpr size_t WS_XBUF = al256(WS_CGQV + (size_t)DEC_BATCH * DEPTH * PAST * GQKV * HD * 2);
constexpr size_t WS_HMOD = al256(WS_XBUF + (size_t)NT * D * 4);
constexpr size_t WS_GATES = al256(WS_HMOD + (size_t)NT * D * 2);
constexpr size_t WS_NAQ = al256(WS_GATES + (size_t)NT * 16 * 4);
constexpr size_t WS_NAK = al256(WS_NAQ + (size_t)NT * 384 * 2);
constexpr size_t WS_NAV = al256(WS_NAK + (size_t)NT * 384 * 2);
constexpr size_t WS_MLQ = al256(WS_NAV + (size_t)NT * 384 * 2);
constexpr size_t WS_MLK = al256(WS_MLQ + (size_t)NT * 256 * 2);
constexpr size_t WS_MLV = al256(WS_MLK + (size_t)NT * 256 * 2);
constexpr size_t WS_MLO = al256(WS_MLV + (size_t)NT * 256 * 2);
constexpr size_t WS_GQQ = al256(WS_MLO + (size_t)NT * 256 * 2);
constexpr size_t WS_GQK = al256(WS_GQQ + (size_t)NT * 384 * 2);
constexpr size_t WS_GQV = al256(WS_GQK + (size_t)NT * 128 * 2);
constexpr size_t WS_MIXED = al256(WS_GQV + (size_t)NT * 128 * 2);
constexpr size_t WS_U = al256(WS_MIXED + (size_t)NT * MIXW * 2);
constexpr size_t WS_X1 = al256(WS_U + (size_t)NT * D * 4);
constexpr size_t WS_H2 = al256(WS_X1 + (size_t)NT * D * 4);
constexpr size_t WS_AFF = al256(WS_H2 + (size_t)NT * D * 2);
constexpr size_t WS_IDX = al256(WS_AFF + (size_t)NT * 16 * 4);
constexpr size_t WS_GSEL = al256(WS_IDX + (size_t)NEXP * SLOTS * 4);
constexpr size_t WS_TOKSLOT = al256(WS_GSEL + (size_t)NEXP * SLOTS * 4);
constexpr size_t WS_HID = al256(WS_TOKSLOT + (size_t)NT * 16 * 4);
constexpr size_t WS_YE = al256(WS_HID + (size_t)NEXP * SLOTS * EH * 2);
constexpr int MLSUM_STRIDE = 4096 + 64 + 64;
constexpr int N_MLSUM = (BATCH * NCH_P + DEC_BATCH * NCH_S) * MLH * 2;
constexpr size_t WS_MLSUM = al256(WS_YE + (size_t)NEXP * SLOTS * D * 2);
constexpr int PART_STRIDE = 256 * 64 + 512;
constexpr int N_PART = DEC_BATCH * GQH * (DEC_SEQ / 256) * 2;
constexpr size_t WS_PART = al256(WS_MLSUM + (size_t)N_MLSUM * MLSUM_STRIDE * 4);
constexpr size_t WS_TOTAL = al256(WS_PART + (size_t)N_PART * PART_STRIDE * 4);

struct Params {
    const float* in[N_IN];
    float* out;
    char* ws;
    int ph0, ph1;
};

DEV float bf2f(bf16_t s) { unsigned u = ((unsigned)s) << 16; return __builtin_bit_cast(float, u); }
DEV bf16_t f2bf(float f) {
#ifdef EMU
    unsigned u = __builtin_bit_cast(unsigned, f); u += 0x7fffu + ((u >> 16) & 1u); return (bf16_t)(u >> 16);
#else
    return __builtin_bit_cast(bf16_t, (__bf16)f);
#endif
}
DEV unsigned pack2(float a, float b) {
#ifdef EMU
    return (unsigned)f2bf(a) | ((unsigned)f2bf(b) << 16);
#else
    typedef __bf16 b2 __attribute__((ext_vector_type(2))); b2 r; r[0] = (__bf16)a; r[1] = (__bf16)b; return __builtin_bit_cast(unsigned, r);
#endif
}
DEV float fexp(float x) {
#ifdef EMU
    return expf(x);
#else
    return __expf(x);
#endif
}
DEV float frcp(float x) {
#ifdef EMU
    return 1.f / x;
#else
    return __builtin_amdgcn_rcpf(x);
#endif
}
DEV float sigmoidf_(float x) { return frcp(1.f + fexp(-x)); }
DEV float siluf_(float x) { return x * frcp(1.f + fexp(-x)); }
DEV float logsigmoidf_(float x) { return fminf(x, 0.f) - log1pf(expf(-fabsf(x))); }
DEV f16v mfma32(s8v a, s8v b, f16v c) {
#ifdef EMU
    return emu_mfma_32x32x16_bf16(a, b, c);
#else
    typedef __bf16 bf8 __attribute__((ext_vector_type(8)));
    return __builtin_amdgcn_mfma_f32_32x32x16_bf16(__builtin_bit_cast(bf8, a), __builtin_bit_cast(bf8, b), c, 0, 0, 0);
#endif
}
DEV s4v lds_tr16(const void* p) {
#ifdef EMU
    return emu_ds_read_tr16_b64(p);
#else
    typedef s4v __attribute__((address_space(3))) * lp;
    return __builtin_amdgcn_ds_read_tr16_b64_v4i16((lp)(p));
#endif
}
#ifdef EMU
DEV float wave_sum(float v) { for (int m = 32; m >= 1; m >>= 1) v += __shfl_xor(v, m); return v; }
#else
template <int CTRL, int RM> DEV float dpp_f(float v) { return __builtin_bit_cast(float, __builtin_amdgcn_update_dpp(0, __builtin_bit_cast(int, v), CTRL, RM, 0xF, false)); }
DEV float wave_sum(float v) {
    v += dpp_f<0xB1, 0xF>(v); v += dpp_f<0x4E, 0xF>(v); v += dpp_f<0x141, 0xF>(v); v += dpp_f<0x140, 0xF>(v);
    v += dpp_f<0x142, 0xA>(v); v += dpp_f<0x143, 0xC>(v);
    return __builtin_bit_cast(float, __builtin_amdgcn_readlane(__builtin_bit_cast(int, v), 63));
}
#endif
DEV float wave_max(float v) { for (int m = 32; m >= 1; m >>= 1) v = fmaxf(v, __shfl_xor(v, m)); return v; }
DEV f16v f16zero() { f16v z; for (int i = 0; i < 16; ++i) z[i] = 0.f; return z; }

#ifdef EMU
#define VGPR_PIN(x) do {} while (0)
#define SGPR_PIN(x) do {} while (0)
#define SCHED_FENCE() do {} while (0)
#define CFENCE() do {} while (0)
#else
#define SCHED_FENCE() __builtin_amdgcn_sched_barrier(0)
#define SGPR_PIN(x) asm volatile("" : "+s"(x))
#define VGPR_PIN(x) asm volatile("" : "+v"(x))
#define CFENCE() asm volatile("" ::: "memory")
#endif
#ifdef EMU
DEV int get_tid() { return (int)threadIdx.x; }
#else
DEV int get_tid() { int t = threadIdx.x; asm volatile("" : "+v"(t)); return t; }
#endif
struct UnitIter { int i, end, step; };
DEV UnitIter unit_iter(int NU) {
    const int G = (int)gridDim.x, b = (int)blockIdx.x;
    UnitIter it;
#ifndef XCD_MODE
#define XCD_MODE 0
#endif
    if ((G & 7) == 0 && (NU & 7) == 0) { const int W = G >> 3, x = XCD_MODE ? b / W : b & 7, j = XCD_MODE ? b % W : b >> 3, C = NU >> 3; it.i = x * C + j; it.end = (x + 1) * C; it.step = W; }
    else { it.i = b; it.end = NU; it.step = G; }
    return it;
}
DEV int tok_cond(int t) { return t < NP ? 0 : 1 + (t - NP) / DEC_SEQ; }

#ifndef EMU
#define XB_TMO      128
#define XB_XCNT(j)  (256  + 64 * (j))
#define XB_XSUB(j)  (1280 + 64 * (j))
#define XB_XGEN(j)  (2304 + 64 * (j))
#define XB_TOP      3328
#define XB_TOPGEN   3392
#define XCD_BAR_WORDS 3456
#define XB_SPIN_CAP (1u << 20)
#define LAS __attribute__((address_space(3)))
__device__ __forceinline__ unsigned xb_ld(unsigned* p)              { return __hip_atomic_load(p, __ATOMIC_RELAXED, __HIP_MEMORY_SCOPE_AGENT); }
__device__ __forceinline__ unsigned xb_add(unsigned* p, unsigned v) { return __hip_atomic_fetch_add(p, v, __ATOMIC_RELAXED, __HIP_MEMORY_SCOPE_AGENT); }
__device__ __forceinline__ unsigned xb_xcc_id() { return (unsigned)__builtin_amdgcn_s_getreg((3 << 11) | 20) & 0xFu; }
#define XB_SPIN(cond, bar) do { unsigned _sp = 0; while (cond) { __builtin_amdgcn_s_sleep(1); \
    if ((++_sp & 255u) == 0u) { if (xb_ld(&(bar)[XB_TMO])) break; if (_sp > XB_SPIN_CAP) { atomicAdd(&(bar)[XB_TMO], 1u); break; } } } } while (0)
struct XcdBarrier { unsigned* bar; unsigned x; volatile LAS unsigned* st; };
__device__ __forceinline__ XcdBarrier xcd_barrier_post(unsigned* bar, volatile LAS unsigned* st) {
    XcdBarrier b; b.bar = bar; b.x = xb_xcc_id(); b.st = st;
    if (threadIdx.x == 0) (void)xb_add(&bar[XB_XCNT(b.x)], 1u);
    return b;
}
__device__ __forceinline__ void xcd_barrier_complete(unsigned* bar, unsigned x, unsigned& nloc, unsigned& nx) {
    const unsigned G = gridDim.x * gridDim.y * gridDim.z;
    unsigned sum, cnt, mine, sp = 0u;
    for (;;) {
        sum = 0u; cnt = 0u; mine = 0u;
#pragma unroll
        for (unsigned j = 0; j < 16; ++j) { const unsigned c = xb_ld(&bar[XB_XCNT(j)]); sum += c; cnt += (c > 0u) ? 1u : 0u; mine = (j == x) ? c : mine; }
        if (sum == G) break;
        __builtin_amdgcn_s_sleep(1);
        if ((++sp & 255u) == 0u) { if (xb_ld(&bar[XB_TMO])) break; if (sp > XB_SPIN_CAP) { atomicAdd(&bar[XB_TMO], 1u); break; } }
    }
    nloc = mine > 0u ? mine : 1u; nx = cnt > 0u ? cnt : 1u;
}
__device__ __forceinline__ void xcd_barrier(const XcdBarrier& b) {
    asm volatile("s_waitcnt vmcnt(0)" ::: "memory");
    __syncthreads();
    if (threadIdx.x == 0) {
        unsigned* bar = b.bar;
        __builtin_amdgcn_s_waitcnt(0);
        unsigned nloc = b.st[0], nx = b.st[1];
        if (nloc == 0u) { xcd_barrier_complete(bar, b.x, nloc, nx); b.st[0] = nloc; b.st[1] = nx; }
        const unsigned old = xb_add(&bar[XB_XSUB(b.x)], 1u);
        const unsigned gen = old / nloc;
        if (old + 1u == (gen + 1u) * nloc) {
            __builtin_amdgcn_fence(__ATOMIC_RELEASE, "agent");
            asm volatile("s_waitcnt vmcnt(0)" ::: "memory");
            const unsigned og = xb_add(&bar[XB_TOP], 1u);
            const unsigned tg = og / nx;
            if (og + 1u == (tg + 1u) * nx) xb_add(&bar[XB_TOPGEN], 1u);
            else XB_SPIN(xb_ld(&bar[XB_TOPGEN]) == tg, bar);
            __builtin_amdgcn_fence(__ATOMIC_ACQUIRE, "agent");
            xb_add(&bar[XB_XGEN(b.x)], 1u);
            asm volatile("s_waitcnt vmcnt(0)" ::: "memory");
        } else {
            XB_SPIN(xb_ld(&bar[XB_XGEN(b.x)]) == gen, bar);
            __builtin_amdgcn_fence(__ATOMIC_ACQUIRE, "agent");
            asm volatile("s_waitcnt vmcnt(0)" ::: "memory");
        }
    }
    __syncthreads();
}
#endif
constexpr int QUEUE_WORD0 = 4096;

constexpr int LROW = 144;
constexpr int GEMM_AS = 256 * LROW;
constexpr int GEMM_BS = 64 * (256 * 2 + 64);
constexpr int SMEM_BYTES = 2 * GEMM_AS + 2 * GEMM_BS + 64;
constexpr int SMEM_XB = 2 * GEMM_AS + 2 * GEMM_BS;

#ifdef EMU
struct BufRsrc { const char* base; };
DEV BufRsrc make_rsrc(const void* p) { BufRsrc r; r.base = (const char*)p; return r; }
DEV float buf_load_f32(BufRsrc r, unsigned voff, unsigned soff) { return *(const float*)(r.base + voff + soff); }
DEV u4v buf_load_b128(BufRsrc r, unsigned voff, unsigned soff) { return *(const u4v*)(r.base + voff + soff); }
#else
typedef __amdgpu_buffer_rsrc_t BufRsrc;
DEV BufRsrc make_rsrc(const void* p) { return __builtin_amdgcn_make_buffer_rsrc((void*)p, 0, 0x7fffffff, 0x00020000); }
DEV float buf_load_f32(BufRsrc r, unsigned voff, unsigned soff) { return __builtin_bit_cast(float, __builtin_amdgcn_raw_buffer_load_b32(r, voff, soff, 0)); }
DEV u4v buf_load_b128(BufRsrc r, unsigned voff, unsigned soff) { return __builtin_amdgcn_raw_buffer_load_b128(r, voff, soff, 0); }
#endif
#ifdef EMU
#define WAVE_SYNC() do { (void)__shfl(0, 0); } while (0)
#else
#define WAVE_SYNC() asm volatile("s_waitcnt lgkmcnt(0)" ::: "memory")
#endif
DEV char* wave_stage_ptr(char* smem, int wave) { return smem + (wave < 4 ? GEMM_AS + wave * 9216 : 2 * GEMM_AS + GEMM_BS + (wave - 4) * 9216); }
DEV void stage64_write_bf16(char* stg, int tt, const f16v& v0, const f16v& v1, int l31, int h) {
    char* row = stg + (tt * 32 + l31) * LROW;
#pragma unroll
    for (int ft = 0; ft < 2; ++ft) {
        const f16v& v = ft ? v1 : v0;
#pragma unroll
        for (int g = 0; g < 4; ++g) { u2v pk; pk[0] = pack2(v[4 * g], v[4 * g + 1]); pk[1] = pack2(v[4 * g + 2], v[4 * g + 3]); *(u2v*)(row + (ft * 32 + 8 * g + 4 * h) * 2) = pk; }
    }
}
DEV void stage64_write4(char* stg, int row, int col, float a, float b, float c, float d) {
    u2v pk; pk[0] = pack2(a, b); pk[1] = pack2(c, d); *(u2v*)(stg + row * LROW + col * 2) = pk;
}
DEV void stage64_flush_bf16(const char* stg, bf16_t* dst0, size_t row_stride, int lane) {
    WAVE_SYNC();
#pragma unroll
    for (int i = 0; i < 8; ++i) { const int r = (lane >> 3) + 8 * i, c = lane & 7; const u4v v = *(const u4v*)(stg + r * LROW + c * 16); *(u4v*)(dst0 + (size_t)r * row_stride + c * 8) = v; }
    WAVE_SYNC();
}
template <int NTW, int VAR, class Epi>
DEV void gemm_tile(char* smem, BufRsrc ars, unsigned ao0, unsigned ao1, unsigned ao2, unsigned ao3,
                   BufRsrc brs, unsigned bvo, unsigned blds, unsigned ldb4, int K, Epi&& epi) {
    constexpr int BN = 64 * NTW, NLD = 2 * NTW, KSTEP = 64 / NLD, RSB = BN * 2 + 64;
    const int tid = get_tid(), lane = tid & 63, wave = tid >> 6, wm = wave & 3, wn = wave >> 2, h = lane >> 5, l31 = lane & 31;
    char* As = smem; char* Bs = smem + 2 * GEMM_AS;
    constexpr int BSZ = GEMM_BS;
    const int ar = tid >> 3, ac = tid & 7;
    u4v areg[2]; f4v b0[NLD], b1[NLD];
    if (VAR & 3) { for (int i = 0; i < 2; ++i) areg[i] = (u4v){1u, 2u, 3u, 4u}; for (int j = 0; j < NLD; ++j) { b0[j] = (f4v){1.f, 1.f, 1.f, 1.f}; b1[j] = (f4v){2.f, 2.f, 2.f, 2.f}; } }
    f16v acc[NTW][2];
#pragma unroll
    for (int i = 0; i < NTW; ++i) { acc[i][0] = f16zero(); acc[i][1] = f16zero(); }
    auto gloadA = [&](int k0, bool real, int half) {
        if (VAR & 2) return;
        const unsigned so = real ? k0 * 2 : 0u;
        areg[0] = buf_load_b128(ars, real ? (half ? ao2 : ao0) : 0u, so); areg[1] = buf_load_b128(ars, real ? (half ? ao3 : ao1) : 0u, so);
    };
    auto gloadB = [&](int k0, bool real, f4v (&br)[NLD]) {
        if (VAR & 1) return;
        const unsigned vo = real ? bvo : 0u; const int kk = real ? k0 : 0;
        unsigned so = (unsigned)kk * ldb4;
#pragma unroll
        for (int j = 0; j < NLD; ++j) { br[j] = __builtin_bit_cast(f4v, buf_load_b128(brs, vo, so)); so += KSTEP * ldb4; SGPR_PIN(so); }
    };
    auto lstoreA = [&](int buf, int half) {
        if (VAR & 16) return;
        char* ab = As + buf * GEMM_AS + (ar + half * 128) * LROW + ac * 16;
        *(u4v*)(ab) = areg[0]; *(u4v*)(ab + 64 * LROW) = areg[1];
    };
    auto lstoreB = [&](int buf, const f4v (&br)[NLD]) {
        if (VAR & 16) return;
        char* bb = Bs + buf * BSZ + blds;
#pragma unroll
        for (int j = 0; j < NLD; ++j) { u2v v; v[0] = pack2(br[j][0], br[j][1]); v[1] = pack2(br[j][2], br[j][3]); *(u2v*)(bb + j * KSTEP * RSB) = v; }
    };
    const unsigned btr = (unsigned)(8 * h + ((lane & 15) >> 2)) * RSB + (unsigned)((((lane >> 4) & 1) * 16 + 4 * (lane & 3)) * 2) + (unsigned)(wn * NTW * 32) * 2;
    const unsigned atr = (unsigned)(wm * 64 + l31) * LROW + h * 16;
    auto rdw = [&](int buf, int s, int ft) -> s8v {
        const char* bb = Bs + buf * BSZ + btr + s * 16 * RSB + ft * 64;
        const s4v lo = lds_tr16(bb), hi = lds_tr16(bb + 4 * RSB);
        s8v wf; wf[0] = lo[0]; wf[1] = lo[1]; wf[2] = lo[2]; wf[3] = lo[3]; wf[4] = hi[0]; wf[5] = hi[1]; wf[6] = hi[2]; wf[7] = hi[3];
        return wf;
    };
    auto compute2 = [&](int buf, int s0) {
        if (VAR & 8) return;
        const char* ab = As + buf * GEMM_AS + atr;
        s8v xa[2];
        xa[0] = *(const s8v*)(ab + s0 * 32); xa[1] = *(const s8v*)(ab + 32 * LROW + s0 * 32);
        s8v wcur = rdw(buf, s0, 0);
#pragma unroll
        for (int g = 0; g < 2 * NTW; ++g) {
            const int ft = g % NTW;
            s8v wnext = wcur;
            if (g + 1 < 2 * NTW) wnext = rdw(buf, s0 + (g + 1) / NTW, (g + 1) % NTW);
            if (VAR & 4) { acc[ft][0][0] += __builtin_bit_cast(float, (int)wcur[0] | ((int)xa[0][1] << 16)); acc[ft][1][0] += __builtin_bit_cast(float, (int)wcur[1] | ((int)xa[1][1] << 16)); }
            else { acc[ft][0] = mfma32(wcur, xa[0], acc[ft][0]); acc[ft][1] = mfma32(wcur, xa[1], acc[ft][1]); }
            if (g == NTW - 1) { xa[0] = *(const s8v*)(ab + (s0 + 1) * 32); xa[1] = *(const s8v*)(ab + 32 * LROW + (s0 + 1) * 32); }
            wcur = wnext;
            SCHED_FENCE();
        }
    };
    const int nk = K / 64;
    if (NTW == 2) {
        u4v a0[4], a1[4];
        if (VAR & 3) { for (int i = 0; i < 4; ++i) { a0[i] = (u4v){1u, 2u, 3u, 4u}; a1[i] = (u4v){1u, 2u, 3u, 4u}; } }
        auto gA = [&](int k0, bool real, u4v (&ar4)[4]) {
            if (VAR & 2) return;
            const unsigned so = real ? k0 * 2 : 0u;
            ar4[0] = buf_load_b128(ars, real ? ao0 : 0u, so); ar4[1] = buf_load_b128(ars, real ? ao1 : 0u, so);
            ar4[2] = buf_load_b128(ars, real ? ao2 : 0u, so); ar4[3] = buf_load_b128(ars, real ? ao3 : 0u, so);
        };
        auto sA = [&](int buf, const u4v (&ar4)[4]) {
            if (VAR & 16) return;
            char* ab = As + buf * GEMM_AS + ar * LROW + ac * 16;
#pragma unroll
            for (int i = 0; i < 4; ++i) *(u4v*)(ab + i * 64 * LROW) = ar4[i];
        };
        gA(0, true, a0); gloadB(0, true, b0); gA(64, true, a1); gloadB(64, true, b1);
        sA(0, a0); lstoreB(0, b0);
        __syncthreads();
        for (int kt = 0; kt < nk; kt += 2) {
            const bool t2 = kt + 2 < nk;
            gA((kt + 2) * 64, t2, a0); gloadB((kt + 2) * 64, t2, b0);
            compute2(0, 0); compute2(0, 2);
            sA(1, a1); lstoreB(1, b1);
            __syncthreads();
            gA((kt + 3) * 64, t2, a1); gloadB((kt + 3) * 64, t2, b1);
            compute2(1, 0); compute2(1, 2);
            sA(0, a0); lstoreB(0, b0);
            __syncthreads();
        }
    } else {
    gloadA(0, true, 0); gloadB(0, true, b0); lstoreA(0, 0); gloadA(0, true, 1); gloadB(64, true, b1); lstoreA(0, 1); lstoreB(0, b0);
    __syncthreads();
    for (int kt = 0; kt < nk; kt += 2) {
        const bool t2 = kt + 2 < nk;
        gloadA((kt + 1) * 64, true, 0);
        compute2(0, 0);
        lstoreA(1, 0);
        gloadA((kt + 1) * 64, true, 1);
        gloadB((kt + 2) * 64, t2, b0);
        compute2(0, 2);
        lstoreA(1, 1); lstoreB(1, b1);
        __syncthreads();
        gloadA((kt + 2) * 64, t2, 0);
        compute2(1, 0);
        lstoreA(0, 0);
        gloadA((kt + 2) * 64, t2, 1);
        gloadB((kt + 3) * 64, t2, b1);
        compute2(1, 2);
        lstoreA(0, 1); lstoreB(0, b0);
        __syncthreads();
    }
    }
    if (VAR & 32) { float t = 0.f; for (int i = 0; i < NTW; ++i) t += acc[i][0][0] + acc[i][1][5]; if (t == 123.456f) *(float*)smem = t; }
    else epi(acc);
}

DEV void phase_ada(const Params& p, char* smem) {
    const int tid = get_tid();
    float* siluS = (float*)smem;
    float* red = (float*)(smem + NCOND * D * 4);
    for (int i = tid; i < NCOND * D; i += 512) {
        const int cnd = i / D, k = i % D;
        const float c = cnd == 0 ? p.in[I_CCTX][k] : p.in[I_C][(cnd - 1) * D + k];
        siluS[i] = c / (1.f + expf(-c));
    }
    __syncthreads();
    constexpr int CPL = 6 * D / 32, NCHUNK = DEPTH * CPL, KG = D / 16;
    float* mods = (float*)(p.ws + WS_MODS);
    const int col = tid & 31, kg = tid >> 5;
    for (int u = blockIdx.x; u < NCHUNK; u += gridDim.x) {
        const int l = u / CPL, c0 = (u % CPL) * 32;
        const float* W = p.in[I_ADAW] + (size_t)l * D * 6 * D + c0 + col;
        float acc[NCOND];
#pragma unroll
        for (int c = 0; c < NCOND; ++c) acc[c] = 0.f;
#pragma unroll 8
        for (int k = kg * KG; k < kg * KG + KG; ++k) {
            const float w = W[(size_t)k * 6 * D];
#pragma unroll
            for (int c = 0; c < NCOND; ++c) acc[c] += siluS[c * D + k] * w;
        }
#pragma unroll
        for (int c = 0; c < NCOND; ++c) red[(kg * NCOND + c) * 32 + col] = acc[c];
        __syncthreads();
        if (tid < 32 * NCOND) {
            const int c = tid >> 5, cc = tid & 31;
            float s = 0.f;
            for (int g = 0; g < 16; ++g) s += red[(g * NCOND + c) * 32 + cc];
            mods[((size_t)l * NCOND + c) * 6 * D + c0 + cc] = s + p.in[I_ADAB][(size_t)l * 6 * D + c0 + cc];
        }
        __syncthreads();
    }
    const int gtid = blockIdx.x * 512 + tid, gsz = gridDim.x * 512;
    float* rope = (float*)(p.ws + WS_ROPE);
    for (int i = gtid; i < 64 * 16; i += gsz) {
        const int pos = i >> 4, fi = i & 15;
        const float inv = powf(10000.f, -(float)(2 * fi) / 32.f);
        const float ang = (float)pos * inv;
        rope[2 * i] = cosf(ang); rope[2 * i + 1] = sinf(ang);
    }
    constexpr int NNA = DEC_BATCH * DEPTH * PAST * NAH * HD, NGQ = DEC_BATCH * DEPTH * PAST * GQKV * HD;
    bf16_t* cnak = (bf16_t*)(p.ws + WS_CNAK); bf16_t* cnav = (bf16_t*)(p.ws + WS_CNAV);
    bf16_t* cgqk = (bf16_t*)(p.ws + WS_CGQK); bf16_t* cgqv = (bf16_t*)(p.ws + WS_CGQV);
    for (int i = gtid; i < NNA; i += gsz) { cnak[i] = f2bf(p.in[I_CNAK][i]); cnav[i] = f2bf(p.in[I_CNAV][i]); }
    for (int i = gtid; i < NGQ; i += gsz) { cgqk[i] = f2bf(p.in[I_CGQK][i]); cgqv[i] = f2bf(p.in[I_CGQV][i]); }
}

constexpr int EPL = D / 64;
constexpr int W16ROW = 20;
template <int MODE>
DEV void phase_rows(const Params& p, char* smem, int l) {
    const int tid = get_tid(), lane = tid & 63, wave = tid >> 6;
    float* W16 = (float*)smem;
    const bool need_w = (MODE == 1) || (l < DEPTH);
    if (need_w) {
        for (int i = tid; i < D * 4; i += 512) {
            const int k = i >> 2, q = i & 3;
            const float* src = (MODE == 1) ? p.in[I_RW] + ((size_t)l * D + k) * 16 + q * 4 : p.in[I_WIN] + ((size_t)l * D + k) * PROJ_W + 2176 + q * 4;
            *(f4v*)(W16 + k * W16ROW + q * 4) = *(const f4v*)src;
        }
    }
    __syncthreads();
    const float* mods = (const float*)(p.ws + WS_MODS);
    for (int t = blockIdx.x * 8 + wave; t < NT; t += gridDim.x * 8) {
        const int cnd = tok_cond(t);
        float v[EPL];
        if (MODE == 0 && l == 0) {
            const float* xr = t < NP ? p.in[I_XP] + (size_t)t * D : p.in[I_XS] + (size_t)(t - NP) * D;
#pragma unroll
            for (int j = 0; j < EPL; ++j) v[j] = xr[lane + 64 * j];
        } else if (MODE == 0) {
            const float* x1 = (const float*)(p.ws + WS_X1) + (size_t)t * D;
            const float* g2 = mods + ((size_t)(l - 1) * NCOND + cnd) * 6 * D + 5 * D;
            float f[EPL], xv[EPL], gv[EPL];
#pragma unroll
            for (int j = 0; j < EPL; ++j) { f[j] = 0.f; xv[j] = x1[lane + 64 * j]; gv[j] = g2[lane + 64 * j]; }
            const int* ts = (const int*)(p.ws + WS_TOKSLOT) + (size_t)t * 16;
            const int myslot = lane < 16 ? ts[lane] : -1;
            unsigned vm = (unsigned)__ballot(myslot >= 0);
            while (vm) {
                const int e = __builtin_ctz(vm); vm &= vm - 1u;
                const int slot = __shfl(myslot, e);
                const bf16_t* yr = (const bf16_t*)(p.ws + WS_YE) + ((size_t)e * SLOTS + slot) * D;
#pragma unroll
                for (int j = 0; j < EPL; ++j) f[j] += bf2f(yr[lane + 64 * j]);
            }
#pragma unroll
            for (int j = 0; j < EPL; ++j) v[j] = ALPHA * xv[j] + gv[j] * f[j];
        } else {
            const float* u = (const float*)(p.ws + WS_U) + (size_t)t * D;
#pragma unroll
            for (int j = 0; j < EPL; ++j) v[j] = u[lane + 64 * j];
        }
        if (!(MODE == 0 && l == 0)) {
            const int li = (MODE == 0) ? (l - 1) * 2 + 1 : l * 2;
            const float* lg = p.in[I_LNG] + (size_t)li * D; const float* lb = p.in[I_LNB] + (size_t)li * D;
            float g[EPL], bb[EPL];
#pragma unroll
            for (int j = 0; j < EPL; ++j) { g[j] = lg[lane + 64 * j]; bb[j] = lb[lane + 64 * j]; }
            float s = 0.f;
#pragma unroll
            for (int j = 0; j < EPL; ++j) s += v[j];
            const float mu = wave_sum(s) * (1.f / D);
            float q = 0.f;
#pragma unroll
            for (int j = 0; j < EPL; ++j) { const float dlt = v[j] - mu; q += dlt * dlt; }
            const float rstd = 1.f / sqrtf(wave_sum(q) * (1.f / D) + EPS);
            float* dst = (MODE == 1) ? (float*)(p.ws + WS_X1) + (size_t)t * D
                       : (l == DEPTH) ? (t < NP ? p.out + O_YP + (size_t)t * D : p.out + O_YS + (size_t)(t - NP) * D) : (float*)(p.ws + WS_XBUF) + (size_t)t * D;
#pragma unroll
            for (int j = 0; j < EPL; ++j) { v[j] = (v[j] - mu) * rstd * g[j] + bb[j]; dst[lane + 64 * j] = v[j]; }
        }
        if (MODE == 1 || l < DEPTH) {
            const float* sh = mods + ((size_t)l * NCOND + cnd) * 6 * D + (MODE == 1 ? 3 * D : 0); const float* sc = sh + D;
            bf16_t* hb = (bf16_t*)(p.ws + (MODE == 1 ? WS_H2 : WS_HMOD)) + (size_t)t * D;
            {
                float s1[EPL], s0[EPL];
#pragma unroll
                for (int j = 0; j < EPL; ++j) { s1[j] = sc[lane + 64 * j]; s0[j] = sh[lane + 64 * j]; }
#pragma unroll
                for (int j = 0; j < EPL; ++j) { v[j] = v[j] * (1.f + s1[j]) + s0[j]; hb[lane + 64 * j] = f2bf(v[j]); }
            }
            CFENCE();
            float a16[16];
#pragma unroll
            for (int e = 0; e < 16; ++e) a16[e] = 0.f;
#pragma unroll
            for (int j = 0; j < EPL; ++j) {
                const float hv = v[j];
                const float* wr = W16 + (lane + 64 * j) * W16ROW;
#pragma unroll
                for (int q = 0; q < 4; ++q) { const f4v w4 = *(const f4v*)(wr + 4 * q); a16[4 * q] += hv * w4[0]; a16[4 * q + 1] += hv * w4[1]; a16[4 * q + 2] += hv * w4[2]; a16[4 * q + 3] += hv * w4[3]; }
                if (j & 1) CFENCE();
            }
            float mine = -1e30f;
#pragma unroll
            for (int e = 0; e < 16; ++e) { const float sm = wave_sum(a16[e]); if (lane == e) mine = sm; }
            if (MODE == 0) {
                if (lane < 16) ((float*)(p.ws + WS_GATES))[(size_t)t * 16 + lane] = mine + p.in[I_BGATE][l * 16 + lane];
            } else {
                float mx = mine;
                for (int m = 8; m >= 1; m >>= 1) mx = fmaxf(mx, __shfl_xor(mx, m));
                const float ex = lane < 16 ? expf(mine - mx) : 0.f;
                float sm = ex;
                for (int m = 8; m >= 1; m >>= 1) sm += __shfl_xor(sm, m);
                if (lane < 16) ((float*)(p.ws + WS_AFF))[(size_t)t * 16 + lane] = ex / sm;
            }
        }
    }
}

template <int NPL>
DEV void topk_wave(const Params& p, int tb, int cap, int sbase, int e, int lane) {
    const float* aff = (const float*)(p.ws + WS_AFF);
    int* idx = (int*)(p.ws + WS_IDX); float* gsel = (float*)(p.ws + WS_GSEL); int* tokslot = (int*)(p.ws + WS_TOKSLOT);
    unsigned bits[NPL];
#pragma unroll
    for (int i = 0; i < NPL; ++i) bits[i] = __builtin_bit_cast(unsigned, aff[(size_t)(tb + lane + 64 * i) * 16 + e]);
    unsigned T = 0u;
    for (int b = 30; b >= 0; --b) {
        const unsigned cand = T | (1u << b);
        int cnt = 0;
#pragma unroll
        for (int i = 0; i < NPL; ++i) cnt += __popcll(__ballot(bits[i] >= cand));
        if (cnt >= cap) T = cand;
    }
    int ngt = 0;
#pragma unroll
    for (int i = 0; i < NPL; ++i) ngt += __popcll(__ballot(bits[i] > T));
    int need_eq = cap - ngt, run = 0;
    const unsigned long long lt = (1ull << lane) - 1ull;
#pragma unroll
    for (int i = 0; i < NPL; ++i) {
        const bool eq = bits[i] == T;
        const unsigned long long meq = __ballot(eq);
        const int eqrank = __popcll(meq & lt);
        const bool sel = bits[i] > T || (eq && eqrank < need_eq);
        const unsigned long long ms = __ballot(sel);
        const int t = tb + lane + 64 * i;
        if (sel) { const int slot = sbase + run + __popcll(ms & lt); idx[e * SLOTS + slot] = t; gsel[e * SLOTS + slot] = __builtin_bit_cast(float, bits[i]); tokslot[(size_t)t * 16 + e] = slot; }
        else tokslot[(size_t)t * 16 + e] = -1;
        run += __popcll(ms);
        const int neq = __popcll(meq); need_eq -= neq < need_eq ? neq : need_eq;
    }
}
DEV void phase_topk(const Params& p, char* smem) {
    (void)smem;
    const int tid = get_tid(), lane = tid & 63;
    constexpr int US = DEC_BATCH * NEXP, UP = BATCH * NEXP;
    const int gw = blockIdx.x + gridDim.x * (tid >> 6), nw = gridDim.x * 8;
    for (int u = gw; u < US + UP; u += nw) {
        if (u < US) { const int b = u / NEXP, e = u % NEXP; topk_wave<DEC_SEQ / 64>(p, NP + b * DEC_SEQ, CAP_S, BATCH * CAP_P + b * CAP_S, e, lane); }
        else { const int uu = u - US; const int b = uu / NEXP, e = uu % NEXP; topk_wave<SEQ / 64>(p, b * SEQ, CAP_P, b * CAP_P, e, lane); }
    }
}

DEV void store_head_f32(float* dst_f32, const f16v& v0, const f16v& v1, int h) {
#pragma unroll
    for (int ft = 0; ft < 2; ++ft) {
        const f16v& v = ft ? v1 : v0;
#pragma unroll
        for (int g = 0; g < 4; ++g) { f4v o; o[0] = v[4 * g]; o[1] = v[4 * g + 1]; o[2] = v[4 * g + 2]; o[3] = v[4 * g + 3]; *(f4v*)(dst_f32 + ft * 32 + 8 * g + 4 * h) = o; }
    }
}
template <int VAR>
DEV void phase_inproj(const Params& p, char* smem, int l) {
    constexpr int NJ = 22, NU = (NT / 256) * NJ;
    const int tid = get_tid(), lane = tid & 63, wave = tid >> 6, wm = wave & 3, wn = wave >> 2, h = lane >> 5, l31 = lane & 31;
    const bf16_t* hmod = (const bf16_t*)(p.ws + WS_HMOD);
    const float* rope = (const float*)(p.ws + WS_ROPE);
    constexpr int NMB = NT / 256, RPX = (NMB % 8 == 0) ? NMB / 8 : NMB;
    const UnitIter it = unit_iter(NU);
    for (int u = it.i; u < it.end; u += it.step) {
        const int mb = (u / (RPX * NJ)) * RPX + u % RPX, j = (u / RPX) % NJ;
        const int colbase = j < 17 ? 128 * j : 2192 + 128 * (j - 17);
        const unsigned ao = ((unsigned)(mb * 256 + (tid >> 3)) * D + (tid & 7) * 8) * 2;
        const unsigned bvo = (unsigned)(colbase + 4 * (tid & 31)) * 4 + (unsigned)(tid >> 5) * (PROJ_W * 4);
        const unsigned blds = (unsigned)(tid >> 5) * 320u + (unsigned)(tid & 31) * 8u;
        gemm_tile<2, VAR>(smem, make_rsrc(hmod), ao, ao + 128u * D, ao + 256u * D, ao + 384u * D, make_rsrc(p.in[I_WIN] + (size_t)l * D * PROJ_W), bvo, blds, PROJ_W * 4, D, [&](f16v (&acc)[2][2]) {
            int lane_e = lane; VGPR_PIN(lane_e); const int lane = lane_e, l31 = lane_e & 31, h = lane_e >> 5; (void)l31; (void)h;
            const int cb = colbase + wn * 64;
            char* stg = wave_stage_ptr(smem, wave);
            const int t0 = mb * 256 + wm * 64;
            const bool isP = t0 < NP;
            bf16_t* dstb; size_t dstride;
            int f32out = 0, fhead = 0, fheads = 0; size_t fbase = 0;
            int mode = 0;
            if (cb < 1152) {
                const int seg = cb / 384, head = (cb % 384) / 64;
                dstb = (bf16_t*)(p.ws + (seg == 0 ? WS_NAQ : seg == 1 ? WS_NAK : WS_NAV)) + (size_t)t0 * 384 + head * 64; dstride = 384;
                if (seg >= 1 && isP) { f32out = 1; fbase = seg == 1 ? O_NAK : O_NAV; fhead = head; fheads = NAH; }
            } else if (cb < 2176) {
                const int seg = (cb - 1152) / 256, head = ((cb - 1152) % 256) / 64;
                dstb = (bf16_t*)(p.ws + (seg == 0 ? WS_MLQ : seg == 1 ? WS_MLK : seg == 2 ? WS_MLV : WS_MLO)) + (size_t)t0 * 256 + head * 64; dstride = 256;
                mode = seg == 1 ? 1 : 0;
            } else {
                const int c2 = cb - 2192;
                if (c2 < 384) { dstb = (bf16_t*)(p.ws + WS_GQQ) + (size_t)t0 * 384 + (c2 / 64) * 64; dstride = 384; mode = 2; }
                else if (c2 < 512) { const int head = (c2 - 384) / 64; dstb = (bf16_t*)(p.ws + WS_GQK) + (size_t)t0 * 128 + head * 64; dstride = 128; mode = 3;
                                     if (isP) { f32out = 1; fbase = O_GQK; fhead = head; fheads = GQKV; } }
                else { const int head = (c2 - 512) / 64; dstb = (bf16_t*)(p.ws + WS_GQV) + (size_t)t0 * 128 + head * 64; dstride = 128;
                       if (isP) { f32out = 1; fbase = O_GQV; fhead = head; fheads = GQKV; } }
            }
#pragma unroll
            for (int tt = 0; tt < 2; ++tt) {
                const int t = t0 + tt * 32 + l31;
                f16v v0 = acc[0][tt], v1 = acc[1][tt];
                if (mode == 1) { v0 *= ATT_SCALE; v1 *= ATT_SCALE; }
                if (mode >= 2) {
                    float ss = 0.f;
#pragma unroll
                    for (int r = 0; r < 16; ++r) ss += v0[r] * v0[r] + v1[r] * v1[r];
                    ss += __shfl_xor(ss, 32);
                    const float rn = 1.f / sqrtf(ss * (1.f / 64.f) + EPS);
                    const float* gq = p.in[I_QKG] + ((size_t)l * 2 + (mode == 2 ? 0 : 1)) * 64;
#pragma unroll
                    for (int r = 0; r < 16; ++r) {
                        const int d = (r & 3) + 8 * (r >> 2) + 4 * h;
                        v0[r] *= rn * gq[d]; v1[r] *= rn * gq[32 + d];
                    }
                }
                if (f32out) { const int bP = t / SEQ, sP = t % SEQ; store_head_f32(p.out + fbase + ((((size_t)bP * DEPTH + l) * SEQ + sP) * fheads + fhead) * 64, v0, v1, h); }
                if (mode >= 2 && !isP) {
                    const int pos = (t - NP) % DEC_SEQ, prow = pos / GRIDW, pcol = pos % GRIDW;
#pragma unroll
                    for (int rr = 0; rr < 8; ++rr) {
                        const int fi = (rr & 3) + 8 * ((rr >> 2) & 1) + 4 * h;
                        const float c0 = rope[(prow * 16 + fi) * 2], s0 = rope[(prow * 16 + fi) * 2 + 1];
                        const float c1 = rope[(pcol * 16 + fi) * 2], s1 = rope[(pcol * 16 + fi) * 2 + 1];
                        const float a_lo = v0[rr], a_hi = v0[rr + 8]; v0[rr] = a_lo * c0 - a_hi * s0; v0[rr + 8] = a_hi * c0 + a_lo * s0;
                        const float b_lo = v1[rr], b_hi = v1[rr + 8]; v1[rr] = b_lo * c1 - b_hi * s1; v1[rr + 8] = b_hi * c1 + b_lo * s1;
                    }
                }
                stage64_write_bf16(stg, tt, v0, v1, l31, h);
            }
            stage64_flush_bf16(stg, dstb, dstride, lane);
        });
    }
}

template <int VAR>
DEV void phase_outproj(const Params& p, char* smem, int l) {
    constexpr int NC = D / 128, NU = (NT / 256) * NC;
    const int tid = get_tid(), lane = tid & 63, wave = tid >> 6, wm = wave & 3, wn = wave >> 2, h = lane >> 5, l31 = lane & 31;
    const bf16_t* mixed = (const bf16_t*)(p.ws + WS_MIXED);
    const float* mods = (const float*)(p.ws + WS_MODS);
    float* U = (float*)(p.ws + WS_U);
    constexpr int NMB = NT / 256, RPX = (NMB % 8 == 0) ? NMB / 8 : NMB;
    const UnitIter it = unit_iter(NU);
    for (int u = it.i; u < it.end; u += it.step) {
        const int mb = (u / (RPX * NC)) * RPX + u % RPX, cbk = (u / RPX) % NC;
        const unsigned ao = ((unsigned)(mb * 256 + (tid >> 3)) * MIXW + (tid & 7) * 8) * 2;
        const unsigned bvo = (unsigned)(cbk * 128 + 4 * (tid & 31)) * 4 + (unsigned)(tid >> 5) * (D * 4);
        const unsigned blds = (unsigned)(tid >> 5) * 320u + (unsigned)(tid & 31) * 8u;
        gemm_tile<2, VAR>(smem, make_rsrc(mixed), ao, ao + 128u * MIXW, ao + 256u * MIXW, ao + 384u * MIXW, make_rsrc(p.in[I_WOUT] + (size_t)l * MIXW * D), bvo, blds, D * 4, MIXW, [&](f16v (&acc)[2][2]) {
            int lane_e = lane; VGPR_PIN(lane_e); const int lane = lane_e, l31 = lane_e & 31, h = lane_e >> 5; (void)l31; (void)h;
            char* stg = wave_stage_ptr(smem, wave);
            const int t0 = mb * 256 + wm * 64;
            const float* g1 = mods + ((size_t)l * NCOND + tok_cond(t0)) * 6 * D + 2 * D;
#pragma unroll
            for (int ft = 0; ft < 2; ++ft) {
#pragma unroll
                for (int tt = 0; tt < 2; ++tt)
#pragma unroll
                    for (int g = 0; g < 4; ++g) { f4v o; o[0] = acc[ft][tt][4 * g]; o[1] = acc[ft][tt][4 * g + 1]; o[2] = acc[ft][tt][4 * g + 2]; o[3] = acc[ft][tt][4 * g + 3];
                        *(f4v*)(stg + (tt * 32 + l31) * LROW + (8 * g + 4 * h) * 4) = o; }
                WAVE_SYNC();
                const int f0 = cbk * 128 + wn * 64 + ft * 32 + (lane & 7) * 4;
                const f4v gv = *(const f4v*)(g1 + f0);
#pragma unroll
                for (int i = 0; i < 8; ++i) {
                    const int r = (lane >> 3) + 8 * i, t = t0 + r;
                    const f4v a = *(const f4v*)(stg + r * LROW + (lane & 7) * 16);
                    const float* xr = (l == 0) ? (t < NP ? p.in[I_XP] + (size_t)t * D : p.in[I_XS] + (size_t)(t - NP) * D) : (const float*)(p.ws + WS_XBUF) + (size_t)t * D;
                    const f4v xv = *(const f4v*)(xr + f0);
                    f4v o;
#pragma unroll
                    for (int q = 0; q < 4; ++q) o[q] = ALPHA * xv[q] + gv[q] * a[q];
                    *(f4v*)(U + (size_t)t * D + f0) = o;
                }
                WAVE_SYNC();
            }
        });
    }
}

template <int VAR>
DEV void phase_gateup(const Params& p, char* smem, int l) {
    constexpr int NRB = SLOTS / 256, NCB = EH / 128, NU = NEXP * NCB * NRB;
    const int tid = get_tid(), lane = tid & 63, wave = tid >> 6, wm = wave & 3, wn = wave >> 2, h = lane >> 5, l31 = lane & 31;
    const bf16_t* h2 = (const bf16_t*)(p.ws + WS_H2);
    const int* idx = (const int*)(p.ws + WS_IDX);
    bf16_t* hid = (bf16_t*)(p.ws + WS_HID);
    const UnitIter it = unit_iter(NU);
    for (int u = it.i; u < it.end; u += it.step) {
        const int rb = u % NRB, cbk = (u / NRB) % NCB, e = u / (NRB * NCB);
        const int* ip = idx + e * SLOTS + rb * 256 + (tid >> 3);
        const unsigned a0 = ((unsigned)ip[0] * D + (tid & 7) * 8) * 2, a1 = ((unsigned)ip[64] * D + (tid & 7) * 8) * 2;
        const unsigned a2 = ((unsigned)ip[128] * D + (tid & 7) * 8) * 2, a3 = ((unsigned)ip[192] * D + (tid & 7) * 8) * 2;
#ifdef EMU
        const int bw = tid >> 6;
#else
        const int bw = __builtin_amdgcn_readfirstlane(tid >> 6);
#endif
        const int is_up = bw & 1, bkr = 2 * (bw >> 1) + ((tid >> 5) & 1), hc = 4 * (tid & 31);
        const int ncol = (hc >> 6) * 128 + (2 * ((hc >> 5) & 1) + is_up) * 32 + (hc & 31);
        const unsigned bvo = (unsigned)(cbk * 128 + hc) * 4 + (unsigned)bkr * (EH * 4);
        const unsigned blds = (unsigned)bkr * 576u + (unsigned)ncol * 2u;
        const float* wmat = (is_up ? p.in[I_WU] : p.in[I_WG]) + ((size_t)l * NEXP + e) * D * EH;
        gemm_tile<4, VAR>(smem, make_rsrc(h2), a0, a1, a2, a3, make_rsrc(wmat), bvo, blds, EH * 4, D, [&](f16v (&acc)[4][2]) {
            int lane_e = lane; VGPR_PIN(lane_e); const int lane = lane_e, l31 = lane_e & 31, h = lane_e >> 5; (void)l31; (void)h;
            char* stg = wave_stage_ptr(smem, wave);
#pragma unroll
            for (int tt = 0; tt < 2; ++tt)
#pragma unroll
                for (int pr = 0; pr < 2; ++pr)
#pragma unroll
                    for (int g = 0; g < 4; ++g) {
                        float o[4];
#pragma unroll
                        for (int q = 0; q < 4; ++q) o[q] = siluf_(acc[2 * pr][tt][4 * g + q]) * acc[2 * pr + 1][tt][4 * g + q];
                        stage64_write4(stg, tt * 32 + l31, pr * 32 + 8 * g + 4 * h, o[0], o[1], o[2], o[3]);
                    }
            stage64_flush_bf16(stg, hid + ((size_t)e * SLOTS + rb * 256 + wm * 64) * EH + cbk * 128 + wn * 64, EH, lane);
        });
    }
}

template <int VAR>
DEV void phase_down(const Params& p, char* smem, int l) {
    constexpr int NRB = SLOTS / 256, NCB = D / 256, NU = NEXP * NCB * NRB;
    const int tid = get_tid(), lane = tid & 63, wave = tid >> 6, wm = wave & 3, wn = wave >> 2, h = lane >> 5, l31 = lane & 31;
    const bf16_t* hid = (const bf16_t*)(p.ws + WS_HID);
    const float* gsel = (const float*)(p.ws + WS_GSEL);
    bf16_t* ye = (bf16_t*)(p.ws + WS_YE);
    const UnitIter it = unit_iter(NU);
    for (int u = it.i; u < it.end; u += it.step) {
        const int rb = u % NRB, cbk = (u / NRB) % NCB, e = u / (NRB * NCB);
        const unsigned ao = ((unsigned)(rb * 256 + (tid >> 3)) * EH + (tid & 7) * 8) * 2;
        const unsigned bvo = (unsigned)(cbk * 256 + 4 * (tid & 63)) * 4 + (unsigned)(tid >> 6) * (D * 4);
        const unsigned blds = (unsigned)(tid >> 6) * 576u + (unsigned)(tid & 63) * 8u;
        gemm_tile<4, VAR>(smem, make_rsrc(hid + (size_t)e * SLOTS * EH), ao, ao + 128u * EH, ao + 256u * EH, ao + 384u * EH, make_rsrc(p.in[I_WD] + ((size_t)l * NEXP + e) * EH * D), bvo, blds, D * 4, EH, [&](f16v (&acc)[4][2]) {
            int lane_e = lane; VGPR_PIN(lane_e); const int lane = lane_e, l31 = lane_e & 31, h = lane_e >> 5; (void)l31; (void)h;
            char* stg = wave_stage_ptr(smem, wave);
            const float gs0 = gsel[e * SLOTS + rb * 256 + wm * 64 + l31], gs1 = gsel[e * SLOTS + rb * 256 + wm * 64 + 32 + l31];
#pragma unroll
            for (int hb = 0; hb < 2; ++hb) {
#pragma unroll
                for (int tt = 0; tt < 2; ++tt) {
                    const float gs = tt ? gs1 : gs0;
#pragma unroll
                    for (int f2 = 0; f2 < 2; ++f2)
#pragma unroll
                        for (int g = 0; g < 4; ++g) { const f16v& a = acc[2 * hb + f2][tt]; stage64_write4(stg, tt * 32 + l31, f2 * 32 + 8 * g + 4 * h, a[4 * g] * gs, a[4 * g + 1] * gs, a[4 * g + 2] * gs, a[4 * g + 3] * gs); }
                }
                stage64_flush_bf16(stg, ye + ((size_t)e * SLOTS + rb * 256 + wm * 64) * D + cbk * 256 + wn * 128 + hb * 64, D, lane);
            }
        });
    }
}

struct AttnDesc {
    const bf16_t* q; int qstride;
    int ntiles, n0;
    const bf16_t *k0, *v0; int stride0;
    const bf16_t *k1, *v1; int stride1;
    int na;
    int r0, rlo;
    const float* rpb;
    bf16_t* out; int ostride;
    float* part;
};
constexpr int ATT_TILE = 64 * LROW;
DEV int na_row_start(int r) { int s = r - KR / 2; s = s < 0 ? 0 : s; return s > ROWS - KR ? ROWS - KR : s; }
DEV void attn_unit(char* smem, const AttnDesc& d) {
    const int tid = get_tid(), lane = tid & 63, wave = tid >> 6, h = lane >> 5, l31 = lane & 31;
    char* Ks = smem; char* Vs = smem + 2 * ATT_TILE; float* rpbS = (float*)(smem + 4 * ATT_TILE);
    if (d.na) { for (int i = tid; i < 15 * 31; i += 512) rpbS[i] = d.rpb[i]; }
    const bf16_t* qp = d.q + (size_t)(wave * 32 + l31) * d.qstride + h * 8;
    s8v qf[4];
#pragma unroll
    for (int s = 0; s < 4; ++s) qf[s] = *(const s8v*)(qp + 16 * s);
    float m_run = -1e30f, l_run = 0.f;
    f16v o[2]; o[0] = f16zero(); o[1] = f16zero();
    const int srow = tid >> 3, sch = tid & 7;
    u4v kreg, vreg;
    auto gload = [&](int t) {
        const bf16_t *kp, *vp;
        if (t < d.n0) { const size_t off = (size_t)(t * 64 + srow) * d.stride0 + sch * 8; kp = d.k0 + off; vp = d.v0 + off; }
        else { const size_t off = (size_t)((t - d.n0) * 64 + srow) * d.stride1 + sch * 8; kp = d.k1 + off; vp = d.v1 + off; }
        kreg = *(const u4v*)kp; vreg = *(const u4v*)vp;
    };
    auto lstore = [&](int buf) { *(u4v*)(Ks + buf * ATT_TILE + srow * LROW + sch * 16) = kreg; *(u4v*)(Vs + buf * ATT_TILE + srow * LROW + sch * 16) = vreg; };
    const int qr = d.r0 + (wave >> 1), qw = (wave & 1) * 32 + l31;
    const int rs = na_row_start(qr);
    int cs = qw - KC / 2; cs = cs < 0 ? 0 : (cs > GRIDW - KC ? GRIDW - KC : cs);
    gload(0); lstore(0);
    __syncthreads();
    for (int t = 0; t < d.ntiles; ++t) {
        const int buf = t & 1;
        if (t + 1 < d.ntiles) gload(t + 1);
        const bool local = d.na && t >= d.n0;
        const int kr = d.rlo + (t - d.n0);
        const bool active = !local || (kr >= rs && kr < rs + KR);
        if (active) {
            const char* kb = Ks + buf * ATT_TILE + l31 * LROW + h * 16;
            f16v sa[2];
#pragma unroll
            for (int kt = 0; kt < 2; ++kt) {
                sa[kt] = f16zero();
#pragma unroll
                for (int s = 0; s < 4; ++s) { const s8v kf = *(const s8v*)(kb + kt * 32 * LROW + s * 32); sa[kt] = mfma32(kf, qf[s], sa[kt]); }
            }
            float mx = -1e30f;
#pragma unroll
            for (int kt = 0; kt < 2; ++kt)
#pragma unroll
                for (int r = 0; r < 16; ++r) {
                    float v = sa[kt][r] * ATT_SCALE;
                    if (local) {
                        const int kc = kt * 32 + (r & 3) + 8 * (r >> 2) + 4 * h;
                        const bool inw = kc >= cs && kc < cs + KC;
                        const int bi = (kr - qr + 7) * 31 + (kc - qw + 15);
                        v = inw ? v + rpbS[inw ? bi : 0] : -1e30f;
                    }
                    sa[kt][r] = v; mx = fmaxf(mx, v);
                }
            mx = fmaxf(mx, __shfl_xor(mx, 32));
            const float m_new = fmaxf(m_run, mx);
            const float alpha = fexp(m_run - m_new);
            float ps = 0.f;
#pragma unroll
            for (int kt = 0; kt < 2; ++kt)
#pragma unroll
                for (int r = 0; r < 16; ++r) { const float pv = fexp(sa[kt][r] - m_new); sa[kt][r] = pv; ps += pv; }
            l_run = l_run * alpha + ps; m_run = m_new;
            o[0] *= alpha; o[1] *= alpha;
            const char* vb = Vs + buf * ATT_TILE + (4 * h + ((lane & 15) >> 2)) * LROW + (((lane >> 4) & 1) * 16 + 4 * (lane & 3)) * 2;
#pragma unroll
            for (int ks = 0; ks < 4; ++ks) {
                const int kt = ks >> 1, rb = 8 * (ks & 1);
                u4v pk; pk[0] = pack2(sa[kt][rb], sa[kt][rb + 1]); pk[1] = pack2(sa[kt][rb + 2], sa[kt][rb + 3]);
                pk[2] = pack2(sa[kt][rb + 4], sa[kt][rb + 5]); pk[3] = pack2(sa[kt][rb + 6], sa[kt][rb + 7]);
                const s8v pf = __builtin_bit_cast(s8v, pk);
                const char* vk = vb + (kt * 32 + 16 * (ks & 1)) * LROW;
#pragma unroll
                for (int dt = 0; dt < 2; ++dt) {
                    const s4v lo = lds_tr16(vk + dt * 64), hi = lds_tr16(vk + 8 * LROW + dt * 64);
                    s8v vf; vf[0] = lo[0]; vf[1] = lo[1]; vf[2] = lo[2]; vf[3] = lo[3]; vf[4] = hi[0]; vf[5] = hi[1]; vf[6] = hi[2]; vf[7] = hi[3];
                    o[dt] = mfma32(vf, pf, o[dt]);
                }
            }
        }
        if (t + 1 < d.ntiles) lstore(buf ^ 1);
        __syncthreads();
    }
    const float l_tot = l_run + __shfl_xor(l_run, 32);
    const int qrow = wave * 32 + l31;
    if (d.part) {
        float* po = d.part + (size_t)qrow * 64;
#pragma unroll
        for (int dt = 0; dt < 2; ++dt)
#pragma unroll
            for (int g = 0; g < 4; ++g) { f4v v; v[0] = o[dt][4 * g]; v[1] = o[dt][4 * g + 1]; v[2] = o[dt][4 * g + 2]; v[3] = o[dt][4 * g + 3]; *(f4v*)(po + dt * 32 + 8 * g + 4 * h) = v; }
        if (h == 0) { d.part[256 * 64 + qrow] = m_run; d.part[256 * 64 + 256 + qrow] = l_tot; }
    } else {
        const float inv = 1.f / l_tot;
        bf16_t* po = d.out + (size_t)qrow * d.ostride;
#pragma unroll
        for (int dt = 0; dt < 2; ++dt)
#pragma unroll
            for (int g = 0; g < 4; ++g) {
                u2v pk; pk[0] = pack2(o[dt][4 * g] * inv, o[dt][4 * g + 1] * inv); pk[1] = pack2(o[dt][4 * g + 2] * inv, o[dt][4 * g + 3] * inv);
                *(u2v*)(po + dt * 32 + 8 * g + 4 * h) = pk;
            }
    }
}

DEV int ml_sidx(int grp, int b, int head, int c) { return grp == 0 ? ((b * MLH + head) * NCH_P + c) : BATCH * MLH * NCH_P + ((b * MLH + head) * NCH_S + c); }
DEV float lane_prefix_sum(float v, int lane) { for (int dlt = 1; dlt < 64; dlt <<= 1) { const float o = __shfl(v, lane - dlt); if (lane >= dlt) v += o; } return v; }
DEV float lane_prefix_max(float v, int lane) { for (int dlt = 1; dlt < 64; dlt <<= 1) { const float o = __shfl(v, lane - dlt); if (lane >= dlt) v = fmaxf(v, o); } return v; }

DEV void mlstm_summary_unit(const Params& p, char* smem, int grp, int b, int head, int c) {
    const int tid = get_tid(), lane = tid & 63, wave = tid >> 6, h = lane >> 5, l31 = lane & 31;
    char* KT = smem;
    char* VT = smem + 2 * ATT_TILE;
    float* wsS = (float*)(smem + 3 * ATT_TILE);
    float* scal = wsS + 128;
    const int tb = (grp == 0 ? b * SEQ : NP + b * DEC_SEQ) + c * 64;
    const float* gates = (const float*)(p.ws + WS_GATES);
    if (wave == 0) {
        const float* gr = gates + (size_t)(tb + lane) * 16;
        const float i_f = gr[head], lf_f = logsigmoidf_(gr[4 + head]), i_b = gr[8 + head], lf_b = logsigmoidf_(gr[12 + head]);
        const float pf = lane_prefix_sum(lf_f, lane), pb = lane_prefix_sum(lf_b, lane);
        const float tot_f = __shfl(pf, 63), tot_b = __shfl(pb, 63);
        const float g_f = (tot_f - pf) + i_f, g_b = (pb - lf_b) + i_b;
        const float G_f = wave_max(g_f), G_b = wave_max(g_b);
        wsS[lane] = expf(g_f - G_f); wsS[64 + lane] = expf(g_b - G_b);
        if (lane == 0) { scal[0] = tot_f; scal[1] = tot_b; scal[2] = G_f; scal[3] = G_b; }
    }
    __syncthreads();
    {
        const int tau = tid >> 3, ch = tid & 7;
        const u4v kv = *(const u4v*)((const bf16_t*)(p.ws + WS_MLK) + (size_t)(tb + tau) * 256 + head * 64 + ch * 8);
        const u4v vv = *(const u4v*)((const bf16_t*)(p.ws + WS_MLV) + (size_t)(tb + tau) * 256 + head * 64 + ch * 8);
        const float wf = wsS[tau], wb = wsS[64 + tau];
#pragma unroll
        for (int j = 0; j < 8; ++j) {
            const bf16_t kb = (bf16_t)(kv[j >> 1] >> (16 * (j & 1))), vb = (bf16_t)(vv[j >> 1] >> (16 * (j & 1)));
            const int dim = ch * 8 + j; const float kf = bf2f(kb);
            *(bf16_t*)(KT + dim * LROW + tau * 2) = f2bf(kf * wf);
            *(bf16_t*)(KT + ATT_TILE + dim * LROW + tau * 2) = f2bf(kf * wb);
            *(bf16_t*)(VT + dim * LROW + tau * 2) = vb;
        }
    }
    __syncthreads();
    float* sum = (float*)(p.ws + WS_MLSUM);
    const int sidx = ml_sidx(grp, b, head, c);
    {
        const int dir = wave >> 2, mi = (wave >> 1) & 1, ni = wave & 1;
        f16v acc = f16zero();
#pragma unroll
        for (int s = 0; s < 4; ++s) {
            const s8v af = *(const s8v*)(KT + dir * ATT_TILE + (mi * 32 + l31) * LROW + (16 * s + 8 * h) * 2);
            const s8v bf = *(const s8v*)(VT + (ni * 32 + l31) * LROW + (16 * s + 8 * h) * 2);
            acc = mfma32(af, bf, acc);
        }
        float* U = sum + (size_t)(sidx * 2 + dir) * MLSUM_STRIDE;
#pragma unroll
        for (int r = 0; r < 16; ++r) U[(mi * 32 + (r & 3) + 8 * (r >> 2) + 4 * h) * 64 + ni * 32 + l31] = acc[r];
    }
    if (tid < 128) {
        const int dir = tid >> 6, kd = tid & 63;
        float s = 0.f;
        for (int tau = 0; tau < 64; ++tau) s += bf2f(*(const bf16_t*)(KT + dir * ATT_TILE + kd * LROW + tau * 2));
        float* E = sum + (size_t)(sidx * 2 + dir) * MLSUM_STRIDE;
        E[4096 + kd] = s;
        if (kd == 0) { E[4160] = scal[dir]; E[4161] = scal[2 + dir]; }
    }
    __syncthreads();
}

DEV void mlstm_output_unit(const Params& p, char* smem, int l, int grp, int b, int head, int c) {
    const int tid = get_tid(), lane = tid & 63, wave = tid >> 6, h = lane >> 5, l31 = lane & 31;
    const int nc = grp ? NCH_S : NCH_P;
    char* Qs = smem;
    char* Ks = smem + 2 * ATT_TILE;
    char* VT = smem + 4 * ATT_TILE;
    char* CT = smem + 6 * ATT_TILE;
    char* QK = smem + 8 * ATT_TILE;
    float* hS = (float*)(smem + 10 * ATT_TILE);
    float* vec = hS + 2 * 64 * 68;
    float* aS = vec; float* MjS = vec + 128; float* bS = vec + 256; float* nS = vec + 384; float* denp = vec + 512; float* qnS = vec + 768; float* scal = vec + 896;
    const int tb = (grp == 0 ? b * SEQ : NP + b * DEC_SEQ) + c * 64;
    const float* sum = (const float*)(p.ws + WS_MLSUM);
#pragma unroll
    for (int dir = 0; dir < 2; ++dir) {
        float C[8], nst = 0.f, m;
        if (grp == 0) {
#pragma unroll
            for (int i = 0; i < 8; ++i) C[i] = 0.f;
            m = 0.f;
        } else {
            const size_t sb = (((size_t)b * DEPTH + l) * 2 + dir) * MLH + head;
#pragma unroll
            for (int i = 0; i < 8; ++i) C[i] = p.in[I_SC][sb * 4096 + tid + 512 * i];
            if (tid < 64) nst = p.in[I_SN][sb * 64 + tid];
            m = p.in[I_SM][sb];
        }
        const int nsteps = dir == 0 ? c : nc - 1 - c;
        const bool fin = (grp == 0) && (dir == 0 ? c == nc - 1 : c == 0);
        {
            float A = 0.f, G = -1e30f;
            if (lane < nsteps) { const float* E = sum + (size_t)(ml_sidx(grp, b, head, dir == 0 ? lane : nc - 1 - lane) * 2 + dir) * MLSUM_STRIDE; A = E[4160]; G = E[4161]; }
            const float P = lane_prefix_sum(A, lane);
            const float T = __shfl(P, 63);
            const float ev = lane < nsteps ? G + (T - P) : -1e30f;
            const float mc = fmaxf(m + T, wave_max(ev));
            const float coef = lane < nsteps ? expf(ev - mc) : 0.f;
            const float coef0 = expf(m + T - mc);
#pragma unroll
            for (int i = 0; i < 8; ++i) C[i] *= coef0;
            nst *= coef0;
#pragma unroll 4
            for (int st = 0; st < nsteps; ++st) {
                const float* E = sum + (size_t)(ml_sidx(grp, b, head, dir == 0 ? st : nc - 1 - st) * 2 + dir) * MLSUM_STRIDE;
                const float cf = __shfl(coef, st);
#pragma unroll
                for (int i = 0; i < 8; ++i) C[i] += cf * E[tid + 512 * i];
                if (tid < 64) nst += cf * E[4096 + tid];
            }
            m = mc;
        }
#pragma unroll
        for (int i = 0; i < 8; ++i) { const int e = tid + 512 * i; *(bf16_t*)(CT + dir * ATT_TILE + (e & 63) * LROW + (e >> 6) * 2) = f2bf(C[i]); }
        if (tid < 64) nS[dir * 64 + tid] = nst;
        if (tid == 0) scal[dir] = m;
        if (fin) {
            const float* E = sum + (size_t)(ml_sidx(grp, b, head, c) * 2 + dir) * MLSUM_STRIDE;
            const float A = E[4160], G = E[4161];
            const float m_new = fmaxf(A + m, G);
            const float sc = expf(A + m - m_new), su = expf(G - m_new);
            const size_t ob = (((size_t)b * DEPTH + l) * 2 + dir) * MLH + head;
#pragma unroll
            for (int i = 0; i < 8; ++i) p.out[O_MC + ob * 4096 + tid + 512 * i] = sc * C[i] + su * E[tid + 512 * i];
            if (tid < 64) p.out[O_MN + ob * 64 + tid] = sc * nst + su * E[4096 + tid];
            if (tid == 0) p.out[O_MM + ob] = m_new;
        }
    }
    {
        const int row = tid >> 3, ch = tid & 7;
#pragma unroll
        for (int dir = 0; dir < 2; ++dir) {
            const int tok = tb + (dir ? 63 - row : row);
            const size_t off = (size_t)tok * 256 + head * 64 + ch * 8;
            *(u4v*)(Qs + dir * ATT_TILE + row * LROW + ch * 16) = *(const u4v*)((const bf16_t*)(p.ws + WS_MLQ) + off);
            *(u4v*)(Ks + dir * ATT_TILE + row * LROW + ch * 16) = *(const u4v*)((const bf16_t*)(p.ws + WS_MLK) + off);
            const u4v vv = *(const u4v*)((const bf16_t*)(p.ws + WS_MLV) + off);
#pragma unroll
            for (int j = 0; j < 8; ++j) *(bf16_t*)(VT + dir * ATT_TILE + (ch * 8 + j) * LROW + row * 2) = (bf16_t)(vv[j >> 1] >> (16 * (j & 1)));
        }
    }
    __syncthreads();
    if (wave < 2) {
        const int dir = wave;
        const float* gr = (const float*)(p.ws + WS_GATES) + (size_t)(tb + (dir ? 63 - lane : lane)) * 16;
        const float ig = gr[dir * 8 + head], lf = logsigmoidf_(gr[dir * 8 + 4 + head]);
        const float bj = lane_prefix_sum(lf, lane);
        const float a = ig - bj;
        const float Pj = lane_prefix_max(a, lane);
        aS[dir * 64 + lane] = a; bS[dir * 64 + lane] = bj; MjS[dir * 64 + lane] = fmaxf(scal[dir], Pj);
    } else if (wave < 4) {
        const int dir = wave - 2;
        float s = 0.f;
        for (int k = 0; k < 64; ++k) s += bf2f(*(const bf16_t*)(Qs + dir * ATT_TILE + lane * LROW + k * 2)) * nS[dir * 64 + k];
        qnS[dir * 64 + lane] = s;
    }
    __syncthreads();
    const int dir = wave >> 2, rt = (wave >> 1) & 1, jt = wave & 1;
    const int j = jt * 32 + l31;
    const float Mj = MjS[dir * 64 + j];
    {
        f16v acc = f16zero();
#pragma unroll
        for (int s4 = 0; s4 < 4; ++s4) {
            const s8v af = *(const s8v*)(Ks + dir * ATT_TILE + (rt * 32 + l31) * LROW + (16 * s4 + 8 * h) * 2);
            const s8v bf = *(const s8v*)(Qs + dir * ATT_TILE + j * LROW + (16 * s4 + 8 * h) * 2);
            acc = mfma32(af, bf, acc);
        }
        float dsum = 0.f;
#pragma unroll
        for (int g = 0; g < 4; ++g) {
            float o[4];
#pragma unroll
            for (int q = 0; q < 4; ++q) {
                const int s = rt * 32 + 8 * g + 4 * h + q;
                const float w = s <= j ? expf(aS[dir * 64 + s] - Mj) : 0.f;
                o[q] = acc[4 * g + q] * w; dsum += o[q];
            }
            u2v pk; pk[0] = pack2(o[0], o[1]); pk[1] = pack2(o[2], o[3]);
            *(u2v*)(QK + dir * ATT_TILE + j * LROW + (rt * 32 + 8 * g + 4 * h) * 2) = pk;
        }
        dsum += __shfl_xor(dsum, 32);
        if (h == 0) denp[(dir * 2 + rt) * 64 + j] = dsum;
    }
    __syncthreads();
    {
        const float mst = scal[dir];
        const float decay = expf(mst - Mj);
        f16v acc = f16zero();
#pragma unroll
        for (int s4 = 0; s4 < 4; ++s4) {
            const s8v af = *(const s8v*)(CT + dir * ATT_TILE + (rt * 32 + l31) * LROW + (16 * s4 + 8 * h) * 2);
            const s8v bf = *(const s8v*)(Qs + dir * ATT_TILE + j * LROW + (16 * s4 + 8 * h) * 2);
            acc = mfma32(af, bf, acc);
        }
        acc *= decay;
#pragma unroll
        for (int s4 = 0; s4 < 4; ++s4) {
            const s8v af = *(const s8v*)(VT + dir * ATT_TILE + (rt * 32 + l31) * LROW + (16 * s4 + 8 * h) * 2);
            const s8v bf = *(const s8v*)(QK + dir * ATT_TILE + j * LROW + (16 * s4 + 8 * h) * 2);
            acc = mfma32(af, bf, acc);
        }
        const float den = decay * qnS[dir * 64 + j] + denp[(dir * 2) * 64 + j] + denp[(dir * 2 + 1) * 64 + j];
        const float dn = fmaxf(fabsf(den), expf(-(bS[dir * 64 + j] + Mj)));
        const float inv = 1.f / dn;
#pragma unroll
        for (int g = 0; g < 4; ++g) { f4v o; o[0] = acc[4 * g] * inv; o[1] = acc[4 * g + 1] * inv; o[2] = acc[4 * g + 2] * inv; o[3] = acc[4 * g + 3] * inv;
            *(f4v*)(hS + (dir * 64 + j) * 68 + rt * 32 + 8 * g + 4 * h) = o; }
    }
    __syncthreads();
    {
        const int tau = tid >> 3, v8 = (tid & 7) * 8;
        float hv[8]; float s = 0.f;
#pragma unroll
        for (int q = 0; q < 8; ++q) { hv[q] = hS[tau * 68 + v8 + q] + hS[(64 + 63 - tau) * 68 + v8 + q]; s += hv[q]; }
        s += __shfl_xor(s, 1); s += __shfl_xor(s, 2); s += __shfl_xor(s, 4);
        const float mu = s * (1.f / 64.f);
        float qq = 0.f;
#pragma unroll
        for (int q = 0; q < 8; ++q) { const float dlt = hv[q] - mu; qq += dlt * dlt; }
        qq += __shfl_xor(qq, 1); qq += __shfl_xor(qq, 2); qq += __shfl_xor(qq, 4);
        const float rstd = 1.f / sqrtf(qq * (1.f / 64.f) + EPS);
        const int t = tb + tau;
        const u4v ov = *(const u4v*)((const bf16_t*)(p.ws + WS_MLO) + (size_t)t * 256 + head * 64 + v8);
        const float* ng = p.in[I_MLG] + (size_t)l * 256 + head * 64 + v8;
        float o[8];
#pragma unroll
        for (int q = 0; q < 8; ++q) { const float og = bf2f((bf16_t)(ov[q >> 1] >> (16 * (q & 1)))); o[q] = (hv[q] - mu) * rstd * ng[q] * sigmoidf_(og); }
        u4v pk; pk[0] = pack2(o[0], o[1]); pk[1] = pack2(o[2], o[3]); pk[2] = pack2(o[4], o[5]); pk[3] = pack2(o[6], o[7]);
        *(u4v*)((bf16_t*)(p.ws + WS_MIXED) + (size_t)t * MIXW + 384 + head * 64 + v8) = pk;
    }
    __syncthreads();
}

DEV int queue_next(const Params& p, char* smem, int qi) {
    int* slot = (int*)(smem + SMEM_XB + 32);
    __syncthreads();
    if (threadIdx.x == 0) {
#ifdef EMU
        unsigned* w = (unsigned*)(p.ws + WS_BAR) + QUEUE_WORD0 + 64 * qi; *slot = (int)(*w)++;
#else
        *slot = (int)__hip_atomic_fetch_add((unsigned*)(p.ws + WS_BAR) + QUEUE_WORD0 + 64 * qi, 1u, __ATOMIC_RELAXED, __HIP_MEMORY_SCOPE_AGENT);
#endif
    }
    __syncthreads();
    return *slot;
}
DEV void phase_attn(const Params& p, char* smem, int l, int qi) {
    constexpr int QB_S = DEC_SEQ / 256, QB_P = SEQ / 256;
    constexpr int U_SG = DEC_BATCH * GQH * QB_S * 2, U_SN = DEC_BATCH * NAH * QB_S, U_PN = BATCH * NAH * QB_P, U_PG = BATCH * GQH * QB_P;
    constexpr int U_MP = BATCH * MLH * NCH_P, U_MS = DEC_BATCH * MLH * NCH_S;
    constexpr int NU = U_SG + U_SN + U_PN + U_PG + U_MP + U_MS;
    const bf16_t* naq = (const bf16_t*)(p.ws + WS_NAQ); const bf16_t* nak = (const bf16_t*)(p.ws + WS_NAK); const bf16_t* nav = (const bf16_t*)(p.ws + WS_NAV);
    const bf16_t* gqq = (const bf16_t*)(p.ws + WS_GQQ); const bf16_t* gqk = (const bf16_t*)(p.ws + WS_GQK); const bf16_t* gqv = (const bf16_t*)(p.ws + WS_GQV);
    bf16_t* mixed = (bf16_t*)(p.ws + WS_MIXED);
    for (;;) {
        int u = queue_next(p, smem, qi);
        if (u >= NU) break;
        AttnDesc d; d.na = 0; d.r0 = 0; d.rlo = 0; d.rpb = nullptr; d.part = nullptr; d.out = nullptr; d.ostride = MIXW; d.n0 = 0; d.k0 = d.v0 = nullptr; d.stride0 = 0;
        if (u < U_SG) {
            const int half = u & 1, qb = (u >> 1) % QB_S, qh = (u / (2 * QB_S)) % GQH, b = u / (2 * QB_S * GQH);
            const int kvh = qh / (GQH / GQKV);
            constexpr int NCT = PAST / 64, TT = NCT + DEC_SEQ / 64, H0 = TT / 2;
            const size_t tq = (size_t)NP + (size_t)b * DEC_SEQ + qb * 256;
            d.q = gqq + tq * 384 + qh * 64; d.qstride = 384;
            const bf16_t* lk = gqk + ((size_t)NP + (size_t)b * DEC_SEQ) * 128 + kvh * 64; const bf16_t* lv = gqv + ((size_t)NP + (size_t)b * DEC_SEQ) * 128 + kvh * 64;
            if (half == 0) {
                d.n0 = NCT; d.ntiles = H0; d.stride0 = 128;
                const size_t co = (((size_t)b * DEPTH + l) * PAST) * 128 + kvh * 64;
                d.k0 = (const bf16_t*)(p.ws + WS_CGQK) + co; d.v0 = (const bf16_t*)(p.ws + WS_CGQV) + co;
                d.k1 = lk; d.v1 = lv; d.stride1 = 128;
            } else {
                d.n0 = 0; d.ntiles = TT - H0; d.stride1 = 128;
                d.k1 = lk + (size_t)(H0 - NCT) * 64 * 128; d.v1 = lv + (size_t)(H0 - NCT) * 64 * 128;
            }
            d.part = (float*)(p.ws + WS_PART) + (size_t)u * PART_STRIDE;
        } else if (u < U_SG + U_SN) {
            const int uu = u - U_SG; const int qb = uu % QB_S, hd = (uu / QB_S) % NAH, b = uu / (QB_S * NAH);
            const size_t t0 = (size_t)NP + (size_t)b * DEC_SEQ;
            d.q = naq + (t0 + qb * 256) * 384 + hd * 64; d.qstride = 384;
            d.na = 1; d.r0 = qb * 4; d.rlo = na_row_start(d.r0);
            const int rhi = na_row_start(d.r0 + 3) + KR;
            d.n0 = PAST / 64; d.ntiles = d.n0 + (rhi - d.rlo); d.stride0 = 384; d.stride1 = 384;
            const size_t co = (((size_t)b * DEPTH + l) * PAST) * 384 + hd * 64;
            d.k0 = (const bf16_t*)(p.ws + WS_CNAK) + co; d.v0 = (const bf16_t*)(p.ws + WS_CNAV) + co;
            d.k1 = nak + (t0 + (size_t)d.rlo * 64) * 384 + hd * 64; d.v1 = nav + (t0 + (size_t)d.rlo * 64) * 384 + hd * 64;
            d.rpb = p.in[I_RPB] + ((size_t)l * NAH + hd) * 15 * 31;
            d.out = mixed + (t0 + qb * 256) * MIXW + hd * 64;
        } else if (u < U_SG + U_SN + U_PN) {
            const int uu = u - U_SG - U_SN; const int qb = uu % QB_P, hd = (uu / QB_P) % NAH, b = uu / (QB_P * NAH);
            const size_t t0 = (size_t)b * SEQ;
            d.q = naq + (t0 + qb * 256) * 384 + hd * 64; d.qstride = 384;
            d.n0 = 0; d.ntiles = SEQ / 64; d.stride1 = 384; d.k1 = nak + t0 * 384 + hd * 64; d.v1 = nav + t0 * 384 + hd * 64;
            d.out = mixed + (t0 + qb * 256) * MIXW + hd * 64;
        } else if (u < U_SG + U_SN + U_PN + U_PG) {
            const int uu = u - U_SG - U_SN - U_PN; const int qb = uu % QB_P, qh = (uu / QB_P) % GQH, b = uu / (QB_P * GQH);
            const int kvh = qh / (GQH / GQKV);
            const size_t t0 = (size_t)b * SEQ;
            d.q = gqq + (t0 + qb * 256) * 384 + qh * 64; d.qstride = 384;
            d.n0 = 0; d.ntiles = SEQ / 64; d.stride1 = 128; d.k1 = gqk + t0 * 128 + kvh * 64; d.v1 = gqv + t0 * 128 + kvh * 64;
            d.out = mixed + (t0 + qb * 256) * MIXW + 640 + qh * 64;
        } else {
            int uu = u - (U_SG + U_SN + U_PN + U_PG); const int grp = uu >= U_MP ? 1 : 0; if (grp) uu -= U_MP;
            const int nch = grp ? NCH_S : NCH_P;
            mlstm_summary_unit(p, smem, grp, uu / (nch * MLH), (uu / nch) % MLH, uu % nch);
        }
        if (u < U_SG + U_SN + U_PN + U_PG) attn_unit(smem, d);
    }
}

DEV void phase_mlout(const Params& p, char* smem, int l) {
    constexpr int QB_S = DEC_SEQ / 256;
    constexpr int U_MS = DEC_BATCH * MLH * NCH_S, U_MP = BATCH * MLH * NCH_P, U_CB = DEC_BATCH * GQH * QB_S;
    const int tid = get_tid();
    for (int u = blockIdx.x; u < U_MS + U_MP + U_CB; u += gridDim.x) {
        if (u < U_MS + U_MP) { const int grp = u < U_MS ? 1 : 0; const int uu = grp ? u : u - U_MS; const int nch = grp ? NCH_S : NCH_P;
            mlstm_output_unit(p, smem, l, grp, uu / (nch * MLH), (uu / nch) % MLH, uu % nch); }
        else {
            const int uu = u - U_MS - U_MP; const int qb = uu % QB_S, qh = (uu / QB_S) % GQH, b = uu / (QB_S * GQH);
            const float* p0 = (const float*)(p.ws + WS_PART) + (size_t)(2 * uu) * PART_STRIDE; const float* p1 = p0 + PART_STRIDE;
            const int q = tid >> 1, d0 = (tid & 1) * 32;
            const float m0 = p0[256 * 64 + q], m1 = p1[256 * 64 + q], l0 = p0[256 * 64 + 256 + q], l1 = p1[256 * 64 + 256 + q];
            const float m = fmaxf(m0, m1), w0 = expf(m0 - m), w1 = expf(m1 - m);
            const float inv = 1.f / (l0 * w0 + l1 * w1);
            bf16_t* dst = (bf16_t*)(p.ws + WS_MIXED) + ((size_t)NP + (size_t)b * DEC_SEQ + qb * 256 + q) * MIXW + 640 + qh * 64 + d0;
#pragma unroll
            for (int i = 0; i < 8; ++i) {
                const f4v a = *(const f4v*)(p0 + (size_t)q * 64 + d0 + 4 * i), bb = *(const f4v*)(p1 + (size_t)q * 64 + d0 + 4 * i);
                u2v pk; pk[0] = pack2((a[0] * w0 + bb[0] * w1) * inv, (a[1] * w0 + bb[1] * w1) * inv); pk[1] = pack2((a[2] * w0 + bb[2] * w1) * inv, (a[3] * w0 + bb[3] * w1) * inv);
                *(u2v*)(dst + 4 * i) = pk;
            }
        }
    }
}

constexpr int N_PHASES = 2 + 9 * DEPTH;
#ifndef EMU
typedef const __attribute__((address_space(4))) Params* KParamsPtr;
DEV void load_params(Params& p) {
    KParamsPtr kp = (KParamsPtr)__builtin_amdgcn_kernarg_segment_ptr();
    asm volatile("" : "+s"(kp));
#pragma unroll
    for (int i = 0; i < N_IN; ++i) p.in[i] = kp->in[i];
    p.out = kp->out; p.ws = kp->ws; p.ph0 = kp->ph0; p.ph1 = kp->ph1;
}
#endif
#ifdef EMU
static char emu_smem[SMEM_BYTES + 64];
#endif
__global__ void __launch_bounds__(512, 2) mega_kernel(Params p_) {
    const int ph0 = p_.ph0, ph1 = p_.ph1;
#ifdef EMU
    char* smem = emu_smem;
#define GRID_SYNC() do {} while (0)
#else
    extern __shared__ __attribute__((aligned(16))) char smem[];
    if (threadIdx.x == 0) *(u4v*)(smem + SMEM_XB) = (u4v){0u, 0u, 0u, 0u};
    __syncthreads();
    (void)xcd_barrier_post((unsigned*)(p_.ws + WS_BAR), (volatile LAS unsigned*)(smem + SMEM_XB));
    const bool multi = (ph1 - ph0) > 1;
#define GRID_SYNC() do { if (multi) { KParamsPtr kpb = (KParamsPtr)__builtin_amdgcn_kernarg_segment_ptr(); asm volatile("" : "+s"(kpb)); \
        XcdBarrier xb; xb.bar = (unsigned*)(kpb->ws + WS_BAR); xb.x = xb_xcc_id(); xb.st = (volatile LAS unsigned*)(smem + SMEM_XB); xcd_barrier(xb); } } while (0)
#endif
    int ph = 0;
#ifndef KIND_MASK
#define KIND_MASK 0x3ff
#endif
#ifdef EMU
#define LOAD_PARAMS() const Params& p = p_
#else
#define LOAD_PARAMS() Params p; load_params(p)
#endif
#ifndef DOUBLE_MASK
#define DOUBLE_MASK 0
#endif
#define PH_KIND() (ph == 0 ? 0 : ph == 1 + 9 * DEPTH ? 1 : 1 + (ph - 1) % 9)
#define RUN_PHASE(body) do { if (((KIND_MASK >> PH_KIND()) & 1) && ph >= ph0 && ph < ph1) { \
    if (DOUBLE_MASK && ((DOUBLE_MASK >> PH_KIND()) & 1)) { { const int rep_ = 1; LOAD_PARAMS(); body; } GRID_SYNC(); } \
    { const int rep_ = 0; LOAD_PARAMS(); body; } if (ph + 1 < ph1) GRID_SYNC(); } ++ph; } while (0)
    RUN_PHASE(phase_ada(p, smem));
    for (int l = 0; l < DEPTH; ++l) {
        RUN_PHASE(phase_rows<0>(p, smem, l));
        RUN_PHASE(phase_inproj<0>(p, smem, l));
        RUN_PHASE(phase_attn(p, smem, l, l + DEPTH * rep_));
        RUN_PHASE(phase_mlout(p, smem, l));
        RUN_PHASE(phase_outproj<0>(p, smem, l));
        RUN_PHASE(phase_rows<1>(p, smem, l));
        RUN_PHASE(phase_topk(p, smem));
        RUN_PHASE(phase_gateup<0>(p, smem, l));
        RUN_PHASE(phase_down<0>(p, smem, l));
    }
    RUN_PHASE(phase_rows<0>(p, smem, DEPTH));
}

#if !defined(EMU) && defined(PROBE_KIND)
__global__ void __launch_bounds__(512, 2) probe_kernel(Params p) {
    extern __shared__ __attribute__((aligned(16))) char smem[];
    for (int r = 0; r < PROBE_REPS; ++r) {
#if PROBE_KIND == 8
        phase_gateup<PROBE_VAR>(p, smem, 1);
#elif PROBE_KIND == 9
        phase_down<PROBE_VAR>(p, smem, 1);
#elif PROBE_KIND == 2
        phase_inproj<PROBE_VAR>(p, smem, 1);
#elif PROBE_KIND == 5
        phase_outproj<PROBE_VAR>(p, smem, 1);
#elif PROBE_KIND == 0
        phase_ada(p, smem);
#elif PROBE_KIND == 1
        phase_rows<0>(p, smem, 1);
#elif PROBE_KIND == 6
        phase_rows<1>(p, smem, 1);
#elif PROBE_KIND == 7
        phase_topk(p, smem);
#elif PROBE_KIND == 3
        phase_attn(p, smem, 1, 8 + r);
#elif PROBE_KIND == 4
        phase_mlout(p, smem, 1);
#endif
        __syncthreads();
    }
}
#endif
#ifndef EMU
#ifndef MK_N_LAUNCHES
#define MK_N_LAUNCHES 1
#endif
extern "C" void kernel_launch(void* const* d_in, const int* in_sizes, int n_in, void* d_out, int out_size, void* d_ws, size_t ws_size, hipStream_t stream) {
    (void)in_sizes; (void)n_in; (void)out_size; (void)ws_size;
    static int grid = 0;
    if (!grid) {
        int dev = 0, cus = 0, per_cu = 0;
        (void)hipGetDevice(&dev);
        (void)hipDeviceGetAttribute(&cus, hipDeviceAttributeMultiprocessorCount, dev);
        (void)hipFuncSetAttribute((const void*)mega_kernel, hipFuncAttributeMaxDynamicSharedMemorySize, SMEM_BYTES);
        (void)hipOccupancyMaxActiveBlocksPerMultiprocessor(&per_cu, mega_kernel, 512, SMEM_BYTES);
        grid = cus * (per_cu < 1 ? per_cu : 1);
        if (grid <= 0) grid = cus;
    }
    (void)hipMemsetAsync((char*)d_ws + WS_BAR, 0, WS_BAR_BYTES, stream);
    Params p = {};
    for (int i = 0; i < N_IN; ++i) p.in[i] = (const float*)d_in[i];
    p.out = (float*)d_out; p.ws = (char*)d_ws;
#if MK_N_LAUNCHES == 1
    p.ph0 = 0; p.ph1 = N_PHASES;
    mega_kernel<<<dim3(grid), dim3(512), SMEM_BYTES, stream>>>(p);
#ifdef PROBE_KIND
    (void)hipFuncSetAttribute((const void*)probe_kernel, hipFuncAttributeMaxDynamicSharedMemorySize, SMEM_BYTES);
    probe_kernel<<<dim3(grid), dim3(512), SMEM_BYTES, stream>>>(p);
#endif
#else
    for (int ph = 0; ph < N_PHASES; ++ph) { p.ph0 = ph; p.ph1 = ph + 1; mega_kernel<<<dim3(grid), dim3(512), SMEM_BYTES, stream>>>(p); }
#endif
}
#endif
```

```cpp
#ifndef EMU
#include <hip/hip_runtime.h>
#define DEV __device__ __forceinline__
#else
#define DEV static inline __attribute__((always_inline))
#endif
#include <stdint.h>
#include <stddef.h>

#ifndef CFG_D
#define CFG_D 1024
#define CFG_BATCH 16
#define CFG_SEQ 256
#define CFG_DEC_BATCH 2
#define CFG_DEC_SEQ 2048
#define CFG_PAST 256
#define CFG_EH 2816
#endif
constexpr int D = CFG_D, BATCH = CFG_BATCH, SEQ = CFG_SEQ, DEC_BATCH = CFG_DEC_BATCH, DEC_SEQ = CFG_DEC_SEQ, PAST = CFG_PAST, EH = CFG_EH;
constexpr int DEPTH = 2, HD = 64, NAH = 6, MLH = 4, GQH = 6, GQKV = 2, NEXP = 16, GRIDW = 64;
constexpr int NP = BATCH * SEQ, NS = DEC_BATCH * DEC_SEQ, NT = NP + NS, NCOND = 1 + DEC_BATCH;
constexpr int PROJ_W = 2832, MIXW = 1024;
constexpr int CAP_P = SEQ / 8, CAP_S = DEC_SEQ / 8, SLOTS = BATCH * CAP_P + DEC_BATCH * CAP_S;
constexpr int ROWS = DEC_SEQ / GRIDW, KR = ROWS < 8 ? ROWS : 8, KC = 16;
constexpr int NCH_P = SEQ / 64, NCH_S = DEC_SEQ / 64;
constexpr float ALPHA = 1.41421356237309515f;
constexpr float ATT_SCALE = 0.125f;
constexpr float EPS = 1e-6f;
static_assert(SLOTS % 256 == 0 && NP % 256 == 0 && NS % 256 == 0 && SEQ % 256 == 0 && DEC_SEQ % 256 == 0, "tile divisibility");
static_assert(D % 256 == 0 && EH % 128 == 0 && PAST % 64 == 0, "tile divisibility");

typedef unsigned short bf16_t;
typedef short s8v __attribute__((ext_vector_type(8)));
typedef short s4v __attribute__((ext_vector_type(4)));
typedef float f16v __attribute__((ext_vector_type(16)));
typedef float f4v __attribute__((ext_vector_type(4)));
typedef unsigned u4v __attribute__((ext_vector_type(4)));
typedef unsigned u2v __attribute__((ext_vector_type(2)));

enum { I_XP = 0, I_XS, I_C, I_CNAK, I_CNAV, I_CGQK, I_CGQV, I_SC, I_SN, I_SM, I_CCTX, I_ADAW, I_ADAB, I_WIN, I_BGATE, I_WOUT, I_RPB, I_QKG, I_MLG,
       I_LNG, I_LNB, I_RW, I_WG, I_WU, I_WD, N_IN };

constexpr size_t O_YP = 0;
constexpr size_t O_YS = O_YP + (size_t)NP * D;
constexpr size_t O_NAK = O_YS + (size_t)NS * D;
constexpr size_t O_NAV = O_NAK + (size_t)BATCH * DEPTH * SEQ * NAH * HD;
constexpr size_t O_GQK = O_NAV + (size_t)BATCH * DEPTH * SEQ * NAH * HD;
constexpr size_t O_GQV = O_GQK + (size_t)BATCH * DEPTH * SEQ * GQKV * HD;
constexpr size_t O_MC = O_GQV + (size_t)BATCH * DEPTH * SEQ * GQKV * HD;
constexpr size_t O_MN = O_MC + (size_t)BATCH * DEPTH * 2 * MLH * HD * HD;
constexpr size_t O_MM = O_MN + (size_t)BATCH * DEPTH * 2 * MLH * HD;
constexpr size_t O_END = O_MM + (size_t)BATCH * DEPTH * 2 * MLH;

constexpr size_t al256(size_t x) { return (x + 255) & ~(size_t)255; }
constexpr size_t WS_BAR = 0;
constexpr size_t WS_BAR_BYTES = 32768;
constexpr size_t WS_MODS = WS_BAR + WS_BAR_BYTES;
constexpr size_t WS_ROPE = al256(WS_MODS + (size_t)DEPTH * NCOND * 6 * D * 4);
constexpr size_t WS_CNAK = al256(WS_ROPE + 64 * 16 * 2 * 4);
constexpr size_t WS_CNAV = al256(WS_CNAK + (size_t)DEC_BATCH * DEPTH * PAST * NAH * HD * 2);
constexpr size_t WS_CGQK = al256(WS_CNAV + (size_t)DEC_BATCH * DEPTH * PAST * NAH * HD * 2);
constexpr size_t WS_CGQV = al256(WS_CGQK + (size_t)DEC_BATCH * DEPTH * PAST * GQKV * HD * 2);
constexpr size_t WS_XBUF = al256(WS_CGQV + (size_t)DEC_BATCH * DEPTH * PAST * GQKV * HD * 2);
constexpr size_t WS_HMOD = al256(WS_XBUF + (size_t)NT * D * 4);
constexpr size_t WS_GATES = al256(WS_HMOD + (size_t)NT * D * 2);
constexpr size_t WS_NAQ = al256(WS_GATES + (size_t)NT * 16 * 4);
constexpr size_t WS_NAK = al256(WS_NAQ + (size_t)NT * 384 * 2);
constexpr size_t WS_NAV = al256(WS_NAK + (size_t)NT * 384 * 2);
constexpr size_t WS_MLQ = al256(WS_NAV + (size_t)NT * 384 * 2);
constexpr size_t WS_MLK = al256(WS_MLQ + (size_t)NT * 256 * 2);
constexpr size_t WS_MLV = al256(WS_MLK + (size_t)NT * 256 * 2);
constexpr size_t WS_MLO = al256(WS_MLV + (size_t)NT * 256 * 2);
constexpr size_t WS_GQQ = al256(WS_MLO + (size_t)NT * 256 * 2);
constexpr size_t WS_GQK = al256(WS_GQQ + (size_t)NT * 384 * 2);
constexpr size_t WS_GQV = al256(WS_GQK + (size_t)NT * 128 * 2);
constexpr size_t WS_MIXED = al256(WS_GQV + (size_t)NT * 128 * 2);
constexpr size_t WS_U = al256(WS_MIXED + (size_t)NT * MIXW * 2);
constexpr size_t WS_X1 = al256(WS_U + (size_t)NT * D * 4);
constexpr size_t WS_H2 = al256(WS_X1 + (size_t)NT * D * 4);
constexpr size_t WS_AFF = al256(WS_H2 + (size_t)NT * D * 2);
constexpr size_t WS_IDX = al256(WS_AFF + (size_t)NT * 16 * 4);
constexpr size_t WS_GSEL = al256(WS_IDX + (size_t)NEXP * SLOTS * 4);
constexpr size_t WS_TOKSLOT = al256(WS_GSEL + (size_t)NEXP * SLOTS * 4);
constexpr size_t WS_HID = al256(WS_TOKSLOT + (size_t)NT * 16 * 4);
constexpr size_t WS_YE = al256(WS_HID + (size_t)NEXP * SLOTS * EH * 2);
constexpr int MLSUM_STRIDE = 4096 + 64 + 64;
constexpr int N_MLSUM = (BATCH * NCH_P + DEC_BATCH * NCH_S) * MLH * 2;
constexpr size_t WS_MLSUM = al256(WS_YE + (size_t)NEXP * SLOTS * D * 2);
constexpr int PART_STRIDE = 256 * 64 + 512;
constexpr int N_PART = DEC_BATCH * GQH * (DEC_SEQ / 256) * 2;
constexpr size_t WS_PART = al256(WS_MLSUM + (size_t)N_MLSUM * MLSUM_STRIDE * 4);
constexpr size_t WS_TOTAL = al256(WS_PART + (size_t)N_PART * PART_STRIDE * 4);

struct Params {
    const float* in[N_IN];
    float* out;
    char* ws;
    int ph0, ph1;
};

DEV float bf2f(bf16_t s) { unsigned u = ((unsigned)s) << 16; return __builtin_bit_cast(float, u); }
DEV bf16_t f2bf(float f) {
#ifdef EMU
    unsigned u = __builtin_bit_cast(unsigned, f); u += 0x7fffu + ((u >> 16) & 1u); return (bf16_t)(u >> 16);
#else
    return __builtin_bit_cast(bf16_t, (__bf16)f);
#endif
}
DEV unsigned pack2(float a, float b) {
#ifdef EMU
    return (unsigned)f2bf(a) | ((unsigned)f2bf(b) << 16);
#else
    typedef __bf16 b2 __attribute__((ext_vector_type(2))); b2 r; r[0] = (__bf16)a; r[1] = (__bf16)b; return __builtin_bit_cast(unsigned, r);
#endif
}
DEV float fexp(float x) {
#ifdef EMU
    return expf(x);
#else
    return __expf(x);
#endif
}
DEV float fexp2(float x) {
#ifdef EMU
    return exp2f(x);
#else
    return __builtin_amdgcn_exp2f(x);
#endif
}
DEV float frcp(float x) {
#ifdef EMU
    return 1.f / x;
#else
    return __builtin_amdgcn_rcpf(x);
#endif
}
DEV float sigmoidf_(float x) { return frcp(1.f + fexp(-x)); }
DEV float siluf_(float x) { return x * frcp(1.f + fexp(-x)); }
DEV float logsigmoidf_(float x) { return fminf(x, 0.f) - log1pf(expf(-fabsf(x))); }
DEV f16v mfma32(s8v a, s8v b, f16v c) {
#ifdef EMU
    return emu_mfma_32x32x16_bf16(a, b, c);
#else
    typedef __bf16 bf8 __attribute__((ext_vector_type(8)));
    return __builtin_amdgcn_mfma_f32_32x32x16_bf16(__builtin_bit_cast(bf8, a), __builtin_bit_cast(bf8, b), c, 0, 0, 0);
#endif
}
DEV s4v lds_tr16(const void* p) {
#ifdef EMU
    return emu_ds_read_tr16_b64(p);
#else
    typedef s4v __attribute__((address_space(3))) * lp;
    return __builtin_amdgcn_ds_read_tr16_b64_v4i16((lp)(p));
#endif
}
#ifdef EMU
DEV float wave_sum(float v) { for (int m = 32; m >= 1; m >>= 1) v += __shfl_xor(v, m); return v; }
#else
template <int CTRL, int RM> DEV float dpp_f(float v) { return __builtin_bit_cast(float, __builtin_amdgcn_update_dpp(0, __builtin_bit_cast(int, v), CTRL, RM, 0xF, false)); }
DEV float wave_sum(float v) {
    v += dpp_f<0xB1, 0xF>(v); v += dpp_f<0x4E, 0xF>(v); v += dpp_f<0x141, 0xF>(v); v += dpp_f<0x140, 0xF>(v);
    v += dpp_f<0x142, 0xA>(v); v += dpp_f<0x143, 0xC>(v);
    return __builtin_bit_cast(float, __builtin_amdgcn_readlane(__builtin_bit_cast(int, v), 63));
}
#endif
DEV float wave_max(float v) { for (int m = 32; m >= 1; m >>= 1) v = fmaxf(v, __shfl_xor(v, m)); return v; }
DEV f16v f16zero() { f16v z; for (int i = 0; i < 16; ++i) z[i] = 0.f; return z; }

#ifdef EMU
#define VGPR_PIN(x) do {} while (0)
#define SGPR_PIN(x) do {} while (0)
#define SCHED_FENCE() do {} while (0)
#define CFENCE() do {} while (0)
#else
#define SCHED_FENCE() __builtin_amdgcn_sched_barrier(0)
#define SGPR_PIN(x) asm volatile("" : "+s"(x))
#define VGPR_PIN(x) asm volatile("" : "+v"(x))
#define CFENCE() asm volatile("" ::: "memory")
#endif
#ifdef EMU
DEV int get_tid() { return (int)threadIdx.x; }
#else
DEV int get_tid() { int t = threadIdx.x; asm volatile("" : "+v"(t)); return t; }
#endif
struct UnitIter { int i, end, step; };
DEV UnitIter unit_iter(int NU) {
    const int G = (int)gridDim.x, b = (int)blockIdx.x;
    UnitIter it;
#ifndef XCD_MODE
#define XCD_MODE 0
#endif
    if ((G & 7) == 0 && (NU & 7) == 0) { const int W = G >> 3, x = XCD_MODE ? b / W : b & 7, j = XCD_MODE ? b % W : b >> 3, C = NU >> 3; it.i = x * C + j; it.end = (x + 1) * C; it.step = W; }
    else { it.i = b; it.end = NU; it.step = G; }
    return it;
}
DEV int tok_cond(int t) { return t < NP ? 0 : 1 + (t - NP) / DEC_SEQ; }

#ifndef EMU
#define XB_TMO      128
#define XB_XCNT(j)  (256  + 64 * (j))
#define XB_XSUB(j)  (1280 + 64 * (j))
#define XB_XGEN(j)  (2304 + 64 * (j))
#define XB_TOP      3328
#define XB_TOPGEN   3392
#define XCD_BAR_WORDS 3456
#define XB_SPIN_CAP (1u << 20)
#define LAS __attribute__((address_space(3)))
__device__ __forceinline__ unsigned xb_ld(unsigned* p)              { return __hip_atomic_load(p, __ATOMIC_RELAXED, __HIP_MEMORY_SCOPE_AGENT); }
__device__ __forceinline__ unsigned xb_add(unsigned* p, unsigned v) { return __hip_atomic_fetch_add(p, v, __ATOMIC_RELAXED, __HIP_MEMORY_SCOPE_AGENT); }
__device__ __forceinline__ unsigned xb_xcc_id() { return (unsigned)__builtin_amdgcn_s_getreg((3 << 11) | 20) & 0xFu; }
#define XB_SPIN(cond, bar) do { unsigned _sp = 0; while (cond) { __builtin_amdgcn_s_sleep(1); \
    if ((++_sp & 255u) == 0u) { if (xb_ld(&(bar)[XB_TMO])) break; if (_sp > XB_SPIN_CAP) { atomicAdd(&(bar)[XB_TMO], 1u); break; } } } } while (0)
struct XcdBarrier { unsigned* bar; unsigned x; volatile LAS unsigned* st; };
__device__ __forceinline__ XcdBarrier xcd_barrier_post(unsigned* bar, volatile LAS unsigned* st) {
    XcdBarrier b; b.bar = bar; b.x = xb_xcc_id(); b.st = st;
    if (threadIdx.x == 0) (void)xb_add(&bar[XB_XCNT(b.x)], 1u);
    return b;
}
__device__ __forceinline__ void xcd_barrier_complete(unsigned* bar, unsigned x, unsigned& nloc, unsigned& nx) {
    const unsigned G = gridDim.x * gridDim.y * gridDim.z;
    unsigned sum, cnt, mine, sp = 0u;
    for (;;) {
        sum = 0u; cnt = 0u; mine = 0u;
#pragma unroll
        for (unsigned j = 0; j < 16; ++j) { const unsigned c = xb_ld(&bar[XB_XCNT(j)]); sum += c; cnt += (c > 0u) ? 1u : 0u; mine = (j == x) ? c : mine; }
        if (sum == G) break;
        __builtin_amdgcn_s_sleep(1);
        if ((++sp & 255u) == 0u) { if (xb_ld(&bar[XB_TMO])) break; if (sp > XB_SPIN_CAP) { atomicAdd(&bar[XB_TMO], 1u); break; } }
    }
    nloc = mine > 0u ? mine : 1u; nx = cnt > 0u ? cnt : 1u;
}
__device__ __forceinline__ void xcd_barrier(const XcdBarrier& b) {
    asm volatile("s_waitcnt vmcnt(0)" ::: "memory");
    __syncthreads();
    if (threadIdx.x == 0) {
        unsigned* bar = b.bar;
        __builtin_amdgcn_s_waitcnt(0);
        unsigned nloc = b.st[0], nx = b.st[1];
        if (nloc == 0u) { xcd_barrier_complete(bar, b.x, nloc, nx); b.st[0] = nloc; b.st[1] = nx; }
        const unsigned old = xb_add(&bar[XB_XSUB(b.x)], 1u);
        const unsigned gen = old / nloc;
        if (old + 1u == (gen + 1u) * nloc) {
            __builtin_amdgcn_fence(__ATOMIC_RELEASE, "agent");
            asm volatile("s_waitcnt vmcnt(0)" ::: "memory");
            const unsigned og = xb_add(&bar[XB_TOP], 1u);
            const unsigned tg = og / nx;
            if (og + 1u == (tg + 1u) * nx) xb_add(&bar[XB_TOPGEN], 1u);
            else XB_SPIN(xb_ld(&bar[XB_TOPGEN]) == tg, bar);
            __builtin_amdgcn_fence(__ATOMIC_ACQUIRE, "agent");
            xb_add(&bar[XB_XGEN(b.x)], 1u);
            asm volatile("s_waitcnt vmcnt(0)" ::: "memory");
        } else {
            XB_SPIN(xb_ld(&bar[XB_XGEN(b.x)]) == gen, bar);
            __builtin_amdgcn_fence(__ATOMIC_ACQUIRE, "agent");
            asm volatile("s_waitcnt vmcnt(0)" ::: "memory");
        }
    }
    __syncthreads();
}
#endif
constexpr int QUEUE_WORD0 = 4096;

constexpr int LROW = 144;
constexpr int GEMM_AS = 256 * LROW;
constexpr int GEMM_BS = 64 * (256 * 2 + 64);
constexpr int SMEM_BYTES = 2 * GEMM_AS + 2 * GEMM_BS + 64;
constexpr int SMEM_XB = 2 * GEMM_AS + 2 * GEMM_BS;

#ifdef EMU
struct BufRsrc { const char* base; };
DEV BufRsrc make_rsrc(const void* p) { BufRsrc r; r.base = (const char*)p; return r; }
DEV float buf_load_f32(BufRsrc r, unsigned voff, unsigned soff) { return *(const float*)(r.base + voff + soff); }
DEV u4v buf_load_b128(BufRsrc r, unsigned voff, unsigned soff) { return *(const u4v*)(r.base + voff + soff); }
#else
typedef __amdgpu_buffer_rsrc_t BufRsrc;
DEV BufRsrc make_rsrc(const void* p) { return __builtin_amdgcn_make_buffer_rsrc((void*)p, 0, 0x7fffffff, 0x00020000); }
DEV float buf_load_f32(BufRsrc r, unsigned voff, unsigned soff) { return __builtin_bit_cast(float, __builtin_amdgcn_raw_buffer_load_b32(r, voff, soff, 0)); }
DEV u4v buf_load_b128(BufRsrc r, unsigned voff, unsigned soff) { return __builtin_amdgcn_raw_buffer_load_b128(r, voff, soff, 0); }
#endif
#ifdef EMU
#define WAVE_SYNC() do { (void)__shfl(0, 0); } while (0)
#else
#define WAVE_SYNC() asm volatile("s_waitcnt lgkmcnt(0)" ::: "memory")
#endif
DEV char* wave_stage_ptr(char* smem, int wave) { return smem + (wave < 4 ? GEMM_AS + wave * 9216 : 2 * GEMM_AS + GEMM_BS + (wave - 4) * 9216); }
DEV void stage64_write_bf16(char* stg, int tt, const f16v& v0, const f16v& v1, int l31, int h) {
    char* row = stg + (tt * 32 + l31) * LROW;
#pragma unroll
    for (int ft = 0; ft < 2; ++ft) {
        const f16v& v = ft ? v1 : v0;
#pragma unroll
        for (int g = 0; g < 4; ++g) { u2v pk; pk[0] = pack2(v[4 * g], v[4 * g + 1]); pk[1] = pack2(v[4 * g + 2], v[4 * g + 3]); *(u2v*)(row + (ft * 32 + 8 * g + 4 * h) * 2) = pk; }
    }
}
DEV void stage64_write4(char* stg, int row, int col, float a, float b, float c, float d) {
    u2v pk; pk[0] = pack2(a, b); pk[1] = pack2(c, d); *(u2v*)(stg + row * LROW + col * 2) = pk;
}
DEV void stage64_flush_bf16(const char* stg, bf16_t* dst0, size_t row_stride, int lane) {
    WAVE_SYNC();
#pragma unroll
    for (int i = 0; i < 8; ++i) { const int r = (lane >> 3) + 8 * i, c = lane & 7; const u4v v = *(const u4v*)(stg + r * LROW + c * 16); *(u4v*)(dst0 + (size_t)r * row_stride + c * 8) = v; }
    WAVE_SYNC();
}
template <int NTW, int VAR, class Epi>
DEV void gemm_tile(char* smem, BufRsrc ars, unsigned ao0, unsigned ao1, unsigned ao2, unsigned ao3,
                   BufRsrc brs, unsigned bvo, unsigned blds, unsigned ldb4, int K, Epi&& epi) {
    constexpr int BN = 64 * NTW, NLD = 2 * NTW, KSTEP = 64 / NLD, RSB = BN * 2 + 64;
    const int tid = get_tid(), lane = tid & 63, wave = tid >> 6, wm = wave & 3, wn = wave >> 2, h = lane >> 5, l31 = lane & 31;
    char* As = smem; char* Bs = smem + 2 * GEMM_AS;
    constexpr int BSZ = GEMM_BS;
    const int ar = tid >> 3, ac = tid & 7;
    u4v areg[2]; f4v b0[NLD], b1[NLD];
    if (VAR & 3) { for (int i = 0; i < 2; ++i) areg[i] = (u4v){1u, 2u, 3u, 4u}; for (int j = 0; j < NLD; ++j) { b0[j] = (f4v){1.f, 1.f, 1.f, 1.f}; b1[j] = (f4v){2.f, 2.f, 2.f, 2.f}; } }
    f16v acc[NTW][2];
#pragma unroll
    for (int i = 0; i < NTW; ++i) { acc[i][0] = f16zero(); acc[i][1] = f16zero(); }
    auto gloadA = [&](int k0, bool real, int half) {
        if (VAR & 2) return;
        const unsigned so = real ? k0 * 2 : 0u;
        areg[0] = buf_load_b128(ars, real ? (half ? ao2 : ao0) : 0u, so); areg[1] = buf_load_b128(ars, real ? (half ? ao3 : ao1) : 0u, so);
    };
    auto gloadB = [&](int k0, bool real, f4v (&br)[NLD]) {
        if (VAR & 1) return;
        const unsigned vo = real ? bvo : 0u; const int kk = real ? k0 : 0;
        unsigned so = (unsigned)kk * ldb4;
#pragma unroll
        for (int j = 0; j < NLD; ++j) { br[j] = __builtin_bit_cast(f4v, buf_load_b128(brs, vo, so)); so += KSTEP * ldb4; SGPR_PIN(so); }
    };
    auto lstoreA = [&](int buf, int half) {
        if (VAR & 16) return;
        char* ab = As + buf * GEMM_AS + (ar + half * 128) * LROW + ac * 16;
        *(u4v*)(ab) = areg[0]; *(u4v*)(ab + 64 * LROW) = areg[1];
    };
    auto lstoreB = [&](int buf, const f4v (&br)[NLD]) {
        if (VAR & 16) return;
        char* bb = Bs + buf * BSZ + blds;
#pragma unroll
        for (int j = 0; j < NLD; ++j) { u2v v; v[0] = pack2(br[j][0], br[j][1]); v[1] = pack2(br[j][2], br[j][3]); *(u2v*)(bb + j * KSTEP * RSB) = v; }
    };
    const unsigned btr = (unsigned)(8 * h + ((lane & 15) >> 2)) * RSB + (unsigned)((((lane >> 4) & 1) * 16 + 4 * (lane & 3)) * 2) + (unsigned)(wn * NTW * 32) * 2;
    const unsigned atr = (unsigned)(wm * 64 + l31) * LROW + h * 16;
    auto rdw = [&](int buf, int s, int ft) -> s8v {
        const char* bb = Bs + buf * BSZ + btr + s * 16 * RSB + ft * 64;
        const s4v lo = lds_tr16(bb), hi = lds_tr16(bb + 4 * RSB);
        s8v wf; wf[0] = lo[0]; wf[1] = lo[1]; wf[2] = lo[2]; wf[3] = lo[3]; wf[4] = hi[0]; wf[5] = hi[1]; wf[6] = hi[2]; wf[7] = hi[3];
        return wf;
    };
    auto compute2 = [&](int buf, int s0) {
        if (VAR & 8) return;
        const char* ab = As + buf * GEMM_AS + atr;
        s8v xa[2];
        xa[0] = *(const s8v*)(ab + s0 * 32); xa[1] = *(const s8v*)(ab + 32 * LROW + s0 * 32);
        s8v wcur = rdw(buf, s0, 0);
#pragma unroll
        for (int g = 0; g < 2 * NTW; ++g) {
            const int ft = g % NTW;
            s8v wnext = wcur;
            if (g + 1 < 2 * NTW) wnext = rdw(buf, s0 + (g + 1) / NTW, (g + 1) % NTW);
            if (VAR & 4) { acc[ft][0][0] += __builtin_bit_cast(float, (int)wcur[0] | ((int)xa[0][1] << 16)); acc[ft][1][0] += __builtin_bit_cast(float, (int)wcur[1] | ((int)xa[1][1] << 16)); }
            else { acc[ft][0] = mfma32(wcur, xa[0], acc[ft][0]); acc[ft][1] = mfma32(wcur, xa[1], acc[ft][1]); }
            if (g == NTW - 1) { xa[0] = *(const s8v*)(ab + (s0 + 1) * 32); xa[1] = *(const s8v*)(ab + 32 * LROW + (s0 + 1) * 32); }
            wcur = wnext;
            SCHED_FENCE();
        }
    };
    const int nk = K / 64;
    if (NTW == 2) {
        u4v a0[4], a1[4];
        if (VAR & 3) { for (int i = 0; i < 4; ++i) { a0[i] = (u4v){1u, 2u, 3u, 4u}; a1[i] = (u4v){1u, 2u, 3u, 4u}; } }
        auto gA = [&](int k0, bool real, u4v (&ar4)[4]) {
            if (VAR & 2) return;
            const unsigned so = real ? k0 * 2 : 0u;
            ar4[0] = buf_load_b128(ars, real ? ao0 : 0u, so); ar4[1] = buf_load_b128(ars, real ? ao1 : 0u, so);
            ar4[2] = buf_load_b128(ars, real ? ao2 : 0u, so); ar4[3] = buf_load_b128(ars, real ? ao3 : 0u, so);
        };
        auto sA = [&](int buf, const u4v (&ar4)[4]) {
            if (VAR & 16) return;
            char* ab = As + buf * GEMM_AS + ar * LROW + ac * 16;
#pragma unroll
            for (int i = 0; i < 4; ++i) *(u4v*)(ab + i * 64 * LROW) = ar4[i];
        };
        gA(0, true, a0); gloadB(0, true, b0); gA(64, true, a1); gloadB(64, true, b1);
        sA(0, a0); lstoreB(0, b0);
        __syncthreads();
        for (int kt = 0; kt < nk; kt += 2) {
            const bool t2 = kt + 2 < nk;
            gA((kt + 2) * 64, t2, a0); gloadB((kt + 2) * 64, t2, b0);
            compute2(0, 0); compute2(0, 2);
            sA(1, a1); lstoreB(1, b1);
            __syncthreads();
            gA((kt + 3) * 64, t2, a1); gloadB((kt + 3) * 64, t2, b1);
            compute2(1, 0); compute2(1, 2);
            sA(0, a0); lstoreB(0, b0);
            __syncthreads();
        }
    } else {
    gloadA(0, true, 0); gloadB(0, true, b0); lstoreA(0, 0); gloadA(0, true, 1); gloadB(64, true, b1); lstoreA(0, 1); lstoreB(0, b0);
    __syncthreads();
    for (int kt = 0; kt < nk; kt += 2) {
        const bool t2 = kt + 2 < nk;
        gloadA((kt + 1) * 64, true, 0);
        compute2(0, 0);
        lstoreA(1, 0);
        gloadA((kt + 1) * 64, true, 1);
        gloadB((kt + 2) * 64, t2, b0);
        compute2(0, 2);
        lstoreA(1, 1); lstoreB(1, b1);
        __syncthreads();
        gloadA((kt + 2) * 64, t2, 0);
        compute2(1, 0);
        lstoreA(0, 0);
        gloadA((kt + 2) * 64, t2, 1);
        gloadB((kt + 3) * 64, t2, b1);
        compute2(1, 2);
        lstoreA(0, 1); lstoreB(0, b0);
        __syncthreads();
    }
    }
    if (VAR & 32) { float t = 0.f; for (int i = 0; i < NTW; ++i) t += acc[i][0][0] + acc[i][1][5]; if (t == 123.456f) *(float*)smem = t; }
    else epi(acc);
}

DEV void phase_ada(const Params& p, char* smem) {
    const int tid = get_tid();
    float* siluS = (float*)smem;
    float* red = (float*)(smem + NCOND * D * 4);
    for (int i = tid; i < NCOND * D; i += 512) {
        const int cnd = i / D, k = i % D;
        const float c = cnd == 0 ? p.in[I_CCTX][k] : p.in[I_C][(cnd - 1) * D + k];
        siluS[i] = c / (1.f + expf(-c));
    }
    __syncthreads();
    constexpr int CPL = 6 * D / 32, NCHUNK = DEPTH * CPL, KG = D / 16;
    float* mods = (float*)(p.ws + WS_MODS);
    const int col = tid & 31, kg = tid >> 5;
    for (int u = blockIdx.x; u < NCHUNK; u += gridDim.x) {
        const int l = u / CPL, c0 = (u % CPL) * 32;
        const float* W = p.in[I_ADAW] + (size_t)l * D * 6 * D + c0 + col;
        float acc[NCOND];
#pragma unroll
        for (int c = 0; c < NCOND; ++c) acc[c] = 0.f;
#pragma unroll 8
        for (int k = kg * KG; k < kg * KG + KG; ++k) {
            const float w = W[(size_t)k * 6 * D];
#pragma unroll
            for (int c = 0; c < NCOND; ++c) acc[c] += siluS[c * D + k] * w;
        }
#pragma unroll
        for (int c = 0; c < NCOND; ++c) red[(kg * NCOND + c) * 32 + col] = acc[c];
        __syncthreads();
        if (tid < 32 * NCOND) {
            const int c = tid >> 5, cc = tid & 31;
            float s = 0.f;
            for (int g = 0; g < 16; ++g) s += red[(g * NCOND + c) * 32 + cc];
            mods[((size_t)l * NCOND + c) * 6 * D + c0 + cc] = s + p.in[I_ADAB][(size_t)l * 6 * D + c0 + cc];
        }
        __syncthreads();
    }
    const int gtid = blockIdx.x * 512 + tid, gsz = gridDim.x * 512;
    float* rope = (float*)(p.ws + WS_ROPE);
    for (int i = gtid; i < 64 * 16; i += gsz) {
        const int pos = i >> 4, fi = i & 15;
        const float inv = powf(10000.f, -(float)(2 * fi) / 32.f);
        const float ang = (float)pos * inv;
        rope[2 * i] = cosf(ang); rope[2 * i + 1] = sinf(ang);
    }
    constexpr int NNA = DEC_BATCH * DEPTH * PAST * NAH * HD, NGQ = DEC_BATCH * DEPTH * PAST * GQKV * HD;
    bf16_t* cnak = (bf16_t*)(p.ws + WS_CNAK); bf16_t* cnav = (bf16_t*)(p.ws + WS_CNAV);
    bf16_t* cgqk = (bf16_t*)(p.ws + WS_CGQK); bf16_t* cgqv = (bf16_t*)(p.ws + WS_CGQV);
    for (int i = gtid; i < NNA; i += gsz) { cnak[i] = f2bf(p.in[I_CNAK][i]); cnav[i] = f2bf(p.in[I_CNAV][i]); }
    for (int i = gtid; i < NGQ; i += gsz) { cgqk[i] = f2bf(p.in[I_CGQK][i]); cgqv[i] = f2bf(p.in[I_CGQV][i]); }
}

constexpr int EPL = D / 64;
constexpr int W16ROW = 20;
template <int MODE>
DEV void phase_rows(const Params& p, char* smem, int l) {
    const int tid = get_tid(), lane = tid & 63, wave = tid >> 6;
    float* W16 = (float*)smem;
    const bool need_w = (MODE == 1) || (l < DEPTH);
    if (need_w) {
        for (int i = tid; i < D * 4; i += 512) {
            const int k = i >> 2, q = i & 3;
            const float* src = (MODE == 1) ? p.in[I_RW] + ((size_t)l * D + k) * 16 + q * 4 : p.in[I_WIN] + ((size_t)l * D + k) * PROJ_W + 2176 + q * 4;
            *(f4v*)(W16 + k * W16ROW + q * 4) = *(const f4v*)src;
        }
    }
    __syncthreads();
    const float* mods = (const float*)(p.ws + WS_MODS);
    for (int t = blockIdx.x * 8 + wave; t < NT; t += gridDim.x * 8) {
        const int cnd = tok_cond(t);
        float v[EPL];
        if (MODE == 0 && l == 0) {
            const float* xr = t < NP ? p.in[I_XP] + (size_t)t * D : p.in[I_XS] + (size_t)(t - NP) * D;
#pragma unroll
            for (int j = 0; j < EPL; ++j) v[j] = xr[lane + 64 * j];
        } else if (MODE == 0) {
            const float* x1 = (const float*)(p.ws + WS_X1) + (size_t)t * D;
            const float* g2 = mods + ((size_t)(l - 1) * NCOND + cnd) * 6 * D + 5 * D;
            float f[EPL], xv[EPL], gv[EPL];
#pragma unroll
            for (int j = 0; j < EPL; ++j) { f[j] = 0.f; xv[j] = x1[lane + 64 * j]; gv[j] = g2[lane + 64 * j]; }
            const int* ts = (const int*)(p.ws + WS_TOKSLOT) + (size_t)t * 16;
            const int myslot = lane < 16 ? ts[lane] : -1;
            unsigned vm = (unsigned)__ballot(myslot >= 0);
            while (vm) {
                const int e = __builtin_ctz(vm); vm &= vm - 1u;
                const int slot = __shfl(myslot, e);
                const bf16_t* yr = (const bf16_t*)(p.ws + WS_YE) + ((size_t)e * SLOTS + slot) * D;
#pragma unroll
                for (int j = 0; j < EPL; ++j) f[j] += bf2f(yr[lane + 64 * j]);
            }
#pragma unroll
            for (int j = 0; j < EPL; ++j) v[j] = ALPHA * xv[j] + gv[j] * f[j];
        } else {
            const float* u = (const float*)(p.ws + WS_U) + (size_t)t * D;
#pragma unroll
            for (int j = 0; j < EPL; ++j) v[j] = u[lane + 64 * j];
        }
        if (!(MODE == 0 && l == 0)) {
            const int li = (MODE == 0) ? (l - 1) * 2 + 1 : l * 2;
            const float* lg = p.in[I_LNG] + (size_t)li * D; const float* lb = p.in[I_LNB] + (size_t)li * D;
            float g[EPL], bb[EPL];
#pragma unroll
            for (int j = 0; j < EPL; ++j) { g[j] = lg[lane + 64 * j]; bb[j] = lb[lane + 64 * j]; }
            float s = 0.f;
#pragma unroll
            for (int j = 0; j < EPL; ++j) s += v[j];
            const float mu = wave_sum(s) * (1.f / D);
            float q = 0.f;
#pragma unroll
            for (int j = 0; j < EPL; ++j) { const float dlt = v[j] - mu; q += dlt * dlt; }
            const float rstd = 1.f / sqrtf(wave_sum(q) * (1.f / D) + EPS);
            float* dst = (MODE == 1) ? (float*)(p.ws + WS_X1) + (size_t)t * D
                       : (l == DEPTH) ? (t < NP ? p.out + O_YP + (size_t)t * D : p.out + O_YS + (size_t)(t - NP) * D) : (float*)(p.ws + WS_XBUF) + (size_t)t * D;
#pragma unroll
            for (int j = 0; j < EPL; ++j) { v[j] = (v[j] - mu) * rstd * g[j] + bb[j]; dst[lane + 64 * j] = v[j]; }
        }
        if (MODE == 1 || l < DEPTH) {
            const float* sh = mods + ((size_t)l * NCOND + cnd) * 6 * D + (MODE == 1 ? 3 * D : 0); const float* sc = sh + D;
            bf16_t* hb = (bf16_t*)(p.ws + (MODE == 1 ? WS_H2 : WS_HMOD)) + (size_t)t * D;
            {
                float s1[EPL], s0[EPL];
#pragma unroll
                for (int j = 0; j < EPL; ++j) { s1[j] = sc[lane + 64 * j]; s0[j] = sh[lane + 64 * j]; }
#pragma unroll
                for (int j = 0; j < EPL; ++j) { v[j] = v[j] * (1.f + s1[j]) + s0[j]; hb[lane + 64 * j] = f2bf(v[j]); }
            }
            CFENCE();
            float a16[16];
#pragma unroll
            for (int e = 0; e < 16; ++e) a16[e] = 0.f;
#pragma unroll
            for (int j = 0; j < EPL; ++j) {
                const float hv = v[j];
                const float* wr = W16 + (lane + 64 * j) * W16ROW;
#pragma unroll
                for (int q = 0; q < 4; ++q) { const f4v w4 = *(const f4v*)(wr + 4 * q); a16[4 * q] += hv * w4[0]; a16[4 * q + 1] += hv * w4[1]; a16[4 * q + 2] += hv * w4[2]; a16[4 * q + 3] += hv * w4[3]; }
                if (j & 1) CFENCE();
            }
            float mine = -1e30f;
#pragma unroll
            for (int e = 0; e < 16; ++e) { const float sm = wave_sum(a16[e]); if (lane == e) mine = sm; }
            if (MODE == 0) {
                if (lane < 16) ((float*)(p.ws + WS_GATES))[(size_t)t * 16 + lane] = mine + p.in[I_BGATE][l * 16 + lane];
            } else {
                float mx = mine;
                for (int m = 8; m >= 1; m >>= 1) mx = fmaxf(mx, __shfl_xor(mx, m));
                const float ex = lane < 16 ? expf(mine - mx) : 0.f;
                float sm = ex;
                for (int m = 8; m >= 1; m >>= 1) sm += __shfl_xor(sm, m);
                if (lane < 16) ((float*)(p.ws + WS_AFF))[(size_t)t * 16 + lane] = ex / sm;
            }
        }
    }
}

template <int NPL>
DEV void topk_wave(const Params& p, int tb, int cap, int sbase, int e, int lane) {
    const float* aff = (const float*)(p.ws + WS_AFF);
    int* idx = (int*)(p.ws + WS_IDX); float* gsel = (float*)(p.ws + WS_GSEL); int* tokslot = (int*)(p.ws + WS_TOKSLOT);
    unsigned bits[NPL];
#pragma unroll
    for (int i = 0; i < NPL; ++i) bits[i] = __builtin_bit_cast(unsigned, aff[(size_t)(tb + lane + 64 * i) * 16 + e]);
    unsigned T = 0u;
    for (int b = 30; b >= 0; --b) {
        const unsigned cand = T | (1u << b);
        int cnt = 0;
#pragma unroll
        for (int i = 0; i < NPL; ++i) cnt += __popcll(__ballot(bits[i] >= cand));
        if (cnt >= cap) T = cand;
    }
    int ngt = 0;
#pragma unroll
    for (int i = 0; i < NPL; ++i) ngt += __popcll(__ballot(bits[i] > T));
    int need_eq = cap - ngt, run = 0;
    const unsigned long long lt = (1ull << lane) - 1ull;
#pragma unroll
    for (int i = 0; i < NPL; ++i) {
        const bool eq = bits[i] == T;
        const unsigned long long meq = __ballot(eq);
        const int eqrank = __popcll(meq & lt);
        const bool sel = bits[i] > T || (eq && eqrank < need_eq);
        const unsigned long long ms = __ballot(sel);
        const int t = tb + lane + 64 * i;
        if (sel) { const int slot = sbase + run + __popcll(ms & lt); idx[e * SLOTS + slot] = t; gsel[e * SLOTS + slot] = __builtin_bit_cast(float, bits[i]); tokslot[(size_t)t * 16 + e] = slot; }
        else tokslot[(size_t)t * 16 + e] = -1;
        run += __popcll(ms);
        const int neq = __popcll(meq); need_eq -= neq < need_eq ? neq : need_eq;
    }
}
DEV void phase_topk(const Params& p, char* smem) {
    (void)smem;
    const int tid = get_tid(), lane = tid & 63;
    constexpr int US = DEC_BATCH * NEXP, UP = BATCH * NEXP;
    const int gw = blockIdx.x + gridDim.x * (tid >> 6), nw = gridDim.x * 8;
    for (int u = gw; u < US + UP; u += nw) {
        if (u < US) { const int b = u / NEXP, e = u % NEXP; topk_wave<DEC_SEQ / 64>(p, NP + b * DEC_SEQ, CAP_S, BATCH * CAP_P + b * CAP_S, e, lane); }
        else { const int uu = u - US; const int b = uu / NEXP, e = uu % NEXP; topk_wave<SEQ / 64>(p, b * SEQ, CAP_P, b * CAP_P, e, lane); }
    }
}

DEV void store_head_f32(float* dst_f32, const f16v& v0, const f16v& v1, int h) {
#pragma unroll
    for (int ft = 0; ft < 2; ++ft) {
        const f16v& v = ft ? v1 : v0;
#pragma unroll
        for (int g = 0; g < 4; ++g) { f4v o; o[0] = v[4 * g]; o[1] = v[4 * g + 1]; o[2] = v[4 * g + 2]; o[3] = v[4 * g + 3]; *(f4v*)(dst_f32 + ft * 32 + 8 * g + 4 * h) = o; }
    }
}
template <int VAR>
DEV void phase_inproj(const Params& p, char* smem, int l) {
    constexpr int NJ = 22, NU = (NT / 256) * NJ;
    const int tid = get_tid(), lane = tid & 63, wave = tid >> 6, wm = wave & 3, wn = wave >> 2, h = lane >> 5, l31 = lane & 31;
    const bf16_t* hmod = (const bf16_t*)(p.ws + WS_HMOD);
    const float* rope = (const float*)(p.ws + WS_ROPE);
    constexpr int NMB = NT / 256, RPX = (NMB % 8 == 0) ? NMB / 8 : NMB;
    const UnitIter it = unit_iter(NU);
    for (int u = it.i; u < it.end; u += it.step) {
        const int mb = (u / (RPX * NJ)) * RPX + u % RPX, j = (u / RPX) % NJ;
        const int colbase = j < 17 ? 128 * j : 2192 + 128 * (j - 17);
        const unsigned ao = ((unsigned)(mb * 256 + (tid >> 3)) * D + (tid & 7) * 8) * 2;
        const unsigned bvo = (unsigned)(colbase + 4 * (tid & 31)) * 4 + (unsigned)(tid >> 5) * (PROJ_W * 4);
        const unsigned blds = (unsigned)(tid >> 5) * 320u + (unsigned)(tid & 31) * 8u;
        gemm_tile<2, VAR>(smem, make_rsrc(hmod), ao, ao + 128u * D, ao + 256u * D, ao + 384u * D, make_rsrc(p.in[I_WIN] + (size_t)l * D * PROJ_W), bvo, blds, PROJ_W * 4, D, [&](f16v (&acc)[2][2]) {
            int lane_e = lane; VGPR_PIN(lane_e); const int lane = lane_e, l31 = lane_e & 31, h = lane_e >> 5; (void)l31; (void)h;
            const int cb = colbase + wn * 64;
            char* stg = wave_stage_ptr(smem, wave);
            const int t0 = mb * 256 + wm * 64;
            const bool isP = t0 < NP;
            bf16_t* dstb; size_t dstride;
            int f32out = 0, fhead = 0, fheads = 0; size_t fbase = 0;
            int mode = 0;
            if (cb < 1152) {
                const int seg = cb / 384, head = (cb % 384) / 64;
                dstb = (bf16_t*)(p.ws + (seg == 0 ? WS_NAQ : seg == 1 ? WS_NAK : WS_NAV)) + (size_t)t0 * 384 + head * 64; dstride = 384;
                if (seg >= 1 && isP) { f32out = 1; fbase = seg == 1 ? O_NAK : O_NAV; fhead = head; fheads = NAH; }
            } else if (cb < 2176) {
                const int seg = (cb - 1152) / 256, head = ((cb - 1152) % 256) / 64;
                dstb = (bf16_t*)(p.ws + (seg == 0 ? WS_MLQ : seg == 1 ? WS_MLK : seg == 2 ? WS_MLV : WS_MLO)) + (size_t)t0 * 256 + head * 64; dstride = 256;
                mode = seg == 1 ? 1 : 0;
            } else {
                const int c2 = cb - 2192;
                if (c2 < 384) { dstb = (bf16_t*)(p.ws + WS_GQQ) + (size_t)t0 * 384 + (c2 / 64) * 64; dstride = 384; mode = 2; }
                else if (c2 < 512) { const int head = (c2 - 384) / 64; dstb = (bf16_t*)(p.ws + WS_GQK) + (size_t)t0 * 128 + head * 64; dstride = 128; mode = 3;
                                     if (isP) { f32out = 1; fbase = O_GQK; fhead = head; fheads = GQKV; } }
                else { const int head = (c2 - 512) / 64; dstb = (bf16_t*)(p.ws + WS_GQV) + (size_t)t0 * 128 + head * 64; dstride = 128;
                       if (isP) { f32out = 1; fbase = O_GQV; fhead = head; fheads = GQKV; } }
            }
#pragma unroll
            for (int tt = 0; tt < 2; ++tt) {
                const int t = t0 + tt * 32 + l31;
                f16v v0 = acc[0][tt], v1 = acc[1][tt];
                if (mode == 1) { v0 *= ATT_SCALE; v1 *= ATT_SCALE; }
                if (mode >= 2) {
                    float ss = 0.f;
#pragma unroll
                    for (int r = 0; r < 16; ++r) ss += v0[r] * v0[r] + v1[r] * v1[r];
                    ss += __shfl_xor(ss, 32);
                    const float rn = 1.f / sqrtf(ss * (1.f / 64.f) + EPS);
                    const float* gq = p.in[I_QKG] + ((size_t)l * 2 + (mode == 2 ? 0 : 1)) * 64;
#pragma unroll
                    for (int r = 0; r < 16; ++r) {
                        const int d = (r & 3) + 8 * (r >> 2) + 4 * h;
                        v0[r] *= rn * gq[d]; v1[r] *= rn * gq[32 + d];
                    }
                }
                if (f32out) { const int bP = t / SEQ, sP = t % SEQ; store_head_f32(p.out + fbase + ((((size_t)bP * DEPTH + l) * SEQ + sP) * fheads + fhead) * 64, v0, v1, h); }
                if (mode >= 2 && !isP) {
                    const int pos = (t - NP) % DEC_SEQ, prow = pos / GRIDW, pcol = pos % GRIDW;
#pragma unroll
                    for (int rr = 0; rr < 8; ++rr) {
                        const int fi = (rr & 3) + 8 * ((rr >> 2) & 1) + 4 * h;
                        const float c0 = rope[(prow * 16 + fi) * 2], s0 = rope[(prow * 16 + fi) * 2 + 1];
                        const float c1 = rope[(pcol * 16 + fi) * 2], s1 = rope[(pcol * 16 + fi) * 2 + 1];
                        const float a_lo = v0[rr], a_hi = v0[rr + 8]; v0[rr] = a_lo * c0 - a_hi * s0; v0[rr + 8] = a_hi * c0 + a_lo * s0;
                        const float b_lo = v1[rr], b_hi = v1[rr + 8]; v1[rr] = b_lo * c1 - b_hi * s1; v1[rr + 8] = b_hi * c1 + b_lo * s1;
                    }
                }
                stage64_write_bf16(stg, tt, v0, v1, l31, h);
            }
            stage64_flush_bf16(stg, dstb, dstride, lane);
        });
    }
}

template <int VAR>
DEV void phase_outproj(const Params& p, char* smem, int l) {
    constexpr int NC = D / 128, NU = (NT / 256) * NC;
    const int tid = get_tid(), lane = tid & 63, wave = tid >> 6, wm = wave & 3, wn = wave >> 2, h = lane >> 5, l31 = lane & 31;
    const bf16_t* mixed = (const bf16_t*)(p.ws + WS_MIXED);
    const float* mods = (const float*)(p.ws + WS_MODS);
    float* U = (float*)(p.ws + WS_U);
    constexpr int NMB = NT / 256, RPX = (NMB % 8 == 0) ? NMB / 8 : NMB;
    const UnitIter it = unit_iter(NU);
    for (int u = it.i; u < it.end; u += it.step) {
        const int mb = (u / (RPX * NC)) * RPX + u % RPX, cbk = (u / RPX) % NC;
        const unsigned ao = ((unsigned)(mb * 256 + (tid >> 3)) * MIXW + (tid & 7) * 8) * 2;
        const unsigned bvo = (unsigned)(cbk * 128 + 4 * (tid & 31)) * 4 + (unsigned)(tid >> 5) * (D * 4);
        const unsigned blds = (unsigned)(tid >> 5) * 320u + (unsigned)(tid & 31) * 8u;
        gemm_tile<2, VAR>(smem, make_rsrc(mixed), ao, ao + 128u * MIXW, ao + 256u * MIXW, ao + 384u * MIXW, make_rsrc(p.in[I_WOUT] + (size_t)l * MIXW * D), bvo, blds, D * 4, MIXW, [&](f16v (&acc)[2][2]) {
            int lane_e = lane; VGPR_PIN(lane_e); const int lane = lane_e, l31 = lane_e & 31, h = lane_e >> 5; (void)l31; (void)h;
            char* stg = wave_stage_ptr(smem, wave);
            const int t0 = mb * 256 + wm * 64;
            const float* g1 = mods + ((size_t)l * NCOND + tok_cond(t0)) * 6 * D + 2 * D;
#pragma unroll
            for (int ft = 0; ft < 2; ++ft) {
#pragma unroll
                for (int tt = 0; tt < 2; ++tt)
#pragma unroll
                    for (int g = 0; g < 4; ++g) { f4v o; o[0] = acc[ft][tt][4 * g]; o[1] = acc[ft][tt][4 * g + 1]; o[2] = acc[ft][tt][4 * g + 2]; o[3] = acc[ft][tt][4 * g + 3];
                        *(f4v*)(stg + (tt * 32 + l31) * LROW + (8 * g + 4 * h) * 4) = o; }
                WAVE_SYNC();
                const int f0 = cbk * 128 + wn * 64 + ft * 32 + (lane & 7) * 4;
                const f4v gv = *(const f4v*)(g1 + f0);
#pragma unroll
                for (int i = 0; i < 8; ++i) {
                    const int r = (lane >> 3) + 8 * i, t = t0 + r;
                    const f4v a = *(const f4v*)(stg + r * LROW + (lane & 7) * 16);
                    const float* xr = (l == 0) ? (t < NP ? p.in[I_XP] + (size_t)t * D : p.in[I_XS] + (size_t)(t - NP) * D) : (const float*)(p.ws + WS_XBUF) + (size_t)t * D;
                    const f4v xv = *(const f4v*)(xr + f0);
                    f4v o;
#pragma unroll
                    for (int q = 0; q < 4; ++q) o[q] = ALPHA * xv[q] + gv[q] * a[q];
                    *(f4v*)(U + (size_t)t * D + f0) = o;
                }
                WAVE_SYNC();
            }
        });
    }
}

template <int VAR>
DEV void phase_gateup(const Params& p, char* smem, int l) {
    constexpr int NRB = SLOTS / 256, NCB = EH / 128, NU = NEXP * NCB * NRB;
    const int tid = get_tid(), lane = tid & 63, wave = tid >> 6, wm = wave & 3, wn = wave >> 2, h = lane >> 5, l31 = lane & 31;
    const bf16_t* h2 = (const bf16_t*)(p.ws + WS_H2);
    const int* idx = (const int*)(p.ws + WS_IDX);
    bf16_t* hid = (bf16_t*)(p.ws + WS_HID);
    const UnitIter it = unit_iter(NU);
    for (int u = it.i; u < it.end; u += it.step) {
        const int rb = u % NRB, cbk = (u / NRB) % NCB, e = u / (NRB * NCB);
        const int* ip = idx + e * SLOTS + rb * 256 + (tid >> 3);
        const unsigned a0 = ((unsigned)ip[0] * D + (tid & 7) * 8) * 2, a1 = ((unsigned)ip[64] * D + (tid & 7) * 8) * 2;
        const unsigned a2 = ((unsigned)ip[128] * D + (tid & 7) * 8) * 2, a3 = ((unsigned)ip[192] * D + (tid & 7) * 8) * 2;
#ifdef EMU
        const int bw = tid >> 6;
#else
        const int bw = __builtin_amdgcn_readfirstlane(tid >> 6);
#endif
        const int is_up = bw & 1, bkr = 2 * (bw >> 1) + ((tid >> 5) & 1), hc = 4 * (tid & 31);
        const int ncol = (hc >> 6) * 128 + (2 * ((hc >> 5) & 1) + is_up) * 32 + (hc & 31);
        const unsigned bvo = (unsigned)(cbk * 128 + hc) * 4 + (unsigned)bkr * (EH * 4);
        const unsigned blds = (unsigned)bkr * 576u + (unsigned)ncol * 2u;
        const float* wmat = (is_up ? p.in[I_WU] : p.in[I_WG]) + ((size_t)l * NEXP + e) * D * EH;
        gemm_tile<4, VAR>(smem, make_rsrc(h2), a0, a1, a2, a3, make_rsrc(wmat), bvo, blds, EH * 4, D, [&](f16v (&acc)[4][2]) {
            int lane_e = lane; VGPR_PIN(lane_e); const int lane = lane_e, l31 = lane_e & 31, h = lane_e >> 5; (void)l31; (void)h;
            char* stg = wave_stage_ptr(smem, wave);
#pragma unroll
            for (int tt = 0; tt < 2; ++tt)
#pragma unroll
                for (int pr = 0; pr < 2; ++pr)
#pragma unroll
                    for (int g = 0; g < 4; ++g) {
                        float o[4];
#pragma unroll
                        for (int q = 0; q < 4; ++q) o[q] = siluf_(acc[2 * pr][tt][4 * g + q]) * acc[2 * pr + 1][tt][4 * g + q];
                        stage64_write4(stg, tt * 32 + l31, pr * 32 + 8 * g + 4 * h, o[0], o[1], o[2], o[3]);
                    }
            stage64_flush_bf16(stg, hid + ((size_t)e * SLOTS + rb * 256 + wm * 64) * EH + cbk * 128 + wn * 64, EH, lane);
        });
    }
}

template <int VAR>
DEV void phase_down(const Params& p, char* smem, int l) {
    constexpr int NRB = SLOTS / 256, NCB = D / 256, NU = NEXP * NCB * NRB;
    const int tid = get_tid(), lane = tid & 63, wave = tid >> 6, wm = wave & 3, wn = wave >> 2, h = lane >> 5, l31 = lane & 31;
    const bf16_t* hid = (const bf16_t*)(p.ws + WS_HID);
    const float* gsel = (const float*)(p.ws + WS_GSEL);
    bf16_t* ye = (bf16_t*)(p.ws + WS_YE);
    const UnitIter it = unit_iter(NU);
    for (int u = it.i; u < it.end; u += it.step) {
        const int rb = u % NRB, cbk = (u / NRB) % NCB, e = u / (NRB * NCB);
        const unsigned ao = ((unsigned)(rb * 256 + (tid >> 3)) * EH + (tid & 7) * 8) * 2;
        const unsigned bvo = (unsigned)(cbk * 256 + 4 * (tid & 63)) * 4 + (unsigned)(tid >> 6) * (D * 4);
        const unsigned blds = (unsigned)(tid >> 6) * 576u + (unsigned)(tid & 63) * 8u;
        gemm_tile<4, VAR>(smem, make_rsrc(hid + (size_t)e * SLOTS * EH), ao, ao + 128u * EH, ao + 256u * EH, ao + 384u * EH, make_rsrc(p.in[I_WD] + ((size_t)l * NEXP + e) * EH * D), bvo, blds, D * 4, EH, [&](f16v (&acc)[4][2]) {
            int lane_e = lane; VGPR_PIN(lane_e); const int lane = lane_e, l31 = lane_e & 31, h = lane_e >> 5; (void)l31; (void)h;
            char* stg = wave_stage_ptr(smem, wave);
            const float gs0 = gsel[e * SLOTS + rb * 256 + wm * 64 + l31], gs1 = gsel[e * SLOTS + rb * 256 + wm * 64 + 32 + l31];
#pragma unroll
            for (int hb = 0; hb < 2; ++hb) {
#pragma unroll
                for (int tt = 0; tt < 2; ++tt) {
                    const float gs = tt ? gs1 : gs0;
#pragma unroll
                    for (int f2 = 0; f2 < 2; ++f2)
#pragma unroll
                        for (int g = 0; g < 4; ++g) { const f16v& a = acc[2 * hb + f2][tt]; stage64_write4(stg, tt * 32 + l31, f2 * 32 + 8 * g + 4 * h, a[4 * g] * gs, a[4 * g + 1] * gs, a[4 * g + 2] * gs, a[4 * g + 3] * gs); }
                }
                stage64_flush_bf16(stg, ye + ((size_t)e * SLOTS + rb * 256 + wm * 64) * D + cbk * 256 + wn * 128 + hb * 64, D, lane);
            }
        });
    }
}

struct AttnDesc {
    const bf16_t* q; int qstride;
    int ntiles, n0;
    const bf16_t *k0, *v0; int stride0;
    const bf16_t *k1, *v1; int stride1;
    int na;
    int r0, rlo;
    const float* rpb;
    bf16_t* out; int ostride;
    float* part;
};
constexpr int ATT_TILE = 64 * LROW;
DEV int na_row_start(int r) { int s = r - KR / 2; s = s < 0 ? 0 : s; return s > ROWS - KR ? ROWS - KR : s; }
DEV void attn_unit(char* smem, const AttnDesc& d) {
    const int tid = get_tid(), lane = tid & 63, wave = tid >> 6, h = lane >> 5, l31 = lane & 31;
    char* Ks = smem; char* Vs = smem + 2 * ATT_TILE; float* rpbS = (float*)(smem + 4 * ATT_TILE);
    if (d.na) { for (int i = tid; i < 15 * 31; i += 512) rpbS[i] = d.rpb[i] * 1.4426950408889634f; }
    const bf16_t* qp = d.q + (size_t)(wave * 32 + l31) * d.qstride + h * 8;
    s8v qf[4];
#pragma unroll
    for (int s = 0; s < 4; ++s) qf[s] = *(const s8v*)(qp + 16 * s);
    float m_run = -1e30f, l_run = 0.f;
    f16v o[2]; o[0] = f16zero(); o[1] = f16zero();
    const int srow = tid >> 3, sch = tid & 7;
    u4v kreg, vreg;
    auto gload = [&](int t) {
        const bf16_t *kp, *vp;
        if (t < d.n0) { const size_t off = (size_t)(t * 64 + srow) * d.stride0 + sch * 8; kp = d.k0 + off; vp = d.v0 + off; }
        else { const size_t off = (size_t)((t - d.n0) * 64 + srow) * d.stride1 + sch * 8; kp = d.k1 + off; vp = d.v1 + off; }
        kreg = *(const u4v*)kp; vreg = *(const u4v*)vp;
    };
    auto lstore = [&](int buf) { *(u4v*)(Ks + buf * ATT_TILE + srow * LROW + sch * 16) = kreg; *(u4v*)(Vs + buf * ATT_TILE + srow * LROW + sch * 16) = vreg; };
    const int qr = d.r0 + (wave >> 1), qw = (wave & 1) * 32 + l31;
    const int rs = na_row_start(qr);
    int cs = qw - KC / 2; cs = cs < 0 ? 0 : (cs > GRIDW - KC ? GRIDW - KC : cs);
    gload(0); lstore(0);
    __syncthreads();
    for (int t = 0; t < d.ntiles; ++t) {
        const int buf = t & 1;
        if (t + 1 < d.ntiles) gload(t + 1);
        const bool local = d.na && t >= d.n0;
        const int kr = d.rlo + (t - d.n0);
        const bool active = !local || (kr >= rs && kr < rs + KR);
        if (active) {
            const char* kb = Ks + buf * ATT_TILE + l31 * LROW + h * 16;
            f16v sa[2];
#pragma unroll
            for (int kt = 0; kt < 2; ++kt) {
                sa[kt] = f16zero();
#pragma unroll
                for (int s = 0; s < 4; ++s) { const s8v kf = *(const s8v*)(kb + kt * 32 * LROW + s * 32); sa[kt] = mfma32(kf, qf[s], sa[kt]); }
            }
            constexpr float C2 = ATT_SCALE * 1.4426950408889634f;
            float mx = -1e30f;
            if (local) {
#pragma unroll
                for (int kt = 0; kt < 2; ++kt)
#pragma unroll
                    for (int r = 0; r < 16; ++r) {
                        const int kc = kt * 32 + (r & 3) + 8 * (r >> 2) + 4 * h;
                        const bool inw = kc >= cs && kc < cs + KC;
                        const int bi = (kr - qr + 7) * 31 + (kc - qw + 15);
                        const float v = inw ? sa[kt][r] * C2 + rpbS[inw ? bi : 0] : -1e30f;
                        sa[kt][r] = v; mx = fmaxf(mx, v);
                    }
            } else {
#pragma unroll
                for (int kt = 0; kt < 2; ++kt)
#pragma unroll
                    for (int r = 0; r < 16; ++r) mx = fmaxf(mx, sa[kt][r]);
                mx *= C2;
            }
            mx = fmaxf(mx, __shfl_xor(mx, 32));
            if (__ballot(mx > m_run) != 0ull) {
                const float m_new = fmaxf(m_run, mx);
                const float alpha = fexp2(m_run - m_new);
                l_run *= alpha; m_run = m_new;
                o[0] *= alpha; o[1] *= alpha;
            }
            float ps = 0.f;
            if (local) {
#pragma unroll
                for (int kt = 0; kt < 2; ++kt)
#pragma unroll
                    for (int r = 0; r < 16; ++r) { const float pv = fexp2(sa[kt][r] - m_run); sa[kt][r] = pv; ps += pv; }
            } else {
#pragma unroll
                for (int kt = 0; kt < 2; ++kt)
#pragma unroll
                    for (int r = 0; r < 16; ++r) { const float pv = fexp2(sa[kt][r] * C2 - m_run); sa[kt][r] = pv; ps += pv; }
            }
            l_run += ps;
            const char* vb = Vs + buf * ATT_TILE + (4 * h + ((lane & 15) >> 2)) * LROW + (((lane >> 4) & 1) * 16 + 4 * (lane & 3)) * 2;
#pragma unroll
            for (int ks = 0; ks < 4; ++ks) {
                const int kt = ks >> 1, rb = 8 * (ks & 1);
                u4v pk; pk[0] = pack2(sa[kt][rb], sa[kt][rb + 1]); pk[1] = pack2(sa[kt][rb + 2], sa[kt][rb + 3]);
                pk[2] = pack2(sa[kt][rb + 4], sa[kt][rb + 5]); pk[3] = pack2(sa[kt][rb + 6], sa[kt][rb + 7]);
                const s8v pf = __builtin_bit_cast(s8v, pk);
                const char* vk = vb + (kt * 32 + 16 * (ks & 1)) * LROW;
#pragma unroll
                for (int dt = 0; dt < 2; ++dt) {
                    const s4v lo = lds_tr16(vk + dt * 64), hi = lds_tr16(vk + 8 * LROW + dt * 64);
                    s8v vf; vf[0] = lo[0]; vf[1] = lo[1]; vf[2] = lo[2]; vf[3] = lo[3]; vf[4] = hi[0]; vf[5] = hi[1]; vf[6] = hi[2]; vf[7] = hi[3];
                    o[dt] = mfma32(vf, pf, o[dt]);
                }
            }
        }
        if (t + 1 < d.ntiles) lstore(buf ^ 1);
        __syncthreads();
    }
    const float l_tot = l_run + __shfl_xor(l_run, 32);
    const int qrow = wave * 32 + l31;
    if (d.part) {
        float* po = d.part + (size_t)qrow * 64;
#pragma unroll
        for (int dt = 0; dt < 2; ++dt)
#pragma unroll
            for (int g = 0; g < 4; ++g) { f4v v; v[0] = o[dt][4 * g]; v[1] = o[dt][4 * g + 1]; v[2] = o[dt][4 * g + 2]; v[3] = o[dt][4 * g + 3]; *(f4v*)(po + dt * 32 + 8 * g + 4 * h) = v; }
        if (h == 0) { d.part[256 * 64 + qrow] = m_run; d.part[256 * 64 + 256 + qrow] = l_tot; }
    } else {
        const float inv = 1.f / l_tot;
        bf16_t* po = d.out + (size_t)qrow * d.ostride;
#pragma unroll
        for (int dt = 0; dt < 2; ++dt)
#pragma unroll
            for (int g = 0; g < 4; ++g) {
                u2v pk; pk[0] = pack2(o[dt][4 * g] * inv, o[dt][4 * g + 1] * inv); pk[1] = pack2(o[dt][4 * g + 2] * inv, o[dt][4 * g + 3] * inv);
                *(u2v*)(po + dt * 32 + 8 * g + 4 * h) = pk;
            }
    }
}

DEV int ml_sidx(int grp, int b, int head, int c) { return grp == 0 ? ((b * MLH + head) * NCH_P + c) : BATCH * MLH * NCH_P + ((b * MLH + head) * NCH_S + c); }
DEV float lane_prefix_sum(float v, int lane) { for (int dlt = 1; dlt < 64; dlt <<= 1) { const float o = __shfl(v, lane - dlt); if (lane >= dlt) v += o; } return v; }
DEV float lane_prefix_max(float v, int lane) { for (int dlt = 1; dlt < 64; dlt <<= 1) { const float o = __shfl(v, lane - dlt); if (lane >= dlt) v = fmaxf(v, o); } return v; }

DEV void mlstm_summary_unit(const Params& p, char* smem, int grp, int b, int head, int c) {
    const int tid = get_tid(), lane = tid & 63, wave = tid >> 6, h = lane >> 5, l31 = lane & 31;
    char* KT = smem;
    char* VT = smem + 2 * ATT_TILE;
    float* wsS = (float*)(smem + 3 * ATT_TILE);
    float* scal = wsS + 128;
    const int tb = (grp == 0 ? b * SEQ : NP + b * DEC_SEQ) + c * 64;
    const float* gates = (const float*)(p.ws + WS_GATES);
    if (wave == 0) {
        const float* gr = gates + (size_t)(tb + lane) * 16;
        const float i_f = gr[head], lf_f = logsigmoidf_(gr[4 + head]), i_b = gr[8 + head], lf_b = logsigmoidf_(gr[12 + head]);
        const float pf = lane_prefix_sum(lf_f, lane), pb = lane_prefix_sum(lf_b, lane);
        const float tot_f = __shfl(pf, 63), tot_b = __shfl(pb, 63);
        const float g_f = (tot_f - pf) + i_f, g_b = (pb - lf_b) + i_b;
        const float G_f = wave_max(g_f), G_b = wave_max(g_b);
        wsS[lane] = expf(g_f - G_f); wsS[64 + lane] = expf(g_b - G_b);
        if (lane == 0) { scal[0] = tot_f; scal[1] = tot_b; scal[2] = G_f; scal[3] = G_b; }
    }
    __syncthreads();
    {
        const int tau = tid >> 3, ch = tid & 7;
        const u4v kv = *(const u4v*)((const bf16_t*)(p.ws + WS_MLK) + (size_t)(tb + tau) * 256 + head * 64 + ch * 8);
        const u4v vv = *(const u4v*)((const bf16_t*)(p.ws + WS_MLV) + (size_t)(tb + tau) * 256 + head * 64 + ch * 8);
        const float wf = wsS[tau], wb = wsS[64 + tau];
#pragma unroll
        for (int j = 0; j < 8; ++j) {
            const bf16_t kb = (bf16_t)(kv[j >> 1] >> (16 * (j & 1))), vb = (bf16_t)(vv[j >> 1] >> (16 * (j & 1)));
            const int dim = ch * 8 + j; const float kf = bf2f(kb);
            *(bf16_t*)(KT + dim * LROW + tau * 2) = f2bf(kf * wf);
            *(bf16_t*)(KT + ATT_TILE + dim * LROW + tau * 2) = f2bf(kf * wb);
            *(bf16_t*)(VT + dim * LROW + tau * 2) = vb;
        }
    }
    __syncthreads();
    float* sum = (float*)(p.ws + WS_MLSUM);
    const int sidx = ml_sidx(grp, b, head, c);
    {
        const int dir = wave >> 2, mi = (wave >> 1) & 1, ni = wave & 1;
        f16v acc = f16zero();
#pragma unroll
        for (int s = 0; s < 4; ++s) {
            const s8v af = *(const s8v*)(KT + dir * ATT_TILE + (mi * 32 + l31) * LROW + (16 * s + 8 * h) * 2);
            const s8v bf = *(const s8v*)(VT + (ni * 32 + l31) * LROW + (16 * s + 8 * h) * 2);
            acc = mfma32(af, bf, acc);
        }
        float* U = sum + (size_t)(sidx * 2 + dir) * MLSUM_STRIDE;
#pragma unroll
        for (int r = 0; r < 16; ++r) U[(mi * 32 + (r & 3) + 8 * (r >> 2) + 4 * h) * 64 + ni * 32 + l31] = acc[r];
    }
    if (tid < 128) {
        const int dir = tid >> 6, kd = tid & 63;
        float s = 0.f;
        for (int tau = 0; tau < 64; ++tau) s += bf2f(*(const bf16_t*)(KT + dir * ATT_TILE + kd * LROW + tau * 2));
        float* E = sum + (size_t)(sidx * 2 + dir) * MLSUM_STRIDE;
        E[4096 + kd] = s;
        if (kd == 0) { E[4160] = scal[dir]; E[4161] = scal[2 + dir]; }
    }
    __syncthreads();
}

DEV void mlstm_output_unit(const Params& p, char* smem, int l, int grp, int b, int head, int c) {
    const int tid = get_tid(), lane = tid & 63, wave = tid >> 6, h = lane >> 5, l31 = lane & 31;
    const int nc = grp ? NCH_S : NCH_P;
    char* Qs = smem;
    char* Ks = smem + 2 * ATT_TILE;
    char* VT = smem + 4 * ATT_TILE;
    char* CT = smem + 6 * ATT_TILE;
    char* QK = smem + 8 * ATT_TILE;
    float* hS = (float*)(smem + 10 * ATT_TILE);
    float* vec = hS + 2 * 64 * 68;
    float* aS = vec; float* MjS = vec + 128; float* bS = vec + 256; float* nS = vec + 384; float* denp = vec + 512; float* qnS = vec + 768; float* scal = vec + 896;
    const int tb = (grp == 0 ? b * SEQ : NP + b * DEC_SEQ) + c * 64;
    const float* sum = (const float*)(p.ws + WS_MLSUM);
#pragma unroll
    for (int dir = 0; dir < 2; ++dir) {
        float C[8], nst = 0.f, m;
        if (grp == 0) {
#pragma unroll
            for (int i = 0; i < 8; ++i) C[i] = 0.f;
            m = 0.f;
        } else {
            const size_t sb = (((size_t)b * DEPTH + l) * 2 + dir) * MLH + head;
#pragma unroll
            for (int i = 0; i < 8; ++i) C[i] = p.in[I_SC][sb * 4096 + tid + 512 * i];
            if (tid < 64) nst = p.in[I_SN][sb * 64 + tid];
            m = p.in[I_SM][sb];
        }
        const int nsteps = dir == 0 ? c : nc - 1 - c;
        const bool fin = (grp == 0) && (dir == 0 ? c == nc - 1 : c == 0);
        {
            float A = 0.f, G = -1e30f;
            if (lane < nsteps) { const float* E = sum + (size_t)(ml_sidx(grp, b, head, dir == 0 ? lane : nc - 1 - lane) * 2 + dir) * MLSUM_STRIDE; A = E[4160]; G = E[4161]; }
            const float P = lane_prefix_sum(A, lane);
            const float T = __shfl(P, 63);
            const float ev = lane < nsteps ? G + (T - P) : -1e30f;
            const float mc = fmaxf(m + T, wave_max(ev));
            const float coef = lane < nsteps ? expf(ev - mc) : 0.f;
            const float coef0 = expf(m + T - mc);
#pragma unroll
            for (int i = 0; i < 8; ++i) C[i] *= coef0;
            nst *= coef0;
#pragma unroll 4
            for (int st = 0; st < nsteps; ++st) {
                const float* E = sum + (size_t)(ml_sidx(grp, b, head, dir == 0 ? st : nc - 1 - st) * 2 + dir) * MLSUM_STRIDE;
                const float cf = __shfl(coef, st);
#pragma unroll
                for (int i = 0; i < 8; ++i) C[i] += cf * E[tid + 512 * i];
                if (tid < 64) nst += cf * E[4096 + tid];
            }
            m = mc;
        }
#pragma unroll
        for (int i = 0; i < 8; ++i) { const int e = tid + 512 * i; *(bf16_t*)(CT + dir * ATT_TILE + (e & 63) * LROW + (e >> 6) * 2) = f2bf(C[i]); }
        if (tid < 64) nS[dir * 64 + tid] = nst;
        if (tid == 0) scal[dir] = m;
        if (fin) {
            const float* E = sum + (size_t)(ml_sidx(grp, b, head, c) * 2 + dir) * MLSUM_STRIDE;
            const float A = E[4160], G = E[4161];
            const float m_new = fmaxf(A + m, G);
            const float sc = expf(A + m - m_new), su = expf(G - m_new);
            const size_t ob = (((size_t)b * DEPTH + l) * 2 + dir) * MLH + head;
#pragma unroll
            for (int i = 0; i < 8; ++i) p.out[O_MC + ob * 4096 + tid + 512 * i] = sc * C[i] + su * E[tid + 512 * i];
            if (tid < 64) p.out[O_MN + ob * 64 + tid] = sc * nst + su * E[4096 + tid];
            if (tid == 0) p.out[O_MM + ob] = m_new;
        }
    }
    {
        const int row = tid >> 3, ch = tid & 7;
#pragma unroll
        for (int dir = 0; dir < 2; ++dir) {
            const int tok = tb + (dir ? 63 - row : row);
            const size_t off = (size_t)tok * 256 + head * 64 + ch * 8;
            *(u4v*)(Qs + dir * ATT_TILE + row * LROW + ch * 16) = *(const u4v*)((const bf16_t*)(p.ws + WS_MLQ) + off);
            *(u4v*)(Ks + dir * ATT_TILE + row * LROW + ch * 16) = *(const u4v*)((const bf16_t*)(p.ws + WS_MLK) + off);
            const u4v vv = *(const u4v*)((const bf16_t*)(p.ws + WS_MLV) + off);
#pragma unroll
            for (int j = 0; j < 8; ++j) *(bf16_t*)(VT + dir * ATT_TILE + (ch * 8 + j) * LROW + row * 2) = (bf16_t)(vv[j >> 1] >> (16 * (j & 1)));
        }
    }
    __syncthreads();
    if (wave < 2) {
        const int dir = wave;
        const float* gr = (const float*)(p.ws + WS_GATES) + (size_t)(tb + (dir ? 63 - lane : lane)) * 16;
        const float ig = gr[dir * 8 + head], lf = logsigmoidf_(gr[dir * 8 + 4 + head]);
        const float bj = lane_prefix_sum(lf, lane);
        const float a = ig - bj;
        const float Pj = lane_prefix_max(a, lane);
        aS[dir * 64 + lane] = a; bS[dir * 64 + lane] = bj; MjS[dir * 64 + lane] = fmaxf(scal[dir], Pj);
    } else if (wave < 4) {
        const int dir = wave - 2;
        float s = 0.f;
        for (int k = 0; k < 64; ++k) s += bf2f(*(const bf16_t*)(Qs + dir * ATT_TILE + lane * LROW + k * 2)) * nS[dir * 64 + k];
        qnS[dir * 64 + lane] = s;
    }
    __syncthreads();
    const int dir = wave >> 2, rt = (wave >> 1) & 1, jt = wave & 1;
    const int j = jt * 32 + l31;
    const float Mj = MjS[dir * 64 + j];
    {
        f16v acc = f16zero();
#pragma unroll
        for (int s4 = 0; s4 < 4; ++s4) {
            const s8v af = *(const s8v*)(Ks + dir * ATT_TILE + (rt * 32 + l31) * LROW + (16 * s4 + 8 * h) * 2);
            const s8v bf = *(const s8v*)(Qs + dir * ATT_TILE + j * LROW + (16 * s4 + 8 * h) * 2);
            acc = mfma32(af, bf, acc);
        }
        float dsum = 0.f;
#pragma unroll
        for (int g = 0; g < 4; ++g) {
            float o[4];
#pragma unroll
            for (int q = 0; q < 4; ++q) {
                const int s = rt * 32 + 8 * g + 4 * h + q;
                const float w = s <= j ? expf(aS[dir * 64 + s] - Mj) : 0.f;
                o[q] = acc[4 * g + q] * w; dsum += o[q];
            }
            u2v pk; pk[0] = pack2(o[0], o[1]); pk[1] = pack2(o[2], o[3]);
            *(u2v*)(QK + dir * ATT_TILE + j * LROW + (rt * 32 + 8 * g + 4 * h) * 2) = pk;
        }
        dsum += __shfl_xor(dsum, 32);
        if (h == 0) denp[(dir * 2 + rt) * 64 + j] = dsum;
    }
    __syncthreads();
    {
        const float mst = scal[dir];
        const float decay = expf(mst - Mj);
        f16v acc = f16zero();
#pragma unroll
        for (int s4 = 0; s4 < 4; ++s4) {
            const s8v af = *(const s8v*)(CT + dir * ATT_TILE + (rt * 32 + l31) * LROW + (16 * s4 + 8 * h) * 2);
            const s8v bf = *(const s8v*)(Qs + dir * ATT_TILE + j * LROW + (16 * s4 + 8 * h) * 2);
            acc = mfma32(af, bf, acc);
        }
        acc *= decay;
#pragma unroll
        for (int s4 = 0; s4 < 4; ++s4) {
            const s8v af = *(const s8v*)(VT + dir * ATT_TILE + (rt * 32 + l31) * LROW + (16 * s4 + 8 * h) * 2);
            const s8v bf = *(const s8v*)(QK + dir * ATT_TILE + j * LROW + (16 * s4 + 8 * h) * 2);
            acc = mfma32(af, bf, acc);
        }
        const float den = decay * qnS[dir * 64 + j] + denp[(dir * 2) * 64 + j] + denp[(dir * 2 + 1) * 64 + j];
        const float dn = fmaxf(fabsf(den), expf(-(bS[dir * 64 + j] + Mj)));
        const float inv = 1.f / dn;
#pragma unroll
        for (int g = 0; g < 4; ++g) { f4v o; o[0] = acc[4 * g] * inv; o[1] = acc[4 * g + 1] * inv; o[2] = acc[4 * g + 2] * inv; o[3] = acc[4 * g + 3] * inv;
            *(f4v*)(hS + (dir * 64 + j) * 68 + rt * 32 + 8 * g + 4 * h) = o; }
    }
    __syncthreads();
    {
        const int tau = tid >> 3, v8 = (tid & 7) * 8;
        float hv[8]; float s = 0.f;
#pragma unroll
        for (int q = 0; q < 8; ++q) { hv[q] = hS[tau * 68 + v8 + q] + hS[(64 + 63 - tau) * 68 + v8 + q]; s += hv[q]; }
        s += __shfl_xor(s, 1); s += __shfl_xor(s, 2); s += __shfl_xor(s, 4);
        const float mu = s * (1.f / 64.f);
        float qq = 0.f;
#pragma unroll
        for (int q = 0; q < 8; ++q) { const float dlt = hv[q] - mu; qq += dlt * dlt; }
        qq += __shfl_xor(qq, 1); qq += __shfl_xor(qq, 2); qq += __shfl_xor(qq, 4);
        const float rstd = 1.f / sqrtf(qq * (1.f / 64.f) + EPS);
        const int t = tb + tau;
        const u4v ov = *(const u4v*)((const bf16_t*)(p.ws + WS_MLO) + (size_t)t * 256 + head * 64 + v8);
        const float* ng = p.in[I_MLG] + (size_t)l * 256 + head * 64 + v8;
        float o[8];
#pragma unroll
        for (int q = 0; q < 8; ++q) { const float og = bf2f((bf16_t)(ov[q >> 1] >> (16 * (q & 1)))); o[q] = (hv[q] - mu) * rstd * ng[q] * sigmoidf_(og); }
        u4v pk; pk[0] = pack2(o[0], o[1]); pk[1] = pack2(o[2], o[3]); pk[2] = pack2(o[4], o[5]); pk[3] = pack2(o[6], o[7]);
        *(u4v*)((bf16_t*)(p.ws + WS_MIXED) + (size_t)t * MIXW + 384 + head * 64 + v8) = pk;
    }
    __syncthreads();
}

DEV int queue_next(const Params& p, char* smem, int qi) {
    int* slot = (int*)(smem + SMEM_XB + 32);
    __syncthreads();
    if (threadIdx.x == 0) {
#ifdef EMU
        unsigned* w = (unsigned*)(p.ws + WS_BAR) + QUEUE_WORD0 + 64 * qi; *slot = (int)(*w)++;
#else
        *slot = (int)__hip_atomic_fetch_add((unsigned*)(p.ws + WS_BAR) + QUEUE_WORD0 + 64 * qi, 1u, __ATOMIC_RELAXED, __HIP_MEMORY_SCOPE_AGENT);
#endif
    }
    __syncthreads();
    return *slot;
}
DEV void phase_attn(const Params& p, char* smem, int l, int qi) {
    constexpr int QB_S = DEC_SEQ / 256, QB_P = SEQ / 256;
    constexpr int U_SG = DEC_BATCH * GQH * QB_S * 2, U_SN = DEC_BATCH * NAH * QB_S, U_PN = BATCH * NAH * QB_P, U_PG = BATCH * GQH * QB_P;
    constexpr int U_MP = BATCH * MLH * NCH_P, U_MS = DEC_BATCH * MLH * NCH_S;
    constexpr int NU = U_SG + U_SN + U_PN + U_PG + U_MP + U_MS;
    const bf16_t* naq = (const bf16_t*)(p.ws + WS_NAQ); const bf16_t* nak = (const bf16_t*)(p.ws + WS_NAK); const bf16_t* nav = (const bf16_t*)(p.ws + WS_NAV);
    const bf16_t* gqq = (const bf16_t*)(p.ws + WS_GQQ); const bf16_t* gqk = (const bf16_t*)(p.ws + WS_GQK); const bf16_t* gqv = (const bf16_t*)(p.ws + WS_GQV);
    bf16_t* mixed = (bf16_t*)(p.ws + WS_MIXED);
    for (;;) {
        int u = queue_next(p, smem, qi);
        if (u >= NU) break;
        AttnDesc d; d.na = 0; d.r0 = 0; d.rlo = 0; d.rpb = nullptr; d.part = nullptr; d.out = nullptr; d.ostride = MIXW; d.n0 = 0; d.k0 = d.v0 = nullptr; d.stride0 = 0;
        if (u < U_SG) {
            const int half = u & 1, qb = (u >> 1) % QB_S, qh = (u / (2 * QB_S)) % GQH, b = u / (2 * QB_S * GQH);
            const int kvh = qh / (GQH / GQKV);
            constexpr int NCT = PAST / 64, TT = NCT + DEC_SEQ / 64, H0 = TT / 2;
            const size_t tq = (size_t)NP + (size_t)b * DEC_SEQ + qb * 256;
            d.q = gqq + tq * 384 + qh * 64; d.qstride = 384;
            const bf16_t* lk = gqk + ((size_t)NP + (size_t)b * DEC_SEQ) * 128 + kvh * 64; const bf16_t* lv = gqv + ((size_t)NP + (size_t)b * DEC_SEQ) * 128 + kvh * 64;
            if (half == 0) {
                d.n0 = NCT; d.ntiles = H0; d.stride0 = 128;
                const size_t co = (((size_t)b * DEPTH + l) * PAST) * 128 + kvh * 64;
                d.k0 = (const bf16_t*)(p.ws + WS_CGQK) + co; d.v0 = (const bf16_t*)(p.ws + WS_CGQV) + co;
                d.k1 = lk; d.v1 = lv; d.stride1 = 128;
            } else {
                d.n0 = 0; d.ntiles = TT - H0; d.stride1 = 128;
                d.k1 = lk + (size_t)(H0 - NCT) * 64 * 128; d.v1 = lv + (size_t)(H0 - NCT) * 64 * 128;
            }
            d.part = (float*)(p.ws + WS_PART) + (size_t)u * PART_STRIDE;
        } else if (u < U_SG + U_SN) {
            const int uu = u - U_SG; const int qb = uu % QB_S, hd = (uu / QB_S) % NAH, b = uu / (QB_S * NAH);
            const size_t t0 = (size_t)NP + (size_t)b * DEC_SEQ;
            d.q = naq + (t0 + qb * 256) * 384 + hd * 64; d.qstride = 384;
            d.na = 1; d.r0 = qb * 4; d.rlo = na_row_start(d.r0);
            const int rhi = na_row_start(d.r0 + 3) + KR;
            d.n0 = PAST / 64; d.ntiles = d.n0 + (rhi - d.rlo); d.stride0 = 384; d.stride1 = 384;
            const size_t co = (((size_t)b * DEPTH + l) * PAST) * 384 + hd * 64;
            d.k0 = (const bf16_t*)(p.ws + WS_CNAK) + co; d.v0 = (const bf16_t*)(p.ws + WS_CNAV) + co;
            d.k1 = nak + (t0 + (size_t)d.rlo * 64) * 384 + hd * 64; d.v1 = nav + (t0 + (size_t)d.rlo * 64) * 384 + hd * 64;
            d.rpb = p.in[I_RPB] + ((size_t)l * NAH + hd) * 15 * 31;
            d.out = mixed + (t0 + qb * 256) * MIXW + hd * 64;
        } else if (u < U_SG + U_SN + U_PN) {
            const int uu = u - U_SG - U_SN; const int qb = uu % QB_P, hd = (uu / QB_P) % NAH, b = uu / (QB_P * NAH);
            const size_t t0 = (size_t)b * SEQ;
            d.q = naq + (t0 + qb * 256) * 384 + hd * 64; d.qstride = 384;
            d.n0 = 0; d.ntiles = SEQ / 64; d.stride1 = 384; d.k1 = nak + t0 * 384 + hd * 64; d.v1 = nav + t0 * 384 + hd * 64;
            d.out = mixed + (t0 + qb * 256) * MIXW + hd * 64;
        } else if (u < U_SG + U_SN + U_PN + U_PG) {
            const int uu = u - U_SG - U_SN - U_PN; const int qb = uu % QB_P, qh = (uu / QB_P) % GQH, b = uu / (QB_P * GQH);
            const int kvh = qh / (GQH / GQKV);
            const size_t t0 = (size_t)b * SEQ;
            d.q = gqq + (t0 + qb * 256) * 384 + qh * 64; d.qstride = 384;
            d.n0 = 0; d.ntiles = SEQ / 64; d.stride1 = 128; d.k1 = gqk + t0 * 128 + kvh * 64; d.v1 = gqv + t0 * 128 + kvh * 64;
            d.out = mixed + (t0 + qb * 256) * MIXW + 640 + qh * 64;
        } else {
            int uu = u - (U_SG + U_SN + U_PN + U_PG); const int grp = uu >= U_MP ? 1 : 0; if (grp) uu -= U_MP;
            const int nch = grp ? NCH_S : NCH_P;
            mlstm_summary_unit(p, smem, grp, uu / (nch * MLH), (uu / nch) % MLH, uu % nch);
        }
        if (u < U_SG + U_SN + U_PN + U_PG) attn_unit(smem, d);
    }
}

DEV void phase_mlout(const Params& p, char* smem, int l) {
    constexpr int QB_S = DEC_SEQ / 256;
    constexpr int U_MS = DEC_BATCH * MLH * NCH_S, U_MP = BATCH * MLH * NCH_P, U_CB = DEC_BATCH * GQH * QB_S;
    const int tid = get_tid();
    for (int u = blockIdx.x; u < U_MS + U_MP + U_CB; u += gridDim.x) {
        if (u < U_MS + U_MP) { const int grp = u < U_MS ? 1 : 0; const int uu = grp ? u : u - U_MS; const int nch = grp ? NCH_S : NCH_P;
            mlstm_output_unit(p, smem, l, grp, uu / (nch * MLH), (uu / nch) % MLH, uu % nch); }
        else {
            const int uu = u - U_MS - U_MP; const int qb = uu % QB_S, qh = (uu / QB_S) % GQH, b = uu / (QB_S * GQH);
            const float* p0 = (const float*)(p.ws + WS_PART) + (size_t)(2 * uu) * PART_STRIDE; const float* p1 = p0 + PART_STRIDE;
            const int q = tid >> 1, d0 = (tid & 1) * 32;
            const float m0 = p0[256 * 64 + q], m1 = p1[256 * 64 + q], l0 = p0[256 * 64 + 256 + q], l1 = p1[256 * 64 + 256 + q];
            const float m = fmaxf(m0, m1), w0 = exp2f(m0 - m), w1 = exp2f(m1 - m);
            const float inv = 1.f / (l0 * w0 + l1 * w1);
            bf16_t* dst = (bf16_t*)(p.ws + WS_MIXED) + ((size_t)NP + (size_t)b * DEC_SEQ + qb * 256 + q) * MIXW + 640 + qh * 64 + d0;
#pragma unroll
            for (int i = 0; i < 8; ++i) {
                const f4v a = *(const f4v*)(p0 + (size_t)q * 64 + d0 + 4 * i), bb = *(const f4v*)(p1 + (size_t)q * 64 + d0 + 4 * i);
                u2v pk; pk[0] = pack2((a[0] * w0 + bb[0] * w1) * inv, (a[1] * w0 + bb[1] * w1) * inv); pk[1] = pack2((a[2] * w0 + bb[2] * w1) * inv, (a[3] * w0 + bb[3] * w1) * inv);
                *(u2v*)(dst + 4 * i) = pk;
            }
        }
    }
}

constexpr int N_PHASES = 2 + 9 * DEPTH;
#ifndef EMU
typedef const __attribute__((address_space(4))) Params* KParamsPtr;
DEV void load_params(Params& p) {
    KParamsPtr kp = (KParamsPtr)__builtin_amdgcn_kernarg_segment_ptr();
    asm volatile("" : "+s"(kp));
#pragma unroll
    for (int i = 0; i < N_IN; ++i) p.in[i] = kp->in[i];
    p.out = kp->out; p.ws = kp->ws; p.ph0 = kp->ph0; p.ph1 = kp->ph1;
}
#endif
#ifdef EMU
static char emu_smem[SMEM_BYTES + 64];
#endif
__global__ void __launch_bounds__(512, 2) mega_kernel(Params p_) {
    const int ph0 = p_.ph0, ph1 = p_.ph1;
#ifdef EMU
    char* smem = emu_smem;
#define GRID_SYNC() do {} while (0)
#else
    extern __shared__ __attribute__((aligned(16))) char smem[];
    if (threadIdx.x == 0) *(u4v*)(smem + SMEM_XB) = (u4v){0u, 0u, 0u, 0u};
    __syncthreads();
    (void)xcd_barrier_post((unsigned*)(p_.ws + WS_BAR), (volatile LAS unsigned*)(smem + SMEM_XB));
    const bool multi = (ph1 - ph0) > 1;
#define GRID_SYNC() do { if (multi) { KParamsPtr kpb = (KParamsPtr)__builtin_amdgcn_kernarg_segment_ptr(); asm volatile("" : "+s"(kpb)); \
        XcdBarrier xb; xb.bar = (unsigned*)(kpb->ws + WS_BAR); xb.x = xb_xcc_id(); xb.st = (volatile LAS unsigned*)(smem + SMEM_XB); xcd_barrier(xb); } } while (0)
#endif
    int ph = 0;
#ifndef KIND_MASK
#define KIND_MASK 0x3ff
#endif
#ifdef EMU
#define LOAD_PARAMS() const Params& p = p_
#else
#define LOAD_PARAMS() Params p; load_params(p)
#endif
#ifndef DOUBLE_MASK
#define DOUBLE_MASK 0
#endif
#define PH_KIND() (ph == 0 ? 0 : ph == 1 + 9 * DEPTH ? 1 : 1 + (ph - 1) % 9)
#define RUN_PHASE(body) do { if (((KIND_MASK >> PH_KIND()) & 1) && ph >= ph0 && ph < ph1) { \
    if (DOUBLE_MASK && ((DOUBLE_MASK >> PH_KIND()) & 1)) { { const int rep_ = 1; LOAD_PARAMS(); body; } GRID_SYNC(); } \
    { const int rep_ = 0; LOAD_PARAMS(); body; } if (ph + 1 < ph1) GRID_SYNC(); } ++ph; } while (0)
    RUN_PHASE(phase_ada(p, smem));
    for (int l = 0; l < DEPTH; ++l) {
        RUN_PHASE(phase_rows<0>(p, smem, l));
        RUN_PHASE(phase_inproj<0>(p, smem, l));
        RUN_PHASE(phase_attn(p, smem, l, l + DEPTH * rep_));
        RUN_PHASE(phase_mlout(p, smem, l));
        RUN_PHASE(phase_outproj<0>(p, smem, l));
        RUN_PHASE(phase_rows<1>(p, smem, l));
        RUN_PHASE(phase_topk(p, smem));
        RUN_PHASE(phase_gateup<0>(p, smem, l));
        RUN_PHASE(phase_down<0>(p, smem, l));
    }
    RUN_PHASE(phase_rows<0>(p, smem, DEPTH));
}

#if !defined(EMU) && defined(PROBE_KIND)
__global__ void __launch_bounds__(512, 2) probe_kernel(Params p) {
    extern __shared__ __attribute__((aligned(16))) char smem[];
    for (int r = 0; r < PROBE_REPS; ++r) {
#if PROBE_KIND == 8
        phase_gateup<PROBE_VAR>(p, smem, 1);
#elif PROBE_KIND == 9
        phase_down<PROBE_VAR>(p, smem, 1);
#elif PROBE_KIND == 2
        phase_inproj<PROBE_VAR>(p, smem, 1);
#elif PROBE_KIND == 5
        phase_outproj<PROBE_VAR>(p, smem, 1);
#elif PROBE_KIND == 0
        phase_ada(p, smem);
#elif PROBE_KIND == 1
        phase_rows<0>(p, smem, 1);
#elif PROBE_KIND == 6
        phase_rows<1>(p, smem, 1);
#elif PROBE_KIND == 7
        phase_topk(p, smem);
#elif PROBE_KIND == 3
        phase_attn(p, smem, 1, 8 + r);
#elif PROBE_KIND == 4
        phase_mlout(p, smem, 1);
#endif
        __syncthreads();
    }
}
#endif
#ifndef EMU
#ifndef MK_N_LAUNCHES
#define MK_N_LAUNCHES 1
#endif
extern "C" void kernel_launch(void* const* d_in, const int* in_sizes, int n_in, void* d_out, int out_size, void* d_ws, size_t ws_size, hipStream_t stream) {
    (void)in_sizes; (void)n_in; (void)out_size; (void)ws_size;
    static int grid = 0;
    if (!grid) {
        int dev = 0, cus = 0, per_cu = 0;
        (void)hipGetDevice(&dev);
        (void)hipDeviceGetAttribute(&cus, hipDeviceAttributeMultiprocessorCount, dev);
        (void)hipFuncSetAttribute((const void*)mega_kernel, hipFuncAttributeMaxDynamicSharedMemorySize, SMEM_BYTES);
        (void)hipOccupancyMaxActiveBlocksPerMultiprocessor(&per_cu, mega_kernel, 512, SMEM_BYTES);
        grid = cus * (per_cu < 1 ? per_cu : 1);
        if (grid <= 0) grid = cus;
    }
    (void)hipMemsetAsync((char*)d_ws + WS_BAR, 0, WS_BAR_BYTES, stream);
    Params p = {};
    for (int i = 0; i < N_IN; ++i) p.in[i] = (const float*)d_in[i];
    p.out = (float*)d_out; p.ws = (char*)d_ws;
#if MK_N_LAUNCHES == 1
    p.ph0 = 0; p.ph1 = N_PHASES;
    mega_kernel<<<dim3(grid), dim3(512), SMEM_BYTES, stream>>>(p);
#ifdef PROBE_KIND
    (void)hipFuncSetAttribute((const void*)probe_kernel, hipFuncAttributeMaxDynamicSharedMemorySize, SMEM_BYTES);
    probe_kernel<<<dim3(grid), dim3(512), SMEM_BYTES, stream>>>(p);
#endif
#else
    for (int ph = 0; ph < N_PHASES; ++ph) { p.ph0 = ph; p.ph1 = ph + 1; mega_kernel<<<dim3(grid), dim3(512), SMEM_BYTES, stream>>>(p); }
#endif
}
#endif
```

```cpp
#ifndef EMU
#include <hip/hip_runtime.h>
#define DEV __device__ __forceinline__
#else
#define DEV static inline __attribute__((always_inline))
#endif
#include <stdint.h>
#include <stddef.h>

#ifndef CFG_D
#define CFG_D 1024
#define CFG_BATCH 16
#define CFG_SEQ 256
#define CFG_DEC_BATCH 2
#define CFG_DEC_SEQ 2048
#define CFG_PAST 256
#define CFG_EH 2816
#endif
constexpr int D = CFG_D, BATCH = CFG_BATCH, SEQ = CFG_SEQ, DEC_BATCH = CFG_DEC_BATCH, DEC_SEQ = CFG_DEC_SEQ, PAST = CFG_PAST, EH = CFG_EH;
constexpr int DEPTH = 2, HD = 64, NAH = 6, MLH = 4, GQH = 6, GQKV = 2, NEXP = 16, GRIDW = 64;
constexpr int NP = BATCH * SEQ, NS = DEC_BATCH * DEC_SEQ, NT = NP + NS, NCOND = 1 + DEC_BATCH;
constexpr int PROJ_W = 2832, MIXW = 1024;
constexpr int CAP_P = SEQ / 8, CAP_S = DEC_SEQ / 8, SLOTS = BATCH * CAP_P + DEC_BATCH * CAP_S;
constexpr int ROWS = DEC_SEQ / GRIDW, KR = ROWS < 8 ? ROWS : 8, KC = 16;
constexpr int NCH_P = SEQ / 64, NCH_S = DEC_SEQ / 64;
constexpr float ALPHA = 1.41421356237309515f;
constexpr float ATT_SCALE = 0.125f;
constexpr float EPS = 1e-6f;
static_assert(SLOTS % 256 == 0 && NP % 256 == 0 && NS % 256 == 0 && SEQ % 256 == 0 && DEC_SEQ % 256 == 0, "tile divisibility");
static_assert(D % 256 == 0 && EH % 128 == 0 && PAST % 64 == 0, "tile divisibility");

typedef unsigned short bf16_t;
typedef short s8v __attribute__((ext_vector_type(8)));
typedef short s4v __attribute__((ext_vector_type(4)));
typedef float f16v __attribute__((ext_vector_type(16)));
typedef float f4v __attribute__((ext_vector_type(4)));
typedef unsigned u4v __attribute__((ext_vector_type(4)));
typedef unsigned u2v __attribute__((ext_vector_type(2)));

enum { I_XP = 0, I_XS, I_C, I_CNAK, I_CNAV, I_CGQK, I_CGQV, I_SC, I_SN, I_SM, I_CCTX, I_ADAW, I_ADAB, I_WIN, I_BGATE, I_WOUT, I_RPB, I_QKG, I_MLG,
       I_LNG, I_LNB, I_RW, I_WG, I_WU, I_WD, N_IN };

constexpr size_t O_YP = 0;
constexpr size_t O_YS = O_YP + (size_t)NP * D;
constexpr size_t O_NAK = O_YS + (size_t)NS * D;
constexpr size_t O_NAV = O_NAK + (size_t)BATCH * DEPTH * SEQ * NAH * HD;
constexpr size_t O_GQK = O_NAV + (size_t)BATCH * DEPTH * SEQ * NAH * HD;
constexpr size_t O_GQV = O_GQK + (size_t)BATCH * DEPTH * SEQ * GQKV * HD;
constexpr size_t O_MC = O_GQV + (size_t)BATCH * DEPTH * SEQ * GQKV * HD;
constexpr size_t O_MN = O_MC + (size_t)BATCH * DEPTH * 2 * MLH * HD * HD;
constexpr size_t O_MM = O_MN + (size_t)BATCH * DEPTH * 2 * MLH * HD;
constexpr size_t O_END = O_MM + (size_t)BATCH * DEPTH * 2 * MLH;

constexpr size_t al256(size_t x) { return (x + 255) & ~(size_t)255; }
constexpr size_t WS_BAR = 0;
constexpr size_t WS_BAR_BYTES = 32768;
constexpr size_t WS_MODS = WS_BAR + WS_BAR_BYTES;
constexpr size_t WS_ROPE = al256(WS_MODS + (size_t)DEPTH * NCOND * 6 * D * 4);
constexpr size_t WS_CNAK = al256(WS_ROPE + 64 * 16 * 2 * 4);
constexpr size_t WS_CNAV = al256(WS_CNAK + (size_t)DEC_BATCH * DEPTH * PAST * NAH * HD * 2);
constexpr size_t WS_CGQK = al256(WS_CNAV + (size_t)DEC_BATCH * DEPTH * PAST * NAH * HD * 2);
constexpr size_t WS_CGQV = al256(WS_CGQK + (size_t)DEC_BATCH * DEPTH * PAST * GQKV * HD * 2);
constexpr size_t WS_XBUF = al256(WS_CGQV + (size_t)DEC_BATCH * DEPTH * PAST * GQKV * HD * 2);
constexpr size_t WS_HMOD = al256(WS_XBUF + (size_t)NT * D * 4);
constexpr size_t WS_GATES = al256(WS_HMOD + (size_t)NT * D * 2);
constexpr size_t WS_NAQ = al256(WS_GATES + (size_t)NT * 16 * 4);
constexpr size_t WS_NAK = al256(WS_NAQ + (size_t)NT * 384 * 2);
constexpr size_t WS_NAV = al256(WS_NAK + (size_t)NT * 384 * 2);
constexpr size_t WS_MLQ = al256(WS_NAV + (size_t)NT * 384 * 2);
constexpr size_t WS_MLK = al256(WS_MLQ + (size_t)NT * 256 * 2);
constexpr size_t WS_MLV = al256(WS_MLK + (size_t)NT * 256 * 2);
constexpr size_t WS_MLO = al256(WS_MLV + (size_t)NT * 256 * 2);
constexpr size_t WS_GQQ = al256(WS_MLO + (size_t)NT * 256 * 2);
constexpr size_t WS_GQK = al256(WS_GQQ + (size_t)NT * 384 * 2);
constexpr size_t WS_GQV = al256(WS_GQK + (size_t)NT * 128 * 2);
constexpr size_t WS_MIXED = al256(WS_GQV + (size_t)NT * 128 * 2);
constexpr size_t WS_U = al256(WS_MIXED + (size_t)NT * MIXW * 2);
constexpr size_t WS_X1 = al256(WS_U + (size_t)NT * D * 4);
constexpr size_t WS_H2 = al256(WS_X1 + (size_t)NT * D * 4);
constexpr size_t WS_AFF = al256(WS_H2 + (size_t)NT * D * 2);
constexpr size_t WS_IDX = al256(WS_AFF + (size_t)NT * 16 * 4);
constexpr size_t WS_GSEL = al256(WS_IDX + (size_t)NEXP * SLOTS * 4);
constexpr size_t WS_TOKSLOT = al256(WS_GSEL + (size_t)NEXP * SLOTS * 4);
constexpr size_t WS_HID = al256(WS_TOKSLOT + (size_t)NT * 16 * 4);
constexpr size_t WS_YE = al256(WS_HID + (size_t)NEXP * SLOTS * EH * 2);
constexpr int MLSUM_STRIDE = 4096 + 64 + 64;
constexpr int N_MLSUM = (BATCH * NCH_P + DEC_BATCH * NCH_S) * MLH * 2;
constexpr size_t WS_MLSUM = al256(WS_YE + (size_t)NEXP * SLOTS * D * 2);
constexpr int PART_STRIDE = 256 * 64 + 512;
constexpr int N_PART = DEC_BATCH * GQH * (DEC_SEQ / 256) * 2;
constexpr size_t WS_PART = al256(WS_MLSUM + (size_t)N_MLSUM * MLSUM_STRIDE * 4);
constexpr size_t WS_TOTAL = al256(WS_PART + (size_t)N_PART * PART_STRIDE * 4);

struct Params {
    const float* in[N_IN];
    float* out;
    char* ws;
    int ph0, ph1;
};

DEV float bf2f(bf16_t s) { unsigned u = ((unsigned)s) << 16; return __builtin_bit_cast(float, u); }
DEV bf16_t f2bf(float f) {
#ifdef EMU
    unsigned u = __builtin_bit_cast(unsigned, f); u += 0x7fffu + ((u >> 16) & 1u); return (bf16_t)(u >> 16);
#else
    return __builtin_bit_cast(bf16_t, (__bf16)f);
#endif
}
DEV unsigned pack2(float a, float b) {
#ifdef EMU
    return (unsigned)f2bf(a) | ((unsigned)f2bf(b) << 16);
#else
    typedef __bf16 b2 __attribute__((ext_vector_type(2))); b2 r; r[0] = (__bf16)a; r[1] = (__bf16)b; return __builtin_bit_cast(unsigned, r);
#endif
}
DEV float fexp(float x) {
#ifdef EMU
    return expf(x);
#else
    return __expf(x);
#endif
}
DEV float fexp2(float x) {
#ifdef EMU
    return exp2f(x);
#else
    return __builtin_amdgcn_exp2f(x);
#endif
}
DEV float frcp(float x) {
#ifdef EMU
    return 1.f / x;
#else
    return __builtin_amdgcn_rcpf(x);
#endif
}
DEV float sigmoidf_(float x) { return frcp(1.f + fexp(-x)); }
DEV float siluf_(float x) { return x * frcp(1.f + fexp(-x)); }
DEV float logsigmoidf_(float x) { return fminf(x, 0.f) - log1pf(expf(-fabsf(x))); }
DEV f16v mfma32(s8v a, s8v b, f16v c) {
#ifdef EMU
    return emu_mfma_32x32x16_bf16(a, b, c);
#else
    typedef __bf16 bf8 __attribute__((ext_vector_type(8)));
    return __builtin_amdgcn_mfma_f32_32x32x16_bf16(__builtin_bit_cast(bf8, a), __builtin_bit_cast(bf8, b), c, 0, 0, 0);
#endif
}
DEV s4v lds_tr16(const void* p) {
#ifdef EMU
    return emu_ds_read_tr16_b64(p);
#else
    typedef s4v __attribute__((address_space(3))) * lp;
    return __builtin_amdgcn_ds_read_tr16_b64_v4i16((lp)(p));
#endif
}
#ifdef EMU
DEV float wave_sum(float v) { for (int m = 32; m >= 1; m >>= 1) v += __shfl_xor(v, m); return v; }
#else
template <int CTRL, int RM> DEV float dpp_f(float v) { return __builtin_bit_cast(float, __builtin_amdgcn_update_dpp(0, __builtin_bit_cast(int, v), CTRL, RM, 0xF, false)); }
DEV float wave_sum(float v) {
    v += dpp_f<0xB1, 0xF>(v); v += dpp_f<0x4E, 0xF>(v); v += dpp_f<0x141, 0xF>(v); v += dpp_f<0x140, 0xF>(v);
    v += dpp_f<0x142, 0xA>(v); v += dpp_f<0x143, 0xC>(v);
    return __builtin_bit_cast(float, __builtin_amdgcn_readlane(__builtin_bit_cast(int, v), 63));
}
#endif
DEV float wave_max(float v) { for (int m = 32; m >= 1; m >>= 1) v = fmaxf(v, __shfl_xor(v, m)); return v; }
DEV f16v f16zero() { f16v z; for (int i = 0; i < 16; ++i) z[i] = 0.f; return z; }

#ifdef EMU
#define VGPR_PIN(x) do {} while (0)
#define SGPR_PIN(x) do {} while (0)
#define SCHED_FENCE() do {} while (0)
#define CFENCE() do {} while (0)
#else
#define SCHED_FENCE() __builtin_amdgcn_sched_barrier(0)
#define SGPR_PIN(x) asm volatile("" : "+s"(x))
#define VGPR_PIN(x) asm volatile("" : "+v"(x))
#define CFENCE() asm volatile("" ::: "memory")
#endif
#ifdef EMU
DEV int get_tid() { return (int)threadIdx.x; }
#else
DEV int get_tid() { int t = threadIdx.x; asm volatile("" : "+v"(t)); return t; }
#endif
struct UnitIter { int i, end, step; };
DEV UnitIter unit_iter(int NU) {
    const int G = (int)gridDim.x, b = (int)blockIdx.x;
    UnitIter it;
#ifndef XCD_MODE
#define XCD_MODE 0
#endif
    if ((G & 7) == 0 && (NU & 7) == 0) { const int W = G >> 3, x = XCD_MODE ? b / W : b & 7, j = XCD_MODE ? b % W : b >> 3, C = NU >> 3; it.i = x * C + j; it.end = (x + 1) * C; it.step = W; }
    else { it.i = b; it.end = NU; it.step = G; }
    return it;
}
DEV int tok_cond(int t) { return t < NP ? 0 : 1 + (t - NP) / DEC_SEQ; }

#ifndef EMU
#define XB_TMO      128
#define XB_XCNT(j)  (256  + 64 * (j))
#define XB_XSUB(j)  (1280 + 64 * (j))
#define XB_XGEN(j)  (2304 + 64 * (j))
#define XB_TOP      3328
#define XB_TOPGEN   3392
#define XCD_BAR_WORDS 3456
#define XB_SPIN_CAP (1u << 20)
#define LAS __attribute__((address_space(3)))
__device__ __forceinline__ unsigned xb_ld(unsigned* p)              { return __hip_atomic_load(p, __ATOMIC_RELAXED, __HIP_MEMORY_SCOPE_AGENT); }
__device__ __forceinline__ unsigned xb_add(unsigned* p, unsigned v) { return __hip_atomic_fetch_add(p, v, __ATOMIC_RELAXED, __HIP_MEMORY_SCOPE_AGENT); }
__device__ __forceinline__ unsigned xb_xcc_id() { return (unsigned)__builtin_amdgcn_s_getreg((3 << 11) | 20) & 0xFu; }
#define XB_SPIN(cond, bar) do { unsigned _sp = 0; while (cond) { __builtin_amdgcn_s_sleep(1); \
    if ((++_sp & 255u) == 0u) { if (xb_ld(&(bar)[XB_TMO])) break; if (_sp > XB_SPIN_CAP) { atomicAdd(&(bar)[XB_TMO], 1u); break; } } } } while (0)
struct XcdBarrier { unsigned* bar; unsigned x; volatile LAS unsigned* st; };
__device__ __forceinline__ XcdBarrier xcd_barrier_post(unsigned* bar, volatile LAS unsigned* st) {
    XcdBarrier b; b.bar = bar; b.x = xb_xcc_id(); b.st = st;
    if (threadIdx.x == 0) (void)xb_add(&bar[XB_XCNT(b.x)], 1u);
    return b;
}
__device__ __forceinline__ void xcd_barrier_complete(unsigned* bar, unsigned x, unsigned& nloc, unsigned& nx) {
    const unsigned G = gridDim.x * gridDim.y * gridDim.z;
    unsigned sum, cnt, mine, sp = 0u;
    for (;;) {
        sum = 0u; cnt = 0u; mine = 0u;
#pragma unroll
        for (unsigned j = 0; j < 16; ++j) { const unsigned c = xb_ld(&bar[XB_XCNT(j)]); sum += c; cnt += (c > 0u) ? 1u : 0u; mine = (j == x) ? c : mine; }
        if (sum == G) break;
        __builtin_amdgcn_s_sleep(1);
        if ((++sp & 255u) == 0u) { if (xb_ld(&bar[XB_TMO])) break; if (sp > XB_SPIN_CAP) { atomicAdd(&bar[XB_TMO], 1u); break; } }
    }
    nloc = mine > 0u ? mine : 1u; nx = cnt > 0u ? cnt : 1u;
}
__device__ __forceinline__ void xcd_barrier(const XcdBarrier& b) {
    asm volatile("s_waitcnt vmcnt(0)" ::: "memory");
    __syncthreads();
    if (threadIdx.x == 0) {
        unsigned* bar = b.bar;
        __builtin_amdgcn_s_waitcnt(0);
        unsigned nloc = b.st[0], nx = b.st[1];
        if (nloc == 0u) { xcd_barrier_complete(bar, b.x, nloc, nx); b.st[0] = nloc; b.st[1] = nx; }
        const unsigned old = xb_add(&bar[XB_XSUB(b.x)], 1u);
        const unsigned gen = old / nloc;
        if (old + 1u == (gen + 1u) * nloc) {
            __builtin_amdgcn_fence(__ATOMIC_RELEASE, "agent");
            asm volatile("s_waitcnt vmcnt(0)" ::: "memory");
            const unsigned og = xb_add(&bar[XB_TOP], 1u);
            const unsigned tg = og / nx;
            if (og + 1u == (tg + 1u) * nx) xb_add(&bar[XB_TOPGEN], 1u);
            else XB_SPIN(xb_ld(&bar[XB_TOPGEN]) == tg, bar);
            __builtin_amdgcn_fence(__ATOMIC_ACQUIRE, "agent");
            xb_add(&bar[XB_XGEN(b.x)], 1u);
            asm volatile("s_waitcnt vmcnt(0)" ::: "memory");
        } else {
            XB_SPIN(xb_ld(&bar[XB_XGEN(b.x)]) == gen, bar);
            __builtin_amdgcn_fence(__ATOMIC_ACQUIRE, "agent");
            asm volatile("s_waitcnt vmcnt(0)" ::: "memory");
        }
    }
    __syncthreads();
}
#endif
constexpr int QUEUE_WORD0 = 4096;

constexpr int LROW = 144;
constexpr int GEMM_AS = 256 * LROW;
constexpr int GEMM_BS = 64 * (256 * 2 + 64);
constexpr int SMEM_XB = 2 * GEMM_AS + 2 * GEMM_BS;
constexpr int SMEM_AUX = SMEM_XB + 64;
constexpr int SMEM_BYTES = SMEM_AUX + 2048;

#ifdef EMU
struct BufRsrc { const char* base; };
DEV BufRsrc make_rsrc(const void* p) { BufRsrc r; r.base = (const char*)p; return r; }
DEV float buf_load_f32(BufRsrc r, unsigned voff, unsigned soff) { return *(const float*)(r.base + voff + soff); }
DEV u4v buf_load_b128(BufRsrc r, unsigned voff, unsigned soff) { return *(const u4v*)(r.base + voff + soff); }
#else
typedef __amdgpu_buffer_rsrc_t BufRsrc;
DEV BufRsrc make_rsrc(const void* p) { return __builtin_amdgcn_make_buffer_rsrc((void*)p, 0, 0x7fffffff, 0x00020000); }
DEV float buf_load_f32(BufRsrc r, unsigned voff, unsigned soff) { return __builtin_bit_cast(float, __builtin_amdgcn_raw_buffer_load_b32(r, voff, soff, 0)); }
DEV u4v buf_load_b128(BufRsrc r, unsigned voff, unsigned soff) { return __builtin_amdgcn_raw_buffer_load_b128(r, voff, soff, 0); }
#endif
#ifdef EMU
#define WAVE_SYNC() do { (void)__shfl(0, 0); } while (0)
#else
#define WAVE_SYNC() asm volatile("s_waitcnt lgkmcnt(0)" ::: "memory")
#endif
DEV char* wave_stage_ptr(char* smem, int wave) { return smem + (wave < 4 ? GEMM_AS + wave * 9216 : 2 * GEMM_AS + GEMM_BS + (wave - 4) * 9216); }
DEV void stage64_write_bf16(char* stg, int tt, const f16v& v0, const f16v& v1, int l31, int h) {
    char* row = stg + (tt * 32 + l31) * LROW;
#pragma unroll
    for (int ft = 0; ft < 2; ++ft) {
        const f16v& v = ft ? v1 : v0;
#pragma unroll
        for (int g = 0; g < 4; ++g) { u2v pk; pk[0] = pack2(v[4 * g], v[4 * g + 1]); pk[1] = pack2(v[4 * g + 2], v[4 * g + 3]); *(u2v*)(row + (ft * 32 + 8 * g + 4 * h) * 2) = pk; }
    }
}
DEV void stage64_write4(char* stg, int row, int col, float a, float b, float c, float d) {
    u2v pk; pk[0] = pack2(a, b); pk[1] = pack2(c, d); *(u2v*)(stg + row * LROW + col * 2) = pk;
}
DEV void stage64_flush_bf16(const char* stg, bf16_t* dst0, size_t row_stride, int lane) {
    WAVE_SYNC();
#pragma unroll
    for (int i = 0; i < 8; ++i) { const int r = (lane >> 3) + 8 * i, c = lane & 7; const u4v v = *(const u4v*)(stg + r * LROW + c * 16); *(u4v*)(dst0 + (size_t)r * row_stride + c * 8) = v; }
    WAVE_SYNC();
}
template <int NTW, int VAR, class Epi>
DEV void gemm_tile(char* smem, BufRsrc ars, unsigned ao0, unsigned ao1, unsigned ao2, unsigned ao3,
                   BufRsrc brs, unsigned bvo, unsigned blds, unsigned ldb4, int K, Epi&& epi) {
    constexpr int BN = 64 * NTW, NLD = 2 * NTW, KSTEP = 64 / NLD, RSB = BN * 2 + 64;
    const int tid = get_tid(), lane = tid & 63, wave = tid >> 6, wm = wave & 3, wn = wave >> 2, h = lane >> 5, l31 = lane & 31;
    char* As = smem; char* Bs = smem + 2 * GEMM_AS;
    constexpr int BSZ = GEMM_BS;
    const int ar = tid >> 3, ac = tid & 7;
    u4v areg[2]; f4v b0[NLD], b1[NLD];
    if (VAR & 3) { for (int i = 0; i < 2; ++i) areg[i] = (u4v){1u, 2u, 3u, 4u}; for (int j = 0; j < NLD; ++j) { b0[j] = (f4v){1.f, 1.f, 1.f, 1.f}; b1[j] = (f4v){2.f, 2.f, 2.f, 2.f}; } }
    f16v acc[NTW][2];
#pragma unroll
    for (int i = 0; i < NTW; ++i) { acc[i][0] = f16zero(); acc[i][1] = f16zero(); }
    auto gloadA = [&](int k0, bool real, int half) {
        if (VAR & 2) return;
        const unsigned so = real ? k0 * 2 : 0u;
        areg[0] = buf_load_b128(ars, real ? (half ? ao2 : ao0) : 0u, so); areg[1] = buf_load_b128(ars, real ? (half ? ao3 : ao1) : 0u, so);
    };
    auto gloadB = [&](int k0, bool real, f4v (&br)[NLD]) {
        if (VAR & 1) return;
        const unsigned vo = real ? bvo : 0u; const int kk = real ? k0 : 0;
        unsigned so = (unsigned)kk * ldb4;
#pragma unroll
        for (int j = 0; j < NLD; ++j) { br[j] = __builtin_bit_cast(f4v, buf_load_b128(brs, vo, so)); so += KSTEP * ldb4; SGPR_PIN(so); }
    };
    auto lstoreA = [&](int buf, int half) {
        if (VAR & 16) return;
        char* ab = As + buf * GEMM_AS + (ar + half * 128) * LROW + ac * 16;
        *(u4v*)(ab) = areg[0]; *(u4v*)(ab + 64 * LROW) = areg[1];
    };
    auto lstoreB = [&](int buf, const f4v (&br)[NLD]) {
        if (VAR & 16) return;
        char* bb = Bs + buf * BSZ + blds;
#pragma unroll
        for (int j = 0; j < NLD; ++j) { u2v v; v[0] = pack2(br[j][0], br[j][1]); v[1] = pack2(br[j][2], br[j][3]); *(u2v*)(bb + j * KSTEP * RSB) = v; }
    };
    const unsigned btr = (unsigned)(8 * h + ((lane & 15) >> 2)) * RSB + (unsigned)((((lane >> 4) & 1) * 16 + 4 * (lane & 3)) * 2) + (unsigned)(wn * NTW * 32) * 2;
    const unsigned atr = (unsigned)(wm * 64 + l31) * LROW + h * 16;
    auto rdw = [&](int buf, int s, int ft) -> s8v {
        if (VAR & 64) { s8v z; for (int q = 0; q < 8; ++q) z[q] = (short)(0x3f80 + ft); return z; }
        const char* bb = Bs + buf * BSZ + btr + s * 16 * RSB + ft * 64;
        const s4v lo = lds_tr16(bb), hi = lds_tr16(bb + 4 * RSB);
        s8v wf; wf[0] = lo[0]; wf[1] = lo[1]; wf[2] = lo[2]; wf[3] = lo[3]; wf[4] = hi[0]; wf[5] = hi[1]; wf[6] = hi[2]; wf[7] = hi[3];
        return wf;
    };
    auto compute2 = [&](int buf, int s0) {
        if (VAR & 8) return;
        const char* ab = As + buf * GEMM_AS + atr;
        s8v xa[2];
        if (VAR & 64) { for (int q = 0; q < 8; ++q) { xa[0][q] = 0x3f80; xa[1][q] = 0x3f80; } } else { xa[0] = *(const s8v*)(ab + s0 * 32); xa[1] = *(const s8v*)(ab + 32 * LROW + s0 * 32); }
        s8v wcur = rdw(buf, s0, 0);
#pragma unroll
        for (int g = 0; g < 2 * NTW; ++g) {
            const int ft = g % NTW;
            s8v wnext = wcur;
            if (g + 1 < 2 * NTW) wnext = rdw(buf, s0 + (g + 1) / NTW, (g + 1) % NTW);
            if (VAR & 4) { acc[ft][0][0] += __builtin_bit_cast(float, (int)wcur[0] | ((int)xa[0][1] << 16)); acc[ft][1][0] += __builtin_bit_cast(float, (int)wcur[1] | ((int)xa[1][1] << 16)); }
            else { acc[ft][0] = mfma32(wcur, xa[0], acc[ft][0]); acc[ft][1] = mfma32(wcur, xa[1], acc[ft][1]); }
            if (g == NTW - 1 && !(VAR & 64)) { xa[0] = *(const s8v*)(ab + (s0 + 1) * 32); xa[1] = *(const s8v*)(ab + 32 * LROW + (s0 + 1) * 32); }
            wcur = wnext;
            SCHED_FENCE();
        }
    };
    const int nk = K / 64;
    if (NTW == 2) {
        u4v a0[4], a1[4];
        if (VAR & 3) { for (int i = 0; i < 4; ++i) { a0[i] = (u4v){1u, 2u, 3u, 4u}; a1[i] = (u4v){1u, 2u, 3u, 4u}; } }
        auto gA = [&](int k0, bool real, u4v (&ar4)[4]) {
            if (VAR & 2) return;
            const unsigned so = real ? k0 * 2 : 0u;
            ar4[0] = buf_load_b128(ars, real ? ao0 : 0u, so); ar4[1] = buf_load_b128(ars, real ? ao1 : 0u, so);
            ar4[2] = buf_load_b128(ars, real ? ao2 : 0u, so); ar4[3] = buf_load_b128(ars, real ? ao3 : 0u, so);
        };
        auto sA = [&](int buf, const u4v (&ar4)[4]) {
            if (VAR & 16) return;
            char* ab = As + buf * GEMM_AS + ar * LROW + ac * 16;
#pragma unroll
            for (int i = 0; i < 4; ++i) *(u4v*)(ab + i * 64 * LROW) = ar4[i];
        };
        gA(0, true, a0); gloadB(0, true, b0); gA(64, true, a1); gloadB(64, true, b1);
        sA(0, a0); lstoreB(0, b0);
        __syncthreads();
        for (int kt = 0; kt < nk; kt += 2) {
            const bool t2 = kt + 2 < nk;
            gA((kt + 2) * 64, t2, a0); gloadB((kt + 2) * 64, t2, b0);
            compute2(0, 0); compute2(0, 2);
            sA(1, a1); lstoreB(1, b1);
            __syncthreads();
            gA((kt + 3) * 64, t2, a1); gloadB((kt + 3) * 64, t2, b1);
            compute2(1, 0); compute2(1, 2);
            sA(0, a0); lstoreB(0, b0);
            __syncthreads();
        }
    } else {
    gloadA(0, true, 0); gloadB(0, true, b0); lstoreA(0, 0); gloadA(0, true, 1); gloadB(64, true, b1); lstoreA(0, 1); lstoreB(0, b0);
    __syncthreads();
    for (int kt = 0; kt < nk; kt += 2) {
        const bool t2 = kt + 2 < nk;
        gloadA((kt + 1) * 64, true, 0);
        compute2(0, 0);
        lstoreA(1, 0);
        gloadA((kt + 1) * 64, true, 1);
        gloadB((kt + 2) * 64, t2, b0);
        compute2(0, 2);
        lstoreA(1, 1); lstoreB(1, b1);
        __syncthreads();
        gloadA((kt + 2) * 64, t2, 0);
        compute2(1, 0);
        lstoreA(0, 0);
        gloadA((kt + 2) * 64, t2, 1);
        gloadB((kt + 3) * 64, t2, b1);
        compute2(1, 2);
        lstoreA(0, 1); lstoreB(0, b0);
        __syncthreads();
    }
    }
    if (VAR & 32) { float t = 0.f; for (int i = 0; i < NTW; ++i) t += acc[i][0][0] + acc[i][1][5]; if (t == 123.456f) *(float*)smem = t; }
    else epi(acc);
}

DEV void phase_ada(const Params& p, char* smem) {
    const int tid = get_tid();
    float* siluS = (float*)smem;
    float* red = (float*)(smem + NCOND * D * 4);
    for (int i = tid; i < NCOND * D; i += 512) {
        const int cnd = i / D, k = i % D;
        const float c = cnd == 0 ? p.in[I_CCTX][k] : p.in[I_C][(cnd - 1) * D + k];
        siluS[i] = c / (1.f + expf(-c));
    }
    __syncthreads();
    constexpr int CPL = 6 * D / 32, NCHUNK = DEPTH * CPL, KG = D / 16;
    float* mods = (float*)(p.ws + WS_MODS);
    const int col = tid & 31, kg = tid >> 5;
    for (int u = blockIdx.x; u < NCHUNK; u += gridDim.x) {
        const int l = u / CPL, c0 = (u % CPL) * 32;
        const float* W = p.in[I_ADAW] + (size_t)l * D * 6 * D + c0 + col;
        float acc[NCOND];
#pragma unroll
        for (int c = 0; c < NCOND; ++c) acc[c] = 0.f;
#pragma unroll 8
        for (int k = kg * KG; k < kg * KG + KG; ++k) {
            const float w = W[(size_t)k * 6 * D];
#pragma unroll
            for (int c = 0; c < NCOND; ++c) acc[c] += siluS[c * D + k] * w;
        }
#pragma unroll
        for (int c = 0; c < NCOND; ++c) red[(kg * NCOND + c) * 32 + col] = acc[c];
        __syncthreads();
        if (tid < 32 * NCOND) {
            const int c = tid >> 5, cc = tid & 31;
            float s = 0.f;
            for (int g = 0; g < 16; ++g) s += red[(g * NCOND + c) * 32 + cc];
            mods[((size_t)l * NCOND + c) * 6 * D + c0 + cc] = s + p.in[I_ADAB][(size_t)l * 6 * D + c0 + cc];
        }
        __syncthreads();
    }
    const int gtid = blockIdx.x * 512 + tid, gsz = gridDim.x * 512;
    float* rope = (float*)(p.ws + WS_ROPE);
    for (int i = gtid; i < 64 * 16; i += gsz) {
        const int pos = i >> 4, fi = i & 15;
        const float inv = powf(10000.f, -(float)(2 * fi) / 32.f);
        const float ang = (float)pos * inv;
        rope[2 * i] = cosf(ang); rope[2 * i + 1] = sinf(ang);
    }
    constexpr int NNA = DEC_BATCH * DEPTH * PAST * NAH * HD, NGQ = DEC_BATCH * DEPTH * PAST * GQKV * HD;
    bf16_t* cnak = (bf16_t*)(p.ws + WS_CNAK); bf16_t* cnav = (bf16_t*)(p.ws + WS_CNAV);
    bf16_t* cgqk = (bf16_t*)(p.ws + WS_CGQK); bf16_t* cgqv = (bf16_t*)(p.ws + WS_CGQV);
    for (int i = gtid; i < NNA; i += gsz) { cnak[i] = f2bf(p.in[I_CNAK][i]); cnav[i] = f2bf(p.in[I_CNAV][i]); }
    for (int i = gtid; i < NGQ; i += gsz) { cgqk[i] = f2bf(p.in[I_CGQK][i]); cgqv[i] = f2bf(p.in[I_CGQV][i]); }
}

constexpr int EPL = D / 64;
constexpr int W16ROW = 20;
template <int MODE>
DEV void phase_rows(const Params& p, char* smem, int l) {
    const int tid = get_tid(), lane = tid & 63, wave = tid >> 6;
    float* W16 = (float*)smem;
    const bool need_w = (MODE == 1) || (l < DEPTH);
    if (need_w) {
        for (int i = tid; i < D * 4; i += 512) {
            const int k = i >> 2, q = i & 3;
            const float* src = (MODE == 1) ? p.in[I_RW] + ((size_t)l * D + k) * 16 + q * 4 : p.in[I_WIN] + ((size_t)l * D + k) * PROJ_W + 2176 + q * 4;
            *(f4v*)(W16 + k * W16ROW + q * 4) = *(const f4v*)src;
        }
    }
    __syncthreads();
    const float* mods = (const float*)(p.ws + WS_MODS);
    for (int t = blockIdx.x * 8 + wave; t < NT; t += gridDim.x * 8) {
        const int cnd = tok_cond(t);
        float v[EPL];
        if (MODE == 0 && l == 0) {
            const float* xr = t < NP ? p.in[I_XP] + (size_t)t * D : p.in[I_XS] + (size_t)(t - NP) * D;
#pragma unroll
            for (int j = 0; j < EPL; ++j) v[j] = xr[lane + 64 * j];
        } else if (MODE == 0) {
            const float* x1 = (const float*)(p.ws + WS_X1) + (size_t)t * D;
            const float* g2 = mods + ((size_t)(l - 1) * NCOND + cnd) * 6 * D + 5 * D;
            float f[EPL], xv[EPL], gv[EPL];
#pragma unroll
            for (int j = 0; j < EPL; ++j) { f[j] = 0.f; xv[j] = x1[lane + 64 * j]; gv[j] = g2[lane + 64 * j]; }
            const int* ts = (const int*)(p.ws + WS_TOKSLOT) + (size_t)t * 16;
            const int myslot = lane < 16 ? ts[lane] : -1;
            unsigned vm = (unsigned)__ballot(myslot >= 0);
            while (vm) {
                const int e = __builtin_ctz(vm); vm &= vm - 1u;
                const int slot = __shfl(myslot, e);
                const bf16_t* yr = (const bf16_t*)(p.ws + WS_YE) + ((size_t)e * SLOTS + slot) * D;
#pragma unroll
                for (int j = 0; j < EPL; ++j) f[j] += bf2f(yr[lane + 64 * j]);
            }
#pragma unroll
            for (int j = 0; j < EPL; ++j) v[j] = ALPHA * xv[j] + gv[j] * f[j];
        } else {
            const float* u = (const float*)(p.ws + WS_U) + (size_t)t * D;
#pragma unroll
            for (int j = 0; j < EPL; ++j) v[j] = u[lane + 64 * j];
        }
        if (!(MODE == 0 && l == 0)) {
            const int li = (MODE == 0) ? (l - 1) * 2 + 1 : l * 2;
            const float* lg = p.in[I_LNG] + (size_t)li * D; const float* lb = p.in[I_LNB] + (size_t)li * D;
            float g[EPL], bb[EPL];
#pragma unroll
            for (int j = 0; j < EPL; ++j) { g[j] = lg[lane + 64 * j]; bb[j] = lb[lane + 64 * j]; }
            float s = 0.f;
#pragma unroll
            for (int j = 0; j < EPL; ++j) s += v[j];
            const float mu = wave_sum(s) * (1.f / D);
            float q = 0.f;
#pragma unroll
            for (int j = 0; j < EPL; ++j) { const float dlt = v[j] - mu; q += dlt * dlt; }
            const float rstd = 1.f / sqrtf(wave_sum(q) * (1.f / D) + EPS);
            float* dst = (MODE == 1) ? (float*)(p.ws + WS_X1) + (size_t)t * D
                       : (l == DEPTH) ? (t < NP ? p.out + O_YP + (size_t)t * D : p.out + O_YS + (size_t)(t - NP) * D) : (float*)(p.ws + WS_XBUF) + (size_t)t * D;
#pragma unroll
            for (int j = 0; j < EPL; ++j) { v[j] = (v[j] - mu) * rstd * g[j] + bb[j]; dst[lane + 64 * j] = v[j]; }
        }
        if (MODE == 1 || l < DEPTH) {
            const float* sh = mods + ((size_t)l * NCOND + cnd) * 6 * D + (MODE == 1 ? 3 * D : 0); const float* sc = sh + D;
            bf16_t* hb = (bf16_t*)(p.ws + (MODE == 1 ? WS_H2 : WS_HMOD)) + (size_t)t * D;
            {
                float s1[EPL], s0[EPL];
#pragma unroll
                for (int j = 0; j < EPL; ++j) { s1[j] = sc[lane + 64 * j]; s0[j] = sh[lane + 64 * j]; }
#pragma unroll
                for (int j = 0; j < EPL; ++j) { v[j] = v[j] * (1.f + s1[j]) + s0[j]; hb[lane + 64 * j] = f2bf(v[j]); }
            }
            CFENCE();
            float a16[16];
#pragma unroll
            for (int e = 0; e < 16; ++e) a16[e] = 0.f;
#pragma unroll
            for (int j = 0; j < EPL; ++j) {
                const float hv = v[j];
                const float* wr = W16 + (lane + 64 * j) * W16ROW;
#pragma unroll
                for (int q = 0; q < 4; ++q) { const f4v w4 = *(const f4v*)(wr + 4 * q); a16[4 * q] += hv * w4[0]; a16[4 * q + 1] += hv * w4[1]; a16[4 * q + 2] += hv * w4[2]; a16[4 * q + 3] += hv * w4[3]; }
                if (j & 1) CFENCE();
            }
            float mine = -1e30f;
#pragma unroll
            for (int e = 0; e < 16; ++e) { const float sm = wave_sum(a16[e]); if (lane == e) mine = sm; }
            if (MODE == 0) {
                if (lane < 16) ((float*)(p.ws + WS_GATES))[(size_t)t * 16 + lane] = mine + p.in[I_BGATE][l * 16 + lane];
            } else {
                float mx = mine;
                for (int m = 8; m >= 1; m >>= 1) mx = fmaxf(mx, __shfl_xor(mx, m));
                const float ex = lane < 16 ? expf(mine - mx) : 0.f;
                float sm = ex;
                for (int m = 8; m >= 1; m >>= 1) sm += __shfl_xor(sm, m);
                if (lane < 16) ((float*)(p.ws + WS_AFF))[(size_t)t * 16 + lane] = ex / sm;
            }
        }
    }
}

template <int NPL>
DEV void topk_wave(const Params& p, int tb, int cap, int sbase, int e, int lane) {
    const float* aff = (const float*)(p.ws + WS_AFF);
    int* idx = (int*)(p.ws + WS_IDX); float* gsel = (float*)(p.ws + WS_GSEL); int* tokslot = (int*)(p.ws + WS_TOKSLOT);
    unsigned bits[NPL];
#pragma unroll
    for (int i = 0; i < NPL; ++i) bits[i] = __builtin_bit_cast(unsigned, aff[(size_t)(tb + lane + 64 * i) * 16 + e]);
    unsigned T = 0u;
    for (int b = 30; b >= 0; --b) {
        const unsigned cand = T | (1u << b);
        int cnt = 0;
#pragma unroll
        for (int i = 0; i < NPL; ++i) cnt += __popcll(__ballot(bits[i] >= cand));
        if (cnt >= cap) T = cand;
    }
    int ngt = 0;
#pragma unroll
    for (int i = 0; i < NPL; ++i) ngt += __popcll(__ballot(bits[i] > T));
    int need_eq = cap - ngt, run = 0;
    const unsigned long long lt = (1ull << lane) - 1ull;
#pragma unroll
    for (int i = 0; i < NPL; ++i) {
        const bool eq = bits[i] == T;
        const unsigned long long meq = __ballot(eq);
        const int eqrank = __popcll(meq & lt);
        const bool sel = bits[i] > T || (eq && eqrank < need_eq);
        const unsigned long long ms = __ballot(sel);
        const int t = tb + lane + 64 * i;
        if (sel) { const int slot = sbase + run + __popcll(ms & lt); idx[e * SLOTS + slot] = t; gsel[e * SLOTS + slot] = __builtin_bit_cast(float, bits[i]); tokslot[(size_t)t * 16 + e] = slot; }
        else tokslot[(size_t)t * 16 + e] = -1;
        run += __popcll(ms);
        const int neq = __popcll(meq); need_eq -= neq < need_eq ? neq : need_eq;
    }
}
DEV void phase_topk(const Params& p, char* smem) {
    (void)smem;
    const int tid = get_tid(), lane = tid & 63;
    constexpr int US = DEC_BATCH * NEXP, UP = BATCH * NEXP;
    const int gw = blockIdx.x + gridDim.x * (tid >> 6), nw = gridDim.x * 8;
    for (int u = gw; u < US + UP; u += nw) {
        if (u < US) { const int b = u / NEXP, e = u % NEXP; topk_wave<DEC_SEQ / 64>(p, NP + b * DEC_SEQ, CAP_S, BATCH * CAP_P + b * CAP_S, e, lane); }
        else { const int uu = u - US; const int b = uu / NEXP, e = uu % NEXP; topk_wave<SEQ / 64>(p, b * SEQ, CAP_P, b * CAP_P, e, lane); }
    }
}

DEV void store_head_f32(float* dst_f32, const f16v& v0, const f16v& v1, int h) {
#pragma unroll
    for (int ft = 0; ft < 2; ++ft) {
        const f16v& v = ft ? v1 : v0;
#pragma unroll
        for (int g = 0; g < 4; ++g) { f4v o; o[0] = v[4 * g]; o[1] = v[4 * g + 1]; o[2] = v[4 * g + 2]; o[3] = v[4 * g + 3]; *(f4v*)(dst_f32 + ft * 32 + 8 * g + 4 * h) = o; }
    }
}
template <int VAR>
DEV void phase_inproj(const Params& p, char* smem, int l) {
    constexpr int NJ = 22, NU = (NT / 256) * NJ;
    const int tid = get_tid(), lane = tid & 63, wave = tid >> 6, wm = wave & 3, wn = wave >> 2, h = lane >> 5, l31 = lane & 31;
    const bf16_t* hmod = (const bf16_t*)(p.ws + WS_HMOD);
    const float* rope = (const float*)(p.ws + WS_ROPE);
    constexpr int NMB = NT / 256, RPX = (NMB % 8 == 0) ? NMB / 8 : NMB;
    const UnitIter it = unit_iter(NU);
    for (int u = it.i; u < it.end; u += it.step) {
        const int mb = (u / (RPX * NJ)) * RPX + u % RPX, j = (u / RPX) % NJ;
        const int colbase = j < 17 ? 128 * j : 2192 + 128 * (j - 17);
        const unsigned ao = ((unsigned)(mb * 256 + (tid >> 3)) * D + (tid & 7) * 8) * 2;
        const unsigned bvo = (unsigned)(colbase + 4 * (tid & 31)) * 4 + (unsigned)(tid >> 5) * (PROJ_W * 4);
        const unsigned blds = (unsigned)(tid >> 5) * 320u + (unsigned)(tid & 31) * 8u;
        gemm_tile<2, VAR>(smem, make_rsrc(hmod), ao, ao + 128u * D, ao + 256u * D, ao + 384u * D, make_rsrc(p.in[I_WIN] + (size_t)l * D * PROJ_W), bvo, blds, PROJ_W * 4, D, [&](f16v (&acc)[2][2]) {
            int lane_e = lane; VGPR_PIN(lane_e); const int lane = lane_e, l31 = lane_e & 31, h = lane_e >> 5; (void)l31; (void)h;
            const int cb = colbase + wn * 64;
            char* stg = wave_stage_ptr(smem, wave);
            const int t0 = mb * 256 + wm * 64;
            const bool isP = t0 < NP;
            bf16_t* dstb; size_t dstride;
            int f32out = 0, fhead = 0, fheads = 0; size_t fbase = 0;
            int mode = 0;
            if (cb < 1152) {
                const int seg = cb / 384, head = (cb % 384) / 64;
                dstb = (bf16_t*)(p.ws + (seg == 0 ? WS_NAQ : seg == 1 ? WS_NAK : WS_NAV)) + (size_t)t0 * 384 + head * 64; dstride = 384;
                if (seg >= 1 && isP) { f32out = 1; fbase = seg == 1 ? O_NAK : O_NAV; fhead = head; fheads = NAH; }
            } else if (cb < 2176) {
                const int seg = (cb - 1152) / 256, head = ((cb - 1152) % 256) / 64;
                dstb = (bf16_t*)(p.ws + (seg == 0 ? WS_MLQ : seg == 1 ? WS_MLK : seg == 2 ? WS_MLV : WS_MLO)) + (size_t)t0 * 256 + head * 64; dstride = 256;
                mode = seg == 1 ? 1 : 0;
            } else {
                const int c2 = cb - 2192;
                if (c2 < 384) { dstb = (bf16_t*)(p.ws + WS_GQQ) + (size_t)t0 * 384 + (c2 / 64) * 64; dstride = 384; mode = 2; }
                else if (c2 < 512) { const int head = (c2 - 384) / 64; dstb = (bf16_t*)(p.ws + WS_GQK) + (size_t)t0 * 128 + head * 64; dstride = 128; mode = 3;
                                     if (isP) { f32out = 1; fbase = O_GQK; fhead = head; fheads = GQKV; } }
                else { const int head = (c2 - 512) / 64; dstb = (bf16_t*)(p.ws + WS_GQV) + (size_t)t0 * 128 + head * 64; dstride = 128;
                       if (isP) { f32out = 1; fbase = O_GQV; fhead = head; fheads = GQKV; } }
            }
#pragma unroll
            for (int tt = 0; tt < 2; ++tt) {
                const int t = t0 + tt * 32 + l31;
                f16v v0 = acc[0][tt], v1 = acc[1][tt];
                if (mode == 1) { v0 *= ATT_SCALE; v1 *= ATT_SCALE; }
                if (mode >= 2) {
                    float ss = 0.f;
#pragma unroll
                    for (int r = 0; r < 16; ++r) ss += v0[r] * v0[r] + v1[r] * v1[r];
                    ss += __shfl_xor(ss, 32);
                    const float rn = 1.f / sqrtf(ss * (1.f / 64.f) + EPS);
                    const float* gq = p.in[I_QKG] + ((size_t)l * 2 + (mode == 2 ? 0 : 1)) * 64;
#pragma unroll
                    for (int r = 0; r < 16; ++r) {
                        const int d = (r & 3) + 8 * (r >> 2) + 4 * h;
                        v0[r] *= rn * gq[d]; v1[r] *= rn * gq[32 + d];
                    }
                }
                if (f32out) { const int bP = t / SEQ, sP = t % SEQ; store_head_f32(p.out + fbase + ((((size_t)bP * DEPTH + l) * SEQ + sP) * fheads + fhead) * 64, v0, v1, h); }
                if (mode >= 2 && !isP) {
                    const int pos = (t - NP) % DEC_SEQ, prow = pos / GRIDW, pcol = pos % GRIDW;
#pragma unroll
                    for (int rr = 0; rr < 8; ++rr) {
                        const int fi = (rr & 3) + 8 * ((rr >> 2) & 1) + 4 * h;
                        const float c0 = rope[(prow * 16 + fi) * 2], s0 = rope[(prow * 16 + fi) * 2 + 1];
                        const float c1 = rope[(pcol * 16 + fi) * 2], s1 = rope[(pcol * 16 + fi) * 2 + 1];
                        const float a_lo = v0[rr], a_hi = v0[rr + 8]; v0[rr] = a_lo * c0 - a_hi * s0; v0[rr + 8] = a_hi * c0 + a_lo * s0;
                        const float b_lo = v1[rr], b_hi = v1[rr + 8]; v1[rr] = b_lo * c1 - b_hi * s1; v1[rr + 8] = b_hi * c1 + b_lo * s1;
                    }
                }
                stage64_write_bf16(stg, tt, v0, v1, l31, h);
            }
            stage64_flush_bf16(stg, dstb, dstride, lane);
        });
    }
}

template <int VAR>
DEV void phase_outproj(const Params& p, char* smem, int l) {
    constexpr int NC = D / 128, NU = (NT / 256) * NC;
    const int tid = get_tid(), lane = tid & 63, wave = tid >> 6, wm = wave & 3, wn = wave >> 2, h = lane >> 5, l31 = lane & 31;
    const bf16_t* mixed = (const bf16_t*)(p.ws + WS_MIXED);
    const float* mods = (const float*)(p.ws + WS_MODS);
    float* U = (float*)(p.ws + WS_U);
    constexpr int NMB = NT / 256, RPX = (NMB % 8 == 0) ? NMB / 8 : NMB;
    const UnitIter it = unit_iter(NU);
    for (int u = it.i; u < it.end; u += it.step) {
        const int mb = (u / (RPX * NC)) * RPX + u % RPX, cbk = (u / RPX) % NC;
        const unsigned ao = ((unsigned)(mb * 256 + (tid >> 3)) * MIXW + (tid & 7) * 8) * 2;
        const unsigned bvo = (unsigned)(cbk * 128 + 4 * (tid & 31)) * 4 + (unsigned)(tid >> 5) * (D * 4);
        const unsigned blds = (unsigned)(tid >> 5) * 320u + (unsigned)(tid & 31) * 8u;
        gemm_tile<2, VAR>(smem, make_rsrc(mixed), ao, ao + 128u * MIXW, ao + 256u * MIXW, ao + 384u * MIXW, make_rsrc(p.in[I_WOUT] + (size_t)l * MIXW * D), bvo, blds, D * 4, MIXW, [&](f16v (&acc)[2][2]) {
            int lane_e = lane; VGPR_PIN(lane_e); const int lane = lane_e, l31 = lane_e & 31, h = lane_e >> 5; (void)l31; (void)h;
            char* stg = wave_stage_ptr(smem, wave);
            const int t0 = mb * 256 + wm * 64;
            const float* g1 = mods + ((size_t)l * NCOND + tok_cond(t0)) * 6 * D + 2 * D;
#pragma unroll
            for (int ft = 0; ft < 2; ++ft) {
#pragma unroll
                for (int tt = 0; tt < 2; ++tt)
#pragma unroll
                    for (int g = 0; g < 4; ++g) { f4v o; o[0] = acc[ft][tt][4 * g]; o[1] = acc[ft][tt][4 * g + 1]; o[2] = acc[ft][tt][4 * g + 2]; o[3] = acc[ft][tt][4 * g + 3];
                        *(f4v*)(stg + (tt * 32 + l31) * LROW + (8 * g + 4 * h) * 4) = o; }
                WAVE_SYNC();
                const int f0 = cbk * 128 + wn * 64 + ft * 32 + (lane & 7) * 4;
                const f4v gv = *(const f4v*)(g1 + f0);
#pragma unroll
                for (int i = 0; i < 8; ++i) {
                    const int r = (lane >> 3) + 8 * i, t = t0 + r;
                    const f4v a = *(const f4v*)(stg + r * LROW + (lane & 7) * 16);
                    const float* xr = (l == 0) ? (t < NP ? p.in[I_XP] + (size_t)t * D : p.in[I_XS] + (size_t)(t - NP) * D) : (const float*)(p.ws + WS_XBUF) + (size_t)t * D;
                    const f4v xv = *(const f4v*)(xr + f0);
                    f4v o;
#pragma unroll
                    for (int q = 0; q < 4; ++q) o[q] = ALPHA * xv[q] + gv[q] * a[q];
                    *(f4v*)(U + (size_t)t * D + f0) = o;
                }
                WAVE_SYNC();
            }
        });
    }
}

template <int VAR>
DEV void phase_gateup(const Params& p, char* smem, int l) {
    constexpr int NRB = SLOTS / 256, NCB = EH / 128, NU = NEXP * NCB * NRB;
    const int tid = get_tid(), lane = tid & 63, wave = tid >> 6, wm = wave & 3, wn = wave >> 2, h = lane >> 5, l31 = lane & 31;
    const bf16_t* h2 = (const bf16_t*)(p.ws + WS_H2);
    const int* idx = (const int*)(p.ws + WS_IDX);
    bf16_t* hid = (bf16_t*)(p.ws + WS_HID);
    const UnitIter it = unit_iter(NU);
    for (int u = it.i; u < it.end; u += it.step) {
        const int rb = u % NRB, cbk = (u / NRB) % NCB, e = u / (NRB * NCB);
        const int* ip = idx + e * SLOTS + rb * 256 + (tid >> 3);
        const unsigned a0 = ((unsigned)ip[0] * D + (tid & 7) * 8) * 2, a1 = ((unsigned)ip[64] * D + (tid & 7) * 8) * 2;
        const unsigned a2 = ((unsigned)ip[128] * D + (tid & 7) * 8) * 2, a3 = ((unsigned)ip[192] * D + (tid & 7) * 8) * 2;
#ifdef EMU
        const int bw = tid >> 6;
#else
        const int bw = __builtin_amdgcn_readfirstlane(tid >> 6);
#endif
        const int is_up = bw & 1, bkr = 2 * (bw >> 1) + ((tid >> 5) & 1), hc = 4 * (tid & 31);
        const int ncol = (hc >> 6) * 128 + (2 * ((hc >> 5) & 1) + is_up) * 32 + (hc & 31);
        const unsigned bvo = (unsigned)(cbk * 128 + hc) * 4 + (unsigned)bkr * (EH * 4);
        const unsigned blds = (unsigned)bkr * 576u + (unsigned)ncol * 2u;
        const float* wmat = (is_up ? p.in[I_WU] : p.in[I_WG]) + ((size_t)l * NEXP + e) * D * EH;
        gemm_tile<4, VAR>(smem, make_rsrc(h2), a0, a1, a2, a3, make_rsrc(wmat), bvo, blds, EH * 4, D, [&](f16v (&acc)[4][2]) {
            int lane_e = lane; VGPR_PIN(lane_e); const int lane = lane_e, l31 = lane_e & 31, h = lane_e >> 5; (void)l31; (void)h;
            char* stg = wave_stage_ptr(smem, wave);
#pragma unroll
            for (int tt = 0; tt < 2; ++tt)
#pragma unroll
                for (int pr = 0; pr < 2; ++pr)
#pragma unroll
                    for (int g = 0; g < 4; ++g) {
                        float o[4];
#pragma unroll
                        for (int q = 0; q < 4; ++q) o[q] = siluf_(acc[2 * pr][tt][4 * g + q]) * acc[2 * pr + 1][tt][4 * g + q];
                        stage64_write4(stg, tt * 32 + l31, pr * 32 + 8 * g + 4 * h, o[0], o[1], o[2], o[3]);
                    }
            stage64_flush_bf16(stg, hid + ((size_t)e * SLOTS + rb * 256 + wm * 64) * EH + cbk * 128 + wn * 64, EH, lane);
        });
    }
}

template <int VAR>
DEV void phase_down(const Params& p, char* smem, int l) {
    constexpr int NRB = SLOTS / 256, NCB = D / 256, NU = NEXP * NCB * NRB;
    const int tid = get_tid(), lane = tid & 63, wave = tid >> 6, wm = wave & 3, wn = wave >> 2, h = lane >> 5, l31 = lane & 31;
    const bf16_t* hid = (const bf16_t*)(p.ws + WS_HID);
    const float* gsel = (const float*)(p.ws + WS_GSEL);
    bf16_t* ye = (bf16_t*)(p.ws + WS_YE);
    const UnitIter it = unit_iter(NU);
    for (int u = it.i; u < it.end; u += it.step) {
        const int rb = u % NRB, cbk = (u / NRB) % NCB, e = u / (NRB * NCB);
        const unsigned ao = ((unsigned)(rb * 256 + (tid >> 3)) * EH + (tid & 7) * 8) * 2;
        const unsigned bvo = (unsigned)(cbk * 256 + 4 * (tid & 63)) * 4 + (unsigned)(tid >> 6) * (D * 4);
        const unsigned blds = (unsigned)(tid >> 6) * 576u + (unsigned)(tid & 63) * 8u;
        gemm_tile<4, VAR>(smem, make_rsrc(hid + (size_t)e * SLOTS * EH), ao, ao + 128u * EH, ao + 256u * EH, ao + 384u * EH, make_rsrc(p.in[I_WD] + ((size_t)l * NEXP + e) * EH * D), bvo, blds, D * 4, EH, [&](f16v (&acc)[4][2]) {
            int lane_e = lane; VGPR_PIN(lane_e); const int lane = lane_e, l31 = lane_e & 31, h = lane_e >> 5; (void)l31; (void)h;
            char* stg = wave_stage_ptr(smem, wave);
            const float gs0 = gsel[e * SLOTS + rb * 256 + wm * 64 + l31], gs1 = gsel[e * SLOTS + rb * 256 + wm * 64 + 32 + l31];
#pragma unroll
            for (int hb = 0; hb < 2; ++hb) {
#pragma unroll
                for (int tt = 0; tt < 2; ++tt) {
                    const float gs = tt ? gs1 : gs0;
#pragma unroll
                    for (int f2 = 0; f2 < 2; ++f2)
#pragma unroll
                        for (int g = 0; g < 4; ++g) { const f16v& a = acc[2 * hb + f2][tt]; stage64_write4(stg, tt * 32 + l31, f2 * 32 + 8 * g + 4 * h, a[4 * g] * gs, a[4 * g + 1] * gs, a[4 * g + 2] * gs, a[4 * g + 3] * gs); }
                }
                stage64_flush_bf16(stg, ye + ((size_t)e * SLOTS + rb * 256 + wm * 64) * D + cbk * 256 + wn * 128 + hb * 64, D, lane);
            }
        });
    }
}

struct AttnDesc {
    const bf16_t* q; int qstride;
    int ntiles, n0;
    const bf16_t *k0, *v0; int stride0;
    const bf16_t *k1, *v1; int stride1;
    int na;
    int r0, rlo;
    const float* rpb;
    bf16_t* out; int ostride;
    float* part;
};
constexpr int ATT_TILE = 64 * LROW;
DEV int na_row_start(int r) { int s = r - KR / 2; s = s < 0 ? 0 : s; return s > ROWS - KR ? ROWS - KR : s; }
DEV void attn_unit(char* smem, const AttnDesc& d) {
    const int tid = get_tid(), lane = tid & 63, wave = tid >> 6, h = lane >> 5, l31 = lane & 31;
    char* Ks = smem; char* Vs = smem + 2 * ATT_TILE; float* rpbS = (float*)(smem + 4 * ATT_TILE);
    if (d.na) { for (int i = tid; i < 15 * 31; i += 512) rpbS[i] = d.rpb[i] * 1.4426950408889634f; }
    const bf16_t* qp = d.q + (size_t)(wave * 32 + l31) * d.qstride + h * 8;
    s8v qf[4];
#pragma unroll
    for (int s = 0; s < 4; ++s) qf[s] = *(const s8v*)(qp + 16 * s);
    float m_run = -1e30f, l_run = 0.f;
    f16v o[2]; o[0] = f16zero(); o[1] = f16zero();
    const int srow = tid >> 3, sch = tid & 7;
    u4v kreg, vreg;
    auto gload = [&](int t) {
        const bf16_t *kp, *vp;
        if (t < d.n0) { const size_t off = (size_t)(t * 64 + srow) * d.stride0 + sch * 8; kp = d.k0 + off; vp = d.v0 + off; }
        else { const size_t off = (size_t)((t - d.n0) * 64 + srow) * d.stride1 + sch * 8; kp = d.k1 + off; vp = d.v1 + off; }
        kreg = *(const u4v*)kp; vreg = *(const u4v*)vp;
    };
    auto lstore = [&](int buf) { *(u4v*)(Ks + buf * ATT_TILE + srow * LROW + sch * 16) = kreg; *(u4v*)(Vs + buf * ATT_TILE + srow * LROW + sch * 16) = vreg; };
    const int qr = d.r0 + (wave >> 1), qw = (wave & 1) * 32 + l31;
    const int rs = na_row_start(qr);
    int cs = qw - KC / 2; cs = cs < 0 ? 0 : (cs > GRIDW - KC ? GRIDW - KC : cs);
    gload(0); lstore(0);
    __syncthreads();
    for (int t = 0; t < d.ntiles; ++t) {
        const int buf = t & 1;
        if (t + 1 < d.ntiles) gload(t + 1);
        const bool local = d.na && t >= d.n0;
        const int kr = d.rlo + (t - d.n0);
        const bool active = !local || (kr >= rs && kr < rs + KR);
        if (active) {
            const char* kb = Ks + buf * ATT_TILE + l31 * LROW + h * 16;
            f16v sa[2];
#pragma unroll
            for (int kt = 0; kt < 2; ++kt) {
                sa[kt] = f16zero();
#pragma unroll
                for (int s = 0; s < 4; ++s) { const s8v kf = *(const s8v*)(kb + kt * 32 * LROW + s * 32); sa[kt] = mfma32(kf, qf[s], sa[kt]); }
            }
            constexpr float C2 = ATT_SCALE * 1.4426950408889634f;
            float mx = -1e30f;
            if (local) {
#pragma unroll
                for (int kt = 0; kt < 2; ++kt)
#pragma unroll
                    for (int r = 0; r < 16; ++r) {
                        const int kc = kt * 32 + (r & 3) + 8 * (r >> 2) + 4 * h;
                        const bool inw = kc >= cs && kc < cs + KC;
                        const int bi = (kr - qr + 7) * 31 + (kc - qw + 15);
                        const float v = inw ? sa[kt][r] * C2 + rpbS[inw ? bi : 0] : -1e30f;
                        sa[kt][r] = v; mx = fmaxf(mx, v);
                    }
            } else {
#pragma unroll
                for (int kt = 0; kt < 2; ++kt)
#pragma unroll
                    for (int r = 0; r < 16; ++r) mx = fmaxf(mx, sa[kt][r]);
                mx *= C2;
            }
            mx = fmaxf(mx, __shfl_xor(mx, 32));
            if (__ballot(mx > m_run) != 0ull) {
                const float m_new = fmaxf(m_run, mx);
                const float alpha = fexp2(m_run - m_new);
                l_run *= alpha; m_run = m_new;
                o[0] *= alpha; o[1] *= alpha;
            }
            float ps = 0.f;
            if (local) {
#pragma unroll
                for (int kt = 0; kt < 2; ++kt)
#pragma unroll
                    for (int r = 0; r < 16; ++r) { const float pv = fexp2(sa[kt][r] - m_run); sa[kt][r] = pv; ps += pv; }
            } else {
#pragma unroll
                for (int kt = 0; kt < 2; ++kt)
#pragma unroll
                    for (int r = 0; r < 16; ++r) { const float pv = fexp2(sa[kt][r] * C2 - m_run); sa[kt][r] = pv; ps += pv; }
            }
            l_run += ps;
            const char* vb = Vs + buf * ATT_TILE + (4 * h + ((lane & 15) >> 2)) * LROW + (((lane >> 4) & 1) * 16 + 4 * (lane & 3)) * 2;
#pragma unroll
            for (int ks = 0; ks < 4; ++ks) {
                const int kt = ks >> 1, rb = 8 * (ks & 1);
                u4v pk; pk[0] = pack2(sa[kt][rb], sa[kt][rb + 1]); pk[1] = pack2(sa[kt][rb + 2], sa[kt][rb + 3]);
                pk[2] = pack2(sa[kt][rb + 4], sa[kt][rb + 5]); pk[3] = pack2(sa[kt][rb + 6], sa[kt][rb + 7]);
                const s8v pf = __builtin_bit_cast(s8v, pk);
                const char* vk = vb + (kt * 32 + 16 * (ks & 1)) * LROW;
#pragma unroll
                for (int dt = 0; dt < 2; ++dt) {
                    const s4v lo = lds_tr16(vk + dt * 64), hi = lds_tr16(vk + 8 * LROW + dt * 64);
                    s8v vf; vf[0] = lo[0]; vf[1] = lo[1]; vf[2] = lo[2]; vf[3] = lo[3]; vf[4] = hi[0]; vf[5] = hi[1]; vf[6] = hi[2]; vf[7] = hi[3];
                    o[dt] = mfma32(vf, pf, o[dt]);
                }
            }
        }
        if (t + 1 < d.ntiles) lstore(buf ^ 1);
        __syncthreads();
    }
    const float l_tot = l_run + __shfl_xor(l_run, 32);
    const int qrow = wave * 32 + l31;
    if (d.part) {
        float* po = d.part + (size_t)qrow * 64;
#pragma unroll
        for (int dt = 0; dt < 2; ++dt)
#pragma unroll
            for (int g = 0; g < 4; ++g) { f4v v; v[0] = o[dt][4 * g]; v[1] = o[dt][4 * g + 1]; v[2] = o[dt][4 * g + 2]; v[3] = o[dt][4 * g + 3]; *(f4v*)(po + dt * 32 + 8 * g + 4 * h) = v; }
        if (h == 0) { d.part[256 * 64 + qrow] = m_run; d.part[256 * 64 + 256 + qrow] = l_tot; }
    } else {
        const float inv = 1.f / l_tot;
        bf16_t* po = d.out + (size_t)qrow * d.ostride;
#pragma unroll
        for (int dt = 0; dt < 2; ++dt)
#pragma unroll
            for (int g = 0; g < 4; ++g) {
                u2v pk; pk[0] = pack2(o[dt][4 * g] * inv, o[dt][4 * g + 1] * inv); pk[1] = pack2(o[dt][4 * g + 2] * inv, o[dt][4 * g + 3] * inv);
                *(u2v*)(po + dt * 32 + 8 * g + 4 * h) = pk;
            }
    }
}

DEV int ml_sidx(int grp, int b, int head, int c) { return grp == 0 ? ((b * MLH + head) * NCH_P + c) : BATCH * MLH * NCH_P + ((b * MLH + head) * NCH_S + c); }
DEV float lane_prefix_sum(float v, int lane) { for (int dlt = 1; dlt < 64; dlt <<= 1) { const float o = __shfl(v, lane - dlt); if (lane >= dlt) v += o; } return v; }
DEV float lane_prefix_max(float v, int lane) { for (int dlt = 1; dlt < 64; dlt <<= 1) { const float o = __shfl(v, lane - dlt); if (lane >= dlt) v = fmaxf(v, o); } return v; }

DEV void mlstm_summary_unit(const Params& p, char* smem, int grp, int b, int head, int c) {
    const int tid = get_tid(), lane = tid & 63, wave = tid >> 6, h = lane >> 5, l31 = lane & 31;
    char* KT = smem;
    char* VT = smem + 2 * ATT_TILE;
    float* wsS = (float*)(smem + 3 * ATT_TILE);
    float* scal = wsS + 128;
    const int tb = (grp == 0 ? b * SEQ : NP + b * DEC_SEQ) + c * 64;
    const float* gates = (const float*)(p.ws + WS_GATES);
    if (wave == 0) {
        const float* gr = gates + (size_t)(tb + lane) * 16;
        const float i_f = gr[head], lf_f = logsigmoidf_(gr[4 + head]), i_b = gr[8 + head], lf_b = logsigmoidf_(gr[12 + head]);
        const float pf = lane_prefix_sum(lf_f, lane), pb = lane_prefix_sum(lf_b, lane);
        const float tot_f = __shfl(pf, 63), tot_b = __shfl(pb, 63);
        const float g_f = (tot_f - pf) + i_f, g_b = (pb - lf_b) + i_b;
        const float G_f = wave_max(g_f), G_b = wave_max(g_b);
        wsS[lane] = expf(g_f - G_f); wsS[64 + lane] = expf(g_b - G_b);
        if (lane == 0) { scal[0] = tot_f; scal[1] = tot_b; scal[2] = G_f; scal[3] = G_b; }
    }
    __syncthreads();
    {
        const int tau = tid >> 3, ch = tid & 7;
        const u4v kv = *(const u4v*)((const bf16_t*)(p.ws + WS_MLK) + (size_t)(tb + tau) * 256 + head * 64 + ch * 8);
        const u4v vv = *(const u4v*)((const bf16_t*)(p.ws + WS_MLV) + (size_t)(tb + tau) * 256 + head * 64 + ch * 8);
        const float wf = wsS[tau], wb = wsS[64 + tau];
#pragma unroll
        for (int j = 0; j < 8; ++j) {
            const bf16_t kb = (bf16_t)(kv[j >> 1] >> (16 * (j & 1))), vb = (bf16_t)(vv[j >> 1] >> (16 * (j & 1)));
            const int dim = ch * 8 + j; const float kf = bf2f(kb);
            *(bf16_t*)(KT + dim * LROW + tau * 2) = f2bf(kf * wf);
            *(bf16_t*)(KT + ATT_TILE + dim * LROW + tau * 2) = f2bf(kf * wb);
            *(bf16_t*)(VT + dim * LROW + tau * 2) = vb;
        }
    }
    __syncthreads();
    float* sum = (float*)(p.ws + WS_MLSUM);
    const int sidx = ml_sidx(grp, b, head, c);
    {
        const int dir = wave >> 2, mi = (wave >> 1) & 1, ni = wave & 1;
        f16v acc = f16zero();
#pragma unroll
        for (int s = 0; s < 4; ++s) {
            const s8v af = *(const s8v*)(KT + dir * ATT_TILE + (mi * 32 + l31) * LROW + (16 * s + 8 * h) * 2);
            const s8v bf = *(const s8v*)(VT + (ni * 32 + l31) * LROW + (16 * s + 8 * h) * 2);
            acc = mfma32(af, bf, acc);
        }
        float* U = sum + (size_t)(sidx * 2 + dir) * MLSUM_STRIDE;
#pragma unroll
        for (int r = 0; r < 16; ++r) U[(mi * 32 + (r & 3) + 8 * (r >> 2) + 4 * h) * 64 + ni * 32 + l31] = acc[r];
    }
    if (tid < 128) {
        const int dir = tid >> 6, kd = tid & 63;
        float s = 0.f;
        for (int tau = 0; tau < 64; ++tau) s += bf2f(*(const bf16_t*)(KT + dir * ATT_TILE + kd * LROW + tau * 2));
        float* E = sum + (size_t)(sidx * 2 + dir) * MLSUM_STRIDE;
        E[4096 + kd] = s;
        if (kd == 0) { E[4160] = scal[dir]; E[4161] = scal[2 + dir]; }
    }
    __syncthreads();
}

DEV void mlstm_output_unit(const Params& p, char* smem, int l, int grp, int b, int head, int c) {
    const int tid = get_tid(), lane = tid & 63, wave = tid >> 6, h = lane >> 5, l31 = lane & 31;
    const int nc = grp ? NCH_S : NCH_P;
    char* Qs = smem;
    char* Ks = smem + 2 * ATT_TILE;
    char* VT = smem + 4 * ATT_TILE;
    char* CT = smem + 6 * ATT_TILE;
    char* QK = smem + 8 * ATT_TILE;
    float* hS = (float*)(smem + 10 * ATT_TILE);
    float* vec = hS + 2 * 64 * 68;
    float* aS = vec; float* MjS = vec + 128; float* bS = vec + 256; float* nS = vec + 384; float* denp = vec + 512; float* qnS = vec + 768; float* scal = vec + 896;
    const int tb = (grp == 0 ? b * SEQ : NP + b * DEC_SEQ) + c * 64;
    const float* sum = (const float*)(p.ws + WS_MLSUM);
    const size_t qoff = (size_t)(tb + (tid >> 3)) * 256 + head * 64 + (tid & 7) * 8;
    const u4v q_r = *(const u4v*)((const bf16_t*)(p.ws + WS_MLQ) + qoff);
    const u4v k_r = *(const u4v*)((const bf16_t*)(p.ws + WS_MLK) + qoff);
    const u4v v_r = *(const u4v*)((const bf16_t*)(p.ws + WS_MLV) + qoff);
    const u4v o_r = *(const u4v*)((const bf16_t*)(p.ws + WS_MLO) + qoff);
    float g_i = 0.f, g_f = 0.f;
    if (wave < 2) { const float* gr = (const float*)(p.ws + WS_GATES) + (size_t)(tb + (wave ? 63 - lane : lane)) * 16; g_i = gr[wave * 8 + head]; g_f = gr[wave * 8 + 4 + head]; }
#pragma unroll
    for (int dir = 0; dir < 2; ++dir) {
        float C[8], nst = 0.f, m;
        if (grp == 0) {
#pragma unroll
            for (int i = 0; i < 8; ++i) C[i] = 0.f;
            m = 0.f;
        } else {
            const size_t sb = (((size_t)b * DEPTH + l) * 2 + dir) * MLH + head;
#pragma unroll
            for (int i = 0; i < 8; ++i) C[i] = p.in[I_SC][sb * 4096 + tid + 512 * i];
            if (tid < 64) nst = p.in[I_SN][sb * 64 + tid];
            m = p.in[I_SM][sb];
        }
        const int nsteps = dir == 0 ? c : nc - 1 - c;
        const bool fin = (grp == 0) && (dir == 0 ? c == nc - 1 : c == 0);
        {
            float A = 0.f, G = -1e30f;
            if (lane < nsteps) { const float* E = sum + (size_t)(ml_sidx(grp, b, head, dir == 0 ? lane : nc - 1 - lane) * 2 + dir) * MLSUM_STRIDE; A = E[4160]; G = E[4161]; }
            const float P = lane_prefix_sum(A, lane);
            const float T = __shfl(P, 63);
            const float ev = lane < nsteps ? G + (T - P) : -1e30f;
            const float mc = fmaxf(m + T, wave_max(ev));
            const float coef = lane < nsteps ? expf(ev - mc) : 0.f;
            const float coef0 = expf(m + T - mc);
#pragma unroll
            for (int i = 0; i < 8; ++i) C[i] *= coef0;
            nst *= coef0;
#pragma unroll 4
            for (int st = 0; st < nsteps; ++st) {
                const float* E = sum + (size_t)(ml_sidx(grp, b, head, dir == 0 ? st : nc - 1 - st) * 2 + dir) * MLSUM_STRIDE;
                const float cf = __shfl(coef, st);
#pragma unroll
                for (int i = 0; i < 8; ++i) C[i] += cf * E[tid + 512 * i];
                if (tid < 64) nst += cf * E[4096 + tid];
            }
            m = mc;
        }
#pragma unroll
        for (int i = 0; i < 8; ++i) { const int e = tid + 512 * i; *(bf16_t*)(CT + dir * ATT_TILE + (e & 63) * LROW + (e >> 6) * 2) = f2bf(C[i]); }
        if (tid < 64) nS[dir * 64 + tid] = nst;
        if (tid == 0) scal[dir] = m;
        if (fin) {
            const float* E = sum + (size_t)(ml_sidx(grp, b, head, c) * 2 + dir) * MLSUM_STRIDE;
            const float A = E[4160], G = E[4161];
            const float m_new = fmaxf(A + m, G);
            const float sc = expf(A + m - m_new), su = expf(G - m_new);
            const size_t ob = (((size_t)b * DEPTH + l) * 2 + dir) * MLH + head;
#pragma unroll
            for (int i = 0; i < 8; ++i) p.out[O_MC + ob * 4096 + tid + 512 * i] = sc * C[i] + su * E[tid + 512 * i];
            if (tid < 64) p.out[O_MN + ob * 64 + tid] = sc * nst + su * E[4096 + tid];
            if (tid == 0) p.out[O_MM + ob] = m_new;
        }
    }
    {
        const int row = tid >> 3, ch = tid & 7;
#pragma unroll
        for (int dir = 0; dir < 2; ++dir) {
            const int pr = dir ? 63 - row : row;
            *(u4v*)(Qs + dir * ATT_TILE + pr * LROW + ch * 16) = q_r;
            *(u4v*)(Ks + dir * ATT_TILE + pr * LROW + ch * 16) = k_r;
#pragma unroll
            for (int j = 0; j < 8; ++j) *(bf16_t*)(VT + dir * ATT_TILE + (ch * 8 + j) * LROW + pr * 2) = (bf16_t)(v_r[j >> 1] >> (16 * (j & 1)));
        }
    }
    __syncthreads();
    if (wave < 2) {
        const int dir = wave;
        const float ig = g_i, lf = logsigmoidf_(g_f);
        const float bj = lane_prefix_sum(lf, lane);
        const float a = ig - bj;
        const float Pj = lane_prefix_max(a, lane);
        aS[dir * 64 + lane] = a; bS[dir * 64 + lane] = bj; MjS[dir * 64 + lane] = fmaxf(scal[dir], Pj);
    } else if (wave < 4) {
        const int dir = wave - 2;
        float s = 0.f;
        for (int k = 0; k < 64; ++k) s += bf2f(*(const bf16_t*)(Qs + dir * ATT_TILE + lane * LROW + k * 2)) * nS[dir * 64 + k];
        qnS[dir * 64 + lane] = s;
    }
    __syncthreads();
    const int dir = wave >> 2, rt = (wave >> 1) & 1, jt = wave & 1;
    const int j = jt * 32 + l31;
    const float Mj = MjS[dir * 64 + j];
    {
        f16v acc = f16zero();
#pragma unroll
        for (int s4 = 0; s4 < 4; ++s4) {
            const s8v af = *(const s8v*)(Ks + dir * ATT_TILE + (rt * 32 + l31) * LROW + (16 * s4 + 8 * h) * 2);
            const s8v bf = *(const s8v*)(Qs + dir * ATT_TILE + j * LROW + (16 * s4 + 8 * h) * 2);
            acc = mfma32(af, bf, acc);
        }
        float dsum = 0.f;
#pragma unroll
        for (int g = 0; g < 4; ++g) {
            float o[4];
#pragma unroll
            for (int q = 0; q < 4; ++q) {
                const int s = rt * 32 + 8 * g + 4 * h + q;
                const float w = s <= j ? expf(aS[dir * 64 + s] - Mj) : 0.f;
                o[q] = acc[4 * g + q] * w; dsum += o[q];
            }
            u2v pk; pk[0] = pack2(o[0], o[1]); pk[1] = pack2(o[2], o[3]);
            *(u2v*)(QK + dir * ATT_TILE + j * LROW + (rt * 32 + 8 * g + 4 * h) * 2) = pk;
        }
        dsum += __shfl_xor(dsum, 32);
        if (h == 0) denp[(dir * 2 + rt) * 64 + j] = dsum;
    }
    __syncthreads();
    {
        const float mst = scal[dir];
        const float decay = expf(mst - Mj);
        f16v acc = f16zero();
#pragma unroll
        for (int s4 = 0; s4 < 4; ++s4) {
            const s8v af = *(const s8v*)(CT + dir * ATT_TILE + (rt * 32 + l31) * LROW + (16 * s4 + 8 * h) * 2);
            const s8v bf = *(const s8v*)(Qs + dir * ATT_TILE + j * LROW + (16 * s4 + 8 * h) * 2);
            acc = mfma32(af, bf, acc);
        }
        acc *= decay;
#pragma unroll
        for (int s4 = 0; s4 < 4; ++s4) {
            const s8v af = *(const s8v*)(VT + dir * ATT_TILE + (rt * 32 + l31) * LROW + (16 * s4 + 8 * h) * 2);
            const s8v bf = *(const s8v*)(QK + dir * ATT_TILE + j * LROW + (16 * s4 + 8 * h) * 2);
            acc = mfma32(af, bf, acc);
        }
        const float den = decay * qnS[dir * 64 + j] + denp[(dir * 2) * 64 + j] + denp[(dir * 2 + 1) * 64 + j];
        const float dn = fmaxf(fabsf(den), expf(-(bS[dir * 64 + j] + Mj)));
        const float inv = 1.f / dn;
#pragma unroll
        for (int g = 0; g < 4; ++g) { f4v o; o[0] = acc[4 * g] * inv; o[1] = acc[4 * g + 1] * inv; o[2] = acc[4 * g + 2] * inv; o[3] = acc[4 * g + 3] * inv;
            *(f4v*)(hS + (dir * 64 + j) * 68 + rt * 32 + 8 * g + 4 * h) = o; }
    }
    __syncthreads();
    {
        const int tau = tid >> 3, v8 = (tid & 7) * 8;
        float hv[8]; float s = 0.f;
#pragma unroll
        for (int q = 0; q < 8; ++q) { hv[q] = hS[tau * 68 + v8 + q] + hS[(64 + 63 - tau) * 68 + v8 + q]; s += hv[q]; }
        s += __shfl_xor(s, 1); s += __shfl_xor(s, 2); s += __shfl_xor(s, 4);
        const float mu = s * (1.f / 64.f);
        float qq = 0.f;
#pragma unroll
        for (int q = 0; q < 8; ++q) { const float dlt = hv[q] - mu; qq += dlt * dlt; }
        qq += __shfl_xor(qq, 1); qq += __shfl_xor(qq, 2); qq += __shfl_xor(qq, 4);
        const float rstd = 1.f / sqrtf(qq * (1.f / 64.f) + EPS);
        const int t = tb + tau;
        const u4v ov = o_r;
        const float* ng = p.in[I_MLG] + (size_t)l * 256 + head * 64 + v8;
        float o[8];
#pragma unroll
        for (int q = 0; q < 8; ++q) { const float og = bf2f((bf16_t)(ov[q >> 1] >> (16 * (q & 1)))); o[q] = (hv[q] - mu) * rstd * ng[q] * sigmoidf_(og); }
        u4v pk; pk[0] = pack2(o[0], o[1]); pk[1] = pack2(o[2], o[3]); pk[2] = pack2(o[4], o[5]); pk[3] = pack2(o[6], o[7]);
        *(u4v*)((bf16_t*)(p.ws + WS_MIXED) + (size_t)t * MIXW + 384 + head * 64 + v8) = pk;
    }
    __syncthreads();
}

DEV int queue_next(const Params& p, char* smem, int qi) {
    int* slot = (int*)(smem + SMEM_XB + 32);
    __syncthreads();
    if (threadIdx.x == 0) {
#ifdef EMU
        unsigned* w = (unsigned*)(p.ws + WS_BAR) + QUEUE_WORD0 + 64 * qi; *slot = (int)(*w)++;
#else
        *slot = (int)__hip_atomic_fetch_add((unsigned*)(p.ws + WS_BAR) + QUEUE_WORD0 + 64 * qi, 1u, __ATOMIC_RELAXED, __HIP_MEMORY_SCOPE_AGENT);
#endif
    }
    __syncthreads();
    return *slot;
}
DEV void phase_attn(const Params& p, char* smem, int l, int qi) {
    constexpr int QB_S = DEC_SEQ / 256, QB_P = SEQ / 256;
    constexpr int U_SG = DEC_BATCH * GQH * QB_S * 2, U_SN = DEC_BATCH * NAH * QB_S, U_PN = BATCH * NAH * QB_P, U_PG = BATCH * GQH * QB_P;
    constexpr int U_MP = BATCH * MLH * NCH_P, U_MS = DEC_BATCH * MLH * NCH_S;
    constexpr int NU = U_SG + U_SN + U_PN + U_PG + U_MP + U_MS;
    const bf16_t* naq = (const bf16_t*)(p.ws + WS_NAQ); const bf16_t* nak = (const bf16_t*)(p.ws + WS_NAK); const bf16_t* nav = (const bf16_t*)(p.ws + WS_NAV);
    const bf16_t* gqq = (const bf16_t*)(p.ws + WS_GQQ); const bf16_t* gqk = (const bf16_t*)(p.ws + WS_GQK); const bf16_t* gqv = (const bf16_t*)(p.ws + WS_GQV);
    bf16_t* mixed = (bf16_t*)(p.ws + WS_MIXED);
    for (;;) {
        int u = queue_next(p, smem, qi);
        if (u >= NU) break;
#ifdef PROBE_ATT
        if (qi >= 8) { const int cls = u < U_SG ? 1 : u < U_SG + U_SN ? 2 : u < U_SG + U_SN + U_PN + U_PG ? 3 : 4; if (cls != PROBE_ATT) continue; }
#endif
        AttnDesc d; d.na = 0; d.r0 = 0; d.rlo = 0; d.rpb = nullptr; d.part = nullptr; d.out = nullptr; d.ostride = MIXW; d.n0 = 0; d.k0 = d.v0 = nullptr; d.stride0 = 0;
        if (u < U_SG) {
            const int half = u & 1, qb = (u >> 1) % QB_S, qh = (u / (2 * QB_S)) % GQH, b = u / (2 * QB_S * GQH);
            const int kvh = qh / (GQH / GQKV);
            constexpr int NCT = PAST / 64, TT = NCT + DEC_SEQ / 64, H0 = TT / 2;
            const size_t tq = (size_t)NP + (size_t)b * DEC_SEQ + qb * 256;
            d.q = gqq + tq * 384 + qh * 64; d.qstride = 384;
            const bf16_t* lk = gqk + ((size_t)NP + (size_t)b * DEC_SEQ) * 128 + kvh * 64; const bf16_t* lv = gqv + ((size_t)NP + (size_t)b * DEC_SEQ) * 128 + kvh * 64;
            if (half == 0) {
                d.n0 = NCT; d.ntiles = H0; d.stride0 = 128;
                const size_t co = (((size_t)b * DEPTH + l) * PAST) * 128 + kvh * 64;
                d.k0 = (const bf16_t*)(p.ws + WS_CGQK) + co; d.v0 = (const bf16_t*)(p.ws + WS_CGQV) + co;
                d.k1 = lk; d.v1 = lv; d.stride1 = 128;
            } else {
                d.n0 = 0; d.ntiles = TT - H0; d.stride1 = 128;
                d.k1 = lk + (size_t)(H0 - NCT) * 64 * 128; d.v1 = lv + (size_t)(H0 - NCT) * 64 * 128;
            }
            d.part = (float*)(p.ws + WS_PART) + (size_t)u * PART_STRIDE;
        } else if (u < U_SG + U_SN) {
            const int uu = u - U_SG; const int qb = uu % QB_S, hd = (uu / QB_S) % NAH, b = uu / (QB_S * NAH);
            const size_t t0 = (size_t)NP + (size_t)b * DEC_SEQ;
            d.q = naq + (t0 + qb * 256) * 384 + hd * 64; d.qstride = 384;
            d.na = 1; d.r0 = qb * 4; d.rlo = na_row_start(d.r0);
            const int rhi = na_row_start(d.r0 + 3) + KR;
            d.n0 = PAST / 64; d.ntiles = d.n0 + (rhi - d.rlo); d.stride0 = 384; d.stride1 = 384;
            const size_t co = (((size_t)b * DEPTH + l) * PAST) * 384 + hd * 64;
            d.k0 = (const bf16_t*)(p.ws + WS_CNAK) + co; d.v0 = (const bf16_t*)(p.ws + WS_CNAV) + co;
            d.k1 = nak + (t0 + (size_t)d.rlo * 64) * 384 + hd * 64; d.v1 = nav + (t0 + (size_t)d.rlo * 64) * 384 + hd * 64;
            d.rpb = p.in[I_RPB] + ((size_t)l * NAH + hd) * 15 * 31;
            d.out = mixed + (t0 + qb * 256) * MIXW + hd * 64;
        } else if (u < U_SG + U_SN + U_PN) {
            const int uu = u - U_SG - U_SN; const int qb = uu % QB_P, hd = (uu / QB_P) % NAH, b = uu / (QB_P * NAH);
            const size_t t0 = (size_t)b * SEQ;
            d.q = naq + (t0 + qb * 256) * 384 + hd * 64; d.qstride = 384;
            d.n0 = 0; d.ntiles = SEQ / 64; d.stride1 = 384; d.k1 = nak + t0 * 384 + hd * 64; d.v1 = nav + t0 * 384 + hd * 64;
            d.out = mixed + (t0 + qb * 256) * MIXW + hd * 64;
        } else if (u < U_SG + U_SN + U_PN + U_PG) {
            const int uu = u - U_SG - U_SN - U_PN; const int qb = uu % QB_P, qh = (uu / QB_P) % GQH, b = uu / (QB_P * GQH);
            const int kvh = qh / (GQH / GQKV);
            const size_t t0 = (size_t)b * SEQ;
            d.q = gqq + (t0 + qb * 256) * 384 + qh * 64; d.qstride = 384;
            d.n0 = 0; d.ntiles = SEQ / 64; d.stride1 = 128; d.k1 = gqk + t0 * 128 + kvh * 64; d.v1 = gqv + t0 * 128 + kvh * 64;
            d.out = mixed + (t0 + qb * 256) * MIXW + 640 + qh * 64;
        } else {
            int uu = u - (U_SG + U_SN + U_PN + U_PG); const int grp = uu >= U_MP ? 1 : 0; if (grp) uu -= U_MP;
            const int nch = grp ? NCH_S : NCH_P;
            mlstm_summary_unit(p, smem, grp, uu / (nch * MLH), (uu / nch) % MLH, uu % nch);
        }
        if (u < U_SG + U_SN + U_PN + U_PG) attn_unit(smem, d);
    }
}

DEV void phase_mlout(const Params& p, char* smem, int l) {
    constexpr int QB_S = DEC_SEQ / 256;
    constexpr int U_MS = DEC_BATCH * MLH * NCH_S, U_MP = BATCH * MLH * NCH_P, U_CB = DEC_BATCH * GQH * QB_S;
    const int tid = get_tid(), lane = tid & 63, wave = tid >> 6;
    for (int tk = blockIdx.x + gridDim.x * wave; tk < U_CB * 4; tk += gridDim.x * 8) {
        const int uu = tk >> 2, sl = tk & 3;
        const int qb = uu % QB_S, qh = (uu / QB_S) % GQH, b = uu / (QB_S * GQH);
        const float* p0 = (const float*)(p.ws + WS_PART) + (size_t)(2 * uu) * PART_STRIDE; const float* p1 = p0 + PART_STRIDE;
        const int q = sl * 64 + (lane >> 1) + 32 * 0, d0 = (lane & 1) * 32;
#pragma unroll
        for (int hq = 0; hq < 2; ++hq) {
            const int qq = q + 32 * hq;
            const float m0 = p0[256 * 64 + qq], m1 = p1[256 * 64 + qq], l0 = p0[256 * 64 + 256 + qq], l1 = p1[256 * 64 + 256 + qq];
            const float m = fmaxf(m0, m1), w0 = exp2f(m0 - m), w1 = exp2f(m1 - m);
            const float inv = 1.f / (l0 * w0 + l1 * w1);
            bf16_t* dst = (bf16_t*)(p.ws + WS_MIXED) + ((size_t)NP + (size_t)b * DEC_SEQ + qb * 256 + qq) * MIXW + 640 + qh * 64 + d0;
#pragma unroll
            for (int i = 0; i < 8; ++i) {
                const f4v a = *(const f4v*)(p0 + (size_t)qq * 64 + d0 + 4 * i), bb = *(const f4v*)(p1 + (size_t)qq * 64 + d0 + 4 * i);
                u2v pk; pk[0] = pack2((a[0] * w0 + bb[0] * w1) * inv, (a[1] * w0 + bb[1] * w1) * inv); pk[1] = pack2((a[2] * w0 + bb[2] * w1) * inv, (a[3] * w0 + bb[3] * w1) * inv);
                *(u2v*)(dst + 4 * i) = pk;
            }
        }
    }
    for (int u = blockIdx.x; u < U_MS + U_MP; u += gridDim.x) {
        const int grp = u < U_MS ? 1 : 0; const int uu = grp ? u : u - U_MS; const int nch = grp ? NCH_S : NCH_P;
        mlstm_output_unit(p, smem, l, grp, uu / (nch * MLH), (uu / nch) % MLH, uu % nch);
    }
}

constexpr int N_PHASES = 2 + 9 * DEPTH;
#ifndef EMU
typedef const __attribute__((address_space(4))) Params* KParamsPtr;
DEV void load_params(Params& p) {
    KParamsPtr kp = (KParamsPtr)__builtin_amdgcn_kernarg_segment_ptr();
    asm volatile("" : "+s"(kp));
#pragma unroll
    for (int i = 0; i < N_IN; ++i) p.in[i] = kp->in[i];
    p.out = kp->out; p.ws = kp->ws; p.ph0 = kp->ph0; p.ph1 = kp->ph1;
}
#endif
#ifdef EMU
static char emu_smem[SMEM_BYTES + 64];
#endif
__global__ void __launch_bounds__(512, 2) mega_kernel(Params p_) {
    const int ph0 = p_.ph0, ph1 = p_.ph1;
#ifdef EMU
    char* smem = emu_smem;
#define GRID_SYNC() do {} while (0)
#else
    extern __shared__ __attribute__((aligned(16))) char smem[];
    if (threadIdx.x == 0) *(u4v*)(smem + SMEM_XB) = (u4v){0u, 0u, 0u, 0u};
    __syncthreads();
    (void)xcd_barrier_post((unsigned*)(p_.ws + WS_BAR), (volatile LAS unsigned*)(smem + SMEM_XB));
    const bool multi = (ph1 - ph0) > 1;
#define GRID_SYNC() do { if (multi) { KParamsPtr kpb = (KParamsPtr)__builtin_amdgcn_kernarg_segment_ptr(); asm volatile("" : "+s"(kpb)); \
        XcdBarrier xb; xb.bar = (unsigned*)(kpb->ws + WS_BAR); xb.x = xb_xcc_id(); xb.st = (volatile LAS unsigned*)(smem + SMEM_XB); xcd_barrier(xb); } } while (0)
#endif
    int ph = 0;
#ifndef KIND_MASK
#define KIND_MASK 0x3ff
#endif
#ifdef EMU
#define LOAD_PARAMS() const Params& p = p_
#else
#define LOAD_PARAMS() Params p; load_params(p)
#endif
#ifndef DOUBLE_MASK
#define DOUBLE_MASK 0
#endif
#define PH_KIND() (ph == 0 ? 0 : ph == 1 + 9 * DEPTH ? 1 : 1 + (ph - 1) % 9)
#define RUN_PHASE(body) do { if (((KIND_MASK >> PH_KIND()) & 1) && ph >= ph0 && ph < ph1) { \
    if (DOUBLE_MASK && ((DOUBLE_MASK >> PH_KIND()) & 1)) { { const int rep_ = 1; LOAD_PARAMS(); body; } GRID_SYNC(); } \
    { const int rep_ = 0; LOAD_PARAMS(); body; } if (ph + 1 < ph1) GRID_SYNC(); } ++ph; } while (0)
    RUN_PHASE(phase_ada(p, smem));
    for (int l = 0; l < DEPTH; ++l) {
        RUN_PHASE(phase_rows<0>(p, smem, l));
        RUN_PHASE(phase_inproj<0>(p, smem, l));
        RUN_PHASE(phase_attn(p, smem, l, l + DEPTH * rep_));
        RUN_PHASE(phase_mlout(p, smem, l));
        RUN_PHASE(phase_outproj<0>(p, smem, l));
        RUN_PHASE(phase_rows<1>(p, smem, l));
        RUN_PHASE(phase_topk(p, smem));
        RUN_PHASE(phase_gateup<0>(p, smem, l));
        RUN_PHASE(phase_down<0>(p, smem, l));
    }
    RUN_PHASE(phase_rows<0>(p, smem, DEPTH));
}

#if !defined(EMU) && defined(PROBE_KIND)
__global__ void __launch_bounds__(512, 2) probe_kernel(Params p) {
    extern __shared__ __attribute__((aligned(16))) char smem[];
    for (int r = 0; r < PROBE_REPS; ++r) {
#if PROBE_KIND == 8
        phase_gateup<PROBE_VAR>(p, smem, 1);
#elif PROBE_KIND == 9
        phase_down<PROBE_VAR>(p, smem, 1);
#elif PROBE_KIND == 2
        phase_inproj<PROBE_VAR>(p, smem, 1);
#elif PROBE_KIND == 5
        phase_outproj<PROBE_VAR>(p, smem, 1);
#elif PROBE_KIND == 0
        phase_ada(p, smem);
#elif PROBE_KIND == 1
        phase_rows<0>(p, smem, 1);
#elif PROBE_KIND == 6
        phase_rows<1>(p, smem, 1);
#elif PROBE_KIND == 7
        phase_topk(p, smem);
#elif PROBE_KIND == 3
        phase_attn(p, smem, 1, 8 + r);
#elif PROBE_KIND == 4
        phase_mlout(p, smem, 1);
#endif
        __syncthreads();
    }
}
#endif
#ifndef EMU
#ifndef MK_N_LAUNCHES
#define MK_N_LAUNCHES 1
#endif
extern "C" void kernel_launch(void* const* d_in, const int* in_sizes, int n_in, void* d_out, int out_size, void* d_ws, size_t ws_size, hipStream_t stream) {
    (void)in_sizes; (void)n_in; (void)out_size; (void)ws_size;
    static int grid = 0;
    if (!grid) {
        int dev = 0, cus = 0, per_cu = 0;
        (void)hipGetDevice(&dev);
        (void)hipDeviceGetAttribute(&cus, hipDeviceAttributeMultiprocessorCount, dev);
        (void)hipFuncSetAttribute((const void*)mega_kernel, hipFuncAttributeMaxDynamicSharedMemorySize, SMEM_BYTES);
        (void)hipOccupancyMaxActiveBlocksPerMultiprocessor(&per_cu, mega_kernel, 512, SMEM_BYTES);
        grid = cus * (per_cu < 1 ? per_cu : 1);
        if (grid <= 0) grid = cus;
    }
    (void)hipMemsetAsync((char*)d_ws + WS_BAR, 0, WS_BAR_BYTES, stream);
    Params p = {};
    for (int i = 0; i < N_IN; ++i) p.in[i] = (const float*)d_in[i];
    p.out = (float*)d_out; p.ws = (char*)d_ws;
#if MK_N_LAUNCHES == 1
    p.ph0 = 0; p.ph1 = N_PHASES;
    mega_kernel<<<dim3(grid), dim3(512), SMEM_BYTES, stream>>>(p);
#ifdef PROBE_KIND
    (void)hipFuncSetAttribute((const void*)probe_kernel, hipFuncAttributeMaxDynamicSharedMemorySize, SMEM_BYTES);
    probe_kernel<<<dim3(grid), dim3(512), SMEM_BYTES, stream>>>(p);
#endif
#else
    for (int ph = 0; ph < N_PHASES; ++ph) { p.ph0 = ph; p.ph1 = ph + 1; mega_kernel<<<dim3(grid), dim3(512), SMEM_BYTES, stream>>>(p); }
#endif
}
#endif
```

```cpp
#ifndef EMU
#include <hip/hip_runtime.h>
#define DEV __device__ __forceinline__
#else
#define DEV static inline __attribute__((always_inline))
#endif
#include <stdint.h>
#include <stddef.h>

#ifndef CFG_D
#define CFG_D 1024
#define CFG_BATCH 16
#define CFG_SEQ 256
#define CFG_DEC_BATCH 2
#define CFG_DEC_SEQ 2048
#define CFG_PAST 256
#define CFG_EH 2816
#endif
constexpr int D = CFG_D, BATCH = CFG_BATCH, SEQ = CFG_SEQ, DEC_BATCH = CFG_DEC_BATCH, DEC_SEQ = CFG_DEC_SEQ, PAST = CFG_PAST, EH = CFG_EH;
constexpr int DEPTH = 2, HD = 64, NAH = 6, MLH = 4, GQH = 6, GQKV = 2, NEXP = 16, GRIDW = 64;
constexpr int NP = BATCH * SEQ, NS = DEC_BATCH * DEC_SEQ, NT = NP + NS, NCOND = 1 + DEC_BATCH;
constexpr int PROJ_W = 2832, MIXW = 1024;
constexpr int CAP_P = SEQ / 8, CAP_S = DEC_SEQ / 8, SLOTS = BATCH * CAP_P + DEC_BATCH * CAP_S;
constexpr int ROWS = DEC_SEQ / GRIDW, KR = ROWS < 8 ? ROWS : 8, KC = 16;
constexpr int NCH_P = SEQ / 64, NCH_S = DEC_SEQ / 64;
constexpr float ALPHA = 1.41421356237309515f;
constexpr float ATT_SCALE = 0.125f;
constexpr float EPS = 1e-6f;
static_assert(SLOTS % 256 == 0 && NP % 256 == 0 && NS % 256 == 0 && SEQ % 256 == 0 && DEC_SEQ % 256 == 0, "tile divisibility");
static_assert(D % 256 == 0 && EH % 128 == 0 && PAST % 64 == 0, "tile divisibility");

typedef unsigned short bf16_t;
typedef short s8v __attribute__((ext_vector_type(8)));
typedef short s4v __attribute__((ext_vector_type(4)));
typedef float f16v __attribute__((ext_vector_type(16)));
typedef float f4v __attribute__((ext_vector_type(4)));
typedef unsigned u4v __attribute__((ext_vector_type(4)));
typedef unsigned u2v __attribute__((ext_vector_type(2)));

enum { I_XP = 0, I_XS, I_C, I_CNAK, I_CNAV, I_CGQK, I_CGQV, I_SC, I_SN, I_SM, I_CCTX, I_ADAW, I_ADAB, I_WIN, I_BGATE, I_WOUT, I_RPB, I_QKG, I_MLG,
       I_LNG, I_LNB, I_RW, I_WG, I_WU, I_WD, N_IN };

constexpr size_t O_YP = 0;
constexpr size_t O_YS = O_YP + (size_t)NP * D;
constexpr size_t O_NAK = O_YS + (size_t)NS * D;
constexpr size_t O_NAV = O_NAK + (size_t)BATCH * DEPTH * SEQ * NAH * HD;
constexpr size_t O_GQK = O_NAV + (size_t)BATCH * DEPTH * SEQ * NAH * HD;
constexpr size_t O_GQV = O_GQK + (size_t)BATCH * DEPTH * SEQ * GQKV * HD;
constexpr size_t O_MC = O_GQV + (size_t)BATCH * DEPTH * SEQ * GQKV * HD;
constexpr size_t O_MN = O_MC + (size_t)BATCH * DEPTH * 2 * MLH * HD * HD;
constexpr size_t O_MM = O_MN + (size_t)BATCH * DEPTH * 2 * MLH * HD;
constexpr size_t O_END = O_MM + (size_t)BATCH * DEPTH * 2 * MLH;

constexpr size_t al256(size_t x) { return (x + 255) & ~(size_t)255; }
constexpr size_t WS_BAR = 0;
constexpr size_t WS_BAR_BYTES = 32768;
constexpr size_t WS_MODS = WS_BAR + WS_BAR_BYTES;
constexpr size_t WS_ROPE = al256(WS_MODS + (size_t)DEPTH * NCOND * 6 * D * 4);
constexpr size_t WS_CNAK = al256(WS_ROPE + 64 * 16 * 2 * 4);
constexpr size_t WS_CNAV = al256(WS_CNAK + (size_t)DEC_BATCH * DEPTH * PAST * NAH * HD * 2);
constexpr size_t WS_CGQK = al256(WS_CNAV + (size_t)DEC_BATCH * DEPTH * PAST * NAH * HD * 2);
constexpr size_t WS_CGQV = al256(WS_CGQK + (size_t)DEC_BATCH * DEPTH * PAST * GQKV * HD * 2);
constexpr size_t WS_XBUF = al256(WS_CGQV + (size_t)DEC_BATCH * DEPTH * PAST * GQKV * HD * 2);
constexpr size_t WS_HMOD = al256(WS_XBUF + (size_t)NT * D * 4);
constexpr size_t WS_GATES = al256(WS_HMOD + (size_t)NT * D * 2);
constexpr size_t WS_NAQ = al256(WS_GATES + (size_t)NT * 16 * 4);
constexpr size_t WS_NAK = al256(WS_NAQ + (size_t)NT * 384 * 2);
constexpr size_t WS_NAV = al256(WS_NAK + (size_t)NT * 384 * 2);
constexpr size_t WS_MLQ = al256(WS_NAV + (size_t)NT * 384 * 2);
constexpr size_t WS_MLK = al256(WS_MLQ + (size_t)NT * 256 * 2);
constexpr size_t WS_MLV = al256(WS_MLK + (size_t)NT * 256 * 2);
constexpr size_t WS_MLO = al256(WS_MLV + (size_t)NT * 256 * 2);
constexpr size_t WS_GQQ = al256(WS_MLO + (size_t)NT * 256 * 2);
constexpr size_t WS_GQK = al256(WS_GQQ + (size_t)NT * 384 * 2);
constexpr size_t WS_GQV = al256(WS_GQK + (size_t)NT * 128 * 2);
constexpr size_t WS_MIXED = al256(WS_GQV + (size_t)NT * 128 * 2);
constexpr size_t WS_U = al256(WS_MIXED + (size_t)NT * MIXW * 2);
constexpr size_t WS_X1 = al256(WS_U + (size_t)NT * D * 4);
constexpr size_t WS_H2 = al256(WS_X1 + (size_t)NT * D * 4);
constexpr size_t WS_AFF = al256(WS_H2 + (size_t)NT * D * 2);
constexpr size_t WS_IDX = al256(WS_AFF + (size_t)NT * 16 * 4);
constexpr size_t WS_GSEL = al256(WS_IDX + (size_t)NEXP * SLOTS * 4);
constexpr size_t WS_TOKSLOT = al256(WS_GSEL + (size_t)NEXP * SLOTS * 4);
constexpr size_t WS_HID = al256(WS_TOKSLOT + (size_t)NT * 16 * 4);
constexpr size_t WS_YE = al256(WS_HID + (size_t)NEXP * SLOTS * EH * 2);
constexpr int MLSUM_STRIDE = 4096 + 64 + 64;
constexpr int N_MLSUM = (BATCH * NCH_P + DEC_BATCH * NCH_S) * MLH * 2;
constexpr size_t WS_MLSUM = al256(WS_YE + (size_t)NEXP * SLOTS * D * 2);
constexpr int PART_STRIDE = 256 * 64 + 512;
constexpr int N_PART = DEC_BATCH * GQH * (DEC_SEQ / 256) * 2;
constexpr size_t WS_PART = al256(WS_MLSUM + (size_t)N_MLSUM * MLSUM_STRIDE * 4);
constexpr size_t WS_TOTAL = al256(WS_PART + (size_t)N_PART * PART_STRIDE * 4);

struct Params {
    const float* in[N_IN];
    float* out;
    char* ws;
    int ph0, ph1;
};

DEV float bf2f(bf16_t s) { unsigned u = ((unsigned)s) << 16; return __builtin_bit_cast(float, u); }
DEV bf16_t f2bf(float f) {
#ifdef EMU
    unsigned u = __builtin_bit_cast(unsigned, f); u += 0x7fffu + ((u >> 16) & 1u); return (bf16_t)(u >> 16);
#else
    return __builtin_bit_cast(bf16_t, (__bf16)f);
#endif
}
DEV unsigned pack2(float a, float b) {
#ifdef EMU
    return (unsigned)f2bf(a) | ((unsigned)f2bf(b) << 16);
#else
    typedef __bf16 b2 __attribute__((ext_vector_type(2))); b2 r; r[0] = (__bf16)a; r[1] = (__bf16)b; return __builtin_bit_cast(unsigned, r);
#endif
}
DEV float fexp(float x) {
#ifdef EMU
    return expf(x);
#else
    return __expf(x);
#endif
}
DEV float fexp2(float x) {
#ifdef EMU
    return exp2f(x);
#else
    return __builtin_amdgcn_exp2f(x);
#endif
}
DEV float frcp(float x) {
#ifdef EMU
    return 1.f / x;
#else
    return __builtin_amdgcn_rcpf(x);
#endif
}
DEV float sigmoidf_(float x) { return frcp(1.f + fexp(-x)); }
DEV float siluf_(float x) { return x * frcp(1.f + fexp(-x)); }
DEV float flog(float x) {
#ifdef EMU
    return logf(x);
#else
    return __logf(x);
#endif
}
DEV float frsqrt(float x) {
#ifdef EMU
    return 1.f / sqrtf(x);
#else
    return __builtin_amdgcn_rsqf(x);
#endif
}
DEV float logsigmoidf_(float x) { return fminf(x, 0.f) - flog(1.f + fexp(-fabsf(x))); }
DEV f16v mfma32(s8v a, s8v b, f16v c) {
#ifdef EMU
    return emu_mfma_32x32x16_bf16(a, b, c);
#else
    typedef __bf16 bf8 __attribute__((ext_vector_type(8)));
    return __builtin_amdgcn_mfma_f32_32x32x16_bf16(__builtin_bit_cast(bf8, a), __builtin_bit_cast(bf8, b), c, 0, 0, 0);
#endif
}
DEV s4v lds_tr16(const void* p) {
#ifdef EMU
    return emu_ds_read_tr16_b64(p);
#else
    typedef s4v __attribute__((address_space(3))) * lp;
    return __builtin_amdgcn_ds_read_tr16_b64_v4i16((lp)(p));
#endif
}
#ifdef EMU
DEV float wave_sum(float v) { for (int m = 32; m >= 1; m >>= 1) v += __shfl_xor(v, m); return v; }
#else
template <int CTRL, int RM> DEV float dpp_f(float v) { return __builtin_bit_cast(float, __builtin_amdgcn_update_dpp(0, __builtin_bit_cast(int, v), CTRL, RM, 0xF, false)); }
DEV float wave_sum(float v) {
    v += dpp_f<0xB1, 0xF>(v); v += dpp_f<0x4E, 0xF>(v); v += dpp_f<0x141, 0xF>(v); v += dpp_f<0x140, 0xF>(v);
    v += dpp_f<0x142, 0xA>(v); v += dpp_f<0x143, 0xC>(v);
    return __builtin_bit_cast(float, __builtin_amdgcn_readlane(__builtin_bit_cast(int, v), 63));
}
#endif
DEV float wave_max(float v) { for (int m = 32; m >= 1; m >>= 1) v = fmaxf(v, __shfl_xor(v, m)); return v; }
DEV f16v f16zero() { f16v z; for (int i = 0; i < 16; ++i) z[i] = 0.f; return z; }

#ifdef EMU
#define VGPR_PIN(x) do {} while (0)
#define SGPR_PIN(x) do {} while (0)
#define SCHED_FENCE() do {} while (0)
#define CFENCE() do {} while (0)
#else
#define SCHED_FENCE() __builtin_amdgcn_sched_barrier(0)
#define SGPR_PIN(x) asm volatile("" : "+s"(x))
#define VGPR_PIN(x) asm volatile("" : "+v"(x))
#define CFENCE() asm volatile("" ::: "memory")
#endif
#ifdef EMU
DEV int get_tid() { return (int)threadIdx.x; }
#else
DEV int get_tid() { int t = threadIdx.x; asm volatile("" : "+v"(t)); return t; }
#endif
struct UnitIter { int i, end, step; };
DEV UnitIter unit_iter(int NU) {
    const int G = (int)gridDim.x, b = (int)blockIdx.x;
    UnitIter it;
#ifndef XCD_MODE
#define XCD_MODE 0
#endif
    if ((G & 7) == 0 && (NU & 7) == 0) { const int W = G >> 3, x = XCD_MODE ? b / W : b & 7, j = XCD_MODE ? b % W : b >> 3, C = NU >> 3; it.i = x * C + j; it.end = (x + 1) * C; it.step = W; }
    else { it.i = b; it.end = NU; it.step = G; }
    return it;
}
DEV int tok_cond(int t) { return t < NP ? 0 : 1 + (t - NP) / DEC_SEQ; }

#ifndef EMU
#define XB_TMO      128
#define XB_XCNT(j)  (256  + 64 * (j))
#define XB_XSUB(j)  (1280 + 64 * (j))
#define XB_XGEN(j)  (2304 + 64 * (j))
#define XB_TOP      3328
#define XB_TOPGEN   3392
#define XCD_BAR_WORDS 3456
#define XB_SPIN_CAP (1u << 20)
#define LAS __attribute__((address_space(3)))
__device__ __forceinline__ unsigned xb_ld(unsigned* p)              { return __hip_atomic_load(p, __ATOMIC_RELAXED, __HIP_MEMORY_SCOPE_AGENT); }
__device__ __forceinline__ unsigned xb_add(unsigned* p, unsigned v) { return __hip_atomic_fetch_add(p, v, __ATOMIC_RELAXED, __HIP_MEMORY_SCOPE_AGENT); }
__device__ __forceinline__ unsigned xb_xcc_id() { return (unsigned)__builtin_amdgcn_s_getreg((3 << 11) | 20) & 0xFu; }
#define XB_SPIN(cond, bar) do { unsigned _sp = 0; while (cond) { __builtin_amdgcn_s_sleep(1); \
    if ((++_sp & 255u) == 0u) { if (xb_ld(&(bar)[XB_TMO])) break; if (_sp > XB_SPIN_CAP) { atomicAdd(&(bar)[XB_TMO], 1u); break; } } } } while (0)
struct XcdBarrier { unsigned* bar; unsigned x; volatile LAS unsigned* st; };
__device__ __forceinline__ XcdBarrier xcd_barrier_post(unsigned* bar, volatile LAS unsigned* st) {
    XcdBarrier b; b.bar = bar; b.x = xb_xcc_id(); b.st = st;
    if (threadIdx.x == 0) (void)xb_add(&bar[XB_XCNT(b.x)], 1u);
    return b;
}
__device__ __forceinline__ void xcd_barrier_complete(unsigned* bar, unsigned x, unsigned& nloc, unsigned& nx) {
    const unsigned G = gridDim.x * gridDim.y * gridDim.z;
    unsigned sum, cnt, mine, sp = 0u;
    for (;;) {
        sum = 0u; cnt = 0u; mine = 0u;
#pragma unroll
        for (unsigned j = 0; j < 16; ++j) { const unsigned c = xb_ld(&bar[XB_XCNT(j)]); sum += c; cnt += (c > 0u) ? 1u : 0u; mine = (j == x) ? c : mine; }
        if (sum == G) break;
        __builtin_amdgcn_s_sleep(1);
        if ((++sp & 255u) == 0u) { if (xb_ld(&bar[XB_TMO])) break; if (sp > XB_SPIN_CAP) { atomicAdd(&bar[XB_TMO], 1u); break; } }
    }
    nloc = mine > 0u ? mine : 1u; nx = cnt > 0u ? cnt : 1u;
}
__device__ __forceinline__ void xcd_barrier(const XcdBarrier& b) {
    asm volatile("s_waitcnt vmcnt(0)" ::: "memory");
    __syncthreads();
    if (threadIdx.x == 0) {
        unsigned* bar = b.bar;
        __builtin_amdgcn_s_waitcnt(0);
        unsigned nloc = b.st[0], nx = b.st[1];
        if (nloc == 0u) { xcd_barrier_complete(bar, b.x, nloc, nx); b.st[0] = nloc; b.st[1] = nx; }
        const unsigned old = xb_add(&bar[XB_XSUB(b.x)], 1u);
        const unsigned gen = old / nloc;
        if (old + 1u == (gen + 1u) * nloc) {
            __builtin_amdgcn_fence(__ATOMIC_RELEASE, "agent");
            asm volatile("s_waitcnt vmcnt(0)" ::: "memory");
            const unsigned og = xb_add(&bar[XB_TOP], 1u);
            const unsigned tg = og / nx;
            if (og + 1u == (tg + 1u) * nx) xb_add(&bar[XB_TOPGEN], 1u);
            else XB_SPIN(xb_ld(&bar[XB_TOPGEN]) == tg, bar);
            __builtin_amdgcn_fence(__ATOMIC_ACQUIRE, "agent");
            xb_add(&bar[XB_XGEN(b.x)], 1u);
            asm volatile("s_waitcnt vmcnt(0)" ::: "memory");
        } else {
            XB_SPIN(xb_ld(&bar[XB_XGEN(b.x)]) == gen, bar);
            __builtin_amdgcn_fence(__ATOMIC_ACQUIRE, "agent");
            asm volatile("s_waitcnt vmcnt(0)" ::: "memory");
        }
    }
    __syncthreads();
}
#endif
constexpr int QUEUE_WORD0 = 4096;

constexpr int LROW = 144;
constexpr int GEMM_AS = 256 * LROW;
constexpr int GEMM_BS = 64 * (256 * 2 + 64);
constexpr int SMEM_XB = 2 * GEMM_AS + 2 * GEMM_BS;
constexpr int SMEM_AUX = SMEM_XB + 64;
constexpr int SMEM_BYTES = SMEM_AUX + 2048;

#ifdef EMU
struct BufRsrc { const char* base; };
DEV BufRsrc make_rsrc(const void* p) { BufRsrc r; r.base = (const char*)p; return r; }
DEV float buf_load_f32(BufRsrc r, unsigned voff, unsigned soff) { return *(const float*)(r.base + voff + soff); }
DEV u4v buf_load_b128(BufRsrc r, unsigned voff, unsigned soff) { return *(const u4v*)(r.base + voff + soff); }
#else
typedef __amdgpu_buffer_rsrc_t BufRsrc;
DEV BufRsrc make_rsrc(const void* p) { return __builtin_amdgcn_make_buffer_rsrc((void*)p, 0, 0x7fffffff, 0x00020000); }
DEV float buf_load_f32(BufRsrc r, unsigned voff, unsigned soff) { return __builtin_bit_cast(float, __builtin_amdgcn_raw_buffer_load_b32(r, voff, soff, 0)); }
DEV u4v buf_load_b128(BufRsrc r, unsigned voff, unsigned soff) { return __builtin_amdgcn_raw_buffer_load_b128(r, voff, soff, 0); }
#endif
#ifdef EMU
#define WAVE_SYNC() do { (void)__shfl(0, 0); } while (0)
#else
#define WAVE_SYNC() asm volatile("s_waitcnt lgkmcnt(0)" ::: "memory")
#endif
DEV char* wave_stage_ptr(char* smem, int wave) { return smem + (wave < 4 ? GEMM_AS + wave * 9216 : 2 * GEMM_AS + GEMM_BS + (wave - 4) * 9216); }
DEV void stage64_write_bf16(char* stg, int tt, const f16v& v0, const f16v& v1, int l31, int h) {
    char* row = stg + (tt * 32 + l31) * LROW;
#pragma unroll
    for (int ft = 0; ft < 2; ++ft) {
        const f16v& v = ft ? v1 : v0;
#pragma unroll
        for (int g = 0; g < 4; ++g) { u2v pk; pk[0] = pack2(v[4 * g], v[4 * g + 1]); pk[1] = pack2(v[4 * g + 2], v[4 * g + 3]); *(u2v*)(row + (ft * 32 + 8 * g + 4 * h) * 2) = pk; }
    }
}
DEV void stage64_write4(char* stg, int row, int col, float a, float b, float c, float d) {
    u2v pk; pk[0] = pack2(a, b); pk[1] = pack2(c, d); *(u2v*)(stg + row * LROW + col * 2) = pk;
}
DEV void stage64_flush_bf16(const char* stg, bf16_t* dst0, size_t row_stride, int lane) {
    WAVE_SYNC();
#pragma unroll
    for (int i = 0; i < 8; ++i) { const int r = (lane >> 3) + 8 * i, c = lane & 7; const u4v v = *(const u4v*)(stg + r * LROW + c * 16); *(u4v*)(dst0 + (size_t)r * row_stride + c * 8) = v; }
    WAVE_SYNC();
}
template <int NTW, int VAR, class Epi>
DEV void gemm_tile(char* smem, BufRsrc ars, unsigned ao0, unsigned ao1, unsigned ao2, unsigned ao3,
                   BufRsrc brs, unsigned bvo, unsigned blds, unsigned ldb4, int K, Epi&& epi) {
    constexpr int BN = 64 * NTW, NLD = 2 * NTW, KSTEP = 64 / NLD, RSB = BN * 2 + 64;
    const int tid = get_tid(), lane = tid & 63, wave = tid >> 6, wm = wave & 3, wn = wave >> 2, h = lane >> 5, l31 = lane & 31;
    char* As = smem; char* Bs = smem + 2 * GEMM_AS;
    constexpr int BSZ = GEMM_BS;
    const int ar = tid >> 3, ac = tid & 7;
    u4v areg[2]; f4v b0[NLD], b1[NLD];
    if (VAR & 3) { for (int i = 0; i < 2; ++i) areg[i] = (u4v){1u, 2u, 3u, 4u}; for (int j = 0; j < NLD; ++j) { b0[j] = (f4v){1.f, 1.f, 1.f, 1.f}; b1[j] = (f4v){2.f, 2.f, 2.f, 2.f}; } }
    f16v acc[NTW][2];
#pragma unroll
    for (int i = 0; i < NTW; ++i) { acc[i][0] = f16zero(); acc[i][1] = f16zero(); }
    auto gloadA = [&](int k0, bool real, int half) {
        if (VAR & 2) return;
        const unsigned so = real ? k0 * 2 : 0u;
        areg[0] = buf_load_b128(ars, real ? (half ? ao2 : ao0) : 0u, so); areg[1] = buf_load_b128(ars, real ? (half ? ao3 : ao1) : 0u, so);
    };
    auto gloadB = [&](int k0, bool real, f4v (&br)[NLD]) {
        if (VAR & 1) return;
        const unsigned vo = real ? bvo : 0u; const int kk = real ? k0 : 0;
        unsigned so = (unsigned)kk * ldb4;
#pragma unroll
        for (int j = 0; j < NLD; ++j) { br[j] = __builtin_bit_cast(f4v, buf_load_b128(brs, vo, so)); so += KSTEP * ldb4; SGPR_PIN(so); }
    };
    auto lstoreA = [&](int buf, int half) {
        if (VAR & 16) return;
        char* ab = As + buf * GEMM_AS + (ar + half * 128) * LROW + ac * 16;
        *(u4v*)(ab) = areg[0]; *(u4v*)(ab + 64 * LROW) = areg[1];
    };
    auto lstoreB = [&](int buf, const f4v (&br)[NLD]) {
        if (VAR & 16) return;
        char* bb = Bs + buf * BSZ + blds;
#pragma unroll
        for (int j = 0; j < NLD; ++j) { u2v v; v[0] = pack2(br[j][0], br[j][1]); v[1] = pack2(br[j][2], br[j][3]); *(u2v*)(bb + j * KSTEP * RSB) = v; }
    };
    const unsigned btr = (unsigned)(8 * h + ((lane & 15) >> 2)) * RSB + (unsigned)((((lane >> 4) & 1) * 16 + 4 * (lane & 3)) * 2) + (unsigned)(wn * NTW * 32) * 2;
    const unsigned atr = (unsigned)(wm * 64 + l31) * LROW + h * 16;
    auto rdw = [&](int buf, int s, int ft) -> s8v {
        if (VAR & 64) { s8v z; for (int q = 0; q < 8; ++q) z[q] = (short)(0x3f80 + ft); return z; }
        const char* bb = Bs + buf * BSZ + btr + s * 16 * RSB + ft * 64;
        const s4v lo = lds_tr16(bb), hi = lds_tr16(bb + 4 * RSB);
        s8v wf; wf[0] = lo[0]; wf[1] = lo[1]; wf[2] = lo[2]; wf[3] = lo[3]; wf[4] = hi[0]; wf[5] = hi[1]; wf[6] = hi[2]; wf[7] = hi[3];
        return wf;
    };
    auto compute2 = [&](int buf, int s0) {
        if (VAR & 8) return;
        const char* ab = As + buf * GEMM_AS + atr;
        s8v xa[2];
        if (VAR & 64) { for (int q = 0; q < 8; ++q) { xa[0][q] = 0x3f80; xa[1][q] = 0x3f80; } } else { xa[0] = *(const s8v*)(ab + s0 * 32); xa[1] = *(const s8v*)(ab + 32 * LROW + s0 * 32); }
        s8v wcur = rdw(buf, s0, 0);
#pragma unroll
        for (int g = 0; g < 2 * NTW; ++g) {
            const int ft = g % NTW;
            s8v wnext = wcur;
            if (g + 1 < 2 * NTW) wnext = rdw(buf, s0 + (g + 1) / NTW, (g + 1) % NTW);
            if (VAR & 4) { acc[ft][0][0] += __builtin_bit_cast(float, (int)wcur[0] | ((int)xa[0][1] << 16)); acc[ft][1][0] += __builtin_bit_cast(float, (int)wcur[1] | ((int)xa[1][1] << 16)); }
            else { acc[ft][0] = mfma32(wcur, xa[0], acc[ft][0]); acc[ft][1] = mfma32(wcur, xa[1], acc[ft][1]); }
            if (g == NTW - 1 && !(VAR & 64)) { xa[0] = *(const s8v*)(ab + (s0 + 1) * 32); xa[1] = *(const s8v*)(ab + 32 * LROW + (s0 + 1) * 32); }
            wcur = wnext;
            SCHED_FENCE();
        }
    };
    const int nk = K / 64;
    if (NTW == 2) {
        u4v a0[4], a1[4];
        if (VAR & 3) { for (int i = 0; i < 4; ++i) { a0[i] = (u4v){1u, 2u, 3u, 4u}; a1[i] = (u4v){1u, 2u, 3u, 4u}; } }
        auto gA = [&](int k0, bool real, u4v (&ar4)[4]) {
            if (VAR & 2) return;
            const unsigned so = real ? k0 * 2 : 0u;
            ar4[0] = buf_load_b128(ars, real ? ao0 : 0u, so); ar4[1] = buf_load_b128(ars, real ? ao1 : 0u, so);
            ar4[2] = buf_load_b128(ars, real ? ao2 : 0u, so); ar4[3] = buf_load_b128(ars, real ? ao3 : 0u, so);
        };
        auto sA = [&](int buf, const u4v (&ar4)[4]) {
            if (VAR & 16) return;
            char* ab = As + buf * GEMM_AS + ar * LROW + ac * 16;
#pragma unroll
            for (int i = 0; i < 4; ++i) *(u4v*)(ab + i * 64 * LROW) = ar4[i];
        };
        gA(0, true, a0); gloadB(0, true, b0); gA(64, true, a1); gloadB(64, true, b1);
        sA(0, a0); lstoreB(0, b0);
        __syncthreads();
        for (int kt = 0; kt < nk; kt += 2) {
            const bool t2 = kt + 2 < nk;
            gA((kt + 2) * 64, t2, a0); gloadB((kt + 2) * 64, t2, b0);
            compute2(0, 0); compute2(0, 2);
            sA(1, a1); lstoreB(1, b1);
            __syncthreads();
            gA((kt + 3) * 64, t2, a1); gloadB((kt + 3) * 64, t2, b1);
            compute2(1, 0); compute2(1, 2);
            sA(0, a0); lstoreB(0, b0);
            __syncthreads();
        }
    } else {
    gloadA(0, true, 0); gloadB(0, true, b0); lstoreA(0, 0); gloadA(0, true, 1); gloadB(64, true, b1); lstoreA(0, 1); lstoreB(0, b0);
    __syncthreads();
    for (int kt = 0; kt < nk; kt += 2) {
        const bool t2 = kt + 2 < nk;
        gloadA((kt + 1) * 64, true, 0);
        compute2(0, 0);
        lstoreA(1, 0);
        gloadA((kt + 1) * 64, true, 1);
        gloadB((kt + 2) * 64, t2, b0);
        compute2(0, 2);
        lstoreA(1, 1); lstoreB(1, b1);
        __syncthreads();
        gloadA((kt + 2) * 64, t2, 0);
        compute2(1, 0);
        lstoreA(0, 0);
        gloadA((kt + 2) * 64, t2, 1);
        gloadB((kt + 3) * 64, t2, b1);
        compute2(1, 2);
        lstoreA(0, 1); lstoreB(0, b0);
        __syncthreads();
    }
    }
    if (VAR & 32) { float t = 0.f; for (int i = 0; i < NTW; ++i) t += acc[i][0][0] + acc[i][1][5]; if (t == 123.456f) *(float*)smem = t; }
    else epi(acc);
}

DEV void phase_ada(const Params& p, char* smem) {
    const int tid = get_tid();
    float* siluS = (float*)smem;
    float* red = (float*)(smem + NCOND * D * 4);
    for (int i = tid; i < NCOND * D; i += 512) {
        const int cnd = i / D, k = i % D;
        const float c = cnd == 0 ? p.in[I_CCTX][k] : p.in[I_C][(cnd - 1) * D + k];
        siluS[i] = c * frcp(1.f + fexp(-c));
    }
    __syncthreads();
    constexpr int CPL = 6 * D / 32, NCHUNK = DEPTH * CPL, KG = D / 16;
    float* mods = (float*)(p.ws + WS_MODS);
    const int col = tid & 31, kg = tid >> 5;
    for (int u = blockIdx.x; u < NCHUNK; u += gridDim.x) {
        const int l = u / CPL, c0 = (u % CPL) * 32;
        const float* W = p.in[I_ADAW] + (size_t)l * D * 6 * D + c0 + col;
        float acc[NCOND];
#pragma unroll
        for (int c = 0; c < NCOND; ++c) acc[c] = 0.f;
#pragma unroll 8
        for (int k = kg * KG; k < kg * KG + KG; ++k) {
            const float w = W[(size_t)k * 6 * D];
#pragma unroll
            for (int c = 0; c < NCOND; ++c) acc[c] += siluS[c * D + k] * w;
        }
#pragma unroll
        for (int c = 0; c < NCOND; ++c) red[(kg * NCOND + c) * 32 + col] = acc[c];
        __syncthreads();
        if (tid < 32 * NCOND) {
            const int c = tid >> 5, cc = tid & 31;
            float s = 0.f;
            for (int g = 0; g < 16; ++g) s += red[(g * NCOND + c) * 32 + cc];
            mods[((size_t)l * NCOND + c) * 6 * D + c0 + cc] = s + p.in[I_ADAB][(size_t)l * 6 * D + c0 + cc];
        }
        __syncthreads();
    }
    const int gtid = blockIdx.x * 512 + tid, gsz = gridDim.x * 512;
    float* rope = (float*)(p.ws + WS_ROPE);
    for (int i = gtid; i < 64 * 16; i += gsz) {
        const int pos = i >> 4, fi = i & 15;
        const float inv = fexp2(-(float)(2 * fi) * (13.287712379549449f / 32.f));
        const float ang = (float)pos * inv;
#ifdef EMU
        rope[2 * i] = cosf(ang); rope[2 * i + 1] = sinf(ang);
#else
        rope[2 * i] = __cosf(ang); rope[2 * i + 1] = __sinf(ang);
#endif
    }
    constexpr int NNA = DEC_BATCH * DEPTH * PAST * NAH * HD, NGQ = DEC_BATCH * DEPTH * PAST * GQKV * HD;
    bf16_t* cnak = (bf16_t*)(p.ws + WS_CNAK); bf16_t* cnav = (bf16_t*)(p.ws + WS_CNAV);
    bf16_t* cgqk = (bf16_t*)(p.ws + WS_CGQK); bf16_t* cgqv = (bf16_t*)(p.ws + WS_CGQV);
    for (int i = gtid; i < NNA; i += gsz) { cnak[i] = f2bf(p.in[I_CNAK][i]); cnav[i] = f2bf(p.in[I_CNAV][i]); }
    for (int i = gtid; i < NGQ; i += gsz) { cgqk[i] = f2bf(p.in[I_CGQK][i]); cgqv[i] = f2bf(p.in[I_CGQV][i]); }
}

constexpr int EPL = D / 64;
constexpr int W16ROW = 20;
template <int MODE>
DEV void phase_rows(const Params& p, char* smem, int l) {
    const int tid = get_tid(), lane = tid & 63, wave = tid >> 6;
    float* W16 = (float*)smem;
    const bool need_w = (MODE == 1) || (l < DEPTH);
    if (need_w) {
        for (int i = tid; i < D * 4; i += 512) {
            const int k = i >> 2, q = i & 3;
            const float* src = (MODE == 1) ? p.in[I_RW] + ((size_t)l * D + k) * 16 + q * 4 : p.in[I_WIN] + ((size_t)l * D + k) * PROJ_W + 2176 + q * 4;
            *(f4v*)(W16 + k * W16ROW + q * 4) = *(const f4v*)src;
        }
    }
    __syncthreads();
    const float* mods = (const float*)(p.ws + WS_MODS);
    for (int t = blockIdx.x * 8 + wave; t < NT; t += gridDim.x * 8) {
        const int cnd = tok_cond(t);
        float v[EPL];
        if (MODE == 0 && l == 0) {
            const float* xr = t < NP ? p.in[I_XP] + (size_t)t * D : p.in[I_XS] + (size_t)(t - NP) * D;
#pragma unroll
            for (int j = 0; j < EPL; ++j) v[j] = xr[lane + 64 * j];
        } else if (MODE == 0) {
            const float* x1 = (const float*)(p.ws + WS_X1) + (size_t)t * D;
            const float* g2 = mods + ((size_t)(l - 1) * NCOND + cnd) * 6 * D + 5 * D;
            float f[EPL], xv[EPL], gv[EPL];
#pragma unroll
            for (int j = 0; j < EPL; ++j) { f[j] = 0.f; xv[j] = x1[lane + 64 * j]; gv[j] = g2[lane + 64 * j]; }
            const int* ts = (const int*)(p.ws + WS_TOKSLOT) + (size_t)t * 16;
            const int myslot = lane < 16 ? ts[lane] : -1;
            unsigned vm = (unsigned)__ballot(myslot >= 0);
            while (vm) {
                const int e = __builtin_ctz(vm); vm &= vm - 1u;
                const int slot = __shfl(myslot, e);
                const bf16_t* yr = (const bf16_t*)(p.ws + WS_YE) + ((size_t)e * SLOTS + slot) * D;
#pragma unroll
                for (int j = 0; j < EPL; ++j) f[j] += bf2f(yr[lane + 64 * j]);
            }
#pragma unroll
            for (int j = 0; j < EPL; ++j) v[j] = ALPHA * xv[j] + gv[j] * f[j];
        } else {
            const float* u = (const float*)(p.ws + WS_U) + (size_t)t * D;
#pragma unroll
            for (int j = 0; j < EPL; ++j) v[j] = u[lane + 64 * j];
        }
        if (!(MODE == 0 && l == 0)) {
            const int li = (MODE == 0) ? (l - 1) * 2 + 1 : l * 2;
            const float* lg = p.in[I_LNG] + (size_t)li * D; const float* lb = p.in[I_LNB] + (size_t)li * D;
            float g[EPL], bb[EPL];
#pragma unroll
            for (int j = 0; j < EPL; ++j) { g[j] = lg[lane + 64 * j]; bb[j] = lb[lane + 64 * j]; }
            float s = 0.f;
#pragma unroll
            for (int j = 0; j < EPL; ++j) s += v[j];
            const float mu = wave_sum(s) * (1.f / D);
            float q = 0.f;
#pragma unroll
            for (int j = 0; j < EPL; ++j) { const float dlt = v[j] - mu; q += dlt * dlt; }
            const float rstd = frsqrt(wave_sum(q) * (1.f / D) + EPS);
            float* dst = (MODE == 1) ? (float*)(p.ws + WS_X1) + (size_t)t * D
                       : (l == DEPTH) ? (t < NP ? p.out + O_YP + (size_t)t * D : p.out + O_YS + (size_t)(t - NP) * D) : (float*)(p.ws + WS_XBUF) + (size_t)t * D;
#pragma unroll
            for (int j = 0; j < EPL; ++j) { v[j] = (v[j] - mu) * rstd * g[j] + bb[j]; dst[lane + 64 * j] = v[j]; }
        }
        if (MODE == 1 || l < DEPTH) {
            const float* sh = mods + ((size_t)l * NCOND + cnd) * 6 * D + (MODE == 1 ? 3 * D : 0); const float* sc = sh + D;
            bf16_t* hb = (bf16_t*)(p.ws + (MODE == 1 ? WS_H2 : WS_HMOD)) + (size_t)t * D;
            {
                float s1[EPL], s0[EPL];
#pragma unroll
                for (int j = 0; j < EPL; ++j) { s1[j] = sc[lane + 64 * j]; s0[j] = sh[lane + 64 * j]; }
#pragma unroll
                for (int j = 0; j < EPL; ++j) { v[j] = v[j] * (1.f + s1[j]) + s0[j]; hb[lane + 64 * j] = f2bf(v[j]); }
            }
            CFENCE();
            float a16[16];
#pragma unroll
            for (int e = 0; e < 16; ++e) a16[e] = 0.f;
#pragma unroll
            for (int j = 0; j < EPL; ++j) {
                const float hv = v[j];
                const float* wr = W16 + (lane + 64 * j) * W16ROW;
#pragma unroll
                for (int q = 0; q < 4; ++q) { const f4v w4 = *(const f4v*)(wr + 4 * q); a16[4 * q] += hv * w4[0]; a16[4 * q + 1] += hv * w4[1]; a16[4 * q + 2] += hv * w4[2]; a16[4 * q + 3] += hv * w4[3]; }
                if (j & 1) CFENCE();
            }
            float mine = -1e30f;
#pragma unroll
            for (int e = 0; e < 16; ++e) { const float sm = wave_sum(a16[e]); if (lane == e) mine = sm; }
            if (MODE == 0) {
                if (lane < 16) ((float*)(p.ws + WS_GATES))[(size_t)t * 16 + lane] = mine + p.in[I_BGATE][l * 16 + lane];
            } else {
                float mx = mine;
                for (int m = 8; m >= 1; m >>= 1) mx = fmaxf(mx, __shfl_xor(mx, m));
                const float ex = lane < 16 ? fexp(mine - mx) : 0.f;
                float sm = ex;
                for (int m = 8; m >= 1; m >>= 1) sm += __shfl_xor(sm, m);
                if (lane < 16) ((float*)(p.ws + WS_AFF))[(size_t)t * 16 + lane] = ex / sm;
            }
        }
    }
}

template <int NPL>
DEV void topk_wave(const Params& p, int tb, int cap, int sbase, int e, int lane) {
    const float* aff = (const float*)(p.ws + WS_AFF);
    int* idx = (int*)(p.ws + WS_IDX); float* gsel = (float*)(p.ws + WS_GSEL); int* tokslot = (int*)(p.ws + WS_TOKSLOT);
    unsigned bits[NPL];
#pragma unroll
    for (int i = 0; i < NPL; ++i) bits[i] = __builtin_bit_cast(unsigned, aff[(size_t)(tb + lane + 64 * i) * 16 + e]);
    unsigned T = 0u;
    for (int b = 30; b >= 0; --b) {
        const unsigned cand = T | (1u << b);
        int cnt = 0;
#pragma unroll
        for (int i = 0; i < NPL; ++i) cnt += __popcll(__ballot(bits[i] >= cand));
        if (cnt >= cap) T = cand;
    }
    int ngt = 0;
#pragma unroll
    for (int i = 0; i < NPL; ++i) ngt += __popcll(__ballot(bits[i] > T));
    int need_eq = cap - ngt, run = 0;
    const unsigned long long lt = (1ull << lane) - 1ull;
#pragma unroll
    for (int i = 0; i < NPL; ++i) {
        const bool eq = bits[i] == T;
        const unsigned long long meq = __ballot(eq);
        const int eqrank = __popcll(meq & lt);
        const bool sel = bits[i] > T || (eq && eqrank < need_eq);
        const unsigned long long ms = __ballot(sel);
        const int t = tb + lane + 64 * i;
        if (sel) { const int slot = sbase + run + __popcll(ms & lt); idx[e * SLOTS + slot] = t; gsel[e * SLOTS + slot] = __builtin_bit_cast(float, bits[i]); tokslot[(size_t)t * 16 + e] = slot; }
        else tokslot[(size_t)t * 16 + e] = -1;
        run += __popcll(ms);
        const int neq = __popcll(meq); need_eq -= neq < need_eq ? neq : need_eq;
    }
}
DEV void phase_topk(const Params& p, char* smem) {
    (void)smem;
    const int tid = get_tid(), lane = tid & 63;
    constexpr int US = DEC_BATCH * NEXP, UP = BATCH * NEXP;
    const int gw = blockIdx.x + gridDim.x * (tid >> 6), nw = gridDim.x * 8;
    for (int u = gw; u < US + UP; u += nw) {
        if (u < US) { const int b = u / NEXP, e = u % NEXP; topk_wave<DEC_SEQ / 64>(p, NP + b * DEC_SEQ, CAP_S, BATCH * CAP_P + b * CAP_S, e, lane); }
        else { const int uu = u - US; const int b = uu / NEXP, e = uu % NEXP; topk_wave<SEQ / 64>(p, b * SEQ, CAP_P, b * CAP_P, e, lane); }
    }
}

DEV void store_head_f32(float* dst_f32, const f16v& v0, const f16v& v1, int h) {
#pragma unroll
    for (int ft = 0; ft < 2; ++ft) {
        const f16v& v = ft ? v1 : v0;
#pragma unroll
        for (int g = 0; g < 4; ++g) { f4v o; o[0] = v[4 * g]; o[1] = v[4 * g + 1]; o[2] = v[4 * g + 2]; o[3] = v[4 * g + 3]; *(f4v*)(dst_f32 + ft * 32 + 8 * g + 4 * h) = o; }
    }
}
template <int VAR>
DEV void phase_inproj(const Params& p, char* smem, int l) {
    constexpr int NJ = 22, NU = (NT / 256) * NJ;
    const int tid = get_tid(), lane = tid & 63, wave = tid >> 6, wm = wave & 3, wn = wave >> 2, h = lane >> 5, l31 = lane & 31;
    const bf16_t* hmod = (const bf16_t*)(p.ws + WS_HMOD);
    const float* rope = (const float*)(p.ws + WS_ROPE);
    constexpr int NMB = NT / 256, RPX = (NMB % 8 == 0) ? NMB / 8 : NMB;
    const UnitIter it = unit_iter(NU);
    for (int u = it.i; u < it.end; u += it.step) {
        const int mb = (u / (RPX * NJ)) * RPX + u % RPX, j = (u / RPX) % NJ;
        const int colbase = j < 17 ? 128 * j : 2192 + 128 * (j - 17);
        const unsigned ao = ((unsigned)(mb * 256 + (tid >> 3)) * D + (tid & 7) * 8) * 2;
        const unsigned bvo = (unsigned)(colbase + 4 * (tid & 31)) * 4 + (unsigned)(tid >> 5) * (PROJ_W * 4);
        const unsigned blds = (unsigned)(tid >> 5) * 320u + (unsigned)(tid & 31) * 8u;
        gemm_tile<2, VAR>(smem, make_rsrc(hmod), ao, ao + 128u * D, ao + 256u * D, ao + 384u * D, make_rsrc(p.in[I_WIN] + (size_t)l * D * PROJ_W), bvo, blds, PROJ_W * 4, D, [&](f16v (&acc)[2][2]) {
            int lane_e = lane; VGPR_PIN(lane_e); const int lane = lane_e, l31 = lane_e & 31, h = lane_e >> 5; (void)l31; (void)h;
            const int cb = colbase + wn * 64;
            char* stg = wave_stage_ptr(smem, wave);
            const int t0 = mb * 256 + wm * 64;
            const bool isP = t0 < NP;
            bf16_t* dstb; size_t dstride;
            int f32out = 0, fhead = 0, fheads = 0; size_t fbase = 0;
            int mode = 0;
            if (cb < 1152) {
                const int seg = cb / 384, head = (cb % 384) / 64;
                dstb = (bf16_t*)(p.ws + (seg == 0 ? WS_NAQ : seg == 1 ? WS_NAK : WS_NAV)) + (size_t)t0 * 384 + head * 64; dstride = 384;
                if (seg >= 1 && isP) { f32out = 1; fbase = seg == 1 ? O_NAK : O_NAV; fhead = head; fheads = NAH; }
            } else if (cb < 2176) {
                const int seg = (cb - 1152) / 256, head = ((cb - 1152) % 256) / 64;
                dstb = (bf16_t*)(p.ws + (seg == 0 ? WS_MLQ : seg == 1 ? WS_MLK : seg == 2 ? WS_MLV : WS_MLO)) + (size_t)t0 * 256 + head * 64; dstride = 256;
                mode = seg == 1 ? 1 : 0;
            } else {
                const int c2 = cb - 2192;
                if (c2 < 384) { dstb = (bf16_t*)(p.ws + WS_GQQ) + (size_t)t0 * 384 + (c2 / 64) * 64; dstride = 384; mode = 2; }
                else if (c2 < 512) { const int head = (c2 - 384) / 64; dstb = (bf16_t*)(p.ws + WS_GQK) + (size_t)t0 * 128 + head * 64; dstride = 128; mode = 3;
                                     if (isP) { f32out = 1; fbase = O_GQK; fhead = head; fheads = GQKV; } }
                else { const int head = (c2 - 512) / 64; dstb = (bf16_t*)(p.ws + WS_GQV) + (size_t)t0 * 128 + head * 64; dstride = 128;
                       if (isP) { f32out = 1; fbase = O_GQV; fhead = head; fheads = GQKV; } }
            }
#pragma unroll
            for (int tt = 0; tt < 2; ++tt) {
                const int t = t0 + tt * 32 + l31;
                f16v v0 = acc[0][tt], v1 = acc[1][tt];
                if (mode == 1) { v0 *= ATT_SCALE; v1 *= ATT_SCALE; }
                if (mode >= 2) {
                    float ss = 0.f;
#pragma unroll
                    for (int r = 0; r < 16; ++r) ss += v0[r] * v0[r] + v1[r] * v1[r];
                    ss += __shfl_xor(ss, 32);
                    const float rn = frsqrt(ss * (1.f / 64.f) + EPS);
                    const float* gq = p.in[I_QKG] + ((size_t)l * 2 + (mode == 2 ? 0 : 1)) * 64;
#pragma unroll
                    for (int r = 0; r < 16; ++r) {
                        const int d = (r & 3) + 8 * (r >> 2) + 4 * h;
                        v0[r] *= rn * gq[d]; v1[r] *= rn * gq[32 + d];
                    }
                }
                if (f32out) { const int bP = t / SEQ, sP = t % SEQ; store_head_f32(p.out + fbase + ((((size_t)bP * DEPTH + l) * SEQ + sP) * fheads + fhead) * 64, v0, v1, h); }
                if (mode >= 2 && !isP) {
                    const int pos = (t - NP) % DEC_SEQ, prow = pos / GRIDW, pcol = pos % GRIDW;
#pragma unroll
                    for (int rr = 0; rr < 8; ++rr) {
                        const int fi = (rr & 3) + 8 * ((rr >> 2) & 1) + 4 * h;
                        const float c0 = rope[(prow * 16 + fi) * 2], s0 = rope[(prow * 16 + fi) * 2 + 1];
                        const float c1 = rope[(pcol * 16 + fi) * 2], s1 = rope[(pcol * 16 + fi) * 2 + 1];
                        const float a_lo = v0[rr], a_hi = v0[rr + 8]; v0[rr] = a_lo * c0 - a_hi * s0; v0[rr + 8] = a_hi * c0 + a_lo * s0;
                        const float b_lo = v1[rr], b_hi = v1[rr + 8]; v1[rr] = b_lo * c1 - b_hi * s1; v1[rr + 8] = b_hi * c1 + b_lo * s1;
                    }
                }
                stage64_write_bf16(stg, tt, v0, v1, l31, h);
            }
            stage64_flush_bf16(stg, dstb, dstride, lane);
        });
    }
}

template <int VAR>
DEV void phase_outproj(const Params& p, char* smem, int l) {
    constexpr int NC = D / 128, NU = (NT / 256) * NC;
    const int tid = get_tid(), lane = tid & 63, wave = tid >> 6, wm = wave & 3, wn = wave >> 2, h = lane >> 5, l31 = lane & 31;
    const bf16_t* mixed = (const bf16_t*)(p.ws + WS_MIXED);
    const float* mods = (const float*)(p.ws + WS_MODS);
    float* U = (float*)(p.ws + WS_U);
    constexpr int NMB = NT / 256, RPX = (NMB % 8 == 0) ? NMB / 8 : NMB;
    const UnitIter it = unit_iter(NU);
    for (int u = it.i; u < it.end; u += it.step) {
        const int mb = (u / (RPX * NC)) * RPX + u % RPX, cbk = (u / RPX) % NC;
        const unsigned ao = ((unsigned)(mb * 256 + (tid >> 3)) * MIXW + (tid & 7) * 8) * 2;
        const unsigned bvo = (unsigned)(cbk * 128 + 4 * (tid & 31)) * 4 + (unsigned)(tid >> 5) * (D * 4);
        const unsigned blds = (unsigned)(tid >> 5) * 320u + (unsigned)(tid & 31) * 8u;
        gemm_tile<2, VAR>(smem, make_rsrc(mixed), ao, ao + 128u * MIXW, ao + 256u * MIXW, ao + 384u * MIXW, make_rsrc(p.in[I_WOUT] + (size_t)l * MIXW * D), bvo, blds, D * 4, MIXW, [&](f16v (&acc)[2][2]) {
            int lane_e = lane; VGPR_PIN(lane_e); const int lane = lane_e, l31 = lane_e & 31, h = lane_e >> 5; (void)l31; (void)h;
            char* stg = wave_stage_ptr(smem, wave);
            const int t0 = mb * 256 + wm * 64;
            const float* g1 = mods + ((size_t)l * NCOND + tok_cond(t0)) * 6 * D + 2 * D;
#pragma unroll
            for (int ft = 0; ft < 2; ++ft) {
#pragma unroll
                for (int tt = 0; tt < 2; ++tt)
#pragma unroll
                    for (int g = 0; g < 4; ++g) { f4v o; o[0] = acc[ft][tt][4 * g]; o[1] = acc[ft][tt][4 * g + 1]; o[2] = acc[ft][tt][4 * g + 2]; o[3] = acc[ft][tt][4 * g + 3];
                        *(f4v*)(stg + (tt * 32 + l31) * LROW + (8 * g + 4 * h) * 4) = o; }
                WAVE_SYNC();
                const int f0 = cbk * 128 + wn * 64 + ft * 32 + (lane & 7) * 4;
                const f4v gv = *(const f4v*)(g1 + f0);
#pragma unroll
                for (int i = 0; i < 8; ++i) {
                    const int r = (lane >> 3) + 8 * i, t = t0 + r;
                    const f4v a = *(const f4v*)(stg + r * LROW + (lane & 7) * 16);
                    const float* xr = (l == 0) ? (t < NP ? p.in[I_XP] + (size_t)t * D : p.in[I_XS] + (size_t)(t - NP) * D) : (const float*)(p.ws + WS_XBUF) + (size_t)t * D;
                    const f4v xv = *(const f4v*)(xr + f0);
                    f4v o;
#pragma unroll
                    for (int q = 0; q < 4; ++q) o[q] = ALPHA * xv[q] + gv[q] * a[q];
                    *(f4v*)(U + (size_t)t * D + f0) = o;
                }
                WAVE_SYNC();
            }
        });
    }
}

template <int VAR>
DEV void phase_gateup(const Params& p, char* smem, int l) {
    constexpr int NRB = SLOTS / 256, NCB = EH / 128, NU = NEXP * NCB * NRB;
    const int tid = get_tid(), lane = tid & 63, wave = tid >> 6, wm = wave & 3, wn = wave >> 2, h = lane >> 5, l31 = lane & 31;
    const bf16_t* h2 = (const bf16_t*)(p.ws + WS_H2);
    const int* idx = (const int*)(p.ws + WS_IDX);
    bf16_t* hid = (bf16_t*)(p.ws + WS_HID);
    constexpr int TPC = NU / 8;
#ifdef GU_FORCE_HALF
    constexpr int HT = GU_FORCE_HALF;
#else
    constexpr int HT = (NU % 8 == 0 && TPC % 32 == 16) ? 16 : 0;
#endif
    constexpr int UPC = TPC + HT;
    const bool chunked = (gridDim.x & 7) == 0 && (NU & 7) == 0;
    const UnitIter it = unit_iter(chunked ? 8 * UPC : NU);
    for (int uu = it.i; uu < it.end; uu += it.step) {
        int u = uu, half = -1;
        if (chunked) { const int x = uu / UPC, v = uu % UPC; if (v < TPC - HT) u = x * TPC + v; else { const int hv = v - (TPC - HT); u = x * TPC + (TPC - HT) + (hv >> 1); half = hv & 1; } }
        const int rb = u % NRB, cbk = (u / NRB) % NCB, e = u / (NRB * NCB);
        const int* ip = idx + e * SLOTS + rb * 256 + (tid >> 3);
        const unsigned a0 = ((unsigned)ip[0] * D + (tid & 7) * 8) * 2, a1 = ((unsigned)ip[64] * D + (tid & 7) * 8) * 2;
        const unsigned a2 = ((unsigned)ip[128] * D + (tid & 7) * 8) * 2, a3 = ((unsigned)ip[192] * D + (tid & 7) * 8) * 2;
#ifdef EMU
        const int bw = tid >> 6;
#else
        const int bw = __builtin_amdgcn_readfirstlane(tid >> 6);
#endif
        const int is_up = bw & 1;
        const float* wmat = (is_up ? p.in[I_WU] : p.in[I_WG]) + ((size_t)l * NEXP + e) * D * EH;
        if (half < 0) {
        const int bkr = 2 * (bw >> 1) + ((tid >> 5) & 1), hc = 4 * (tid & 31);
        const int ncol = (hc >> 6) * 128 + (2 * ((hc >> 5) & 1) + is_up) * 32 + (hc & 31);
        const unsigned bvo = (unsigned)(cbk * 128 + hc) * 4 + (unsigned)bkr * (EH * 4);
        const unsigned blds = (unsigned)bkr * 576u + (unsigned)ncol * 2u;
        gemm_tile<4, VAR>(smem, make_rsrc(h2), a0, a1, a2, a3, make_rsrc(wmat), bvo, blds, EH * 4, D, [&](f16v (&acc)[4][2]) {
            int lane_e = lane; VGPR_PIN(lane_e); const int lane = lane_e, l31 = lane_e & 31, h = lane_e >> 5; (void)l31; (void)h;
            char* stg = wave_stage_ptr(smem, wave);
#pragma unroll
            for (int tt = 0; tt < 2; ++tt)
#pragma unroll
                for (int pr = 0; pr < 2; ++pr)
#pragma unroll
                    for (int g = 0; g < 4; ++g) {
                        float o[4];
#pragma unroll
                        for (int q = 0; q < 4; ++q) o[q] = siluf_(acc[2 * pr][tt][4 * g + q]) * acc[2 * pr + 1][tt][4 * g + q];
                        stage64_write4(stg, tt * 32 + l31, pr * 32 + 8 * g + 4 * h, o[0], o[1], o[2], o[3]);
                    }
            stage64_flush_bf16(stg, hid + ((size_t)e * SLOTS + rb * 256 + wm * 64) * EH + cbk * 128 + wn * 64, EH, lane);
        });
        } else {
        const int bkr = 4 * (bw >> 1) + ((tid >> 4) & 3), hc = 4 * (tid & 15);
        const int ncol = (hc >> 5) * 64 + is_up * 32 + (hc & 31);
        const unsigned bvo = (unsigned)(cbk * 128 + half * 64 + hc) * 4 + (unsigned)bkr * (EH * 4);
        const unsigned blds = (unsigned)bkr * 320u + (unsigned)ncol * 2u;
        gemm_tile<2, VAR>(smem, make_rsrc(h2), a0, a1, a2, a3, make_rsrc(wmat), bvo, blds, EH * 4, D, [&](f16v (&acc)[2][2]) {
            int lane_e = lane; VGPR_PIN(lane_e); const int lane = lane_e, l31 = lane_e & 31, h = lane_e >> 5; (void)l31; (void)h;
            char* stg = wave_stage_ptr(smem, wave);
#pragma unroll
            for (int tt = 0; tt < 2; ++tt)
#pragma unroll
                for (int g = 0; g < 4; ++g) {
                    float o[4];
#pragma unroll
                    for (int q = 0; q < 4; ++q) o[q] = siluf_(acc[0][tt][4 * g + q]) * acc[1][tt][4 * g + q];
                    stage64_write4(stg, tt * 32 + l31, 8 * g + 4 * h, o[0], o[1], o[2], o[3]);
                }
            WAVE_SYNC();
            bf16_t* dst0 = hid + ((size_t)e * SLOTS + rb * 256 + wm * 64) * EH + cbk * 128 + half * 64 + wn * 32;
#pragma unroll
            for (int i = 0; i < 4; ++i) { const int r = (lane >> 2) + 16 * i, c = lane & 3; const u4v v = *(const u4v*)(stg + r * LROW + c * 16); *(u4v*)(dst0 + (size_t)r * EH + c * 8) = v; }
            WAVE_SYNC();
        });
        }
    }
}

template <int VAR>
DEV void phase_down(const Params& p, char* smem, int l) {
    constexpr int NRB = SLOTS / 256, NCB = D / 256, NU = NEXP * NCB * NRB;
    const int tid = get_tid(), lane = tid & 63, wave = tid >> 6, wm = wave & 3, wn = wave >> 2, h = lane >> 5, l31 = lane & 31;
    const bf16_t* hid = (const bf16_t*)(p.ws + WS_HID);
    const float* gsel = (const float*)(p.ws + WS_GSEL);
    bf16_t* ye = (bf16_t*)(p.ws + WS_YE);
    const UnitIter it = unit_iter(NU);
    for (int u = it.i; u < it.end; u += it.step) {
        const int rb = u % NRB, cbk = (u / NRB) % NCB, e = u / (NRB * NCB);
        const unsigned ao = ((unsigned)(rb * 256 + (tid >> 3)) * EH + (tid & 7) * 8) * 2;
        const unsigned bvo = (unsigned)(cbk * 256 + 4 * (tid & 63)) * 4 + (unsigned)(tid >> 6) * (D * 4);
        const unsigned blds = (unsigned)(tid >> 6) * 576u + (unsigned)(tid & 63) * 8u;
        gemm_tile<4, VAR>(smem, make_rsrc(hid + (size_t)e * SLOTS * EH), ao, ao + 128u * EH, ao + 256u * EH, ao + 384u * EH, make_rsrc(p.in[I_WD] + ((size_t)l * NEXP + e) * EH * D), bvo, blds, D * 4, EH, [&](f16v (&acc)[4][2]) {
            int lane_e = lane; VGPR_PIN(lane_e); const int lane = lane_e, l31 = lane_e & 31, h = lane_e >> 5; (void)l31; (void)h;
            char* stg = wave_stage_ptr(smem, wave);
            const float gs0 = gsel[e * SLOTS + rb * 256 + wm * 64 + l31], gs1 = gsel[e * SLOTS + rb * 256 + wm * 64 + 32 + l31];
#pragma unroll
            for (int hb = 0; hb < 2; ++hb) {
#pragma unroll
                for (int tt = 0; tt < 2; ++tt) {
                    const float gs = tt ? gs1 : gs0;
#pragma unroll
                    for (int f2 = 0; f2 < 2; ++f2)
#pragma unroll
                        for (int g = 0; g < 4; ++g) { const f16v& a = acc[2 * hb + f2][tt]; stage64_write4(stg, tt * 32 + l31, f2 * 32 + 8 * g + 4 * h, a[4 * g] * gs, a[4 * g + 1] * gs, a[4 * g + 2] * gs, a[4 * g + 3] * gs); }
                }
                stage64_flush_bf16(stg, ye + ((size_t)e * SLOTS + rb * 256 + wm * 64) * D + cbk * 256 + wn * 128 + hb * 64, D, lane);
            }
        });
    }
}

struct AttnDesc {
    const bf16_t* q; int qstride;
    int ntiles, n0;
    const bf16_t *k0, *v0; int stride0;
    const bf16_t *k1, *v1; int stride1;
    int na;
    int r0, rlo;
    const float* rpb;
    bf16_t* out; int ostride;
    float* part;
};
constexpr int ATT_TILE = 64 * LROW;
DEV int na_row_start(int r) { int s = r - KR / 2; s = s < 0 ? 0 : s; return s > ROWS - KR ? ROWS - KR : s; }
DEV void attn_unit(char* smem, const AttnDesc& d) {
    const int tid = get_tid(), lane = tid & 63, wave = tid >> 6, h = lane >> 5, l31 = lane & 31;
    char* Ks = smem; char* Vs = smem + 2 * ATT_TILE; float* rpbS = (float*)(smem + 4 * ATT_TILE);
    if (d.na) { for (int i = tid; i < 15 * 31; i += 512) rpbS[i] = d.rpb[i] * 1.4426950408889634f; }
    const bf16_t* qp = d.q + (size_t)(wave * 32 + l31) * d.qstride + h * 8;
    s8v qf[4];
#pragma unroll
    for (int s = 0; s < 4; ++s) qf[s] = *(const s8v*)(qp + 16 * s);
    float m_run = -1e30f, l_run = 0.f;
    f16v o[2]; o[0] = f16zero(); o[1] = f16zero();
    const int srow = tid >> 3, sch = tid & 7;
    u4v kreg, vreg;
    auto gload = [&](int t) {
        const bf16_t *kp, *vp;
        if (t < d.n0) { const size_t off = (size_t)(t * 64 + srow) * d.stride0 + sch * 8; kp = d.k0 + off; vp = d.v0 + off; }
        else { const size_t off = (size_t)((t - d.n0) * 64 + srow) * d.stride1 + sch * 8; kp = d.k1 + off; vp = d.v1 + off; }
        kreg = *(const u4v*)kp; vreg = *(const u4v*)vp;
    };
    auto lstore = [&](int buf) { *(u4v*)(Ks + buf * ATT_TILE + srow * LROW + sch * 16) = kreg; *(u4v*)(Vs + buf * ATT_TILE + srow * LROW + sch * 16) = vreg; };
    const int qr = d.r0 + (wave >> 1), qw = (wave & 1) * 32 + l31;
    const int rs = na_row_start(qr);
    int cs = qw - KC / 2; cs = cs < 0 ? 0 : (cs > GRIDW - KC ? GRIDW - KC : cs);
    gload(0); lstore(0);
    __syncthreads();
    for (int t = 0; t < d.ntiles; ++t) {
        const int buf = t & 1;
        if (t + 1 < d.ntiles) gload(t + 1);
        const bool local = d.na && t >= d.n0;
        const int kr = d.rlo + (t - d.n0);
        const bool active = !local || (kr >= rs && kr < rs + KR);
        if (active) {
            const char* kb = Ks + buf * ATT_TILE + l31 * LROW + h * 16;
            f16v sa[2];
#pragma unroll
            for (int kt = 0; kt < 2; ++kt) {
                sa[kt] = f16zero();
#pragma unroll
                for (int s = 0; s < 4; ++s) { const s8v kf = *(const s8v*)(kb + kt * 32 * LROW + s * 32); sa[kt] = mfma32(kf, qf[s], sa[kt]); }
            }
            constexpr float C2 = ATT_SCALE * 1.4426950408889634f;
            float mx = -1e30f;
            if (local) {
#pragma unroll
                for (int kt = 0; kt < 2; ++kt)
#pragma unroll
                    for (int r = 0; r < 16; ++r) {
                        const int kc = kt * 32 + (r & 3) + 8 * (r >> 2) + 4 * h;
                        const bool inw = kc >= cs && kc < cs + KC;
                        const int bi = (kr - qr + 7) * 31 + (kc - qw + 15);
                        const float v = inw ? sa[kt][r] * C2 + rpbS[inw ? bi : 0] : -1e30f;
                        sa[kt][r] = v; mx = fmaxf(mx, v);
                    }
            } else {
#pragma unroll
                for (int kt = 0; kt < 2; ++kt)
#pragma unroll
                    for (int r = 0; r < 16; ++r) mx = fmaxf(mx, sa[kt][r]);
                mx *= C2;
            }
            mx = fmaxf(mx, __shfl_xor(mx, 32));
            if (__ballot(mx > m_run) != 0ull) {
                const float m_new = fmaxf(m_run, mx);
                const float alpha = fexp2(m_run - m_new);
                l_run *= alpha; m_run = m_new;
                o[0] *= alpha; o[1] *= alpha;
            }
            float ps = 0.f;
            if (local) {
#pragma unroll
                for (int kt = 0; kt < 2; ++kt)
#pragma unroll
                    for (int r = 0; r < 16; ++r) { const float pv = fexp2(sa[kt][r] - m_run); sa[kt][r] = pv; ps += pv; }
            } else {
#pragma unroll
                for (int kt = 0; kt < 2; ++kt)
#pragma unroll
                    for (int r = 0; r < 16; ++r) { const float pv = fexp2(sa[kt][r] * C2 - m_run); sa[kt][r] = pv; ps += pv; }
            }
            l_run += ps;
            const char* vb = Vs + buf * ATT_TILE + (4 * h + ((lane & 15) >> 2)) * LROW + (((lane >> 4) & 1) * 16 + 4 * (lane & 3)) * 2;
#pragma unroll
            for (int ks = 0; ks < 4; ++ks) {
                const int kt = ks >> 1, rb = 8 * (ks & 1);
                u4v pk; pk[0] = pack2(sa[kt][rb], sa[kt][rb + 1]); pk[1] = pack2(sa[kt][rb + 2], sa[kt][rb + 3]);
                pk[2] = pack2(sa[kt][rb + 4], sa[kt][rb + 5]); pk[3] = pack2(sa[kt][rb + 6], sa[kt][rb + 7]);
                const s8v pf = __builtin_bit_cast(s8v, pk);
                const char* vk = vb + (kt * 32 + 16 * (ks & 1)) * LROW;
#pragma unroll
                for (int dt = 0; dt < 2; ++dt) {
                    const s4v lo = lds_tr16(vk + dt * 64), hi = lds_tr16(vk + 8 * LROW + dt * 64);
                    s8v vf; vf[0] = lo[0]; vf[1] = lo[1]; vf[2] = lo[2]; vf[3] = lo[3]; vf[4] = hi[0]; vf[5] = hi[1]; vf[6] = hi[2]; vf[7] = hi[3];
                    o[dt] = mfma32(vf, pf, o[dt]);
                }
            }
        }
        if (t + 1 < d.ntiles) lstore(buf ^ 1);
        __syncthreads();
    }
    const float l_tot = l_run + __shfl_xor(l_run, 32);
    const int qrow = wave * 32 + l31;
    if (d.part) {
        float* po = d.part + (size_t)qrow * 64;
#pragma unroll
        for (int dt = 0; dt < 2; ++dt)
#pragma unroll
            for (int g = 0; g < 4; ++g) { f4v v; v[0] = o[dt][4 * g]; v[1] = o[dt][4 * g + 1]; v[2] = o[dt][4 * g + 2]; v[3] = o[dt][4 * g + 3]; *(f4v*)(po + dt * 32 + 8 * g + 4 * h) = v; }
        if (h == 0) { d.part[256 * 64 + qrow] = m_run; d.part[256 * 64 + 256 + qrow] = l_tot; }
    } else {
        const float inv = 1.f / l_tot;
        bf16_t* po = d.out + (size_t)qrow * d.ostride;
#pragma unroll
        for (int dt = 0; dt < 2; ++dt)
#pragma unroll
            for (int g = 0; g < 4; ++g) {
                u2v pk; pk[0] = pack2(o[dt][4 * g] * inv, o[dt][4 * g + 1] * inv); pk[1] = pack2(o[dt][4 * g + 2] * inv, o[dt][4 * g + 3] * inv);
                *(u2v*)(po + dt * 32 + 8 * g + 4 * h) = pk;
            }
    }
}

DEV int ml_sidx(int grp, int b, int head, int c) { return grp == 0 ? ((b * MLH + head) * NCH_P + c) : BATCH * MLH * NCH_P + ((b * MLH + head) * NCH_S + c); }
DEV float lane_prefix_sum(float v, int lane) { for (int dlt = 1; dlt < 64; dlt <<= 1) { const float o = __shfl(v, lane - dlt); if (lane >= dlt) v += o; } return v; }
DEV float lane_prefix_max(float v, int lane) { for (int dlt = 1; dlt < 64; dlt <<= 1) { const float o = __shfl(v, lane - dlt); if (lane >= dlt) v = fmaxf(v, o); } return v; }

DEV void mlstm_summary_unit(const Params& p, char* smem, int grp, int b, int head, int c) {
    const int tid = get_tid(), lane = tid & 63, wave = tid >> 6, h = lane >> 5, l31 = lane & 31;
    char* KT = smem;
    char* VT = smem + 2 * ATT_TILE;
    float* wsS = (float*)(smem + 3 * ATT_TILE);
    float* scal = wsS + 128;
    const int tb = (grp == 0 ? b * SEQ : NP + b * DEC_SEQ) + c * 64;
    const float* gates = (const float*)(p.ws + WS_GATES);
    if (wave == 0) {
        const float* gr = gates + (size_t)(tb + lane) * 16;
        const float i_f = gr[head], lf_f = logsigmoidf_(gr[4 + head]), i_b = gr[8 + head], lf_b = logsigmoidf_(gr[12 + head]);
        const float pf = lane_prefix_sum(lf_f, lane), pb = lane_prefix_sum(lf_b, lane);
        const float tot_f = __shfl(pf, 63), tot_b = __shfl(pb, 63);
        const float g_f = (tot_f - pf) + i_f, g_b = (pb - lf_b) + i_b;
        const float G_f = wave_max(g_f), G_b = wave_max(g_b);
        wsS[lane] = fexp(g_f - G_f); wsS[64 + lane] = fexp(g_b - G_b);
        if (lane == 0) { scal[0] = tot_f; scal[1] = tot_b; scal[2] = G_f; scal[3] = G_b; }
    }
    __syncthreads();
    {
        const int tau = tid >> 3, ch = tid & 7;
        const u4v kv = *(const u4v*)((const bf16_t*)(p.ws + WS_MLK) + (size_t)(tb + tau) * 256 + head * 64 + ch * 8);
        const u4v vv = *(const u4v*)((const bf16_t*)(p.ws + WS_MLV) + (size_t)(tb + tau) * 256 + head * 64 + ch * 8);
        const float wf = wsS[tau], wb = wsS[64 + tau];
#pragma unroll
        for (int j = 0; j < 8; ++j) {
            const bf16_t kb = (bf16_t)(kv[j >> 1] >> (16 * (j & 1))), vb = (bf16_t)(vv[j >> 1] >> (16 * (j & 1)));
            const int dim = ch * 8 + j; const float kf = bf2f(kb);
            *(bf16_t*)(KT + dim * LROW + tau * 2) = f2bf(kf * wf);
            *(bf16_t*)(KT + ATT_TILE + dim * LROW + tau * 2) = f2bf(kf * wb);
            *(bf16_t*)(VT + dim * LROW + tau * 2) = vb;
        }
    }
    __syncthreads();
    float* sum = (float*)(p.ws + WS_MLSUM);
    const int sidx = ml_sidx(grp, b, head, c);
    {
        const int dir = wave >> 2, mi = (wave >> 1) & 1, ni = wave & 1;
        f16v acc = f16zero();
#pragma unroll
        for (int s = 0; s < 4; ++s) {
            const s8v af = *(const s8v*)(KT + dir * ATT_TILE + (mi * 32 + l31) * LROW + (16 * s + 8 * h) * 2);
            const s8v bf = *(const s8v*)(VT + (ni * 32 + l31) * LROW + (16 * s + 8 * h) * 2);
            acc = mfma32(af, bf, acc);
        }
        float* U = sum + (size_t)(sidx * 2 + dir) * MLSUM_STRIDE;
#pragma unroll
        for (int r = 0; r < 16; ++r) U[(mi * 32 + (r & 3) + 8 * (r >> 2) + 4 * h) * 64 + ni * 32 + l31] = acc[r];
    }
    if (tid < 128) {
        const int dir = tid >> 6, kd = tid & 63;
        float s = 0.f;
        for (int tau = 0; tau < 64; ++tau) s += bf2f(*(const bf16_t*)(KT + dir * ATT_TILE + kd * LROW + tau * 2));
        float* E = sum + (size_t)(sidx * 2 + dir) * MLSUM_STRIDE;
        E[4096 + kd] = s;
        if (kd == 0) { E[4160] = scal[dir]; E[4161] = scal[2 + dir]; }
    }
    __syncthreads();
}

DEV void mlstm_output_unit(const Params& p, char* smem, int l, int grp, int b, int head, int c) {
    const int tid = get_tid(), lane = tid & 63, wave = tid >> 6, h = lane >> 5, l31 = lane & 31;
    const int nc = grp ? NCH_S : NCH_P;
    char* Qs = smem;
    char* Ks = smem + 2 * ATT_TILE;
    char* VT = smem + 4 * ATT_TILE;
    char* CT = smem + 6 * ATT_TILE;
    char* QK = smem + 8 * ATT_TILE;
    float* hS = (float*)(smem + 10 * ATT_TILE);
    float* vec = hS + 2 * 64 * 68;
    float* aS = vec; float* MjS = vec + 128; float* bS = vec + 256; float* nS = vec + 384; float* denp = vec + 512; float* qnS = vec + 768; float* scal = vec + 896;
    const int tb = (grp == 0 ? b * SEQ : NP + b * DEC_SEQ) + c * 64;
    const float* sum = (const float*)(p.ws + WS_MLSUM);
    const size_t qoff = (size_t)(tb + (tid >> 3)) * 256 + head * 64 + (tid & 7) * 8;
    const u4v q_r = *(const u4v*)((const bf16_t*)(p.ws + WS_MLQ) + qoff);
    const u4v k_r = *(const u4v*)((const bf16_t*)(p.ws + WS_MLK) + qoff);
    const u4v v_r = *(const u4v*)((const bf16_t*)(p.ws + WS_MLV) + qoff);
    const u4v o_r = *(const u4v*)((const bf16_t*)(p.ws + WS_MLO) + qoff);
    float g_i = 0.f, g_f = 0.f;
    if (wave < 2) { const float* gr = (const float*)(p.ws + WS_GATES) + (size_t)(tb + (wave ? 63 - lane : lane)) * 16; g_i = gr[wave * 8 + head]; g_f = gr[wave * 8 + 4 + head]; }
#pragma unroll
    for (int dir = 0; dir < 2; ++dir) {
        float C[8], nst = 0.f, m;
        if (grp == 0) {
#pragma unroll
            for (int i = 0; i < 8; ++i) C[i] = 0.f;
            m = 0.f;
        } else {
            const size_t sb = (((size_t)b * DEPTH + l) * 2 + dir) * MLH + head;
#pragma unroll
            for (int i = 0; i < 8; ++i) C[i] = p.in[I_SC][sb * 4096 + tid + 512 * i];
            if (tid < 64) nst = p.in[I_SN][sb * 64 + tid];
            m = p.in[I_SM][sb];
        }
        const int nsteps = dir == 0 ? c : nc - 1 - c;
        const bool fin = (grp == 0) && (dir == 0 ? c == nc - 1 : c == 0);
        {
            float A = 0.f, G = -1e30f;
            if (lane < nsteps) { const float* E = sum + (size_t)(ml_sidx(grp, b, head, dir == 0 ? lane : nc - 1 - lane) * 2 + dir) * MLSUM_STRIDE; A = E[4160]; G = E[4161]; }
            const float P = lane_prefix_sum(A, lane);
            const float T = __shfl(P, 63);
            const float ev = lane < nsteps ? G + (T - P) : -1e30f;
            const float mc = fmaxf(m + T, wave_max(ev));
            const float coef = lane < nsteps ? fexp(ev - mc) : 0.f;
            const float coef0 = fexp(m + T - mc);
#pragma unroll
            for (int i = 0; i < 8; ++i) C[i] *= coef0;
            nst *= coef0;
#pragma unroll 4
            for (int st = 0; st < nsteps; ++st) {
                const float* E = sum + (size_t)(ml_sidx(grp, b, head, dir == 0 ? st : nc - 1 - st) * 2 + dir) * MLSUM_STRIDE;
                const float cf = __shfl(coef, st);
#pragma unroll
                for (int i = 0; i < 8; ++i) C[i] += cf * E[tid + 512 * i];
                if (tid < 64) nst += cf * E[4096 + tid];
            }
            m = mc;
        }
#pragma unroll
        for (int i = 0; i < 8; ++i) { const int e = tid + 512 * i; *(bf16_t*)(CT + dir * ATT_TILE + (e & 63) * LROW + (e >> 6) * 2) = f2bf(C[i]); }
        if (tid < 64) nS[dir * 64 + tid] = nst;
        if (tid == 0) scal[dir] = m;
        if (fin) {
            const float* E = sum + (size_t)(ml_sidx(grp, b, head, c) * 2 + dir) * MLSUM_STRIDE;
            const float A = E[4160], G = E[4161];
            const float m_new = fmaxf(A + m, G);
            const float sc = fexp(A + m - m_new), su = fexp(G - m_new);
            const size_t ob = (((size_t)b * DEPTH + l) * 2 + dir) * MLH + head;
#pragma unroll
            for (int i = 0; i < 8; ++i) p.out[O_MC + ob * 4096 + tid + 512 * i] = sc * C[i] + su * E[tid + 512 * i];
            if (tid < 64) p.out[O_MN + ob * 64 + tid] = sc * nst + su * E[4096 + tid];
            if (tid == 0) p.out[O_MM + ob] = m_new;
        }
    }
    {
        const int row = tid >> 3, ch = tid & 7;
#pragma unroll
        for (int dir = 0; dir < 2; ++dir) {
            const int pr = dir ? 63 - row : row;
            *(u4v*)(Qs + dir * ATT_TILE + pr * LROW + ch * 16) = q_r;
            *(u4v*)(Ks + dir * ATT_TILE + pr * LROW + ch * 16) = k_r;
#pragma unroll
            for (int j = 0; j < 8; ++j) *(bf16_t*)(VT + dir * ATT_TILE + (ch * 8 + j) * LROW + pr * 2) = (bf16_t)(v_r[j >> 1] >> (16 * (j & 1)));
        }
    }
    __syncthreads();
    if (wave < 2) {
        const int dir = wave;
        const float ig = g_i, lf = logsigmoidf_(g_f);
        const float bj = lane_prefix_sum(lf, lane);
        const float a = ig - bj;
        const float Pj = lane_prefix_max(a, lane);
        aS[dir * 64 + lane] = a; bS[dir * 64 + lane] = bj; MjS[dir * 64 + lane] = fmaxf(scal[dir], Pj);
    } else if (wave < 4) {
        const int dir = wave - 2;
        float s = 0.f;
        for (int k = 0; k < 64; ++k) s += bf2f(*(const bf16_t*)(Qs + dir * ATT_TILE + lane * LROW + k * 2)) * nS[dir * 64 + k];
        qnS[dir * 64 + lane] = s;
    }
    __syncthreads();
    const int dir = wave >> 2, rt = (wave >> 1) & 1, jt = wave & 1;
    const int j = jt * 32 + l31;
    const float Mj = MjS[dir * 64 + j];
    {
        f16v acc = f16zero();
#pragma unroll
        for (int s4 = 0; s4 < 4; ++s4) {
            const s8v af = *(const s8v*)(Ks + dir * ATT_TILE + (rt * 32 + l31) * LROW + (16 * s4 + 8 * h) * 2);
            const s8v bf = *(const s8v*)(Qs + dir * ATT_TILE + j * LROW + (16 * s4 + 8 * h) * 2);
            acc = mfma32(af, bf, acc);
        }
        float dsum = 0.f;
#pragma unroll
        for (int g = 0; g < 4; ++g) {
            float o[4];
#pragma unroll
            for (int q = 0; q < 4; ++q) {
                const int s = rt * 32 + 8 * g + 4 * h + q;
                const float w = s <= j ? fexp(aS[dir * 64 + s] - Mj) : 0.f;
                o[q] = acc[4 * g + q] * w; dsum += o[q];
            }
            u2v pk; pk[0] = pack2(o[0], o[1]); pk[1] = pack2(o[2], o[3]);
            *(u2v*)(QK + dir * ATT_TILE + j * LROW + (rt * 32 + 8 * g + 4 * h) * 2) = pk;
        }
        dsum += __shfl_xor(dsum, 32);
        if (h == 0) denp[(dir * 2 + rt) * 64 + j] = dsum;
    }
    __syncthreads();
    {
        const float mst = scal[dir];
        const float decay = fexp(mst - Mj);
        f16v acc = f16zero();
#pragma unroll
        for (int s4 = 0; s4 < 4; ++s4) {
            const s8v af = *(const s8v*)(CT + dir * ATT_TILE + (rt * 32 + l31) * LROW + (16 * s4 + 8 * h) * 2);
            const s8v bf = *(const s8v*)(Qs + dir * ATT_TILE + j * LROW + (16 * s4 + 8 * h) * 2);
            acc = mfma32(af, bf, acc);
        }
        acc *= decay;
#pragma unroll
        for (int s4 = 0; s4 < 4; ++s4) {
            const s8v af = *(const s8v*)(VT + dir * ATT_TILE + (rt * 32 + l31) * LROW + (16 * s4 + 8 * h) * 2);
            const s8v bf = *(const s8v*)(QK + dir * ATT_TILE + j * LROW + (16 * s4 + 8 * h) * 2);
            acc = mfma32(af, bf, acc);
        }
        const float den = decay * qnS[dir * 64 + j] + denp[(dir * 2) * 64 + j] + denp[(dir * 2 + 1) * 64 + j];
        const float dn = fmaxf(fabsf(den), fexp(-(bS[dir * 64 + j] + Mj)));
        const float inv = 1.f / dn;
#pragma unroll
        for (int g = 0; g < 4; ++g) { f4v o; o[0] = acc[4 * g] * inv; o[1] = acc[4 * g + 1] * inv; o[2] = acc[4 * g + 2] * inv; o[3] = acc[4 * g + 3] * inv;
            *(f4v*)(hS + (dir * 64 + j) * 68 + rt * 32 + 8 * g + 4 * h) = o; }
    }
    __syncthreads();
    {
        const int tau = tid >> 3, v8 = (tid & 7) * 8;
        float hv[8]; float s = 0.f;
#pragma unroll
        for (int q = 0; q < 8; ++q) { hv[q] = hS[tau * 68 + v8 + q] + hS[(64 + 63 - tau) * 68 + v8 + q]; s += hv[q]; }
        s += __shfl_xor(s, 1); s += __shfl_xor(s, 2); s += __shfl_xor(s, 4);
        const float mu = s * (1.f / 64.f);
        float qq = 0.f;
#pragma unroll
        for (int q = 0; q < 8; ++q) { const float dlt = hv[q] - mu; qq += dlt * dlt; }
        qq += __shfl_xor(qq, 1); qq += __shfl_xor(qq, 2); qq += __shfl_xor(qq, 4);
        const float rstd = frsqrt(qq * (1.f / 64.f) + EPS);
        const int t = tb + tau;
        const u4v ov = o_r;
        const float* ng = p.in[I_MLG] + (size_t)l * 256 + head * 64 + v8;
        float o[8];
#pragma unroll
        for (int q = 0; q < 8; ++q) { const float og = bf2f((bf16_t)(ov[q >> 1] >> (16 * (q & 1)))); o[q] = (hv[q] - mu) * rstd * ng[q] * sigmoidf_(og); }
        u4v pk; pk[0] = pack2(o[0], o[1]); pk[1] = pack2(o[2], o[3]); pk[2] = pack2(o[4], o[5]); pk[3] = pack2(o[6], o[7]);
        *(u4v*)((bf16_t*)(p.ws + WS_MIXED) + (size_t)t * MIXW + 384 + head * 64 + v8) = pk;
    }
    __syncthreads();
}

DEV int queue_next(const Params& p, char* smem, int qi) {
    int* slot = (int*)(smem + SMEM_XB + 32);
    __syncthreads();
    if (threadIdx.x == 0) {
#ifdef EMU
        unsigned* w = (unsigned*)(p.ws + WS_BAR) + QUEUE_WORD0 + 64 * qi; *slot = (int)(*w)++;
#else
        *slot = (int)__hip_atomic_fetch_add((unsigned*)(p.ws + WS_BAR) + QUEUE_WORD0 + 64 * qi, 1u, __ATOMIC_RELAXED, __HIP_MEMORY_SCOPE_AGENT);
#endif
    }
    __syncthreads();
    return *slot;
}
DEV void phase_attn(const Params& p, char* smem, int l, int qi) {
    constexpr int QB_S = DEC_SEQ / 256, QB_P = SEQ / 256;
    constexpr int U_SG = DEC_BATCH * GQH * QB_S * 2, U_SN = DEC_BATCH * NAH * QB_S, U_PN = BATCH * NAH * QB_P, U_PG = BATCH * GQH * QB_P;
    constexpr int U_MP = BATCH * MLH * NCH_P, U_MS = DEC_BATCH * MLH * NCH_S;
    constexpr int NU = U_SG + U_SN + U_PN + U_PG + U_MP + U_MS;
    const bf16_t* naq = (const bf16_t*)(p.ws + WS_NAQ); const bf16_t* nak = (const bf16_t*)(p.ws + WS_NAK); const bf16_t* nav = (const bf16_t*)(p.ws + WS_NAV);
    const bf16_t* gqq = (const bf16_t*)(p.ws + WS_GQQ); const bf16_t* gqk = (const bf16_t*)(p.ws + WS_GQK); const bf16_t* gqv = (const bf16_t*)(p.ws + WS_GQV);
    bf16_t* mixed = (bf16_t*)(p.ws + WS_MIXED);
    for (;;) {
        int u = queue_next(p, smem, qi);
        if (u >= NU) break;
#ifdef PROBE_ATT
        if (qi >= 8) { const int cls = u < U_SG ? 1 : u < U_SG + U_SN ? 2 : u < U_SG + U_SN + U_PN + U_PG ? 3 : 4; if (cls != PROBE_ATT) continue; }
#endif
        AttnDesc d; d.na = 0; d.r0 = 0; d.rlo = 0; d.rpb = nullptr; d.part = nullptr; d.out = nullptr; d.ostride = MIXW; d.n0 = 0; d.k0 = d.v0 = nullptr; d.stride0 = 0;
        if (u < U_SG) {
            const int half = u & 1, qb = (u >> 1) % QB_S, qh = (u / (2 * QB_S)) % GQH, b = u / (2 * QB_S * GQH);
            const int kvh = qh / (GQH / GQKV);
            constexpr int NCT = PAST / 64, TT = NCT + DEC_SEQ / 64, H0 = TT / 2;
            const size_t tq = (size_t)NP + (size_t)b * DEC_SEQ + qb * 256;
            d.q = gqq + tq * 384 + qh * 64; d.qstride = 384;
            const bf16_t* lk = gqk + ((size_t)NP + (size_t)b * DEC_SEQ) * 128 + kvh * 64; const bf16_t* lv = gqv + ((size_t)NP + (size_t)b * DEC_SEQ) * 128 + kvh * 64;
            if (half == 0) {
                d.n0 = NCT; d.ntiles = H0; d.stride0 = 128;
                const size_t co = (((size_t)b * DEPTH + l) * PAST) * 128 + kvh * 64;
                d.k0 = (const bf16_t*)(p.ws + WS_CGQK) + co; d.v0 = (const bf16_t*)(p.ws + WS_CGQV) + co;
                d.k1 = lk; d.v1 = lv; d.stride1 = 128;
            } else {
                d.n0 = 0; d.ntiles = TT - H0; d.stride1 = 128;
                d.k1 = lk + (size_t)(H0 - NCT) * 64 * 128; d.v1 = lv + (size_t)(H0 - NCT) * 64 * 128;
            }
            d.part = (float*)(p.ws + WS_PART) + (size_t)u * PART_STRIDE;
        } else if (u < U_SG + U_SN) {
            const int uu = u - U_SG; const int qb = uu % QB_S, hd = (uu / QB_S) % NAH, b = uu / (QB_S * NAH);
            const size_t t0 = (size_t)NP + (size_t)b * DEC_SEQ;
            d.q = naq + (t0 + qb * 256) * 384 + hd * 64; d.qstride = 384;
            d.na = 1; d.r0 = qb * 4; d.rlo = na_row_start(d.r0);
            const int rhi = na_row_start(d.r0 + 3) + KR;
            d.n0 = PAST / 64; d.ntiles = d.n0 + (rhi - d.rlo); d.stride0 = 384; d.stride1 = 384;
            const size_t co = (((size_t)b * DEPTH + l) * PAST) * 384 + hd * 64;
            d.k0 = (const bf16_t*)(p.ws + WS_CNAK) + co; d.v0 = (const bf16_t*)(p.ws + WS_CNAV) + co;
            d.k1 = nak + (t0 + (size_t)d.rlo * 64) * 384 + hd * 64; d.v1 = nav + (t0 + (size_t)d.rlo * 64) * 384 + hd * 64;
            d.rpb = p.in[I_RPB] + ((size_t)l * NAH + hd) * 15 * 31;
            d.out = mixed + (t0 + qb * 256) * MIXW + hd * 64;
        } else if (u < U_SG + U_SN + U_PN) {
            const int uu = u - U_SG - U_SN; const int qb = uu % QB_P, hd = (uu / QB_P) % NAH, b = uu / (QB_P * NAH);
            const size_t t0 = (size_t)b * SEQ;
            d.q = naq + (t0 + qb * 256) * 384 + hd * 64; d.qstride = 384;
            d.n0 = 0; d.ntiles = SEQ / 64; d.stride1 = 384; d.k1 = nak + t0 * 384 + hd * 64; d.v1 = nav + t0 * 384 + hd * 64;
            d.out = mixed + (t0 + qb * 256) * MIXW + hd * 64;
        } else if (u < U_SG + U_SN + U_PN + U_PG) {
            const int uu = u - U_SG - U_SN - U_PN; const int qb = uu % QB_P, qh = (uu / QB_P) % GQH, b = uu / (QB_P * GQH);
            const int kvh = qh / (GQH / GQKV);
            const size_t t0 = (size_t)b * SEQ;
            d.q = gqq + (t0 + qb * 256) * 384 + qh * 64; d.qstride = 384;
            d.n0 = 0; d.ntiles = SEQ / 64; d.stride1 = 128; d.k1 = gqk + t0 * 128 + kvh * 64; d.v1 = gqv + t0 * 128 + kvh * 64;
            d.out = mixed + (t0 + qb * 256) * MIXW + 640 + qh * 64;
        } else {
            int uu = u - (U_SG + U_SN + U_PN + U_PG); const int grp = uu >= U_MP ? 1 : 0; if (grp) uu -= U_MP;
            const int nch = grp ? NCH_S : NCH_P;
            mlstm_summary_unit(p, smem, grp, uu / (nch * MLH), (uu / nch) % MLH, uu % nch);
        }
        if (u < U_SG + U_SN + U_PN + U_PG) attn_unit(smem, d);
    }
}

DEV void phase_mlout(const Params& p, char* smem, int l) {
    constexpr int QB_S = DEC_SEQ / 256;
    constexpr int U_MS = DEC_BATCH * MLH * NCH_S, U_MP = BATCH * MLH * NCH_P, U_CB = DEC_BATCH * GQH * QB_S;
    const int tid = get_tid(), lane = tid & 63, wave = tid >> 6;
    for (int tk = blockIdx.x + gridDim.x * wave; tk < U_CB * 4; tk += gridDim.x * 8) {
        const int uu = tk >> 2, sl = tk & 3;
        const int qb = uu % QB_S, qh = (uu / QB_S) % GQH, b = uu / (QB_S * GQH);
        const float* p0 = (const float*)(p.ws + WS_PART) + (size_t)(2 * uu) * PART_STRIDE; const float* p1 = p0 + PART_STRIDE;
        const int q = sl * 64 + (lane >> 1) + 32 * 0, d0 = (lane & 1) * 32;
#pragma unroll
        for (int hq = 0; hq < 2; ++hq) {
            const int qq = q + 32 * hq;
            const float m0 = p0[256 * 64 + qq], m1 = p1[256 * 64 + qq], l0 = p0[256 * 64 + 256 + qq], l1 = p1[256 * 64 + 256 + qq];
            const float m = fmaxf(m0, m1), w0 = fexp2(m0 - m), w1 = fexp2(m1 - m);
            const float inv = 1.f / (l0 * w0 + l1 * w1);
            bf16_t* dst = (bf16_t*)(p.ws + WS_MIXED) + ((size_t)NP + (size_t)b * DEC_SEQ + qb * 256 + qq) * MIXW + 640 + qh * 64 + d0;
#pragma unroll
            for (int i = 0; i < 8; ++i) {
                const f4v a = *(const f4v*)(p0 + (size_t)qq * 64 + d0 + 4 * i), bb = *(const f4v*)(p1 + (size_t)qq * 64 + d0 + 4 * i);
                u2v pk; pk[0] = pack2((a[0] * w0 + bb[0] * w1) * inv, (a[1] * w0 + bb[1] * w1) * inv); pk[1] = pack2((a[2] * w0 + bb[2] * w1) * inv, (a[3] * w0 + bb[3] * w1) * inv);
                *(u2v*)(dst + 4 * i) = pk;
            }
        }
    }
    for (int u = blockIdx.x; u < U_MS + U_MP; u += gridDim.x) {
        const int grp = u < U_MS ? 1 : 0; const int uu = grp ? u : u - U_MS; const int nch = grp ? NCH_S : NCH_P;
        mlstm_output_unit(p, smem, l, grp, uu / (nch * MLH), (uu / nch) % MLH, uu % nch);
    }
}

constexpr int N_PHASES = 2 + 9 * DEPTH;
#ifndef EMU
typedef const __attribute__((address_space(4))) Params* KParamsPtr;
DEV void load_params(Params& p) {
    KParamsPtr kp = (KParamsPtr)__builtin_amdgcn_kernarg_segment_ptr();
    asm volatile("" : "+s"(kp));
#pragma unroll
    for (int i = 0; i < N_IN; ++i) p.in[i] = kp->in[i];
    p.out = kp->out; p.ws = kp->ws; p.ph0 = kp->ph0; p.ph1 = kp->ph1;
}
#endif
#ifdef EMU
static char emu_smem[SMEM_BYTES + 64];
#endif
__global__ void __launch_bounds__(512, 2) mega_kernel(Params p_) {
    const int ph0 = p_.ph0, ph1 = p_.ph1;
#ifdef EMU
    char* smem = emu_smem;
#define GRID_SYNC() do {} while (0)
#else
    extern __shared__ __attribute__((aligned(16))) char smem[];
    if (threadIdx.x == 0) *(u4v*)(smem + SMEM_XB) = (u4v){0u, 0u, 0u, 0u};
    __syncthreads();
    (void)xcd_barrier_post((unsigned*)(p_.ws + WS_BAR), (volatile LAS unsigned*)(smem + SMEM_XB));
    const bool multi = (ph1 - ph0) > 1;
#define GRID_SYNC() do { if (multi) { KParamsPtr kpb = (KParamsPtr)__builtin_amdgcn_kernarg_segment_ptr(); asm volatile("" : "+s"(kpb)); \
        XcdBarrier xb; xb.bar = (unsigned*)(kpb->ws + WS_BAR); xb.x = xb_xcc_id(); xb.st = (volatile LAS unsigned*)(smem + SMEM_XB); xcd_barrier(xb); } } while (0)
#endif
    int ph = 0;
#ifndef KIND_MASK
#define KIND_MASK 0x3ff
#endif
#ifdef EMU
#define LOAD_PARAMS() const Params& p = p_
#else
#define LOAD_PARAMS() Params p; load_params(p)
#endif
#ifndef DOUBLE_MASK
#define DOUBLE_MASK 0
#endif
#define PH_KIND() (ph == 0 ? 0 : ph == 1 + 9 * DEPTH ? 1 : 1 + (ph - 1) % 9)
#define RUN_PHASE(body) do { if (((KIND_MASK >> PH_KIND()) & 1) && ph >= ph0 && ph < ph1) { \
    if (DOUBLE_MASK && ((DOUBLE_MASK >> PH_KIND()) & 1)) { { const int rep_ = 1; LOAD_PARAMS(); body; } GRID_SYNC(); } \
    { const int rep_ = 0; LOAD_PARAMS(); body; } if (ph + 1 < ph1) GRID_SYNC(); } ++ph; } while (0)
    RUN_PHASE(phase_ada(p, smem));
    for (int l = 0; l < DEPTH; ++l) {
        RUN_PHASE(phase_rows<0>(p, smem, l));
        RUN_PHASE(phase_inproj<0>(p, smem, l));
        RUN_PHASE(phase_attn(p, smem, l, l + DEPTH * rep_));
        RUN_PHASE(phase_mlout(p, smem, l));
        RUN_PHASE(phase_outproj<0>(p, smem, l));
        RUN_PHASE(phase_rows<1>(p, smem, l));
        RUN_PHASE(phase_topk(p, smem));
        RUN_PHASE(phase_gateup<0>(p, smem, l));
        RUN_PHASE(phase_down<0>(p, smem, l));
    }
    RUN_PHASE(phase_rows<0>(p, smem, DEPTH));
}

#if !defined(EMU) && defined(PROBE_KIND)
__global__ void __launch_bounds__(512, 2) probe_kernel(Params p) {
    extern __shared__ __attribute__((aligned(16))) char smem[];
    for (int r = 0; r < PROBE_REPS; ++r) {
#if PROBE_KIND == 8
        phase_gateup<PROBE_VAR>(p, smem, 1);
#elif PROBE_KIND == 9
        phase_down<PROBE_VAR>(p, smem, 1);
#elif PROBE_KIND == 2
        phase_inproj<PROBE_VAR>(p, smem, 1);
#elif PROBE_KIND == 5
        phase_outproj<PROBE_VAR>(p, smem, 1);
#elif PROBE_KIND == 0
        phase_ada(p, smem);
#elif PROBE_KIND == 1
        phase_rows<0>(p, smem, 1);
#elif PROBE_KIND == 6
        phase_rows<1>(p, smem, 1);
#elif PROBE_KIND == 7
        phase_topk(p, smem);
#elif PROBE_KIND == 3
        phase_attn(p, smem, 1, 8 + r);
#elif PROBE_KIND == 4
        phase_mlout(p, smem, 1);
#endif
        __syncthreads();
    }
}
#endif
#ifndef EMU
#ifndef MK_N_LAUNCHES
#define MK_N_LAUNCHES 1
#endif
extern "C" void kernel_launch(void* const* d_in, const int* in_sizes, int n_in, void* d_out, int out_size, void* d_ws, size_t ws_size, hipStream_t stream) {
    (void)in_sizes; (void)n_in; (void)out_size; (void)ws_size;
    static int grid = 0;
    if (!grid) {
        int dev = 0, cus = 0, per_cu = 0;
        (void)hipGetDevice(&dev);
        (void)hipDeviceGetAttribute(&cus, hipDeviceAttributeMultiprocessorCount, dev);
        (void)hipFuncSetAttribute((const void*)mega_kernel, hipFuncAttributeMaxDynamicSharedMemorySize, SMEM_BYTES);
        (void)hipOccupancyMaxActiveBlocksPerMultiprocessor(&per_cu, mega_kernel, 512, SMEM_BYTES);
        grid = cus * (per_cu < 1 ? per_cu : 1);
        if (grid <= 0) grid = cus;
    }
    (void)hipMemsetAsync((char*)d_ws + WS_BAR, 0, WS_BAR_BYTES, stream);
    Params p = {};
    for (int i = 0; i < N_IN; ++i) p.in[i] = (const float*)d_in[i];
    p.out = (float*)d_out; p.ws = (char*)d_ws;
#if MK_N_LAUNCHES == 1
    p.ph0 = 0; p.ph1 = N_PHASES;
    mega_kernel<<<dim3(grid), dim3(512), SMEM_BYTES, stream>>>(p);
#ifdef PROBE_KIND
    (void)hipFuncSetAttribute((const void*)probe_kernel, hipFuncAttributeMaxDynamicSharedMemorySize, SMEM_BYTES);
    probe_kernel<<<dim3(grid), dim3(512), SMEM_BYTES, stream>>>(p);
#endif
#else
    for (int ph = 0; ph < N_PHASES; ++ph) { p.ph0 = ph; p.ph1 = ph + 1; mega_kernel<<<dim3(grid), dim3(512), SMEM_BYTES, stream>>>(p); }
#endif
}
#endif
```

```cpp
#ifndef EMU
#include <hip/hip_runtime.h>
#define DEV __device__ __forceinline__
#else
#define DEV static inline __attribute__((always_inline))
#endif
#include <stdint.h>
#include <stddef.h>

#ifndef CFG_D
#define CFG_D 1024
#define CFG_BATCH 16
#define CFG_SEQ 256
#define CFG_DEC_BATCH 2
#define CFG_DEC_SEQ 2048
#define CFG_PAST 256
#define CFG_EH 2816
#endif
constexpr int D = CFG_D, BATCH = CFG_BATCH, SEQ = CFG_SEQ, DEC_BATCH = CFG_DEC_BATCH, DEC_SEQ = CFG_DEC_SEQ, PAST = CFG_PAST, EH = CFG_EH;
constexpr int DEPTH = 2, HD = 64, NAH = 6, MLH = 4, GQH = 6, GQKV = 2, NEXP = 16, GRIDW = 64;
constexpr int NP = BATCH * SEQ, NS = DEC_BATCH * DEC_SEQ, NT = NP + NS, NCOND = 1 + DEC_BATCH;
constexpr int PROJ_W = 2832, MIXW = 1024;
constexpr int CAP_P = SEQ / 8, CAP_S = DEC_SEQ / 8, SLOTS = BATCH * CAP_P + DEC_BATCH * CAP_S;
constexpr int ROWS = DEC_SEQ / GRIDW, KR = ROWS < 8 ? ROWS : 8, KC = 16;
constexpr int NCH_P = SEQ / 64, NCH_S = DEC_SEQ / 64;
constexpr float ALPHA = 1.41421356237309515f;
constexpr float ATT_SCALE = 0.125f;
constexpr float EPS = 1e-6f;
static_assert(SLOTS % 256 == 0 && NP % 256 == 0 && NS % 256 == 0 && SEQ % 256 == 0 && DEC_SEQ % 256 == 0, "tile divisibility");
static_assert(D % 256 == 0 && EH % 128 == 0 && PAST % 64 == 0, "tile divisibility");

typedef unsigned short bf16_t;
typedef short s8v __attribute__((ext_vector_type(8)));
typedef short s4v __attribute__((ext_vector_type(4)));
typedef float f16v __attribute__((ext_vector_type(16)));
typedef float f4v __attribute__((ext_vector_type(4)));
typedef unsigned u4v __attribute__((ext_vector_type(4)));
typedef unsigned u2v __attribute__((ext_vector_type(2)));

enum { I_XP = 0, I_XS, I_C, I_CNAK, I_CNAV, I_CGQK, I_CGQV, I_SC, I_SN, I_SM, I_CCTX, I_ADAW, I_ADAB, I_WIN, I_BGATE, I_WOUT, I_RPB, I_QKG, I_MLG,
       I_LNG, I_LNB, I_RW, I_WG, I_WU, I_WD, N_IN };

constexpr size_t O_YP = 0;
constexpr size_t O_YS = O_YP + (size_t)NP * D;
constexpr size_t O_NAK = O_YS + (size_t)NS * D;
constexpr size_t O_NAV = O_NAK + (size_t)BATCH * DEPTH * SEQ * NAH * HD;
constexpr size_t O_GQK = O_NAV + (size_t)BATCH * DEPTH * SEQ * NAH * HD;
constexpr size_t O_GQV = O_GQK + (size_t)BATCH * DEPTH * SEQ * GQKV * HD;
constexpr size_t O_MC = O_GQV + (size_t)BATCH * DEPTH * SEQ * GQKV * HD;
constexpr size_t O_MN = O_MC + (size_t)BATCH * DEPTH * 2 * MLH * HD * HD;
constexpr size_t O_MM = O_MN + (size_t)BATCH * DEPTH * 2 * MLH * HD;
constexpr size_t O_END = O_MM + (size_t)BATCH * DEPTH * 2 * MLH;

constexpr size_t al256(size_t x) { return (x + 255) & ~(size_t)255; }
constexpr size_t WS_BAR = 0;
constexpr size_t WS_BAR_BYTES = 32768;
constexpr size_t WS_MODS = WS_BAR + WS_BAR_BYTES;
constexpr size_t WS_ROPE = al256(WS_MODS + (size_t)DEPTH * NCOND * 6 * D * 4);
constexpr size_t WS_CNAK = al256(WS_ROPE + 64 * 16 * 2 * 4);
constexpr size_t WS_CNAV = al256(WS_CNAK + (size_t)DEC_BATCH * DEPTH * PAST * NAH * HD * 2);
constexpr size_t WS_CGQK = al256(WS_CNAV + (size_t)DEC_BATCH * DEPTH * PAST * NAH * HD * 2);
constexpr size_t WS_CGQV = al256(WS_CGQK + (size_t)DEC_BATCH * DEPTH * PAST * GQKV * HD * 2);
constexpr size_t WS_XBUF = al256(WS_CGQV + (size_t)DEC_BATCH * DEPTH * PAST * GQKV * HD * 2);
constexpr size_t WS_HMOD = al256(WS_XBUF + (size_t)NT * D * 4);
constexpr size_t WS_GATES = al256(WS_HMOD + (size_t)NT * D * 2);
constexpr size_t WS_NAQ = al256(WS_GATES + (size_t)NT * 16 * 4);
constexpr size_t WS_NAK = al256(WS_NAQ + (size_t)NT * 384 * 2);
constexpr size_t WS_NAV = al256(WS_NAK + (size_t)NT * 384 * 2);
constexpr size_t WS_MLQ = al256(WS_NAV + (size_t)NT * 384 * 2);
constexpr size_t WS_MLK = al256(WS_MLQ + (size_t)NT * 256 * 2);
constexpr size_t WS_MLV = al256(WS_MLK + (size_t)NT * 256 * 2);
constexpr size_t WS_MLO = al256(WS_MLV + (size_t)NT * 256 * 2);
constexpr size_t WS_GQQ = al256(WS_MLO + (size_t)NT * 256 * 2);
constexpr size_t WS_GQK = al256(WS_GQQ + (size_t)NT * 384 * 2);
constexpr size_t WS_GQV = al256(WS_GQK + (size_t)NT * 128 * 2);
constexpr size_t WS_MIXED = al256(WS_GQV + (size_t)NT * 128 * 2);
constexpr size_t WS_U = al256(WS_MIXED + (size_t)NT * MIXW * 2);
constexpr size_t WS_X1 = al256(WS_U + (size_t)NT * D * 4);
constexpr size_t WS_H2 = al256(WS_X1 + (size_t)NT * D * 4);
constexpr size_t WS_AFF = al256(WS_H2 + (size_t)NT * D * 2);
constexpr size_t WS_IDX = al256(WS_AFF + (size_t)NT * 16 * 4);
constexpr size_t WS_GSEL = al256(WS_IDX + (size_t)NEXP * SLOTS * 4);
constexpr size_t WS_TOKSLOT = al256(WS_GSEL + (size_t)NEXP * SLOTS * 4);
constexpr size_t WS_HID = al256(WS_TOKSLOT + (size_t)NT * 16 * 4);
constexpr size_t WS_YE = al256(WS_HID + (size_t)NEXP * SLOTS * EH * 2);
constexpr int MLSUM_STRIDE = 4096 + 64 + 64;
constexpr int N_MLSUM = (BATCH * NCH_P + DEC_BATCH * NCH_S) * MLH * 2;
constexpr size_t WS_MLSUM = al256(WS_YE + (size_t)NEXP * SLOTS * D * 2);
constexpr int PART_STRIDE = 256 * 64 + 512;
constexpr int N_PART = DEC_BATCH * GQH * (DEC_SEQ / 256) * 2;
constexpr size_t WS_PART = al256(WS_MLSUM + (size_t)N_MLSUM * MLSUM_STRIDE * 4);
constexpr size_t WS_TOTAL = al256(WS_PART + (size_t)N_PART * PART_STRIDE * 4);

struct Params {
    const float* in[N_IN];
    float* out;
    char* ws;
    int ph0, ph1;
};

DEV float bf2f(bf16_t s) { unsigned u = ((unsigned)s) << 16; return __builtin_bit_cast(float, u); }
DEV bf16_t f2bf(float f) {
#ifdef EMU
    unsigned u = __builtin_bit_cast(unsigned, f); u += 0x7fffu + ((u >> 16) & 1u); return (bf16_t)(u >> 16);
#else
    return __builtin_bit_cast(bf16_t, (__bf16)f);
#endif
}
DEV unsigned pack2(float a, float b) {
#ifdef EMU
    return (unsigned)f2bf(a) | ((unsigned)f2bf(b) << 16);
#else
    typedef __bf16 b2 __attribute__((ext_vector_type(2))); b2 r; r[0] = (__bf16)a; r[1] = (__bf16)b; return __builtin_bit_cast(unsigned, r);
#endif
}
DEV float fexp(float x) {
#ifdef EMU
    return expf(x);
#else
    return __expf(x);
#endif
}
DEV float fexp2(float x) {
#ifdef EMU
    return exp2f(x);
#else
    return __builtin_amdgcn_exp2f(x);
#endif
}
DEV float frcp(float x) {
#ifdef EMU
    return 1.f / x;
#else
    return __builtin_amdgcn_rcpf(x);
#endif
}
DEV float sigmoidf_(float x) { return frcp(1.f + fexp(-x)); }
DEV float siluf_(float x) { return x * frcp(1.f + fexp(-x)); }
DEV float flog(float x) {
#ifdef EMU
    return logf(x);
#else
    return __logf(x);
#endif
}
DEV float frsqrt(float x) {
#ifdef EMU
    return 1.f / sqrtf(x);
#else
    return __builtin_amdgcn_rsqf(x);
#endif
}
DEV float logsigmoidf_(float x) { return fminf(x, 0.f) - flog(1.f + fexp(-fabsf(x))); }
DEV f16v mfma32(s8v a, s8v b, f16v c) {
#ifdef EMU
    return emu_mfma_32x32x16_bf16(a, b, c);
#else
    typedef __bf16 bf8 __attribute__((ext_vector_type(8)));
    return __builtin_amdgcn_mfma_f32_32x32x16_bf16(__builtin_bit_cast(bf8, a), __builtin_bit_cast(bf8, b), c, 0, 0, 0);
#endif
}
DEV s4v lds_tr16(const void* p) {
#ifdef EMU
    return emu_ds_read_tr16_b64(p);
#else
    typedef s4v __attribute__((address_space(3))) * lp;
    return __builtin_amdgcn_ds_read_tr16_b64_v4i16((lp)(p));
#endif
}
#ifdef EMU
DEV float wave_sum(float v) { for (int m = 32; m >= 1; m >>= 1) v += __shfl_xor(v, m); return v; }
#else
template <int CTRL, int RM> DEV float dpp_f(float v) { return __builtin_bit_cast(float, __builtin_amdgcn_update_dpp(0, __builtin_bit_cast(int, v), CTRL, RM, 0xF, false)); }
DEV float wave_sum(float v) {
    v += dpp_f<0xB1, 0xF>(v); v += dpp_f<0x4E, 0xF>(v); v += dpp_f<0x141, 0xF>(v); v += dpp_f<0x140, 0xF>(v);
    v += dpp_f<0x142, 0xA>(v); v += dpp_f<0x143, 0xC>(v);
    return __builtin_bit_cast(float, __builtin_amdgcn_readlane(__builtin_bit_cast(int, v), 63));
}
#endif
DEV float wave_max(float v) { for (int m = 32; m >= 1; m >>= 1) v = fmaxf(v, __shfl_xor(v, m)); return v; }
DEV f16v f16zero() { f16v z; for (int i = 0; i < 16; ++i) z[i] = 0.f; return z; }

#ifdef EMU
#define VGPR_PIN(x) do {} while (0)
#define SGPR_PIN(x) do {} while (0)
#define SCHED_FENCE() do {} while (0)
#define CFENCE() do {} while (0)
#else
#define SCHED_FENCE() __builtin_amdgcn_sched_barrier(0)
#define SGPR_PIN(x) asm volatile("" : "+s"(x))
#define VGPR_PIN(x) asm volatile("" : "+v"(x))
#define CFENCE() asm volatile("" ::: "memory")
#endif
#ifdef EMU
DEV int get_tid() { return (int)threadIdx.x; }
#else
DEV int get_tid() { int t = threadIdx.x; asm volatile("" : "+v"(t)); return t; }
#endif
struct UnitIter { int i, end, step; };
DEV UnitIter unit_iter(int NU) {
    const int G = (int)gridDim.x, b = (int)blockIdx.x;
    UnitIter it;
#ifndef XCD_MODE
#define XCD_MODE 0
#endif
    if ((G & 7) == 0 && (NU & 7) == 0) { const int W = G >> 3, x = XCD_MODE ? b / W : b & 7, j = XCD_MODE ? b % W : b >> 3, C = NU >> 3; it.i = x * C + j; it.end = (x + 1) * C; it.step = W; }
    else { it.i = b; it.end = NU; it.step = G; }
    return it;
}
DEV int tok_cond(int t) { return t < NP ? 0 : 1 + (t - NP) / DEC_SEQ; }

#ifndef EMU
#define XB_TMO      128
#define XB_XCNT(j)  (256  + 64 * (j))
#define XB_XSUB(j)  (1280 + 64 * (j))
#define XB_XGEN(j)  (2304 + 64 * (j))
#define XB_TOP      3328
#define XB_TOPGEN   3392
#define XCD_BAR_WORDS 3456
#define XB_SPIN_CAP (1u << 20)
#define LAS __attribute__((address_space(3)))
__device__ __forceinline__ unsigned xb_ld(unsigned* p)              { return __hip_atomic_load(p, __ATOMIC_RELAXED, __HIP_MEMORY_SCOPE_AGENT); }
__device__ __forceinline__ unsigned xb_add(unsigned* p, unsigned v) { return __hip_atomic_fetch_add(p, v, __ATOMIC_RELAXED, __HIP_MEMORY_SCOPE_AGENT); }
__device__ __forceinline__ unsigned xb_xcc_id() { return (unsigned)__builtin_amdgcn_s_getreg((3 << 11) | 20) & 0xFu; }
#define XB_SPIN(cond, bar) do { unsigned _sp = 0; while (cond) { __builtin_amdgcn_s_sleep(1); \
    if ((++_sp & 255u) == 0u) { if (xb_ld(&(bar)[XB_TMO])) break; if (_sp > XB_SPIN_CAP) { atomicAdd(&(bar)[XB_TMO], 1u); break; } } } } while (0)
struct XcdBarrier { unsigned* bar; unsigned x; volatile LAS unsigned* st; };
__device__ __forceinline__ XcdBarrier xcd_barrier_post(unsigned* bar, volatile LAS unsigned* st) {
    XcdBarrier b; b.bar = bar; b.x = xb_xcc_id(); b.st = st;
    if (threadIdx.x == 0) (void)xb_add(&bar[XB_XCNT(b.x)], 1u);
    return b;
}
__device__ __forceinline__ void xcd_barrier_complete(unsigned* bar, unsigned x, unsigned& nloc, unsigned& nx) {
    const unsigned G = gridDim.x * gridDim.y * gridDim.z;
    unsigned sum, cnt, mine, sp = 0u;
    for (;;) {
        sum = 0u; cnt = 0u; mine = 0u;
#pragma unroll
        for (unsigned j = 0; j < 16; ++j) { const unsigned c = xb_ld(&bar[XB_XCNT(j)]); sum += c; cnt += (c > 0u) ? 1u : 0u; mine = (j == x) ? c : mine; }
        if (sum == G) break;
        __builtin_amdgcn_s_sleep(1);
        if ((++sp & 255u) == 0u) { if (xb_ld(&bar[XB_TMO])) break; if (sp > XB_SPIN_CAP) { atomicAdd(&bar[XB_TMO], 1u); break; } }
    }
    nloc = mine > 0u ? mine : 1u; nx = cnt > 0u ? cnt : 1u;
}
__device__ __forceinline__ void xcd_barrier(const XcdBarrier& b) {
    asm volatile("s_waitcnt vmcnt(0)" ::: "memory");
    __syncthreads();
    if (threadIdx.x == 0) {
        unsigned* bar = b.bar;
        __builtin_amdgcn_s_waitcnt(0);
        unsigned nloc = b.st[0], nx = b.st[1];
        if (nloc == 0u) { xcd_barrier_complete(bar, b.x, nloc, nx); b.st[0] = nloc; b.st[1] = nx; }
        const unsigned old = xb_add(&bar[XB_XSUB(b.x)], 1u);
        const unsigned gen = old / nloc;
        if (old + 1u == (gen + 1u) * nloc) {
            __builtin_amdgcn_fence(__ATOMIC_RELEASE, "agent");
            asm volatile("s_waitcnt vmcnt(0)" ::: "memory");
            const unsigned og = xb_add(&bar[XB_TOP], 1u);
            const unsigned tg = og / nx;
            if (og + 1u == (tg + 1u) * nx) xb_add(&bar[XB_TOPGEN], 1u);
            else XB_SPIN(xb_ld(&bar[XB_TOPGEN]) == tg, bar);
            __builtin_amdgcn_fence(__ATOMIC_ACQUIRE, "agent");
            xb_add(&bar[XB_XGEN(b.x)], 1u);
            asm volatile("s_waitcnt vmcnt(0)" ::: "memory");
        } else {
            XB_SPIN(xb_ld(&bar[XB_XGEN(b.x)]) == gen, bar);
            __builtin_amdgcn_fence(__ATOMIC_ACQUIRE, "agent");
            asm volatile("s_waitcnt vmcnt(0)" ::: "memory");
        }
    }
    __syncthreads();
}
#endif
constexpr int QUEUE_WORD0 = 4096;

constexpr int LROW = 144;
constexpr int GEMM_AS = 256 * LROW;
constexpr int GEMM_BS = 64 * (256 * 2 + 64);
constexpr int SMEM_XB = 2 * GEMM_AS + 2 * GEMM_BS;
constexpr int SMEM_AUX = SMEM_XB + 64;
constexpr int SMEM_BYTES = SMEM_AUX + 2048;

#ifdef EMU
struct BufRsrc { const char* base; };
DEV BufRsrc make_rsrc(const void* p) { BufRsrc r; r.base = (const char*)p; return r; }
DEV float buf_load_f32(BufRsrc r, unsigned voff, unsigned soff) { return *(const float*)(r.base + voff + soff); }
DEV u4v buf_load_b128(BufRsrc r, unsigned voff, unsigned soff) { return *(const u4v*)(r.base + voff + soff); }
#else
typedef __amdgpu_buffer_rsrc_t BufRsrc;
DEV BufRsrc make_rsrc(const void* p) { return __builtin_amdgcn_make_buffer_rsrc((void*)p, 0, 0x7fffffff, 0x00020000); }
DEV float buf_load_f32(BufRsrc r, unsigned voff, unsigned soff) { return __builtin_bit_cast(float, __builtin_amdgcn_raw_buffer_load_b32(r, voff, soff, 0)); }
DEV u4v buf_load_b128(BufRsrc r, unsigned voff, unsigned soff) { return __builtin_amdgcn_raw_buffer_load_b128(r, voff, soff, 0); }
#endif
#ifdef EMU
#define WAVE_SYNC() do { (void)__shfl(0, 0); } while (0)
#else
#define WAVE_SYNC() asm volatile("s_waitcnt lgkmcnt(0)" ::: "memory")
#endif
DEV char* wave_stage_ptr(char* smem, int wave) { return smem + (wave < 4 ? GEMM_AS + wave * 9216 : 2 * GEMM_AS + GEMM_BS + (wave - 4) * 9216); }
DEV void stage64_write_bf16(char* stg, int tt, const f16v& v0, const f16v& v1, int l31, int h) {
    char* row = stg + (tt * 32 + l31) * LROW;
#pragma unroll
    for (int ft = 0; ft < 2; ++ft) {
        const f16v& v = ft ? v1 : v0;
#pragma unroll
        for (int g = 0; g < 4; ++g) { u2v pk; pk[0] = pack2(v[4 * g], v[4 * g + 1]); pk[1] = pack2(v[4 * g + 2], v[4 * g + 3]); *(u2v*)(row + (ft * 32 + 8 * g + 4 * h) * 2) = pk; }
    }
}
DEV void stage64_write4(char* stg, int row, int col, float a, float b, float c, float d) {
    u2v pk; pk[0] = pack2(a, b); pk[1] = pack2(c, d); *(u2v*)(stg + row * LROW + col * 2) = pk;
}
DEV void stage64_flush_bf16(const char* stg, bf16_t* dst0, size_t row_stride, int lane) {
    WAVE_SYNC();
#pragma unroll
    for (int i = 0; i < 8; ++i) { const int r = (lane >> 3) + 8 * i, c = lane & 7; const u4v v = *(const u4v*)(stg + r * LROW + c * 16); *(u4v*)(dst0 + (size_t)r * row_stride + c * 8) = v; }
    WAVE_SYNC();
}
template <int NTW, int VAR, class Epi>
DEV void gemm_tile(char* smem, BufRsrc ars, unsigned ao0, unsigned ao1, unsigned ao2, unsigned ao3,
                   BufRsrc brs, unsigned bvo, unsigned blds, unsigned ldb4, int K, Epi&& epi) {
    constexpr int BN = 64 * NTW, NLD = 2 * NTW, KSTEP = 64 / NLD, RSB = BN * 2 + 64;
    const int tid = get_tid(), lane = tid & 63, wave = tid >> 6, wm = wave & 3, wn = wave >> 2, h = lane >> 5, l31 = lane & 31;
    char* As = smem; char* Bs = smem + 2 * GEMM_AS;
    constexpr int BSZ = GEMM_BS;
    const int ar = tid >> 3, ac = tid & 7;
    u4v areg[2]; f4v b0[NLD], b1[NLD];
    if (VAR & 3) { for (int i = 0; i < 2; ++i) areg[i] = (u4v){1u, 2u, 3u, 4u}; for (int j = 0; j < NLD; ++j) { b0[j] = (f4v){1.f, 1.f, 1.f, 1.f}; b1[j] = (f4v){2.f, 2.f, 2.f, 2.f}; } }
    f16v acc[NTW][2];
#pragma unroll
    for (int i = 0; i < NTW; ++i) { acc[i][0] = f16zero(); acc[i][1] = f16zero(); }
    auto gloadA = [&](int k0, bool real, int half) {
        if (VAR & 2) return;
        const unsigned so = real ? k0 * 2 : 0u;
        areg[0] = buf_load_b128(ars, real ? (half ? ao2 : ao0) : 0u, so); areg[1] = buf_load_b128(ars, real ? (half ? ao3 : ao1) : 0u, so);
    };
    auto gloadB = [&](int k0, bool real, f4v (&br)[NLD]) {
        if (VAR & 1) return;
        const unsigned vo = real ? bvo : 0u; const int kk = real ? k0 : 0;
        unsigned so = (unsigned)kk * ldb4;
#pragma unroll
        for (int j = 0; j < NLD; ++j) { br[j] = __builtin_bit_cast(f4v, buf_load_b128(brs, vo, so)); so += KSTEP * ldb4; SGPR_PIN(so); }
    };
    auto gloadB1 = [&](int k0, bool real, f4v (&br)[NLD], int j) {
        if (VAR & 1) return;
        br[j] = __builtin_bit_cast(f4v, buf_load_b128(brs, real ? bvo : 0u, (unsigned)((real ? k0 : 0) + j * KSTEP) * ldb4));
    };
    auto lstoreA = [&](int buf, int half) {
        if (VAR & 16) return;
        char* ab = As + buf * GEMM_AS + (ar + half * 128) * LROW + ac * 16;
        *(u4v*)(ab) = areg[0]; *(u4v*)(ab + 64 * LROW) = areg[1];
    };
    auto lstoreB = [&](int buf, const f4v (&br)[NLD]) {
        if (VAR & 16) return;
        char* bb = Bs + buf * BSZ + blds;
#pragma unroll
        for (int j = 0; j < NLD; ++j) { u2v v; v[0] = pack2(br[j][0], br[j][1]); v[1] = pack2(br[j][2], br[j][3]); *(u2v*)(bb + j * KSTEP * RSB) = v; }
    };
    const unsigned btr = (unsigned)(8 * h + ((lane & 15) >> 2)) * RSB + (unsigned)((((lane >> 4) & 1) * 16 + 4 * (lane & 3)) * 2) + (unsigned)(wn * NTW * 32) * 2;
    const unsigned atr = (unsigned)(wm * 64 + l31) * LROW + h * 16;
    auto rdw = [&](int buf, int s, int ft) -> s8v {
        if (VAR & 64) { s8v z; for (int q = 0; q < 8; ++q) z[q] = (short)(0x3f80 + ft); return z; }
        const char* bb = Bs + buf * BSZ + btr + s * 16 * RSB + ft * 64;
        const s4v lo = lds_tr16(bb), hi = lds_tr16(bb + 4 * RSB);
        s8v wf; wf[0] = lo[0]; wf[1] = lo[1]; wf[2] = lo[2]; wf[3] = lo[3]; wf[4] = hi[0]; wf[5] = hi[1]; wf[6] = hi[2]; wf[7] = hi[3];
        return wf;
    };
    auto compute2 = [&](int buf, int s0, auto&& hook) {
        if (VAR & 8) { for (int g = 0; g < 2 * NTW; ++g) hook(g); return; }
        const char* ab = As + buf * GEMM_AS + atr;
        s8v xa[2];
        if (VAR & 64) { for (int q = 0; q < 8; ++q) { xa[0][q] = 0x3f80; xa[1][q] = 0x3f80; } } else { xa[0] = *(const s8v*)(ab + s0 * 32); xa[1] = *(const s8v*)(ab + 32 * LROW + s0 * 32); }
        s8v wcur = rdw(buf, s0, 0);
#pragma unroll
        for (int g = 0; g < 2 * NTW; ++g) {
            const int ft = g % NTW;
            s8v wnext = wcur;
            if (g + 1 < 2 * NTW) wnext = rdw(buf, s0 + (g + 1) / NTW, (g + 1) % NTW);
            if (VAR & 4) { acc[ft][0][0] += __builtin_bit_cast(float, (int)wcur[0] | ((int)xa[0][1] << 16)); acc[ft][1][0] += __builtin_bit_cast(float, (int)wcur[1] | ((int)xa[1][1] << 16)); }
            else { acc[ft][0] = mfma32(wcur, xa[0], acc[ft][0]); acc[ft][1] = mfma32(wcur, xa[1], acc[ft][1]); }
            if (g == NTW - 1 && !(VAR & 64)) { xa[0] = *(const s8v*)(ab + (s0 + 1) * 32); xa[1] = *(const s8v*)(ab + 32 * LROW + (s0 + 1) * 32); }
            wcur = wnext;
            hook(g);
            SCHED_FENCE();
        }
    };
    auto nohook = [](int) {};
    const int nk = K / 64;
    if (NTW == 2) {
        u4v a0[4], a1[4];
        if (VAR & 3) { for (int i = 0; i < 4; ++i) { a0[i] = (u4v){1u, 2u, 3u, 4u}; a1[i] = (u4v){1u, 2u, 3u, 4u}; } }
        auto gA = [&](int k0, bool real, u4v (&ar4)[4]) {
            if (VAR & 2) return;
            const unsigned so = real ? k0 * 2 : 0u;
            ar4[0] = buf_load_b128(ars, real ? ao0 : 0u, so); ar4[1] = buf_load_b128(ars, real ? ao1 : 0u, so);
            ar4[2] = buf_load_b128(ars, real ? ao2 : 0u, so); ar4[3] = buf_load_b128(ars, real ? ao3 : 0u, so);
        };
        auto sA = [&](int buf, const u4v (&ar4)[4]) {
            if (VAR & 16) return;
            char* ab = As + buf * GEMM_AS + ar * LROW + ac * 16;
#pragma unroll
            for (int i = 0; i < 4; ++i) *(u4v*)(ab + i * 64 * LROW) = ar4[i];
        };
        gA(0, true, a0); gloadB(0, true, b0); gA(64, true, a1); gloadB(64, true, b1);
        sA(0, a0); lstoreB(0, b0);
        __syncthreads();
        for (int kt = 0; kt < nk; kt += 2) {
            const bool t2 = kt + 2 < nk;
            gA((kt + 2) * 64, t2, a0); gloadB((kt + 2) * 64, t2, b0);
            compute2(0, 0, nohook); compute2(0, 2, nohook);
            sA(1, a1); lstoreB(1, b1);
            __syncthreads();
            gA((kt + 3) * 64, t2, a1); gloadB((kt + 3) * 64, t2, b1);
            compute2(1, 0, nohook); compute2(1, 2, nohook);
            sA(0, a0); lstoreB(0, b0);
            __syncthreads();
        }
    } else {
    {
        u4v at0, at1;
        gloadA(0, true, 0);
        if (!(VAR & 2)) { at0 = buf_load_b128(ars, ao2, 0); at1 = buf_load_b128(ars, ao3, 0); } else { at0 = areg[0]; at1 = areg[1]; }
        gloadB(0, true, b0); gloadB(64, true, b1);
        lstoreA(0, 0);
        if (!(VAR & 16)) { char* ab = As + (ar + 128) * LROW + ac * 16; *(u4v*)(ab) = at0; *(u4v*)(ab + 64 * LROW) = at1; }
        lstoreB(0, b0);
    }
    __syncthreads();
    for (int kt = 0; kt < nk; kt += 2) {
        const bool t2 = kt + 2 < nk;
        gloadA((kt + 1) * 64, true, 0);
        compute2(0, 0, nohook);
        lstoreA(1, 0);
        gloadA((kt + 1) * 64, true, 1);
        if (NLD == 2 * NTW) compute2(0, 2, [&](int g) { gloadB1((kt + 2) * 64, t2, b0, g); });
        else { gloadB((kt + 2) * 64, t2, b0); compute2(0, 2, nohook); }
        lstoreA(1, 1); lstoreB(1, b1);
        __syncthreads();
        gloadA((kt + 2) * 64, t2, 0);
        compute2(1, 0, nohook);
        lstoreA(0, 0);
        gloadA((kt + 2) * 64, t2, 1);
        if (NLD == 2 * NTW) compute2(1, 2, [&](int g) { gloadB1((kt + 3) * 64, t2, b1, g); });
        else { gloadB((kt + 3) * 64, t2, b1); compute2(1, 2, nohook); }
        lstoreA(0, 1); lstoreB(0, b0);
        __syncthreads();
    }
    }
    if (VAR & 32) { float t = 0.f; for (int i = 0; i < NTW; ++i) t += acc[i][0][0] + acc[i][1][5]; if (t == 123.456f) *(float*)smem = t; }
    else epi(acc);
}

DEV void phase_ada(const Params& p, char* smem) {
    const int tid = get_tid();
    float* siluS = (float*)smem;
    float* red = (float*)(smem + NCOND * D * 4);
    for (int i = tid; i < NCOND * D; i += 512) {
        const int cnd = i / D, k = i % D;
        const float c = cnd == 0 ? p.in[I_CCTX][k] : p.in[I_C][(cnd - 1) * D + k];
        siluS[i] = c * frcp(1.f + fexp(-c));
    }
    __syncthreads();
    constexpr int CPL = 6 * D / 32, NCHUNK = DEPTH * CPL, KG = D / 16;
    float* mods = (float*)(p.ws + WS_MODS);
    const int col = tid & 31, kg = tid >> 5;
    for (int u = blockIdx.x; u < NCHUNK; u += gridDim.x) {
        const int l = u / CPL, c0 = (u % CPL) * 32;
        const float* W = p.in[I_ADAW] + (size_t)l * D * 6 * D + c0 + col;
        float acc[NCOND];
#pragma unroll
        for (int c = 0; c < NCOND; ++c) acc[c] = 0.f;
#pragma unroll 8
        for (int k = kg * KG; k < kg * KG + KG; ++k) {
            const float w = W[(size_t)k * 6 * D];
#pragma unroll
            for (int c = 0; c < NCOND; ++c) acc[c] += siluS[c * D + k] * w;
        }
#pragma unroll
        for (int c = 0; c < NCOND; ++c) red[(kg * NCOND + c) * 32 + col] = acc[c];
        __syncthreads();
        if (tid < 32 * NCOND) {
            const int c = tid >> 5, cc = tid & 31;
            float s = 0.f;
            for (int g = 0; g < 16; ++g) s += red[(g * NCOND + c) * 32 + cc];
            mods[((size_t)l * NCOND + c) * 6 * D + c0 + cc] = s + p.in[I_ADAB][(size_t)l * 6 * D + c0 + cc];
        }
        __syncthreads();
    }
    const int gtid = blockIdx.x * 512 + tid, gsz = gridDim.x * 512;
    float* rope = (float*)(p.ws + WS_ROPE);
    for (int i = gtid; i < 64 * 16; i += gsz) {
        const int pos = i >> 4, fi = i & 15;
        const float inv = fexp2(-(float)(2 * fi) * (13.287712379549449f / 32.f));
        const float ang = (float)pos * inv;
#ifdef EMU
        rope[2 * i] = cosf(ang); rope[2 * i + 1] = sinf(ang);
#else
        rope[2 * i] = __cosf(ang); rope[2 * i + 1] = __sinf(ang);
#endif
    }
    constexpr int NNA = DEC_BATCH * DEPTH * PAST * NAH * HD, NGQ = DEC_BATCH * DEPTH * PAST * GQKV * HD;
    bf16_t* cnak = (bf16_t*)(p.ws + WS_CNAK); bf16_t* cnav = (bf16_t*)(p.ws + WS_CNAV);
    bf16_t* cgqk = (bf16_t*)(p.ws + WS_CGQK); bf16_t* cgqv = (bf16_t*)(p.ws + WS_CGQV);
    for (int i = gtid; i < NNA; i += gsz) { cnak[i] = f2bf(p.in[I_CNAK][i]); cnav[i] = f2bf(p.in[I_CNAV][i]); }
    for (int i = gtid; i < NGQ; i += gsz) { cgqk[i] = f2bf(p.in[I_CGQK][i]); cgqv[i] = f2bf(p.in[I_CGQV][i]); }
}

constexpr int EPL = D / 64;
constexpr int W16ROW = 20;
template <int MODE>
DEV void phase_rows(const Params& p, char* smem, int l) {
    const int tid = get_tid(), lane = tid & 63, wave = tid >> 6;
    float* W16 = (float*)smem;
    const bool need_w = (MODE == 1) || (l < DEPTH);
    if (need_w) {
        for (int i = tid; i < D * 4; i += 512) {
            const int k = i >> 2, q = i & 3;
            const float* src = (MODE == 1) ? p.in[I_RW] + ((size_t)l * D + k) * 16 + q * 4 : p.in[I_WIN] + ((size_t)l * D + k) * PROJ_W + 2176 + q * 4;
            *(f4v*)(W16 + k * W16ROW + q * 4) = *(const f4v*)src;
        }
    }
    __syncthreads();
    const float* mods = (const float*)(p.ws + WS_MODS);
    for (int t = blockIdx.x * 8 + wave; t < NT; t += gridDim.x * 8) {
        const int cnd = tok_cond(t);
        float v[EPL];
        if (MODE == 0 && l == 0) {
            const float* xr = t < NP ? p.in[I_XP] + (size_t)t * D : p.in[I_XS] + (size_t)(t - NP) * D;
#pragma unroll
            for (int j = 0; j < EPL; ++j) v[j] = xr[lane + 64 * j];
        } else if (MODE == 0) {
            const float* x1 = (const float*)(p.ws + WS_X1) + (size_t)t * D;
            const float* g2 = mods + ((size_t)(l - 1) * NCOND + cnd) * 6 * D + 5 * D;
            float f[EPL], xv[EPL], gv[EPL];
#pragma unroll
            for (int j = 0; j < EPL; ++j) { f[j] = 0.f; xv[j] = x1[lane + 64 * j]; gv[j] = g2[lane + 64 * j]; }
            const int* ts = (const int*)(p.ws + WS_TOKSLOT) + (size_t)t * 16;
            const int myslot = lane < 16 ? ts[lane] : -1;
            unsigned vm = (unsigned)__ballot(myslot >= 0);
            while (vm) {
                const int e = __builtin_ctz(vm); vm &= vm - 1u;
                const int slot = __shfl(myslot, e);
                const bf16_t* yr = (const bf16_t*)(p.ws + WS_YE) + ((size_t)e * SLOTS + slot) * D;
#pragma unroll
                for (int j = 0; j < EPL; ++j) f[j] += bf2f(yr[lane + 64 * j]);
            }
#pragma unroll
            for (int j = 0; j < EPL; ++j) v[j] = ALPHA * xv[j] + gv[j] * f[j];
        } else {
            const float* u = (const float*)(p.ws + WS_U) + (size_t)t * D;
#pragma unroll
            for (int j = 0; j < EPL; ++j) v[j] = u[lane + 64 * j];
        }
        if (!(MODE == 0 && l == 0)) {
            const int li = (MODE == 0) ? (l - 1) * 2 + 1 : l * 2;
            const float* lg = p.in[I_LNG] + (size_t)li * D; const float* lb = p.in[I_LNB] + (size_t)li * D;
            float g[EPL], bb[EPL];
#pragma unroll
            for (int j = 0; j < EPL; ++j) { g[j] = lg[lane + 64 * j]; bb[j] = lb[lane + 64 * j]; }
            float s = 0.f;
#pragma unroll
            for (int j = 0; j < EPL; ++j) s += v[j];
            const float mu = wave_sum(s) * (1.f / D);
            float q = 0.f;
#pragma unroll
            for (int j = 0; j < EPL; ++j) { const float dlt = v[j] - mu; q += dlt * dlt; }
            const float rstd = frsqrt(wave_sum(q) * (1.f / D) + EPS);
            float* dst = (MODE == 1) ? (float*)(p.ws + WS_X1) + (size_t)t * D
                       : (l == DEPTH) ? (t < NP ? p.out + O_YP + (size_t)t * D : p.out + O_YS + (size_t)(t - NP) * D) : (float*)(p.ws + WS_XBUF) + (size_t)t * D;
#pragma unroll
            for (int j = 0; j < EPL; ++j) { v[j] = (v[j] - mu) * rstd * g[j] + bb[j]; dst[lane + 64 * j] = v[j]; }
        }
        if (MODE == 1 || l < DEPTH) {
            const float* sh = mods + ((size_t)l * NCOND + cnd) * 6 * D + (MODE == 1 ? 3 * D : 0); const float* sc = sh + D;
            bf16_t* hb = (bf16_t*)(p.ws + (MODE == 1 ? WS_H2 : WS_HMOD)) + (size_t)t * D;
            {
                float s1[EPL], s0[EPL];
#pragma unroll
                for (int j = 0; j < EPL; ++j) { s1[j] = sc[lane + 64 * j]; s0[j] = sh[lane + 64 * j]; }
#pragma unroll
                for (int j = 0; j < EPL; ++j) { v[j] = v[j] * (1.f + s1[j]) + s0[j]; hb[lane + 64 * j] = f2bf(v[j]); }
            }
            CFENCE();
            float a16[16];
#pragma unroll
            for (int e = 0; e < 16; ++e) a16[e] = 0.f;
#pragma unroll
            for (int j = 0; j < EPL; ++j) {
                const float hv = v[j];
                const float* wr = W16 + (lane + 64 * j) * W16ROW;
#pragma unroll
                for (int q = 0; q < 4; ++q) { const f4v w4 = *(const f4v*)(wr + 4 * q); a16[4 * q] += hv * w4[0]; a16[4 * q + 1] += hv * w4[1]; a16[4 * q + 2] += hv * w4[2]; a16[4 * q + 3] += hv * w4[3]; }
                if (j & 1) CFENCE();
            }
            float mine = -1e30f;
#pragma unroll
            for (int e = 0; e < 16; ++e) { const float sm = wave_sum(a16[e]); if (lane == e) mine = sm; }
            if (MODE == 0) {
                if (lane < 16) ((float*)(p.ws + WS_GATES))[(size_t)t * 16 + lane] = mine + p.in[I_BGATE][l * 16 + lane];
            } else {
                float mx = mine;
                for (int m = 8; m >= 1; m >>= 1) mx = fmaxf(mx, __shfl_xor(mx, m));
                const float ex = lane < 16 ? fexp(mine - mx) : 0.f;
                float sm = ex;
                for (int m = 8; m >= 1; m >>= 1) sm += __shfl_xor(sm, m);
                if (lane < 16) ((float*)(p.ws + WS_AFF))[(size_t)t * 16 + lane] = ex / sm;
            }
        }
    }
}

template <int NPL>
DEV void topk_wave(const Params& p, int tb, int cap, int sbase, int e, int lane) {
    const float* aff = (const float*)(p.ws + WS_AFF);
    int* idx = (int*)(p.ws + WS_IDX); float* gsel = (float*)(p.ws + WS_GSEL); int* tokslot = (int*)(p.ws + WS_TOKSLOT);
    unsigned bits[NPL];
#pragma unroll
    for (int i = 0; i < NPL; ++i) bits[i] = __builtin_bit_cast(unsigned, aff[(size_t)(tb + lane + 64 * i) * 16 + e]);
    unsigned T = 0u;
    for (int b = 30; b >= 0; --b) {
        const unsigned cand = T | (1u << b);
        int cnt = 0;
#pragma unroll
        for (int i = 0; i < NPL; ++i) cnt += __popcll(__ballot(bits[i] >= cand));
        if (cnt >= cap) T = cand;
    }
    int ngt = 0;
#pragma unroll
    for (int i = 0; i < NPL; ++i) ngt += __popcll(__ballot(bits[i] > T));
    int need_eq = cap - ngt, run = 0;
    const unsigned long long lt = (1ull << lane) - 1ull;
#pragma unroll
    for (int i = 0; i < NPL; ++i) {
        const bool eq = bits[i] == T;
        const unsigned long long meq = __ballot(eq);
        const int eqrank = __popcll(meq & lt);
        const bool sel = bits[i] > T || (eq && eqrank < need_eq);
        const unsigned long long ms = __ballot(sel);
        const int t = tb + lane + 64 * i;
        if (sel) { const int slot = sbase + run + __popcll(ms & lt); idx[e * SLOTS + slot] = t; gsel[e * SLOTS + slot] = __builtin_bit_cast(float, bits[i]); tokslot[(size_t)t * 16 + e] = slot; }
        else tokslot[(size_t)t * 16 + e] = -1;
        run += __popcll(ms);
        const int neq = __popcll(meq); need_eq -= neq < need_eq ? neq : need_eq;
    }
}
DEV void phase_topk(const Params& p, char* smem) {
    (void)smem;
    const int tid = get_tid(), lane = tid & 63;
    constexpr int US = DEC_BATCH * NEXP, UP = BATCH * NEXP;
    const int gw = blockIdx.x + gridDim.x * (tid >> 6), nw = gridDim.x * 8;
    for (int u = gw; u < US + UP; u += nw) {
        if (u < US) { const int b = u / NEXP, e = u % NEXP; topk_wave<DEC_SEQ / 64>(p, NP + b * DEC_SEQ, CAP_S, BATCH * CAP_P + b * CAP_S, e, lane); }
        else { const int uu = u - US; const int b = uu / NEXP, e = uu % NEXP; topk_wave<SEQ / 64>(p, b * SEQ, CAP_P, b * CAP_P, e, lane); }
    }
}

DEV void store_head_f32(float* dst_f32, const f16v& v0, const f16v& v1, int h) {
#pragma unroll
    for (int ft = 0; ft < 2; ++ft) {
        const f16v& v = ft ? v1 : v0;
#pragma unroll
        for (int g = 0; g < 4; ++g) { f4v o; o[0] = v[4 * g]; o[1] = v[4 * g + 1]; o[2] = v[4 * g + 2]; o[3] = v[4 * g + 3]; *(f4v*)(dst_f32 + ft * 32 + 8 * g + 4 * h) = o; }
    }
}
template <int VAR>
DEV void phase_inproj(const Params& p, char* smem, int l) {
    constexpr int NJ = 22, NU = (NT / 256) * NJ;
    const int tid = get_tid(), lane = tid & 63, wave = tid >> 6, wm = wave & 3, wn = wave >> 2, h = lane >> 5, l31 = lane & 31;
    const bf16_t* hmod = (const bf16_t*)(p.ws + WS_HMOD);
    const float* rope = (const float*)(p.ws + WS_ROPE);
    constexpr int NMB = NT / 256, RPX = (NMB % 8 == 0) ? NMB / 8 : NMB;
    const UnitIter it = unit_iter(NU);
    for (int u = it.i; u < it.end; u += it.step) {
        const int mb = (u / (RPX * NJ)) * RPX + u % RPX, j = (u / RPX) % NJ;
        const int colbase = j < 17 ? 128 * j : 2192 + 128 * (j - 17);
        const unsigned ao = ((unsigned)(mb * 256 + (tid >> 3)) * D + (tid & 7) * 8) * 2;
        const unsigned bvo = (unsigned)(colbase + 4 * (tid & 31)) * 4 + (unsigned)(tid >> 5) * (PROJ_W * 4);
        const unsigned blds = (unsigned)(tid >> 5) * 320u + (unsigned)(tid & 31) * 8u;
        gemm_tile<2, VAR>(smem, make_rsrc(hmod), ao, ao + 128u * D, ao + 256u * D, ao + 384u * D, make_rsrc(p.in[I_WIN] + (size_t)l * D * PROJ_W), bvo, blds, PROJ_W * 4, D, [&](f16v (&acc)[2][2]) {
            int lane_e = lane; VGPR_PIN(lane_e); const int lane = lane_e, l31 = lane_e & 31, h = lane_e >> 5; (void)l31; (void)h;
            const int cb = colbase + wn * 64;
            char* stg = wave_stage_ptr(smem, wave);
            const int t0 = mb * 256 + wm * 64;
            const bool isP = t0 < NP;
            bf16_t* dstb; size_t dstride;
            int f32out = 0, fhead = 0, fheads = 0; size_t fbase = 0;
            int mode = 0;
            if (cb < 1152) {
                const int seg = cb / 384, head = (cb % 384) / 64;
                dstb = (bf16_t*)(p.ws + (seg == 0 ? WS_NAQ : seg == 1 ? WS_NAK : WS_NAV)) + (size_t)t0 * 384 + head * 64; dstride = 384;
                if (seg >= 1 && isP) { f32out = 1; fbase = seg == 1 ? O_NAK : O_NAV; fhead = head; fheads = NAH; }
            } else if (cb < 2176) {
                const int seg = (cb - 1152) / 256, head = ((cb - 1152) % 256) / 64;
                dstb = (bf16_t*)(p.ws + (seg == 0 ? WS_MLQ : seg == 1 ? WS_MLK : seg == 2 ? WS_MLV : WS_MLO)) + (size_t)t0 * 256 + head * 64; dstride = 256;
                mode = seg == 1 ? 1 : 0;
            } else {
                const int c2 = cb - 2192;
                if (c2 < 384) { dstb = (bf16_t*)(p.ws + WS_GQQ) + (size_t)t0 * 384 + (c2 / 64) * 64; dstride = 384; mode = 2; }
                else if (c2 < 512) { const int head = (c2 - 384) / 64; dstb = (bf16_t*)(p.ws + WS_GQK) + (size_t)t0 * 128 + head * 64; dstride = 128; mode = 3;
                                     if (isP) { f32out = 1; fbase = O_GQK; fhead = head; fheads = GQKV; } }
                else { const int head = (c2 - 512) / 64; dstb = (bf16_t*)(p.ws + WS_GQV) + (size_t)t0 * 128 + head * 64; dstride = 128;
                       if (isP) { f32out = 1; fbase = O_GQV; fhead = head; fheads = GQKV; } }
            }
#pragma unroll
            for (int tt = 0; tt < 2; ++tt) {
                const int t = t0 + tt * 32 + l31;
                f16v v0 = acc[0][tt], v1 = acc[1][tt];
                if (mode == 1) { v0 *= ATT_SCALE; v1 *= ATT_SCALE; }
                if (mode >= 2) {
                    float ss = 0.f;
#pragma unroll
                    for (int r = 0; r < 16; ++r) ss += v0[r] * v0[r] + v1[r] * v1[r];
                    ss += __shfl_xor(ss, 32);
                    const float rn = frsqrt(ss * (1.f / 64.f) + EPS);
                    const float* gq = p.in[I_QKG] + ((size_t)l * 2 + (mode == 2 ? 0 : 1)) * 64;
#pragma unroll
                    for (int r = 0; r < 16; ++r) {
                        const int d = (r & 3) + 8 * (r >> 2) + 4 * h;
                        v0[r] *= rn * gq[d]; v1[r] *= rn * gq[32 + d];
                    }
                }
                if (f32out) { const int bP = t / SEQ, sP = t % SEQ; store_head_f32(p.out + fbase + ((((size_t)bP * DEPTH + l) * SEQ + sP) * fheads + fhead) * 64, v0, v1, h); }
                if (mode >= 2 && !isP) {
                    const int pos = (t - NP) % DEC_SEQ, prow = pos / GRIDW, pcol = pos % GRIDW;
#pragma unroll
                    for (int rr = 0; rr < 8; ++rr) {
                        const int fi = (rr & 3) + 8 * ((rr >> 2) & 1) + 4 * h;
                        const float c0 = rope[(prow * 16 + fi) * 2], s0 = rope[(prow * 16 + fi) * 2 + 1];
                        const float c1 = rope[(pcol * 16 + fi) * 2], s1 = rope[(pcol * 16 + fi) * 2 + 1];
                        const float a_lo = v0[rr], a_hi = v0[rr + 8]; v0[rr] = a_lo * c0 - a_hi * s0; v0[rr + 8] = a_hi * c0 + a_lo * s0;
                        const float b_lo = v1[rr], b_hi = v1[rr + 8]; v1[rr] = b_lo * c1 - b_hi * s1; v1[rr + 8] = b_hi * c1 + b_lo * s1;
                    }
                }
                stage64_write_bf16(stg, tt, v0, v1, l31, h);
            }
            stage64_flush_bf16(stg, dstb, dstride, lane);
        });
    }
}

template <int VAR>
DEV void phase_outproj(const Params& p, char* smem, int l) {
    constexpr int NC = D / 128, NU = (NT / 256) * NC;
    const int tid = get_tid(), lane = tid & 63, wave = tid >> 6, wm = wave & 3, wn = wave >> 2, h = lane >> 5, l31 = lane & 31;
    const bf16_t* mixed = (const bf16_t*)(p.ws + WS_MIXED);
    const float* mods = (const float*)(p.ws + WS_MODS);
    float* U = (float*)(p.ws + WS_U);
    constexpr int NMB = NT / 256, RPX = (NMB % 8 == 0) ? NMB / 8 : NMB;
    const UnitIter it = unit_iter(NU);
    for (int u = it.i; u < it.end; u += it.step) {
        const int mb = (u / (RPX * NC)) * RPX + u % RPX, cbk = (u / RPX) % NC;
        const unsigned ao = ((unsigned)(mb * 256 + (tid >> 3)) * MIXW + (tid & 7) * 8) * 2;
        const unsigned bvo = (unsigned)(cbk * 128 + 4 * (tid & 31)) * 4 + (unsigned)(tid >> 5) * (D * 4);
        const unsigned blds = (unsigned)(tid >> 5) * 320u + (unsigned)(tid & 31) * 8u;
        gemm_tile<2, VAR>(smem, make_rsrc(mixed), ao, ao + 128u * MIXW, ao + 256u * MIXW, ao + 384u * MIXW, make_rsrc(p.in[I_WOUT] + (size_t)l * MIXW * D), bvo, blds, D * 4, MIXW, [&](f16v (&acc)[2][2]) {
            int lane_e = lane; VGPR_PIN(lane_e); const int lane = lane_e, l31 = lane_e & 31, h = lane_e >> 5; (void)l31; (void)h;
            char* stg = wave_stage_ptr(smem, wave);
            const int t0 = mb * 256 + wm * 64;
            const float* g1 = mods + ((size_t)l * NCOND + tok_cond(t0)) * 6 * D + 2 * D;
#pragma unroll
            for (int ft = 0; ft < 2; ++ft) {
#pragma unroll
                for (int tt = 0; tt < 2; ++tt)
#pragma unroll
                    for (int g = 0; g < 4; ++g) { f4v o; o[0] = acc[ft][tt][4 * g]; o[1] = acc[ft][tt][4 * g + 1]; o[2] = acc[ft][tt][4 * g + 2]; o[3] = acc[ft][tt][4 * g + 3];
                        *(f4v*)(stg + (tt * 32 + l31) * LROW + (8 * g + 4 * h) * 4) = o; }
                WAVE_SYNC();
                const int f0 = cbk * 128 + wn * 64 + ft * 32 + (lane & 7) * 4;
                const f4v gv = *(const f4v*)(g1 + f0);
#pragma unroll
                for (int i = 0; i < 8; ++i) {
                    const int r = (lane >> 3) + 8 * i, t = t0 + r;
                    const f4v a = *(const f4v*)(stg + r * LROW + (lane & 7) * 16);
                    const float* xr = (l == 0) ? (t < NP ? p.in[I_XP] + (size_t)t * D : p.in[I_XS] + (size_t)(t - NP) * D) : (const float*)(p.ws + WS_XBUF) + (size_t)t * D;
                    const f4v xv = *(const f4v*)(xr + f0);
                    f4v o;
#pragma unroll
                    for (int q = 0; q < 4; ++q) o[q] = ALPHA * xv[q] + gv[q] * a[q];
                    *(f4v*)(U + (size_t)t * D + f0) = o;
                }
                WAVE_SYNC();
            }
        });
    }
}

template <int VAR>
DEV void phase_gateup(const Params& p, char* smem, int l) {
    constexpr int NRB = SLOTS / 256, NCB = EH / 128, NU = NEXP * NCB * NRB;
    const int tid = get_tid(), lane = tid & 63, wave = tid >> 6, wm = wave & 3, wn = wave >> 2, h = lane >> 5, l31 = lane & 31;
    const bf16_t* h2 = (const bf16_t*)(p.ws + WS_H2);
    const int* idx = (const int*)(p.ws + WS_IDX);
    bf16_t* hid = (bf16_t*)(p.ws + WS_HID);
    constexpr int TPC = NU / 8;
#ifdef GU_FORCE_HALF
    constexpr int HT = GU_FORCE_HALF;
#else
    constexpr int HT = (NU % 8 == 0 && TPC % 32 == 16) ? 16 : 0;
#endif
    constexpr int UPC = TPC + HT;
    const bool chunked = (gridDim.x & 7) == 0 && (NU & 7) == 0;
    const UnitIter it = unit_iter(chunked ? 8 * UPC : NU);
    for (int uu = it.i; uu < it.end; uu += it.step) {
        int u = uu, half = -1;
        if (chunked) { const int x = uu / UPC, v = uu % UPC; if (v < TPC - HT) u = x * TPC + v; else { const int hv = v - (TPC - HT); u = x * TPC + (TPC - HT) + (hv >> 1); half = hv & 1; } }
        const int rb = u % NRB, cbk = (u / NRB) % NCB, e = u / (NRB * NCB);
        const int* ip = idx + e * SLOTS + rb * 256 + (tid >> 3);
        const unsigned a0 = ((unsigned)ip[0] * D + (tid & 7) * 8) * 2, a1 = ((unsigned)ip[64] * D + (tid & 7) * 8) * 2;
        const unsigned a2 = ((unsigned)ip[128] * D + (tid & 7) * 8) * 2, a3 = ((unsigned)ip[192] * D + (tid & 7) * 8) * 2;
#ifdef EMU
        const int bw = tid >> 6;
#else
        const int bw = __builtin_amdgcn_readfirstlane(tid >> 6);
#endif
        const int is_up = bw & 1;
        const float* wmat = (is_up ? p.in[I_WU] : p.in[I_WG]) + ((size_t)l * NEXP + e) * D * EH;
        if (half < 0) {
        const int bkr = 2 * (bw >> 1) + ((tid >> 5) & 1), hc = 4 * (tid & 31);
        const int ncol = (hc >> 6) * 128 + (2 * ((hc >> 5) & 1) + is_up) * 32 + (hc & 31);
        const unsigned bvo = (unsigned)(cbk * 128 + hc) * 4 + (unsigned)bkr * (EH * 4);
        const unsigned blds = (unsigned)bkr * 576u + (unsigned)ncol * 2u;
        gemm_tile<4, VAR>(smem, make_rsrc(h2), a0, a1, a2, a3, make_rsrc(wmat), bvo, blds, EH * 4, D, [&](f16v (&acc)[4][2]) {
            int lane_e = lane; VGPR_PIN(lane_e); const int lane = lane_e, l31 = lane_e & 31, h = lane_e >> 5; (void)l31; (void)h;
            char* stg = wave_stage_ptr(smem, wave);
#pragma unroll
            for (int tt = 0; tt < 2; ++tt)
#pragma unroll
                for (int pr = 0; pr < 2; ++pr)
#pragma unroll
                    for (int g = 0; g < 4; ++g) {
                        float o[4];
#pragma unroll
                        for (int q = 0; q < 4; ++q) o[q] = siluf_(acc[2 * pr][tt][4 * g + q]) * acc[2 * pr + 1][tt][4 * g + q];
                        stage64_write4(stg, tt * 32 + l31, pr * 32 + 8 * g + 4 * h, o[0], o[1], o[2], o[3]);
                    }
            stage64_flush_bf16(stg, hid + ((size_t)e * SLOTS + rb * 256 + wm * 64) * EH + cbk * 128 + wn * 64, EH, lane);
        });
        } else {
        const int bkr = 4 * (bw >> 1) + ((tid >> 4) & 3), hc = 4 * (tid & 15);
        const int ncol = (hc >> 5) * 64 + is_up * 32 + (hc & 31);
        const unsigned bvo = (unsigned)(cbk * 128 + half * 64 + hc) * 4 + (unsigned)bkr * (EH * 4);
        const unsigned blds = (unsigned)bkr * 320u + (unsigned)ncol * 2u;
        gemm_tile<2, VAR>(smem, make_rsrc(h2), a0, a1, a2, a3, make_rsrc(wmat), bvo, blds, EH * 4, D, [&](f16v (&acc)[2][2]) {
            int lane_e = lane; VGPR_PIN(lane_e); const int lane = lane_e, l31 = lane_e & 31, h = lane_e >> 5; (void)l31; (void)h;
            char* stg = wave_stage_ptr(smem, wave);
#pragma unroll
            for (int tt = 0; tt < 2; ++tt)
#pragma unroll
                for (int g = 0; g < 4; ++g) {
                    float o[4];
#pragma unroll
                    for (int q = 0; q < 4; ++q) o[q] = siluf_(acc[0][tt][4 * g + q]) * acc[1][tt][4 * g + q];
                    stage64_write4(stg, tt * 32 + l31, 8 * g + 4 * h, o[0], o[1], o[2], o[3]);
                }
            WAVE_SYNC();
            bf16_t* dst0 = hid + ((size_t)e * SLOTS + rb * 256 + wm * 64) * EH + cbk * 128 + half * 64 + wn * 32;
#pragma unroll
            for (int i = 0; i < 4; ++i) { const int r = (lane >> 2) + 16 * i, c = lane & 3; const u4v v = *(const u4v*)(stg + r * LROW + c * 16); *(u4v*)(dst0 + (size_t)r * EH + c * 8) = v; }
            WAVE_SYNC();
        });
        }
    }
}

template <int VAR>
DEV void phase_down(const Params& p, char* smem, int l) {
    constexpr int NRB = SLOTS / 256, NCB = D / 256, NU = NEXP * NCB * NRB;
    const int tid = get_tid(), lane = tid & 63, wave = tid >> 6, wm = wave & 3, wn = wave >> 2, h = lane >> 5, l31 = lane & 31;
    const bf16_t* hid = (const bf16_t*)(p.ws + WS_HID);
    const float* gsel = (const float*)(p.ws + WS_GSEL);
    bf16_t* ye = (bf16_t*)(p.ws + WS_YE);
    const UnitIter it = unit_iter(NU);
    for (int u = it.i; u < it.end; u += it.step) {
        const int rb = u % NRB, cbk = (u / NRB) % NCB, e = u / (NRB * NCB);
        const unsigned ao = ((unsigned)(rb * 256 + (tid >> 3)) * EH + (tid & 7) * 8) * 2;
        const unsigned bvo = (unsigned)(cbk * 256 + 4 * (tid & 63)) * 4 + (unsigned)(tid >> 6) * (D * 4);
        const unsigned blds = (unsigned)(tid >> 6) * 576u + (unsigned)(tid & 63) * 8u;
        gemm_tile<4, VAR>(smem, make_rsrc(hid + (size_t)e * SLOTS * EH), ao, ao + 128u * EH, ao + 256u * EH, ao + 384u * EH, make_rsrc(p.in[I_WD] + ((size_t)l * NEXP + e) * EH * D), bvo, blds, D * 4, EH, [&](f16v (&acc)[4][2]) {
            int lane_e = lane; VGPR_PIN(lane_e); const int lane = lane_e, l31 = lane_e & 31, h = lane_e >> 5; (void)l31; (void)h;
            char* stg = wave_stage_ptr(smem, wave);
            const float gs0 = gsel[e * SLOTS + rb * 256 + wm * 64 + l31], gs1 = gsel[e * SLOTS + rb * 256 + wm * 64 + 32 + l31];
#pragma unroll
            for (int hb = 0; hb < 2; ++hb) {
#pragma unroll
                for (int tt = 0; tt < 2; ++tt) {
                    const float gs = tt ? gs1 : gs0;
#pragma unroll
                    for (int f2 = 0; f2 < 2; ++f2)
#pragma unroll
                        for (int g = 0; g < 4; ++g) { const f16v& a = acc[2 * hb + f2][tt]; stage64_write4(stg, tt * 32 + l31, f2 * 32 + 8 * g + 4 * h, a[4 * g] * gs, a[4 * g + 1] * gs, a[4 * g + 2] * gs, a[4 * g + 3] * gs); }
                }
                stage64_flush_bf16(stg, ye + ((size_t)e * SLOTS + rb * 256 + wm * 64) * D + cbk * 256 + wn * 128 + hb * 64, D, lane);
            }
        });
    }
}

struct AttnDesc {
    const bf16_t* q; int qstride;
    int ntiles, n0;
    const bf16_t *k0, *v0; int stride0;
    const bf16_t *k1, *v1; int stride1;
    int na;
    int r0, rlo;
    const float* rpb;
    bf16_t* out; int ostride;
    float* part;
};
constexpr int ATT_TILE = 64 * LROW;
DEV int na_row_start(int r) { int s = r - KR / 2; s = s < 0 ? 0 : s; return s > ROWS - KR ? ROWS - KR : s; }
DEV void attn_unit(char* smem, const AttnDesc& d) {
    const int tid = get_tid(), lane = tid & 63, wave = tid >> 6, h = lane >> 5, l31 = lane & 31;
    char* Ks = smem; char* Vs = smem + 2 * ATT_TILE; float* rpbS = (float*)(smem + 4 * ATT_TILE);
    if (d.na) { for (int i = tid; i < 15 * 31; i += 512) rpbS[i] = d.rpb[i] * 1.4426950408889634f; }
    const bf16_t* qp = d.q + (size_t)(wave * 32 + l31) * d.qstride + h * 8;
    s8v qf[4];
#pragma unroll
    for (int s = 0; s < 4; ++s) qf[s] = *(const s8v*)(qp + 16 * s);
    float m_run = -1e30f, l_run = 0.f;
    f16v o[2]; o[0] = f16zero(); o[1] = f16zero();
    const int srow = tid >> 3, sch = tid & 7;
    u4v kreg, vreg;
    auto gload = [&](int t) {
        const bf16_t *kp, *vp;
        if (t < d.n0) { const size_t off = (size_t)(t * 64 + srow) * d.stride0 + sch * 8; kp = d.k0 + off; vp = d.v0 + off; }
        else { const size_t off = (size_t)((t - d.n0) * 64 + srow) * d.stride1 + sch * 8; kp = d.k1 + off; vp = d.v1 + off; }
        kreg = *(const u4v*)kp; vreg = *(const u4v*)vp;
    };
    auto lstore = [&](int buf) { *(u4v*)(Ks + buf * ATT_TILE + srow * LROW + sch * 16) = kreg; *(u4v*)(Vs + buf * ATT_TILE + srow * LROW + sch * 16) = vreg; };
    const int qr = d.r0 + (wave >> 1), qw = (wave & 1) * 32 + l31;
    const int rs = na_row_start(qr);
    int cs = qw - KC / 2; cs = cs < 0 ? 0 : (cs > GRIDW - KC ? GRIDW - KC : cs);
    gload(0); lstore(0);
    __syncthreads();
    for (int t = 0; t < d.ntiles; ++t) {
        const int buf = t & 1;
        if (t + 1 < d.ntiles) gload(t + 1);
        const bool local = d.na && t >= d.n0;
        const int kr = d.rlo + (t - d.n0);
        const bool active = !local || (kr >= rs && kr < rs + KR);
        if (active) {
            const char* kb = Ks + buf * ATT_TILE + l31 * LROW + h * 16;
            f16v sa[2];
#pragma unroll
            for (int kt = 0; kt < 2; ++kt) {
                sa[kt] = f16zero();
#pragma unroll
                for (int s = 0; s < 4; ++s) { const s8v kf = *(const s8v*)(kb + kt * 32 * LROW + s * 32); sa[kt] = mfma32(kf, qf[s], sa[kt]); }
            }
            constexpr float C2 = ATT_SCALE * 1.4426950408889634f;
            float mx = -1e30f;
            if (local) {
#pragma unroll
                for (int kt = 0; kt < 2; ++kt)
#pragma unroll
                    for (int r = 0; r < 16; ++r) {
                        const int kc = kt * 32 + (r & 3) + 8 * (r >> 2) + 4 * h;
                        const bool inw = kc >= cs && kc < cs + KC;
                        const int bi = (kr - qr + 7) * 31 + (kc - qw + 15);
                        const float v = inw ? sa[kt][r] * C2 + rpbS[inw ? bi : 0] : -1e30f;
                        sa[kt][r] = v; mx = fmaxf(mx, v);
                    }
            } else {
#pragma unroll
                for (int kt = 0; kt < 2; ++kt)
#pragma unroll
                    for (int r = 0; r < 16; ++r) mx = fmaxf(mx, sa[kt][r]);
                mx *= C2;
            }
            mx = fmaxf(mx, __shfl_xor(mx, 32));
            if (__ballot(mx > m_run) != 0ull) {
                const float m_new = fmaxf(m_run, mx);
                const float alpha = fexp2(m_run - m_new);
                l_run *= alpha; m_run = m_new;
                o[0] *= alpha; o[1] *= alpha;
            }
            float ps = 0.f;
            if (local) {
#pragma unroll
                for (int kt = 0; kt < 2; ++kt)
#pragma unroll
                    for (int r = 0; r < 16; ++r) { const float pv = fexp2(sa[kt][r] - m_run); sa[kt][r] = pv; ps += pv; }
            } else {
#pragma unroll
                for (int kt = 0; kt < 2; ++kt)
#pragma unroll
                    for (int r = 0; r < 16; ++r) { const float pv = fexp2(sa[kt][r] * C2 - m_run); sa[kt][r] = pv; ps += pv; }
            }
            l_run += ps;
            const char* vb = Vs + buf * ATT_TILE + (4 * h + ((lane & 15) >> 2)) * LROW + (((lane >> 4) & 1) * 16 + 4 * (lane & 3)) * 2;
#pragma unroll
            for (int ks = 0; ks < 4; ++ks) {
                const int kt = ks >> 1, rb = 8 * (ks & 1);
                u4v pk; pk[0] = pack2(sa[kt][rb], sa[kt][rb + 1]); pk[1] = pack2(sa[kt][rb + 2], sa[kt][rb + 3]);
                pk[2] = pack2(sa[kt][rb + 4], sa[kt][rb + 5]); pk[3] = pack2(sa[kt][rb + 6], sa[kt][rb + 7]);
                const s8v pf = __builtin_bit_cast(s8v, pk);
                const char* vk = vb + (kt * 32 + 16 * (ks & 1)) * LROW;
#pragma unroll
                for (int dt = 0; dt < 2; ++dt) {
                    const s4v lo = lds_tr16(vk + dt * 64), hi = lds_tr16(vk + 8 * LROW + dt * 64);
                    s8v vf; vf[0] = lo[0]; vf[1] = lo[1]; vf[2] = lo[2]; vf[3] = lo[3]; vf[4] = hi[0]; vf[5] = hi[1]; vf[6] = hi[2]; vf[7] = hi[3];
                    o[dt] = mfma32(vf, pf, o[dt]);
                }
            }
        }
        if (t + 1 < d.ntiles) lstore(buf ^ 1);
        __syncthreads();
    }
    const float l_tot = l_run + __shfl_xor(l_run, 32);
    const int qrow = wave * 32 + l31;
    if (d.part) {
        float* po = d.part + (size_t)qrow * 64;
#pragma unroll
        for (int dt = 0; dt < 2; ++dt)
#pragma unroll
            for (int g = 0; g < 4; ++g) { f4v v; v[0] = o[dt][4 * g]; v[1] = o[dt][4 * g + 1]; v[2] = o[dt][4 * g + 2]; v[3] = o[dt][4 * g + 3]; *(f4v*)(po + dt * 32 + 8 * g + 4 * h) = v; }
        if (h == 0) { d.part[256 * 64 + qrow] = m_run; d.part[256 * 64 + 256 + qrow] = l_tot; }
    } else {
        const float inv = 1.f / l_tot;
        bf16_t* po = d.out + (size_t)qrow * d.ostride;
#pragma unroll
        for (int dt = 0; dt < 2; ++dt)
#pragma unroll
            for (int g = 0; g < 4; ++g) {
                u2v pk; pk[0] = pack2(o[dt][4 * g] * inv, o[dt][4 * g + 1] * inv); pk[1] = pack2(o[dt][4 * g + 2] * inv, o[dt][4 * g + 3] * inv);
                *(u2v*)(po + dt * 32 + 8 * g + 4 * h) = pk;
            }
    }
}

DEV int ml_sidx(int grp, int b, int head, int c) { return grp == 0 ? ((b * MLH + head) * NCH_P + c) : BATCH * MLH * NCH_P + ((b * MLH + head) * NCH_S + c); }
DEV float lane_prefix_sum(float v, int lane) { for (int dlt = 1; dlt < 64; dlt <<= 1) { const float o = __shfl(v, lane - dlt); if (lane >= dlt) v += o; } return v; }
DEV float lane_prefix_max(float v, int lane) { for (int dlt = 1; dlt < 64; dlt <<= 1) { const float o = __shfl(v, lane - dlt); if (lane >= dlt) v = fmaxf(v, o); } return v; }

DEV void mlstm_summary_unit(const Params& p, char* smem, int grp, int b, int head, int c) {
    const int tid = get_tid(), lane = tid & 63, wave = tid >> 6, h = lane >> 5, l31 = lane & 31;
    char* KT = smem;
    char* VT = smem + 2 * ATT_TILE;
    float* wsS = (float*)(smem + 3 * ATT_TILE);
    float* scal = wsS + 128;
    const int tb = (grp == 0 ? b * SEQ : NP + b * DEC_SEQ) + c * 64;
    const float* gates = (const float*)(p.ws + WS_GATES);
    if (wave == 0) {
        const float* gr = gates + (size_t)(tb + lane) * 16;
        const float i_f = gr[head], lf_f = logsigmoidf_(gr[4 + head]), i_b = gr[8 + head], lf_b = logsigmoidf_(gr[12 + head]);
        const float pf = lane_prefix_sum(lf_f, lane), pb = lane_prefix_sum(lf_b, lane);
        const float tot_f = __shfl(pf, 63), tot_b = __shfl(pb, 63);
        const float g_f = (tot_f - pf) + i_f, g_b = (pb - lf_b) + i_b;
        const float G_f = wave_max(g_f), G_b = wave_max(g_b);
        wsS[lane] = fexp(g_f - G_f); wsS[64 + lane] = fexp(g_b - G_b);
        if (lane == 0) { scal[0] = tot_f; scal[1] = tot_b; scal[2] = G_f; scal[3] = G_b; }
    }
    __syncthreads();
    {
        const int tau = tid >> 3, ch = tid & 7;
        const u4v kv = *(const u4v*)((const bf16_t*)(p.ws + WS_MLK) + (size_t)(tb + tau) * 256 + head * 64 + ch * 8);
        const u4v vv = *(const u4v*)((const bf16_t*)(p.ws + WS_MLV) + (size_t)(tb + tau) * 256 + head * 64 + ch * 8);
        const float wf = wsS[tau], wb = wsS[64 + tau];
#pragma unroll
        for (int j = 0; j < 8; ++j) {
            const bf16_t kb = (bf16_t)(kv[j >> 1] >> (16 * (j & 1))), vb = (bf16_t)(vv[j >> 1] >> (16 * (j & 1)));
            const int dim = ch * 8 + j; const float kf = bf2f(kb);
            *(bf16_t*)(KT + dim * LROW + tau * 2) = f2bf(kf * wf);
            *(bf16_t*)(KT + ATT_TILE + dim * LROW + tau * 2) = f2bf(kf * wb);
            *(bf16_t*)(VT + dim * LROW + tau * 2) = vb;
        }
    }
    __syncthreads();
    float* sum = (float*)(p.ws + WS_MLSUM);
    const int sidx = ml_sidx(grp, b, head, c);
    {
        const int dir = wave >> 2, mi = (wave >> 1) & 1, ni = wave & 1;
        f16v acc = f16zero();
#pragma unroll
        for (int s = 0; s < 4; ++s) {
            const s8v af = *(const s8v*)(KT + dir * ATT_TILE + (mi * 32 + l31) * LROW + (16 * s + 8 * h) * 2);
            const s8v bf = *(const s8v*)(VT + (ni * 32 + l31) * LROW + (16 * s + 8 * h) * 2);
            acc = mfma32(af, bf, acc);
        }
        float* U = sum + (size_t)(sidx * 2 + dir) * MLSUM_STRIDE;
#pragma unroll
        for (int r = 0; r < 16; ++r) U[(mi * 32 + (r & 3) + 8 * (r >> 2) + 4 * h) * 64 + ni * 32 + l31] = acc[r];
    }
    if (tid < 128) {
        const int dir = tid >> 6, kd = tid & 63;
        float s = 0.f;
        for (int tau = 0; tau < 64; ++tau) s += bf2f(*(const bf16_t*)(KT + dir * ATT_TILE + kd * LROW + tau * 2));
        float* E = sum + (size_t)(sidx * 2 + dir) * MLSUM_STRIDE;
        E[4096 + kd] = s;
        if (kd == 0) { E[4160] = scal[dir]; E[4161] = scal[2 + dir]; }
    }
    __syncthreads();
}

DEV void mlstm_output_unit(const Params& p, char* smem, int l, int grp, int b, int head, int c) {
    const int tid = get_tid(), lane = tid & 63, wave = tid >> 6, h = lane >> 5, l31 = lane & 31;
    const int nc = grp ? NCH_S : NCH_P;
    char* Qs = smem;
    char* Ks = smem + 2 * ATT_TILE;
    char* VT = smem + 4 * ATT_TILE;
    char* CT = smem + 6 * ATT_TILE;
    char* QK = smem + 8 * ATT_TILE;
    float* hS = (float*)(smem + 10 * ATT_TILE);
    float* vec = hS + 2 * 64 * 68;
    float* aS = vec; float* MjS = vec + 128; float* bS = vec + 256; float* nS = vec + 384; float* denp = vec + 512; float* qnS = vec + 768; float* scal = vec + 896;
    const int tb = (grp == 0 ? b * SEQ : NP + b * DEC_SEQ) + c * 64;
    const float* sum = (const float*)(p.ws + WS_MLSUM);
    const size_t qoff = (size_t)(tb + (tid >> 3)) * 256 + head * 64 + (tid & 7) * 8;
    const u4v q_r = *(const u4v*)((const bf16_t*)(p.ws + WS_MLQ) + qoff);
    const u4v k_r = *(const u4v*)((const bf16_t*)(p.ws + WS_MLK) + qoff);
    const u4v v_r = *(const u4v*)((const bf16_t*)(p.ws + WS_MLV) + qoff);
    const u4v o_r = *(const u4v*)((const bf16_t*)(p.ws + WS_MLO) + qoff);
    float g_i = 0.f, g_f = 0.f;
    if (wave < 2) { const float* gr = (const float*)(p.ws + WS_GATES) + (size_t)(tb + (wave ? 63 - lane : lane)) * 16; g_i = gr[wave * 8 + head]; g_f = gr[wave * 8 + 4 + head]; }
#pragma unroll
    for (int dir = 0; dir < 2; ++dir) {
        float C[8], nst = 0.f, m;
        if (grp == 0) {
#pragma unroll
            for (int i = 0; i < 8; ++i) C[i] = 0.f;
            m = 0.f;
        } else {
            const size_t sb = (((size_t)b * DEPTH + l) * 2 + dir) * MLH + head;
#pragma unroll
            for (int i = 0; i < 8; ++i) C[i] = p.in[I_SC][sb * 4096 + tid + 512 * i];
            if (tid < 64) nst = p.in[I_SN][sb * 64 + tid];
            m = p.in[I_SM][sb];
        }
        const int nsteps = dir == 0 ? c : nc - 1 - c;
        const bool fin = (grp == 0) && (dir == 0 ? c == nc - 1 : c == 0);
        {
            float A = 0.f, G = -1e30f;
            if (lane < nsteps) { const float* E = sum + (size_t)(ml_sidx(grp, b, head, dir == 0 ? lane : nc - 1 - lane) * 2 + dir) * MLSUM_STRIDE; A = E[4160]; G = E[4161]; }
            const float P = lane_prefix_sum(A, lane);
            const float T = __shfl(P, 63);
            const float ev = lane < nsteps ? G + (T - P) : -1e30f;
            const float mc = fmaxf(m + T, wave_max(ev));
            const float coef = lane < nsteps ? fexp(ev - mc) : 0.f;
            const float coef0 = fexp(m + T - mc);
#pragma unroll
            for (int i = 0; i < 8; ++i) C[i] *= coef0;
            nst *= coef0;
#pragma unroll 4
            for (int st = 0; st < nsteps; ++st) {
                const float* E = sum + (size_t)(ml_sidx(grp, b, head, dir == 0 ? st : nc - 1 - st) * 2 + dir) * MLSUM_STRIDE;
                const float cf = __shfl(coef, st);
#pragma unroll
                for (int i = 0; i < 8; ++i) C[i] += cf * E[tid + 512 * i];
                if (tid < 64) nst += cf * E[4096 + tid];
            }
            m = mc;
        }
#pragma unroll
        for (int i = 0; i < 8; ++i) { const int e = tid + 512 * i; *(bf16_t*)(CT + dir * ATT_TILE + (e & 63) * LROW + (e >> 6) * 2) = f2bf(C[i]); }
        if (tid < 64) nS[dir * 64 + tid] = nst;
        if (tid == 0) scal[dir] = m;
        if (fin) {
            const float* E = sum + (size_t)(ml_sidx(grp, b, head, c) * 2 + dir) * MLSUM_STRIDE;
            const float A = E[4160], G = E[4161];
            const float m_new = fmaxf(A + m, G);
            const float sc = fexp(A + m - m_new), su = fexp(G - m_new);
            const size_t ob = (((size_t)b * DEPTH + l) * 2 + dir) * MLH + head;
#pragma unroll
            for (int i = 0; i < 8; ++i) p.out[O_MC + ob * 4096 + tid + 512 * i] = sc * C[i] + su * E[tid + 512 * i];
            if (tid < 64) p.out[O_MN + ob * 64 + tid] = sc * nst + su * E[4096 + tid];
            if (tid == 0) p.out[O_MM + ob] = m_new;
        }
    }
    {
        const int row = tid >> 3, ch = tid & 7;
#pragma unroll
        for (int dir = 0; dir < 2; ++dir) {
            const int pr = dir ? 63 - row : row;
            *(u4v*)(Qs + dir * ATT_TILE + pr * LROW + ch * 16) = q_r;
            *(u4v*)(Ks + dir * ATT_TILE + pr * LROW + ch * 16) = k_r;
#pragma unroll
            for (int j = 0; j < 8; ++j) *(bf16_t*)(VT + dir * ATT_TILE + (ch * 8 + j) * LROW + pr * 2) = (bf16_t)(v_r[j >> 1] >> (16 * (j & 1)));
        }
    }
    __syncthreads();
    if (wave < 2) {
        const int dir = wave;
        const float ig = g_i, lf = logsigmoidf_(g_f);
        const float bj = lane_prefix_sum(lf, lane);
        const float a = ig - bj;
        const float Pj = lane_prefix_max(a, lane);
        aS[dir * 64 + lane] = a; bS[dir * 64 + lane] = bj; MjS[dir * 64 + lane] = fmaxf(scal[dir], Pj);
    } else if (wave < 4) {
        const int dir = wave - 2;
        float s = 0.f;
        for (int k = 0; k < 64; ++k) s += bf2f(*(const bf16_t*)(Qs + dir * ATT_TILE + lane * LROW + k * 2)) * nS[dir * 64 + k];
        qnS[dir * 64 + lane] = s;
    }
    __syncthreads();
    const int dir = wave >> 2, rt = (wave >> 1) & 1, jt = wave & 1;
    const int j = jt * 32 + l31;
    const float Mj = MjS[dir * 64 + j];
    {
        f16v acc = f16zero();
#pragma unroll
        for (int s4 = 0; s4 < 4; ++s4) {
            const s8v af = *(const s8v*)(Ks + dir * ATT_TILE + (rt * 32 + l31) * LROW + (16 * s4 + 8 * h) * 2);
            const s8v bf = *(const s8v*)(Qs + dir * ATT_TILE + j * LROW + (16 * s4 + 8 * h) * 2);
            acc = mfma32(af, bf, acc);
        }
        float dsum = 0.f;
#pragma unroll
        for (int g = 0; g < 4; ++g) {
            float o[4];
#pragma unroll
            for (int q = 0; q < 4; ++q) {
                const int s = rt * 32 + 8 * g + 4 * h + q;
                const float w = s <= j ? fexp(aS[dir * 64 + s] - Mj) : 0.f;
                o[q] = acc[4 * g + q] * w; dsum += o[q];
            }
            u2v pk; pk[0] = pack2(o[0], o[1]); pk[1] = pack2(o[2], o[3]);
            *(u2v*)(QK + dir * ATT_TILE + j * LROW + (rt * 32 + 8 * g + 4 * h) * 2) = pk;
        }
        dsum += __shfl_xor(dsum, 32);
        if (h == 0) denp[(dir * 2 + rt) * 64 + j] = dsum;
    }
    __syncthreads();
    {
        const float mst = scal[dir];
        const float decay = fexp(mst - Mj);
        f16v acc = f16zero();
#pragma unroll
        for (int s4 = 0; s4 < 4; ++s4) {
            const s8v af = *(const s8v*)(CT + dir * ATT_TILE + (rt * 32 + l31) * LROW + (16 * s4 + 8 * h) * 2);
            const s8v bf = *(const s8v*)(Qs + dir * ATT_TILE + j * LROW + (16 * s4 + 8 * h) * 2);
            acc = mfma32(af, bf, acc);
        }
        acc *= decay;
#pragma unroll
        for (int s4 = 0; s4 < 4; ++s4) {
            const s8v af = *(const s8v*)(VT + dir * ATT_TILE + (rt * 32 + l31) * LROW + (16 * s4 + 8 * h) * 2);
            const s8v bf = *(const s8v*)(QK + dir * ATT_TILE + j * LROW + (16 * s4 + 8 * h) * 2);
            acc = mfma32(af, bf, acc);
        }
        const float den = decay * qnS[dir * 64 + j] + denp[(dir * 2) * 64 + j] + denp[(dir * 2 + 1) * 64 + j];
        const float dn = fmaxf(fabsf(den), fexp(-(bS[dir * 64 + j] + Mj)));
        const float inv = 1.f / dn;
#pragma unroll
        for (int g = 0; g < 4; ++g) { f4v o; o[0] = acc[4 * g] * inv; o[1] = acc[4 * g + 1] * inv; o[2] = acc[4 * g + 2] * inv; o[3] = acc[4 * g + 3] * inv;
            *(f4v*)(hS + (dir * 64 + j) * 68 + rt * 32 + 8 * g + 4 * h) = o; }
    }
    __syncthreads();
    {
        const int tau = tid >> 3, v8 = (tid & 7) * 8;
        float hv[8]; float s = 0.f;
#pragma unroll
        for (int q = 0; q < 8; ++q) { hv[q] = hS[tau * 68 + v8 + q] + hS[(64 + 63 - tau) * 68 + v8 + q]; s += hv[q]; }
        s += __shfl_xor(s, 1); s += __shfl_xor(s, 2); s += __shfl_xor(s, 4);
        const float mu = s * (1.f / 64.f);
        float qq = 0.f;
#pragma unroll
        for (int q = 0; q < 8; ++q) { const float dlt = hv[q] - mu; qq += dlt * dlt; }
        qq += __shfl_xor(qq, 1); qq += __shfl_xor(qq, 2); qq += __shfl_xor(qq, 4);
        const float rstd = frsqrt(qq * (1.f / 64.f) + EPS);
        const int t = tb + tau;
        const u4v ov = o_r;
        const float* ng = p.in[I_MLG] + (size_t)l * 256 + head * 64 + v8;
        float o[8];
#pragma unroll
        for (int q = 0; q < 8; ++q) { const float og = bf2f((bf16_t)(ov[q >> 1] >> (16 * (q & 1)))); o[q] = (hv[q] - mu) * rstd * ng[q] * sigmoidf_(og); }
        u4v pk; pk[0] = pack2(o[0], o[1]); pk[1] = pack2(o[2], o[3]); pk[2] = pack2(o[4], o[5]); pk[3] = pack2(o[6], o[7]);
        *(u4v*)((bf16_t*)(p.ws + WS_MIXED) + (size_t)t * MIXW + 384 + head * 64 + v8) = pk;
    }
    __syncthreads();
}

DEV int queue_next(const Params& p, char* smem, int qi) {
    int* slot = (int*)(smem + SMEM_XB + 32);
    __syncthreads();
    if (threadIdx.x == 0) {
#ifdef EMU
        unsigned* w = (unsigned*)(p.ws + WS_BAR) + QUEUE_WORD0 + 64 * qi; *slot = (int)(*w)++;
#else
        *slot = (int)__hip_atomic_fetch_add((unsigned*)(p.ws + WS_BAR) + QUEUE_WORD0 + 64 * qi, 1u, __ATOMIC_RELAXED, __HIP_MEMORY_SCOPE_AGENT);
#endif
    }
    __syncthreads();
    return *slot;
}
DEV void phase_attn(const Params& p, char* smem, int l, int qi) {
    constexpr int QB_S = DEC_SEQ / 256, QB_P = SEQ / 256;
    constexpr int U_SG = DEC_BATCH * GQH * QB_S * 2, U_SN = DEC_BATCH * NAH * QB_S, U_PN = BATCH * NAH * QB_P, U_PG = BATCH * GQH * QB_P;
    constexpr int U_MP = BATCH * MLH * NCH_P, U_MS = DEC_BATCH * MLH * NCH_S;
    constexpr int NU = U_SG + U_SN + U_PN + U_PG + U_MP + U_MS;
    const bf16_t* naq = (const bf16_t*)(p.ws + WS_NAQ); const bf16_t* nak = (const bf16_t*)(p.ws + WS_NAK); const bf16_t* nav = (const bf16_t*)(p.ws + WS_NAV);
    const bf16_t* gqq = (const bf16_t*)(p.ws + WS_GQQ); const bf16_t* gqk = (const bf16_t*)(p.ws + WS_GQK); const bf16_t* gqv = (const bf16_t*)(p.ws + WS_GQV);
    bf16_t* mixed = (bf16_t*)(p.ws + WS_MIXED);
    for (;;) {
        int u = queue_next(p, smem, qi);
        if (u >= NU) break;
#ifdef PROBE_ATT
        if (qi >= 8) { const int cls = u < U_SG ? 1 : u < U_SG + U_SN ? 2 : u < U_SG + U_SN + U_PN + U_PG ? 3 : 4; if (cls != PROBE_ATT) continue; }
#endif
        AttnDesc d; d.na = 0; d.r0 = 0; d.rlo = 0; d.rpb = nullptr; d.part = nullptr; d.out = nullptr; d.ostride = MIXW; d.n0 = 0; d.k0 = d.v0 = nullptr; d.stride0 = 0;
        if (u < U_SG) {
            const int half = u & 1, qb = (u >> 1) % QB_S, qh = (u / (2 * QB_S)) % GQH, b = u / (2 * QB_S * GQH);
            const int kvh = qh / (GQH / GQKV);
            constexpr int NCT = PAST / 64, TT = NCT + DEC_SEQ / 64, H0 = TT / 2;
            const size_t tq = (size_t)NP + (size_t)b * DEC_SEQ + qb * 256;
            d.q = gqq + tq * 384 + qh * 64; d.qstride = 384;
            const bf16_t* lk = gqk + ((size_t)NP + (size_t)b * DEC_SEQ) * 128 + kvh * 64; const bf16_t* lv = gqv + ((size_t)NP + (size_t)b * DEC_SEQ) * 128 + kvh * 64;
            if (half == 0) {
                d.n0 = NCT; d.ntiles = H0; d.stride0 = 128;
                const size_t co = (((size_t)b * DEPTH + l) * PAST) * 128 + kvh * 64;
                d.k0 = (const bf16_t*)(p.ws + WS_CGQK) + co; d.v0 = (const bf16_t*)(p.ws + WS_CGQV) + co;
                d.k1 = lk; d.v1 = lv; d.stride1 = 128;
            } else {
                d.n0 = 0; d.ntiles = TT - H0; d.stride1 = 128;
                d.k1 = lk + (size_t)(H0 - NCT) * 64 * 128; d.v1 = lv + (size_t)(H0 - NCT) * 64 * 128;
            }
            d.part = (float*)(p.ws + WS_PART) + (size_t)u * PART_STRIDE;
        } else if (u < U_SG + U_SN) {
            const int uu = u - U_SG; const int qb = uu % QB_S, hd = (uu / QB_S) % NAH, b = uu / (QB_S * NAH);
            const size_t t0 = (size_t)NP + (size_t)b * DEC_SEQ;
            d.q = naq + (t0 + qb * 256) * 384 + hd * 64; d.qstride = 384;
            d.na = 1; d.r0 = qb * 4; d.rlo = na_row_start(d.r0);
            const int rhi = na_row_start(d.r0 + 3) + KR;
            d.n0 = PAST / 64; d.ntiles = d.n0 + (rhi - d.rlo); d.stride0 = 384; d.stride1 = 384;
            const size_t co = (((size_t)b * DEPTH + l) * PAST) * 384 + hd * 64;
            d.k0 = (const bf16_t*)(p.ws + WS_CNAK) + co; d.v0 = (const bf16_t*)(p.ws + WS_CNAV) + co;
            d.k1 = nak + (t0 + (size_t)d.rlo * 64) * 384 + hd * 64; d.v1 = nav + (t0 + (size_t)d.rlo * 64) * 384 + hd * 64;
            d.rpb = p.in[I_RPB] + ((size_t)l * NAH + hd) * 15 * 31;
            d.out = mixed + (t0 + qb * 256) * MIXW + hd * 64;
        } else if (u < U_SG + U_SN + U_PN) {
            const int uu = u - U_SG - U_SN; const int qb = uu % QB_P, hd = (uu / QB_P) % NAH, b = uu / (QB_P * NAH);
            const size_t t0 = (size_t)b * SEQ;
            d.q = naq + (t0 + qb * 256) * 384 + hd * 64; d.qstride = 384;
            d.n0 = 0; d.ntiles = SEQ / 64; d.stride1 = 384; d.k1 = nak + t0 * 384 + hd * 64; d.v1 = nav + t0 * 384 + hd * 64;
            d.out = mixed + (t0 + qb * 256) * MIXW + hd * 64;
        } else if (u < U_SG + U_SN + U_PN + U_PG) {
            const int uu = u - U_SG - U_SN - U_PN; const int qb = uu % QB_P, qh = (uu / QB_P) % GQH, b = uu / (QB_P * GQH);
            const int kvh = qh / (GQH / GQKV);
            const size_t t0 = (size_t)b * SEQ;
            d.q = gqq + (t0 + qb * 256) * 384 + qh * 64; d.qstride = 384;
            d.n0 = 0; d.ntiles = SEQ / 64; d.stride1 = 128; d.k1 = gqk + t0 * 128 + kvh * 64; d.v1 = gqv + t0 * 128 + kvh * 64;
            d.out = mixed + (t0 + qb * 256) * MIXW + 640 + qh * 64;
        } else {
            int uu = u - (U_SG + U_SN + U_PN + U_PG); const int grp = uu >= U_MP ? 1 : 0; if (grp) uu -= U_MP;
            const int nch = grp ? NCH_S : NCH_P;
            mlstm_summary_unit(p, smem, grp, uu / (nch * MLH), (uu / nch) % MLH, uu % nch);
        }
        if (u < U_SG + U_SN + U_PN + U_PG) attn_unit(smem, d);
    }
}

DEV void phase_mlout(const Params& p, char* smem, int l) {
    constexpr int QB_S = DEC_SEQ / 256;
    constexpr int U_MS = DEC_BATCH * MLH * NCH_S, U_MP = BATCH * MLH * NCH_P, U_CB = DEC_BATCH * GQH * QB_S;
    const int tid = get_tid(), lane = tid & 63, wave = tid >> 6;
    for (int tk = blockIdx.x + gridDim.x * wave; tk < U_CB * 4; tk += gridDim.x * 8) {
        const int uu = tk >> 2, sl = tk & 3;
        const int qb = uu % QB_S, qh = (uu / QB_S) % GQH, b = uu / (QB_S * GQH);
        const float* p0 = (const float*)(p.ws + WS_PART) + (size_t)(2 * uu) * PART_STRIDE; const float* p1 = p0 + PART_STRIDE;
        const int q = sl * 64 + (lane >> 1) + 32 * 0, d0 = (lane & 1) * 32;
#pragma unroll
        for (int hq = 0; hq < 2; ++hq) {
            const int qq = q + 32 * hq;
            const float m0 = p0[256 * 64 + qq], m1 = p1[256 * 64 + qq], l0 = p0[256 * 64 + 256 + qq], l1 = p1[256 * 64 + 256 + qq];
            const float m = fmaxf(m0, m1), w0 = fexp2(m0 - m), w1 = fexp2(m1 - m);
            const float inv = 1.f / (l0 * w0 + l1 * w1);
            bf16_t* dst = (bf16_t*)(p.ws + WS_MIXED) + ((size_t)NP + (size_t)b * DEC_SEQ + qb * 256 + qq) * MIXW + 640 + qh * 64 + d0;
#pragma unroll
            for (int i = 0; i < 8; ++i) {
                const f4v a = *(const f4v*)(p0 + (size_t)qq * 64 + d0 + 4 * i), bb = *(const f4v*)(p1 + (size_t)qq * 64 + d0 + 4 * i);
                u2v pk; pk[0] = pack2((a[0] * w0 + bb[0] * w1) * inv, (a[1] * w0 + bb[1] * w1) * inv); pk[1] = pack2((a[2] * w0 + bb[2] * w1) * inv, (a[3] * w0 + bb[3] * w1) * inv);
                *(u2v*)(dst + 4 * i) = pk;
            }
        }
    }
    for (int u = blockIdx.x; u < U_MS + U_MP; u += gridDim.x) {
        const int grp = u < U_MS ? 1 : 0; const int uu = grp ? u : u - U_MS; const int nch = grp ? NCH_S : NCH_P;
        mlstm_output_unit(p, smem, l, grp, uu / (nch * MLH), (uu / nch) % MLH, uu % nch);
    }
}

constexpr int N_PHASES = 2 + 9 * DEPTH;
#ifndef EMU
typedef const __attribute__((address_space(4))) Params* KParamsPtr;
DEV void load_params(Params& p) {
    KParamsPtr kp = (KParamsPtr)__builtin_amdgcn_kernarg_segment_ptr();
    asm volatile("" : "+s"(kp));
#pragma unroll
    for (int i = 0; i < N_IN; ++i) p.in[i] = kp->in[i];
    p.out = kp->out; p.ws = kp->ws; p.ph0 = kp->ph0; p.ph1 = kp->ph1;
}
#endif
#ifdef EMU
static char emu_smem[SMEM_BYTES + 64];
#endif
__global__ void __launch_bounds__(512, 2) mega_kernel(Params p_) {
    const int ph0 = p_.ph0, ph1 = p_.ph1;
#ifdef EMU
    char* smem = emu_smem;
#define GRID_SYNC() do {} while (0)
#else
    extern __shared__ __attribute__((aligned(16))) char smem[];
    if (threadIdx.x == 0) *(u4v*)(smem + SMEM_XB) = (u4v){0u, 0u, 0u, 0u};
    __syncthreads();
    (void)xcd_barrier_post((unsigned*)(p_.ws + WS_BAR), (volatile LAS unsigned*)(smem + SMEM_XB));
    const bool multi = (ph1 - ph0) > 1;
#define GRID_SYNC() do { if (multi) { KParamsPtr kpb = (KParamsPtr)__builtin_amdgcn_kernarg_segment_ptr(); asm volatile("" : "+s"(kpb)); \
        XcdBarrier xb; xb.bar = (unsigned*)(kpb->ws + WS_BAR); xb.x = xb_xcc_id(); xb.st = (volatile LAS unsigned*)(smem + SMEM_XB); xcd_barrier(xb); } } while (0)
#endif
    int ph = 0;
#ifndef KIND_MASK
#define KIND_MASK 0x3ff
#endif
#ifdef EMU
#define LOAD_PARAMS() const Params& p = p_
#else
#define LOAD_PARAMS() Params p; load_params(p)
#endif
#ifndef DOUBLE_MASK
#define DOUBLE_MASK 0
#endif
#define PH_KIND() (ph == 0 ? 0 : ph == 1 + 9 * DEPTH ? 1 : 1 + (ph - 1) % 9)
#define RUN_PHASE(body) do { if (((KIND_MASK >> PH_KIND()) & 1) && ph >= ph0 && ph < ph1) { \
    if (DOUBLE_MASK && ((DOUBLE_MASK >> PH_KIND()) & 1)) { { const int rep_ = 1; LOAD_PARAMS(); body; } GRID_SYNC(); } \
    { const int rep_ = 0; LOAD_PARAMS(); body; } if (ph + 1 < ph1) GRID_SYNC(); } ++ph; } while (0)
    RUN_PHASE(phase_ada(p, smem));
    for (int l = 0; l < DEPTH; ++l) {
        RUN_PHASE(phase_rows<0>(p, smem, l));
        RUN_PHASE(phase_inproj<0>(p, smem, l));
        RUN_PHASE(phase_attn(p, smem, l, l + DEPTH * rep_));
        RUN_PHASE(phase_mlout(p, smem, l));
        RUN_PHASE(phase_outproj<0>(p, smem, l));
        RUN_PHASE(phase_rows<1>(p, smem, l));
        RUN_PHASE(phase_topk(p, smem));
        RUN_PHASE(phase_gateup<0>(p, smem, l));
        RUN_PHASE(phase_down<0>(p, smem, l));
    }
    RUN_PHASE(phase_rows<0>(p, smem, DEPTH));
#ifdef PROBE_BARRIERS
    for (int i = 0; i < PROBE_BARRIERS; ++i) GRID_SYNC();
#endif
}

#if !defined(EMU) && defined(PROBE_KIND)
__global__ void __launch_bounds__(512, 2) probe_kernel(Params p) {
    extern __shared__ __attribute__((aligned(16))) char smem[];
    for (int r = 0; r < PROBE_REPS; ++r) {
#if PROBE_KIND == 8
        phase_gateup<PROBE_VAR>(p, smem, 1);
#elif PROBE_KIND == 9
        phase_down<PROBE_VAR>(p, smem, 1);
#elif PROBE_KIND == 2
        phase_inproj<PROBE_VAR>(p, smem, 1);
#elif PROBE_KIND == 5
        phase_outproj<PROBE_VAR>(p, smem, 1);
#elif PROBE_KIND == 0
        phase_ada(p, smem);
#elif PROBE_KIND == 1
        phase_rows<0>(p, smem, 1);
#elif PROBE_KIND == 6
        phase_rows<1>(p, smem, 1);
#elif PROBE_KIND == 7
        phase_topk(p, smem);
#elif PROBE_KIND == 3
        phase_attn(p, smem, 1, 8 + r);
#elif PROBE_KIND == 4
        phase_mlout(p, smem, 1);
#endif
        __syncthreads();
    }
}
#endif
#ifndef EMU
#ifndef MK_N_LAUNCHES
#define MK_N_LAUNCHES 1
#endif
extern "C" void kernel_launch(void* const* d_in, const int* in_sizes, int n_in, void* d_out, int out_size, void* d_ws, size_t ws_size, hipStream_t stream) {
    (void)in_sizes; (void)n_in; (void)out_size; (void)ws_size;
    static int grid = 0;
    if (!grid) {
        int dev = 0, cus = 0, per_cu = 0;
        (void)hipGetDevice(&dev);
        (void)hipDeviceGetAttribute(&cus, hipDeviceAttributeMultiprocessorCount, dev);
        (void)hipFuncSetAttribute((const void*)mega_kernel, hipFuncAttributeMaxDynamicSharedMemorySize, SMEM_BYTES);
        (void)hipOccupancyMaxActiveBlocksPerMultiprocessor(&per_cu, mega_kernel, 512, SMEM_BYTES);
        grid = cus * (per_cu < 1 ? per_cu : 1);
        if (grid <= 0) grid = cus;
    }
    (void)hipMemsetAsync((char*)d_ws + WS_BAR, 0, WS_BAR_BYTES, stream);
    Params p = {};
    for (int i = 0; i < N_IN; ++i) p.in[i] = (const float*)d_in[i];
    p.out = (float*)d_out; p.ws = (char*)d_ws;
#if MK_N_LAUNCHES == 1
    p.ph0 = 0; p.ph1 = N_PHASES;
    mega_kernel<<<dim3(grid), dim3(512), SMEM_BYTES, stream>>>(p);
#ifdef PROBE_KIND
    (void)hipFuncSetAttribute((const void*)probe_kernel, hipFuncAttributeMaxDynamicSharedMemorySize, SMEM_BYTES);
    probe_kernel<<<dim3(grid), dim3(512), SMEM_BYTES, stream>>>(p);
#endif
#else
    for (int ph = 0; ph < N_PHASES; ++ph) { p.ph0 = ph; p.ph1 = ph + 1; mega_kernel<<<dim3(grid), dim3(512), SMEM_BYTES, stream>>>(p); }
#endif
}
#endif
```

```cpp
#ifndef EMU
#include <hip/hip_runtime.h>
#define DEV __device__ __forceinline__
#else
#define DEV static inline __attribute__((always_inline))
#endif
#include <stdint.h>
#include <stddef.h>

#ifndef CFG_D
#define CFG_D 1024
#define CFG_BATCH 16
#define CFG_SEQ 256
#define CFG_DEC_BATCH 2
#define CFG_DEC_SEQ 2048
#define CFG_PAST 256
#define CFG_EH 2816
#endif
constexpr int D = CFG_D, BATCH = CFG_BATCH, SEQ = CFG_SEQ, DEC_BATCH = CFG_DEC_BATCH, DEC_SEQ = CFG_DEC_SEQ, PAST = CFG_PAST, EH = CFG_EH;
constexpr int DEPTH = 2, HD = 64, NAH = 6, MLH = 4, GQH = 6, GQKV = 2, NEXP = 16, GRIDW = 64;
constexpr int NP = BATCH * SEQ, NS = DEC_BATCH * DEC_SEQ, NT = NP + NS, NCOND = 1 + DEC_BATCH;
constexpr int PROJ_W = 2832, MIXW = 1024;
constexpr int CAP_P = SEQ / 8, CAP_S = DEC_SEQ / 8, SLOTS = BATCH * CAP_P + DEC_BATCH * CAP_S;
constexpr int ROWS = DEC_SEQ / GRIDW, KR = ROWS < 8 ? ROWS : 8, KC = 16;
constexpr int NCH_P = SEQ / 64, NCH_S = DEC_SEQ / 64;
constexpr float ALPHA = 1.41421356237309515f;
constexpr float ATT_SCALE = 0.125f;
constexpr float EPS = 1e-6f;
static_assert(SLOTS % 256 == 0 && NP % 256 == 0 && NS % 256 == 0 && SEQ % 256 == 0 && DEC_SEQ % 256 == 0, "tile divisibility");
static_assert(D % 256 == 0 && EH % 128 == 0 && PAST % 64 == 0, "tile divisibility");

typedef unsigned short bf16_t;
typedef short s8v __attribute__((ext_vector_type(8)));
typedef short s4v __attribute__((ext_vector_type(4)));
typedef float f16v __attribute__((ext_vector_type(16)));
typedef float f4v __attribute__((ext_vector_type(4)));
typedef unsigned u4v __attribute__((ext_vector_type(4)));
typedef unsigned u2v __attribute__((ext_vector_type(2)));

enum { I_XP = 0, I_XS, I_C, I_CNAK, I_CNAV, I_CGQK, I_CGQV, I_SC, I_SN, I_SM, I_CCTX, I_ADAW, I_ADAB, I_WIN, I_BGATE, I_WOUT, I_RPB, I_QKG, I_MLG,
       I_LNG, I_LNB, I_RW, I_WG, I_WU, I_WD, N_IN };

constexpr size_t O_YP = 0;
constexpr size_t O_YS = O_YP + (size_t)NP * D;
constexpr size_t O_NAK = O_YS + (size_t)NS * D;
constexpr size_t O_NAV = O_NAK + (size_t)BATCH * DEPTH * SEQ * NAH * HD;
constexpr size_t O_GQK = O_NAV + (size_t)BATCH * DEPTH * SEQ * NAH * HD;
constexpr size_t O_GQV = O_GQK + (size_t)BATCH * DEPTH * SEQ * GQKV * HD;
constexpr size_t O_MC = O_GQV + (size_t)BATCH * DEPTH * SEQ * GQKV * HD;
constexpr size_t O_MN = O_MC + (size_t)BATCH * DEPTH * 2 * MLH * HD * HD;
constexpr size_t O_MM = O_MN + (size_t)BATCH * DEPTH * 2 * MLH * HD;
constexpr size_t O_END = O_MM + (size_t)BATCH * DEPTH * 2 * MLH;

constexpr size_t al256(size_t x) { return (x + 255) & ~(size_t)255; }
constexpr size_t WS_BAR = 0;
constexpr size_t WS_BAR_BYTES = 32768;
constexpr size_t WS_MODS = WS_BAR + WS_BAR_BYTES;
constexpr size_t WS_ROPE = al256(WS_MODS + (size_t)DEPTH * NCOND * 6 * D * 4);
constexpr size_t WS_CNAK = al256(WS_ROPE + 64 * 16 * 2 * 4);
constexpr size_t WS_CNAV = al256(WS_CNAK + (size_t)DEC_BATCH * DEPTH * PAST * NAH * HD * 2);
constexpr size_t WS_CGQK = al256(WS_CNAV + (size_t)DEC_BATCH * DEPTH * PAST * NAH * HD * 2);
constexpr size_t WS_CGQV = al256(WS_CGQK + (size_t)DEC_BATCH * DEPTH * PAST * GQKV * HD * 2);
constexpr size_t WS_XBUF = al256(WS_CGQV + (size_t)DEC_BATCH * DEPTH * PAST * GQKV * HD * 2);
constexpr size_t WS_HMOD = al256(WS_XBUF + (size_t)NT * D * 4);
constexpr size_t WS_GATES = al256(WS_HMOD + (size_t)NT * D * 2);
constexpr size_t WS_NAQ = al256(WS_GATES + (size_t)NT * 16 * 4);
constexpr size_t WS_NAK = al256(WS_NAQ + (size_t)NT * 384 * 2);
constexpr size_t WS_NAV = al256(WS_NAK + (size_t)NT * 384 * 2);
constexpr size_t WS_MLQ = al256(WS_NAV + (size_t)NT * 384 * 2);
constexpr size_t WS_MLK = al256(WS_MLQ + (size_t)NT * 256 * 2);
constexpr size_t WS_MLV = al256(WS_MLK + (size_t)NT * 256 * 2);
constexpr size_t WS_MLO = al256(WS_MLV + (size_t)NT * 256 * 2);
constexpr size_t WS_GQQ = al256(WS_MLO + (size_t)NT * 256 * 2);
constexpr size_t WS_GQK = al256(WS_GQQ + (size_t)NT * 384 * 2);
constexpr size_t WS_GQV = al256(WS_GQK + (size_t)NT * 128 * 2);
constexpr size_t WS_MIXED = al256(WS_GQV + (size_t)NT * 128 * 2);
constexpr size_t WS_U = al256(WS_MIXED + (size_t)NT * MIXW * 2);
constexpr size_t WS_X1 = al256(WS_U + (size_t)NT * D * 4);
constexpr size_t WS_H2 = al256(WS_X1 + (size_t)NT * D * 4);
constexpr size_t WS_AFF = al256(WS_H2 + (size_t)NT * D * 2);
constexpr size_t WS_IDX = al256(WS_AFF + (size_t)NT * 16 * 4);
constexpr size_t WS_GSEL = al256(WS_IDX + (size_t)NEXP * SLOTS * 4);
constexpr size_t WS_TOKSLOT = al256(WS_GSEL + (size_t)NEXP * SLOTS * 4);
constexpr size_t WS_HID = al256(WS_TOKSLOT + (size_t)NT * 16 * 4);
constexpr size_t WS_YE = al256(WS_HID + (size_t)NEXP * SLOTS * EH * 2);
constexpr int MLSUM_STRIDE = 4096 + 64 + 64;
constexpr int N_MLSUM = (BATCH * NCH_P + DEC_BATCH * NCH_S) * MLH * 2;
constexpr size_t WS_MLSUM = al256(WS_YE + (size_t)NEXP * SLOTS * D * 2);
constexpr int PART_STRIDE = 256 * 64 + 512;
constexpr int N_PART = DEC_BATCH * GQH * (DEC_SEQ / 256) * 2;
constexpr size_t WS_PART = al256(WS_MLSUM + (size_t)N_MLSUM * MLSUM_STRIDE * 4);
constexpr size_t WS_TOTAL = al256(WS_PART + (size_t)N_PART * PART_STRIDE * 4);

struct Params {
    const float* in[N_IN];
    float* out;
    char* ws;
    int ph0, ph1;
};

DEV float bf2f(bf16_t s) { unsigned u = ((unsigned)s) << 16; return __builtin_bit_cast(float, u); }
DEV bf16_t f2bf(float f) {
#ifdef EMU
    unsigned u = __builtin_bit_cast(unsigned, f); u += 0x7fffu + ((u >> 16) & 1u); return (bf16_t)(u >> 16);
#else
    return __builtin_bit_cast(bf16_t, (__bf16)f);
#endif
}
DEV unsigned pack2(float a, float b) {
#ifdef EMU
    return (unsigned)f2bf(a) | ((unsigned)f2bf(b) << 16);
#else
    typedef __bf16 b2 __attribute__((ext_vector_type(2))); b2 r; r[0] = (__bf16)a; r[1] = (__bf16)b; return __builtin_bit_cast(unsigned, r);
#endif
}
DEV float fexp(float x) {
#ifdef EMU
    return expf(x);
#else
    return __expf(x);
#endif
}
DEV float fexp2(float x) {
#ifdef EMU
    return exp2f(x);
#else
    return __builtin_amdgcn_exp2f(x);
#endif
}
DEV float frcp(float x) {
#ifdef EMU
    return 1.f / x;
#else
    return __builtin_amdgcn_rcpf(x);
#endif
}
DEV float sigmoidf_(float x) { return frcp(1.f + fexp(-x)); }
DEV float siluf_(float x) { return x * frcp(1.f + fexp(-x)); }
DEV float flog(float x) {
#ifdef EMU
    return logf(x);
#else
    return __logf(x);
#endif
}
DEV float frsqrt(float x) {
#ifdef EMU
    return 1.f / sqrtf(x);
#else
    return __builtin_amdgcn_rsqf(x);
#endif
}
DEV float logsigmoidf_(float x) { return fminf(x, 0.f) - flog(1.f + fexp(-fabsf(x))); }
DEV f16v mfma32(s8v a, s8v b, f16v c) {
#ifdef EMU
    return emu_mfma_32x32x16_bf16(a, b, c);
#else
    typedef __bf16 bf8 __attribute__((ext_vector_type(8)));
    return __builtin_amdgcn_mfma_f32_32x32x16_bf16(__builtin_bit_cast(bf8, a), __builtin_bit_cast(bf8, b), c, 0, 0, 0);
#endif
}
DEV s4v lds_tr16(const void* p) {
#ifdef EMU
    return emu_ds_read_tr16_b64(p);
#else
    typedef s4v __attribute__((address_space(3))) * lp;
    return __builtin_amdgcn_ds_read_tr16_b64_v4i16((lp)(p));
#endif
}
#ifdef EMU
DEV float wave_sum(float v) { for (int m = 32; m >= 1; m >>= 1) v += __shfl_xor(v, m); return v; }
#else
template <int CTRL, int RM> DEV float dpp_f(float v) { return __builtin_bit_cast(float, __builtin_amdgcn_update_dpp(0, __builtin_bit_cast(int, v), CTRL, RM, 0xF, false)); }
DEV float wave_sum(float v) {
    v += dpp_f<0xB1, 0xF>(v); v += dpp_f<0x4E, 0xF>(v); v += dpp_f<0x141, 0xF>(v); v += dpp_f<0x140, 0xF>(v);
    v += dpp_f<0x142, 0xA>(v); v += dpp_f<0x143, 0xC>(v);
    return __builtin_bit_cast(float, __builtin_amdgcn_readlane(__builtin_bit_cast(int, v), 63));
}
#endif
DEV float wave_max(float v) { for (int m = 32; m >= 1; m >>= 1) v = fmaxf(v, __shfl_xor(v, m)); return v; }
DEV f16v f16zero() { f16v z; for (int i = 0; i < 16; ++i) z[i] = 0.f; return z; }

#ifdef EMU
#define VGPR_PIN(x) do {} while (0)
#define SGPR_PIN(x) do {} while (0)
#define SCHED_FENCE() do {} while (0)
#define CFENCE() do {} while (0)
#else
#define SCHED_FENCE() __builtin_amdgcn_sched_barrier(0)
#define SGPR_PIN(x) asm volatile("" : "+s"(x))
#define VGPR_PIN(x) asm volatile("" : "+v"(x))
#define CFENCE() asm volatile("" ::: "memory")
#endif
#ifdef EMU
DEV int get_tid() { return (int)threadIdx.x; }
#else
DEV int get_tid() { int t = threadIdx.x; asm volatile("" : "+v"(t)); return t; }
#endif
struct UnitIter { int i, end, step; };
DEV UnitIter unit_iter(int NU) {
    const int G = (int)gridDim.x, b = (int)blockIdx.x;
    UnitIter it;
#ifndef XCD_MODE
#define XCD_MODE 0
#endif
    if ((G & 7) == 0 && (NU & 7) == 0) { const int W = G >> 3, x = XCD_MODE ? b / W : b & 7, j = XCD_MODE ? b % W : b >> 3, C = NU >> 3; it.i = x * C + j; it.end = (x + 1) * C; it.step = W; }
    else { it.i = b; it.end = NU; it.step = G; }
    return it;
}
DEV int tok_cond(int t) { return t < NP ? 0 : 1 + (t - NP) / DEC_SEQ; }

#ifndef EMU
#define XB_TMO      128
#define XB_XCNT(j)  (256  + 64 * (j))
#define XB_XSUB(j)  (1280 + 64 * (j))
#define XB_XGEN(j)  (2304 + 64 * (j))
#define XB_TOP      3328
#define XB_TOPGEN   3392
#define XCD_BAR_WORDS 3456
#define XB_SPIN_CAP (1u << 20)
#define LAS __attribute__((address_space(3)))
__device__ __forceinline__ unsigned xb_ld(unsigned* p)              { return __hip_atomic_load(p, __ATOMIC_RELAXED, __HIP_MEMORY_SCOPE_AGENT); }
__device__ __forceinline__ unsigned xb_add(unsigned* p, unsigned v) { return __hip_atomic_fetch_add(p, v, __ATOMIC_RELAXED, __HIP_MEMORY_SCOPE_AGENT); }
__device__ __forceinline__ unsigned xb_xcc_id() { return (unsigned)__builtin_amdgcn_s_getreg((3 << 11) | 20) & 0xFu; }
#define XB_SPIN(cond, bar) do { unsigned _sp = 0; while (cond) { __builtin_amdgcn_s_sleep(1); \
    if ((++_sp & 255u) == 0u) { if (xb_ld(&(bar)[XB_TMO])) break; if (_sp > XB_SPIN_CAP) { atomicAdd(&(bar)[XB_TMO], 1u); break; } } } } while (0)
struct XcdBarrier { unsigned* bar; unsigned x; volatile LAS unsigned* st; };
__device__ __forceinline__ XcdBarrier xcd_barrier_post(unsigned* bar, volatile LAS unsigned* st) {
    XcdBarrier b; b.bar = bar; b.x = xb_xcc_id(); b.st = st;
    if (threadIdx.x == 0) (void)xb_add(&bar[XB_XCNT(b.x)], 1u);
    return b;
}
__device__ __forceinline__ void xcd_barrier_complete(unsigned* bar, unsigned x, unsigned& nloc, unsigned& nx) {
    const unsigned G = gridDim.x * gridDim.y * gridDim.z;
    unsigned sum, cnt, mine, sp = 0u;
    for (;;) {
        sum = 0u; cnt = 0u; mine = 0u;
#pragma unroll
        for (unsigned j = 0; j < 16; ++j) { const unsigned c = xb_ld(&bar[XB_XCNT(j)]); sum += c; cnt += (c > 0u) ? 1u : 0u; mine = (j == x) ? c : mine; }
        if (sum == G) break;
        __builtin_amdgcn_s_sleep(1);
        if ((++sp & 255u) == 0u) { if (xb_ld(&bar[XB_TMO])) break; if (sp > XB_SPIN_CAP) { atomicAdd(&bar[XB_TMO], 1u); break; } }
    }
    nloc = mine > 0u ? mine : 1u; nx = cnt > 0u ? cnt : 1u;
}
__device__ __forceinline__ void xcd_barrier(const XcdBarrier& b) {
    asm volatile("s_waitcnt vmcnt(0)" ::: "memory");
    __syncthreads();
    if (threadIdx.x == 0) {
        unsigned* bar = b.bar;
        __builtin_amdgcn_s_waitcnt(0);
        unsigned nloc = b.st[0], nx = b.st[1];
        if (nloc == 0u) { xcd_barrier_complete(bar, b.x, nloc, nx); b.st[0] = nloc; b.st[1] = nx; }
        const unsigned old = xb_add(&bar[XB_XSUB(b.x)], 1u);
        const unsigned gen = old / nloc;
        if (old + 1u == (gen + 1u) * nloc) {
            __builtin_amdgcn_fence(__ATOMIC_RELEASE, "agent");
            asm volatile("s_waitcnt vmcnt(0)" ::: "memory");
            const unsigned og = xb_add(&bar[XB_TOP], 1u);
            const unsigned tg = og / nx;
            if (og + 1u == (tg + 1u) * nx) xb_add(&bar[XB_TOPGEN], 1u);
            else XB_SPIN(xb_ld(&bar[XB_TOPGEN]) == tg, bar);
            __builtin_amdgcn_fence(__ATOMIC_ACQUIRE, "agent");
            xb_add(&bar[XB_XGEN(b.x)], 1u);
            asm volatile("s_waitcnt vmcnt(0)" ::: "memory");
        } else {
            XB_SPIN(xb_ld(&bar[XB_XGEN(b.x)]) == gen, bar);
            __builtin_amdgcn_fence(__ATOMIC_ACQUIRE, "agent");
            asm volatile("s_waitcnt vmcnt(0)" ::: "memory");
        }
    }
    __syncthreads();
}
#endif
constexpr int QUEUE_WORD0 = 4096;

constexpr int LROW = 144;
constexpr int GEMM_AS = 256 * LROW;
constexpr int GEMM_BS = 64 * (256 * 2 + 64);
constexpr int SMEM_XB = 2 * GEMM_AS + 2 * GEMM_BS;
constexpr int SMEM_AUX = SMEM_XB + 64;
constexpr int SMEM_BYTES = SMEM_AUX + 2048;

#ifdef EMU
struct BufRsrc { const char* base; };
DEV BufRsrc make_rsrc(const void* p) { BufRsrc r; r.base = (const char*)p; return r; }
DEV float buf_load_f32(BufRsrc r, unsigned voff, unsigned soff) { return *(const float*)(r.base + voff + soff); }
DEV u4v buf_load_b128(BufRsrc r, unsigned voff, unsigned soff) { return *(const u4v*)(r.base + voff + soff); }
#else
typedef __amdgpu_buffer_rsrc_t BufRsrc;
DEV BufRsrc make_rsrc(const void* p) { return __builtin_amdgcn_make_buffer_rsrc((void*)p, 0, 0x7fffffff, 0x00020000); }
DEV float buf_load_f32(BufRsrc r, unsigned voff, unsigned soff) { return __builtin_bit_cast(float, __builtin_amdgcn_raw_buffer_load_b32(r, voff, soff, 0)); }
DEV u4v buf_load_b128(BufRsrc r, unsigned voff, unsigned soff) { return __builtin_amdgcn_raw_buffer_load_b128(r, voff, soff, 0); }
#endif
#ifdef EMU
#define WAVE_SYNC() do { (void)__shfl(0, 0); } while (0)
#else
#define WAVE_SYNC() asm volatile("s_waitcnt lgkmcnt(0)" ::: "memory")
#endif
DEV char* wave_stage_ptr(char* smem, int wave) { return smem + (wave < 4 ? GEMM_AS + wave * 9216 : 2 * GEMM_AS + GEMM_BS + (wave - 4) * 9216); }
DEV void stage64_write_bf16(char* stg, int tt, const f16v& v0, const f16v& v1, int l31, int h) {
    char* row = stg + (tt * 32 + l31) * LROW;
#pragma unroll
    for (int ft = 0; ft < 2; ++ft) {
        const f16v& v = ft ? v1 : v0;
#pragma unroll
        for (int g = 0; g < 4; ++g) { u2v pk; pk[0] = pack2(v[4 * g], v[4 * g + 1]); pk[1] = pack2(v[4 * g + 2], v[4 * g + 3]); *(u2v*)(row + (ft * 32 + 8 * g + 4 * h) * 2) = pk; }
    }
}
DEV void stage64_write4(char* stg, int row, int col, float a, float b, float c, float d) {
    u2v pk; pk[0] = pack2(a, b); pk[1] = pack2(c, d); *(u2v*)(stg + row * LROW + col * 2) = pk;
}
DEV void stage64_flush_bf16(const char* stg, bf16_t* dst0, size_t row_stride, int lane) {
    WAVE_SYNC();
#pragma unroll
    for (int i = 0; i < 8; ++i) { const int r = (lane >> 3) + 8 * i, c = lane & 7; const u4v v = *(const u4v*)(stg + r * LROW + c * 16); *(u4v*)(dst0 + (size_t)r * row_stride + c * 8) = v; }
    WAVE_SYNC();
}
template <int NTW, int VAR, class Epi>
DEV void gemm_tile(char* smem, BufRsrc ars, unsigned ao0, unsigned ao1, unsigned ao2, unsigned ao3,
                   BufRsrc brs, unsigned bvo, unsigned blds, unsigned ldb4, int K, Epi&& epi) {
    constexpr int BN = 64 * NTW, NLD = 2 * NTW, KSTEP = 64 / NLD, RSB = BN * 2 + 64;
    const int tid = get_tid(), lane = tid & 63, wave = tid >> 6, wm = wave & 3, wn = wave >> 2, h = lane >> 5, l31 = lane & 31;
    char* As = smem; char* Bs = smem + 2 * GEMM_AS;
    constexpr int BSZ = GEMM_BS;
    const int ar = tid >> 3, ac = tid & 7;
    u4v areg[2]; f4v b0[NLD], b1[NLD];
    if (VAR & 3) { for (int i = 0; i < 2; ++i) areg[i] = (u4v){1u, 2u, 3u, 4u}; for (int j = 0; j < NLD; ++j) { b0[j] = (f4v){1.f, 1.f, 1.f, 1.f}; b1[j] = (f4v){2.f, 2.f, 2.f, 2.f}; } }
    f16v acc[NTW][2];
#pragma unroll
    for (int i = 0; i < NTW; ++i) { acc[i][0] = f16zero(); acc[i][1] = f16zero(); }
    auto gloadA = [&](int k0, bool real, int half) {
        if (VAR & 2) return;
        const unsigned so = real ? k0 * 2 : 0u;
        areg[0] = buf_load_b128(ars, real ? (half ? ao2 : ao0) : 0u, so); areg[1] = buf_load_b128(ars, real ? (half ? ao3 : ao1) : 0u, so);
    };
    auto gloadB = [&](int k0, bool real, f4v (&br)[NLD]) {
        if (VAR & 1) return;
        const unsigned vo = real ? bvo : 0u; const int kk = real ? k0 : 0;
        unsigned so = (unsigned)kk * ldb4;
#pragma unroll
        for (int j = 0; j < NLD; ++j) { br[j] = __builtin_bit_cast(f4v, buf_load_b128(brs, vo, so)); so += KSTEP * ldb4; SGPR_PIN(so); }
    };
    auto gloadB1 = [&](int k0, bool real, f4v (&br)[NLD], int j) {
        if (VAR & 1) return;
        br[j] = __builtin_bit_cast(f4v, buf_load_b128(brs, real ? bvo : 0u, (unsigned)((real ? k0 : 0) + j * KSTEP) * ldb4));
    };
    auto lstoreA = [&](int buf, int half) {
        if (VAR & 16) return;
        char* ab = As + buf * GEMM_AS + (ar + half * 128) * LROW + ac * 16;
        *(u4v*)(ab) = areg[0]; *(u4v*)(ab + 64 * LROW) = areg[1];
    };
    auto lstoreB1 = [&](int buf, const f4v (&br)[NLD], int j) {
        if (VAR & 16) return;
        u2v v; v[0] = pack2(br[j][0], br[j][1]); v[1] = pack2(br[j][2], br[j][3]); *(u2v*)(Bs + buf * BSZ + blds + j * KSTEP * RSB) = v;
    };
    auto lstoreB = [&](int buf, const f4v (&br)[NLD]) {
        if (VAR & 16) return;
        char* bb = Bs + buf * BSZ + blds;
#pragma unroll
        for (int j = 0; j < NLD; ++j) { u2v v; v[0] = pack2(br[j][0], br[j][1]); v[1] = pack2(br[j][2], br[j][3]); *(u2v*)(bb + j * KSTEP * RSB) = v; }
    };
    const unsigned btr = (unsigned)(8 * h + ((lane & 15) >> 2)) * RSB + (unsigned)((((lane >> 4) & 1) * 16 + 4 * (lane & 3)) * 2) + (unsigned)(wn * NTW * 32) * 2;
    const unsigned atr = (unsigned)(wm * 64 + l31) * LROW + h * 16;
    auto rdw = [&](int buf, int s, int ft) -> s8v {
        if (VAR & 64) { s8v z; for (int q = 0; q < 8; ++q) z[q] = (short)(0x3f80 + ft); return z; }
        const char* bb = Bs + buf * BSZ + btr + s * 16 * RSB + ft * 64;
        const s4v lo = lds_tr16(bb), hi = lds_tr16(bb + 4 * RSB);
        s8v wf; wf[0] = lo[0]; wf[1] = lo[1]; wf[2] = lo[2]; wf[3] = lo[3]; wf[4] = hi[0]; wf[5] = hi[1]; wf[6] = hi[2]; wf[7] = hi[3];
        return wf;
    };
    auto compute2 = [&](int buf, int s0, auto&& hook) {
        if (VAR & 8) { for (int g = 0; g < 2 * NTW; ++g) hook(g); return; }
        const char* ab = As + buf * GEMM_AS + atr;
        s8v xa[2];
        if (VAR & 64) { for (int q = 0; q < 8; ++q) { xa[0][q] = 0x3f80; xa[1][q] = 0x3f80; } } else { xa[0] = *(const s8v*)(ab + s0 * 32); xa[1] = *(const s8v*)(ab + 32 * LROW + s0 * 32); }
        s8v wcur = rdw(buf, s0, 0);
#pragma unroll
        for (int g = 0; g < 2 * NTW; ++g) {
            const int ft = g % NTW;
            s8v wnext = wcur;
            if (g + 1 < 2 * NTW) wnext = rdw(buf, s0 + (g + 1) / NTW, (g + 1) % NTW);
            if (VAR & 4) { acc[ft][0][0] += __builtin_bit_cast(float, (int)wcur[0] | ((int)xa[0][1] << 16)); acc[ft][1][0] += __builtin_bit_cast(float, (int)wcur[1] | ((int)xa[1][1] << 16)); }
            else { acc[ft][0] = mfma32(wcur, xa[0], acc[ft][0]); acc[ft][1] = mfma32(wcur, xa[1], acc[ft][1]); }
            if (g == NTW - 1 && !(VAR & 64)) { xa[0] = *(const s8v*)(ab + (s0 + 1) * 32); xa[1] = *(const s8v*)(ab + 32 * LROW + (s0 + 1) * 32); }
            wcur = wnext;
            hook(g);
            SCHED_FENCE();
        }
    };
    auto nohook = [](int) {};
    const int nk = K / 64;
    if (NTW == 2) {
        u4v a0[4], a1[4];
        if (VAR & 3) { for (int i = 0; i < 4; ++i) { a0[i] = (u4v){1u, 2u, 3u, 4u}; a1[i] = (u4v){1u, 2u, 3u, 4u}; } }
        auto gA = [&](int k0, bool real, u4v (&ar4)[4]) {
            if (VAR & 2) return;
            const unsigned so = real ? k0 * 2 : 0u;
            ar4[0] = buf_load_b128(ars, real ? ao0 : 0u, so); ar4[1] = buf_load_b128(ars, real ? ao1 : 0u, so);
            ar4[2] = buf_load_b128(ars, real ? ao2 : 0u, so); ar4[3] = buf_load_b128(ars, real ? ao3 : 0u, so);
        };
        auto sA = [&](int buf, const u4v (&ar4)[4]) {
            if (VAR & 16) return;
            char* ab = As + buf * GEMM_AS + ar * LROW + ac * 16;
#pragma unroll
            for (int i = 0; i < 4; ++i) *(u4v*)(ab + i * 64 * LROW) = ar4[i];
        };
        gA(0, true, a0); gloadB(0, true, b0); gA(64, true, a1); gloadB(64, true, b1);
        sA(0, a0); lstoreB(0, b0);
        __syncthreads();
        for (int kt = 0; kt < nk; kt += 2) {
            const bool t2 = kt + 2 < nk;
            gA((kt + 2) * 64, t2, a0);
            compute2(0, 0, [&](int g) { gloadB1((kt + 2) * 64, t2, b0, g); });
            compute2(0, 2, [&](int g) { lstoreB1(1, b1, g); });
            sA(1, a1);
            __syncthreads();
            gA((kt + 3) * 64, t2, a1);
            compute2(1, 0, [&](int g) { gloadB1((kt + 3) * 64, t2, b1, g); });
            compute2(1, 2, [&](int g) { lstoreB1(0, b0, g); });
            sA(0, a0);
            __syncthreads();
        }
    } else {
    {
        u4v at0, at1;
        gloadA(0, true, 0);
        if (!(VAR & 2)) { at0 = buf_load_b128(ars, ao2, 0); at1 = buf_load_b128(ars, ao3, 0); } else { at0 = areg[0]; at1 = areg[1]; }
        gloadB(0, true, b0); gloadB(64, true, b1);
        lstoreA(0, 0);
        if (!(VAR & 16)) { char* ab = As + (ar + 128) * LROW + ac * 16; *(u4v*)(ab) = at0; *(u4v*)(ab + 64 * LROW) = at1; }
        lstoreB(0, b0);
    }
    __syncthreads();
    for (int kt = 0; kt < nk; kt += 2) {
        const bool t2 = kt + 2 < nk;
        gloadA((kt + 1) * 64, true, 0);
        compute2(0, 0, [&](int g) { lstoreB1(1, b1, g); });
        lstoreA(1, 0);
        gloadA((kt + 1) * 64, true, 1);
        compute2(0, 2, [&](int g) { gloadB1((kt + 2) * 64, t2, b0, g); });
        lstoreA(1, 1);
        __syncthreads();
        gloadA((kt + 2) * 64, t2, 0);
        compute2(1, 0, [&](int g) { lstoreB1(0, b0, g); });
        lstoreA(0, 0);
        gloadA((kt + 2) * 64, t2, 1);
        compute2(1, 2, [&](int g) { gloadB1((kt + 3) * 64, t2, b1, g); });
        lstoreA(0, 1);
        __syncthreads();
    }
    }
    if (VAR & 32) { float t = 0.f; for (int i = 0; i < NTW; ++i) t += acc[i][0][0] + acc[i][1][5]; if (t == 123.456f) *(float*)smem = t; }
    else epi(acc);
}

DEV void phase_ada(const Params& p, char* smem) {
    const int tid = get_tid();
    float* siluS = (float*)smem;
    float* red = (float*)(smem + NCOND * D * 4);
    for (int i = tid; i < NCOND * D; i += 512) {
        const int cnd = i / D, k = i % D;
        const float c = cnd == 0 ? p.in[I_CCTX][k] : p.in[I_C][(cnd - 1) * D + k];
        siluS[i] = c * frcp(1.f + fexp(-c));
    }
    __syncthreads();
    constexpr int CPL = 6 * D / 32, NCHUNK = DEPTH * CPL, KG = D / 16;
    float* mods = (float*)(p.ws + WS_MODS);
    const int col = tid & 31, kg = tid >> 5;
    for (int u = blockIdx.x; u < NCHUNK; u += gridDim.x) {
        const int l = u / CPL, c0 = (u % CPL) * 32;
        const float* W = p.in[I_ADAW] + (size_t)l * D * 6 * D + c0 + col;
        float acc[NCOND];
#pragma unroll
        for (int c = 0; c < NCOND; ++c) acc[c] = 0.f;
#pragma unroll 8
        for (int k = kg * KG; k < kg * KG + KG; ++k) {
            const float w = W[(size_t)k * 6 * D];
#pragma unroll
            for (int c = 0; c < NCOND; ++c) acc[c] += siluS[c * D + k] * w;
        }
#pragma unroll
        for (int c = 0; c < NCOND; ++c) red[(kg * NCOND + c) * 32 + col] = acc[c];
        __syncthreads();
        if (tid < 32 * NCOND) {
            const int c = tid >> 5, cc = tid & 31;
            float s = 0.f;
            for (int g = 0; g < 16; ++g) s += red[(g * NCOND + c) * 32 + cc];
            mods[((size_t)l * NCOND + c) * 6 * D + c0 + cc] = s + p.in[I_ADAB][(size_t)l * 6 * D + c0 + cc];
        }
        __syncthreads();
    }
    const int gtid = blockIdx.x * 512 + tid, gsz = gridDim.x * 512;
    float* rope = (float*)(p.ws + WS_ROPE);
    for (int i = gtid; i < 64 * 16; i += gsz) {
        const int pos = i >> 4, fi = i & 15;
        const float inv = fexp2(-(float)(2 * fi) * (13.287712379549449f / 32.f));
        const float ang = (float)pos * inv;
#ifdef EMU
        rope[2 * i] = cosf(ang); rope[2 * i + 1] = sinf(ang);
#else
        rope[2 * i] = __cosf(ang); rope[2 * i + 1] = __sinf(ang);
#endif
    }
    constexpr int NNA = DEC_BATCH * DEPTH * PAST * NAH * HD, NGQ = DEC_BATCH * DEPTH * PAST * GQKV * HD;
    bf16_t* cnak = (bf16_t*)(p.ws + WS_CNAK); bf16_t* cnav = (bf16_t*)(p.ws + WS_CNAV);
    bf16_t* cgqk = (bf16_t*)(p.ws + WS_CGQK); bf16_t* cgqv = (bf16_t*)(p.ws + WS_CGQV);
    for (int i = gtid; i < NNA; i += gsz) { cnak[i] = f2bf(p.in[I_CNAK][i]); cnav[i] = f2bf(p.in[I_CNAV][i]); }
    for (int i = gtid; i < NGQ; i += gsz) { cgqk[i] = f2bf(p.in[I_CGQK][i]); cgqv[i] = f2bf(p.in[I_CGQV][i]); }
}

constexpr int EPL = D / 64;
constexpr int W16ROW = 20;
template <int MODE>
DEV void phase_rows(const Params& p, char* smem, int l) {
    const int tid = get_tid(), lane = tid & 63, wave = tid >> 6;
    float* W16 = (float*)smem;
    const bool need_w = (MODE == 1) || (l < DEPTH);
    if (need_w) {
        for (int i = tid; i < D * 4; i += 512) {
            const int k = i >> 2, q = i & 3;
            const float* src = (MODE == 1) ? p.in[I_RW] + ((size_t)l * D + k) * 16 + q * 4 : p.in[I_WIN] + ((size_t)l * D + k) * PROJ_W + 2176 + q * 4;
            *(f4v*)(W16 + k * W16ROW + q * 4) = *(const f4v*)src;
        }
    }
    __syncthreads();
    const float* mods = (const float*)(p.ws + WS_MODS);
    for (int t = blockIdx.x * 8 + wave; t < NT; t += gridDim.x * 8) {
        const int cnd = tok_cond(t);
        float v[EPL];
        if (MODE == 0 && l == 0) {
            const float* xr = t < NP ? p.in[I_XP] + (size_t)t * D : p.in[I_XS] + (size_t)(t - NP) * D;
#pragma unroll
            for (int j = 0; j < EPL; ++j) v[j] = xr[lane + 64 * j];
        } else if (MODE == 0) {
            const float* x1 = (const float*)(p.ws + WS_X1) + (size_t)t * D;
            const float* g2 = mods + ((size_t)(l - 1) * NCOND + cnd) * 6 * D + 5 * D;
            float f[EPL], xv[EPL], gv[EPL];
#pragma unroll
            for (int j = 0; j < EPL; ++j) { f[j] = 0.f; xv[j] = x1[lane + 64 * j]; gv[j] = g2[lane + 64 * j]; }
            const int* ts = (const int*)(p.ws + WS_TOKSLOT) + (size_t)t * 16;
            const int myslot = lane < 16 ? ts[lane] : -1;
            unsigned vm = (unsigned)__ballot(myslot >= 0);
            while (vm) {
                const int e = __builtin_ctz(vm); vm &= vm - 1u;
                const int slot = __shfl(myslot, e);
                const bf16_t* yr = (const bf16_t*)(p.ws + WS_YE) + ((size_t)e * SLOTS + slot) * D;
#pragma unroll
                for (int j = 0; j < EPL; ++j) f[j] += bf2f(yr[lane + 64 * j]);
            }
#pragma unroll
            for (int j = 0; j < EPL; ++j) v[j] = ALPHA * xv[j] + gv[j] * f[j];
        } else {
            const float* u = (const float*)(p.ws + WS_U) + (size_t)t * D;
#pragma unroll
            for (int j = 0; j < EPL; ++j) v[j] = u[lane + 64 * j];
        }
        if (!(MODE == 0 && l == 0)) {
            const int li = (MODE == 0) ? (l - 1) * 2 + 1 : l * 2;
            const float* lg = p.in[I_LNG] + (size_t)li * D; const float* lb = p.in[I_LNB] + (size_t)li * D;
            float g[EPL], bb[EPL];
#pragma unroll
            for (int j = 0; j < EPL; ++j) { g[j] = lg[lane + 64 * j]; bb[j] = lb[lane + 64 * j]; }
            float s = 0.f;
#pragma unroll
            for (int j = 0; j < EPL; ++j) s += v[j];
            const float mu = wave_sum(s) * (1.f / D);
            float q = 0.f;
#pragma unroll
            for (int j = 0; j < EPL; ++j) { const float dlt = v[j] - mu; q += dlt * dlt; }
            const float rstd = frsqrt(wave_sum(q) * (1.f / D) + EPS);
            float* dst = (MODE == 1) ? (float*)(p.ws + WS_X1) + (size_t)t * D
                       : (l == DEPTH) ? (t < NP ? p.out + O_YP + (size_t)t * D : p.out + O_YS + (size_t)(t - NP) * D) : (float*)(p.ws + WS_XBUF) + (size_t)t * D;
#pragma unroll
            for (int j = 0; j < EPL; ++j) { v[j] = (v[j] - mu) * rstd * g[j] + bb[j]; dst[lane + 64 * j] = v[j]; }
        }
        if (MODE == 1 || l < DEPTH) {
            const float* sh = mods + ((size_t)l * NCOND + cnd) * 6 * D + (MODE == 1 ? 3 * D : 0); const float* sc = sh + D;
            bf16_t* hb = (bf16_t*)(p.ws + (MODE == 1 ? WS_H2 : WS_HMOD)) + (size_t)t * D;
            {
                float s1[EPL], s0[EPL];
#pragma unroll
                for (int j = 0; j < EPL; ++j) { s1[j] = sc[lane + 64 * j]; s0[j] = sh[lane + 64 * j]; }
#pragma unroll
                for (int j = 0; j < EPL; ++j) { v[j] = v[j] * (1.f + s1[j]) + s0[j]; hb[lane + 64 * j] = f2bf(v[j]); }
            }
            CFENCE();
            float a16[16];
#pragma unroll
            for (int e = 0; e < 16; ++e) a16[e] = 0.f;
#pragma unroll
            for (int j = 0; j < EPL; ++j) {
                const float hv = v[j];
                const float* wr = W16 + (lane + 64 * j) * W16ROW;
#pragma unroll
                for (int q = 0; q < 4; ++q) { const f4v w4 = *(const f4v*)(wr + 4 * q); a16[4 * q] += hv * w4[0]; a16[4 * q + 1] += hv * w4[1]; a16[4 * q + 2] += hv * w4[2]; a16[4 * q + 3] += hv * w4[3]; }
                if (j & 1) CFENCE();
            }
            float mine = -1e30f;
#pragma unroll
            for (int e = 0; e < 16; ++e) { const float sm = wave_sum(a16[e]); if (lane == e) mine = sm; }
            if (MODE == 0) {
                if (lane < 16) ((float*)(p.ws + WS_GATES))[(size_t)t * 16 + lane] = mine + p.in[I_BGATE][l * 16 + lane];
            } else {
                float mx = mine;
                for (int m = 8; m >= 1; m >>= 1) mx = fmaxf(mx, __shfl_xor(mx, m));
                const float ex = lane < 16 ? fexp(mine - mx) : 0.f;
                float sm = ex;
                for (int m = 8; m >= 1; m >>= 1) sm += __shfl_xor(sm, m);
                if (lane < 16) ((float*)(p.ws + WS_AFF))[(size_t)t * 16 + lane] = ex / sm;
            }
        }
    }
}

template <int NPL>
DEV void topk_wave(const Params& p, int tb, int cap, int sbase, int e, int lane) {
    const float* aff = (const float*)(p.ws + WS_AFF);
    int* idx = (int*)(p.ws + WS_IDX); float* gsel = (float*)(p.ws + WS_GSEL); int* tokslot = (int*)(p.ws + WS_TOKSLOT);
    unsigned bits[NPL];
#pragma unroll
    for (int i = 0; i < NPL; ++i) bits[i] = __builtin_bit_cast(unsigned, aff[(size_t)(tb + lane + 64 * i) * 16 + e]);
    unsigned T = 0u;
    for (int b = 30; b >= 0; --b) {
        const unsigned cand = T | (1u << b);
        int cnt = 0;
#pragma unroll
        for (int i = 0; i < NPL; ++i) cnt += __popcll(__ballot(bits[i] >= cand));
        if (cnt >= cap) T = cand;
    }
    int ngt = 0;
#pragma unroll
    for (int i = 0; i < NPL; ++i) ngt += __popcll(__ballot(bits[i] > T));
    int need_eq = cap - ngt, run = 0;
    const unsigned long long lt = (1ull << lane) - 1ull;
#pragma unroll
    for (int i = 0; i < NPL; ++i) {
        const bool eq = bits[i] == T;
        const unsigned long long meq = __ballot(eq);
        const int eqrank = __popcll(meq & lt);
        const bool sel = bits[i] > T || (eq && eqrank < need_eq);
        const unsigned long long ms = __ballot(sel);
        const int t = tb + lane + 64 * i;
        if (sel) { const int slot = sbase + run + __popcll(ms & lt); idx[e * SLOTS + slot] = t; gsel[e * SLOTS + slot] = __builtin_bit_cast(float, bits[i]); tokslot[(size_t)t * 16 + e] = slot; }
        else tokslot[(size_t)t * 16 + e] = -1;
        run += __popcll(ms);
        const int neq = __popcll(meq); need_eq -= neq < need_eq ? neq : need_eq;
    }
}
DEV void phase_topk(const Params& p, char* smem) {
    (void)smem;
    const int tid = get_tid(), lane = tid & 63;
    constexpr int US = DEC_BATCH * NEXP, UP = BATCH * NEXP;
    const int gw = blockIdx.x + gridDim.x * (tid >> 6), nw = gridDim.x * 8;
    for (int u = gw; u < US + UP; u += nw) {
        if (u < US) { const int b = u / NEXP, e = u % NEXP; topk_wave<DEC_SEQ / 64>(p, NP + b * DEC_SEQ, CAP_S, BATCH * CAP_P + b * CAP_S, e, lane); }
        else { const int uu = u - US; const int b = uu / NEXP, e = uu % NEXP; topk_wave<SEQ / 64>(p, b * SEQ, CAP_P, b * CAP_P, e, lane); }
    }
}

DEV void store_head_f32(float* dst_f32, const f16v& v0, const f16v& v1, int h) {
#pragma unroll
    for (int ft = 0; ft < 2; ++ft) {
        const f16v& v = ft ? v1 : v0;
#pragma unroll
        for (int g = 0; g < 4; ++g) { f4v o; o[0] = v[4 * g]; o[1] = v[4 * g + 1]; o[2] = v[4 * g + 2]; o[3] = v[4 * g + 3]; *(f4v*)(dst_f32 + ft * 32 + 8 * g + 4 * h) = o; }
    }
}
template <int VAR>
DEV void phase_inproj(const Params& p, char* smem, int l) {
    constexpr int NJ = 22, NU = (NT / 256) * NJ;
    const int tid = get_tid(), lane = tid & 63, wave = tid >> 6, wm = wave & 3, wn = wave >> 2, h = lane >> 5, l31 = lane & 31;
    const bf16_t* hmod = (const bf16_t*)(p.ws + WS_HMOD);
    const float* rope = (const float*)(p.ws + WS_ROPE);
    constexpr int NMB = NT / 256, RPX = (NMB % 8 == 0) ? NMB / 8 : NMB;
    const UnitIter it = unit_iter(NU);
    for (int u = it.i; u < it.end; u += it.step) {
        const int mb = (u / (RPX * NJ)) * RPX + u % RPX, j = (u / RPX) % NJ;
        const int colbase = j < 17 ? 128 * j : 2192 + 128 * (j - 17);
        const unsigned ao = ((unsigned)(mb * 256 + (tid >> 3)) * D + (tid & 7) * 8) * 2;
        const unsigned bvo = (unsigned)(colbase + 4 * (tid & 31)) * 4 + (unsigned)(tid >> 5) * (PROJ_W * 4);
        const unsigned blds = (unsigned)(tid >> 5) * 320u + (unsigned)(tid & 31) * 8u;
        gemm_tile<2, VAR>(smem, make_rsrc(hmod), ao, ao + 128u * D, ao + 256u * D, ao + 384u * D, make_rsrc(p.in[I_WIN] + (size_t)l * D * PROJ_W), bvo, blds, PROJ_W * 4, D, [&](f16v (&acc)[2][2]) {
            int lane_e = lane; VGPR_PIN(lane_e); const int lane = lane_e, l31 = lane_e & 31, h = lane_e >> 5; (void)l31; (void)h;
            const int cb = colbase + wn * 64;
            char* stg = wave_stage_ptr(smem, wave);
            const int t0 = mb * 256 + wm * 64;
            const bool isP = t0 < NP;
            bf16_t* dstb; size_t dstride;
            int f32out = 0, fhead = 0, fheads = 0; size_t fbase = 0;
            int mode = 0;
            if (cb < 1152) {
                const int seg = cb / 384, head = (cb % 384) / 64;
                dstb = (bf16_t*)(p.ws + (seg == 0 ? WS_NAQ : seg == 1 ? WS_NAK : WS_NAV)) + (size_t)t0 * 384 + head * 64; dstride = 384;
                if (seg >= 1 && isP) { f32out = 1; fbase = seg == 1 ? O_NAK : O_NAV; fhead = head; fheads = NAH; }
            } else if (cb < 2176) {
                const int seg = (cb - 1152) / 256, head = ((cb - 1152) % 256) / 64;
                dstb = (bf16_t*)(p.ws + (seg == 0 ? WS_MLQ : seg == 1 ? WS_MLK : seg == 2 ? WS_MLV : WS_MLO)) + (size_t)t0 * 256 + head * 64; dstride = 256;
                mode = seg == 1 ? 1 : 0;
            } else {
                const int c2 = cb - 2192;
                if (c2 < 384) { dstb = (bf16_t*)(p.ws + WS_GQQ) + (size_t)t0 * 384 + (c2 / 64) * 64; dstride = 384; mode = 2; }
                else if (c2 < 512) { const int head = (c2 - 384) / 64; dstb = (bf16_t*)(p.ws + WS_GQK) + (size_t)t0 * 128 + head * 64; dstride = 128; mode = 3;
                                     if (isP) { f32out = 1; fbase = O_GQK; fhead = head; fheads = GQKV; } }
                else { const int head = (c2 - 512) / 64; dstb = (bf16_t*)(p.ws + WS_GQV) + (size_t)t0 * 128 + head * 64; dstride = 128;
                       if (isP) { f32out = 1; fbase = O_GQV; fhead = head; fheads = GQKV; } }
            }
#pragma unroll
            for (int tt = 0; tt < 2; ++tt) {
                const int t = t0 + tt * 32 + l31;
                f16v v0 = acc[0][tt], v1 = acc[1][tt];
                if (mode == 1) { v0 *= ATT_SCALE; v1 *= ATT_SCALE; }
                if (mode >= 2) {
                    float ss = 0.f;
#pragma unroll
                    for (int r = 0; r < 16; ++r) ss += v0[r] * v0[r] + v1[r] * v1[r];
                    ss += __shfl_xor(ss, 32);
                    const float rn = frsqrt(ss * (1.f / 64.f) + EPS);
                    const float* gq = p.in[I_QKG] + ((size_t)l * 2 + (mode == 2 ? 0 : 1)) * 64;
#pragma unroll
                    for (int r = 0; r < 16; ++r) {
                        const int d = (r & 3) + 8 * (r >> 2) + 4 * h;
                        v0[r] *= rn * gq[d]; v1[r] *= rn * gq[32 + d];
                    }
                }
                if (f32out) { const int bP = t / SEQ, sP = t % SEQ; store_head_f32(p.out + fbase + ((((size_t)bP * DEPTH + l) * SEQ + sP) * fheads + fhead) * 64, v0, v1, h); }
                if (mode >= 2 && !isP) {
                    const int pos = (t - NP) % DEC_SEQ, prow = pos / GRIDW, pcol = pos % GRIDW;
#pragma unroll
                    for (int rr = 0; rr < 8; ++rr) {
                        const int fi = (rr & 3) + 8 * ((rr >> 2) & 1) + 4 * h;
                        const float c0 = rope[(prow * 16 + fi) * 2], s0 = rope[(prow * 16 + fi) * 2 + 1];
                        const float c1 = rope[(pcol * 16 + fi) * 2], s1 = rope[(pcol * 16 + fi) * 2 + 1];
                        const float a_lo = v0[rr], a_hi = v0[rr + 8]; v0[rr] = a_lo * c0 - a_hi * s0; v0[rr + 8] = a_hi * c0 + a_lo * s0;
                        const float b_lo = v1[rr], b_hi = v1[rr + 8]; v1[rr] = b_lo * c1 - b_hi * s1; v1[rr + 8] = b_hi * c1 + b_lo * s1;
                    }
                }
                stage64_write_bf16(stg, tt, v0, v1, l31, h);
            }
            stage64_flush_bf16(stg, dstb, dstride, lane);
        });
    }
}

template <int VAR>
DEV void phase_outproj(const Params& p, char* smem, int l) {
    constexpr int NC = D / 128, NU = (NT / 256) * NC;
    const int tid = get_tid(), lane = tid & 63, wave = tid >> 6, wm = wave & 3, wn = wave >> 2, h = lane >> 5, l31 = lane & 31;
    const bf16_t* mixed = (const bf16_t*)(p.ws + WS_MIXED);
    const float* mods = (const float*)(p.ws + WS_MODS);
    float* U = (float*)(p.ws + WS_U);
    constexpr int NMB = NT / 256, RPX = (NMB % 8 == 0) ? NMB / 8 : NMB;
    const UnitIter it = unit_iter(NU);
    for (int u = it.i; u < it.end; u += it.step) {
        const int mb = (u / (RPX * NC)) * RPX + u % RPX, cbk = (u / RPX) % NC;
        const unsigned ao = ((unsigned)(mb * 256 + (tid >> 3)) * MIXW + (tid & 7) * 8) * 2;
        const unsigned bvo = (unsigned)(cbk * 128 + 4 * (tid & 31)) * 4 + (unsigned)(tid >> 5) * (D * 4);
        const unsigned blds = (unsigned)(tid >> 5) * 320u + (unsigned)(tid & 31) * 8u;
        gemm_tile<2, VAR>(smem, make_rsrc(mixed), ao, ao + 128u * MIXW, ao + 256u * MIXW, ao + 384u * MIXW, make_rsrc(p.in[I_WOUT] + (size_t)l * MIXW * D), bvo, blds, D * 4, MIXW, [&](f16v (&acc)[2][2]) {
            int lane_e = lane; VGPR_PIN(lane_e); const int lane = lane_e, l31 = lane_e & 31, h = lane_e >> 5; (void)l31; (void)h;
            char* stg = wave_stage_ptr(smem, wave);
            const int t0 = mb * 256 + wm * 64;
            const float* g1 = mods + ((size_t)l * NCOND + tok_cond(t0)) * 6 * D + 2 * D;
#pragma unroll
            for (int ft = 0; ft < 2; ++ft) {
#pragma unroll
                for (int tt = 0; tt < 2; ++tt)
#pragma unroll
                    for (int g = 0; g < 4; ++g) { f4v o; o[0] = acc[ft][tt][4 * g]; o[1] = acc[ft][tt][4 * g + 1]; o[2] = acc[ft][tt][4 * g + 2]; o[3] = acc[ft][tt][4 * g + 3];
                        *(f4v*)(stg + (tt * 32 + l31) * LROW + (8 * g + 4 * h) * 4) = o; }
                WAVE_SYNC();
                const int f0 = cbk * 128 + wn * 64 + ft * 32 + (lane & 7) * 4;
                const f4v gv = *(const f4v*)(g1 + f0);
#pragma unroll
                for (int i = 0; i < 8; ++i) {
                    const int r = (lane >> 3) + 8 * i, t = t0 + r;
                    const f4v a = *(const f4v*)(stg + r * LROW + (lane & 7) * 16);
                    const float* xr = (l == 0) ? (t < NP ? p.in[I_XP] + (size_t)t * D : p.in[I_XS] + (size_t)(t - NP) * D) : (const float*)(p.ws + WS_XBUF) + (size_t)t * D;
                    const f4v xv = *(const f4v*)(xr + f0);
                    f4v o;
#pragma unroll
                    for (int q = 0; q < 4; ++q) o[q] = ALPHA * xv[q] + gv[q] * a[q];
                    *(f4v*)(U + (size_t)t * D + f0) = o;
                }
                WAVE_SYNC();
            }
        });
    }
}

template <int VAR>
DEV void phase_gateup(const Params& p, char* smem, int l) {
    constexpr int NRB = SLOTS / 256, NCB = EH / 128, NU = NEXP * NCB * NRB;
    const int tid = get_tid(), lane = tid & 63, wave = tid >> 6, wm = wave & 3, wn = wave >> 2, h = lane >> 5, l31 = lane & 31;
    const bf16_t* h2 = (const bf16_t*)(p.ws + WS_H2);
    const int* idx = (const int*)(p.ws + WS_IDX);
    bf16_t* hid = (bf16_t*)(p.ws + WS_HID);
    constexpr int TPC = NU / 8;
#ifdef GU_FORCE_HALF
    constexpr int HT = GU_FORCE_HALF;
#else
    constexpr int HT = (NU % 8 == 0 && TPC % 32 == 16) ? 16 : 0;
#endif
    constexpr int UPC = TPC + HT;
    const bool chunked = (gridDim.x & 7) == 0 && (NU & 7) == 0;
    const UnitIter it = unit_iter(chunked ? 8 * UPC : NU);
    for (int uu = it.i; uu < it.end; uu += it.step) {
        int u = uu, half = -1;
        if (chunked) { const int x = uu / UPC, v = uu % UPC; if (v < TPC - HT) u = x * TPC + v; else { const int hv = v - (TPC - HT); u = x * TPC + (TPC - HT) + (hv >> 1); half = hv & 1; } }
        const int rb = u % NRB, cbk = (u / NRB) % NCB, e = u / (NRB * NCB);
        const int* ip = idx + e * SLOTS + rb * 256 + (tid >> 3);
        const unsigned a0 = ((unsigned)ip[0] * D + (tid & 7) * 8) * 2, a1 = ((unsigned)ip[64] * D + (tid & 7) * 8) * 2;
        const unsigned a2 = ((unsigned)ip[128] * D + (tid & 7) * 8) * 2, a3 = ((unsigned)ip[192] * D + (tid & 7) * 8) * 2;
#ifdef EMU
        const int bw = tid >> 6;
#else
        const int bw = __builtin_amdgcn_readfirstlane(tid >> 6);
#endif
        const int is_up = bw & 1;
        const float* wmat = (is_up ? p.in[I_WU] : p.in[I_WG]) + ((size_t)l * NEXP + e) * D * EH;
        if (half < 0) {
        const int bkr = 2 * (bw >> 1) + ((tid >> 5) & 1), hc = 4 * (tid & 31);
        const int ncol = (hc >> 6) * 128 + (2 * ((hc >> 5) & 1) + is_up) * 32 + (hc & 31);
        const unsigned bvo = (unsigned)(cbk * 128 + hc) * 4 + (unsigned)bkr * (EH * 4);
        const unsigned blds = (unsigned)bkr * 576u + (unsigned)ncol * 2u;
        gemm_tile<4, VAR>(smem, make_rsrc(h2), a0, a1, a2, a3, make_rsrc(wmat), bvo, blds, EH * 4, D, [&](f16v (&acc)[4][2]) {
            int lane_e = lane; VGPR_PIN(lane_e); const int lane = lane_e, l31 = lane_e & 31, h = lane_e >> 5; (void)l31; (void)h;
            char* stg = wave_stage_ptr(smem, wave);
#pragma unroll
            for (int tt = 0; tt < 2; ++tt)
#pragma unroll
                for (int pr = 0; pr < 2; ++pr)
#pragma unroll
                    for (int g = 0; g < 4; ++g) {
                        float o[4];
#pragma unroll
                        for (int q = 0; q < 4; ++q) o[q] = siluf_(acc[2 * pr][tt][4 * g + q]) * acc[2 * pr + 1][tt][4 * g + q];
                        stage64_write4(stg, tt * 32 + l31, pr * 32 + 8 * g + 4 * h, o[0], o[1], o[2], o[3]);
                    }
            stage64_flush_bf16(stg, hid + ((size_t)e * SLOTS + rb * 256 + wm * 64) * EH + cbk * 128 + wn * 64, EH, lane);
        });
        } else {
        const int bkr = 4 * (bw >> 1) + ((tid >> 4) & 3), hc = 4 * (tid & 15);
        const int ncol = (hc >> 5) * 64 + is_up * 32 + (hc & 31);
        const unsigned bvo = (unsigned)(cbk * 128 + half * 64 + hc) * 4 + (unsigned)bkr * (EH * 4);
        const unsigned blds = (unsigned)bkr * 320u + (unsigned)ncol * 2u;
        gemm_tile<2, VAR>(smem, make_rsrc(h2), a0, a1, a2, a3, make_rsrc(wmat), bvo, blds, EH * 4, D, [&](f16v (&acc)[2][2]) {
            int lane_e = lane; VGPR_PIN(lane_e); const int lane = lane_e, l31 = lane_e & 31, h = lane_e >> 5; (void)l31; (void)h;
            char* stg = wave_stage_ptr(smem, wave);
#pragma unroll
            for (int tt = 0; tt < 2; ++tt)
#pragma unroll
                for (int g = 0; g < 4; ++g) {
                    float o[4];
#pragma unroll
                    for (int q = 0; q < 4; ++q) o[q] = siluf_(acc[0][tt][4 * g + q]) * acc[1][tt][4 * g + q];
                    stage64_write4(stg, tt * 32 + l31, 8 * g + 4 * h, o[0], o[1], o[2], o[3]);
                }
            WAVE_SYNC();
            bf16_t* dst0 = hid + ((size_t)e * SLOTS + rb * 256 + wm * 64) * EH + cbk * 128 + half * 64 + wn * 32;
#pragma unroll
            for (int i = 0; i < 4; ++i) { const int r = (lane >> 2) + 16 * i, c = lane & 3; const u4v v = *(const u4v*)(stg + r * LROW + c * 16); *(u4v*)(dst0 + (size_t)r * EH + c * 8) = v; }
            WAVE_SYNC();
        });
        }
    }
}

template <int VAR>
DEV void phase_down(const Params& p, char* smem, int l) {
    constexpr int NRB = SLOTS / 256, NCB = D / 256, NU = NEXP * NCB * NRB;
    const int tid = get_tid(), lane = tid & 63, wave = tid >> 6, wm = wave & 3, wn = wave >> 2, h = lane >> 5, l31 = lane & 31;
    const bf16_t* hid = (const bf16_t*)(p.ws + WS_HID);
    const float* gsel = (const float*)(p.ws + WS_GSEL);
    bf16_t* ye = (bf16_t*)(p.ws + WS_YE);
    const UnitIter it = unit_iter(NU);
    for (int u = it.i; u < it.end; u += it.step) {
        const int rb = u % NRB, cbk = (u / NRB) % NCB, e = u / (NRB * NCB);
        const unsigned ao = ((unsigned)(rb * 256 + (tid >> 3)) * EH + (tid & 7) * 8) * 2;
        const unsigned bvo = (unsigned)(cbk * 256 + 4 * (tid & 63)) * 4 + (unsigned)(tid >> 6) * (D * 4);
        const unsigned blds = (unsigned)(tid >> 6) * 576u + (unsigned)(tid & 63) * 8u;
        gemm_tile<4, VAR>(smem, make_rsrc(hid + (size_t)e * SLOTS * EH), ao, ao + 128u * EH, ao + 256u * EH, ao + 384u * EH, make_rsrc(p.in[I_WD] + ((size_t)l * NEXP + e) * EH * D), bvo, blds, D * 4, EH, [&](f16v (&acc)[4][2]) {
            int lane_e = lane; VGPR_PIN(lane_e); const int lane = lane_e, l31 = lane_e & 31, h = lane_e >> 5; (void)l31; (void)h;
            char* stg = wave_stage_ptr(smem, wave);
            const float gs0 = gsel[e * SLOTS + rb * 256 + wm * 64 + l31], gs1 = gsel[e * SLOTS + rb * 256 + wm * 64 + 32 + l31];
#pragma unroll
            for (int hb = 0; hb < 2; ++hb) {
#pragma unroll
                for (int tt = 0; tt < 2; ++tt) {
                    const float gs = tt ? gs1 : gs0;
#pragma unroll
                    for (int f2 = 0; f2 < 2; ++f2)
#pragma unroll
                        for (int g = 0; g < 4; ++g) { const f16v& a = acc[2 * hb + f2][tt]; stage64_write4(stg, tt * 32 + l31, f2 * 32 + 8 * g + 4 * h, a[4 * g] * gs, a[4 * g + 1] * gs, a[4 * g + 2] * gs, a[4 * g + 3] * gs); }
                }
                stage64_flush_bf16(stg, ye + ((size_t)e * SLOTS + rb * 256 + wm * 64) * D + cbk * 256 + wn * 128 + hb * 64, D, lane);
            }
        });
    }
}

struct AttnDesc {
    const bf16_t* q; int qstride;
    int ntiles, n0;
    const bf16_t *k0, *v0; int stride0;
    const bf16_t *k1, *v1; int stride1;
    int na;
    int r0, rlo;
    const float* rpb;
    bf16_t* out; int ostride;
    float* part;
};
constexpr int ATT_TILE = 64 * LROW;
DEV int na_row_start(int r) { int s = r - KR / 2; s = s < 0 ? 0 : s; return s > ROWS - KR ? ROWS - KR : s; }
DEV void attn_unit(char* smem, const AttnDesc& d) {
    const int tid = get_tid(), lane = tid & 63, wave = tid >> 6, h = lane >> 5, l31 = lane & 31;
    char* Ks = smem; char* Vs = smem + 2 * ATT_TILE; float* rpbS = (float*)(smem + 4 * ATT_TILE);
    if (d.na) { for (int i = tid; i < 15 * 31; i += 512) rpbS[i] = d.rpb[i] * 1.4426950408889634f; }
    const bf16_t* qp = d.q + (size_t)(wave * 32 + l31) * d.qstride + h * 8;
    s8v qf[4];
#pragma unroll
    for (int s = 0; s < 4; ++s) qf[s] = *(const s8v*)(qp + 16 * s);
    float m_run = -1e30f, l_run = 0.f;
    f16v o[2]; o[0] = f16zero(); o[1] = f16zero();
    const int srow = tid >> 3, sch = tid & 7;
    u4v kreg, vreg;
    auto gload = [&](int t) {
        const bf16_t *kp, *vp;
        if (t < d.n0) { const size_t off = (size_t)(t * 64 + srow) * d.stride0 + sch * 8; kp = d.k0 + off; vp = d.v0 + off; }
        else { const size_t off = (size_t)((t - d.n0) * 64 + srow) * d.stride1 + sch * 8; kp = d.k1 + off; vp = d.v1 + off; }
        kreg = *(const u4v*)kp; vreg = *(const u4v*)vp;
    };
    auto lstore = [&](int buf) { *(u4v*)(Ks + buf * ATT_TILE + srow * LROW + sch * 16) = kreg; *(u4v*)(Vs + buf * ATT_TILE + srow * LROW + sch * 16) = vreg; };
    const int qr = d.r0 + (wave >> 1), qw = (wave & 1) * 32 + l31;
    const int rs = na_row_start(qr);
    int cs = qw - KC / 2; cs = cs < 0 ? 0 : (cs > GRIDW - KC ? GRIDW - KC : cs);
    gload(0); lstore(0);
    __syncthreads();
    for (int t = 0; t < d.ntiles; ++t) {
        const int buf = t & 1;
        if (t + 1 < d.ntiles) gload(t + 1);
        const bool local = d.na && t >= d.n0;
        const int kr = d.rlo + (t - d.n0);
        const bool active = !local || (kr >= rs && kr < rs + KR);
        if (active) {
            const char* kb = Ks + buf * ATT_TILE + l31 * LROW + h * 16;
            f16v sa[2];
#pragma unroll
            for (int kt = 0; kt < 2; ++kt) {
                sa[kt] = f16zero();
#pragma unroll
                for (int s = 0; s < 4; ++s) { const s8v kf = *(const s8v*)(kb + kt * 32 * LROW + s * 32); sa[kt] = mfma32(kf, qf[s], sa[kt]); }
            }
            constexpr float C2 = ATT_SCALE * 1.4426950408889634f;
            float mx = -1e30f;
            if (local) {
#pragma unroll
                for (int kt = 0; kt < 2; ++kt)
#pragma unroll
                    for (int r = 0; r < 16; ++r) {
                        const int kc = kt * 32 + (r & 3) + 8 * (r >> 2) + 4 * h;
                        const bool inw = kc >= cs && kc < cs + KC;
                        const int bi = (kr - qr + 7) * 31 + (kc - qw + 15);
                        const float v = inw ? sa[kt][r] * C2 + rpbS[inw ? bi : 0] : -1e30f;
                        sa[kt][r] = v; mx = fmaxf(mx, v);
                    }
            } else {
#pragma unroll
                for (int kt = 0; kt < 2; ++kt)
#pragma unroll
                    for (int r = 0; r < 16; ++r) mx = fmaxf(mx, sa[kt][r]);
                mx *= C2;
            }
            mx = fmaxf(mx, __shfl_xor(mx, 32));
            if (__ballot(mx > m_run) != 0ull) {
                const float m_new = fmaxf(m_run, mx);
                const float alpha = fexp2(m_run - m_new);
                l_run *= alpha; m_run = m_new;
                o[0] *= alpha; o[1] *= alpha;
            }
            float ps = 0.f;
            if (local) {
#pragma unroll
                for (int kt = 0; kt < 2; ++kt)
#pragma unroll
                    for (int r = 0; r < 16; ++r) { const float pv = fexp2(sa[kt][r] - m_run); sa[kt][r] = pv; ps += pv; }
            } else {
#pragma unroll
                for (int kt = 0; kt < 2; ++kt)
#pragma unroll
                    for (int r = 0; r < 16; ++r) { const float pv = fexp2(sa[kt][r] * C2 - m_run); sa[kt][r] = pv; ps += pv; }
            }
            l_run += ps;
            const char* vb = Vs + buf * ATT_TILE + (4 * h + ((lane & 15) >> 2)) * LROW + (((lane >> 4) & 1) * 16 + 4 * (lane & 3)) * 2;
#pragma unroll
            for (int ks = 0; ks < 4; ++ks) {
                const int kt = ks >> 1, rb = 8 * (ks & 1);
                u4v pk; pk[0] = pack2(sa[kt][rb], sa[kt][rb + 1]); pk[1] = pack2(sa[kt][rb + 2], sa[kt][rb + 3]);
                pk[2] = pack2(sa[kt][rb + 4], sa[kt][rb + 5]); pk[3] = pack2(sa[kt][rb + 6], sa[kt][rb + 7]);
                const s8v pf = __builtin_bit_cast(s8v, pk);
                const char* vk = vb + (kt * 32 + 16 * (ks & 1)) * LROW;
#pragma unroll
                for (int dt = 0; dt < 2; ++dt) {
                    const s4v lo = lds_tr16(vk + dt * 64), hi = lds_tr16(vk + 8 * LROW + dt * 64);
                    s8v vf; vf[0] = lo[0]; vf[1] = lo[1]; vf[2] = lo[2]; vf[3] = lo[3]; vf[4] = hi[0]; vf[5] = hi[1]; vf[6] = hi[2]; vf[7] = hi[3];
                    o[dt] = mfma32(vf, pf, o[dt]);
                }
            }
        }
        if (t + 1 < d.ntiles) lstore(buf ^ 1);
        __syncthreads();
    }
    const float l_tot = l_run + __shfl_xor(l_run, 32);
    const int qrow = wave * 32 + l31;
    if (d.part) {
        float* po = d.part + (size_t)qrow * 64;
#pragma unroll
        for (int dt = 0; dt < 2; ++dt)
#pragma unroll
            for (int g = 0; g < 4; ++g) { f4v v; v[0] = o[dt][4 * g]; v[1] = o[dt][4 * g + 1]; v[2] = o[dt][4 * g + 2]; v[3] = o[dt][4 * g + 3]; *(f4v*)(po + dt * 32 + 8 * g + 4 * h) = v; }
        if (h == 0) { d.part[256 * 64 + qrow] = m_run; d.part[256 * 64 + 256 + qrow] = l_tot; }
    } else {
        const float inv = 1.f / l_tot;
        bf16_t* po = d.out + (size_t)qrow * d.ostride;
#pragma unroll
        for (int dt = 0; dt < 2; ++dt)
#pragma unroll
            for (int g = 0; g < 4; ++g) {
                u2v pk; pk[0] = pack2(o[dt][4 * g] * inv, o[dt][4 * g + 1] * inv); pk[1] = pack2(o[dt][4 * g + 2] * inv, o[dt][4 * g + 3] * inv);
                *(u2v*)(po + dt * 32 + 8 * g + 4 * h) = pk;
            }
    }
}

DEV int ml_sidx(int grp, int b, int head, int c) { return grp == 0 ? ((b * MLH + head) * NCH_P + c) : BATCH * MLH * NCH_P + ((b * MLH + head) * NCH_S + c); }
DEV float lane_prefix_sum(float v, int lane) { for (int dlt = 1; dlt < 64; dlt <<= 1) { const float o = __shfl(v, lane - dlt); if (lane >= dlt) v += o; } return v; }
DEV float lane_prefix_max(float v, int lane) { for (int dlt = 1; dlt < 64; dlt <<= 1) { const float o = __shfl(v, lane - dlt); if (lane >= dlt) v = fmaxf(v, o); } return v; }

DEV void mlstm_summary_unit(const Params& p, char* smem, int grp, int b, int head, int c) {
    const int tid = get_tid(), lane = tid & 63, wave = tid >> 6, h = lane >> 5, l31 = lane & 31;
    char* KT = smem;
    char* VT = smem + 2 * ATT_TILE;
    float* wsS = (float*)(smem + 3 * ATT_TILE);
    float* scal = wsS + 128;
    const int tb = (grp == 0 ? b * SEQ : NP + b * DEC_SEQ) + c * 64;
    const float* gates = (const float*)(p.ws + WS_GATES);
    if (wave == 0) {
        const float* gr = gates + (size_t)(tb + lane) * 16;
        const float i_f = gr[head], lf_f = logsigmoidf_(gr[4 + head]), i_b = gr[8 + head], lf_b = logsigmoidf_(gr[12 + head]);
        const float pf = lane_prefix_sum(lf_f, lane), pb = lane_prefix_sum(lf_b, lane);
        const float tot_f = __shfl(pf, 63), tot_b = __shfl(pb, 63);
        const float g_f = (tot_f - pf) + i_f, g_b = (pb - lf_b) + i_b;
        const float G_f = wave_max(g_f), G_b = wave_max(g_b);
        wsS[lane] = fexp(g_f - G_f); wsS[64 + lane] = fexp(g_b - G_b);
        if (lane == 0) { scal[0] = tot_f; scal[1] = tot_b; scal[2] = G_f; scal[3] = G_b; }
    }
    __syncthreads();
    {
        const int tau = tid >> 3, ch = tid & 7;
        const u4v kv = *(const u4v*)((const bf16_t*)(p.ws + WS_MLK) + (size_t)(tb + tau) * 256 + head * 64 + ch * 8);
        const u4v vv = *(const u4v*)((const bf16_t*)(p.ws + WS_MLV) + (size_t)(tb + tau) * 256 + head * 64 + ch * 8);
        const float wf = wsS[tau], wb = wsS[64 + tau];
#pragma unroll
        for (int j = 0; j < 8; ++j) {
            const bf16_t kb = (bf16_t)(kv[j >> 1] >> (16 * (j & 1))), vb = (bf16_t)(vv[j >> 1] >> (16 * (j & 1)));
            const int dim = ch * 8 + j; const float kf = bf2f(kb);
            *(bf16_t*)(KT + dim * LROW + tau * 2) = f2bf(kf * wf);
            *(bf16_t*)(KT + ATT_TILE + dim * LROW + tau * 2) = f2bf(kf * wb);
            *(bf16_t*)(VT + dim * LROW + tau * 2) = vb;
        }
    }
    __syncthreads();
    float* sum = (float*)(p.ws + WS_MLSUM);
    const int sidx = ml_sidx(grp, b, head, c);
    {
        const int dir = wave >> 2, mi = (wave >> 1) & 1, ni = wave & 1;
        f16v acc = f16zero();
#pragma unroll
        for (int s = 0; s < 4; ++s) {
            const s8v af = *(const s8v*)(KT + dir * ATT_TILE + (mi * 32 + l31) * LROW + (16 * s + 8 * h) * 2);
            const s8v bf = *(const s8v*)(VT + (ni * 32 + l31) * LROW + (16 * s + 8 * h) * 2);
            acc = mfma32(af, bf, acc);
        }
        float* U = sum + (size_t)(sidx * 2 + dir) * MLSUM_STRIDE;
#pragma unroll
        for (int r = 0; r < 16; ++r) U[(mi * 32 + (r & 3) + 8 * (r >> 2) + 4 * h) * 64 + ni * 32 + l31] = acc[r];
    }
    if (tid < 128) {
        const int dir = tid >> 6, kd = tid & 63;
        float s = 0.f;
        for (int tau = 0; tau < 64; ++tau) s += bf2f(*(const bf16_t*)(KT + dir * ATT_TILE + kd * LROW + tau * 2));
        float* E = sum + (size_t)(sidx * 2 + dir) * MLSUM_STRIDE;
        E[4096 + kd] = s;
        if (kd == 0) { E[4160] = scal[dir]; E[4161] = scal[2 + dir]; }
    }
    __syncthreads();
}

DEV void mlstm_output_unit(const Params& p, char* smem, int l, int grp, int b, int head, int c) {
    const int tid = get_tid(), lane = tid & 63, wave = tid >> 6, h = lane >> 5, l31 = lane & 31;
    const int nc = grp ? NCH_S : NCH_P;
    char* Qs = smem;
    char* Ks = smem + 2 * ATT_TILE;
    char* VT = smem + 4 * ATT_TILE;
    char* CT = smem + 6 * ATT_TILE;
    char* QK = smem + 8 * ATT_TILE;
    float* hS = (float*)(smem + 10 * ATT_TILE);
    float* vec = hS + 2 * 64 * 68;
    float* aS = vec; float* MjS = vec + 128; float* bS = vec + 256; float* nS = vec + 384; float* denp = vec + 512; float* qnS = vec + 768; float* scal = vec + 896;
    const int tb = (grp == 0 ? b * SEQ : NP + b * DEC_SEQ) + c * 64;
    const float* sum = (const float*)(p.ws + WS_MLSUM);
    const size_t qoff = (size_t)(tb + (tid >> 3)) * 256 + head * 64 + (tid & 7) * 8;
    const u4v q_r = *(const u4v*)((const bf16_t*)(p.ws + WS_MLQ) + qoff);
    const u4v k_r = *(const u4v*)((const bf16_t*)(p.ws + WS_MLK) + qoff);
    const u4v v_r = *(const u4v*)((const bf16_t*)(p.ws + WS_MLV) + qoff);
    const u4v o_r = *(const u4v*)((const bf16_t*)(p.ws + WS_MLO) + qoff);
    float g_i = 0.f, g_f = 0.f;
    if (wave < 2) { const float* gr = (const float*)(p.ws + WS_GATES) + (size_t)(tb + (wave ? 63 - lane : lane)) * 16; g_i = gr[wave * 8 + head]; g_f = gr[wave * 8 + 4 + head]; }
#pragma unroll
    for (int dir = 0; dir < 2; ++dir) {
        float C[8], nst = 0.f, m;
        if (grp == 0) {
#pragma unroll
            for (int i = 0; i < 8; ++i) C[i] = 0.f;
            m = 0.f;
        } else {
            const size_t sb = (((size_t)b * DEPTH + l) * 2 + dir) * MLH + head;
#pragma unroll
            for (int i = 0; i < 8; ++i) C[i] = p.in[I_SC][sb * 4096 + tid + 512 * i];
            if (tid < 64) nst = p.in[I_SN][sb * 64 + tid];
            m = p.in[I_SM][sb];
        }
        const int nsteps = dir == 0 ? c : nc - 1 - c;
        const bool fin = (grp == 0) && (dir == 0 ? c == nc - 1 : c == 0);
        {
            float A = 0.f, G = -1e30f;
            if (lane < nsteps) { const float* E = sum + (size_t)(ml_sidx(grp, b, head, dir == 0 ? lane : nc - 1 - lane) * 2 + dir) * MLSUM_STRIDE; A = E[4160]; G = E[4161]; }
            const float P = lane_prefix_sum(A, lane);
            const float T = __shfl(P, 63);
            const float ev = lane < nsteps ? G + (T - P) : -1e30f;
            const float mc = fmaxf(m + T, wave_max(ev));
            const float coef = lane < nsteps ? fexp(ev - mc) : 0.f;
            const float coef0 = fexp(m + T - mc);
#pragma unroll
            for (int i = 0; i < 8; ++i) C[i] *= coef0;
            nst *= coef0;
#pragma unroll 4
            for (int st = 0; st < nsteps; ++st) {
                const float* E = sum + (size_t)(ml_sidx(grp, b, head, dir == 0 ? st : nc - 1 - st) * 2 + dir) * MLSUM_STRIDE;
                const float cf = __shfl(coef, st);
#pragma unroll
                for (int i = 0; i < 8; ++i) C[i] += cf * E[tid + 512 * i];
                if (tid < 64) nst += cf * E[4096 + tid];
            }
            m = mc;
        }
#pragma unroll
        for (int i = 0; i < 8; ++i) { const int e = tid + 512 * i; *(bf16_t*)(CT + dir * ATT_TILE + (e & 63) * LROW + (e >> 6) * 2) = f2bf(C[i]); }
        if (tid < 64) nS[dir * 64 + tid] = nst;
        if (tid == 0) scal[dir] = m;
        if (fin) {
            const float* E = sum + (size_t)(ml_sidx(grp, b, head, c) * 2 + dir) * MLSUM_STRIDE;
            const float A = E[4160], G = E[4161];
            const float m_new = fmaxf(A + m, G);
            const float sc = fexp(A + m - m_new), su = fexp(G - m_new);
            const size_t ob = (((size_t)b * DEPTH + l) * 2 + dir) * MLH + head;
#pragma unroll
            for (int i = 0; i < 8; ++i) p.out[O_MC + ob * 4096 + tid + 512 * i] = sc * C[i] + su * E[tid + 512 * i];
            if (tid < 64) p.out[O_MN + ob * 64 + tid] = sc * nst + su * E[4096 + tid];
            if (tid == 0) p.out[O_MM + ob] = m_new;
        }
    }
    {
        const int row = tid >> 3, ch = tid & 7;
#pragma unroll
        for (int dir = 0; dir < 2; ++dir) {
            const int pr = dir ? 63 - row : row;
            *(u4v*)(Qs + dir * ATT_TILE + pr * LROW + ch * 16) = q_r;
            *(u4v*)(Ks + dir * ATT_TILE + pr * LROW + ch * 16) = k_r;
#pragma unroll
            for (int j = 0; j < 8; ++j) *(bf16_t*)(VT + dir * ATT_TILE + (ch * 8 + j) * LROW + pr * 2) = (bf16_t)(v_r[j >> 1] >> (16 * (j & 1)));
        }
    }
    __syncthreads();
    if (wave < 2) {
        const int dir = wave;
        const float ig = g_i, lf = logsigmoidf_(g_f);
        const float bj = lane_prefix_sum(lf, lane);
        const float a = ig - bj;
        const float Pj = lane_prefix_max(a, lane);
        aS[dir * 64 + lane] = a; bS[dir * 64 + lane] = bj; MjS[dir * 64 + lane] = fmaxf(scal[dir], Pj);
    } else if (wave < 4) {
        const int dir = wave - 2;
        float s = 0.f;
        for (int k = 0; k < 64; ++k) s += bf2f(*(const bf16_t*)(Qs + dir * ATT_TILE + lane * LROW + k * 2)) * nS[dir * 64 + k];
        qnS[dir * 64 + lane] = s;
    }
    __syncthreads();
    const int dir = wave >> 2, rt = (wave >> 1) & 1, jt = wave & 1;
    const int j = jt * 32 + l31;
    const float Mj = MjS[dir * 64 + j];
    {
        f16v acc = f16zero();
#pragma unroll
        for (int s4 = 0; s4 < 4; ++s4) {
            const s8v af = *(const s8v*)(Ks + dir * ATT_TILE + (rt * 32 + l31) * LROW + (16 * s4 + 8 * h) * 2);
            const s8v bf = *(const s8v*)(Qs + dir * ATT_TILE + j * LROW + (16 * s4 + 8 * h) * 2);
            acc = mfma32(af, bf, acc);
        }
        float dsum = 0.f;
#pragma unroll
        for (int g = 0; g < 4; ++g) {
            float o[4];
#pragma unroll
            for (int q = 0; q < 4; ++q) {
                const int s = rt * 32 + 8 * g + 4 * h + q;
                const float w = s <= j ? fexp(aS[dir * 64 + s] - Mj) : 0.f;
                o[q] = acc[4 * g + q] * w; dsum += o[q];
            }
            u2v pk; pk[0] = pack2(o[0], o[1]); pk[1] = pack2(o[2], o[3]);
            *(u2v*)(QK + dir * ATT_TILE + j * LROW + (rt * 32 + 8 * g + 4 * h) * 2) = pk;
        }
        dsum += __shfl_xor(dsum, 32);
        if (h == 0) denp[(dir * 2 + rt) * 64 + j] = dsum;
    }
    __syncthreads();
    {
        const float mst = scal[dir];
        const float decay = fexp(mst - Mj);
        f16v acc = f16zero();
#pragma unroll
        for (int s4 = 0; s4 < 4; ++s4) {
            const s8v af = *(const s8v*)(CT + dir * ATT_TILE + (rt * 32 + l31) * LROW + (16 * s4 + 8 * h) * 2);
            const s8v bf = *(const s8v*)(Qs + dir * ATT_TILE + j * LROW + (16 * s4 + 8 * h) * 2);
            acc = mfma32(af, bf, acc);
        }
        acc *= decay;
#pragma unroll
        for (int s4 = 0; s4 < 4; ++s4) {
            const s8v af = *(const s8v*)(VT + dir * ATT_TILE + (rt * 32 + l31) * LROW + (16 * s4 + 8 * h) * 2);
            const s8v bf = *(const s8v*)(QK + dir * ATT_TILE + j * LROW + (16 * s4 + 8 * h) * 2);
            acc = mfma32(af, bf, acc);
        }
        const float den = decay * qnS[dir * 64 + j] + denp[(dir * 2) * 64 + j] + denp[(dir * 2 + 1) * 64 + j];
        const float dn = fmaxf(fabsf(den), fexp(-(bS[dir * 64 + j] + Mj)));
        const float inv = 1.f / dn;
#pragma unroll
        for (int g = 0; g < 4; ++g) { f4v o; o[0] = acc[4 * g] * inv; o[1] = acc[4 * g + 1] * inv; o[2] = acc[4 * g + 2] * inv; o[3] = acc[4 * g + 3] * inv;
            *(f4v*)(hS + (dir * 64 + j) * 68 + rt * 32 + 8 * g + 4 * h) = o; }
    }
    __syncthreads();
    {
        const int tau = tid >> 3, v8 = (tid & 7) * 8;
        float hv[8]; float s = 0.f;
#pragma unroll
        for (int q = 0; q < 8; ++q) { hv[q] = hS[tau * 68 + v8 + q] + hS[(64 + 63 - tau) * 68 + v8 + q]; s += hv[q]; }
        s += __shfl_xor(s, 1); s += __shfl_xor(s, 2); s += __shfl_xor(s, 4);
        const float mu = s * (1.f / 64.f);
        float qq = 0.f;
#pragma unroll
        for (int q = 0; q < 8; ++q) { const float dlt = hv[q] - mu; qq += dlt * dlt; }
        qq += __shfl_xor(qq, 1); qq += __shfl_xor(qq, 2); qq += __shfl_xor(qq, 4);
        const float rstd = frsqrt(qq * (1.f / 64.f) + EPS);
        const int t = tb + tau;
        const u4v ov = o_r;
        const float* ng = p.in[I_MLG] + (size_t)l * 256 + head * 64 + v8;
        float o[8];
#pragma unroll
        for (int q = 0; q < 8; ++q) { const float og = bf2f((bf16_t)(ov[q >> 1] >> (16 * (q & 1)))); o[q] = (hv[q] - mu) * rstd * ng[q] * sigmoidf_(og); }
        u4v pk; pk[0] = pack2(o[0], o[1]); pk[1] = pack2(o[2], o[3]); pk[2] = pack2(o[4], o[5]); pk[3] = pack2(o[6], o[7]);
        *(u4v*)((bf16_t*)(p.ws + WS_MIXED) + (size_t)t * MIXW + 384 + head * 64 + v8) = pk;
    }
    __syncthreads();
}

DEV int queue_next(const Params& p, char* smem, int qi) {
    int* slot = (int*)(smem + SMEM_XB + 32);
    __syncthreads();
    if (threadIdx.x == 0) {
#ifdef EMU
        unsigned* w = (unsigned*)(p.ws + WS_BAR) + QUEUE_WORD0 + 64 * qi; *slot = (int)(*w)++;
#else
        *slot = (int)__hip_atomic_fetch_add((unsigned*)(p.ws + WS_BAR) + QUEUE_WORD0 + 64 * qi, 1u, __ATOMIC_RELAXED, __HIP_MEMORY_SCOPE_AGENT);
#endif
    }
    __syncthreads();
    return *slot;
}
DEV void phase_attn(const Params& p, char* smem, int l, int qi) {
    constexpr int QB_S = DEC_SEQ / 256, QB_P = SEQ / 256;
    constexpr int U_SG = DEC_BATCH * GQH * QB_S * 2, U_SN = DEC_BATCH * NAH * QB_S, U_PN = BATCH * NAH * QB_P, U_PG = BATCH * GQH * QB_P;
    constexpr int U_MP = BATCH * MLH * NCH_P, U_MS = DEC_BATCH * MLH * NCH_S;
    constexpr int NU = U_SG + U_SN + U_PN + U_PG + U_MP + U_MS;
    const bf16_t* naq = (const bf16_t*)(p.ws + WS_NAQ); const bf16_t* nak = (const bf16_t*)(p.ws + WS_NAK); const bf16_t* nav = (const bf16_t*)(p.ws + WS_NAV);
    const bf16_t* gqq = (const bf16_t*)(p.ws + WS_GQQ); const bf16_t* gqk = (const bf16_t*)(p.ws + WS_GQK); const bf16_t* gqv = (const bf16_t*)(p.ws + WS_GQV);
    bf16_t* mixed = (bf16_t*)(p.ws + WS_MIXED);
    for (;;) {
        int u = queue_next(p, smem, qi);
        if (u >= NU) break;
#ifdef PROBE_ATT
        if (qi >= 8) { const int cls = u < U_SG ? 1 : u < U_SG + U_SN ? 2 : u < U_SG + U_SN + U_PN + U_PG ? 3 : 4; if (cls != PROBE_ATT) continue; }
#endif
        AttnDesc d; d.na = 0; d.r0 = 0; d.rlo = 0; d.rpb = nullptr; d.part = nullptr; d.out = nullptr; d.ostride = MIXW; d.n0 = 0; d.k0 = d.v0 = nullptr; d.stride0 = 0;
        if (u < U_SG) {
            const int half = u & 1, qb = (u >> 1) % QB_S, qh = (u / (2 * QB_S)) % GQH, b = u / (2 * QB_S * GQH);
            const int kvh = qh / (GQH / GQKV);
            constexpr int NCT = PAST / 64, TT = NCT + DEC_SEQ / 64, H0 = TT / 2;
            const size_t tq = (size_t)NP + (size_t)b * DEC_SEQ + qb * 256;
            d.q = gqq + tq * 384 + qh * 64; d.qstride = 384;
            const bf16_t* lk = gqk + ((size_t)NP + (size_t)b * DEC_SEQ) * 128 + kvh * 64; const bf16_t* lv = gqv + ((size_t)NP + (size_t)b * DEC_SEQ) * 128 + kvh * 64;
            if (half == 0) {
                d.n0 = NCT; d.ntiles = H0; d.stride0 = 128;
                const size_t co = (((size_t)b * DEPTH + l) * PAST) * 128 + kvh * 64;
                d.k0 = (const bf16_t*)(p.ws + WS_CGQK) + co; d.v0 = (const bf16_t*)(p.ws + WS_CGQV) + co;
                d.k1 = lk; d.v1 = lv; d.stride1 = 128;
            } else {
                d.n0 = 0; d.ntiles = TT - H0; d.stride1 = 128;
                d.k1 = lk + (size_t)(H0 - NCT) * 64 * 128; d.v1 = lv + (size_t)(H0 - NCT) * 64 * 128;
            }
            d.part = (float*)(p.ws + WS_PART) + (size_t)u * PART_STRIDE;
        } else if (u < U_SG + U_SN) {
            const int uu = u - U_SG; const int qb = uu % QB_S, hd = (uu / QB_S) % NAH, b = uu / (QB_S * NAH);
            const size_t t0 = (size_t)NP + (size_t)b * DEC_SEQ;
            d.q = naq + (t0 + qb * 256) * 384 + hd * 64; d.qstride = 384;
            d.na = 1; d.r0 = qb * 4; d.rlo = na_row_start(d.r0);
            const int rhi = na_row_start(d.r0 + 3) + KR;
            d.n0 = PAST / 64; d.ntiles = d.n0 + (rhi - d.rlo); d.stride0 = 384; d.stride1 = 384;
            const size_t co = (((size_t)b * DEPTH + l) * PAST) * 384 + hd * 64;
            d.k0 = (const bf16_t*)(p.ws + WS_CNAK) + co; d.v0 = (const bf16_t*)(p.ws + WS_CNAV) + co;
            d.k1 = nak + (t0 + (size_t)d.rlo * 64) * 384 + hd * 64; d.v1 = nav + (t0 + (size_t)d.rlo * 64) * 384 + hd * 64;
            d.rpb = p.in[I_RPB] + ((size_t)l * NAH + hd) * 15 * 31;
            d.out = mixed + (t0 + qb * 256) * MIXW + hd * 64;
        } else if (u < U_SG + U_SN + U_PN) {
            const int uu = u - U_SG - U_SN; const int qb = uu % QB_P, hd = (uu / QB_P) % NAH, b = uu / (QB_P * NAH);
            const size_t t0 = (size_t)b * SEQ;
            d.q = naq + (t0 + qb * 256) * 384 + hd * 64; d.qstride = 384;
            d.n0 = 0; d.ntiles = SEQ / 64; d.stride1 = 384; d.k1 = nak + t0 * 384 + hd * 64; d.v1 = nav + t0 * 384 + hd * 64;
            d.out = mixed + (t0 + qb * 256) * MIXW + hd * 64;
        } else if (u < U_SG + U_SN + U_PN + U_PG) {
            const int uu = u - U_SG - U_SN - U_PN; const int qb = uu % QB_P, qh = (uu / QB_P) % GQH, b = uu / (QB_P * GQH);
            const int kvh = qh / (GQH / GQKV);
            const size_t t0 = (size_t)b * SEQ;
            d.q = gqq + (t0 + qb * 256) * 384 + qh * 64; d.qstride = 384;
            d.n0 = 0; d.ntiles = SEQ / 64; d.stride1 = 128; d.k1 = gqk + t0 * 128 + kvh * 64; d.v1 = gqv + t0 * 128 + kvh * 64;
            d.out = mixed + (t0 + qb * 256) * MIXW + 640 + qh * 64;
        } else {
            int uu = u - (U_SG + U_SN + U_PN + U_PG); const int grp = uu >= U_MP ? 1 : 0; if (grp) uu -= U_MP;
            const int nch = grp ? NCH_S : NCH_P;
            mlstm_summary_unit(p, smem, grp, uu / (nch * MLH), (uu / nch) % MLH, uu % nch);
        }
        if (u < U_SG + U_SN + U_PN + U_PG) attn_unit(smem, d);
    }
}

DEV void phase_mlout(const Params& p, char* smem, int l) {
    constexpr int QB_S = DEC_SEQ / 256;
    constexpr int U_MS = DEC_BATCH * MLH * NCH_S, U_MP = BATCH * MLH * NCH_P, U_CB = DEC_BATCH * GQH * QB_S;
    const int tid = get_tid(), lane = tid & 63, wave = tid >> 6;
    for (int tk = blockIdx.x + gridDim.x * wave; tk < U_CB * 4; tk += gridDim.x * 8) {
        const int uu = tk >> 2, sl = tk & 3;
        const int qb = uu % QB_S, qh = (uu / QB_S) % GQH, b = uu / (QB_S * GQH);
        const float* p0 = (const float*)(p.ws + WS_PART) + (size_t)(2 * uu) * PART_STRIDE; const float* p1 = p0 + PART_STRIDE;
        const int q = sl * 64 + (lane >> 1) + 32 * 0, d0 = (lane & 1) * 32;
#pragma unroll
        for (int hq = 0; hq < 2; ++hq) {
            const int qq = q + 32 * hq;
            const float m0 = p0[256 * 64 + qq], m1 = p1[256 * 64 + qq], l0 = p0[256 * 64 + 256 + qq], l1 = p1[256 * 64 + 256 + qq];
            const float m = fmaxf(m0, m1), w0 = fexp2(m0 - m), w1 = fexp2(m1 - m);
            const float inv = 1.f / (l0 * w0 + l1 * w1);
            bf16_t* dst = (bf16_t*)(p.ws + WS_MIXED) + ((size_t)NP + (size_t)b * DEC_SEQ + qb * 256 + qq) * MIXW + 640 + qh * 64 + d0;
#pragma unroll
            for (int i = 0; i < 8; ++i) {
                const f4v a = *(const f4v*)(p0 + (size_t)qq * 64 + d0 + 4 * i), bb = *(const f4v*)(p1 + (size_t)qq * 64 + d0 + 4 * i);
                u2v pk; pk[0] = pack2((a[0] * w0 + bb[0] * w1) * inv, (a[1] * w0 + bb[1] * w1) * inv); pk[1] = pack2((a[2] * w0 + bb[2] * w1) * inv, (a[3] * w0 + bb[3] * w1) * inv);
                *(u2v*)(dst + 4 * i) = pk;
            }
        }
    }
    for (int u = blockIdx.x; u < U_MS + U_MP; u += gridDim.x) {
        const int grp = u < U_MS ? 1 : 0; const int uu = grp ? u : u - U_MS; const int nch = grp ? NCH_S : NCH_P;
        mlstm_output_unit(p, smem, l, grp, uu / (nch * MLH), (uu / nch) % MLH, uu % nch);
    }
}

constexpr int N_PHASES = 2 + 9 * DEPTH;
#ifndef EMU
typedef const __attribute__((address_space(4))) Params* KParamsPtr;
DEV void load_params(Params& p) {
    KParamsPtr kp = (KParamsPtr)__builtin_amdgcn_kernarg_segment_ptr();
    asm volatile("" : "+s"(kp));
#pragma unroll
    for (int i = 0; i < N_IN; ++i) p.in[i] = kp->in[i];
    p.out = kp->out; p.ws = kp->ws; p.ph0 = kp->ph0; p.ph1 = kp->ph1;
}
#endif
#ifdef EMU
static char emu_smem[SMEM_BYTES + 64];
#endif
__global__ void __launch_bounds__(512, 2) mega_kernel(Params p_) {
    const int ph0 = p_.ph0, ph1 = p_.ph1;
#ifdef EMU
    char* smem = emu_smem;
#define GRID_SYNC() do {} while (0)
#else
    extern __shared__ __attribute__((aligned(16))) char smem[];
    if (threadIdx.x == 0) *(u4v*)(smem + SMEM_XB) = (u4v){0u, 0u, 0u, 0u};
    __syncthreads();
    (void)xcd_barrier_post((unsigned*)(p_.ws + WS_BAR), (volatile LAS unsigned*)(smem + SMEM_XB));
    const bool multi = (ph1 - ph0) > 1;
#define GRID_SYNC() do { if (multi) { KParamsPtr kpb = (KParamsPtr)__builtin_amdgcn_kernarg_segment_ptr(); asm volatile("" : "+s"(kpb)); \
        XcdBarrier xb; xb.bar = (unsigned*)(kpb->ws + WS_BAR); xb.x = xb_xcc_id(); xb.st = (volatile LAS unsigned*)(smem + SMEM_XB); xcd_barrier(xb); } } while (0)
#endif
    int ph = 0;
#ifndef KIND_MASK
#define KIND_MASK 0x3ff
#endif
#ifdef EMU
#define LOAD_PARAMS() const Params& p = p_
#else
#define LOAD_PARAMS() Params p; load_params(p)
#endif
#ifndef DOUBLE_MASK
#define DOUBLE_MASK 0
#endif
#define PH_KIND() (ph == 0 ? 0 : ph == 1 + 9 * DEPTH ? 1 : 1 + (ph - 1) % 9)
#define RUN_PHASE(body) do { if (((KIND_MASK >> PH_KIND()) & 1) && ph >= ph0 && ph < ph1) { \
    if (DOUBLE_MASK && ((DOUBLE_MASK >> PH_KIND()) & 1)) { { const int rep_ = 1; LOAD_PARAMS(); body; } GRID_SYNC(); } \
    { const int rep_ = 0; LOAD_PARAMS(); body; } if (ph + 1 < ph1) GRID_SYNC(); } ++ph; } while (0)
    RUN_PHASE(phase_ada(p, smem));
    for (int l = 0; l < DEPTH; ++l) {
        RUN_PHASE(phase_rows<0>(p, smem, l));
        RUN_PHASE(phase_inproj<0>(p, smem, l));
        RUN_PHASE(phase_attn(p, smem, l, l + DEPTH * rep_));
        RUN_PHASE(phase_mlout(p, smem, l));
        RUN_PHASE(phase_outproj<0>(p, smem, l));
        RUN_PHASE(phase_rows<1>(p, smem, l));
        RUN_PHASE(phase_topk(p, smem));
        RUN_PHASE(phase_gateup<0>(p, smem, l));
        RUN_PHASE(phase_down<0>(p, smem, l));
    }
    RUN_PHASE(phase_rows<0>(p, smem, DEPTH));
#ifdef PROBE_BARRIERS
    for (int i = 0; i < PROBE_BARRIERS; ++i) GRID_SYNC();
#endif
}

#if !defined(EMU) && defined(PROBE_KIND)
__global__ void __launch_bounds__(512, 2) probe_kernel(Params p) {
    extern __shared__ __attribute__((aligned(16))) char smem[];
    for (int r = 0; r < PROBE_REPS; ++r) {
#if PROBE_KIND == 8
        phase_gateup<PROBE_VAR>(p, smem, 1);
#elif PROBE_KIND == 9
        phase_down<PROBE_VAR>(p, smem, 1);
#elif PROBE_KIND == 2
        phase_inproj<PROBE_VAR>(p, smem, 1);
#elif PROBE_KIND == 5
        phase_outproj<PROBE_VAR>(p, smem, 1);
#elif PROBE_KIND == 0
        phase_ada(p, smem);
#elif PROBE_KIND == 1
        phase_rows<0>(p, smem, 1);
#elif PROBE_KIND == 6
        phase_rows<1>(p, smem, 1);
#elif PROBE_KIND == 7
        phase_topk(p, smem);
#elif PROBE_KIND == 3
        phase_attn(p, smem, 1, 8 + r);
#elif PROBE_KIND == 4
        phase_mlout(p, smem, 1);
#endif
        __syncthreads();
    }
}
#endif
#ifndef EMU
#ifndef MK_N_LAUNCHES
#define MK_N_LAUNCHES 1
#endif
extern "C" void kernel_launch(void* const* d_in, const int* in_sizes, int n_in, void* d_out, int out_size, void* d_ws, size_t ws_size, hipStream_t stream) {
    (void)in_sizes; (void)n_in; (void)out_size; (void)ws_size;
    static int grid = 0;
    if (!grid) {
        int dev = 0, cus = 0, per_cu = 0;
        (void)hipGetDevice(&dev);
        (void)hipDeviceGetAttribute(&cus, hipDeviceAttributeMultiprocessorCount, dev);
        (void)hipFuncSetAttribute((const void*)mega_kernel, hipFuncAttributeMaxDynamicSharedMemorySize, SMEM_BYTES);
        (void)hipOccupancyMaxActiveBlocksPerMultiprocessor(&per_cu, mega_kernel, 512, SMEM_BYTES);
        grid = cus * (per_cu < 1 ? per_cu : 1);
        if (grid <= 0) grid = cus;
    }
    (void)hipMemsetAsync((char*)d_ws + WS_BAR, 0, WS_BAR_BYTES, stream);
    Params p = {};
    for (int i = 0; i < N_IN; ++i) p.in[i] = (const float*)d_in[i];
    p.out = (float*)d_out; p.ws = (char*)d_ws;
#if MK_N_LAUNCHES == 1
    p.ph0 = 0; p.ph1 = N_PHASES;
    mega_kernel<<<dim3(grid), dim3(512), SMEM_BYTES, stream>>>(p);
#ifdef PROBE_KIND
    (void)hipFuncSetAttribute((const void*)probe_kernel, hipFuncAttributeMaxDynamicSharedMemorySize, SMEM_BYTES);
    probe_kernel<<<dim3(grid), dim3(512), SMEM_BYTES, stream>>>(p);
#endif
#else
    for (int ph = 0; ph < N_PHASES; ++ph) { p.ph0 = ph; p.ph1 = ph + 1; mega_kernel<<<dim3(grid), dim3(512), SMEM_BYTES, stream>>>(p); }
#endif
}
#endif
```

```cpp
#ifndef EMU
#include <hip/hip_runtime.h>
#define DEV __device__ __forceinline__
#else
#define DEV static inline __attribute__((always_inline))
#endif
#include <stdint.h>
#include <stddef.h>

#ifndef CFG_D
#define CFG_D 1024
#define CFG_BATCH 16
#define CFG_SEQ 256
#define CFG_DEC_BATCH 2
#define CFG_DEC_SEQ 2048
#define CFG_PAST 256
#define CFG_EH 2816
#endif
constexpr int D = CFG_D, BATCH = CFG_BATCH, SEQ = CFG_SEQ, DEC_BATCH = CFG_DEC_BATCH, DEC_SEQ = CFG_DEC_SEQ, PAST = CFG_PAST, EH = CFG_EH;
constexpr int DEPTH = 2, HD = 64, NAH = 6, MLH = 4, GQH = 6, GQKV = 2, NEXP = 16, GRIDW = 64;
constexpr int NP = BATCH * SEQ, NS = DEC_BATCH * DEC_SEQ, NT = NP + NS, NCOND = 1 + DEC_BATCH;
constexpr int PROJ_W = 2832, MIXW = 1024;
constexpr int CAP_P = SEQ / 8, CAP_S = DEC_SEQ / 8, SLOTS = BATCH * CAP_P + DEC_BATCH * CAP_S;
constexpr int ROWS = DEC_SEQ / GRIDW, KR = ROWS < 8 ? ROWS : 8, KC = 16;
constexpr int NCH_P = SEQ / 64, NCH_S = DEC_SEQ / 64;
constexpr float ALPHA = 1.41421356237309515f;
constexpr float ATT_SCALE = 0.125f;
constexpr float EPS = 1e-6f;
static_assert(SLOTS % 256 == 0 && NP % 256 == 0 && NS % 256 == 0 && SEQ % 256 == 0 && DEC_SEQ % 256 == 0, "tile divisibility");
static_assert(D % 256 == 0 && EH % 128 == 0 && PAST % 64 == 0, "tile divisibility");

typedef unsigned short bf16_t;
typedef short s8v __attribute__((ext_vector_type(8)));
typedef short s4v __attribute__((ext_vector_type(4)));
typedef float f16v __attribute__((ext_vector_type(16)));
typedef float f4v __attribute__((ext_vector_type(4)));
typedef unsigned u4v __attribute__((ext_vector_type(4)));
typedef unsigned u2v __attribute__((ext_vector_type(2)));

enum { I_XP = 0, I_XS, I_C, I_CNAK, I_CNAV, I_CGQK, I_CGQV, I_SC, I_SN, I_SM, I_CCTX, I_ADAW, I_ADAB, I_WIN, I_BGATE, I_WOUT, I_RPB, I_QKG, I_MLG,
       I_LNG, I_LNB, I_RW, I_WG, I_WU, I_WD, N_IN };

constexpr size_t O_YP = 0;
constexpr size_t O_YS = O_YP + (size_t)NP * D;
constexpr size_t O_NAK = O_YS + (size_t)NS * D;
constexpr size_t O_NAV = O_NAK + (size_t)BATCH * DEPTH * SEQ * NAH * HD;
constexpr size_t O_GQK = O_NAV + (size_t)BATCH * DEPTH * SEQ * NAH * HD;
constexpr size_t O_GQV = O_GQK + (size_t)BATCH * DEPTH * SEQ * GQKV * HD;
constexpr size_t O_MC = O_GQV + (size_t)BATCH * DEPTH * SEQ * GQKV * HD;
constexpr size_t O_MN = O_MC + (size_t)BATCH * DEPTH * 2 * MLH * HD * HD;
constexpr size_t O_MM = O_MN + (size_t)BATCH * DEPTH * 2 * MLH * HD;
constexpr size_t O_END = O_MM + (size_t)BATCH * DEPTH * 2 * MLH;

constexpr size_t al256(size_t x) { return (x + 255) & ~(size_t)255; }
constexpr size_t WS_BAR = 0;
constexpr size_t WS_BAR_BYTES = 32768;
constexpr size_t WS_MODS = WS_BAR + WS_BAR_BYTES;
constexpr size_t WS_ROPE = al256(WS_MODS + (size_t)DEPTH * NCOND * 6 * D * 4);
constexpr size_t WS_CNAK = al256(WS_ROPE + 64 * 16 * 2 * 4);
constexpr size_t WS_CNAV = al256(WS_CNAK + (size_t)DEC_BATCH * DEPTH * PAST * NAH * HD * 2);
constexpr size_t WS_CGQK = al256(WS_CNAV + (size_t)DEC_BATCH * DEPTH * PAST * NAH * HD * 2);
constexpr size_t WS_CGQV = al256(WS_CGQK + (size_t)DEC_BATCH * DEPTH * PAST * GQKV * HD * 2);
constexpr size_t WS_XBUF = al256(WS_CGQV + (size_t)DEC_BATCH * DEPTH * PAST * GQKV * HD * 2);
constexpr size_t WS_HMOD = al256(WS_XBUF + (size_t)NT * D * 4);
constexpr size_t WS_GATES = al256(WS_HMOD + (size_t)NT * D * 2);
constexpr size_t WS_NAQ = al256(WS_GATES + (size_t)NT * 16 * 4);
constexpr size_t WS_NAK = al256(WS_NAQ + (size_t)NT * 384 * 2);
constexpr size_t WS_NAV = al256(WS_NAK + (size_t)NT * 384 * 2);
constexpr size_t WS_MLQ = al256(WS_NAV + (size_t)NT * 384 * 2);
constexpr size_t WS_MLK = al256(WS_MLQ + (size_t)NT * 256 * 2);
constexpr size_t WS_MLV = al256(WS_MLK + (size_t)NT * 256 * 2);
constexpr size_t WS_MLO = al256(WS_MLV + (size_t)NT * 256 * 2);
constexpr size_t WS_GQQ = al256(WS_MLO + (size_t)NT * 256 * 2);
constexpr size_t WS_GQK = al256(WS_GQQ + (size_t)NT * 384 * 2);
constexpr size_t WS_GQV = al256(WS_GQK + (size_t)NT * 128 * 2);
constexpr size_t WS_MIXED = al256(WS_GQV + (size_t)NT * 128 * 2);
constexpr size_t WS_U = al256(WS_MIXED + (size_t)NT * MIXW * 2);
constexpr size_t WS_X1 = al256(WS_U + (size_t)NT * D * 4);
constexpr size_t WS_H2 = al256(WS_X1 + (size_t)NT * D * 4);
constexpr size_t WS_AFF = al256(WS_H2 + (size_t)NT * D * 2);
constexpr size_t WS_IDX = al256(WS_AFF + (size_t)NT * 16 * 4);
constexpr size_t WS_GSEL = al256(WS_IDX + (size_t)NEXP * SLOTS * 4);
constexpr size_t WS_TOKSLOT = al256(WS_GSEL + (size_t)NEXP * SLOTS * 4);
constexpr size_t WS_HID = al256(WS_TOKSLOT + (size_t)NT * 16 * 4);
constexpr size_t WS_YE = al256(WS_HID + (size_t)NEXP * SLOTS * EH * 2);
constexpr int MLSUM_STRIDE = 4096 + 64 + 64;
constexpr int N_MLSUM = (BATCH * NCH_P + DEC_BATCH * NCH_S) * MLH * 2;
constexpr size_t WS_MLSUM = al256(WS_YE + (size_t)NEXP * SLOTS * D * 2);
constexpr int PART_STRIDE = 256 * 64 + 512;
constexpr int N_PART = DEC_BATCH * GQH * (DEC_SEQ / 256) * 2;
constexpr size_t WS_PART = al256(WS_MLSUM + (size_t)N_MLSUM * MLSUM_STRIDE * 4);
constexpr size_t WS_TOTAL = al256(WS_PART + (size_t)N_PART * PART_STRIDE * 4);

struct Params {
    const float* in[N_IN];
    float* out;
    char* ws;
    int ph0, ph1;
};

DEV float bf2f(bf16_t s) { unsigned u = ((unsigned)s) << 16; return __builtin_bit_cast(float, u); }
DEV bf16_t f2bf(float f) {
#ifdef EMU
    unsigned u = __builtin_bit_cast(unsigned, f); u += 0x7fffu + ((u >> 16) & 1u); return (bf16_t)(u >> 16);
#else
    return __builtin_bit_cast(bf16_t, (__bf16)f);
#endif
}
DEV unsigned pack2(float a, float b) {
#ifdef EMU
    return (unsigned)f2bf(a) | ((unsigned)f2bf(b) << 16);
#else
    typedef __bf16 b2 __attribute__((ext_vector_type(2))); b2 r; r[0] = (__bf16)a; r[1] = (__bf16)b; return __builtin_bit_cast(unsigned, r);
#endif
}
DEV float fexp(float x) {
#ifdef EMU
    return expf(x);
#else
    return __expf(x);
#endif
}
DEV float fexp2(float x) {
#ifdef EMU
    return exp2f(x);
#else
    return __builtin_amdgcn_exp2f(x);
#endif
}
DEV float frcp(float x) {
#ifdef EMU
    return 1.f / x;
#else
    return __builtin_amdgcn_rcpf(x);
#endif
}
DEV float sigmoidf_(float x) { return frcp(1.f + fexp(-x)); }
DEV float siluf_(float x) { return x * frcp(1.f + fexp(-x)); }
DEV float flog(float x) {
#ifdef EMU
    return logf(x);
#else
    return __logf(x);
#endif
}
DEV float frsqrt(float x) {
#ifdef EMU
    return 1.f / sqrtf(x);
#else
    return __builtin_amdgcn_rsqf(x);
#endif
}
DEV float logsigmoidf_(float x) { return fminf(x, 0.f) - flog(1.f + fexp(-fabsf(x))); }
DEV f16v mfma32(s8v a, s8v b, f16v c) {
#ifdef EMU
    return emu_mfma_32x32x16_bf16(a, b, c);
#else
    typedef __bf16 bf8 __attribute__((ext_vector_type(8)));
    return __builtin_amdgcn_mfma_f32_32x32x16_bf16(__builtin_bit_cast(bf8, a), __builtin_bit_cast(bf8, b), c, 0, 0, 0);
#endif
}
DEV s4v lds_tr16(const void* p) {
#ifdef EMU
    return emu_ds_read_tr16_b64(p);
#else
    typedef s4v __attribute__((address_space(3))) * lp;
    return __builtin_amdgcn_ds_read_tr16_b64_v4i16((lp)(p));
#endif
}
#ifdef EMU
DEV float wave_sum(float v) { for (int m = 32; m >= 1; m >>= 1) v += __shfl_xor(v, m); return v; }
#else
template <int CTRL, int RM> DEV float dpp_f(float v) { return __builtin_bit_cast(float, __builtin_amdgcn_update_dpp(0, __builtin_bit_cast(int, v), CTRL, RM, 0xF, false)); }
DEV float wave_sum(float v) {
    v += dpp_f<0xB1, 0xF>(v); v += dpp_f<0x4E, 0xF>(v); v += dpp_f<0x141, 0xF>(v); v += dpp_f<0x140, 0xF>(v);
    v += dpp_f<0x142, 0xA>(v); v += dpp_f<0x143, 0xC>(v);
    return __builtin_bit_cast(float, __builtin_amdgcn_readlane(__builtin_bit_cast(int, v), 63));
}
#endif
DEV float wave_max(float v) { for (int m = 32; m >= 1; m >>= 1) v = fmaxf(v, __shfl_xor(v, m)); return v; }
DEV f16v f16zero() { f16v z; for (int i = 0; i < 16; ++i) z[i] = 0.f; return z; }

#ifdef EMU
#define VGPR_PIN(x) do {} while (0)
#define SGPR_PIN(x) do {} while (0)
#define SCHED_FENCE() do {} while (0)
#define CFENCE() do {} while (0)
#else
#define SCHED_FENCE() __builtin_amdgcn_sched_barrier(0)
#define SGPR_PIN(x) asm volatile("" : "+s"(x))
#define VGPR_PIN(x) asm volatile("" : "+v"(x))
#define CFENCE() asm volatile("" ::: "memory")
#endif
#ifdef EMU
DEV int get_tid() { return (int)threadIdx.x; }
#else
DEV int get_tid() { int t = threadIdx.x; asm volatile("" : "+v"(t)); return t; }
#endif
struct UnitIter { int i, end, step; };
DEV UnitIter unit_iter(int NU) {
    const int G = (int)gridDim.x, b = (int)blockIdx.x;
    UnitIter it;
#ifndef XCD_MODE
#define XCD_MODE 0
#endif
    if ((G & 7) == 0 && (NU & 7) == 0) { const int W = G >> 3, x = XCD_MODE ? b / W : b & 7, j = XCD_MODE ? b % W : b >> 3, C = NU >> 3; it.i = x * C + j; it.end = (x + 1) * C; it.step = W; }
    else { it.i = b; it.end = NU; it.step = G; }
    return it;
}
DEV int tok_cond(int t) { return t < NP ? 0 : 1 + (t - NP) / DEC_SEQ; }

#ifndef EMU
#define XB_TMO      128
#define XB_XCNT(j)  (256  + 64 * (j))
#define XB_XSUB(j)  (1280 + 64 * (j))
#define XB_XGEN(j)  (2304 + 64 * (j))
#define XB_TOP      3328
#define XB_TOPGEN   3392
#define XCD_BAR_WORDS 3456
#define XB_SPIN_CAP (1u << 20)
#define LAS __attribute__((address_space(3)))
__device__ __forceinline__ unsigned xb_ld(unsigned* p)              { return __hip_atomic_load(p, __ATOMIC_RELAXED, __HIP_MEMORY_SCOPE_AGENT); }
__device__ __forceinline__ unsigned xb_add(unsigned* p, unsigned v) { return __hip_atomic_fetch_add(p, v, __ATOMIC_RELAXED, __HIP_MEMORY_SCOPE_AGENT); }
__device__ __forceinline__ unsigned xb_xcc_id() { return (unsigned)__builtin_amdgcn_s_getreg((3 << 11) | 20) & 0xFu; }
#define XB_SPIN(cond, bar) do { unsigned _sp = 0; while (cond) { __builtin_amdgcn_s_sleep(1); \
    if ((++_sp & 255u) == 0u) { if (xb_ld(&(bar)[XB_TMO])) break; if (_sp > XB_SPIN_CAP) { atomicAdd(&(bar)[XB_TMO], 1u); break; } } } } while (0)
struct XcdBarrier { unsigned* bar; unsigned x; volatile LAS unsigned* st; };
__device__ __forceinline__ XcdBarrier xcd_barrier_post(unsigned* bar, volatile LAS unsigned* st) {
    XcdBarrier b; b.bar = bar; b.x = xb_xcc_id(); b.st = st;
    if (threadIdx.x == 0) (void)xb_add(&bar[XB_XCNT(b.x)], 1u);
    return b;
}
__device__ __forceinline__ void xcd_barrier_complete(unsigned* bar, unsigned x, unsigned& nloc, unsigned& nx) {
    const unsigned G = gridDim.x * gridDim.y * gridDim.z;
    unsigned sum, cnt, mine, sp = 0u;
    for (;;) {
        sum = 0u; cnt = 0u; mine = 0u;
#pragma unroll
        for (unsigned j = 0; j < 16; ++j) { const unsigned c = xb_ld(&bar[XB_XCNT(j)]); sum += c; cnt += (c > 0u) ? 1u : 0u; mine = (j == x) ? c : mine; }
        if (sum == G) break;
        __builtin_amdgcn_s_sleep(1);
        if ((++sp & 255u) == 0u) { if (xb_ld(&bar[XB_TMO])) break; if (sp > XB_SPIN_CAP) { atomicAdd(&bar[XB_TMO], 1u); break; } }
    }
    nloc = mine > 0u ? mine : 1u; nx = cnt > 0u ? cnt : 1u;
}
__device__ __forceinline__ void xcd_barrier(const XcdBarrier& b) {
    asm volatile("s_waitcnt vmcnt(0)" ::: "memory");
    __syncthreads();
    if (threadIdx.x == 0) {
        unsigned* bar = b.bar;
        __builtin_amdgcn_s_waitcnt(0);
        unsigned nloc = b.st[0], nx = b.st[1];
        if (nloc == 0u) { xcd_barrier_complete(bar, b.x, nloc, nx); b.st[0] = nloc; b.st[1] = nx; }
        const unsigned old = xb_add(&bar[XB_XSUB(b.x)], 1u);
        const unsigned gen = old / nloc;
        if (old + 1u == (gen + 1u) * nloc) {
            __builtin_amdgcn_fence(__ATOMIC_RELEASE, "agent");
            asm volatile("s_waitcnt vmcnt(0)" ::: "memory");
            const unsigned og = xb_add(&bar[XB_TOP], 1u);
            const unsigned tg = og / nx;
            if (og + 1u == (tg + 1u) * nx) xb_add(&bar[XB_TOPGEN], 1u);
            else XB_SPIN(xb_ld(&bar[XB_TOPGEN]) == tg, bar);
            __builtin_amdgcn_fence(__ATOMIC_ACQUIRE, "agent");
            xb_add(&bar[XB_XGEN(b.x)], 1u);
            asm volatile("s_waitcnt vmcnt(0)" ::: "memory");
        } else {
            XB_SPIN(xb_ld(&bar[XB_XGEN(b.x)]) == gen, bar);
            __builtin_amdgcn_fence(__ATOMIC_ACQUIRE, "agent");
            asm volatile("s_waitcnt vmcnt(0)" ::: "memory");
        }
    }
    __syncthreads();
}
#endif
constexpr int QUEUE_WORD0 = 4096;

constexpr int LROW = 144;
constexpr int GEMM_AS = 256 * LROW;
constexpr int GEMM_BS = 64 * (256 * 2 + 64);
constexpr int SMEM_XB = 2 * GEMM_AS + 2 * GEMM_BS;
constexpr int SMEM_AUX = SMEM_XB + 64;
constexpr int SMEM_BYTES = SMEM_AUX + 2048;

#ifdef EMU
struct BufRsrc { const char* base; };
DEV BufRsrc make_rsrc(const void* p) { BufRsrc r; r.base = (const char*)p; return r; }
DEV float buf_load_f32(BufRsrc r, unsigned voff, unsigned soff) { return *(const float*)(r.base + voff + soff); }
DEV u4v buf_load_b128(BufRsrc r, unsigned voff, unsigned soff) { return *(const u4v*)(r.base + voff + soff); }
#else
typedef __amdgpu_buffer_rsrc_t BufRsrc;
DEV BufRsrc make_rsrc(const void* p) { return __builtin_amdgcn_make_buffer_rsrc((void*)p, 0, 0x7fffffff, 0x00020000); }
DEV float buf_load_f32(BufRsrc r, unsigned voff, unsigned soff) { return __builtin_bit_cast(float, __builtin_amdgcn_raw_buffer_load_b32(r, voff, soff, 0)); }
DEV u4v buf_load_b128(BufRsrc r, unsigned voff, unsigned soff) { return __builtin_amdgcn_raw_buffer_load_b128(r, voff, soff, 0); }
#endif
#ifdef EMU
#define WAVE_SYNC() do { (void)__shfl(0, 0); } while (0)
#else
#define WAVE_SYNC() asm volatile("s_waitcnt lgkmcnt(0)" ::: "memory")
#endif
DEV char* wave_stage_ptr(char* smem, int wave) { return smem + (wave < 4 ? GEMM_AS + wave * 9216 : 2 * GEMM_AS + GEMM_BS + (wave - 4) * 9216); }
DEV void stage64_write_bf16(char* stg, int tt, const f16v& v0, const f16v& v1, int l31, int h) {
    char* row = stg + (tt * 32 + l31) * LROW;
#pragma unroll
    for (int ft = 0; ft < 2; ++ft) {
        const f16v& v = ft ? v1 : v0;
#pragma unroll
        for (int g = 0; g < 4; ++g) { u2v pk; pk[0] = pack2(v[4 * g], v[4 * g + 1]); pk[1] = pack2(v[4 * g + 2], v[4 * g + 3]); *(u2v*)(row + (ft * 32 + 8 * g + 4 * h) * 2) = pk; }
    }
}
DEV void stage64_write4(char* stg, int row, int col, float a, float b, float c, float d) {
    u2v pk; pk[0] = pack2(a, b); pk[1] = pack2(c, d); *(u2v*)(stg + row * LROW + col * 2) = pk;
}
DEV void stage64_flush_bf16(const char* stg, bf16_t* dst0, size_t row_stride, int lane) {
    WAVE_SYNC();
#pragma unroll
    for (int i = 0; i < 8; ++i) { const int r = (lane >> 3) + 8 * i, c = lane & 7; const u4v v = *(const u4v*)(stg + r * LROW + c * 16); *(u4v*)(dst0 + (size_t)r * row_stride + c * 8) = v; }
    WAVE_SYNC();
}
template <int NTW, int VAR, class Epi>
DEV void gemm_tile(char* smem, BufRsrc ars, unsigned ao0, unsigned ao1, unsigned ao2, unsigned ao3,
                   BufRsrc brs, unsigned bvo, unsigned blds, unsigned ldb4, int K, Epi&& epi) {
    constexpr int BN = 64 * NTW, NLD = 2 * NTW, KSTEP = 64 / NLD, RSB = BN * 2 + 64;
    const int tid = get_tid(), lane = tid & 63, wave = tid >> 6, wm = wave & 3, wn = wave >> 2, h = lane >> 5, l31 = lane & 31;
    char* As = smem; char* Bs = smem + 2 * GEMM_AS;
    constexpr int BSZ = GEMM_BS;
    const int ar = tid >> 3, ac = tid & 7;
    u4v areg[2]; f4v b0[NLD], b1[NLD];
    if (VAR & 3) { for (int i = 0; i < 2; ++i) areg[i] = (u4v){1u, 2u, 3u, 4u}; for (int j = 0; j < NLD; ++j) { b0[j] = (f4v){1.f, 1.f, 1.f, 1.f}; b1[j] = (f4v){2.f, 2.f, 2.f, 2.f}; } }
    f16v acc[NTW][2];
#pragma unroll
    for (int i = 0; i < NTW; ++i) { acc[i][0] = f16zero(); acc[i][1] = f16zero(); }
    auto gloadA = [&](int k0, bool real, int half) {
        if (VAR & 2) return;
        const unsigned so = real ? k0 * 2 : 0u;
        areg[0] = buf_load_b128(ars, real ? (half ? ao2 : ao0) : 0u, so); areg[1] = buf_load_b128(ars, real ? (half ? ao3 : ao1) : 0u, so);
    };
    auto gloadB = [&](int k0, bool real, f4v (&br)[NLD]) {
        if (VAR & 1) return;
        const unsigned vo = real ? bvo : 0u; const int kk = real ? k0 : 0;
        unsigned so = (unsigned)kk * ldb4;
#pragma unroll
        for (int j = 0; j < NLD; ++j) { br[j] = __builtin_bit_cast(f4v, buf_load_b128(brs, vo, so)); so += KSTEP * ldb4; SGPR_PIN(so); }
    };
    auto gloadB1 = [&](int k0, bool real, f4v (&br)[NLD], int j) {
        if (VAR & 1) return;
        br[j] = __builtin_bit_cast(f4v, buf_load_b128(brs, real ? bvo : 0u, (unsigned)((real ? k0 : 0) + j * KSTEP) * ldb4));
    };
    auto lstoreA = [&](int buf, int half) {
        if (VAR & 16) return;
        char* ab = As + buf * GEMM_AS + (ar + half * 128) * LROW + ac * 16;
        *(u4v*)(ab) = areg[0]; *(u4v*)(ab + 64 * LROW) = areg[1];
    };
    auto lstoreB1 = [&](int buf, const f4v (&br)[NLD], int j) {
        if (VAR & 16) return;
        u2v v; v[0] = pack2(br[j][0], br[j][1]); v[1] = pack2(br[j][2], br[j][3]); *(u2v*)(Bs + buf * BSZ + blds + j * KSTEP * RSB) = v;
    };
    auto lstoreB = [&](int buf, const f4v (&br)[NLD]) {
        if (VAR & 16) return;
        char* bb = Bs + buf * BSZ + blds;
#pragma unroll
        for (int j = 0; j < NLD; ++j) { u2v v; v[0] = pack2(br[j][0], br[j][1]); v[1] = pack2(br[j][2], br[j][3]); *(u2v*)(bb + j * KSTEP * RSB) = v; }
    };
    const unsigned btr = (unsigned)(8 * h + ((lane & 15) >> 2)) * RSB + (unsigned)((((lane >> 4) & 1) * 16 + 4 * (lane & 3)) * 2) + (unsigned)(wn * NTW * 32) * 2;
    const unsigned atr = (unsigned)(wm * 64 + l31) * LROW + h * 16;
    auto rdw = [&](int buf, int s, int ft) -> s8v {
        if (VAR & 64) { s8v z; for (int q = 0; q < 8; ++q) z[q] = (short)(0x3f80 + ft); return z; }
        const char* bb = Bs + buf * BSZ + btr + s * 16 * RSB + ft * 64;
        const s4v lo = lds_tr16(bb), hi = lds_tr16(bb + 4 * RSB);
        s8v wf; wf[0] = lo[0]; wf[1] = lo[1]; wf[2] = lo[2]; wf[3] = lo[3]; wf[4] = hi[0]; wf[5] = hi[1]; wf[6] = hi[2]; wf[7] = hi[3];
        return wf;
    };
    auto compute2 = [&](int buf, int s0, auto&& hook) {
        if (VAR & 8) { for (int g = 0; g < 2 * NTW; ++g) hook(g); return; }
        const char* ab = As + buf * GEMM_AS + atr;
        s8v xa[2];
        if (VAR & 64) { for (int q = 0; q < 8; ++q) { xa[0][q] = 0x3f80; xa[1][q] = 0x3f80; } } else { xa[0] = *(const s8v*)(ab + s0 * 32); xa[1] = *(const s8v*)(ab + 32 * LROW + s0 * 32); }
        s8v wcur = rdw(buf, s0, 0);
#pragma unroll
        for (int g = 0; g < 2 * NTW; ++g) {
            const int ft = g % NTW;
            s8v wnext = wcur;
            if (g + 1 < 2 * NTW) wnext = rdw(buf, s0 + (g + 1) / NTW, (g + 1) % NTW);
            if (VAR & 4) { acc[ft][0][0] += __builtin_bit_cast(float, (int)wcur[0] | ((int)xa[0][1] << 16)); acc[ft][1][0] += __builtin_bit_cast(float, (int)wcur[1] | ((int)xa[1][1] << 16)); }
            else { acc[ft][0] = mfma32(wcur, xa[0], acc[ft][0]); acc[ft][1] = mfma32(wcur, xa[1], acc[ft][1]); }
            if (g == NTW - 1 && !(VAR & 64)) { xa[0] = *(const s8v*)(ab + (s0 + 1) * 32); xa[1] = *(const s8v*)(ab + 32 * LROW + (s0 + 1) * 32); }
            wcur = wnext;
            hook(g);
            SCHED_FENCE();
        }
    };
    auto nohook = [](int) {};
    const int nk = K / 64;
    if (NTW == 2) {
        u4v a0[4], a1[4];
        if (VAR & 3) { for (int i = 0; i < 4; ++i) { a0[i] = (u4v){1u, 2u, 3u, 4u}; a1[i] = (u4v){1u, 2u, 3u, 4u}; } }
        auto gA = [&](int k0, bool real, u4v (&ar4)[4]) {
            if (VAR & 2) return;
            const unsigned so = real ? k0 * 2 : 0u;
            ar4[0] = buf_load_b128(ars, real ? ao0 : 0u, so); ar4[1] = buf_load_b128(ars, real ? ao1 : 0u, so);
            ar4[2] = buf_load_b128(ars, real ? ao2 : 0u, so); ar4[3] = buf_load_b128(ars, real ? ao3 : 0u, so);
        };
        auto sA = [&](int buf, const u4v (&ar4)[4]) {
            if (VAR & 16) return;
            char* ab = As + buf * GEMM_AS + ar * LROW + ac * 16;
#pragma unroll
            for (int i = 0; i < 4; ++i) *(u4v*)(ab + i * 64 * LROW) = ar4[i];
        };
        auto gA1 = [&](int k0, bool real, u4v (&ar4)[4], int i) {
            if (VAR & 2) return;
            const unsigned ao = i == 0 ? ao0 : i == 1 ? ao1 : i == 2 ? ao2 : ao3;
            ar4[i] = buf_load_b128(ars, real ? ao : 0u, real ? k0 * 2 : 0u);
        };
        auto sA1 = [&](int buf, const u4v (&ar4)[4], int i) {
            if (VAR & 16) return;
            *(u4v*)(As + buf * GEMM_AS + (ar + i * 64) * LROW + ac * 16) = ar4[i];
        };
        gA(0, true, a0); gloadB(0, true, b0); gA(64, true, a1); gloadB(64, true, b1);
        sA(0, a0); lstoreB(0, b0);
        __syncthreads();
        for (int kt = 0; kt < nk; kt += 2) {
            const bool t2 = kt + 2 < nk;
            compute2(0, 0, [&](int g) { gA1((kt + 2) * 64, t2, a0, g); gloadB1((kt + 2) * 64, t2, b0, g); });
            compute2(0, 2, [&](int g) { sA1(1, a1, g); lstoreB1(1, b1, g); });
            __syncthreads();
            compute2(1, 0, [&](int g) { gA1((kt + 3) * 64, t2, a1, g); gloadB1((kt + 3) * 64, t2, b1, g); });
            compute2(1, 2, [&](int g) { sA1(0, a0, g); lstoreB1(0, b0, g); });
            __syncthreads();
        }
    } else {
    {
        u4v at0, at1;
        gloadA(0, true, 0);
        if (!(VAR & 2)) { at0 = buf_load_b128(ars, ao2, 0); at1 = buf_load_b128(ars, ao3, 0); } else { at0 = areg[0]; at1 = areg[1]; }
        gloadB(0, true, b0); gloadB(64, true, b1);
        lstoreA(0, 0);
        if (!(VAR & 16)) { char* ab = As + (ar + 128) * LROW + ac * 16; *(u4v*)(ab) = at0; *(u4v*)(ab + 64 * LROW) = at1; }
        lstoreB(0, b0);
    }
    __syncthreads();
    for (int kt = 0; kt < nk; kt += 2) {
        const bool t2 = kt + 2 < nk;
        gloadA((kt + 1) * 64, true, 0);
        compute2(0, 0, [&](int g) { if (g & 1) gloadB1((kt + 2) * 64, t2, b0, g >> 1); else lstoreB1(1, b1, g >> 1); });
        lstoreA(1, 0);
        gloadA((kt + 1) * 64, true, 1);
        compute2(0, 2, [&](int g) { if (g & 1) gloadB1((kt + 2) * 64, t2, b0, 4 + (g >> 1)); else lstoreB1(1, b1, 4 + (g >> 1)); });
        lstoreA(1, 1);
        __syncthreads();
        gloadA((kt + 2) * 64, t2, 0);
        compute2(1, 0, [&](int g) { if (g & 1) gloadB1((kt + 3) * 64, t2, b1, g >> 1); else lstoreB1(0, b0, g >> 1); });
        lstoreA(0, 0);
        gloadA((kt + 2) * 64, t2, 1);
        compute2(1, 2, [&](int g) { if (g & 1) gloadB1((kt + 3) * 64, t2, b1, 4 + (g >> 1)); else lstoreB1(0, b0, 4 + (g >> 1)); });
        lstoreA(0, 1);
        __syncthreads();
    }
    }
    if (VAR & 32) { float t = 0.f; for (int i = 0; i < NTW; ++i) t += acc[i][0][0] + acc[i][1][5]; if (t == 123.456f) *(float*)smem = t; }
    else epi(acc);
}

DEV void phase_ada(const Params& p, char* smem) {
    const int tid = get_tid();
    float* siluS = (float*)smem;
    float* red = (float*)(smem + NCOND * D * 4);
    for (int i = tid; i < NCOND * D; i += 512) {
        const int cnd = i / D, k = i % D;
        const float c = cnd == 0 ? p.in[I_CCTX][k] : p.in[I_C][(cnd - 1) * D + k];
        siluS[i] = c * frcp(1.f + fexp(-c));
    }
    __syncthreads();
    constexpr int CPL = 6 * D / 32, NCHUNK = DEPTH * CPL, KG = D / 16;
    float* mods = (float*)(p.ws + WS_MODS);
    const int col = tid & 31, kg = tid >> 5;
    for (int u = blockIdx.x; u < NCHUNK; u += gridDim.x) {
        const int l = u / CPL, c0 = (u % CPL) * 32;
        const float* W = p.in[I_ADAW] + (size_t)l * D * 6 * D + c0 + col;
        float acc[NCOND];
#pragma unroll
        for (int c = 0; c < NCOND; ++c) acc[c] = 0.f;
#pragma unroll 8
        for (int k = kg * KG; k < kg * KG + KG; ++k) {
            const float w = W[(size_t)k * 6 * D];
#pragma unroll
            for (int c = 0; c < NCOND; ++c) acc[c] += siluS[c * D + k] * w;
        }
#pragma unroll
        for (int c = 0; c < NCOND; ++c) red[(kg * NCOND + c) * 32 + col] = acc[c];
        __syncthreads();
        if (tid < 32 * NCOND) {
            const int c = tid >> 5, cc = tid & 31;
            float s = 0.f;
            for (int g = 0; g < 16; ++g) s += red[(g * NCOND + c) * 32 + cc];
            mods[((size_t)l * NCOND + c) * 6 * D + c0 + cc] = s + p.in[I_ADAB][(size_t)l * 6 * D + c0 + cc];
        }
        __syncthreads();
    }
    const int gtid = blockIdx.x * 512 + tid, gsz = gridDim.x * 512;
    float* rope = (float*)(p.ws + WS_ROPE);
    for (int i = gtid; i < 64 * 16; i += gsz) {
        const int pos = i >> 4, fi = i & 15;
        const float inv = fexp2(-(float)(2 * fi) * (13.287712379549449f / 32.f));
        const float ang = (float)pos * inv;
#ifdef EMU
        rope[2 * i] = cosf(ang); rope[2 * i + 1] = sinf(ang);
#else
        rope[2 * i] = __cosf(ang); rope[2 * i + 1] = __sinf(ang);
#endif
    }
    constexpr int NNA = DEC_BATCH * DEPTH * PAST * NAH * HD, NGQ = DEC_BATCH * DEPTH * PAST * GQKV * HD;
    bf16_t* cnak = (bf16_t*)(p.ws + WS_CNAK); bf16_t* cnav = (bf16_t*)(p.ws + WS_CNAV);
    bf16_t* cgqk = (bf16_t*)(p.ws + WS_CGQK); bf16_t* cgqv = (bf16_t*)(p.ws + WS_CGQV);
    for (int i = gtid; i < NNA; i += gsz) { cnak[i] = f2bf(p.in[I_CNAK][i]); cnav[i] = f2bf(p.in[I_CNAV][i]); }
    for (int i = gtid; i < NGQ; i += gsz) { cgqk[i] = f2bf(p.in[I_CGQK][i]); cgqv[i] = f2bf(p.in[I_CGQV][i]); }
}

constexpr int EPL = D / 64;
constexpr int W16ROW = 20;
template <int MODE>
DEV void phase_rows(const Params& p, char* smem, int l) {
    const int tid = get_tid(), lane = tid & 63, wave = tid >> 6;
    float* W16 = (float*)smem;
    const bool need_w = (MODE == 1) || (l < DEPTH);
    if (need_w) {
        for (int i = tid; i < D * 4; i += 512) {
            const int k = i >> 2, q = i & 3;
            const float* src = (MODE == 1) ? p.in[I_RW] + ((size_t)l * D + k) * 16 + q * 4 : p.in[I_WIN] + ((size_t)l * D + k) * PROJ_W + 2176 + q * 4;
            *(f4v*)(W16 + k * W16ROW + q * 4) = *(const f4v*)src;
        }
    }
    __syncthreads();
    const float* mods = (const float*)(p.ws + WS_MODS);
    auto load_row = [&](int t, float (&vr)[EPL], int& ms) {
        const float* rp = (MODE == 1) ? (const float*)(p.ws + WS_U) + (size_t)t * D
                        : (l == 0) ? (t < NP ? p.in[I_XP] + (size_t)t * D : p.in[I_XS] + (size_t)(t - NP) * D) : (const float*)(p.ws + WS_X1) + (size_t)t * D;
#pragma unroll
        for (int j = 0; j < EPL; ++j) vr[j] = rp[lane + 64 * j];
        if (MODE == 0 && l > 0) ms = lane < 16 ? ((const int*)(p.ws + WS_TOKSLOT))[(size_t)t * 16 + lane] : -1;
    };
    const int tstride = gridDim.x * 8;
    float vr[EPL]; int ms = -1;
    {
        const int t0 = blockIdx.x * 8 + wave;
        if (t0 < NT) load_row(t0, vr, ms);
    }
    for (int t = blockIdx.x * 8 + wave; t < NT; t += tstride) {
        const int cnd = tok_cond(t);
        float vn[EPL]; int msn = -1;
#pragma unroll
        for (int j = 0; j < EPL; ++j) vn[j] = 0.f;
        if (t + tstride < NT) load_row(t + tstride, vn, msn);
        float v[EPL];
        if (MODE == 0 && l > 0) {
            const float* g2 = mods + ((size_t)(l - 1) * NCOND + cnd) * 6 * D + 5 * D;
            float f[EPL], gv[EPL];
#pragma unroll
            for (int j = 0; j < EPL; ++j) { f[j] = 0.f; gv[j] = g2[lane + 64 * j]; }
            const int myslot = ms;
            unsigned vm = (unsigned)__ballot(myslot >= 0);
            while (vm) {
                const int e = __builtin_ctz(vm); vm &= vm - 1u;
                const int slot = __shfl(myslot, e);
                const bf16_t* yr = (const bf16_t*)(p.ws + WS_YE) + ((size_t)e * SLOTS + slot) * D;
#pragma unroll
                for (int j = 0; j < EPL; ++j) f[j] += bf2f(yr[lane + 64 * j]);
            }
#pragma unroll
            for (int j = 0; j < EPL; ++j) v[j] = ALPHA * vr[j] + gv[j] * f[j];
        } else {
#pragma unroll
            for (int j = 0; j < EPL; ++j) v[j] = vr[j];
        }
#pragma unroll
        for (int j = 0; j < EPL; ++j) vr[j] = vn[j];
        ms = msn;
        if (!(MODE == 0 && l == 0)) {
            const int li = (MODE == 0) ? (l - 1) * 2 + 1 : l * 2;
            const float* lg = p.in[I_LNG] + (size_t)li * D; const float* lb = p.in[I_LNB] + (size_t)li * D;
            float g[EPL], bb[EPL];
#pragma unroll
            for (int j = 0; j < EPL; ++j) { g[j] = lg[lane + 64 * j]; bb[j] = lb[lane + 64 * j]; }
            float s = 0.f;
#pragma unroll
            for (int j = 0; j < EPL; ++j) s += v[j];
            const float mu = wave_sum(s) * (1.f / D);
            float q = 0.f;
#pragma unroll
            for (int j = 0; j < EPL; ++j) { const float dlt = v[j] - mu; q += dlt * dlt; }
            const float rstd = frsqrt(wave_sum(q) * (1.f / D) + EPS);
            float* dst = (MODE == 1) ? (float*)(p.ws + WS_X1) + (size_t)t * D
                       : (l == DEPTH) ? (t < NP ? p.out + O_YP + (size_t)t * D : p.out + O_YS + (size_t)(t - NP) * D) : (float*)(p.ws + WS_XBUF) + (size_t)t * D;
#pragma unroll
            for (int j = 0; j < EPL; ++j) { v[j] = (v[j] - mu) * rstd * g[j] + bb[j]; dst[lane + 64 * j] = v[j]; }
        }
        if (MODE == 1 || l < DEPTH) {
            const float* sh = mods + ((size_t)l * NCOND + cnd) * 6 * D + (MODE == 1 ? 3 * D : 0); const float* sc = sh + D;
            bf16_t* hb = (bf16_t*)(p.ws + (MODE == 1 ? WS_H2 : WS_HMOD)) + (size_t)t * D;
            {
                float s1[EPL], s0[EPL];
#pragma unroll
                for (int j = 0; j < EPL; ++j) { s1[j] = sc[lane + 64 * j]; s0[j] = sh[lane + 64 * j]; }
#pragma unroll
                for (int j = 0; j < EPL; ++j) { v[j] = v[j] * (1.f + s1[j]) + s0[j]; hb[lane + 64 * j] = f2bf(v[j]); }
            }
            CFENCE();
            float a16[16];
#pragma unroll
            for (int e = 0; e < 16; ++e) a16[e] = 0.f;
#pragma unroll
            for (int j = 0; j < EPL; ++j) {
                const float hv = v[j];
                const float* wr = W16 + (lane + 64 * j) * W16ROW;
#pragma unroll
                for (int q = 0; q < 4; ++q) { const f4v w4 = *(const f4v*)(wr + 4 * q); a16[4 * q] += hv * w4[0]; a16[4 * q + 1] += hv * w4[1]; a16[4 * q + 2] += hv * w4[2]; a16[4 * q + 3] += hv * w4[3]; }
                if (j & 1) CFENCE();
            }
            float mine = -1e30f;
#pragma unroll
            for (int e = 0; e < 16; ++e) { const float sm = wave_sum(a16[e]); if (lane == e) mine = sm; }
            if (MODE == 0) {
                if (lane < 16) ((float*)(p.ws + WS_GATES))[(size_t)t * 16 + lane] = mine + p.in[I_BGATE][l * 16 + lane];
            } else {
                float mx = mine;
                for (int m = 8; m >= 1; m >>= 1) mx = fmaxf(mx, __shfl_xor(mx, m));
                const float ex = lane < 16 ? fexp(mine - mx) : 0.f;
                float sm = ex;
                for (int m = 8; m >= 1; m >>= 1) sm += __shfl_xor(sm, m);
                if (lane < 16) ((float*)(p.ws + WS_AFF))[(size_t)t * 16 + lane] = ex / sm;
            }
        }
    }
}

template <int NPL>
DEV void topk_wave(const Params& p, int tb, int cap, int sbase, int e, int lane) {
    const float* aff = (const float*)(p.ws + WS_AFF);
    int* idx = (int*)(p.ws + WS_IDX); float* gsel = (float*)(p.ws + WS_GSEL); int* tokslot = (int*)(p.ws + WS_TOKSLOT);
    unsigned bits[NPL];
#pragma unroll
    for (int i = 0; i < NPL; ++i) bits[i] = __builtin_bit_cast(unsigned, aff[(size_t)(tb + lane + 64 * i) * 16 + e]);
    unsigned T = 0u;
    for (int b = 30; b >= 0; --b) {
        const unsigned cand = T | (1u << b);
        int cnt = 0;
#pragma unroll
        for (int i = 0; i < NPL; ++i) cnt += __popcll(__ballot(bits[i] >= cand));
        if (cnt >= cap) T = cand;
    }
    int ngt = 0;
#pragma unroll
    for (int i = 0; i < NPL; ++i) ngt += __popcll(__ballot(bits[i] > T));
    int need_eq = cap - ngt, run = 0;
    const unsigned long long lt = (1ull << lane) - 1ull;
#pragma unroll
    for (int i = 0; i < NPL; ++i) {
        const bool eq = bits[i] == T;
        const unsigned long long meq = __ballot(eq);
        const int eqrank = __popcll(meq & lt);
        const bool sel = bits[i] > T || (eq && eqrank < need_eq);
        const unsigned long long ms = __ballot(sel);
        const int t = tb + lane + 64 * i;
        if (sel) { const int slot = sbase + run + __popcll(ms & lt); idx[e * SLOTS + slot] = t; gsel[e * SLOTS + slot] = __builtin_bit_cast(float, bits[i]); tokslot[(size_t)t * 16 + e] = slot; }
        else tokslot[(size_t)t * 16 + e] = -1;
        run += __popcll(ms);
        const int neq = __popcll(meq); need_eq -= neq < need_eq ? neq : need_eq;
    }
}
DEV void phase_topk(const Params& p, char* smem) {
    (void)smem;
    const int tid = get_tid(), lane = tid & 63;
    constexpr int US = DEC_BATCH * NEXP, UP = BATCH * NEXP;
    const int gw = blockIdx.x + gridDim.x * (tid >> 6), nw = gridDim.x * 8;
    for (int u = gw; u < US + UP; u += nw) {
        if (u < US) { const int b = u / NEXP, e = u % NEXP; topk_wave<DEC_SEQ / 64>(p, NP + b * DEC_SEQ, CAP_S, BATCH * CAP_P + b * CAP_S, e, lane); }
        else { const int uu = u - US; const int b = uu / NEXP, e = uu % NEXP; topk_wave<SEQ / 64>(p, b * SEQ, CAP_P, b * CAP_P, e, lane); }
    }
}

DEV void store_head_f32(float* dst_f32, const f16v& v0, const f16v& v1, int h) {
#pragma unroll
    for (int ft = 0; ft < 2; ++ft) {
        const f16v& v = ft ? v1 : v0;
#pragma unroll
        for (int g = 0; g < 4; ++g) { f4v o; o[0] = v[4 * g]; o[1] = v[4 * g + 1]; o[2] = v[4 * g + 2]; o[3] = v[4 * g + 3]; *(f4v*)(dst_f32 + ft * 32 + 8 * g + 4 * h) = o; }
    }
}
template <int VAR>
DEV void phase_inproj(const Params& p, char* smem, int l) {
    constexpr int NJ = 22, NU = (NT / 256) * NJ;
    const int tid = get_tid(), lane = tid & 63, wave = tid >> 6, wm = wave & 3, wn = wave >> 2, h = lane >> 5, l31 = lane & 31;
    const bf16_t* hmod = (const bf16_t*)(p.ws + WS_HMOD);
    const float* rope = (const float*)(p.ws + WS_ROPE);
    constexpr int NMB = NT / 256, RPX = (NMB % 8 == 0) ? NMB / 8 : NMB;
    const UnitIter it = unit_iter(NU);
    for (int u = it.i; u < it.end; u += it.step) {
        const int mb = (u / (RPX * NJ)) * RPX + u % RPX, j = (u / RPX) % NJ;
        const int colbase = j < 17 ? 128 * j : 2192 + 128 * (j - 17);
        const unsigned ao = ((unsigned)(mb * 256 + (tid >> 3)) * D + (tid & 7) * 8) * 2;
        const unsigned bvo = (unsigned)(colbase + 4 * (tid & 31)) * 4 + (unsigned)(tid >> 5) * (PROJ_W * 4);
        const unsigned blds = (unsigned)(tid >> 5) * 320u + (unsigned)(tid & 31) * 8u;
        gemm_tile<2, VAR>(smem, make_rsrc(hmod), ao, ao + 128u * D, ao + 256u * D, ao + 384u * D, make_rsrc(p.in[I_WIN] + (size_t)l * D * PROJ_W), bvo, blds, PROJ_W * 4, D, [&](f16v (&acc)[2][2]) {
            int lane_e = lane; VGPR_PIN(lane_e); const int lane = lane_e, l31 = lane_e & 31, h = lane_e >> 5; (void)l31; (void)h;
            const int cb = colbase + wn * 64;
            char* stg = wave_stage_ptr(smem, wave);
            const int t0 = mb * 256 + wm * 64;
            const bool isP = t0 < NP;
            bf16_t* dstb; size_t dstride;
            int f32out = 0, fhead = 0, fheads = 0; size_t fbase = 0;
            int mode = 0;
            if (cb < 1152) {
                const int seg = cb / 384, head = (cb % 384) / 64;
                dstb = (bf16_t*)(p.ws + (seg == 0 ? WS_NAQ : seg == 1 ? WS_NAK : WS_NAV)) + (size_t)t0 * 384 + head * 64; dstride = 384;
                if (seg >= 1 && isP) { f32out = 1; fbase = seg == 1 ? O_NAK : O_NAV; fhead = head; fheads = NAH; }
            } else if (cb < 2176) {
                const int seg = (cb - 1152) / 256, head = ((cb - 1152) % 256) / 64;
                dstb = (bf16_t*)(p.ws + (seg == 0 ? WS_MLQ : seg == 1 ? WS_MLK : seg == 2 ? WS_MLV : WS_MLO)) + (size_t)t0 * 256 + head * 64; dstride = 256;
                mode = seg == 1 ? 1 : 0;
            } else {
                const int c2 = cb - 2192;
                if (c2 < 384) { dstb = (bf16_t*)(p.ws + WS_GQQ) + (size_t)t0 * 384 + (c2 / 64) * 64; dstride = 384; mode = 2; }
                else if (c2 < 512) { const int head = (c2 - 384) / 64; dstb = (bf16_t*)(p.ws + WS_GQK) + (size_t)t0 * 128 + head * 64; dstride = 128; mode = 3;
                                     if (isP) { f32out = 1; fbase = O_GQK; fhead = head; fheads = GQKV; } }
                else { const int head = (c2 - 512) / 64; dstb = (bf16_t*)(p.ws + WS_GQV) + (size_t)t0 * 128 + head * 64; dstride = 128;
                       if (isP) { f32out = 1; fbase = O_GQV; fhead = head; fheads = GQKV; } }
            }
#pragma unroll
            for (int tt = 0; tt < 2; ++tt) {
                const int t = t0 + tt * 32 + l31;
                f16v v0 = acc[0][tt], v1 = acc[1][tt];
                if (mode == 1) { v0 *= ATT_SCALE; v1 *= ATT_SCALE; }
                if (mode >= 2) {
                    float ss = 0.f;
#pragma unroll
                    for (int r = 0; r < 16; ++r) ss += v0[r] * v0[r] + v1[r] * v1[r];
                    ss += __shfl_xor(ss, 32);
                    const float rn = frsqrt(ss * (1.f / 64.f) + EPS);
                    const float* gq = p.in[I_QKG] + ((size_t)l * 2 + (mode == 2 ? 0 : 1)) * 64;
#pragma unroll
                    for (int r = 0; r < 16; ++r) {
                        const int d = (r & 3) + 8 * (r >> 2) + 4 * h;
                        v0[r] *= rn * gq[d]; v1[r] *= rn * gq[32 + d];
                    }
                }
                if (f32out) { const int bP = t / SEQ, sP = t % SEQ; store_head_f32(p.out + fbase + ((((size_t)bP * DEPTH + l) * SEQ + sP) * fheads + fhead) * 64, v0, v1, h); }
                if (mode >= 2 && !isP) {
                    const int pos = (t - NP) % DEC_SEQ, prow = pos / GRIDW, pcol = pos % GRIDW;
#pragma unroll
                    for (int rr = 0; rr < 8; ++rr) {
                        const int fi = (rr & 3) + 8 * ((rr >> 2) & 1) + 4 * h;
                        const float c0 = rope[(prow * 16 + fi) * 2], s0 = rope[(prow * 16 + fi) * 2 + 1];
                        const float c1 = rope[(pcol * 16 + fi) * 2], s1 = rope[(pcol * 16 + fi) * 2 + 1];
                        const float a_lo = v0[rr], a_hi = v0[rr + 8]; v0[rr] = a_lo * c0 - a_hi * s0; v0[rr + 8] = a_hi * c0 + a_lo * s0;
                        const float b_lo = v1[rr], b_hi = v1[rr + 8]; v1[rr] = b_lo * c1 - b_hi * s1; v1[rr + 8] = b_hi * c1 + b_lo * s1;
                    }
                }
                stage64_write_bf16(stg, tt, v0, v1, l31, h);
            }
            stage64_flush_bf16(stg, dstb, dstride, lane);
        });
    }
}

template <int VAR>
DEV void phase_outproj(const Params& p, char* smem, int l) {
    constexpr int NC = D / 128, NU = (NT / 256) * NC;
    const int tid = get_tid(), lane = tid & 63, wave = tid >> 6, wm = wave & 3, wn = wave >> 2, h = lane >> 5, l31 = lane & 31;
    const bf16_t* mixed = (const bf16_t*)(p.ws + WS_MIXED);
    const float* mods = (const float*)(p.ws + WS_MODS);
    float* U = (float*)(p.ws + WS_U);
    constexpr int NMB = NT / 256, RPX = (NMB % 8 == 0) ? NMB / 8 : NMB;
    const UnitIter it = unit_iter(NU);
    for (int u = it.i; u < it.end; u += it.step) {
        const int mb = (u / (RPX * NC)) * RPX + u % RPX, cbk = (u / RPX) % NC;
        const unsigned ao = ((unsigned)(mb * 256 + (tid >> 3)) * MIXW + (tid & 7) * 8) * 2;
        const unsigned bvo = (unsigned)(cbk * 128 + 4 * (tid & 31)) * 4 + (unsigned)(tid >> 5) * (D * 4);
        const unsigned blds = (unsigned)(tid >> 5) * 320u + (unsigned)(tid & 31) * 8u;
        gemm_tile<2, VAR>(smem, make_rsrc(mixed), ao, ao + 128u * MIXW, ao + 256u * MIXW, ao + 384u * MIXW, make_rsrc(p.in[I_WOUT] + (size_t)l * MIXW * D), bvo, blds, D * 4, MIXW, [&](f16v (&acc)[2][2]) {
            int lane_e = lane; VGPR_PIN(lane_e); const int lane = lane_e, l31 = lane_e & 31, h = lane_e >> 5; (void)l31; (void)h;
            char* stg = wave_stage_ptr(smem, wave);
            const int t0 = mb * 256 + wm * 64;
            const float* g1 = mods + ((size_t)l * NCOND + tok_cond(t0)) * 6 * D + 2 * D;
#pragma unroll
            for (int ft = 0; ft < 2; ++ft) {
#pragma unroll
                for (int tt = 0; tt < 2; ++tt)
#pragma unroll
                    for (int g = 0; g < 4; ++g) { f4v o; o[0] = acc[ft][tt][4 * g]; o[1] = acc[ft][tt][4 * g + 1]; o[2] = acc[ft][tt][4 * g + 2]; o[3] = acc[ft][tt][4 * g + 3];
                        *(f4v*)(stg + (tt * 32 + l31) * LROW + (8 * g + 4 * h) * 4) = o; }
                WAVE_SYNC();
                const int f0 = cbk * 128 + wn * 64 + ft * 32 + (lane & 7) * 4;
                const f4v gv = *(const f4v*)(g1 + f0);
#pragma unroll
                for (int i = 0; i < 8; ++i) {
                    const int r = (lane >> 3) + 8 * i, t = t0 + r;
                    const f4v a = *(const f4v*)(stg + r * LROW + (lane & 7) * 16);
                    const float* xr = (l == 0) ? (t < NP ? p.in[I_XP] + (size_t)t * D : p.in[I_XS] + (size_t)(t - NP) * D) : (const float*)(p.ws + WS_XBUF) + (size_t)t * D;
                    const f4v xv = *(const f4v*)(xr + f0);
                    f4v o;
#pragma unroll
                    for (int q = 0; q < 4; ++q) o[q] = ALPHA * xv[q] + gv[q] * a[q];
                    *(f4v*)(U + (size_t)t * D + f0) = o;
                }
                WAVE_SYNC();
            }
        });
    }
}

template <int VAR>
DEV void phase_gateup(const Params& p, char* smem, int l) {
    constexpr int NRB = SLOTS / 256, NCB = EH / 128, NU = NEXP * NCB * NRB;
    const int tid = get_tid(), lane = tid & 63, wave = tid >> 6, wm = wave & 3, wn = wave >> 2, h = lane >> 5, l31 = lane & 31;
    const bf16_t* h2 = (const bf16_t*)(p.ws + WS_H2);
    const int* idx = (const int*)(p.ws + WS_IDX);
    bf16_t* hid = (bf16_t*)(p.ws + WS_HID);
    constexpr int TPC = NU / 8;
#ifdef GU_FORCE_HALF
    constexpr int HT = GU_FORCE_HALF;
#else
    constexpr int HT = (NU % 8 == 0 && TPC % 32 == 16) ? 16 : 0;
#endif
    constexpr int UPC = TPC + HT;
    const bool chunked = (gridDim.x & 7) == 0 && (NU & 7) == 0;
    const UnitIter it = unit_iter(chunked ? 8 * UPC : NU);
    for (int uu = it.i; uu < it.end; uu += it.step) {
        int u = uu, half = -1;
        if (chunked) { const int x = uu / UPC, v = uu % UPC; if (v < TPC - HT) u = x * TPC + v; else { const int hv = v - (TPC - HT); u = x * TPC + (TPC - HT) + (hv >> 1); half = hv & 1; } }
        const int rb = u % NRB, cbk = (u / NRB) % NCB, e = u / (NRB * NCB);
        const int* ip = idx + e * SLOTS + rb * 256 + (tid >> 3);
        const unsigned a0 = ((unsigned)ip[0] * D + (tid & 7) * 8) * 2, a1 = ((unsigned)ip[64] * D + (tid & 7) * 8) * 2;
        const unsigned a2 = ((unsigned)ip[128] * D + (tid & 7) * 8) * 2, a3 = ((unsigned)ip[192] * D + (tid & 7) * 8) * 2;
#ifdef EMU
        const int bw = tid >> 6;
#else
        const int bw = __builtin_amdgcn_readfirstlane(tid >> 6);
#endif
        const int is_up = bw & 1;
        const float* wmat = (is_up ? p.in[I_WU] : p.in[I_WG]) + ((size_t)l * NEXP + e) * D * EH;
        if (half < 0) {
        const int bkr = 2 * (bw >> 1) + ((tid >> 5) & 1), hc = 4 * (tid & 31);
        const int ncol = (hc >> 6) * 128 + (2 * ((hc >> 5) & 1) + is_up) * 32 + (hc & 31);
        const unsigned bvo = (unsigned)(cbk * 128 + hc) * 4 + (unsigned)bkr * (EH * 4);
        const unsigned blds = (unsigned)bkr * 576u + (unsigned)ncol * 2u;
        gemm_tile<4, VAR>(smem, make_rsrc(h2), a0, a1, a2, a3, make_rsrc(wmat), bvo, blds, EH * 4, D, [&](f16v (&acc)[4][2]) {
            int lane_e = lane; VGPR_PIN(lane_e); const int lane = lane_e, l31 = lane_e & 31, h = lane_e >> 5; (void)l31; (void)h;
            char* stg = wave_stage_ptr(smem, wave);
#pragma unroll
            for (int tt = 0; tt < 2; ++tt)
#pragma unroll
                for (int pr = 0; pr < 2; ++pr)
#pragma unroll
                    for (int g = 0; g < 4; ++g) {
                        float o[4];
#pragma unroll
                        for (int q = 0; q < 4; ++q) o[q] = siluf_(acc[2 * pr][tt][4 * g + q]) * acc[2 * pr + 1][tt][4 * g + q];
                        stage64_write4(stg, tt * 32 + l31, pr * 32 + 8 * g + 4 * h, o[0], o[1], o[2], o[3]);
                    }
            stage64_flush_bf16(stg, hid + ((size_t)e * SLOTS + rb * 256 + wm * 64) * EH + cbk * 128 + wn * 64, EH, lane);
        });
        } else {
        const int bkr = 4 * (bw >> 1) + ((tid >> 4) & 3), hc = 4 * (tid & 15);
        const int ncol = (hc >> 5) * 64 + is_up * 32 + (hc & 31);
        const unsigned bvo = (unsigned)(cbk * 128 + half * 64 + hc) * 4 + (unsigned)bkr * (EH * 4);
        const unsigned blds = (unsigned)bkr * 320u + (unsigned)ncol * 2u;
        gemm_tile<2, VAR>(smem, make_rsrc(h2), a0, a1, a2, a3, make_rsrc(wmat), bvo, blds, EH * 4, D, [&](f16v (&acc)[2][2]) {
            int lane_e = lane; VGPR_PIN(lane_e); const int lane = lane_e, l31 = lane_e & 31, h = lane_e >> 5; (void)l31; (void)h;
            char* stg = wave_stage_ptr(smem, wave);
#pragma unroll
            for (int tt = 0; tt < 2; ++tt)
#pragma unroll
                for (int g = 0; g < 4; ++g) {
                    float o[4];
#pragma unroll
                    for (int q = 0; q < 4; ++q) o[q] = siluf_(acc[0][tt][4 * g + q]) * acc[1][tt][4 * g + q];
                    stage64_write4(stg, tt * 32 + l31, 8 * g + 4 * h, o[0], o[1], o[2], o[3]);
                }
            WAVE_SYNC();
            bf16_t* dst0 = hid + ((size_t)e * SLOTS + rb * 256 + wm * 64) * EH + cbk * 128 + half * 64 + wn * 32;
#pragma unroll
            for (int i = 0; i < 4; ++i) { const int r = (lane >> 2) + 16 * i, c = lane & 3; const u4v v = *(const u4v*)(stg + r * LROW + c * 16); *(u4v*)(dst0 + (size_t)r * EH + c * 8) = v; }
            WAVE_SYNC();
        });
        }
    }
}

template <int VAR>
DEV void phase_down(const Params& p, char* smem, int l) {
    constexpr int NRB = SLOTS / 256, NCB = D / 256, NU = NEXP * NCB * NRB;
    const int tid = get_tid(), lane = tid & 63, wave = tid >> 6, wm = wave & 3, wn = wave >> 2, h = lane >> 5, l31 = lane & 31;
    const bf16_t* hid = (const bf16_t*)(p.ws + WS_HID);
    const float* gsel = (const float*)(p.ws + WS_GSEL);
    bf16_t* ye = (bf16_t*)(p.ws + WS_YE);
    const UnitIter it = unit_iter(NU);
    for (int u = it.i; u < it.end; u += it.step) {
        const int rb = u % NRB, cbk = (u / NRB) % NCB, e = u / (NRB * NCB);
        const unsigned ao = ((unsigned)(rb * 256 + (tid >> 3)) * EH + (tid & 7) * 8) * 2;
        const unsigned bvo = (unsigned)(cbk * 256 + 4 * (tid & 63)) * 4 + (unsigned)(tid >> 6) * (D * 4);
        const unsigned blds = (unsigned)(tid >> 6) * 576u + (unsigned)(tid & 63) * 8u;
        gemm_tile<4, VAR>(smem, make_rsrc(hid + (size_t)e * SLOTS * EH), ao, ao + 128u * EH, ao + 256u * EH, ao + 384u * EH, make_rsrc(p.in[I_WD] + ((size_t)l * NEXP + e) * EH * D), bvo, blds, D * 4, EH, [&](f16v (&acc)[4][2]) {
            int lane_e = lane; VGPR_PIN(lane_e); const int lane = lane_e, l31 = lane_e & 31, h = lane_e >> 5; (void)l31; (void)h;
            char* stg = wave_stage_ptr(smem, wave);
            const float gs0 = gsel[e * SLOTS + rb * 256 + wm * 64 + l31], gs1 = gsel[e * SLOTS + rb * 256 + wm * 64 + 32 + l31];
#pragma unroll
            for (int hb = 0; hb < 2; ++hb) {
#pragma unroll
                for (int tt = 0; tt < 2; ++tt) {
                    const float gs = tt ? gs1 : gs0;
#pragma unroll
                    for (int f2 = 0; f2 < 2; ++f2)
#pragma unroll
                        for (int g = 0; g < 4; ++g) { const f16v& a = acc[2 * hb + f2][tt]; stage64_write4(stg, tt * 32 + l31, f2 * 32 + 8 * g + 4 * h, a[4 * g] * gs, a[4 * g + 1] * gs, a[4 * g + 2] * gs, a[4 * g + 3] * gs); }
                }
                stage64_flush_bf16(stg, ye + ((size_t)e * SLOTS + rb * 256 + wm * 64) * D + cbk * 256 + wn * 128 + hb * 64, D, lane);
            }
        });
    }
}

struct AttnDesc {
    const bf16_t* q; int qstride;
    int ntiles, n0;
    const bf16_t *k0, *v0; int stride0;
    const bf16_t *k1, *v1; int stride1;
    int na;
    int r0, rlo;
    const float* rpb;
    bf16_t* out; int ostride;
    float* part;
};
constexpr int ATT_TILE = 64 * LROW;
DEV int na_row_start(int r) { int s = r - KR / 2; s = s < 0 ? 0 : s; return s > ROWS - KR ? ROWS - KR : s; }
DEV void attn_unit(char* smem, const AttnDesc& d) {
    const int tid = get_tid(), lane = tid & 63, wave = tid >> 6, h = lane >> 5, l31 = lane & 31;
    char* Ks = smem; char* Vs = smem + 2 * ATT_TILE; float* rpbS = (float*)(smem + 4 * ATT_TILE);
    if (d.na) { for (int i = tid; i < 15 * 31; i += 512) rpbS[i] = d.rpb[i] * 1.4426950408889634f; }
    const bf16_t* qp = d.q + (size_t)(wave * 32 + l31) * d.qstride + h * 8;
    s8v qf[4];
#pragma unroll
    for (int s = 0; s < 4; ++s) qf[s] = *(const s8v*)(qp + 16 * s);
    float m_run = -1e30f, l_run = 0.f;
    f16v o[2]; o[0] = f16zero(); o[1] = f16zero();
    const int srow = tid >> 3, sch = tid & 7;
    u4v kreg, vreg;
    auto gload = [&](int t) {
        const bf16_t *kp, *vp;
        if (t < d.n0) { const size_t off = (size_t)(t * 64 + srow) * d.stride0 + sch * 8; kp = d.k0 + off; vp = d.v0 + off; }
        else { const size_t off = (size_t)((t - d.n0) * 64 + srow) * d.stride1 + sch * 8; kp = d.k1 + off; vp = d.v1 + off; }
        kreg = *(const u4v*)kp; vreg = *(const u4v*)vp;
    };
    auto lstore = [&](int buf) { *(u4v*)(Ks + buf * ATT_TILE + srow * LROW + sch * 16) = kreg; *(u4v*)(Vs + buf * ATT_TILE + srow * LROW + sch * 16) = vreg; };
    const int qr = d.r0 + (wave >> 1), qw = (wave & 1) * 32 + l31;
    const int rs = na_row_start(qr);
    int cs = qw - KC / 2; cs = cs < 0 ? 0 : (cs > GRIDW - KC ? GRIDW - KC : cs);
    gload(0); lstore(0);
    __syncthreads();
    for (int t = 0; t < d.ntiles; ++t) {
        const int buf = t & 1;
        if (t + 1 < d.ntiles) gload(t + 1);
        const bool local = d.na && t >= d.n0;
        const int kr = d.rlo + (t - d.n0);
        const bool active = !local || (kr >= rs && kr < rs + KR);
        if (active) {
            const char* kb = Ks + buf * ATT_TILE + l31 * LROW + h * 16;
            f16v sa[2];
#pragma unroll
            for (int kt = 0; kt < 2; ++kt) {
                sa[kt] = f16zero();
#pragma unroll
                for (int s = 0; s < 4; ++s) { const s8v kf = *(const s8v*)(kb + kt * 32 * LROW + s * 32); sa[kt] = mfma32(kf, qf[s], sa[kt]); }
            }
            constexpr float C2 = ATT_SCALE * 1.4426950408889634f;
            float mx = -1e30f;
            if (local) {
#pragma unroll
                for (int kt = 0; kt < 2; ++kt)
#pragma unroll
                    for (int r = 0; r < 16; ++r) {
                        const int kc = kt * 32 + (r & 3) + 8 * (r >> 2) + 4 * h;
                        const bool inw = kc >= cs && kc < cs + KC;
                        const int bi = (kr - qr + 7) * 31 + (kc - qw + 15);
                        const float v = inw ? sa[kt][r] * C2 + rpbS[inw ? bi : 0] : -1e30f;
                        sa[kt][r] = v; mx = fmaxf(mx, v);
                    }
            } else {
#pragma unroll
                for (int kt = 0; kt < 2; ++kt)
#pragma unroll
                    for (int r = 0; r < 16; ++r) mx = fmaxf(mx, sa[kt][r]);
                mx *= C2;
            }
            mx = fmaxf(mx, __shfl_xor(mx, 32));
            if (__ballot(mx > m_run) != 0ull) {
                const float m_new = fmaxf(m_run, mx);
                const float alpha = fexp2(m_run - m_new);
                l_run *= alpha; m_run = m_new;
                o[0] *= alpha; o[1] *= alpha;
            }
            float ps = 0.f;
            if (local) {
#pragma unroll
                for (int kt = 0; kt < 2; ++kt)
#pragma unroll
                    for (int r = 0; r < 16; ++r) { const float pv = fexp2(sa[kt][r] - m_run); sa[kt][r] = pv; ps += pv; }
            } else {
#pragma unroll
                for (int kt = 0; kt < 2; ++kt)
#pragma unroll
                    for (int r = 0; r < 16; ++r) { const float pv = fexp2(sa[kt][r] * C2 - m_run); sa[kt][r] = pv; ps += pv; }
            }
            l_run += ps;
            const char* vb = Vs + buf * ATT_TILE + (4 * h + ((lane & 15) >> 2)) * LROW + (((lane >> 4) & 1) * 16 + 4 * (lane & 3)) * 2;
#pragma unroll
            for (int ks = 0; ks < 4; ++ks) {
                const int kt = ks >> 1, rb = 8 * (ks & 1);
                u4v pk; pk[0] = pack2(sa[kt][rb], sa[kt][rb + 1]); pk[1] = pack2(sa[kt][rb + 2], sa[kt][rb + 3]);
                pk[2] = pack2(sa[kt][rb + 4], sa[kt][rb + 5]); pk[3] = pack2(sa[kt][rb + 6], sa[kt][rb + 7]);
                const s8v pf = __builtin_bit_cast(s8v, pk);
                const char* vk = vb + (kt * 32 + 16 * (ks & 1)) * LROW;
#pragma unroll
                for (int dt = 0; dt < 2; ++dt) {
                    const s4v lo = lds_tr16(vk + dt * 64), hi = lds_tr16(vk + 8 * LROW + dt * 64);
                    s8v vf; vf[0] = lo[0]; vf[1] = lo[1]; vf[2] = lo[2]; vf[3] = lo[3]; vf[4] = hi[0]; vf[5] = hi[1]; vf[6] = hi[2]; vf[7] = hi[3];
                    o[dt] = mfma32(vf, pf, o[dt]);
                }
            }
        }
        if (t + 1 < d.ntiles) lstore(buf ^ 1);
        __syncthreads();
    }
    const float l_tot = l_run + __shfl_xor(l_run, 32);
    const int qrow = wave * 32 + l31;
    if (d.part) {
        float* po = d.part + (size_t)qrow * 64;
#pragma unroll
        for (int dt = 0; dt < 2; ++dt)
#pragma unroll
            for (int g = 0; g < 4; ++g) { f4v v; v[0] = o[dt][4 * g]; v[1] = o[dt][4 * g + 1]; v[2] = o[dt][4 * g + 2]; v[3] = o[dt][4 * g + 3]; *(f4v*)(po + dt * 32 + 8 * g + 4 * h) = v; }
        if (h == 0) { d.part[256 * 64 + qrow] = m_run; d.part[256 * 64 + 256 + qrow] = l_tot; }
    } else {
        const float inv = 1.f / l_tot;
        bf16_t* po = d.out + (size_t)qrow * d.ostride;
#pragma unroll
        for (int dt = 0; dt < 2; ++dt)
#pragma unroll
            for (int g = 0; g < 4; ++g) {
                u2v pk; pk[0] = pack2(o[dt][4 * g] * inv, o[dt][4 * g + 1] * inv); pk[1] = pack2(o[dt][4 * g + 2] * inv, o[dt][4 * g + 3] * inv);
                *(u2v*)(po + dt * 32 + 8 * g + 4 * h) = pk;
            }
    }
}

DEV int ml_sidx(int grp, int b, int head, int c) { return grp == 0 ? ((b * MLH + head) * NCH_P + c) : BATCH * MLH * NCH_P + ((b * MLH + head) * NCH_S + c); }
DEV float lane_prefix_sum(float v, int lane) { for (int dlt = 1; dlt < 64; dlt <<= 1) { const float o = __shfl(v, lane - dlt); if (lane >= dlt) v += o; } return v; }
DEV float lane_prefix_max(float v, int lane) { for (int dlt = 1; dlt < 64; dlt <<= 1) { const float o = __shfl(v, lane - dlt); if (lane >= dlt) v = fmaxf(v, o); } return v; }

DEV void mlstm_summary_unit(const Params& p, char* smem, int grp, int b, int head, int c) {
    const int tid = get_tid(), lane = tid & 63, wave = tid >> 6, h = lane >> 5, l31 = lane & 31;
    char* KT = smem;
    char* VT = smem + 2 * ATT_TILE;
    float* wsS = (float*)(smem + 3 * ATT_TILE);
    float* scal = wsS + 128;
    const int tb = (grp == 0 ? b * SEQ : NP + b * DEC_SEQ) + c * 64;
    const float* gates = (const float*)(p.ws + WS_GATES);
    if (wave == 0) {
        const float* gr = gates + (size_t)(tb + lane) * 16;
        const float i_f = gr[head], lf_f = logsigmoidf_(gr[4 + head]), i_b = gr[8 + head], lf_b = logsigmoidf_(gr[12 + head]);
        const float pf = lane_prefix_sum(lf_f, lane), pb = lane_prefix_sum(lf_b, lane);
        const float tot_f = __shfl(pf, 63), tot_b = __shfl(pb, 63);
        const float g_f = (tot_f - pf) + i_f, g_b = (pb - lf_b) + i_b;
        const float G_f = wave_max(g_f), G_b = wave_max(g_b);
        wsS[lane] = fexp(g_f - G_f); wsS[64 + lane] = fexp(g_b - G_b);
        if (lane == 0) { scal[0] = tot_f; scal[1] = tot_b; scal[2] = G_f; scal[3] = G_b; }
    }
    __syncthreads();
    {
        const int tau = tid >> 3, ch = tid & 7;
        const u4v kv = *(const u4v*)((const bf16_t*)(p.ws + WS_MLK) + (size_t)(tb + tau) * 256 + head * 64 + ch * 8);
        const u4v vv = *(const u4v*)((const bf16_t*)(p.ws + WS_MLV) + (size_t)(tb + tau) * 256 + head * 64 + ch * 8);
        const float wf = wsS[tau], wb = wsS[64 + tau];
#pragma unroll
        for (int j = 0; j < 8; ++j) {
            const bf16_t kb = (bf16_t)(kv[j >> 1] >> (16 * (j & 1))), vb = (bf16_t)(vv[j >> 1] >> (16 * (j & 1)));
            const int dim = ch * 8 + j; const float kf = bf2f(kb);
            *(bf16_t*)(KT + dim * LROW + tau * 2) = f2bf(kf * wf);
            *(bf16_t*)(KT + ATT_TILE + dim * LROW + tau * 2) = f2bf(kf * wb);
            *(bf16_t*)(VT + dim * LROW + tau * 2) = vb;
        }
    }
    __syncthreads();
    float* sum = (float*)(p.ws + WS_MLSUM);
    const int sidx = ml_sidx(grp, b, head, c);
    {
        const int dir = wave >> 2, mi = (wave >> 1) & 1, ni = wave & 1;
        f16v acc = f16zero();
#pragma unroll
        for (int s = 0; s < 4; ++s) {
            const s8v af = *(const s8v*)(KT + dir * ATT_TILE + (mi * 32 + l31) * LROW + (16 * s + 8 * h) * 2);
            const s8v bf = *(const s8v*)(VT + (ni * 32 + l31) * LROW + (16 * s + 8 * h) * 2);
            acc = mfma32(af, bf, acc);
        }
        float* U = sum + (size_t)(sidx * 2 + dir) * MLSUM_STRIDE;
#pragma unroll
        for (int r = 0; r < 16; ++r) U[(mi * 32 + (r & 3) + 8 * (r >> 2) + 4 * h) * 64 + ni * 32 + l31] = acc[r];
    }
    if (tid < 128) {
        const int dir = tid >> 6, kd = tid & 63;
        float s = 0.f;
        for (int tau = 0; tau < 64; ++tau) s += bf2f(*(const bf16_t*)(KT + dir * ATT_TILE + kd * LROW + tau * 2));
        float* E = sum + (size_t)(sidx * 2 + dir) * MLSUM_STRIDE;
        E[4096 + kd] = s;
        if (kd == 0) { E[4160] = scal[dir]; E[4161] = scal[2 + dir]; }
    }
    __syncthreads();
}

DEV void mlstm_output_unit(const Params& p, char* smem, int l, int grp, int b, int head, int c) {
    const int tid = get_tid(), lane = tid & 63, wave = tid >> 6, h = lane >> 5, l31 = lane & 31;
    const int nc = grp ? NCH_S : NCH_P;
    char* Qs = smem;
    char* Ks = smem + 2 * ATT_TILE;
    char* VT = smem + 4 * ATT_TILE;
    char* CT = smem + 6 * ATT_TILE;
    char* QK = smem + 8 * ATT_TILE;
    float* hS = (float*)(smem + 10 * ATT_TILE);
    float* vec = hS + 2 * 64 * 68;
    float* aS = vec; float* MjS = vec + 128; float* bS = vec + 256; float* nS = vec + 384; float* denp = vec + 512; float* qnS = vec + 768; float* scal = vec + 896;
    const int tb = (grp == 0 ? b * SEQ : NP + b * DEC_SEQ) + c * 64;
    const float* sum = (const float*)(p.ws + WS_MLSUM);
    const size_t qoff = (size_t)(tb + (tid >> 3)) * 256 + head * 64 + (tid & 7) * 8;
    const u4v q_r = *(const u4v*)((const bf16_t*)(p.ws + WS_MLQ) + qoff);
    const u4v k_r = *(const u4v*)((const bf16_t*)(p.ws + WS_MLK) + qoff);
    const u4v v_r = *(const u4v*)((const bf16_t*)(p.ws + WS_MLV) + qoff);
    const u4v o_r = *(const u4v*)((const bf16_t*)(p.ws + WS_MLO) + qoff);
    float g_i = 0.f, g_f = 0.f;
    if (wave < 2) { const float* gr = (const float*)(p.ws + WS_GATES) + (size_t)(tb + (wave ? 63 - lane : lane)) * 16; g_i = gr[wave * 8 + head]; g_f = gr[wave * 8 + 4 + head]; }
#pragma unroll
    for (int dir = 0; dir < 2; ++dir) {
        float C[8], nst = 0.f, m;
        if (grp == 0) {
#pragma unroll
            for (int i = 0; i < 8; ++i) C[i] = 0.f;
            m = 0.f;
        } else {
            const size_t sb = (((size_t)b * DEPTH + l) * 2 + dir) * MLH + head;
#pragma unroll
            for (int i = 0; i < 8; ++i) C[i] = p.in[I_SC][sb * 4096 + tid + 512 * i];
            if (tid < 64) nst = p.in[I_SN][sb * 64 + tid];
            m = p.in[I_SM][sb];
        }
        const int nsteps = dir == 0 ? c : nc - 1 - c;
        const bool fin = (grp == 0) && (dir == 0 ? c == nc - 1 : c == 0);
        {
            float A = 0.f, G = -1e30f;
            if (lane < nsteps) { const float* E = sum + (size_t)(ml_sidx(grp, b, head, dir == 0 ? lane : nc - 1 - lane) * 2 + dir) * MLSUM_STRIDE; A = E[4160]; G = E[4161]; }
            const float P = lane_prefix_sum(A, lane);
            const float T = __shfl(P, 63);
            const float ev = lane < nsteps ? G + (T - P) : -1e30f;
            const float mc = fmaxf(m + T, wave_max(ev));
            const float coef = lane < nsteps ? fexp(ev - mc) : 0.f;
            const float coef0 = fexp(m + T - mc);
#pragma unroll
            for (int i = 0; i < 8; ++i) C[i] *= coef0;
            nst *= coef0;
#pragma unroll 4
            for (int st = 0; st < nsteps; ++st) {
                const float* E = sum + (size_t)(ml_sidx(grp, b, head, dir == 0 ? st : nc - 1 - st) * 2 + dir) * MLSUM_STRIDE;
                const float cf = __shfl(coef, st);
#pragma unroll
                for (int i = 0; i < 8; ++i) C[i] += cf * E[tid + 512 * i];
                if (tid < 64) nst += cf * E[4096 + tid];
            }
            m = mc;
        }
#pragma unroll
        for (int i = 0; i < 8; ++i) { const int e = tid + 512 * i; *(bf16_t*)(CT + dir * ATT_TILE + (e & 63) * LROW + (e >> 6) * 2) = f2bf(C[i]); }
        if (tid < 64) nS[dir * 64 + tid] = nst;
        if (tid == 0) scal[dir] = m;
        if (fin) {
            const float* E = sum + (size_t)(ml_sidx(grp, b, head, c) * 2 + dir) * MLSUM_STRIDE;
            const float A = E[4160], G = E[4161];
            const float m_new = fmaxf(A + m, G);
            const float sc = fexp(A + m - m_new), su = fexp(G - m_new);
            const size_t ob = (((size_t)b * DEPTH + l) * 2 + dir) * MLH + head;
#pragma unroll
            for (int i = 0; i < 8; ++i) p.out[O_MC + ob * 4096 + tid + 512 * i] = sc * C[i] + su * E[tid + 512 * i];
            if (tid < 64) p.out[O_MN + ob * 64 + tid] = sc * nst + su * E[4096 + tid];
            if (tid == 0) p.out[O_MM + ob] = m_new;
        }
    }
    {
        const int row = tid >> 3, ch = tid & 7;
#pragma unroll
        for (int dir = 0; dir < 2; ++dir) {
            const int pr = dir ? 63 - row : row;
            *(u4v*)(Qs + dir * ATT_TILE + pr * LROW + ch * 16) = q_r;
            *(u4v*)(Ks + dir * ATT_TILE + pr * LROW + ch * 16) = k_r;
#pragma unroll
            for (int j = 0; j < 8; ++j) *(bf16_t*)(VT + dir * ATT_TILE + (ch * 8 + j) * LROW + pr * 2) = (bf16_t)(v_r[j >> 1] >> (16 * (j & 1)));
        }
    }
    __syncthreads();
    if (wave < 2) {
        const int dir = wave;
        const float ig = g_i, lf = logsigmoidf_(g_f);
        const float bj = lane_prefix_sum(lf, lane);
        const float a = ig - bj;
        const float Pj = lane_prefix_max(a, lane);
        aS[dir * 64 + lane] = a; bS[dir * 64 + lane] = bj; MjS[dir * 64 + lane] = fmaxf(scal[dir], Pj);
    } else if (wave < 4) {
        const int dir = wave - 2;
        float s = 0.f;
        for (int k = 0; k < 64; ++k) s += bf2f(*(const bf16_t*)(Qs + dir * ATT_TILE + lane * LROW + k * 2)) * nS[dir * 64 + k];
        qnS[dir * 64 + lane] = s;
    }
    __syncthreads();
    const int dir = wave >> 2, rt = (wave >> 1) & 1, jt = wave & 1;
    const int j = jt * 32 + l31;
    const float Mj = MjS[dir * 64 + j];
    {
        f16v acc = f16zero();
#pragma unroll
        for (int s4 = 0; s4 < 4; ++s4) {
            const s8v af = *(const s8v*)(Ks + dir * ATT_TILE + (rt * 32 + l31) * LROW + (16 * s4 + 8 * h) * 2);
            const s8v bf = *(const s8v*)(Qs + dir * ATT_TILE + j * LROW + (16 * s4 + 8 * h) * 2);
            acc = mfma32(af, bf, acc);
        }
        float dsum = 0.f;
#pragma unroll
        for (int g = 0; g < 4; ++g) {
            float o[4];
#pragma unroll
            for (int q = 0; q < 4; ++q) {
                const int s = rt * 32 + 8 * g + 4 * h + q;
                const float w = s <= j ? fexp(aS[dir * 64 + s] - Mj) : 0.f;
                o[q] = acc[4 * g + q] * w; dsum += o[q];
            }
            u2v pk; pk[0] = pack2(o[0], o[1]); pk[1] = pack2(o[2], o[3]);
            *(u2v*)(QK + dir * ATT_TILE + j * LROW + (rt * 32 + 8 * g + 4 * h) * 2) = pk;
        }
        dsum += __shfl_xor(dsum, 32);
        if (h == 0) denp[(dir * 2 + rt) * 64 + j] = dsum;
    }
    __syncthreads();
    {
        const float mst = scal[dir];
        const float decay = fexp(mst - Mj);
        f16v acc = f16zero();
#pragma unroll
        for (int s4 = 0; s4 < 4; ++s4) {
            const s8v af = *(const s8v*)(CT + dir * ATT_TILE + (rt * 32 + l31) * LROW + (16 * s4 + 8 * h) * 2);
            const s8v bf = *(const s8v*)(Qs + dir * ATT_TILE + j * LROW + (16 * s4 + 8 * h) * 2);
            acc = mfma32(af, bf, acc);
        }
        acc *= decay;
#pragma unroll
        for (int s4 = 0; s4 < 4; ++s4) {
            const s8v af = *(const s8v*)(VT + dir * ATT_TILE + (rt * 32 + l31) * LROW + (16 * s4 + 8 * h) * 2);
            const s8v bf = *(const s8v*)(QK + dir * ATT_TILE + j * LROW + (16 * s4 + 8 * h) * 2);
            acc = mfma32(af, bf, acc);
        }
        const float den = decay * qnS[dir * 64 + j] + denp[(dir * 2) * 64 + j] + denp[(dir * 2 + 1) * 64 + j];
        const float dn = fmaxf(fabsf(den), fexp(-(bS[dir * 64 + j] + Mj)));
        const float inv = 1.f / dn;
#pragma unroll
        for (int g = 0; g < 4; ++g) { f4v o; o[0] = acc[4 * g] * inv; o[1] = acc[4 * g + 1] * inv; o[2] = acc[4 * g + 2] * inv; o[3] = acc[4 * g + 3] * inv;
            *(f4v*)(hS + (dir * 64 + j) * 68 + rt * 32 + 8 * g + 4 * h) = o; }
    }
    __syncthreads();
    {
        const int tau = tid >> 3, v8 = (tid & 7) * 8;
        float hv[8]; float s = 0.f;
#pragma unroll
        for (int q = 0; q < 8; ++q) { hv[q] = hS[tau * 68 + v8 + q] + hS[(64 + 63 - tau) * 68 + v8 + q]; s += hv[q]; }
        s += __shfl_xor(s, 1); s += __shfl_xor(s, 2); s += __shfl_xor(s, 4);
        const float mu = s * (1.f / 64.f);
        float qq = 0.f;
#pragma unroll
        for (int q = 0; q < 8; ++q) { const float dlt = hv[q] - mu; qq += dlt * dlt; }
        qq += __shfl_xor(qq, 1); qq += __shfl_xor(qq, 2); qq += __shfl_xor(qq, 4);
        const float rstd = frsqrt(qq * (1.f / 64.f) + EPS);
        const int t = tb + tau;
        const u4v ov = o_r;
        const float* ng = p.in[I_MLG] + (size_t)l * 256 + head * 64 + v8;
        float o[8];
#pragma unroll
        for (int q = 0; q < 8; ++q) { const float og = bf2f((bf16_t)(ov[q >> 1] >> (16 * (q & 1)))); o[q] = (hv[q] - mu) * rstd * ng[q] * sigmoidf_(og); }
        u4v pk; pk[0] = pack2(o[0], o[1]); pk[1] = pack2(o[2], o[3]); pk[2] = pack2(o[4], o[5]); pk[3] = pack2(o[6], o[7]);
        *(u4v*)((bf16_t*)(p.ws + WS_MIXED) + (size_t)t * MIXW + 384 + head * 64 + v8) = pk;
    }
    __syncthreads();
}

DEV int queue_next(const Params& p, char* smem, int qi) {
    int* slot = (int*)(smem + SMEM_XB + 32);
    __syncthreads();
    if (threadIdx.x == 0) {
#ifdef EMU
        unsigned* w = (unsigned*)(p.ws + WS_BAR) + QUEUE_WORD0 + 64 * qi; *slot = (int)(*w)++;
#else
        *slot = (int)__hip_atomic_fetch_add((unsigned*)(p.ws + WS_BAR) + QUEUE_WORD0 + 64 * qi, 1u, __ATOMIC_RELAXED, __HIP_MEMORY_SCOPE_AGENT);
#endif
    }
    __syncthreads();
    return *slot;
}
DEV void phase_attn(const Params& p, char* smem, int l, int qi) {
    constexpr int QB_S = DEC_SEQ / 256, QB_P = SEQ / 256;
    constexpr int U_SG = DEC_BATCH * GQH * QB_S * 2, U_SN = DEC_BATCH * NAH * QB_S, U_PN = BATCH * NAH * QB_P, U_PG = BATCH * GQH * QB_P;
    constexpr int U_MP = BATCH * MLH * NCH_P, U_MS = DEC_BATCH * MLH * NCH_S;
    constexpr int NU = U_SG + U_SN + U_PN + U_PG + U_MP + U_MS;
    const bf16_t* naq = (const bf16_t*)(p.ws + WS_NAQ); const bf16_t* nak = (const bf16_t*)(p.ws + WS_NAK); const bf16_t* nav = (const bf16_t*)(p.ws + WS_NAV);
    const bf16_t* gqq = (const bf16_t*)(p.ws + WS_GQQ); const bf16_t* gqk = (const bf16_t*)(p.ws + WS_GQK); const bf16_t* gqv = (const bf16_t*)(p.ws + WS_GQV);
    bf16_t* mixed = (bf16_t*)(p.ws + WS_MIXED);
    for (;;) {
        int u = queue_next(p, smem, qi);
        if (u >= NU) break;
#ifdef PROBE_ATT
        if (qi >= 8) { const int cls = u < U_SG ? 1 : u < U_SG + U_SN ? 2 : u < U_SG + U_SN + U_PN + U_PG ? 3 : 4; if (cls != PROBE_ATT) continue; }
#endif
        AttnDesc d; d.na = 0; d.r0 = 0; d.rlo = 0; d.rpb = nullptr; d.part = nullptr; d.out = nullptr; d.ostride = MIXW; d.n0 = 0; d.k0 = d.v0 = nullptr; d.stride0 = 0;
        if (u < U_SG) {
            const int half = u & 1, qb = (u >> 1) % QB_S, qh = (u / (2 * QB_S)) % GQH, b = u / (2 * QB_S * GQH);
            const int kvh = qh / (GQH / GQKV);
            constexpr int NCT = PAST / 64, TT = NCT + DEC_SEQ / 64, H0 = TT / 2;
            const size_t tq = (size_t)NP + (size_t)b * DEC_SEQ + qb * 256;
            d.q = gqq + tq * 384 + qh * 64; d.qstride = 384;
            const bf16_t* lk = gqk + ((size_t)NP + (size_t)b * DEC_SEQ) * 128 + kvh * 64; const bf16_t* lv = gqv + ((size_t)NP + (size_t)b * DEC_SEQ) * 128 + kvh * 64;
            if (half == 0) {
                d.n0 = NCT; d.ntiles = H0; d.stride0 = 128;
                const size_t co = (((size_t)b * DEPTH + l) * PAST) * 128 + kvh * 64;
                d.k0 = (const bf16_t*)(p.ws + WS_CGQK) + co; d.v0 = (const bf16_t*)(p.ws + WS_CGQV) + co;
                d.k1 = lk; d.v1 = lv; d.stride1 = 128;
            } else {
                d.n0 = 0; d.ntiles = TT - H0; d.stride1 = 128;
                d.k1 = lk + (size_t)(H0 - NCT) * 64 * 128; d.v1 = lv + (size_t)(H0 - NCT) * 64 * 128;
            }
            d.part = (float*)(p.ws + WS_PART) + (size_t)u * PART_STRIDE;
        } else if (u < U_SG + U_SN) {
            const int uu = u - U_SG; const int qb = uu % QB_S, hd = (uu / QB_S) % NAH, b = uu / (QB_S * NAH);
            const size_t t0 = (size_t)NP + (size_t)b * DEC_SEQ;
            d.q = naq + (t0 + qb * 256) * 384 + hd * 64; d.qstride = 384;
            d.na = 1; d.r0 = qb * 4; d.rlo = na_row_start(d.r0);
            const int rhi = na_row_start(d.r0 + 3) + KR;
            d.n0 = PAST / 64; d.ntiles = d.n0 + (rhi - d.rlo); d.stride0 = 384; d.stride1 = 384;
            const size_t co = (((size_t)b * DEPTH + l) * PAST) * 384 + hd * 64;
            d.k0 = (const bf16_t*)(p.ws + WS_CNAK) + co; d.v0 = (const bf16_t*)(p.ws + WS_CNAV) + co;
            d.k1 = nak + (t0 + (size_t)d.rlo * 64) * 384 + hd * 64; d.v1 = nav + (t0 + (size_t)d.rlo * 64) * 384 + hd * 64;
            d.rpb = p.in[I_RPB] + ((size_t)l * NAH + hd) * 15 * 31;
            d.out = mixed + (t0 + qb * 256) * MIXW + hd * 64;
        } else if (u < U_SG + U_SN + U_PN) {
            const int uu = u - U_SG - U_SN; const int qb = uu % QB_P, hd = (uu / QB_P) % NAH, b = uu / (QB_P * NAH);
            const size_t t0 = (size_t)b * SEQ;
            d.q = naq + (t0 + qb * 256) * 384 + hd * 64; d.qstride = 384;
            d.n0 = 0; d.ntiles = SEQ / 64; d.stride1 = 384; d.k1 = nak + t0 * 384 + hd * 64; d.v1 = nav + t0 * 384 + hd * 64;
            d.out = mixed + (t0 + qb * 256) * MIXW + hd * 64;
        } else if (u < U_SG + U_SN + U_PN + U_PG) {
            const int uu = u - U_SG - U_SN - U_PN; const int qb = uu % QB_P, qh = (uu / QB_P) % GQH, b = uu / (QB_P * GQH);
            const int kvh = qh / (GQH / GQKV);
            const size_t t0 = (size_t)b * SEQ;
            d.q = gqq + (t0 + qb * 256) * 384 + qh * 64; d.qstride = 384;
            d.n0 = 0; d.ntiles = SEQ / 64; d.stride1 = 128; d.k1 = gqk + t0 * 128 + kvh * 64; d.v1 = gqv + t0 * 128 + kvh * 64;
            d.out = mixed + (t0 + qb * 256) * MIXW + 640 + qh * 64;
        } else {
            int uu = u - (U_SG + U_SN + U_PN + U_PG); const int grp = uu >= U_MP ? 1 : 0; if (grp) uu -= U_MP;
            const int nch = grp ? NCH_S : NCH_P;
            mlstm_summary_unit(p, smem, grp, uu / (nch * MLH), (uu / nch) % MLH, uu % nch);
        }
        if (u < U_SG + U_SN + U_PN + U_PG) attn_unit(smem, d);
    }
}

DEV void phase_mlout(const Params& p, char* smem, int l) {
    constexpr int QB_S = DEC_SEQ / 256;
    constexpr int U_MS = DEC_BATCH * MLH * NCH_S, U_MP = BATCH * MLH * NCH_P, U_CB = DEC_BATCH * GQH * QB_S;
    const int tid = get_tid(), lane = tid & 63, wave = tid >> 6;
    for (int tk = blockIdx.x + gridDim.x * wave; tk < U_CB * 4; tk += gridDim.x * 8) {
        const int uu = tk >> 2, sl = tk & 3;
        const int qb = uu % QB_S, qh = (uu / QB_S) % GQH, b = uu / (QB_S * GQH);
        const float* p0 = (const float*)(p.ws + WS_PART) + (size_t)(2 * uu) * PART_STRIDE; const float* p1 = p0 + PART_STRIDE;
        const int q = sl * 64 + (lane >> 1) + 32 * 0, d0 = (lane & 1) * 32;
#pragma unroll
        for (int hq = 0; hq < 2; ++hq) {
            const int qq = q + 32 * hq;
            const float m0 = p0[256 * 64 + qq], m1 = p1[256 * 64 + qq], l0 = p0[256 * 64 + 256 + qq], l1 = p1[256 * 64 + 256 + qq];
            const float m = fmaxf(m0, m1), w0 = fexp2(m0 - m), w1 = fexp2(m1 - m);
            const float inv = 1.f / (l0 * w0 + l1 * w1);
            bf16_t* dst = (bf16_t*)(p.ws + WS_MIXED) + ((size_t)NP + (size_t)b * DEC_SEQ + qb * 256 + qq) * MIXW + 640 + qh * 64 + d0;
#pragma unroll
            for (int i = 0; i < 8; ++i) {
                const f4v a = *(const f4v*)(p0 + (size_t)qq * 64 + d0 + 4 * i), bb = *(const f4v*)(p1 + (size_t)qq * 64 + d0 + 4 * i);
                u2v pk; pk[0] = pack2((a[0] * w0 + bb[0] * w1) * inv, (a[1] * w0 + bb[1] * w1) * inv); pk[1] = pack2((a[2] * w0 + bb[2] * w1) * inv, (a[3] * w0 + bb[3] * w1) * inv);
                *(u2v*)(dst + 4 * i) = pk;
            }
        }
    }
    for (int u = blockIdx.x; u < U_MS + U_MP; u += gridDim.x) {
        const int grp = u < U_MS ? 1 : 0; const int uu = grp ? u : u - U_MS; const int nch = grp ? NCH_S : NCH_P;
        mlstm_output_unit(p, smem, l, grp, uu / (nch * MLH), (uu / nch) % MLH, uu % nch);
    }
}

constexpr int N_PHASES = 2 + 9 * DEPTH;
#ifndef EMU
typedef const __attribute__((address_space(4))) Params* KParamsPtr;
DEV void load_params(Params& p) {
    KParamsPtr kp = (KParamsPtr)__builtin_amdgcn_kernarg_segment_ptr();
    asm volatile("" : "+s"(kp));
#pragma unroll
    for (int i = 0; i < N_IN; ++i) p.in[i] = kp->in[i];
    p.out = kp->out; p.ws = kp->ws; p.ph0 = kp->ph0; p.ph1 = kp->ph1;
}
#endif
#ifdef EMU
static char emu_smem[SMEM_BYTES + 64];
#endif
__global__ void __launch_bounds__(512, 2) mega_kernel(Params p_) {
    const int ph0 = p_.ph0, ph1 = p_.ph1;
#ifdef EMU
    char* smem = emu_smem;
#define GRID_SYNC() do {} while (0)
#else
    extern __shared__ __attribute__((aligned(16))) char smem[];
    if (threadIdx.x == 0) *(u4v*)(smem + SMEM_XB) = (u4v){0u, 0u, 0u, 0u};
    __syncthreads();
    (void)xcd_barrier_post((unsigned*)(p_.ws + WS_BAR), (volatile LAS unsigned*)(smem + SMEM_XB));
    const bool multi = (ph1 - ph0) > 1;
#define GRID_SYNC() do { if (multi) { KParamsPtr kpb = (KParamsPtr)__builtin_amdgcn_kernarg_segment_ptr(); asm volatile("" : "+s"(kpb)); \
        XcdBarrier xb; xb.bar = (unsigned*)(kpb->ws + WS_BAR); xb.x = xb_xcc_id(); xb.st = (volatile LAS unsigned*)(smem + SMEM_XB); xcd_barrier(xb); } } while (0)
#endif
    int ph = 0;
#ifndef KIND_MASK
#define KIND_MASK 0x3ff
#endif
#ifdef EMU
#define LOAD_PARAMS() const Params& p = p_
#else
#define LOAD_PARAMS() Params p; load_params(p)
#endif
#ifndef DOUBLE_MASK
#define DOUBLE_MASK 0
#endif
#define PH_KIND() (ph == 0 ? 0 : ph == 1 + 9 * DEPTH ? 1 : 1 + (ph - 1) % 9)
#define RUN_PHASE(body) do { if (((KIND_MASK >> PH_KIND()) & 1) && ph >= ph0 && ph < ph1) { \
    if (DOUBLE_MASK && ((DOUBLE_MASK >> PH_KIND()) & 1)) { { const int rep_ = 1; LOAD_PARAMS(); body; } GRID_SYNC(); } \
    { const int rep_ = 0; LOAD_PARAMS(); body; } if (ph + 1 < ph1) GRID_SYNC(); } ++ph; } while (0)
    RUN_PHASE(phase_ada(p, smem));
    for (int l = 0; l < DEPTH; ++l) {
        RUN_PHASE(phase_rows<0>(p, smem, l));
        RUN_PHASE(phase_inproj<0>(p, smem, l));
        RUN_PHASE(phase_attn(p, smem, l, l + DEPTH * rep_));
        RUN_PHASE(phase_mlout(p, smem, l));
        RUN_PHASE(phase_outproj<0>(p, smem, l));
        RUN_PHASE(phase_rows<1>(p, smem, l));
        RUN_PHASE(phase_topk(p, smem));
        RUN_PHASE(phase_gateup<0>(p, smem, l));
        RUN_PHASE(phase_down<0>(p, smem, l));
    }
    RUN_PHASE(phase_rows<0>(p, smem, DEPTH));
#ifdef PROBE_BARRIERS
    for (int i = 0; i < PROBE_BARRIERS; ++i) GRID_SYNC();
#endif
}

#if !defined(EMU) && defined(PROBE_KIND)
__global__ void __launch_bounds__(512, 2) probe_kernel(Params p) {
    extern __shared__ __attribute__((aligned(16))) char smem[];
    for (int r = 0; r < PROBE_REPS; ++r) {
#if PROBE_KIND == 8
        phase_gateup<PROBE_VAR>(p, smem, 1);
#elif PROBE_KIND == 9
        phase_down<PROBE_VAR>(p, smem, 1);
#elif PROBE_KIND == 2
        phase_inproj<PROBE_VAR>(p, smem, 1);
#elif PROBE_KIND == 5
        phase_outproj<PROBE_VAR>(p, smem, 1);
#elif PROBE_KIND == 0
        phase_ada(p, smem);
#elif PROBE_KIND == 1
        phase_rows<0>(p, smem, 1);
#elif PROBE_KIND == 6
        phase_rows<1>(p, smem, 1);
#elif PROBE_KIND == 7
        phase_topk(p, smem);
#elif PROBE_KIND == 3
        phase_attn(p, smem, 1, 8 + r);
#elif PROBE_KIND == 4
        phase_mlout(p, smem, 1);
#endif
        __syncthreads();
    }
}
#endif
#ifndef EMU
#ifndef MK_N_LAUNCHES
#define MK_N_LAUNCHES 1
#endif
extern "C" void kernel_launch(void* const* d_in, const int* in_sizes, int n_in, void* d_out, int out_size, void* d_ws, size_t ws_size, hipStream_t stream) {
    (void)in_sizes; (void)n_in; (void)out_size; (void)ws_size;
    static int grid = 0;
    if (!grid) {
        int dev = 0, cus = 0, per_cu = 0;
        (void)hipGetDevice(&dev);
        (void)hipDeviceGetAttribute(&cus, hipDeviceAttributeMultiprocessorCount, dev);
        (void)hipFuncSetAttribute((const void*)mega_kernel, hipFuncAttributeMaxDynamicSharedMemorySize, SMEM_BYTES);
        (void)hipOccupancyMaxActiveBlocksPerMultiprocessor(&per_cu, mega_kernel, 512, SMEM_BYTES);
        grid = cus * (per_cu < 1 ? per_cu : 1);
        if (grid <= 0) grid = cus;
    }
    (void)hipMemsetAsync((char*)d_ws + WS_BAR, 0, WS_BAR_BYTES, stream);
    Params p = {};
    for (int i = 0; i < N_IN; ++i) p.in[i] = (const float*)d_in[i];
    p.out = (float*)d_out; p.ws = (char*)d_ws;
#if MK_N_LAUNCHES == 1
    p.ph0 = 0; p.ph1 = N_PHASES;
    mega_kernel<<<dim3(grid), dim3(512), SMEM_BYTES, stream>>>(p);
#ifdef PROBE_KIND
    (void)hipFuncSetAttribute((const void*)probe_kernel, hipFuncAttributeMaxDynamicSharedMemorySize, SMEM_BYTES);
    probe_kernel<<<dim3(grid), dim3(512), SMEM_BYTES, stream>>>(p);
#endif
#else
    for (int ph = 0; ph < N_PHASES; ++ph) { p.ph0 = ph; p.ph1 = ph + 1; mega_kernel<<<dim3(grid), dim3(512), SMEM_BYTES, stream>>>(p); }
#endif
}
#endif
```

```cpp
#ifndef EMU
#include <hip/hip_runtime.h>
#define DEV __device__ __forceinline__
#else
#define DEV static inline __attribute__((always_inline))
#endif
#include <stdint.h>
#include <stddef.h>

#ifndef CFG_D
#define CFG_D 1024
#define CFG_BATCH 16
#define CFG_SEQ 256
#define CFG_DEC_BATCH 2
#define CFG_DEC_SEQ 2048
#define CFG_PAST 256
#define CFG_EH 2816
#endif
constexpr int D = CFG_D, BATCH = CFG_BATCH, SEQ = CFG_SEQ, DEC_BATCH = CFG_DEC_BATCH, DEC_SEQ = CFG_DEC_SEQ, PAST = CFG_PAST, EH = CFG_EH;
constexpr int DEPTH = 2, HD = 64, NAH = 6, MLH = 4, GQH = 6, GQKV = 2, NEXP = 16, GRIDW = 64;
constexpr int NP = BATCH * SEQ, NS = DEC_BATCH * DEC_SEQ, NT = NP + NS, NCOND = 1 + DEC_BATCH;
constexpr int PROJ_W = 2832, MIXW = 1024;
constexpr int CAP_P = SEQ / 8, CAP_S = DEC_SEQ / 8, SLOTS = BATCH * CAP_P + DEC_BATCH * CAP_S;
constexpr int ROWS = DEC_SEQ / GRIDW, KR = ROWS < 8 ? ROWS : 8, KC = 16;
constexpr int NCH_P = SEQ / 64, NCH_S = DEC_SEQ / 64;
constexpr float ALPHA = 1.41421356237309515f;
constexpr float ATT_SCALE = 0.125f;
constexpr float EPS = 1e-6f;
static_assert(SLOTS % 256 == 0 && NP % 256 == 0 && NS % 256 == 0 && SEQ % 256 == 0 && DEC_SEQ % 256 == 0, "tile divisibility");
static_assert(D % 256 == 0 && EH % 128 == 0 && PAST % 64 == 0, "tile divisibility");

typedef unsigned short bf16_t;
typedef short s8v __attribute__((ext_vector_type(8)));
typedef short s4v __attribute__((ext_vector_type(4)));
typedef float f16v __attribute__((ext_vector_type(16)));
typedef float f4v __attribute__((ext_vector_type(4)));
typedef unsigned u4v __attribute__((ext_vector_type(4)));
typedef unsigned u2v __attribute__((ext_vector_type(2)));

enum { I_XP = 0, I_XS, I_C, I_CNAK, I_CNAV, I_CGQK, I_CGQV, I_SC, I_SN, I_SM, I_CCTX, I_ADAW, I_ADAB, I_WIN, I_BGATE, I_WOUT, I_RPB, I_QKG, I_MLG,
       I_LNG, I_LNB, I_RW, I_WG, I_WU, I_WD, N_IN };

constexpr size_t O_YP = 0;
constexpr size_t O_YS = O_YP + (size_t)NP * D;
constexpr size_t O_NAK = O_YS + (size_t)NS * D;
constexpr size_t O_NAV = O_NAK + (size_t)BATCH * DEPTH * SEQ * NAH * HD;
constexpr size_t O_GQK = O_NAV + (size_t)BATCH * DEPTH * SEQ * NAH * HD;
constexpr size_t O_GQV = O_GQK + (size_t)BATCH * DEPTH * SEQ * GQKV * HD;
constexpr size_t O_MC = O_GQV + (size_t)BATCH * DEPTH * SEQ * GQKV * HD;
constexpr size_t O_MN = O_MC + (size_t)BATCH * DEPTH * 2 * MLH * HD * HD;
constexpr size_t O_MM = O_MN + (size_t)BATCH * DEPTH * 2 * MLH * HD;
constexpr size_t O_END = O_MM + (size_t)BATCH * DEPTH * 2 * MLH;

constexpr size_t al256(size_t x) { return (x + 255) & ~(size_t)255; }
constexpr size_t WS_BAR = 0;
constexpr size_t WS_BAR_BYTES = 32768;
constexpr size_t WS_MODS = WS_BAR + WS_BAR_BYTES;
constexpr size_t WS_ROPE = al256(WS_MODS + (size_t)DEPTH * NCOND * 6 * D * 4);
constexpr size_t WS_CNAK = al256(WS_ROPE + 64 * 16 * 2 * 4);
constexpr size_t WS_CNAV = al256(WS_CNAK + (size_t)DEC_BATCH * DEPTH * PAST * NAH * HD * 2);
constexpr size_t WS_CGQK = al256(WS_CNAV + (size_t)DEC_BATCH * DEPTH * PAST * NAH * HD * 2);
constexpr size_t WS_CGQV = al256(WS_CGQK + (size_t)DEC_BATCH * DEPTH * PAST * GQKV * HD * 2);
constexpr size_t WS_XBUF = al256(WS_CGQV + (size_t)DEC_BATCH * DEPTH * PAST * GQKV * HD * 2);
constexpr size_t WS_HMOD = al256(WS_XBUF + (size_t)NT * D * 4);
constexpr size_t WS_GATES = al256(WS_HMOD + (size_t)NT * D * 2);
constexpr size_t WS_NAQ = al256(WS_GATES + (size_t)NT * 16 * 4);
constexpr size_t WS_NAK = al256(WS_NAQ + (size_t)NT * 384 * 2);
constexpr size_t WS_NAV = al256(WS_NAK + (size_t)NT * 384 * 2);
constexpr size_t WS_MLQ = al256(WS_NAV + (size_t)NT * 384 * 2);
constexpr size_t WS_MLK = al256(WS_MLQ + (size_t)NT * 256 * 2);
constexpr size_t WS_MLV = al256(WS_MLK + (size_t)NT * 256 * 2);
constexpr size_t WS_MLO = al256(WS_MLV + (size_t)NT * 256 * 2);
constexpr size_t WS_GQQ = al256(WS_MLO + (size_t)NT * 256 * 2);
constexpr size_t WS_GQK = al256(WS_GQQ + (size_t)NT * 384 * 2);
constexpr size_t WS_GQV = al256(WS_GQK + (size_t)NT * 128 * 2);
constexpr size_t WS_MIXED = al256(WS_GQV + (size_t)NT * 128 * 2);
constexpr size_t WS_U = al256(WS_MIXED + (size_t)NT * MIXW * 2);
constexpr size_t WS_X1 = al256(WS_U + (size_t)NT * D * 4);
constexpr size_t WS_H2 = al256(WS_X1 + (size_t)NT * D * 4);
constexpr size_t WS_AFF = al256(WS_H2 + (size_t)NT * D * 2);
constexpr size_t WS_IDX = al256(WS_AFF + (size_t)NT * 16 * 4);
constexpr size_t WS_GSEL = al256(WS_IDX + (size_t)NEXP * SLOTS * 4);
constexpr size_t WS_TOKSLOT = al256(WS_GSEL + (size_t)NEXP * SLOTS * 4);
constexpr size_t WS_HID = al256(WS_TOKSLOT + (size_t)NT * 16 * 4);
constexpr size_t WS_YE = al256(WS_HID + (size_t)NEXP * SLOTS * EH * 2);
constexpr int MLSUM_STRIDE = 4096 + 64 + 64;
constexpr int N_MLSUM = (BATCH * NCH_P + DEC_BATCH * NCH_S) * MLH * 2;
constexpr size_t WS_MLSUM = al256(WS_YE + (size_t)NEXP * SLOTS * D * 2);
constexpr int PART_STRIDE = 256 * 64 + 512;
constexpr int N_PART = DEC_BATCH * GQH * (DEC_SEQ / 256) * 2;
constexpr size_t WS_PART = al256(WS_MLSUM + (size_t)N_MLSUM * MLSUM_STRIDE * 4);
constexpr size_t WS_TOTAL = al256(WS_PART + (size_t)N_PART * PART_STRIDE * 4);

struct Params {
    const float* in[N_IN];
    float* out;
    char* ws;
    int ph0, ph1;
};

DEV float bf2f(bf16_t s) { unsigned u = ((unsigned)s) << 16; return __builtin_bit_cast(float, u); }
DEV bf16_t f2bf(float f) {
#ifdef EMU
    unsigned u = __builtin_bit_cast(unsigned, f); u += 0x7fffu + ((u >> 16) & 1u); return (bf16_t)(u >> 16);
#else
    return __builtin_bit_cast(bf16_t, (__bf16)f);
#endif
}
DEV unsigned pack2(float a, float b) {
#ifdef EMU
    return (unsigned)f2bf(a) | ((unsigned)f2bf(b) << 16);
#else
    typedef __bf16 b2 __attribute__((ext_vector_type(2))); b2 r; r[0] = (__bf16)a; r[1] = (__bf16)b; return __builtin_bit_cast(unsigned, r);
#endif
}
DEV float fexp(float x) {
#ifdef EMU
    return expf(x);
#else
    return __expf(x);
#endif
}
DEV float fexp2(float x) {
#ifdef EMU
    return exp2f(x);
#else
    return __builtin_amdgcn_exp2f(x);
#endif
}
DEV float frcp(float x) {
#ifdef EMU
    return 1.f / x;
#else
    return __builtin_amdgcn_rcpf(x);
#endif
}
DEV float sigmoidf_(float x) { return frcp(1.f + fexp(-x)); }
DEV float siluf_(float x) { return x * frcp(1.f + fexp(-x)); }
DEV float flog(float x) {
#ifdef EMU
    return logf(x);
#else
    return __logf(x);
#endif
}
DEV float frsqrt(float x) {
#ifdef EMU
    return 1.f / sqrtf(x);
#else
    return __builtin_amdgcn_rsqf(x);
#endif
}
DEV float logsigmoidf_(float x) { return fminf(x, 0.f) - flog(1.f + fexp(-fabsf(x))); }
DEV f16v mfma32(s8v a, s8v b, f16v c) {
#ifdef EMU
    return emu_mfma_32x32x16_bf16(a, b, c);
#else
    typedef __bf16 bf8 __attribute__((ext_vector_type(8)));
    return __builtin_amdgcn_mfma_f32_32x32x16_bf16(__builtin_bit_cast(bf8, a), __builtin_bit_cast(bf8, b), c, 0, 0, 0);
#endif
}
DEV s4v lds_tr16(const void* p) {
#ifdef EMU
    return emu_ds_read_tr16_b64(p);
#else
    typedef s4v __attribute__((address_space(3))) * lp;
    return __builtin_amdgcn_ds_read_tr16_b64_v4i16((lp)(p));
#endif
}
#ifdef EMU
DEV float wave_sum(float v) { for (int m = 32; m >= 1; m >>= 1) v += __shfl_xor(v, m); return v; }
#else
template <int CTRL, int RM> DEV float dpp_f(float v) { return __builtin_bit_cast(float, __builtin_amdgcn_update_dpp(0, __builtin_bit_cast(int, v), CTRL, RM, 0xF, false)); }
DEV float wave_sum(float v) {
    v += dpp_f<0xB1, 0xF>(v); v += dpp_f<0x4E, 0xF>(v); v += dpp_f<0x141, 0xF>(v); v += dpp_f<0x140, 0xF>(v);
    v += dpp_f<0x142, 0xA>(v); v += dpp_f<0x143, 0xC>(v);
    return __builtin_bit_cast(float, __builtin_amdgcn_readlane(__builtin_bit_cast(int, v), 63));
}
#endif
DEV float wave_max(float v) { for (int m = 32; m >= 1; m >>= 1) v = fmaxf(v, __shfl_xor(v, m)); return v; }
DEV f16v f16zero() { f16v z; for (int i = 0; i < 16; ++i) z[i] = 0.f; return z; }

#ifdef EMU
#define VGPR_PIN(x) do {} while (0)
#define SGPR_PIN(x) do {} while (0)
#define SCHED_FENCE() do {} while (0)
#define CFENCE() do {} while (0)
#else
#define SCHED_FENCE() __builtin_amdgcn_sched_barrier(0)
#define SGPR_PIN(x) asm volatile("" : "+s"(x))
#define VGPR_PIN(x) asm volatile("" : "+v"(x))
#define CFENCE() asm volatile("" ::: "memory")
#endif
#ifdef EMU
DEV int get_tid() { return (int)threadIdx.x; }
#else
DEV int get_tid() { int t = threadIdx.x; asm volatile("" : "+v"(t)); return t; }
#endif
struct UnitIter { int i, end, step; };
DEV UnitIter unit_iter(int NU) {
    const int G = (int)gridDim.x, b = (int)blockIdx.x;
    UnitIter it;
#ifndef XCD_MODE
#define XCD_MODE 0
#endif
    if ((G & 7) == 0 && (NU & 7) == 0) { const int W = G >> 3, x = XCD_MODE ? b / W : b & 7, j = XCD_MODE ? b % W : b >> 3, C = NU >> 3; it.i = x * C + j; it.end = (x + 1) * C; it.step = W; }
    else { it.i = b; it.end = NU; it.step = G; }
    return it;
}
DEV int tok_cond(int t) { return t < NP ? 0 : 1 + (t - NP) / DEC_SEQ; }

#ifndef EMU
#define XB_TMO      128
#define XB_XCNT(j)  (256  + 64 * (j))
#define XB_XSUB(j)  (1280 + 64 * (j))
#define XB_XGEN(j)  (2304 + 64 * (j))
#define XB_TOP      3328
#define XB_TOPGEN   3392
#define XCD_BAR_WORDS 3456
#define XB_SPIN_CAP (1u << 20)
#define LAS __attribute__((address_space(3)))
__device__ __forceinline__ unsigned xb_ld(unsigned* p)              { return __hip_atomic_load(p, __ATOMIC_RELAXED, __HIP_MEMORY_SCOPE_AGENT); }
__device__ __forceinline__ unsigned xb_add(unsigned* p, unsigned v) { return __hip_atomic_fetch_add(p, v, __ATOMIC_RELAXED, __HIP_MEMORY_SCOPE_AGENT); }
__device__ __forceinline__ unsigned xb_xcc_id() { return (unsigned)__builtin_amdgcn_s_getreg((3 << 11) | 20) & 0xFu; }
#define XB_SPIN(cond, bar) do { unsigned _sp = 0; while (cond) { __builtin_amdgcn_s_sleep(1); \
    if ((++_sp & 255u) == 0u) { if (xb_ld(&(bar)[XB_TMO])) break; if (_sp > XB_SPIN_CAP) { atomicAdd(&(bar)[XB_TMO], 1u); break; } } } } while (0)
struct XcdBarrier { unsigned* bar; unsigned x; volatile LAS unsigned* st; };
__device__ __forceinline__ XcdBarrier xcd_barrier_post(unsigned* bar, volatile LAS unsigned* st) {
    XcdBarrier b; b.bar = bar; b.x = xb_xcc_id(); b.st = st;
    if (threadIdx.x == 0) (void)xb_add(&bar[XB_XCNT(b.x)], 1u);
    return b;
}
__device__ __forceinline__ void xcd_barrier_complete(unsigned* bar, unsigned x, unsigned& nloc, unsigned& nx) {
    const unsigned G = gridDim.x * gridDim.y * gridDim.z;
    unsigned sum, cnt, mine, sp = 0u;
    for (;;) {
        sum = 0u; cnt = 0u; mine = 0u;
#pragma unroll
        for (unsigned j = 0; j < 16; ++j) { const unsigned c = xb_ld(&bar[XB_XCNT(j)]); sum += c; cnt += (c > 0u) ? 1u : 0u; mine = (j == x) ? c : mine; }
        if (sum == G) break;
        __builtin_amdgcn_s_sleep(1);
        if ((++sp & 255u) == 0u) { if (xb_ld(&bar[XB_TMO])) break; if (sp > XB_SPIN_CAP) { atomicAdd(&bar[XB_TMO], 1u); break; } }
    }
    nloc = mine > 0u ? mine : 1u; nx = cnt > 0u ? cnt : 1u;
}
__device__ __forceinline__ void xcd_barrier(const XcdBarrier& b) {
    asm volatile("s_waitcnt vmcnt(0)" ::: "memory");
    __syncthreads();
    if (threadIdx.x == 0) {
        unsigned* bar = b.bar;
        __builtin_amdgcn_s_waitcnt(0);
        unsigned nloc = b.st[0], nx = b.st[1];
        if (nloc == 0u) { xcd_barrier_complete(bar, b.x, nloc, nx); b.st[0] = nloc; b.st[1] = nx; }
        const unsigned old = xb_add(&bar[XB_XSUB(b.x)], 1u);
        const unsigned gen = old / nloc;
        if (old + 1u == (gen + 1u) * nloc) {
            __builtin_amdgcn_fence(__ATOMIC_RELEASE, "agent");
            asm volatile("s_waitcnt vmcnt(0)" ::: "memory");
            const unsigned og = xb_add(&bar[XB_TOP], 1u);
            const unsigned tg = og / nx;
            if (og + 1u == (tg + 1u) * nx) xb_add(&bar[XB_TOPGEN], 1u);
            else XB_SPIN(xb_ld(&bar[XB_TOPGEN]) == tg, bar);
            __builtin_amdgcn_fence(__ATOMIC_ACQUIRE, "agent");
            xb_add(&bar[XB_XGEN(b.x)], 1u);
            asm volatile("s_waitcnt vmcnt(0)" ::: "memory");
        } else {
            XB_SPIN(xb_ld(&bar[XB_XGEN(b.x)]) == gen, bar);
            __builtin_amdgcn_fence(__ATOMIC_ACQUIRE, "agent");
            asm volatile("s_waitcnt vmcnt(0)" ::: "memory");
        }
    }
    __syncthreads();
}
#endif
constexpr int QUEUE_WORD0 = 4096;

constexpr int LROW = 144;
constexpr int GEMM_AS = 256 * LROW;
constexpr int GEMM_BS = 64 * (256 * 2 + 64);
constexpr int SMEM_XB = 2 * GEMM_AS + 2 * GEMM_BS;
constexpr int SMEM_AUX = SMEM_XB + 64;
constexpr int SMEM_BYTES = SMEM_AUX + 2048;

#ifdef EMU
struct BufRsrc { const char* base; };
DEV BufRsrc make_rsrc(const void* p) { BufRsrc r; r.base = (const char*)p; return r; }
DEV float buf_load_f32(BufRsrc r, unsigned voff, unsigned soff) { return *(const float*)(r.base + voff + soff); }
DEV u4v buf_load_b128(BufRsrc r, unsigned voff, unsigned soff) { return *(const u4v*)(r.base + voff + soff); }
#else
typedef __amdgpu_buffer_rsrc_t BufRsrc;
DEV BufRsrc make_rsrc(const void* p) { return __builtin_amdgcn_make_buffer_rsrc((void*)p, 0, 0x7fffffff, 0x00020000); }
DEV float buf_load_f32(BufRsrc r, unsigned voff, unsigned soff) { return __builtin_bit_cast(float, __builtin_amdgcn_raw_buffer_load_b32(r, voff, soff, 0)); }
DEV u4v buf_load_b128(BufRsrc r, unsigned voff, unsigned soff) { return __builtin_amdgcn_raw_buffer_load_b128(r, voff, soff, 0); }
#endif
#ifdef EMU
#define WAVE_SYNC() do { (void)__shfl(0, 0); } while (0)
#else
#define WAVE_SYNC() asm volatile("s_waitcnt lgkmcnt(0)" ::: "memory")
#endif
DEV char* wave_stage_ptr(char* smem, int wave) { return smem + (wave < 4 ? GEMM_AS + wave * 9216 : 2 * GEMM_AS + GEMM_BS + (wave - 4) * 9216); }
DEV void stage64_write_bf16(char* stg, int tt, const f16v& v0, const f16v& v1, int l31, int h) {
    char* row = stg + (tt * 32 + l31) * LROW;
#pragma unroll
    for (int ft = 0; ft < 2; ++ft) {
        const f16v& v = ft ? v1 : v0;
#pragma unroll
        for (int g = 0; g < 4; ++g) { u2v pk; pk[0] = pack2(v[4 * g], v[4 * g + 1]); pk[1] = pack2(v[4 * g + 2], v[4 * g + 3]); *(u2v*)(row + (ft * 32 + 8 * g + 4 * h) * 2) = pk; }
    }
}
DEV void stage64_write4(char* stg, int row, int col, float a, float b, float c, float d) {
    u2v pk; pk[0] = pack2(a, b); pk[1] = pack2(c, d); *(u2v*)(stg + row * LROW + col * 2) = pk;
}
DEV void stage64_flush_bf16(const char* stg, bf16_t* dst0, size_t row_stride, int lane) {
    WAVE_SYNC();
#pragma unroll
    for (int i = 0; i < 8; ++i) { const int r = (lane >> 3) + 8 * i, c = lane & 7; const u4v v = *(const u4v*)(stg + r * LROW + c * 16); *(u4v*)(dst0 + (size_t)r * row_stride + c * 8) = v; }
    WAVE_SYNC();
}
template <int NTW, int VAR, class Epi>
DEV void gemm_tile(char* smem, BufRsrc ars, unsigned ao0, unsigned ao1, unsigned ao2, unsigned ao3,
                   BufRsrc brs, unsigned bvo, unsigned blds, unsigned ldb4, int K, Epi&& epi) {
    constexpr int BN = 64 * NTW, NLD = 2 * NTW, KSTEP = 64 / NLD, RSB = BN * 2 + 64;
    const int tid = get_tid(), lane = tid & 63, wave = tid >> 6, wm = wave & 3, wn = wave >> 2, h = lane >> 5, l31 = lane & 31;
    char* As = smem; char* Bs = smem + 2 * GEMM_AS;
    constexpr int BSZ = GEMM_BS;
    const int ar = tid >> 3, ac = tid & 7;
    u4v areg[2]; f4v b0[NLD], b1[NLD];
    if (VAR & 3) { for (int i = 0; i < 2; ++i) areg[i] = (u4v){1u, 2u, 3u, 4u}; for (int j = 0; j < NLD; ++j) { b0[j] = (f4v){1.f, 1.f, 1.f, 1.f}; b1[j] = (f4v){2.f, 2.f, 2.f, 2.f}; } }
    f16v acc[NTW][2];
#pragma unroll
    for (int i = 0; i < NTW; ++i) { acc[i][0] = f16zero(); acc[i][1] = f16zero(); }
    auto gloadA = [&](int k0, bool real, int half) {
        if (VAR & 2) return;
        const unsigned so = real ? k0 * 2 : 0u;
        areg[0] = buf_load_b128(ars, real ? (half ? ao2 : ao0) : 0u, so); areg[1] = buf_load_b128(ars, real ? (half ? ao3 : ao1) : 0u, so);
    };
    auto gloadB = [&](int k0, bool real, f4v (&br)[NLD]) {
        if (VAR & 1) return;
        const unsigned vo = real ? bvo : 0u; const int kk = real ? k0 : 0;
        unsigned so = (unsigned)kk * ldb4;
#pragma unroll
        for (int j = 0; j < NLD; ++j) { br[j] = __builtin_bit_cast(f4v, buf_load_b128(brs, vo, so)); so += KSTEP * ldb4; SGPR_PIN(so); }
    };
    auto gloadB1 = [&](int k0, bool real, f4v (&br)[NLD], int j) {
        if (VAR & 1) return;
        br[j] = __builtin_bit_cast(f4v, buf_load_b128(brs, real ? bvo : 0u, (unsigned)((real ? k0 : 0) + j * KSTEP) * ldb4));
    };
    auto lstoreA = [&](int buf, int half) {
        if (VAR & 16) return;
        char* ab = As + buf * GEMM_AS + (ar + half * 128) * LROW + ac * 16;
        *(u4v*)(ab) = areg[0]; *(u4v*)(ab + 64 * LROW) = areg[1];
    };
    auto lstoreB1 = [&](int buf, const f4v (&br)[NLD], int j) {
        if (VAR & 16) return;
        u2v v; v[0] = pack2(br[j][0], br[j][1]); v[1] = pack2(br[j][2], br[j][3]); *(u2v*)(Bs + buf * BSZ + blds + j * KSTEP * RSB) = v;
    };
    auto lstoreB = [&](int buf, const f4v (&br)[NLD]) {
        if (VAR & 16) return;
        char* bb = Bs + buf * BSZ + blds;
#pragma unroll
        for (int j = 0; j < NLD; ++j) { u2v v; v[0] = pack2(br[j][0], br[j][1]); v[1] = pack2(br[j][2], br[j][3]); *(u2v*)(bb + j * KSTEP * RSB) = v; }
    };
    const unsigned btr = (unsigned)(8 * h + ((lane & 15) >> 2)) * RSB + (unsigned)((((lane >> 4) & 1) * 16 + 4 * (lane & 3)) * 2) + (unsigned)(wn * NTW * 32) * 2;
    const unsigned atr = (unsigned)(wm * 64 + l31) * LROW + h * 16;
    auto rdw = [&](int buf, int s, int ft) -> s8v {
        if (VAR & 64) { s8v z; for (int q = 0; q < 8; ++q) z[q] = (short)(0x3f80 + ft); return z; }
        const char* bb = Bs + buf * BSZ + btr + s * 16 * RSB + ft * 64;
        const s4v lo = lds_tr16(bb), hi = lds_tr16(bb + 4 * RSB);
        s8v wf; wf[0] = lo[0]; wf[1] = lo[1]; wf[2] = lo[2]; wf[3] = lo[3]; wf[4] = hi[0]; wf[5] = hi[1]; wf[6] = hi[2]; wf[7] = hi[3];
        return wf;
    };
    auto compute2 = [&](int buf, int s0, auto&& hook) {
        if (VAR & 8) { for (int g = 0; g < 2 * NTW; ++g) hook(g); return; }
        const char* ab = As + buf * GEMM_AS + atr;
        s8v xa[2];
        if (VAR & 64) { for (int q = 0; q < 8; ++q) { xa[0][q] = 0x3f80; xa[1][q] = 0x3f80; } } else { xa[0] = *(const s8v*)(ab + s0 * 32); xa[1] = *(const s8v*)(ab + 32 * LROW + s0 * 32); }
        s8v wcur = rdw(buf, s0, 0);
#pragma unroll
        for (int g = 0; g < 2 * NTW; ++g) {
            const int ft = g % NTW;
            s8v wnext = wcur;
            if (g + 1 < 2 * NTW) wnext = rdw(buf, s0 + (g + 1) / NTW, (g + 1) % NTW);
            if (VAR & 4) { acc[ft][0][0] += __builtin_bit_cast(float, (int)wcur[0] | ((int)xa[0][1] << 16)); acc[ft][1][0] += __builtin_bit_cast(float, (int)wcur[1] | ((int)xa[1][1] << 16)); }
            else { acc[ft][0] = mfma32(wcur, xa[0], acc[ft][0]); acc[ft][1] = mfma32(wcur, xa[1], acc[ft][1]); }
            if (g == NTW - 1 && !(VAR & 64)) { xa[0] = *(const s8v*)(ab + (s0 + 1) * 32); xa[1] = *(const s8v*)(ab + 32 * LROW + (s0 + 1) * 32); }
            wcur = wnext;
            hook(g);
            SCHED_FENCE();
        }
    };
    auto nohook = [](int) {};
    const int nk = K / 64;
    if (NTW == 2) {
        u4v a0[4], a1[4];
        if (VAR & 3) { for (int i = 0; i < 4; ++i) { a0[i] = (u4v){1u, 2u, 3u, 4u}; a1[i] = (u4v){1u, 2u, 3u, 4u}; } }
        auto gA = [&](int k0, bool real, u4v (&ar4)[4]) {
            if (VAR & 2) return;
            const unsigned so = real ? k0 * 2 : 0u;
            ar4[0] = buf_load_b128(ars, real ? ao0 : 0u, so); ar4[1] = buf_load_b128(ars, real ? ao1 : 0u, so);
            ar4[2] = buf_load_b128(ars, real ? ao2 : 0u, so); ar4[3] = buf_load_b128(ars, real ? ao3 : 0u, so);
        };
        auto sA = [&](int buf, const u4v (&ar4)[4]) {
            if (VAR & 16) return;
            char* ab = As + buf * GEMM_AS + ar * LROW + ac * 16;
#pragma unroll
            for (int i = 0; i < 4; ++i) *(u4v*)(ab + i * 64 * LROW) = ar4[i];
        };
        auto gA1 = [&](int k0, bool real, u4v (&ar4)[4], int i) {
            if (VAR & 2) return;
            const unsigned ao = i == 0 ? ao0 : i == 1 ? ao1 : i == 2 ? ao2 : ao3;
            ar4[i] = buf_load_b128(ars, real ? ao : 0u, real ? k0 * 2 : 0u);
        };
        auto sA1 = [&](int buf, const u4v (&ar4)[4], int i) {
            if (VAR & 16) return;
            *(u4v*)(As + buf * GEMM_AS + (ar + i * 64) * LROW + ac * 16) = ar4[i];
        };
        gA(0, true, a0); gloadB(0, true, b0); gA(64, true, a1); gloadB(64, true, b1);
        sA(0, a0); lstoreB(0, b0);
        __syncthreads();
        for (int kt = 0; kt < nk; kt += 2) {
            const bool t2 = kt + 2 < nk;
            compute2(0, 0, [&](int g) { gA1((kt + 2) * 64, t2, a0, g); lstoreB1(1, b1, g); });
            compute2(0, 2, [&](int g) { gloadB1((kt + 2) * 64, t2, b0, g); sA1(1, a1, g); });
            __syncthreads();
            compute2(1, 0, [&](int g) { gA1((kt + 3) * 64, t2, a1, g); lstoreB1(0, b0, g); });
            compute2(1, 2, [&](int g) { gloadB1((kt + 3) * 64, t2, b1, g); sA1(0, a0, g); });
            __syncthreads();
        }
    } else {
    {
        u4v at0, at1;
        gloadA(0, true, 0);
        if (!(VAR & 2)) { at0 = buf_load_b128(ars, ao2, 0); at1 = buf_load_b128(ars, ao3, 0); } else { at0 = areg[0]; at1 = areg[1]; }
        gloadB(0, true, b0); gloadB(64, true, b1);
        lstoreA(0, 0);
        if (!(VAR & 16)) { char* ab = As + (ar + 128) * LROW + ac * 16; *(u4v*)(ab) = at0; *(u4v*)(ab + 64 * LROW) = at1; }
        lstoreB(0, b0);
    }
    __syncthreads();
    for (int kt = 0; kt < nk; kt += 2) {
        const bool t2 = kt + 2 < nk;
        gloadA((kt + 1) * 64, true, 0);
        compute2(0, 0, [&](int g) { if (g & 1) gloadB1((kt + 2) * 64, t2, b0, g >> 1); else lstoreB1(1, b1, g >> 1); });
        lstoreA(1, 0);
        gloadA((kt + 1) * 64, true, 1);
        compute2(0, 2, [&](int g) { if (g & 1) gloadB1((kt + 2) * 64, t2, b0, 4 + (g >> 1)); else lstoreB1(1, b1, 4 + (g >> 1)); });
        lstoreA(1, 1);
        __syncthreads();
        gloadA((kt + 2) * 64, t2, 0);
        compute2(1, 0, [&](int g) { if (g & 1) gloadB1((kt + 3) * 64, t2, b1, g >> 1); else lstoreB1(0, b0, g >> 1); });
        lstoreA(0, 0);
        gloadA((kt + 2) * 64, t2, 1);
        compute2(1, 2, [&](int g) { if (g & 1) gloadB1((kt + 3) * 64, t2, b1, 4 + (g >> 1)); else lstoreB1(0, b0, 4 + (g >> 1)); });
        lstoreA(0, 1);
        __syncthreads();
    }
    }
    if (VAR & 32) { float t = 0.f; for (int i = 0; i < NTW; ++i) t += acc[i][0][0] + acc[i][1][5]; if (t == 123.456f) *(float*)smem = t; }
    else epi(acc);
}

DEV void phase_ada(const Params& p, char* smem) {
    const int tid = get_tid();
    float* siluS = (float*)smem;
    float* red = (float*)(smem + NCOND * D * 4);
    for (int i = tid; i < NCOND * D; i += 512) {
        const int cnd = i / D, k = i % D;
        const float c = cnd == 0 ? p.in[I_CCTX][k] : p.in[I_C][(cnd - 1) * D + k];
        siluS[i] = c * frcp(1.f + fexp(-c));
    }
    __syncthreads();
    constexpr int CPL = 6 * D / 32, NCHUNK = DEPTH * CPL, KG = D / 16;
    float* mods = (float*)(p.ws + WS_MODS);
    const int col = tid & 31, kg = tid >> 5;
    for (int u = blockIdx.x; u < NCHUNK; u += gridDim.x) {
        const int l = u / CPL, c0 = (u % CPL) * 32;
        const float* W = p.in[I_ADAW] + (size_t)l * D * 6 * D + c0 + col;
        float acc[NCOND];
#pragma unroll
        for (int c = 0; c < NCOND; ++c) acc[c] = 0.f;
#pragma unroll 8
        for (int k = kg * KG; k < kg * KG + KG; ++k) {
            const float w = W[(size_t)k * 6 * D];
#pragma unroll
            for (int c = 0; c < NCOND; ++c) acc[c] += siluS[c * D + k] * w;
        }
#pragma unroll
        for (int c = 0; c < NCOND; ++c) red[(kg * NCOND + c) * 32 + col] = acc[c];
        __syncthreads();
        if (tid < 32 * NCOND) {
            const int c = tid >> 5, cc = tid & 31;
            float s = 0.f;
            for (int g = 0; g < 16; ++g) s += red[(g * NCOND + c) * 32 + cc];
            mods[((size_t)l * NCOND + c) * 6 * D + c0 + cc] = s + p.in[I_ADAB][(size_t)l * 6 * D + c0 + cc];
        }
        __syncthreads();
    }
    const int gtid = blockIdx.x * 512 + tid, gsz = gridDim.x * 512;
    float* rope = (float*)(p.ws + WS_ROPE);
    for (int i = gtid; i < 64 * 16; i += gsz) {
        const int pos = i >> 4, fi = i & 15;
        const float inv = fexp2(-(float)(2 * fi) * (13.287712379549449f / 32.f));
        const float ang = (float)pos * inv;
#ifdef EMU
        rope[2 * i] = cosf(ang); rope[2 * i + 1] = sinf(ang);
#else
        rope[2 * i] = __cosf(ang); rope[2 * i + 1] = __sinf(ang);
#endif
    }
    constexpr int NNA = DEC_BATCH * DEPTH * PAST * NAH * HD, NGQ = DEC_BATCH * DEPTH * PAST * GQKV * HD;
    bf16_t* cnak = (bf16_t*)(p.ws + WS_CNAK); bf16_t* cnav = (bf16_t*)(p.ws + WS_CNAV);
    bf16_t* cgqk = (bf16_t*)(p.ws + WS_CGQK); bf16_t* cgqv = (bf16_t*)(p.ws + WS_CGQV);
    for (int i = gtid; i < NNA; i += gsz) { cnak[i] = f2bf(p.in[I_CNAK][i]); cnav[i] = f2bf(p.in[I_CNAV][i]); }
    for (int i = gtid; i < NGQ; i += gsz) { cgqk[i] = f2bf(p.in[I_CGQK][i]); cgqv[i] = f2bf(p.in[I_CGQV][i]); }
}

constexpr int EPL = D / 64;
constexpr int W16ROW = 20;
template <int MODE>
DEV void phase_rows(const Params& p, char* smem, int l) {
    const int tid = get_tid(), lane = tid & 63, wave = tid >> 6;
    float* W16 = (float*)smem;
    const bool need_w = (MODE == 1) || (l < DEPTH);
    if (need_w) {
        for (int i = tid; i < D * 4; i += 512) {
            const int k = i >> 2, q = i & 3;
            const float* src = (MODE == 1) ? p.in[I_RW] + ((size_t)l * D + k) * 16 + q * 4 : p.in[I_WIN] + ((size_t)l * D + k) * PROJ_W + 2176 + q * 4;
            *(f4v*)(W16 + k * W16ROW + q * 4) = *(const f4v*)src;
        }
    }
    __syncthreads();
    const float* mods = (const float*)(p.ws + WS_MODS);
    auto load_row = [&](int t, float (&vr)[EPL], int& ms) {
        const float* rp = (MODE == 1) ? (const float*)(p.ws + WS_U) + (size_t)t * D
                        : (l == 0) ? (t < NP ? p.in[I_XP] + (size_t)t * D : p.in[I_XS] + (size_t)(t - NP) * D) : (const float*)(p.ws + WS_X1) + (size_t)t * D;
#pragma unroll
        for (int j = 0; j < EPL; ++j) vr[j] = rp[lane + 64 * j];
        if (MODE == 0 && l > 0) ms = lane < 16 ? ((const int*)(p.ws + WS_TOKSLOT))[(size_t)t * 16 + lane] : -1;
    };
    const int tstride = gridDim.x * 8;
    float vr[EPL]; int ms = -1;
    {
        const int t0 = blockIdx.x * 8 + wave;
        if (t0 < NT) load_row(t0, vr, ms);
    }
    for (int t = blockIdx.x * 8 + wave; t < NT; t += tstride) {
        const int cnd = tok_cond(t);
        float vn[EPL]; int msn = -1;
#pragma unroll
        for (int j = 0; j < EPL; ++j) vn[j] = 0.f;
        if (t + tstride < NT) load_row(t + tstride, vn, msn);
        float v[EPL];
        if (MODE == 0 && l > 0) {
            const float* g2 = mods + ((size_t)(l - 1) * NCOND + cnd) * 6 * D + 5 * D;
            float f[EPL], gv[EPL];
#pragma unroll
            for (int j = 0; j < EPL; ++j) { f[j] = 0.f; gv[j] = g2[lane + 64 * j]; }
            const int myslot = ms;
            unsigned vm = (unsigned)__ballot(myslot >= 0);
            while (vm) {
                const int e = __builtin_ctz(vm); vm &= vm - 1u;
                const int slot = __shfl(myslot, e);
                const bf16_t* yr = (const bf16_t*)(p.ws + WS_YE) + ((size_t)e * SLOTS + slot) * D;
#pragma unroll
                for (int j = 0; j < EPL; ++j) f[j] += bf2f(yr[lane + 64 * j]);
            }
#pragma unroll
            for (int j = 0; j < EPL; ++j) v[j] = ALPHA * vr[j] + gv[j] * f[j];
        } else {
#pragma unroll
            for (int j = 0; j < EPL; ++j) v[j] = vr[j];
        }
#pragma unroll
        for (int j = 0; j < EPL; ++j) vr[j] = vn[j];
        ms = msn;
        if (!(MODE == 0 && l == 0)) {
            const int li = (MODE == 0) ? (l - 1) * 2 + 1 : l * 2;
            const float* lg = p.in[I_LNG] + (size_t)li * D; const float* lb = p.in[I_LNB] + (size_t)li * D;
            float g[EPL], bb[EPL];
#pragma unroll
            for (int j = 0; j < EPL; ++j) { g[j] = lg[lane + 64 * j]; bb[j] = lb[lane + 64 * j]; }
            float s = 0.f;
#pragma unroll
            for (int j = 0; j < EPL; ++j) s += v[j];
            const float mu = wave_sum(s) * (1.f / D);
            float q = 0.f;
#pragma unroll
            for (int j = 0; j < EPL; ++j) { const float dlt = v[j] - mu; q += dlt * dlt; }
            const float rstd = frsqrt(wave_sum(q) * (1.f / D) + EPS);
            float* dst = (MODE == 1) ? (float*)(p.ws + WS_X1) + (size_t)t * D
                       : (l == DEPTH) ? (t < NP ? p.out + O_YP + (size_t)t * D : p.out + O_YS + (size_t)(t - NP) * D) : (float*)(p.ws + WS_XBUF) + (size_t)t * D;
#pragma unroll
            for (int j = 0; j < EPL; ++j) { v[j] = (v[j] - mu) * rstd * g[j] + bb[j]; dst[lane + 64 * j] = v[j]; }
        }
        if (MODE == 1 || l < DEPTH) {
            const float* sh = mods + ((size_t)l * NCOND + cnd) * 6 * D + (MODE == 1 ? 3 * D : 0); const float* sc = sh + D;
            bf16_t* hb = (bf16_t*)(p.ws + (MODE == 1 ? WS_H2 : WS_HMOD)) + (size_t)t * D;
            {
                float s1[EPL], s0[EPL];
#pragma unroll
                for (int j = 0; j < EPL; ++j) { s1[j] = sc[lane + 64 * j]; s0[j] = sh[lane + 64 * j]; }
#pragma unroll
                for (int j = 0; j < EPL; ++j) { v[j] = v[j] * (1.f + s1[j]) + s0[j]; hb[lane + 64 * j] = f2bf(v[j]); }
            }
            CFENCE();
            float a16[16];
#pragma unroll
            for (int e = 0; e < 16; ++e) a16[e] = 0.f;
#pragma unroll
            for (int j = 0; j < EPL; ++j) {
                const float hv = v[j];
                const float* wr = W16 + (lane + 64 * j) * W16ROW;
#pragma unroll
                for (int q = 0; q < 4; ++q) { const f4v w4 = *(const f4v*)(wr + 4 * q); a16[4 * q] += hv * w4[0]; a16[4 * q + 1] += hv * w4[1]; a16[4 * q + 2] += hv * w4[2]; a16[4 * q + 3] += hv * w4[3]; }
                if (j & 1) CFENCE();
            }
            float mine = -1e30f;
#pragma unroll
            for (int e = 0; e < 16; ++e) { const float sm = wave_sum(a16[e]); if (lane == e) mine = sm; }
            if (MODE == 0) {
                if (lane < 16) ((float*)(p.ws + WS_GATES))[(size_t)t * 16 + lane] = mine + p.in[I_BGATE][l * 16 + lane];
            } else {
                float mx = mine;
                for (int m = 8; m >= 1; m >>= 1) mx = fmaxf(mx, __shfl_xor(mx, m));
                const float ex = lane < 16 ? fexp(mine - mx) : 0.f;
                float sm = ex;
                for (int m = 8; m >= 1; m >>= 1) sm += __shfl_xor(sm, m);
                if (lane < 16) ((float*)(p.ws + WS_AFF))[(size_t)t * 16 + lane] = ex / sm;
            }
        }
    }
}

template <int NPL>
DEV void topk_wave(const Params& p, int tb, int cap, int sbase, int e, int lane) {
    const float* aff = (const float*)(p.ws + WS_AFF);
    int* idx = (int*)(p.ws + WS_IDX); float* gsel = (float*)(p.ws + WS_GSEL); int* tokslot = (int*)(p.ws + WS_TOKSLOT);
    unsigned bits[NPL];
#pragma unroll
    for (int i = 0; i < NPL; ++i) bits[i] = __builtin_bit_cast(unsigned, aff[(size_t)(tb + lane + 64 * i) * 16 + e]);
    unsigned T = 0u;
    for (int b = 30; b >= 0; --b) {
        const unsigned cand = T | (1u << b);
        int cnt = 0;
#pragma unroll
        for (int i = 0; i < NPL; ++i) cnt += __popcll(__ballot(bits[i] >= cand));
        if (cnt >= cap) T = cand;
    }
    int ngt = 0;
#pragma unroll
    for (int i = 0; i < NPL; ++i) ngt += __popcll(__ballot(bits[i] > T));
    int need_eq = cap - ngt, run = 0;
    const unsigned long long lt = (1ull << lane) - 1ull;
#pragma unroll
    for (int i = 0; i < NPL; ++i) {
        const bool eq = bits[i] == T;
        const unsigned long long meq = __ballot(eq);
        const int eqrank = __popcll(meq & lt);
        const bool sel = bits[i] > T || (eq && eqrank < need_eq);
        const unsigned long long ms = __ballot(sel);
        const int t = tb + lane + 64 * i;
        if (sel) { const int slot = sbase + run + __popcll(ms & lt); idx[e * SLOTS + slot] = t; gsel[e * SLOTS + slot] = __builtin_bit_cast(float, bits[i]); tokslot[(size_t)t * 16 + e] = slot; }
        else tokslot[(size_t)t * 16 + e] = -1;
        run += __popcll(ms);
        const int neq = __popcll(meq); need_eq -= neq < need_eq ? neq : need_eq;
    }
}
DEV void phase_topk(const Params& p, char* smem) {
    (void)smem;
    const int tid = get_tid(), lane = tid & 63;
    constexpr int US = DEC_BATCH * NEXP, UP = BATCH * NEXP;
    const int gw = blockIdx.x + gridDim.x * (tid >> 6), nw = gridDim.x * 8;
    for (int u = gw; u < US + UP; u += nw) {
        if (u < US) { const int b = u / NEXP, e = u % NEXP; topk_wave<DEC_SEQ / 64>(p, NP + b * DEC_SEQ, CAP_S, BATCH * CAP_P + b * CAP_S, e, lane); }
        else { const int uu = u - US; const int b = uu / NEXP, e = uu % NEXP; topk_wave<SEQ / 64>(p, b * SEQ, CAP_P, b * CAP_P, e, lane); }
    }
}

DEV void store_head_f32(float* dst_f32, const f16v& v0, const f16v& v1, int h) {
#pragma unroll
    for (int ft = 0; ft < 2; ++ft) {
        const f16v& v = ft ? v1 : v0;
#pragma unroll
        for (int g = 0; g < 4; ++g) { f4v o; o[0] = v[4 * g]; o[1] = v[4 * g + 1]; o[2] = v[4 * g + 2]; o[3] = v[4 * g + 3]; *(f4v*)(dst_f32 + ft * 32 + 8 * g + 4 * h) = o; }
    }
}
template <int VAR>
DEV void phase_inproj(const Params& p, char* smem, int l) {
    constexpr int NJ = 22, NU = (NT / 256) * NJ;
    const int tid = get_tid(), lane = tid & 63, wave = tid >> 6, wm = wave & 3, wn = wave >> 2, h = lane >> 5, l31 = lane & 31;
    const bf16_t* hmod = (const bf16_t*)(p.ws + WS_HMOD);
    const float* rope = (const float*)(p.ws + WS_ROPE);
    constexpr int NMB = NT / 256, RPX = (NMB % 8 == 0) ? NMB / 8 : NMB;
    const UnitIter it = unit_iter(NU);
    for (int u = it.i; u < it.end; u += it.step) {
        const int mb = (u / (RPX * NJ)) * RPX + u % RPX, j = (u / RPX) % NJ;
        const int colbase = j < 17 ? 128 * j : 2192 + 128 * (j - 17);
        const unsigned ao = ((unsigned)(mb * 256 + (tid >> 3)) * D + (tid & 7) * 8) * 2;
        const unsigned bvo = (unsigned)(colbase + 4 * (tid & 31)) * 4 + (unsigned)(tid >> 5) * (PROJ_W * 4);
        const unsigned blds = (unsigned)(tid >> 5) * 320u + (unsigned)(tid & 31) * 8u;
        gemm_tile<2, VAR>(smem, make_rsrc(hmod), ao, ao + 128u * D, ao + 256u * D, ao + 384u * D, make_rsrc(p.in[I_WIN] + (size_t)l * D * PROJ_W), bvo, blds, PROJ_W * 4, D, [&](f16v (&acc)[2][2]) {
            int lane_e = lane; VGPR_PIN(lane_e); const int lane = lane_e, l31 = lane_e & 31, h = lane_e >> 5; (void)l31; (void)h;
            const int cb = colbase + wn * 64;
            char* stg = wave_stage_ptr(smem, wave);
            const int t0 = mb * 256 + wm * 64;
            const bool isP = t0 < NP;
            bf16_t* dstb; size_t dstride;
            int f32out = 0, fhead = 0, fheads = 0; size_t fbase = 0;
            int mode = 0;
            if (cb < 1152) {
                const int seg = cb / 384, head = (cb % 384) / 64;
                dstb = (bf16_t*)(p.ws + (seg == 0 ? WS_NAQ : seg == 1 ? WS_NAK : WS_NAV)) + (size_t)t0 * 384 + head * 64; dstride = 384;
                if (seg >= 1 && isP) { f32out = 1; fbase = seg == 1 ? O_NAK : O_NAV; fhead = head; fheads = NAH; }
            } else if (cb < 2176) {
                const int seg = (cb - 1152) / 256, head = ((cb - 1152) % 256) / 64;
                dstb = (bf16_t*)(p.ws + (seg == 0 ? WS_MLQ : seg == 1 ? WS_MLK : seg == 2 ? WS_MLV : WS_MLO)) + (size_t)t0 * 256 + head * 64; dstride = 256;
                mode = seg == 1 ? 1 : 0;
            } else {
                const int c2 = cb - 2192;
                if (c2 < 384) { dstb = (bf16_t*)(p.ws + WS_GQQ) + (size_t)t0 * 384 + (c2 / 64) * 64; dstride = 384; mode = 2; }
                else if (c2 < 512) { const int head = (c2 - 384) / 64; dstb = (bf16_t*)(p.ws + WS_GQK) + (size_t)t0 * 128 + head * 64; dstride = 128; mode = 3;
                                     if (isP) { f32out = 1; fbase = O_GQK; fhead = head; fheads = GQKV; } }
                else { const int head = (c2 - 512) / 64; dstb = (bf16_t*)(p.ws + WS_GQV) + (size_t)t0 * 128 + head * 64; dstride = 128;
                       if (isP) { f32out = 1; fbase = O_GQV; fhead = head; fheads = GQKV; } }
            }
#pragma unroll
            for (int tt = 0; tt < 2; ++tt) {
                const int t = t0 + tt * 32 + l31;
                f16v v0 = acc[0][tt], v1 = acc[1][tt];
                if (mode == 1) { v0 *= ATT_SCALE; v1 *= ATT_SCALE; }
                if (mode >= 2) {
                    float ss = 0.f;
#pragma unroll
                    for (int r = 0; r < 16; ++r) ss += v0[r] * v0[r] + v1[r] * v1[r];
                    ss += __shfl_xor(ss, 32);
                    const float rn = frsqrt(ss * (1.f / 64.f) + EPS);
                    const float* gq = p.in[I_QKG] + ((size_t)l * 2 + (mode == 2 ? 0 : 1)) * 64;
#pragma unroll
                    for (int r = 0; r < 16; ++r) {
                        const int d = (r & 3) + 8 * (r >> 2) + 4 * h;
                        v0[r] *= rn * gq[d]; v1[r] *= rn * gq[32 + d];
                    }
                }
                if (f32out) { const int bP = t / SEQ, sP = t % SEQ; store_head_f32(p.out + fbase + ((((size_t)bP * DEPTH + l) * SEQ + sP) * fheads + fhead) * 64, v0, v1, h); }
                if (mode >= 2 && !isP) {
                    const int pos = (t - NP) % DEC_SEQ, prow = pos / GRIDW, pcol = pos % GRIDW;
#pragma unroll
                    for (int rr = 0; rr < 8; ++rr) {
                        const int fi = (rr & 3) + 8 * ((rr >> 2) & 1) + 4 * h;
                        const float c0 = rope[(prow * 16 + fi) * 2], s0 = rope[(prow * 16 + fi) * 2 + 1];
                        const float c1 = rope[(pcol * 16 + fi) * 2], s1 = rope[(pcol * 16 + fi) * 2 + 1];
                        const float a_lo = v0[rr], a_hi = v0[rr + 8]; v0[rr] = a_lo * c0 - a_hi * s0; v0[rr + 8] = a_hi * c0 + a_lo * s0;
                        const float b_lo = v1[rr], b_hi = v1[rr + 8]; v1[rr] = b_lo * c1 - b_hi * s1; v1[rr + 8] = b_hi * c1 + b_lo * s1;
                    }
                }
                stage64_write_bf16(stg, tt, v0, v1, l31, h);
            }
            stage64_flush_bf16(stg, dstb, dstride, lane);
        });
    }
}

template <int VAR>
DEV void phase_outproj(const Params& p, char* smem, int l) {
    constexpr int NC = D / 128, NU = (NT / 256) * NC;
    const int tid = get_tid(), lane = tid & 63, wave = tid >> 6, wm = wave & 3, wn = wave >> 2, h = lane >> 5, l31 = lane & 31;
    const bf16_t* mixed = (const bf16_t*)(p.ws + WS_MIXED);
    const float* mods = (const float*)(p.ws + WS_MODS);
    float* U = (float*)(p.ws + WS_U);
    constexpr int NMB = NT / 256, RPX = (NMB % 8 == 0) ? NMB / 8 : NMB;
    const UnitIter it = unit_iter(NU);
    for (int u = it.i; u < it.end; u += it.step) {
        const int mb = (u / (RPX * NC)) * RPX + u % RPX, cbk = (u / RPX) % NC;
        const unsigned ao = ((unsigned)(mb * 256 + (tid >> 3)) * MIXW + (tid & 7) * 8) * 2;
        const unsigned bvo = (unsigned)(cbk * 128 + 4 * (tid & 31)) * 4 + (unsigned)(tid >> 5) * (D * 4);
        const unsigned blds = (unsigned)(tid >> 5) * 320u + (unsigned)(tid & 31) * 8u;
        gemm_tile<2, VAR>(smem, make_rsrc(mixed), ao, ao + 128u * MIXW, ao + 256u * MIXW, ao + 384u * MIXW, make_rsrc(p.in[I_WOUT] + (size_t)l * MIXW * D), bvo, blds, D * 4, MIXW, [&](f16v (&acc)[2][2]) {
            int lane_e = lane; VGPR_PIN(lane_e); const int lane = lane_e, l31 = lane_e & 31, h = lane_e >> 5; (void)l31; (void)h;
            char* stg = wave_stage_ptr(smem, wave);
            const int t0 = mb * 256 + wm * 64;
            const float* g1 = mods + ((size_t)l * NCOND + tok_cond(t0)) * 6 * D + 2 * D;
#pragma unroll
            for (int ft = 0; ft < 2; ++ft) {
#pragma unroll
                for (int tt = 0; tt < 2; ++tt)
#pragma unroll
                    for (int g = 0; g < 4; ++g) { f4v o; o[0] = acc[ft][tt][4 * g]; o[1] = acc[ft][tt][4 * g + 1]; o[2] = acc[ft][tt][4 * g + 2]; o[3] = acc[ft][tt][4 * g + 3];
                        *(f4v*)(stg + (tt * 32 + l31) * LROW + (8 * g + 4 * h) * 4) = o; }
                WAVE_SYNC();
                const int f0 = cbk * 128 + wn * 64 + ft * 32 + (lane & 7) * 4;
                const f4v gv = *(const f4v*)(g1 + f0);
#pragma unroll
                for (int i = 0; i < 8; ++i) {
                    const int r = (lane >> 3) + 8 * i, t = t0 + r;
                    const f4v a = *(const f4v*)(stg + r * LROW + (lane & 7) * 16);
                    const float* xr = (l == 0) ? (t < NP ? p.in[I_XP] + (size_t)t * D : p.in[I_XS] + (size_t)(t - NP) * D) : (const float*)(p.ws + WS_XBUF) + (size_t)t * D;
                    const f4v xv = *(const f4v*)(xr + f0);
                    f4v o;
#pragma unroll
                    for (int q = 0; q < 4; ++q) o[q] = ALPHA * xv[q] + gv[q] * a[q];
                    *(f4v*)(U + (size_t)t * D + f0) = o;
                }
                WAVE_SYNC();
            }
        });
    }
}

template <int VAR>
DEV void phase_gateup(const Params& p, char* smem, int l) {
    constexpr int NRB = SLOTS / 256, NCB = EH / 128, NU = NEXP * NCB * NRB;
    const int tid = get_tid(), lane = tid & 63, wave = tid >> 6, wm = wave & 3, wn = wave >> 2, h = lane >> 5, l31 = lane & 31;
    const bf16_t* h2 = (const bf16_t*)(p.ws + WS_H2);
    const int* idx = (const int*)(p.ws + WS_IDX);
    bf16_t* hid = (bf16_t*)(p.ws + WS_HID);
    constexpr int TPC = NU / 8;
#ifdef GU_FORCE_HALF
    constexpr int HT = GU_FORCE_HALF;
#else
    constexpr int HT = (NU % 8 == 0 && TPC % 32 == 16) ? 16 : 0;
#endif
    constexpr int UPC = TPC + HT;
    const bool chunked = (gridDim.x & 7) == 0 && (NU & 7) == 0;
    const UnitIter it = unit_iter(chunked ? 8 * UPC : NU);
    for (int uu = it.i; uu < it.end; uu += it.step) {
        int u = uu, half = -1;
        if (chunked) { const int x = uu / UPC, v = uu % UPC; if (v < TPC - HT) u = x * TPC + v; else { const int hv = v - (TPC - HT); u = x * TPC + (TPC - HT) + (hv >> 1); half = hv & 1; } }
        const int rb = u % NRB, cbk = (u / NRB) % NCB, e = u / (NRB * NCB);
        const int* ip = idx + e * SLOTS + rb * 256 + (tid >> 3);
        const unsigned a0 = ((unsigned)ip[0] * D + (tid & 7) * 8) * 2, a1 = ((unsigned)ip[64] * D + (tid & 7) * 8) * 2;
        const unsigned a2 = ((unsigned)ip[128] * D + (tid & 7) * 8) * 2, a3 = ((unsigned)ip[192] * D + (tid & 7) * 8) * 2;
#ifdef EMU
        const int bw = tid >> 6;
#else
        const int bw = __builtin_amdgcn_readfirstlane(tid >> 6);
#endif
        const int is_up = bw & 1;
        const float* wmat = (is_up ? p.in[I_WU] : p.in[I_WG]) + ((size_t)l * NEXP + e) * D * EH;
        if (half < 0) {
        const int bkr = 2 * (bw >> 1) + ((tid >> 5) & 1), hc = 4 * (tid & 31);
        const int ncol = (hc >> 6) * 128 + (2 * ((hc >> 5) & 1) + is_up) * 32 + (hc & 31);
        const unsigned bvo = (unsigned)(cbk * 128 + hc) * 4 + (unsigned)bkr * (EH * 4);
        const unsigned blds = (unsigned)bkr * 576u + (unsigned)ncol * 2u;
        gemm_tile<4, VAR>(smem, make_rsrc(h2), a0, a1, a2, a3, make_rsrc(wmat), bvo, blds, EH * 4, D, [&](f16v (&acc)[4][2]) {
            int lane_e = lane; VGPR_PIN(lane_e); const int lane = lane_e, l31 = lane_e & 31, h = lane_e >> 5; (void)l31; (void)h;
            char* stg = wave_stage_ptr(smem, wave);
#pragma unroll
            for (int tt = 0; tt < 2; ++tt)
#pragma unroll
                for (int pr = 0; pr < 2; ++pr)
#pragma unroll
                    for (int g = 0; g < 4; ++g) {
                        float o[4];
#pragma unroll
                        for (int q = 0; q < 4; ++q) o[q] = siluf_(acc[2 * pr][tt][4 * g + q]) * acc[2 * pr + 1][tt][4 * g + q];
                        stage64_write4(stg, tt * 32 + l31, pr * 32 + 8 * g + 4 * h, o[0], o[1], o[2], o[3]);
                    }
            stage64_flush_bf16(stg, hid + ((size_t)e * SLOTS + rb * 256 + wm * 64) * EH + cbk * 128 + wn * 64, EH, lane);
        });
        } else {
        const int bkr = 4 * (bw >> 1) + ((tid >> 4) & 3), hc = 4 * (tid & 15);
        const int ncol = (hc >> 5) * 64 + is_up * 32 + (hc & 31);
        const unsigned bvo = (unsigned)(cbk * 128 + half * 64 + hc) * 4 + (unsigned)bkr * (EH * 4);
        const unsigned blds = (unsigned)bkr * 320u + (unsigned)ncol * 2u;
        gemm_tile<2, VAR>(smem, make_rsrc(h2), a0, a1, a2, a3, make_rsrc(wmat), bvo, blds, EH * 4, D, [&](f16v (&acc)[2][2]) {
            int lane_e = lane; VGPR_PIN(lane_e); const int lane = lane_e, l31 = lane_e & 31, h = lane_e >> 5; (void)l31; (void)h;
            char* stg = wave_stage_ptr(smem, wave);
#pragma unroll
            for (int tt = 0; tt < 2; ++tt)
#pragma unroll
                for (int g = 0; g < 4; ++g) {
                    float o[4];
#pragma unroll
                    for (int q = 0; q < 4; ++q) o[q] = siluf_(acc[0][tt][4 * g + q]) * acc[1][tt][4 * g + q];
                    stage64_write4(stg, tt * 32 + l31, 8 * g + 4 * h, o[0], o[1], o[2], o[3]);
                }
            WAVE_SYNC();
            bf16_t* dst0 = hid + ((size_t)e * SLOTS + rb * 256 + wm * 64) * EH + cbk * 128 + half * 64 + wn * 32;
#pragma unroll
            for (int i = 0; i < 4; ++i) { const int r = (lane >> 2) + 16 * i, c = lane & 3; const u4v v = *(const u4v*)(stg + r * LROW + c * 16); *(u4v*)(dst0 + (size_t)r * EH + c * 8) = v; }
            WAVE_SYNC();
        });
        }
    }
}

template <int VAR>
DEV void phase_down(const Params& p, char* smem, int l) {
    constexpr int NRB = SLOTS / 256, NCB = D / 256, NU = NEXP * NCB * NRB;
    const int tid = get_tid(), lane = tid & 63, wave = tid >> 6, wm = wave & 3, wn = wave >> 2, h = lane >> 5, l31 = lane & 31;
    const bf16_t* hid = (const bf16_t*)(p.ws + WS_HID);
    const float* gsel = (const float*)(p.ws + WS_GSEL);
    bf16_t* ye = (bf16_t*)(p.ws + WS_YE);
    const UnitIter it = unit_iter(NU);
    for (int u = it.i; u < it.end; u += it.step) {
        const int rb = u % NRB, cbk = (u / NRB) % NCB, e = u / (NRB * NCB);
        const unsigned ao = ((unsigned)(rb * 256 + (tid >> 3)) * EH + (tid & 7) * 8) * 2;
        const unsigned bvo = (unsigned)(cbk * 256 + 4 * (tid & 63)) * 4 + (unsigned)(tid >> 6) * (D * 4);
        const unsigned blds = (unsigned)(tid >> 6) * 576u + (unsigned)(tid & 63) * 8u;
        gemm_tile<4, VAR>(smem, make_rsrc(hid + (size_t)e * SLOTS * EH), ao, ao + 128u * EH, ao + 256u * EH, ao + 384u * EH, make_rsrc(p.in[I_WD] + ((size_t)l * NEXP + e) * EH * D), bvo, blds, D * 4, EH, [&](f16v (&acc)[4][2]) {
            int lane_e = lane; VGPR_PIN(lane_e); const int lane = lane_e, l31 = lane_e & 31, h = lane_e >> 5; (void)l31; (void)h;
            char* stg = wave_stage_ptr(smem, wave);
            const float gs0 = gsel[e * SLOTS + rb * 256 + wm * 64 + l31], gs1 = gsel[e * SLOTS + rb * 256 + wm * 64 + 32 + l31];
#pragma unroll
            for (int hb = 0; hb < 2; ++hb) {
#pragma unroll
                for (int tt = 0; tt < 2; ++tt) {
                    const float gs = tt ? gs1 : gs0;
#pragma unroll
                    for (int f2 = 0; f2 < 2; ++f2)
#pragma unroll
                        for (int g = 0; g < 4; ++g) { const f16v& a = acc[2 * hb + f2][tt]; stage64_write4(stg, tt * 32 + l31, f2 * 32 + 8 * g + 4 * h, a[4 * g] * gs, a[4 * g + 1] * gs, a[4 * g + 2] * gs, a[4 * g + 3] * gs); }
                }
                stage64_flush_bf16(stg, ye + ((size_t)e * SLOTS + rb * 256 + wm * 64) * D + cbk * 256 + wn * 128 + hb * 64, D, lane);
            }
        });
    }
}

struct AttnDesc {
    const bf16_t* q; int qstride;
    int ntiles, n0;
    const bf16_t *k0, *v0; int stride0;
    const bf16_t *k1, *v1; int stride1;
    int na;
    int r0, rlo;
    const float* rpb;
    bf16_t* out; int ostride;
    float* part;
};
constexpr int ATT_TILE = 64 * LROW;
DEV int na_row_start(int r) { int s = r - KR / 2; s = s < 0 ? 0 : s; return s > ROWS - KR ? ROWS - KR : s; }
DEV void attn_unit(char* smem, const AttnDesc& d) {
    const int tid = get_tid(), lane = tid & 63, wave = tid >> 6, h = lane >> 5, l31 = lane & 31;
    char* Ks = smem; char* Vs = smem + 2 * ATT_TILE; float* rpbS = (float*)(smem + 4 * ATT_TILE);
    if (d.na) { for (int i = tid; i < 15 * 31; i += 512) rpbS[i] = d.rpb[i] * 1.4426950408889634f; }
    const bf16_t* qp = d.q + (size_t)(wave * 32 + l31) * d.qstride + h * 8;
    s8v qf[4];
#pragma unroll
    for (int s = 0; s < 4; ++s) qf[s] = *(const s8v*)(qp + 16 * s);
    float m_run = -1e30f, l_run = 0.f;
    f16v o[2]; o[0] = f16zero(); o[1] = f16zero();
    const int srow = tid >> 3, sch = tid & 7;
    u4v kreg, vreg;
    auto gload = [&](int t) {
        const bf16_t *kp, *vp;
        if (t < d.n0) { const size_t off = (size_t)(t * 64 + srow) * d.stride0 + sch * 8; kp = d.k0 + off; vp = d.v0 + off; }
        else { const size_t off = (size_t)((t - d.n0) * 64 + srow) * d.stride1 + sch * 8; kp = d.k1 + off; vp = d.v1 + off; }
        kreg = *(const u4v*)kp; vreg = *(const u4v*)vp;
    };
    auto lstore = [&](int buf) { *(u4v*)(Ks + buf * ATT_TILE + srow * LROW + sch * 16) = kreg; *(u4v*)(Vs + buf * ATT_TILE + srow * LROW + sch * 16) = vreg; };
    const int qr = d.r0 + (wave >> 1), qw = (wave & 1) * 32 + l31;
    const int rs = na_row_start(qr);
    int cs = qw - KC / 2; cs = cs < 0 ? 0 : (cs > GRIDW - KC ? GRIDW - KC : cs);
    gload(0); lstore(0);
    __syncthreads();
    for (int t = 0; t < d.ntiles; ++t) {
        const int buf = t & 1;
        if (t + 1 < d.ntiles) gload(t + 1);
        const bool local = d.na && t >= d.n0;
        const int kr = d.rlo + (t - d.n0);
        const bool active = !local || (kr >= rs && kr < rs + KR);
        if (active) {
            const char* kb = Ks + buf * ATT_TILE + l31 * LROW + h * 16;
            f16v sa[2];
#pragma unroll
            for (int kt = 0; kt < 2; ++kt) {
                sa[kt] = f16zero();
#pragma unroll
                for (int s = 0; s < 4; ++s) { const s8v kf = *(const s8v*)(kb + kt * 32 * LROW + s * 32); sa[kt] = mfma32(kf, qf[s], sa[kt]); }
            }
            constexpr float C2 = ATT_SCALE * 1.4426950408889634f;
            float mx = -1e30f;
            if (local) {
#pragma unroll
                for (int kt = 0; kt < 2; ++kt)
#pragma unroll
                    for (int r = 0; r < 16; ++r) {
                        const int kc = kt * 32 + (r & 3) + 8 * (r >> 2) + 4 * h;
                        const bool inw = kc >= cs && kc < cs + KC;
                        const int bi = (kr - qr + 7) * 31 + (kc - qw + 15);
                        const float v = inw ? sa[kt][r] * C2 + rpbS[inw ? bi : 0] : -1e30f;
                        sa[kt][r] = v; mx = fmaxf(mx, v);
                    }
            } else {
#pragma unroll
                for (int kt = 0; kt < 2; ++kt)
#pragma unroll
                    for (int r = 0; r < 16; ++r) mx = fmaxf(mx, sa[kt][r]);
                mx *= C2;
            }
            mx = fmaxf(mx, __shfl_xor(mx, 32));
            if (__ballot(mx > m_run) != 0ull) {
                const float m_new = fmaxf(m_run, mx);
                const float alpha = fexp2(m_run - m_new);
                l_run *= alpha; m_run = m_new;
                o[0] *= alpha; o[1] *= alpha;
            }
            float ps = 0.f;
            if (local) {
#pragma unroll
                for (int kt = 0; kt < 2; ++kt)
#pragma unroll
                    for (int r = 0; r < 16; ++r) { const float pv = fexp2(sa[kt][r] - m_run); sa[kt][r] = pv; ps += pv; }
            } else {
#pragma unroll
                for (int kt = 0; kt < 2; ++kt)
#pragma unroll
                    for (int r = 0; r < 16; ++r) { const float pv = fexp2(sa[kt][r] * C2 - m_run); sa[kt][r] = pv; ps += pv; }
            }
            l_run += ps;
            const char* vb = Vs + buf * ATT_TILE + (4 * h + ((lane & 15) >> 2)) * LROW + (((lane >> 4) & 1) * 16 + 4 * (lane & 3)) * 2;
#pragma unroll
            for (int ks = 0; ks < 4; ++ks) {
                const int kt = ks >> 1, rb = 8 * (ks & 1);
                u4v pk; pk[0] = pack2(sa[kt][rb], sa[kt][rb + 1]); pk[1] = pack2(sa[kt][rb + 2], sa[kt][rb + 3]);
                pk[2] = pack2(sa[kt][rb + 4], sa[kt][rb + 5]); pk[3] = pack2(sa[kt][rb + 6], sa[kt][rb + 7]);
                const s8v pf = __builtin_bit_cast(s8v, pk);
                const char* vk = vb + (kt * 32 + 16 * (ks & 1)) * LROW;
#pragma unroll
                for (int dt = 0; dt < 2; ++dt) {
                    const s4v lo = lds_tr16(vk + dt * 64), hi = lds_tr16(vk + 8 * LROW + dt * 64);
                    s8v vf; vf[0] = lo[0]; vf[1] = lo[1]; vf[2] = lo[2]; vf[3] = lo[3]; vf[4] = hi[0]; vf[5] = hi[1]; vf[6] = hi[2]; vf[7] = hi[3];
                    o[dt] = mfma32(vf, pf, o[dt]);
                }
            }
        }
        if (t + 1 < d.ntiles) lstore(buf ^ 1);
        __syncthreads();
    }
    const float l_tot = l_run + __shfl_xor(l_run, 32);
    const int qrow = wave * 32 + l31;
    if (d.part) {
        float* po = d.part + (size_t)qrow * 64;
#pragma unroll
        for (int dt = 0; dt < 2; ++dt)
#pragma unroll
            for (int g = 0; g < 4; ++g) { f4v v; v[0] = o[dt][4 * g]; v[1] = o[dt][4 * g + 1]; v[2] = o[dt][4 * g + 2]; v[3] = o[dt][4 * g + 3]; *(f4v*)(po + dt * 32 + 8 * g + 4 * h) = v; }
        if (h == 0) { d.part[256 * 64 + qrow] = m_run; d.part[256 * 64 + 256 + qrow] = l_tot; }
    } else {
        const float inv = 1.f / l_tot;
        bf16_t* po = d.out + (size_t)qrow * d.ostride;
#pragma unroll
        for (int dt = 0; dt < 2; ++dt)
#pragma unroll
            for (int g = 0; g < 4; ++g) {
                u2v pk; pk[0] = pack2(o[dt][4 * g] * inv, o[dt][4 * g + 1] * inv); pk[1] = pack2(o[dt][4 * g + 2] * inv, o[dt][4 * g + 3] * inv);
                *(u2v*)(po + dt * 32 + 8 * g + 4 * h) = pk;
            }
    }
}

DEV int ml_sidx(int grp, int b, int head, int c) { return grp == 0 ? ((b * MLH + head) * NCH_P + c) : BATCH * MLH * NCH_P + ((b * MLH + head) * NCH_S + c); }
DEV float lane_prefix_sum(float v, int lane) { for (int dlt = 1; dlt < 64; dlt <<= 1) { const float o = __shfl(v, lane - dlt); if (lane >= dlt) v += o; } return v; }
DEV float lane_prefix_max(float v, int lane) { for (int dlt = 1; dlt < 64; dlt <<= 1) { const float o = __shfl(v, lane - dlt); if (lane >= dlt) v = fmaxf(v, o); } return v; }

DEV void mlstm_summary_unit(const Params& p, char* smem, int grp, int b, int head, int c) {
    const int tid = get_tid(), lane = tid & 63, wave = tid >> 6, h = lane >> 5, l31 = lane & 31;
    char* KT = smem;
    char* VT = smem + 2 * ATT_TILE;
    float* wsS = (float*)(smem + 3 * ATT_TILE);
    float* scal = wsS + 128;
    const int tb = (grp == 0 ? b * SEQ : NP + b * DEC_SEQ) + c * 64;
    const float* gates = (const float*)(p.ws + WS_GATES);
    if (wave == 0) {
        const float* gr = gates + (size_t)(tb + lane) * 16;
        const float i_f = gr[head], lf_f = logsigmoidf_(gr[4 + head]), i_b = gr[8 + head], lf_b = logsigmoidf_(gr[12 + head]);
        const float pf = lane_prefix_sum(lf_f, lane), pb = lane_prefix_sum(lf_b, lane);
        const float tot_f = __shfl(pf, 63), tot_b = __shfl(pb, 63);
        const float g_f = (tot_f - pf) + i_f, g_b = (pb - lf_b) + i_b;
        const float G_f = wave_max(g_f), G_b = wave_max(g_b);
        wsS[lane] = fexp(g_f - G_f); wsS[64 + lane] = fexp(g_b - G_b);
        if (lane == 0) { scal[0] = tot_f; scal[1] = tot_b; scal[2] = G_f; scal[3] = G_b; }
    }
    __syncthreads();
    {
        const int tau = tid >> 3, ch = tid & 7;
        const u4v kv = *(const u4v*)((const bf16_t*)(p.ws + WS_MLK) + (size_t)(tb + tau) * 256 + head * 64 + ch * 8);
        const u4v vv = *(const u4v*)((const bf16_t*)(p.ws + WS_MLV) + (size_t)(tb + tau) * 256 + head * 64 + ch * 8);
        const float wf = wsS[tau], wb = wsS[64 + tau];
#pragma unroll
        for (int j = 0; j < 8; ++j) {
            const bf16_t kb = (bf16_t)(kv[j >> 1] >> (16 * (j & 1))), vb = (bf16_t)(vv[j >> 1] >> (16 * (j & 1)));
            const int dim = ch * 8 + j; const float kf = bf2f(kb);
            *(bf16_t*)(KT + dim * LROW + tau * 2) = f2bf(kf * wf);
            *(bf16_t*)(KT + ATT_TILE + dim * LROW + tau * 2) = f2bf(kf * wb);
            *(bf16_t*)(VT + dim * LROW + tau * 2) = vb;
        }
    }
    __syncthreads();
    float* sum = (float*)(p.ws + WS_MLSUM);
    const int sidx = ml_sidx(grp, b, head, c);
    {
        const int dir = wave >> 2, mi = (wave >> 1) & 1, ni = wave & 1;
        f16v acc = f16zero();
#pragma unroll
        for (int s = 0; s < 4; ++s) {
            const s8v af = *(const s8v*)(KT + dir * ATT_TILE + (mi * 32 + l31) * LROW + (16 * s + 8 * h) * 2);
            const s8v bf = *(const s8v*)(VT + (ni * 32 + l31) * LROW + (16 * s + 8 * h) * 2);
            acc = mfma32(af, bf, acc);
        }
        float* U = sum + (size_t)(sidx * 2 + dir) * MLSUM_STRIDE;
#pragma unroll
        for (int r = 0; r < 16; ++r) U[(mi * 32 + (r & 3) + 8 * (r >> 2) + 4 * h) * 64 + ni * 32 + l31] = acc[r];
    }
    if (tid < 128) {
        const int dir = tid >> 6, kd = tid & 63;
        float s = 0.f;
        for (int tau = 0; tau < 64; ++tau) s += bf2f(*(const bf16_t*)(KT + dir * ATT_TILE + kd * LROW + tau * 2));
        float* E = sum + (size_t)(sidx * 2 + dir) * MLSUM_STRIDE;
        E[4096 + kd] = s;
        if (kd == 0) { E[4160] = scal[dir]; E[4161] = scal[2 + dir]; }
    }
    __syncthreads();
}

DEV void mlstm_output_unit(const Params& p, char* smem, int l, int grp, int b, int head, int c) {
    const int tid = get_tid(), lane = tid & 63, wave = tid >> 6, h = lane >> 5, l31 = lane & 31;
    const int nc = grp ? NCH_S : NCH_P;
    char* Qs = smem;
    char* Ks = smem + 2 * ATT_TILE;
    char* VT = smem + 4 * ATT_TILE;
    char* CT = smem + 6 * ATT_TILE;
    char* QK = smem + 8 * ATT_TILE;
    float* hS = (float*)(smem + 10 * ATT_TILE);
    float* vec = hS + 2 * 64 * 68;
    float* aS = vec; float* MjS = vec + 128; float* bS = vec + 256; float* nS = vec + 384; float* denp = vec + 512; float* qnS = vec + 768; float* scal = vec + 896;
    const int tb = (grp == 0 ? b * SEQ : NP + b * DEC_SEQ) + c * 64;
    const float* sum = (const float*)(p.ws + WS_MLSUM);
    const size_t qoff = (size_t)(tb + (tid >> 3)) * 256 + head * 64 + (tid & 7) * 8;
    const u4v q_r = *(const u4v*)((const bf16_t*)(p.ws + WS_MLQ) + qoff);
    const u4v k_r = *(const u4v*)((const bf16_t*)(p.ws + WS_MLK) + qoff);
    const u4v v_r = *(const u4v*)((const bf16_t*)(p.ws + WS_MLV) + qoff);
    const u4v o_r = *(const u4v*)((const bf16_t*)(p.ws + WS_MLO) + qoff);
    float g_i = 0.f, g_f = 0.f;
    if (wave < 2) { const float* gr = (const float*)(p.ws + WS_GATES) + (size_t)(tb + (wave ? 63 - lane : lane)) * 16; g_i = gr[wave * 8 + head]; g_f = gr[wave * 8 + 4 + head]; }
#pragma unroll
    for (int dir = 0; dir < 2; ++dir) {
        float C[8], nst = 0.f, m;
        if (grp == 0) {
#pragma unroll
            for (int i = 0; i < 8; ++i) C[i] = 0.f;
            m = 0.f;
        } else {
            const size_t sb = (((size_t)b * DEPTH + l) * 2 + dir) * MLH + head;
#pragma unroll
            for (int i = 0; i < 8; ++i) C[i] = p.in[I_SC][sb * 4096 + tid + 512 * i];
            if (tid < 64) nst = p.in[I_SN][sb * 64 + tid];
            m = p.in[I_SM][sb];
        }
        const int nsteps = dir == 0 ? c : nc - 1 - c;
        const bool fin = (grp == 0) && (dir == 0 ? c == nc - 1 : c == 0);
        {
            float A = 0.f, G = -1e30f;
            if (lane < nsteps) { const float* E = sum + (size_t)(ml_sidx(grp, b, head, dir == 0 ? lane : nc - 1 - lane) * 2 + dir) * MLSUM_STRIDE; A = E[4160]; G = E[4161]; }
            const float P = lane_prefix_sum(A, lane);
            const float T = __shfl(P, 63);
            const float ev = lane < nsteps ? G + (T - P) : -1e30f;
            const float mc = fmaxf(m + T, wave_max(ev));
            const float coef = lane < nsteps ? fexp(ev - mc) : 0.f;
            const float coef0 = fexp(m + T - mc);
#pragma unroll
            for (int i = 0; i < 8; ++i) C[i] *= coef0;
            nst *= coef0;
#pragma unroll 4
            for (int st = 0; st < nsteps; ++st) {
                const float* E = sum + (size_t)(ml_sidx(grp, b, head, dir == 0 ? st : nc - 1 - st) * 2 + dir) * MLSUM_STRIDE;
                const float cf = __shfl(coef, st);
#pragma unroll
                for (int i = 0; i < 8; ++i) C[i] += cf * E[tid + 512 * i];
                if (tid < 64) nst += cf * E[4096 + tid];
            }
            m = mc;
        }
#pragma unroll
        for (int i = 0; i < 8; ++i) { const int e = tid + 512 * i; *(bf16_t*)(CT + dir * ATT_TILE + (e & 63) * LROW + (e >> 6) * 2) = f2bf(C[i]); }
        if (tid < 64) nS[dir * 64 + tid] = nst;
        if (tid == 0) scal[dir] = m;
        if (fin) {
            const float* E = sum + (size_t)(ml_sidx(grp, b, head, c) * 2 + dir) * MLSUM_STRIDE;
            const float A = E[4160], G = E[4161];
            const float m_new = fmaxf(A + m, G);
            const float sc = fexp(A + m - m_new), su = fexp(G - m_new);
            const size_t ob = (((size_t)b * DEPTH + l) * 2 + dir) * MLH + head;
#pragma unroll
            for (int i = 0; i < 8; ++i) p.out[O_MC + ob * 4096 + tid + 512 * i] = sc * C[i] + su * E[tid + 512 * i];
            if (tid < 64) p.out[O_MN + ob * 64 + tid] = sc * nst + su * E[4096 + tid];
            if (tid == 0) p.out[O_MM + ob] = m_new;
        }
    }
    {
        const int row = tid >> 3, ch = tid & 7;
#pragma unroll
        for (int dir = 0; dir < 2; ++dir) {
            const int pr = dir ? 63 - row : row;
            *(u4v*)(Qs + dir * ATT_TILE + pr * LROW + ch * 16) = q_r;
            *(u4v*)(Ks + dir * ATT_TILE + pr * LROW + ch * 16) = k_r;
#pragma unroll
            for (int j = 0; j < 8; ++j) *(bf16_t*)(VT + dir * ATT_TILE + (ch * 8 + j) * LROW + pr * 2) = (bf16_t)(v_r[j >> 1] >> (16 * (j & 1)));
        }
    }
    __syncthreads();
    if (wave < 2) {
        const int dir = wave;
        const float ig = g_i, lf = logsigmoidf_(g_f);
        const float bj = lane_prefix_sum(lf, lane);
        const float a = ig - bj;
        const float Pj = lane_prefix_max(a, lane);
        aS[dir * 64 + lane] = a; bS[dir * 64 + lane] = bj; MjS[dir * 64 + lane] = fmaxf(scal[dir], Pj);
    } else if (wave < 4) {
        const int dir = wave - 2;
        float s = 0.f;
        for (int k = 0; k < 64; ++k) s += bf2f(*(const bf16_t*)(Qs + dir * ATT_TILE + lane * LROW + k * 2)) * nS[dir * 64 + k];
        qnS[dir * 64 + lane] = s;
    }
    __syncthreads();
    const int dir = wave >> 2, rt = (wave >> 1) & 1, jt = wave & 1;
    const int j = jt * 32 + l31;
    const float Mj = MjS[dir * 64 + j];
    {
        f16v acc = f16zero();
#pragma unroll
        for (int s4 = 0; s4 < 4; ++s4) {
            const s8v af = *(const s8v*)(Ks + dir * ATT_TILE + (rt * 32 + l31) * LROW + (16 * s4 + 8 * h) * 2);
            const s8v bf = *(const s8v*)(Qs + dir * ATT_TILE + j * LROW + (16 * s4 + 8 * h) * 2);
            acc = mfma32(af, bf, acc);
        }
        float dsum = 0.f;
#pragma unroll
        for (int g = 0; g < 4; ++g) {
            float o[4];
#pragma unroll
            for (int q = 0; q < 4; ++q) {
                const int s = rt * 32 + 8 * g + 4 * h + q;
                const float w = s <= j ? fexp(aS[dir * 64 + s] - Mj) : 0.f;
                o[q] = acc[4 * g + q] * w; dsum += o[q];
            }
            u2v pk; pk[0] = pack2(o[0], o[1]); pk[1] = pack2(o[2], o[3]);
            *(u2v*)(QK + dir * ATT_TILE + j * LROW + (rt * 32 + 8 * g + 4 * h) * 2) = pk;
        }
        dsum += __shfl_xor(dsum, 32);
        if (h == 0) denp[(dir * 2 + rt) * 64 + j] = dsum;
    }
    __syncthreads();
    {
        const float mst = scal[dir];
        const float decay = fexp(mst - Mj);
        f16v acc = f16zero();
#pragma unroll
        for (int s4 = 0; s4 < 4; ++s4) {
            const s8v af = *(const s8v*)(CT + dir * ATT_TILE + (rt * 32 + l31) * LROW + (16 * s4 + 8 * h) * 2);
            const s8v bf = *(const s8v*)(Qs + dir * ATT_TILE + j * LROW + (16 * s4 + 8 * h) * 2);
            acc = mfma32(af, bf, acc);
        }
        acc *= decay;
#pragma unroll
        for (int s4 = 0; s4 < 4; ++s4) {
            const s8v af = *(const s8v*)(VT + dir * ATT_TILE + (rt * 32 + l31) * LROW + (16 * s4 + 8 * h) * 2);
            const s8v bf = *(const s8v*)(QK + dir * ATT_TILE + j * LROW + (16 * s4 + 8 * h) * 2);
            acc = mfma32(af, bf, acc);
        }
        const float den = decay * qnS[dir * 64 + j] + denp[(dir * 2) * 64 + j] + denp[(dir * 2 + 1) * 64 + j];
        const float dn = fmaxf(fabsf(den), fexp(-(bS[dir * 64 + j] + Mj)));
        const float inv = 1.f / dn;
#pragma unroll
        for (int g = 0; g < 4; ++g) { f4v o; o[0] = acc[4 * g] * inv; o[1] = acc[4 * g + 1] * inv; o[2] = acc[4 * g + 2] * inv; o[3] = acc[4 * g + 3] * inv;
            *(f4v*)(hS + (dir * 64 + j) * 68 + rt * 32 + 8 * g + 4 * h) = o; }
    }
    __syncthreads();
    {
        const int tau = tid >> 3, v8 = (tid & 7) * 8;
        float hv[8]; float s = 0.f;
#pragma unroll
        for (int q = 0; q < 8; ++q) { hv[q] = hS[tau * 68 + v8 + q] + hS[(64 + 63 - tau) * 68 + v8 + q]; s += hv[q]; }
        s += __shfl_xor(s, 1); s += __shfl_xor(s, 2); s += __shfl_xor(s, 4);
        const float mu = s * (1.f / 64.f);
        float qq = 0.f;
#pragma unroll
        for (int q = 0; q < 8; ++q) { const float dlt = hv[q] - mu; qq += dlt * dlt; }
        qq += __shfl_xor(qq, 1); qq += __shfl_xor(qq, 2); qq += __shfl_xor(qq, 4);
        const float rstd = frsqrt(qq * (1.f / 64.f) + EPS);
        const int t = tb + tau;
        const u4v ov = o_r;
        const float* ng = p.in[I_MLG] + (size_t)l * 256 + head * 64 + v8;
        float o[8];
#pragma unroll
        for (int q = 0; q < 8; ++q) { const float og = bf2f((bf16_t)(ov[q >> 1] >> (16 * (q & 1)))); o[q] = (hv[q] - mu) * rstd * ng[q] * sigmoidf_(og); }
        u4v pk; pk[0] = pack2(o[0], o[1]); pk[1] = pack2(o[2], o[3]); pk[2] = pack2(o[4], o[5]); pk[3] = pack2(o[6], o[7]);
        *(u4v*)((bf16_t*)(p.ws + WS_MIXED) + (size_t)t * MIXW + 384 + head * 64 + v8) = pk;
    }
    __syncthreads();
}

DEV int queue_next(const Params& p, char* smem, int qi) {
    int* slot = (int*)(smem + SMEM_XB + 32);
    __syncthreads();
    if (threadIdx.x == 0) {
#ifdef EMU
        unsigned* w = (unsigned*)(p.ws + WS_BAR) + QUEUE_WORD0 + 64 * qi; *slot = (int)(*w)++;
#else
        *slot = (int)__hip_atomic_fetch_add((unsigned*)(p.ws + WS_BAR) + QUEUE_WORD0 + 64 * qi, 1u, __ATOMIC_RELAXED, __HIP_MEMORY_SCOPE_AGENT);
#endif
    }
    __syncthreads();
    return *slot;
}
DEV void phase_attn(const Params& p, char* smem, int l, int qi) {
    constexpr int QB_S = DEC_SEQ / 256, QB_P = SEQ / 256;
    constexpr int U_SG = DEC_BATCH * GQH * QB_S * 2, U_SN = DEC_BATCH * NAH * QB_S, U_PN = BATCH * NAH * QB_P, U_PG = BATCH * GQH * QB_P;
    constexpr int U_MP = BATCH * MLH * NCH_P, U_MS = DEC_BATCH * MLH * NCH_S;
    constexpr int NU = U_SG + U_SN + U_PN + U_PG + U_MP + U_MS;
    const bf16_t* naq = (const bf16_t*)(p.ws + WS_NAQ); const bf16_t* nak = (const bf16_t*)(p.ws + WS_NAK); const bf16_t* nav = (const bf16_t*)(p.ws + WS_NAV);
    const bf16_t* gqq = (const bf16_t*)(p.ws + WS_GQQ); const bf16_t* gqk = (const bf16_t*)(p.ws + WS_GQK); const bf16_t* gqv = (const bf16_t*)(p.ws + WS_GQV);
    bf16_t* mixed = (bf16_t*)(p.ws + WS_MIXED);
    for (;;) {
        int u = queue_next(p, smem, qi);
        if (u >= NU) break;
#ifdef PROBE_ATT
        if (qi >= 8) { const int cls = u < U_SG ? 1 : u < U_SG + U_SN ? 2 : u < U_SG + U_SN + U_PN + U_PG ? 3 : 4; if (cls != PROBE_ATT) continue; }
#endif
        AttnDesc d; d.na = 0; d.r0 = 0; d.rlo = 0; d.rpb = nullptr; d.part = nullptr; d.out = nullptr; d.ostride = MIXW; d.n0 = 0; d.k0 = d.v0 = nullptr; d.stride0 = 0;
        if (u < U_SG) {
            const int half = u & 1, qb = (u >> 1) % QB_S, qh = (u / (2 * QB_S)) % GQH, b = u / (2 * QB_S * GQH);
            const int kvh = qh / (GQH / GQKV);
            constexpr int NCT = PAST / 64, TT = NCT + DEC_SEQ / 64, H0 = TT / 2;
            const size_t tq = (size_t)NP + (size_t)b * DEC_SEQ + qb * 256;
            d.q = gqq + tq * 384 + qh * 64; d.qstride = 384;
            const bf16_t* lk = gqk + ((size_t)NP + (size_t)b * DEC_SEQ) * 128 + kvh * 64; const bf16_t* lv = gqv + ((size_t)NP + (size_t)b * DEC_SEQ) * 128 + kvh * 64;
            if (half == 0) {
                d.n0 = NCT; d.ntiles = H0; d.stride0 = 128;
                const size_t co = (((size_t)b * DEPTH + l) * PAST) * 128 + kvh * 64;
                d.k0 = (const bf16_t*)(p.ws + WS_CGQK) + co; d.v0 = (const bf16_t*)(p.ws + WS_CGQV) + co;
                d.k1 = lk; d.v1 = lv; d.stride1 = 128;
            } else {
                d.n0 = 0; d.ntiles = TT - H0; d.stride1 = 128;
                d.k1 = lk + (size_t)(H0 - NCT) * 64 * 128; d.v1 = lv + (size_t)(H0 - NCT) * 64 * 128;
            }
            d.part = (float*)(p.ws + WS_PART) + (size_t)u * PART_STRIDE;
        } else if (u < U_SG + U_SN) {
            const int uu = u - U_SG; const int qb = uu % QB_S, hd = (uu / QB_S) % NAH, b = uu / (QB_S * NAH);
            const size_t t0 = (size_t)NP + (size_t)b * DEC_SEQ;
            d.q = naq + (t0 + qb * 256) * 384 + hd * 64; d.qstride = 384;
            d.na = 1; d.r0 = qb * 4; d.rlo = na_row_start(d.r0);
            const int rhi = na_row_start(d.r0 + 3) + KR;
            d.n0 = PAST / 64; d.ntiles = d.n0 + (rhi - d.rlo); d.stride0 = 384; d.stride1 = 384;
            const size_t co = (((size_t)b * DEPTH + l) * PAST) * 384 + hd * 64;
            d.k0 = (const bf16_t*)(p.ws + WS_CNAK) + co; d.v0 = (const bf16_t*)(p.ws + WS_CNAV) + co;
            d.k1 = nak + (t0 + (size_t)d.rlo * 64) * 384 + hd * 64; d.v1 = nav + (t0 + (size_t)d.rlo * 64) * 384 + hd * 64;
            d.rpb = p.in[I_RPB] + ((size_t)l * NAH + hd) * 15 * 31;
            d.out = mixed + (t0 + qb * 256) * MIXW + hd * 64;
        } else if (u < U_SG + U_SN + U_PN) {
            const int uu = u - U_SG - U_SN; const int qb = uu % QB_P, hd = (uu / QB_P) % NAH, b = uu / (QB_P * NAH);
            const size_t t0 = (size_t)b * SEQ;
            d.q = naq + (t0 + qb * 256) * 384 + hd * 64; d.qstride = 384;
            d.n0 = 0; d.ntiles = SEQ / 64; d.stride1 = 384; d.k1 = nak + t0 * 384 + hd * 64; d.v1 = nav + t0 * 384 + hd * 64;
            d.out = mixed + (t0 + qb * 256) * MIXW + hd * 64;
        } else if (u < U_SG + U_SN + U_PN + U_PG) {
            const int uu = u - U_SG - U_SN - U_PN; const int qb = uu % QB_P, qh = (uu / QB_P) % GQH, b = uu / (QB_P * GQH);
            const int kvh = qh / (GQH / GQKV);
            const size_t t0 = (size_t)b * SEQ;
            d.q = gqq + (t0 + qb * 256) * 384 + qh * 64; d.qstride = 384;
            d.n0 = 0; d.ntiles = SEQ / 64; d.stride1 = 128; d.k1 = gqk + t0 * 128 + kvh * 64; d.v1 = gqv + t0 * 128 + kvh * 64;
            d.out = mixed + (t0 + qb * 256) * MIXW + 640 + qh * 64;
        } else {
            int uu = u - (U_SG + U_SN + U_PN + U_PG); const int grp = uu >= U_MP ? 1 : 0; if (grp) uu -= U_MP;
            const int nch = grp ? NCH_S : NCH_P;
            mlstm_summary_unit(p, smem, grp, uu / (nch * MLH), (uu / nch) % MLH, uu % nch);
        }
        if (u < U_SG + U_SN + U_PN + U_PG) attn_unit(smem, d);
    }
}

DEV void phase_mlout(const Params& p, char* smem, int l) {
    constexpr int QB_S = DEC_SEQ / 256;
    constexpr int U_MS = DEC_BATCH * MLH * NCH_S, U_MP = BATCH * MLH * NCH_P, U_CB = DEC_BATCH * GQH * QB_S;
    const int tid = get_tid(), lane = tid & 63, wave = tid >> 6;
    for (int tk = blockIdx.x + gridDim.x * wave; tk < U_CB * 4; tk += gridDim.x * 8) {
        const int uu = tk >> 2, sl = tk & 3;
        const int qb = uu % QB_S, qh = (uu / QB_S) % GQH, b = uu / (QB_S * GQH);
        const float* p0 = (const float*)(p.ws + WS_PART) + (size_t)(2 * uu) * PART_STRIDE; const float* p1 = p0 + PART_STRIDE;
        const int q = sl * 64 + (lane >> 1) + 32 * 0, d0 = (lane & 1) * 32;
#pragma unroll
        for (int hq = 0; hq < 2; ++hq) {
            const int qq = q + 32 * hq;
            const float m0 = p0[256 * 64 + qq], m1 = p1[256 * 64 + qq], l0 = p0[256 * 64 + 256 + qq], l1 = p1[256 * 64 + 256 + qq];
            const float m = fmaxf(m0, m1), w0 = fexp2(m0 - m), w1 = fexp2(m1 - m);
            const float inv = 1.f / (l0 * w0 + l1 * w1);
            bf16_t* dst = (bf16_t*)(p.ws + WS_MIXED) + ((size_t)NP + (size_t)b * DEC_SEQ + qb * 256 + qq) * MIXW + 640 + qh * 64 + d0;
#pragma unroll
            for (int i = 0; i < 8; ++i) {
                const f4v a = *(const f4v*)(p0 + (size_t)qq * 64 + d0 + 4 * i), bb = *(const f4v*)(p1 + (size_t)qq * 64 + d0 + 4 * i);
                u2v pk; pk[0] = pack2((a[0] * w0 + bb[0] * w1) * inv, (a[1] * w0 + bb[1] * w1) * inv); pk[1] = pack2((a[2] * w0 + bb[2] * w1) * inv, (a[3] * w0 + bb[3] * w1) * inv);
                *(u2v*)(dst + 4 * i) = pk;
            }
        }
    }
    for (int u = blockIdx.x; u < U_MS + U_MP; u += gridDim.x) {
        const int grp = u < U_MS ? 1 : 0; const int uu = grp ? u : u - U_MS; const int nch = grp ? NCH_S : NCH_P;
        mlstm_output_unit(p, smem, l, grp, uu / (nch * MLH), (uu / nch) % MLH, uu % nch);
    }
}

constexpr int N_PHASES = 2 + 9 * DEPTH;
#ifndef EMU
typedef const __attribute__((address_space(4))) Params* KParamsPtr;
DEV void load_params(Params& p) {
    KParamsPtr kp = (KParamsPtr)__builtin_amdgcn_kernarg_segment_ptr();
    asm volatile("" : "+s"(kp));
#pragma unroll
    for (int i = 0; i < N_IN; ++i) p.in[i] = kp->in[i];
    p.out = kp->out; p.ws = kp->ws; p.ph0 = kp->ph0; p.ph1 = kp->ph1;
}
#endif
#ifdef EMU
static char emu_smem[SMEM_BYTES + 64];
#endif
__global__ void __launch_bounds__(512, 2) mega_kernel(Params p_) {
    const int ph0 = p_.ph0, ph1 = p_.ph1;
#ifdef EMU
    char* smem = emu_smem;
#define GRID_SYNC() do {} while (0)
#else
    extern __shared__ __attribute__((aligned(16))) char smem[];
    if (threadIdx.x == 0) *(u4v*)(smem + SMEM_XB) = (u4v){0u, 0u, 0u, 0u};
    __syncthreads();
    (void)xcd_barrier_post((unsigned*)(p_.ws + WS_BAR), (volatile LAS unsigned*)(smem + SMEM_XB));
    const bool multi = (ph1 - ph0) > 1;
#define GRID_SYNC() do { if (multi) { KParamsPtr kpb = (KParamsPtr)__builtin_amdgcn_kernarg_segment_ptr(); asm volatile("" : "+s"(kpb)); \
        XcdBarrier xb; xb.bar = (unsigned*)(kpb->ws + WS_BAR); xb.x = xb_xcc_id(); xb.st = (volatile LAS unsigned*)(smem + SMEM_XB); xcd_barrier(xb); } } while (0)
#endif
    int ph = 0;
#ifndef KIND_MASK
#define KIND_MASK 0x3ff
#endif
#ifdef EMU
#define LOAD_PARAMS() const Params& p = p_
#else
#define LOAD_PARAMS() Params p; load_params(p)
#endif
#ifndef DOUBLE_MASK
#define DOUBLE_MASK 0
#endif
#define PH_KIND() (ph == 0 ? 0 : ph == 1 + 9 * DEPTH ? 1 : 1 + (ph - 1) % 9)
#define RUN_PHASE(body) do { if (((KIND_MASK >> PH_KIND()) & 1) && ph >= ph0 && ph < ph1) { \
    if (DOUBLE_MASK && ((DOUBLE_MASK >> PH_KIND()) & 1)) { { const int rep_ = 1; LOAD_PARAMS(); body; } GRID_SYNC(); } \
    { const int rep_ = 0; LOAD_PARAMS(); body; } if (ph + 1 < ph1) GRID_SYNC(); } ++ph; } while (0)
    RUN_PHASE(phase_ada(p, smem));
    for (int l = 0; l < DEPTH; ++l) {
        RUN_PHASE(phase_rows<0>(p, smem, l));
        RUN_PHASE(phase_inproj<0>(p, smem, l));
        RUN_PHASE(phase_attn(p, smem, l, l + DEPTH * rep_));
        RUN_PHASE(phase_mlout(p, smem, l));
        RUN_PHASE(phase_outproj<0>(p, smem, l));
        RUN_PHASE(phase_rows<1>(p, smem, l));
        RUN_PHASE(phase_topk(p, smem));
        RUN_PHASE(phase_gateup<0>(p, smem, l));
        RUN_PHASE(phase_down<0>(p, smem, l));
    }
    RUN_PHASE(phase_rows<0>(p, smem, DEPTH));
#ifdef PROBE_BARRIERS
    for (int i = 0; i < PROBE_BARRIERS; ++i) GRID_SYNC();
#endif
}

#if !defined(EMU) && defined(PROBE_KIND)
__global__ void __launch_bounds__(512, 2) probe_kernel(Params p) {
    extern __shared__ __attribute__((aligned(16))) char smem[];
    for (int r = 0; r < PROBE_REPS; ++r) {
#if PROBE_KIND == 8
        phase_gateup<PROBE_VAR>(p, smem, 1);
#elif PROBE_KIND == 9
        phase_down<PROBE_VAR>(p, smem, 1);
#elif PROBE_KIND == 2
        phase_inproj<PROBE_VAR>(p, smem, 1);
#elif PROBE_KIND == 5
        phase_outproj<PROBE_VAR>(p, smem, 1);
#elif PROBE_KIND == 0
        phase_ada(p, smem);
#elif PROBE_KIND == 1
        phase_rows<0>(p, smem, 1);
#elif PROBE_KIND == 6
        phase_rows<1>(p, smem, 1);
#elif PROBE_KIND == 7
        phase_topk(p, smem);
#elif PROBE_KIND == 3
        phase_attn(p, smem, 1, 8 + r);
#elif PROBE_KIND == 4
        phase_mlout(p, smem, 1);
#endif
        __syncthreads();
    }
}
#endif
#ifndef EMU
#ifndef MK_N_LAUNCHES
#define MK_N_LAUNCHES 1
#endif
extern "C" void kernel_launch(void* const* d_in, const int* in_sizes, int n_in, void* d_out, int out_size, void* d_ws, size_t ws_size, hipStream_t stream) {
    (void)in_sizes; (void)n_in; (void)out_size; (void)ws_size;
    static int grid = 0;
    if (!grid) {
        int dev = 0, cus = 0, per_cu = 0;
        (void)hipGetDevice(&dev);
        (void)hipDeviceGetAttribute(&cus, hipDeviceAttributeMultiprocessorCount, dev);
        (void)hipFuncSetAttribute((const void*)mega_kernel, hipFuncAttributeMaxDynamicSharedMemorySize, SMEM_BYTES);
        (void)hipOccupancyMaxActiveBlocksPerMultiprocessor(&per_cu, mega_kernel, 512, SMEM_BYTES);
        grid = cus * (per_cu < 1 ? per_cu : 1);
        if (grid <= 0) grid = cus;
    }
    (void)hipMemsetAsync((char*)d_ws + WS_BAR, 0, WS_BAR_BYTES, stream);
    Params p = {};
    for (int i = 0; i < N_IN; ++i) p.in[i] = (const float*)d_in[i];
    p.out = (float*)d_out; p.ws = (char*)d_ws;
#if MK_N_LAUNCHES == 1
    p.ph0 = 0; p.ph1 = N_PHASES;
    mega_kernel<<<dim3(grid), dim3(512), SMEM_BYTES, stream>>>(p);
#ifdef PROBE_KIND
    (void)hipFuncSetAttribute((const void*)probe_kernel, hipFuncAttributeMaxDynamicSharedMemorySize, SMEM_BYTES);
    probe_kernel<<<dim3(grid), dim3(512), SMEM_BYTES, stream>>>(p);
#endif
#else
    for (int ph = 0; ph < N_PHASES; ++ph) { p.ph0 = ph; p.ph1 = ph + 1; mega_kernel<<<dim3(grid), dim3(512), SMEM_BYTES, stream>>>(p); }
#endif
}
#endif
```

```cpp
#ifndef EMU
#include <hip/hip_runtime.h>
#define DEV __device__ __forceinline__
#else
#define DEV static inline __attribute__((always_inline))
#endif
#include <stdint.h>
#include <stddef.h>

#ifndef CFG_D
#define CFG_D 1024
#define CFG_BATCH 16
#define CFG_SEQ 256
#define CFG_DEC_BATCH 2
#define CFG_DEC_SEQ 2048
#define CFG_PAST 256
#define CFG_EH 2816
#endif
constexpr int D = CFG_D, BATCH = CFG_BATCH, SEQ = CFG_SEQ, DEC_BATCH = CFG_DEC_BATCH, DEC_SEQ = CFG_DEC_SEQ, PAST = CFG_PAST, EH = CFG_EH;
constexpr int DEPTH = 2, HD = 64, NAH = 6, MLH = 4, GQH = 6, GQKV = 2, NEXP = 16, GRIDW = 64;
constexpr int NP = BATCH * SEQ, NS = DEC_BATCH * DEC_SEQ, NT = NP + NS, NCOND = 1 + DEC_BATCH;
constexpr int PROJ_W = 2832, MIXW = 1024;
constexpr int CAP_P = SEQ / 8, CAP_S = DEC_SEQ / 8, SLOTS = BATCH * CAP_P + DEC_BATCH * CAP_S;
constexpr int ROWS = DEC_SEQ / GRIDW, KR = ROWS < 8 ? ROWS : 8, KC = 16;
constexpr int NCH_P = SEQ / 64, NCH_S = DEC_SEQ / 64;
constexpr float ALPHA = 1.41421356237309515f;
constexpr float ATT_SCALE = 0.125f;
constexpr float EPS = 1e-6f;
static_assert(SLOTS % 256 == 0 && NP % 256 == 0 && NS % 256 == 0 && SEQ % 256 == 0 && DEC_SEQ % 256 == 0, "tile divisibility");
static_assert(D % 256 == 0 && EH % 128 == 0 && PAST % 64 == 0, "tile divisibility");

typedef unsigned short bf16_t;
typedef short s8v __attribute__((ext_vector_type(8)));
typedef short s4v __attribute__((ext_vector_type(4)));
typedef float f16v __attribute__((ext_vector_type(16)));
typedef float f4v __attribute__((ext_vector_type(4)));
typedef unsigned u4v __attribute__((ext_vector_type(4)));
typedef unsigned u2v __attribute__((ext_vector_type(2)));

enum { I_XP = 0, I_XS, I_C, I_CNAK, I_CNAV, I_CGQK, I_CGQV, I_SC, I_SN, I_SM, I_CCTX, I_ADAW, I_ADAB, I_WIN, I_BGATE, I_WOUT, I_RPB, I_QKG, I_MLG,
       I_LNG, I_LNB, I_RW, I_WG, I_WU, I_WD, N_IN };

constexpr size_t O_YP = 0;
constexpr size_t O_YS = O_YP + (size_t)NP * D;
constexpr size_t O_NAK = O_YS + (size_t)NS * D;
constexpr size_t O_NAV = O_NAK + (size_t)BATCH * DEPTH * SEQ * NAH * HD;
constexpr size_t O_GQK = O_NAV + (size_t)BATCH * DEPTH * SEQ * NAH * HD;
constexpr size_t O_GQV = O_GQK + (size_t)BATCH * DEPTH * SEQ * GQKV * HD;
constexpr size_t O_MC = O_GQV + (size_t)BATCH * DEPTH * SEQ * GQKV * HD;
constexpr size_t O_MN = O_MC + (size_t)BATCH * DEPTH * 2 * MLH * HD * HD;
constexpr size_t O_MM = O_MN + (size_t)BATCH * DEPTH * 2 * MLH * HD;
constexpr size_t O_END = O_MM + (size_t)BATCH * DEPTH * 2 * MLH;

constexpr size_t al256(size_t x) { return (x + 255) & ~(size_t)255; }
constexpr size_t WS_BAR = 0;
constexpr size_t WS_BAR_BYTES = 32768;
constexpr size_t WS_MODS = WS_BAR + WS_BAR_BYTES;
constexpr size_t WS_ROPE = al256(WS_MODS + (size_t)DEPTH * NCOND * 6 * D * 4);
constexpr size_t WS_CNAK = al256(WS_ROPE + 64 * 16 * 2 * 4);
constexpr size_t WS_CNAV = al256(WS_CNAK + (size_t)DEC_BATCH * DEPTH * PAST * NAH * HD * 2);
constexpr size_t WS_CGQK = al256(WS_CNAV + (size_t)DEC_BATCH * DEPTH * PAST * NAH * HD * 2);
constexpr size_t WS_CGQV = al256(WS_CGQK + (size_t)DEC_BATCH * DEPTH * PAST * GQKV * HD * 2);
constexpr size_t WS_XBUF = al256(WS_CGQV + (size_t)DEC_BATCH * DEPTH * PAST * GQKV * HD * 2);
constexpr size_t WS_HMOD = al256(WS_XBUF + (size_t)NT * D * 4);
constexpr size_t WS_GATES = al256(WS_HMOD + (size_t)NT * D * 2);
constexpr size_t WS_NAQ = al256(WS_GATES + (size_t)NT * 16 * 4);
constexpr size_t WS_NAK = al256(WS_NAQ + (size_t)NT * 384 * 2);
constexpr size_t WS_NAV = al256(WS_NAK + (size_t)NT * 384 * 2);
constexpr size_t WS_MLQ = al256(WS_NAV + (size_t)NT * 384 * 2);
constexpr size_t WS_MLK = al256(WS_MLQ + (size_t)NT * 256 * 2);
constexpr size_t WS_MLV = al256(WS_MLK + (size_t)NT * 256 * 2);
constexpr size_t WS_MLO = al256(WS_MLV + (size_t)NT * 256 * 2);
constexpr size_t WS_GQQ = al256(WS_MLO + (size_t)NT * 256 * 2);
constexpr size_t WS_GQK = al256(WS_GQQ + (size_t)NT * 384 * 2);
constexpr size_t WS_GQV = al256(WS_GQK + (size_t)NT * 128 * 2);
constexpr size_t WS_MIXED = al256(WS_GQV + (size_t)NT * 128 * 2);
constexpr size_t WS_U = al256(WS_MIXED + (size_t)NT * MIXW * 2);
constexpr size_t WS_X1 = al256(WS_U + (size_t)NT * D * 4);
constexpr size_t WS_H2 = al256(WS_X1 + (size_t)NT * D * 4);
constexpr size_t WS_AFF = al256(WS_H2 + (size_t)NT * D * 2);
constexpr size_t WS_IDX = al256(WS_AFF + (size_t)NT * 16 * 4);
constexpr size_t WS_GSEL = al256(WS_IDX + (size_t)NEXP * SLOTS * 4);
constexpr size_t WS_TOKSLOT = al256(WS_GSEL + (size_t)NEXP * SLOTS * 4);
constexpr size_t WS_HID = al256(WS_TOKSLOT + (size_t)NT * 16 * 4);
constexpr size_t WS_YE = al256(WS_HID + (size_t)NEXP * SLOTS * EH * 2);
constexpr int MLSUM_STRIDE = 4096 + 64 + 64;
constexpr int N_MLSUM = (BATCH * NCH_P + DEC_BATCH * NCH_S) * MLH * 2;
constexpr size_t WS_MLSUM = al256(WS_YE + (size_t)NEXP * SLOTS * D * 2);
constexpr int PART_STRIDE = 256 * 64 + 512;
constexpr int N_PART = DEC_BATCH * GQH * (DEC_SEQ / 256) * 2;
constexpr size_t WS_PART = al256(WS_MLSUM + (size_t)N_MLSUM * MLSUM_STRIDE * 4);
constexpr size_t WS_TOTAL = al256(WS_PART + (size_t)N_PART * PART_STRIDE * 4);

struct Params {
    const float* in[N_IN];
    float* out;
    char* ws;
    int ph0, ph1;
};

DEV float bf2f(bf16_t s) { unsigned u = ((unsigned)s) << 16; return __builtin_bit_cast(float, u); }
DEV bf16_t f2bf(float f) {
#ifdef EMU
    unsigned u = __builtin_bit_cast(unsigned, f); u += 0x7fffu + ((u >> 16) & 1u); return (bf16_t)(u >> 16);
#else
    return __builtin_bit_cast(bf16_t, (__bf16)f);
#endif
}
DEV unsigned pack2(float a, float b) {
#ifdef EMU
    return (unsigned)f2bf(a) | ((unsigned)f2bf(b) << 16);
#else
    typedef __bf16 b2 __attribute__((ext_vector_type(2))); b2 r; r[0] = (__bf16)a; r[1] = (__bf16)b; return __builtin_bit_cast(unsigned, r);
#endif
}
DEV float fexp(float x) {
#ifdef EMU
    return expf(x);
#else
    return __expf(x);
#endif
}
DEV float fexp2(float x) {
#ifdef EMU
    return exp2f(x);
#else
    return __builtin_amdgcn_exp2f(x);
#endif
}
DEV float frcp(float x) {
#ifdef EMU
    return 1.f / x;
#else
    return __builtin_amdgcn_rcpf(x);
#endif
}
DEV float sigmoidf_(float x) { return frcp(1.f + fexp(-x)); }
DEV float siluf_(float x) { return x * frcp(1.f + fexp(-x)); }
DEV float flog(float x) {
#ifdef EMU
    return logf(x);
#else
    return __logf(x);
#endif
}
DEV float frsqrt(float x) {
#ifdef EMU
    return 1.f / sqrtf(x);
#else
    return __builtin_amdgcn_rsqf(x);
#endif
}
DEV float logsigmoidf_(float x) { return fminf(x, 0.f) - flog(1.f + fexp(-fabsf(x))); }
DEV f16v mfma32(s8v a, s8v b, f16v c) {
#ifdef EMU
    return emu_mfma_32x32x16_bf16(a, b, c);
#else
    typedef __bf16 bf8 __attribute__((ext_vector_type(8)));
    return __builtin_amdgcn_mfma_f32_32x32x16_bf16(__builtin_bit_cast(bf8, a), __builtin_bit_cast(bf8, b), c, 0, 0, 0);
#endif
}
DEV s4v lds_tr16(const void* p) {
#ifdef EMU
    return emu_ds_read_tr16_b64(p);
#else
    typedef s4v __attribute__((address_space(3))) * lp;
    return __builtin_amdgcn_ds_read_tr16_b64_v4i16((lp)(p));
#endif
}
#ifdef EMU
DEV float wave_sum(float v) { for (int m = 32; m >= 1; m >>= 1) v += __shfl_xor(v, m); return v; }
#else
template <int CTRL, int RM> DEV float dpp_f(float v) { return __builtin_bit_cast(float, __builtin_amdgcn_update_dpp(0, __builtin_bit_cast(int, v), CTRL, RM, 0xF, false)); }
DEV float wave_sum(float v) {
    v += dpp_f<0xB1, 0xF>(v); v += dpp_f<0x4E, 0xF>(v); v += dpp_f<0x141, 0xF>(v); v += dpp_f<0x140, 0xF>(v);
    v += dpp_f<0x142, 0xA>(v); v += dpp_f<0x143, 0xC>(v);
    return __builtin_bit_cast(float, __builtin_amdgcn_readlane(__builtin_bit_cast(int, v), 63));
}
#endif
DEV float wave_max(float v) { for (int m = 32; m >= 1; m >>= 1) v = fmaxf(v, __shfl_xor(v, m)); return v; }
DEV f16v f16zero() { f16v z; for (int i = 0; i < 16; ++i) z[i] = 0.f; return z; }

#ifdef EMU
#define VGPR_PIN(x) do {} while (0)
#define SGPR_PIN(x) do {} while (0)
#define SCHED_FENCE() do {} while (0)
#define CFENCE() do {} while (0)
#else
#define SCHED_FENCE() __builtin_amdgcn_sched_barrier(0)
#define SGPR_PIN(x) asm volatile("" : "+s"(x))
#define VGPR_PIN(x) asm volatile("" : "+v"(x))
#define CFENCE() asm volatile("" ::: "memory")
#endif
#ifdef EMU
DEV int get_tid() { return (int)threadIdx.x; }
#else
DEV int get_tid() { int t = threadIdx.x; asm volatile("" : "+v"(t)); return t; }
#endif
struct UnitIter { int i, end, step; };
DEV UnitIter unit_iter(int NU) {
    const int G = (int)gridDim.x, b = (int)blockIdx.x;
    UnitIter it;
#ifndef XCD_MODE
#define XCD_MODE 0
#endif
    if ((G & 7) == 0 && (NU & 7) == 0) { const int W = G >> 3, x = XCD_MODE ? b / W : b & 7, j = XCD_MODE ? b % W : b >> 3, C = NU >> 3; it.i = x * C + j; it.end = (x + 1) * C; it.step = W; }
    else { it.i = b; it.end = NU; it.step = G; }
    return it;
}
DEV int tok_cond(int t) { return t < NP ? 0 : 1 + (t - NP) / DEC_SEQ; }

#ifndef EMU
#define XB_TMO      128
#define XB_XCNT(j)  (256  + 64 * (j))
#define XB_XSUB(j)  (1280 + 64 * (j))
#define XB_XGEN(j)  (2304 + 64 * (j))
#define XB_TOP      3328
#define XB_TOPGEN   3392
#define XCD_BAR_WORDS 3456
#define XB_SPIN_CAP (1u << 20)
#define LAS __attribute__((address_space(3)))
__device__ __forceinline__ unsigned xb_ld(unsigned* p)              { return __hip_atomic_load(p, __ATOMIC_RELAXED, __HIP_MEMORY_SCOPE_AGENT); }
__device__ __forceinline__ unsigned xb_add(unsigned* p, unsigned v) { return __hip_atomic_fetch_add(p, v, __ATOMIC_RELAXED, __HIP_MEMORY_SCOPE_AGENT); }
__device__ __forceinline__ unsigned xb_xcc_id() { return (unsigned)__builtin_amdgcn_s_getreg((3 << 11) | 20) & 0xFu; }
#define XB_SPIN(cond, bar) do { unsigned _sp = 0; while (cond) { __builtin_amdgcn_s_sleep(1); \
    if ((++_sp & 255u) == 0u) { if (xb_ld(&(bar)[XB_TMO])) break; if (_sp > XB_SPIN_CAP) { atomicAdd(&(bar)[XB_TMO], 1u); break; } } } } while (0)
struct XcdBarrier { unsigned* bar; unsigned x; volatile LAS unsigned* st; };
__device__ __forceinline__ XcdBarrier xcd_barrier_post(unsigned* bar, volatile LAS unsigned* st) {
    XcdBarrier b; b.bar = bar; b.x = xb_xcc_id(); b.st = st;
    if (threadIdx.x == 0) (void)xb_add(&bar[XB_XCNT(b.x)], 1u);
    return b;
}
__device__ __forceinline__ void xcd_barrier_complete(unsigned* bar, unsigned x, unsigned& nloc, unsigned& nx) {
    const unsigned G = gridDim.x * gridDim.y * gridDim.z;
    unsigned sum, cnt, mine, sp = 0u;
    for (;;) {
        sum = 0u; cnt = 0u; mine = 0u;
#pragma unroll
        for (unsigned j = 0; j < 16; ++j) { const unsigned c = xb_ld(&bar[XB_XCNT(j)]); sum += c; cnt += (c > 0u) ? 1u : 0u; mine = (j == x) ? c : mine; }
        if (sum == G) break;
        __builtin_amdgcn_s_sleep(1);
        if ((++sp & 255u) == 0u) { if (xb_ld(&bar[XB_TMO])) break; if (sp > XB_SPIN_CAP) { atomicAdd(&bar[XB_TMO], 1u); break; } }
    }
    nloc = mine > 0u ? mine : 1u; nx = cnt > 0u ? cnt : 1u;
}
__device__ __forceinline__ void xcd_barrier(const XcdBarrier& b) {
    asm volatile("s_waitcnt vmcnt(0)" ::: "memory");
    __syncthreads();
    if (threadIdx.x == 0) {
        unsigned* bar = b.bar;
        __builtin_amdgcn_s_waitcnt(0);
        unsigned nloc = b.st[0], nx = b.st[1];
        if (nloc == 0u) { xcd_barrier_complete(bar, b.x, nloc, nx); b.st[0] = nloc; b.st[1] = nx; }
        const unsigned old = xb_add(&bar[XB_XSUB(b.x)], 1u);
        const unsigned gen = old / nloc;
        if (old + 1u == (gen + 1u) * nloc) {
            __builtin_amdgcn_fence(__ATOMIC_RELEASE, "agent");
            asm volatile("s_waitcnt vmcnt(0)" ::: "memory");
            const unsigned og = xb_add(&bar[XB_TOP], 1u);
            const unsigned tg = og / nx;
            if (og + 1u == (tg + 1u) * nx) xb_add(&bar[XB_TOPGEN], 1u);
            else XB_SPIN(xb_ld(&bar[XB_TOPGEN]) == tg, bar);
            __builtin_amdgcn_fence(__ATOMIC_ACQUIRE, "agent");
            xb_add(&bar[XB_XGEN(b.x)], 1u);
            asm volatile("s_waitcnt vmcnt(0)" ::: "memory");
        } else {
            XB_SPIN(xb_ld(&bar[XB_XGEN(b.x)]) == gen, bar);
            __builtin_amdgcn_fence(__ATOMIC_ACQUIRE, "agent");
            asm volatile("s_waitcnt vmcnt(0)" ::: "memory");
        }
    }
    __syncthreads();
}
#endif
constexpr int QUEUE_WORD0 = 4096;

constexpr int LROW = 144;
constexpr int GEMM_AS = 256 * LROW;
constexpr int GEMM_BS = 64 * (256 * 2 + 64);
constexpr int SMEM_XB = 2 * GEMM_AS + 2 * GEMM_BS;
constexpr int SMEM_AUX = SMEM_XB + 64;
constexpr int SMEM_BYTES = SMEM_AUX + 2048;

#ifdef EMU
struct BufRsrc { const char* base; };
DEV BufRsrc make_rsrc(const void* p) { BufRsrc r; r.base = (const char*)p; return r; }
DEV float buf_load_f32(BufRsrc r, unsigned voff, unsigned soff) { return *(const float*)(r.base + voff + soff); }
DEV u4v buf_load_b128(BufRsrc r, unsigned voff, unsigned soff) { return *(const u4v*)(r.base + voff + soff); }
#else
typedef __amdgpu_buffer_rsrc_t BufRsrc;
DEV BufRsrc make_rsrc(const void* p) { return __builtin_amdgcn_make_buffer_rsrc((void*)p, 0, 0x7fffffff, 0x00020000); }
DEV float buf_load_f32(BufRsrc r, unsigned voff, unsigned soff) { return __builtin_bit_cast(float, __builtin_amdgcn_raw_buffer_load_b32(r, voff, soff, 0)); }
DEV u4v buf_load_b128(BufRsrc r, unsigned voff, unsigned soff) { return __builtin_amdgcn_raw_buffer_load_b128(r, voff, soff, 0); }
#endif
#ifdef EMU
#define WAVE_SYNC() do { (void)__shfl(0, 0); } while (0)
#else
#define WAVE_SYNC() asm volatile("s_waitcnt lgkmcnt(0)" ::: "memory")
#endif
DEV char* wave_stage_ptr(char* smem, int wave) { return smem + (wave < 4 ? GEMM_AS + wave * 9216 : 2 * GEMM_AS + GEMM_BS + (wave - 4) * 9216); }
DEV void stage64_write_bf16(char* stg, int tt, const f16v& v0, const f16v& v1, int l31, int h) {
    char* row = stg + (tt * 32 + l31) * LROW;
#pragma unroll
    for (int ft = 0; ft < 2; ++ft) {
        const f16v& v = ft ? v1 : v0;
#pragma unroll
        for (int g = 0; g < 4; ++g) { u2v pk; pk[0] = pack2(v[4 * g], v[4 * g + 1]); pk[1] = pack2(v[4 * g + 2], v[4 * g + 3]); *(u2v*)(row + (ft * 32 + 8 * g + 4 * h) * 2) = pk; }
    }
}
DEV void stage64_write4(char* stg, int row, int col, float a, float b, float c, float d) {
    u2v pk; pk[0] = pack2(a, b); pk[1] = pack2(c, d); *(u2v*)(stg + row * LROW + col * 2) = pk;
}
DEV void stage64_flush_bf16(const char* stg, bf16_t* dst0, size_t row_stride, int lane) {
    WAVE_SYNC();
#pragma unroll
    for (int i = 0; i < 8; ++i) { const int r = (lane >> 3) + 8 * i, c = lane & 7; const u4v v = *(const u4v*)(stg + r * LROW + c * 16); *(u4v*)(dst0 + (size_t)r * row_stride + c * 8) = v; }
    WAVE_SYNC();
}
template <int NTW, int VAR, class Epi>
DEV void gemm_tile(char* smem, BufRsrc ars, unsigned ao0, unsigned ao1, unsigned ao2, unsigned ao3,
                   BufRsrc brs, unsigned bvo, unsigned blds, unsigned ldb4, int K, Epi&& epi) {
    constexpr int BN = 64 * NTW, NLD = 2 * NTW, KSTEP = 64 / NLD, RSB = BN * 2 + 64;
    const int tid = get_tid(), lane = tid & 63, wave = tid >> 6, wm = wave & 3, wn = wave >> 2, h = lane >> 5, l31 = lane & 31;
    char* As = smem; char* Bs = smem + 2 * GEMM_AS;
    constexpr int BSZ = GEMM_BS;
    const int ar = tid >> 3, ac = tid & 7;
    u4v areg[2]; f4v b0[NLD], b1[NLD];
    if (VAR & 3) { for (int i = 0; i < 2; ++i) areg[i] = (u4v){1u, 2u, 3u, 4u}; for (int j = 0; j < NLD; ++j) { b0[j] = (f4v){1.f, 1.f, 1.f, 1.f}; b1[j] = (f4v){2.f, 2.f, 2.f, 2.f}; } }
    f16v acc[NTW][2];
#pragma unroll
    for (int i = 0; i < NTW; ++i) { acc[i][0] = f16zero(); acc[i][1] = f16zero(); }
    auto gloadA = [&](int k0, bool real, int half) {
        if (VAR & 2) return;
        const unsigned so = real ? k0 * 2 : 0u;
        areg[0] = buf_load_b128(ars, real ? (half ? ao2 : ao0) : 0u, so); areg[1] = buf_load_b128(ars, real ? (half ? ao3 : ao1) : 0u, so);
    };
    auto gloadB = [&](int k0, bool real, f4v (&br)[NLD]) {
        if (VAR & 1) return;
        const unsigned vo = real ? bvo : 0u; const int kk = real ? k0 : 0;
        unsigned so = (unsigned)kk * ldb4;
#pragma unroll
        for (int j = 0; j < NLD; ++j) { br[j] = __builtin_bit_cast(f4v, buf_load_b128(brs, vo, so)); so += KSTEP * ldb4; SGPR_PIN(so); }
    };
    auto gloadB1 = [&](int k0, bool real, f4v (&br)[NLD], int j) {
        if (VAR & 1) return;
        br[j] = __builtin_bit_cast(f4v, buf_load_b128(brs, real ? bvo : 0u, (unsigned)((real ? k0 : 0) + j * KSTEP) * ldb4));
    };
    auto lstoreA = [&](int buf, int half) {
        if (VAR & 16) return;
        char* ab = As + buf * GEMM_AS + (ar + half * 128) * LROW + ac * 16;
        *(u4v*)(ab) = areg[0]; *(u4v*)(ab + 64 * LROW) = areg[1];
    };
    auto lstoreB1 = [&](int buf, const f4v (&br)[NLD], int j) {
        if (VAR & 16) return;
        u2v v; v[0] = pack2(br[j][0], br[j][1]); v[1] = pack2(br[j][2], br[j][3]); *(u2v*)(Bs + buf * BSZ + blds + j * KSTEP * RSB) = v;
    };
    auto lstoreB = [&](int buf, const f4v (&br)[NLD]) {
        if (VAR & 16) return;
        char* bb = Bs + buf * BSZ + blds;
#pragma unroll
        for (int j = 0; j < NLD; ++j) { u2v v; v[0] = pack2(br[j][0], br[j][1]); v[1] = pack2(br[j][2], br[j][3]); *(u2v*)(bb + j * KSTEP * RSB) = v; }
    };
    const unsigned btr = (unsigned)(8 * h + ((lane & 15) >> 2)) * RSB + (unsigned)((((lane >> 4) & 1) * 16 + 4 * (lane & 3)) * 2) + (unsigned)(wn * NTW * 32) * 2;
    const unsigned atr = (unsigned)(wm * 64 + l31) * LROW + h * 16;
    auto rdw = [&](int buf, int s, int ft) -> s8v {
        if (VAR & 64) { s8v z; for (int q = 0; q < 8; ++q) z[q] = (short)(0x3f80 + ft); return z; }
        const char* bb = Bs + buf * BSZ + btr + s * 16 * RSB + ft * 64;
        const s4v lo = lds_tr16(bb), hi = lds_tr16(bb + 4 * RSB);
        s8v wf; wf[0] = lo[0]; wf[1] = lo[1]; wf[2] = lo[2]; wf[3] = lo[3]; wf[4] = hi[0]; wf[5] = hi[1]; wf[6] = hi[2]; wf[7] = hi[3];
        return wf;
    };
    auto compute2 = [&](int buf, int s0, auto&& hook) {
        if (VAR & 8) { for (int g = 0; g < 2 * NTW; ++g) hook(g); return; }
        const char* ab = As + buf * GEMM_AS + atr;
        s8v xa[2];
        if (VAR & 64) { for (int q = 0; q < 8; ++q) { xa[0][q] = 0x3f80; xa[1][q] = 0x3f80; } } else { xa[0] = *(const s8v*)(ab + s0 * 32); xa[1] = *(const s8v*)(ab + 32 * LROW + s0 * 32); }
        s8v wcur = rdw(buf, s0, 0);
#pragma unroll
        for (int g = 0; g < 2 * NTW; ++g) {
            const int ft = g % NTW;
            s8v wnext = wcur;
            if (g + 1 < 2 * NTW) wnext = rdw(buf, s0 + (g + 1) / NTW, (g + 1) % NTW);
            if (VAR & 4) { acc[ft][0][0] += __builtin_bit_cast(float, (int)wcur[0] | ((int)xa[0][1] << 16)); acc[ft][1][0] += __builtin_bit_cast(float, (int)wcur[1] | ((int)xa[1][1] << 16)); }
            else { acc[ft][0] = mfma32(wcur, xa[0], acc[ft][0]); acc[ft][1] = mfma32(wcur, xa[1], acc[ft][1]); }
            if (g == NTW - 1 && !(VAR & 64)) { xa[0] = *(const s8v*)(ab + (s0 + 1) * 32); xa[1] = *(const s8v*)(ab + 32 * LROW + (s0 + 1) * 32); }
            wcur = wnext;
            hook(g);
            SCHED_FENCE();
        }
    };
    auto nohook = [](int) {};
    const int nk = K / 64;
    if (NTW == 2) {
        u4v a0[4], a1[4];
        if (VAR & 3) { for (int i = 0; i < 4; ++i) { a0[i] = (u4v){1u, 2u, 3u, 4u}; a1[i] = (u4v){1u, 2u, 3u, 4u}; } }
        auto gA = [&](int k0, bool real, u4v (&ar4)[4]) {
            if (VAR & 2) return;
            const unsigned so = real ? k0 * 2 : 0u;
            ar4[0] = buf_load_b128(ars, real ? ao0 : 0u, so); ar4[1] = buf_load_b128(ars, real ? ao1 : 0u, so);
            ar4[2] = buf_load_b128(ars, real ? ao2 : 0u, so); ar4[3] = buf_load_b128(ars, real ? ao3 : 0u, so);
        };
        auto sA = [&](int buf, const u4v (&ar4)[4]) {
            if (VAR & 16) return;
            char* ab = As + buf * GEMM_AS + ar * LROW + ac * 16;
#pragma unroll
            for (int i = 0; i < 4; ++i) *(u4v*)(ab + i * 64 * LROW) = ar4[i];
        };
        auto gA1 = [&](int k0, bool real, u4v (&ar4)[4], int i) {
            if (VAR & 2) return;
            const unsigned ao = i == 0 ? ao0 : i == 1 ? ao1 : i == 2 ? ao2 : ao3;
            ar4[i] = buf_load_b128(ars, real ? ao : 0u, real ? k0 * 2 : 0u);
        };
        auto sA1 = [&](int buf, const u4v (&ar4)[4], int i) {
            if (VAR & 16) return;
            *(u4v*)(As + buf * GEMM_AS + (ar + i * 64) * LROW + ac * 16) = ar4[i];
        };
        gA(0, true, a0); gloadB(0, true, b0); gA(64, true, a1); gloadB(64, true, b1);
        sA(0, a0); lstoreB(0, b0);
        __syncthreads();
        for (int kt = 0; kt < nk; kt += 2) {
            const bool t2 = kt + 2 < nk;
            compute2(0, 0, [&](int g) { gA1((kt + 2) * 64, t2, a0, g); lstoreB1(1, b1, g); });
            compute2(0, 2, [&](int g) { gloadB1((kt + 2) * 64, t2, b0, g); sA1(1, a1, g); });
            __syncthreads();
            compute2(1, 0, [&](int g) { gA1((kt + 3) * 64, t2, a1, g); lstoreB1(0, b0, g); });
            compute2(1, 2, [&](int g) { gloadB1((kt + 3) * 64, t2, b1, g); sA1(0, a0, g); });
            __syncthreads();
        }
    } else {
    {
        u4v at0, at1;
        gloadA(0, true, 0);
        if (!(VAR & 2)) { at0 = buf_load_b128(ars, ao2, 0); at1 = buf_load_b128(ars, ao3, 0); } else { at0 = areg[0]; at1 = areg[1]; }
        gloadB(0, true, b0); gloadB(64, true, b1);
        lstoreA(0, 0);
        if (!(VAR & 16)) { char* ab = As + (ar + 128) * LROW + ac * 16; *(u4v*)(ab) = at0; *(u4v*)(ab + 64 * LROW) = at1; }
        lstoreB(0, b0);
    }
    __syncthreads();
    for (int kt = 0; kt < nk; kt += 2) {
        const bool t2 = kt + 2 < nk;
        gloadA((kt + 1) * 64, true, 0);
        compute2(0, 0, [&](int g) { if (g & 1) gloadB1((kt + 2) * 64, t2, b0, g >> 1); else lstoreB1(1, b1, g >> 1); });
        lstoreA(1, 0);
        gloadA((kt + 1) * 64, true, 1);
        compute2(0, 2, [&](int g) { if (g & 1) gloadB1((kt + 2) * 64, t2, b0, 4 + (g >> 1)); else lstoreB1(1, b1, 4 + (g >> 1)); });
        lstoreA(1, 1);
        __syncthreads();
        gloadA((kt + 2) * 64, t2, 0);
        compute2(1, 0, [&](int g) { if (g & 1) gloadB1((kt + 3) * 64, t2, b1, g >> 1); else lstoreB1(0, b0, g >> 1); });
        lstoreA(0, 0);
        gloadA((kt + 2) * 64, t2, 1);
        compute2(1, 2, [&](int g) { if (g & 1) gloadB1((kt + 3) * 64, t2, b1, 4 + (g >> 1)); else lstoreB1(0, b0, 4 + (g >> 1)); });
        lstoreA(0, 1);
        __syncthreads();
    }
    }
    if (VAR & 32) { float t = 0.f; for (int i = 0; i < NTW; ++i) t += acc[i][0][0] + acc[i][1][5]; if (t == 123.456f) *(float*)smem = t; }
    else epi(acc);
}

DEV void phase_ada(const Params& p, char* smem) {
    const int tid = get_tid();
    float* siluS = (float*)smem;
    float* red = (float*)(smem + NCOND * D * 4);
    for (int i = tid; i < NCOND * D; i += 512) {
        const int cnd = i / D, k = i % D;
        const float c = cnd == 0 ? p.in[I_CCTX][k] : p.in[I_C][(cnd - 1) * D + k];
        siluS[i] = c * frcp(1.f + fexp(-c));
    }
    __syncthreads();
    constexpr int CPL = 6 * D / 32, NCHUNK = DEPTH * CPL, KG = D / 16;
    float* mods = (float*)(p.ws + WS_MODS);
    const int col = tid & 31, kg = tid >> 5;
    for (int u = blockIdx.x; u < NCHUNK; u += gridDim.x) {
        const int l = u / CPL, c0 = (u % CPL) * 32;
        const float* W = p.in[I_ADAW] + (size_t)l * D * 6 * D + c0 + col;
        float acc[NCOND];
#pragma unroll
        for (int c = 0; c < NCOND; ++c) acc[c] = 0.f;
#pragma unroll 8
        for (int k = kg * KG; k < kg * KG + KG; ++k) {
            const float w = W[(size_t)k * 6 * D];
#pragma unroll
            for (int c = 0; c < NCOND; ++c) acc[c] += siluS[c * D + k] * w;
        }
#pragma unroll
        for (int c = 0; c < NCOND; ++c) red[(kg * NCOND + c) * 32 + col] = acc[c];
        __syncthreads();
        if (tid < 32 * NCOND) {
            const int c = tid >> 5, cc = tid & 31;
            float s = 0.f;
            for (int g = 0; g < 16; ++g) s += red[(g * NCOND + c) * 32 + cc];
            mods[((size_t)l * NCOND + c) * 6 * D + c0 + cc] = s + p.in[I_ADAB][(size_t)l * 6 * D + c0 + cc];
        }
        __syncthreads();
    }
    const int gtid = blockIdx.x * 512 + tid, gsz = gridDim.x * 512;
    float* rope = (float*)(p.ws + WS_ROPE);
    for (int i = gtid; i < 64 * 16; i += gsz) {
        const int pos = i >> 4, fi = i & 15;
        const float inv = fexp2(-(float)(2 * fi) * (13.287712379549449f / 32.f));
        const float ang = (float)pos * inv;
#ifdef EMU
        rope[2 * i] = cosf(ang); rope[2 * i + 1] = sinf(ang);
#else
        rope[2 * i] = __cosf(ang); rope[2 * i + 1] = __sinf(ang);
#endif
    }
    constexpr int NNA = DEC_BATCH * DEPTH * PAST * NAH * HD, NGQ = DEC_BATCH * DEPTH * PAST * GQKV * HD;
    bf16_t* cnak = (bf16_t*)(p.ws + WS_CNAK); bf16_t* cnav = (bf16_t*)(p.ws + WS_CNAV);
    bf16_t* cgqk = (bf16_t*)(p.ws + WS_CGQK); bf16_t* cgqv = (bf16_t*)(p.ws + WS_CGQV);
    for (int i = gtid; i < NNA; i += gsz) { cnak[i] = f2bf(p.in[I_CNAK][i]); cnav[i] = f2bf(p.in[I_CNAV][i]); }
    for (int i = gtid; i < NGQ; i += gsz) { cgqk[i] = f2bf(p.in[I_CGQK][i]); cgqv[i] = f2bf(p.in[I_CGQV][i]); }
}

constexpr int EPL = D / 64;
constexpr int W16ROW = 20;
template <int MODE>
DEV void phase_rows(const Params& p, char* smem, int l) {
    const int tid = get_tid(), lane = tid & 63, wave = tid >> 6;
    float* W16 = (float*)smem;
    const bool need_w = (MODE == 1) || (l < DEPTH);
    if (need_w) {
        for (int i = tid; i < D * 4; i += 512) {
            const int k = i >> 2, q = i & 3;
            const float* src = (MODE == 1) ? p.in[I_RW] + ((size_t)l * D + k) * 16 + q * 4 : p.in[I_WIN] + ((size_t)l * D + k) * PROJ_W + 2176 + q * 4;
            *(f4v*)(W16 + k * W16ROW + q * 4) = *(const f4v*)src;
        }
    }
    __syncthreads();
    const float* mods = (const float*)(p.ws + WS_MODS);
    auto load_row = [&](int t, float (&vr)[EPL], int& ms) {
        const float* rp = (MODE == 1) ? (const float*)(p.ws + WS_U) + (size_t)t * D
                        : (l == 0) ? (t < NP ? p.in[I_XP] + (size_t)t * D : p.in[I_XS] + (size_t)(t - NP) * D) : (const float*)(p.ws + WS_X1) + (size_t)t * D;
#pragma unroll
        for (int j = 0; j < EPL; ++j) vr[j] = rp[lane + 64 * j];
        if (MODE == 0 && l > 0) ms = lane < 16 ? ((const int*)(p.ws + WS_TOKSLOT))[(size_t)t * 16 + lane] : -1;
    };
    const int tstride = gridDim.x * 8;
    float vr[EPL]; int ms = -1;
    {
        const int t0 = blockIdx.x * 8 + wave;
        if (t0 < NT) load_row(t0, vr, ms);
    }
    for (int t = blockIdx.x * 8 + wave; t < NT; t += tstride) {
        const int cnd = tok_cond(t);
        float vn[EPL]; int msn = -1;
#pragma unroll
        for (int j = 0; j < EPL; ++j) vn[j] = 0.f;
        if (t + tstride < NT) load_row(t + tstride, vn, msn);
        float v[EPL];
        if (MODE == 0 && l > 0) {
            const float* g2 = mods + ((size_t)(l - 1) * NCOND + cnd) * 6 * D + 5 * D;
            float f[EPL], gv[EPL];
#pragma unroll
            for (int j = 0; j < EPL; ++j) { f[j] = 0.f; gv[j] = g2[lane + 64 * j]; }
            const int myslot = ms;
            unsigned vm = (unsigned)__ballot(myslot >= 0);
            while (vm) {
                const int e = __builtin_ctz(vm); vm &= vm - 1u;
                const int slot = __shfl(myslot, e);
                const bf16_t* yr = (const bf16_t*)(p.ws + WS_YE) + ((size_t)e * SLOTS + slot) * D;
#pragma unroll
                for (int j = 0; j < EPL; ++j) f[j] += bf2f(yr[lane + 64 * j]);
            }
#pragma unroll
            for (int j = 0; j < EPL; ++j) v[j] = ALPHA * vr[j] + gv[j] * f[j];
        } else {
#pragma unroll
            for (int j = 0; j < EPL; ++j) v[j] = vr[j];
        }
#pragma unroll
        for (int j = 0; j < EPL; ++j) vr[j] = vn[j];
        ms = msn;
        if (!(MODE == 0 && l == 0)) {
            const int li = (MODE == 0) ? (l - 1) * 2 + 1 : l * 2;
            const float* lg = p.in[I_LNG] + (size_t)li * D; const float* lb = p.in[I_LNB] + (size_t)li * D;
            float g[EPL], bb[EPL];
#pragma unroll
            for (int j = 0; j < EPL; ++j) { g[j] = lg[lane + 64 * j]; bb[j] = lb[lane + 64 * j]; }
            float s = 0.f;
#pragma unroll
            for (int j = 0; j < EPL; ++j) s += v[j];
            const float mu = wave_sum(s) * (1.f / D);
            float q = 0.f;
#pragma unroll
            for (int j = 0; j < EPL; ++j) { const float dlt = v[j] - mu; q += dlt * dlt; }
            const float rstd = frsqrt(wave_sum(q) * (1.f / D) + EPS);
            float* dst = (MODE == 1) ? (float*)(p.ws + WS_X1) + (size_t)t * D
                       : (l == DEPTH) ? (t < NP ? p.out + O_YP + (size_t)t * D : p.out + O_YS + (size_t)(t - NP) * D) : (float*)(p.ws + WS_XBUF) + (size_t)t * D;
#pragma unroll
            for (int j = 0; j < EPL; ++j) { v[j] = (v[j] - mu) * rstd * g[j] + bb[j]; dst[lane + 64 * j] = v[j]; }
        }
        if (MODE == 1 || l < DEPTH) {
            const float* sh = mods + ((size_t)l * NCOND + cnd) * 6 * D + (MODE == 1 ? 3 * D : 0); const float* sc = sh + D;
            bf16_t* hb = (bf16_t*)(p.ws + (MODE == 1 ? WS_H2 : WS_HMOD)) + (size_t)t * D;
            {
                float s1[EPL], s0[EPL];
#pragma unroll
                for (int j = 0; j < EPL; ++j) { s1[j] = sc[lane + 64 * j]; s0[j] = sh[lane + 64 * j]; }
#pragma unroll
                for (int j = 0; j < EPL; ++j) { v[j] = v[j] * (1.f + s1[j]) + s0[j]; hb[lane + 64 * j] = f2bf(v[j]); }
            }
            CFENCE();
            float a16[16];
#pragma unroll
            for (int e = 0; e < 16; ++e) a16[e] = 0.f;
#pragma unroll
            for (int j = 0; j < EPL; ++j) {
                const float hv = v[j];
                const float* wr = W16 + (lane + 64 * j) * W16ROW;
#pragma unroll
                for (int q = 0; q < 4; ++q) { const f4v w4 = *(const f4v*)(wr + 4 * q); a16[4 * q] += hv * w4[0]; a16[4 * q + 1] += hv * w4[1]; a16[4 * q + 2] += hv * w4[2]; a16[4 * q + 3] += hv * w4[3]; }
                if (j & 1) CFENCE();
            }
            float mine = -1e30f;
#pragma unroll
            for (int e = 0; e < 16; ++e) { const float sm = wave_sum(a16[e]); if (lane == e) mine = sm; }
            if (MODE == 0) {
                if (lane < 16) ((float*)(p.ws + WS_GATES))[(size_t)t * 16 + lane] = mine + p.in[I_BGATE][l * 16 + lane];
            } else {
                float mx = mine;
                for (int m = 8; m >= 1; m >>= 1) mx = fmaxf(mx, __shfl_xor(mx, m));
                const float ex = lane < 16 ? fexp(mine - mx) : 0.f;
                float sm = ex;
                for (int m = 8; m >= 1; m >>= 1) sm += __shfl_xor(sm, m);
                if (lane < 16) ((float*)(p.ws + WS_AFF))[(size_t)t * 16 + lane] = ex / sm;
            }
        }
    }
}

template <int NPL>
DEV void topk_wave(const Params& p, int tb, int cap, int sbase, int e, int lane) {
    const float* aff = (const float*)(p.ws + WS_AFF);
    int* idx = (int*)(p.ws + WS_IDX); float* gsel = (float*)(p.ws + WS_GSEL); int* tokslot = (int*)(p.ws + WS_TOKSLOT);
    unsigned bits[NPL];
#pragma unroll
    for (int i = 0; i < NPL; ++i) bits[i] = __builtin_bit_cast(unsigned, aff[(size_t)(tb + lane + 64 * i) * 16 + e]);
    unsigned T = 0u;
    for (int b = 30; b >= 0; --b) {
        const unsigned cand = T | (1u << b);
        int cnt = 0;
#pragma unroll
        for (int i = 0; i < NPL; ++i) cnt += __popcll(__ballot(bits[i] >= cand));
        if (cnt >= cap) T = cand;
    }
    int ngt = 0;
#pragma unroll
    for (int i = 0; i < NPL; ++i) ngt += __popcll(__ballot(bits[i] > T));
    int need_eq = cap - ngt, run = 0;
    const unsigned long long lt = (1ull << lane) - 1ull;
#pragma unroll
    for (int i = 0; i < NPL; ++i) {
        const bool eq = bits[i] == T;
        const unsigned long long meq = __ballot(eq);
        const int eqrank = __popcll(meq & lt);
        const bool sel = bits[i] > T || (eq && eqrank < need_eq);
        const unsigned long long ms = __ballot(sel);
        const int t = tb + lane + 64 * i;
        if (sel) { const int slot = sbase + run + __popcll(ms & lt); idx[e * SLOTS + slot] = t; gsel[e * SLOTS + slot] = __builtin_bit_cast(float, bits[i]); tokslot[(size_t)t * 16 + e] = slot; }
        else tokslot[(size_t)t * 16 + e] = -1;
        run += __popcll(ms);
        const int neq = __popcll(meq); need_eq -= neq < need_eq ? neq : need_eq;
    }
}
template <int NPW>
DEV void topk_quad(const Params& p, char* smem, bool valid, int tb, int cap, int sbase, int e, int grp, int wq, int lane) {
    const float* aff = (const float*)(p.ws + WS_AFF);
    int* idx = (int*)(p.ws + WS_IDX); float* gsel = (float*)(p.ws + WS_GSEL); int* tokslot = (int*)(p.ws + WS_TOKSLOT);
    int* cntS = (int*)smem + grp * 64;
    const int t0 = tb + wq * (NPW * 64);
    unsigned bits[NPW];
#pragma unroll
    for (int i = 0; i < NPW; ++i) bits[i] = valid ? __builtin_bit_cast(unsigned, aff[(size_t)(t0 + lane + 64 * i) * 16 + e]) : 0u;
    unsigned T = 0u;
    for (int b = 30; b >= 0; --b) {
        const unsigned cand = T | (1u << b);
        int cnt = 0;
#pragma unroll
        for (int i = 0; i < NPW; ++i) cnt += __popcll(__ballot(bits[i] >= cand));
        if (lane == 0) cntS[(b & 1) * 4 + wq] = cnt;
        __syncthreads();
        const int tot = cntS[(b & 1) * 4] + cntS[(b & 1) * 4 + 1] + cntS[(b & 1) * 4 + 2] + cntS[(b & 1) * 4 + 3];
        if (tot >= cap) T = cand;
    }
    int ngt = 0, neqw = 0;
#pragma unroll
    for (int i = 0; i < NPW; ++i) { ngt += __popcll(__ballot(bits[i] > T)); neqw += __popcll(__ballot(bits[i] == T)); }
    if (lane == 0) { cntS[16 + wq] = ngt; cntS[20 + wq] = neqw; }
    __syncthreads();
    int gt_tot = 0;
    for (int w = 0; w < 4; ++w) gt_tot += cntS[16 + w];
    int rem = cap - gt_tot, run = 0, need_eq = 0;
    for (int w = 0; w < 4; ++w) {
        const int take = cntS[20 + w] < rem ? cntS[20 + w] : rem;
        if (w < wq) run += cntS[16 + w] + take;
        if (w == wq) need_eq = take;
        rem -= take;
    }
    if (!valid) return;
    const unsigned long long lt = (1ull << lane) - 1ull;
#pragma unroll
    for (int i = 0; i < NPW; ++i) {
        const bool eq = bits[i] == T;
        const unsigned long long meq = __ballot(eq);
        const int eqrank = __popcll(meq & lt);
        const bool sel = bits[i] > T || (eq && eqrank < need_eq);
        const unsigned long long ms = __ballot(sel);
        const int t = t0 + lane + 64 * i;
        if (sel) { const int slot = sbase + run + __popcll(ms & lt); idx[e * SLOTS + slot] = t; gsel[e * SLOTS + slot] = __builtin_bit_cast(float, bits[i]); tokslot[(size_t)t * 16 + e] = slot; }
        else tokslot[(size_t)t * 16 + e] = -1;
        run += __popcll(ms);
        const int neq = __popcll(meq); need_eq -= neq < need_eq ? neq : need_eq;
    }
}
DEV void phase_topk(const Params& p, char* smem) {
    const int tid = get_tid(), lane = tid & 63, wave = tid >> 6;
    constexpr int US = DEC_BATCH * NEXP, UP = BATCH * NEXP, NSB = (US + 1) / 2;
    static_assert(DEC_SEQ % 256 == 0, "quarter split");
    for (int ub = blockIdx.x; ub < NSB; ub += gridDim.x) {
        const int u = 2 * ub + (wave >> 2);
        const bool valid = u < US;
        const int b = valid ? u / NEXP : 0, e = valid ? u % NEXP : 0;
        topk_quad<DEC_SEQ / 256>(p, smem, valid, NP + b * DEC_SEQ, CAP_S, BATCH * CAP_P + b * CAP_S, e, wave >> 2, wave & 3, lane);
        __syncthreads();
    }
    const int gw = (gridDim.x - 1 - blockIdx.x) + gridDim.x * wave, nw = gridDim.x * 8;
    for (int u = gw; u < UP; u += nw) { const int b = u / NEXP, e = u % NEXP; topk_wave<SEQ / 64>(p, b * SEQ, CAP_P, b * CAP_P, e, lane); }
}

DEV void store_head_f32(float* dst_f32, const f16v& v0, const f16v& v1, int h) {
#pragma unroll
    for (int ft = 0; ft < 2; ++ft) {
        const f16v& v = ft ? v1 : v0;
#pragma unroll
        for (int g = 0; g < 4; ++g) { f4v o; o[0] = v[4 * g]; o[1] = v[4 * g + 1]; o[2] = v[4 * g + 2]; o[3] = v[4 * g + 3]; *(f4v*)(dst_f32 + ft * 32 + 8 * g + 4 * h) = o; }
    }
}
template <int VAR>
DEV void phase_inproj(const Params& p, char* smem, int l) {
    constexpr int NJ = 22, NU = (NT / 256) * NJ;
    const int tid = get_tid(), lane = tid & 63, wave = tid >> 6, wm = wave & 3, wn = wave >> 2, h = lane >> 5, l31 = lane & 31;
    const bf16_t* hmod = (const bf16_t*)(p.ws + WS_HMOD);
    const float* rope = (const float*)(p.ws + WS_ROPE);
    constexpr int NMB = NT / 256, RPX = (NMB % 8 == 0) ? NMB / 8 : NMB;
    const UnitIter it = unit_iter(NU);
    for (int u = it.i; u < it.end; u += it.step) {
        const int mb = (u / (RPX * NJ)) * RPX + u % RPX, j = (u / RPX) % NJ;
        const int colbase = j < 17 ? 128 * j : 2192 + 128 * (j - 17);
        const unsigned ao = ((unsigned)(mb * 256 + (tid >> 3)) * D + (tid & 7) * 8) * 2;
        const unsigned bvo = (unsigned)(colbase + 4 * (tid & 31)) * 4 + (unsigned)(tid >> 5) * (PROJ_W * 4);
        const unsigned blds = (unsigned)(tid >> 5) * 320u + (unsigned)(tid & 31) * 8u;
        gemm_tile<2, VAR>(smem, make_rsrc(hmod), ao, ao + 128u * D, ao + 256u * D, ao + 384u * D, make_rsrc(p.in[I_WIN] + (size_t)l * D * PROJ_W), bvo, blds, PROJ_W * 4, D, [&](f16v (&acc)[2][2]) {
            int lane_e = lane; VGPR_PIN(lane_e); const int lane = lane_e, l31 = lane_e & 31, h = lane_e >> 5; (void)l31; (void)h;
            const int cb = colbase + wn * 64;
            char* stg = wave_stage_ptr(smem, wave);
            const int t0 = mb * 256 + wm * 64;
            const bool isP = t0 < NP;
            bf16_t* dstb; size_t dstride;
            int f32out = 0, fhead = 0, fheads = 0; size_t fbase = 0;
            int mode = 0;
            if (cb < 1152) {
                const int seg = cb / 384, head = (cb % 384) / 64;
                dstb = (bf16_t*)(p.ws + (seg == 0 ? WS_NAQ : seg == 1 ? WS_NAK : WS_NAV)) + (size_t)t0 * 384 + head * 64; dstride = 384;
                if (seg >= 1 && isP) { f32out = 1; fbase = seg == 1 ? O_NAK : O_NAV; fhead = head; fheads = NAH; }
            } else if (cb < 2176) {
                const int seg = (cb - 1152) / 256, head = ((cb - 1152) % 256) / 64;
                dstb = (bf16_t*)(p.ws + (seg == 0 ? WS_MLQ : seg == 1 ? WS_MLK : seg == 2 ? WS_MLV : WS_MLO)) + (size_t)t0 * 256 + head * 64; dstride = 256;
                mode = seg == 1 ? 1 : 0;
            } else {
                const int c2 = cb - 2192;
                if (c2 < 384) { dstb = (bf16_t*)(p.ws + WS_GQQ) + (size_t)t0 * 384 + (c2 / 64) * 64; dstride = 384; mode = 2; }
                else if (c2 < 512) { const int head = (c2 - 384) / 64; dstb = (bf16_t*)(p.ws + WS_GQK) + (size_t)t0 * 128 + head * 64; dstride = 128; mode = 3;
                                     if (isP) { f32out = 1; fbase = O_GQK; fhead = head; fheads = GQKV; } }
                else { const int head = (c2 - 512) / 64; dstb = (bf16_t*)(p.ws + WS_GQV) + (size_t)t0 * 128 + head * 64; dstride = 128;
                       if (isP) { f32out = 1; fbase = O_GQV; fhead = head; fheads = GQKV; } }
            }
#pragma unroll
            for (int tt = 0; tt < 2; ++tt) {
                const int t = t0 + tt * 32 + l31;
                f16v v0 = acc[0][tt], v1 = acc[1][tt];
                if (mode == 1) { v0 *= ATT_SCALE; v1 *= ATT_SCALE; }
                if (mode >= 2) {
                    float ss = 0.f;
#pragma unroll
                    for (int r = 0; r < 16; ++r) ss += v0[r] * v0[r] + v1[r] * v1[r];
                    ss += __shfl_xor(ss, 32);
                    const float rn = frsqrt(ss * (1.f / 64.f) + EPS);
                    const float* gq = p.in[I_QKG] + ((size_t)l * 2 + (mode == 2 ? 0 : 1)) * 64;
#pragma unroll
                    for (int r = 0; r < 16; ++r) {
                        const int d = (r & 3) + 8 * (r >> 2) + 4 * h;
                        v0[r] *= rn * gq[d]; v1[r] *= rn * gq[32 + d];
                    }
                }
                if (f32out) { const int bP = t / SEQ, sP = t % SEQ; store_head_f32(p.out + fbase + ((((size_t)bP * DEPTH + l) * SEQ + sP) * fheads + fhead) * 64, v0, v1, h); }
                if (mode >= 2 && !isP) {
                    const int pos = (t - NP) % DEC_SEQ, prow = pos / GRIDW, pcol = pos % GRIDW;
#pragma unroll
                    for (int rr = 0; rr < 8; ++rr) {
                        const int fi = (rr & 3) + 8 * ((rr >> 2) & 1) + 4 * h;
                        const float c0 = rope[(prow * 16 + fi) * 2], s0 = rope[(prow * 16 + fi) * 2 + 1];
                        const float c1 = rope[(pcol * 16 + fi) * 2], s1 = rope[(pcol * 16 + fi) * 2 + 1];
                        const float a_lo = v0[rr], a_hi = v0[rr + 8]; v0[rr] = a_lo * c0 - a_hi * s0; v0[rr + 8] = a_hi * c0 + a_lo * s0;
                        const float b_lo = v1[rr], b_hi = v1[rr + 8]; v1[rr] = b_lo * c1 - b_hi * s1; v1[rr + 8] = b_hi * c1 + b_lo * s1;
                    }
                }
                stage64_write_bf16(stg, tt, v0, v1, l31, h);
            }
            stage64_flush_bf16(stg, dstb, dstride, lane);
        });
    }
}

template <int VAR>
DEV void phase_outproj(const Params& p, char* smem, int l) {
    constexpr int NC = D / 128, NU = (NT / 256) * NC;
    const int tid = get_tid(), lane = tid & 63, wave = tid >> 6, wm = wave & 3, wn = wave >> 2, h = lane >> 5, l31 = lane & 31;
    const bf16_t* mixed = (const bf16_t*)(p.ws + WS_MIXED);
    const float* mods = (const float*)(p.ws + WS_MODS);
    float* U = (float*)(p.ws + WS_U);
    constexpr int NMB = NT / 256, RPX = (NMB % 8 == 0) ? NMB / 8 : NMB;
    const UnitIter it = unit_iter(NU);
    for (int u = it.i; u < it.end; u += it.step) {
        const int mb = (u / (RPX * NC)) * RPX + u % RPX, cbk = (u / RPX) % NC;
        const unsigned ao = ((unsigned)(mb * 256 + (tid >> 3)) * MIXW + (tid & 7) * 8) * 2;
        const unsigned bvo = (unsigned)(cbk * 128 + 4 * (tid & 31)) * 4 + (unsigned)(tid >> 5) * (D * 4);
        const unsigned blds = (unsigned)(tid >> 5) * 320u + (unsigned)(tid & 31) * 8u;
        gemm_tile<2, VAR>(smem, make_rsrc(mixed), ao, ao + 128u * MIXW, ao + 256u * MIXW, ao + 384u * MIXW, make_rsrc(p.in[I_WOUT] + (size_t)l * MIXW * D), bvo, blds, D * 4, MIXW, [&](f16v (&acc)[2][2]) {
            int lane_e = lane; VGPR_PIN(lane_e); const int lane = lane_e, l31 = lane_e & 31, h = lane_e >> 5; (void)l31; (void)h;
            char* stg = wave_stage_ptr(smem, wave);
            const int t0 = mb * 256 + wm * 64;
            const float* g1 = mods + ((size_t)l * NCOND + tok_cond(t0)) * 6 * D + 2 * D;
#pragma unroll
            for (int ft = 0; ft < 2; ++ft) {
#pragma unroll
                for (int tt = 0; tt < 2; ++tt)
#pragma unroll
                    for (int g = 0; g < 4; ++g) { f4v o; o[0] = acc[ft][tt][4 * g]; o[1] = acc[ft][tt][4 * g + 1]; o[2] = acc[ft][tt][4 * g + 2]; o[3] = acc[ft][tt][4 * g + 3];
                        *(f4v*)(stg + (tt * 32 + l31) * LROW + (8 * g + 4 * h) * 4) = o; }
                WAVE_SYNC();
                const int f0 = cbk * 128 + wn * 64 + ft * 32 + (lane & 7) * 4;
                const f4v gv = *(const f4v*)(g1 + f0);
#pragma unroll
                for (int i = 0; i < 8; ++i) {
                    const int r = (lane >> 3) + 8 * i, t = t0 + r;
                    const f4v a = *(const f4v*)(stg + r * LROW + (lane & 7) * 16);
                    const float* xr = (l == 0) ? (t < NP ? p.in[I_XP] + (size_t)t * D : p.in[I_XS] + (size_t)(t - NP) * D) : (const float*)(p.ws + WS_XBUF) + (size_t)t * D;
                    const f4v xv = *(const f4v*)(xr + f0);
                    f4v o;
#pragma unroll
                    for (int q = 0; q < 4; ++q) o[q] = ALPHA * xv[q] + gv[q] * a[q];
                    *(f4v*)(U + (size_t)t * D + f0) = o;
                }
                WAVE_SYNC();
            }
        });
    }
}

template <int VAR>
DEV void phase_gateup(const Params& p, char* smem, int l) {
    constexpr int NRB = SLOTS / 256, NCB = EH / 128, NU = NEXP * NCB * NRB;
    const int tid = get_tid(), lane = tid & 63, wave = tid >> 6, wm = wave & 3, wn = wave >> 2, h = lane >> 5, l31 = lane & 31;
    const bf16_t* h2 = (const bf16_t*)(p.ws + WS_H2);
    const int* idx = (const int*)(p.ws + WS_IDX);
    bf16_t* hid = (bf16_t*)(p.ws + WS_HID);
    constexpr int TPC = NU / 8;
#ifdef GU_FORCE_HALF
    constexpr int HT = GU_FORCE_HALF;
#else
    constexpr int HT = (NU % 8 == 0 && TPC % 32 == 16) ? 16 : 0;
#endif
    constexpr int UPC = TPC + HT;
    const bool chunked = (gridDim.x & 7) == 0 && (NU & 7) == 0;
    const UnitIter it = unit_iter(chunked ? 8 * UPC : NU);
    for (int uu = it.i; uu < it.end; uu += it.step) {
        int u = uu, half = -1;
        if (chunked) { const int x = uu / UPC, v = uu % UPC; if (v < TPC - HT) u = x * TPC + v; else { const int hv = v - (TPC - HT); u = x * TPC + (TPC - HT) + (hv >> 1); half = hv & 1; } }
        const int rb = u % NRB, cbk = (u / NRB) % NCB, e = u / (NRB * NCB);
        const int* ip = idx + e * SLOTS + rb * 256 + (tid >> 3);
        const unsigned a0 = ((unsigned)ip[0] * D + (tid & 7) * 8) * 2, a1 = ((unsigned)ip[64] * D + (tid & 7) * 8) * 2;
        const unsigned a2 = ((unsigned)ip[128] * D + (tid & 7) * 8) * 2, a3 = ((unsigned)ip[192] * D + (tid & 7) * 8) * 2;
#ifdef EMU
        const int bw = tid >> 6;
#else
        const int bw = __builtin_amdgcn_readfirstlane(tid >> 6);
#endif
        const int is_up = bw & 1;
        const float* wmat = (is_up ? p.in[I_WU] : p.in[I_WG]) + ((size_t)l * NEXP + e) * D * EH;
        if (half < 0) {
        const int bkr = 2 * (bw >> 1) + ((tid >> 5) & 1), hc = 4 * (tid & 31);
        const int ncol = (hc >> 6) * 128 + (2 * ((hc >> 5) & 1) + is_up) * 32 + (hc & 31);
        const unsigned bvo = (unsigned)(cbk * 128 + hc) * 4 + (unsigned)bkr * (EH * 4);
        const unsigned blds = (unsigned)bkr * 576u + (unsigned)ncol * 2u;
        gemm_tile<4, VAR>(smem, make_rsrc(h2), a0, a1, a2, a3, make_rsrc(wmat), bvo, blds, EH * 4, D, [&](f16v (&acc)[4][2]) {
            int lane_e = lane; VGPR_PIN(lane_e); const int lane = lane_e, l31 = lane_e & 31, h = lane_e >> 5; (void)l31; (void)h;
            char* stg = wave_stage_ptr(smem, wave);
#pragma unroll
            for (int tt = 0; tt < 2; ++tt)
#pragma unroll
                for (int pr = 0; pr < 2; ++pr)
#pragma unroll
                    for (int g = 0; g < 4; ++g) {
                        float o[4];
#pragma unroll
                        for (int q = 0; q < 4; ++q) o[q] = siluf_(acc[2 * pr][tt][4 * g + q]) * acc[2 * pr + 1][tt][4 * g + q];
                        stage64_write4(stg, tt * 32 + l31, pr * 32 + 8 * g + 4 * h, o[0], o[1], o[2], o[3]);
                    }
            stage64_flush_bf16(stg, hid + ((size_t)e * SLOTS + rb * 256 + wm * 64) * EH + cbk * 128 + wn * 64, EH, lane);
        });
        } else {
        const int bkr = 4 * (bw >> 1) + ((tid >> 4) & 3), hc = 4 * (tid & 15);
        const int ncol = (hc >> 5) * 64 + is_up * 32 + (hc & 31);
        const unsigned bvo = (unsigned)(cbk * 128 + half * 64 + hc) * 4 + (unsigned)bkr * (EH * 4);
        const unsigned blds = (unsigned)bkr * 320u + (unsigned)ncol * 2u;
        gemm_tile<2, VAR>(smem, make_rsrc(h2), a0, a1, a2, a3, make_rsrc(wmat), bvo, blds, EH * 4, D, [&](f16v (&acc)[2][2]) {
            int lane_e = lane; VGPR_PIN(lane_e); const int lane = lane_e, l31 = lane_e & 31, h = lane_e >> 5; (void)l31; (void)h;
            char* stg = wave_stage_ptr(smem, wave);
#pragma unroll
            for (int tt = 0; tt < 2; ++tt)
#pragma unroll
                for (int g = 0; g < 4; ++g) {
                    float o[4];
#pragma unroll
                    for (int q = 0; q < 4; ++q) o[q] = siluf_(acc[0][tt][4 * g + q]) * acc[1][tt][4 * g + q];
                    stage64_write4(stg, tt * 32 + l31, 8 * g + 4 * h, o[0], o[1], o[2], o[3]);
                }
            WAVE_SYNC();
            bf16_t* dst0 = hid + ((size_t)e * SLOTS + rb * 256 + wm * 64) * EH + cbk * 128 + half * 64 + wn * 32;
#pragma unroll
            for (int i = 0; i < 4; ++i) { const int r = (lane >> 2) + 16 * i, c = lane & 3; const u4v v = *(const u4v*)(stg + r * LROW + c * 16); *(u4v*)(dst0 + (size_t)r * EH + c * 8) = v; }
            WAVE_SYNC();
        });
        }
    }
}

template <int VAR>
DEV void phase_down(const Params& p, char* smem, int l) {
    constexpr int NRB = SLOTS / 256, NCB = D / 256, NU = NEXP * NCB * NRB;
    const int tid = get_tid(), lane = tid & 63, wave = tid >> 6, wm = wave & 3, wn = wave >> 2, h = lane >> 5, l31 = lane & 31;
    const bf16_t* hid = (const bf16_t*)(p.ws + WS_HID);
    const float* gsel = (const float*)(p.ws + WS_GSEL);
    bf16_t* ye = (bf16_t*)(p.ws + WS_YE);
    const UnitIter it = unit_iter(NU);
    for (int u = it.i; u < it.end; u += it.step) {
        const int rb = u % NRB, cbk = (u / NRB) % NCB, e = u / (NRB * NCB);
        const unsigned ao = ((unsigned)(rb * 256 + (tid >> 3)) * EH + (tid & 7) * 8) * 2;
        const unsigned bvo = (unsigned)(cbk * 256 + 4 * (tid & 63)) * 4 + (unsigned)(tid >> 6) * (D * 4);
        const unsigned blds = (unsigned)(tid >> 6) * 576u + (unsigned)(tid & 63) * 8u;
        gemm_tile<4, VAR>(smem, make_rsrc(hid + (size_t)e * SLOTS * EH), ao, ao + 128u * EH, ao + 256u * EH, ao + 384u * EH, make_rsrc(p.in[I_WD] + ((size_t)l * NEXP + e) * EH * D), bvo, blds, D * 4, EH, [&](f16v (&acc)[4][2]) {
            int lane_e = lane; VGPR_PIN(lane_e); const int lane = lane_e, l31 = lane_e & 31, h = lane_e >> 5; (void)l31; (void)h;
            char* stg = wave_stage_ptr(smem, wave);
            const float gs0 = gsel[e * SLOTS + rb * 256 + wm * 64 + l31], gs1 = gsel[e * SLOTS + rb * 256 + wm * 64 + 32 + l31];
#pragma unroll
            for (int hb = 0; hb < 2; ++hb) {
#pragma unroll
                for (int tt = 0; tt < 2; ++tt) {
                    const float gs = tt ? gs1 : gs0;
#pragma unroll
                    for (int f2 = 0; f2 < 2; ++f2)
#pragma unroll
                        for (int g = 0; g < 4; ++g) { const f16v& a = acc[2 * hb + f2][tt]; stage64_write4(stg, tt * 32 + l31, f2 * 32 + 8 * g + 4 * h, a[4 * g] * gs, a[4 * g + 1] * gs, a[4 * g + 2] * gs, a[4 * g + 3] * gs); }
                }
                stage64_flush_bf16(stg, ye + ((size_t)e * SLOTS + rb * 256 + wm * 64) * D + cbk * 256 + wn * 128 + hb * 64, D, lane);
            }
        });
    }
}

struct AttnDesc {
    const bf16_t* q; int qstride;
    int ntiles, n0;
    const bf16_t *k0, *v0; int stride0;
    const bf16_t *k1, *v1; int stride1;
    int na;
    int r0, rlo;
    const float* rpb;
    bf16_t* out; int ostride;
    float* part;
};
constexpr int ATT_TILE = 64 * LROW;
DEV int na_row_start(int r) { int s = r - KR / 2; s = s < 0 ? 0 : s; return s > ROWS - KR ? ROWS - KR : s; }
DEV void attn_unit(char* smem, const AttnDesc& d) {
    const int tid = get_tid(), lane = tid & 63, wave = tid >> 6, h = lane >> 5, l31 = lane & 31;
    char* Ks = smem; char* Vs = smem + 2 * ATT_TILE; float* rpbS = (float*)(smem + 4 * ATT_TILE);
    if (d.na) { for (int i = tid; i < 15 * 31; i += 512) rpbS[i] = d.rpb[i] * 1.4426950408889634f; }
    const bf16_t* qp = d.q + (size_t)(wave * 32 + l31) * d.qstride + h * 8;
    s8v qf[4];
#pragma unroll
    for (int s = 0; s < 4; ++s) qf[s] = *(const s8v*)(qp + 16 * s);
    float m_run = -1e30f, l_run = 0.f;
    f16v o[2]; o[0] = f16zero(); o[1] = f16zero();
    const int srow = tid >> 3, sch = tid & 7;
    u4v kreg, vreg;
    auto gload = [&](int t) {
        const bf16_t *kp, *vp;
        if (t < d.n0) { const size_t off = (size_t)(t * 64 + srow) * d.stride0 + sch * 8; kp = d.k0 + off; vp = d.v0 + off; }
        else { const size_t off = (size_t)((t - d.n0) * 64 + srow) * d.stride1 + sch * 8; kp = d.k1 + off; vp = d.v1 + off; }
        kreg = *(const u4v*)kp; vreg = *(const u4v*)vp;
    };
    auto lstore = [&](int buf) { *(u4v*)(Ks + buf * ATT_TILE + srow * LROW + sch * 16) = kreg; *(u4v*)(Vs + buf * ATT_TILE + srow * LROW + sch * 16) = vreg; };
    const int qr = d.r0 + (wave >> 1), qw = (wave & 1) * 32 + l31;
    const int rs = na_row_start(qr);
    int cs = qw - KC / 2; cs = cs < 0 ? 0 : (cs > GRIDW - KC ? GRIDW - KC : cs);
    gload(0); lstore(0);
    __syncthreads();
    for (int t = 0; t < d.ntiles; ++t) {
        const int buf = t & 1;
        if (t + 1 < d.ntiles) gload(t + 1);
        const bool local = d.na && t >= d.n0;
        const int kr = d.rlo + (t - d.n0);
        const bool active = !local || (kr >= rs && kr < rs + KR);
        if (active) {
            const char* kb = Ks + buf * ATT_TILE + l31 * LROW + h * 16;
            f16v sa[2];
#pragma unroll
            for (int kt = 0; kt < 2; ++kt) {
                sa[kt] = f16zero();
#pragma unroll
                for (int s = 0; s < 4; ++s) { const s8v kf = *(const s8v*)(kb + kt * 32 * LROW + s * 32); sa[kt] = mfma32(kf, qf[s], sa[kt]); }
            }
            constexpr float C2 = ATT_SCALE * 1.4426950408889634f;
            float mx = -1e30f;
            if (local) {
#pragma unroll
                for (int kt = 0; kt < 2; ++kt)
#pragma unroll
                    for (int r = 0; r < 16; ++r) {
                        const int kc = kt * 32 + (r & 3) + 8 * (r >> 2) + 4 * h;
                        const bool inw = kc >= cs && kc < cs + KC;
                        const int bi = (kr - qr + 7) * 31 + (kc - qw + 15);
                        const float v = inw ? sa[kt][r] * C2 + rpbS[inw ? bi : 0] : -1e30f;
                        sa[kt][r] = v; mx = fmaxf(mx, v);
                    }
            } else {
#pragma unroll
                for (int kt = 0; kt < 2; ++kt)
#pragma unroll
                    for (int r = 0; r < 16; ++r) mx = fmaxf(mx, sa[kt][r]);
                mx *= C2;
            }
            mx = fmaxf(mx, __shfl_xor(mx, 32));
            if (__ballot(mx > m_run) != 0ull) {
                const float m_new = fmaxf(m_run, mx);
                const float alpha = fexp2(m_run - m_new);
                l_run *= alpha; m_run = m_new;
                o[0] *= alpha; o[1] *= alpha;
            }
            float ps = 0.f;
            if (local) {
#pragma unroll
                for (int kt = 0; kt < 2; ++kt)
#pragma unroll
                    for (int r = 0; r < 16; ++r) { const float pv = fexp2(sa[kt][r] - m_run); sa[kt][r] = pv; ps += pv; }
            } else {
#pragma unroll
                for (int kt = 0; kt < 2; ++kt)
#pragma unroll
                    for (int r = 0; r < 16; ++r) { const float pv = fexp2(sa[kt][r] * C2 - m_run); sa[kt][r] = pv; ps += pv; }
            }
            l_run += ps;
            const char* vb = Vs + buf * ATT_TILE + (4 * h + ((lane & 15) >> 2)) * LROW + (((lane >> 4) & 1) * 16 + 4 * (lane & 3)) * 2;
#pragma unroll
            for (int ks = 0; ks < 4; ++ks) {
                const int kt = ks >> 1, rb = 8 * (ks & 1);
                u4v pk; pk[0] = pack2(sa[kt][rb], sa[kt][rb + 1]); pk[1] = pack2(sa[kt][rb + 2], sa[kt][rb + 3]);
                pk[2] = pack2(sa[kt][rb + 4], sa[kt][rb + 5]); pk[3] = pack2(sa[kt][rb + 6], sa[kt][rb + 7]);
                const s8v pf = __builtin_bit_cast(s8v, pk);
                const char* vk = vb + (kt * 32 + 16 * (ks & 1)) * LROW;
#pragma unroll
                for (int dt = 0; dt < 2; ++dt) {
                    const s4v lo = lds_tr16(vk + dt * 64), hi = lds_tr16(vk + 8 * LROW + dt * 64);
                    s8v vf; vf[0] = lo[0]; vf[1] = lo[1]; vf[2] = lo[2]; vf[3] = lo[3]; vf[4] = hi[0]; vf[5] = hi[1]; vf[6] = hi[2]; vf[7] = hi[3];
                    o[dt] = mfma32(vf, pf, o[dt]);
                }
            }
        }
        if (t + 1 < d.ntiles) lstore(buf ^ 1);
        __syncthreads();
    }
    const float l_tot = l_run + __shfl_xor(l_run, 32);
    const int qrow = wave * 32 + l31;
    if (d.part) {
        float* po = d.part + (size_t)qrow * 64;
#pragma unroll
        for (int dt = 0; dt < 2; ++dt)
#pragma unroll
            for (int g = 0; g < 4; ++g) { f4v v; v[0] = o[dt][4 * g]; v[1] = o[dt][4 * g + 1]; v[2] = o[dt][4 * g + 2]; v[3] = o[dt][4 * g + 3]; *(f4v*)(po + dt * 32 + 8 * g + 4 * h) = v; }
        if (h == 0) { d.part[256 * 64 + qrow] = m_run; d.part[256 * 64 + 256 + qrow] = l_tot; }
    } else {
        const float inv = 1.f / l_tot;
        bf16_t* po = d.out + (size_t)qrow * d.ostride;
#pragma unroll
        for (int dt = 0; dt < 2; ++dt)
#pragma unroll
            for (int g = 0; g < 4; ++g) {
                u2v pk; pk[0] = pack2(o[dt][4 * g] * inv, o[dt][4 * g + 1] * inv); pk[1] = pack2(o[dt][4 * g + 2] * inv, o[dt][4 * g + 3] * inv);
                *(u2v*)(po + dt * 32 + 8 * g + 4 * h) = pk;
            }
    }
}

DEV int ml_sidx(int grp, int b, int head, int c) { return grp == 0 ? ((b * MLH + head) * NCH_P + c) : BATCH * MLH * NCH_P + ((b * MLH + head) * NCH_S + c); }
DEV float lane_prefix_sum(float v, int lane) { for (int dlt = 1; dlt < 64; dlt <<= 1) { const float o = __shfl(v, lane - dlt); if (lane >= dlt) v += o; } return v; }
DEV float lane_prefix_max(float v, int lane) { for (int dlt = 1; dlt < 64; dlt <<= 1) { const float o = __shfl(v, lane - dlt); if (lane >= dlt) v = fmaxf(v, o); } return v; }

DEV void mlstm_summary_unit(const Params& p, char* smem, int grp, int b, int head, int c) {
    const int tid = get_tid(), lane = tid & 63, wave = tid >> 6, h = lane >> 5, l31 = lane & 31;
    char* KT = smem;
    char* VT = smem + 2 * ATT_TILE;
    float* wsS = (float*)(smem + 3 * ATT_TILE);
    float* scal = wsS + 128;
    const int tb = (grp == 0 ? b * SEQ : NP + b * DEC_SEQ) + c * 64;
    const float* gates = (const float*)(p.ws + WS_GATES);
    if (wave == 0) {
        const float* gr = gates + (size_t)(tb + lane) * 16;
        const float i_f = gr[head], lf_f = logsigmoidf_(gr[4 + head]), i_b = gr[8 + head], lf_b = logsigmoidf_(gr[12 + head]);
        const float pf = lane_prefix_sum(lf_f, lane), pb = lane_prefix_sum(lf_b, lane);
        const float tot_f = __shfl(pf, 63), tot_b = __shfl(pb, 63);
        const float g_f = (tot_f - pf) + i_f, g_b = (pb - lf_b) + i_b;
        const float G_f = wave_max(g_f), G_b = wave_max(g_b);
        wsS[lane] = fexp(g_f - G_f); wsS[64 + lane] = fexp(g_b - G_b);
        if (lane == 0) { scal[0] = tot_f; scal[1] = tot_b; scal[2] = G_f; scal[3] = G_b; }
    }
    __syncthreads();
    {
        const int tau = tid >> 3, ch = tid & 7;
        const u4v kv = *(const u4v*)((const bf16_t*)(p.ws + WS_MLK) + (size_t)(tb + tau) * 256 + head * 64 + ch * 8);
        const u4v vv = *(const u4v*)((const bf16_t*)(p.ws + WS_MLV) + (size_t)(tb + tau) * 256 + head * 64 + ch * 8);
        const float wf = wsS[tau], wb = wsS[64 + tau];
#pragma unroll
        for (int j = 0; j < 8; ++j) {
            const bf16_t kb = (bf16_t)(kv[j >> 1] >> (16 * (j & 1))), vb = (bf16_t)(vv[j >> 1] >> (16 * (j & 1)));
            const int dim = ch * 8 + j; const float kf = bf2f(kb);
            *(bf16_t*)(KT + dim * LROW + tau * 2) = f2bf(kf * wf);
            *(bf16_t*)(KT + ATT_TILE + dim * LROW + tau * 2) = f2bf(kf * wb);
            *(bf16_t*)(VT + dim * LROW + tau * 2) = vb;
        }
    }
    __syncthreads();
    float* sum = (float*)(p.ws + WS_MLSUM);
    const int sidx = ml_sidx(grp, b, head, c);
    {
        const int dir = wave >> 2, mi = (wave >> 1) & 1, ni = wave & 1;
        f16v acc = f16zero();
#pragma unroll
        for (int s = 0; s < 4; ++s) {
            const s8v af = *(const s8v*)(KT + dir * ATT_TILE + (mi * 32 + l31) * LROW + (16 * s + 8 * h) * 2);
            const s8v bf = *(const s8v*)(VT + (ni * 32 + l31) * LROW + (16 * s + 8 * h) * 2);
            acc = mfma32(af, bf, acc);
        }
        float* U = sum + (size_t)(sidx * 2 + dir) * MLSUM_STRIDE;
#pragma unroll
        for (int r = 0; r < 16; ++r) U[(mi * 32 + (r & 3) + 8 * (r >> 2) + 4 * h) * 64 + ni * 32 + l31] = acc[r];
    }
    if (tid < 128) {
        const int dir = tid >> 6, kd = tid & 63;
        float s = 0.f;
        for (int tau = 0; tau < 64; ++tau) s += bf2f(*(const bf16_t*)(KT + dir * ATT_TILE + kd * LROW + tau * 2));
        float* E = sum + (size_t)(sidx * 2 + dir) * MLSUM_STRIDE;
        E[4096 + kd] = s;
        if (kd == 0) { E[4160] = scal[dir]; E[4161] = scal[2 + dir]; }
    }
    __syncthreads();
}

DEV void mlstm_output_unit(const Params& p, char* smem, int l, int grp, int b, int head, int c) {
    const int tid = get_tid(), lane = tid & 63, wave = tid >> 6, h = lane >> 5, l31 = lane & 31;
    const int nc = grp ? NCH_S : NCH_P;
    char* Qs = smem;
    char* Ks = smem + 2 * ATT_TILE;
    char* VT = smem + 4 * ATT_TILE;
    char* CT = smem + 6 * ATT_TILE;
    char* QK = smem + 8 * ATT_TILE;
    float* hS = (float*)(smem + 10 * ATT_TILE);
    float* vec = hS + 2 * 64 * 68;
    float* aS = vec; float* MjS = vec + 128; float* bS = vec + 256; float* nS = vec + 384; float* denp = vec + 512; float* qnS = vec + 768; float* scal = vec + 896;
    const int tb = (grp == 0 ? b * SEQ : NP + b * DEC_SEQ) + c * 64;
    const float* sum = (const float*)(p.ws + WS_MLSUM);
    const size_t qoff = (size_t)(tb + (tid >> 3)) * 256 + head * 64 + (tid & 7) * 8;
    const u4v q_r = *(const u4v*)((const bf16_t*)(p.ws + WS_MLQ) + qoff);
    const u4v k_r = *(const u4v*)((const bf16_t*)(p.ws + WS_MLK) + qoff);
    const u4v v_r = *(const u4v*)((const bf16_t*)(p.ws + WS_MLV) + qoff);
    const u4v o_r = *(const u4v*)((const bf16_t*)(p.ws + WS_MLO) + qoff);
    float g_i = 0.f, g_f = 0.f;
    if (wave < 2) { const float* gr = (const float*)(p.ws + WS_GATES) + (size_t)(tb + (wave ? 63 - lane : lane)) * 16; g_i = gr[wave * 8 + head]; g_f = gr[wave * 8 + 4 + head]; }
#pragma unroll
    for (int dir = 0; dir < 2; ++dir) {
        float C[8], nst = 0.f, m;
        if (grp == 0) {
#pragma unroll
            for (int i = 0; i < 8; ++i) C[i] = 0.f;
            m = 0.f;
        } else {
            const size_t sb = (((size_t)b * DEPTH + l) * 2 + dir) * MLH + head;
#pragma unroll
            for (int i = 0; i < 8; ++i) C[i] = p.in[I_SC][sb * 4096 + tid + 512 * i];
            if (tid < 64) nst = p.in[I_SN][sb * 64 + tid];
            m = p.in[I_SM][sb];
        }
        const int nsteps = dir == 0 ? c : nc - 1 - c;
        const bool fin = (grp == 0) && (dir == 0 ? c == nc - 1 : c == 0);
        {
            float A = 0.f, G = -1e30f;
            if (lane < nsteps) { const float* E = sum + (size_t)(ml_sidx(grp, b, head, dir == 0 ? lane : nc - 1 - lane) * 2 + dir) * MLSUM_STRIDE; A = E[4160]; G = E[4161]; }
            const float P = lane_prefix_sum(A, lane);
            const float T = __shfl(P, 63);
            const float ev = lane < nsteps ? G + (T - P) : -1e30f;
            const float mc = fmaxf(m + T, wave_max(ev));
            const float coef = lane < nsteps ? fexp(ev - mc) : 0.f;
            const float coef0 = fexp(m + T - mc);
#pragma unroll
            for (int i = 0; i < 8; ++i) C[i] *= coef0;
            nst *= coef0;
#pragma unroll 4
            for (int st = 0; st < nsteps; ++st) {
                const float* E = sum + (size_t)(ml_sidx(grp, b, head, dir == 0 ? st : nc - 1 - st) * 2 + dir) * MLSUM_STRIDE;
                const float cf = __shfl(coef, st);
#pragma unroll
                for (int i = 0; i < 8; ++i) C[i] += cf * E[tid + 512 * i];
                if (tid < 64) nst += cf * E[4096 + tid];
            }
            m = mc;
        }
#pragma unroll
        for (int i = 0; i < 8; ++i) { const int e = tid + 512 * i; *(bf16_t*)(CT + dir * ATT_TILE + (e & 63) * LROW + (e >> 6) * 2) = f2bf(C[i]); }
        if (tid < 64) nS[dir * 64 + tid] = nst;
        if (tid == 0) scal[dir] = m;
        if (fin) {
            const float* E = sum + (size_t)(ml_sidx(grp, b, head, c) * 2 + dir) * MLSUM_STRIDE;
            const float A = E[4160], G = E[4161];
            const float m_new = fmaxf(A + m, G);
            const float sc = fexp(A + m - m_new), su = fexp(G - m_new);
            const size_t ob = (((size_t)b * DEPTH + l) * 2 + dir) * MLH + head;
#pragma unroll
            for (int i = 0; i < 8; ++i) p.out[O_MC + ob * 4096 + tid + 512 * i] = sc * C[i] + su * E[tid + 512 * i];
            if (tid < 64) p.out[O_MN + ob * 64 + tid] = sc * nst + su * E[4096 + tid];
            if (tid == 0) p.out[O_MM + ob] = m_new;
        }
    }
    {
        const int row = tid >> 3, ch = tid & 7;
#pragma unroll
        for (int dir = 0; dir < 2; ++dir) {
            const int pr = dir ? 63 - row : row;
            *(u4v*)(Qs + dir * ATT_TILE + pr * LROW + ch * 16) = q_r;
            *(u4v*)(Ks + dir * ATT_TILE + pr * LROW + ch * 16) = k_r;
#pragma unroll
            for (int j = 0; j < 8; ++j) *(bf16_t*)(VT + dir * ATT_TILE + (ch * 8 + j) * LROW + pr * 2) = (bf16_t)(v_r[j >> 1] >> (16 * (j & 1)));
        }
    }
    __syncthreads();
    if (wave < 2) {
        const int dir = wave;
        const float ig = g_i, lf = logsigmoidf_(g_f);
        const float bj = lane_prefix_sum(lf, lane);
        const float a = ig - bj;
        const float Pj = lane_prefix_max(a, lane);
        aS[dir * 64 + lane] = a; bS[dir * 64 + lane] = bj; MjS[dir * 64 + lane] = fmaxf(scal[dir], Pj);
    } else if (wave < 4) {
        const int dir = wave - 2;
        float s = 0.f;
        for (int k = 0; k < 64; ++k) s += bf2f(*(const bf16_t*)(Qs + dir * ATT_TILE + lane * LROW + k * 2)) * nS[dir * 64 + k];
        qnS[dir * 64 + lane] = s;
    }
    __syncthreads();
    const int dir = wave >> 2, rt = (wave >> 1) & 1, jt = wave & 1;
    const int j = jt * 32 + l31;
    const float Mj = MjS[dir * 64 + j];
    {
        f16v acc = f16zero();
#pragma unroll
        for (int s4 = 0; s4 < 4; ++s4) {
            const s8v af = *(const s8v*)(Ks + dir * ATT_TILE + (rt * 32 + l31) * LROW + (16 * s4 + 8 * h) * 2);
            const s8v bf = *(const s8v*)(Qs + dir * ATT_TILE + j * LROW + (16 * s4 + 8 * h) * 2);
            acc = mfma32(af, bf, acc);
        }
        float dsum = 0.f;
#pragma unroll
        for (int g = 0; g < 4; ++g) {
            float o[4];
#pragma unroll
            for (int q = 0; q < 4; ++q) {
                const int s = rt * 32 + 8 * g + 4 * h + q;
                const float w = s <= j ? fexp(aS[dir * 64 + s] - Mj) : 0.f;
                o[q] = acc[4 * g + q] * w; dsum += o[q];
            }
            u2v pk; pk[0] = pack2(o[0], o[1]); pk[1] = pack2(o[2], o[3]);
            *(u2v*)(QK + dir * ATT_TILE + j * LROW + (rt * 32 + 8 * g + 4 * h) * 2) = pk;
        }
        dsum += __shfl_xor(dsum, 32);
        if (h == 0) denp[(dir * 2 + rt) * 64 + j] = dsum;
    }
    __syncthreads();
    {
        const float mst = scal[dir];
        const float decay = fexp(mst - Mj);
        f16v acc = f16zero();
#pragma unroll
        for (int s4 = 0; s4 < 4; ++s4) {
            const s8v af = *(const s8v*)(CT + dir * ATT_TILE + (rt * 32 + l31) * LROW + (16 * s4 + 8 * h) * 2);
            const s8v bf = *(const s8v*)(Qs + dir * ATT_TILE + j * LROW + (16 * s4 + 8 * h) * 2);
            acc = mfma32(af, bf, acc);
        }
        acc *= decay;
#pragma unroll
        for (int s4 = 0; s4 < 4; ++s4) {
            const s8v af = *(const s8v*)(VT + dir * ATT_TILE + (rt * 32 + l31) * LROW + (16 * s4 + 8 * h) * 2);
            const s8v bf = *(const s8v*)(QK + dir * ATT_TILE + j * LROW + (16 * s4 + 8 * h) * 2);
            acc = mfma32(af, bf, acc);
        }
        const float den = decay * qnS[dir * 64 + j] + denp[(dir * 2) * 64 + j] + denp[(dir * 2 + 1) * 64 + j];
        const float dn = fmaxf(fabsf(den), fexp(-(bS[dir * 64 + j] + Mj)));
        const float inv = 1.f / dn;
#pragma unroll
        for (int g = 0; g < 4; ++g) { f4v o; o[0] = acc[4 * g] * inv; o[1] = acc[4 * g + 1] * inv; o[2] = acc[4 * g + 2] * inv; o[3] = acc[4 * g + 3] * inv;
            *(f4v*)(hS + (dir * 64 + j) * 68 + rt * 32 + 8 * g + 4 * h) = o; }
    }
    __syncthreads();
    {
        const int tau = tid >> 3, v8 = (tid & 7) * 8;
        float hv[8]; float s = 0.f;
#pragma unroll
        for (int q = 0; q < 8; ++q) { hv[q] = hS[tau * 68 + v8 + q] + hS[(64 + 63 - tau) * 68 + v8 + q]; s += hv[q]; }
        s += __shfl_xor(s, 1); s += __shfl_xor(s, 2); s += __shfl_xor(s, 4);
        const float mu = s * (1.f / 64.f);
        float qq = 0.f;
#pragma unroll
        for (int q = 0; q < 8; ++q) { const float dlt = hv[q] - mu; qq += dlt * dlt; }
        qq += __shfl_xor(qq, 1); qq += __shfl_xor(qq, 2); qq += __shfl_xor(qq, 4);
        const float rstd = frsqrt(qq * (1.f / 64.f) + EPS);
        const int t = tb + tau;
        const u4v ov = o_r;
        const float* ng = p.in[I_MLG] + (size_t)l * 256 + head * 64 + v8;
        float o[8];
#pragma unroll
        for (int q = 0; q < 8; ++q) { const float og = bf2f((bf16_t)(ov[q >> 1] >> (16 * (q & 1)))); o[q] = (hv[q] - mu) * rstd * ng[q] * sigmoidf_(og); }
        u4v pk; pk[0] = pack2(o[0], o[1]); pk[1] = pack2(o[2], o[3]); pk[2] = pack2(o[4], o[5]); pk[3] = pack2(o[6], o[7]);
        *(u4v*)((bf16_t*)(p.ws + WS_MIXED) + (size_t)t * MIXW + 384 + head * 64 + v8) = pk;
    }
    __syncthreads();
}

DEV int queue_next(const Params& p, char* smem, int qi) {
    int* slot = (int*)(smem + SMEM_XB + 32);
    __syncthreads();
    if (threadIdx.x == 0) {
#ifdef EMU
        unsigned* w = (unsigned*)(p.ws + WS_BAR) + QUEUE_WORD0 + 64 * qi; *slot = (int)(*w)++;
#else
        *slot = (int)__hip_atomic_fetch_add((unsigned*)(p.ws + WS_BAR) + QUEUE_WORD0 + 64 * qi, 1u, __ATOMIC_RELAXED, __HIP_MEMORY_SCOPE_AGENT);
#endif
    }
    __syncthreads();
    return *slot;
}
DEV void phase_attn(const Params& p, char* smem, int l, int qi) {
    constexpr int QB_S = DEC_SEQ / 256, QB_P = SEQ / 256;
    constexpr int U_SG = DEC_BATCH * GQH * QB_S * 2, U_SN = DEC_BATCH * NAH * QB_S, U_PN = BATCH * NAH * QB_P, U_PG = BATCH * GQH * QB_P;
    constexpr int U_MP = BATCH * MLH * NCH_P, U_MS = DEC_BATCH * MLH * NCH_S;
    constexpr int NU = U_SG + U_SN + U_PN + U_PG + U_MP + U_MS;
    const bf16_t* naq = (const bf16_t*)(p.ws + WS_NAQ); const bf16_t* nak = (const bf16_t*)(p.ws + WS_NAK); const bf16_t* nav = (const bf16_t*)(p.ws + WS_NAV);
    const bf16_t* gqq = (const bf16_t*)(p.ws + WS_GQQ); const bf16_t* gqk = (const bf16_t*)(p.ws + WS_GQK); const bf16_t* gqv = (const bf16_t*)(p.ws + WS_GQV);
    bf16_t* mixed = (bf16_t*)(p.ws + WS_MIXED);
    for (;;) {
        int u = queue_next(p, smem, qi);
        if (u >= NU) break;
#ifdef PROBE_ATT
        if (qi >= 8) { const int cls = u < U_SG ? 1 : u < U_SG + U_SN ? 2 : u < U_SG + U_SN + U_PN + U_PG ? 3 : 4; if (cls != PROBE_ATT) continue; }
#endif
        AttnDesc d; d.na = 0; d.r0 = 0; d.rlo = 0; d.rpb = nullptr; d.part = nullptr; d.out = nullptr; d.ostride = MIXW; d.n0 = 0; d.k0 = d.v0 = nullptr; d.stride0 = 0;
        if (u < U_SG) {
            const int half = u & 1, qb = (u >> 1) % QB_S, qh = (u / (2 * QB_S)) % GQH, b = u / (2 * QB_S * GQH);
            const int kvh = qh / (GQH / GQKV);
            constexpr int NCT = PAST / 64, TT = NCT + DEC_SEQ / 64, H0 = TT / 2;
            const size_t tq = (size_t)NP + (size_t)b * DEC_SEQ + qb * 256;
            d.q = gqq + tq * 384 + qh * 64; d.qstride = 384;
            const bf16_t* lk = gqk + ((size_t)NP + (size_t)b * DEC_SEQ) * 128 + kvh * 64; const bf16_t* lv = gqv + ((size_t)NP + (size_t)b * DEC_SEQ) * 128 + kvh * 64;
            if (half == 0) {
                d.n0 = NCT; d.ntiles = H0; d.stride0 = 128;
                const size_t co = (((size_t)b * DEPTH + l) * PAST) * 128 + kvh * 64;
                d.k0 = (const bf16_t*)(p.ws + WS_CGQK) + co; d.v0 = (const bf16_t*)(p.ws + WS_CGQV) + co;
                d.k1 = lk; d.v1 = lv; d.stride1 = 128;
            } else {
                d.n0 = 0; d.ntiles = TT - H0; d.stride1 = 128;
                d.k1 = lk + (size_t)(H0 - NCT) * 64 * 128; d.v1 = lv + (size_t)(H0 - NCT) * 64 * 128;
            }
            d.part = (float*)(p.ws + WS_PART) + (size_t)u * PART_STRIDE;
        } else if (u < U_SG + U_SN) {
            const int uu = u - U_SG; const int qb = uu % QB_S, hd = (uu / QB_S) % NAH, b = uu / (QB_S * NAH);
            const size_t t0 = (size_t)NP + (size_t)b * DEC_SEQ;
            d.q = naq + (t0 + qb * 256) * 384 + hd * 64; d.qstride = 384;
            d.na = 1; d.r0 = qb * 4; d.rlo = na_row_start(d.r0);
            const int rhi = na_row_start(d.r0 + 3) + KR;
            d.n0 = PAST / 64; d.ntiles = d.n0 + (rhi - d.rlo); d.stride0 = 384; d.stride1 = 384;
            const size_t co = (((size_t)b * DEPTH + l) * PAST) * 384 + hd * 64;
            d.k0 = (const bf16_t*)(p.ws + WS_CNAK) + co; d.v0 = (const bf16_t*)(p.ws + WS_CNAV) + co;
            d.k1 = nak + (t0 + (size_t)d.rlo * 64) * 384 + hd * 64; d.v1 = nav + (t0 + (size_t)d.rlo * 64) * 384 + hd * 64;
            d.rpb = p.in[I_RPB] + ((size_t)l * NAH + hd) * 15 * 31;
            d.out = mixed + (t0 + qb * 256) * MIXW + hd * 64;
        } else if (u < U_SG + U_SN + U_PN) {
            const int uu = u - U_SG - U_SN; const int qb = uu % QB_P, hd = (uu / QB_P) % NAH, b = uu / (QB_P * NAH);
            const size_t t0 = (size_t)b * SEQ;
            d.q = naq + (t0 + qb * 256) * 384 + hd * 64; d.qstride = 384;
            d.n0 = 0; d.ntiles = SEQ / 64; d.stride1 = 384; d.k1 = nak + t0 * 384 + hd * 64; d.v1 = nav + t0 * 384 + hd * 64;
            d.out = mixed + (t0 + qb * 256) * MIXW + hd * 64;
        } else if (u < U_SG + U_SN + U_PN + U_PG) {
            const int uu = u - U_SG - U_SN - U_PN; const int qb = uu % QB_P, qh = (uu / QB_P) % GQH, b = uu / (QB_P * GQH);
            const int kvh = qh / (GQH / GQKV);
            const size_t t0 = (size_t)b * SEQ;
            d.q = gqq + (t0 + qb * 256) * 384 + qh * 64; d.qstride = 384;
            d.n0 = 0; d.ntiles = SEQ / 64; d.stride1 = 128; d.k1 = gqk + t0 * 128 + kvh * 64; d.v1 = gqv + t0 * 128 + kvh * 64;
            d.out = mixed + (t0 + qb * 256) * MIXW + 640 + qh * 64;
        } else {
            int uu = u - (U_SG + U_SN + U_PN + U_PG); const int grp = uu >= U_MP ? 1 : 0; if (grp) uu -= U_MP;
            const int nch = grp ? NCH_S : NCH_P;
            mlstm_summary_unit(p, smem, grp, uu / (nch * MLH), (uu / nch) % MLH, uu % nch);
        }
        if (u < U_SG + U_SN + U_PN + U_PG) attn_unit(smem, d);
    }
}

DEV void phase_mlout(const Params& p, char* smem, int l) {
    constexpr int QB_S = DEC_SEQ / 256;
    constexpr int U_MS = DEC_BATCH * MLH * NCH_S, U_MP = BATCH * MLH * NCH_P, U_CB = DEC_BATCH * GQH * QB_S;
    const int tid = get_tid(), lane = tid & 63, wave = tid >> 6;
    for (int tk = blockIdx.x + gridDim.x * wave; tk < U_CB * 4; tk += gridDim.x * 8) {
        const int uu = tk >> 2, sl = tk & 3;
        const int qb = uu % QB_S, qh = (uu / QB_S) % GQH, b = uu / (QB_S * GQH);
        const float* p0 = (const float*)(p.ws + WS_PART) + (size_t)(2 * uu) * PART_STRIDE; const float* p1 = p0 + PART_STRIDE;
        const int q = sl * 64 + (lane >> 1) + 32 * 0, d0 = (lane & 1) * 32;
#pragma unroll
        for (int hq = 0; hq < 2; ++hq) {
            const int qq = q + 32 * hq;
            const float m0 = p0[256 * 64 + qq], m1 = p1[256 * 64 + qq], l0 = p0[256 * 64 + 256 + qq], l1 = p1[256 * 64 + 256 + qq];
            const float m = fmaxf(m0, m1), w0 = fexp2(m0 - m), w1 = fexp2(m1 - m);
            const float inv = 1.f / (l0 * w0 + l1 * w1);
            bf16_t* dst = (bf16_t*)(p.ws + WS_MIXED) + ((size_t)NP + (size_t)b * DEC_SEQ + qb * 256 + qq) * MIXW + 640 + qh * 64 + d0;
#pragma unroll
            for (int i = 0; i < 8; ++i) {
                const f4v a = *(const f4v*)(p0 + (size_t)qq * 64 + d0 + 4 * i), bb = *(const f4v*)(p1 + (size_t)qq * 64 + d0 + 4 * i);
                u2v pk; pk[0] = pack2((a[0] * w0 + bb[0] * w1) * inv, (a[1] * w0 + bb[1] * w1) * inv); pk[1] = pack2((a[2] * w0 + bb[2] * w1) * inv, (a[3] * w0 + bb[3] * w1) * inv);
                *(u2v*)(dst + 4 * i) = pk;
            }
        }
    }
    for (int u = blockIdx.x; u < U_MS + U_MP; u += gridDim.x) {
        const int grp = u < U_MS ? 1 : 0; const int uu = grp ? u : u - U_MS; const int nch = grp ? NCH_S : NCH_P;
        mlstm_output_unit(p, smem, l, grp, uu / (nch * MLH), (uu / nch) % MLH, uu % nch);
    }
}

constexpr int N_PHASES = 2 + 9 * DEPTH;
#ifndef EMU
typedef const __attribute__((address_space(4))) Params* KParamsPtr;
DEV void load_params(Params& p) {
    KParamsPtr kp = (KParamsPtr)__builtin_amdgcn_kernarg_segment_ptr();
    asm volatile("" : "+s"(kp));
#pragma unroll
    for (int i = 0; i < N_IN; ++i) p.in[i] = kp->in[i];
    p.out = kp->out; p.ws = kp->ws; p.ph0 = kp->ph0; p.ph1 = kp->ph1;
}
#endif
#ifdef EMU
static char emu_smem[SMEM_BYTES + 64];
#endif
__global__ void __launch_bounds__(512, 2) mega_kernel(Params p_) {
    const int ph0 = p_.ph0, ph1 = p_.ph1;
#ifdef EMU
    char* smem = emu_smem;
#define GRID_SYNC() do {} while (0)
#else
    extern __shared__ __attribute__((aligned(16))) char smem[];
    if (threadIdx.x == 0) *(u4v*)(smem + SMEM_XB) = (u4v){0u, 0u, 0u, 0u};
    __syncthreads();
    (void)xcd_barrier_post((unsigned*)(p_.ws + WS_BAR), (volatile LAS unsigned*)(smem + SMEM_XB));
    const bool multi = (ph1 - ph0) > 1;
#define GRID_SYNC() do { if (multi) { KParamsPtr kpb = (KParamsPtr)__builtin_amdgcn_kernarg_segment_ptr(); asm volatile("" : "+s"(kpb)); \
        XcdBarrier xb; xb.bar = (unsigned*)(kpb->ws + WS_BAR); xb.x = xb_xcc_id(); xb.st = (volatile LAS unsigned*)(smem + SMEM_XB); xcd_barrier(xb); } } while (0)
#endif
    int ph = 0;
#ifndef KIND_MASK
#define KIND_MASK 0x3ff
#endif
#ifdef EMU
#define LOAD_PARAMS() const Params& p = p_
#else
#define LOAD_PARAMS() Params p; load_params(p)
#endif
#ifndef DOUBLE_MASK
#define DOUBLE_MASK 0
#endif
#define PH_KIND() (ph == 0 ? 0 : ph == 1 + 9 * DEPTH ? 1 : 1 + (ph - 1) % 9)
#define RUN_PHASE(body) do { if (((KIND_MASK >> PH_KIND()) & 1) && ph >= ph0 && ph < ph1) { \
    if (DOUBLE_MASK && ((DOUBLE_MASK >> PH_KIND()) & 1)) { { const int rep_ = 1; LOAD_PARAMS(); body; } GRID_SYNC(); } \
    { const int rep_ = 0; LOAD_PARAMS(); body; } if (ph + 1 < ph1) GRID_SYNC(); } ++ph; } while (0)
    RUN_PHASE(phase_ada(p, smem));
    for (int l = 0; l < DEPTH; ++l) {
        RUN_PHASE(phase_rows<0>(p, smem, l));
        RUN_PHASE(phase_inproj<0>(p, smem, l));
        RUN_PHASE(phase_attn(p, smem, l, l + DEPTH * rep_));
        RUN_PHASE(phase_mlout(p, smem, l));
        RUN_PHASE(phase_outproj<0>(p, smem, l));
        RUN_PHASE(phase_rows<1>(p, smem, l));
        RUN_PHASE(phase_topk(p, smem));
        RUN_PHASE(phase_gateup<0>(p, smem, l));
        RUN_PHASE(phase_down<0>(p, smem, l));
    }
    RUN_PHASE(phase_rows<0>(p, smem, DEPTH));
#ifdef PROBE_BARRIERS
    for (int i = 0; i < PROBE_BARRIERS; ++i) GRID_SYNC();
#endif
}

#if !defined(EMU) && defined(PROBE_KIND)
__global__ void __launch_bounds__(512, 2) probe_kernel(Params p) {
    extern __shared__ __attribute__((aligned(16))) char smem[];
    for (int r = 0; r < PROBE_REPS; ++r) {
#if PROBE_KIND == 8
        phase_gateup<PROBE_VAR>(p, smem, 1);
#elif PROBE_KIND == 9
        phase_down<PROBE_VAR>(p, smem, 1);
#elif PROBE_KIND == 2
        phase_inproj<PROBE_VAR>(p, smem, 1);
#elif PROBE_KIND == 5
        phase_outproj<PROBE_VAR>(p, smem, 1);
#elif PROBE_KIND == 0
        phase_ada(p, smem);
#elif PROBE_KIND == 1
        phase_rows<0>(p, smem, 1);
#elif PROBE_KIND == 6
        phase_rows<1>(p, smem, 1);
#elif PROBE_KIND == 7
        phase_topk(p, smem);
#elif PROBE_KIND == 3
        phase_attn(p, smem, 1, 8 + r);
#elif PROBE_KIND == 4
        phase_mlout(p, smem, 1);
#endif
        __syncthreads();
    }
}
#endif
#ifndef EMU
#ifndef MK_N_LAUNCHES
#define MK_N_LAUNCHES 1
#endif
extern "C" void kernel_launch(void* const* d_in, const int* in_sizes, int n_in, void* d_out, int out_size, void* d_ws, size_t ws_size, hipStream_t stream) {
    (void)in_sizes; (void)n_in; (void)out_size; (void)ws_size;
    static int grid = 0;
    if (!grid) {
        int dev = 0, cus = 0, per_cu = 0;
        (void)hipGetDevice(&dev);
        (void)hipDeviceGetAttribute(&cus, hipDeviceAttributeMultiprocessorCount, dev);
        (void)hipFuncSetAttribute((const void*)mega_kernel, hipFuncAttributeMaxDynamicSharedMemorySize, SMEM_BYTES);
        (void)hipOccupancyMaxActiveBlocksPerMultiprocessor(&per_cu, mega_kernel, 512, SMEM_BYTES);
        grid = cus * (per_cu < 1 ? per_cu : 1);
        if (grid <= 0) grid = cus;
    }
    (void)hipMemsetAsync((char*)d_ws + WS_BAR, 0, WS_BAR_BYTES, stream);
    Params p = {};
    for (int i = 0; i < N_IN; ++i) p.in[i] = (const float*)d_in[i];
    p.out = (float*)d_out; p.ws = (char*)d_ws;
#if MK_N_LAUNCHES == 1
    p.ph0 = 0; p.ph1 = N_PHASES;
    mega_kernel<<<dim3(grid), dim3(512), SMEM_BYTES, stream>>>(p);
#ifdef PROBE_KIND
    (void)hipFuncSetAttribute((const void*)probe_kernel, hipFuncAttributeMaxDynamicSharedMemorySize, SMEM_BYTES);
    probe_kernel<<<dim3(grid), dim3(512), SMEM_BYTES, stream>>>(p);
#endif
#else
    for (int ph = 0; ph < N_PHASES; ++ph) { p.ph0 = ph; p.ph1 = ph + 1; mega_kernel<<<dim3(grid), dim3(512), SMEM_BYTES, stream>>>(p); }
#endif
}
#endif
```

```cpp
#ifndef EMU
#include <hip/hip_runtime.h>
#define DEV __device__ __forceinline__
#else
#define DEV static inline __attribute__((always_inline))
#endif
#include <stdint.h>
#include <stddef.h>

#ifndef CFG_D
#define CFG_D 1024
#define CFG_BATCH 16
#define CFG_SEQ 256
#define CFG_DEC_BATCH 2
#define CFG_DEC_SEQ 2048
#define CFG_PAST 256
#define CFG_EH 2816
#endif
constexpr int D = CFG_D, BATCH = CFG_BATCH, SEQ = CFG_SEQ, DEC_BATCH = CFG_DEC_BATCH, DEC_SEQ = CFG_DEC_SEQ, PAST = CFG_PAST, EH = CFG_EH;
constexpr int DEPTH = 2, HD = 64, NAH = 6, MLH = 4, GQH = 6, GQKV = 2, NEXP = 16, GRIDW = 64;
constexpr int NP = BATCH * SEQ, NS = DEC_BATCH * DEC_SEQ, NT = NP + NS, NCOND = 1 + DEC_BATCH;
constexpr int PROJ_W = 2832, MIXW = 1024;
constexpr int CAP_P = SEQ / 8, CAP_S = DEC_SEQ / 8, SLOTS = BATCH * CAP_P + DEC_BATCH * CAP_S;
constexpr int ROWS = DEC_SEQ / GRIDW, KR = ROWS < 8 ? ROWS : 8, KC = 16;
constexpr int NCH_P = SEQ / 64, NCH_S = DEC_SEQ / 64;
constexpr float ALPHA = 1.41421356237309515f;
constexpr float ATT_SCALE = 0.125f;
constexpr float EPS = 1e-6f;
static_assert(SLOTS % 256 == 0 && NP % 256 == 0 && NS % 256 == 0 && SEQ % 256 == 0 && DEC_SEQ % 256 == 0, "tile divisibility");
static_assert(D % 256 == 0 && EH % 128 == 0 && PAST % 64 == 0, "tile divisibility");

typedef unsigned short bf16_t;
typedef short s8v __attribute__((ext_vector_type(8)));
typedef short s4v __attribute__((ext_vector_type(4)));
typedef float f16v __attribute__((ext_vector_type(16)));
typedef float f4v __attribute__((ext_vector_type(4)));
typedef unsigned u4v __attribute__((ext_vector_type(4)));
typedef unsigned u2v __attribute__((ext_vector_type(2)));

enum { I_XP = 0, I_XS, I_C, I_CNAK, I_CNAV, I_CGQK, I_CGQV, I_SC, I_SN, I_SM, I_CCTX, I_ADAW, I_ADAB, I_WIN, I_BGATE, I_WOUT, I_RPB, I_QKG, I_MLG,
       I_LNG, I_LNB, I_RW, I_WG, I_WU, I_WD, N_IN };

constexpr size_t O_YP = 0;
constexpr size_t O_YS = O_YP + (size_t)NP * D;
constexpr size_t O_NAK = O_YS + (size_t)NS * D;
constexpr size_t O_NAV = O_NAK + (size_t)BATCH * DEPTH * SEQ * NAH * HD;
constexpr size_t O_GQK = O_NAV + (size_t)BATCH * DEPTH * SEQ * NAH * HD;
constexpr size_t O_GQV = O_GQK + (size_t)BATCH * DEPTH * SEQ * GQKV * HD;
constexpr size_t O_MC = O_GQV + (size_t)BATCH * DEPTH * SEQ * GQKV * HD;
constexpr size_t O_MN = O_MC + (size_t)BATCH * DEPTH * 2 * MLH * HD * HD;
constexpr size_t O_MM = O_MN + (size_t)BATCH * DEPTH * 2 * MLH * HD;
constexpr size_t O_END = O_MM + (size_t)BATCH * DEPTH * 2 * MLH;

constexpr size_t al256(size_t x) { return (x + 255) & ~(size_t)255; }
constexpr size_t WS_BAR = 0;
constexpr size_t WS_BAR_BYTES = 32768;
constexpr size_t WS_MODS = WS_BAR + WS_BAR_BYTES;
constexpr size_t WS_ROPE = al256(WS_MODS + (size_t)DEPTH * NCOND * 6 * D * 4);
constexpr size_t WS_CNAK = al256(WS_ROPE + 64 * 16 * 2 * 4);
constexpr size_t WS_CNAV = al256(WS_CNAK + (size_t)DEC_BATCH * DEPTH * PAST * NAH * HD * 2);
constexpr size_t WS_CGQK = al256(WS_CNAV + (size_t)DEC_BATCH * DEPTH * PAST * NAH * HD * 2);
constexpr size_t WS_CGQV = al256(WS_CGQK + (size_t)DEC_BATCH * DEPTH * PAST * GQKV * HD * 2);
constexpr size_t WS_XBUF = al256(WS_CGQV + (size_t)DEC_BATCH * DEPTH * PAST * GQKV * HD * 2);
constexpr size_t WS_HMOD = al256(WS_XBUF + (size_t)NT * D * 4);
constexpr size_t WS_GATES = al256(WS_HMOD + (size_t)NT * D * 2);
constexpr size_t WS_NAQ = al256(WS_GATES + (size_t)NT * 16 * 4);
constexpr size_t WS_NAK = al256(WS_NAQ + (size_t)NT * 384 * 2);
constexpr size_t WS_NAV = al256(WS_NAK + (size_t)NT * 384 * 2);
constexpr size_t WS_MLQ = al256(WS_NAV + (size_t)NT * 384 * 2);
constexpr size_t WS_MLK = al256(WS_MLQ + (size_t)NT * 256 * 2);
constexpr size_t WS_MLV = al256(WS_MLK + (size_t)NT * 256 * 2);
constexpr size_t WS_MLO = al256(WS_MLV + (size_t)NT * 256 * 2);
constexpr size_t WS_GQQ = al256(WS_MLO + (size_t)NT * 256 * 2);
constexpr size_t WS_GQK = al256(WS_GQQ + (size_t)NT * 384 * 2);
constexpr size_t WS_GQV = al256(WS_GQK + (size_t)NT * 128 * 2);
constexpr size_t WS_MIXED = al256(WS_GQV + (size_t)NT * 128 * 2);
constexpr size_t WS_U = al256(WS_MIXED + (size_t)NT * MIXW * 2);
constexpr size_t WS_X1 = al256(WS_U + (size_t)NT * D * 4);
constexpr size_t WS_H2 = al256(WS_X1 + (size_t)NT * D * 4);
constexpr size_t WS_AFF = al256(WS_H2 + (size_t)NT * D * 2);
constexpr size_t WS_IDX = al256(WS_AFF + (size_t)NT * 16 * 4);
constexpr size_t WS_GSEL = al256(WS_IDX + (size_t)NEXP * SLOTS * 4);
constexpr size_t WS_TOKSLOT = al256(WS_GSEL + (size_t)NEXP * SLOTS * 4);
constexpr size_t WS_HID = al256(WS_TOKSLOT + (size_t)NT * 16 * 4);
constexpr size_t WS_YE = al256(WS_HID + (size_t)NEXP * SLOTS * EH * 2);
constexpr int ML_NU = 2048, ML_AG = 2112;
constexpr int MLSUM_STRIDE = 2048 + 64 + 64;
constexpr int N_MLSUM = (BATCH * NCH_P + DEC_BATCH * NCH_S) * MLH * 2;
constexpr size_t WS_MLSUM = al256(WS_YE + (size_t)NEXP * SLOTS * D * 2);
constexpr int PART_STRIDE = 256 * 64 + 512;
constexpr int N_PART = DEC_BATCH * GQH * (DEC_SEQ / 256) * 2;
constexpr size_t WS_PART = al256(WS_MLSUM + (size_t)N_MLSUM * MLSUM_STRIDE * 4);
constexpr size_t WS_TOTAL = al256(WS_PART + (size_t)N_PART * PART_STRIDE * 4);

struct Params {
    const float* in[N_IN];
    float* out;
    char* ws;
    int ph0, ph1;
};

DEV float bf2f(bf16_t s) { unsigned u = ((unsigned)s) << 16; return __builtin_bit_cast(float, u); }
DEV bf16_t f2bf(float f) {
#ifdef EMU
    unsigned u = __builtin_bit_cast(unsigned, f); u += 0x7fffu + ((u >> 16) & 1u); return (bf16_t)(u >> 16);
#else
    return __builtin_bit_cast(bf16_t, (__bf16)f);
#endif
}
DEV unsigned pack2(float a, float b) {
#ifdef EMU
    return (unsigned)f2bf(a) | ((unsigned)f2bf(b) << 16);
#else
    typedef __bf16 b2 __attribute__((ext_vector_type(2))); b2 r; r[0] = (__bf16)a; r[1] = (__bf16)b; return __builtin_bit_cast(unsigned, r);
#endif
}
DEV float fexp(float x) {
#ifdef EMU
    return expf(x);
#else
    return __expf(x);
#endif
}
DEV float fexp2(float x) {
#ifdef EMU
    return exp2f(x);
#else
    return __builtin_amdgcn_exp2f(x);
#endif
}
DEV float frcp(float x) {
#ifdef EMU
    return 1.f / x;
#else
    return __builtin_amdgcn_rcpf(x);
#endif
}
DEV float sigmoidf_(float x) { return frcp(1.f + fexp(-x)); }
DEV float siluf_(float x) { return x * frcp(1.f + fexp(-x)); }
DEV float flog(float x) {
#ifdef EMU
    return logf(x);
#else
    return __logf(x);
#endif
}
DEV float frsqrt(float x) {
#ifdef EMU
    return 1.f / sqrtf(x);
#else
    return __builtin_amdgcn_rsqf(x);
#endif
}
DEV float logsigmoidf_(float x) { return fminf(x, 0.f) - flog(1.f + fexp(-fabsf(x))); }
DEV f16v mfma32(s8v a, s8v b, f16v c) {
#ifdef EMU
    return emu_mfma_32x32x16_bf16(a, b, c);
#else
    typedef __bf16 bf8 __attribute__((ext_vector_type(8)));
    return __builtin_amdgcn_mfma_f32_32x32x16_bf16(__builtin_bit_cast(bf8, a), __builtin_bit_cast(bf8, b), c, 0, 0, 0);
#endif
}
DEV s4v lds_tr16(const void* p) {
#ifdef EMU
    return emu_ds_read_tr16_b64(p);
#else
    typedef s4v __attribute__((address_space(3))) * lp;
    return __builtin_amdgcn_ds_read_tr16_b64_v4i16((lp)(p));
#endif
}
#ifdef EMU
DEV float wave_sum(float v) { for (int m = 32; m >= 1; m >>= 1) v += __shfl_xor(v, m); return v; }
#else
template <int CTRL, int RM> DEV float dpp_f(float v) { return __builtin_bit_cast(float, __builtin_amdgcn_update_dpp(0, __builtin_bit_cast(int, v), CTRL, RM, 0xF, false)); }
DEV float wave_sum(float v) {
    v += dpp_f<0xB1, 0xF>(v); v += dpp_f<0x4E, 0xF>(v); v += dpp_f<0x141, 0xF>(v); v += dpp_f<0x140, 0xF>(v);
    v += dpp_f<0x142, 0xA>(v); v += dpp_f<0x143, 0xC>(v);
    return __builtin_bit_cast(float, __builtin_amdgcn_readlane(__builtin_bit_cast(int, v), 63));
}
#endif
DEV float wave_max(float v) { for (int m = 32; m >= 1; m >>= 1) v = fmaxf(v, __shfl_xor(v, m)); return v; }
DEV f16v f16zero() { f16v z; for (int i = 0; i < 16; ++i) z[i] = 0.f; return z; }

#ifdef EMU
#define VGPR_PIN(x) do {} while (0)
#define SGPR_PIN(x) do {} while (0)
#define SCHED_FENCE() do {} while (0)
#define CFENCE() do {} while (0)
#else
#define SCHED_FENCE() __builtin_amdgcn_sched_barrier(0)
#define SGPR_PIN(x) asm volatile("" : "+s"(x))
#define VGPR_PIN(x) asm volatile("" : "+v"(x))
#define CFENCE() asm volatile("" ::: "memory")
#endif
#ifdef EMU
DEV int get_tid() { return (int)threadIdx.x; }
#else
DEV int get_tid() { int t = threadIdx.x; asm volatile("" : "+v"(t)); return t; }
#endif
struct UnitIter { int i, end, step; };
DEV UnitIter unit_iter(int NU) {
    const int G = (int)gridDim.x, b = (int)blockIdx.x;
    UnitIter it;
#ifndef XCD_MODE
#define XCD_MODE 0
#endif
    if ((G & 7) == 0 && (NU & 7) == 0) { const int W = G >> 3, x = XCD_MODE ? b / W : b & 7, j = XCD_MODE ? b % W : b >> 3, C = NU >> 3; it.i = x * C + j; it.end = (x + 1) * C; it.step = W; }
    else { it.i = b; it.end = NU; it.step = G; }
    return it;
}
DEV int tok_cond(int t) { return t < NP ? 0 : 1 + (t - NP) / DEC_SEQ; }

#ifndef EMU
#define XB_TMO      128
#define XB_XCNT(j)  (256  + 64 * (j))
#define XB_XSUB(j)  (1280 + 64 * (j))
#define XB_XGEN(j)  (2304 + 64 * (j))
#define XB_TOP      3328
#define XB_TOPGEN   3392
#define XCD_BAR_WORDS 3456
#define XB_SPIN_CAP (1u << 20)
#define LAS __attribute__((address_space(3)))
__device__ __forceinline__ unsigned xb_ld(unsigned* p)              { return __hip_atomic_load(p, __ATOMIC_RELAXED, __HIP_MEMORY_SCOPE_AGENT); }
__device__ __forceinline__ unsigned xb_add(unsigned* p, unsigned v) { return __hip_atomic_fetch_add(p, v, __ATOMIC_RELAXED, __HIP_MEMORY_SCOPE_AGENT); }
__device__ __forceinline__ unsigned xb_xcc_id() { return (unsigned)__builtin_amdgcn_s_getreg((3 << 11) | 20) & 0xFu; }
#define XB_SPIN(cond, bar) do { unsigned _sp = 0; while (cond) { __builtin_amdgcn_s_sleep(1); \
    if ((++_sp & 255u) == 0u) { if (xb_ld(&(bar)[XB_TMO])) break; if (_sp > XB_SPIN_CAP) { atomicAdd(&(bar)[XB_TMO], 1u); break; } } } } while (0)
struct XcdBarrier { unsigned* bar; unsigned x; volatile LAS unsigned* st; };
__device__ __forceinline__ XcdBarrier xcd_barrier_post(unsigned* bar, volatile LAS unsigned* st) {
    XcdBarrier b; b.bar = bar; b.x = xb_xcc_id(); b.st = st;
    if (threadIdx.x == 0) (void)xb_add(&bar[XB_XCNT(b.x)], 1u);
    return b;
}
__device__ __forceinline__ void xcd_barrier_complete(unsigned* bar, unsigned x, unsigned& nloc, unsigned& nx) {
    const unsigned G = gridDim.x * gridDim.y * gridDim.z;
    unsigned sum, cnt, mine, sp = 0u;
    for (;;) {
        sum = 0u; cnt = 0u; mine = 0u;
#pragma unroll
        for (unsigned j = 0; j < 16; ++j) { const unsigned c = xb_ld(&bar[XB_XCNT(j)]); sum += c; cnt += (c > 0u) ? 1u : 0u; mine = (j == x) ? c : mine; }
        if (sum == G) break;
        __builtin_amdgcn_s_sleep(1);
        if ((++sp & 255u) == 0u) { if (xb_ld(&bar[XB_TMO])) break; if (sp > XB_SPIN_CAP) { atomicAdd(&bar[XB_TMO], 1u); break; } }
    }
    nloc = mine > 0u ? mine : 1u; nx = cnt > 0u ? cnt : 1u;
}
__device__ __forceinline__ void xcd_barrier(const XcdBarrier& b) {
    asm volatile("s_waitcnt vmcnt(0)" ::: "memory");
    __syncthreads();
    if (threadIdx.x == 0) {
        unsigned* bar = b.bar;
        __builtin_amdgcn_s_waitcnt(0);
        unsigned nloc = b.st[0], nx = b.st[1];
        if (nloc == 0u) { xcd_barrier_complete(bar, b.x, nloc, nx); b.st[0] = nloc; b.st[1] = nx; }
        const unsigned old = xb_add(&bar[XB_XSUB(b.x)], 1u);
        const unsigned gen = old / nloc;
        if (old + 1u == (gen + 1u) * nloc) {
            __builtin_amdgcn_fence(__ATOMIC_RELEASE, "agent");
            asm volatile("s_waitcnt vmcnt(0)" ::: "memory");
            const unsigned og = xb_add(&bar[XB_TOP], 1u);
            const unsigned tg = og / nx;
            if (og + 1u == (tg + 1u) * nx) xb_add(&bar[XB_TOPGEN], 1u);
            else XB_SPIN(xb_ld(&bar[XB_TOPGEN]) == tg, bar);
            __builtin_amdgcn_fence(__ATOMIC_ACQUIRE, "agent");
            xb_add(&bar[XB_XGEN(b.x)], 1u);
            asm volatile("s_waitcnt vmcnt(0)" ::: "memory");
        } else {
            XB_SPIN(xb_ld(&bar[XB_XGEN(b.x)]) == gen, bar);
            __builtin_amdgcn_fence(__ATOMIC_ACQUIRE, "agent");
            asm volatile("s_waitcnt vmcnt(0)" ::: "memory");
        }
    }
    __syncthreads();
}
#endif
constexpr int QUEUE_WORD0 = 4096;

constexpr int LROW = 144;
constexpr int GEMM_AS = 256 * LROW;
constexpr int GEMM_BS = 64 * (256 * 2 + 64);
constexpr int SMEM_XB = 2 * GEMM_AS + 2 * GEMM_BS;
constexpr int SMEM_AUX = SMEM_XB + 64;
constexpr int SMEM_BYTES = SMEM_AUX + 2048;

#ifdef EMU
struct BufRsrc { const char* base; };
DEV BufRsrc make_rsrc(const void* p) { BufRsrc r; r.base = (const char*)p; return r; }
DEV float buf_load_f32(BufRsrc r, unsigned voff, unsigned soff) { return *(const float*)(r.base + voff + soff); }
DEV u4v buf_load_b128(BufRsrc r, unsigned voff, unsigned soff) { return *(const u4v*)(r.base + voff + soff); }
#else
typedef __amdgpu_buffer_rsrc_t BufRsrc;
DEV BufRsrc make_rsrc(const void* p) { return __builtin_amdgcn_make_buffer_rsrc((void*)p, 0, 0x7fffffff, 0x00020000); }
DEV float buf_load_f32(BufRsrc r, unsigned voff, unsigned soff) { return __builtin_bit_cast(float, __builtin_amdgcn_raw_buffer_load_b32(r, voff, soff, 0)); }
DEV u4v buf_load_b128(BufRsrc r, unsigned voff, unsigned soff) { return __builtin_amdgcn_raw_buffer_load_b128(r, voff, soff, 0); }
#endif
#ifdef EMU
#define WAVE_SYNC() do { (void)__shfl(0, 0); } while (0)
#else
#define WAVE_SYNC() asm volatile("s_waitcnt lgkmcnt(0)" ::: "memory")
#endif
DEV char* wave_stage_ptr(char* smem, int wave) { return smem + (wave < 4 ? GEMM_AS + wave * 9216 : 2 * GEMM_AS + GEMM_BS + (wave - 4) * 9216); }
DEV void stage64_write_bf16(char* stg, int tt, const f16v& v0, const f16v& v1, int l31, int h) {
    char* row = stg + (tt * 32 + l31) * LROW;
#pragma unroll
    for (int ft = 0; ft < 2; ++ft) {
        const f16v& v = ft ? v1 : v0;
#pragma unroll
        for (int g = 0; g < 4; ++g) { u2v pk; pk[0] = pack2(v[4 * g], v[4 * g + 1]); pk[1] = pack2(v[4 * g + 2], v[4 * g + 3]); *(u2v*)(row + (ft * 32 + 8 * g + 4 * h) * 2) = pk; }
    }
}
DEV void stage64_write4(char* stg, int row, int col, float a, float b, float c, float d) {
    u2v pk; pk[0] = pack2(a, b); pk[1] = pack2(c, d); *(u2v*)(stg + row * LROW + col * 2) = pk;
}
DEV void stage64_flush_bf16(const char* stg, bf16_t* dst0, size_t row_stride, int lane) {
    WAVE_SYNC();
#pragma unroll
    for (int i = 0; i < 8; ++i) { const int r = (lane >> 3) + 8 * i, c = lane & 7; const u4v v = *(const u4v*)(stg + r * LROW + c * 16); *(u4v*)(dst0 + (size_t)r * row_stride + c * 8) = v; }
    WAVE_SYNC();
}
template <int NTW, int VAR, class Epi>
DEV void gemm_tile(char* smem, BufRsrc ars, unsigned ao0, unsigned ao1, unsigned ao2, unsigned ao3,
                   BufRsrc brs, unsigned bvo, unsigned blds, unsigned ldb4, int K, Epi&& epi) {
    constexpr int BN = 64 * NTW, NLD = 2 * NTW, KSTEP = 64 / NLD, RSB = BN * 2 + 64;
    const int tid = get_tid(), lane = tid & 63, wave = tid >> 6, wm = wave & 3, wn = wave >> 2, h = lane >> 5, l31 = lane & 31;
    char* As = smem; char* Bs = smem + 2 * GEMM_AS;
    constexpr int BSZ = GEMM_BS;
    const int ar = tid >> 3, ac = tid & 7;
    u4v areg[2]; f4v b0[NLD], b1[NLD];
    if (VAR & 3) { for (int i = 0; i < 2; ++i) areg[i] = (u4v){1u, 2u, 3u, 4u}; for (int j = 0; j < NLD; ++j) { b0[j] = (f4v){1.f, 1.f, 1.f, 1.f}; b1[j] = (f4v){2.f, 2.f, 2.f, 2.f}; } }
    f16v acc[NTW][2];
#pragma unroll
    for (int i = 0; i < NTW; ++i) { acc[i][0] = f16zero(); acc[i][1] = f16zero(); }
    auto gloadA = [&](int k0, bool real, int half) {
        if (VAR & 2) return;
        const unsigned so = real ? k0 * 2 : 0u;
        areg[0] = buf_load_b128(ars, real ? (half ? ao2 : ao0) : 0u, so); areg[1] = buf_load_b128(ars, real ? (half ? ao3 : ao1) : 0u, so);
    };
    auto gloadB = [&](int k0, bool real, f4v (&br)[NLD]) {
        if (VAR & 1) return;
        const unsigned vo = real ? bvo : 0u; const int kk = real ? k0 : 0;
        unsigned so = (unsigned)kk * ldb4;
#pragma unroll
        for (int j = 0; j < NLD; ++j) { br[j] = __builtin_bit_cast(f4v, buf_load_b128(brs, vo, so)); so += KSTEP * ldb4; SGPR_PIN(so); }
    };
    auto gloadB1 = [&](int k0, bool real, f4v (&br)[NLD], int j) {
        if (VAR & 1) return;
        br[j] = __builtin_bit_cast(f4v, buf_load_b128(brs, real ? bvo : 0u, (unsigned)((real ? k0 : 0) + j * KSTEP) * ldb4));
    };
    auto lstoreA = [&](int buf, int half) {
        if (VAR & 16) return;
        char* ab = As + buf * GEMM_AS + (ar + half * 128) * LROW + ac * 16;
        *(u4v*)(ab) = areg[0]; *(u4v*)(ab + 64 * LROW) = areg[1];
    };
    auto lstoreB1 = [&](int buf, const f4v (&br)[NLD], int j) {
        if (VAR & 16) return;
        u2v v; v[0] = pack2(br[j][0], br[j][1]); v[1] = pack2(br[j][2], br[j][3]); *(u2v*)(Bs + buf * BSZ + blds + j * KSTEP * RSB) = v;
    };
    auto lstoreB = [&](int buf, const f4v (&br)[NLD]) {
        if (VAR & 16) return;
        char* bb = Bs + buf * BSZ + blds;
#pragma unroll
        for (int j = 0; j < NLD; ++j) { u2v v; v[0] = pack2(br[j][0], br[j][1]); v[1] = pack2(br[j][2], br[j][3]); *(u2v*)(bb + j * KSTEP * RSB) = v; }
    };
    const unsigned btr = (unsigned)(8 * h + ((lane & 15) >> 2)) * RSB + (unsigned)((((lane >> 4) & 1) * 16 + 4 * (lane & 3)) * 2) + (unsigned)(wn * NTW * 32) * 2;
    const unsigned atr = (unsigned)(wm * 64 + l31) * LROW + h * 16;
    auto rdw = [&](int buf, int s, int ft) -> s8v {
        if (VAR & 64) { s8v z; for (int q = 0; q < 8; ++q) z[q] = (short)(0x3f80 + ft); return z; }
        const char* bb = Bs + buf * BSZ + btr + s * 16 * RSB + ft * 64;
        const s4v lo = lds_tr16(bb), hi = lds_tr16(bb + 4 * RSB);
        s8v wf; wf[0] = lo[0]; wf[1] = lo[1]; wf[2] = lo[2]; wf[3] = lo[3]; wf[4] = hi[0]; wf[5] = hi[1]; wf[6] = hi[2]; wf[7] = hi[3];
        return wf;
    };
    auto compute2 = [&](int buf, int s0, auto&& hook) {
        if (VAR & 8) { for (int g = 0; g < 2 * NTW; ++g) hook(g); return; }
        const char* ab = As + buf * GEMM_AS + atr;
        s8v xa[2];
        if (VAR & 64) { for (int q = 0; q < 8; ++q) { xa[0][q] = 0x3f80; xa[1][q] = 0x3f80; } } else { xa[0] = *(const s8v*)(ab + s0 * 32); xa[1] = *(const s8v*)(ab + 32 * LROW + s0 * 32); }
        s8v wcur = rdw(buf, s0, 0);
#pragma unroll
        for (int g = 0; g < 2 * NTW; ++g) {
            const int ft = g % NTW;
            s8v wnext = wcur;
            if (g + 1 < 2 * NTW) wnext = rdw(buf, s0 + (g + 1) / NTW, (g + 1) % NTW);
            if (VAR & 4) { acc[ft][0][0] += __builtin_bit_cast(float, (int)wcur[0] | ((int)xa[0][1] << 16)); acc[ft][1][0] += __builtin_bit_cast(float, (int)wcur[1] | ((int)xa[1][1] << 16)); }
            else { acc[ft][0] = mfma32(wcur, xa[0], acc[ft][0]); acc[ft][1] = mfma32(wcur, xa[1], acc[ft][1]); }
            if (g == NTW - 1 && !(VAR & 64)) { xa[0] = *(const s8v*)(ab + (s0 + 1) * 32); xa[1] = *(const s8v*)(ab + 32 * LROW + (s0 + 1) * 32); }
            wcur = wnext;
            hook(g);
            SCHED_FENCE();
        }
    };
    auto nohook = [](int) {};
    const int nk = K / 64;
    if (NTW == 2) {
        u4v a0[4], a1[4];
        if (VAR & 3) { for (int i = 0; i < 4; ++i) { a0[i] = (u4v){1u, 2u, 3u, 4u}; a1[i] = (u4v){1u, 2u, 3u, 4u}; } }
        auto gA = [&](int k0, bool real, u4v (&ar4)[4]) {
            if (VAR & 2) return;
            const unsigned so = real ? k0 * 2 : 0u;
            ar4[0] = buf_load_b128(ars, real ? ao0 : 0u, so); ar4[1] = buf_load_b128(ars, real ? ao1 : 0u, so);
            ar4[2] = buf_load_b128(ars, real ? ao2 : 0u, so); ar4[3] = buf_load_b128(ars, real ? ao3 : 0u, so);
        };
        auto sA = [&](int buf, const u4v (&ar4)[4]) {
            if (VAR & 16) return;
            char* ab = As + buf * GEMM_AS + ar * LROW + ac * 16;
#pragma unroll
            for (int i = 0; i < 4; ++i) *(u4v*)(ab + i * 64 * LROW) = ar4[i];
        };
        auto gA1 = [&](int k0, bool real, u4v (&ar4)[4], int i) {
            if (VAR & 2) return;
            const unsigned ao = i == 0 ? ao0 : i == 1 ? ao1 : i == 2 ? ao2 : ao3;
            ar4[i] = buf_load_b128(ars, real ? ao : 0u, real ? k0 * 2 : 0u);
        };
        auto sA1 = [&](int buf, const u4v (&ar4)[4], int i) {
            if (VAR & 16) return;
            *(u4v*)(As + buf * GEMM_AS + (ar + i * 64) * LROW + ac * 16) = ar4[i];
        };
        gA(0, true, a0); gloadB(0, true, b0); gA(64, true, a1); gloadB(64, true, b1);
        sA(0, a0); lstoreB(0, b0);
        __syncthreads();
        for (int kt = 0; kt < nk; kt += 2) {
            const bool t2 = kt + 2 < nk;
            compute2(0, 0, [&](int g) { gA1((kt + 2) * 64, t2, a0, g); lstoreB1(1, b1, g); });
            compute2(0, 2, [&](int g) { gloadB1((kt + 2) * 64, t2, b0, g); sA1(1, a1, g); });
            __syncthreads();
            compute2(1, 0, [&](int g) { gA1((kt + 3) * 64, t2, a1, g); lstoreB1(0, b0, g); });
            compute2(1, 2, [&](int g) { gloadB1((kt + 3) * 64, t2, b1, g); sA1(0, a0, g); });
            __syncthreads();
        }
    } else {
    {
        u4v at0, at1;
        gloadA(0, true, 0);
        if (!(VAR & 2)) { at0 = buf_load_b128(ars, ao2, 0); at1 = buf_load_b128(ars, ao3, 0); } else { at0 = areg[0]; at1 = areg[1]; }
        gloadB(0, true, b0); gloadB(64, true, b1);
        lstoreA(0, 0);
        if (!(VAR & 16)) { char* ab = As + (ar + 128) * LROW + ac * 16; *(u4v*)(ab) = at0; *(u4v*)(ab + 64 * LROW) = at1; }
        lstoreB(0, b0);
    }
    __syncthreads();
    for (int kt = 0; kt < nk; kt += 2) {
        const bool t2 = kt + 2 < nk;
        gloadA((kt + 1) * 64, true, 0);
        compute2(0, 0, [&](int g) { if (g & 1) gloadB1((kt + 2) * 64, t2, b0, g >> 1); else lstoreB1(1, b1, g >> 1); });
        lstoreA(1, 0);
        gloadA((kt + 1) * 64, true, 1);
        compute2(0, 2, [&](int g) { if (g & 1) gloadB1((kt + 2) * 64, t2, b0, 4 + (g >> 1)); else lstoreB1(1, b1, 4 + (g >> 1)); });
        lstoreA(1, 1);
        __syncthreads();
        gloadA((kt + 2) * 64, t2, 0);
        compute2(1, 0, [&](int g) { if (g & 1) gloadB1((kt + 3) * 64, t2, b1, g >> 1); else lstoreB1(0, b0, g >> 1); });
        lstoreA(0, 0);
        gloadA((kt + 2) * 64, t2, 1);
        compute2(1, 2, [&](int g) { if (g & 1) gloadB1((kt + 3) * 64, t2, b1, 4 + (g >> 1)); else lstoreB1(0, b0, 4 + (g >> 1)); });
        lstoreA(0, 1);
        __syncthreads();
    }
    }
    if (VAR & 32) { float t = 0.f; for (int i = 0; i < NTW; ++i) t += acc[i][0][0] + acc[i][1][5]; if (t == 123.456f) *(float*)smem = t; }
    else epi(acc);
}

DEV void phase_ada(const Params& p, char* smem) {
    const int tid = get_tid();
    float* siluS = (float*)smem;
    float* red = (float*)(smem + NCOND * D * 4);
    for (int i = tid; i < NCOND * D; i += 512) {
        const int cnd = i / D, k = i % D;
        const float c = cnd == 0 ? p.in[I_CCTX][k] : p.in[I_C][(cnd - 1) * D + k];
        siluS[i] = c * frcp(1.f + fexp(-c));
    }
    __syncthreads();
    constexpr int CPL = 6 * D / 32, NCHUNK = DEPTH * CPL, KG = D / 16;
    float* mods = (float*)(p.ws + WS_MODS);
    const int col = tid & 31, kg = tid >> 5;
    for (int u = blockIdx.x; u < NCHUNK; u += gridDim.x) {
        const int l = u / CPL, c0 = (u % CPL) * 32;
        const float* W = p.in[I_ADAW] + (size_t)l * D * 6 * D + c0 + col;
        float acc[NCOND];
#pragma unroll
        for (int c = 0; c < NCOND; ++c) acc[c] = 0.f;
#pragma unroll 8
        for (int k = kg * KG; k < kg * KG + KG; ++k) {
            const float w = W[(size_t)k * 6 * D];
#pragma unroll
            for (int c = 0; c < NCOND; ++c) acc[c] += siluS[c * D + k] * w;
        }
#pragma unroll
        for (int c = 0; c < NCOND; ++c) red[(kg * NCOND + c) * 32 + col] = acc[c];
        __syncthreads();
        if (tid < 32 * NCOND) {
            const int c = tid >> 5, cc = tid & 31;
            float s = 0.f;
            for (int g = 0; g < 16; ++g) s += red[(g * NCOND + c) * 32 + cc];
            mods[((size_t)l * NCOND + c) * 6 * D + c0 + cc] = s + p.in[I_ADAB][(size_t)l * 6 * D + c0 + cc];
        }
        __syncthreads();
    }
    const int gtid = blockIdx.x * 512 + tid, gsz = gridDim.x * 512;
    float* rope = (float*)(p.ws + WS_ROPE);
    for (int i = gtid; i < 64 * 16; i += gsz) {
        const int pos = i >> 4, fi = i & 15;
        const float inv = fexp2(-(float)(2 * fi) * (13.287712379549449f / 32.f));
        const float ang = (float)pos * inv;
#ifdef EMU
        rope[2 * i] = cosf(ang); rope[2 * i + 1] = sinf(ang);
#else
        rope[2 * i] = __cosf(ang); rope[2 * i + 1] = __sinf(ang);
#endif
    }
    constexpr int NNA = DEC_BATCH * DEPTH * PAST * NAH * HD, NGQ = DEC_BATCH * DEPTH * PAST * GQKV * HD;
    bf16_t* cnak = (bf16_t*)(p.ws + WS_CNAK); bf16_t* cnav = (bf16_t*)(p.ws + WS_CNAV);
    bf16_t* cgqk = (bf16_t*)(p.ws + WS_CGQK); bf16_t* cgqv = (bf16_t*)(p.ws + WS_CGQV);
    for (int i = gtid; i < NNA; i += gsz) { cnak[i] = f2bf(p.in[I_CNAK][i]); cnav[i] = f2bf(p.in[I_CNAV][i]); }
    for (int i = gtid; i < NGQ; i += gsz) { cgqk[i] = f2bf(p.in[I_CGQK][i]); cgqv[i] = f2bf(p.in[I_CGQV][i]); }
}

constexpr int EPL = D / 64;
constexpr int W16ROW = 20;
template <int MODE>
DEV void phase_rows(const Params& p, char* smem, int l) {
    const int tid = get_tid(), lane = tid & 63, wave = tid >> 6;
    float* W16 = (float*)smem;
    const bool need_w = (MODE == 1) || (l < DEPTH);
    if (need_w) {
        for (int i = tid; i < D * 4; i += 512) {
            const int k = i >> 2, q = i & 3;
            const float* src = (MODE == 1) ? p.in[I_RW] + ((size_t)l * D + k) * 16 + q * 4 : p.in[I_WIN] + ((size_t)l * D + k) * PROJ_W + 2176 + q * 4;
            *(f4v*)(W16 + k * W16ROW + q * 4) = *(const f4v*)src;
        }
    }
    __syncthreads();
    const float* mods = (const float*)(p.ws + WS_MODS);
    auto load_row = [&](int t, float (&vr)[EPL], int& ms) {
        const float* rp = (MODE == 1) ? (const float*)(p.ws + WS_U) + (size_t)t * D
                        : (l == 0) ? (t < NP ? p.in[I_XP] + (size_t)t * D : p.in[I_XS] + (size_t)(t - NP) * D) : (const float*)(p.ws + WS_X1) + (size_t)t * D;
#pragma unroll
        for (int j = 0; j < EPL; ++j) vr[j] = rp[lane + 64 * j];
        if (MODE == 0 && l > 0) ms = lane < 16 ? ((const int*)(p.ws + WS_TOKSLOT))[(size_t)t * 16 + lane] : -1;
    };
    const int tstride = gridDim.x * 8;
    float vr[EPL]; int ms = -1;
    {
        const int t0 = blockIdx.x * 8 + wave;
        if (t0 < NT) load_row(t0, vr, ms);
    }
    for (int t = blockIdx.x * 8 + wave; t < NT; t += tstride) {
        const int cnd = tok_cond(t);
        float vn[EPL]; int msn = -1;
#pragma unroll
        for (int j = 0; j < EPL; ++j) vn[j] = 0.f;
        if (t + tstride < NT) load_row(t + tstride, vn, msn);
        float v[EPL];
        if (MODE == 0 && l > 0) {
            const float* g2 = mods + ((size_t)(l - 1) * NCOND + cnd) * 6 * D + 5 * D;
            float f[EPL], gv[EPL];
#pragma unroll
            for (int j = 0; j < EPL; ++j) { f[j] = 0.f; gv[j] = g2[lane + 64 * j]; }
            const int myslot = ms;
            unsigned vm = (unsigned)__ballot(myslot >= 0);
            while (vm) {
                const int e = __builtin_ctz(vm); vm &= vm - 1u;
                const int slot = __shfl(myslot, e);
                const bf16_t* yr = (const bf16_t*)(p.ws + WS_YE) + ((size_t)e * SLOTS + slot) * D;
#pragma unroll
                for (int j = 0; j < EPL; ++j) f[j] += bf2f(yr[lane + 64 * j]);
            }
#pragma unroll
            for (int j = 0; j < EPL; ++j) v[j] = ALPHA * vr[j] + gv[j] * f[j];
        } else {
#pragma unroll
            for (int j = 0; j < EPL; ++j) v[j] = vr[j];
        }
#pragma unroll
        for (int j = 0; j < EPL; ++j) vr[j] = vn[j];
        ms = msn;
        if (!(MODE == 0 && l == 0)) {
            const int li = (MODE == 0) ? (l - 1) * 2 + 1 : l * 2;
            const float* lg = p.in[I_LNG] + (size_t)li * D; const float* lb = p.in[I_LNB] + (size_t)li * D;
            float g[EPL], bb[EPL];
#pragma unroll
            for (int j = 0; j < EPL; ++j) { g[j] = lg[lane + 64 * j]; bb[j] = lb[lane + 64 * j]; }
            float s = 0.f;
#pragma unroll
            for (int j = 0; j < EPL; ++j) s += v[j];
            const float mu = wave_sum(s) * (1.f / D);
            float q = 0.f;
#pragma unroll
            for (int j = 0; j < EPL; ++j) { const float dlt = v[j] - mu; q += dlt * dlt; }
            const float rstd = frsqrt(wave_sum(q) * (1.f / D) + EPS);
            float* dst = (MODE == 1) ? (float*)(p.ws + WS_X1) + (size_t)t * D
                       : (l == DEPTH) ? (t < NP ? p.out + O_YP + (size_t)t * D : p.out + O_YS + (size_t)(t - NP) * D) : (float*)(p.ws + WS_XBUF) + (size_t)t * D;
#pragma unroll
            for (int j = 0; j < EPL; ++j) { v[j] = (v[j] - mu) * rstd * g[j] + bb[j]; dst[lane + 64 * j] = v[j]; }
        }
        if (MODE == 1 || l < DEPTH) {
            const float* sh = mods + ((size_t)l * NCOND + cnd) * 6 * D + (MODE == 1 ? 3 * D : 0); const float* sc = sh + D;
            bf16_t* hb = (bf16_t*)(p.ws + (MODE == 1 ? WS_H2 : WS_HMOD)) + (size_t)t * D;
            {
                float s1[EPL], s0[EPL];
#pragma unroll
                for (int j = 0; j < EPL; ++j) { s1[j] = sc[lane + 64 * j]; s0[j] = sh[lane + 64 * j]; }
#pragma unroll
                for (int j = 0; j < EPL; ++j) { v[j] = v[j] * (1.f + s1[j]) + s0[j]; hb[lane + 64 * j] = f2bf(v[j]); }
            }
            CFENCE();
            float a16[16];
#pragma unroll
            for (int e = 0; e < 16; ++e) a16[e] = 0.f;
#pragma unroll
            for (int j = 0; j < EPL; ++j) {
                const float hv = v[j];
                const float* wr = W16 + (lane + 64 * j) * W16ROW;
#pragma unroll
                for (int q = 0; q < 4; ++q) { const f4v w4 = *(const f4v*)(wr + 4 * q); a16[4 * q] += hv * w4[0]; a16[4 * q + 1] += hv * w4[1]; a16[4 * q + 2] += hv * w4[2]; a16[4 * q + 3] += hv * w4[3]; }
                if (j & 1) CFENCE();
            }
            float mine = -1e30f;
#pragma unroll
            for (int e = 0; e < 16; ++e) { const float sm = wave_sum(a16[e]); if (lane == e) mine = sm; }
            if (MODE == 0) {
                if (lane < 16) ((float*)(p.ws + WS_GATES))[(size_t)t * 16 + lane] = mine + p.in[I_BGATE][l * 16 + lane];
            } else {
                float mx = mine;
                for (int m = 8; m >= 1; m >>= 1) mx = fmaxf(mx, __shfl_xor(mx, m));
                const float ex = lane < 16 ? fexp(mine - mx) : 0.f;
                float sm = ex;
                for (int m = 8; m >= 1; m >>= 1) sm += __shfl_xor(sm, m);
                if (lane < 16) ((float*)(p.ws + WS_AFF))[(size_t)t * 16 + lane] = ex / sm;
            }
        }
    }
}

template <int NPL>
DEV void topk_wave(const Params& p, int tb, int cap, int sbase, int e, int lane) {
    const float* aff = (const float*)(p.ws + WS_AFF);
    int* idx = (int*)(p.ws + WS_IDX); float* gsel = (float*)(p.ws + WS_GSEL); int* tokslot = (int*)(p.ws + WS_TOKSLOT);
    unsigned bits[NPL];
#pragma unroll
    for (int i = 0; i < NPL; ++i) bits[i] = __builtin_bit_cast(unsigned, aff[(size_t)(tb + lane + 64 * i) * 16 + e]);
    unsigned T = 0u;
    for (int b = 30; b >= 0; --b) {
        const unsigned cand = T | (1u << b);
        int cnt = 0;
#pragma unroll
        for (int i = 0; i < NPL; ++i) cnt += __popcll(__ballot(bits[i] >= cand));
        if (cnt >= cap) T = cand;
    }
    int ngt = 0;
#pragma unroll
    for (int i = 0; i < NPL; ++i) ngt += __popcll(__ballot(bits[i] > T));
    int need_eq = cap - ngt, run = 0;
    const unsigned long long lt = (1ull << lane) - 1ull;
#pragma unroll
    for (int i = 0; i < NPL; ++i) {
        const bool eq = bits[i] == T;
        const unsigned long long meq = __ballot(eq);
        const int eqrank = __popcll(meq & lt);
        const bool sel = bits[i] > T || (eq && eqrank < need_eq);
        const unsigned long long ms = __ballot(sel);
        const int t = tb + lane + 64 * i;
        if (sel) { const int slot = sbase + run + __popcll(ms & lt); idx[e * SLOTS + slot] = t; gsel[e * SLOTS + slot] = __builtin_bit_cast(float, bits[i]); tokslot[(size_t)t * 16 + e] = slot; }
        else tokslot[(size_t)t * 16 + e] = -1;
        run += __popcll(ms);
        const int neq = __popcll(meq); need_eq -= neq < need_eq ? neq : need_eq;
    }
}
template <int NPW>
DEV void topk_quad(const Params& p, char* smem, bool valid, int tb, int cap, int sbase, int e, int grp, int wq, int lane) {
    const float* aff = (const float*)(p.ws + WS_AFF);
    int* idx = (int*)(p.ws + WS_IDX); float* gsel = (float*)(p.ws + WS_GSEL); int* tokslot = (int*)(p.ws + WS_TOKSLOT);
    int* cntS = (int*)smem + grp * 64;
    const int t0 = tb + wq * (NPW * 64);
    unsigned bits[NPW];
#pragma unroll
    for (int i = 0; i < NPW; ++i) bits[i] = valid ? __builtin_bit_cast(unsigned, aff[(size_t)(t0 + lane + 64 * i) * 16 + e]) : 0u;
    unsigned T = 0u;
    for (int b = 30; b >= 0; --b) {
        const unsigned cand = T | (1u << b);
        int cnt = 0;
#pragma unroll
        for (int i = 0; i < NPW; ++i) cnt += __popcll(__ballot(bits[i] >= cand));
        if (lane == 0) cntS[(b & 1) * 4 + wq] = cnt;
        __syncthreads();
        const int tot = cntS[(b & 1) * 4] + cntS[(b & 1) * 4 + 1] + cntS[(b & 1) * 4 + 2] + cntS[(b & 1) * 4 + 3];
        if (tot >= cap) T = cand;
    }
    int ngt = 0, neqw = 0;
#pragma unroll
    for (int i = 0; i < NPW; ++i) { ngt += __popcll(__ballot(bits[i] > T)); neqw += __popcll(__ballot(bits[i] == T)); }
    if (lane == 0) { cntS[16 + wq] = ngt; cntS[20 + wq] = neqw; }
    __syncthreads();
    int gt_tot = 0;
    for (int w = 0; w < 4; ++w) gt_tot += cntS[16 + w];
    int rem = cap - gt_tot, run = 0, need_eq = 0;
    for (int w = 0; w < 4; ++w) {
        const int take = cntS[20 + w] < rem ? cntS[20 + w] : rem;
        if (w < wq) run += cntS[16 + w] + take;
        if (w == wq) need_eq = take;
        rem -= take;
    }
    if (!valid) return;
    const unsigned long long lt = (1ull << lane) - 1ull;
#pragma unroll
    for (int i = 0; i < NPW; ++i) {
        const bool eq = bits[i] == T;
        const unsigned long long meq = __ballot(eq);
        const int eqrank = __popcll(meq & lt);
        const bool sel = bits[i] > T || (eq && eqrank < need_eq);
        const unsigned long long ms = __ballot(sel);
        const int t = t0 + lane + 64 * i;
        if (sel) { const int slot = sbase + run + __popcll(ms & lt); idx[e * SLOTS + slot] = t; gsel[e * SLOTS + slot] = __builtin_bit_cast(float, bits[i]); tokslot[(size_t)t * 16 + e] = slot; }
        else tokslot[(size_t)t * 16 + e] = -1;
        run += __popcll(ms);
        const int neq = __popcll(meq); need_eq -= neq < need_eq ? neq : need_eq;
    }
}
DEV void phase_topk(const Params& p, char* smem) {
    const int tid = get_tid(), lane = tid & 63, wave = tid >> 6;
    constexpr int US = DEC_BATCH * NEXP, UP = BATCH * NEXP, NSB = (US + 1) / 2;
    static_assert(DEC_SEQ % 256 == 0, "quarter split");
    for (int ub = blockIdx.x; ub < NSB; ub += gridDim.x) {
        const int u = 2 * ub + (wave >> 2);
        const bool valid = u < US;
        const int b = valid ? u / NEXP : 0, e = valid ? u % NEXP : 0;
        topk_quad<DEC_SEQ / 256>(p, smem, valid, NP + b * DEC_SEQ, CAP_S, BATCH * CAP_P + b * CAP_S, e, wave >> 2, wave & 3, lane);
        __syncthreads();
    }
    const int gw = (gridDim.x - 1 - blockIdx.x) + gridDim.x * wave, nw = gridDim.x * 8;
    for (int u = gw; u < UP; u += nw) { const int b = u / NEXP, e = u % NEXP; topk_wave<SEQ / 64>(p, b * SEQ, CAP_P, b * CAP_P, e, lane); }
}

DEV void store_head_f32(float* dst_f32, const f16v& v0, const f16v& v1, int h) {
#pragma unroll
    for (int ft = 0; ft < 2; ++ft) {
        const f16v& v = ft ? v1 : v0;
#pragma unroll
        for (int g = 0; g < 4; ++g) { f4v o; o[0] = v[4 * g]; o[1] = v[4 * g + 1]; o[2] = v[4 * g + 2]; o[3] = v[4 * g + 3]; *(f4v*)(dst_f32 + ft * 32 + 8 * g + 4 * h) = o; }
    }
}
template <int VAR>
DEV void phase_inproj(const Params& p, char* smem, int l) {
    constexpr int NJ = 22, NU = (NT / 256) * NJ;
    const int tid = get_tid(), lane = tid & 63, wave = tid >> 6, wm = wave & 3, wn = wave >> 2, h = lane >> 5, l31 = lane & 31;
    const bf16_t* hmod = (const bf16_t*)(p.ws + WS_HMOD);
    const float* rope = (const float*)(p.ws + WS_ROPE);
    constexpr int NMB = NT / 256, RPX = (NMB % 8 == 0) ? NMB / 8 : NMB;
    const UnitIter it = unit_iter(NU);
    for (int u = it.i; u < it.end; u += it.step) {
        const int mb = (u / (RPX * NJ)) * RPX + u % RPX, j = (u / RPX) % NJ;
        const int colbase = j < 17 ? 128 * j : 2192 + 128 * (j - 17);
        const unsigned ao = ((unsigned)(mb * 256 + (tid >> 3)) * D + (tid & 7) * 8) * 2;
        const unsigned bvo = (unsigned)(colbase + 4 * (tid & 31)) * 4 + (unsigned)(tid >> 5) * (PROJ_W * 4);
        const unsigned blds = (unsigned)(tid >> 5) * 320u + (unsigned)(tid & 31) * 8u;
        gemm_tile<2, VAR>(smem, make_rsrc(hmod), ao, ao + 128u * D, ao + 256u * D, ao + 384u * D, make_rsrc(p.in[I_WIN] + (size_t)l * D * PROJ_W), bvo, blds, PROJ_W * 4, D, [&](f16v (&acc)[2][2]) {
            int lane_e = lane; VGPR_PIN(lane_e); const int lane = lane_e, l31 = lane_e & 31, h = lane_e >> 5; (void)l31; (void)h;
            const int cb = colbase + wn * 64;
            char* stg = wave_stage_ptr(smem, wave);
            const int t0 = mb * 256 + wm * 64;
            const bool isP = t0 < NP;
            bf16_t* dstb; size_t dstride;
            int f32out = 0, fhead = 0, fheads = 0; size_t fbase = 0;
            int mode = 0;
            if (cb < 1152) {
                const int seg = cb / 384, head = (cb % 384) / 64;
                dstb = (bf16_t*)(p.ws + (seg == 0 ? WS_NAQ : seg == 1 ? WS_NAK : WS_NAV)) + (size_t)t0 * 384 + head * 64; dstride = 384;
                if (seg >= 1 && isP) { f32out = 1; fbase = seg == 1 ? O_NAK : O_NAV; fhead = head; fheads = NAH; }
            } else if (cb < 2176) {
                const int seg = (cb - 1152) / 256, head = ((cb - 1152) % 256) / 64;
                dstb = (bf16_t*)(p.ws + (seg == 0 ? WS_MLQ : seg == 1 ? WS_MLK : seg == 2 ? WS_MLV : WS_MLO)) + (size_t)t0 * 256 + head * 64; dstride = 256;
                mode = seg == 1 ? 1 : 0;
            } else {
                const int c2 = cb - 2192;
                if (c2 < 384) { dstb = (bf16_t*)(p.ws + WS_GQQ) + (size_t)t0 * 384 + (c2 / 64) * 64; dstride = 384; mode = 2; }
                else if (c2 < 512) { const int head = (c2 - 384) / 64; dstb = (bf16_t*)(p.ws + WS_GQK) + (size_t)t0 * 128 + head * 64; dstride = 128; mode = 3;
                                     if (isP) { f32out = 1; fbase = O_GQK; fhead = head; fheads = GQKV; } }
                else { const int head = (c2 - 512) / 64; dstb = (bf16_t*)(p.ws + WS_GQV) + (size_t)t0 * 128 + head * 64; dstride = 128;
                       if (isP) { f32out = 1; fbase = O_GQV; fhead = head; fheads = GQKV; } }
            }
#pragma unroll
            for (int tt = 0; tt < 2; ++tt) {
                const int t = t0 + tt * 32 + l31;
                f16v v0 = acc[0][tt], v1 = acc[1][tt];
                if (mode == 1) { v0 *= ATT_SCALE; v1 *= ATT_SCALE; }
                if (mode >= 2) {
                    float ss = 0.f;
#pragma unroll
                    for (int r = 0; r < 16; ++r) ss += v0[r] * v0[r] + v1[r] * v1[r];
                    ss += __shfl_xor(ss, 32);
                    const float rn = frsqrt(ss * (1.f / 64.f) + EPS);
                    const float* gq = p.in[I_QKG] + ((size_t)l * 2 + (mode == 2 ? 0 : 1)) * 64;
#pragma unroll
                    for (int r = 0; r < 16; ++r) {
                        const int d = (r & 3) + 8 * (r >> 2) + 4 * h;
                        v0[r] *= rn * gq[d]; v1[r] *= rn * gq[32 + d];
                    }
                }
                if (f32out) { const int bP = t / SEQ, sP = t % SEQ; store_head_f32(p.out + fbase + ((((size_t)bP * DEPTH + l) * SEQ + sP) * fheads + fhead) * 64, v0, v1, h); }
                if (mode >= 2 && !isP) {
                    const int pos = (t - NP) % DEC_SEQ, prow = pos / GRIDW, pcol = pos % GRIDW;
#pragma unroll
                    for (int rr = 0; rr < 8; ++rr) {
                        const int fi = (rr & 3) + 8 * ((rr >> 2) & 1) + 4 * h;
                        const float c0 = rope[(prow * 16 + fi) * 2], s0 = rope[(prow * 16 + fi) * 2 + 1];
                        const float c1 = rope[(pcol * 16 + fi) * 2], s1 = rope[(pcol * 16 + fi) * 2 + 1];
                        const float a_lo = v0[rr], a_hi = v0[rr + 8]; v0[rr] = a_lo * c0 - a_hi * s0; v0[rr + 8] = a_hi * c0 + a_lo * s0;
                        const float b_lo = v1[rr], b_hi = v1[rr + 8]; v1[rr] = b_lo * c1 - b_hi * s1; v1[rr + 8] = b_hi * c1 + b_lo * s1;
                    }
                }
                stage64_write_bf16(stg, tt, v0, v1, l31, h);
            }
            stage64_flush_bf16(stg, dstb, dstride, lane);
        });
    }
}

template <int VAR>
DEV void phase_outproj(const Params& p, char* smem, int l) {
    constexpr int NC = D / 128, NU = (NT / 256) * NC;
    const int tid = get_tid(), lane = tid & 63, wave = tid >> 6, wm = wave & 3, wn = wave >> 2, h = lane >> 5, l31 = lane & 31;
    const bf16_t* mixed = (const bf16_t*)(p.ws + WS_MIXED);
    const float* mods = (const float*)(p.ws + WS_MODS);
    float* U = (float*)(p.ws + WS_U);
    constexpr int NMB = NT / 256, RPX = (NMB % 8 == 0) ? NMB / 8 : NMB;
    const UnitIter it = unit_iter(NU);
    for (int u = it.i; u < it.end; u += it.step) {
        const int mb = (u / (RPX * NC)) * RPX + u % RPX, cbk = (u / RPX) % NC;
        const unsigned ao = ((unsigned)(mb * 256 + (tid >> 3)) * MIXW + (tid & 7) * 8) * 2;
        const unsigned bvo = (unsigned)(cbk * 128 + 4 * (tid & 31)) * 4 + (unsigned)(tid >> 5) * (D * 4);
        const unsigned blds = (unsigned)(tid >> 5) * 320u + (unsigned)(tid & 31) * 8u;
        gemm_tile<2, VAR>(smem, make_rsrc(mixed), ao, ao + 128u * MIXW, ao + 256u * MIXW, ao + 384u * MIXW, make_rsrc(p.in[I_WOUT] + (size_t)l * MIXW * D), bvo, blds, D * 4, MIXW, [&](f16v (&acc)[2][2]) {
            int lane_e = lane; VGPR_PIN(lane_e); const int lane = lane_e, l31 = lane_e & 31, h = lane_e >> 5; (void)l31; (void)h;
            char* stg = wave_stage_ptr(smem, wave);
            const int t0 = mb * 256 + wm * 64;
            const float* g1 = mods + ((size_t)l * NCOND + tok_cond(t0)) * 6 * D + 2 * D;
#pragma unroll
            for (int ft = 0; ft < 2; ++ft) {
#pragma unroll
                for (int tt = 0; tt < 2; ++tt)
#pragma unroll
                    for (int g = 0; g < 4; ++g) { f4v o; o[0] = acc[ft][tt][4 * g]; o[1] = acc[ft][tt][4 * g + 1]; o[2] = acc[ft][tt][4 * g + 2]; o[3] = acc[ft][tt][4 * g + 3];
                        *(f4v*)(stg + (tt * 32 + l31) * LROW + (8 * g + 4 * h) * 4) = o; }
                WAVE_SYNC();
                const int f0 = cbk * 128 + wn * 64 + ft * 32 + (lane & 7) * 4;
                const f4v gv = *(const f4v*)(g1 + f0);
#pragma unroll
                for (int i = 0; i < 8; ++i) {
                    const int r = (lane >> 3) + 8 * i, t = t0 + r;
                    const f4v a = *(const f4v*)(stg + r * LROW + (lane & 7) * 16);
                    const float* xr = (l == 0) ? (t < NP ? p.in[I_XP] + (size_t)t * D : p.in[I_XS] + (size_t)(t - NP) * D) : (const float*)(p.ws + WS_XBUF) + (size_t)t * D;
                    const f4v xv = *(const f4v*)(xr + f0);
                    f4v o;
#pragma unroll
                    for (int q = 0; q < 4; ++q) o[q] = ALPHA * xv[q] + gv[q] * a[q];
                    *(f4v*)(U + (size_t)t * D + f0) = o;
                }
                WAVE_SYNC();
            }
        });
    }
}

template <int VAR>
DEV void phase_gateup(const Params& p, char* smem, int l) {
    constexpr int NRB = SLOTS / 256, NCB = EH / 128, NU = NEXP * NCB * NRB;
    const int tid = get_tid(), lane = tid & 63, wave = tid >> 6, wm = wave & 3, wn = wave >> 2, h = lane >> 5, l31 = lane & 31;
    const bf16_t* h2 = (const bf16_t*)(p.ws + WS_H2);
    const int* idx = (const int*)(p.ws + WS_IDX);
    bf16_t* hid = (bf16_t*)(p.ws + WS_HID);
    constexpr int TPC = NU / 8;
#ifdef GU_FORCE_HALF
    constexpr int HT = GU_FORCE_HALF;
#else
    constexpr int HT = (NU % 8 == 0 && TPC % 32 == 16) ? 16 : 0;
#endif
    constexpr int UPC = TPC + HT;
    const bool chunked = (gridDim.x & 7) == 0 && (NU & 7) == 0;
    const UnitIter it = unit_iter(chunked ? 8 * UPC : NU);
    for (int uu = it.i; uu < it.end; uu += it.step) {
        int u = uu, half = -1;
        if (chunked) { const int x = uu / UPC, v = uu % UPC; if (v < TPC - HT) u = x * TPC + v; else { const int hv = v - (TPC - HT); u = x * TPC + (TPC - HT) + (hv >> 1); half = hv & 1; } }
        const int rb = u % NRB, cbk = (u / NRB) % NCB, e = u / (NRB * NCB);
        const int* ip = idx + e * SLOTS + rb * 256 + (tid >> 3);
        const unsigned a0 = ((unsigned)ip[0] * D + (tid & 7) * 8) * 2, a1 = ((unsigned)ip[64] * D + (tid & 7) * 8) * 2;
        const unsigned a2 = ((unsigned)ip[128] * D + (tid & 7) * 8) * 2, a3 = ((unsigned)ip[192] * D + (tid & 7) * 8) * 2;
#ifdef EMU
        const int bw = tid >> 6;
#else
        const int bw = __builtin_amdgcn_readfirstlane(tid >> 6);
#endif
        const int is_up = bw & 1;
        const float* wmat = (is_up ? p.in[I_WU] : p.in[I_WG]) + ((size_t)l * NEXP + e) * D * EH;
        if (half < 0) {
        const int bkr = 2 * (bw >> 1) + ((tid >> 5) & 1), hc = 4 * (tid & 31);
        const int ncol = (hc >> 6) * 128 + (2 * ((hc >> 5) & 1) + is_up) * 32 + (hc & 31);
        const unsigned bvo = (unsigned)(cbk * 128 + hc) * 4 + (unsigned)bkr * (EH * 4);
        const unsigned blds = (unsigned)bkr * 576u + (unsigned)ncol * 2u;
        gemm_tile<4, VAR>(smem, make_rsrc(h2), a0, a1, a2, a3, make_rsrc(wmat), bvo, blds, EH * 4, D, [&](f16v (&acc)[4][2]) {
            int lane_e = lane; VGPR_PIN(lane_e); const int lane = lane_e, l31 = lane_e & 31, h = lane_e >> 5; (void)l31; (void)h;
            char* stg = wave_stage_ptr(smem, wave);
#pragma unroll
            for (int tt = 0; tt < 2; ++tt)
#pragma unroll
                for (int pr = 0; pr < 2; ++pr)
#pragma unroll
                    for (int g = 0; g < 4; ++g) {
                        float o[4];
#pragma unroll
                        for (int q = 0; q < 4; ++q) o[q] = siluf_(acc[2 * pr][tt][4 * g + q]) * acc[2 * pr + 1][tt][4 * g + q];
                        stage64_write4(stg, tt * 32 + l31, pr * 32 + 8 * g + 4 * h, o[0], o[1], o[2], o[3]);
                    }
            stage64_flush_bf16(stg, hid + ((size_t)e * SLOTS + rb * 256 + wm * 64) * EH + cbk * 128 + wn * 64, EH, lane);
        });
        } else {
        const int bkr = 4 * (bw >> 1) + ((tid >> 4) & 3), hc = 4 * (tid & 15);
        const int ncol = (hc >> 5) * 64 + is_up * 32 + (hc & 31);
        const unsigned bvo = (unsigned)(cbk * 128 + half * 64 + hc) * 4 + (unsigned)bkr * (EH * 4);
        const unsigned blds = (unsigned)bkr * 320u + (unsigned)ncol * 2u;
        gemm_tile<2, VAR>(smem, make_rsrc(h2), a0, a1, a2, a3, make_rsrc(wmat), bvo, blds, EH * 4, D, [&](f16v (&acc)[2][2]) {
            int lane_e = lane; VGPR_PIN(lane_e); const int lane = lane_e, l31 = lane_e & 31, h = lane_e >> 5; (void)l31; (void)h;
            char* stg = wave_stage_ptr(smem, wave);
#pragma unroll
            for (int tt = 0; tt < 2; ++tt)
#pragma unroll
                for (int g = 0; g < 4; ++g) {
                    float o[4];
#pragma unroll
                    for (int q = 0; q < 4; ++q) o[q] = siluf_(acc[0][tt][4 * g + q]) * acc[1][tt][4 * g + q];
                    stage64_write4(stg, tt * 32 + l31, 8 * g + 4 * h, o[0], o[1], o[2], o[3]);
                }
            WAVE_SYNC();
            bf16_t* dst0 = hid + ((size_t)e * SLOTS + rb * 256 + wm * 64) * EH + cbk * 128 + half * 64 + wn * 32;
#pragma unroll
            for (int i = 0; i < 4; ++i) { const int r = (lane >> 2) + 16 * i, c = lane & 3; const u4v v = *(const u4v*)(stg + r * LROW + c * 16); *(u4v*)(dst0 + (size_t)r * EH + c * 8) = v; }
            WAVE_SYNC();
        });
        }
    }
}

template <int VAR>
DEV void phase_down(const Params& p, char* smem, int l) {
    constexpr int NRB = SLOTS / 256, NCB = D / 256, NU = NEXP * NCB * NRB;
    const int tid = get_tid(), lane = tid & 63, wave = tid >> 6, wm = wave & 3, wn = wave >> 2, h = lane >> 5, l31 = lane & 31;
    const bf16_t* hid = (const bf16_t*)(p.ws + WS_HID);
    const float* gsel = (const float*)(p.ws + WS_GSEL);
    bf16_t* ye = (bf16_t*)(p.ws + WS_YE);
    const UnitIter it = unit_iter(NU);
    for (int u = it.i; u < it.end; u += it.step) {
        const int rb = u % NRB, cbk = (u / NRB) % NCB, e = u / (NRB * NCB);
        const unsigned ao = ((unsigned)(rb * 256 + (tid >> 3)) * EH + (tid & 7) * 8) * 2;
        const unsigned bvo = (unsigned)(cbk * 256 + 4 * (tid & 63)) * 4 + (unsigned)(tid >> 6) * (D * 4);
        const unsigned blds = (unsigned)(tid >> 6) * 576u + (unsigned)(tid & 63) * 8u;
        gemm_tile<4, VAR>(smem, make_rsrc(hid + (size_t)e * SLOTS * EH), ao, ao + 128u * EH, ao + 256u * EH, ao + 384u * EH, make_rsrc(p.in[I_WD] + ((size_t)l * NEXP + e) * EH * D), bvo, blds, D * 4, EH, [&](f16v (&acc)[4][2]) {
            int lane_e = lane; VGPR_PIN(lane_e); const int lane = lane_e, l31 = lane_e & 31, h = lane_e >> 5; (void)l31; (void)h;
            char* stg = wave_stage_ptr(smem, wave);
            const float gs0 = gsel[e * SLOTS + rb * 256 + wm * 64 + l31], gs1 = gsel[e * SLOTS + rb * 256 + wm * 64 + 32 + l31];
#pragma unroll
            for (int hb = 0; hb < 2; ++hb) {
#pragma unroll
                for (int tt = 0; tt < 2; ++tt) {
                    const float gs = tt ? gs1 : gs0;
#pragma unroll
                    for (int f2 = 0; f2 < 2; ++f2)
#pragma unroll
                        for (int g = 0; g < 4; ++g) { const f16v& a = acc[2 * hb + f2][tt]; stage64_write4(stg, tt * 32 + l31, f2 * 32 + 8 * g + 4 * h, a[4 * g] * gs, a[4 * g + 1] * gs, a[4 * g + 2] * gs, a[4 * g + 3] * gs); }
                }
                stage64_flush_bf16(stg, ye + ((size_t)e * SLOTS + rb * 256 + wm * 64) * D + cbk * 256 + wn * 128 + hb * 64, D, lane);
            }
        });
    }
}

struct AttnDesc {
    const bf16_t* q; int qstride;
    int ntiles, n0;
    const bf16_t *k0, *v0; int stride0;
    const bf16_t *k1, *v1; int stride1;
    int na;
    int r0, rlo;
    const float* rpb;
    bf16_t* out; int ostride;
    float* part;
};
constexpr int ATT_TILE = 64 * LROW;
DEV int na_row_start(int r) { int s = r - KR / 2; s = s < 0 ? 0 : s; return s > ROWS - KR ? ROWS - KR : s; }
DEV void attn_unit(char* smem, const AttnDesc& d) {
    const int tid = get_tid(), lane = tid & 63, wave = tid >> 6, h = lane >> 5, l31 = lane & 31;
    char* Ks = smem; char* Vs = smem + 2 * ATT_TILE; float* rpbS = (float*)(smem + 4 * ATT_TILE);
    if (d.na) { for (int i = tid; i < 15 * 31; i += 512) rpbS[i] = d.rpb[i] * 1.4426950408889634f; }
    const bf16_t* qp = d.q + (size_t)(wave * 32 + l31) * d.qstride + h * 8;
    s8v qf[4];
#pragma unroll
    for (int s = 0; s < 4; ++s) qf[s] = *(const s8v*)(qp + 16 * s);
    float m_run = -1e30f, l_run = 0.f;
    f16v o[2]; o[0] = f16zero(); o[1] = f16zero();
    const int srow = tid >> 3, sch = tid & 7;
    u4v kreg, vreg;
    auto gload = [&](int t) {
        const bf16_t *kp, *vp;
        if (t < d.n0) { const size_t off = (size_t)(t * 64 + srow) * d.stride0 + sch * 8; kp = d.k0 + off; vp = d.v0 + off; }
        else { const size_t off = (size_t)((t - d.n0) * 64 + srow) * d.stride1 + sch * 8; kp = d.k1 + off; vp = d.v1 + off; }
        kreg = *(const u4v*)kp; vreg = *(const u4v*)vp;
    };
    auto lstore = [&](int buf) { *(u4v*)(Ks + buf * ATT_TILE + srow * LROW + sch * 16) = kreg; *(u4v*)(Vs + buf * ATT_TILE + srow * LROW + sch * 16) = vreg; };
    const int qr = d.r0 + (wave >> 1), qw = (wave & 1) * 32 + l31;
    const int rs = na_row_start(qr);
    int cs = qw - KC / 2; cs = cs < 0 ? 0 : (cs > GRIDW - KC ? GRIDW - KC : cs);
    gload(0); lstore(0);
    __syncthreads();
    for (int t = 0; t < d.ntiles; ++t) {
        const int buf = t & 1;
        if (t + 1 < d.ntiles) gload(t + 1);
        const bool local = d.na && t >= d.n0;
        const int kr = d.rlo + (t - d.n0);
        const bool active = !local || (kr >= rs && kr < rs + KR);
        if (active) {
            const char* kb = Ks + buf * ATT_TILE + l31 * LROW + h * 16;
            f16v sa[2];
#pragma unroll
            for (int kt = 0; kt < 2; ++kt) {
                sa[kt] = f16zero();
#pragma unroll
                for (int s = 0; s < 4; ++s) { const s8v kf = *(const s8v*)(kb + kt * 32 * LROW + s * 32); sa[kt] = mfma32(kf, qf[s], sa[kt]); }
            }
            constexpr float C2 = ATT_SCALE * 1.4426950408889634f;
            float mx = -1e30f;
            if (local) {
#pragma unroll
                for (int kt = 0; kt < 2; ++kt)
#pragma unroll
                    for (int r = 0; r < 16; ++r) {
                        const int kc = kt * 32 + (r & 3) + 8 * (r >> 2) + 4 * h;
                        const bool inw = kc >= cs && kc < cs + KC;
                        const int bi = (kr - qr + 7) * 31 + (kc - qw + 15);
                        const float v = inw ? sa[kt][r] * C2 + rpbS[inw ? bi : 0] : -1e30f;
                        sa[kt][r] = v; mx = fmaxf(mx, v);
                    }
            } else {
#pragma unroll
                for (int kt = 0; kt < 2; ++kt)
#pragma unroll
                    for (int r = 0; r < 16; ++r) mx = fmaxf(mx, sa[kt][r]);
                mx *= C2;
            }
            mx = fmaxf(mx, __shfl_xor(mx, 32));
            if (__ballot(mx > m_run) != 0ull) {
                const float m_new = fmaxf(m_run, mx);
                const float alpha = fexp2(m_run - m_new);
                l_run *= alpha; m_run = m_new;
                o[0] *= alpha; o[1] *= alpha;
            }
            float ps = 0.f;
            if (local) {
#pragma unroll
                for (int kt = 0; kt < 2; ++kt)
#pragma unroll
                    for (int r = 0; r < 16; ++r) { const float pv = fexp2(sa[kt][r] - m_run); sa[kt][r] = pv; ps += pv; }
            } else {
#pragma unroll
                for (int kt = 0; kt < 2; ++kt)
#pragma unroll
                    for (int r = 0; r < 16; ++r) { const float pv = fexp2(sa[kt][r] * C2 - m_run); sa[kt][r] = pv; ps += pv; }
            }
            l_run += ps;
            const char* vb = Vs + buf * ATT_TILE + (4 * h + ((lane & 15) >> 2)) * LROW + (((lane >> 4) & 1) * 16 + 4 * (lane & 3)) * 2;
#pragma unroll
            for (int ks = 0; ks < 4; ++ks) {
                const int kt = ks >> 1, rb = 8 * (ks & 1);
                u4v pk; pk[0] = pack2(sa[kt][rb], sa[kt][rb + 1]); pk[1] = pack2(sa[kt][rb + 2], sa[kt][rb + 3]);
                pk[2] = pack2(sa[kt][rb + 4], sa[kt][rb + 5]); pk[3] = pack2(sa[kt][rb + 6], sa[kt][rb + 7]);
                const s8v pf = __builtin_bit_cast(s8v, pk);
                const char* vk = vb + (kt * 32 + 16 * (ks & 1)) * LROW;
#pragma unroll
                for (int dt = 0; dt < 2; ++dt) {
                    const s4v lo = lds_tr16(vk + dt * 64), hi = lds_tr16(vk + 8 * LROW + dt * 64);
                    s8v vf; vf[0] = lo[0]; vf[1] = lo[1]; vf[2] = lo[2]; vf[3] = lo[3]; vf[4] = hi[0]; vf[5] = hi[1]; vf[6] = hi[2]; vf[7] = hi[3];
                    o[dt] = mfma32(vf, pf, o[dt]);
                }
            }
        }
        if (t + 1 < d.ntiles) lstore(buf ^ 1);
        __syncthreads();
    }
    const float l_tot = l_run + __shfl_xor(l_run, 32);
    const int qrow = wave * 32 + l31;
    if (d.part) {
        float* po = d.part + (size_t)qrow * 64;
#pragma unroll
        for (int dt = 0; dt < 2; ++dt)
#pragma unroll
            for (int g = 0; g < 4; ++g) { f4v v; v[0] = o[dt][4 * g]; v[1] = o[dt][4 * g + 1]; v[2] = o[dt][4 * g + 2]; v[3] = o[dt][4 * g + 3]; *(f4v*)(po + dt * 32 + 8 * g + 4 * h) = v; }
        if (h == 0) { d.part[256 * 64 + qrow] = m_run; d.part[256 * 64 + 256 + qrow] = l_tot; }
    } else {
        const float inv = 1.f / l_tot;
        bf16_t* po = d.out + (size_t)qrow * d.ostride;
#pragma unroll
        for (int dt = 0; dt < 2; ++dt)
#pragma unroll
            for (int g = 0; g < 4; ++g) {
                u2v pk; pk[0] = pack2(o[dt][4 * g] * inv, o[dt][4 * g + 1] * inv); pk[1] = pack2(o[dt][4 * g + 2] * inv, o[dt][4 * g + 3] * inv);
                *(u2v*)(po + dt * 32 + 8 * g + 4 * h) = pk;
            }
    }
}

DEV int ml_sidx(int grp, int b, int head, int c) { return grp == 0 ? ((b * MLH + head) * NCH_P + c) : BATCH * MLH * NCH_P + ((b * MLH + head) * NCH_S + c); }
DEV float lane_prefix_sum(float v, int lane) { for (int dlt = 1; dlt < 64; dlt <<= 1) { const float o = __shfl(v, lane - dlt); if (lane >= dlt) v += o; } return v; }
DEV float lane_prefix_max(float v, int lane) { for (int dlt = 1; dlt < 64; dlt <<= 1) { const float o = __shfl(v, lane - dlt); if (lane >= dlt) v = fmaxf(v, o); } return v; }

DEV void mlstm_summary_unit(const Params& p, char* smem, int grp, int b, int head, int c) {
    const int tid = get_tid(), lane = tid & 63, wave = tid >> 6, h = lane >> 5, l31 = lane & 31;
    char* KT = smem;
    char* VT = smem + 2 * ATT_TILE;
    float* wsS = (float*)(smem + 3 * ATT_TILE);
    float* scal = wsS + 128;
    const int tb = (grp == 0 ? b * SEQ : NP + b * DEC_SEQ) + c * 64;
    const float* gates = (const float*)(p.ws + WS_GATES);
    if (wave == 0) {
        const float* gr = gates + (size_t)(tb + lane) * 16;
        const float i_f = gr[head], lf_f = logsigmoidf_(gr[4 + head]), i_b = gr[8 + head], lf_b = logsigmoidf_(gr[12 + head]);
        const float pf = lane_prefix_sum(lf_f, lane), pb = lane_prefix_sum(lf_b, lane);
        const float tot_f = __shfl(pf, 63), tot_b = __shfl(pb, 63);
        const float g_f = (tot_f - pf) + i_f, g_b = (pb - lf_b) + i_b;
        const float G_f = wave_max(g_f), G_b = wave_max(g_b);
        wsS[lane] = fexp(g_f - G_f); wsS[64 + lane] = fexp(g_b - G_b);
        if (lane == 0) { scal[0] = tot_f; scal[1] = tot_b; scal[2] = G_f; scal[3] = G_b; }
    }
    __syncthreads();
    {
        const int tau = tid >> 3, ch = tid & 7;
        const u4v kv = *(const u4v*)((const bf16_t*)(p.ws + WS_MLK) + (size_t)(tb + tau) * 256 + head * 64 + ch * 8);
        const u4v vv = *(const u4v*)((const bf16_t*)(p.ws + WS_MLV) + (size_t)(tb + tau) * 256 + head * 64 + ch * 8);
        const float wf = wsS[tau], wb = wsS[64 + tau];
#pragma unroll
        for (int j = 0; j < 8; ++j) {
            const bf16_t kb = (bf16_t)(kv[j >> 1] >> (16 * (j & 1))), vb = (bf16_t)(vv[j >> 1] >> (16 * (j & 1)));
            const int dim = ch * 8 + j; const float kf = bf2f(kb);
            *(bf16_t*)(KT + dim * LROW + tau * 2) = f2bf(kf * wf);
            *(bf16_t*)(KT + ATT_TILE + dim * LROW + tau * 2) = f2bf(kf * wb);
            *(bf16_t*)(VT + dim * LROW + tau * 2) = vb;
        }
    }
    __syncthreads();
    float* sum = (float*)(p.ws + WS_MLSUM);
    const int sidx = ml_sidx(grp, b, head, c);
    {
        const int dir = wave >> 2, mi = (wave >> 1) & 1, ni = wave & 1;
        f16v acc = f16zero();
#pragma unroll
        for (int s = 0; s < 4; ++s) {
            const s8v af = *(const s8v*)(KT + dir * ATT_TILE + (mi * 32 + l31) * LROW + (16 * s + 8 * h) * 2);
            const s8v bf = *(const s8v*)(VT + (ni * 32 + l31) * LROW + (16 * s + 8 * h) * 2);
            acc = mfma32(af, bf, acc);
        }
        bf16_t* U = (bf16_t*)(sum + (size_t)(sidx * 2 + dir) * MLSUM_STRIDE);
#pragma unroll
        for (int r = 0; r < 16; ++r) U[(mi * 32 + (r & 3) + 8 * (r >> 2) + 4 * h) * 64 + ni * 32 + l31] = f2bf(acc[r]);
    }
    if (tid < 128) {
        const int dir = tid >> 6, kd = tid & 63;
        float s = 0.f;
        for (int tau = 0; tau < 64; ++tau) s += bf2f(*(const bf16_t*)(KT + dir * ATT_TILE + kd * LROW + tau * 2));
        float* E = sum + (size_t)(sidx * 2 + dir) * MLSUM_STRIDE;
        E[ML_NU + kd] = s;
        if (kd == 0) { E[ML_AG] = scal[dir]; E[ML_AG + 1] = scal[2 + dir]; }
    }
    __syncthreads();
}

DEV void mlstm_output_unit(const Params& p, char* smem, int l, int grp, int b, int head, int c) {
    const int tid = get_tid(), lane = tid & 63, wave = tid >> 6, h = lane >> 5, l31 = lane & 31;
    const int nc = grp ? NCH_S : NCH_P;
    char* Qs = smem;
    char* Ks = smem + 2 * ATT_TILE;
    char* VT = smem + 4 * ATT_TILE;
    char* CT = smem + 6 * ATT_TILE;
    char* QK = smem + 8 * ATT_TILE;
    float* hS = (float*)(smem + 10 * ATT_TILE);
    float* vec = hS + 2 * 64 * 68;
    float* aS = vec; float* MjS = vec + 128; float* bS = vec + 256; float* nS = vec + 384; float* denp = vec + 512; float* qnS = vec + 768; float* scal = vec + 896;
    const int tb = (grp == 0 ? b * SEQ : NP + b * DEC_SEQ) + c * 64;
    const float* sum = (const float*)(p.ws + WS_MLSUM);
    const size_t qoff = (size_t)(tb + (tid >> 3)) * 256 + head * 64 + (tid & 7) * 8;
    const u4v q_r = *(const u4v*)((const bf16_t*)(p.ws + WS_MLQ) + qoff);
    const u4v k_r = *(const u4v*)((const bf16_t*)(p.ws + WS_MLK) + qoff);
    const u4v v_r = *(const u4v*)((const bf16_t*)(p.ws + WS_MLV) + qoff);
    const u4v o_r = *(const u4v*)((const bf16_t*)(p.ws + WS_MLO) + qoff);
    float g_i = 0.f, g_f = 0.f;
    if (wave < 2) { const float* gr = (const float*)(p.ws + WS_GATES) + (size_t)(tb + (wave ? 63 - lane : lane)) * 16; g_i = gr[wave * 8 + head]; g_f = gr[wave * 8 + 4 + head]; }
#pragma unroll
    for (int dir = 0; dir < 2; ++dir) {
        float C[8], nst = 0.f, m;
        if (grp == 0) {
#pragma unroll
            for (int i = 0; i < 8; ++i) C[i] = 0.f;
            m = 0.f;
        } else {
            const size_t sb = (((size_t)b * DEPTH + l) * 2 + dir) * MLH + head;
#pragma unroll
            for (int i = 0; i < 8; ++i) C[i] = p.in[I_SC][sb * 4096 + 8 * tid + i];
            if (tid < 64) nst = p.in[I_SN][sb * 64 + tid];
            m = p.in[I_SM][sb];
        }
        const int nsteps = dir == 0 ? c : nc - 1 - c;
        const bool fin = (grp == 0) && (dir == 0 ? c == nc - 1 : c == 0);
        {
            float A = 0.f, G = -1e30f;
            if (lane < nsteps) { const float* E = sum + (size_t)(ml_sidx(grp, b, head, dir == 0 ? lane : nc - 1 - lane) * 2 + dir) * MLSUM_STRIDE; A = E[ML_AG]; G = E[ML_AG + 1]; }
            const float P = lane_prefix_sum(A, lane);
            const float T = __shfl(P, 63);
            const float ev = lane < nsteps ? G + (T - P) : -1e30f;
            const float mc = fmaxf(m + T, wave_max(ev));
            const float coef = lane < nsteps ? fexp(ev - mc) : 0.f;
            const float coef0 = fexp(m + T - mc);
#pragma unroll
            for (int i = 0; i < 8; ++i) C[i] *= coef0;
            nst *= coef0;
#pragma unroll 4
            for (int st = 0; st < nsteps; ++st) {
                const float* E = sum + (size_t)(ml_sidx(grp, b, head, dir == 0 ? st : nc - 1 - st) * 2 + dir) * MLSUM_STRIDE;
                const float cf = __shfl(coef, st);
                const u4v uu = *(const u4v*)((const bf16_t*)E + 8 * tid);
#pragma unroll
                for (int i = 0; i < 8; ++i) C[i] += cf * bf2f((bf16_t)(uu[i >> 1] >> (16 * (i & 1))));
                if (tid < 64) nst += cf * E[ML_NU + tid];
            }
            m = mc;
        }
#pragma unroll
        for (int i = 0; i < 8; ++i) { const int e = 8 * tid + i; *(bf16_t*)(CT + dir * ATT_TILE + (e & 63) * LROW + (e >> 6) * 2) = f2bf(C[i]); }
        if (tid < 64) nS[dir * 64 + tid] = nst;
        if (tid == 0) scal[dir] = m;
        if (fin) {
            const float* E = sum + (size_t)(ml_sidx(grp, b, head, c) * 2 + dir) * MLSUM_STRIDE;
            const float A = E[ML_AG], G = E[ML_AG + 1];
            const float m_new = fmaxf(A + m, G);
            const float sc = fexp(A + m - m_new), su = fexp(G - m_new);
            const size_t ob = (((size_t)b * DEPTH + l) * 2 + dir) * MLH + head;
            const u4v uo = *(const u4v*)((const bf16_t*)E + 8 * tid);
#pragma unroll
            for (int i = 0; i < 8; ++i) p.out[O_MC + ob * 4096 + 8 * tid + i] = sc * C[i] + su * bf2f((bf16_t)(uo[i >> 1] >> (16 * (i & 1))));
            if (tid < 64) p.out[O_MN + ob * 64 + tid] = sc * nst + su * E[ML_NU + tid];
            if (tid == 0) p.out[O_MM + ob] = m_new;
        }
    }
    {
        const int row = tid >> 3, ch = tid & 7;
#pragma unroll
        for (int dir = 0; dir < 2; ++dir) {
            const int pr = dir ? 63 - row : row;
            *(u4v*)(Qs + dir * ATT_TILE + pr * LROW + ch * 16) = q_r;
            *(u4v*)(Ks + dir * ATT_TILE + pr * LROW + ch * 16) = k_r;
#pragma unroll
            for (int j = 0; j < 8; ++j) *(bf16_t*)(VT + dir * ATT_TILE + (ch * 8 + j) * LROW + pr * 2) = (bf16_t)(v_r[j >> 1] >> (16 * (j & 1)));
        }
    }
    __syncthreads();
    if (wave < 2) {
        const int dir = wave;
        const float ig = g_i, lf = logsigmoidf_(g_f);
        const float bj = lane_prefix_sum(lf, lane);
        const float a = ig - bj;
        const float Pj = lane_prefix_max(a, lane);
        aS[dir * 64 + lane] = a; bS[dir * 64 + lane] = bj; MjS[dir * 64 + lane] = fmaxf(scal[dir], Pj);
    } else if (wave < 4) {
        const int dir = wave - 2;
        float s = 0.f;
        for (int k = 0; k < 64; ++k) s += bf2f(*(const bf16_t*)(Qs + dir * ATT_TILE + lane * LROW + k * 2)) * nS[dir * 64 + k];
        qnS[dir * 64 + lane] = s;
    }
    __syncthreads();
    const int dir = wave >> 2, rt = (wave >> 1) & 1, jt = wave & 1;
    const int j = jt * 32 + l31;
    const float Mj = MjS[dir * 64 + j];
    {
        f16v acc = f16zero();
#pragma unroll
        for (int s4 = 0; s4 < 4; ++s4) {
            const s8v af = *(const s8v*)(Ks + dir * ATT_TILE + (rt * 32 + l31) * LROW + (16 * s4 + 8 * h) * 2);
            const s8v bf = *(const s8v*)(Qs + dir * ATT_TILE + j * LROW + (16 * s4 + 8 * h) * 2);
            acc = mfma32(af, bf, acc);
        }
        float dsum = 0.f;
#pragma unroll
        for (int g = 0; g < 4; ++g) {
            float o[4];
#pragma unroll
            for (int q = 0; q < 4; ++q) {
                const int s = rt * 32 + 8 * g + 4 * h + q;
                const float w = s <= j ? fexp(aS[dir * 64 + s] - Mj) : 0.f;
                o[q] = acc[4 * g + q] * w; dsum += o[q];
            }
            u2v pk; pk[0] = pack2(o[0], o[1]); pk[1] = pack2(o[2], o[3]);
            *(u2v*)(QK + dir * ATT_TILE + j * LROW + (rt * 32 + 8 * g + 4 * h) * 2) = pk;
        }
        dsum += __shfl_xor(dsum, 32);
        if (h == 0) denp[(dir * 2 + rt) * 64 + j] = dsum;
    }
    __syncthreads();
    {
        const float mst = scal[dir];
        const float decay = fexp(mst - Mj);
        f16v acc = f16zero();
#pragma unroll
        for (int s4 = 0; s4 < 4; ++s4) {
            const s8v af = *(const s8v*)(CT + dir * ATT_TILE + (rt * 32 + l31) * LROW + (16 * s4 + 8 * h) * 2);
            const s8v bf = *(const s8v*)(Qs + dir * ATT_TILE + j * LROW + (16 * s4 + 8 * h) * 2);
            acc = mfma32(af, bf, acc);
        }
        acc *= decay;
#pragma unroll
        for (int s4 = 0; s4 < 4; ++s4) {
            const s8v af = *(const s8v*)(VT + dir * ATT_TILE + (rt * 32 + l31) * LROW + (16 * s4 + 8 * h) * 2);
            const s8v bf = *(const s8v*)(QK + dir * ATT_TILE + j * LROW + (16 * s4 + 8 * h) * 2);
            acc = mfma32(af, bf, acc);
        }
        const float den = decay * qnS[dir * 64 + j] + denp[(dir * 2) * 64 + j] + denp[(dir * 2 + 1) * 64 + j];
        const float dn = fmaxf(fabsf(den), fexp(-(bS[dir * 64 + j] + Mj)));
        const float inv = 1.f / dn;
#pragma unroll
        for (int g = 0; g < 4; ++g) { f4v o; o[0] = acc[4 * g] * inv; o[1] = acc[4 * g + 1] * inv; o[2] = acc[4 * g + 2] * inv; o[3] = acc[4 * g + 3] * inv;
            *(f4v*)(hS + (dir * 64 + j) * 68 + rt * 32 + 8 * g + 4 * h) = o; }
    }
    __syncthreads();
    {
        const int tau = tid >> 3, v8 = (tid & 7) * 8;
        float hv[8]; float s = 0.f;
#pragma unroll
        for (int q = 0; q < 8; ++q) { hv[q] = hS[tau * 68 + v8 + q] + hS[(64 + 63 - tau) * 68 + v8 + q]; s += hv[q]; }
        s += __shfl_xor(s, 1); s += __shfl_xor(s, 2); s += __shfl_xor(s, 4);
        const float mu = s * (1.f / 64.f);
        float qq = 0.f;
#pragma unroll
        for (int q = 0; q < 8; ++q) { const float dlt = hv[q] - mu; qq += dlt * dlt; }
        qq += __shfl_xor(qq, 1); qq += __shfl_xor(qq, 2); qq += __shfl_xor(qq, 4);
        const float rstd = frsqrt(qq * (1.f / 64.f) + EPS);
        const int t = tb + tau;
        const u4v ov = o_r;
        const float* ng = p.in[I_MLG] + (size_t)l * 256 + head * 64 + v8;
        float o[8];
#pragma unroll
        for (int q = 0; q < 8; ++q) { const float og = bf2f((bf16_t)(ov[q >> 1] >> (16 * (q & 1)))); o[q] = (hv[q] - mu) * rstd * ng[q] * sigmoidf_(og); }
        u4v pk; pk[0] = pack2(o[0], o[1]); pk[1] = pack2(o[2], o[3]); pk[2] = pack2(o[4], o[5]); pk[3] = pack2(o[6], o[7]);
        *(u4v*)((bf16_t*)(p.ws + WS_MIXED) + (size_t)t * MIXW + 384 + head * 64 + v8) = pk;
    }
    __syncthreads();
}

DEV int queue_next(const Params& p, char* smem, int qi) {
    int* slot = (int*)(smem + SMEM_XB + 32);
    __syncthreads();
    if (threadIdx.x == 0) {
#ifdef EMU
        unsigned* w = (unsigned*)(p.ws + WS_BAR) + QUEUE_WORD0 + 64 * qi; *slot = (int)(*w)++;
#else
        *slot = (int)__hip_atomic_fetch_add((unsigned*)(p.ws + WS_BAR) + QUEUE_WORD0 + 64 * qi, 1u, __ATOMIC_RELAXED, __HIP_MEMORY_SCOPE_AGENT);
#endif
    }
    __syncthreads();
    return *slot;
}
DEV void phase_attn(const Params& p, char* smem, int l, int qi) {
    constexpr int QB_S = DEC_SEQ / 256, QB_P = SEQ / 256;
    constexpr int U_SG = DEC_BATCH * GQH * QB_S * 2, U_SN = DEC_BATCH * NAH * QB_S, U_PN = BATCH * NAH * QB_P, U_PG = BATCH * GQH * QB_P;
    constexpr int U_MP = BATCH * MLH * NCH_P, U_MS = DEC_BATCH * MLH * NCH_S;
    constexpr int NU = U_SG + U_SN + U_PN + U_PG + U_MP + U_MS;
    const bf16_t* naq = (const bf16_t*)(p.ws + WS_NAQ); const bf16_t* nak = (const bf16_t*)(p.ws + WS_NAK); const bf16_t* nav = (const bf16_t*)(p.ws + WS_NAV);
    const bf16_t* gqq = (const bf16_t*)(p.ws + WS_GQQ); const bf16_t* gqk = (const bf16_t*)(p.ws + WS_GQK); const bf16_t* gqv = (const bf16_t*)(p.ws + WS_GQV);
    bf16_t* mixed = (bf16_t*)(p.ws + WS_MIXED);
    for (;;) {
        int u = queue_next(p, smem, qi);
        if (u >= NU) break;
#ifdef PROBE_ATT
        if (qi >= 8) { const int cls = u < U_SG ? 1 : u < U_SG + U_SN ? 2 : u < U_SG + U_SN + U_PN + U_PG ? 3 : 4; if (cls != PROBE_ATT) continue; }
#endif
        AttnDesc d; d.na = 0; d.r0 = 0; d.rlo = 0; d.rpb = nullptr; d.part = nullptr; d.out = nullptr; d.ostride = MIXW; d.n0 = 0; d.k0 = d.v0 = nullptr; d.stride0 = 0;
        if (u < U_SG) {
            const int half = u & 1, qb = (u >> 1) % QB_S, qh = (u / (2 * QB_S)) % GQH, b = u / (2 * QB_S * GQH);
            const int kvh = qh / (GQH / GQKV);
            constexpr int NCT = PAST / 64, TT = NCT + DEC_SEQ / 64, H0 = TT / 2;
            const size_t tq = (size_t)NP + (size_t)b * DEC_SEQ + qb * 256;
            d.q = gqq + tq * 384 + qh * 64; d.qstride = 384;
            const bf16_t* lk = gqk + ((size_t)NP + (size_t)b * DEC_SEQ) * 128 + kvh * 64; const bf16_t* lv = gqv + ((size_t)NP + (size_t)b * DEC_SEQ) * 128 + kvh * 64;
            if (half == 0) {
                d.n0 = NCT; d.ntiles = H0; d.stride0 = 128;
                const size_t co = (((size_t)b * DEPTH + l) * PAST) * 128 + kvh * 64;
                d.k0 = (const bf16_t*)(p.ws + WS_CGQK) + co; d.v0 = (const bf16_t*)(p.ws + WS_CGQV) + co;
                d.k1 = lk; d.v1 = lv; d.stride1 = 128;
            } else {
                d.n0 = 0; d.ntiles = TT - H0; d.stride1 = 128;
                d.k1 = lk + (size_t)(H0 - NCT) * 64 * 128; d.v1 = lv + (size_t)(H0 - NCT) * 64 * 128;
            }
            d.part = (float*)(p.ws + WS_PART) + (size_t)u * PART_STRIDE;
        } else if (u < U_SG + U_SN) {
            const int uu = u - U_SG; const int qb = uu % QB_S, hd = (uu / QB_S) % NAH, b = uu / (QB_S * NAH);
            const size_t t0 = (size_t)NP + (size_t)b * DEC_SEQ;
            d.q = naq + (t0 + qb * 256) * 384 + hd * 64; d.qstride = 384;
            d.na = 1; d.r0 = qb * 4; d.rlo = na_row_start(d.r0);
            const int rhi = na_row_start(d.r0 + 3) + KR;
            d.n0 = PAST / 64; d.ntiles = d.n0 + (rhi - d.rlo); d.stride0 = 384; d.stride1 = 384;
            const size_t co = (((size_t)b * DEPTH + l) * PAST) * 384 + hd * 64;
            d.k0 = (const bf16_t*)(p.ws + WS_CNAK) + co; d.v0 = (const bf16_t*)(p.ws + WS_CNAV) + co;
            d.k1 = nak + (t0 + (size_t)d.rlo * 64) * 384 + hd * 64; d.v1 = nav + (t0 + (size_t)d.rlo * 64) * 384 + hd * 64;
            d.rpb = p.in[I_RPB] + ((size_t)l * NAH + hd) * 15 * 31;
            d.out = mixed + (t0 + qb * 256) * MIXW + hd * 64;
        } else if (u < U_SG + U_SN + U_PN) {
            const int uu = u - U_SG - U_SN; const int qb = uu % QB_P, hd = (uu / QB_P) % NAH, b = uu / (QB_P * NAH);
            const size_t t0 = (size_t)b * SEQ;
            d.q = naq + (t0 + qb * 256) * 384 + hd * 64; d.qstride = 384;
            d.n0 = 0; d.ntiles = SEQ / 64; d.stride1 = 384; d.k1 = nak + t0 * 384 + hd * 64; d.v1 = nav + t0 * 384 + hd * 64;
            d.out = mixed + (t0 + qb * 256) * MIXW + hd * 64;
        } else if (u < U_SG + U_SN + U_PN + U_PG) {
            const int uu = u - U_SG - U_SN - U_PN; const int qb = uu % QB_P, qh = (uu / QB_P) % GQH, b = uu / (QB_P * GQH);
            const int kvh = qh / (GQH / GQKV);
            const size_t t0 = (size_t)b * SEQ;
            d.q = gqq + (t0 + qb * 256) * 384 + qh * 64; d.qstride = 384;
            d.n0 = 0; d.ntiles = SEQ / 64; d.stride1 = 128; d.k1 = gqk + t0 * 128 + kvh * 64; d.v1 = gqv + t0 * 128 + kvh * 64;
            d.out = mixed + (t0 + qb * 256) * MIXW + 640 + qh * 64;
        } else {
            int uu = u - (U_SG + U_SN + U_PN + U_PG); const int grp = uu >= U_MP ? 1 : 0; if (grp) uu -= U_MP;
            const int nch = grp ? NCH_S : NCH_P;
            mlstm_summary_unit(p, smem, grp, uu / (nch * MLH), (uu / nch) % MLH, uu % nch);
        }
        if (u < U_SG + U_SN + U_PN + U_PG) attn_unit(smem, d);
    }
}

DEV void phase_mlout(const Params& p, char* smem, int l) {
    constexpr int QB_S = DEC_SEQ / 256;
    constexpr int U_MS = DEC_BATCH * MLH * NCH_S, U_MP = BATCH * MLH * NCH_P, U_CB = DEC_BATCH * GQH * QB_S;
    const int tid = get_tid(), lane = tid & 63, wave = tid >> 6;
    for (int tk = blockIdx.x + gridDim.x * wave; tk < U_CB * 4; tk += gridDim.x * 8) {
        const int uu = tk >> 2, sl = tk & 3;
        const int qb = uu % QB_S, qh = (uu / QB_S) % GQH, b = uu / (QB_S * GQH);
        const float* p0 = (const float*)(p.ws + WS_PART) + (size_t)(2 * uu) * PART_STRIDE; const float* p1 = p0 + PART_STRIDE;
        const int q = sl * 64 + (lane >> 1) + 32 * 0, d0 = (lane & 1) * 32;
#pragma unroll
        for (int hq = 0; hq < 2; ++hq) {
            const int qq = q + 32 * hq;
            const float m0 = p0[256 * 64 + qq], m1 = p1[256 * 64 + qq], l0 = p0[256 * 64 + 256 + qq], l1 = p1[256 * 64 + 256 + qq];
            const float m = fmaxf(m0, m1), w0 = fexp2(m0 - m), w1 = fexp2(m1 - m);
            const float inv = 1.f / (l0 * w0 + l1 * w1);
            bf16_t* dst = (bf16_t*)(p.ws + WS_MIXED) + ((size_t)NP + (size_t)b * DEC_SEQ + qb * 256 + qq) * MIXW + 640 + qh * 64 + d0;
#pragma unroll
            for (int i = 0; i < 8; ++i) {
                const f4v a = *(const f4v*)(p0 + (size_t)qq * 64 + d0 + 4 * i), bb = *(const f4v*)(p1 + (size_t)qq * 64 + d0 + 4 * i);
                u2v pk; pk[0] = pack2((a[0] * w0 + bb[0] * w1) * inv, (a[1] * w0 + bb[1] * w1) * inv); pk[1] = pack2((a[2] * w0 + bb[2] * w1) * inv, (a[3] * w0 + bb[3] * w1) * inv);
                *(u2v*)(dst + 4 * i) = pk;
            }
        }
    }
    for (int u = blockIdx.x; u < U_MS + U_MP; u += gridDim.x) {
        const int grp = u < U_MS ? 1 : 0; const int uu = grp ? u : u - U_MS; const int nch = grp ? NCH_S : NCH_P;
        mlstm_output_unit(p, smem, l, grp, uu / (nch * MLH), (uu / nch) % MLH, uu % nch);
    }
}

constexpr int N_PHASES = 2 + 9 * DEPTH;
#ifndef EMU
typedef const __attribute__((address_space(4))) Params* KParamsPtr;
DEV void load_params(Params& p) {
    KParamsPtr kp = (KParamsPtr)__builtin_amdgcn_kernarg_segment_ptr();
    asm volatile("" : "+s"(kp));
#pragma unroll
    for (int i = 0; i < N_IN; ++i) p.in[i] = kp->in[i];
    p.out = kp->out; p.ws = kp->ws; p.ph0 = kp->ph0; p.ph1 = kp->ph1;
}
#endif
#ifdef EMU
static char emu_smem[SMEM_BYTES + 64];
#endif
__global__ void __launch_bounds__(512, 2) mega_kernel(Params p_) {
    const int ph0 = p_.ph0, ph1 = p_.ph1;
#ifdef EMU
    char* smem = emu_smem;
#define GRID_SYNC() do {} while (0)
#else
    extern __shared__ __attribute__((aligned(16))) char smem[];
    if (threadIdx.x == 0) *(u4v*)(smem + SMEM_XB) = (u4v){0u, 0u, 0u, 0u};
    __syncthreads();
    (void)xcd_barrier_post((unsigned*)(p_.ws + WS_BAR), (volatile LAS unsigned*)(smem + SMEM_XB));
    const bool multi = (ph1 - ph0) > 1;
#define GRID_SYNC() do { if (multi) { KParamsPtr kpb = (KParamsPtr)__builtin_amdgcn_kernarg_segment_ptr(); asm volatile("" : "+s"(kpb)); \
        XcdBarrier xb; xb.bar = (unsigned*)(kpb->ws + WS_BAR); xb.x = xb_xcc_id(); xb.st = (volatile LAS unsigned*)(smem + SMEM_XB); xcd_barrier(xb); } } while (0)
#endif
    int ph = 0;
#ifndef KIND_MASK
#define KIND_MASK 0x3ff
#endif
#ifdef EMU
#define LOAD_PARAMS() const Params& p = p_
#else
#define LOAD_PARAMS() Params p; load_params(p)
#endif
#ifndef DOUBLE_MASK
#define DOUBLE_MASK 0
#endif
#define PH_KIND() (ph == 0 ? 0 : ph == 1 + 9 * DEPTH ? 1 : 1 + (ph - 1) % 9)
#define RUN_PHASE(body) do { if (((KIND_MASK >> PH_KIND()) & 1) && ph >= ph0 && ph < ph1) { \
    if (DOUBLE_MASK && ((DOUBLE_MASK >> PH_KIND()) & 1)) { { const int rep_ = 1; LOAD_PARAMS(); body; } GRID_SYNC(); } \
    { const int rep_ = 0; LOAD_PARAMS(); body; } if (ph + 1 < ph1) GRID_SYNC(); } ++ph; } while (0)
    RUN_PHASE(phase_ada(p, smem));
    for (int l = 0; l < DEPTH; ++l) {
        RUN_PHASE(phase_rows<0>(p, smem, l));
        RUN_PHASE(phase_inproj<0>(p, smem, l));
        RUN_PHASE(phase_attn(p, smem, l, l + DEPTH * rep_));
        RUN_PHASE(phase_mlout(p, smem, l));
        RUN_PHASE(phase_outproj<0>(p, smem, l));
        RUN_PHASE(phase_rows<1>(p, smem, l));
        RUN_PHASE(phase_topk(p, smem));
        RUN_PHASE(phase_gateup<0>(p, smem, l));
        RUN_PHASE(phase_down<0>(p, smem, l));
    }
    RUN_PHASE(phase_rows<0>(p, smem, DEPTH));
#ifdef PROBE_BARRIERS
    for (int i = 0; i < PROBE_BARRIERS; ++i) GRID_SYNC();
#endif
}

#if !defined(EMU) && defined(PROBE_KIND)
__global__ void __launch_bounds__(512, 2) probe_kernel(Params p) {
    extern __shared__ __attribute__((aligned(16))) char smem[];
    for (int r = 0; r < PROBE_REPS; ++r) {
#if PROBE_KIND == 8
        phase_gateup<PROBE_VAR>(p, smem, 1);
#elif PROBE_KIND == 9
        phase_down<PROBE_VAR>(p, smem, 1);
#elif PROBE_KIND == 2
        phase_inproj<PROBE_VAR>(p, smem, 1);
#elif PROBE_KIND == 5
        phase_outproj<PROBE_VAR>(p, smem, 1);
#elif PROBE_KIND == 0
        phase_ada(p, smem);
#elif PROBE_KIND == 1
        phase_rows<0>(p, smem, 1);
#elif PROBE_KIND == 6
        phase_rows<1>(p, smem, 1);
#elif PROBE_KIND == 7
        phase_topk(p, smem);
#elif PROBE_KIND == 3
        phase_attn(p, smem, 1, 8 + r);
#elif PROBE_KIND == 4
        phase_mlout(p, smem, 1);
#endif
        __syncthreads();
    }
}
#endif
#ifndef EMU
#ifndef MK_N_LAUNCHES
#define MK_N_LAUNCHES 1
#endif
extern "C" void kernel_launch(void* const* d_in, const int* in_sizes, int n_in, void* d_out, int out_size, void* d_ws, size_t ws_size, hipStream_t stream) {
    (void)in_sizes; (void)n_in; (void)out_size; (void)ws_size;
    static int grid = 0;
    if (!grid) {
        int dev = 0, cus = 0, per_cu = 0;
        (void)hipGetDevice(&dev);
        (void)hipDeviceGetAttribute(&cus, hipDeviceAttributeMultiprocessorCount, dev);
        (void)hipFuncSetAttribute((const void*)mega_kernel, hipFuncAttributeMaxDynamicSharedMemorySize, SMEM_BYTES);
        (void)hipOccupancyMaxActiveBlocksPerMultiprocessor(&per_cu, mega_kernel, 512, SMEM_BYTES);
        grid = cus * (per_cu < 1 ? per_cu : 1);
        if (grid <= 0) grid = cus;
    }
    (void)hipMemsetAsync((char*)d_ws + WS_BAR, 0, WS_BAR_BYTES, stream);
    Params p = {};
    for (int i = 0; i < N_IN; ++i) p.in[i] = (const float*)d_in[i];
    p.out = (float*)d_out; p.ws = (char*)d_ws;
#if MK_N_LAUNCHES == 1
    p.ph0 = 0; p.ph1 = N_PHASES;
    mega_kernel<<<dim3(grid), dim3(512), SMEM_BYTES, stream>>>(p);
#ifdef PROBE_KIND
    (void)hipFuncSetAttribute((const void*)probe_kernel, hipFuncAttributeMaxDynamicSharedMemorySize, SMEM_BYTES);
    probe_kernel<<<dim3(grid), dim3(512), SMEM_BYTES, stream>>>(p);
#endif
#else
    for (int ph = 0; ph < N_PHASES; ++ph) { p.ph0 = ph; p.ph1 = ph + 1; mega_kernel<<<dim3(grid), dim3(512), SMEM_BYTES, stream>>>(p); }
#endif
}
#endif
```

```cpp
#ifndef EMU
#include <hip/hip_runtime.h>
#define DEV __device__ __forceinline__
#else
#define DEV static inline __attribute__((always_inline))
#endif
#include <stdint.h>
#include <stddef.h>

#ifndef CFG_D
#define CFG_D 1024
#define CFG_BATCH 16
#define CFG_SEQ 256
#define CFG_DEC_BATCH 2
#define CFG_DEC_SEQ 2048
#define CFG_PAST 256
#define CFG_EH 2816
#endif
constexpr int D = CFG_D, BATCH = CFG_BATCH, SEQ = CFG_SEQ, DEC_BATCH = CFG_DEC_BATCH, DEC_SEQ = CFG_DEC_SEQ, PAST = CFG_PAST, EH = CFG_EH;
constexpr int DEPTH = 2, HD = 64, NAH = 6, MLH = 4, GQH = 6, GQKV = 2, NEXP = 16, GRIDW = 64;
constexpr int NP = BATCH * SEQ, NS = DEC_BATCH * DEC_SEQ, NT = NP + NS, NCOND = 1 + DEC_BATCH;
constexpr int PROJ_W = 2832, MIXW = 1024;
constexpr int CAP_P = SEQ / 8, CAP_S = DEC_SEQ / 8, SLOTS = BATCH * CAP_P + DEC_BATCH * CAP_S;
constexpr int ROWS = DEC_SEQ / GRIDW, KR = ROWS < 8 ? ROWS : 8, KC = 16;
constexpr int NCH_P = SEQ / 64, NCH_S = DEC_SEQ / 64;
constexpr float ALPHA = 1.41421356237309515f;
constexpr float ATT_SCALE = 0.125f;
constexpr float EPS = 1e-6f;
static_assert(SLOTS % 256 == 0 && NP % 256 == 0 && NS % 256 == 0 && SEQ % 256 == 0 && DEC_SEQ % 256 == 0, "tile divisibility");
static_assert(D % 256 == 0 && EH % 128 == 0 && PAST % 64 == 0, "tile divisibility");

typedef unsigned short bf16_t;
typedef short s8v __attribute__((ext_vector_type(8)));
typedef short s4v __attribute__((ext_vector_type(4)));
typedef float f16v __attribute__((ext_vector_type(16)));
typedef float f4v __attribute__((ext_vector_type(4)));
typedef unsigned u4v __attribute__((ext_vector_type(4)));
typedef unsigned u2v __attribute__((ext_vector_type(2)));

enum { I_XP = 0, I_XS, I_C, I_CNAK, I_CNAV, I_CGQK, I_CGQV, I_SC, I_SN, I_SM, I_CCTX, I_ADAW, I_ADAB, I_WIN, I_BGATE, I_WOUT, I_RPB, I_QKG, I_MLG,
       I_LNG, I_LNB, I_RW, I_WG, I_WU, I_WD, N_IN };

constexpr size_t O_YP = 0;
constexpr size_t O_YS = O_YP + (size_t)NP * D;
constexpr size_t O_NAK = O_YS + (size_t)NS * D;
constexpr size_t O_NAV = O_NAK + (size_t)BATCH * DEPTH * SEQ * NAH * HD;
constexpr size_t O_GQK = O_NAV + (size_t)BATCH * DEPTH * SEQ * NAH * HD;
constexpr size_t O_GQV = O_GQK + (size_t)BATCH * DEPTH * SEQ * GQKV * HD;
constexpr size_t O_MC = O_GQV + (size_t)BATCH * DEPTH * SEQ * GQKV * HD;
constexpr size_t O_MN = O_MC + (size_t)BATCH * DEPTH * 2 * MLH * HD * HD;
constexpr size_t O_MM = O_MN + (size_t)BATCH * DEPTH * 2 * MLH * HD;
constexpr size_t O_END = O_MM + (size_t)BATCH * DEPTH * 2 * MLH;

constexpr size_t al256(size_t x) { return (x + 255) & ~(size_t)255; }
constexpr size_t WS_BAR = 0;
constexpr size_t WS_BAR_BYTES = 32768;
constexpr size_t WS_MODS = WS_BAR + WS_BAR_BYTES;
constexpr size_t WS_ROPE = al256(WS_MODS + (size_t)DEPTH * NCOND * 6 * D * 4);
constexpr size_t WS_CNAK = al256(WS_ROPE + 64 * 16 * 2 * 4);
constexpr size_t WS_CNAV = al256(WS_CNAK + (size_t)DEC_BATCH * DEPTH * PAST * NAH * HD * 2);
constexpr size_t WS_CGQK = al256(WS_CNAV + (size_t)DEC_BATCH * DEPTH * PAST * NAH * HD * 2);
constexpr size_t WS_CGQV = al256(WS_CGQK + (size_t)DEC_BATCH * DEPTH * PAST * GQKV * HD * 2);
constexpr size_t WS_XBUF = al256(WS_CGQV + (size_t)DEC_BATCH * DEPTH * PAST * GQKV * HD * 2);
constexpr size_t WS_HMOD = al256(WS_XBUF + (size_t)NT * D * 4);
constexpr size_t WS_GATES = al256(WS_HMOD + (size_t)NT * D * 2);
constexpr size_t WS_NAQ = al256(WS_GATES + (size_t)NT * 16 * 4);
constexpr size_t WS_NAK = al256(WS_NAQ + (size_t)NT * 384 * 2);
constexpr size_t WS_NAV = al256(WS_NAK + (size_t)NT * 384 * 2);
constexpr size_t WS_MLQ = al256(WS_NAV + (size_t)NT * 384 * 2);
constexpr size_t WS_MLK = al256(WS_MLQ + (size_t)NT * 256 * 2);
constexpr size_t WS_MLV = al256(WS_MLK + (size_t)NT * 256 * 2);
constexpr size_t WS_MLO = al256(WS_MLV + (size_t)NT * 256 * 2);
constexpr size_t WS_GQQ = al256(WS_MLO + (size_t)NT * 256 * 2);
constexpr size_t WS_GQK = al256(WS_GQQ + (size_t)NT * 384 * 2);
constexpr size_t WS_GQV = al256(WS_GQK + (size_t)NT * 128 * 2);
constexpr size_t WS_MIXED = al256(WS_GQV + (size_t)NT * 128 * 2);
constexpr size_t WS_U = al256(WS_MIXED + (size_t)NT * MIXW * 2);
constexpr size_t WS_X1 = al256(WS_U + (size_t)NT * D * 4);
constexpr size_t WS_H2 = al256(WS_X1 + (size_t)NT * D * 4);
constexpr size_t WS_AFF = al256(WS_H2 + (size_t)NT * D * 2);
constexpr size_t WS_IDX = al256(WS_AFF + (size_t)NT * 16 * 4);
constexpr size_t WS_GSEL = al256(WS_IDX + (size_t)NEXP * SLOTS * 4);
constexpr size_t WS_TOKSLOT = al256(WS_GSEL + (size_t)NEXP * SLOTS * 4);
constexpr size_t WS_HID = al256(WS_TOKSLOT + (size_t)NT * 16 * 4);
constexpr size_t WS_YE = al256(WS_HID + (size_t)NEXP * SLOTS * EH * 2);
constexpr int ML_NU = 2048, ML_AG = 2112;
constexpr int MLSUM_STRIDE = 2048 + 64 + 64;
constexpr int N_MLSUM = (BATCH * NCH_P + DEC_BATCH * NCH_S) * MLH * 2;
constexpr size_t WS_MLSUM = al256(WS_YE + (size_t)NEXP * SLOTS * D * 2);
constexpr int PART_STRIDE = 256 * 64 + 512;
constexpr int N_PART = DEC_BATCH * GQH * (DEC_SEQ / 256) * 2;
constexpr size_t WS_PART = al256(WS_MLSUM + (size_t)N_MLSUM * MLSUM_STRIDE * 4);
constexpr size_t WS_TOTAL = al256(WS_PART + (size_t)N_PART * PART_STRIDE * 4);

struct Params {
    const float* in[N_IN];
    float* out;
    char* ws;
    int ph0, ph1;
};

DEV float bf2f(bf16_t s) { unsigned u = ((unsigned)s) << 16; return __builtin_bit_cast(float, u); }
DEV bf16_t f2bf(float f) {
#ifdef EMU
    unsigned u = __builtin_bit_cast(unsigned, f); u += 0x7fffu + ((u >> 16) & 1u); return (bf16_t)(u >> 16);
#else
    return __builtin_bit_cast(bf16_t, (__bf16)f);
#endif
}
DEV unsigned pack2(float a, float b) {
#ifdef EMU
    return (unsigned)f2bf(a) | ((unsigned)f2bf(b) << 16);
#else
    typedef __bf16 b2 __attribute__((ext_vector_type(2))); b2 r; r[0] = (__bf16)a; r[1] = (__bf16)b; return __builtin_bit_cast(unsigned, r);
#endif
}
DEV float fexp(float x) {
#ifdef EMU
    return expf(x);
#else
    return __expf(x);
#endif
}
DEV float fexp2(float x) {
#ifdef EMU
    return exp2f(x);
#else
    return __builtin_amdgcn_exp2f(x);
#endif
}
DEV float frcp(float x) {
#ifdef EMU
    return 1.f / x;
#else
    return __builtin_amdgcn_rcpf(x);
#endif
}
DEV float sigmoidf_(float x) { return frcp(1.f + fexp(-x)); }
DEV float siluf_(float x) { return x * frcp(1.f + fexp(-x)); }
DEV float flog(float x) {
#ifdef EMU
    return logf(x);
#else
    return __logf(x);
#endif
}
DEV float frsqrt(float x) {
#ifdef EMU
    return 1.f / sqrtf(x);
#else
    return __builtin_amdgcn_rsqf(x);
#endif
}
DEV float logsigmoidf_(float x) { return fminf(x, 0.f) - flog(1.f + fexp(-fabsf(x))); }
DEV f16v mfma32(s8v a, s8v b, f16v c) {
#ifdef EMU
    return emu_mfma_32x32x16_bf16(a, b, c);
#else
    typedef __bf16 bf8 __attribute__((ext_vector_type(8)));
    return __builtin_amdgcn_mfma_f32_32x32x16_bf16(__builtin_bit_cast(bf8, a), __builtin_bit_cast(bf8, b), c, 0, 0, 0);
#endif
}
DEV s4v lds_tr16(const void* p) {
#ifdef EMU
    return emu_ds_read_tr16_b64(p);
#else
    typedef s4v __attribute__((address_space(3))) * lp;
    return __builtin_amdgcn_ds_read_tr16_b64_v4i16((lp)(p));
#endif
}
#ifdef EMU
DEV float wave_sum(float v) { for (int m = 32; m >= 1; m >>= 1) v += __shfl_xor(v, m); return v; }
#else
template <int CTRL, int RM> DEV float dpp_f(float v) { return __builtin_bit_cast(float, __builtin_amdgcn_update_dpp(0, __builtin_bit_cast(int, v), CTRL, RM, 0xF, false)); }
DEV float wave_sum(float v) {
    v += dpp_f<0xB1, 0xF>(v); v += dpp_f<0x4E, 0xF>(v); v += dpp_f<0x141, 0xF>(v); v += dpp_f<0x140, 0xF>(v);
    v += dpp_f<0x142, 0xA>(v); v += dpp_f<0x143, 0xC>(v);
    return __builtin_bit_cast(float, __builtin_amdgcn_readlane(__builtin_bit_cast(int, v), 63));
}
#endif
DEV float wave_max(float v) { for (int m = 32; m >= 1; m >>= 1) v = fmaxf(v, __shfl_xor(v, m)); return v; }
DEV f16v f16zero() { f16v z; for (int i = 0; i < 16; ++i) z[i] = 0.f; return z; }

#ifdef EMU
#define VGPR_PIN(x) do {} while (0)
#define SGPR_PIN(x) do {} while (0)
#define SCHED_FENCE() do {} while (0)
#define CFENCE() do {} while (0)
#else
#define SCHED_FENCE() __builtin_amdgcn_sched_barrier(0)
#define SGPR_PIN(x) asm volatile("" : "+s"(x))
#define VGPR_PIN(x) asm volatile("" : "+v"(x))
#define CFENCE() asm volatile("" ::: "memory")
#endif
#ifdef EMU
DEV int get_tid() { return (int)threadIdx.x; }
#else
DEV int get_tid() { int t = threadIdx.x; asm volatile("" : "+v"(t)); return t; }
#endif
struct UnitIter { int i, end, step; };
DEV UnitIter unit_iter(int NU) {
    const int G = (int)gridDim.x, b = (int)blockIdx.x;
    UnitIter it;
#ifndef XCD_MODE
#define XCD_MODE 0
#endif
    if ((G & 7) == 0 && (NU & 7) == 0) { const int W = G >> 3, x = XCD_MODE ? b / W : b & 7, j = XCD_MODE ? b % W : b >> 3, C = NU >> 3; it.i = x * C + j; it.end = (x + 1) * C; it.step = W; }
    else { it.i = b; it.end = NU; it.step = G; }
    return it;
}
DEV int tok_cond(int t) { return t < NP ? 0 : 1 + (t - NP) / DEC_SEQ; }

#ifndef EMU
#define XB_TMO      128
#define XB_XCNT(j)  (256  + 64 * (j))
#define XB_XSUB(j)  (1280 + 64 * (j))
#define XB_XGEN(j)  (2304 + 64 * (j))
#define XB_TOP      3328
#define XB_TOPGEN   3392
#define XCD_BAR_WORDS 3456
#define XB_SPIN_CAP (1u << 20)
#define LAS __attribute__((address_space(3)))
__device__ __forceinline__ unsigned xb_ld(unsigned* p)              { return __hip_atomic_load(p, __ATOMIC_RELAXED, __HIP_MEMORY_SCOPE_AGENT); }
__device__ __forceinline__ unsigned xb_add(unsigned* p, unsigned v) { return __hip_atomic_fetch_add(p, v, __ATOMIC_RELAXED, __HIP_MEMORY_SCOPE_AGENT); }
__device__ __forceinline__ unsigned xb_xcc_id() { return (unsigned)__builtin_amdgcn_s_getreg((3 << 11) | 20) & 0xFu; }
#define XB_SPIN(cond, bar) do { unsigned _sp = 0; while (cond) { __builtin_amdgcn_s_sleep(1); \
    if ((++_sp & 255u) == 0u) { if (xb_ld(&(bar)[XB_TMO])) break; if (_sp > XB_SPIN_CAP) { atomicAdd(&(bar)[XB_TMO], 1u); break; } } } } while (0)
struct XcdBarrier { unsigned* bar; unsigned x; volatile LAS unsigned* st; };
__device__ __forceinline__ XcdBarrier xcd_barrier_post(unsigned* bar, volatile LAS unsigned* st) {
    XcdBarrier b; b.bar = bar; b.x = xb_xcc_id(); b.st = st;
    if (threadIdx.x == 0) (void)xb_add(&bar[XB_XCNT(b.x)], 1u);
    return b;
}
__device__ __forceinline__ void xcd_barrier_complete(unsigned* bar, unsigned x, unsigned& nloc, unsigned& nx) {
    const unsigned G = gridDim.x * gridDim.y * gridDim.z;
    unsigned sum, cnt, mine, sp = 0u;
    for (;;) {
        sum = 0u; cnt = 0u; mine = 0u;
#pragma unroll
        for (unsigned j = 0; j < 16; ++j) { const unsigned c = xb_ld(&bar[XB_XCNT(j)]); sum += c; cnt += (c > 0u) ? 1u : 0u; mine = (j == x) ? c : mine; }
        if (sum == G) break;
        __builtin_amdgcn_s_sleep(1);
        if ((++sp & 255u) == 0u) { if (xb_ld(&bar[XB_TMO])) break; if (sp > XB_SPIN_CAP) { atomicAdd(&bar[XB_TMO], 1u); break; } }
    }
    nloc = mine > 0u ? mine : 1u; nx = cnt > 0u ? cnt : 1u;
}
__device__ __forceinline__ void xcd_barrier(const XcdBarrier& b) {
    asm volatile("s_waitcnt vmcnt(0)" ::: "memory");
    __syncthreads();
    if (threadIdx.x == 0) {
        unsigned* bar = b.bar;
        __builtin_amdgcn_s_waitcnt(0);
        unsigned nloc = b.st[0], nx = b.st[1];
        if (nloc == 0u) { xcd_barrier_complete(bar, b.x, nloc, nx); b.st[0] = nloc; b.st[1] = nx; }
        const unsigned old = xb_add(&bar[XB_XSUB(b.x)], 1u);
        const unsigned gen = old / nloc;
        if (old + 1u == (gen + 1u) * nloc) {
            __builtin_amdgcn_fence(__ATOMIC_RELEASE, "agent");
            asm volatile("s_waitcnt vmcnt(0)" ::: "memory");
            const unsigned og = xb_add(&bar[XB_TOP], 1u);
            const unsigned tg = og / nx;
            if (og + 1u == (tg + 1u) * nx) xb_add(&bar[XB_TOPGEN], 1u);
            else XB_SPIN(xb_ld(&bar[XB_TOPGEN]) == tg, bar);
            __builtin_amdgcn_fence(__ATOMIC_ACQUIRE, "agent");
            xb_add(&bar[XB_XGEN(b.x)], 1u);
            asm volatile("s_waitcnt vmcnt(0)" ::: "memory");
        } else {
            XB_SPIN(xb_ld(&bar[XB_XGEN(b.x)]) == gen, bar);
            __builtin_amdgcn_fence(__ATOMIC_ACQUIRE, "agent");
            asm volatile("s_waitcnt vmcnt(0)" ::: "memory");
        }
    }
    __syncthreads();
}
#endif
constexpr int QUEUE_WORD0 = 4096;

constexpr int LROW = 144;
constexpr int GEMM_AS = 256 * LROW;
constexpr int GEMM_BS = 64 * (256 * 2 + 64);
constexpr int SMEM_XB = 2 * GEMM_AS + 2 * GEMM_BS;
constexpr int SMEM_AUX = SMEM_XB + 64;
constexpr int SMEM_BYTES = SMEM_AUX + 2048;

#ifdef EMU
struct BufRsrc { const char* base; };
DEV BufRsrc make_rsrc(const void* p) { BufRsrc r; r.base = (const char*)p; return r; }
DEV float buf_load_f32(BufRsrc r, unsigned voff, unsigned soff) { return *(const float*)(r.base + voff + soff); }
DEV u4v buf_load_b128(BufRsrc r, unsigned voff, unsigned soff) { return *(const u4v*)(r.base + voff + soff); }
#else
typedef __amdgpu_buffer_rsrc_t BufRsrc;
DEV BufRsrc make_rsrc(const void* p) { return __builtin_amdgcn_make_buffer_rsrc((void*)p, 0, 0x7fffffff, 0x00020000); }
DEV float buf_load_f32(BufRsrc r, unsigned voff, unsigned soff) { return __builtin_bit_cast(float, __builtin_amdgcn_raw_buffer_load_b32(r, voff, soff, 0)); }
DEV u4v buf_load_b128(BufRsrc r, unsigned voff, unsigned soff) { return __builtin_amdgcn_raw_buffer_load_b128(r, voff, soff, 0); }
#endif
#ifdef EMU
#define WAVE_SYNC() do { (void)__shfl(0, 0); } while (0)
#else
#define WAVE_SYNC() asm volatile("s_waitcnt lgkmcnt(0)" ::: "memory")
#endif
DEV char* wave_stage_ptr(char* smem, int wave) { return smem + (wave < 4 ? GEMM_AS + wave * 9216 : 2 * GEMM_AS + GEMM_BS + (wave - 4) * 9216); }
DEV void stage64_write_bf16(char* stg, int tt, const f16v& v0, const f16v& v1, int l31, int h) {
    char* row = stg + (tt * 32 + l31) * LROW;
#pragma unroll
    for (int ft = 0; ft < 2; ++ft) {
        const f16v& v = ft ? v1 : v0;
#pragma unroll
        for (int g = 0; g < 4; ++g) { u2v pk; pk[0] = pack2(v[4 * g], v[4 * g + 1]); pk[1] = pack2(v[4 * g + 2], v[4 * g + 3]); *(u2v*)(row + (ft * 32 + 8 * g + 4 * h) * 2) = pk; }
    }
}
DEV void stage64_write4(char* stg, int row, int col, float a, float b, float c, float d) {
    u2v pk; pk[0] = pack2(a, b); pk[1] = pack2(c, d); *(u2v*)(stg + row * LROW + col * 2) = pk;
}
DEV void stage64_flush_bf16(const char* stg, bf16_t* dst0, size_t row_stride, int lane) {
    WAVE_SYNC();
#pragma unroll
    for (int i = 0; i < 8; ++i) { const int r = (lane >> 3) + 8 * i, c = lane & 7; const u4v v = *(const u4v*)(stg + r * LROW + c * 16); *(u4v*)(dst0 + (size_t)r * row_stride + c * 8) = v; }
    WAVE_SYNC();
}
template <int NTW, int VAR, class Epi>
DEV void gemm_tile(char* smem, BufRsrc ars, unsigned ao0, unsigned ao1, unsigned ao2, unsigned ao3,
                   BufRsrc brs, unsigned bvo, unsigned blds, unsigned ldb4, int K, Epi&& epi) {
    constexpr int BN = 64 * NTW, NLD = 2 * NTW, KSTEP = 64 / NLD, RSB = BN * 2 + 64;
    const int tid = get_tid(), lane = tid & 63, wave = tid >> 6, wm = wave & 3, wn = wave >> 2, h = lane >> 5, l31 = lane & 31;
    char* As = smem; char* Bs = smem + 2 * GEMM_AS;
    constexpr int BSZ = GEMM_BS;
    const int ar = tid >> 3, ac = tid & 7;
    u4v areg[2]; f4v b0[NLD], b1[NLD];
    if (VAR & 3) { for (int i = 0; i < 2; ++i) areg[i] = (u4v){1u, 2u, 3u, 4u}; for (int j = 0; j < NLD; ++j) { b0[j] = (f4v){1.f, 1.f, 1.f, 1.f}; b1[j] = (f4v){2.f, 2.f, 2.f, 2.f}; } }
    f16v acc[NTW][2];
#pragma unroll
    for (int i = 0; i < NTW; ++i) { acc[i][0] = f16zero(); acc[i][1] = f16zero(); }
    auto gloadA = [&](int k0, bool real, int half) {
        if (VAR & 2) return;
        const unsigned so = real ? k0 * 2 : 0u;
        areg[0] = buf_load_b128(ars, real ? (half ? ao2 : ao0) : 0u, so); areg[1] = buf_load_b128(ars, real ? (half ? ao3 : ao1) : 0u, so);
    };
    auto gloadB = [&](int k0, bool real, f4v (&br)[NLD]) {
        if (VAR & 1) return;
        const unsigned vo = real ? bvo : 0u; const int kk = real ? k0 : 0;
        unsigned so = (unsigned)kk * ldb4;
#pragma unroll
        for (int j = 0; j < NLD; ++j) { br[j] = __builtin_bit_cast(f4v, buf_load_b128(brs, vo, so)); so += KSTEP * ldb4; SGPR_PIN(so); }
    };
    auto gloadB1 = [&](int k0, bool real, f4v (&br)[NLD], int j) {
        if (VAR & 1) return;
        br[j] = __builtin_bit_cast(f4v, buf_load_b128(brs, real ? bvo : 0u, (unsigned)((real ? k0 : 0) + j * KSTEP) * ldb4));
    };
    auto lstoreA = [&](int buf, int half) {
        if (VAR & 16) return;
        char* ab = As + buf * GEMM_AS + (ar + half * 128) * LROW + ac * 16;
        *(u4v*)(ab) = areg[0]; *(u4v*)(ab + 64 * LROW) = areg[1];
    };
    auto lstoreB1 = [&](int buf, const f4v (&br)[NLD], int j) {
        if (VAR & 16) return;
        u2v v; v[0] = pack2(br[j][0], br[j][1]); v[1] = pack2(br[j][2], br[j][3]); *(u2v*)(Bs + buf * BSZ + blds + j * KSTEP * RSB) = v;
    };
    auto lstoreB = [&](int buf, const f4v (&br)[NLD]) {
        if (VAR & 16) return;
        char* bb = Bs + buf * BSZ + blds;
#pragma unroll
        for (int j = 0; j < NLD; ++j) { u2v v; v[0] = pack2(br[j][0], br[j][1]); v[1] = pack2(br[j][2], br[j][3]); *(u2v*)(bb + j * KSTEP * RSB) = v; }
    };
    const unsigned btr = (unsigned)(8 * h + ((lane & 15) >> 2)) * RSB + (unsigned)((((lane >> 4) & 1) * 16 + 4 * (lane & 3)) * 2) + (unsigned)(wn * NTW * 32) * 2;
    const unsigned atr = (unsigned)(wm * 64 + l31) * LROW + h * 16;
    auto rdw = [&](int buf, int s, int ft) -> s8v {
        if (VAR & 64) { s8v z; for (int q = 0; q < 8; ++q) z[q] = (short)(0x3f80 + ft); return z; }
        const char* bb = Bs + buf * BSZ + btr + s * 16 * RSB + ft * 64;
        const s4v lo = lds_tr16(bb), hi = lds_tr16(bb + 4 * RSB);
        s8v wf; wf[0] = lo[0]; wf[1] = lo[1]; wf[2] = lo[2]; wf[3] = lo[3]; wf[4] = hi[0]; wf[5] = hi[1]; wf[6] = hi[2]; wf[7] = hi[3];
        return wf;
    };
    auto compute2 = [&](int buf, int s0, auto&& hook) {
        if (VAR & 8) { for (int g = 0; g < 2 * NTW; ++g) hook(g); return; }
        const char* ab = As + buf * GEMM_AS + atr;
        s8v xa[2];
        if (VAR & 64) { for (int q = 0; q < 8; ++q) { xa[0][q] = 0x3f80; xa[1][q] = 0x3f80; } } else { xa[0] = *(const s8v*)(ab + s0 * 32); xa[1] = *(const s8v*)(ab + 32 * LROW + s0 * 32); }
        s8v wcur = rdw(buf, s0, 0);
#pragma unroll
        for (int g = 0; g < 2 * NTW; ++g) {
            const int ft = g % NTW;
            s8v wnext = wcur;
            if (g + 1 < 2 * NTW) wnext = rdw(buf, s0 + (g + 1) / NTW, (g + 1) % NTW);
            if (VAR & 4) { acc[ft][0][0] += __builtin_bit_cast(float, (int)wcur[0] | ((int)xa[0][1] << 16)); acc[ft][1][0] += __builtin_bit_cast(float, (int)wcur[1] | ((int)xa[1][1] << 16)); }
            else { acc[ft][0] = mfma32(wcur, xa[0], acc[ft][0]); acc[ft][1] = mfma32(wcur, xa[1], acc[ft][1]); }
            if (g == NTW - 1 && !(VAR & 64)) { xa[0] = *(const s8v*)(ab + (s0 + 1) * 32); xa[1] = *(const s8v*)(ab + 32 * LROW + (s0 + 1) * 32); }
            wcur = wnext;
            hook(g);
            SCHED_FENCE();
        }
    };
    auto nohook = [](int) {};
    const int nk = K / 64;
    if (NTW == 2) {
        u4v a0[4], a1[4];
        if (VAR & 3) { for (int i = 0; i < 4; ++i) { a0[i] = (u4v){1u, 2u, 3u, 4u}; a1[i] = (u4v){1u, 2u, 3u, 4u}; } }
        auto gA = [&](int k0, bool real, u4v (&ar4)[4]) {
            if (VAR & 2) return;
            const unsigned so = real ? k0 * 2 : 0u;
            ar4[0] = buf_load_b128(ars, real ? ao0 : 0u, so); ar4[1] = buf_load_b128(ars, real ? ao1 : 0u, so);
            ar4[2] = buf_load_b128(ars, real ? ao2 : 0u, so); ar4[3] = buf_load_b128(ars, real ? ao3 : 0u, so);
        };
        auto sA = [&](int buf, const u4v (&ar4)[4]) {
            if (VAR & 16) return;
            char* ab = As + buf * GEMM_AS + ar * LROW + ac * 16;
#pragma unroll
            for (int i = 0; i < 4; ++i) *(u4v*)(ab + i * 64 * LROW) = ar4[i];
        };
        auto gA1 = [&](int k0, bool real, u4v (&ar4)[4], int i) {
            if (VAR & 2) return;
            const unsigned ao = i == 0 ? ao0 : i == 1 ? ao1 : i == 2 ? ao2 : ao3;
            ar4[i] = buf_load_b128(ars, real ? ao : 0u, real ? k0 * 2 : 0u);
        };
        auto sA1 = [&](int buf, const u4v (&ar4)[4], int i) {
            if (VAR & 16) return;
            *(u4v*)(As + buf * GEMM_AS + (ar + i * 64) * LROW + ac * 16) = ar4[i];
        };
        gA(0, true, a0); gloadB(0, true, b0); gA(64, true, a1); gloadB(64, true, b1);
        sA(0, a0); lstoreB(0, b0);
        __syncthreads();
        for (int kt = 0; kt < nk; kt += 2) {
            const bool t2 = kt + 2 < nk;
            compute2(0, 0, [&](int g) { gA1((kt + 2) * 64, t2, a0, g); lstoreB1(1, b1, g); });
            compute2(0, 2, [&](int g) { gloadB1((kt + 2) * 64, t2, b0, g); sA1(1, a1, g); });
            __syncthreads();
            compute2(1, 0, [&](int g) { gA1((kt + 3) * 64, t2, a1, g); lstoreB1(0, b0, g); });
            compute2(1, 2, [&](int g) { gloadB1((kt + 3) * 64, t2, b1, g); sA1(0, a0, g); });
            __syncthreads();
        }
    } else {
    {
        u4v at0, at1;
        gloadA(0, true, 0);
        if (!(VAR & 2)) { at0 = buf_load_b128(ars, ao2, 0); at1 = buf_load_b128(ars, ao3, 0); } else { at0 = areg[0]; at1 = areg[1]; }
        gloadB(0, true, b0); gloadB(64, true, b1);
        lstoreA(0, 0);
        if (!(VAR & 16)) { char* ab = As + (ar + 128) * LROW + ac * 16; *(u4v*)(ab) = at0; *(u4v*)(ab + 64 * LROW) = at1; }
        lstoreB(0, b0);
    }
    __syncthreads();
    for (int kt = 0; kt < nk; kt += 2) {
        const bool t2 = kt + 2 < nk;
        gloadA((kt + 1) * 64, true, 0);
        compute2(0, 0, [&](int g) { if (g & 1) gloadB1((kt + 2) * 64, t2, b0, g >> 1); else lstoreB1(1, b1, g >> 1); });
        lstoreA(1, 0);
        gloadA((kt + 1) * 64, true, 1);
        compute2(0, 2, [&](int g) { if (g & 1) gloadB1((kt + 2) * 64, t2, b0, 4 + (g >> 1)); else lstoreB1(1, b1, 4 + (g >> 1)); });
        lstoreA(1, 1);
        __syncthreads();
        gloadA((kt + 2) * 64, t2, 0);
        compute2(1, 0, [&](int g) { if (g & 1) gloadB1((kt + 3) * 64, t2, b1, g >> 1); else lstoreB1(0, b0, g >> 1); });
        lstoreA(0, 0);
        gloadA((kt + 2) * 64, t2, 1);
        compute2(1, 2, [&](int g) { if (g & 1) gloadB1((kt + 3) * 64, t2, b1, 4 + (g >> 1)); else lstoreB1(0, b0, 4 + (g >> 1)); });
        lstoreA(0, 1);
        __syncthreads();
    }
    }
    if (VAR & 32) { float t = 0.f; for (int i = 0; i < NTW; ++i) t += acc[i][0][0] + acc[i][1][5]; if (t == 123.456f) *(float*)smem = t; }
    else epi(acc);
}

DEV void phase_ada(const Params& p, char* smem) {
    const int tid = get_tid();
    float* siluS = (float*)smem;
    float* red = (float*)(smem + NCOND * D * 4);
    for (int i = tid; i < NCOND * D; i += 512) {
        const int cnd = i / D, k = i % D;
        const float c = cnd == 0 ? p.in[I_CCTX][k] : p.in[I_C][(cnd - 1) * D + k];
        siluS[i] = c * frcp(1.f + fexp(-c));
    }
    __syncthreads();
    constexpr int CPL = 6 * D / 32, NCHUNK = DEPTH * CPL, KG = D / 16;
    float* mods = (float*)(p.ws + WS_MODS);
    const int col = tid & 31, kg = tid >> 5;
    for (int u = blockIdx.x; u < NCHUNK; u += gridDim.x) {
        const int l = u / CPL, c0 = (u % CPL) * 32;
        const float* W = p.in[I_ADAW] + (size_t)l * D * 6 * D + c0 + col;
        float acc[NCOND];
#pragma unroll
        for (int c = 0; c < NCOND; ++c) acc[c] = 0.f;
#pragma unroll 8
        for (int k = kg * KG; k < kg * KG + KG; ++k) {
            const float w = W[(size_t)k * 6 * D];
#pragma unroll
            for (int c = 0; c < NCOND; ++c) acc[c] += siluS[c * D + k] * w;
        }
#pragma unroll
        for (int c = 0; c < NCOND; ++c) red[(kg * NCOND + c) * 32 + col] = acc[c];
        __syncthreads();
        if (tid < 32 * NCOND) {
            const int c = tid >> 5, cc = tid & 31;
            float s = 0.f;
            for (int g = 0; g < 16; ++g) s += red[(g * NCOND + c) * 32 + cc];
            mods[((size_t)l * NCOND + c) * 6 * D + c0 + cc] = s + p.in[I_ADAB][(size_t)l * 6 * D + c0 + cc];
        }
        __syncthreads();
    }
    const int gtid = blockIdx.x * 512 + tid, gsz = gridDim.x * 512;
    float* rope = (float*)(p.ws + WS_ROPE);
    for (int i = gtid; i < 64 * 16; i += gsz) {
        const int pos = i >> 4, fi = i & 15;
        const float inv = fexp2(-(float)(2 * fi) * (13.287712379549449f / 32.f));
        const float ang = (float)pos * inv;
#ifdef EMU
        rope[2 * i] = cosf(ang); rope[2 * i + 1] = sinf(ang);
#else
        rope[2 * i] = __cosf(ang); rope[2 * i + 1] = __sinf(ang);
#endif
    }
    constexpr int NNA = DEC_BATCH * DEPTH * PAST * NAH * HD, NGQ = DEC_BATCH * DEPTH * PAST * GQKV * HD;
    bf16_t* cnak = (bf16_t*)(p.ws + WS_CNAK); bf16_t* cnav = (bf16_t*)(p.ws + WS_CNAV);
    bf16_t* cgqk = (bf16_t*)(p.ws + WS_CGQK); bf16_t* cgqv = (bf16_t*)(p.ws + WS_CGQV);
    for (int i = gtid; i < NNA; i += gsz) { cnak[i] = f2bf(p.in[I_CNAK][i]); cnav[i] = f2bf(p.in[I_CNAV][i]); }
    for (int i = gtid; i < NGQ; i += gsz) { cgqk[i] = f2bf(p.in[I_CGQK][i]); cgqv[i] = f2bf(p.in[I_CGQV][i]); }
}

constexpr int EPL = D / 64;
constexpr int W16ROW = 20;
template <int MODE>
DEV void phase_rows(const Params& p, char* smem, int l) {
    const int tid = get_tid(), lane = tid & 63, wave = tid >> 6;
    float* W16 = (float*)smem;
    const bool need_w = (MODE == 1) || (l < DEPTH);
    if (need_w) {
        for (int i = tid; i < D * 4; i += 512) {
            const int k = i >> 2, q = i & 3;
            const float* src = (MODE == 1) ? p.in[I_RW] + ((size_t)l * D + k) * 16 + q * 4 : p.in[I_WIN] + ((size_t)l * D + k) * PROJ_W + 2176 + q * 4;
            *(f4v*)(W16 + k * W16ROW + q * 4) = *(const f4v*)src;
        }
    }
    __syncthreads();
    const float* mods = (const float*)(p.ws + WS_MODS);
    auto load_row = [&](int t, float (&vr)[EPL], int& ms) {
        const float* rp = (MODE == 1) ? (const float*)(p.ws + WS_U) + (size_t)t * D
                        : (l == 0) ? (t < NP ? p.in[I_XP] + (size_t)t * D : p.in[I_XS] + (size_t)(t - NP) * D) : (const float*)(p.ws + WS_X1) + (size_t)t * D;
#pragma unroll
        for (int j = 0; j < EPL; ++j) vr[j] = rp[lane + 64 * j];
        if (MODE == 0 && l > 0) ms = lane < 16 ? ((const int*)(p.ws + WS_TOKSLOT))[(size_t)t * 16 + lane] : -1;
    };
    const int tstride = gridDim.x * 8;
    float vr[EPL]; int ms = -1;
    {
        const int t0 = blockIdx.x * 8 + wave;
        if (t0 < NT) load_row(t0, vr, ms);
    }
    for (int t = blockIdx.x * 8 + wave; t < NT; t += tstride) {
        const int cnd = tok_cond(t);
        float vn[EPL]; int msn = -1;
#pragma unroll
        for (int j = 0; j < EPL; ++j) vn[j] = 0.f;
        if (t + tstride < NT) load_row(t + tstride, vn, msn);
        float v[EPL];
        if (MODE == 0 && l > 0) {
            const float* g2 = mods + ((size_t)(l - 1) * NCOND + cnd) * 6 * D + 5 * D;
            float f[EPL], gv[EPL];
#pragma unroll
            for (int j = 0; j < EPL; ++j) { f[j] = 0.f; gv[j] = g2[lane + 64 * j]; }
            const int myslot = ms;
            unsigned vm = (unsigned)__ballot(myslot >= 0);
            while (vm) {
                const int e = __builtin_ctz(vm); vm &= vm - 1u;
                const int slot = __shfl(myslot, e);
                const bf16_t* yr = (const bf16_t*)(p.ws + WS_YE) + ((size_t)e * SLOTS + slot) * D;
#pragma unroll
                for (int j = 0; j < EPL; ++j) f[j] += bf2f(yr[lane + 64 * j]);
            }
#pragma unroll
            for (int j = 0; j < EPL; ++j) v[j] = ALPHA * vr[j] + gv[j] * f[j];
        } else {
#pragma unroll
            for (int j = 0; j < EPL; ++j) v[j] = vr[j];
        }
#pragma unroll
        for (int j = 0; j < EPL; ++j) vr[j] = vn[j];
        ms = msn;
        if (!(MODE == 0 && l == 0)) {
            const int li = (MODE == 0) ? (l - 1) * 2 + 1 : l * 2;
            const float* lg = p.in[I_LNG] + (size_t)li * D; const float* lb = p.in[I_LNB] + (size_t)li * D;
            float g[EPL], bb[EPL];
#pragma unroll
            for (int j = 0; j < EPL; ++j) { g[j] = lg[lane + 64 * j]; bb[j] = lb[lane + 64 * j]; }
            float s = 0.f;
#pragma unroll
            for (int j = 0; j < EPL; ++j) s += v[j];
            const float mu = wave_sum(s) * (1.f / D);
            float q = 0.f;
#pragma unroll
            for (int j = 0; j < EPL; ++j) { const float dlt = v[j] - mu; q += dlt * dlt; }
            const float rstd = frsqrt(wave_sum(q) * (1.f / D) + EPS);
            float* dst = (MODE == 1) ? (float*)(p.ws + WS_X1) + (size_t)t * D
                       : (l == DEPTH) ? (t < NP ? p.out + O_YP + (size_t)t * D : p.out + O_YS + (size_t)(t - NP) * D) : (float*)(p.ws + WS_XBUF) + (size_t)t * D;
#pragma unroll
            for (int j = 0; j < EPL; ++j) { v[j] = (v[j] - mu) * rstd * g[j] + bb[j]; dst[lane + 64 * j] = v[j]; }
        }
        if (MODE == 1 || l < DEPTH) {
            const float* sh = mods + ((size_t)l * NCOND + cnd) * 6 * D + (MODE == 1 ? 3 * D : 0); const float* sc = sh + D;
            bf16_t* hb = (bf16_t*)(p.ws + (MODE == 1 ? WS_H2 : WS_HMOD)) + (size_t)t * D;
            {
                float s1[EPL], s0[EPL];
#pragma unroll
                for (int j = 0; j < EPL; ++j) { s1[j] = sc[lane + 64 * j]; s0[j] = sh[lane + 64 * j]; }
#pragma unroll
                for (int j = 0; j < EPL; ++j) { v[j] = v[j] * (1.f + s1[j]) + s0[j]; hb[lane + 64 * j] = f2bf(v[j]); }
            }
            CFENCE();
            float a16[16];
#pragma unroll
            for (int e = 0; e < 16; ++e) a16[e] = 0.f;
#pragma unroll
            for (int j = 0; j < EPL; ++j) {
                const float hv = v[j];
                const float* wr = W16 + (lane + 64 * j) * W16ROW;
#pragma unroll
                for (int q = 0; q < 4; ++q) { const f4v w4 = *(const f4v*)(wr + 4 * q); a16[4 * q] += hv * w4[0]; a16[4 * q + 1] += hv * w4[1]; a16[4 * q + 2] += hv * w4[2]; a16[4 * q + 3] += hv * w4[3]; }
                if (j & 1) CFENCE();
            }
            float mine = -1e30f;
#pragma unroll
            for (int e = 0; e < 16; ++e) { const float sm = wave_sum(a16[e]); if (lane == e) mine = sm; }
            if (MODE == 0) {
                if (lane < 16) ((float*)(p.ws + WS_GATES))[(size_t)t * 16 + lane] = mine + p.in[I_BGATE][l * 16 + lane];
            } else {
                float mx = mine;
                for (int m = 8; m >= 1; m >>= 1) mx = fmaxf(mx, __shfl_xor(mx, m));
                const float ex = lane < 16 ? fexp(mine - mx) : 0.f;
                float sm = ex;
                for (int m = 8; m >= 1; m >>= 1) sm += __shfl_xor(sm, m);
                if (lane < 16) ((float*)(p.ws + WS_AFF))[(size_t)t * 16 + lane] = ex / sm;
            }
        }
    }
}

template <int NPL>
DEV void topk_wave(const Params& p, int tb, int cap, int sbase, int e, int lane) {
    const float* aff = (const float*)(p.ws + WS_AFF);
    int* idx = (int*)(p.ws + WS_IDX); float* gsel = (float*)(p.ws + WS_GSEL); int* tokslot = (int*)(p.ws + WS_TOKSLOT);
    unsigned bits[NPL];
#pragma unroll
    for (int i = 0; i < NPL; ++i) bits[i] = __builtin_bit_cast(unsigned, aff[(size_t)(tb + lane + 64 * i) * 16 + e]);
    unsigned T = 0u;
    for (int b = 30; b >= 0; --b) {
        const unsigned cand = T | (1u << b);
        int cnt = 0;
#pragma unroll
        for (int i = 0; i < NPL; ++i) cnt += __popcll(__ballot(bits[i] >= cand));
        if (cnt >= cap) T = cand;
    }
    int ngt = 0;
#pragma unroll
    for (int i = 0; i < NPL; ++i) ngt += __popcll(__ballot(bits[i] > T));
    int need_eq = cap - ngt, run = 0;
    const unsigned long long lt = (1ull << lane) - 1ull;
#pragma unroll
    for (int i = 0; i < NPL; ++i) {
        const bool eq = bits[i] == T;
        const unsigned long long meq = __ballot(eq);
        const int eqrank = __popcll(meq & lt);
        const bool sel = bits[i] > T || (eq && eqrank < need_eq);
        const unsigned long long ms = __ballot(sel);
        const int t = tb + lane + 64 * i;
        if (sel) { const int slot = sbase + run + __popcll(ms & lt); idx[e * SLOTS + slot] = t; gsel[e * SLOTS + slot] = __builtin_bit_cast(float, bits[i]); tokslot[(size_t)t * 16 + e] = slot; }
        else tokslot[(size_t)t * 16 + e] = -1;
        run += __popcll(ms);
        const int neq = __popcll(meq); need_eq -= neq < need_eq ? neq : need_eq;
    }
}
template <int NPW>
DEV void topk_quad(const Params& p, char* smem, bool valid, int tb, int cap, int sbase, int e, int grp, int wq, int lane) {
    const float* aff = (const float*)(p.ws + WS_AFF);
    int* idx = (int*)(p.ws + WS_IDX); float* gsel = (float*)(p.ws + WS_GSEL); int* tokslot = (int*)(p.ws + WS_TOKSLOT);
    int* cntS = (int*)smem + grp * 64;
    const int t0 = tb + wq * (NPW * 64);
    unsigned bits[NPW];
#pragma unroll
    for (int i = 0; i < NPW; ++i) bits[i] = valid ? __builtin_bit_cast(unsigned, aff[(size_t)(t0 + lane + 64 * i) * 16 + e]) : 0u;
    unsigned T = 0u;
    for (int b = 30; b >= 0; --b) {
        const unsigned cand = T | (1u << b);
        int cnt = 0;
#pragma unroll
        for (int i = 0; i < NPW; ++i) cnt += __popcll(__ballot(bits[i] >= cand));
        if (lane == 0) cntS[(b & 1) * 4 + wq] = cnt;
        __syncthreads();
        const int tot = cntS[(b & 1) * 4] + cntS[(b & 1) * 4 + 1] + cntS[(b & 1) * 4 + 2] + cntS[(b & 1) * 4 + 3];
        if (tot >= cap) T = cand;
    }
    int ngt = 0, neqw = 0;
#pragma unroll
    for (int i = 0; i < NPW; ++i) { ngt += __popcll(__ballot(bits[i] > T)); neqw += __popcll(__ballot(bits[i] == T)); }
    if (lane == 0) { cntS[16 + wq] = ngt; cntS[20 + wq] = neqw; }
    __syncthreads();
    int gt_tot = 0;
    for (int w = 0; w < 4; ++w) gt_tot += cntS[16 + w];
    int rem = cap - gt_tot, run = 0, need_eq = 0;
    for (int w = 0; w < 4; ++w) {
        const int take = cntS[20 + w] < rem ? cntS[20 + w] : rem;
        if (w < wq) run += cntS[16 + w] + take;
        if (w == wq) need_eq = take;
        rem -= take;
    }
    if (!valid) return;
    const unsigned long long lt = (1ull << lane) - 1ull;
#pragma unroll
    for (int i = 0; i < NPW; ++i) {
        const bool eq = bits[i] == T;
        const unsigned long long meq = __ballot(eq);
        const int eqrank = __popcll(meq & lt);
        const bool sel = bits[i] > T || (eq && eqrank < need_eq);
        const unsigned long long ms = __ballot(sel);
        const int t = t0 + lane + 64 * i;
        if (sel) { const int slot = sbase + run + __popcll(ms & lt); idx[e * SLOTS + slot] = t; gsel[e * SLOTS + slot] = __builtin_bit_cast(float, bits[i]); tokslot[(size_t)t * 16 + e] = slot; }
        else tokslot[(size_t)t * 16 + e] = -1;
        run += __popcll(ms);
        const int neq = __popcll(meq); need_eq -= neq < need_eq ? neq : need_eq;
    }
}
DEV void phase_topk(const Params& p, char* smem) {
    const int tid = get_tid(), lane = tid & 63, wave = tid >> 6;
    constexpr int US = DEC_BATCH * NEXP, UP = BATCH * NEXP, NSB = (US + 1) / 2;
    static_assert(DEC_SEQ % 256 == 0, "quarter split");
    for (int ub = blockIdx.x; ub < NSB; ub += gridDim.x) {
        const int u = 2 * ub + (wave >> 2);
        const bool valid = u < US;
        const int b = valid ? u / NEXP : 0, e = valid ? u % NEXP : 0;
        topk_quad<DEC_SEQ / 256>(p, smem, valid, NP + b * DEC_SEQ, CAP_S, BATCH * CAP_P + b * CAP_S, e, wave >> 2, wave & 3, lane);
        __syncthreads();
    }
    const int gw = (gridDim.x - 1 - blockIdx.x) + gridDim.x * wave, nw = gridDim.x * 8;
    for (int u = gw; u < UP; u += nw) { const int b = u / NEXP, e = u % NEXP; topk_wave<SEQ / 64>(p, b * SEQ, CAP_P, b * CAP_P, e, lane); }
}

DEV void store_head_f32(float* dst_f32, const f16v& v0, const f16v& v1, int h) {
#pragma unroll
    for (int ft = 0; ft < 2; ++ft) {
        const f16v& v = ft ? v1 : v0;
#pragma unroll
        for (int g = 0; g < 4; ++g) { f4v o; o[0] = v[4 * g]; o[1] = v[4 * g + 1]; o[2] = v[4 * g + 2]; o[3] = v[4 * g + 3]; *(f4v*)(dst_f32 + ft * 32 + 8 * g + 4 * h) = o; }
    }
}
DEV void inproj_head(const Params& p, char* stg, const float* rope, int l, int t0, int cb, const f16v& a00, const f16v& a10, const f16v& a01, const f16v& a11, int lane) {
    const int l31 = lane & 31, h = lane >> 5;
    const bool isP = t0 < NP;
    bf16_t* dstb; size_t dstride;
    int f32out = 0, fhead = 0, fheads = 0; size_t fbase = 0;
    int mode = 0;
    if (cb < 1152) {
        const int seg = cb / 384, head = (cb % 384) / 64;
        dstb = (bf16_t*)(p.ws + (seg == 0 ? WS_NAQ : seg == 1 ? WS_NAK : WS_NAV)) + (size_t)t0 * 384 + head * 64; dstride = 384;
        if (seg >= 1 && isP) { f32out = 1; fbase = seg == 1 ? O_NAK : O_NAV; fhead = head; fheads = NAH; }
    } else if (cb < 2176) {
        const int seg = (cb - 1152) / 256, head = ((cb - 1152) % 256) / 64;
        dstb = (bf16_t*)(p.ws + (seg == 0 ? WS_MLQ : seg == 1 ? WS_MLK : seg == 2 ? WS_MLV : WS_MLO)) + (size_t)t0 * 256 + head * 64; dstride = 256;
        mode = seg == 1 ? 1 : 0;
    } else {
        const int c2 = cb - 2192;
        if (c2 < 384) { dstb = (bf16_t*)(p.ws + WS_GQQ) + (size_t)t0 * 384 + (c2 / 64) * 64; dstride = 384; mode = 2; }
        else if (c2 < 512) { const int head = (c2 - 384) / 64; dstb = (bf16_t*)(p.ws + WS_GQK) + (size_t)t0 * 128 + head * 64; dstride = 128; mode = 3;
                             if (isP) { f32out = 1; fbase = O_GQK; fhead = head; fheads = GQKV; } }
        else { const int head = (c2 - 512) / 64; dstb = (bf16_t*)(p.ws + WS_GQV) + (size_t)t0 * 128 + head * 64; dstride = 128;
               if (isP) { f32out = 1; fbase = O_GQV; fhead = head; fheads = GQKV; } }
    }
#pragma unroll
    for (int tt = 0; tt < 2; ++tt) {
        const int t = t0 + tt * 32 + l31;
        f16v v0 = tt ? a01 : a00, v1 = tt ? a11 : a10;
        if (mode == 1) { v0 *= ATT_SCALE; v1 *= ATT_SCALE; }
        if (mode >= 2) {
            float ss = 0.f;
#pragma unroll
            for (int r = 0; r < 16; ++r) ss += v0[r] * v0[r] + v1[r] * v1[r];
            ss += __shfl_xor(ss, 32);
            const float rn = frsqrt(ss * (1.f / 64.f) + EPS);
            const float* gq = p.in[I_QKG] + ((size_t)l * 2 + (mode == 2 ? 0 : 1)) * 64;
#pragma unroll
            for (int r = 0; r < 16; ++r) {
                const int d = (r & 3) + 8 * (r >> 2) + 4 * h;
                v0[r] *= rn * gq[d]; v1[r] *= rn * gq[32 + d];
            }
        }
        if (f32out) { const int bP = t / SEQ, sP = t % SEQ; store_head_f32(p.out + fbase + ((((size_t)bP * DEPTH + l) * SEQ + sP) * fheads + fhead) * 64, v0, v1, h); }
        if (mode >= 2 && !isP) {
            const int pos = (t - NP) % DEC_SEQ, prow = pos / GRIDW, pcol = pos % GRIDW;
#pragma unroll
            for (int rr = 0; rr < 8; ++rr) {
                const int fi = (rr & 3) + 8 * ((rr >> 2) & 1) + 4 * h;
                const float c0 = rope[(prow * 16 + fi) * 2], s0 = rope[(prow * 16 + fi) * 2 + 1];
                const float c1 = rope[(pcol * 16 + fi) * 2], s1 = rope[(pcol * 16 + fi) * 2 + 1];
                const float a_lo = v0[rr], a_hi = v0[rr + 8]; v0[rr] = a_lo * c0 - a_hi * s0; v0[rr + 8] = a_hi * c0 + a_lo * s0;
                const float b_lo = v1[rr], b_hi = v1[rr + 8]; v1[rr] = b_lo * c1 - b_hi * s1; v1[rr + 8] = b_hi * c1 + b_lo * s1;
            }
        }
        stage64_write_bf16(stg, tt, v0, v1, l31, h);
    }
    stage64_flush_bf16(stg, dstb, dstride, lane);
}
template <int VAR>
DEV void phase_inproj(const Params& p, char* smem, int l) {
    constexpr int NJ4 = 11, NMB = NT / 256, RPX = (NMB % 8 == 0) ? NMB / 8 : NMB, TPC = RPX * NJ4;
#ifdef IP_FORCE_FULL
    constexpr int FT = IP_FORCE_FULL;
#else
    constexpr int FT = (NMB % 8 == 0 && TPC > 32) ? 32 : 0;
#endif
    constexpr int UPC = FT + 2 * (TPC - FT), NCHUNK = (NMB % 8 == 0) ? 8 : 1;
    const int tid = get_tid(), lane = tid & 63, wave = tid >> 6, wm = wave & 3, wn = wave >> 2;
    const bf16_t* hmod = (const bf16_t*)(p.ws + WS_HMOD);
    const float* rope = (const float*)(p.ws + WS_ROPE);
    const bool chunked = (gridDim.x & 7) == 0 && NCHUNK == 8;
    const UnitIter it = unit_iter(NCHUNK * UPC);
    for (int uu = it.i; uu < it.end; uu += it.step) {
        const int x = uu / UPC, v = uu % UPC;
        const int tl = v < FT ? v : FT + ((v - FT) >> 1), half = v < FT ? -1 : ((v - FT) & 1);
        const int mb = x * RPX + tl % RPX, j4 = tl / RPX;
        (void)chunked;
        const unsigned ao = ((unsigned)(mb * 256 + (tid >> 3)) * D + (tid & 7) * 8) * 2;
        if (half < 0) {
            const int colbase = 256 * j4;
            const int zc = colbase + 4 * (tid & 63);
            const unsigned bvo = (unsigned)(zc < 2176 ? zc : zc + 16) * 4 + (unsigned)(tid >> 6) * (PROJ_W * 4);
            const unsigned blds = (unsigned)(tid >> 6) * 576u + (unsigned)(tid & 63) * 8u;
            gemm_tile<4, VAR>(smem, make_rsrc(hmod), ao, ao + 128u * D, ao + 256u * D, ao + 384u * D, make_rsrc(p.in[I_WIN] + (size_t)l * D * PROJ_W), bvo, blds, PROJ_W * 4, D, [&](f16v (&acc)[4][2]) {
                int lane_e = lane; VGPR_PIN(lane_e);
                char* stg = wave_stage_ptr(smem, wave);
#pragma unroll
                for (int hh = 0; hh < 2; ++hh) {
                    const int fh = colbase + wn * 128 + hh * 64;
                    inproj_head(p, stg, rope, l, mb * 256 + wm * 64, fh < 2176 ? fh : fh + 16, acc[2 * hh][0], acc[2 * hh + 1][0], acc[2 * hh][1], acc[2 * hh + 1][1], lane_e);
                }
            });
        } else {
            const int j = 2 * j4 + half;
            const int colbase = j < 17 ? 128 * j : 2192 + 128 * (j - 17);
            const unsigned bvo = (unsigned)(colbase + 4 * (tid & 31)) * 4 + (unsigned)(tid >> 5) * (PROJ_W * 4);
            const unsigned blds = (unsigned)(tid >> 5) * 320u + (unsigned)(tid & 31) * 8u;
            gemm_tile<2, VAR>(smem, make_rsrc(hmod), ao, ao + 128u * D, ao + 256u * D, ao + 384u * D, make_rsrc(p.in[I_WIN] + (size_t)l * D * PROJ_W), bvo, blds, PROJ_W * 4, D, [&](f16v (&acc)[2][2]) {
                int lane_e = lane; VGPR_PIN(lane_e);
                inproj_head(p, wave_stage_ptr(smem, wave), rope, l, mb * 256 + wm * 64, colbase + wn * 64, acc[0][0], acc[1][0], acc[0][1], acc[1][1], lane_e);
            });
        }
    }
}

template <int VAR>
DEV void phase_outproj(const Params& p, char* smem, int l) {
    constexpr int NC = D / 128, NU = (NT / 256) * NC;
    const int tid = get_tid(), lane = tid & 63, wave = tid >> 6, wm = wave & 3, wn = wave >> 2, h = lane >> 5, l31 = lane & 31;
    const bf16_t* mixed = (const bf16_t*)(p.ws + WS_MIXED);
    const float* mods = (const float*)(p.ws + WS_MODS);
    float* U = (float*)(p.ws + WS_U);
    constexpr int NMB = NT / 256, RPX = (NMB % 8 == 0) ? NMB / 8 : NMB;
    const UnitIter it = unit_iter(NU);
    for (int u = it.i; u < it.end; u += it.step) {
        const int mb = (u / (RPX * NC)) * RPX + u % RPX, cbk = (u / RPX) % NC;
        const unsigned ao = ((unsigned)(mb * 256 + (tid >> 3)) * MIXW + (tid & 7) * 8) * 2;
        const unsigned bvo = (unsigned)(cbk * 128 + 4 * (tid & 31)) * 4 + (unsigned)(tid >> 5) * (D * 4);
        const unsigned blds = (unsigned)(tid >> 5) * 320u + (unsigned)(tid & 31) * 8u;
        gemm_tile<2, VAR>(smem, make_rsrc(mixed), ao, ao + 128u * MIXW, ao + 256u * MIXW, ao + 384u * MIXW, make_rsrc(p.in[I_WOUT] + (size_t)l * MIXW * D), bvo, blds, D * 4, MIXW, [&](f16v (&acc)[2][2]) {
            int lane_e = lane; VGPR_PIN(lane_e); const int lane = lane_e, l31 = lane_e & 31, h = lane_e >> 5; (void)l31; (void)h;
            char* stg = wave_stage_ptr(smem, wave);
            const int t0 = mb * 256 + wm * 64;
            const float* g1 = mods + ((size_t)l * NCOND + tok_cond(t0)) * 6 * D + 2 * D;
#pragma unroll
            for (int ft = 0; ft < 2; ++ft) {
#pragma unroll
                for (int tt = 0; tt < 2; ++tt)
#pragma unroll
                    for (int g = 0; g < 4; ++g) { f4v o; o[0] = acc[ft][tt][4 * g]; o[1] = acc[ft][tt][4 * g + 1]; o[2] = acc[ft][tt][4 * g + 2]; o[3] = acc[ft][tt][4 * g + 3];
                        *(f4v*)(stg + (tt * 32 + l31) * LROW + (8 * g + 4 * h) * 4) = o; }
                WAVE_SYNC();
                const int f0 = cbk * 128 + wn * 64 + ft * 32 + (lane & 7) * 4;
                const f4v gv = *(const f4v*)(g1 + f0);
#pragma unroll
                for (int i = 0; i < 8; ++i) {
                    const int r = (lane >> 3) + 8 * i, t = t0 + r;
                    const f4v a = *(const f4v*)(stg + r * LROW + (lane & 7) * 16);
                    const float* xr = (l == 0) ? (t < NP ? p.in[I_XP] + (size_t)t * D : p.in[I_XS] + (size_t)(t - NP) * D) : (const float*)(p.ws + WS_XBUF) + (size_t)t * D;
                    const f4v xv = *(const f4v*)(xr + f0);
                    f4v o;
#pragma unroll
                    for (int q = 0; q < 4; ++q) o[q] = ALPHA * xv[q] + gv[q] * a[q];
                    *(f4v*)(U + (size_t)t * D + f0) = o;
                }
                WAVE_SYNC();
            }
        });
    }
}

template <int VAR>
DEV void phase_gateup(const Params& p, char* smem, int l) {
    constexpr int NRB = SLOTS / 256, NCB = EH / 128, NU = NEXP * NCB * NRB;
    const int tid = get_tid(), lane = tid & 63, wave = tid >> 6, wm = wave & 3, wn = wave >> 2, h = lane >> 5, l31 = lane & 31;
    const bf16_t* h2 = (const bf16_t*)(p.ws + WS_H2);
    const int* idx = (const int*)(p.ws + WS_IDX);
    bf16_t* hid = (bf16_t*)(p.ws + WS_HID);
    constexpr int TPC = NU / 8;
#ifdef GU_FORCE_HALF
    constexpr int HT = GU_FORCE_HALF;
#else
    constexpr int HT = (NU % 8 == 0 && TPC % 32 == 16) ? 16 : 0;
#endif
    constexpr int UPC = TPC + HT;
    const bool chunked = (gridDim.x & 7) == 0 && (NU & 7) == 0;
    const UnitIter it = unit_iter(chunked ? 8 * UPC : NU);
    for (int uu = it.i; uu < it.end; uu += it.step) {
        int u = uu, half = -1;
        if (chunked) { const int x = uu / UPC, v = uu % UPC; if (v < TPC - HT) u = x * TPC + v; else { const int hv = v - (TPC - HT); u = x * TPC + (TPC - HT) + (hv >> 1); half = hv & 1; } }
        const int rb = u % NRB, cbk = (u / NRB) % NCB, e = u / (NRB * NCB);
        const int* ip = idx + e * SLOTS + rb * 256 + (tid >> 3);
        const unsigned a0 = ((unsigned)ip[0] * D + (tid & 7) * 8) * 2, a1 = ((unsigned)ip[64] * D + (tid & 7) * 8) * 2;
        const unsigned a2 = ((unsigned)ip[128] * D + (tid & 7) * 8) * 2, a3 = ((unsigned)ip[192] * D + (tid & 7) * 8) * 2;
#ifdef EMU
        const int bw = tid >> 6;
#else
        const int bw = __builtin_amdgcn_readfirstlane(tid >> 6);
#endif
        const int is_up = bw & 1;
        const float* wmat = (is_up ? p.in[I_WU] : p.in[I_WG]) + ((size_t)l * NEXP + e) * D * EH;
        if (half < 0) {
        const int bkr = 2 * (bw >> 1) + ((tid >> 5) & 1), hc = 4 * (tid & 31);
        const int ncol = (hc >> 6) * 128 + (2 * ((hc >> 5) & 1) + is_up) * 32 + (hc & 31);
        const unsigned bvo = (unsigned)(cbk * 128 + hc) * 4 + (unsigned)bkr * (EH * 4);
        const unsigned blds = (unsigned)bkr * 576u + (unsigned)ncol * 2u;
        gemm_tile<4, VAR>(smem, make_rsrc(h2), a0, a1, a2, a3, make_rsrc(wmat), bvo, blds, EH * 4, D, [&](f16v (&acc)[4][2]) {
            int lane_e = lane; VGPR_PIN(lane_e); const int lane = lane_e, l31 = lane_e & 31, h = lane_e >> 5; (void)l31; (void)h;
            char* stg = wave_stage_ptr(smem, wave);
#pragma unroll
            for (int tt = 0; tt < 2; ++tt)
#pragma unroll
                for (int pr = 0; pr < 2; ++pr)
#pragma unroll
                    for (int g = 0; g < 4; ++g) {
                        float o[4];
#pragma unroll
                        for (int q = 0; q < 4; ++q) o[q] = siluf_(acc[2 * pr][tt][4 * g + q]) * acc[2 * pr + 1][tt][4 * g + q];
                        stage64_write4(stg, tt * 32 + l31, pr * 32 + 8 * g + 4 * h, o[0], o[1], o[2], o[3]);
                    }
            stage64_flush_bf16(stg, hid + ((size_t)e * SLOTS + rb * 256 + wm * 64) * EH + cbk * 128 + wn * 64, EH, lane);
        });
        } else {
        const int bkr = 4 * (bw >> 1) + ((tid >> 4) & 3), hc = 4 * (tid & 15);
        const int ncol = (hc >> 5) * 64 + is_up * 32 + (hc & 31);
        const unsigned bvo = (unsigned)(cbk * 128 + half * 64 + hc) * 4 + (unsigned)bkr * (EH * 4);
        const unsigned blds = (unsigned)bkr * 320u + (unsigned)ncol * 2u;
        gemm_tile<2, VAR>(smem, make_rsrc(h2), a0, a1, a2, a3, make_rsrc(wmat), bvo, blds, EH * 4, D, [&](f16v (&acc)[2][2]) {
            int lane_e = lane; VGPR_PIN(lane_e); const int lane = lane_e, l31 = lane_e & 31, h = lane_e >> 5; (void)l31; (void)h;
            char* stg = wave_stage_ptr(smem, wave);
#pragma unroll
            for (int tt = 0; tt < 2; ++tt)
#pragma unroll
                for (int g = 0; g < 4; ++g) {
                    float o[4];
#pragma unroll
                    for (int q = 0; q < 4; ++q) o[q] = siluf_(acc[0][tt][4 * g + q]) * acc[1][tt][4 * g + q];
                    stage64_write4(stg, tt * 32 + l31, 8 * g + 4 * h, o[0], o[1], o[2], o[3]);
                }
            WAVE_SYNC();
            bf16_t* dst0 = hid + ((size_t)e * SLOTS + rb * 256 + wm * 64) * EH + cbk * 128 + half * 64 + wn * 32;
#pragma unroll
            for (int i = 0; i < 4; ++i) { const int r = (lane >> 2) + 16 * i, c = lane & 3; const u4v v = *(const u4v*)(stg + r * LROW + c * 16); *(u4v*)(dst0 + (size_t)r * EH + c * 8) = v; }
            WAVE_SYNC();
        });
        }
    }
}

template <int VAR>
DEV void phase_down(const Params& p, char* smem, int l) {
    constexpr int NRB = SLOTS / 256, NCB = D / 256, NU = NEXP * NCB * NRB;
    const int tid = get_tid(), lane = tid & 63, wave = tid >> 6, wm = wave & 3, wn = wave >> 2, h = lane >> 5, l31 = lane & 31;
    const bf16_t* hid = (const bf16_t*)(p.ws + WS_HID);
    const float* gsel = (const float*)(p.ws + WS_GSEL);
    bf16_t* ye = (bf16_t*)(p.ws + WS_YE);
    const UnitIter it = unit_iter(NU);
    for (int u = it.i; u < it.end; u += it.step) {
        const int rb = u % NRB, cbk = (u / NRB) % NCB, e = u / (NRB * NCB);
        const unsigned ao = ((unsigned)(rb * 256 + (tid >> 3)) * EH + (tid & 7) * 8) * 2;
        const unsigned bvo = (unsigned)(cbk * 256 + 4 * (tid & 63)) * 4 + (unsigned)(tid >> 6) * (D * 4);
        const unsigned blds = (unsigned)(tid >> 6) * 576u + (unsigned)(tid & 63) * 8u;
        gemm_tile<4, VAR>(smem, make_rsrc(hid + (size_t)e * SLOTS * EH), ao, ao + 128u * EH, ao + 256u * EH, ao + 384u * EH, make_rsrc(p.in[I_WD] + ((size_t)l * NEXP + e) * EH * D), bvo, blds, D * 4, EH, [&](f16v (&acc)[4][2]) {
            int lane_e = lane; VGPR_PIN(lane_e); const int lane = lane_e, l31 = lane_e & 31, h = lane_e >> 5; (void)l31; (void)h;
            char* stg = wave_stage_ptr(smem, wave);
            const float gs0 = gsel[e * SLOTS + rb * 256 + wm * 64 + l31], gs1 = gsel[e * SLOTS + rb * 256 + wm * 64 + 32 + l31];
#pragma unroll
            for (int hb = 0; hb < 2; ++hb) {
#pragma unroll
                for (int tt = 0; tt < 2; ++tt) {
                    const float gs = tt ? gs1 : gs0;
#pragma unroll
                    for (int f2 = 0; f2 < 2; ++f2)
#pragma unroll
                        for (int g = 0; g < 4; ++g) { const f16v& a = acc[2 * hb + f2][tt]; stage64_write4(stg, tt * 32 + l31, f2 * 32 + 8 * g + 4 * h, a[4 * g] * gs, a[4 * g + 1] * gs, a[4 * g + 2] * gs, a[4 * g + 3] * gs); }
                }
                stage64_flush_bf16(stg, ye + ((size_t)e * SLOTS + rb * 256 + wm * 64) * D + cbk * 256 + wn * 128 + hb * 64, D, lane);
            }
        });
    }
}

struct AttnDesc {
    const bf16_t* q; int qstride;
    int ntiles, n0;
    const bf16_t *k0, *v0; int stride0;
    const bf16_t *k1, *v1; int stride1;
    int na;
    int r0, rlo;
    const float* rpb;
    bf16_t* out; int ostride;
    float* part;
};
constexpr int ATT_TILE = 64 * LROW;
DEV int na_row_start(int r) { int s = r - KR / 2; s = s < 0 ? 0 : s; return s > ROWS - KR ? ROWS - KR : s; }
DEV void attn_unit(char* smem, const AttnDesc& d) {
    const int tid = get_tid(), lane = tid & 63, wave = tid >> 6, h = lane >> 5, l31 = lane & 31;
    char* Ks = smem; char* Vs = smem + 2 * ATT_TILE; float* rpbS = (float*)(smem + 4 * ATT_TILE);
    if (d.na) { for (int i = tid; i < 15 * 31; i += 512) rpbS[i] = d.rpb[i] * 1.4426950408889634f; }
    const bf16_t* qp = d.q + (size_t)(wave * 32 + l31) * d.qstride + h * 8;
    s8v qf[4];
#pragma unroll
    for (int s = 0; s < 4; ++s) qf[s] = *(const s8v*)(qp + 16 * s);
    float m_run = -1e30f, l_run = 0.f;
    f16v o[2]; o[0] = f16zero(); o[1] = f16zero();
    const int srow = tid >> 3, sch = tid & 7;
    u4v kreg, vreg;
    auto gload = [&](int t) {
        const bf16_t *kp, *vp;
        if (t < d.n0) { const size_t off = (size_t)(t * 64 + srow) * d.stride0 + sch * 8; kp = d.k0 + off; vp = d.v0 + off; }
        else { const size_t off = (size_t)((t - d.n0) * 64 + srow) * d.stride1 + sch * 8; kp = d.k1 + off; vp = d.v1 + off; }
        kreg = *(const u4v*)kp; vreg = *(const u4v*)vp;
    };
    auto lstore = [&](int buf) { *(u4v*)(Ks + buf * ATT_TILE + srow * LROW + sch * 16) = kreg; *(u4v*)(Vs + buf * ATT_TILE + srow * LROW + sch * 16) = vreg; };
    const int qr = d.r0 + (wave >> 1), qw = (wave & 1) * 32 + l31;
    const int rs = na_row_start(qr);
    int cs = qw - KC / 2; cs = cs < 0 ? 0 : (cs > GRIDW - KC ? GRIDW - KC : cs);
    gload(0); lstore(0);
    __syncthreads();
    for (int t = 0; t < d.ntiles; ++t) {
        const int buf = t & 1;
        if (t + 1 < d.ntiles) gload(t + 1);
        const bool local = d.na && t >= d.n0;
        const int kr = d.rlo + (t - d.n0);
        const bool active = !local || (kr >= rs && kr < rs + KR);
        if (active) {
            const char* kb = Ks + buf * ATT_TILE + l31 * LROW + h * 16;
            f16v sa[2];
#pragma unroll
            for (int kt = 0; kt < 2; ++kt) {
                sa[kt] = f16zero();
#pragma unroll
                for (int s = 0; s < 4; ++s) { const s8v kf = *(const s8v*)(kb + kt * 32 * LROW + s * 32); sa[kt] = mfma32(kf, qf[s], sa[kt]); }
            }
            constexpr float C2 = ATT_SCALE * 1.4426950408889634f;
            float mx = -1e30f;
            if (local) {
#pragma unroll
                for (int kt = 0; kt < 2; ++kt)
#pragma unroll
                    for (int r = 0; r < 16; ++r) {
                        const int kc = kt * 32 + (r & 3) + 8 * (r >> 2) + 4 * h;
                        const bool inw = kc >= cs && kc < cs + KC;
                        const int bi = (kr - qr + 7) * 31 + (kc - qw + 15);
                        const float v = inw ? sa[kt][r] * C2 + rpbS[inw ? bi : 0] : -1e30f;
                        sa[kt][r] = v; mx = fmaxf(mx, v);
                    }
            } else {
#pragma unroll
                for (int kt = 0; kt < 2; ++kt)
#pragma unroll
                    for (int r = 0; r < 16; ++r) mx = fmaxf(mx, sa[kt][r]);
                mx *= C2;
            }
            mx = fmaxf(mx, __shfl_xor(mx, 32));
            if (__ballot(mx > m_run) != 0ull) {
                const float m_new = fmaxf(m_run, mx);
                const float alpha = fexp2(m_run - m_new);
                l_run *= alpha; m_run = m_new;
                o[0] *= alpha; o[1] *= alpha;
            }
            float ps = 0.f;
            if (local) {
#pragma unroll
                for (int kt = 0; kt < 2; ++kt)
#pragma unroll
                    for (int r = 0; r < 16; ++r) { const float pv = fexp2(sa[kt][r] - m_run); sa[kt][r] = pv; ps += pv; }
            } else {
#pragma unroll
                for (int kt = 0; kt < 2; ++kt)
#pragma unroll
                    for (int r = 0; r < 16; ++r) { const float pv = fexp2(sa[kt][r] * C2 - m_run); sa[kt][r] = pv; ps += pv; }
            }
            l_run += ps;
            const char* vb = Vs + buf * ATT_TILE + (4 * h + ((lane & 15) >> 2)) * LROW + (((lane >> 4) & 1) * 16 + 4 * (lane & 3)) * 2;
#pragma unroll
            for (int ks = 0; ks < 4; ++ks) {
                const int kt = ks >> 1, rb = 8 * (ks & 1);
                u4v pk; pk[0] = pack2(sa[kt][rb], sa[kt][rb + 1]); pk[1] = pack2(sa[kt][rb + 2], sa[kt][rb + 3]);
                pk[2] = pack2(sa[kt][rb + 4], sa[kt][rb + 5]); pk[3] = pack2(sa[kt][rb + 6], sa[kt][rb + 7]);
                const s8v pf = __builtin_bit_cast(s8v, pk);
                const char* vk = vb + (kt * 32 + 16 * (ks & 1)) * LROW;
#pragma unroll
                for (int dt = 0; dt < 2; ++dt) {
                    const s4v lo = lds_tr16(vk + dt * 64), hi = lds_tr16(vk + 8 * LROW + dt * 64);
                    s8v vf; vf[0] = lo[0]; vf[1] = lo[1]; vf[2] = lo[2]; vf[3] = lo[3]; vf[4] = hi[0]; vf[5] = hi[1]; vf[6] = hi[2]; vf[7] = hi[3];
                    o[dt] = mfma32(vf, pf, o[dt]);
                }
            }
        }
        if (t + 1 < d.ntiles) lstore(buf ^ 1);
        __syncthreads();
    }
    const float l_tot = l_run + __shfl_xor(l_run, 32);
    const int qrow = wave * 32 + l31;
    if (d.part) {
        float* po = d.part + (size_t)qrow * 64;
#pragma unroll
        for (int dt = 0; dt < 2; ++dt)
#pragma unroll
            for (int g = 0; g < 4; ++g) { f4v v; v[0] = o[dt][4 * g]; v[1] = o[dt][4 * g + 1]; v[2] = o[dt][4 * g + 2]; v[3] = o[dt][4 * g + 3]; *(f4v*)(po + dt * 32 + 8 * g + 4 * h) = v; }
        if (h == 0) { d.part[256 * 64 + qrow] = m_run; d.part[256 * 64 + 256 + qrow] = l_tot; }
    } else {
        const float inv = 1.f / l_tot;
        bf16_t* po = d.out + (size_t)qrow * d.ostride;
#pragma unroll
        for (int dt = 0; dt < 2; ++dt)
#pragma unroll
            for (int g = 0; g < 4; ++g) {
                u2v pk; pk[0] = pack2(o[dt][4 * g] * inv, o[dt][4 * g + 1] * inv); pk[1] = pack2(o[dt][4 * g + 2] * inv, o[dt][4 * g + 3] * inv);
                *(u2v*)(po + dt * 32 + 8 * g + 4 * h) = pk;
            }
    }
}

DEV int ml_sidx(int grp, int b, int head, int c) { return grp == 0 ? ((b * MLH + head) * NCH_P + c) : BATCH * MLH * NCH_P + ((b * MLH + head) * NCH_S + c); }
DEV float lane_prefix_sum(float v, int lane) { for (int dlt = 1; dlt < 64; dlt <<= 1) { const float o = __shfl(v, lane - dlt); if (lane >= dlt) v += o; } return v; }
DEV float lane_prefix_max(float v, int lane) { for (int dlt = 1; dlt < 64; dlt <<= 1) { const float o = __shfl(v, lane - dlt); if (lane >= dlt) v = fmaxf(v, o); } return v; }

DEV void mlstm_summary_unit(const Params& p, char* smem, int grp, int b, int head, int c) {
    const int tid = get_tid(), lane = tid & 63, wave = tid >> 6, h = lane >> 5, l31 = lane & 31;
    char* KT = smem;
    char* VT = smem + 2 * ATT_TILE;
    float* wsS = (float*)(smem + 3 * ATT_TILE);
    float* scal = wsS + 128;
    const int tb = (grp == 0 ? b * SEQ : NP + b * DEC_SEQ) + c * 64;
    const float* gates = (const float*)(p.ws + WS_GATES);
    if (wave == 0) {
        const float* gr = gates + (size_t)(tb + lane) * 16;
        const float i_f = gr[head], lf_f = logsigmoidf_(gr[4 + head]), i_b = gr[8 + head], lf_b = logsigmoidf_(gr[12 + head]);
        const float pf = lane_prefix_sum(lf_f, lane), pb = lane_prefix_sum(lf_b, lane);
        const float tot_f = __shfl(pf, 63), tot_b = __shfl(pb, 63);
        const float g_f = (tot_f - pf) + i_f, g_b = (pb - lf_b) + i_b;
        const float G_f = wave_max(g_f), G_b = wave_max(g_b);
        wsS[lane] = fexp(g_f - G_f); wsS[64 + lane] = fexp(g_b - G_b);
        if (lane == 0) { scal[0] = tot_f; scal[1] = tot_b; scal[2] = G_f; scal[3] = G_b; }
    }
    __syncthreads();
    {
        const int tau = tid >> 3, ch = tid & 7;
        const u4v kv = *(const u4v*)((const bf16_t*)(p.ws + WS_MLK) + (size_t)(tb + tau) * 256 + head * 64 + ch * 8);
        const u4v vv = *(const u4v*)((const bf16_t*)(p.ws + WS_MLV) + (size_t)(tb + tau) * 256 + head * 64 + ch * 8);
        const float wf = wsS[tau], wb = wsS[64 + tau];
#pragma unroll
        for (int j = 0; j < 8; ++j) {
            const bf16_t kb = (bf16_t)(kv[j >> 1] >> (16 * (j & 1))), vb = (bf16_t)(vv[j >> 1] >> (16 * (j & 1)));
            const int dim = ch * 8 + j; const float kf = bf2f(kb);
            *(bf16_t*)(KT + dim * LROW + tau * 2) = f2bf(kf * wf);
            *(bf16_t*)(KT + ATT_TILE + dim * LROW + tau * 2) = f2bf(kf * wb);
            *(bf16_t*)(VT + dim * LROW + tau * 2) = vb;
        }
    }
    __syncthreads();
    float* sum = (float*)(p.ws + WS_MLSUM);
    const int sidx = ml_sidx(grp, b, head, c);
    {
        const int dir = wave >> 2, mi = (wave >> 1) & 1, ni = wave & 1;
        f16v acc = f16zero();
#pragma unroll
        for (int s = 0; s < 4; ++s) {
            const s8v af = *(const s8v*)(KT + dir * ATT_TILE + (mi * 32 + l31) * LROW + (16 * s + 8 * h) * 2);
            const s8v bf = *(const s8v*)(VT + (ni * 32 + l31) * LROW + (16 * s + 8 * h) * 2);
            acc = mfma32(af, bf, acc);
        }
        bf16_t* U = (bf16_t*)(sum + (size_t)(sidx * 2 + dir) * MLSUM_STRIDE);
#pragma unroll
        for (int r = 0; r < 16; ++r) U[(mi * 32 + (r & 3) + 8 * (r >> 2) + 4 * h) * 64 + ni * 32 + l31] = f2bf(acc[r]);
    }
    if (tid < 128) {
        const int dir = tid >> 6, kd = tid & 63;
        float s = 0.f;
        for (int tau = 0; tau < 64; ++tau) s += bf2f(*(const bf16_t*)(KT + dir * ATT_TILE + kd * LROW + tau * 2));
        float* E = sum + (size_t)(sidx * 2 + dir) * MLSUM_STRIDE;
        E[ML_NU + kd] = s;
        if (kd == 0) { E[ML_AG] = scal[dir]; E[ML_AG + 1] = scal[2 + dir]; }
    }
    __syncthreads();
}

DEV void mlstm_output_unit(const Params& p, char* smem, int l, int grp, int b, int head, int c) {
    const int tid = get_tid(), lane = tid & 63, wave = tid >> 6, h = lane >> 5, l31 = lane & 31;
    const int nc = grp ? NCH_S : NCH_P;
    char* Qs = smem;
    char* Ks = smem + 2 * ATT_TILE;
    char* VT = smem + 4 * ATT_TILE;
    char* CT = smem + 6 * ATT_TILE;
    char* QK = smem + 8 * ATT_TILE;
    float* hS = (float*)(smem + 10 * ATT_TILE);
    float* vec = hS + 2 * 64 * 68;
    float* aS = vec; float* MjS = vec + 128; float* bS = vec + 256; float* nS = vec + 384; float* denp = vec + 512; float* qnS = vec + 768; float* scal = vec + 896;
    const int tb = (grp == 0 ? b * SEQ : NP + b * DEC_SEQ) + c * 64;
    const float* sum = (const float*)(p.ws + WS_MLSUM);
    const size_t qoff = (size_t)(tb + (tid >> 3)) * 256 + head * 64 + (tid & 7) * 8;
    const u4v q_r = *(const u4v*)((const bf16_t*)(p.ws + WS_MLQ) + qoff);
    const u4v k_r = *(const u4v*)((const bf16_t*)(p.ws + WS_MLK) + qoff);
    const u4v v_r = *(const u4v*)((const bf16_t*)(p.ws + WS_MLV) + qoff);
    const u4v o_r = *(const u4v*)((const bf16_t*)(p.ws + WS_MLO) + qoff);
    float g_i = 0.f, g_f = 0.f;
    if (wave < 2) { const float* gr = (const float*)(p.ws + WS_GATES) + (size_t)(tb + (wave ? 63 - lane : lane)) * 16; g_i = gr[wave * 8 + head]; g_f = gr[wave * 8 + 4 + head]; }
#pragma unroll
    for (int dir = 0; dir < 2; ++dir) {
        float C[8], nst = 0.f, m;
        if (grp == 0) {
#pragma unroll
            for (int i = 0; i < 8; ++i) C[i] = 0.f;
            m = 0.f;
        } else {
            const size_t sb = (((size_t)b * DEPTH + l) * 2 + dir) * MLH + head;
#pragma unroll
            for (int i = 0; i < 8; ++i) C[i] = p.in[I_SC][sb * 4096 + 8 * tid + i];
            if (tid < 64) nst = p.in[I_SN][sb * 64 + tid];
            m = p.in[I_SM][sb];
        }
        const int nsteps = dir == 0 ? c : nc - 1 - c;
        const bool fin = (grp == 0) && (dir == 0 ? c == nc - 1 : c == 0);
        {
            float A = 0.f, G = -1e30f;
            if (lane < nsteps) { const float* E = sum + (size_t)(ml_sidx(grp, b, head, dir == 0 ? lane : nc - 1 - lane) * 2 + dir) * MLSUM_STRIDE; A = E[ML_AG]; G = E[ML_AG + 1]; }
            const float P = lane_prefix_sum(A, lane);
            const float T = __shfl(P, 63);
            const float ev = lane < nsteps ? G + (T - P) : -1e30f;
            const float mc = fmaxf(m + T, wave_max(ev));
            const float coef = lane < nsteps ? fexp(ev - mc) : 0.f;
            const float coef0 = fexp(m + T - mc);
#pragma unroll
            for (int i = 0; i < 8; ++i) C[i] *= coef0;
            nst *= coef0;
#pragma unroll 4
            for (int st = 0; st < nsteps; ++st) {
                const float* E = sum + (size_t)(ml_sidx(grp, b, head, dir == 0 ? st : nc - 1 - st) * 2 + dir) * MLSUM_STRIDE;
                const float cf = __shfl(coef, st);
                const u4v uu = *(const u4v*)((const bf16_t*)E + 8 * tid);
#pragma unroll
                for (int i = 0; i < 8; ++i) C[i] += cf * bf2f((bf16_t)(uu[i >> 1] >> (16 * (i & 1))));
                if (tid < 64) nst += cf * E[ML_NU + tid];
            }
            m = mc;
        }
#pragma unroll
        for (int i = 0; i < 8; ++i) { const int e = 8 * tid + i; *(bf16_t*)(CT + dir * ATT_TILE + (e & 63) * LROW + (e >> 6) * 2) = f2bf(C[i]); }
        if (tid < 64) nS[dir * 64 + tid] = nst;
        if (tid == 0) scal[dir] = m;
        if (fin) {
            const float* E = sum + (size_t)(ml_sidx(grp, b, head, c) * 2 + dir) * MLSUM_STRIDE;
            const float A = E[ML_AG], G = E[ML_AG + 1];
            const float m_new = fmaxf(A + m, G);
            const float sc = fexp(A + m - m_new), su = fexp(G - m_new);
            const size_t ob = (((size_t)b * DEPTH + l) * 2 + dir) * MLH + head;
            const u4v uo = *(const u4v*)((const bf16_t*)E + 8 * tid);
#pragma unroll
            for (int i = 0; i < 8; ++i) p.out[O_MC + ob * 4096 + 8 * tid + i] = sc * C[i] + su * bf2f((bf16_t)(uo[i >> 1] >> (16 * (i & 1))));
            if (tid < 64) p.out[O_MN + ob * 64 + tid] = sc * nst + su * E[ML_NU + tid];
            if (tid == 0) p.out[O_MM + ob] = m_new;
        }
    }
    {
        const int row = tid >> 3, ch = tid & 7;
#pragma unroll
        for (int dir = 0; dir < 2; ++dir) {
            const int pr = dir ? 63 - row : row;
            *(u4v*)(Qs + dir * ATT_TILE + pr * LROW + ch * 16) = q_r;
            *(u4v*)(Ks + dir * ATT_TILE + pr * LROW + ch * 16) = k_r;
#pragma unroll
            for (int j = 0; j < 8; ++j) *(bf16_t*)(VT + dir * ATT_TILE + (ch * 8 + j) * LROW + pr * 2) = (bf16_t)(v_r[j >> 1] >> (16 * (j & 1)));
        }
    }
    __syncthreads();
    if (wave < 2) {
        const int dir = wave;
        const float ig = g_i, lf = logsigmoidf_(g_f);
        const float bj = lane_prefix_sum(lf, lane);
        const float a = ig - bj;
        const float Pj = lane_prefix_max(a, lane);
        aS[dir * 64 + lane] = a; bS[dir * 64 + lane] = bj; MjS[dir * 64 + lane] = fmaxf(scal[dir], Pj);
    } else if (wave < 4) {
        const int dir = wave - 2;
        float s = 0.f;
        for (int k = 0; k < 64; ++k) s += bf2f(*(const bf16_t*)(Qs + dir * ATT_TILE + lane * LROW + k * 2)) * nS[dir * 64 + k];
        qnS[dir * 64 + lane] = s;
    }
    __syncthreads();
    const int dir = wave >> 2, rt = (wave >> 1) & 1, jt = wave & 1;
    const int j = jt * 32 + l31;
    const float Mj = MjS[dir * 64 + j];
    {
        f16v acc = f16zero();
#pragma unroll
        for (int s4 = 0; s4 < 4; ++s4) {
            const s8v af = *(const s8v*)(Ks + dir * ATT_TILE + (rt * 32 + l31) * LROW + (16 * s4 + 8 * h) * 2);
            const s8v bf = *(const s8v*)(Qs + dir * ATT_TILE + j * LROW + (16 * s4 + 8 * h) * 2);
            acc = mfma32(af, bf, acc);
        }
        float dsum = 0.f;
#pragma unroll
        for (int g = 0; g < 4; ++g) {
            float o[4];
#pragma unroll
            for (int q = 0; q < 4; ++q) {
                const int s = rt * 32 + 8 * g + 4 * h + q;
                const float w = s <= j ? fexp(aS[dir * 64 + s] - Mj) : 0.f;
                o[q] = acc[4 * g + q] * w; dsum += o[q];
            }
            u2v pk; pk[0] = pack2(o[0], o[1]); pk[1] = pack2(o[2], o[3]);
            *(u2v*)(QK + dir * ATT_TILE + j * LROW + (rt * 32 + 8 * g + 4 * h) * 2) = pk;
        }
        dsum += __shfl_xor(dsum, 32);
        if (h == 0) denp[(dir * 2 + rt) * 64 + j] = dsum;
    }
    __syncthreads();
    {
        const float mst = scal[dir];
        const float decay = fexp(mst - Mj);
        f16v acc = f16zero();
#pragma unroll
        for (int s4 = 0; s4 < 4; ++s4) {
            const s8v af = *(const s8v*)(CT + dir * ATT_TILE + (rt * 32 + l31) * LROW + (16 * s4 + 8 * h) * 2);
            const s8v bf = *(const s8v*)(Qs + dir * ATT_TILE + j * LROW + (16 * s4 + 8 * h) * 2);
            acc = mfma32(af, bf, acc);
        }
        acc *= decay;
#pragma unroll
        for (int s4 = 0; s4 < 4; ++s4) {
            const s8v af = *(const s8v*)(VT + dir * ATT_TILE + (rt * 32 + l31) * LROW + (16 * s4 + 8 * h) * 2);
            const s8v bf = *(const s8v*)(QK + dir * ATT_TILE + j * LROW + (16 * s4 + 8 * h) * 2);
            acc = mfma32(af, bf, acc);
        }
        const float den = decay * qnS[dir * 64 + j] + denp[(dir * 2) * 64 + j] + denp[(dir * 2 + 1) * 64 + j];
        const float dn = fmaxf(fabsf(den), fexp(-(bS[dir * 64 + j] + Mj)));
        const float inv = 1.f / dn;
#pragma unroll
        for (int g = 0; g < 4; ++g) { f4v o; o[0] = acc[4 * g] * inv; o[1] = acc[4 * g + 1] * inv; o[2] = acc[4 * g + 2] * inv; o[3] = acc[4 * g + 3] * inv;
            *(f4v*)(hS + (dir * 64 + j) * 68 + rt * 32 + 8 * g + 4 * h) = o; }
    }
    __syncthreads();
    {
        const int tau = tid >> 3, v8 = (tid & 7) * 8;
        float hv[8]; float s = 0.f;
#pragma unroll
        for (int q = 0; q < 8; ++q) { hv[q] = hS[tau * 68 + v8 + q] + hS[(64 + 63 - tau) * 68 + v8 + q]; s += hv[q]; }
        s += __shfl_xor(s, 1); s += __shfl_xor(s, 2); s += __shfl_xor(s, 4);
        const float mu = s * (1.f / 64.f);
        float qq = 0.f;
#pragma unroll
        for (int q = 0; q < 8; ++q) { const float dlt = hv[q] - mu; qq += dlt * dlt; }
        qq += __shfl_xor(qq, 1); qq += __shfl_xor(qq, 2); qq += __shfl_xor(qq, 4);
        const float rstd = frsqrt(qq * (1.f / 64.f) + EPS);
        const int t = tb + tau;
        const u4v ov = o_r;
        const float* ng = p.in[I_MLG] + (size_t)l * 256 + head * 64 + v8;
        float o[8];
#pragma unroll
        for (int q = 0; q < 8; ++q) { const float og = bf2f((bf16_t)(ov[q >> 1] >> (16 * (q & 1)))); o[q] = (hv[q] - mu) * rstd * ng[q] * sigmoidf_(og); }
        u4v pk; pk[0] = pack2(o[0], o[1]); pk[1] = pack2(o[2], o[3]); pk[2] = pack2(o[4], o[5]); pk[3] = pack2(o[6], o[7]);
        *(u4v*)((bf16_t*)(p.ws + WS_MIXED) + (size_t)t * MIXW + 384 + head * 64 + v8) = pk;
    }
    __syncthreads();
}

DEV int queue_next(const Params& p, char* smem, int qi) {
    int* slot = (int*)(smem + SMEM_XB + 32);
    __syncthreads();
    if (threadIdx.x == 0) {
#ifdef EMU
        unsigned* w = (unsigned*)(p.ws + WS_BAR) + QUEUE_WORD0 + 64 * qi; *slot = (int)(*w)++;
#else
        *slot = (int)__hip_atomic_fetch_add((unsigned*)(p.ws + WS_BAR) + QUEUE_WORD0 + 64 * qi, 1u, __ATOMIC_RELAXED, __HIP_MEMORY_SCOPE_AGENT);
#endif
    }
    __syncthreads();
    return *slot;
}
DEV void phase_attn(const Params& p, char* smem, int l, int qi) {
    constexpr int QB_S = DEC_SEQ / 256, QB_P = SEQ / 256;
    constexpr int U_SG = DEC_BATCH * GQH * QB_S * 2, U_SN = DEC_BATCH * NAH * QB_S, U_PN = BATCH * NAH * QB_P, U_PG = BATCH * GQH * QB_P;
    constexpr int U_MP = BATCH * MLH * NCH_P, U_MS = DEC_BATCH * MLH * NCH_S;
    constexpr int NU = U_SG + U_SN + U_PN + U_PG + U_MP + U_MS;
    const bf16_t* naq = (const bf16_t*)(p.ws + WS_NAQ); const bf16_t* nak = (const bf16_t*)(p.ws + WS_NAK); const bf16_t* nav = (const bf16_t*)(p.ws + WS_NAV);
    const bf16_t* gqq = (const bf16_t*)(p.ws + WS_GQQ); const bf16_t* gqk = (const bf16_t*)(p.ws + WS_GQK); const bf16_t* gqv = (const bf16_t*)(p.ws + WS_GQV);
    bf16_t* mixed = (bf16_t*)(p.ws + WS_MIXED);
    for (;;) {
        int u = queue_next(p, smem, qi);
        if (u >= NU) break;
#ifdef PROBE_ATT
        if (qi >= 8) { const int cls = u < U_SG ? 1 : u < U_SG + U_SN ? 2 : u < U_SG + U_SN + U_PN + U_PG ? 3 : 4; if (cls != PROBE_ATT) continue; }
#endif
        AttnDesc d; d.na = 0; d.r0 = 0; d.rlo = 0; d.rpb = nullptr; d.part = nullptr; d.out = nullptr; d.ostride = MIXW; d.n0 = 0; d.k0 = d.v0 = nullptr; d.stride0 = 0;
        if (u < U_SG) {
            const int half = u & 1, qb = (u >> 1) % QB_S, qh = (u / (2 * QB_S)) % GQH, b = u / (2 * QB_S * GQH);
            const int kvh = qh / (GQH / GQKV);
            constexpr int NCT = PAST / 64, TT = NCT + DEC_SEQ / 64, H0 = TT / 2;
            const size_t tq = (size_t)NP + (size_t)b * DEC_SEQ + qb * 256;
            d.q = gqq + tq * 384 + qh * 64; d.qstride = 384;
            const bf16_t* lk = gqk + ((size_t)NP + (size_t)b * DEC_SEQ) * 128 + kvh * 64; const bf16_t* lv = gqv + ((size_t)NP + (size_t)b * DEC_SEQ) * 128 + kvh * 64;
            if (half == 0) {
                d.n0 = NCT; d.ntiles = H0; d.stride0 = 128;
                const size_t co = (((size_t)b * DEPTH + l) * PAST) * 128 + kvh * 64;
                d.k0 = (const bf16_t*)(p.ws + WS_CGQK) + co; d.v0 = (const bf16_t*)(p.ws + WS_CGQV) + co;
                d.k1 = lk; d.v1 = lv; d.stride1 = 128;
            } else {
                d.n0 = 0; d.ntiles = TT - H0; d.stride1 = 128;
                d.k1 = lk + (size_t)(H0 - NCT) * 64 * 128; d.v1 = lv + (size_t)(H0 - NCT) * 64 * 128;
            }
            d.part = (float*)(p.ws + WS_PART) + (size_t)u * PART_STRIDE;
        } else if (u < U_SG + U_SN) {
            const int uu = u - U_SG; const int qb = uu % QB_S, hd = (uu / QB_S) % NAH, b = uu / (QB_S * NAH);
            const size_t t0 = (size_t)NP + (size_t)b * DEC_SEQ;
            d.q = naq + (t0 + qb * 256) * 384 + hd * 64; d.qstride = 384;
            d.na = 1; d.r0 = qb * 4; d.rlo = na_row_start(d.r0);
            const int rhi = na_row_start(d.r0 + 3) + KR;
            d.n0 = PAST / 64; d.ntiles = d.n0 + (rhi - d.rlo); d.stride0 = 384; d.stride1 = 384;
            const size_t co = (((size_t)b * DEPTH + l) * PAST) * 384 + hd * 64;
            d.k0 = (const bf16_t*)(p.ws + WS_CNAK) + co; d.v0 = (const bf16_t*)(p.ws + WS_CNAV) + co;
            d.k1 = nak + (t0 + (size_t)d.rlo * 64) * 384 + hd * 64; d.v1 = nav + (t0 + (size_t)d.rlo * 64) * 384 + hd * 64;
            d.rpb = p.in[I_RPB] + ((size_t)l * NAH + hd) * 15 * 31;
            d.out = mixed + (t0 + qb * 256) * MIXW + hd * 64;
        } else if (u < U_SG + U_SN + U_PN) {
            const int uu = u - U_SG - U_SN; const int qb = uu % QB_P, hd = (uu / QB_P) % NAH, b = uu / (QB_P * NAH);
            const size_t t0 = (size_t)b * SEQ;
            d.q = naq + (t0 + qb * 256) * 384 + hd * 64; d.qstride = 384;
            d.n0 = 0; d.ntiles = SEQ / 64; d.stride1 = 384; d.k1 = nak + t0 * 384 + hd * 64; d.v1 = nav + t0 * 384 + hd * 64;
            d.out = mixed + (t0 + qb * 256) * MIXW + hd * 64;
        } else if (u < U_SG + U_SN + U_PN + U_PG) {
            const int uu = u - U_SG - U_SN - U_PN; const int qb = uu % QB_P, qh = (uu / QB_P) % GQH, b = uu / (QB_P * GQH);
            const int kvh = qh / (GQH / GQKV);
            const size_t t0 = (size_t)b * SEQ;
            d.q = gqq + (t0 + qb * 256) * 384 + qh * 64; d.qstride = 384;
            d.n0 = 0; d.ntiles = SEQ / 64; d.stride1 = 128; d.k1 = gqk + t0 * 128 + kvh * 64; d.v1 = gqv + t0 * 128 + kvh * 64;
            d.out = mixed + (t0 + qb * 256) * MIXW + 640 + qh * 64;
        } else {
            int uu = u - (U_SG + U_SN + U_PN + U_PG); const int grp = uu >= U_MP ? 1 : 0; if (grp) uu -= U_MP;
            const int nch = grp ? NCH_S : NCH_P;
            mlstm_summary_unit(p, smem, grp, uu / (nch * MLH), (uu / nch) % MLH, uu % nch);
        }
        if (u < U_SG + U_SN + U_PN + U_PG) attn_unit(smem, d);
    }
}

DEV void phase_mlout(const Params& p, char* smem, int l) {
    constexpr int QB_S = DEC_SEQ / 256;
    constexpr int U_MS = DEC_BATCH * MLH * NCH_S, U_MP = BATCH * MLH * NCH_P, U_CB = DEC_BATCH * GQH * QB_S;
    const int tid = get_tid(), lane = tid & 63, wave = tid >> 6;
    for (int tk = blockIdx.x + gridDim.x * wave; tk < U_CB * 4; tk += gridDim.x * 8) {
        const int uu = tk >> 2, sl = tk & 3;
        const int qb = uu % QB_S, qh = (uu / QB_S) % GQH, b = uu / (QB_S * GQH);
        const float* p0 = (const float*)(p.ws + WS_PART) + (size_t)(2 * uu) * PART_STRIDE; const float* p1 = p0 + PART_STRIDE;
        const int q = sl * 64 + (lane >> 1) + 32 * 0, d0 = (lane & 1) * 32;
#pragma unroll
        for (int hq = 0; hq < 2; ++hq) {
            const int qq = q + 32 * hq;
            const float m0 = p0[256 * 64 + qq], m1 = p1[256 * 64 + qq], l0 = p0[256 * 64 + 256 + qq], l1 = p1[256 * 64 + 256 + qq];
            const float m = fmaxf(m0, m1), w0 = fexp2(m0 - m), w1 = fexp2(m1 - m);
            const float inv = 1.f / (l0 * w0 + l1 * w1);
            bf16_t* dst = (bf16_t*)(p.ws + WS_MIXED) + ((size_t)NP + (size_t)b * DEC_SEQ + qb * 256 + qq) * MIXW + 640 + qh * 64 + d0;
#pragma unroll
            for (int i = 0; i < 8; ++i) {
                const f4v a = *(const f4v*)(p0 + (size_t)qq * 64 + d0 + 4 * i), bb = *(const f4v*)(p1 + (size_t)qq * 64 + d0 + 4 * i);
                u2v pk; pk[0] = pack2((a[0] * w0 + bb[0] * w1) * inv, (a[1] * w0 + bb[1] * w1) * inv); pk[1] = pack2((a[2] * w0 + bb[2] * w1) * inv, (a[3] * w0 + bb[3] * w1) * inv);
                *(u2v*)(dst + 4 * i) = pk;
            }
        }
    }
    for (int u = blockIdx.x; u < U_MS + U_MP; u += gridDim.x) {
        const int grp = u < U_MS ? 1 : 0; const int uu = grp ? u : u - U_MS; const int nch = grp ? NCH_S : NCH_P;
        mlstm_output_unit(p, smem, l, grp, uu / (nch * MLH), (uu / nch) % MLH, uu % nch);
    }
}

constexpr int N_PHASES = 2 + 9 * DEPTH;
#ifndef EMU
typedef const __attribute__((address_space(4))) Params* KParamsPtr;
DEV void load_params(Params& p) {
    KParamsPtr kp = (KParamsPtr)__builtin_amdgcn_kernarg_segment_ptr();
    asm volatile("" : "+s"(kp));
#pragma unroll
    for (int i = 0; i < N_IN; ++i) p.in[i] = kp->in[i];
    p.out = kp->out; p.ws = kp->ws; p.ph0 = kp->ph0; p.ph1 = kp->ph1;
}
#endif
#ifdef EMU
static char emu_smem[SMEM_BYTES + 64];
#endif
__global__ void __launch_bounds__(512, 2) mega_kernel(Params p_) {
    const int ph0 = p_.ph0, ph1 = p_.ph1;
#ifdef EMU
    char* smem = emu_smem;
#define GRID_SYNC() do {} while (0)
#else
    extern __shared__ __attribute__((aligned(16))) char smem[];
    if (threadIdx.x == 0) *(u4v*)(smem + SMEM_XB) = (u4v){0u, 0u, 0u, 0u};
    __syncthreads();
    (void)xcd_barrier_post((unsigned*)(p_.ws + WS_BAR), (volatile LAS unsigned*)(smem + SMEM_XB));
    const bool multi = (ph1 - ph0) > 1;
#define GRID_SYNC() do { if (multi) { KParamsPtr kpb = (KParamsPtr)__builtin_amdgcn_kernarg_segment_ptr(); asm volatile("" : "+s"(kpb)); \
        XcdBarrier xb; xb.bar = (unsigned*)(kpb->ws + WS_BAR); xb.x = xb_xcc_id(); xb.st = (volatile LAS unsigned*)(smem + SMEM_XB); xcd_barrier(xb); } } while (0)
#endif
    int ph = 0;
#ifndef KIND_MASK
#define KIND_MASK 0x3ff
#endif
#ifdef EMU
#define LOAD_PARAMS() const Params& p = p_
#else
#define LOAD_PARAMS() Params p; load_params(p)
#endif
#ifndef DOUBLE_MASK
#define DOUBLE_MASK 0
#endif
#define PH_KIND() (ph == 0 ? 0 : ph == 1 + 9 * DEPTH ? 1 : 1 + (ph - 1) % 9)
#define RUN_PHASE(body) do { if (((KIND_MASK >> PH_KIND()) & 1) && ph >= ph0 && ph < ph1) { \
    if (DOUBLE_MASK && ((DOUBLE_MASK >> PH_KIND()) & 1)) { { const int rep_ = 1; LOAD_PARAMS(); body; } GRID_SYNC(); } \
    { const int rep_ = 0; LOAD_PARAMS(); body; } if (ph + 1 < ph1) GRID_SYNC(); } ++ph; } while (0)
    RUN_PHASE(phase_ada(p, smem));
    for (int l = 0; l < DEPTH; ++l) {
        RUN_PHASE(phase_rows<0>(p, smem, l));
        RUN_PHASE(phase_inproj<0>(p, smem, l));
        RUN_PHASE(phase_attn(p, smem, l, l + DEPTH * rep_));
        RUN_PHASE(phase_mlout(p, smem, l));
        RUN_PHASE(phase_outproj<0>(p, smem, l));
        RUN_PHASE(phase_rows<1>(p, smem, l));
        RUN_PHASE(phase_topk(p, smem));
        RUN_PHASE(phase_gateup<0>(p, smem, l));
        RUN_PHASE(phase_down<0>(p, smem, l));
    }
    RUN_PHASE(phase_rows<0>(p, smem, DEPTH));
#ifdef PROBE_BARRIERS
    for (int i = 0; i < PROBE_BARRIERS; ++i) GRID_SYNC();
#endif
}

#if !defined(EMU) && defined(PROBE_KIND)
__global__ void __launch_bounds__(512, 2) probe_kernel(Params p) {
    extern __shared__ __attribute__((aligned(16))) char smem[];
    for (int r = 0; r < PROBE_REPS; ++r) {
#if PROBE_KIND == 8
        phase_gateup<PROBE_VAR>(p, smem, 1);
#elif PROBE_KIND == 9
        phase_down<PROBE_VAR>(p, smem, 1);
#elif PROBE_KIND == 2
        phase_inproj<PROBE_VAR>(p, smem, 1);
#elif PROBE_KIND == 5
        phase_outproj<PROBE_VAR>(p, smem, 1);
#elif PROBE_KIND == 0
        phase_ada(p, smem);
#elif PROBE_KIND == 1
        phase_rows<0>(p, smem, 1);
#elif PROBE_KIND == 6
        phase_rows<1>(p, smem, 1);
#elif PROBE_KIND == 7
        phase_topk(p, smem);
#elif PROBE_KIND == 3
        phase_attn(p, smem, 1, 8 + r);
#elif PROBE_KIND == 4
        phase_mlout(p, smem, 1);
#endif
        __syncthreads();
    }
}
#endif
#ifndef EMU
#ifndef MK_N_LAUNCHES
#define MK_N_LAUNCHES 1
#endif
extern "C" void kernel_launch(void* const* d_in, const int* in_sizes, int n_in, void* d_out, int out_size, void* d_ws, size_t ws_size, hipStream_t stream) {
    (void)in_sizes; (void)n_in; (void)out_size; (void)ws_size;
    static int grid = 0;
    if (!grid) {
        int dev = 0, cus = 0, per_cu = 0;
        (void)hipGetDevice(&dev);
        (void)hipDeviceGetAttribute(&cus, hipDeviceAttributeMultiprocessorCount, dev);
        (void)hipFuncSetAttribute((const void*)mega_kernel, hipFuncAttributeMaxDynamicSharedMemorySize, SMEM_BYTES);
        (void)hipOccupancyMaxActiveBlocksPerMultiprocessor(&per_cu, mega_kernel, 512, SMEM_BYTES);
        grid = cus * (per_cu < 1 ? per_cu : 1);
        if (grid <= 0) grid = cus;
    }
    (void)hipMemsetAsync((char*)d_ws + WS_BAR, 0, WS_BAR_BYTES, stream);
    Params p = {};
    for (int i = 0; i < N_IN; ++i) p.in[i] = (const float*)d_in[i];
    p.out = (float*)d_out; p.ws = (char*)d_ws;
#if MK_N_LAUNCHES == 1
    p.ph0 = 0; p.ph1 = N_PHASES;
    mega_kernel<<<dim3(grid), dim3(512), SMEM_BYTES, stream>>>(p);
#ifdef PROBE_KIND
    (void)hipFuncSetAttribute((const void*)probe_kernel, hipFuncAttributeMaxDynamicSharedMemorySize, SMEM_BYTES);
    probe_kernel<<<dim3(grid), dim3(512), SMEM_BYTES, stream>>>(p);
#endif
#else
    for (int ph = 0; ph < N_PHASES; ++ph) { p.ph0 = ph; p.ph1 = ph + 1; mega_kernel<<<dim3(grid), dim3(512), SMEM_BYTES, stream>>>(p); }
#endif
}
#endif
```

```cpp
#ifndef EMU
#include <hip/hip_runtime.h>
#define DEV __device__ __forceinline__
#else
#define DEV static inline __attribute__((always_inline))
#endif
#include <stdint.h>
#include <stddef.h>

#ifndef CFG_D
#define CFG_D 1024
#define CFG_BATCH 16
#define CFG_SEQ 256
#define CFG_DEC_BATCH 2
#define CFG_DEC_SEQ 2048
#define CFG_PAST 256
#define CFG_EH 2816
#endif
constexpr int D = CFG_D, BATCH = CFG_BATCH, SEQ = CFG_SEQ, DEC_BATCH = CFG_DEC_BATCH, DEC_SEQ = CFG_DEC_SEQ, PAST = CFG_PAST, EH = CFG_EH;
constexpr int DEPTH = 2, HD = 64, NAH = 6, MLH = 4, GQH = 6, GQKV = 2, NEXP = 16, GRIDW = 64;
constexpr int NP = BATCH * SEQ, NS = DEC_BATCH * DEC_SEQ, NT = NP + NS, NCOND = 1 + DEC_BATCH;
constexpr int PROJ_W = 2832, MIXW = 1024;
constexpr int CAP_P = SEQ / 8, CAP_S = DEC_SEQ / 8, SLOTS = BATCH * CAP_P + DEC_BATCH * CAP_S;
constexpr int ROWS = DEC_SEQ / GRIDW, KR = ROWS < 8 ? ROWS : 8, KC = 16;
constexpr int NCH_P = SEQ / 64, NCH_S = DEC_SEQ / 64;
constexpr float ALPHA = 1.41421356237309515f;
constexpr float ATT_SCALE = 0.125f;
constexpr float EPS = 1e-6f;
static_assert(SLOTS % 256 == 0 && NP % 256 == 0 && NS % 256 == 0 && SEQ % 256 == 0 && DEC_SEQ % 256 == 0, "tile divisibility");
static_assert(D % 256 == 0 && EH % 128 == 0 && PAST % 64 == 0, "tile divisibility");

typedef unsigned short bf16_t;
typedef short s8v __attribute__((ext_vector_type(8)));
typedef short s4v __attribute__((ext_vector_type(4)));
typedef float f16v __attribute__((ext_vector_type(16)));
typedef float f4v __attribute__((ext_vector_type(4)));
typedef unsigned u4v __attribute__((ext_vector_type(4)));
typedef unsigned u2v __attribute__((ext_vector_type(2)));

enum { I_XP = 0, I_XS, I_C, I_CNAK, I_CNAV, I_CGQK, I_CGQV, I_SC, I_SN, I_SM, I_CCTX, I_ADAW, I_ADAB, I_WIN, I_BGATE, I_WOUT, I_RPB, I_QKG, I_MLG,
       I_LNG, I_LNB, I_RW, I_WG, I_WU, I_WD, N_IN };

constexpr size_t O_YP = 0;
constexpr size_t O_YS = O_YP + (size_t)NP * D;
constexpr size_t O_NAK = O_YS + (size_t)NS * D;
constexpr size_t O_NAV = O_NAK + (size_t)BATCH * DEPTH * SEQ * NAH * HD;
constexpr size_t O_GQK = O_NAV + (size_t)BATCH * DEPTH * SEQ * NAH * HD;
constexpr size_t O_GQV = O_GQK + (size_t)BATCH * DEPTH * SEQ * GQKV * HD;
constexpr size_t O_MC = O_GQV + (size_t)BATCH * DEPTH * SEQ * GQKV * HD;
constexpr size_t O_MN = O_MC + (size_t)BATCH * DEPTH * 2 * MLH * HD * HD;
constexpr size_t O_MM = O_MN + (size_t)BATCH * DEPTH * 2 * MLH * HD;
constexpr size_t O_END = O_MM + (size_t)BATCH * DEPTH * 2 * MLH;

constexpr size_t al256(size_t x) { return (x + 255) & ~(size_t)255; }
constexpr size_t WS_BAR = 0;
constexpr size_t WS_BAR_BYTES = 32768;
constexpr size_t WS_MODS = WS_BAR + WS_BAR_BYTES;
constexpr size_t WS_ROPE = al256(WS_MODS + (size_t)DEPTH * NCOND * 6 * D * 4);
constexpr size_t WS_CNAK = al256(WS_ROPE + 64 * 16 * 2 * 4);
constexpr size_t WS_CNAV = al256(WS_CNAK + (size_t)DEC_BATCH * DEPTH * PAST * NAH * HD * 2);
constexpr size_t WS_CGQK = al256(WS_CNAV + (size_t)DEC_BATCH * DEPTH * PAST * NAH * HD * 2);
constexpr size_t WS_CGQV = al256(WS_CGQK + (size_t)DEC_BATCH * DEPTH * PAST * GQKV * HD * 2);
constexpr size_t WS_XBUF = al256(WS_CGQV + (size_t)DEC_BATCH * DEPTH * PAST * GQKV * HD * 2);
constexpr size_t WS_HMOD = al256(WS_XBUF + (size_t)NT * D * 4);
constexpr size_t WS_GATES = al256(WS_HMOD + (size_t)NT * D * 2);
constexpr size_t WS_NAQ = al256(WS_GATES + (size_t)NT * 16 * 4);
constexpr size_t WS_NAK = al256(WS_NAQ + (size_t)NT * 384 * 2);
constexpr size_t WS_NAV = al256(WS_NAK + (size_t)NT * 384 * 2);
constexpr size_t WS_MLQ = al256(WS_NAV + (size_t)NT * 384 * 2);
constexpr size_t WS_MLK = al256(WS_MLQ + (size_t)NT * 256 * 2);
constexpr size_t WS_MLV = al256(WS_MLK + (size_t)NT * 256 * 2);
constexpr size_t WS_MLO = al256(WS_MLV + (size_t)NT * 256 * 2);
constexpr size_t WS_GQQ = al256(WS_MLO + (size_t)NT * 256 * 2);
constexpr size_t WS_GQK = al256(WS_GQQ + (size_t)NT * 384 * 2);
constexpr size_t WS_GQV = al256(WS_GQK + (size_t)NT * 128 * 2);
constexpr size_t WS_MIXED = al256(WS_GQV + (size_t)NT * 128 * 2);
constexpr size_t WS_U = al256(WS_MIXED + (size_t)NT * MIXW * 2);
constexpr size_t WS_X1 = al256(WS_U + (size_t)NT * D * 4);
constexpr size_t WS_H2 = al256(WS_X1 + (size_t)NT * D * 4);
constexpr size_t WS_AFF = al256(WS_H2 + (size_t)NT * D * 2);
constexpr size_t WS_IDX = al256(WS_AFF + (size_t)NT * 16 * 4);
constexpr size_t WS_GSEL = al256(WS_IDX + (size_t)NEXP * SLOTS * 4);
constexpr size_t WS_TOKSLOT = al256(WS_GSEL + (size_t)NEXP * SLOTS * 4);
constexpr size_t WS_HID = al256(WS_TOKSLOT + (size_t)NT * 16 * 4);
constexpr size_t WS_YE = al256(WS_HID + (size_t)NEXP * SLOTS * EH * 2);
constexpr int ML_NU = 2048, ML_AG = 2112;
constexpr int MLSUM_STRIDE = 2048 + 64 + 64;
constexpr int N_MLSUM = (BATCH * NCH_P + DEC_BATCH * NCH_S) * MLH * 2;
constexpr size_t WS_MLSUM = al256(WS_YE + (size_t)NEXP * SLOTS * D * 2);
constexpr int PART_STRIDE = 256 * 64 + 512;
constexpr int N_PART = DEC_BATCH * GQH * (DEC_SEQ / 256) * 2;
constexpr size_t WS_PART = al256(WS_MLSUM + (size_t)N_MLSUM * MLSUM_STRIDE * 4);
constexpr size_t WS_TOTAL = al256(WS_PART + (size_t)N_PART * PART_STRIDE * 4);

struct Params {
    const float* in[N_IN];
    float* out;
    char* ws;
    int ph0, ph1;
};

DEV float bf2f(bf16_t s) { unsigned u = ((unsigned)s) << 16; return __builtin_bit_cast(float, u); }
DEV bf16_t f2bf(float f) {
#ifdef EMU
    unsigned u = __builtin_bit_cast(unsigned, f); u += 0x7fffu + ((u >> 16) & 1u); return (bf16_t)(u >> 16);
#else
    return __builtin_bit_cast(bf16_t, (__bf16)f);
#endif
}
DEV unsigned pack2(float a, float b) {
#ifdef EMU
    return (unsigned)f2bf(a) | ((unsigned)f2bf(b) << 16);
#else
    typedef __bf16 b2 __attribute__((ext_vector_type(2))); b2 r; r[0] = (__bf16)a; r[1] = (__bf16)b; return __builtin_bit_cast(unsigned, r);
#endif
}
DEV float fexp(float x) {
#ifdef EMU
    return expf(x);
#else
    return __expf(x);
#endif
}
DEV float fexp2(float x) {
#ifdef EMU
    return exp2f(x);
#else
    return __builtin_amdgcn_exp2f(x);
#endif
}
DEV float frcp(float x) {
#ifdef EMU
    return 1.f / x;
#else
    return __builtin_amdgcn_rcpf(x);
#endif
}
DEV float sigmoidf_(float x) { return frcp(1.f + fexp(-x)); }
DEV float siluf_(float x) { return x * frcp(1.f + fexp(-x)); }
DEV float flog(float x) {
#ifdef EMU
    return logf(x);
#else
    return __logf(x);
#endif
}
DEV float frsqrt(float x) {
#ifdef EMU
    return 1.f / sqrtf(x);
#else
    return __builtin_amdgcn_rsqf(x);
#endif
}
DEV float logsigmoidf_(float x) { return fminf(x, 0.f) - flog(1.f + fexp(-fabsf(x))); }
DEV f16v mfma32(s8v a, s8v b, f16v c) {
#ifdef EMU
    return emu_mfma_32x32x16_bf16(a, b, c);
#else
    typedef __bf16 bf8 __attribute__((ext_vector_type(8)));
    return __builtin_amdgcn_mfma_f32_32x32x16_bf16(__builtin_bit_cast(bf8, a), __builtin_bit_cast(bf8, b), c, 0, 0, 0);
#endif
}
DEV s4v lds_tr16(const void* p) {
#ifdef EMU
    return emu_ds_read_tr16_b64(p);
#else
    typedef s4v __attribute__((address_space(3))) * lp;
    return __builtin_amdgcn_ds_read_tr16_b64_v4i16((lp)(p));
#endif
}
#ifdef EMU
DEV float wave_sum(float v) { for (int m = 32; m >= 1; m >>= 1) v += __shfl_xor(v, m); return v; }
#else
template <int CTRL, int RM> DEV float dpp_f(float v) { return __builtin_bit_cast(float, __builtin_amdgcn_update_dpp(0, __builtin_bit_cast(int, v), CTRL, RM, 0xF, false)); }
DEV float wave_sum(float v) {
    v += dpp_f<0xB1, 0xF>(v); v += dpp_f<0x4E, 0xF>(v); v += dpp_f<0x141, 0xF>(v); v += dpp_f<0x140, 0xF>(v);
    v += dpp_f<0x142, 0xA>(v); v += dpp_f<0x143, 0xC>(v);
    return __builtin_bit_cast(float, __builtin_amdgcn_readlane(__builtin_bit_cast(int, v), 63));
}
#endif
DEV float wave_max(float v) { for (int m = 32; m >= 1; m >>= 1) v = fmaxf(v, __shfl_xor(v, m)); return v; }
DEV f16v f16zero() { f16v z; for (int i = 0; i < 16; ++i) z[i] = 0.f; return z; }

#ifdef EMU
#define VGPR_PIN(x) do {} while (0)
#define SGPR_PIN(x) do {} while (0)
#define SCHED_FENCE() do {} while (0)
#define CFENCE() do {} while (0)
#else
#define SCHED_FENCE() __builtin_amdgcn_sched_barrier(0)
#define SGPR_PIN(x) asm volatile("" : "+s"(x))
#define VGPR_PIN(x) asm volatile("" : "+v"(x))
#define CFENCE() asm volatile("" ::: "memory")
#endif
#ifdef EMU
DEV int get_tid() { return (int)threadIdx.x; }
#else
DEV int get_tid() { int t = threadIdx.x; asm volatile("" : "+v"(t)); return t; }
#endif
struct UnitIter { int i, end, step; };
DEV UnitIter unit_iter(int NU) {
    const int G = (int)gridDim.x, b = (int)blockIdx.x;
    UnitIter it;
#ifndef XCD_MODE
#define XCD_MODE 0
#endif
    if ((G & 7) == 0 && (NU & 7) == 0) { const int W = G >> 3, x = XCD_MODE ? b / W : b & 7, j = XCD_MODE ? b % W : b >> 3, C = NU >> 3; it.i = x * C + j; it.end = (x + 1) * C; it.step = W; }
    else { it.i = b; it.end = NU; it.step = G; }
    return it;
}
DEV int tok_cond(int t) { return t < NP ? 0 : 1 + (t - NP) / DEC_SEQ; }

#ifndef EMU
#define XB_TMO      128
#define XB_XCNT(j)  (256  + 64 * (j))
#define XB_XSUB(j)  (1280 + 64 * (j))
#define XB_XGEN(j)  (2304 + 64 * (j))
#define XB_TOP      3328
#define XB_TOPGEN   3392
#define XCD_BAR_WORDS 3456
#define XB_SPIN_CAP (1u << 20)
#define LAS __attribute__((address_space(3)))
__device__ __forceinline__ unsigned xb_ld(unsigned* p)              { return __hip_atomic_load(p, __ATOMIC_RELAXED, __HIP_MEMORY_SCOPE_AGENT); }
__device__ __forceinline__ unsigned xb_add(unsigned* p, unsigned v) { return __hip_atomic_fetch_add(p, v, __ATOMIC_RELAXED, __HIP_MEMORY_SCOPE_AGENT); }
__device__ __forceinline__ unsigned xb_xcc_id() { return (unsigned)__builtin_amdgcn_s_getreg((3 << 11) | 20) & 0xFu; }
#define XB_SPIN(cond, bar) do { unsigned _sp = 0; while (cond) { __builtin_amdgcn_s_sleep(1); \
    if ((++_sp & 255u) == 0u) { if (xb_ld(&(bar)[XB_TMO])) break; if (_sp > XB_SPIN_CAP) { atomicAdd(&(bar)[XB_TMO], 1u); break; } } } } while (0)
struct XcdBarrier { unsigned* bar; unsigned x; volatile LAS unsigned* st; };
__device__ __forceinline__ XcdBarrier xcd_barrier_post(unsigned* bar, volatile LAS unsigned* st) {
    XcdBarrier b; b.bar = bar; b.x = xb_xcc_id(); b.st = st;
    if (threadIdx.x == 0) (void)xb_add(&bar[XB_XCNT(b.x)], 1u);
    return b;
}
__device__ __forceinline__ void xcd_barrier_complete(unsigned* bar, unsigned x, unsigned& nloc, unsigned& nx) {
    const unsigned G = gridDim.x * gridDim.y * gridDim.z;
    unsigned sum, cnt, mine, sp = 0u;
    for (;;) {
        sum = 0u; cnt = 0u; mine = 0u;
#pragma unroll
        for (unsigned j = 0; j < 16; ++j) { const unsigned c = xb_ld(&bar[XB_XCNT(j)]); sum += c; cnt += (c > 0u) ? 1u : 0u; mine = (j == x) ? c : mine; }
        if (sum == G) break;
        __builtin_amdgcn_s_sleep(1);
        if ((++sp & 255u) == 0u) { if (xb_ld(&bar[XB_TMO])) break; if (sp > XB_SPIN_CAP) { atomicAdd(&bar[XB_TMO], 1u); break; } }
    }
    nloc = mine > 0u ? mine : 1u; nx = cnt > 0u ? cnt : 1u;
}
__device__ __forceinline__ void xcd_barrier(const XcdBarrier& b) {
    asm volatile("s_waitcnt vmcnt(0)" ::: "memory");
    __syncthreads();
    if (threadIdx.x == 0) {
        unsigned* bar = b.bar;
        __builtin_amdgcn_s_waitcnt(0);
        unsigned nloc = b.st[0], nx = b.st[1];
        if (nloc == 0u) { xcd_barrier_complete(bar, b.x, nloc, nx); b.st[0] = nloc; b.st[1] = nx; }
        const unsigned old = xb_add(&bar[XB_XSUB(b.x)], 1u);
        const unsigned gen = old / nloc;
        if (old + 1u == (gen + 1u) * nloc) {
            __builtin_amdgcn_fence(__ATOMIC_RELEASE, "agent");
            asm volatile("s_waitcnt vmcnt(0)" ::: "memory");
            const unsigned og = xb_add(&bar[XB_TOP], 1u);
            const unsigned tg = og / nx;
            if (og + 1u == (tg + 1u) * nx) xb_add(&bar[XB_TOPGEN], 1u);
            else XB_SPIN(xb_ld(&bar[XB_TOPGEN]) == tg, bar);
            __builtin_amdgcn_fence(__ATOMIC_ACQUIRE, "agent");
            xb_add(&bar[XB_XGEN(b.x)], 1u);
            asm volatile("s_waitcnt vmcnt(0)" ::: "memory");
        } else {
            XB_SPIN(xb_ld(&bar[XB_XGEN(b.x)]) == gen, bar);
            __builtin_amdgcn_fence(__ATOMIC_ACQUIRE, "agent");
            asm volatile("s_waitcnt vmcnt(0)" ::: "memory");
        }
    }
    __syncthreads();
}
#endif
constexpr int QUEUE_WORD0 = 4096;

constexpr int LROW = 144;
constexpr int GEMM_AS = 256 * LROW;
constexpr int GEMM_BS = 64 * (256 * 2 + 64);
constexpr int SMEM_XB = 2 * GEMM_AS + 2 * GEMM_BS;
constexpr int SMEM_AUX = SMEM_XB + 64;
constexpr int SMEM_BYTES = SMEM_AUX + 2048;

#ifdef EMU
struct BufRsrc { const char* base; };
DEV BufRsrc make_rsrc(const void* p) { BufRsrc r; r.base = (const char*)p; return r; }
DEV float buf_load_f32(BufRsrc r, unsigned voff, unsigned soff) { return *(const float*)(r.base + voff + soff); }
DEV u4v buf_load_b128(BufRsrc r, unsigned voff, unsigned soff) { return *(const u4v*)(r.base + voff + soff); }
#else
typedef __amdgpu_buffer_rsrc_t BufRsrc;
DEV BufRsrc make_rsrc(const void* p) { return __builtin_amdgcn_make_buffer_rsrc((void*)p, 0, 0x7fffffff, 0x00020000); }
DEV float buf_load_f32(BufRsrc r, unsigned voff, unsigned soff) { return __builtin_bit_cast(float, __builtin_amdgcn_raw_buffer_load_b32(r, voff, soff, 0)); }
DEV u4v buf_load_b128(BufRsrc r, unsigned voff, unsigned soff) { return __builtin_amdgcn_raw_buffer_load_b128(r, voff, soff, 0); }
#endif
#ifdef EMU
#define WAVE_SYNC() do { (void)__shfl(0, 0); } while (0)
#else
#define WAVE_SYNC() asm volatile("s_waitcnt lgkmcnt(0)" ::: "memory")
#endif
DEV char* wave_stage_ptr(char* smem, int wave) { return smem + (wave < 4 ? GEMM_AS + wave * 9216 : 2 * GEMM_AS + GEMM_BS + (wave - 4) * 9216); }
DEV void stage64_write_bf16(char* stg, int tt, const f16v& v0, const f16v& v1, int l31, int h) {
    char* row = stg + (tt * 32 + l31) * LROW;
#pragma unroll
    for (int ft = 0; ft < 2; ++ft) {
        const f16v& v = ft ? v1 : v0;
#pragma unroll
        for (int g = 0; g < 4; ++g) { u2v pk; pk[0] = pack2(v[4 * g], v[4 * g + 1]); pk[1] = pack2(v[4 * g + 2], v[4 * g + 3]); *(u2v*)(row + (ft * 32 + 8 * g + 4 * h) * 2) = pk; }
    }
}
DEV void stage64_write4(char* stg, int row, int col, float a, float b, float c, float d) {
    u2v pk; pk[0] = pack2(a, b); pk[1] = pack2(c, d); *(u2v*)(stg + row * LROW + col * 2) = pk;
}
DEV void stage64_flush_bf16(const char* stg, bf16_t* dst0, size_t row_stride, int lane) {
    WAVE_SYNC();
#pragma unroll
    for (int i = 0; i < 8; ++i) { const int r = (lane >> 3) + 8 * i, c = lane & 7; const u4v v = *(const u4v*)(stg + r * LROW + c * 16); *(u4v*)(dst0 + (size_t)r * row_stride + c * 8) = v; }
    WAVE_SYNC();
}
template <int NTW, int VAR, class Epi>
DEV void gemm_tile(char* smem, BufRsrc ars, unsigned ao0, unsigned ao1, unsigned ao2, unsigned ao3,
                   BufRsrc brs, unsigned bvo, unsigned blds, unsigned ldb4, int K, Epi&& epi) {
    constexpr int BN = 64 * NTW, NLD = 2 * NTW, KSTEP = 64 / NLD, RSB = BN * 2 + 64;
    const int tid = get_tid(), lane = tid & 63, wave = tid >> 6, wm = wave & 3, wn = wave >> 2, h = lane >> 5, l31 = lane & 31;
    char* As = smem; char* Bs = smem + 2 * GEMM_AS;
    constexpr int BSZ = GEMM_BS;
    const int ar = tid >> 3, ac = tid & 7;
    u4v areg[2]; f4v b0[NLD], b1[NLD];
    if (VAR & 3) { for (int i = 0; i < 2; ++i) areg[i] = (u4v){1u, 2u, 3u, 4u}; for (int j = 0; j < NLD; ++j) { b0[j] = (f4v){1.f, 1.f, 1.f, 1.f}; b1[j] = (f4v){2.f, 2.f, 2.f, 2.f}; } }
    f16v acc[NTW][2];
#pragma unroll
    for (int i = 0; i < NTW; ++i) { acc[i][0] = f16zero(); acc[i][1] = f16zero(); }
    auto gloadA = [&](int k0, bool real, int half) {
        if (VAR & 2) return;
        const unsigned so = real ? k0 * 2 : 0u;
        areg[0] = buf_load_b128(ars, real ? (half ? ao2 : ao0) : 0u, so); areg[1] = buf_load_b128(ars, real ? (half ? ao3 : ao1) : 0u, so);
    };
    auto gloadB = [&](int k0, bool real, f4v (&br)[NLD]) {
        if (VAR & 1) return;
        const unsigned vo = real ? bvo : 0u; const int kk = real ? k0 : 0;
        unsigned so = (unsigned)kk * ldb4;
#pragma unroll
        for (int j = 0; j < NLD; ++j) { br[j] = __builtin_bit_cast(f4v, buf_load_b128(brs, vo, so)); so += KSTEP * ldb4; SGPR_PIN(so); }
    };
    auto gloadB1 = [&](int k0, bool real, f4v (&br)[NLD], int j) {
        if (VAR & 1) return;
        br[j] = __builtin_bit_cast(f4v, buf_load_b128(brs, real ? bvo : 0u, (unsigned)((real ? k0 : 0) + j * KSTEP) * ldb4));
    };
    auto lstoreA = [&](int buf, int half) {
        if (VAR & 16) return;
        char* ab = As + buf * GEMM_AS + (ar + half * 128) * LROW + ac * 16;
        *(u4v*)(ab) = areg[0]; *(u4v*)(ab + 64 * LROW) = areg[1];
    };
    auto lstoreB1 = [&](int buf, const f4v (&br)[NLD], int j) {
        if (VAR & 16) return;
        u2v v; v[0] = pack2(br[j][0], br[j][1]); v[1] = pack2(br[j][2], br[j][3]); *(u2v*)(Bs + buf * BSZ + blds + j * KSTEP * RSB) = v;
    };
    auto lstoreB = [&](int buf, const f4v (&br)[NLD]) {
        if (VAR & 16) return;
        char* bb = Bs + buf * BSZ + blds;
#pragma unroll
        for (int j = 0; j < NLD; ++j) { u2v v; v[0] = pack2(br[j][0], br[j][1]); v[1] = pack2(br[j][2], br[j][3]); *(u2v*)(bb + j * KSTEP * RSB) = v; }
    };
    const unsigned btr = (unsigned)(8 * h + ((lane & 15) >> 2)) * RSB + (unsigned)((((lane >> 4) & 1) * 16 + 4 * (lane & 3)) * 2) + (unsigned)(wn * NTW * 32) * 2;
    const unsigned atr = (unsigned)(wm * 64 + l31) * LROW + h * 16;
    auto rdw = [&](int buf, int s, int ft) -> s8v {
        if (VAR & 64) { s8v z; for (int q = 0; q < 8; ++q) z[q] = (short)(0x3f80 + ft); return z; }
        const char* bb = Bs + buf * BSZ + btr + s * 16 * RSB + ft * 64;
        const s4v lo = lds_tr16(bb), hi = lds_tr16(bb + 4 * RSB);
        s8v wf; wf[0] = lo[0]; wf[1] = lo[1]; wf[2] = lo[2]; wf[3] = lo[3]; wf[4] = hi[0]; wf[5] = hi[1]; wf[6] = hi[2]; wf[7] = hi[3];
        return wf;
    };
    auto compute2 = [&](int buf, int s0, auto&& hook) {
        if (VAR & 8) { for (int g = 0; g < 2 * NTW; ++g) hook(g); return; }
        const char* ab = As + buf * GEMM_AS + atr;
        s8v xa[2];
        if (VAR & 64) { for (int q = 0; q < 8; ++q) { xa[0][q] = 0x3f80; xa[1][q] = 0x3f80; } } else { xa[0] = *(const s8v*)(ab + s0 * 32); xa[1] = *(const s8v*)(ab + 32 * LROW + s0 * 32); }
        s8v wcur = rdw(buf, s0, 0);
#pragma unroll
        for (int g = 0; g < 2 * NTW; ++g) {
            const int ft = g % NTW;
            s8v wnext = wcur;
            if (g + 1 < 2 * NTW) wnext = rdw(buf, s0 + (g + 1) / NTW, (g + 1) % NTW);
            if (VAR & 4) { acc[ft][0][0] += __builtin_bit_cast(float, (int)wcur[0] | ((int)xa[0][1] << 16)); acc[ft][1][0] += __builtin_bit_cast(float, (int)wcur[1] | ((int)xa[1][1] << 16)); }
            else { acc[ft][0] = mfma32(wcur, xa[0], acc[ft][0]); acc[ft][1] = mfma32(wcur, xa[1], acc[ft][1]); }
            if (g == NTW - 1 && !(VAR & 64)) { xa[0] = *(const s8v*)(ab + (s0 + 1) * 32); xa[1] = *(const s8v*)(ab + 32 * LROW + (s0 + 1) * 32); }
            wcur = wnext;
            hook(g);
            SCHED_FENCE();
        }
    };
    auto nohook = [](int) {};
    const int nk = K / 64;
    if (NTW == 2) {
        u4v a0[4], a1[4];
        if (VAR & 3) { for (int i = 0; i < 4; ++i) { a0[i] = (u4v){1u, 2u, 3u, 4u}; a1[i] = (u4v){1u, 2u, 3u, 4u}; } }
        auto gA = [&](int k0, bool real, u4v (&ar4)[4]) {
            if (VAR & 2) return;
            const unsigned so = real ? k0 * 2 : 0u;
            ar4[0] = buf_load_b128(ars, real ? ao0 : 0u, so); ar4[1] = buf_load_b128(ars, real ? ao1 : 0u, so);
            ar4[2] = buf_load_b128(ars, real ? ao2 : 0u, so); ar4[3] = buf_load_b128(ars, real ? ao3 : 0u, so);
        };
        auto sA = [&](int buf, const u4v (&ar4)[4]) {
            if (VAR & 16) return;
            char* ab = As + buf * GEMM_AS + ar * LROW + ac * 16;
#pragma unroll
            for (int i = 0; i < 4; ++i) *(u4v*)(ab + i * 64 * LROW) = ar4[i];
        };
        auto gA1 = [&](int k0, bool real, u4v (&ar4)[4], int i) {
            if (VAR & 2) return;
            const unsigned ao = i == 0 ? ao0 : i == 1 ? ao1 : i == 2 ? ao2 : ao3;
            ar4[i] = buf_load_b128(ars, real ? ao : 0u, real ? k0 * 2 : 0u);
        };
        auto sA1 = [&](int buf, const u4v (&ar4)[4], int i) {
            if (VAR & 16) return;
            *(u4v*)(As + buf * GEMM_AS + (ar + i * 64) * LROW + ac * 16) = ar4[i];
        };
        gA(0, true, a0); gloadB(0, true, b0); gA(64, true, a1); gloadB(64, true, b1);
        sA(0, a0); lstoreB(0, b0);
        __syncthreads();
        for (int kt = 0; kt < nk; kt += 2) {
            const bool t2 = kt + 2 < nk;
            compute2(0, 0, [&](int g) { gA1((kt + 2) * 64, t2, a0, g); lstoreB1(1, b1, g); });
            compute2(0, 2, [&](int g) { gloadB1((kt + 2) * 64, t2, b0, g); sA1(1, a1, g); });
            __syncthreads();
            compute2(1, 0, [&](int g) { gA1((kt + 3) * 64, t2, a1, g); lstoreB1(0, b0, g); });
            compute2(1, 2, [&](int g) { gloadB1((kt + 3) * 64, t2, b1, g); sA1(0, a0, g); });
            __syncthreads();
        }
    } else {
    {
        u4v ah0[2], ah1[2];
        if (VAR & 3) { ah0[0] = ah0[1] = ah1[0] = ah1[1] = (u4v){1u, 2u, 3u, 4u}; }
        auto gAh = [&](u4v (&st)[2], int hsel, int i, int k0, bool real) {
            if (VAR & 2) return;
            const unsigned ao = hsel ? (i ? ao3 : ao2) : (i ? ao1 : ao0);
            st[i] = buf_load_b128(ars, real ? ao : 0u, real ? k0 * 2 : 0u);
        };
        auto sAh = [&](int buf, const u4v (&st)[2], int hsel, int i) {
            if (VAR & 16) return;
            *(u4v*)(As + buf * GEMM_AS + (ar + hsel * 128 + i * 64) * LROW + ac * 16) = st[i];
        };
        gAh(ah0, 0, 0, 0, true); gAh(ah0, 0, 1, 0, true); gAh(ah1, 1, 0, 0, true); gAh(ah1, 1, 1, 0, true);
        gloadB(0, true, b0); gloadB(64, true, b1);
        sAh(0, ah0, 0, 0); sAh(0, ah0, 0, 1); sAh(0, ah1, 1, 0); sAh(0, ah1, 1, 1);
        lstoreB(0, b0);
        gAh(ah0, 0, 0, 64, true); gAh(ah0, 0, 1, 64, true);
        __syncthreads();
        for (int kt = 0; kt < nk; kt += 2) {
            const bool t2 = kt + 2 < nk;
            compute2(0, 0, [&](int g) {
                if (g & 1) gloadB1((kt + 2) * 64, t2, b0, g >> 1); else lstoreB1(1, b1, g >> 1);
                if (g == 1) gAh(ah1, 1, 0, (kt + 1) * 64, true); if (g == 3) gAh(ah1, 1, 1, (kt + 1) * 64, true);
                if (g == 4) sAh(1, ah0, 0, 0); if (g == 6) sAh(1, ah0, 0, 1); });
            compute2(0, 2, [&](int g) {
                if (g & 1) gloadB1((kt + 2) * 64, t2, b0, 4 + (g >> 1)); else lstoreB1(1, b1, 4 + (g >> 1));
                if (g == 1) gAh(ah0, 0, 0, (kt + 2) * 64, t2); if (g == 3) gAh(ah0, 0, 1, (kt + 2) * 64, t2);
                if (g == 4) sAh(1, ah1, 1, 0); if (g == 6) sAh(1, ah1, 1, 1); });
            __syncthreads();
            compute2(1, 0, [&](int g) {
                if (g & 1) gloadB1((kt + 3) * 64, t2, b1, g >> 1); else lstoreB1(0, b0, g >> 1);
                if (g == 1) gAh(ah1, 1, 0, (kt + 2) * 64, t2); if (g == 3) gAh(ah1, 1, 1, (kt + 2) * 64, t2);
                if (g == 4) sAh(0, ah0, 0, 0); if (g == 6) sAh(0, ah0, 0, 1); });
            compute2(1, 2, [&](int g) {
                if (g & 1) gloadB1((kt + 3) * 64, t2, b1, 4 + (g >> 1)); else lstoreB1(0, b0, 4 + (g >> 1));
                if (g == 1) gAh(ah0, 0, 0, (kt + 3) * 64, t2); if (g == 3) gAh(ah0, 0, 1, (kt + 3) * 64, t2);
                if (g == 4) sAh(0, ah1, 1, 0); if (g == 6) sAh(0, ah1, 1, 1); });
            __syncthreads();
        }
    }
    }
    if (VAR & 32) { float t = 0.f; for (int i = 0; i < NTW; ++i) t += acc[i][0][0] + acc[i][1][5]; if (t == 123.456f) *(float*)smem = t; }
    else epi(acc);
}

DEV void phase_ada(const Params& p, char* smem) {
    const int tid = get_tid();
    float* siluS = (float*)smem;
    float* red = (float*)(smem + NCOND * D * 4);
    for (int i = tid; i < NCOND * D; i += 512) {
        const int cnd = i / D, k = i % D;
        const float c = cnd == 0 ? p.in[I_CCTX][k] : p.in[I_C][(cnd - 1) * D + k];
        siluS[i] = c * frcp(1.f + fexp(-c));
    }
    __syncthreads();
    constexpr int CPL = 6 * D / 32, NCHUNK = DEPTH * CPL, KG = D / 16;
    float* mods = (float*)(p.ws + WS_MODS);
    const int col = tid & 31, kg = tid >> 5;
    for (int u = blockIdx.x; u < NCHUNK; u += gridDim.x) {
        const int l = u / CPL, c0 = (u % CPL) * 32;
        const float* W = p.in[I_ADAW] + (size_t)l * D * 6 * D + c0 + col;
        float acc[NCOND];
#pragma unroll
        for (int c = 0; c < NCOND; ++c) acc[c] = 0.f;
#pragma unroll 8
        for (int k = kg * KG; k < kg * KG + KG; ++k) {
            const float w = W[(size_t)k * 6 * D];
#pragma unroll
            for (int c = 0; c < NCOND; ++c) acc[c] += siluS[c * D + k] * w;
        }
#pragma unroll
        for (int c = 0; c < NCOND; ++c) red[(kg * NCOND + c) * 32 + col] = acc[c];
        __syncthreads();
        if (tid < 32 * NCOND) {
            const int c = tid >> 5, cc = tid & 31;
            float s = 0.f;
            for (int g = 0; g < 16; ++g) s += red[(g * NCOND + c) * 32 + cc];
            mods[((size_t)l * NCOND + c) * 6 * D + c0 + cc] = s + p.in[I_ADAB][(size_t)l * 6 * D + c0 + cc];
        }
        __syncthreads();
    }
    const int gtid = blockIdx.x * 512 + tid, gsz = gridDim.x * 512;
    float* rope = (float*)(p.ws + WS_ROPE);
    for (int i = gtid; i < 64 * 16; i += gsz) {
        const int pos = i >> 4, fi = i & 15;
        const float inv = fexp2(-(float)(2 * fi) * (13.287712379549449f / 32.f));
        const float ang = (float)pos * inv;
#ifdef EMU
        rope[2 * i] = cosf(ang); rope[2 * i + 1] = sinf(ang);
#else
        rope[2 * i] = __cosf(ang); rope[2 * i + 1] = __sinf(ang);
#endif
    }
    constexpr int NNA = DEC_BATCH * DEPTH * PAST * NAH * HD, NGQ = DEC_BATCH * DEPTH * PAST * GQKV * HD;
    bf16_t* cnak = (bf16_t*)(p.ws + WS_CNAK); bf16_t* cnav = (bf16_t*)(p.ws + WS_CNAV);
    bf16_t* cgqk = (bf16_t*)(p.ws + WS_CGQK); bf16_t* cgqv = (bf16_t*)(p.ws + WS_CGQV);
    for (int i = gtid; i < NNA; i += gsz) { cnak[i] = f2bf(p.in[I_CNAK][i]); cnav[i] = f2bf(p.in[I_CNAV][i]); }
    for (int i = gtid; i < NGQ; i += gsz) { cgqk[i] = f2bf(p.in[I_CGQK][i]); cgqv[i] = f2bf(p.in[I_CGQV][i]); }
}

constexpr int EPL = D / 64;
constexpr int W16ROW = 20;
template <int MODE>
DEV void phase_rows(const Params& p, char* smem, int l) {
    const int tid = get_tid(), lane = tid & 63, wave = tid >> 6;
    float* W16 = (float*)smem;
    const bool need_w = (MODE == 1) || (l < DEPTH);
    if (need_w) {
        for (int i = tid; i < D * 4; i += 512) {
            const int k = i >> 2, q = i & 3;
            const float* src = (MODE == 1) ? p.in[I_RW] + ((size_t)l * D + k) * 16 + q * 4 : p.in[I_WIN] + ((size_t)l * D + k) * PROJ_W + 2176 + q * 4;
            *(f4v*)(W16 + k * W16ROW + q * 4) = *(const f4v*)src;
        }
    }
    __syncthreads();
    const float* mods = (const float*)(p.ws + WS_MODS);
    auto load_row = [&](int t, float (&vr)[EPL], int& ms) {
        const float* rp = (MODE == 1) ? (const float*)(p.ws + WS_U) + (size_t)t * D
                        : (l == 0) ? (t < NP ? p.in[I_XP] + (size_t)t * D : p.in[I_XS] + (size_t)(t - NP) * D) : (const float*)(p.ws + WS_X1) + (size_t)t * D;
#pragma unroll
        for (int j = 0; j < EPL; ++j) vr[j] = rp[lane + 64 * j];
        if (MODE == 0 && l > 0) ms = lane < 16 ? ((const int*)(p.ws + WS_TOKSLOT))[(size_t)t * 16 + lane] : -1;
    };
    const int tstride = gridDim.x * 8;
    float vr[EPL]; int ms = -1;
    {
        const int t0 = blockIdx.x * 8 + wave;
        if (t0 < NT) load_row(t0, vr, ms);
    }
    for (int t = blockIdx.x * 8 + wave; t < NT; t += tstride) {
        const int cnd = tok_cond(t);
        float vn[EPL]; int msn = -1;
#pragma unroll
        for (int j = 0; j < EPL; ++j) vn[j] = 0.f;
        if (t + tstride < NT) load_row(t + tstride, vn, msn);
        float v[EPL];
        if (MODE == 0 && l > 0) {
            const float* g2 = mods + ((size_t)(l - 1) * NCOND + cnd) * 6 * D + 5 * D;
            float f[EPL], gv[EPL];
#pragma unroll
            for (int j = 0; j < EPL; ++j) { f[j] = 0.f; gv[j] = g2[lane + 64 * j]; }
            const int myslot = ms;
            unsigned vm = (unsigned)__ballot(myslot >= 0);
            while (vm) {
                const int e = __builtin_ctz(vm); vm &= vm - 1u;
                const int slot = __shfl(myslot, e);
                const bf16_t* yr = (const bf16_t*)(p.ws + WS_YE) + ((size_t)e * SLOTS + slot) * D;
#pragma unroll
                for (int j = 0; j < EPL; ++j) f[j] += bf2f(yr[lane + 64 * j]);
            }
#pragma unroll
            for (int j = 0; j < EPL; ++j) v[j] = ALPHA * vr[j] + gv[j] * f[j];
        } else {
#pragma unroll
            for (int j = 0; j < EPL; ++j) v[j] = vr[j];
        }
#pragma unroll
        for (int j = 0; j < EPL; ++j) vr[j] = vn[j];
        ms = msn;
        if (!(MODE == 0 && l == 0)) {
            const int li = (MODE == 0) ? (l - 1) * 2 + 1 : l * 2;
            const float* lg = p.in[I_LNG] + (size_t)li * D; const float* lb = p.in[I_LNB] + (size_t)li * D;
            float g[EPL], bb[EPL];
#pragma unroll
            for (int j = 0; j < EPL; ++j) { g[j] = lg[lane + 64 * j]; bb[j] = lb[lane + 64 * j]; }
            float s = 0.f;
#pragma unroll
            for (int j = 0; j < EPL; ++j) s += v[j];
            const float mu = wave_sum(s) * (1.f / D);
            float q = 0.f;
#pragma unroll
            for (int j = 0; j < EPL; ++j) { const float dlt = v[j] - mu; q += dlt * dlt; }
            const float rstd = frsqrt(wave_sum(q) * (1.f / D) + EPS);
            float* dst = (MODE == 1) ? (float*)(p.ws + WS_X1) + (size_t)t * D
                       : (l == DEPTH) ? (t < NP ? p.out + O_YP + (size_t)t * D : p.out + O_YS + (size_t)(t - NP) * D) : (float*)(p.ws + WS_XBUF) + (size_t)t * D;
#pragma unroll
            for (int j = 0; j < EPL; ++j) { v[j] = (v[j] - mu) * rstd * g[j] + bb[j]; dst[lane + 64 * j] = v[j]; }
        }
        if (MODE == 1 || l < DEPTH) {
            const float* sh = mods + ((size_t)l * NCOND + cnd) * 6 * D + (MODE == 1 ? 3 * D : 0); const float* sc = sh + D;
            bf16_t* hb = (bf16_t*)(p.ws + (MODE == 1 ? WS_H2 : WS_HMOD)) + (size_t)t * D;
            {
                float s1[EPL], s0[EPL];
#pragma unroll
                for (int j = 0; j < EPL; ++j) { s1[j] = sc[lane + 64 * j]; s0[j] = sh[lane + 64 * j]; }
#pragma unroll
                for (int j = 0; j < EPL; ++j) { v[j] = v[j] * (1.f + s1[j]) + s0[j]; hb[lane + 64 * j] = f2bf(v[j]); }
            }
            CFENCE();
            float a16[16];
#pragma unroll
            for (int e = 0; e < 16; ++e) a16[e] = 0.f;
#pragma unroll
            for (int j = 0; j < EPL; ++j) {
                const float hv = v[j];
                const float* wr = W16 + (lane + 64 * j) * W16ROW;
#pragma unroll
                for (int q = 0; q < 4; ++q) { const f4v w4 = *(const f4v*)(wr + 4 * q); a16[4 * q] += hv * w4[0]; a16[4 * q + 1] += hv * w4[1]; a16[4 * q + 2] += hv * w4[2]; a16[4 * q + 3] += hv * w4[3]; }
                if (j & 1) CFENCE();
            }
            float mine = -1e30f;
#pragma unroll
            for (int e = 0; e < 16; ++e) { const float sm = wave_sum(a16[e]); if (lane == e) mine = sm; }
            if (MODE == 0) {
                if (lane < 16) ((float*)(p.ws + WS_GATES))[(size_t)t * 16 + lane] = mine + p.in[I_BGATE][l * 16 + lane];
            } else {
                float mx = mine;
                for (int m = 8; m >= 1; m >>= 1) mx = fmaxf(mx, __shfl_xor(mx, m));
                const float ex = lane < 16 ? fexp(mine - mx) : 0.f;
                float sm = ex;
                for (int m = 8; m >= 1; m >>= 1) sm += __shfl_xor(sm, m);
                if (lane < 16) ((float*)(p.ws + WS_AFF))[(size_t)t * 16 + lane] = ex / sm;
            }
        }
    }
}

template <int NPL>
DEV void topk_wave(const Params& p, int tb, int cap, int sbase, int e, int lane) {
    const float* aff = (const float*)(p.ws + WS_AFF);
    int* idx = (int*)(p.ws + WS_IDX); float* gsel = (float*)(p.ws + WS_GSEL); int* tokslot = (int*)(p.ws + WS_TOKSLOT);
    unsigned bits[NPL];
#pragma unroll
    for (int i = 0; i < NPL; ++i) bits[i] = __builtin_bit_cast(unsigned, aff[(size_t)(tb + lane + 64 * i) * 16 + e]);
    unsigned T = 0u;
    for (int b = 30; b >= 0; --b) {
        const unsigned cand = T | (1u << b);
        int cnt = 0;
#pragma unroll
        for (int i = 0; i < NPL; ++i) cnt += __popcll(__ballot(bits[i] >= cand));
        if (cnt >= cap) T = cand;
    }
    int ngt = 0;
#pragma unroll
    for (int i = 0; i < NPL; ++i) ngt += __popcll(__ballot(bits[i] > T));
    int need_eq = cap - ngt, run = 0;
    const unsigned long long lt = (1ull << lane) - 1ull;
#pragma unroll
    for (int i = 0; i < NPL; ++i) {
        const bool eq = bits[i] == T;
        const unsigned long long meq = __ballot(eq);
        const int eqrank = __popcll(meq & lt);
        const bool sel = bits[i] > T || (eq && eqrank < need_eq);
        const unsigned long long ms = __ballot(sel);
        const int t = tb + lane + 64 * i;
        if (sel) { const int slot = sbase + run + __popcll(ms & lt); idx[e * SLOTS + slot] = t; gsel[e * SLOTS + slot] = __builtin_bit_cast(float, bits[i]); tokslot[(size_t)t * 16 + e] = slot; }
        else tokslot[(size_t)t * 16 + e] = -1;
        run += __popcll(ms);
        const int neq = __popcll(meq); need_eq -= neq < need_eq ? neq : need_eq;
    }
}
template <int NPW>
DEV void topk_quad(const Params& p, char* smem, bool valid, int tb, int cap, int sbase, int e, int grp, int wq, int lane) {
    const float* aff = (const float*)(p.ws + WS_AFF);
    int* idx = (int*)(p.ws + WS_IDX); float* gsel = (float*)(p.ws + WS_GSEL); int* tokslot = (int*)(p.ws + WS_TOKSLOT);
    int* cntS = (int*)smem + grp * 64;
    const int t0 = tb + wq * (NPW * 64);
    unsigned bits[NPW];
#pragma unroll
    for (int i = 0; i < NPW; ++i) bits[i] = valid ? __builtin_bit_cast(unsigned, aff[(size_t)(t0 + lane + 64 * i) * 16 + e]) : 0u;
    unsigned T = 0u;
    for (int b = 30; b >= 0; --b) {
        const unsigned cand = T | (1u << b);
        int cnt = 0;
#pragma unroll
        for (int i = 0; i < NPW; ++i) cnt += __popcll(__ballot(bits[i] >= cand));
        if (lane == 0) cntS[(b & 1) * 4 + wq] = cnt;
        __syncthreads();
        const int tot = cntS[(b & 1) * 4] + cntS[(b & 1) * 4 + 1] + cntS[(b & 1) * 4 + 2] + cntS[(b & 1) * 4 + 3];
        if (tot >= cap) T = cand;
    }
    int ngt = 0, neqw = 0;
#pragma unroll
    for (int i = 0; i < NPW; ++i) { ngt += __popcll(__ballot(bits[i] > T)); neqw += __popcll(__ballot(bits[i] == T)); }
    if (lane == 0) { cntS[16 + wq] = ngt; cntS[20 + wq] = neqw; }
    __syncthreads();
    int gt_tot = 0;
    for (int w = 0; w < 4; ++w) gt_tot += cntS[16 + w];
    int rem = cap - gt_tot, run = 0, need_eq = 0;
    for (int w = 0; w < 4; ++w) {
        const int take = cntS[20 + w] < rem ? cntS[20 + w] : rem;
        if (w < wq) run += cntS[16 + w] + take;
        if (w == wq) need_eq = take;
        rem -= take;
    }
    if (!valid) return;
    const unsigned long long lt = (1ull << lane) - 1ull;
#pragma unroll
    for (int i = 0; i < NPW; ++i) {
        const bool eq = bits[i] == T;
        const unsigned long long meq = __ballot(eq);
        const int eqrank = __popcll(meq & lt);
        const bool sel = bits[i] > T || (eq && eqrank < need_eq);
        const unsigned long long ms = __ballot(sel);
        const int t = t0 + lane + 64 * i;
        if (sel) { const int slot = sbase + run + __popcll(ms & lt); idx[e * SLOTS + slot] = t; gsel[e * SLOTS + slot] = __builtin_bit_cast(float, bits[i]); tokslot[(size_t)t * 16 + e] = slot; }
        else tokslot[(size_t)t * 16 + e] = -1;
        run += __popcll(ms);
        const int neq = __popcll(meq); need_eq -= neq < need_eq ? neq : need_eq;
    }
}
DEV void phase_topk(const Params& p, char* smem) {
    const int tid = get_tid(), lane = tid & 63, wave = tid >> 6;
    constexpr int US = DEC_BATCH * NEXP, UP = BATCH * NEXP, NSB = (US + 1) / 2;
    static_assert(DEC_SEQ % 256 == 0, "quarter split");
    for (int ub = blockIdx.x; ub < NSB; ub += gridDim.x) {
        const int u = 2 * ub + (wave >> 2);
        const bool valid = u < US;
        const int b = valid ? u / NEXP : 0, e = valid ? u % NEXP : 0;
        topk_quad<DEC_SEQ / 256>(p, smem, valid, NP + b * DEC_SEQ, CAP_S, BATCH * CAP_P + b * CAP_S, e, wave >> 2, wave & 3, lane);
        __syncthreads();
    }
    const int gw = (gridDim.x - 1 - blockIdx.x) + gridDim.x * wave, nw = gridDim.x * 8;
    for (int u = gw; u < UP; u += nw) { const int b = u / NEXP, e = u % NEXP; topk_wave<SEQ / 64>(p, b * SEQ, CAP_P, b * CAP_P, e, lane); }
}

DEV void store_head_f32(float* dst_f32, const f16v& v0, const f16v& v1, int h) {
#pragma unroll
    for (int ft = 0; ft < 2; ++ft) {
        const f16v& v = ft ? v1 : v0;
#pragma unroll
        for (int g = 0; g < 4; ++g) { f4v o; o[0] = v[4 * g]; o[1] = v[4 * g + 1]; o[2] = v[4 * g + 2]; o[3] = v[4 * g + 3]; *(f4v*)(dst_f32 + ft * 32 + 8 * g + 4 * h) = o; }
    }
}
DEV void inproj_head(const Params& p, char* stg, const float* rope, int l, int t0, int cb, const f16v& a00, const f16v& a10, const f16v& a01, const f16v& a11, int lane) {
    const int l31 = lane & 31, h = lane >> 5;
    const bool isP = t0 < NP;
    bf16_t* dstb; size_t dstride;
    int f32out = 0, fhead = 0, fheads = 0; size_t fbase = 0;
    int mode = 0;
    if (cb < 1152) {
        const int seg = cb / 384, head = (cb % 384) / 64;
        dstb = (bf16_t*)(p.ws + (seg == 0 ? WS_NAQ : seg == 1 ? WS_NAK : WS_NAV)) + (size_t)t0 * 384 + head * 64; dstride = 384;
        if (seg >= 1 && isP) { f32out = 1; fbase = seg == 1 ? O_NAK : O_NAV; fhead = head; fheads = NAH; }
    } else if (cb < 2176) {
        const int seg = (cb - 1152) / 256, head = ((cb - 1152) % 256) / 64;
        dstb = (bf16_t*)(p.ws + (seg == 0 ? WS_MLQ : seg == 1 ? WS_MLK : seg == 2 ? WS_MLV : WS_MLO)) + (size_t)t0 * 256 + head * 64; dstride = 256;
        mode = seg == 1 ? 1 : 0;
    } else {
        const int c2 = cb - 2192;
        if (c2 < 384) { dstb = (bf16_t*)(p.ws + WS_GQQ) + (size_t)t0 * 384 + (c2 / 64) * 64; dstride = 384; mode = 2; }
        else if (c2 < 512) { const int head = (c2 - 384) / 64; dstb = (bf16_t*)(p.ws + WS_GQK) + (size_t)t0 * 128 + head * 64; dstride = 128; mode = 3;
                             if (isP) { f32out = 1; fbase = O_GQK; fhead = head; fheads = GQKV; } }
        else { const int head = (c2 - 512) / 64; dstb = (bf16_t*)(p.ws + WS_GQV) + (size_t)t0 * 128 + head * 64; dstride = 128;
               if (isP) { f32out = 1; fbase = O_GQV; fhead = head; fheads = GQKV; } }
    }
#pragma unroll
    for (int tt = 0; tt < 2; ++tt) {
        const int t = t0 + tt * 32 + l31;
        f16v v0 = tt ? a01 : a00, v1 = tt ? a11 : a10;
        if (mode == 1) { v0 *= ATT_SCALE; v1 *= ATT_SCALE; }
        if (mode >= 2) {
            float ss = 0.f;
#pragma unroll
            for (int r = 0; r < 16; ++r) ss += v0[r] * v0[r] + v1[r] * v1[r];
            ss += __shfl_xor(ss, 32);
            const float rn = frsqrt(ss * (1.f / 64.f) + EPS);
            const float* gq = p.in[I_QKG] + ((size_t)l * 2 + (mode == 2 ? 0 : 1)) * 64;
#pragma unroll
            for (int r = 0; r < 16; ++r) {
                const int d = (r & 3) + 8 * (r >> 2) + 4 * h;
                v0[r] *= rn * gq[d]; v1[r] *= rn * gq[32 + d];
            }
        }
        if (f32out) { const int bP = t / SEQ, sP = t % SEQ; store_head_f32(p.out + fbase + ((((size_t)bP * DEPTH + l) * SEQ + sP) * fheads + fhead) * 64, v0, v1, h); }
        if (mode >= 2 && !isP) {
            const int pos = (t - NP) % DEC_SEQ, prow = pos / GRIDW, pcol = pos % GRIDW;
#pragma unroll
            for (int rr = 0; rr < 8; ++rr) {
                const int fi = (rr & 3) + 8 * ((rr >> 2) & 1) + 4 * h;
                const float c0 = rope[(prow * 16 + fi) * 2], s0 = rope[(prow * 16 + fi) * 2 + 1];
                const float c1 = rope[(pcol * 16 + fi) * 2], s1 = rope[(pcol * 16 + fi) * 2 + 1];
                const float a_lo = v0[rr], a_hi = v0[rr + 8]; v0[rr] = a_lo * c0 - a_hi * s0; v0[rr + 8] = a_hi * c0 + a_lo * s0;
                const float b_lo = v1[rr], b_hi = v1[rr + 8]; v1[rr] = b_lo * c1 - b_hi * s1; v1[rr + 8] = b_hi * c1 + b_lo * s1;
            }
        }
        stage64_write_bf16(stg, tt, v0, v1, l31, h);
    }
    stage64_flush_bf16(stg, dstb, dstride, lane);
}
template <int VAR>
DEV void phase_inproj(const Params& p, char* smem, int l) {
    constexpr int NJ4 = 11, NMB = NT / 256, RPX = (NMB % 8 == 0) ? NMB / 8 : NMB, TPC = RPX * NJ4;
#ifdef IP_FORCE_FULL
    constexpr int FT = IP_FORCE_FULL;
#else
    constexpr int FT = (NMB % 8 == 0 && TPC > 32) ? 32 : 0;
#endif
    constexpr int UPC = FT + 2 * (TPC - FT), NCHUNK = (NMB % 8 == 0) ? 8 : 1;
    const int tid = get_tid(), lane = tid & 63, wave = tid >> 6, wm = wave & 3, wn = wave >> 2;
    const bf16_t* hmod = (const bf16_t*)(p.ws + WS_HMOD);
    const float* rope = (const float*)(p.ws + WS_ROPE);
    const bool chunked = (gridDim.x & 7) == 0 && NCHUNK == 8;
    const UnitIter it = unit_iter(NCHUNK * UPC);
    for (int uu = it.i; uu < it.end; uu += it.step) {
        const int x = uu / UPC, v = uu % UPC;
        const int tl = v < FT ? v : FT + ((v - FT) >> 1), half = v < FT ? -1 : ((v - FT) & 1);
        const int mb = x * RPX + tl % RPX, j4 = tl / RPX;
        (void)chunked;
        const unsigned ao = ((unsigned)(mb * 256 + (tid >> 3)) * D + (tid & 7) * 8) * 2;
        if (half < 0) {
            const int colbase = 256 * j4;
            const int zc = colbase + 4 * (tid & 63);
            const unsigned bvo = (unsigned)(zc < 2176 ? zc : zc + 16) * 4 + (unsigned)(tid >> 6) * (PROJ_W * 4);
            const unsigned blds = (unsigned)(tid >> 6) * 576u + (unsigned)(tid & 63) * 8u;
            gemm_tile<4, VAR>(smem, make_rsrc(hmod), ao, ao + 128u * D, ao + 256u * D, ao + 384u * D, make_rsrc(p.in[I_WIN] + (size_t)l * D * PROJ_W), bvo, blds, PROJ_W * 4, D, [&](f16v (&acc)[4][2]) {
                int lane_e = lane; VGPR_PIN(lane_e);
                char* stg = wave_stage_ptr(smem, wave);
#pragma unroll
                for (int hh = 0; hh < 2; ++hh) {
                    const int fh = colbase + wn * 128 + hh * 64;
                    inproj_head(p, stg, rope, l, mb * 256 + wm * 64, fh < 2176 ? fh : fh + 16, acc[2 * hh][0], acc[2 * hh + 1][0], acc[2 * hh][1], acc[2 * hh + 1][1], lane_e);
                }
            });
        } else {
            const int j = 2 * j4 + half;
            const int colbase = j < 17 ? 128 * j : 2192 + 128 * (j - 17);
            const unsigned bvo = (unsigned)(colbase + 4 * (tid & 31)) * 4 + (unsigned)(tid >> 5) * (PROJ_W * 4);
            const unsigned blds = (unsigned)(tid >> 5) * 320u + (unsigned)(tid & 31) * 8u;
            gemm_tile<2, VAR>(smem, make_rsrc(hmod), ao, ao + 128u * D, ao + 256u * D, ao + 384u * D, make_rsrc(p.in[I_WIN] + (size_t)l * D * PROJ_W), bvo, blds, PROJ_W * 4, D, [&](f16v (&acc)[2][2]) {
                int lane_e = lane; VGPR_PIN(lane_e);
                inproj_head(p, wave_stage_ptr(smem, wave), rope, l, mb * 256 + wm * 64, colbase + wn * 64, acc[0][0], acc[1][0], acc[0][1], acc[1][1], lane_e);
            });
        }
    }
}

template <int VAR>
DEV void phase_outproj(const Params& p, char* smem, int l) {
    constexpr int NC = D / 128, NU = (NT / 256) * NC;
    const int tid = get_tid(), lane = tid & 63, wave = tid >> 6, wm = wave & 3, wn = wave >> 2, h = lane >> 5, l31 = lane & 31;
    const bf16_t* mixed = (const bf16_t*)(p.ws + WS_MIXED);
    const float* mods = (const float*)(p.ws + WS_MODS);
    float* U = (float*)(p.ws + WS_U);
    constexpr int NMB = NT / 256, RPX = (NMB % 8 == 0) ? NMB / 8 : NMB;
    const UnitIter it = unit_iter(NU);
    for (int u = it.i; u < it.end; u += it.step) {
        const int mb = (u / (RPX * NC)) * RPX + u % RPX, cbk = (u / RPX) % NC;
        const unsigned ao = ((unsigned)(mb * 256 + (tid >> 3)) * MIXW + (tid & 7) * 8) * 2;
        const unsigned bvo = (unsigned)(cbk * 128 + 4 * (tid & 31)) * 4 + (unsigned)(tid >> 5) * (D * 4);
        const unsigned blds = (unsigned)(tid >> 5) * 320u + (unsigned)(tid & 31) * 8u;
        gemm_tile<2, VAR>(smem, make_rsrc(mixed), ao, ao + 128u * MIXW, ao + 256u * MIXW, ao + 384u * MIXW, make_rsrc(p.in[I_WOUT] + (size_t)l * MIXW * D), bvo, blds, D * 4, MIXW, [&](f16v (&acc)[2][2]) {
            int lane_e = lane; VGPR_PIN(lane_e); const int lane = lane_e, l31 = lane_e & 31, h = lane_e >> 5; (void)l31; (void)h;
            char* stg = wave_stage_ptr(smem, wave);
            const int t0 = mb * 256 + wm * 64;
            const float* g1 = mods + ((size_t)l * NCOND + tok_cond(t0)) * 6 * D + 2 * D;
#pragma unroll
            for (int ft = 0; ft < 2; ++ft) {
#pragma unroll
                for (int tt = 0; tt < 2; ++tt)
#pragma unroll
                    for (int g = 0; g < 4; ++g) { f4v o; o[0] = acc[ft][tt][4 * g]; o[1] = acc[ft][tt][4 * g + 1]; o[2] = acc[ft][tt][4 * g + 2]; o[3] = acc[ft][tt][4 * g + 3];
                        *(f4v*)(stg + (tt * 32 + l31) * LROW + (8 * g + 4 * h) * 4) = o; }
                WAVE_SYNC();
                const int f0 = cbk * 128 + wn * 64 + ft * 32 + (lane & 7) * 4;
                const f4v gv = *(const f4v*)(g1 + f0);
#pragma unroll
                for (int i = 0; i < 8; ++i) {
                    const int r = (lane >> 3) + 8 * i, t = t0 + r;
                    const f4v a = *(const f4v*)(stg + r * LROW + (lane & 7) * 16);
                    const float* xr = (l == 0) ? (t < NP ? p.in[I_XP] + (size_t)t * D : p.in[I_XS] + (size_t)(t - NP) * D) : (const float*)(p.ws + WS_XBUF) + (size_t)t * D;
                    const f4v xv = *(const f4v*)(xr + f0);
                    f4v o;
#pragma unroll
                    for (int q = 0; q < 4; ++q) o[q] = ALPHA * xv[q] + gv[q] * a[q];
                    *(f4v*)(U + (size_t)t * D + f0) = o;
                }
                WAVE_SYNC();
            }
        });
    }
}

template <int VAR>
DEV void phase_gateup(const Params& p, char* smem, int l) {
    constexpr int NRB = SLOTS / 256, NCB = EH / 128, NU = NEXP * NCB * NRB;
    const int tid = get_tid(), lane = tid & 63, wave = tid >> 6, wm = wave & 3, wn = wave >> 2, h = lane >> 5, l31 = lane & 31;
    const bf16_t* h2 = (const bf16_t*)(p.ws + WS_H2);
    const int* idx = (const int*)(p.ws + WS_IDX);
    bf16_t* hid = (bf16_t*)(p.ws + WS_HID);
    constexpr int TPC = NU / 8;
#ifdef GU_FORCE_HALF
    constexpr int HT = GU_FORCE_HALF;
#else
    constexpr int HT = (NU % 8 == 0 && TPC % 32 == 16) ? 16 : 0;
#endif
    constexpr int UPC = TPC + HT;
    const bool chunked = (gridDim.x & 7) == 0 && (NU & 7) == 0;
    const UnitIter it = unit_iter(chunked ? 8 * UPC : NU);
    for (int uu = it.i; uu < it.end; uu += it.step) {
        int u = uu, half = -1;
        if (chunked) { const int x = uu / UPC, v = uu % UPC; if (v < TPC - HT) u = x * TPC + v; else { const int hv = v - (TPC - HT); u = x * TPC + (TPC - HT) + (hv >> 1); half = hv & 1; } }
        const int rb = u % NRB, cbk = (u / NRB) % NCB, e = u / (NRB * NCB);
        const int* ip = idx + e * SLOTS + rb * 256 + (tid >> 3);
        const unsigned a0 = ((unsigned)ip[0] * D + (tid & 7) * 8) * 2, a1 = ((unsigned)ip[64] * D + (tid & 7) * 8) * 2;
        const unsigned a2 = ((unsigned)ip[128] * D + (tid & 7) * 8) * 2, a3 = ((unsigned)ip[192] * D + (tid & 7) * 8) * 2;
#ifdef EMU
        const int bw = tid >> 6;
#else
        const int bw = __builtin_amdgcn_readfirstlane(tid >> 6);
#endif
        const int is_up = bw & 1;
        const float* wmat = (is_up ? p.in[I_WU] : p.in[I_WG]) + ((size_t)l * NEXP + e) * D * EH;
        if (half < 0) {
        const int bkr = 2 * (bw >> 1) + ((tid >> 5) & 1), hc = 4 * (tid & 31);
        const int ncol = (hc >> 6) * 128 + (2 * ((hc >> 5) & 1) + is_up) * 32 + (hc & 31);
        const unsigned bvo = (unsigned)(cbk * 128 + hc) * 4 + (unsigned)bkr * (EH * 4);
        const unsigned blds = (unsigned)bkr * 576u + (unsigned)ncol * 2u;
        gemm_tile<4, VAR>(smem, make_rsrc(h2), a0, a1, a2, a3, make_rsrc(wmat), bvo, blds, EH * 4, D, [&](f16v (&acc)[4][2]) {
            int lane_e = lane; VGPR_PIN(lane_e); const int lane = lane_e, l31 = lane_e & 31, h = lane_e >> 5; (void)l31; (void)h;
            char* stg = wave_stage_ptr(smem, wave);
#pragma unroll
            for (int tt = 0; tt < 2; ++tt)
#pragma unroll
                for (int pr = 0; pr < 2; ++pr)
#pragma unroll
                    for (int g = 0; g < 4; ++g) {
                        float o[4];
#pragma unroll
                        for (int q = 0; q < 4; ++q) o[q] = siluf_(acc[2 * pr][tt][4 * g + q]) * acc[2 * pr + 1][tt][4 * g + q];
                        stage64_write4(stg, tt * 32 + l31, pr * 32 + 8 * g + 4 * h, o[0], o[1], o[2], o[3]);
                    }
            stage64_flush_bf16(stg, hid + ((size_t)e * SLOTS + rb * 256 + wm * 64) * EH + cbk * 128 + wn * 64, EH, lane);
        });
        } else {
        const int bkr = 4 * (bw >> 1) + ((tid >> 4) & 3), hc = 4 * (tid & 15);
        const int ncol = (hc >> 5) * 64 + is_up * 32 + (hc & 31);
        const unsigned bvo = (unsigned)(cbk * 128 + half * 64 + hc) * 4 + (unsigned)bkr * (EH * 4);
        const unsigned blds = (unsigned)bkr * 320u + (unsigned)ncol * 2u;
        gemm_tile<2, VAR>(smem, make_rsrc(h2), a0, a1, a2, a3, make_rsrc(wmat), bvo, blds, EH * 4, D, [&](f16v (&acc)[2][2]) {
            int lane_e = lane; VGPR_PIN(lane_e); const int lane = lane_e, l31 = lane_e & 31, h = lane_e >> 5; (void)l31; (void)h;
            char* stg = wave_stage_ptr(smem, wave);
#pragma unroll
            for (int tt = 0; tt < 2; ++tt)
#pragma unroll
                for (int g = 0; g < 4; ++g) {
                    float o[4];
#pragma unroll
                    for (int q = 0; q < 4; ++q) o[q] = siluf_(acc[0][tt][4 * g + q]) * acc[1][tt][4 * g + q];
                    stage64_write4(stg, tt * 32 + l31, 8 * g + 4 * h, o[0], o[1], o[2], o[3]);
                }
            WAVE_SYNC();
            bf16_t* dst0 = hid + ((size_t)e * SLOTS + rb * 256 + wm * 64) * EH + cbk * 128 + half * 64 + wn * 32;
#pragma unroll
            for (int i = 0; i < 4; ++i) { const int r = (lane >> 2) + 16 * i, c = lane & 3; const u4v v = *(const u4v*)(stg + r * LROW + c * 16); *(u4v*)(dst0 + (size_t)r * EH + c * 8) = v; }
            WAVE_SYNC();
        });
        }
    }
}

template <int VAR>
DEV void phase_down(const Params& p, char* smem, int l) {
    constexpr int NRB = SLOTS / 256, NCB = D / 256, NU = NEXP * NCB * NRB;
    const int tid = get_tid(), lane = tid & 63, wave = tid >> 6, wm = wave & 3, wn = wave >> 2, h = lane >> 5, l31 = lane & 31;
    const bf16_t* hid = (const bf16_t*)(p.ws + WS_HID);
    const float* gsel = (const float*)(p.ws + WS_GSEL);
    bf16_t* ye = (bf16_t*)(p.ws + WS_YE);
    const UnitIter it = unit_iter(NU);
    for (int u = it.i; u < it.end; u += it.step) {
        const int rb = u % NRB, cbk = (u / NRB) % NCB, e = u / (NRB * NCB);
        const unsigned ao = ((unsigned)(rb * 256 + (tid >> 3)) * EH + (tid & 7) * 8) * 2;
        const unsigned bvo = (unsigned)(cbk * 256 + 4 * (tid & 63)) * 4 + (unsigned)(tid >> 6) * (D * 4);
        const unsigned blds = (unsigned)(tid >> 6) * 576u + (unsigned)(tid & 63) * 8u;
        gemm_tile<4, VAR>(smem, make_rsrc(hid + (size_t)e * SLOTS * EH), ao, ao + 128u * EH, ao + 256u * EH, ao + 384u * EH, make_rsrc(p.in[I_WD] + ((size_t)l * NEXP + e) * EH * D), bvo, blds, D * 4, EH, [&](f16v (&acc)[4][2]) {
            int lane_e = lane; VGPR_PIN(lane_e); const int lane = lane_e, l31 = lane_e & 31, h = lane_e >> 5; (void)l31; (void)h;
            char* stg = wave_stage_ptr(smem, wave);
            const float gs0 = gsel[e * SLOTS + rb * 256 + wm * 64 + l31], gs1 = gsel[e * SLOTS + rb * 256 + wm * 64 + 32 + l31];
#pragma unroll
            for (int hb = 0; hb < 2; ++hb) {
#pragma unroll
                for (int tt = 0; tt < 2; ++tt) {
                    const float gs = tt ? gs1 : gs0;
#pragma unroll
                    for (int f2 = 0; f2 < 2; ++f2)
#pragma unroll
                        for (int g = 0; g < 4; ++g) { const f16v& a = acc[2 * hb + f2][tt]; stage64_write4(stg, tt * 32 + l31, f2 * 32 + 8 * g + 4 * h, a[4 * g] * gs, a[4 * g + 1] * gs, a[4 * g + 2] * gs, a[4 * g + 3] * gs); }
                }
                stage64_flush_bf16(stg, ye + ((size_t)e * SLOTS + rb * 256 + wm * 64) * D + cbk * 256 + wn * 128 + hb * 64, D, lane);
            }
        });
    }
}

struct AttnDesc {
    const bf16_t* q; int qstride;
    int ntiles, n0;
    const bf16_t *k0, *v0; int stride0;
    const bf16_t *k1, *v1; int stride1;
    int na;
    int r0, rlo;
    const float* rpb;
    bf16_t* out; int ostride;
    float* part;
};
constexpr int ATT_TILE = 64 * LROW;
DEV int na_row_start(int r) { int s = r - KR / 2; s = s < 0 ? 0 : s; return s > ROWS - KR ? ROWS - KR : s; }
DEV void attn_unit(char* smem, const AttnDesc& d) {
    const int tid = get_tid(), lane = tid & 63, wave = tid >> 6, h = lane >> 5, l31 = lane & 31;
    char* Ks = smem; char* Vs = smem + 2 * ATT_TILE; float* rpbS = (float*)(smem + 4 * ATT_TILE);
    if (d.na) { for (int i = tid; i < 15 * 31; i += 512) rpbS[i] = d.rpb[i] * 1.4426950408889634f; }
    const bf16_t* qp = d.q + (size_t)(wave * 32 + l31) * d.qstride + h * 8;
    s8v qf[4];
#pragma unroll
    for (int s = 0; s < 4; ++s) qf[s] = *(const s8v*)(qp + 16 * s);
    float m_run = -1e30f, l_run = 0.f;
    f16v o[2]; o[0] = f16zero(); o[1] = f16zero();
    const int srow = tid >> 3, sch = tid & 7;
    u4v kreg, vreg;
    auto gload = [&](int t) {
        const bf16_t *kp, *vp;
        if (t < d.n0) { const size_t off = (size_t)(t * 64 + srow) * d.stride0 + sch * 8; kp = d.k0 + off; vp = d.v0 + off; }
        else { const size_t off = (size_t)((t - d.n0) * 64 + srow) * d.stride1 + sch * 8; kp = d.k1 + off; vp = d.v1 + off; }
        kreg = *(const u4v*)kp; vreg = *(const u4v*)vp;
    };
    auto lstore = [&](int buf) { *(u4v*)(Ks + buf * ATT_TILE + srow * LROW + sch * 16) = kreg; *(u4v*)(Vs + buf * ATT_TILE + srow * LROW + sch * 16) = vreg; };
    const int qr = d.r0 + (wave >> 1), qw = (wave & 1) * 32 + l31;
    const int rs = na_row_start(qr);
    int cs = qw - KC / 2; cs = cs < 0 ? 0 : (cs > GRIDW - KC ? GRIDW - KC : cs);
    gload(0); lstore(0);
    __syncthreads();
    for (int t = 0; t < d.ntiles; ++t) {
        const int buf = t & 1;
        if (t + 1 < d.ntiles) gload(t + 1);
        const bool local = d.na && t >= d.n0;
        const int kr = d.rlo + (t - d.n0);
        const bool active = !local || (kr >= rs && kr < rs + KR);
        if (active) {
            const char* kb = Ks + buf * ATT_TILE + l31 * LROW + h * 16;
            f16v sa[2];
#pragma unroll
            for (int kt = 0; kt < 2; ++kt) {
                sa[kt] = f16zero();
#pragma unroll
                for (int s = 0; s < 4; ++s) { const s8v kf = *(const s8v*)(kb + kt * 32 * LROW + s * 32); sa[kt] = mfma32(kf, qf[s], sa[kt]); }
            }
            constexpr float C2 = ATT_SCALE * 1.4426950408889634f;
            float mx = -1e30f;
            if (local) {
#pragma unroll
                for (int kt = 0; kt < 2; ++kt)
#pragma unroll
                    for (int r = 0; r < 16; ++r) {
                        const int kc = kt * 32 + (r & 3) + 8 * (r >> 2) + 4 * h;
                        const bool inw = kc >= cs && kc < cs + KC;
                        const int bi = (kr - qr + 7) * 31 + (kc - qw + 15);
                        const float v = inw ? sa[kt][r] * C2 + rpbS[inw ? bi : 0] : -1e30f;
                        sa[kt][r] = v; mx = fmaxf(mx, v);
                    }
            } else {
#pragma unroll
                for (int kt = 0; kt < 2; ++kt)
#pragma unroll
                    for (int r = 0; r < 16; ++r) mx = fmaxf(mx, sa[kt][r]);
                mx *= C2;
            }
            mx = fmaxf(mx, __shfl_xor(mx, 32));
            if (__ballot(mx > m_run) != 0ull) {
                const float m_new = fmaxf(m_run, mx);
                const float alpha = fexp2(m_run - m_new);
                l_run *= alpha; m_run = m_new;
                o[0] *= alpha; o[1] *= alpha;
            }
            float ps = 0.f;
            if (local) {
#pragma unroll
                for (int kt = 0; kt < 2; ++kt)
#pragma unroll
                    for (int r = 0; r < 16; ++r) { const float pv = fexp2(sa[kt][r] - m_run); sa[kt][r] = pv; ps += pv; }
            } else {
#pragma unroll
                for (int kt = 0; kt < 2; ++kt)
#pragma unroll
                    for (int r = 0; r < 16; ++r) { const float pv = fexp2(sa[kt][r] * C2 - m_run); sa[kt][r] = pv; ps += pv; }
            }
            l_run += ps;
            const char* vb = Vs + buf * ATT_TILE + (4 * h + ((lane & 15) >> 2)) * LROW + (((lane >> 4) & 1) * 16 + 4 * (lane & 3)) * 2;
#pragma unroll
            for (int ks = 0; ks < 4; ++ks) {
                const int kt = ks >> 1, rb = 8 * (ks & 1);
                u4v pk; pk[0] = pack2(sa[kt][rb], sa[kt][rb + 1]); pk[1] = pack2(sa[kt][rb + 2], sa[kt][rb + 3]);
                pk[2] = pack2(sa[kt][rb + 4], sa[kt][rb + 5]); pk[3] = pack2(sa[kt][rb + 6], sa[kt][rb + 7]);
                const s8v pf = __builtin_bit_cast(s8v, pk);
                const char* vk = vb + (kt * 32 + 16 * (ks & 1)) * LROW;
#pragma unroll
                for (int dt = 0; dt < 2; ++dt) {
                    const s4v lo = lds_tr16(vk + dt * 64), hi = lds_tr16(vk + 8 * LROW + dt * 64);
                    s8v vf; vf[0] = lo[0]; vf[1] = lo[1]; vf[2] = lo[2]; vf[3] = lo[3]; vf[4] = hi[0]; vf[5] = hi[1]; vf[6] = hi[2]; vf[7] = hi[3];
                    o[dt] = mfma32(vf, pf, o[dt]);
                }
            }
        }
        if (t + 1 < d.ntiles) lstore(buf ^ 1);
        __syncthreads();
    }
    const float l_tot = l_run + __shfl_xor(l_run, 32);
    const int qrow = wave * 32 + l31;
    if (d.part) {
        float* po = d.part + (size_t)qrow * 64;
#pragma unroll
        for (int dt = 0; dt < 2; ++dt)
#pragma unroll
            for (int g = 0; g < 4; ++g) { f4v v; v[0] = o[dt][4 * g]; v[1] = o[dt][4 * g + 1]; v[2] = o[dt][4 * g + 2]; v[3] = o[dt][4 * g + 3]; *(f4v*)(po + dt * 32 + 8 * g + 4 * h) = v; }
        if (h == 0) { d.part[256 * 64 + qrow] = m_run; d.part[256 * 64 + 256 + qrow] = l_tot; }
    } else {
        const float inv = 1.f / l_tot;
        bf16_t* po = d.out + (size_t)qrow * d.ostride;
#pragma unroll
        for (int dt = 0; dt < 2; ++dt)
#pragma unroll
            for (int g = 0; g < 4; ++g) {
                u2v pk; pk[0] = pack2(o[dt][4 * g] * inv, o[dt][4 * g + 1] * inv); pk[1] = pack2(o[dt][4 * g + 2] * inv, o[dt][4 * g + 3] * inv);
                *(u2v*)(po + dt * 32 + 8 * g + 4 * h) = pk;
            }
    }
}

DEV int ml_sidx(int grp, int b, int head, int c) { return grp == 0 ? ((b * MLH + head) * NCH_P + c) : BATCH * MLH * NCH_P + ((b * MLH + head) * NCH_S + c); }
DEV float lane_prefix_sum(float v, int lane) { for (int dlt = 1; dlt < 64; dlt <<= 1) { const float o = __shfl(v, lane - dlt); if (lane >= dlt) v += o; } return v; }
DEV float lane_prefix_max(float v, int lane) { for (int dlt = 1; dlt < 64; dlt <<= 1) { const float o = __shfl(v, lane - dlt); if (lane >= dlt) v = fmaxf(v, o); } return v; }

DEV void mlstm_summary_unit(const Params& p, char* smem, int grp, int b, int head, int c) {
    const int tid = get_tid(), lane = tid & 63, wave = tid >> 6, h = lane >> 5, l31 = lane & 31;
    char* KT = smem;
    char* VT = smem + 2 * ATT_TILE;
    float* wsS = (float*)(smem + 3 * ATT_TILE);
    float* scal = wsS + 128;
    const int tb = (grp == 0 ? b * SEQ : NP + b * DEC_SEQ) + c * 64;
    const float* gates = (const float*)(p.ws + WS_GATES);
    if (wave == 0) {
        const float* gr = gates + (size_t)(tb + lane) * 16;
        const float i_f = gr[head], lf_f = logsigmoidf_(gr[4 + head]), i_b = gr[8 + head], lf_b = logsigmoidf_(gr[12 + head]);
        const float pf = lane_prefix_sum(lf_f, lane), pb = lane_prefix_sum(lf_b, lane);
        const float tot_f = __shfl(pf, 63), tot_b = __shfl(pb, 63);
        const float g_f = (tot_f - pf) + i_f, g_b = (pb - lf_b) + i_b;
        const float G_f = wave_max(g_f), G_b = wave_max(g_b);
        wsS[lane] = fexp(g_f - G_f); wsS[64 + lane] = fexp(g_b - G_b);
        if (lane == 0) { scal[0] = tot_f; scal[1] = tot_b; scal[2] = G_f; scal[3] = G_b; }
    }
    __syncthreads();
    {
        const int tau = tid >> 3, ch = tid & 7;
        const u4v kv = *(const u4v*)((const bf16_t*)(p.ws + WS_MLK) + (size_t)(tb + tau) * 256 + head * 64 + ch * 8);
        const u4v vv = *(const u4v*)((const bf16_t*)(p.ws + WS_MLV) + (size_t)(tb + tau) * 256 + head * 64 + ch * 8);
        const float wf = wsS[tau], wb = wsS[64 + tau];
#pragma unroll
        for (int j = 0; j < 8; ++j) {
            const bf16_t kb = (bf16_t)(kv[j >> 1] >> (16 * (j & 1))), vb = (bf16_t)(vv[j >> 1] >> (16 * (j & 1)));
            const int dim = ch * 8 + j; const float kf = bf2f(kb);
            *(bf16_t*)(KT + dim * LROW + tau * 2) = f2bf(kf * wf);
            *(bf16_t*)(KT + ATT_TILE + dim * LROW + tau * 2) = f2bf(kf * wb);
            *(bf16_t*)(VT + dim * LROW + tau * 2) = vb;
        }
    }
    __syncthreads();
    float* sum = (float*)(p.ws + WS_MLSUM);
    const int sidx = ml_sidx(grp, b, head, c);
    {
        const int dir = wave >> 2, mi = (wave >> 1) & 1, ni = wave & 1;
        f16v acc = f16zero();
#pragma unroll
        for (int s = 0; s < 4; ++s) {
            const s8v af = *(const s8v*)(KT + dir * ATT_TILE + (mi * 32 + l31) * LROW + (16 * s + 8 * h) * 2);
            const s8v bf = *(const s8v*)(VT + (ni * 32 + l31) * LROW + (16 * s + 8 * h) * 2);
            acc = mfma32(af, bf, acc);
        }
        bf16_t* U = (bf16_t*)(sum + (size_t)(sidx * 2 + dir) * MLSUM_STRIDE);
#pragma unroll
        for (int r = 0; r < 16; ++r) U[(mi * 32 + (r & 3) + 8 * (r >> 2) + 4 * h) * 64 + ni * 32 + l31] = f2bf(acc[r]);
    }
    if (tid < 128) {
        const int dir = tid >> 6, kd = tid & 63;
        float s = 0.f;
        for (int tau = 0; tau < 64; ++tau) s += bf2f(*(const bf16_t*)(KT + dir * ATT_TILE + kd * LROW + tau * 2));
        float* E = sum + (size_t)(sidx * 2 + dir) * MLSUM_STRIDE;
        E[ML_NU + kd] = s;
        if (kd == 0) { E[ML_AG] = scal[dir]; E[ML_AG + 1] = scal[2 + dir]; }
    }
    __syncthreads();
}

DEV void mlstm_output_unit(const Params& p, char* smem, int l, int grp, int b, int head, int c) {
    const int tid = get_tid(), lane = tid & 63, wave = tid >> 6, h = lane >> 5, l31 = lane & 31;
    const int nc = grp ? NCH_S : NCH_P;
    char* Qs = smem;
    char* Ks = smem + 2 * ATT_TILE;
    char* VT = smem + 4 * ATT_TILE;
    char* CT = smem + 6 * ATT_TILE;
    char* QK = smem + 8 * ATT_TILE;
    float* hS = (float*)(smem + 10 * ATT_TILE);
    float* vec = hS + 2 * 64 * 68;
    float* aS = vec; float* MjS = vec + 128; float* bS = vec + 256; float* nS = vec + 384; float* denp = vec + 512; float* qnS = vec + 768; float* scal = vec + 896;
    const int tb = (grp == 0 ? b * SEQ : NP + b * DEC_SEQ) + c * 64;
    const float* sum = (const float*)(p.ws + WS_MLSUM);
    const size_t qoff = (size_t)(tb + (tid >> 3)) * 256 + head * 64 + (tid & 7) * 8;
    const u4v q_r = *(const u4v*)((const bf16_t*)(p.ws + WS_MLQ) + qoff);
    const u4v k_r = *(const u4v*)((const bf16_t*)(p.ws + WS_MLK) + qoff);
    const u4v v_r = *(const u4v*)((const bf16_t*)(p.ws + WS_MLV) + qoff);
    const u4v o_r = *(const u4v*)((const bf16_t*)(p.ws + WS_MLO) + qoff);
    float g_i = 0.f, g_f = 0.f;
    if (wave < 2) { const float* gr = (const float*)(p.ws + WS_GATES) + (size_t)(tb + (wave ? 63 - lane : lane)) * 16; g_i = gr[wave * 8 + head]; g_f = gr[wave * 8 + 4 + head]; }
#pragma unroll
    for (int dir = 0; dir < 2; ++dir) {
        float C[8], nst = 0.f, m;
        if (grp == 0) {
#pragma unroll
            for (int i = 0; i < 8; ++i) C[i] = 0.f;
            m = 0.f;
        } else {
            const size_t sb = (((size_t)b * DEPTH + l) * 2 + dir) * MLH + head;
#pragma unroll
            for (int i = 0; i < 8; ++i) C[i] = p.in[I_SC][sb * 4096 + 8 * tid + i];
            if (tid < 64) nst = p.in[I_SN][sb * 64 + tid];
            m = p.in[I_SM][sb];
        }
        const int nsteps = dir == 0 ? c : nc - 1 - c;
        const bool fin = (grp == 0) && (dir == 0 ? c == nc - 1 : c == 0);
        {
            float A = 0.f, G = -1e30f;
            if (lane < nsteps) { const float* E = sum + (size_t)(ml_sidx(grp, b, head, dir == 0 ? lane : nc - 1 - lane) * 2 + dir) * MLSUM_STRIDE; A = E[ML_AG]; G = E[ML_AG + 1]; }
            const float P = lane_prefix_sum(A, lane);
            const float T = __shfl(P, 63);
            const float ev = lane < nsteps ? G + (T - P) : -1e30f;
            const float mc = fmaxf(m + T, wave_max(ev));
            const float coef = lane < nsteps ? fexp(ev - mc) : 0.f;
            const float coef0 = fexp(m + T - mc);
#pragma unroll
            for (int i = 0; i < 8; ++i) C[i] *= coef0;
            nst *= coef0;
#pragma unroll 4
            for (int st = 0; st < nsteps; ++st) {
                const float* E = sum + (size_t)(ml_sidx(grp, b, head, dir == 0 ? st : nc - 1 - st) * 2 + dir) * MLSUM_STRIDE;
                const float cf = __shfl(coef, st);
                const u4v uu = *(const u4v*)((const bf16_t*)E + 8 * tid);
#pragma unroll
                for (int i = 0; i < 8; ++i) C[i] += cf * bf2f((bf16_t)(uu[i >> 1] >> (16 * (i & 1))));
                if (tid < 64) nst += cf * E[ML_NU + tid];
            }
            m = mc;
        }
#pragma unroll
        for (int i = 0; i < 8; ++i) { const int e = 8 * tid + i; *(bf16_t*)(CT + dir * ATT_TILE + (e & 63) * LROW + (e >> 6) * 2) = f2bf(C[i]); }
        if (tid < 64) nS[dir * 64 + tid] = nst;
        if (tid == 0) scal[dir] = m;
        if (fin) {
            const float* E = sum + (size_t)(ml_sidx(grp, b, head, c) * 2 + dir) * MLSUM_STRIDE;
            const float A = E[ML_AG], G = E[ML_AG + 1];
            const float m_new = fmaxf(A + m, G);
            const float sc = fexp(A + m - m_new), su = fexp(G - m_new);
            const size_t ob = (((size_t)b * DEPTH + l) * 2 + dir) * MLH + head;
            const u4v uo = *(const u4v*)((const bf16_t*)E + 8 * tid);
#pragma unroll
            for (int i = 0; i < 8; ++i) p.out[O_MC + ob * 4096 + 8 * tid + i] = sc * C[i] + su * bf2f((bf16_t)(uo[i >> 1] >> (16 * (i & 1))));
            if (tid < 64) p.out[O_MN + ob * 64 + tid] = sc * nst + su * E[ML_NU + tid];
            if (tid == 0) p.out[O_MM + ob] = m_new;
        }
    }
    {
        const int row = tid >> 3, ch = tid & 7;
#pragma unroll
        for (int dir = 0; dir < 2; ++dir) {
            const int pr = dir ? 63 - row : row;
            *(u4v*)(Qs + dir * ATT_TILE + pr * LROW + ch * 16) = q_r;
            *(u4v*)(Ks + dir * ATT_TILE + pr * LROW + ch * 16) = k_r;
#pragma unroll
            for (int j = 0; j < 8; ++j) *(bf16_t*)(VT + dir * ATT_TILE + (ch * 8 + j) * LROW + pr * 2) = (bf16_t)(v_r[j >> 1] >> (16 * (j & 1)));
        }
    }
    __syncthreads();
    if (wave < 2) {
        const int dir = wave;
        const float ig = g_i, lf = logsigmoidf_(g_f);
        const float bj = lane_prefix_sum(lf, lane);
        const float a = ig - bj;
        const float Pj = lane_prefix_max(a, lane);
        aS[dir * 64 + lane] = a; bS[dir * 64 + lane] = bj; MjS[dir * 64 + lane] = fmaxf(scal[dir], Pj);
    } else if (wave < 4) {
        const int dir = wave - 2;
        float s = 0.f;
        for (int k = 0; k < 64; ++k) s += bf2f(*(const bf16_t*)(Qs + dir * ATT_TILE + lane * LROW + k * 2)) * nS[dir * 64 + k];
        qnS[dir * 64 + lane] = s;
    }
    __syncthreads();
    const int dir = wave >> 2, rt = (wave >> 1) & 1, jt = wave & 1;
    const int j = jt * 32 + l31;
    const float Mj = MjS[dir * 64 + j];
    {
        f16v acc = f16zero();
#pragma unroll
        for (int s4 = 0; s4 < 4; ++s4) {
            const s8v af = *(const s8v*)(Ks + dir * ATT_TILE + (rt * 32 + l31) * LROW + (16 * s4 + 8 * h) * 2);
            const s8v bf = *(const s8v*)(Qs + dir * ATT_TILE + j * LROW + (16 * s4 + 8 * h) * 2);
            acc = mfma32(af, bf, acc);
        }
        float dsum = 0.f;
#pragma unroll
        for (int g = 0; g < 4; ++g) {
            float o[4];
#pragma unroll
            for (int q = 0; q < 4; ++q) {
                const int s = rt * 32 + 8 * g + 4 * h + q;
                const float w = s <= j ? fexp(aS[dir * 64 + s] - Mj) : 0.f;
                o[q] = acc[4 * g + q] * w; dsum += o[q];
            }
            u2v pk; pk[0] = pack2(o[0], o[1]); pk[1] = pack2(o[2], o[3]);
            *(u2v*)(QK + dir * ATT_TILE + j * LROW + (rt * 32 + 8 * g + 4 * h) * 2) = pk;
        }
        dsum += __shfl_xor(dsum, 32);
        if (h == 0) denp[(dir * 2 + rt) * 64 + j] = dsum;
    }
    __syncthreads();
    {
        const float mst = scal[dir];
        const float decay = fexp(mst - Mj);
        f16v acc = f16zero();
#pragma unroll
        for (int s4 = 0; s4 < 4; ++s4) {
            const s8v af = *(const s8v*)(CT + dir * ATT_TILE + (rt * 32 + l31) * LROW + (16 * s4 + 8 * h) * 2);
            const s8v bf = *(const s8v*)(Qs + dir * ATT_TILE + j * LROW + (16 * s4 + 8 * h) * 2);
            acc = mfma32(af, bf, acc);
        }
        acc *= decay;
#pragma unroll
        for (int s4 = 0; s4 < 4; ++s4) {
            const s8v af = *(const s8v*)(VT + dir * ATT_TILE + (rt * 32 + l31) * LROW + (16 * s4 + 8 * h) * 2);
            const s8v bf = *(const s8v*)(QK + dir * ATT_TILE + j * LROW + (16 * s4 + 8 * h) * 2);
            acc = mfma32(af, bf, acc);
        }
        const float den = decay * qnS[dir * 64 + j] + denp[(dir * 2) * 64 + j] + denp[(dir * 2 + 1) * 64 + j];
        const float dn = fmaxf(fabsf(den), fexp(-(bS[dir * 64 + j] + Mj)));
        const float inv = 1.f / dn;
#pragma unroll
        for (int g = 0; g < 4; ++g) { f4v o; o[0] = acc[4 * g] * inv; o[1] = acc[4 * g + 1] * inv; o[2] = acc[4 * g + 2] * inv; o[3] = acc[4 * g + 3] * inv;
            *(f4v*)(hS + (dir * 64 + j) * 68 + rt * 32 + 8 * g + 4 * h) = o; }
    }
    __syncthreads();
    {
        const int tau = tid >> 3, v8 = (tid & 7) * 8;
        float hv[8]; float s = 0.f;
#pragma unroll
        for (int q = 0; q < 8; ++q) { hv[q] = hS[tau * 68 + v8 + q] + hS[(64 + 63 - tau) * 68 + v8 + q]; s += hv[q]; }
        s += __shfl_xor(s, 1); s += __shfl_xor(s, 2); s += __shfl_xor(s, 4);
        const float mu = s * (1.f / 64.f);
        float qq = 0.f;
#pragma unroll
        for (int q = 0; q < 8; ++q) { const float dlt = hv[q] - mu; qq += dlt * dlt; }
        qq += __shfl_xor(qq, 1); qq += __shfl_xor(qq, 2); qq += __shfl_xor(qq, 4);
        const float rstd = frsqrt(qq * (1.f / 64.f) + EPS);
        const int t = tb + tau;
        const u4v ov = o_r;
        const float* ng = p.in[I_MLG] + (size_t)l * 256 + head * 64 + v8;
        float o[8];
#pragma unroll
        for (int q = 0; q < 8; ++q) { const float og = bf2f((bf16_t)(ov[q >> 1] >> (16 * (q & 1)))); o[q] = (hv[q] - mu) * rstd * ng[q] * sigmoidf_(og); }
        u4v pk; pk[0] = pack2(o[0], o[1]); pk[1] = pack2(o[2], o[3]); pk[2] = pack2(o[4], o[5]); pk[3] = pack2(o[6], o[7]);
        *(u4v*)((bf16_t*)(p.ws + WS_MIXED) + (size_t)t * MIXW + 384 + head * 64 + v8) = pk;
    }
    __syncthreads();
}

DEV int queue_next(const Params& p, char* smem, int qi) {
    int* slot = (int*)(smem + SMEM_XB + 32);
    __syncthreads();
    if (threadIdx.x == 0) {
#ifdef EMU
        unsigned* w = (unsigned*)(p.ws + WS_BAR) + QUEUE_WORD0 + 64 * qi; *slot = (int)(*w)++;
#else
        *slot = (int)__hip_atomic_fetch_add((unsigned*)(p.ws + WS_BAR) + QUEUE_WORD0 + 64 * qi, 1u, __ATOMIC_RELAXED, __HIP_MEMORY_SCOPE_AGENT);
#endif
    }
    __syncthreads();
    return *slot;
}
DEV void phase_attn(const Params& p, char* smem, int l, int qi) {
    constexpr int QB_S = DEC_SEQ / 256, QB_P = SEQ / 256;
    constexpr int U_SG = DEC_BATCH * GQH * QB_S * 2, U_SN = DEC_BATCH * NAH * QB_S, U_PN = BATCH * NAH * QB_P, U_PG = BATCH * GQH * QB_P;
    constexpr int U_MP = BATCH * MLH * NCH_P, U_MS = DEC_BATCH * MLH * NCH_S;
    constexpr int NU = U_SG + U_SN + U_PN + U_PG + U_MP + U_MS;
    const bf16_t* naq = (const bf16_t*)(p.ws + WS_NAQ); const bf16_t* nak = (const bf16_t*)(p.ws + WS_NAK); const bf16_t* nav = (const bf16_t*)(p.ws + WS_NAV);
    const bf16_t* gqq = (const bf16_t*)(p.ws + WS_GQQ); const bf16_t* gqk = (const bf16_t*)(p.ws + WS_GQK); const bf16_t* gqv = (const bf16_t*)(p.ws + WS_GQV);
    bf16_t* mixed = (bf16_t*)(p.ws + WS_MIXED);
    for (;;) {
        int u = queue_next(p, smem, qi);
        if (u >= NU) break;
#ifdef PROBE_ATT
        if (qi >= 8) { const int cls = u < U_SG ? 1 : u < U_SG + U_SN ? 2 : u < U_SG + U_SN + U_PN + U_PG ? 3 : 4; if (cls != PROBE_ATT) continue; }
#endif
        AttnDesc d; d.na = 0; d.r0 = 0; d.rlo = 0; d.rpb = nullptr; d.part = nullptr; d.out = nullptr; d.ostride = MIXW; d.n0 = 0; d.k0 = d.v0 = nullptr; d.stride0 = 0;
        if (u < U_SG) {
            const int half = u & 1, qb = (u >> 1) % QB_S, qh = (u / (2 * QB_S)) % GQH, b = u / (2 * QB_S * GQH);
            const int kvh = qh / (GQH / GQKV);
            constexpr int NCT = PAST / 64, TT = NCT + DEC_SEQ / 64, H0 = TT / 2;
            const size_t tq = (size_t)NP + (size_t)b * DEC_SEQ + qb * 256;
            d.q = gqq + tq * 384 + qh * 64; d.qstride = 384;
            const bf16_t* lk = gqk + ((size_t)NP + (size_t)b * DEC_SEQ) * 128 + kvh * 64; const bf16_t* lv = gqv + ((size_t)NP + (size_t)b * DEC_SEQ) * 128 + kvh * 64;
            if (half == 0) {
                d.n0 = NCT; d.ntiles = H0; d.stride0 = 128;
                const size_t co = (((size_t)b * DEPTH + l) * PAST) * 128 + kvh * 64;
                d.k0 = (const bf16_t*)(p.ws + WS_CGQK) + co; d.v0 = (const bf16_t*)(p.ws + WS_CGQV) + co;
                d.k1 = lk; d.v1 = lv; d.stride1 = 128;
            } else {
                d.n0 = 0; d.ntiles = TT - H0; d.stride1 = 128;
                d.k1 = lk + (size_t)(H0 - NCT) * 64 * 128; d.v1 = lv + (size_t)(H0 - NCT) * 64 * 128;
            }
            d.part = (float*)(p.ws + WS_PART) + (size_t)u * PART_STRIDE;
        } else if (u < U_SG + U_SN) {
            const int uu = u - U_SG; const int qb = uu % QB_S, hd = (uu / QB_S) % NAH, b = uu / (QB_S * NAH);
            const size_t t0 = (size_t)NP + (size_t)b * DEC_SEQ;
            d.q = naq + (t0 + qb * 256) * 384 + hd * 64; d.qstride = 384;
            d.na = 1; d.r0 = qb * 4; d.rlo = na_row_start(d.r0);
            const int rhi = na_row_start(d.r0 + 3) + KR;
            d.n0 = PAST / 64; d.ntiles = d.n0 + (rhi - d.rlo); d.stride0 = 384; d.stride1 = 384;
            const size_t co = (((size_t)b * DEPTH + l) * PAST) * 384 + hd * 64;
            d.k0 = (const bf16_t*)(p.ws + WS_CNAK) + co; d.v0 = (const bf16_t*)(p.ws + WS_CNAV) + co;
            d.k1 = nak + (t0 + (size_t)d.rlo * 64) * 384 + hd * 64; d.v1 = nav + (t0 + (size_t)d.rlo * 64) * 384 + hd * 64;
            d.rpb = p.in[I_RPB] + ((size_t)l * NAH + hd) * 15 * 31;
            d.out = mixed + (t0 + qb * 256) * MIXW + hd * 64;
        } else if (u < U_SG + U_SN + U_PN) {
            const int uu = u - U_SG - U_SN; const int qb = uu % QB_P, hd = (uu / QB_P) % NAH, b = uu / (QB_P * NAH);
            const size_t t0 = (size_t)b * SEQ;
            d.q = naq + (t0 + qb * 256) * 384 + hd * 64; d.qstride = 384;
            d.n0 = 0; d.ntiles = SEQ / 64; d.stride1 = 384; d.k1 = nak + t0 * 384 + hd * 64; d.v1 = nav + t0 * 384 + hd * 64;
            d.out = mixed + (t0 + qb * 256) * MIXW + hd * 64;
        } else if (u < U_SG + U_SN + U_PN + U_PG) {
            const int uu = u - U_SG - U_SN - U_PN; const int qb = uu % QB_P, qh = (uu / QB_P) % GQH, b = uu / (QB_P * GQH);
            const int kvh = qh / (GQH / GQKV);
            const size_t t0 = (size_t)b * SEQ;
            d.q = gqq + (t0 + qb * 256) * 384 + qh * 64; d.qstride = 384;
            d.n0 = 0; d.ntiles = SEQ / 64; d.stride1 = 128; d.k1 = gqk + t0 * 128 + kvh * 64; d.v1 = gqv + t0 * 128 + kvh * 64;
            d.out = mixed + (t0 + qb * 256) * MIXW + 640 + qh * 64;
        } else {
            int uu = u - (U_SG + U_SN + U_PN + U_PG); const int grp = uu >= U_MP ? 1 : 0; if (grp) uu -= U_MP;
            const int nch = grp ? NCH_S : NCH_P;
            mlstm_summary_unit(p, smem, grp, uu / (nch * MLH), (uu / nch) % MLH, uu % nch);
        }
        if (u < U_SG + U_SN + U_PN + U_PG) attn_unit(smem, d);
    }
}

DEV void phase_mlout(const Params& p, char* smem, int l) {
    constexpr int QB_S = DEC_SEQ / 256;
    constexpr int U_MS = DEC_BATCH * MLH * NCH_S, U_MP = BATCH * MLH * NCH_P, U_CB = DEC_BATCH * GQH * QB_S;
    const int tid = get_tid(), lane = tid & 63, wave = tid >> 6;
    for (int tk = blockIdx.x + gridDim.x * wave; tk < U_CB * 4; tk += gridDim.x * 8) {
        const int uu = tk >> 2, sl = tk & 3;
        const int qb = uu % QB_S, qh = (uu / QB_S) % GQH, b = uu / (QB_S * GQH);
        const float* p0 = (const float*)(p.ws + WS_PART) + (size_t)(2 * uu) * PART_STRIDE; const float* p1 = p0 + PART_STRIDE;
        const int q = sl * 64 + (lane >> 1) + 32 * 0, d0 = (lane & 1) * 32;
#pragma unroll
        for (int hq = 0; hq < 2; ++hq) {
            const int qq = q + 32 * hq;
            const float m0 = p0[256 * 64 + qq], m1 = p1[256 * 64 + qq], l0 = p0[256 * 64 + 256 + qq], l1 = p1[256 * 64 + 256 + qq];
            const float m = fmaxf(m0, m1), w0 = fexp2(m0 - m), w1 = fexp2(m1 - m);
            const float inv = 1.f / (l0 * w0 + l1 * w1);
            bf16_t* dst = (bf16_t*)(p.ws + WS_MIXED) + ((size_t)NP + (size_t)b * DEC_SEQ + qb * 256 + qq) * MIXW + 640 + qh * 64 + d0;
#pragma unroll
            for (int i = 0; i < 8; ++i) {
                const f4v a = *(const f4v*)(p0 + (size_t)qq * 64 + d0 + 4 * i), bb = *(const f4v*)(p1 + (size_t)qq * 64 + d0 + 4 * i);
                u2v pk; pk[0] = pack2((a[0] * w0 + bb[0] * w1) * inv, (a[1] * w0 + bb[1] * w1) * inv); pk[1] = pack2((a[2] * w0 + bb[2] * w1) * inv, (a[3] * w0 + bb[3] * w1) * inv);
                *(u2v*)(dst + 4 * i) = pk;
            }
        }
    }
    for (int u = blockIdx.x; u < U_MS + U_MP; u += gridDim.x) {
        const int grp = u < U_MS ? 1 : 0; const int uu = grp ? u : u - U_MS; const int nch = grp ? NCH_S : NCH_P;
        mlstm_output_unit(p, smem, l, grp, uu / (nch * MLH), (uu / nch) % MLH, uu % nch);
    }
}

constexpr int N_PHASES = 2 + 9 * DEPTH;
#ifndef EMU
typedef const __attribute__((address_space(4))) Params* KParamsPtr;
DEV void load_params(Params& p) {
    KParamsPtr kp = (KParamsPtr)__builtin_amdgcn_kernarg_segment_ptr();
    asm volatile("" : "+s"(kp));
#pragma unroll
    for (int i = 0; i < N_IN; ++i) p.in[i] = kp->in[i];
    p.out = kp->out; p.ws = kp->ws; p.ph0 = kp->ph0; p.ph1 = kp->ph1;
}
#endif
#ifdef EMU
static char emu_smem[SMEM_BYTES + 64];
#endif
__global__ void __launch_bounds__(512, 2) mega_kernel(Params p_) {
    const int ph0 = p_.ph0, ph1 = p_.ph1;
#ifdef EMU
    char* smem = emu_smem;
#define GRID_SYNC() do {} while (0)
#else
    extern __shared__ __attribute__((aligned(16))) char smem[];
    if (threadIdx.x == 0) *(u4v*)(smem + SMEM_XB) = (u4v){0u, 0u, 0u, 0u};
    __syncthreads();
    (void)xcd_barrier_post((unsigned*)(p_.ws + WS_BAR), (volatile LAS unsigned*)(smem + SMEM_XB));
    const bool multi = (ph1 - ph0) > 1;
#define GRID_SYNC() do { if (multi) { KParamsPtr kpb = (KParamsPtr)__builtin_amdgcn_kernarg_segment_ptr(); asm volatile("" : "+s"(kpb)); \
        XcdBarrier xb; xb.bar = (unsigned*)(kpb->ws + WS_BAR); xb.x = xb_xcc_id(); xb.st = (volatile LAS unsigned*)(smem + SMEM_XB); xcd_barrier(xb); } } while (0)
#endif
    int ph = 0;
#ifndef KIND_MASK
#define KIND_MASK 0x3ff
#endif
#ifdef EMU
#define LOAD_PARAMS() const Params& p = p_
#else
#define LOAD_PARAMS() Params p; load_params(p)
#endif
#ifndef DOUBLE_MASK
#define DOUBLE_MASK 0
#endif
#define PH_KIND() (ph == 0 ? 0 : ph == 1 + 9 * DEPTH ? 1 : 1 + (ph - 1) % 9)
#define RUN_PHASE(body) do { if (((KIND_MASK >> PH_KIND()) & 1) && ph >= ph0 && ph < ph1) { \
    if (DOUBLE_MASK && ((DOUBLE_MASK >> PH_KIND()) & 1)) { { const int rep_ = 1; LOAD_PARAMS(); body; } GRID_SYNC(); } \
    { const int rep_ = 0; LOAD_PARAMS(); body; } if (ph + 1 < ph1) GRID_SYNC(); } ++ph; } while (0)
    RUN_PHASE(phase_ada(p, smem));
    for (int l = 0; l < DEPTH; ++l) {
        RUN_PHASE(phase_rows<0>(p, smem, l));
        RUN_PHASE(phase_inproj<0>(p, smem, l));
        RUN_PHASE(phase_attn(p, smem, l, l + DEPTH * rep_));
        RUN_PHASE(phase_mlout(p, smem, l));
        RUN_PHASE(phase_outproj<0>(p, smem, l));
        RUN_PHASE(phase_rows<1>(p, smem, l));
        RUN_PHASE(phase_topk(p, smem));
        RUN_PHASE(phase_gateup<0>(p, smem, l));
        RUN_PHASE(phase_down<0>(p, smem, l));
    }
    RUN_PHASE(phase_rows<0>(p, smem, DEPTH));
#ifdef PROBE_BARRIERS
    for (int i = 0; i < PROBE_BARRIERS; ++i) GRID_SYNC();
#endif
}

#if !defined(EMU) && defined(PROBE_KIND)
__global__ void __launch_bounds__(512, 2) probe_kernel(Params p) {
    extern __shared__ __attribute__((aligned(16))) char smem[];
    for (int r = 0; r < PROBE_REPS; ++r) {
#if PROBE_KIND == 8
        phase_gateup<PROBE_VAR>(p, smem, 1);
#elif PROBE_KIND == 9
        phase_down<PROBE_VAR>(p, smem, 1);
#elif PROBE_KIND == 2
        phase_inproj<PROBE_VAR>(p, smem, 1);
#elif PROBE_KIND == 5
        phase_outproj<PROBE_VAR>(p, smem, 1);
#elif PROBE_KIND == 0
        phase_ada(p, smem);
#elif PROBE_KIND == 1
        phase_rows<0>(p, smem, 1);
#elif PROBE_KIND == 6
        phase_rows<1>(p, smem, 1);
#elif PROBE_KIND == 7
        phase_topk(p, smem);
#elif PROBE_KIND == 3
        phase_attn(p, smem, 1, 8 + r);
#elif PROBE_KIND == 4
        phase_mlout(p, smem, 1);
#endif
        __syncthreads();
    }
}
#endif
#ifndef EMU
#ifndef MK_N_LAUNCHES
#define MK_N_LAUNCHES 1
#endif
extern "C" void kernel_launch(void* const* d_in, const int* in_sizes, int n_in, void* d_out, int out_size, void* d_ws, size_t ws_size, hipStream_t stream) {
    (void)in_sizes; (void)n_in; (void)out_size; (void)ws_size;
    static int grid = 0;
    if (!grid) {
        int dev = 0, cus = 0, per_cu = 0;
        (void)hipGetDevice(&dev);
        (void)hipDeviceGetAttribute(&cus, hipDeviceAttributeMultiprocessorCount, dev);
        (void)hipFuncSetAttribute((const void*)mega_kernel, hipFuncAttributeMaxDynamicSharedMemorySize, SMEM_BYTES);
        (void)hipOccupancyMaxActiveBlocksPerMultiprocessor(&per_cu, mega_kernel, 512, SMEM_BYTES);
        grid = cus * (per_cu < 1 ? per_cu : 1);
        if (grid <= 0) grid = cus;
    }
    (void)hipMemsetAsync((char*)d_ws + WS_BAR, 0, WS_BAR_BYTES, stream);
    Params p = {};
    for (int i = 0; i < N_IN; ++i) p.in[i] = (const float*)d_in[i];
    p.out = (float*)d_out; p.ws = (char*)d_ws;
#if MK_N_LAUNCHES == 1
    p.ph0 = 0; p.ph1 = N_PHASES;
    mega_kernel<<<dim3(grid), dim3(512), SMEM_BYTES, stream>>>(p);
#ifdef PROBE_KIND
    (void)hipFuncSetAttribute((const void*)probe_kernel, hipFuncAttributeMaxDynamicSharedMemorySize, SMEM_BYTES);
    probe_kernel<<<dim3(grid), dim3(512), SMEM_BYTES, stream>>>(p);
#endif
#else
    for (int ph = 0; ph < N_PHASES; ++ph) { p.ph0 = ph; p.ph1 = ph + 1; mega_kernel<<<dim3(grid), dim3(512), SMEM_BYTES, stream>>>(p); }
#endif
}
#endif
```

```cpp
#ifndef EMU
#include <hip/hip_runtime.h>
#define DEV __device__ __forceinline__
#else
#define DEV static inline __attribute__((always_inline))
#endif
#include <stdint.h>
#include <stddef.h>

#ifndef CFG_D
#define CFG_D 1024
#define CFG_BATCH 16
#define CFG_SEQ 256
#define CFG_DEC_BATCH 2
#define CFG_DEC_SEQ 2048
#define CFG_PAST 256
#define CFG_EH 2816
#endif
constexpr int D = CFG_D, BATCH = CFG_BATCH, SEQ = CFG_SEQ, DEC_BATCH = CFG_DEC_BATCH, DEC_SEQ = CFG_DEC_SEQ, PAST = CFG_PAST, EH = CFG_EH;
constexpr int DEPTH = 2, HD = 64, NAH = 6, MLH = 4, GQH = 6, GQKV = 2, NEXP = 16, GRIDW = 64;
constexpr int NP = BATCH * SEQ, NS = DEC_BATCH * DEC_SEQ, NT = NP + NS, NCOND = 1 + DEC_BATCH;
constexpr int PROJ_W = 2832, MIXW = 1024;
constexpr int CAP_P = SEQ / 8, CAP_S = DEC_SEQ / 8, SLOTS = BATCH * CAP_P + DEC_BATCH * CAP_S;
constexpr int ROWS = DEC_SEQ / GRIDW, KR = ROWS < 8 ? ROWS : 8, KC = 16;
constexpr int NCH_P = SEQ / 64, NCH_S = DEC_SEQ / 64;
constexpr float ALPHA = 1.41421356237309515f;
constexpr float ATT_SCALE = 0.125f;
constexpr float EPS = 1e-6f;
static_assert(SLOTS % 256 == 0 && NP % 256 == 0 && NS % 256 == 0 && SEQ % 256 == 0 && DEC_SEQ % 256 == 0, "tile divisibility");
static_assert(D % 256 == 0 && EH % 128 == 0 && PAST % 64 == 0, "tile divisibility");

typedef unsigned short bf16_t;
typedef short s8v __attribute__((ext_vector_type(8)));
typedef short s4v __attribute__((ext_vector_type(4)));
typedef float f16v __attribute__((ext_vector_type(16)));
typedef float f4v __attribute__((ext_vector_type(4)));
typedef unsigned u4v __attribute__((ext_vector_type(4)));
typedef unsigned u2v __attribute__((ext_vector_type(2)));

enum { I_XP = 0, I_XS, I_C, I_CNAK, I_CNAV, I_CGQK, I_CGQV, I_SC, I_SN, I_SM, I_CCTX, I_ADAW, I_ADAB, I_WIN, I_BGATE, I_WOUT, I_RPB, I_QKG, I_MLG,
       I_LNG, I_LNB, I_RW, I_WG, I_WU, I_WD, N_IN };

constexpr size_t O_YP = 0;
constexpr size_t O_YS = O_YP + (size_t)NP * D;
constexpr size_t O_NAK = O_YS + (size_t)NS * D;
constexpr size_t O_NAV = O_NAK + (size_t)BATCH * DEPTH * SEQ * NAH * HD;
constexpr size_t O_GQK = O_NAV + (size_t)BATCH * DEPTH * SEQ * NAH * HD;
constexpr size_t O_GQV = O_GQK + (size_t)BATCH * DEPTH * SEQ * GQKV * HD;
constexpr size_t O_MC = O_GQV + (size_t)BATCH * DEPTH * SEQ * GQKV * HD;
constexpr size_t O_MN = O_MC + (size_t)BATCH * DEPTH * 2 * MLH * HD * HD;
constexpr size_t O_MM = O_MN + (size_t)BATCH * DEPTH * 2 * MLH * HD;
constexpr size_t O_END = O_MM + (size_t)BATCH * DEPTH * 2 * MLH;

constexpr size_t al256(size_t x) { return (x + 255) & ~(size_t)255; }
constexpr size_t WS_BAR = 0;
constexpr size_t WS_BAR_BYTES = 32768;
constexpr size_t WS_MODS = WS_BAR + WS_BAR_BYTES;
constexpr size_t WS_ROPE = al256(WS_MODS + (size_t)DEPTH * NCOND * 6 * D * 4);
constexpr size_t WS_CNAK = al256(WS_ROPE + 64 * 16 * 2 * 4);
constexpr size_t WS_CNAV = al256(WS_CNAK + (size_t)DEC_BATCH * DEPTH * PAST * NAH * HD * 2);
constexpr size_t WS_CGQK = al256(WS_CNAV + (size_t)DEC_BATCH * DEPTH * PAST * NAH * HD * 2);
constexpr size_t WS_CGQV = al256(WS_CGQK + (size_t)DEC_BATCH * DEPTH * PAST * GQKV * HD * 2);
constexpr size_t WS_XBUF = al256(WS_CGQV + (size_t)DEC_BATCH * DEPTH * PAST * GQKV * HD * 2);
constexpr size_t WS_HMOD = al256(WS_XBUF + (size_t)NT * D * 4);
constexpr size_t WS_GATES = al256(WS_HMOD + (size_t)NT * D * 2);
constexpr size_t WS_NAQ = al256(WS_GATES + (size_t)NT * 16 * 4);
constexpr size_t WS_NAK = al256(WS_NAQ + (size_t)NT * 384 * 2);
constexpr size_t WS_NAV = al256(WS_NAK + (size_t)NT * 384 * 2);
constexpr size_t WS_MLQ = al256(WS_NAV + (size_t)NT * 384 * 2);
constexpr size_t WS_MLK = al256(WS_MLQ + (size_t)NT * 256 * 2);
constexpr size_t WS_MLV = al256(WS_MLK + (size_t)NT * 256 * 2);
constexpr size_t WS_MLO = al256(WS_MLV + (size_t)NT * 256 * 2);
constexpr size_t WS_GQQ = al256(WS_MLO + (size_t)NT * 256 * 2);
constexpr size_t WS_GQK = al256(WS_GQQ + (size_t)NT * 384 * 2);
constexpr size_t WS_GQV = al256(WS_GQK + (size_t)NT * 128 * 2);
constexpr size_t WS_MIXED = al256(WS_GQV + (size_t)NT * 128 * 2);
constexpr size_t WS_U = al256(WS_MIXED + (size_t)NT * MIXW * 2);
constexpr size_t WS_X1 = al256(WS_U + (size_t)NT * D * 4);
constexpr size_t WS_H2 = al256(WS_X1 + (size_t)NT * D * 4);
constexpr size_t WS_AFF = al256(WS_H2 + (size_t)NT * D * 2);
constexpr size_t WS_IDX = al256(WS_AFF + (size_t)NT * 16 * 4);
constexpr size_t WS_GSEL = al256(WS_IDX + (size_t)NEXP * SLOTS * 4);
constexpr size_t WS_TOKSLOT = al256(WS_GSEL + (size_t)NEXP * SLOTS * 4);
constexpr size_t WS_HID = al256(WS_TOKSLOT + (size_t)NT * 16 * 4);
constexpr size_t WS_YE = al256(WS_HID + (size_t)NEXP * SLOTS * EH * 2);
constexpr int ML_NU = 2048, ML_AG = 2112;
constexpr int MLSUM_STRIDE = 2048 + 64 + 64;
constexpr int N_MLSUM = (BATCH * NCH_P + DEC_BATCH * NCH_S) * MLH * 2;
constexpr size_t WS_MLSUM = al256(WS_YE + (size_t)NEXP * SLOTS * D * 2);
constexpr int PART_STRIDE = 256 * 64 + 512;
constexpr int GQ_SPLIT = 3;
constexpr int NA_SPLIT = 2;
constexpr int N_PART_GQ = DEC_BATCH * GQH * (DEC_SEQ / 256) * GQ_SPLIT;
constexpr int N_PART = N_PART_GQ + DEC_BATCH * NAH * (DEC_SEQ / 256) * NA_SPLIT;
constexpr size_t WS_PART = al256(WS_MLSUM + (size_t)N_MLSUM * MLSUM_STRIDE * 4);
constexpr size_t WS_TOTAL = al256(WS_PART + (size_t)N_PART * PART_STRIDE * 4);

struct Params {
    const float* in[N_IN];
    float* out;
    char* ws;
    int ph0, ph1;
};

DEV float bf2f(bf16_t s) { unsigned u = ((unsigned)s) << 16; return __builtin_bit_cast(float, u); }
DEV bf16_t f2bf(float f) {
#ifdef EMU
    unsigned u = __builtin_bit_cast(unsigned, f); u += 0x7fffu + ((u >> 16) & 1u); return (bf16_t)(u >> 16);
#else
    return __builtin_bit_cast(bf16_t, (__bf16)f);
#endif
}
DEV unsigned pack2(float a, float b) {
#ifdef EMU
    return (unsigned)f2bf(a) | ((unsigned)f2bf(b) << 16);
#else
    typedef __bf16 b2 __attribute__((ext_vector_type(2))); b2 r; r[0] = (__bf16)a; r[1] = (__bf16)b; return __builtin_bit_cast(unsigned, r);
#endif
}
DEV float fexp(float x) {
#ifdef EMU
    return expf(x);
#else
    return __expf(x);
#endif
}
DEV float fexp2(float x) {
#ifdef EMU
    return exp2f(x);
#else
    return __builtin_amdgcn_exp2f(x);
#endif
}
DEV float frcp(float x) {
#ifdef EMU
    return 1.f / x;
#else
    return __builtin_amdgcn_rcpf(x);
#endif
}
DEV float sigmoidf_(float x) { return frcp(1.f + fexp(-x)); }
DEV float siluf_(float x) { return x * frcp(1.f + fexp(-x)); }
DEV float flog(float x) {
#ifdef EMU
    return logf(x);
#else
    return __logf(x);
#endif
}
DEV float frsqrt(float x) {
#ifdef EMU
    return 1.f / sqrtf(x);
#else
    return __builtin_amdgcn_rsqf(x);
#endif
}
DEV float logsigmoidf_(float x) { return fminf(x, 0.f) - flog(1.f + fexp(-fabsf(x))); }
DEV f16v mfma32(s8v a, s8v b, f16v c) {
#ifdef EMU
    return emu_mfma_32x32x16_bf16(a, b, c);
#else
    typedef __bf16 bf8 __attribute__((ext_vector_type(8)));
    return __builtin_amdgcn_mfma_f32_32x32x16_bf16(__builtin_bit_cast(bf8, a), __builtin_bit_cast(bf8, b), c, 0, 0, 0);
#endif
}
DEV s4v lds_tr16(const void* p) {
#ifdef EMU
    return emu_ds_read_tr16_b64(p);
#else
    typedef s4v __attribute__((address_space(3))) * lp;
    return __builtin_amdgcn_ds_read_tr16_b64_v4i16((lp)(p));
#endif
}
#ifdef EMU
DEV float wave_sum(float v) { for (int m = 32; m >= 1; m >>= 1) v += __shfl_xor(v, m); return v; }
#else
template <int CTRL, int RM> DEV float dpp_f(float v) { return __builtin_bit_cast(float, __builtin_amdgcn_update_dpp(0, __builtin_bit_cast(int, v), CTRL, RM, 0xF, false)); }
DEV float wave_sum(float v) {
    v += dpp_f<0xB1, 0xF>(v); v += dpp_f<0x4E, 0xF>(v); v += dpp_f<0x141, 0xF>(v); v += dpp_f<0x140, 0xF>(v);
    v += dpp_f<0x142, 0xA>(v); v += dpp_f<0x143, 0xC>(v);
    return __builtin_bit_cast(float, __builtin_amdgcn_readlane(__builtin_bit_cast(int, v), 63));
}
#endif
DEV float wave_max(float v) { for (int m = 32; m >= 1; m >>= 1) v = fmaxf(v, __shfl_xor(v, m)); return v; }
DEV f16v f16zero() { f16v z; for (int i = 0; i < 16; ++i) z[i] = 0.f; return z; }

#ifdef EMU
#define VGPR_PIN(x) do {} while (0)
#define SGPR_PIN(x) do {} while (0)
#define SCHED_FENCE() do {} while (0)
#define CFENCE() do {} while (0)
#else
#define SCHED_FENCE() __builtin_amdgcn_sched_barrier(0)
#define SGPR_PIN(x) asm volatile("" : "+s"(x))
#define VGPR_PIN(x) asm volatile("" : "+v"(x))
#define CFENCE() asm volatile("" ::: "memory")
#endif
#ifdef EMU
DEV int get_tid() { return (int)threadIdx.x; }
#else
DEV int get_tid() { int t = threadIdx.x; asm volatile("" : "+v"(t)); return t; }
#endif
struct UnitIter { int i, end, step; };
DEV UnitIter unit_iter(int NU) {
    const int G = (int)gridDim.x, b = (int)blockIdx.x;
    UnitIter it;
#ifndef XCD_MODE
#define XCD_MODE 0
#endif
    if ((G & 7) == 0 && (NU & 7) == 0) { const int W = G >> 3, x = XCD_MODE ? b / W : b & 7, j = XCD_MODE ? b % W : b >> 3, C = NU >> 3; it.i = x * C + j; it.end = (x + 1) * C; it.step = W; }
    else { it.i = b; it.end = NU; it.step = G; }
    return it;
}
DEV int tok_cond(int t) { return t < NP ? 0 : 1 + (t - NP) / DEC_SEQ; }

#ifndef EMU
#define XB_TMO      128
#define XB_XCNT(j)  (256  + 64 * (j))
#define XB_XSUB(j)  (1280 + 64 * (j))
#define XB_XGEN(j)  (2304 + 64 * (j))
#define XB_TOP      3328
#define XB_TOPGEN   3392
#define XCD_BAR_WORDS 3456
#define XB_SPIN_CAP (1u << 20)
#define LAS __attribute__((address_space(3)))
__device__ __forceinline__ unsigned xb_ld(unsigned* p)              { return __hip_atomic_load(p, __ATOMIC_RELAXED, __HIP_MEMORY_SCOPE_AGENT); }
__device__ __forceinline__ unsigned xb_add(unsigned* p, unsigned v) { return __hip_atomic_fetch_add(p, v, __ATOMIC_RELAXED, __HIP_MEMORY_SCOPE_AGENT); }
__device__ __forceinline__ unsigned xb_xcc_id() { return (unsigned)__builtin_amdgcn_s_getreg((3 << 11) | 20) & 0xFu; }
#define XB_SPIN(cond, bar) do { unsigned _sp = 0; while (cond) { __builtin_amdgcn_s_sleep(1); \
    if ((++_sp & 255u) == 0u) { if (xb_ld(&(bar)[XB_TMO])) break; if (_sp > XB_SPIN_CAP) { atomicAdd(&(bar)[XB_TMO], 1u); break; } } } } while (0)
struct XcdBarrier { unsigned* bar; unsigned x; volatile LAS unsigned* st; };
__device__ __forceinline__ XcdBarrier xcd_barrier_post(unsigned* bar, volatile LAS unsigned* st) {
    XcdBarrier b; b.bar = bar; b.x = xb_xcc_id(); b.st = st;
    if (threadIdx.x == 0) (void)xb_add(&bar[XB_XCNT(b.x)], 1u);
    return b;
}
__device__ __forceinline__ void xcd_barrier_complete(unsigned* bar, unsigned x, unsigned& nloc, unsigned& nx) {
    const unsigned G = gridDim.x * gridDim.y * gridDim.z;
    unsigned sum, cnt, mine, sp = 0u;
    for (;;) {
        sum = 0u; cnt = 0u; mine = 0u;
#pragma unroll
        for (unsigned j = 0; j < 16; ++j) { const unsigned c = xb_ld(&bar[XB_XCNT(j)]); sum += c; cnt += (c > 0u) ? 1u : 0u; mine = (j == x) ? c : mine; }
        if (sum == G) break;
        __builtin_amdgcn_s_sleep(1);
        if ((++sp & 255u) == 0u) { if (xb_ld(&bar[XB_TMO])) break; if (sp > XB_SPIN_CAP) { atomicAdd(&bar[XB_TMO], 1u); break; } }
    }
    nloc = mine > 0u ? mine : 1u; nx = cnt > 0u ? cnt : 1u;
}
template <class Warm>
__device__ __forceinline__ void xcd_barrier(const XcdBarrier& b, Warm&& warm) {
    asm volatile("s_waitcnt vmcnt(0)" ::: "memory");
    __syncthreads();
    if (threadIdx.x >= 64) warm();
    if (threadIdx.x == 0) {
        unsigned* bar = b.bar;
        __builtin_amdgcn_s_waitcnt(0);
        unsigned nloc = b.st[0], nx = b.st[1];
        if (nloc == 0u) { xcd_barrier_complete(bar, b.x, nloc, nx); b.st[0] = nloc; b.st[1] = nx; }
        const unsigned old = xb_add(&bar[XB_XSUB(b.x)], 1u);
        const unsigned gen = old / nloc;
        if (old + 1u == (gen + 1u) * nloc) {
            __builtin_amdgcn_fence(__ATOMIC_RELEASE, "agent");
            asm volatile("s_waitcnt vmcnt(0)" ::: "memory");
            const unsigned og = xb_add(&bar[XB_TOP], 1u);
            const unsigned tg = og / nx;
            if (og + 1u == (tg + 1u) * nx) xb_add(&bar[XB_TOPGEN], 1u);
            else XB_SPIN(xb_ld(&bar[XB_TOPGEN]) == tg, bar);
            __builtin_amdgcn_fence(__ATOMIC_ACQUIRE, "agent");
            xb_add(&bar[XB_XGEN(b.x)], 1u);
            asm volatile("s_waitcnt vmcnt(0)" ::: "memory");
        } else {
            XB_SPIN(xb_ld(&bar[XB_XGEN(b.x)]) == gen, bar);
            __builtin_amdgcn_fence(__ATOMIC_ACQUIRE, "agent");
            asm volatile("s_waitcnt vmcnt(0)" ::: "memory");
        }
    }
    __syncthreads();
}
#endif
constexpr int QUEUE_WORD0 = 4096;

constexpr int LROW = 144;
constexpr int GEMM_AS = 256 * LROW;
constexpr int GEMM_BS = 64 * (256 * 2 + 64);
constexpr int SMEM_XB = 2 * GEMM_AS + 2 * GEMM_BS;
constexpr int SMEM_AUX = SMEM_XB + 64;
constexpr int SMEM_BYTES = SMEM_AUX + 2048;

#ifdef EMU
struct BufRsrc { const char* base; };
DEV BufRsrc make_rsrc(const void* p) { BufRsrc r; r.base = (const char*)p; return r; }
DEV float buf_load_f32(BufRsrc r, unsigned voff, unsigned soff) { return *(const float*)(r.base + voff + soff); }
DEV u4v buf_load_b128(BufRsrc r, unsigned voff, unsigned soff) { return *(const u4v*)(r.base + voff + soff); }
#else
typedef __amdgpu_buffer_rsrc_t BufRsrc;
DEV BufRsrc make_rsrc(const void* p) { return __builtin_amdgcn_make_buffer_rsrc((void*)p, 0, 0x7fffffff, 0x00020000); }
DEV float buf_load_f32(BufRsrc r, unsigned voff, unsigned soff) { return __builtin_bit_cast(float, __builtin_amdgcn_raw_buffer_load_b32(r, voff, soff, 0)); }
DEV u4v buf_load_b128(BufRsrc r, unsigned voff, unsigned soff) { return __builtin_amdgcn_raw_buffer_load_b128(r, voff, soff, 0); }
#endif
template <int ROWB, int NROWS, int NL>
DEV void warm_rows(const float* w, unsigned col_byte0, unsigned ldb, int tw) {
    constexpr int TPR = (ROWB >> 7) + 1, N = NROWS * TPR;
    unsigned v[NL];
#pragma unroll
    for (int j = 0; j < NL; ++j) {
        int L = tw + 448 * j; L = L < N ? L : N - 1;
        const int r = L / TPR, s = L - r * TPR; int bo = s * 128; bo = bo < ROWB ? bo : ROWB - 4;
        v[j] = *(const unsigned*)((const char*)w + (size_t)r * ldb + col_byte0 + bo);
    }
#ifndef EMU
#pragma unroll
    for (int j = 0; j < NL; ++j) asm volatile("" :: "v"(v[j]));
#endif
}
#ifdef EMU
#define WAVE_SYNC() do { (void)__shfl(0, 0); } while (0)
#else
#define WAVE_SYNC() asm volatile("s_waitcnt lgkmcnt(0)" ::: "memory")
#endif
DEV char* wave_stage_ptr(char* smem, int wave) { return smem + (wave < 4 ? GEMM_AS + wave * 9216 : 2 * GEMM_AS + GEMM_BS + (wave - 4) * 9216); }
DEV void stage64_write_bf16(char* stg, int tt, const f16v& v0, const f16v& v1, int l31, int h) {
    char* row = stg + (tt * 32 + l31) * LROW;
#pragma unroll
    for (int ft = 0; ft < 2; ++ft) {
        const f16v& v = ft ? v1 : v0;
#pragma unroll
        for (int g = 0; g < 4; ++g) { u2v pk; pk[0] = pack2(v[4 * g], v[4 * g + 1]); pk[1] = pack2(v[4 * g + 2], v[4 * g + 3]); *(u2v*)(row + (ft * 32 + 8 * g + 4 * h) * 2) = pk; }
    }
}
DEV void stage64_write4(char* stg, int row, int col, float a, float b, float c, float d) {
    u2v pk; pk[0] = pack2(a, b); pk[1] = pack2(c, d); *(u2v*)(stg + row * LROW + col * 2) = pk;
}
DEV void stage64_flush_bf16(const char* stg, bf16_t* dst0, size_t row_stride, int lane) {
    WAVE_SYNC();
#pragma unroll
    for (int i = 0; i < 8; ++i) { const int r = (lane >> 3) + 8 * i, c = lane & 7; const u4v v = *(const u4v*)(stg + r * LROW + c * 16); *(u4v*)(dst0 + (size_t)r * row_stride + c * 8) = v; }
    WAVE_SYNC();
}
template <int NTW, int VAR, class Epi>
DEV void gemm_tile(char* smem, BufRsrc ars, unsigned ao0, unsigned ao1, unsigned ao2, unsigned ao3,
                   BufRsrc brs, unsigned bvo, unsigned blds, unsigned ldb4, int K, Epi&& epi) {
    constexpr int BN = 64 * NTW, NLD = 2 * NTW, KSTEP = 64 / NLD, RSB = BN * 2 + 64;
    const int tid = get_tid(), lane = tid & 63, wave = tid >> 6, wm = wave & 3, wn = wave >> 2, h = lane >> 5, l31 = lane & 31;
    char* As = smem; char* Bs = smem + 2 * GEMM_AS;
    constexpr int BSZ = GEMM_BS;
    const int ar = tid >> 3, ac = tid & 7;
    u4v areg[2]; f4v b0[NLD], b1[NLD];
    if (VAR & 3) { for (int i = 0; i < 2; ++i) areg[i] = (u4v){1u, 2u, 3u, 4u}; for (int j = 0; j < NLD; ++j) { b0[j] = (f4v){1.f, 1.f, 1.f, 1.f}; b1[j] = (f4v){2.f, 2.f, 2.f, 2.f}; } }
    f16v acc[NTW][2];
#pragma unroll
    for (int i = 0; i < NTW; ++i) { acc[i][0] = f16zero(); acc[i][1] = f16zero(); }
    auto gloadA = [&](int k0, bool real, int half) {
        if (VAR & 2) return;
        const unsigned so = real ? k0 * 2 : 0u;
        areg[0] = buf_load_b128(ars, real ? (half ? ao2 : ao0) : 0u, so); areg[1] = buf_load_b128(ars, real ? (half ? ao3 : ao1) : 0u, so);
    };
    auto gloadB = [&](int k0, bool real, f4v (&br)[NLD]) {
        if (VAR & 1) return;
        const unsigned vo = real ? bvo : 0u; const int kk = real ? k0 : 0;
        unsigned so = (unsigned)kk * ldb4;
#pragma unroll
        for (int j = 0; j < NLD; ++j) { br[j] = __builtin_bit_cast(f4v, buf_load_b128(brs, vo, so)); so += KSTEP * ldb4; SGPR_PIN(so); }
    };
    auto gloadB1 = [&](int k0, bool real, f4v (&br)[NLD], int j) {
        if (VAR & 1) return;
        br[j] = __builtin_bit_cast(f4v, buf_load_b128(brs, real ? bvo : 0u, (unsigned)((real ? k0 : 0) + j * KSTEP) * ldb4));
    };
    auto lstoreA = [&](int buf, int half) {
        if (VAR & 16) return;
        char* ab = As + buf * GEMM_AS + (ar + half * 128) * LROW + ac * 16;
        *(u4v*)(ab) = areg[0]; *(u4v*)(ab + 64 * LROW) = areg[1];
    };
    auto lstoreB1 = [&](int buf, const f4v (&br)[NLD], int j) {
        if (VAR & 16) return;
        u2v v; v[0] = pack2(br[j][0], br[j][1]); v[1] = pack2(br[j][2], br[j][3]); *(u2v*)(Bs + buf * BSZ + blds + j * KSTEP * RSB) = v;
    };
    auto lstoreB = [&](int buf, const f4v (&br)[NLD]) {
        if (VAR & 16) return;
        char* bb = Bs + buf * BSZ + blds;
#pragma unroll
        for (int j = 0; j < NLD; ++j) { u2v v; v[0] = pack2(br[j][0], br[j][1]); v[1] = pack2(br[j][2], br[j][3]); *(u2v*)(bb + j * KSTEP * RSB) = v; }
    };
    const unsigned btr = (unsigned)(8 * h + ((lane & 15) >> 2)) * RSB + (unsigned)((((lane >> 4) & 1) * 16 + 4 * (lane & 3)) * 2) + (unsigned)(wn * NTW * 32) * 2;
    const unsigned atr = (unsigned)(wm * 64 + l31) * LROW + h * 16;
    auto rdw = [&](int buf, int s, int ft) -> s8v {
        if (VAR & 64) { s8v z; for (int q = 0; q < 8; ++q) z[q] = (short)(0x3f80 + ft); return z; }
        const char* bb = Bs + buf * BSZ + btr + s * 16 * RSB + ft * 64;
        const s4v lo = lds_tr16(bb), hi = lds_tr16(bb + 4 * RSB);
        s8v wf; wf[0] = lo[0]; wf[1] = lo[1]; wf[2] = lo[2]; wf[3] = lo[3]; wf[4] = hi[0]; wf[5] = hi[1]; wf[6] = hi[2]; wf[7] = hi[3];
        return wf;
    };
    auto compute2 = [&](int buf, int s0, auto&& hook) {
        if (VAR & 8) { for (int g = 0; g < 2 * NTW; ++g) hook(g); return; }
        const char* ab = As + buf * GEMM_AS + atr;
        s8v xa[2];
        if (VAR & 64) { for (int q = 0; q < 8; ++q) { xa[0][q] = 0x3f80; xa[1][q] = 0x3f80; } } else { xa[0] = *(const s8v*)(ab + s0 * 32); xa[1] = *(const s8v*)(ab + 32 * LROW + s0 * 32); }
        s8v wcur = rdw(buf, s0, 0);
#pragma unroll
        for (int g = 0; g < 2 * NTW; ++g) {
            const int ft = g % NTW;
            s8v wnext = wcur;
            if (g + 1 < 2 * NTW) wnext = rdw(buf, s0 + (g + 1) / NTW, (g + 1) % NTW);
            if (VAR & 4) { acc[ft][0][0] += __builtin_bit_cast(float, (int)wcur[0] | ((int)xa[0][1] << 16)); acc[ft][1][0] += __builtin_bit_cast(float, (int)wcur[1] | ((int)xa[1][1] << 16)); }
            else { acc[ft][0] = mfma32(wcur, xa[0], acc[ft][0]); acc[ft][1] = mfma32(wcur, xa[1], acc[ft][1]); }
            if (g == NTW - 1 && !(VAR & 64)) { xa[0] = *(const s8v*)(ab + (s0 + 1) * 32); xa[1] = *(const s8v*)(ab + 32 * LROW + (s0 + 1) * 32); }
            wcur = wnext;
            hook(g);
            SCHED_FENCE();
        }
    };
    auto nohook = [](int) {};
    const int nk = K / 64;
    if (NTW == 2) {
        u4v a0[4], a1[4];
        if (VAR & 3) { for (int i = 0; i < 4; ++i) { a0[i] = (u4v){1u, 2u, 3u, 4u}; a1[i] = (u4v){1u, 2u, 3u, 4u}; } }
        auto gA = [&](int k0, bool real, u4v (&ar4)[4]) {
            if (VAR & 2) return;
            const unsigned so = real ? k0 * 2 : 0u;
            ar4[0] = buf_load_b128(ars, real ? ao0 : 0u, so); ar4[1] = buf_load_b128(ars, real ? ao1 : 0u, so);
            ar4[2] = buf_load_b128(ars, real ? ao2 : 0u, so); ar4[3] = buf_load_b128(ars, real ? ao3 : 0u, so);
        };
        auto sA = [&](int buf, const u4v (&ar4)[4]) {
            if (VAR & 16) return;
            char* ab = As + buf * GEMM_AS + ar * LROW + ac * 16;
#pragma unroll
            for (int i = 0; i < 4; ++i) *(u4v*)(ab + i * 64 * LROW) = ar4[i];
        };
        auto gA1 = [&](int k0, bool real, u4v (&ar4)[4], int i) {
            if (VAR & 2) return;
            const unsigned ao = i == 0 ? ao0 : i == 1 ? ao1 : i == 2 ? ao2 : ao3;
            ar4[i] = buf_load_b128(ars, real ? ao : 0u, real ? k0 * 2 : 0u);
        };
        auto sA1 = [&](int buf, const u4v (&ar4)[4], int i) {
            if (VAR & 16) return;
            *(u4v*)(As + buf * GEMM_AS + (ar + i * 64) * LROW + ac * 16) = ar4[i];
        };
        gA(0, true, a0); gloadB(0, true, b0); gA(64, true, a1); gloadB(64, true, b1);
        sA(0, a0); lstoreB(0, b0);
        __syncthreads();
        for (int kt = 0; kt < nk; kt += 2) {
            const bool t2 = kt + 2 < nk;
            compute2(0, 0, [&](int g) { gA1((kt + 2) * 64, t2, a0, g); lstoreB1(1, b1, g); });
            compute2(0, 2, [&](int g) { gloadB1((kt + 2) * 64, t2, b0, g); sA1(1, a1, g); });
            __syncthreads();
            compute2(1, 0, [&](int g) { gA1((kt + 3) * 64, t2, a1, g); lstoreB1(0, b0, g); });
            compute2(1, 2, [&](int g) { gloadB1((kt + 3) * 64, t2, b1, g); sA1(0, a0, g); });
            __syncthreads();
        }
    } else {
    {
        u4v ah0[2], ah1[2];
        if (VAR & 3) { ah0[0] = ah0[1] = ah1[0] = ah1[1] = (u4v){1u, 2u, 3u, 4u}; }
        auto gAh = [&](u4v (&st)[2], int hsel, int i, int k0, bool real) {
            if (VAR & 2) return;
            const unsigned ao = hsel ? (i ? ao3 : ao2) : (i ? ao1 : ao0);
            st[i] = buf_load_b128(ars, real ? ao : 0u, real ? k0 * 2 : 0u);
        };
        auto sAh = [&](int buf, const u4v (&st)[2], int hsel, int i) {
            if (VAR & 16) return;
            *(u4v*)(As + buf * GEMM_AS + (ar + hsel * 128 + i * 64) * LROW + ac * 16) = st[i];
        };
        gAh(ah0, 0, 0, 0, true); gAh(ah0, 0, 1, 0, true); gAh(ah1, 1, 0, 0, true); gAh(ah1, 1, 1, 0, true);
        gloadB(0, true, b0); gloadB(64, true, b1);
        sAh(0, ah0, 0, 0); sAh(0, ah0, 0, 1); sAh(0, ah1, 1, 0); sAh(0, ah1, 1, 1);
        lstoreB(0, b0);
        gAh(ah0, 0, 0, 64, true); gAh(ah0, 0, 1, 64, true);
        __syncthreads();
        for (int kt = 0; kt < nk; kt += 2) {
            const bool t2 = kt + 2 < nk;
            compute2(0, 0, [&](int g) {
                if (g & 1) gloadB1((kt + 2) * 64, t2, b0, g >> 1); else lstoreB1(1, b1, g >> 1);
                if (g == 1) gAh(ah1, 1, 0, (kt + 1) * 64, true); if (g == 3) gAh(ah1, 1, 1, (kt + 1) * 64, true);
                if (g == 4) sAh(1, ah0, 0, 0); if (g == 6) sAh(1, ah0, 0, 1); });
            compute2(0, 2, [&](int g) {
                if (g & 1) gloadB1((kt + 2) * 64, t2, b0, 4 + (g >> 1)); else lstoreB1(1, b1, 4 + (g >> 1));
                if (g == 1) gAh(ah0, 0, 0, (kt + 2) * 64, t2); if (g == 3) gAh(ah0, 0, 1, (kt + 2) * 64, t2);
                if (g == 4) sAh(1, ah1, 1, 0); if (g == 6) sAh(1, ah1, 1, 1); });
            __syncthreads();
            compute2(1, 0, [&](int g) {
                if (g & 1) gloadB1((kt + 3) * 64, t2, b1, g >> 1); else lstoreB1(0, b0, g >> 1);
                if (g == 1) gAh(ah1, 1, 0, (kt + 2) * 64, t2); if (g == 3) gAh(ah1, 1, 1, (kt + 2) * 64, t2);
                if (g == 4) sAh(0, ah0, 0, 0); if (g == 6) sAh(0, ah0, 0, 1); });
            compute2(1, 2, [&](int g) {
                if (g & 1) gloadB1((kt + 3) * 64, t2, b1, 4 + (g >> 1)); else lstoreB1(0, b0, 4 + (g >> 1));
                if (g == 1) gAh(ah0, 0, 0, (kt + 3) * 64, t2); if (g == 3) gAh(ah0, 0, 1, (kt + 3) * 64, t2);
                if (g == 4) sAh(0, ah1, 1, 0); if (g == 6) sAh(0, ah1, 1, 1); });
            __syncthreads();
        }
    }
    }
    if (VAR & 32) { float t = 0.f; for (int i = 0; i < NTW; ++i) t += acc[i][0][0] + acc[i][1][5]; if (t == 123.456f) *(float*)smem = t; }
    else epi(acc);
}

DEV void phase_ada(const Params& p, char* smem) {
    const int tid = get_tid();
    float* siluS = (float*)smem;
    float* red = (float*)(smem + NCOND * D * 4);
    for (int i = tid; i < NCOND * D; i += 512) {
        const int cnd = i / D, k = i % D;
        const float c = cnd == 0 ? p.in[I_CCTX][k] : p.in[I_C][(cnd - 1) * D + k];
        siluS[i] = c * frcp(1.f + fexp(-c));
    }
    __syncthreads();
    constexpr int CPL = 6 * D / 32, NCHUNK = DEPTH * CPL, KG = D / 16;
    float* mods = (float*)(p.ws + WS_MODS);
    const int col = tid & 31, kg = tid >> 5;
    for (int u = blockIdx.x; u < NCHUNK; u += gridDim.x) {
        const int l = u / CPL, c0 = (u % CPL) * 32;
        const float* W = p.in[I_ADAW] + (size_t)l * D * 6 * D + c0 + col;
        float acc[NCOND];
#pragma unroll
        for (int c = 0; c < NCOND; ++c) acc[c] = 0.f;
#pragma unroll 8
        for (int k = kg * KG; k < kg * KG + KG; ++k) {
            const float w = W[(size_t)k * 6 * D];
#pragma unroll
            for (int c = 0; c < NCOND; ++c) acc[c] += siluS[c * D + k] * w;
        }
#pragma unroll
        for (int c = 0; c < NCOND; ++c) red[(kg * NCOND + c) * 32 + col] = acc[c];
        __syncthreads();
        if (tid < 32 * NCOND) {
            const int c = tid >> 5, cc = tid & 31;
            float s = 0.f;
            for (int g = 0; g < 16; ++g) s += red[(g * NCOND + c) * 32 + cc];
            mods[((size_t)l * NCOND + c) * 6 * D + c0 + cc] = s + p.in[I_ADAB][(size_t)l * 6 * D + c0 + cc];
        }
        __syncthreads();
    }
    const int gtid = blockIdx.x * 512 + tid, gsz = gridDim.x * 512;
    float* rope = (float*)(p.ws + WS_ROPE);
    for (int i = gtid; i < 64 * 16; i += gsz) {
        const int pos = i >> 4, fi = i & 15;
        const float inv = fexp2(-(float)(2 * fi) * (13.287712379549449f / 32.f));
        const float ang = (float)pos * inv;
#ifdef EMU
        rope[2 * i] = cosf(ang); rope[2 * i + 1] = sinf(ang);
#else
        rope[2 * i] = __cosf(ang); rope[2 * i + 1] = __sinf(ang);
#endif
    }
    constexpr int NNA = DEC_BATCH * DEPTH * PAST * NAH * HD, NGQ = DEC_BATCH * DEPTH * PAST * GQKV * HD;
    bf16_t* cnak = (bf16_t*)(p.ws + WS_CNAK); bf16_t* cnav = (bf16_t*)(p.ws + WS_CNAV);
    bf16_t* cgqk = (bf16_t*)(p.ws + WS_CGQK); bf16_t* cgqv = (bf16_t*)(p.ws + WS_CGQV);
    for (int i = gtid; i < NNA; i += gsz) { cnak[i] = f2bf(p.in[I_CNAK][i]); cnav[i] = f2bf(p.in[I_CNAV][i]); }
    for (int i = gtid; i < NGQ; i += gsz) { cgqk[i] = f2bf(p.in[I_CGQK][i]); cgqv[i] = f2bf(p.in[I_CGQV][i]); }
}

constexpr int EPL = D / 64;
constexpr int W16ROW = 20;
template <int MODE>
DEV void phase_rows(const Params& p, char* smem, int l) {
    const int tid = get_tid(), lane = tid & 63, wave = tid >> 6;
    float* W16 = (float*)smem;
    const bool need_w = (MODE == 1) || (l < DEPTH);
    const float* mods = (const float*)(p.ws + WS_MODS);
    auto ld4 = [&](const float* src, float (&a)[EPL]) {
#pragma unroll
        for (int j = 0; j < 4; ++j) { const f4v x = *(const f4v*)(src + 4 * lane + 256 * j); a[4 * j] = x[0]; a[4 * j + 1] = x[1]; a[4 * j + 2] = x[2]; a[4 * j + 3] = x[3]; }
    };
    auto ld4h = [&](const bf16_t* src, float (&a)[EPL]) {
#pragma unroll
        for (int j = 0; j < 4; ++j) { const u2v y = *(const u2v*)(src + 4 * lane + 256 * j);
            a[4 * j] = bf2f((bf16_t)(y[0] & 0xffffu)); a[4 * j + 1] = bf2f((bf16_t)(y[0] >> 16)); a[4 * j + 2] = bf2f((bf16_t)(y[1] & 0xffffu)); a[4 * j + 3] = bf2f((bf16_t)(y[1] >> 16)); }
    };
    auto load_row = [&](int t, float (&vr)[EPL], int& ms) {
        if (MODE == 0 && l == 0) ld4(t < NP ? p.in[I_XP] + (size_t)t * D : p.in[I_XS] + (size_t)(t - NP) * D, vr);
        else ld4h((const bf16_t*)(p.ws + (MODE == 1 ? WS_U : WS_X1)) + (size_t)t * D, vr);
        if (MODE == 0 && l > 0) ms = lane < 16 ? ((const int*)(p.ws + WS_TOKSLOT))[(size_t)t * 16 + lane] : -1;
    };
    const int tstride = gridDim.x * 8;
    float vr[EPL]; int ms = -1;
    {
        const int t0 = blockIdx.x * 8 + wave;
        if (t0 < NT) load_row(t0, vr, ms);
    }
    if (need_w) {
        for (int i = tid; i < D * 4; i += 512) {
            const int k = i >> 2, q = i & 3;
            const float* src = (MODE == 1) ? p.in[I_RW] + ((size_t)l * D + k) * 16 + q * 4 : p.in[I_WIN] + ((size_t)l * D + k) * PROJ_W + 2176 + q * 4;
            *(f4v*)(W16 + (((k >> 8) * 4 + (k & 3)) * 64 + ((k >> 2) & 63)) * W16ROW + q * 4) = *(const f4v*)src;
        }
    }
    constexpr bool HAS_LN = true;
    const bool do_ln = !(MODE == 0 && l == 0);
    float g[EPL], bb[EPL];
    if (do_ln) {
        const int li = (MODE == 0) ? (l - 1) * 2 + 1 : l * 2;
        const float* lg = p.in[I_LNG] + (size_t)li * D; const float* lb = p.in[I_LNB] + (size_t)li * D;
        ld4(lg, g); ld4(lb, bb);
    } else {
#pragma unroll
        for (int j = 0; j < EPL; ++j) { g[j] = 1.f; bb[j] = 0.f; }
    }
    (void)HAS_LN;
    __syncthreads();
    for (int t = blockIdx.x * 8 + wave; t < NT; t += tstride) {
        const int cnd = tok_cond(t);
        float vn[EPL]; int msn = -1;
#pragma unroll
        for (int j = 0; j < EPL; ++j) vn[j] = 0.f;
        if (t + tstride < NT) load_row(t + tstride, vn, msn);
        float gv[EPL], s1[EPL], s0[EPL];
        if (MODE == 0 && l > 0) {
            const float* g2 = mods + ((size_t)(l - 1) * NCOND + cnd) * 6 * D + 5 * D;
            ld4(g2, gv);
        }
        if (MODE == 1 || l < DEPTH) {
            const float* sh = mods + ((size_t)l * NCOND + cnd) * 6 * D + (MODE == 1 ? 3 * D : 0); const float* sc = sh + D;
            ld4(sc, s1); ld4(sh, s0);
        }
        float v[EPL];
        if (MODE == 0 && l > 0) {
            float f[EPL];
#pragma unroll
            for (int j = 0; j < EPL; ++j) f[j] = 0.f;
            const int myslot = ms;
            unsigned vm = (unsigned)__ballot(myslot >= 0);
            while (vm) {
                const int e = __builtin_ctz(vm); vm &= vm - 1u;
                const int slot = __shfl(myslot, e);
                const bf16_t* yr = (const bf16_t*)(p.ws + WS_YE) + ((size_t)e * SLOTS + slot) * D;
#pragma unroll
                for (int j = 0; j < 4; ++j) { const u2v y = *(const u2v*)(yr + 4 * lane + 256 * j);
                    f[4 * j] += bf2f((bf16_t)(y[0] & 0xffffu)); f[4 * j + 1] += bf2f((bf16_t)(y[0] >> 16)); f[4 * j + 2] += bf2f((bf16_t)(y[1] & 0xffffu)); f[4 * j + 3] += bf2f((bf16_t)(y[1] >> 16)); }
            }
#pragma unroll
            for (int j = 0; j < EPL; ++j) v[j] = ALPHA * vr[j] + gv[j] * f[j];
        } else {
#pragma unroll
            for (int j = 0; j < EPL; ++j) v[j] = vr[j];
        }
#pragma unroll
        for (int j = 0; j < EPL; ++j) vr[j] = vn[j];
        ms = msn;
        if (do_ln) {
            float s = 0.f;
#pragma unroll
            for (int j = 0; j < EPL; ++j) s += v[j];
            const float mu = wave_sum(s) * (1.f / D);
            float q = 0.f;
#pragma unroll
            for (int j = 0; j < EPL; ++j) { const float dlt = v[j] - mu; q += dlt * dlt; }
            const float rstd = frsqrt(wave_sum(q) * (1.f / D) + EPS);
#pragma unroll
            for (int j = 0; j < EPL; ++j) v[j] = (v[j] - mu) * rstd * g[j] + bb[j];
            if (MODE == 0 && l == DEPTH) {
                float* dst = t < NP ? p.out + O_YP + (size_t)t * D : p.out + O_YS + (size_t)(t - NP) * D;
#pragma unroll
                for (int j = 0; j < 4; ++j) { f4v x; x[0] = v[4 * j]; x[1] = v[4 * j + 1]; x[2] = v[4 * j + 2]; x[3] = v[4 * j + 3]; *(f4v*)(dst + 4 * lane + 256 * j) = x; }
            } else {
                bf16_t* dst = (bf16_t*)(p.ws + (MODE == 1 ? WS_X1 : WS_XBUF)) + (size_t)t * D;
#pragma unroll
                for (int j = 0; j < 4; ++j) { u2v pk; pk[0] = pack2(v[4 * j], v[4 * j + 1]); pk[1] = pack2(v[4 * j + 2], v[4 * j + 3]); *(u2v*)(dst + 4 * lane + 256 * j) = pk; }
            }
        }
        if (MODE == 1 || l < DEPTH) {
            bf16_t* hb = (bf16_t*)(p.ws + (MODE == 1 ? WS_H2 : WS_HMOD)) + (size_t)t * D;
#pragma unroll
            for (int j = 0; j < EPL; ++j) v[j] = v[j] * (1.f + s1[j]) + s0[j];
#pragma unroll
            for (int j = 0; j < 4; ++j) { u2v pk; pk[0] = pack2(v[4 * j], v[4 * j + 1]); pk[1] = pack2(v[4 * j + 2], v[4 * j + 3]); *(u2v*)(hb + 4 * lane + 256 * j) = pk; }
            CFENCE();
            float a16[16];
#pragma unroll
            for (int e = 0; e < 16; ++e) a16[e] = 0.f;
#pragma unroll
            for (int j = 0; j < EPL; ++j) {
                const float hv = v[j];
                const float* wr = W16 + (lane + 64 * j) * W16ROW;
#pragma unroll
                for (int q = 0; q < 4; ++q) { const f4v w4 = *(const f4v*)(wr + 4 * q); a16[4 * q] += hv * w4[0]; a16[4 * q + 1] += hv * w4[1]; a16[4 * q + 2] += hv * w4[2]; a16[4 * q + 3] += hv * w4[3]; }
                if (j & 1) CFENCE();
            }
            float mine = -1e30f;
#pragma unroll
            for (int e = 0; e < 16; ++e) { const float sm = wave_sum(a16[e]); if (lane == e) mine = sm; }
            if (MODE == 0) {
                if (lane < 16) ((float*)(p.ws + WS_GATES))[(size_t)t * 16 + lane] = mine + p.in[I_BGATE][l * 16 + lane];
            } else {
                float mx = mine;
                for (int m = 8; m >= 1; m >>= 1) mx = fmaxf(mx, __shfl_xor(mx, m));
                const float ex = lane < 16 ? fexp(mine - mx) : 0.f;
                float sm = ex;
                for (int m = 8; m >= 1; m >>= 1) sm += __shfl_xor(sm, m);
                if (lane < 16) ((float*)(p.ws + WS_AFF))[(size_t)t * 16 + lane] = ex / sm;
            }
        }
    }
}

template <int NPL>
DEV void topk_wave(const Params& p, int tb, int cap, int sbase, int e, int lane) {
    const float* aff = (const float*)(p.ws + WS_AFF);
    int* idx = (int*)(p.ws + WS_IDX); float* gsel = (float*)(p.ws + WS_GSEL); int* tokslot = (int*)(p.ws + WS_TOKSLOT);
    unsigned bits[NPL];
#pragma unroll
    for (int i = 0; i < NPL; ++i) bits[i] = __builtin_bit_cast(unsigned, aff[(size_t)(tb + lane + 64 * i) * 16 + e]);
    unsigned T = 0u;
    for (int b = 30; b >= 0; --b) {
        const unsigned cand = T | (1u << b);
        int cnt = 0;
#pragma unroll
        for (int i = 0; i < NPL; ++i) cnt += __popcll(__ballot(bits[i] >= cand));
        if (cnt >= cap) T = cand;
    }
    int ngt = 0;
#pragma unroll
    for (int i = 0; i < NPL; ++i) ngt += __popcll(__ballot(bits[i] > T));
    int need_eq = cap - ngt, run = 0;
    const unsigned long long lt = (1ull << lane) - 1ull;
#pragma unroll
    for (int i = 0; i < NPL; ++i) {
        const bool eq = bits[i] == T;
        const unsigned long long meq = __ballot(eq);
        const int eqrank = __popcll(meq & lt);
        const bool sel = bits[i] > T || (eq && eqrank < need_eq);
        const unsigned long long ms = __ballot(sel);
        const int t = tb + lane + 64 * i;
        if (sel) { const int slot = sbase + run + __popcll(ms & lt); idx[e * SLOTS + slot] = t; gsel[e * SLOTS + slot] = __builtin_bit_cast(float, bits[i]); tokslot[(size_t)t * 16 + e] = slot; }
        else tokslot[(size_t)t * 16 + e] = -1;
        run += __popcll(ms);
        const int neq = __popcll(meq); need_eq -= neq < need_eq ? neq : need_eq;
    }
}
template <int NPW>
DEV void topk_quad(const Params& p, char* smem, bool valid, int tb, int cap, int sbase, int e, int grp, int wq, int lane) {
    const float* aff = (const float*)(p.ws + WS_AFF);
    int* idx = (int*)(p.ws + WS_IDX); float* gsel = (float*)(p.ws + WS_GSEL); int* tokslot = (int*)(p.ws + WS_TOKSLOT);
    int* cntS = (int*)smem + grp * 64;
    const int t0 = tb + wq * (NPW * 64);
    unsigned bits[NPW];
#pragma unroll
    for (int i = 0; i < NPW; ++i) bits[i] = valid ? __builtin_bit_cast(unsigned, aff[(size_t)(t0 + lane + 64 * i) * 16 + e]) : 0u;
    unsigned T = 0u;
    for (int b = 30; b >= 0; --b) {
        const unsigned cand = T | (1u << b);
        int cnt = 0;
#pragma unroll
        for (int i = 0; i < NPW; ++i) cnt += __popcll(__ballot(bits[i] >= cand));
        if (lane == 0) cntS[(b & 1) * 4 + wq] = cnt;
        __syncthreads();
        const int tot = cntS[(b & 1) * 4] + cntS[(b & 1) * 4 + 1] + cntS[(b & 1) * 4 + 2] + cntS[(b & 1) * 4 + 3];
        if (tot >= cap) T = cand;
    }
    int ngt = 0, neqw = 0;
#pragma unroll
    for (int i = 0; i < NPW; ++i) { ngt += __popcll(__ballot(bits[i] > T)); neqw += __popcll(__ballot(bits[i] == T)); }
    if (lane == 0) { cntS[16 + wq] = ngt; cntS[20 + wq] = neqw; }
    __syncthreads();
    int gt_tot = 0;
    for (int w = 0; w < 4; ++w) gt_tot += cntS[16 + w];
    int rem = cap - gt_tot, run = 0, need_eq = 0;
    for (int w = 0; w < 4; ++w) {
        const int take = cntS[20 + w] < rem ? cntS[20 + w] : rem;
        if (w < wq) run += cntS[16 + w] + take;
        if (w == wq) need_eq = take;
        rem -= take;
    }
    if (!valid) return;
    const unsigned long long lt = (1ull << lane) - 1ull;
#pragma unroll
    for (int i = 0; i < NPW; ++i) {
        const bool eq = bits[i] == T;
        const unsigned long long meq = __ballot(eq);
        const int eqrank = __popcll(meq & lt);
        const bool sel = bits[i] > T || (eq && eqrank < need_eq);
        const unsigned long long ms = __ballot(sel);
        const int t = t0 + lane + 64 * i;
        if (sel) { const int slot = sbase + run + __popcll(ms & lt); idx[e * SLOTS + slot] = t; gsel[e * SLOTS + slot] = __builtin_bit_cast(float, bits[i]); tokslot[(size_t)t * 16 + e] = slot; }
        else tokslot[(size_t)t * 16 + e] = -1;
        run += __popcll(ms);
        const int neq = __popcll(meq); need_eq -= neq < need_eq ? neq : need_eq;
    }
}
DEV void phase_topk(const Params& p, char* smem) {
    const int tid = get_tid(), lane = tid & 63, wave = tid >> 6;
    constexpr int US = DEC_BATCH * NEXP, UP = BATCH * NEXP, NSB = (US + 1) / 2;
    static_assert(DEC_SEQ % 256 == 0, "quarter split");
    for (int ub = blockIdx.x; ub < NSB; ub += gridDim.x) {
        const int u = 2 * ub + (wave >> 2);
        const bool valid = u < US;
        const int b = valid ? u / NEXP : 0, e = valid ? u % NEXP : 0;
        topk_quad<DEC_SEQ / 256>(p, smem, valid, NP + b * DEC_SEQ, CAP_S, BATCH * CAP_P + b * CAP_S, e, wave >> 2, wave & 3, lane);
        __syncthreads();
    }
    const int G = (int)gridDim.x, skip = G >= 4 * NSB ? NSB : 0, nb = G - skip;
    if ((int)blockIdx.x >= skip) {
        const int gw = ((int)blockIdx.x - skip) + nb * wave, nw = nb * 8;
        for (int u = gw; u < UP; u += nw) { const int b = u / NEXP, e = u % NEXP; topk_wave<SEQ / 64>(p, b * SEQ, CAP_P, b * CAP_P, e, lane); }
    }
}

DEV void store_head_f32(float* dst_f32, const f16v& v0, const f16v& v1, int h) {
#pragma unroll
    for (int ft = 0; ft < 2; ++ft) {
        const f16v& v = ft ? v1 : v0;
#pragma unroll
        for (int g = 0; g < 4; ++g) { f4v o; o[0] = v[4 * g]; o[1] = v[4 * g + 1]; o[2] = v[4 * g + 2]; o[3] = v[4 * g + 3]; *(f4v*)(dst_f32 + ft * 32 + 8 * g + 4 * h) = o; }
    }
}
DEV void inproj_head(const Params& p, char* stg, const float* rope, int l, int t0, int cb, const f16v& a00, const f16v& a10, const f16v& a01, const f16v& a11, int lane) {
    const int l31 = lane & 31, h = lane >> 5;
    const bool isP = t0 < NP;
    bf16_t* dstb; size_t dstride;
    int f32out = 0, fhead = 0, fheads = 0; size_t fbase = 0;
    int mode = 0;
    if (cb < 1152) {
        const int seg = cb / 384, head = (cb % 384) / 64;
        dstb = (bf16_t*)(p.ws + (seg == 0 ? WS_NAQ : seg == 1 ? WS_NAK : WS_NAV)) + (size_t)t0 * 384 + head * 64; dstride = 384;
        if (seg >= 1 && isP) { f32out = 1; fbase = seg == 1 ? O_NAK : O_NAV; fhead = head; fheads = NAH; }
    } else if (cb < 2176) {
        const int seg = (cb - 1152) / 256, head = ((cb - 1152) % 256) / 64;
        dstb = (bf16_t*)(p.ws + (seg == 0 ? WS_MLQ : seg == 1 ? WS_MLK : seg == 2 ? WS_MLV : WS_MLO)) + (size_t)t0 * 256 + head * 64; dstride = 256;
        mode = seg == 1 ? 1 : 0;
    } else {
        const int c2 = cb - 2192;
        if (c2 < 384) { dstb = (bf16_t*)(p.ws + WS_GQQ) + (size_t)t0 * 384 + (c2 / 64) * 64; dstride = 384; mode = 2; }
        else if (c2 < 512) { const int head = (c2 - 384) / 64; dstb = (bf16_t*)(p.ws + WS_GQK) + (size_t)t0 * 128 + head * 64; dstride = 128; mode = 3;
                             if (isP) { f32out = 1; fbase = O_GQK; fhead = head; fheads = GQKV; } }
        else { const int head = (c2 - 512) / 64; dstb = (bf16_t*)(p.ws + WS_GQV) + (size_t)t0 * 128 + head * 64; dstride = 128;
               if (isP) { f32out = 1; fbase = O_GQV; fhead = head; fheads = GQKV; } }
    }
#pragma unroll
    for (int tt = 0; tt < 2; ++tt) {
        const int t = t0 + tt * 32 + l31;
        f16v v0 = tt ? a01 : a00, v1 = tt ? a11 : a10;
        if (mode == 1) { v0 *= ATT_SCALE; v1 *= ATT_SCALE; }
        if (mode >= 2) {
            float ss = 0.f;
#pragma unroll
            for (int r = 0; r < 16; ++r) ss += v0[r] * v0[r] + v1[r] * v1[r];
            ss += __shfl_xor(ss, 32);
            const float rn = frsqrt(ss * (1.f / 64.f) + EPS);
            const float* gq = p.in[I_QKG] + ((size_t)l * 2 + (mode == 2 ? 0 : 1)) * 64;
#pragma unroll
            for (int r = 0; r < 16; ++r) {
                const int d = (r & 3) + 8 * (r >> 2) + 4 * h;
                v0[r] *= rn * gq[d]; v1[r] *= rn * gq[32 + d];
            }
        }
        if (f32out) { const int bP = t / SEQ, sP = t % SEQ; store_head_f32(p.out + fbase + ((((size_t)bP * DEPTH + l) * SEQ + sP) * fheads + fhead) * 64, v0, v1, h); }
        if (mode >= 2 && !isP) {
            const int pos = (t - NP) % DEC_SEQ, prow = pos / GRIDW, pcol = pos % GRIDW;
#pragma unroll
            for (int rr = 0; rr < 8; ++rr) {
                const int fi = (rr & 3) + 8 * ((rr >> 2) & 1) + 4 * h;
                const float c0 = rope[(prow * 16 + fi) * 2], s0 = rope[(prow * 16 + fi) * 2 + 1];
                const float c1 = rope[(pcol * 16 + fi) * 2], s1 = rope[(pcol * 16 + fi) * 2 + 1];
                const float a_lo = v0[rr], a_hi = v0[rr + 8]; v0[rr] = a_lo * c0 - a_hi * s0; v0[rr + 8] = a_hi * c0 + a_lo * s0;
                const float b_lo = v1[rr], b_hi = v1[rr + 8]; v1[rr] = b_lo * c1 - b_hi * s1; v1[rr + 8] = b_hi * c1 + b_lo * s1;
            }
        }
        stage64_write_bf16(stg, tt, v0, v1, l31, h);
    }
    stage64_flush_bf16(stg, dstb, dstride, lane);
}
template <int VAR>
DEV void phase_inproj(const Params& p, char* smem, int l) {
    constexpr int NJ4 = 11, NMB = NT / 256, RPX = (NMB % 8 == 0) ? NMB / 8 : NMB, TPC = RPX * NJ4;
#ifdef IP_FORCE_FULL
    constexpr int FT = IP_FORCE_FULL;
#else
    constexpr int FT = (NMB % 8 == 0 && TPC > 32) ? 32 : 0;
#endif
    constexpr int UPC = FT + 2 * (TPC - FT), NCHUNK = (NMB % 8 == 0) ? 8 : 1;
    const int tid = get_tid(), lane = tid & 63, wave = tid >> 6, wm = wave & 3, wn = wave >> 2;
    const bf16_t* hmod = (const bf16_t*)(p.ws + WS_HMOD);
    const float* rope = (const float*)(p.ws + WS_ROPE);
    const bool chunked = (gridDim.x & 7) == 0 && NCHUNK == 8;
    const UnitIter it = unit_iter(NCHUNK * UPC);
    for (int uu = it.i; uu < it.end; uu += it.step) {
        const int x = uu / UPC, v = uu % UPC;
        const int tl = v < FT ? v : FT + ((v - FT) >> 1), half = v < FT ? -1 : ((v - FT) & 1);
        const int mb = x * RPX + tl % RPX, j4 = tl / RPX;
        (void)chunked;
        const unsigned ao = ((unsigned)(mb * 256 + (tid >> 3)) * D + (tid & 7) * 8) * 2;
        if (half < 0) {
            const int colbase = 256 * j4;
            const int zc = colbase + 4 * (tid & 63);
            const unsigned bvo = (unsigned)(zc < 2176 ? zc : zc + 16) * 4 + (unsigned)(tid >> 6) * (PROJ_W * 4);
            const unsigned blds = (unsigned)(tid >> 6) * 576u + (unsigned)(tid & 63) * 8u;
            gemm_tile<4, VAR>(smem, make_rsrc(hmod), ao, ao + 128u * D, ao + 256u * D, ao + 384u * D, make_rsrc(p.in[I_WIN] + (size_t)l * D * PROJ_W), bvo, blds, PROJ_W * 4, D, [&](f16v (&acc)[4][2]) {
                int lane_e = lane; VGPR_PIN(lane_e);
                char* stg = wave_stage_ptr(smem, wave);
#pragma unroll
                for (int hh = 0; hh < 2; ++hh) {
                    const int fh = colbase + wn * 128 + hh * 64;
                    inproj_head(p, stg, rope, l, mb * 256 + wm * 64, fh < 2176 ? fh : fh + 16, acc[2 * hh][0], acc[2 * hh + 1][0], acc[2 * hh][1], acc[2 * hh + 1][1], lane_e);
                }
            });
        } else {
            const int j = 2 * j4 + half;
            const int colbase = j < 17 ? 128 * j : 2192 + 128 * (j - 17);
            const unsigned bvo = (unsigned)(colbase + 4 * (tid & 31)) * 4 + (unsigned)(tid >> 5) * (PROJ_W * 4);
            const unsigned blds = (unsigned)(tid >> 5) * 320u + (unsigned)(tid & 31) * 8u;
            gemm_tile<2, VAR>(smem, make_rsrc(hmod), ao, ao + 128u * D, ao + 256u * D, ao + 384u * D, make_rsrc(p.in[I_WIN] + (size_t)l * D * PROJ_W), bvo, blds, PROJ_W * 4, D, [&](f16v (&acc)[2][2]) {
                int lane_e = lane; VGPR_PIN(lane_e);
                inproj_head(p, wave_stage_ptr(smem, wave), rope, l, mb * 256 + wm * 64, colbase + wn * 64, acc[0][0], acc[1][0], acc[0][1], acc[1][1], lane_e);
            });
        }
    }
}

DEV void warm_inproj(const Params& p, int l, int tw) {
    constexpr int NJ4 = 11, NMB = NT / 256, RPX = (NMB % 8 == 0) ? NMB / 8 : NMB, TPC = RPX * NJ4;
#ifdef IP_FORCE_FULL
    constexpr int FT = IP_FORCE_FULL;
#else
    constexpr int FT = (NMB % 8 == 0 && TPC > 32) ? 32 : 0;
#endif
    constexpr int UPC = FT + 2 * (TPC - FT), NCHUNK = (NMB % 8 == 0) ? 8 : 1;
    const UnitIter it = unit_iter(NCHUNK * UPC);
    if (it.i >= it.end) return;
    const int v = it.i % UPC;
    if (v >= FT) return;
    const int j4 = v / RPX;
    warm_rows<1024, 128, 3>(p.in[I_WIN] + (size_t)l * D * PROJ_W, (unsigned)(256 * j4) * 4u, PROJ_W * 4, tw);
}

template <int VAR>
DEV void phase_outproj(const Params& p, char* smem, int l) {
    constexpr int NC = D / 128, NU = (NT / 256) * NC;
    const int tid = get_tid(), lane = tid & 63, wave = tid >> 6, wm = wave & 3, wn = wave >> 2, h = lane >> 5, l31 = lane & 31;
    const bf16_t* mixed = (const bf16_t*)(p.ws + WS_MIXED);
    const float* mods = (const float*)(p.ws + WS_MODS);
    bf16_t* U = (bf16_t*)(p.ws + WS_U);
    constexpr int NMB = NT / 256, RPX = (NMB % 8 == 0) ? NMB / 8 : NMB;
    const UnitIter it = unit_iter(NU);
    for (int u = it.i; u < it.end; u += it.step) {
        const int mb = (u / (RPX * NC)) * RPX + u % RPX, cbk = (u / RPX) % NC;
        const unsigned ao = ((unsigned)(mb * 256 + (tid >> 3)) * MIXW + (tid & 7) * 8) * 2;
        const unsigned bvo = (unsigned)(cbk * 128 + 4 * (tid & 31)) * 4 + (unsigned)(tid >> 5) * (D * 4);
        const unsigned blds = (unsigned)(tid >> 5) * 320u + (unsigned)(tid & 31) * 8u;
        gemm_tile<2, VAR>(smem, make_rsrc(mixed), ao, ao + 128u * MIXW, ao + 256u * MIXW, ao + 384u * MIXW, make_rsrc(p.in[I_WOUT] + (size_t)l * MIXW * D), bvo, blds, D * 4, MIXW, [&](f16v (&acc)[2][2]) {
            int lane_e = lane; VGPR_PIN(lane_e); const int lane = lane_e, l31 = lane_e & 31, h = lane_e >> 5; (void)l31; (void)h;
            char* stg = wave_stage_ptr(smem, wave);
            const int t0 = mb * 256 + wm * 64;
            const float* g1 = mods + ((size_t)l * NCOND + tok_cond(t0)) * 6 * D + 2 * D;
#pragma unroll
            for (int ft = 0; ft < 2; ++ft) {
#pragma unroll
                for (int tt = 0; tt < 2; ++tt)
#pragma unroll
                    for (int g = 0; g < 4; ++g) { f4v o; o[0] = acc[ft][tt][4 * g]; o[1] = acc[ft][tt][4 * g + 1]; o[2] = acc[ft][tt][4 * g + 2]; o[3] = acc[ft][tt][4 * g + 3];
                        *(f4v*)(stg + (tt * 32 + l31) * LROW + (8 * g + 4 * h) * 4) = o; }
                WAVE_SYNC();
                const int f0 = cbk * 128 + wn * 64 + ft * 32 + (lane & 7) * 4;
                const f4v gv = *(const f4v*)(g1 + f0);
#pragma unroll
                for (int i = 0; i < 8; ++i) {
                    const int r = (lane >> 3) + 8 * i, t = t0 + r;
                    const f4v a = *(const f4v*)(stg + r * LROW + (lane & 7) * 16);
                    f4v xv;
                    if (l == 0) xv = *(const f4v*)((t < NP ? p.in[I_XP] + (size_t)t * D : p.in[I_XS] + (size_t)(t - NP) * D) + f0);
                    else { const u2v y = *(const u2v*)((const bf16_t*)(p.ws + WS_XBUF) + (size_t)t * D + f0);
                           xv[0] = bf2f((bf16_t)(y[0] & 0xffffu)); xv[1] = bf2f((bf16_t)(y[0] >> 16)); xv[2] = bf2f((bf16_t)(y[1] & 0xffffu)); xv[3] = bf2f((bf16_t)(y[1] >> 16)); }
                    f4v o;
#pragma unroll
                    for (int q = 0; q < 4; ++q) o[q] = ALPHA * xv[q] + gv[q] * a[q];
                    u2v pk; pk[0] = pack2(o[0], o[1]); pk[1] = pack2(o[2], o[3]);
                    *(u2v*)(U + (size_t)t * D + f0) = pk;
                }
                WAVE_SYNC();
            }
        });
    }
}

DEV void warm_outproj(const Params& p, int l, int tw) {
    constexpr int NC = D / 128, NU = (NT / 256) * NC;
    constexpr int NMB = NT / 256, RPX = (NMB % 8 == 0) ? NMB / 8 : NMB;
    const UnitIter it = unit_iter(NU);
    if (it.i >= it.end) return;
    const int cbk = (it.i / RPX) % NC;
    warm_rows<512, 256, 3>(p.in[I_WOUT] + (size_t)l * MIXW * D, (unsigned)(cbk * 128) * 4u, D * 4, tw);
}

template <int VAR>
DEV void phase_gateup(const Params& p, char* smem, int l) {
    constexpr int NRB = SLOTS / 256, NCB = EH / 128, NU = NEXP * NCB * NRB;
    const int tid = get_tid(), lane = tid & 63, wave = tid >> 6, wm = wave & 3, wn = wave >> 2, h = lane >> 5, l31 = lane & 31;
    const bf16_t* h2 = (const bf16_t*)(p.ws + WS_H2);
    const int* idx = (const int*)(p.ws + WS_IDX);
    bf16_t* hid = (bf16_t*)(p.ws + WS_HID);
    constexpr int TPC = NU / 8;
#ifdef GU_FORCE_HALF
    constexpr int HT = GU_FORCE_HALF;
#else
    constexpr int HT = (NU % 8 == 0 && TPC % 32 == 16) ? 16 : 0;
#endif
    constexpr int UPC = TPC + HT;
    const bool chunked = (gridDim.x & 7) == 0 && (NU & 7) == 0;
    const UnitIter it = unit_iter(chunked ? 8 * UPC : NU);
    for (int uu = it.i; uu < it.end; uu += it.step) {
        int u = uu, half = -1;
        if (chunked) { const int x = uu / UPC, v = uu % UPC; if (v < TPC - HT) u = x * TPC + v; else { const int hv = v - (TPC - HT); u = x * TPC + (TPC - HT) + (hv >> 1); half = hv & 1; } }
        const int rb = u % NRB, cbk = (u / NRB) % NCB, e = u / (NRB * NCB);
        const int* ip = idx + e * SLOTS + rb * 256 + (tid >> 3);
        const unsigned a0 = ((unsigned)ip[0] * D + (tid & 7) * 8) * 2, a1 = ((unsigned)ip[64] * D + (tid & 7) * 8) * 2;
        const unsigned a2 = ((unsigned)ip[128] * D + (tid & 7) * 8) * 2, a3 = ((unsigned)ip[192] * D + (tid & 7) * 8) * 2;
#ifdef EMU
        const int bw = tid >> 6;
#else
        const int bw = __builtin_amdgcn_readfirstlane(tid >> 6);
#endif
        const int is_up = bw & 1;
        const float* wmat = (is_up ? p.in[I_WU] : p.in[I_WG]) + ((size_t)l * NEXP + e) * D * EH;
        if (half < 0) {
        const int bkr = 2 * (bw >> 1) + ((tid >> 5) & 1), hc = 4 * (tid & 31);
        const int ncol = (hc >> 6) * 128 + (2 * ((hc >> 5) & 1) + is_up) * 32 + (hc & 31);
        const unsigned bvo = (unsigned)(cbk * 128 + hc) * 4 + (unsigned)bkr * (EH * 4);
        const unsigned blds = (unsigned)bkr * 576u + (unsigned)ncol * 2u;
        gemm_tile<4, VAR>(smem, make_rsrc(h2), a0, a1, a2, a3, make_rsrc(wmat), bvo, blds, EH * 4, D, [&](f16v (&acc)[4][2]) {
            int lane_e = lane; VGPR_PIN(lane_e); const int lane = lane_e, l31 = lane_e & 31, h = lane_e >> 5; (void)l31; (void)h;
            char* stg = wave_stage_ptr(smem, wave);
#pragma unroll
            for (int tt = 0; tt < 2; ++tt)
#pragma unroll
                for (int pr = 0; pr < 2; ++pr)
#pragma unroll
                    for (int g = 0; g < 4; ++g) {
                        float o[4];
#pragma unroll
                        for (int q = 0; q < 4; ++q) o[q] = siluf_(acc[2 * pr][tt][4 * g + q]) * acc[2 * pr + 1][tt][4 * g + q];
                        stage64_write4(stg, tt * 32 + l31, pr * 32 + 8 * g + 4 * h, o[0], o[1], o[2], o[3]);
                    }
            stage64_flush_bf16(stg, hid + ((size_t)e * SLOTS + rb * 256 + wm * 64) * EH + cbk * 128 + wn * 64, EH, lane);
        });
        } else {
        const int bkr = 4 * (bw >> 1) + ((tid >> 4) & 3), hc = 4 * (tid & 15);
        const int ncol = (hc >> 5) * 64 + is_up * 32 + (hc & 31);
        const unsigned bvo = (unsigned)(cbk * 128 + half * 64 + hc) * 4 + (unsigned)bkr * (EH * 4);
        const unsigned blds = (unsigned)bkr * 320u + (unsigned)ncol * 2u;
        gemm_tile<2, VAR>(smem, make_rsrc(h2), a0, a1, a2, a3, make_rsrc(wmat), bvo, blds, EH * 4, D, [&](f16v (&acc)[2][2]) {
            int lane_e = lane; VGPR_PIN(lane_e); const int lane = lane_e, l31 = lane_e & 31, h = lane_e >> 5; (void)l31; (void)h;
            char* stg = wave_stage_ptr(smem, wave);
#pragma unroll
            for (int tt = 0; tt < 2; ++tt)
#pragma unroll
                for (int g = 0; g < 4; ++g) {
                    float o[4];
#pragma unroll
                    for (int q = 0; q < 4; ++q) o[q] = siluf_(acc[0][tt][4 * g + q]) * acc[1][tt][4 * g + q];
                    stage64_write4(stg, tt * 32 + l31, 8 * g + 4 * h, o[0], o[1], o[2], o[3]);
                }
            WAVE_SYNC();
            bf16_t* dst0 = hid + ((size_t)e * SLOTS + rb * 256 + wm * 64) * EH + cbk * 128 + half * 64 + wn * 32;
#pragma unroll
            for (int i = 0; i < 4; ++i) { const int r = (lane >> 2) + 16 * i, c = lane & 3; const u4v v = *(const u4v*)(stg + r * LROW + c * 16); *(u4v*)(dst0 + (size_t)r * EH + c * 8) = v; }
            WAVE_SYNC();
        });
        }
    }
}

DEV void warm_gateup(const Params& p, int l, int tw) {
    constexpr int NRB = SLOTS / 256, NCB = EH / 128, NU = NEXP * NCB * NRB;
    constexpr int TPC = NU / 8;
#ifdef GU_FORCE_HALF
    constexpr int HT = GU_FORCE_HALF;
#else
    constexpr int HT = (NU % 8 == 0 && TPC % 32 == 16) ? 16 : 0;
#endif
    constexpr int UPC = TPC + HT;
    const bool chunked = (gridDim.x & 7) == 0 && (NU & 7) == 0;
    const UnitIter it = unit_iter(chunked ? 8 * UPC : NU);
    if (it.i >= it.end) return;
    int u = it.i;
    if (chunked) { const int x = it.i / UPC, v = it.i % UPC; if (v >= TPC - HT) return; u = x * TPC + v; }
    const int cbk = (u / NRB) % NCB, e = u / (NRB * NCB);
    const size_t mo = ((size_t)l * NEXP + e) * D * EH;
    warm_rows<512, 128, 2>(p.in[I_WG] + mo, (unsigned)(cbk * 128) * 4u, EH * 4, tw);
    warm_rows<512, 128, 2>(p.in[I_WU] + mo, (unsigned)(cbk * 128) * 4u, EH * 4, tw);
}

template <int VAR>
DEV void phase_down(const Params& p, char* smem, int l) {
    constexpr int NRB = SLOTS / 256, NCB = D / 256, NU = NEXP * NCB * NRB;
    const int tid = get_tid(), lane = tid & 63, wave = tid >> 6, wm = wave & 3, wn = wave >> 2, h = lane >> 5, l31 = lane & 31;
    const bf16_t* hid = (const bf16_t*)(p.ws + WS_HID);
    const float* gsel = (const float*)(p.ws + WS_GSEL);
    bf16_t* ye = (bf16_t*)(p.ws + WS_YE);
    const UnitIter it = unit_iter(NU);
    for (int u = it.i; u < it.end; u += it.step) {
        const int rb = u % NRB, cbk = (u / NRB) % NCB, e = u / (NRB * NCB);
        const unsigned ao = ((unsigned)(rb * 256 + (tid >> 3)) * EH + (tid & 7) * 8) * 2;
        const unsigned bvo = (unsigned)(cbk * 256 + 4 * (tid & 63)) * 4 + (unsigned)(tid >> 6) * (D * 4);
        const unsigned blds = (unsigned)(tid >> 6) * 576u + (unsigned)(tid & 63) * 8u;
        gemm_tile<4, VAR>(smem, make_rsrc(hid + (size_t)e * SLOTS * EH), ao, ao + 128u * EH, ao + 256u * EH, ao + 384u * EH, make_rsrc(p.in[I_WD] + ((size_t)l * NEXP + e) * EH * D), bvo, blds, D * 4, EH, [&](f16v (&acc)[4][2]) {
            int lane_e = lane; VGPR_PIN(lane_e); const int lane = lane_e, l31 = lane_e & 31, h = lane_e >> 5; (void)l31; (void)h;
            char* stg = wave_stage_ptr(smem, wave);
            const float gs0 = gsel[e * SLOTS + rb * 256 + wm * 64 + l31], gs1 = gsel[e * SLOTS + rb * 256 + wm * 64 + 32 + l31];
#pragma unroll
            for (int hb = 0; hb < 2; ++hb) {
#pragma unroll
                for (int tt = 0; tt < 2; ++tt) {
                    const float gs = tt ? gs1 : gs0;
#pragma unroll
                    for (int f2 = 0; f2 < 2; ++f2)
#pragma unroll
                        for (int g = 0; g < 4; ++g) { const f16v& a = acc[2 * hb + f2][tt]; stage64_write4(stg, tt * 32 + l31, f2 * 32 + 8 * g + 4 * h, a[4 * g] * gs, a[4 * g + 1] * gs, a[4 * g + 2] * gs, a[4 * g + 3] * gs); }
                }
                stage64_flush_bf16(stg, ye + ((size_t)e * SLOTS + rb * 256 + wm * 64) * D + cbk * 256 + wn * 128 + hb * 64, D, lane);
            }
        });
    }
}
DEV void warm_down(const Params& p, int l, int tw) {
    constexpr int NRB = SLOTS / 256, NCB = D / 256, NU = NEXP * NCB * NRB;
    const UnitIter it = unit_iter(NU);
    if (it.i >= it.end) return;
    const int u = it.i, cbk = (u / NRB) % NCB, e = u / (NRB * NCB);
    warm_rows<1024, 128, 3>(p.in[I_WD] + ((size_t)l * NEXP + e) * EH * D, (unsigned)(cbk * 256) * 4u, D * 4, tw);
}

struct AttnDesc {
    const bf16_t* q; int qstride;
    int ntiles, n0;
    const bf16_t *k0, *v0; int stride0;
    const bf16_t *k1, *v1; int stride1;
    int na;
    int r0, rlo;
    const float* rpb;
    bf16_t* out; int ostride;
    float* part;
};
constexpr int ATT_TILE = 64 * LROW;
DEV int na_row_start(int r) { int s = r - KR / 2; s = s < 0 ? 0 : s; return s > ROWS - KR ? ROWS - KR : s; }
DEV void attn_unit(char* smem, const AttnDesc& d) {
    const int tid = get_tid(), lane = tid & 63, wave = tid >> 6, h = lane >> 5, l31 = lane & 31;
    char* Ks = smem; char* Vs = smem + 4 * ATT_TILE; float* rpbS = (float*)(smem + 8 * ATT_TILE);
    if (d.na) { for (int i = tid; i < 15 * 31; i += 512) rpbS[i] = d.rpb[i] * 1.4426950408889634f; }
    const bf16_t* qp = d.q + (size_t)(wave * 32 + l31) * d.qstride + h * 8;
    s8v qf[4];
#pragma unroll
    for (int s = 0; s < 4; ++s) qf[s] = *(const s8v*)(qp + 16 * s);
    float m_run = -1e30f, l_run = 0.f;
    f16v o[2]; o[0] = f16zero(); o[1] = f16zero();
    const int srow = tid >> 3, sch = tid & 7;
    u4v kreg[2], vreg[2];
    auto gload = [&](int st) {
#pragma unroll
        for (int u = 0; u < 2; ++u) {
            int t = 2 * st + u; t = t < d.ntiles ? t : d.ntiles - 1;
            const bf16_t *kp, *vp;
            if (t < d.n0) { const size_t off = (size_t)(t * 64 + srow) * d.stride0 + sch * 8; kp = d.k0 + off; vp = d.v0 + off; }
            else { const size_t off = (size_t)((t - d.n0) * 64 + srow) * d.stride1 + sch * 8; kp = d.k1 + off; vp = d.v1 + off; }
            kreg[u] = *(const u4v*)kp; vreg[u] = *(const u4v*)vp;
        }
    };
    auto lstore = [&](int buf) {
#pragma unroll
        for (int u = 0; u < 2; ++u) { *(u4v*)(Ks + (buf * 2 + u) * ATT_TILE + srow * LROW + sch * 16) = kreg[u]; *(u4v*)(Vs + (buf * 2 + u) * ATT_TILE + srow * LROW + sch * 16) = vreg[u]; }
    };
    const int qr = d.r0 + (wave >> 1), qw = (wave & 1) * 32 + l31;
    const int rs = na_row_start(qr);
    int cs = qw - KC / 2; cs = cs < 0 ? 0 : (cs > GRIDW - KC ? GRIDW - KC : cs);
    constexpr float C2 = ATT_SCALE * 1.4426950408889634f;
    const unsigned vlane = (unsigned)(4 * h + ((lane & 15) >> 2)) * LROW + (unsigned)((((lane >> 4) & 1) * 16 + 4 * (lane & 3)) * 2);
    auto tile_body = [&](int slot, int t) {
        const bool local = d.na && t >= d.n0;
        const int kr = d.rlo + (t - d.n0);
        const bool active = !local || (kr >= rs && kr < rs + KR);
        if (!active) return;
        const char* kb = Ks + slot * ATT_TILE + l31 * LROW + h * 16;
        f16v sa[2];
#pragma unroll
        for (int kt = 0; kt < 2; ++kt) {
            sa[kt] = f16zero();
#pragma unroll
            for (int s = 0; s < 4; ++s) { const s8v kf = *(const s8v*)(kb + kt * 32 * LROW + s * 32); sa[kt] = mfma32(kf, qf[s], sa[kt]); }
        }
        float mx = -1e30f;
        if (local) {
#pragma unroll
            for (int kt = 0; kt < 2; ++kt)
#pragma unroll
                for (int r = 0; r < 16; ++r) {
                    const int kc = kt * 32 + (r & 3) + 8 * (r >> 2) + 4 * h;
                    const bool inw = kc >= cs && kc < cs + KC;
                    const int bi = (kr - qr + 7) * 31 + (kc - qw + 15);
                    const float v = inw ? sa[kt][r] * C2 + rpbS[inw ? bi : 0] : -1e30f;
                    sa[kt][r] = v; mx = fmaxf(mx, v);
                }
        } else {
#pragma unroll
            for (int kt = 0; kt < 2; ++kt)
#pragma unroll
                for (int r = 0; r < 16; ++r) mx = fmaxf(mx, sa[kt][r]);
            mx *= C2;
        }
        mx = fmaxf(mx, __shfl_xor(mx, 32));
        if (__ballot(mx > m_run) != 0ull) {
            const float m_new = fmaxf(m_run, mx);
            const float alpha = fexp2(m_run - m_new);
            l_run *= alpha; m_run = m_new;
            o[0] *= alpha; o[1] *= alpha;
        }
        float ps = 0.f;
        if (local) {
#pragma unroll
            for (int kt = 0; kt < 2; ++kt)
#pragma unroll
                for (int r = 0; r < 16; ++r) { const float pv = fexp2(sa[kt][r] - m_run); sa[kt][r] = pv; ps += pv; }
        } else {
#pragma unroll
            for (int kt = 0; kt < 2; ++kt)
#pragma unroll
                for (int r = 0; r < 16; ++r) { const float pv = fexp2(sa[kt][r] * C2 - m_run); sa[kt][r] = pv; ps += pv; }
        }
        l_run += ps;
        const char* vb = Vs + slot * ATT_TILE + vlane;
#pragma unroll
        for (int ks = 0; ks < 4; ++ks) {
            const int kt = ks >> 1, rb = 8 * (ks & 1);
            u4v pk; pk[0] = pack2(sa[kt][rb], sa[kt][rb + 1]); pk[1] = pack2(sa[kt][rb + 2], sa[kt][rb + 3]);
            pk[2] = pack2(sa[kt][rb + 4], sa[kt][rb + 5]); pk[3] = pack2(sa[kt][rb + 6], sa[kt][rb + 7]);
            const s8v pf = __builtin_bit_cast(s8v, pk);
            const char* vk = vb + (kt * 32 + 16 * (ks & 1)) * LROW;
#pragma unroll
            for (int dt = 0; dt < 2; ++dt) {
                const s4v lo = lds_tr16(vk + dt * 64), hi = lds_tr16(vk + 8 * LROW + dt * 64);
                s8v vf; vf[0] = lo[0]; vf[1] = lo[1]; vf[2] = lo[2]; vf[3] = lo[3]; vf[4] = hi[0]; vf[5] = hi[1]; vf[6] = hi[2]; vf[7] = hi[3];
                o[dt] = mfma32(vf, pf, o[dt]);
            }
        }
    };
    const int nst = (d.ntiles + 1) >> 1;
    gload(0); lstore(0);
    __syncthreads();
    for (int st = 0; st < nst; ++st) {
        const int buf = st & 1;
        if (st + 1 < nst) gload(st + 1);
        if (!d.na && 2 * st + 1 < d.ntiles) {
            const char* kb = Ks + (buf * 2) * ATT_TILE + l31 * LROW + h * 16;
            f16v sa[4];
#pragma unroll
            for (int i = 0; i < 4; ++i) {
                sa[i] = f16zero();
#pragma unroll
                for (int s = 0; s < 4; ++s) { const s8v kf = *(const s8v*)(kb + (i >> 1) * ATT_TILE + (i & 1) * 32 * LROW + s * 32); sa[i] = mfma32(kf, qf[s], sa[i]); }
            }
            float mx = -1e30f;
#pragma unroll
            for (int i = 0; i < 4; ++i)
#pragma unroll
                for (int r = 0; r < 16; ++r) mx = fmaxf(mx, sa[i][r]);
            mx *= C2;
            mx = fmaxf(mx, __shfl_xor(mx, 32));
            if (__ballot(mx > m_run) != 0ull) {
                const float m_new = fmaxf(m_run, mx);
                const float alpha = fexp2(m_run - m_new);
                l_run *= alpha; m_run = m_new;
                o[0] *= alpha; o[1] *= alpha;
            }
            float ps = 0.f;
            const char* vb = Vs + (buf * 2) * ATT_TILE + vlane;
#pragma unroll
            for (int i = 0; i < 4; ++i) {
#pragma unroll
                for (int r = 0; r < 16; ++r) { const float pv = fexp2(sa[i][r] * C2 - m_run); sa[i][r] = pv; ps += pv; }
#pragma unroll
                for (int hf = 0; hf < 2; ++hf) {
                    const int rb = 8 * hf;
                    u4v pk; pk[0] = pack2(sa[i][rb], sa[i][rb + 1]); pk[1] = pack2(sa[i][rb + 2], sa[i][rb + 3]);
                    pk[2] = pack2(sa[i][rb + 4], sa[i][rb + 5]); pk[3] = pack2(sa[i][rb + 6], sa[i][rb + 7]);
                    const s8v pf = __builtin_bit_cast(s8v, pk);
                    const char* vk = vb + (i >> 1) * ATT_TILE + ((i & 1) * 32 + 16 * hf) * LROW;
#pragma unroll
                    for (int dt = 0; dt < 2; ++dt) {
                        const s4v lo = lds_tr16(vk + dt * 64), hi = lds_tr16(vk + 8 * LROW + dt * 64);
                        s8v vf; vf[0] = lo[0]; vf[1] = lo[1]; vf[2] = lo[2]; vf[3] = lo[3]; vf[4] = hi[0]; vf[5] = hi[1]; vf[6] = hi[2]; vf[7] = hi[3];
                        o[dt] = mfma32(vf, pf, o[dt]);
                    }
                }
            }
            l_run += ps;
        } else {
            tile_body(buf * 2, 2 * st);
            if (2 * st + 1 < d.ntiles) tile_body(buf * 2 + 1, 2 * st + 1);
        }
        if (st + 1 < nst) lstore(buf ^ 1);
        __syncthreads();
    }
    const float l_tot = l_run + __shfl_xor(l_run, 32);
    const int qrow = wave * 32 + l31;
    if (d.part) {
        float* po = d.part + (size_t)qrow * 64;
#pragma unroll
        for (int dt = 0; dt < 2; ++dt)
#pragma unroll
            for (int g = 0; g < 4; ++g) { f4v v; v[0] = o[dt][4 * g]; v[1] = o[dt][4 * g + 1]; v[2] = o[dt][4 * g + 2]; v[3] = o[dt][4 * g + 3]; *(f4v*)(po + dt * 32 + 8 * g + 4 * h) = v; }
        if (h == 0) { d.part[256 * 64 + qrow] = m_run; d.part[256 * 64 + 256 + qrow] = l_tot; }
    } else {
        const float inv = 1.f / l_tot;
        bf16_t* po = d.out + (size_t)qrow * d.ostride;
#pragma unroll
        for (int dt = 0; dt < 2; ++dt)
#pragma unroll
            for (int g = 0; g < 4; ++g) {
                u2v pk; pk[0] = pack2(o[dt][4 * g] * inv, o[dt][4 * g + 1] * inv); pk[1] = pack2(o[dt][4 * g + 2] * inv, o[dt][4 * g + 3] * inv);
                *(u2v*)(po + dt * 32 + 8 * g + 4 * h) = pk;
            }
    }
}

DEV int ml_sidx(int grp, int b, int head, int c) { return grp == 0 ? ((b * MLH + head) * NCH_P + c) : BATCH * MLH * NCH_P + ((b * MLH + head) * NCH_S + c); }
DEV float lane_prefix_sum(float v, int lane) { for (int dlt = 1; dlt < 64; dlt <<= 1) { const float o = __shfl(v, lane - dlt); if (lane >= dlt) v += o; } return v; }
DEV float lane_prefix_max(float v, int lane) { for (int dlt = 1; dlt < 64; dlt <<= 1) { const float o = __shfl(v, lane - dlt); if (lane >= dlt) v = fmaxf(v, o); } return v; }

constexpr int MLG = 4;
static_assert(NCH_P % MLG == 0 && NCH_S % MLG == 0, "chunk groups");
DEV void mlstm_summary_unit(const Params& p, char* smem, int grp, int b, int head, int c0) {
    const int tid = get_tid(), lane = tid & 63, wave = tid >> 6, h = lane >> 5, l31 = lane & 31;
    float* wsS = (float*)(smem + 3 * MLG * ATT_TILE);
    float* scal = wsS + MLG * 128;
    const int tb0 = (grp == 0 ? b * SEQ : NP + b * DEC_SEQ) + c0 * 64;
    const float* gates = (const float*)(p.ws + WS_GATES);
    const int tau = tid >> 3, ch = tid & 7;
    u4v kv[MLG], vv[MLG];
#pragma unroll
    for (int cc = 0; cc < MLG; ++cc) {
        const size_t off = (size_t)(tb0 + cc * 64 + tau) * 256 + head * 64 + ch * 8;
        kv[cc] = *(const u4v*)((const bf16_t*)(p.ws + WS_MLK) + off); vv[cc] = *(const u4v*)((const bf16_t*)(p.ws + WS_MLV) + off);
    }
    if (wave < MLG) {
        const int cc = wave;
        const float* gr = gates + (size_t)(tb0 + cc * 64 + lane) * 16;
        const float i_f = gr[head], lf_f = logsigmoidf_(gr[4 + head]), i_b = gr[8 + head], lf_b = logsigmoidf_(gr[12 + head]);
        const float pf = lane_prefix_sum(lf_f, lane), pb = lane_prefix_sum(lf_b, lane);
        const float tot_f = __shfl(pf, 63), tot_b = __shfl(pb, 63);
        const float g_f = (tot_f - pf) + i_f, g_b = (pb - lf_b) + i_b;
        const float G_f = wave_max(g_f), G_b = wave_max(g_b);
        wsS[(cc * 2) * 64 + lane] = fexp(g_f - G_f); wsS[(cc * 2 + 1) * 64 + lane] = fexp(g_b - G_b);
        if (lane == 0) { scal[cc * 4] = tot_f; scal[cc * 4 + 1] = tot_b; scal[cc * 4 + 2] = G_f; scal[cc * 4 + 3] = G_b; }
    }
    __syncthreads();
#pragma unroll
    for (int cc = 0; cc < MLG; ++cc) {
        const float wf = wsS[(cc * 2) * 64 + tau], wb = wsS[(cc * 2 + 1) * 64 + tau];
        float kf[8];
#pragma unroll
        for (int j = 0; j < 8; ++j) kf[j] = bf2f((bf16_t)(kv[cc][j >> 1] >> (16 * (j & 1))));
        u4v a, bq;
#pragma unroll
        for (int j = 0; j < 4; ++j) { a[j] = pack2(kf[2 * j] * wf, kf[2 * j + 1] * wf); bq[j] = pack2(kf[2 * j] * wb, kf[2 * j + 1] * wb); }
        char* base = smem + (3 * cc) * ATT_TILE + tau * LROW + ch * 16;
        *(u4v*)(base) = a; *(u4v*)(base + ATT_TILE) = bq; *(u4v*)(base + 2 * ATT_TILE) = vv[cc];
    }
    __syncthreads();
    float* sum = (float*)(p.ws + WS_MLSUM);
    const int dir = wave >> 2, mi = (wave >> 1) & 1, ni = wave & 1;
    const unsigned vlane = (unsigned)(4 * h + ((lane & 15) >> 2)) * LROW + (unsigned)((((lane >> 4) & 1) * 16 + 4 * (lane & 3)) * 2);
    auto trfrag = [&](const char* tile, int s4, int blk) -> s8v {
        const char* vk = tile + vlane + (16 * s4) * LROW + blk * 64;
        const s4v lo = lds_tr16(vk), hi = lds_tr16(vk + 8 * LROW);
        s8v f; f[0] = lo[0]; f[1] = lo[1]; f[2] = lo[2]; f[3] = lo[3]; f[4] = hi[0]; f[5] = hi[1]; f[6] = hi[2]; f[7] = hi[3];
        return f;
    };
    s8v ones;
#pragma unroll
    for (int q = 0; q < 8; ++q) ones[q] = (short)0x3f80;
#pragma unroll
    for (int cc = 0; cc < MLG; ++cc) {
        const char* kt = smem + (3 * cc + dir) * ATT_TILE; const char* vt = smem + (3 * cc + 2) * ATT_TILE;
        f16v acc = f16zero(), acc1 = f16zero();
#pragma unroll
        for (int s4 = 0; s4 < 4; ++s4) {
            const s8v af = trfrag(kt, s4, mi), bf = trfrag(vt, s4, ni);
            acc = mfma32(af, bf, acc);
            if (ni == 0) acc1 = mfma32(af, ones, acc1);
        }
        const int sidx = ml_sidx(grp, b, head, c0 + cc);
        float* E = sum + (size_t)(sidx * 2 + dir) * MLSUM_STRIDE;
        bf16_t* U = (bf16_t*)E;
#pragma unroll
        for (int r = 0; r < 16; ++r) U[(mi * 32 + (r & 3) + 8 * (r >> 2) + 4 * h) * 64 + ni * 32 + l31] = f2bf(acc[r]);
        if (ni == 0 && l31 == 0) {
#pragma unroll
            for (int r = 0; r < 16; ++r) E[ML_NU + mi * 32 + (r & 3) + 8 * (r >> 2) + 4 * h] = acc1[r];
        }
        if (tid < 2) { float* E2 = sum + (size_t)(sidx * 2 + tid) * MLSUM_STRIDE; E2[ML_AG] = scal[cc * 4 + tid]; E2[ML_AG + 1] = scal[cc * 4 + 2 + tid]; }
    }
    __syncthreads();
}

DEV void mlstm_output_unit(const Params& p, char* smem, int l, int grp, int b, int head, int c) {
    const int tid = get_tid(), lane = tid & 63, wave = tid >> 6, h = lane >> 5, l31 = lane & 31;
    const int nc = grp ? NCH_S : NCH_P;
    char* Qs = smem;
    char* Ks = smem + 2 * ATT_TILE;
    char* VT = smem + 4 * ATT_TILE;
    char* CT = smem + 6 * ATT_TILE;
    char* QK = smem + 8 * ATT_TILE;
    float* hS = (float*)(smem + 10 * ATT_TILE);
    float* vec = hS + 2 * 64 * 68;
    float* aS = vec; float* MjS = vec + 128; float* bS = vec + 256; float* nS = vec + 384; float* denp = vec + 512; float* qnS = vec + 768; float* scal = vec + 896;
    const int tb = (grp == 0 ? b * SEQ : NP + b * DEC_SEQ) + c * 64;
    const float* sum = (const float*)(p.ws + WS_MLSUM);
    const size_t qoff = (size_t)(tb + (tid >> 3)) * 256 + head * 64 + (tid & 7) * 8;
    const u4v q_r = *(const u4v*)((const bf16_t*)(p.ws + WS_MLQ) + qoff);
    const u4v k_r = *(const u4v*)((const bf16_t*)(p.ws + WS_MLK) + qoff);
    const u4v v_r = *(const u4v*)((const bf16_t*)(p.ws + WS_MLV) + qoff);
    const u4v o_r = *(const u4v*)((const bf16_t*)(p.ws + WS_MLO) + qoff);
    float g_i = 0.f, g_f = 0.f;
    if (wave < 2) { const float* gr = (const float*)(p.ws + WS_GATES) + (size_t)(tb + (wave ? 63 - lane : lane)) * 16; g_i = gr[wave * 8 + head]; g_f = gr[wave * 8 + 4 + head]; }
#pragma unroll
    for (int dir = 0; dir < 2; ++dir) {
        float C[8], nst = 0.f, m;
        if (grp == 0) {
#pragma unroll
            for (int i = 0; i < 8; ++i) C[i] = 0.f;
            m = 0.f;
        } else {
            const size_t sb = (((size_t)b * DEPTH + l) * 2 + dir) * MLH + head;
#pragma unroll
            for (int i = 0; i < 8; ++i) C[i] = p.in[I_SC][sb * 4096 + 8 * tid + i];
            if (tid < 64) nst = p.in[I_SN][sb * 64 + tid];
            m = p.in[I_SM][sb];
        }
        const int nsteps = dir == 0 ? c : nc - 1 - c;
        const bool fin = (grp == 0) && (dir == 0 ? c == nc - 1 : c == 0);
        {
            float A = 0.f, G = -1e30f;
            if (lane < nsteps) { const float* E = sum + (size_t)(ml_sidx(grp, b, head, dir == 0 ? lane : nc - 1 - lane) * 2 + dir) * MLSUM_STRIDE; A = E[ML_AG]; G = E[ML_AG + 1]; }
            const float P = lane_prefix_sum(A, lane);
            const float T = __shfl(P, 63);
            const float ev = lane < nsteps ? G + (T - P) : -1e30f;
            const float mc = fmaxf(m + T, wave_max(ev));
            const float coef = lane < nsteps ? fexp(ev - mc) : 0.f;
            const float coef0 = fexp(m + T - mc);
#pragma unroll
            for (int i = 0; i < 8; ++i) C[i] *= coef0;
            nst *= coef0;
            for (int st0 = 0; st0 < nsteps; st0 += 8) {
                u4v uu[8]; float nn[8], cf[8];
#pragma unroll
                for (int j = 0; j < 8; ++j) {
                    const int st = st0 + j, stc = st < nsteps ? st : nsteps - 1;
                    const float* E = sum + (size_t)(ml_sidx(grp, b, head, dir == 0 ? stc : nc - 1 - stc) * 2 + dir) * MLSUM_STRIDE;
                    uu[j] = *(const u4v*)((const bf16_t*)E + 8 * tid);
                    nn[j] = tid < 64 ? E[ML_NU + tid] : 0.f;
                    const float cj = __shfl(coef, stc);
                    cf[j] = st < nsteps ? cj : 0.f;
                }
#pragma unroll
                for (int j = 0; j < 8; ++j) {
#pragma unroll
                    for (int i = 0; i < 8; ++i) C[i] += cf[j] * bf2f((bf16_t)(uu[j][i >> 1] >> (16 * (i & 1))));
                    nst += cf[j] * nn[j];
                }
            }
            m = mc;
        }
#pragma unroll
        for (int i = 0; i < 8; ++i) { const int e = 8 * tid + i; *(bf16_t*)(CT + dir * ATT_TILE + (e & 63) * LROW + (e >> 6) * 2) = f2bf(C[i]); }
        if (tid < 64) nS[dir * 64 + tid] = nst;
        if (tid == 0) scal[dir] = m;
        if (fin) {
            const float* E = sum + (size_t)(ml_sidx(grp, b, head, c) * 2 + dir) * MLSUM_STRIDE;
            const float A = E[ML_AG], G = E[ML_AG + 1];
            const float m_new = fmaxf(A + m, G);
            const float sc = fexp(A + m - m_new), su = fexp(G - m_new);
            const size_t ob = (((size_t)b * DEPTH + l) * 2 + dir) * MLH + head;
            const u4v uo = *(const u4v*)((const bf16_t*)E + 8 * tid);
#pragma unroll
            for (int i = 0; i < 8; ++i) p.out[O_MC + ob * 4096 + 8 * tid + i] = sc * C[i] + su * bf2f((bf16_t)(uo[i >> 1] >> (16 * (i & 1))));
            if (tid < 64) p.out[O_MN + ob * 64 + tid] = sc * nst + su * E[ML_NU + tid];
            if (tid == 0) p.out[O_MM + ob] = m_new;
        }
    }
    {
        const int row = tid >> 3, ch = tid & 7;
#pragma unroll
        for (int dir = 0; dir < 2; ++dir) {
            const int pr = dir ? 63 - row : row;
            *(u4v*)(Qs + dir * ATT_TILE + pr * LROW + ch * 16) = q_r;
            *(u4v*)(Ks + dir * ATT_TILE + pr * LROW + ch * 16) = k_r;
#pragma unroll
            for (int j = 0; j < 8; ++j) *(bf16_t*)(VT + dir * ATT_TILE + (ch * 8 + j) * LROW + pr * 2) = (bf16_t)(v_r[j >> 1] >> (16 * (j & 1)));
        }
    }
    __syncthreads();
    if (wave < 2) {
        const int dir = wave;
        const float ig = g_i, lf = logsigmoidf_(g_f);
        const float bj = lane_prefix_sum(lf, lane);
        const float a = ig - bj;
        const float Pj = lane_prefix_max(a, lane);
        aS[dir * 64 + lane] = a; bS[dir * 64 + lane] = bj; MjS[dir * 64 + lane] = fmaxf(scal[dir], Pj);
    } else if (wave < 4) {
        const int dir = wave - 2;
        float s = 0.f;
        for (int k = 0; k < 64; ++k) s += bf2f(*(const bf16_t*)(Qs + dir * ATT_TILE + lane * LROW + k * 2)) * nS[dir * 64 + k];
        qnS[dir * 64 + lane] = s;
    }
    __syncthreads();
    const int dir = wave >> 2, rt = (wave >> 1) & 1, jt = wave & 1;
    const int j = jt * 32 + l31;
    const float Mj = MjS[dir * 64 + j];
    {
        f16v acc = f16zero();
#pragma unroll
        for (int s4 = 0; s4 < 4; ++s4) {
            const s8v af = *(const s8v*)(Ks + dir * ATT_TILE + (rt * 32 + l31) * LROW + (16 * s4 + 8 * h) * 2);
            const s8v bf = *(const s8v*)(Qs + dir * ATT_TILE + j * LROW + (16 * s4 + 8 * h) * 2);
            acc = mfma32(af, bf, acc);
        }
        float dsum = 0.f;
#pragma unroll
        for (int g = 0; g < 4; ++g) {
            float o[4];
#pragma unroll
            for (int q = 0; q < 4; ++q) {
                const int s = rt * 32 + 8 * g + 4 * h + q;
                const float w = s <= j ? fexp(aS[dir * 64 + s] - Mj) : 0.f;
                o[q] = acc[4 * g + q] * w; dsum += o[q];
            }
            u2v pk; pk[0] = pack2(o[0], o[1]); pk[1] = pack2(o[2], o[3]);
            *(u2v*)(QK + dir * ATT_TILE + j * LROW + (rt * 32 + 8 * g + 4 * h) * 2) = pk;
        }
        dsum += __shfl_xor(dsum, 32);
        if (h == 0) denp[(dir * 2 + rt) * 64 + j] = dsum;
    }
    __syncthreads();
    {
        const float mst = scal[dir];
        const float decay = fexp(mst - Mj);
        f16v acc = f16zero();
#pragma unroll
        for (int s4 = 0; s4 < 4; ++s4) {
            const s8v af = *(const s8v*)(CT + dir * ATT_TILE + (rt * 32 + l31) * LROW + (16 * s4 + 8 * h) * 2);
            const s8v bf = *(const s8v*)(Qs + dir * ATT_TILE + j * LROW + (16 * s4 + 8 * h) * 2);
            acc = mfma32(af, bf, acc);
        }
        acc *= decay;
#pragma unroll
        for (int s4 = 0; s4 < 4; ++s4) {
            const s8v af = *(const s8v*)(VT + dir * ATT_TILE + (rt * 32 + l31) * LROW + (16 * s4 + 8 * h) * 2);
            const s8v bf = *(const s8v*)(QK + dir * ATT_TILE + j * LROW + (16 * s4 + 8 * h) * 2);
            acc = mfma32(af, bf, acc);
        }
        const float den = decay * qnS[dir * 64 + j] + denp[(dir * 2) * 64 + j] + denp[(dir * 2 + 1) * 64 + j];
        const float dn = fmaxf(fabsf(den), fexp(-(bS[dir * 64 + j] + Mj)));
        const float inv = 1.f / dn;
#pragma unroll
        for (int g = 0; g < 4; ++g) { f4v o; o[0] = acc[4 * g] * inv; o[1] = acc[4 * g + 1] * inv; o[2] = acc[4 * g + 2] * inv; o[3] = acc[4 * g + 3] * inv;
            *(f4v*)(hS + (dir * 64 + j) * 68 + rt * 32 + 8 * g + 4 * h) = o; }
    }
    __syncthreads();
    {
        const int tau = tid >> 3, v8 = (tid & 7) * 8;
        float hv[8]; float s = 0.f;
#pragma unroll
        for (int q = 0; q < 8; ++q) { hv[q] = hS[tau * 68 + v8 + q] + hS[(64 + 63 - tau) * 68 + v8 + q]; s += hv[q]; }
        s += __shfl_xor(s, 1); s += __shfl_xor(s, 2); s += __shfl_xor(s, 4);
        const float mu = s * (1.f / 64.f);
        float qq = 0.f;
#pragma unroll
        for (int q = 0; q < 8; ++q) { const float dlt = hv[q] - mu; qq += dlt * dlt; }
        qq += __shfl_xor(qq, 1); qq += __shfl_xor(qq, 2); qq += __shfl_xor(qq, 4);
        const float rstd = frsqrt(qq * (1.f / 64.f) + EPS);
        const int t = tb + tau;
        const u4v ov = o_r;
        const float* ng = p.in[I_MLG] + (size_t)l * 256 + head * 64 + v8;
        float o[8];
#pragma unroll
        for (int q = 0; q < 8; ++q) { const float og = bf2f((bf16_t)(ov[q >> 1] >> (16 * (q & 1)))); o[q] = (hv[q] - mu) * rstd * ng[q] * sigmoidf_(og); }
        u4v pk; pk[0] = pack2(o[0], o[1]); pk[1] = pack2(o[2], o[3]); pk[2] = pack2(o[4], o[5]); pk[3] = pack2(o[6], o[7]);
        *(u4v*)((bf16_t*)(p.ws + WS_MIXED) + (size_t)t * MIXW + 384 + head * 64 + v8) = pk;
    }
    __syncthreads();
}

DEV int queue_fetch(const Params& p, int qi) {
#ifdef EMU
    unsigned* w = (unsigned*)(p.ws + WS_BAR) + QUEUE_WORD0 + 64 * qi; return (int)(*w)++;
#else
    return (int)__hip_atomic_fetch_add((unsigned*)(p.ws + WS_BAR) + QUEUE_WORD0 + 64 * qi, 1u, __ATOMIC_RELAXED, __HIP_MEMORY_SCOPE_AGENT);
#endif
}
DEV int queue_publish(char* smem, int ticket) {
    int* slot = (int*)(smem + SMEM_XB + 32);
    __syncthreads();
    if (threadIdx.x == 0) *slot = ticket;
    __syncthreads();
    return *slot;
}
DEV void phase_attn(const Params& p, char* smem, int l, int qi) {
    constexpr int QB_S = DEC_SEQ / 256, QB_P = SEQ / 256;
    constexpr int U_SG = DEC_BATCH * GQH * QB_S * GQ_SPLIT, U_SN = DEC_BATCH * NAH * QB_S * NA_SPLIT, U_PN = BATCH * NAH * QB_P, U_PG = BATCH * GQH * QB_P;
    constexpr int U_MP = BATCH * MLH * (NCH_P / MLG), U_MS = DEC_BATCH * MLH * (NCH_S / MLG);
    constexpr int NU = U_SG + U_SN + U_PN + U_PG + U_MP + U_MS;
    const bf16_t* naq = (const bf16_t*)(p.ws + WS_NAQ); const bf16_t* nak = (const bf16_t*)(p.ws + WS_NAK); const bf16_t* nav = (const bf16_t*)(p.ws + WS_NAV);
    const bf16_t* gqq = (const bf16_t*)(p.ws + WS_GQQ); const bf16_t* gqk = (const bf16_t*)(p.ws + WS_GQK); const bf16_t* gqv = (const bf16_t*)(p.ws + WS_GQV);
    bf16_t* mixed = (bf16_t*)(p.ws + WS_MIXED);
    int ticket = (int)blockIdx.x;
    for (;;) {
        int u = queue_publish(smem, ticket);
        if (u >= NU) break;
        if (threadIdx.x == 0) ticket = queue_fetch(p, qi) + (int)gridDim.x;
#ifdef PROBE_ATT
        if (qi >= 8) { const int cls = u < U_SN ? 2 : u < U_SG + U_SN ? 1 : u < U_SG + U_SN + U_PN + U_PG ? 3 : 4; if (cls != PROBE_ATT) continue; }
#endif
        AttnDesc d; d.na = 0; d.r0 = 0; d.rlo = 0; d.rpb = nullptr; d.part = nullptr; d.out = nullptr; d.ostride = MIXW; d.n0 = 0; d.k0 = d.v0 = nullptr; d.stride0 = 0;
        if (u < U_SN) {
            const int uu = u; const int part = uu % NA_SPLIT, qb = (uu / NA_SPLIT) % QB_S, hd = (uu / (NA_SPLIT * QB_S)) % NAH, b = uu / (NA_SPLIT * QB_S * NAH);
            const size_t t0 = (size_t)NP + (size_t)b * DEC_SEQ;
            d.q = naq + (t0 + qb * 256) * 384 + hd * 64; d.qstride = 384;
            d.na = 1; d.r0 = qb * 4;
            const int rlo = na_row_start(d.r0), rhi = na_row_start(d.r0 + 3) + KR;
            constexpr int NCT = PAST / 64, L0 = 8 - NCT;
            static_assert(NA_SPLIT == 2 && NCT < 8 && ROWS >= 16, "S-NA key split");
            d.stride0 = 384; d.stride1 = 384;
            if (part == 0) {
                d.rlo = rlo; d.n0 = NCT; d.ntiles = NCT + L0;
                const size_t co = (((size_t)b * DEPTH + l) * PAST) * 384 + hd * 64;
                d.k0 = (const bf16_t*)(p.ws + WS_CNAK) + co; d.v0 = (const bf16_t*)(p.ws + WS_CNAV) + co;
            } else { d.rlo = rlo + L0; d.n0 = 0; d.ntiles = (rhi - rlo) - L0; }
            d.k1 = nak + (t0 + (size_t)d.rlo * 64) * 384 + hd * 64; d.v1 = nav + (t0 + (size_t)d.rlo * 64) * 384 + hd * 64;
            d.rpb = p.in[I_RPB] + ((size_t)l * NAH + hd) * 15 * 31;
            d.part = (float*)(p.ws + WS_PART) + (size_t)(N_PART_GQ + uu) * PART_STRIDE;
        } else if (u < U_SN + U_SG) {
            const int uu = u - U_SN;
            const int part = uu % GQ_SPLIT, qb = (uu / GQ_SPLIT) % QB_S, qh = (uu / (GQ_SPLIT * QB_S)) % GQH, b = uu / (GQ_SPLIT * QB_S * GQH);
            const int kvh = qh / (GQH / GQKV);
            constexpr int NCT = PAST / 64, TT = NCT + DEC_SEQ / 64, TP = TT / GQ_SPLIT;
            static_assert(TT % GQ_SPLIT == 0 && TP % 2 == 0 && TP >= NCT, "S-GQA key split");
            const size_t tq = (size_t)NP + (size_t)b * DEC_SEQ + qb * 256;
            d.q = gqq + tq * 384 + qh * 64; d.qstride = 384;
            const bf16_t* lk = gqk + ((size_t)NP + (size_t)b * DEC_SEQ) * 128 + kvh * 64; const bf16_t* lv = gqv + ((size_t)NP + (size_t)b * DEC_SEQ) * 128 + kvh * 64;
            d.ntiles = TP; d.stride1 = 128;
            if (part == 0) {
                d.n0 = NCT; d.stride0 = 128;
                const size_t co = (((size_t)b * DEPTH + l) * PAST) * 128 + kvh * 64;
                d.k0 = (const bf16_t*)(p.ws + WS_CGQK) + co; d.v0 = (const bf16_t*)(p.ws + WS_CGQV) + co;
                d.k1 = lk; d.v1 = lv;
            } else {
                d.n0 = 0;
                d.k1 = lk + (size_t)(part * TP - NCT) * 64 * 128; d.v1 = lv + (size_t)(part * TP - NCT) * 64 * 128;
            }
            d.part = (float*)(p.ws + WS_PART) + (size_t)uu * PART_STRIDE;
        } else if (u < U_SG + U_SN + U_PN) {
            const int uu = u - U_SG - U_SN; const int qb = uu % QB_P, hd = (uu / QB_P) % NAH, b = uu / (QB_P * NAH);
            const size_t t0 = (size_t)b * SEQ;
            d.q = naq + (t0 + qb * 256) * 384 + hd * 64; d.qstride = 384;
            d.n0 = 0; d.ntiles = SEQ / 64; d.stride1 = 384; d.k1 = nak + t0 * 384 + hd * 64; d.v1 = nav + t0 * 384 + hd * 64;
            d.out = mixed + (t0 + qb * 256) * MIXW + hd * 64;
        } else if (u < U_SG + U_SN + U_PN + U_PG) {
            const int uu = u - U_SG - U_SN - U_PN; const int qb = uu % QB_P, qh = (uu / QB_P) % GQH, b = uu / (QB_P * GQH);
            const int kvh = qh / (GQH / GQKV);
            const size_t t0 = (size_t)b * SEQ;
            d.q = gqq + (t0 + qb * 256) * 384 + qh * 64; d.qstride = 384;
            d.n0 = 0; d.ntiles = SEQ / 64; d.stride1 = 128; d.k1 = gqk + t0 * 128 + kvh * 64; d.v1 = gqv + t0 * 128 + kvh * 64;
            d.out = mixed + (t0 + qb * 256) * MIXW + 640 + qh * 64;
        } else {
            int uu = u - (U_SG + U_SN + U_PN + U_PG); const int grp = uu >= U_MP ? 1 : 0; if (grp) uu -= U_MP;
            const int nch = (grp ? NCH_S : NCH_P) / MLG;
            mlstm_summary_unit(p, smem, grp, uu / (nch * MLH), (uu / nch) % MLH, (uu % nch) * MLG);
        }
        if (u < U_SG + U_SN + U_PN + U_PG) attn_unit(smem, d);
    }
}

DEV void phase_mlout(const Params& p, char* smem, int l) {
    constexpr int QB_S = DEC_SEQ / 256;
    constexpr int U_MS = DEC_BATCH * MLH * NCH_S, U_MP = BATCH * MLH * NCH_P, U_CB = DEC_BATCH * GQH * QB_S;
    const int tid = get_tid(), lane = tid & 63, wave = tid >> 6;
    constexpr int U_CN = DEC_BATCH * NAH * QB_S;
    auto combine = [&](const float* p0, int nparts, bf16_t* dst0, int sl8) {
        const int qq = sl8 * 32 + (lane >> 1), d0 = (lane & 1) * 32;
        f4v ov[3][8]; float mp[3], lp[3];
#pragma unroll
        for (int s3 = 0; s3 < 3; ++s3) {
            const float* ps = p0 + (size_t)(s3 < nparts ? s3 : 0) * PART_STRIDE;
#pragma unroll
            for (int i = 0; i < 8; ++i) ov[s3][i] = *(const f4v*)(ps + (size_t)qq * 64 + d0 + 4 * i);
            mp[s3] = ps[256 * 64 + qq]; lp[s3] = ps[256 * 64 + 256 + qq];
        }
        float wp[3], m = -1e30f, den = 0.f;
#pragma unroll
        for (int s3 = 0; s3 < 3; ++s3) { if (s3 >= nparts) mp[s3] = -1e30f; m = fmaxf(m, mp[s3]); }
#pragma unroll
        for (int s3 = 0; s3 < 3; ++s3) { wp[s3] = s3 < nparts ? fexp2(mp[s3] - m) : 0.f; den += s3 < nparts ? lp[s3] * wp[s3] : 0.f; }
        const float inv = 1.f / den;
#pragma unroll
        for (int s3 = 0; s3 < 3; ++s3) wp[s3] *= inv;
        bf16_t* dst = dst0 + (size_t)qq * MIXW + d0;
#pragma unroll
        for (int i = 0; i < 4; ++i) {
            const f4v a = ov[0][2 * i] * wp[0] + ov[1][2 * i] * wp[1] + ov[2][2 * i] * wp[2], c = ov[0][2 * i + 1] * wp[0] + ov[1][2 * i + 1] * wp[1] + ov[2][2 * i + 1] * wp[2];
            u4v pk; pk[0] = pack2(a[0], a[1]); pk[1] = pack2(a[2], a[3]); pk[2] = pack2(c[0], c[1]); pk[3] = pack2(c[2], c[3]);
            *(u4v*)(dst + 8 * i) = pk;
        }
    };
    static_assert(GQ_SPLIT <= 3 && NA_SPLIT == 2, "combine");
    for (int tk = blockIdx.x + gridDim.x * wave; tk < (U_CB + U_CN) * 8; tk += gridDim.x * 8) {
        const int sl8 = tk & 7;
        if (tk < U_CB * 8) {
            const int uu = tk >> 3, qb = uu % QB_S, qh = (uu / QB_S) % GQH, b = uu / (QB_S * GQH);
            combine((const float*)(p.ws + WS_PART) + (size_t)(GQ_SPLIT * uu) * PART_STRIDE, GQ_SPLIT,
                    (bf16_t*)(p.ws + WS_MIXED) + ((size_t)NP + (size_t)b * DEC_SEQ + qb * 256) * MIXW + 640 + qh * 64, sl8);
        } else {
            const int uu = (tk >> 3) - U_CB, qb = uu % QB_S, hd = (uu / QB_S) % NAH, b = uu / (QB_S * NAH);
            combine((const float*)(p.ws + WS_PART) + (size_t)(N_PART_GQ + NA_SPLIT * uu) * PART_STRIDE, NA_SPLIT,
                    (bf16_t*)(p.ws + WS_MIXED) + ((size_t)NP + (size_t)b * DEC_SEQ + qb * 256) * MIXW + hd * 64, sl8);
        }
    }
    for (int u = blockIdx.x; u < U_MS + U_MP; u += gridDim.x) {
        const int grp = u < U_MS ? 1 : 0; const int uu = grp ? u : u - U_MS; const int nch = grp ? NCH_S : NCH_P;
        mlstm_output_unit(p, smem, l, grp, uu / (nch * MLH), (uu / nch) % MLH, uu % nch);
    }
}

constexpr int N_PHASES = 2 + 9 * DEPTH;
#ifndef EMU
typedef const __attribute__((address_space(4))) Params* KParamsPtr;
DEV void load_params(Params& p) {
    KParamsPtr kp = (KParamsPtr)__builtin_amdgcn_kernarg_segment_ptr();
    asm volatile("" : "+s"(kp));
#pragma unroll
    for (int i = 0; i < N_IN; ++i) p.in[i] = kp->in[i];
    p.out = kp->out; p.ws = kp->ws; p.ph0 = kp->ph0; p.ph1 = kp->ph1;
}
#endif
#ifdef EMU
static char emu_smem[SMEM_BYTES + 64];
#endif
__global__ void __launch_bounds__(512, 2) mega_kernel(Params p_) {
    const int ph0 = p_.ph0, ph1 = p_.ph1;
#ifdef EMU
    char* smem = emu_smem;
#define GRID_SYNC() do {} while (0)
#define GRID_SYNC_W(warm) do {} while (0)
#else
    extern __shared__ __attribute__((aligned(16))) char smem[];
    if (threadIdx.x == 0) *(u4v*)(smem + SMEM_XB) = (u4v){0u, 0u, 0u, 0u};
    __syncthreads();
    (void)xcd_barrier_post((unsigned*)(p_.ws + WS_BAR), (volatile LAS unsigned*)(smem + SMEM_XB));
    const bool multi = (ph1 - ph0) > 1;
#define GRID_SYNC_W(warm) do { if (multi) { KParamsPtr kpb = (KParamsPtr)__builtin_amdgcn_kernarg_segment_ptr(); asm volatile("" : "+s"(kpb)); \
        XcdBarrier xb; xb.bar = (unsigned*)(kpb->ws + WS_BAR); xb.x = xb_xcc_id(); xb.st = (volatile LAS unsigned*)(smem + SMEM_XB); \
        xcd_barrier(xb, [&]() { const int tw = get_tid() - 64; (void)tw; warm; }); } } while (0)
#define GRID_SYNC() GRID_SYNC_W((void)0)
#endif
    int ph = 0;
#ifndef KIND_MASK
#define KIND_MASK 0x3ff
#endif
#ifdef EMU
#define LOAD_PARAMS() const Params& p = p_
#else
#define LOAD_PARAMS() Params p; load_params(p)
#endif
#ifndef DOUBLE_MASK
#define DOUBLE_MASK 0
#endif
#define PH_KIND() (ph == 0 ? 0 : ph == 1 + 9 * DEPTH ? 1 : 1 + (ph - 1) % 9)
#define RUN_PHASE_W(body, warm) do { if (((KIND_MASK >> PH_KIND()) & 1) && ph >= ph0 && ph < ph1) { \
    if (DOUBLE_MASK && ((DOUBLE_MASK >> PH_KIND()) & 1)) { { const int rep_ = 1; LOAD_PARAMS(); body; } GRID_SYNC(); } \
    { const int rep_ = 0; LOAD_PARAMS(); body; } if (ph + 1 < ph1) GRID_SYNC_W(warm); } ++ph; } while (0)
#define RUN_PHASE(body) RUN_PHASE_W(body, (void)0)
#ifndef NO_WARM
#define WARM(call) do { LOAD_PARAMS(); call; } while (0)
#else
#define WARM(call) (void)0
#endif
    RUN_PHASE(phase_ada(p, smem));
    for (int l = 0; l < DEPTH; ++l) {
        RUN_PHASE_W(phase_rows<0>(p, smem, l), WARM(warm_inproj(p, l, tw)));
        RUN_PHASE(phase_inproj<0>(p, smem, l));
        RUN_PHASE(phase_attn(p, smem, l, l + DEPTH * rep_));
        RUN_PHASE_W(phase_mlout(p, smem, l), WARM(warm_outproj(p, l, tw)));
        RUN_PHASE(phase_outproj<0>(p, smem, l));
        RUN_PHASE(phase_rows<1>(p, smem, l));
        RUN_PHASE_W(phase_topk(p, smem), WARM(warm_gateup(p, l, tw)));
        RUN_PHASE_W(phase_gateup<0>(p, smem, l), WARM(warm_down(p, l, tw)));
        RUN_PHASE(phase_down<0>(p, smem, l));
    }
    RUN_PHASE(phase_rows<0>(p, smem, DEPTH));
#ifdef PROBE_BARRIERS
    for (int i = 0; i < PROBE_BARRIERS; ++i) GRID_SYNC();
#endif
}

#if !defined(EMU) && defined(PROBE_KIND)
__global__ void __launch_bounds__(512, 2) probe_kernel(Params p) {
    extern __shared__ __attribute__((aligned(16))) char smem[];
    for (int r = 0; r < PROBE_REPS; ++r) {
#if PROBE_KIND == 8
        phase_gateup<PROBE_VAR>(p, smem, 1);
#elif PROBE_KIND == 9
        phase_down<PROBE_VAR>(p, smem, 1);
#elif PROBE_KIND == 2
        phase_inproj<PROBE_VAR>(p, smem, 1);
#elif PROBE_KIND == 5
        phase_outproj<PROBE_VAR>(p, smem, 1);
#elif PROBE_KIND == 0
        phase_ada(p, smem);
#elif PROBE_KIND == 1
        phase_rows<0>(p, smem, 1);
#elif PROBE_KIND == 6
        phase_rows<1>(p, smem, 1);
#elif PROBE_KIND == 7
        phase_topk(p, smem);
#elif PROBE_KIND == 3
        phase_attn(p, smem, 1, 8 + r);
#elif PROBE_KIND == 4
        phase_mlout(p, smem, 1);
#endif
        __syncthreads();
    }
}
#endif
#ifndef EMU
#ifndef MK_N_LAUNCHES
#define MK_N_LAUNCHES 1
#endif
extern "C" void kernel_launch(void* const* d_in, const int* in_sizes, int n_in, void* d_out, int out_size, void* d_ws, size_t ws_size, hipStream_t stream) {
    (void)in_sizes; (void)n_in; (void)out_size; (void)ws_size;
    static int grid = 0;
    if (!grid) {
        int dev = 0, cus = 0, per_cu = 0;
        (void)hipGetDevice(&dev);
        (void)hipDeviceGetAttribute(&cus, hipDeviceAttributeMultiprocessorCount, dev);
        (void)hipFuncSetAttribute((const void*)mega_kernel, hipFuncAttributeMaxDynamicSharedMemorySize, SMEM_BYTES);
        (void)hipOccupancyMaxActiveBlocksPerMultiprocessor(&per_cu, mega_kernel, 512, SMEM_BYTES);
        grid = cus * (per_cu < 1 ? per_cu : 1);
        if (grid <= 0) grid = cus;
    }
    (void)hipMemsetAsync((char*)d_ws + WS_BAR, 0, WS_BAR_BYTES, stream);
    Params p = {};
    for (int i = 0; i < N_IN; ++i) p.in[i] = (const float*)d_in[i];
    p.out = (float*)d_out; p.ws = (char*)d_ws;
#if MK_N_LAUNCHES == 1
    p.ph0 = 0; p.ph1 = N_PHASES;
    mega_kernel<<<dim3(grid), dim3(512), SMEM_BYTES, stream>>>(p);
#ifdef PROBE_KIND
    (void)hipFuncSetAttribute((const void*)probe_kernel, hipFuncAttributeMaxDynamicSharedMemorySize, SMEM_BYTES);
    probe_kernel<<<dim3(grid), dim3(512), SMEM_BYTES, stream>>>(p);
#endif
#else
    for (int ph = 0; ph < N_PHASES; ++ph) { p.ph0 = ph; p.ph1 = ph + 1; mega_kernel<<<dim3(grid), dim3(512), SMEM_BYTES, stream>>>(p); }
#endif
}
#endif
```
